# Optimizing an MI355X kernel written in HIP

```python
import math
import jax, jax.numpy as jnp
from jax import lax
import numpy as np

D_MODEL = 1024
BATCH = 16
SEQ = 4096
DEPTH = 4

GRID_W = 64
CTX_LEN = 256

NA_HEADS = 8
NA_HEAD_DIM = 64
NA_WIDTH = NA_HEADS * NA_HEAD_DIM
NA_WIN_ROWS = 8
NA_WIN_COLS = 16

GLA_HEADS = 4
GLA_DK = 32
GLA_DV = 64
GLA_KEY_WIDTH = GLA_HEADS * GLA_DK
GLA_WIDTH = GLA_HEADS * GLA_DV
GLA_RANK = 16
GLA_GATE_NORM = 16.0
GLA_CHUNK = 64

HY_CH = 256
HY_ORDER = 2
HY_SHORT = 3
HY_BANDS = 16
HY_EMB = 1 + 2 * HY_BANDS
HY_FILTER_HIDDEN = 64
HY_TARGET = 1e-2
HY_FAST_DECAY = 0.3
HY_SLOW_DECAY = 1.5

MIX_WIDTH = NA_WIDTH + GLA_WIDTH + HY_CH
IN_SPLITS = (NA_WIDTH, NA_WIDTH, NA_WIDTH, GLA_KEY_WIDTH, GLA_KEY_WIDTH, GLA_WIDTH, GLA_WIDTH, 2 * GLA_RANK, (HY_ORDER + 1) * HY_CH)
D_IN = sum(IN_SPLITS)

ROPE_BASE = 10000.0

N_EXPERTS = 128
TOP_K = 8
N_GROUPS = 8
TOPK_GROUPS = 4
EXPERT_HIDDEN = 256
SHARED_HIDDEN = 256
ROUTED_SCALE = 2.5
MOE_BLOCK = 64

DEEPNORM_ALPHA = (2 * DEPTH) ** 0.25
DEEPNORM_BETA = (8 * DEPTH) ** -0.25
LN_EPS = 1e-6

kernel_name = 'hybrid_na_gla_hyena_moe_diffusion_block'


def layer_norm(x, g, b):
    xf = x.astype(jnp.float32)
    mu = xf.mean(-1, keepdims=True)
    var = jnp.square(xf - mu).mean(-1, keepdims=True)
    return ((xf - mu) * lax.rsqrt(var + LN_EPS) * g + b).astype(x.dtype)


def split_cols(u):
    idx = [int(i) for i in np.cumsum(IN_SPLITS)[:-1]]
    return jnp.split(u, idx, axis=-1)


def rope_axial_2d(t, row, col):
    half = t.shape[-1] // 2
    quarter = half // 2
    inv = ROPE_BASE ** (-jnp.arange(quarter, dtype=jnp.float32) / quarter)

    def rot(x, pos):
        ang = pos.astype(jnp.float32)[:, None] * inv
        cos = jnp.cos(ang)[None, :, None, :]
        sin = jnp.sin(ang)[None, :, None, :]
        x1, x2 = x[..., :quarter], x[..., quarter:]
        return jnp.concatenate([x1 * cos - x2 * sin, x1 * sin + x2 * cos], -1)

    return jnp.concatenate([rot(t[..., :half], row), rot(t[..., half:], col)], -1).astype(t.dtype)


def na_tables(rows, rpb):
    kh = min(NA_WIN_ROWS, rows)
    kw = NA_WIN_COLS
    r = jnp.arange(rows)
    c = jnp.arange(GRID_W)
    kr = jnp.clip(r - kh // 2, 0, rows - kh)[:, None] + jnp.arange(kh)
    kc = jnp.clip(c - kw // 2, 0, GRID_W - kw)[:, None] + jnp.arange(kw)
    idx = (kr[:, None, :, None] * GRID_W + kc[None, :, None, :]).reshape(rows, GRID_W, kh * kw)
    dr = kr - r[:, None] + NA_WIN_ROWS - 1
    dc = kc - c[:, None] + NA_WIN_COLS - 1
    bias = rpb[:, dr[:, None, :, None], dc[None, :, None, :]]
    bias = bias.reshape(rpb.shape[0], rows, GRID_W, kh * kw).transpose(1, 0, 2, 3)
    return idx, bias


def na_attention(q, k, v, k_ctx, v_ctx, rows, rpb):
    B, L, H, d = q.shape
    idx, bias = na_tables(rows, rpb)
    scale = d ** -0.5
    q_rows = q.reshape(B, rows, GRID_W, H, d).transpose(1, 0, 2, 3, 4)

    def row_block(args):
        q_r, idx_r, bias_r = args
        k_g = k[:, idx_r]
        v_g = v[:, idx_r]
        s_loc = jnp.einsum('bwhd,bwkhd->bhwk', q_r, k_g).astype(jnp.float32) * scale + bias_r.astype(jnp.float32)[None]
        s_ctx = jnp.einsum('bwhd,bchd->bhwc', q_r, k_ctx).astype(jnp.float32) * scale
        p = jax.nn.softmax(jnp.concatenate([s_loc, s_ctx], -1), axis=-1).astype(q.dtype)
        n_loc = idx_r.shape[-1]
        return (jnp.einsum('bhwk,bwkhd->bwhd', p[..., :n_loc], v_g)
                + jnp.einsum('bhwc,bchd->bwhd', p[..., n_loc:], v_ctx))

    o = lax.map(row_block, (q_rows, idx, bias))
    return o.transpose(1, 0, 2, 3, 4).reshape(B, L, H * d)


def ctx_attention(q, k, v):
    B, C, H, d = q.shape
    s = jnp.einsum('bqhd,bkhd->bhqk', q, k).astype(jnp.float32) * d ** -0.5
    p = jax.nn.softmax(s, axis=-1).astype(q.dtype)
    return jnp.einsum('bhqk,bkhd->bqhd', p, v).reshape(B, C, H * d)


def gla_chunked(q, k, v, log_a, s0):
    B, L, H, dk = q.shape
    dv = v.shape[-1]
    n = L // GLA_CHUNK

    def chunks(t):
        return t.astype(jnp.float32).reshape(B, n, GLA_CHUNK, H, t.shape[-1]).transpose(1, 0, 2, 3, 4)

    tri = jnp.tril(jnp.ones((GLA_CHUNK, GLA_CHUNK), bool))

    def step(s, inp):
        qc, kc, vc, ac = inp
        b = jnp.cumsum(ac, axis=1)
        qt = qc * jnp.exp(b)
        kt = kc * jnp.exp(-b)
        att = jnp.where(tri[None, None], jnp.einsum('bihd,bjhd->bhij', qt, kt), 0.0)
        o = jnp.einsum('bhij,bjhv->bihv', att, vc) + jnp.einsum('bihd,bhdv->bihv', qt, s)
        b_last = b[:, -1]
        s_new = jnp.exp(b_last)[..., None] * s + jnp.einsum('bjhd,bjhv->bhdv', kc * jnp.exp(b_last[:, None] - b), vc)
        return s_new, o

    s_fin, o = lax.scan(step, s0, (chunks(q), chunks(k), chunks(v), chunks(log_a)))
    return o.transpose(1, 0, 2, 3, 4).reshape(B, L, H, dv), s_fin


def gla_bidir(q, k, v, la_f, la_b, s0_f, s0_b):
    o_f, s_f = gla_chunked(q, k, v, la_f, s0_f)
    flip = lambda t: jnp.flip(t, axis=1)
    o_b, s_b = gla_chunked(flip(q), flip(k), flip(v), flip(la_b), s0_b)
    return o_f + flip(o_b), s_f, s_b


def gla_inputs(gq, gk, gv, glr, w_a2, b_a2):
    B, L, _ = gq.shape
    q = gq.reshape(B, L, GLA_HEADS, GLA_DK) * GLA_DK ** -0.5
    k = gk.reshape(B, L, GLA_HEADS, GLA_DK)
    v = gv.reshape(B, L, GLA_HEADS, GLA_DV)
    lr = glr.reshape(B, L, 2, GLA_RANK)
    logit = jnp.einsum('bldr,drk->bldk', lr, w_a2) + b_a2
    la = (jax.nn.log_sigmoid(logit.astype(jnp.float32)) / GLA_GATE_NORM).reshape(B, L, 2, GLA_HEADS, GLA_DK)
    return q, k, v, la[:, :, 0], la[:, :, 1]


def gla_output(o, r, g):
    B, L = o.shape[:2]
    of = o.astype(jnp.float32)
    of = of * lax.rsqrt(jnp.mean(of * of, -1, keepdims=True) + LN_EPS) * g
    return (of.reshape(B, L, GLA_WIDTH) * jax.nn.silu(r.astype(jnp.float32))).astype(r.dtype)


def short_conv_centred(u, w, b):
    L = u.shape[1]
    pad = HY_SHORT // 2
    up = jnp.pad(u, ((0, 0), (pad, HY_SHORT - 1 - pad), (0, 0)))
    y = b
    for j in range(HY_SHORT):
        y = y + up[:, j:j + L] * w[j]
    return y


def hyena_filters(L, w1, b1, f1, w2, b2, f2, w3, b3, decay):
    t = jnp.linspace(0.0, 1.0, L, dtype=jnp.float32)
    w = 2.0 * math.pi * jnp.arange(L, dtype=jnp.float32) / L
    bands = jnp.linspace(1e-4, HY_BANDS - 1, HY_BANDS, dtype=jnp.float32)
    ang = w[:, None] * bands[None]
    z = jnp.concatenate([t[:, None], jnp.cos(ang), -jnp.sin(ang)], -1)
    h = jnp.sin(f1 * (z @ w1 + b1))
    h = jnp.sin(f2 * (h @ w2 + b2))
    h = (h @ w3 + b3).reshape(L, HY_ORDER, 2, HY_CH)
    window = jnp.exp(-t[:, None, None, None] * jnp.abs(decay)[None])
    return (h * window).astype(jnp.float32)


def bidir_long_conv(u, h_fwd, h_bwd, d_skip):
    B, L, C = u.shape
    kern = jnp.concatenate([h_fwd, jnp.zeros((1, C), h_fwd.dtype), h_bwd[:0:-1]], axis=0)
    kf = jnp.fft.rfft(kern, n=2 * L, axis=0)
    uf32 = u.astype(jnp.float32)
    uf = jnp.fft.rfft(uf32, n=2 * L, axis=1)
    y = jnp.fft.irfft(uf * kf[None], n=2 * L, axis=1)[:, :L]
    return (y + uf32 * d_skip).astype(u.dtype)


def hyena_mixer(hu, short_w, short_b, w1, b1, f1, w2, b2, f2, w3, b3, decay, skip):
    L = hu.shape[1]
    hu = short_conv_centred(hu, short_w, short_b)
    parts = jnp.split(hu, HY_ORDER + 1, axis=-1)
    filt = hyena_filters(L, w1, b1, f1, w2, b2, f2, w3, b3, decay)
    z = parts[0]
    for o in range(HY_ORDER):
        z = parts[o + 1] * bidir_long_conv(z, filt[:, o, 0], filt[:, o, 1], skip[o])
    return z


def swiglu(x, wg, wu, wd):
    return (jax.nn.silu(x @ wg) * (x @ wu)) @ wd


def route(h, w_router, b_corr):
    logits = jnp.einsum('btd,de->bte', h, w_router).astype(jnp.float32)
    s = jax.nn.sigmoid(logits)
    sel = s + b_corr.astype(jnp.float32)
    B, T, E = s.shape
    per = E // N_GROUPS
    grp_score = lax.top_k(sel.reshape(B, T, N_GROUPS, per), 2)[0].sum(-1)
    _, gidx = lax.top_k(grp_score, TOPK_GROUPS)
    gmask = jax.nn.one_hot(gidx, N_GROUPS, dtype=jnp.float32).sum(-2)
    emask = jnp.repeat(gmask, per, axis=-1) > 0
    _, eidx = lax.top_k(jnp.where(emask, sel, -jnp.inf), TOP_K)
    w = jnp.take_along_axis(s, eidx, axis=-1)
    w = w / w.sum(-1, keepdims=True) * ROUTED_SCALE
    return eidx, w


def expert_dispatch(hs, ei, wi, we_g, we_u, we_d):
    T, D = hs.shape
    E = we_g.shape[0]
    M = T * TOP_K
    e_flat = ei.reshape(M)
    tok = jnp.arange(M) // TOP_K
    w_flat = wi.reshape(M)
    order = jnp.argsort(e_flat)
    e_s, tok_s, w_s = e_flat[order], tok[order], w_flat[order]
    counts = jnp.bincount(e_flat, length=E)
    starts = jnp.cumsum(counts) - counts
    padded = (counts + MOE_BLOCK - 1) // MOE_BLOCK * MOE_BLOCK
    pends = jnp.cumsum(padded)
    pstarts = pends - padded
    dest = pstarts[e_s] + jnp.arange(M) - starts[e_s]
    n_blk = -(-M // MOE_BLOCK) + E
    buf = jnp.zeros((n_blk * MOE_BLOCK, D), hs.dtype).at[dest].set(hs[tok_s])
    blk_e = jnp.minimum(jnp.searchsorted(pends, jnp.arange(n_blk) * MOE_BLOCK, side='right'), E - 1)

    def block(args):
        xb, e = args
        return swiglu(xb, we_g[e], we_u[e], we_d[e])

    yb = lax.map(block, (buf.reshape(n_blk, MOE_BLOCK, D), blk_e)).reshape(n_blk * MOE_BLOCK, D)
    return jnp.zeros((T, D), jnp.float32).at[tok_s].add(yb[dest].astype(jnp.float32) * w_s[:, None])


def moe_ffn(h, w_router, b_corr, we_g, we_u, we_d, ws_g, ws_u, ws_d):
    eidx, w = route(h, w_router, b_corr)
    routed = lax.map(lambda a: expert_dispatch(a[0], a[1], a[2], we_g, we_u, we_d), (h, eidx, w))
    return swiglu(h, ws_g, ws_u, ws_d) + routed.astype(h.dtype)


def setup_inputs(seed: int = 0) -> dict:
    key = jax.random.key(seed)
    keys = iter(jax.random.split(key, 48))

    def nrm(shape, std):
        return jax.random.normal(next(keys), shape, jnp.float32) * std

    D = D_MODEL
    hid = HY_FILTER_HIDDEN
    decay_base = jnp.linspace(math.log(HY_TARGET) / HY_SLOW_DECAY, math.log(HY_TARGET) / HY_FAST_DECAY, HY_CH, dtype=jnp.float32)
    return {
        'x': nrm((BATCH, SEQ, D), 1.0),
        'c': nrm((BATCH, D), 1.0),
        'ctx': nrm((BATCH, CTX_LEN, D), 1.0),
        'c_ctx': nrm((D,), 1.0),
        'w_mod': nrm((DEPTH, D, 6 * D), 0.5 * D ** -0.5),
        'b_mod': nrm((DEPTH, 6 * D), 0.02),
        'w_in': nrm((DEPTH, D, D_IN), D ** -0.5),
        'na_rpb': nrm((DEPTH, NA_HEADS, 2 * NA_WIN_ROWS - 1, 2 * NA_WIN_COLS - 1), 0.1),
        'gla_w_a2': nrm((DEPTH, 2, GLA_RANK, GLA_KEY_WIDTH), GLA_RANK ** -0.5),
        'gla_b_a2': nrm((DEPTH, 2, GLA_KEY_WIDTH), 0.1),
        'gla_norm_g': 1.0 + nrm((DEPTH, GLA_DV), 0.02),
        'hy_short_w': nrm((DEPTH, HY_SHORT, (HY_ORDER + 1) * HY_CH), HY_SHORT ** -0.5),
        'hy_short_b': nrm((DEPTH, (HY_ORDER + 1) * HY_CH), 0.02),
        'hy_w1': nrm((DEPTH, HY_EMB, hid), HY_EMB ** -0.5),
        'hy_b1': nrm((DEPTH, hid), 0.1),
        'hy_f1': 1.0 + nrm((DEPTH, hid), 0.1),
        'hy_w2': nrm((DEPTH, hid, hid), hid ** -0.5),
        'hy_b2': nrm((DEPTH, hid), 0.1),
        'hy_f2': 1.0 + nrm((DEPTH, hid), 0.1),
        'hy_w3': nrm((DEPTH, hid, HY_ORDER * 2 * HY_CH), 0.05 * hid ** -0.5),
        'hy_b3': nrm((DEPTH, HY_ORDER * 2 * HY_CH), 0.005),
        'hy_decay': decay_base + nrm((DEPTH, HY_ORDER, 2, HY_CH), 0.1),
        'hy_skip': nrm((DEPTH, HY_ORDER, HY_CH), 0.5),
        'w_out': nrm((DEPTH, MIX_WIDTH, D), MIX_WIDTH ** -0.5 * DEEPNORM_BETA),
        'ln1_g': 1.0 + nrm((DEPTH, D), 0.02),
        'ln1_b': nrm((DEPTH, D), 0.02),
        'router_w': nrm((DEPTH, D, N_EXPERTS), D ** -0.5),
        'router_b': nrm((DEPTH, N_EXPERTS), 0.01),
        'we_gate': nrm((DEPTH, N_EXPERTS, D, EXPERT_HIDDEN), D ** -0.5),
        'we_up': nrm((DEPTH, N_EXPERTS, D, EXPERT_HIDDEN), D ** -0.5),
        'we_down': nrm((DEPTH, N_EXPERTS, EXPERT_HIDDEN, D), EXPERT_HIDDEN ** -0.5 * DEEPNORM_BETA),
        'ws_gate': nrm((DEPTH, D, SHARED_HIDDEN), D ** -0.5),
        'ws_up': nrm((DEPTH, D, SHARED_HIDDEN), D ** -0.5),
        'ws_down': nrm((DEPTH, SHARED_HIDDEN, D), SHARED_HIDDEN ** -0.5 * DEEPNORM_BETA),
        'ln2_g': 1.0 + nrm((DEPTH, D), 0.02),
        'ln2_b': nrm((DEPTH, D), 0.02),
    }


def reference(x, c, ctx, c_ctx, w_mod, b_mod, w_in, na_rpb, gla_w_a2, gla_b_a2, gla_norm_g,
              hy_short_w, hy_short_b, hy_w1, hy_b1, hy_f1, hy_w2, hy_b2, hy_f2, hy_w3, hy_b3,
              hy_decay, hy_skip, w_out, ln1_g, ln1_b, router_w, router_b, we_gate, we_up, we_down,
              ws_gate, ws_up, ws_down, ln2_g, ln2_b):
    B, L, D = x.shape
    rows = L // GRID_W
    t = jnp.arange(L)
    row_pos, col_pos = t // GRID_W, t % GRID_W
    silu_c = jax.nn.silu(c)
    silu_cc = jax.nn.silu(c_ctx)
    xc = ctx

    def na_heads(a):
        return a.reshape(a.shape[0], a.shape[1], NA_HEADS, NA_HEAD_DIM)

    for l in range(DEPTH):
        last = l == DEPTH - 1
        hy_params = (hy_short_w[l], hy_short_b[l], hy_w1[l], hy_b1[l], hy_f1[l], hy_w2[l], hy_b2[l],
                     hy_f2[l], hy_w3[l], hy_b3[l], hy_decay[l], hy_skip[l])
        moe_params = (router_w[l], router_b[l], we_gate[l], we_up[l], we_down[l], ws_gate[l], ws_up[l], ws_down[l])
        mod = (silu_c @ w_mod[l] + b_mod[l])[:, None, :]
        mod_c = silu_cc @ w_mod[l] + b_mod[l]
        sh1, sc1, g1, sh2, sc2, g2 = jnp.split(mod, 6, axis=-1)
        sh1c, sc1c, g1c, sh2c, sc2c, g2c = jnp.split(mod_c, 6, axis=-1)

        u = (x * (1.0 + sc1) + sh1) @ w_in[l]
        uc = (xc * (1.0 + sc1c) + sh1c) @ w_in[l]
        nq, nk, nv, gq, gk, gv, gr, glr, hy = split_cols(u)
        nqc, nkc, nvc, gqc, gkc, gvc, grc, glrc, hyc = split_cols(uc)

        na_lat = na_attention(na_heads(nq), na_heads(nk), na_heads(nv), na_heads(nkc), na_heads(nvc), rows, na_rpb[l])

        q, k, v, la_f, la_b = gla_inputs(gq, gk, gv, glr, gla_w_a2[l], gla_b_a2[l])
        qc_, kc_, vc_, lac_f, lac_b = gla_inputs(gqc, gkc, gvc, glrc, gla_w_a2[l], gla_b_a2[l])
        zero_state = jnp.zeros((B, GLA_HEADS, GLA_DK, GLA_DV), jnp.float32)
        o_ctx, s_ctx_f, s_ctx_b = gla_bidir(qc_, kc_, vc_, lac_f, lac_b, zero_state, zero_state)
        q = rope_axial_2d(q, row_pos, col_pos)
        k = rope_axial_2d(k, row_pos, col_pos)
        o_lat, _, _ = gla_bidir(q, k, v, la_f, la_b, s_ctx_f, s_ctx_b)
        gla_lat = gla_output(o_lat, gr, gla_norm_g[l])

        hy_lat = hyena_mixer(hy, *hy_params)

        mix = jnp.concatenate([na_lat, gla_lat, hy_lat], axis=-1) @ w_out[l]
        x_new = layer_norm(DEEPNORM_ALPHA * x + g1 * mix, ln1_g[l], ln1_b[l])
        if not last:
            na_c = ctx_attention(na_heads(nqc), na_heads(nkc), na_heads(nvc))
            gla_c = gla_output(o_ctx, grc, gla_norm_g[l])
            hy_c = hyena_mixer(hyc, *hy_params)
            mix_c = jnp.concatenate([na_c, gla_c, hy_c], axis=-1) @ w_out[l]
            xc = layer_norm(DEEPNORM_ALPHA * xc + g1c * mix_c, ln1_g[l], ln1_b[l])
        x = x_new

        ff = moe_ffn(x * (1.0 + sc2) + sh2, *moe_params)
        x = layer_norm(DEEPNORM_ALPHA * x + g2 * ff, ln2_g[l], ln2_b[l])
        if not last:
            ffc = moe_ffn(xc * (1.0 + sc2c) + sh2c, *moe_params)
            xc = layer_norm(DEEPNORM_ALPHA * xc + g2c * ffc, ln2_g[l], ln2_b[l])
    return x
```

```cpp
#define MK_MULTI 1
#include <hip/hip_runtime.h>
#include <cstdio>
#include <cstdint>

#define LAS __attribute__((address_space(3)))
#define GAS __attribute__((address_space(1)))
typedef unsigned short bf16_t;
typedef short bf16x8 __attribute__((ext_vector_type(8)));
typedef float f32x4 __attribute__((ext_vector_type(4)));
typedef float f32x2 __attribute__((ext_vector_type(2)));
typedef unsigned u32x4 __attribute__((ext_vector_type(4)));
typedef unsigned u32x2 __attribute__((ext_vector_type(2)));

constexpr int NB = 16, SEQ = 4096, CTXL = 256, DM = 1024, DEPTH = 4;
constexpr int NLAT = NB * SEQ;
constexpr int NCTX = NB * CTXL;
constexpr int NROW = NLAT + NCTX;
constexpr int SPB = SEQ + CTXL;
constexpr int DIN_REF = 3104;
constexpr int DIN = 3328;
constexpr int UQ = 0, UK = 512, UV = 1024, UGQ = 1536, UGK = 1664, UGV = 1792, UGR = 2048, UHY = 2304, ULAF = 3072, ULAB = 3200;
constexpr int NEXP = 128, TOPK = 8, EH = 256;
constexpr int NE1 = NEXP + 1;
constexpr int RMAX = 659712;
constexpr int TMAX = RMAX / 256;
constexpr float LN_EPS = 1e-6f;
constexpr float DN_ALPHA = 1.6817928305074290f;

__device__ __forceinline__ unsigned f2bf(float f) { unsigned u = __builtin_bit_cast(unsigned, f); return (u + 0x7fffu + ((u >> 16) & 1u)) >> 16; }
__device__ __forceinline__ unsigned pk2(float lo, float hi) { return f2bf(lo) | (f2bf(hi) << 16); }
__device__ __forceinline__ float bf2f(unsigned short b) { return __builtin_bit_cast(float, ((unsigned)b) << 16); }
__device__ __forceinline__ float bflo(unsigned w) { return __builtin_bit_cast(float, w << 16); }
__device__ __forceinline__ float bfhi(unsigned w) { return __builtin_bit_cast(float, w & 0xffff0000u); }
__device__ __forceinline__ float shx(float v, int o, int lane) { return __builtin_bit_cast(float, __builtin_amdgcn_ds_bpermute((lane ^ o) << 2, __builtin_bit_cast(int, v))); }
__device__ __forceinline__ int shxi(int v, int o, int lane) { return __builtin_amdgcn_ds_bpermute((lane ^ o) << 2, v); }
__device__ __forceinline__ float shf(float v, int src) { return __builtin_bit_cast(float, __builtin_amdgcn_ds_bpermute(src << 2, __builtin_bit_cast(int, v))); }
__device__ __forceinline__ float wave_sum(float v, int lane) {
#pragma unroll
    for (int o = 1; o < 64; o <<= 1) v += shx(v, o, lane);
    return v;
}
__device__ __forceinline__ float silu_f(float x) { return x / (1.0f + __expf(-x)); }
#define LDS_WAIT() asm volatile("s_waitcnt lgkmcnt(0)" ::: "memory")
#define VM_WAIT() asm volatile("s_waitcnt vmcnt(0)" ::: "memory")

#define XB_TMO      128
#define XB_XCNT(j)  (256  + 64 * (j))
#define XB_XSUB(j)  (1280 + 64 * (j))
#define XB_XGEN(j)  (2304 + 64 * (j))
#define XB_TOP      3328
#define XB_TOPGEN   3392
#define XCD_BAR_WORDS 3456
#define XB_SPIN_CAP (1u << 18)

__device__ __forceinline__ unsigned xb_ld(unsigned* p)              { return __hip_atomic_load(p, __ATOMIC_RELAXED, __HIP_MEMORY_SCOPE_AGENT); }
__device__ __forceinline__ unsigned xb_add(unsigned* p, unsigned v) { return __hip_atomic_fetch_add(p, v, __ATOMIC_RELAXED, __HIP_MEMORY_SCOPE_AGENT); }
__device__ __forceinline__ unsigned xb_xcc_id() { return (unsigned)__builtin_amdgcn_s_getreg((3 << 11) | 20) & 0xFu; }
#define XB_SPIN(cond, bar) do { unsigned _sp = 0; while (cond) { __builtin_amdgcn_s_sleep(1); \
    if ((++_sp & 255u) == 0u) { if (xb_ld(&(bar)[XB_TMO])) break; if (_sp > XB_SPIN_CAP) { atomicAdd(&(bar)[XB_TMO], 1u); break; } } } } while (0)

struct XcdBarrier { unsigned* bar; unsigned x; volatile LAS unsigned* st; };

__device__ __forceinline__ XcdBarrier xcd_barrier_post(unsigned* bar, volatile LAS unsigned* st) {
    XcdBarrier b; b.bar = bar; b.x = xb_xcc_id(); b.st = st;
    if (threadIdx.x == 0) (void)xb_add(&bar[XB_XCNT(b.x)], 1u);
    return b;
}
__device__ __forceinline__ void xcd_barrier_complete(unsigned* bar, unsigned x, unsigned& nloc, unsigned& nx) {
    const unsigned G = gridDim.x * gridDim.y * gridDim.z;
    unsigned sum, cnt, mine, sp = 0u;
    for (;;) {
        sum = 0u; cnt = 0u; mine = 0u;
#pragma unroll
        for (unsigned j = 0; j < 16; ++j) { const unsigned c = xb_ld(&bar[XB_XCNT(j)]); sum += c; cnt += (c > 0u) ? 1u : 0u; mine = (j == x) ? c : mine; }
        if (sum == G) break;
        __builtin_amdgcn_s_sleep(1);
        if ((++sp & 255u) == 0u) { if (xb_ld(&bar[XB_TMO])) break; if (sp > XB_SPIN_CAP) { atomicAdd(&bar[XB_TMO], 1u); break; } }
    }
    nloc = mine > 0u ? mine : 1u; nx = cnt > 0u ? cnt : 1u;
}
__device__ __forceinline__ void xcd_barrier(const XcdBarrier& b) {
    asm volatile("s_waitcnt vmcnt(0)" ::: "memory");
    __syncthreads();
    if (threadIdx.x == 0) {
        unsigned* bar = b.bar;
        __builtin_amdgcn_s_waitcnt(0);
        unsigned nloc = b.st[0], nx = b.st[1];
        if (nloc == 0u) { xcd_barrier_complete(bar, b.x, nloc, nx); b.st[0] = nloc; b.st[1] = nx; }
        const unsigned old = xb_add(&bar[XB_XSUB(b.x)], 1u);
        const unsigned gen = old / nloc;
        if (old + 1u == (gen + 1u) * nloc) {
            __builtin_amdgcn_fence(__ATOMIC_RELEASE, "agent");
            asm volatile("s_waitcnt vmcnt(0)" ::: "memory");
            const unsigned og = xb_add(&bar[XB_TOP], 1u);
            const unsigned tg = og / nx;
            if (og + 1u == (tg + 1u) * nx) xb_add(&bar[XB_TOPGEN], 1u);
            else XB_SPIN(xb_ld(&bar[XB_TOPGEN]) == tg, bar);
            __builtin_amdgcn_fence(__ATOMIC_ACQUIRE, "agent");
            xb_add(&bar[XB_XGEN(b.x)], 1u);
            asm volatile("s_waitcnt vmcnt(0)" ::: "memory");
        } else {
            XB_SPIN(xb_ld(&bar[XB_XGEN(b.x)]) == gen, bar);
            __builtin_amdgcn_fence(__ATOMIC_ACQUIRE, "agent");
            asm volatile("s_waitcnt vmcnt(0)" ::: "memory");
        }
    }
    __syncthreads();
}

namespace pg8 {
constexpr int BM = 256, BK = 64, HALF = 128, HTB = HALF * BK * 2, STAGE_BYTES = 8 * HTB, NXCD = 8, WGM = 8;
__host__ __device__ __forceinline__ int lds_byte(int r, int c) { const int st = (r >> 4) * 2 + (c >> 5), rr = r & 15, cc = c & 31, ob = rr * 64 + cc * 2; return st * 1024 + (ob ^ (((ob >> 9) & 1) << 5)); }
__host__ __device__ __forceinline__ void stage_rc(int b, int& R, int& C) { const int st = b / 1024, sb = b % 1024, swz = sb ^ (((sb >> 9) & 1) << 5); R = (st >> 1) * 16 + swz / 64; C = (st & 1) * 32 + (swz % 64) / 2; }
__host__ __device__ __forceinline__ int perm32(int rho) { const int n = rho >> 4, i = rho & 15; return 8 * (i >> 2) + 4 * n + (i & 3); }

struct Unit { int arow0, brow0, orow0, ocol0, aux; };

struct DenseOrder {
    int nM, nN, nwg, G, c;
    __device__ void init(int M, int N, int G_, int c_) { nM = M / BM; nN = N / BM; nwg = nM * nN; G = G_; c = c_; }
    __device__ __forceinline__ bool next(int i, Unit& u) const {
        const long L = (long)i * G + c; if (L >= nwg) return false;
        int wgid = (int)L; { const int q = nwg / NXCD, r = nwg % NXCD, xcd = wgid % NXCD, off = wgid / NXCD; wgid = (xcd < r ? xcd * (q + 1) : r * (q + 1) + (xcd - r) * q) + off; }
        const int nig = WGM * nN, gid = wgid / nig, fm = gid * WGM, gsz = (nM - fm) < WGM ? (nM - fm) : WGM;
        const int pm = fm + ((wgid % nig) % gsz), pn = (wgid % nig) / gsz;
        u.arow0 = pm * BM; u.brow0 = pn * BM; u.orow0 = pm * BM; u.ocol0 = pn * BM; u.aux = 0; return true;
    }
};
struct GroupedOrder {
    const int* tile_exp; int ntiles, nN, G, c;
    __device__ __forceinline__ bool next(int i, Unit& u) const {
        const long L = (long)i * G + c; if (L >= (long)ntiles * nN) return false;
        const int t = (int)(L / nN), pn = (int)(L % nN);
        const int e = tile_exp[t];
        u.arow0 = t * BM; u.brow0 = (e * nN + pn) * BM; u.orow0 = t * BM; u.ocol0 = pn * BM; u.aux = e; return true;
    }
};

__device__ __forceinline__ unsigned cvt_pk_bf16(float lo, float hi) { unsigned r; asm volatile("v_cvt_pk_bf16_f32 %0, %1, %2" : "=v"(r) : "v"(lo), "v"(hi)); return r; }

struct EpiF32 {
    static constexpr bool PERM = false;
    float* C; int ldc;
    __device__ __forceinline__ void operator()(const f32x4 (&acc)[2][2][4][2], const Unit& u, int wr, int wc, int fr, int fq) const {
        const int row0 = u.orow0 + wr * 64 + fr, col0 = u.ocol0 + wc * 32 + 4 * fq;
#pragma unroll
        for (int ai = 0; ai < 2; ++ai)
#pragma unroll
            for (int m = 0; m < 4; ++m) { float* rowp = C + (size_t)(row0 + ai * HALF + m * 16) * ldc + col0;
#pragma unroll
                for (int bj = 0; bj < 2; ++bj)
#pragma unroll
                    for (int n = 0; n < 2; ++n) *(f32x4*)(rowp + bj * HALF + n * 16) = acc[ai][bj][m][n]; }
    }
};
struct EpiBf16 {
    static constexpr bool PERM = true;
    bf16_t* O; int ldc;
    __device__ __forceinline__ void operator()(const f32x4 (&acc)[2][2][4][2], const Unit& u, int wr, int wc, int fr, int fq) const {
        const int row0 = u.orow0 + wr * 64 + fr, col0 = u.ocol0 + wc * 32 + 8 * fq;
#pragma unroll
        for (int ai = 0; ai < 2; ++ai)
#pragma unroll
            for (int m = 0; m < 4; ++m) { bf16_t* rowp = O + (size_t)(row0 + ai * HALF + m * 16) * ldc + col0;
#pragma unroll
                for (int bj = 0; bj < 2; ++bj) { const f32x4 v0 = acc[ai][bj][m][0], v1 = acc[ai][bj][m][1];
                    u32x4 w; w.x = cvt_pk_bf16(v0[0], v0[1]); w.y = cvt_pk_bf16(v0[2], v0[3]); w.z = cvt_pk_bf16(v1[0], v1[1]); w.w = cvt_pk_bf16(v1[2], v1[3]);
                    *(u32x4*)(rowp + bj * HALF) = w; } }
    }
};
struct EpiSwiglu {
    static constexpr bool PERM = false;
    bf16_t* ACT;
    __device__ __forceinline__ void operator()(const f32x4 (&acc)[2][2][4][2], const Unit& u, int wr, int wc, int fr, int fq) const {
        const int row0 = u.orow0 + wr * 64 + fr, pn = u.ocol0 >> 8;
#pragma unroll
        for (int ai = 0; ai < 2; ++ai)
#pragma unroll
            for (int m = 0; m < 4; ++m) { bf16_t* rowp = ACT + (size_t)(row0 + ai * HALF + m * 16) * EH + wc * 16 + 4 * fq;
#pragma unroll
                for (int bj = 0; bj < 2; ++bj) { const f32x4 g = acc[ai][bj][m][0], up = acc[ai][bj][m][1]; float h[4];
#pragma unroll
                    for (int i = 0; i < 4; ++i) h[i] = g[i] / (1.0f + __expf(-g[i])) * up[i];
                    u32x2 w; w.x = cvt_pk_bf16(h[0], h[1]); w.y = cvt_pk_bf16(h[2], h[3]);
                    *(u32x2*)(rowp + (pn * 2 + bj) * 64) = w; } }
    }
};
struct EpiScatter {
    static constexpr bool PERM = true;
    bf16_t* Y2; const int* rowdst;
    __device__ __forceinline__ void operator()(const f32x4 (&acc)[2][2][4][2], const Unit& u, int wr, int wc, int fr, int fq) const {
        const int row0 = u.orow0 + wr * 64 + fr, col0 = u.ocol0 + wc * 32 + 8 * fq;
#pragma unroll
        for (int ai = 0; ai < 2; ++ai)
#pragma unroll
            for (int m = 0; m < 4; ++m) { const int dst = rowdst[row0 + ai * HALF + m * 16];
                if (dst >= 0) { bf16_t* rowp = Y2 + (size_t)dst * DM + col0;
#pragma unroll
                    for (int bj = 0; bj < 2; ++bj) { const f32x4 v0 = acc[ai][bj][m][0], v1 = acc[ai][bj][m][1];
                        u32x4 w; w.x = cvt_pk_bf16(v0[0], v0[1]); w.y = cvt_pk_bf16(v0[2], v0[3]); w.z = cvt_pk_bf16(v1[0], v1[1]); w.w = cvt_pk_bf16(v1[2], v1[3]);
                        *(u32x4*)(rowp + bj * HALF) = w; } } }
    }
};

template <class Epi, class Sched, bool GATHER>
__device__ __forceinline__ void gemm_phase(const int tid_in, LAS unsigned char* lds, const bf16_t* Ag, const bf16_t* Bg, const int K, const int* rowidx, const Sched& S, const Epi& E) {
    int tid_ = tid_in; asm volatile("" : "+v"(tid_));
    const int tid = tid_, wid = __builtin_amdgcn_readfirstlane(tid >> 6), lane = tid & 63, wr = wid >> 2, wc = wid & 3, fr = lane & 15, fq = lane >> 4;
    const int nt = K / BK;
    int RA[2]; unsigned colA[2], voffB[2];
#pragma unroll
    for (int i = 0; i < 2; ++i) { int R, C; stage_rc(tid * 16 + i * 8192, R, C); const int Rb = Epi::PERM ? ((R & ~31) + perm32(R & 31)) : R;
        RA[i] = R; colA[i] = (unsigned)C * 2u; voffB[i] = (unsigned)(Rb * K + C) * 2u; }
    const size_t kstep = (size_t)(BK * 2);
    const size_t hstep = (size_t)HALF * K * 2;
    const unsigned ldsw = (unsigned)wid * 1024u;
    const int aoff = lds_byte(wr * 64 + fr, fq * 8), boff = lds_byte(wc * 32 + fr, fq * 8);
#define PG8_SA(b, h) (((b) * 2 + (h)) * HTB)
#define PG8_SB(b, h) ((4 + (b) * 2 + (h)) * HTB)
#define PG8_STAGE_B(bufoff, gbase) do { _Pragma("unroll") for (int _i = 0; _i < 2; ++_i) \
        __builtin_amdgcn_global_load_lds((const unsigned*)((const char*)(gbase) + voffB[_i]), (LAS unsigned*)(lds + (bufoff) + ldsw + _i * 8192), 16, 0, 0); } while (0)
#define PG8_STAGE_A(bufoff, gbase, o0, o1) do { \
        __builtin_amdgcn_global_load_lds((const unsigned*)((const char*)(gbase) + (o0)), (LAS unsigned*)(lds + (bufoff) + ldsw), 16, 0, 0); \
        __builtin_amdgcn_global_load_lds((const unsigned*)((const char*)(gbase) + (o1)), (LAS unsigned*)(lds + (bufoff) + ldsw + 8192), 16, 0, 0); } while (0)
#define PG8_LDA(dst, b, h) do { _Pragma("unroll") for (int m = 0; m < 4; ++m) _Pragma("unroll") for (int k = 0; k < 2; ++k) dst[m][k] = *(const LAS bf16x8*)(lds + PG8_SA(b, h) + aoff + m * 2048 + k * 1024); } while (0)
#define PG8_LDB(dst, b, h) do { _Pragma("unroll") for (int n = 0; n < 2; ++n) _Pragma("unroll") for (int k = 0; k < 2; ++k) dst[n][k] = *(const LAS bf16x8*)(lds + PG8_SB(b, h) + boff + n * 2048 + k * 1024); } while (0)
#define PG8_MMA(ai, bj, At, Bt) do { __builtin_amdgcn_s_setprio(1); _Pragma("unroll") for (int m = 0; m < 4; ++m) _Pragma("unroll") for (int n = 0; n < 2; ++n) _Pragma("unroll") for (int k = 0; k < 2; ++k) \
        acc[ai][bj][m][n] = __builtin_amdgcn_mfma_f32_16x16x32_bf16(Bt[n][k], At[m][k], acc[ai][bj][m][n], 0, 0, 0); __builtin_amdgcn_s_setprio(0); } while (0)
#define PG8_WAIT_V(n) asm volatile("s_waitcnt vmcnt(" #n ")" ::: "memory")
#define PG8_WAIT_L(n) asm volatile("s_waitcnt lgkmcnt(" #n ")" ::: "memory")
#define PG8_BAR __builtin_amdgcn_s_barrier()
#define PG8_SCHED __builtin_amdgcn_sched_barrier(0)
#define PG8_AOFF(dst, unit) do { if (GATHER) { _Pragma("unroll") for (int _h = 0; _h < 2; ++_h) _Pragma("unroll") for (int _i = 0; _i < 2; ++_i) \
            dst[_h][_i] = (unsigned)rowidx[(unit).arow0 + _h * HALF + RA[_i]] * (unsigned)(K * 2) + colA[_i]; } \
        else { _Pragma("unroll") for (int _h = 0; _h < 2; ++_h) _Pragma("unroll") for (int _i = 0; _i < 2; ++_i) dst[_h][_i] = (unsigned)((_h * HALF + RA[_i]) * K) * 2u + colA[_i]; } } while (0)
    Unit cur, nxt; int ui = 0;
    if (!S.next(0, cur)) return;
    f32x4 acc[2][2][4][2];
#pragma unroll
    for (int a = 0; a < 2; ++a)
#pragma unroll
        for (int b = 0; b < 2; ++b)
#pragma unroll
            for (int m = 0; m < 4; ++m)
#pragma unroll
                for (int n = 0; n < 2; ++n) acc[a][b][m][n] = (f32x4){0.f, 0.f, 0.f, 0.f};
    bf16x8 At[4][2], B0[2][2], B1[2][2];
    unsigned ac[2][2], an[2][2];
    PG8_AOFF(ac, cur);
    const char* cA = (const char*)Ag + (GATHER ? (size_t)0 : (size_t)cur.arow0 * K * 2); const char* cB = (const char*)Bg + (size_t)cur.brow0 * K * 2;
    PG8_STAGE_B(PG8_SB(0, 0), cB); PG8_STAGE_A(PG8_SA(0, 0), cA, ac[0][0], ac[0][1]); PG8_STAGE_B(PG8_SB(0, 1), cB + hstep); PG8_STAGE_A(PG8_SA(0, 1), cA, ac[1][0], ac[1][1]);
    if (wr == 1) PG8_BAR;
    PG8_WAIT_V(4); PG8_BAR;
    PG8_STAGE_B(PG8_SB(1, 0), cB + kstep); PG8_STAGE_A(PG8_SA(1, 0), cA + kstep, ac[0][0], ac[0][1]); PG8_STAGE_B(PG8_SB(1, 1), cB + hstep + kstep);
    PG8_WAIT_V(6); PG8_BAR;
    for (;;) {
        const bool has_next = S.next(ui + 1, nxt);
        if (has_next) { PG8_AOFF(an, nxt); } else {
#pragma unroll
            for (int _h = 0; _h < 2; ++_h)
#pragma unroll
                for (int _i = 0; _i < 2; ++_i) an[_h][_i] = ac[_h][_i]; }
        const char* nA = has_next ? ((const char*)Ag + (GATHER ? (size_t)0 : (size_t)nxt.arow0 * K * 2)) : cA; const char* nB = has_next ? (const char*)Bg + (size_t)nxt.brow0 * K * 2 : cB;
_Pragma("nounroll")
        for (int t = 0; t < nt; t += 2) {
            const bool last = (t == nt - 2);
            const char* a1 = cA + (size_t)(t + 1) * kstep;
            const char* a2 = last ? nA : cA + (size_t)(t + 2) * kstep; const char* b2 = last ? nB : cB + (size_t)(t + 2) * kstep;
            const char* a3 = a2 + kstep; const char* b3 = b2 + kstep;
            const unsigned s00 = last ? an[0][0] : ac[0][0], s01 = last ? an[0][1] : ac[0][1], s10 = last ? an[1][0] : ac[1][0], s11 = last ? an[1][1] : ac[1][1];
            PG8_LDB(B0, 0, 0); PG8_SCHED; PG8_LDA(At, 0, 0); PG8_STAGE_A(PG8_SA(1, 1), a1, ac[1][0], ac[1][1]);
            PG8_WAIT_L(8); PG8_BAR; PG8_WAIT_L(0); PG8_MMA(0, 0, At, B0); PG8_BAR; PG8_SCHED;
            PG8_LDB(B1, 0, 1); PG8_STAGE_B(PG8_SB(0, 0), b2);
            PG8_BAR; PG8_WAIT_L(0); PG8_MMA(0, 1, At, B1); PG8_BAR;
            PG8_LDA(At, 0, 1); PG8_STAGE_A(PG8_SA(0, 0), a2, s00, s01);
            PG8_BAR; PG8_WAIT_L(0); PG8_MMA(1, 0, At, B0); PG8_BAR; PG8_SCHED;
            PG8_STAGE_B(PG8_SB(0, 1), b2 + hstep);
            PG8_WAIT_V(6); PG8_BAR; PG8_MMA(1, 1, At, B1); PG8_BAR;
            PG8_LDB(B0, 1, 0); PG8_SCHED; PG8_LDA(At, 1, 0); PG8_STAGE_A(PG8_SA(0, 1), a2, s10, s11);
            PG8_WAIT_L(8); PG8_BAR; PG8_WAIT_L(0); PG8_MMA(0, 0, At, B0); PG8_BAR; PG8_SCHED;
            PG8_LDB(B1, 1, 1); PG8_STAGE_B(PG8_SB(1, 0), b3);
            PG8_BAR; PG8_WAIT_L(0); PG8_MMA(0, 1, At, B1); PG8_BAR;
            PG8_LDA(At, 1, 1); PG8_STAGE_A(PG8_SA(1, 0), a3, s00, s01);
            PG8_BAR; PG8_WAIT_L(0); PG8_MMA(1, 0, At, B0); PG8_BAR; PG8_SCHED;
            PG8_STAGE_B(PG8_SB(1, 1), b3 + hstep);
            PG8_WAIT_V(6); PG8_BAR; PG8_MMA(1, 1, At, B1); PG8_BAR;
        }
        E(acc, cur, wr, wc, fr, fq);
        if (!has_next) break;
#pragma unroll
        for (int a = 0; a < 2; ++a)
#pragma unroll
            for (int b = 0; b < 2; ++b)
#pragma unroll
                for (int m = 0; m < 4; ++m)
#pragma unroll
                    for (int n = 0; n < 2; ++n) acc[a][b][m][n] = (f32x4){0.f, 0.f, 0.f, 0.f};
        cur = nxt; cA = nA; cB = nB; ++ui;
#pragma unroll
        for (int _h = 0; _h < 2; ++_h)
#pragma unroll
            for (int _i = 0; _i < 2; ++_i) ac[_h][_i] = an[_h][_i];
    }
    PG8_WAIT_V(0);
    if (wr == 0) PG8_BAR;
    PG8_BAR;
#undef PG8_SA
#undef PG8_SB
#undef PG8_STAGE_A
#undef PG8_STAGE_B
#undef PG8_LDA
#undef PG8_LDB
#undef PG8_MMA
#undef PG8_WAIT_V
#undef PG8_WAIT_L
#undef PG8_BAR
#undef PG8_SCHED
#undef PG8_AOFF
}
}

constexpr int NWAVES = 8, NTHR = 512;
constexpr size_t MiB = 1u << 20;
constexpr size_t WS_CTL = 0, CTL_BYTES = 1 * MiB;
constexpr size_t WS_MOD = 1 * MiB;
constexpr size_t WS_WIN = 3 * MiB;
constexpr size_t WS_WOUT = 29 * MiB;
constexpr size_t WS_WR = 37 * MiB;
constexpr size_t WS_HYF = 39 * MiB;
constexpr size_t WS_HYFC = 71 * MiB;
constexpr size_t WS_XC = 73 * MiB;
constexpr size_t WS_EXP1 = 89 * MiB;
constexpr size_t WS_EXP2 = 218 * MiB;
constexpr size_t WS_XM = 283 * MiB;
constexpr size_t WS_EIDX = 419 * MiB;
constexpr size_t WS_WGT = 422 * MiB;
constexpr size_t WS_RNK = 425 * MiB;
constexpr size_t WS_ROWTOK = 428 * MiB;
constexpr size_t WS_ROWDST = 431 * MiB;
constexpr size_t WS_TILEEXP = 434 * MiB;
constexpr size_t WS_BIG = 435 * MiB;
constexpr size_t WS_U = WS_BIG;
constexpr size_t WS_MIX = 877 * MiB;
constexpr size_t WS_VT = 1013 * MiB;
constexpr size_t WS_HV = 1081 * MiB;
constexpr size_t WS_Z2 = 1183 * MiB;
constexpr size_t WS_GDS = 1217 * MiB;
constexpr size_t WS_GSIN = 1285 * MiB;
constexpr size_t WS_GD = 1319 * MiB;
constexpr size_t WS_Y = 1321 * MiB;
constexpr size_t WS_LOGIT = WS_BIG;
constexpr size_t WS_ACT = WS_BIG;
constexpr size_t WS_Y2 = 758 * MiB;
constexpr size_t WS_END = 1982 * MiB;
constexpr int CW_BAR = 4096;
constexpr int CW_CNT = 16384;
constexpr int CW_NTL = 20480;

constexpr int LDS_BYTES = 147456;
constexpr int MISC_OFF = 143360;

struct Frame {
    LAS unsigned char* lds;
    int tid, lane, wave, G, wg;
    const float* const* in;
    float* out; unsigned char* ws; unsigned* ctl;
};
enum { I_X = 0, I_C, I_CTX, I_CCTX, I_WMOD, I_BMOD, I_WIN, I_RPB, I_WA2, I_BA2, I_GNORM, I_HSW, I_HSB, I_HW1, I_HB1, I_HF1, I_HW2, I_HB2, I_HF2, I_HW3, I_HB3, I_HDEC, I_HSKIP,
       I_WOUT, I_LN1G, I_LN1B, I_RW, I_RB, I_WEG, I_WEU, I_WED, I_WSG, I_WSU, I_WSD, I_LN2G, I_LN2B };

__device__ __forceinline__ int row_b(int row) { return row < NLAT ? (row >> 12) : 16; }
__device__ __forceinline__ const float* mod_ptr(const Frame& F, int l, int row) { return (const float*)(F.ws + WS_MOD) + ((size_t)l * 17 + row_b(row)) * 6144; }

template <class RowFn>
__device__ __forceinline__ void tr_item(const float* W, int ldw, int k0, int n0, bf16_t* dst, int ldd, RowFn rf, LAS float* scr, int lane) {
#pragma unroll 8
    for (int i = 0; i < 32; ++i) { const int kk = 2 * i + (lane >> 5); scr[kk * 33 + (lane & 31)] = W[(size_t)(k0 + kk) * ldw + n0 + (lane & 31)]; }
    LDS_WAIT(); asm volatile("" ::: "memory");
    const int c = lane & 7;
#pragma unroll
    for (int j = 0; j < 4; ++j) { const int n = (lane >> 3) + 8 * j; const LAS float* s = scr + (8 * c) * 33 + n;
        u32x4 o; o.x = pk2(s[0 * 33], s[1 * 33]); o.y = pk2(s[2 * 33], s[3 * 33]); o.z = pk2(s[4 * 33], s[5 * 33]); o.w = pk2(s[6 * 33], s[7 * 33]);
        *(u32x4*)(dst + (size_t)rf(n0 + n) * ldd + k0 + 8 * c) = o; }
    LDS_WAIT(); asm volatile("" ::: "memory");
}
struct RowId { __device__ __forceinline__ int operator()(int n) const { return n; } };
struct RowWin { __device__ __forceinline__ int operator()(int n) const { return n >= 2336 ? n - 32 : n; } };
struct RowGU { int up; __device__ __forceinline__ int operator()(int j) const { return (j >> 6) * 128 + ((j & 63) >> 4) * 32 + up * 16 + (j & 15); } };

__device__ __forceinline__ void p0_static_weights(Frame& F) {
    LAS float* scr = (LAS float*)(F.lds + F.wave * 16384);
    const int gw = F.wg * NWAVES + F.wave, NGW = F.G * NWAVES;
    constexpr int I_IN = 16 * 97, I_OUT = 16 * 32, I_R = 16 * 4, PER_L = I_IN + I_OUT + I_R;
    for (int it = gw; it < DEPTH * PER_L; it += NGW) {
        const int l = it / PER_L; int r = it % PER_L;
        if (r < I_IN) { const int kb = r / 97, nb = r % 97; if (nb == 72) continue;
            tr_item(F.in[I_WIN] + (size_t)l * DM * DIN_REF, DIN_REF, kb * 64, nb * 32, (bf16_t*)(F.ws + WS_WIN) + (size_t)l * DIN * DM, DM, RowWin{}, scr, F.lane); continue; }
        r -= I_IN;
        if (r < I_OUT) { const int kb = r / 32, nb = r % 32;
            tr_item(F.in[I_WOUT] + (size_t)l * DM * DM, DM, kb * 64, nb * 32, (bf16_t*)(F.ws + WS_WOUT) + (size_t)l * DM * DM, DM, RowId{}, scr, F.lane); continue; }
        r -= I_OUT;
        { const int kb = r / 4, nb = r % 4;
            tr_item(F.in[I_RW] + (size_t)l * DM * NEXP, NEXP, kb * 64, nb * 32, (bf16_t*)(F.ws + WS_WR) + (size_t)l * 256 * DM, DM, RowId{}, scr, F.lane); }
    }
    const int gt = F.wg * NTHR + F.tid, NGT = F.G * NTHR;
    for (int i = gt; i < DEPTH * 128 * DM / 8; i += NGT) { const int l = i / (128 * DM / 8), r = i % (128 * DM / 8);
        *(u32x4*)((bf16_t*)(F.ws + WS_WR) + ((size_t)l * 256 + 128) * DM + (size_t)r * 8) = (u32x4){0u, 0u, 0u, 0u}; }
    for (int i = gt; i < DEPTH * 256 * DM; i += NGT) {
        const int k = i % DM, n = (i / DM) % 256, l = i / (DM * 256), dir = n >> 7, j = n & 127;
        const float* wi = F.in[I_WIN] + ((size_t)l * DM + k) * DIN_REF + 2304 + dir * 16;
        const float* wa = F.in[I_WA2] + ((size_t)(l * 2 + dir) * 16) * 128 + j;
        float s = 0.f;
#pragma unroll
        for (int r = 0; r < 16; ++r) s += wi[r] * wa[r * 128];
        ((bf16_t*)(F.ws + WS_WIN))[((size_t)l * DIN + 3072 + n) * DM + k] = (bf16_t)f2bf(s);
    }
}
__device__ __forceinline__ void p0_mod(Frame& F) {
    LAS float* sc = (LAS float*)F.lds;
    LAS float* red = (LAS float*)(F.lds + 17 * 1024 * 4);
    for (int i = F.tid; i < 17 * 1024; i += NTHR) { const int r = i >> 10, k = i & 1023; const float v = r < 16 ? F.in[I_C][r * 1024 + k] : F.in[I_CCTX][k]; sc[i] = silu_f(v); }
    __syncthreads();
    const int kq = F.tid >> 7, cl = F.tid & 127;
    for (int u = F.wg; u < DEPTH * 48; u += F.G) {
        const int l = u / 48, col = (u % 48) * 128 + cl;
        const float* w = F.in[I_WMOD] + (size_t)l * DM * 6144 + col;
        float a[17];
#pragma unroll
        for (int r = 0; r < 17; ++r) a[r] = 0.f;
#pragma unroll 4
        for (int k = kq * 256; k < kq * 256 + 256; ++k) { const float wv = w[(size_t)k * 6144];
#pragma unroll
            for (int r = 0; r < 17; ++r) a[r] += sc[r * 1024 + k] * wv; }
#pragma unroll
        for (int r = 0; r < 17; ++r) red[(kq * 17 + r) * 128 + cl] = a[r];
        __syncthreads();
        for (int i = F.tid; i < 17 * 128; i += NTHR) { const int r = i >> 7, c2 = i & 127, cc = (u % 48) * 128 + c2;
            const float s = red[(0 * 17 + r) * 128 + c2] + red[(1 * 17 + r) * 128 + c2] + red[(2 * 17 + r) * 128 + c2] + red[(3 * 17 + r) * 128 + c2] + F.in[I_BMOD][l * 6144 + cc];
            ((float*)(F.ws + WS_MOD))[((size_t)l * 17 + r) * 6144 + cc] = s; }
        __syncthreads();
    }
}
__device__ __forceinline__ void p0_hyena_filters(Frame& F) {
    LAS float* z = (LAS float*)F.lds;
    LAS float* h1 = z + 32 * 33;
    LAS float* h2 = h1 + 32 * 64;
    LAS float* tt = h2 + 32 * 64;
    constexpr int UL = 4096 / 32, UC = 256 / 32, UPL = UL + UC;
    for (int u = F.wg; u < DEPTH * UPL; u += F.G) {
        const int l = u / UPL, r = u % UPL; const bool lat = r < UL; const int L = lat ? 4096 : 256, n0 = (lat ? r : r - UL) * 32;
        __syncthreads();
        for (int i = F.tid; i < 32 * 33; i += NTHR) { const int p = i / 33, e = i % 33, n = n0 + p;
            const float t = (float)n / (float)(L - 1);
            float v;
            if (e == 0) v = t;
            else { const int kb = (e - 1) & 15; const float band = 1e-4f + (float)kb * ((15.0f - 1e-4f) / 15.0f);
                   const float w = 6.283185307179586f * (float)n / (float)L; const float ang = w * band;
                   v = e <= 16 ? __cosf(ang) : -__sinf(ang); }
            z[i] = v; if (e == 0) tt[p] = t; }
        __syncthreads();
        for (int i = F.tid; i < 32 * 64; i += NTHR) { const int p = i >> 6, j = i & 63; float s = F.in[I_HB1][l * 64 + j];
            for (int e = 0; e < 33; ++e) s += z[p * 33 + e] * F.in[I_HW1][((size_t)l * 33 + e) * 64 + j];
            h1[i] = __sinf(F.in[I_HF1][l * 64 + j] * s); }
        __syncthreads();
        for (int i = F.tid; i < 32 * 64; i += NTHR) { const int p = i >> 6, j = i & 63; float s = F.in[I_HB2][l * 64 + j];
            for (int e = 0; e < 64; ++e) s += h1[p * 64 + e] * F.in[I_HW2][((size_t)l * 64 + e) * 64 + j];
            h2[i] = __sinf(F.in[I_HF2][l * 64 + j] * s); }
        __syncthreads();
#pragma unroll 1
        for (int cc = 0; cc < 2; ++cc) {
            const int col = F.tid + cc * 512, o = col >> 9, dir = (col >> 8) & 1, ch = col & 255;
            float a[32];
#pragma unroll
            for (int p = 0; p < 32; ++p) a[p] = 0.f;
            const float* w3 = F.in[I_HW3] + (size_t)l * 64 * 1024 + col;
            for (int k = 0; k < 64; ++k) { const float wv = w3[(size_t)k * 1024];
#pragma unroll
                for (int p = 0; p < 32; ++p) a[p] += h2[p * 64 + k] * wv; }
            const float b3 = F.in[I_HB3][l * 1024 + col], dec = fabsf(F.in[I_HDEC][((size_t)(l * 2 + o) * 2 + dir) * 256 + ch]);
            const float skip = F.in[I_HSKIP][(l * 2 + o) * 256 + ch];
            bf16_t* R = lat ? (bf16_t*)(F.ws + WS_HYF) + ((size_t)(l * 2 + o) * 256 + ch) * 8192 : (bf16_t*)(F.ws + WS_HYFC) + ((size_t)(l * 2 + o) * 256 + ch) * 512;
#pragma unroll
            for (int p = 0; p < 32; ++p) { const int n = n0 + p; float v = (a[p] + b3) * __expf(-tt[p] * dec);
                if (dir == 0) { if (n == 0) v += skip; R[L - n] = (bf16_t)f2bf(v); }
                else { if (n == 0) R[0] = 0; else R[L + n] = (bf16_t)f2bf(v); } }
        }
    }
    __syncthreads();
}
__device__ __forceinline__ void p0_init_rows(Frame& F) {
    const int gw = F.wg * NWAVES + F.wave, NGW = F.G * NWAVES;
    for (int row = gw; row < NROW; row += NGW) {
        const float* src = row < NLAT ? F.in[I_X] + (size_t)row * DM : F.in[I_CTX] + (size_t)(row - NLAT) * DM;
        float* dst = row < NLAT ? F.out + (size_t)row * DM : (float*)(F.ws + WS_XC) + (size_t)(row - NLAT) * DM;
        const float* md = mod_ptr(F, 0, row);
        bf16_t* xm = (bf16_t*)(F.ws + WS_XM) + (size_t)row * DM;
#pragma unroll
        for (int j = 0; j < 4; ++j) { const int c = 4 * F.lane + 256 * j;
            const f32x4 v = *(const f32x4*)(src + c), sh = *(const f32x4*)(md + c), sc = *(const f32x4*)(md + 1024 + c);
            *(f32x4*)(dst + c) = v;
            u32x2 w; w.x = pk2(v[0] * (1.f + sc[0]) + sh[0], v[1] * (1.f + sc[1]) + sh[1]); w.y = pk2(v[2] * (1.f + sc[2]) + sh[2], v[3] * (1.f + sc[3]) + sh[3]);
            *(u32x2*)(xm + c) = w; }
    }
}
__device__ __forceinline__ void p_expert_weights(Frame& F, int l) {
    LAS float* scr = (LAS float*)(F.lds + F.wave * 16384);
    const int gw = F.wg * NWAVES + F.wave, NGW = F.G * NWAVES;
    constexpr int I1 = 16 * 8, I2 = 4 * 32, PER_E = 2 * I1 + I2;
    for (int it = gw; it < NE1 * PER_E; it += NGW) {
        const int e = it / PER_E; int r = it % PER_E;
        bf16_t* d1 = (bf16_t*)(F.ws + WS_EXP1) + (size_t)e * 512 * DM; bf16_t* d2 = (bf16_t*)(F.ws + WS_EXP2) + (size_t)e * DM * EH;
        if (r < 2 * I1) { const int up = r >= I1; if (up) r -= I1; const int kb = r / 8, nb = r % 8;
            const float* src = e < NEXP ? F.in[up ? I_WEU : I_WEG] + ((size_t)l * NEXP + e) * DM * EH : F.in[up ? I_WSU : I_WSG] + (size_t)l * DM * EH;
            tr_item(src, EH, kb * 64, nb * 32, d1, DM, RowGU{up}, scr, F.lane); }
        else { r -= 2 * I1; const int kb = r / 32, nb = r % 32;
            const float* src = e < NEXP ? F.in[I_WED] + ((size_t)l * NEXP + e) * EH * DM : F.in[I_WSD] + (size_t)l * EH * DM;
            tr_item(src, DM, kb * 64, nb * 32, d2, EH, RowId{}, scr, F.lane); }
    }
}

__device__ __forceinline__ f32x4 mfma16(bf16x8 a, bf16x8 b, f32x4 c) { return __builtin_amdgcn_mfma_f32_16x16x32_bf16(a, b, c, 0, 0, 0); }

__device__ __forceinline__ void ph_transposes(Frame& F, int l) {
    LAS bf16_t* tile = (LAS bf16_t*)(F.lds + F.wave * 16384);
    const bf16_t* U = (const bf16_t*)(F.ws + WS_U);
    const int gw = F.wg * NWAVES + F.wave, NGW = F.G * NWAVES;
    const int rsub = F.lane >> 3, cseg = F.lane & 7;
    for (int u = gw; u < 1088 * 20; u += NGW) {
        const int tt = u / 20, blk = u % 20;
        int b, s0, Ls, rowbase, posbase;
        if (tt < 1024) { b = tt >> 6; s0 = (tt & 63) * 64; Ls = SEQ; rowbase = b * SEQ; posbase = 0; }
        else { const int t2 = tt - 1024; b = t2 >> 2; s0 = (t2 & 3) * 64; Ls = CTXL; rowbase = NLAT + b * CTXL; posbase = SEQ; }
        if (blk < 12) {
            const int c0 = blk * 64 + cseg * 8;
            float w0[8], w1[8], w2[8], bb[8];
#pragma unroll
            for (int i = 0; i < 8; ++i) { w0[i] = F.in[I_HSW][(l * 3 + 0) * 768 + c0 + i]; w1[i] = F.in[I_HSW][(l * 3 + 1) * 768 + c0 + i]; w2[i] = F.in[I_HSW][(l * 3 + 2) * 768 + c0 + i]; bb[i] = F.in[I_HSB][l * 768 + c0 + i]; }
#pragma unroll 2
            for (int it = 0; it < 8; ++it) {
                const int sl = rsub + 8 * it, s = s0 + sl;
                const bf16_t* p = U + (size_t)(rowbase + s) * DIN + UHY + c0;
                const u32x4 zc = *(const u32x4*)p;
                u32x4 zm = (u32x4){0u, 0u, 0u, 0u}, zp = (u32x4){0u, 0u, 0u, 0u};
                if (s > 0) zm = *(const u32x4*)(p - DIN);
                if (s < Ls - 1) zp = *(const u32x4*)(p + DIN);
                const unsigned am[4] = {zm.x, zm.y, zm.z, zm.w}, ac[4] = {zc.x, zc.y, zc.z, zc.w}, ap[4] = {zp.x, zp.y, zp.z, zp.w};
#pragma unroll
                for (int i = 0; i < 4; ++i) {
                    const float v0 = bb[2 * i] + w0[2 * i] * bflo(am[i]) + w1[2 * i] * bflo(ac[i]) + w2[2 * i] * bflo(ap[i]);
                    const float v1 = bb[2 * i + 1] + w0[2 * i + 1] * bfhi(am[i]) + w1[2 * i + 1] * bfhi(ac[i]) + w2[2 * i + 1] * bfhi(ap[i]);
                    tile[(cseg * 8 + 2 * i) * 72 + sl] = (bf16_t)f2bf(v0); tile[(cseg * 8 + 2 * i + 1) * 72 + sl] = (bf16_t)f2bf(v1);
                }
            }
        } else {
            const int c0 = (blk - 12) * 64 + cseg * 8;
#pragma unroll 2
            for (int it = 0; it < 8; ++it) {
                const int sl = rsub + 8 * it, s = s0 + sl;
                const u32x4 zc = *(const u32x4*)(U + (size_t)(rowbase + s) * DIN + UV + c0);
                const unsigned ac[4] = {zc.x, zc.y, zc.z, zc.w};
#pragma unroll
                for (int i = 0; i < 4; ++i) { tile[(cseg * 8 + 2 * i) * 72 + sl] = (bf16_t)(ac[i] & 0xffffu); tile[(cseg * 8 + 2 * i + 1) * 72 + sl] = (bf16_t)(ac[i] >> 16); }
            }
        }
        LDS_WAIT(); asm volatile("" ::: "memory");
#pragma unroll 2
        for (int it = 0; it < 8; ++it) {
            const int ch = rsub + 8 * it;
            const u32x4 v = *(const LAS u32x4*)(tile + ch * 72 + cseg * 8);
            bf16_t* dst;
            if (blk < 12) dst = (bf16_t*)(F.ws + WS_HV) + ((size_t)(blk * 64 + ch) * NB + b) * SPB + posbase + s0 + cseg * 8;
            else dst = (bf16_t*)(F.ws + WS_VT) + ((size_t)b * 512 + (blk - 12) * 64 + ch) * SPB + posbase + s0 + cseg * 8;
            *(u32x4*)dst = v;
        }
        LDS_WAIT(); asm volatile("" ::: "memory");
    }
}

template <bool WIN>
__device__ __forceinline__ void na_unit(Frame& F, const LAS float* rpb, int b, int h, int r, int strip) {
    const bf16_t* U = (const bf16_t*)(F.ws + WS_U);
    const bf16_t* VT = (const bf16_t*)(F.ws + WS_VT) + ((size_t)b * 512 + h * 64) * SPB;
    const int i = F.lane & 15, g = F.lane >> 4;
    const int qrow = WIN ? (b * SEQ + r * 64 + strip * 16 + i) : (NLAT + b * CTXL + strip * 16 + i);
    const bf16_t* qp = U + (size_t)qrow * DIN + UQ + h * 64 + 8 * g;
    const bf16x8 q0 = *(const bf16x8*)qp, q1 = *(const bf16x8*)(qp + 32);
    constexpr int NT = WIN ? 32 : 16;
    f32x4 st[NT];
    int kr0 = 0, u0 = 0;
    if (WIN) { kr0 = r - 4; kr0 = kr0 < 0 ? 0 : (kr0 > 56 ? 56 : kr0); u0 = strip == 0 ? 0 : (strip == 1 ? 8 : (strip == 2 ? 24 : 32)); }
    if (WIN) {
#pragma unroll
        for (int kt = 0; kt < 16; ++kt) {
            const int krow = b * SEQ + (kr0 + (kt >> 1)) * 64 + u0 + (kt & 1) * 16 + i;
            const bf16_t* kp = U + (size_t)krow * DIN + UK + h * 64 + 8 * g;
            const bf16x8 k0 = *(const bf16x8*)kp, k1 = *(const bf16x8*)(kp + 32);
            f32x4 a = (f32x4){0.f, 0.f, 0.f, 0.f}; a = mfma16(k0, q0, a); a = mfma16(k1, q1, a); st[kt] = a;
        }
    }
#pragma unroll
    for (int ct = 0; ct < 16; ++ct) {
        const int krow = NLAT + b * CTXL + ct * 16 + i;
        const bf16_t* kp = U + (size_t)krow * DIN + UK + h * 64 + 8 * g;
        const bf16x8 k0 = *(const bf16x8*)kp, k1 = *(const bf16x8*)(kp + 32);
        f32x4 a = (f32x4){0.f, 0.f, 0.f, 0.f}; a = mfma16(k0, q0, a); a = mfma16(k1, q1, a); st[(WIN ? 16 : 0) + ct] = a;
    }
    float mx = -3.0e38f;
    if (WIN) {
        const int c = strip * 16 + i; int kc0 = c - 8; kc0 = kc0 < 0 ? 0 : (kc0 > 48 ? 48 : kc0);
#pragma unroll
        for (int kt = 0; kt < 16; ++kt) {
            const int kr = kr0 + (kt >> 1), dr = kr - r + 7;
#pragma unroll
            for (int e = 0; e < 4; ++e) {
                const int kc = u0 + (kt & 1) * 16 + 4 * g + e; const bool ok = (kc >= kc0) && (kc < kc0 + 16);
                int dc = kc - c + 15; dc = dc < 0 ? 0 : (dc > 30 ? 30 : dc);
                const float s = ok ? (st[kt][e] * 0.125f + rpb[(h * 15 + dr) * 31 + dc]) : -3.0e38f;
                st[kt][e] = s; mx = fmaxf(mx, s);
            }
        }
    }
#pragma unroll
    for (int ct = 0; ct < 16; ++ct)
#pragma unroll
        for (int e = 0; e < 4; ++e) { const float s = st[(WIN ? 16 : 0) + ct][e] * 0.125f; st[(WIN ? 16 : 0) + ct][e] = s; mx = fmaxf(mx, s); }
    mx = fmaxf(mx, shx(mx, 16, F.lane)); mx = fmaxf(mx, shx(mx, 32, F.lane));
    float sum = 0.f;
#pragma unroll
    for (int t = 0; t < NT; ++t)
#pragma unroll
        for (int e = 0; e < 4; ++e) { const float p = __expf(st[t][e] - mx); st[t][e] = p; sum += p; }
    sum += shx(sum, 16, F.lane); sum += shx(sum, 32, F.lane);
    const float inv = 1.0f / sum;
    f32x4 o[4];
#pragma unroll
    for (int d = 0; d < 4; ++d) o[d] = (f32x4){0.f, 0.f, 0.f, 0.f};
#pragma unroll
    for (int c = 0; c < NT / 2; ++c) {
        const f32x4 p0 = st[2 * c], p1 = st[2 * c + 1];
        u32x4 pw; pw.x = pk2(p0[0], p0[1]); pw.y = pk2(p0[2], p0[3]); pw.z = pk2(p1[0], p1[1]); pw.w = pk2(p1[2], p1[3]);
        const bf16x8 pf = __builtin_bit_cast(bf16x8, pw);
        int pos;
        if (WIN && c < 8) pos = (kr0 + c) * 64 + u0 + 4 * g; else pos = SEQ + (c - (WIN ? 8 : 0)) * 32 + 4 * g;
#pragma unroll
        for (int d = 0; d < 4; ++d) {
            const bf16_t* vp = VT + (size_t)(d * 16 + i) * SPB + pos;
            const u32x2 v0 = *(const u32x2*)vp, v1 = *(const u32x2*)(vp + 16);
            const bf16x8 vf = __builtin_bit_cast(bf16x8, ((u32x4){v0.x, v0.y, v1.x, v1.y}));
            o[d] = mfma16(vf, pf, o[d]);
        }
    }
    bf16_t* op = (bf16_t*)(F.ws + WS_MIX) + (size_t)qrow * DM + h * 64 + 4 * g;
#pragma unroll
    for (int d = 0; d < 4; ++d) { u32x2 w; w.x = pk2(o[d][0] * inv, o[d][1] * inv); w.y = pk2(o[d][2] * inv, o[d][3] * inv); *(u32x2*)(op + d * 16) = w; }
}
__device__ __forceinline__ void ph_na(Frame& F, int l, bool last) {
    LAS float* rpb = (LAS float*)(F.lds);
    __syncthreads();
    for (int i = F.tid; i < 8 * 15 * 31; i += NTHR) rpb[i] = F.in[I_RPB][(size_t)l * 8 * 15 * 31 + i];
    __syncthreads();
    const int gw = F.wg * NWAVES + F.wave, NGW = F.G * NWAVES;
    for (int u = gw; u < NB * 8 * 64 * 4; u += NGW) { const int strip = u & 3, r = (u >> 2) & 63, h = (u >> 8) & 7, b = u >> 11; na_unit<true>(F, rpb, b, h, r, strip); }
    if (!last) for (int u = gw; u < NB * 8 * 16; u += NGW) { const int qt = u & 15, h = (u >> 4) & 7, b = u >> 7; na_unit<false>(F, rpb, b, h, 0, qt); }
}

constexpr int GL_LAF = 0, GL_LAB = 8448, GL_Q = 16896, GL_K = 25344;
constexpr int GL_QTF = 33792, GL_KTF = 38912, GL_QTB = 44032, GL_KTB = 49152;
constexpr int GL_KDF = 54272, GL_KDB = 58880;
constexpr int GL_VT = 63488, GL_ATT = 72704;
constexpr int GL_SF = 81920, GL_SB = 87040;
constexpr int GL_O = 92160;
constexpr int GL_SEG = 108800;
__device__ __forceinline__ float log_sigmoid_f(float x) { return fminf(x, 0.f) - log1pf(__expf(-fabsf(x))); }
__device__ __forceinline__ f32x4 mma_lds(const LAS bf16_t* A, int lda, const LAS bf16_t* B, int ldb, int ksteps, f32x4 acc, int lane) {
    const int r = lane & 15, g = lane >> 4;
    for (int ks = 0; ks < ksteps; ++ks) { const bf16x8 a = *(const LAS bf16x8*)(A + r * lda + ks * 32 + 8 * g), b = *(const LAS bf16x8*)(B + r * ldb + ks * 32 + 8 * g); acc = mfma16(a, b, acc); }
    return acc;
}
template <bool FULL>
__device__ __forceinline__ void gla_prep(Frame& F, int l, int b, int cn, int h) {
    const bf16_t* U = (const bf16_t*)(F.ws + WS_U);
    LAS float* LAF = (LAS float*)(F.lds + GL_LAF); LAS float* LAB = (LAS float*)(F.lds + GL_LAB); LAS float* Q = (LAS float*)(F.lds + GL_Q); LAS float* Kk = (LAS float*)(F.lds + GL_K);
    LAS bf16_t* VT = (LAS bf16_t*)(F.lds + GL_VT); LAS float* SEG = (LAS float*)(F.lds + GL_SEG);
    const bool lat = cn >= 4; const int row0 = lat ? b * SEQ + (cn - 4) * 64 : NLAT + b * CTXL + cn * 64;
    const int t = F.tid;
    { const int i = t >> 3, d4 = (t & 7) * 4; const bf16_t* p = U + (size_t)(row0 + i) * DIN;
      const u32x2 wq = *(const u32x2*)(p + UGQ + h * 32 + d4), wk = *(const u32x2*)(p + UGK + h * 32 + d4), wf = *(const u32x2*)(p + ULAF + h * 32 + d4), wb = *(const u32x2*)(p + ULAB + h * 32 + d4);
      const float* ba = F.in[I_BA2] + (size_t)l * 256 + h * 32 + d4;
      const float qs = 0.17677669529663687f;
      Q[i * 33 + d4 + 0] = bflo(wq.x) * qs; Q[i * 33 + d4 + 1] = bfhi(wq.x) * qs; Q[i * 33 + d4 + 2] = bflo(wq.y) * qs; Q[i * 33 + d4 + 3] = bfhi(wq.y) * qs;
      Kk[i * 33 + d4 + 0] = bflo(wk.x); Kk[i * 33 + d4 + 1] = bfhi(wk.x); Kk[i * 33 + d4 + 2] = bflo(wk.y); Kk[i * 33 + d4 + 3] = bfhi(wk.y);
      LAF[i * 33 + d4 + 0] = log_sigmoid_f(bflo(wf.x) + ba[0]) * 0.0625f; LAF[i * 33 + d4 + 1] = log_sigmoid_f(bfhi(wf.x) + ba[1]) * 0.0625f;
      LAF[i * 33 + d4 + 2] = log_sigmoid_f(bflo(wf.y) + ba[2]) * 0.0625f; LAF[i * 33 + d4 + 3] = log_sigmoid_f(bfhi(wf.y) + ba[3]) * 0.0625f;
      LAB[i * 33 + d4 + 0] = log_sigmoid_f(bflo(wb.x) + ba[128]) * 0.0625f; LAB[i * 33 + d4 + 1] = log_sigmoid_f(bfhi(wb.x) + ba[129]) * 0.0625f;
      LAB[i * 33 + d4 + 2] = log_sigmoid_f(bflo(wb.y) + ba[130]) * 0.0625f; LAB[i * 33 + d4 + 3] = log_sigmoid_f(bfhi(wb.y) + ba[131]) * 0.0625f;
      const int dv8 = (t & 7) * 8; const u32x4 wv = *(const u32x4*)(p + UGV + h * 64 + dv8); const unsigned av[4] = {wv.x, wv.y, wv.z, wv.w};
#pragma unroll
      for (int e = 0; e < 4; ++e) { VT[(dv8 + 2 * e) * 72 + i] = (bf16_t)(av[e] & 0xffffu); VT[(dv8 + 2 * e + 1) * 72 + i] = (bf16_t)(av[e] >> 16); }
    }
    __syncthreads();
    if (lat) {
        for (int e = t; e < 64 * 16 * 2; e += NTHR) {
            const int which = e >> 10, i = (e >> 4) & 63, p = e & 15, half = p >> 3, idx = p & 7;
            const float pos = half ? (float)i : (float)(cn - 4);
            const float inv = __expf(-(float)idx * (9.210340371976184f / 8.0f));
            const float sn = __sinf(pos * inv), cs = __cosf(pos * inv);
            LAS float* A = which ? Kk : Q; const int d1 = half * 16 + idx;
            const float x1 = A[i * 33 + d1], x2 = A[i * 33 + d1 + 8];
            A[i * 33 + d1] = x1 * cs - x2 * sn; A[i * 33 + d1 + 8] = x1 * sn + x2 * cs;
        }
    }
    { const int x = t & 63, d = x & 31, dir = x >> 5, seg = t >> 6; LAS float* LA = dir ? LAB : LAF; float run = 0.f;
#pragma unroll
      for (int k = 0; k < 8; ++k) { const int p = seg * 8 + k, i = dir ? 63 - p : p; run += LA[i * 33 + d]; LA[i * 33 + d] = run; }
      SEG[x * 9 + seg] = run;
    }
    __syncthreads();
    { const int x = t & 63, d = x & 31, dir = x >> 5, seg = t >> 6; LAS float* LA = dir ? LAB : LAF; float pre = 0.f;
      for (int s2 = 0; s2 < seg; ++s2) pre += SEG[x * 9 + s2];
#pragma unroll
      for (int k = 0; k < 8; ++k) { const int p = seg * 8 + k, i = dir ? 63 - p : p; LA[i * 33 + d] += pre; }
    }
    __syncthreads();
    LAS bf16_t* QTF = (LAS bf16_t*)(F.lds + GL_QTF); LAS bf16_t* KTF = (LAS bf16_t*)(F.lds + GL_KTF); LAS bf16_t* QTB = (LAS bf16_t*)(F.lds + GL_QTB); LAS bf16_t* KTB = (LAS bf16_t*)(F.lds + GL_KTB);
    LAS bf16_t* KDF = (LAS bf16_t*)(F.lds + GL_KDF); LAS bf16_t* KDB = (LAS bf16_t*)(F.lds + GL_KDB);
    for (int e = t; e < 64 * 32; e += NTHR) {
        const int i = e >> 5, d = e & 31;
        const float bf = LAF[i * 33 + d], bb = LAB[i * 33 + d], bfl = LAF[63 * 33 + d], bbl = LAB[0 * 33 + d], kv = Kk[i * 33 + d];
        KDF[d * 72 + i] = (bf16_t)f2bf(kv * __expf(bfl - bf)); KDB[d * 72 + i] = (bf16_t)f2bf(kv * __expf(bbl - bb));
        if (FULL) { const float qv = Q[i * 33 + d];
            QTF[i * 40 + d] = (bf16_t)f2bf(qv * __expf(bf)); KTF[i * 40 + d] = (bf16_t)f2bf(kv * __expf(-bf));
            QTB[i * 40 + d] = (bf16_t)f2bf(qv * __expf(bb)); KTB[i * 40 + d] = (bf16_t)f2bf(kv * __expf(-bb)); }
    }
    __syncthreads();
}
__device__ __forceinline__ void ph_gla_local(Frame& F, int l) {
    LAS float* LAF = (LAS float*)(F.lds + GL_LAF); LAS float* LAB = (LAS float*)(F.lds + GL_LAB);
    for (int u = F.wg; u < NB * 68 * 4; u += F.G) {
        const int h = u & 3, cn = (u >> 2) % 68, b = (u >> 2) / 68;
        __syncthreads();
        gla_prep<false>(F, l, b, cn, h);
        const int mt = F.wave >> 1, nt = F.wave & 1, g = F.lane >> 4, c = F.lane & 15;
        float* DS = (float*)(F.ws + WS_GDS) + (size_t)u * 2 * 2048;
#pragma unroll
        for (int dir = 0; dir < 2; ++dir) {
            const LAS bf16_t* KD = (const LAS bf16_t*)(F.lds + (dir ? GL_KDB : GL_KDF));
            f32x4 a = (f32x4){0.f, 0.f, 0.f, 0.f};
            a = mma_lds((const LAS bf16_t*)(F.lds + GL_VT) + mt * 16 * 72, 72, KD + nt * 16 * 72, 72, 2, a, F.lane);
#pragma unroll
            for (int e = 0; e < 4; ++e) DS[dir * 2048 + (mt * 16 + 4 * g + e) * 32 + nt * 16 + c] = a[e];
        }
        if (F.tid < 64) { const int d = F.tid & 31, dir = F.tid >> 5; ((float*)(F.ws + WS_GD))[(size_t)u * 64 + F.tid] = __expf(dir ? LAB[0 * 33 + d] : LAF[63 * 33 + d]); }
    }
}
__device__ __forceinline__ void ph_gla_scan(Frame& F) {
    const int gt = F.wg * NTHR + F.tid, NGT = F.G * NTHR;
    const float* DS = (const float*)(F.ws + WS_GDS); const float* GD = (const float*)(F.ws + WS_GD); bf16_t* SIN = (bf16_t*)(F.ws + WS_GSIN);
    for (int w = gt; w < 128 * 1024; w += NGT) {
        const int chain = w >> 10, el = (w & 1023) * 2, dir = chain & 1, h = (chain >> 1) & 3, b = chain >> 3, d = el & 31;
        float s0 = 0.f, s1 = 0.f;
        for (int step = 0; step < 68; ++step) {
            const int cn = dir ? (step < 4 ? 3 - step : 71 - step) : step;
            const size_t u = (size_t)(b * 68 + cn) * 4 + h;
            *(unsigned*)(SIN + (u * 2 + dir) * 2048 + el) = pk2(s0, s1);
            const f32x2 ds = *(const f32x2*)(DS + (u * 2 + dir) * 2048 + el); const f32x2 dd = *(const f32x2*)(GD + u * 64 + dir * 32 + d);
            s0 = dd.x * s0 + ds.x; s1 = dd.y * s1 + ds.y;
        }
    }
}
__device__ __forceinline__ void ph_gla_out(Frame& F, int l, bool last) {
    const bf16_t* U = (const bf16_t*)(F.ws + WS_U);
    for (int u = F.wg; u < NB * 68 * 4; u += F.G) {
        const int h = u & 3, cn = (u >> 2) % 68, b = (u >> 2) / 68;
        if (last && cn < 4) continue;
        __syncthreads();
        gla_prep<true>(F, l, b, cn, h);
        const int t = F.tid;
        { const bf16_t* SIN = (const bf16_t*)(F.ws + WS_GSIN) + (size_t)u * 2 * 2048;
          for (int e = t; e < 2 * 64 * 4; e += NTHR) { const int dir = e >> 8, dv = (e >> 2) & 63, d8 = (e & 3) * 8;
              const u32x4 v = *(const u32x4*)(SIN + dir * 2048 + dv * 32 + d8); *(LAS u32x4*)((LAS bf16_t*)(F.lds + (dir ? GL_SB : GL_SF)) + dv * 40 + d8) = v; } }
        const int g = F.lane >> 4, c = F.lane & 15;
        LAS bf16_t* ATT = (LAS bf16_t*)(F.lds + GL_ATT);
#pragma unroll
        for (int k = 0; k < 2; ++k) { const int tile = F.wave + 8 * k, mt = tile >> 2, nt = tile & 3;
            f32x4 af = (f32x4){0.f, 0.f, 0.f, 0.f}, ab = af;
            af = mma_lds((const LAS bf16_t*)(F.lds + GL_QTF) + mt * 16 * 40, 40, (const LAS bf16_t*)(F.lds + GL_KTF) + nt * 16 * 40, 40, 1, af, F.lane);
            ab = mma_lds((const LAS bf16_t*)(F.lds + GL_QTB) + mt * 16 * 40, 40, (const LAS bf16_t*)(F.lds + GL_KTB) + nt * 16 * 40, 40, 1, ab, F.lane);
#pragma unroll
            for (int e = 0; e < 4; ++e) { const int i = mt * 16 + 4 * g + e, j = nt * 16 + c; const float v = (j <= i ? af[e] : 0.f) + (j >= i ? ab[e] : 0.f); ATT[i * 72 + j] = (bf16_t)f2bf(v); } }
        __syncthreads();
        LAS float* O = (LAS float*)(F.lds + GL_O);
#pragma unroll
        for (int k = 0; k < 2; ++k) { const int tile = F.wave + 8 * k, mt = tile >> 2, nt = tile & 3;
            f32x4 a = (f32x4){0.f, 0.f, 0.f, 0.f};
            a = mma_lds(ATT + mt * 16 * 72, 72, (const LAS bf16_t*)(F.lds + GL_VT) + nt * 16 * 72, 72, 2, a, F.lane);
            a = mma_lds((const LAS bf16_t*)(F.lds + GL_QTF) + mt * 16 * 40, 40, (const LAS bf16_t*)(F.lds + GL_SF) + nt * 16 * 40, 40, 1, a, F.lane);
            a = mma_lds((const LAS bf16_t*)(F.lds + GL_QTB) + mt * 16 * 40, 40, (const LAS bf16_t*)(F.lds + GL_SB) + nt * 16 * 40, 40, 1, a, F.lane);
#pragma unroll
            for (int e = 0; e < 4; ++e) O[(mt * 16 + 4 * g + e) * 65 + nt * 16 + c] = a[e]; }
        __syncthreads();
        { const int i = t >> 3, dv8 = (t & 7) * 8; const bool lat = cn >= 4; const int row = (lat ? b * SEQ + (cn - 4) * 64 : NLAT + b * CTXL + cn * 64) + i;
          float v[8]; float ss = 0.f;
#pragma unroll
          for (int e = 0; e < 8; ++e) { v[e] = O[i * 65 + dv8 + e]; ss += v[e] * v[e]; }
          ss += shx(ss, 1, F.lane); ss += shx(ss, 2, F.lane); ss += shx(ss, 4, F.lane);
          const float rs = 1.0f / sqrtf(ss * (1.0f / 64.0f) + LN_EPS);
          const u32x4 gw = *(const u32x4*)(U + (size_t)row * DIN + UGR + h * 64 + dv8); const unsigned ga[4] = {gw.x, gw.y, gw.z, gw.w};
          const float* gn = F.in[I_GNORM] + l * 64 + dv8;
          float o[8];
#pragma unroll
          for (int e = 0; e < 4; ++e) { o[2 * e] = v[2 * e] * rs * gn[2 * e] * silu_f(bflo(ga[e])); o[2 * e + 1] = v[2 * e + 1] * rs * gn[2 * e + 1] * silu_f(bfhi(ga[e])); }
          u32x4 w; w.x = pk2(o[0], o[1]); w.y = pk2(o[2], o[3]); w.z = pk2(o[4], o[5]); w.w = pk2(o[6], o[7]);
          *(u32x4*)((bf16_t*)(F.ws + WS_MIX) + (size_t)row * DM + 512 + h * 64 + dv8) = w; }
    }
}

template <int L>
__device__ __forceinline__ void hyena_conv(Frame& F, const bf16_t* Rg, const bf16_t* Uin, const bf16_t* Xmul, int pos0, bool final_out, int ch, bf16_t* Zout) {
    constexpr int CS = 2 * L + 16;
    constexpr int NTL = L / 16, J = (NTL >= 64) ? 8 : 2, NGRP = NTL / J;
    LAS bf16_t* Rl = (LAS bf16_t*)F.lds;
    __syncthreads();
    for (int e = F.tid; e < 8 * CS; e += NTHR) { const int rho = e / CS, m = e % CS, src = m - rho; Rl[e] = (src >= 0 && src < 2 * L) ? Rg[src] : (bf16_t)0; }
    __syncthreads();
    const int i = F.lane & 15, g = F.lane >> 4, rho = i & 7;
    const LAS bf16_t* Rc = Rl + rho * CS + rho;
    for (int grp = F.wave; grp < NGRP; grp += NWAVES) {
        f32x4 acc[J];
#pragma unroll
        for (int j = 0; j < J; ++j) acc[j] = (f32x4){0.f, 0.f, 0.f, 0.f};
        const bf16_t* up = Uin + (size_t)i * SPB + pos0 + 8 * g;
        const int tb = grp * J * 16;
#pragma unroll 2
        for (int s0 = 0; s0 < L; s0 += 32) {
            const bf16x8 bfr = *(const bf16x8*)(up + s0);
#pragma unroll
            for (int j = 0; j < J; ++j) { const int m0 = L - (tb + j * 16 - s0) - i + 8 * g;
                const bf16x8 afr = *(const LAS bf16x8*)(Rc + m0);
                acc[j] = mfma16(afr, bfr, acc[j]); }
        }
#pragma unroll
        for (int j = 0; j < J; ++j) { const int t0 = tb + j * 16 + 4 * g;
            const u32x2 xw = *(const u32x2*)(Xmul + (size_t)i * SPB + pos0 + t0);
            const float y0 = acc[j][0] * bflo(xw.x), y1 = acc[j][1] * bfhi(xw.x), y2 = acc[j][2] * bflo(xw.y), y3 = acc[j][3] * bfhi(xw.y);
            if (!final_out) { u32x2 w; w.x = pk2(y0, y1); w.y = pk2(y2, y3); *(u32x2*)(Zout + (size_t)i * SPB + pos0 + t0) = w; }
            else { const int row = (pos0 ? NLAT + i * CTXL : i * SEQ) + t0; bf16_t* mp = (bf16_t*)(F.ws + WS_MIX) + (size_t)row * DM + 768 + ch;
                mp[0] = (bf16_t)f2bf(y0); mp[DM] = (bf16_t)f2bf(y1); mp[2 * DM] = (bf16_t)f2bf(y2); mp[3 * DM] = (bf16_t)f2bf(y3); } }
    }
}
__device__ __forceinline__ void ph_hyena(Frame& F, int l, bool last) {
    const bf16_t* HV = (const bf16_t*)(F.ws + WS_HV); bf16_t* Z2 = (bf16_t*)(F.ws + WS_Z2);
    for (int ch = F.wg; ch < 256; ch += F.G) {
        const bf16_t* v = HV + (size_t)(0 * 256 + ch) * NB * SPB; const bf16_t* x1 = HV + (size_t)(256 + ch) * NB * SPB; const bf16_t* x2 = HV + (size_t)(512 + ch) * NB * SPB;
        bf16_t* z = Z2 + (size_t)ch * NB * SPB;
        const bf16_t* R0 = (const bf16_t*)(F.ws + WS_HYF) + ((size_t)(l * 2 + 0) * 256 + ch) * 8192; const bf16_t* R1 = (const bf16_t*)(F.ws + WS_HYF) + ((size_t)(l * 2 + 1) * 256 + ch) * 8192;
        hyena_conv<4096>(F, R0, v, x1, 0, false, ch, z);
        VM_WAIT(); __syncthreads(); __builtin_amdgcn_fence(__ATOMIC_ACQUIRE, "agent"); VM_WAIT();
        hyena_conv<4096>(F, R1, z, x2, 0, true, ch, z);
        if (!last) {
            const bf16_t* C0 = (const bf16_t*)(F.ws + WS_HYFC) + ((size_t)(l * 2 + 0) * 256 + ch) * 512; const bf16_t* C1 = (const bf16_t*)(F.ws + WS_HYFC) + ((size_t)(l * 2 + 1) * 256 + ch) * 512;
            hyena_conv<256>(F, C0, v, x1, SEQ, false, ch, z);
            VM_WAIT(); __syncthreads(); __builtin_amdgcn_fence(__ATOMIC_ACQUIRE, "agent"); VM_WAIT();
            hyena_conv<256>(F, C1, z, x2, SEQ, true, ch, z);
        }
    }
}

__device__ __forceinline__ void ph_ln1(Frame& F, int l, int ntok) {
    const int gw = F.wg * NWAVES + F.wave, NGW = F.G * NWAVES;
    const float* lg = F.in[I_LN1G] + l * DM; const float* lb = F.in[I_LN1B] + l * DM;
    for (int row = gw; row < ntok; row += NGW) {
        float* xr = row < NLAT ? F.out + (size_t)row * DM : (float*)(F.ws + WS_XC) + (size_t)(row - NLAT) * DM;
        const float* yr = (const float*)(F.ws + WS_Y) + (size_t)row * DM;
        const float* md = mod_ptr(F, l, row);
        bf16_t* xm = (bf16_t*)(F.ws + WS_XM) + (size_t)row * DM;
        f32x4 v[4]; float s = 0.f;
#pragma unroll
        for (int j = 0; j < 4; ++j) { const int c = 4 * F.lane + 256 * j; const f32x4 x = *(const f32x4*)(xr + c), y = *(const f32x4*)(yr + c), g1 = *(const f32x4*)(md + 2048 + c);
            v[j] = x * DN_ALPHA + g1 * y; s += (v[j][0] + v[j][1]) + (v[j][2] + v[j][3]); }
        const float mean = wave_sum(s, F.lane) * (1.f / DM); float s2 = 0.f;
#pragma unroll
        for (int j = 0; j < 4; ++j) { v[j] = v[j] - mean; s2 += (v[j][0] * v[j][0] + v[j][1] * v[j][1]) + (v[j][2] * v[j][2] + v[j][3] * v[j][3]); }
        const float rstd = 1.f / sqrtf(wave_sum(s2, F.lane) * (1.f / DM) + LN_EPS);
#pragma unroll
        for (int j = 0; j < 4; ++j) { const int c = 4 * F.lane + 256 * j; const f32x4 g = *(const f32x4*)(lg + c), bb = *(const f32x4*)(lb + c), sh = *(const f32x4*)(md + 3072 + c), sc = *(const f32x4*)(md + 4096 + c);
            const f32x4 xn = v[j] * rstd * g + bb; *(f32x4*)(xr + c) = xn;
            u32x2 w; w.x = pk2(xn[0] * (1.f + sc[0]) + sh[0], xn[1] * (1.f + sc[1]) + sh[1]); w.y = pk2(xn[2] * (1.f + sc[2]) + sh[2], xn[3] * (1.f + sc[3]) + sh[3]);
            *(u32x2*)(xm + c) = w; }
    }
}
__device__ __forceinline__ void ph_ln2(Frame& F, int l, int ntok, bool last) {
    const int gw = F.wg * NWAVES + F.wave, NGW = F.G * NWAVES;
    const float* lg = F.in[I_LN2G] + l * DM; const float* lb = F.in[I_LN2B] + l * DM;
    for (int row = gw; row < ntok; row += NGW) {
        float* xr = row < NLAT ? F.out + (size_t)row * DM : (float*)(F.ws + WS_XC) + (size_t)(row - NLAT) * DM;
        const bf16_t* y2 = (const bf16_t*)(F.ws + WS_Y2) + (size_t)row * 9 * DM;
        const float* wg = (const float*)(F.ws + WS_WGT) + (size_t)row * 8;
        const float* md = mod_ptr(F, l, row);
        float ff[2][8];
#pragma unroll
        for (int j = 0; j < 2; ++j)
#pragma unroll
            for (int e = 0; e < 8; ++e) ff[j][e] = 0.f;
#pragma unroll
        for (int k = 0; k < 9; ++k) { const float wk = k < 8 ? wg[k] : 1.0f;
#pragma unroll
            for (int j = 0; j < 2; ++j) { const u32x4 q = *(const u32x4*)(y2 + (size_t)k * DM + 8 * F.lane + 512 * j); const unsigned a[4] = {q.x, q.y, q.z, q.w};
#pragma unroll
                for (int e = 0; e < 4; ++e) { ff[j][2 * e] += wk * bflo(a[e]); ff[j][2 * e + 1] += wk * bfhi(a[e]); } } }
        float v[2][8]; float s = 0.f;
#pragma unroll
        for (int j = 0; j < 2; ++j) { const int c = 8 * F.lane + 512 * j;
            const f32x4 x0 = *(const f32x4*)(xr + c), x1 = *(const f32x4*)(xr + c + 4), g0 = *(const f32x4*)(md + 5120 + c), g1 = *(const f32x4*)(md + 5120 + c + 4);
#pragma unroll
            for (int e = 0; e < 4; ++e) { v[j][e] = x0[e] * DN_ALPHA + g0[e] * ff[j][e]; v[j][4 + e] = x1[e] * DN_ALPHA + g1[e] * ff[j][4 + e]; s += v[j][e] + v[j][4 + e]; } }
        const float mean = wave_sum(s, F.lane) * (1.f / DM); float s2 = 0.f;
#pragma unroll
        for (int j = 0; j < 2; ++j)
#pragma unroll
            for (int e = 0; e < 8; ++e) { v[j][e] -= mean; s2 += v[j][e] * v[j][e]; }
        const float rstd = 1.f / sqrtf(wave_sum(s2, F.lane) * (1.f / DM) + LN_EPS);
        const float* mdn = last ? md : mod_ptr(F, l + 1, row);
        bf16_t* xm = (bf16_t*)(F.ws + WS_XM) + (size_t)row * DM;
#pragma unroll
        for (int j = 0; j < 2; ++j) { const int c = 8 * F.lane + 512 * j; float xn[8];
#pragma unroll
            for (int e = 0; e < 8; ++e) xn[e] = v[j][e] * rstd * lg[c + e] + lb[c + e];
            *(f32x4*)(xr + c) = (f32x4){xn[0], xn[1], xn[2], xn[3]}; *(f32x4*)(xr + c + 4) = (f32x4){xn[4], xn[5], xn[6], xn[7]};
            if (!last) { u32x4 w; w.x = pk2(xn[0] * (1.f + mdn[1024 + c + 0]) + mdn[c + 0], xn[1] * (1.f + mdn[1024 + c + 1]) + mdn[c + 1]);
                w.y = pk2(xn[2] * (1.f + mdn[1024 + c + 2]) + mdn[c + 2], xn[3] * (1.f + mdn[1024 + c + 3]) + mdn[c + 3]);
                w.z = pk2(xn[4] * (1.f + mdn[1024 + c + 4]) + mdn[c + 4], xn[5] * (1.f + mdn[1024 + c + 5]) + mdn[c + 5]);
                w.w = pk2(xn[6] * (1.f + mdn[1024 + c + 6]) + mdn[c + 6], xn[7] * (1.f + mdn[1024 + c + 7]) + mdn[c + 7]);
                *(u32x4*)(xm + c) = w; } }
    }
}

__device__ __forceinline__ unsigned f_ord(float f) { const unsigned u = __builtin_bit_cast(unsigned, f); return (u & 0x80000000u) ? ~u : (u | 0x80000000u); }
__device__ __forceinline__ unsigned long long wave_max_u64(unsigned long long v, int lane) {
#pragma unroll
    for (int o = 1; o < 64; o <<= 1) { const unsigned lo = (unsigned)shxi((int)(unsigned)v, o, lane), hi = (unsigned)shxi((int)(unsigned)(v >> 32), o, lane); const unsigned long long w = ((unsigned long long)hi << 32) | lo; v = w > v ? w : v; }
    return v;
}
__device__ __forceinline__ float seg16_max(float v, int lane) { v = fmaxf(v, shx(v, 1, lane)); v = fmaxf(v, shx(v, 2, lane)); v = fmaxf(v, shx(v, 4, lane)); v = fmaxf(v, shx(v, 8, lane)); return v; }
__device__ __forceinline__ int seg16_min_i(int v, int lane) { int w; w = shxi(v, 1, lane); v = w < v ? w : v; w = shxi(v, 2, lane); v = w < v ? w : v; w = shxi(v, 4, lane); v = w < v ? w : v; w = shxi(v, 8, lane); v = w < v ? w : v; return v; }
__device__ __forceinline__ float seg16_top2(float v, int lane) {
    const float m1 = seg16_max(v, lane);
    const int first = seg16_min_i(v == m1 ? (lane & 15) : 99, lane);
    const float m2 = seg16_max((lane & 15) == first ? -3.0e38f : v, lane);
    return m1 + m2;
}
__device__ __forceinline__ void ph_route(Frame& F, int l, int ntok) {
    LAS int* hist = (LAS int*)F.lds;
    LAS int* base = hist + 128;
    LAS unsigned* alist = (LAS unsigned*)(F.lds + 1024);
    const int tpw = (ntok + F.G - 1) / F.G, t0 = F.wg * tpw, t1 = (t0 + tpw) < ntok ? (t0 + tpw) : ntok;
    __syncthreads();
    if (F.tid < 128) hist[F.tid] = 0;
    __syncthreads();
    const float* LG = (const float*)(F.ws + WS_LOGIT); const float* rb = F.in[I_RB] + l * NEXP;
    const float b0 = rb[F.lane], b1 = rb[F.lane + 64];
    for (int tok = t0 + F.wave; tok < t1; tok += NWAVES) {
        const float x0 = LG[(size_t)tok * 256 + F.lane], x1 = LG[(size_t)tok * 256 + 64 + F.lane];
        const float s0 = 1.0f / (1.0f + __expf(-x0)), s1 = 1.0f / (1.0f + __expf(-x1));
        const float e0 = s0 + b0, e1 = s1 + b1;
        const float gs0 = seg16_top2(e0, F.lane), gs1 = seg16_top2(e1, F.lane);
        float gsc[8];
#pragma unroll
        for (int g = 0; g < 4; ++g) { gsc[g] = shf(gs0, g * 16); gsc[4 + g] = shf(gs1, g * 16); }
        unsigned gmask = 0u;
#pragma unroll
        for (int g = 0; g < 8; ++g) { int cnt = 0;
#pragma unroll
            for (int g2 = 0; g2 < 8; ++g2) cnt += (gsc[g2] > gsc[g] || (gsc[g2] == gsc[g] && g2 < g)) ? 1 : 0;
            gmask |= (cnt < 4) ? (1u << g) : 0u; }
        const bool ok0 = (gmask >> (F.lane >> 4)) & 1u, ok1 = (gmask >> (4 + (F.lane >> 4))) & 1u;
        unsigned long long k0 = ok0 ? (((unsigned long long)f_ord(e0) << 32) | (unsigned)(255 - F.lane)) : 0ull;
        unsigned long long k1 = ok1 ? (((unsigned long long)f_ord(e1) << 32) | (unsigned)(255 - 64 - F.lane)) : 0ull;
        int mye = 0; float myw = 0.f; float wsum = 0.f;
#pragma unroll
        for (int k = 0; k < 8; ++k) {
            const unsigned long long best = wave_max_u64(k0 > k1 ? k0 : k1, F.lane);
            const int e = 255 - (int)(best & 0xffu);
            if (k0 == best) k0 = 0ull; if (k1 == best) k1 = 0ull;
            const float sv = shf(e < 64 ? s0 : s1, e & 63);
            wsum += sv; if (F.lane == k) { mye = e; myw = sv; }
        }
        if (F.lane < 8) {
            const int lr = __hip_atomic_fetch_add(&hist[mye], 1, __ATOMIC_RELAXED, __HIP_MEMORY_SCOPE_WORKGROUP);
            alist[(tok - t0) * 8 + F.lane] = (unsigned)mye | ((unsigned)lr << 8);
            ((int*)(F.ws + WS_EIDX))[(size_t)tok * 8 + F.lane] = mye;
            ((float*)(F.ws + WS_WGT))[(size_t)tok * 8 + F.lane] = myw / wsum * 2.5f;
        }
    }
    __syncthreads();
    if (F.tid < 128) { const int hcount = hist[F.tid]; base[F.tid] = hcount ? (int)atomicAdd(F.ctl + CW_CNT + l * 256 + F.tid, (unsigned)hcount) : 0; }
    __syncthreads();
    for (int a = F.tid; a < (t1 - t0) * 8; a += NTHR) { const unsigned v = alist[a]; ((int*)(F.ws + WS_RNK))[(size_t)t0 * 8 + a] = base[v & 0xffu] + (int)(v >> 8); }
}
__device__ __forceinline__ void ph_positions(Frame& F, int l, int ntok) {
    LAS int* cnt = (LAS int*)F.lds;
    LAS int* off = cnt + 132;
    __syncthreads();
    if (F.tid < NE1) cnt[F.tid] = F.tid < NEXP ? (int)__hip_atomic_load(F.ctl + CW_CNT + l * 256 + F.tid, __ATOMIC_RELAXED, __HIP_MEMORY_SCOPE_AGENT) : ntok;
    __syncthreads();
    if (F.tid == 0) { int o = 0; for (int e = 0; e < NE1; ++e) { off[e] = o; o += (cnt[e] + 255) & ~255; } off[NE1] = o; }
    __syncthreads();
    const int gt = F.wg * NTHR + F.tid, NGT = F.G * NTHR;
    int* rowtok = (int*)(F.ws + WS_ROWTOK); int* rowdst = (int*)(F.ws + WS_ROWDST); int* tile_exp = (int*)(F.ws + WS_TILEEXP);
    const int* eidx = (const int*)(F.ws + WS_EIDX); const int* rnk = (const int*)(F.ws + WS_RNK);
    for (int a = gt; a < ntok * 8; a += NGT) { const int tok = a >> 3, k = a & 7; const int pos = off[eidx[a]] + rnk[a]; rowtok[pos] = tok; rowdst[pos] = tok * 9 + k; }
    for (int tok = gt; tok < ntok; tok += NGT) { const int pos = off[NEXP] + tok; rowtok[pos] = tok; rowdst[pos] = tok * 9 + 8; }
    for (int i = gt; i < NE1 * 256; i += NGT) { const int e = i >> 8, p = i & 255; const int row = off[e] + cnt[e] + p; if (row < off[e + 1]) { rowtok[row] = 0; rowdst[row] = -1; } }
    for (int i = gt; i < NE1 * 320; i += NGT) { const int e = i / 320, p = i % 320; const int t = (off[e] >> 8) + p; if (t < (off[e + 1] >> 8)) tile_exp[t] = e; }
    if (gt == 0) F.ctl[CW_NTL + l] = (unsigned)(off[NE1] >> 8);
}

#ifndef MK_MULTI
#define MK_MULTI 0
#endif
constexpr int PH_PER_LAYER = 12, NPHASE = 2 + DEPTH * PH_PER_LAYER;
struct Args { const float* in[36]; float* out; unsigned char* ws; int ph_lo, ph_hi; };

__global__ void __launch_bounds__(NTHR, 2) mk_fwd(Args args) {
    extern __shared__ __attribute__((aligned(16))) unsigned char lds_raw[];
    Frame F;
    F.lds = (LAS unsigned char*)lds_raw;
    F.tid = threadIdx.x; F.lane = F.tid & 63; F.wave = __builtin_amdgcn_readfirstlane(F.tid >> 6);
    const int wave0 = F.wave;
    F.G = gridDim.x; F.wg = blockIdx.x;
    F.in = args.in;
    F.out = args.out; F.ws = args.ws; F.ctl = (unsigned*)(args.ws + WS_CTL);
    volatile LAS unsigned* MISC = (volatile LAS unsigned*)(F.lds + MISC_OFF);
    if (F.tid < 32) MISC[F.tid] = 0u;
    __syncthreads();
    const int lo = args.ph_lo, hi = args.ph_hi;
    const bool single = (hi - lo) > 1;
    XcdBarrier bar; bar.bar = F.ctl + CW_BAR; bar.x = 0; bar.st = nullptr;
    if (single) bar = xcd_barrier_post(F.ctl + CW_BAR, MISC + 8);
#define IN(k) (lo <= (k) && (k) < hi)
#define SEAM(k) do { if (IN(k) && IN((k) + 1)) xcd_barrier(bar); } while (0)
#define FRESH() do { int _ln; asm volatile("v_mbcnt_lo_u32_b32 %0, -1, 0\n\tv_mbcnt_hi_u32_b32 %0, -1, %0" : "=v"(_ln)); int _wv = wave0; asm volatile("" : "+s"(_wv)); F.lane = _ln; F.wave = _wv; F.tid = (_wv << 6) | _ln; \
        unsigned char* _w = args.ws; asm volatile("" : "+s"(_w)); F.ws = _w; F.ctl = (unsigned*)(_w + WS_CTL); float* _o = args.out; asm volatile("" : "+s"(_o)); F.out = _o; } while (0)

    if (IN(0)) { FRESH(); p0_static_weights(F); __syncthreads(); p0_mod(F); __syncthreads(); p0_hyena_filters(F); }
    SEAM(0);
    if (IN(1)) { FRESH(); p0_init_rows(F); }
    SEAM(1);
#pragma unroll 1
    for (int l = 0; l < DEPTH; ++l) {
        const int pb = 2 + l * PH_PER_LAYER; const bool last = (l == DEPTH - 1); const int ntok = last ? NLAT : NROW;
        if (IN(pb + 0)) { FRESH();
            p_expert_weights(F, l); __syncthreads();
            pg8::DenseOrder S; S.init(NROW, DIN, F.G, F.wg); pg8::EpiBf16 E{(bf16_t*)(F.ws + WS_U), DIN};
            pg8::gemm_phase<pg8::EpiBf16, pg8::DenseOrder, false>(F.tid, F.lds, (const bf16_t*)(F.ws + WS_XM), (const bf16_t*)(F.ws + WS_WIN) + (size_t)l * DIN * DM, DM, nullptr, S, E);
        }
        SEAM(pb + 0);
        if (IN(pb + 1)) { FRESH(); ph_transposes(F, l); __syncthreads(); ph_gla_local(F, l); }
        SEAM(pb + 1);
        if (IN(pb + 2)) { FRESH(); ph_na(F, l, last); ph_gla_scan(F); __syncthreads(); ph_hyena(F, l, last); }
        SEAM(pb + 2);
        if (IN(pb + 3)) { FRESH(); ph_gla_out(F, l, last); }
        SEAM(pb + 3);
        if (IN(pb + 4)) { FRESH();
            pg8::DenseOrder S; S.init(ntok, DM, F.G, F.wg); pg8::EpiF32 E{(float*)(F.ws + WS_Y), DM};
            pg8::gemm_phase<pg8::EpiF32, pg8::DenseOrder, false>(F.tid, F.lds, (const bf16_t*)(F.ws + WS_MIX), (const bf16_t*)(F.ws + WS_WOUT) + (size_t)l * DM * DM, DM, nullptr, S, E);
        }
        SEAM(pb + 4);
        if (IN(pb + 5)) { FRESH(); ph_ln1(F, l, ntok); }
        SEAM(pb + 5);
        if (IN(pb + 6)) { FRESH();
            pg8::DenseOrder S; S.init(ntok, 256, F.G, F.wg); pg8::EpiF32 E{(float*)(F.ws + WS_LOGIT), 256};
            pg8::gemm_phase<pg8::EpiF32, pg8::DenseOrder, false>(F.tid, F.lds, (const bf16_t*)(F.ws + WS_XM), (const bf16_t*)(F.ws + WS_WR) + (size_t)l * 256 * DM, DM, nullptr, S, E);
        }
        SEAM(pb + 6);
        if (IN(pb + 7)) { FRESH(); ph_route(F, l, ntok); }
        SEAM(pb + 7);
        if (IN(pb + 8)) { FRESH(); ph_positions(F, l, ntok); }
        SEAM(pb + 8);
        if (IN(pb + 9)) { FRESH();
            const int ntl = (int)__hip_atomic_load(F.ctl + CW_NTL + l, __ATOMIC_RELAXED, __HIP_MEMORY_SCOPE_AGENT);
            pg8::GroupedOrder S{(const int*)(F.ws + WS_TILEEXP), ntl, 2, F.G, F.wg}; pg8::EpiSwiglu E{(bf16_t*)(F.ws + WS_ACT)};
            pg8::gemm_phase<pg8::EpiSwiglu, pg8::GroupedOrder, true>(F.tid, F.lds, (const bf16_t*)(F.ws + WS_XM), (const bf16_t*)(F.ws + WS_EXP1), DM, (const int*)(F.ws + WS_ROWTOK), S, E);
        }
        SEAM(pb + 9);
        if (IN(pb + 10)) { FRESH();
            const int ntl = (int)__hip_atomic_load(F.ctl + CW_NTL + l, __ATOMIC_RELAXED, __HIP_MEMORY_SCOPE_AGENT);
            pg8::GroupedOrder S{(const int*)(F.ws + WS_TILEEXP), ntl, 4, F.G, F.wg}; pg8::EpiScatter E{(bf16_t*)(F.ws + WS_Y2), (const int*)(F.ws + WS_ROWDST)};
            pg8::gemm_phase<pg8::EpiScatter, pg8::GroupedOrder, false>(F.tid, F.lds, (const bf16_t*)(F.ws + WS_ACT), (const bf16_t*)(F.ws + WS_EXP2), EH, nullptr, S, E);
        }
        SEAM(pb + 10);
        if (IN(pb + 11)) { FRESH(); ph_ln2(F, l, ntok, last); }
        SEAM(pb + 11);
    }
#undef IN
#undef SEAM
#undef FRESH
}

extern "C" void kernel_launch(void* const* d_in, const int* in_sizes, int n_in, void* d_out, int out_size, void* d_ws, size_t ws_size, hipStream_t stream) {
    static int grid = 0;
    if (grid == 0) {
        if (n_in != 36 || out_size != NLAT * DM || ws_size < WS_END) { fprintf(stderr, "kernel_launch: unexpected shapes (n_in %d out %d ws %zu need %zu)\n", n_in, out_size, ws_size, (size_t)WS_END); grid = -1; return; }
        int dev = 0, cus = 0, per_cu = 0;
        if (hipGetDevice(&dev) != hipSuccess || hipDeviceGetAttribute(&cus, hipDeviceAttributeMultiprocessorCount, dev) != hipSuccess) { grid = -1; return; }
        if (hipFuncSetAttribute((const void*)mk_fwd, hipFuncAttributeMaxDynamicSharedMemorySize, LDS_BYTES) != hipSuccess) { fprintf(stderr, "kernel_launch: hipFuncSetAttribute failed\n"); grid = -1; return; }
        if (hipOccupancyMaxActiveBlocksPerMultiprocessor(&per_cu, (const void*)mk_fwd, NTHR, LDS_BYTES) != hipSuccess || per_cu < 1) { fprintf(stderr, "kernel_launch: occupancy query says %d\n", per_cu); }
        (void)hipGetLastError();
        grid = cus;
    }
    if (grid < 0) return;
    (void)hipMemsetAsync((char*)d_ws + WS_CTL, 0, CTL_BYTES, stream);
    Args a{};
    for (int i = 0; i < 36; ++i) a.in[i] = (const float*)d_in[i];
    a.out = (float*)d_out; a.ws = (unsigned char*)d_ws;
#if MK_MULTI
    for (int p = 0; p < NPHASE; ++p) { a.ph_lo = p; a.ph_hi = p + 1; hipLaunchKernelGGL(mk_fwd, dim3(grid), dim3(NTHR), LDS_BYTES, stream, a); }
#else
    a.ph_lo = 0; a.ph_hi = NPHASE; hipLaunchKernelGGL(mk_fwd, dim3(grid), dim3(NTHR), LDS_BYTES, stream, a);
#endif
}
```

```cpp
#include <hip/hip_runtime.h>
#include <cstdio>
#include <cstdint>

#define LAS __attribute__((address_space(3)))
#define GAS __attribute__((address_space(1)))
typedef unsigned short bf16_t;
typedef short bf16x8 __attribute__((ext_vector_type(8)));
typedef float f32x4 __attribute__((ext_vector_type(4)));
typedef float f32x2 __attribute__((ext_vector_type(2)));
typedef unsigned u32x4 __attribute__((ext_vector_type(4)));
typedef unsigned u32x2 __attribute__((ext_vector_type(2)));

constexpr int NB = 16, SEQ = 4096, CTXL = 256, DM = 1024, DEPTH = 4;
constexpr int NLAT = NB * SEQ;
constexpr int NCTX = NB * CTXL;
constexpr int NROW = NLAT + NCTX;
constexpr int SPB = SEQ + CTXL;
constexpr int DIN_REF = 3104;
constexpr int DIN = 3328;
constexpr int UQ = 0, UK = 512, UV = 1024, UGQ = 1536, UGK = 1664, UGV = 1792, UGR = 2048, UHY = 2304, ULAF = 3072, ULAB = 3200;
constexpr int NEXP = 128, TOPK = 8, EH = 256;
constexpr int NE1 = NEXP + 1;
constexpr int RMAX = 659712;
constexpr int TMAX = RMAX / 256;
constexpr float LN_EPS = 1e-6f;
constexpr float DN_ALPHA = 1.6817928305074290f;

__device__ __forceinline__ unsigned f2bf(float f) { unsigned u = __builtin_bit_cast(unsigned, f); return (u + 0x7fffu + ((u >> 16) & 1u)) >> 16; }
__device__ __forceinline__ unsigned pk2(float lo, float hi) { return f2bf(lo) | (f2bf(hi) << 16); }
__device__ __forceinline__ float bf2f(unsigned short b) { return __builtin_bit_cast(float, ((unsigned)b) << 16); }
__device__ __forceinline__ float bflo(unsigned w) { return __builtin_bit_cast(float, w << 16); }
__device__ __forceinline__ float bfhi(unsigned w) { return __builtin_bit_cast(float, w & 0xffff0000u); }
__device__ __forceinline__ float shx(float v, int o, int lane) { return __builtin_bit_cast(float, __builtin_amdgcn_ds_bpermute((lane ^ o) << 2, __builtin_bit_cast(int, v))); }
__device__ __forceinline__ int shxi(int v, int o, int lane) { return __builtin_amdgcn_ds_bpermute((lane ^ o) << 2, v); }
__device__ __forceinline__ float shf(float v, int src) { return __builtin_bit_cast(float, __builtin_amdgcn_ds_bpermute(src << 2, __builtin_bit_cast(int, v))); }
__device__ __forceinline__ float wave_sum(float v, int lane) {
#pragma unroll
    for (int o = 1; o < 64; o <<= 1) v += shx(v, o, lane);
    return v;
}
__device__ __forceinline__ float silu_f(float x) { return x / (1.0f + __expf(-x)); }
#define LDS_WAIT() asm volatile("s_waitcnt lgkmcnt(0)" ::: "memory")
#define VM_WAIT() asm volatile("s_waitcnt vmcnt(0)" ::: "memory")

#define XB_TMO      128
#define XB_XCNT(j)  (256  + 64 * (j))
#define XB_XSUB(j)  (1280 + 64 * (j))
#define XB_XGEN(j)  (2304 + 64 * (j))
#define XB_TOP      3328
#define XB_TOPGEN   3392
#define XCD_BAR_WORDS 3456
#define XB_SPIN_CAP (1u << 18)

__device__ __forceinline__ unsigned xb_ld(unsigned* p)              { return __hip_atomic_load(p, __ATOMIC_RELAXED, __HIP_MEMORY_SCOPE_AGENT); }
__device__ __forceinline__ unsigned xb_add(unsigned* p, unsigned v) { return __hip_atomic_fetch_add(p, v, __ATOMIC_RELAXED, __HIP_MEMORY_SCOPE_AGENT); }
__device__ __forceinline__ unsigned xb_xcc_id() { return (unsigned)__builtin_amdgcn_s_getreg((3 << 11) | 20) & 0xFu; }
#define XB_SPIN(cond, bar) do { unsigned _sp = 0; while (cond) { __builtin_amdgcn_s_sleep(1); \
    if ((++_sp & 255u) == 0u) { if (xb_ld(&(bar)[XB_TMO])) break; if (_sp > XB_SPIN_CAP) { atomicAdd(&(bar)[XB_TMO], 1u); break; } } } } while (0)

struct XcdBarrier { unsigned* bar; unsigned x; volatile LAS unsigned* st; };

__device__ __forceinline__ XcdBarrier xcd_barrier_post(unsigned* bar, volatile LAS unsigned* st) {
    XcdBarrier b; b.bar = bar; b.x = xb_xcc_id(); b.st = st;
    if (threadIdx.x == 0) (void)xb_add(&bar[XB_XCNT(b.x)], 1u);
    return b;
}
__device__ __forceinline__ void xcd_barrier_complete(unsigned* bar, unsigned x, unsigned& nloc, unsigned& nx) {
    const unsigned G = gridDim.x * gridDim.y * gridDim.z;
    unsigned sum, cnt, mine, sp = 0u;
    for (;;) {
        sum = 0u; cnt = 0u; mine = 0u;
#pragma unroll
        for (unsigned j = 0; j < 16; ++j) { const unsigned c = xb_ld(&bar[XB_XCNT(j)]); sum += c; cnt += (c > 0u) ? 1u : 0u; mine = (j == x) ? c : mine; }
        if (sum == G) break;
        __builtin_amdgcn_s_sleep(1);
        if ((++sp & 255u) == 0u) { if (xb_ld(&bar[XB_TMO])) break; if (sp > XB_SPIN_CAP) { atomicAdd(&bar[XB_TMO], 1u); break; } }
    }
    nloc = mine > 0u ? mine : 1u; nx = cnt > 0u ? cnt : 1u;
}
__device__ __forceinline__ void xcd_barrier(const XcdBarrier& b) {
    asm volatile("s_waitcnt vmcnt(0)" ::: "memory");
    __syncthreads();
    if (threadIdx.x == 0) {
        unsigned* bar = b.bar;
        __builtin_amdgcn_s_waitcnt(0);
        unsigned nloc = b.st[0], nx = b.st[1];
        if (nloc == 0u) { xcd_barrier_complete(bar, b.x, nloc, nx); b.st[0] = nloc; b.st[1] = nx; }
        const unsigned old = xb_add(&bar[XB_XSUB(b.x)], 1u);
        const unsigned gen = old / nloc;
        if (old + 1u == (gen + 1u) * nloc) {
            __builtin_amdgcn_fence(__ATOMIC_RELEASE, "agent");
            asm volatile("s_waitcnt vmcnt(0)" ::: "memory");
            const unsigned og = xb_add(&bar[XB_TOP], 1u);
            const unsigned tg = og / nx;
            if (og + 1u == (tg + 1u) * nx) xb_add(&bar[XB_TOPGEN], 1u);
            else XB_SPIN(xb_ld(&bar[XB_TOPGEN]) == tg, bar);
            __builtin_amdgcn_fence(__ATOMIC_ACQUIRE, "agent");
            xb_add(&bar[XB_XGEN(b.x)], 1u);
            asm volatile("s_waitcnt vmcnt(0)" ::: "memory");
        } else {
            XB_SPIN(xb_ld(&bar[XB_XGEN(b.x)]) == gen, bar);
            __builtin_amdgcn_fence(__ATOMIC_ACQUIRE, "agent");
            asm volatile("s_waitcnt vmcnt(0)" ::: "memory");
        }
    }
    __syncthreads();
}

namespace pg8 {
constexpr int BM = 256, BK = 64, HALF = 128, HTB = HALF * BK * 2, STAGE_BYTES = 8 * HTB, NXCD = 8, WGM = 8;
__host__ __device__ __forceinline__ int lds_byte(int r, int c) { const int st = (r >> 4) * 2 + (c >> 5), rr = r & 15, cc = c & 31, ob = rr * 64 + cc * 2; return st * 1024 + (ob ^ (((ob >> 9) & 1) << 5)); }
__host__ __device__ __forceinline__ void stage_rc(int b, int& R, int& C) { const int st = b / 1024, sb = b % 1024, swz = sb ^ (((sb >> 9) & 1) << 5); R = (st >> 1) * 16 + swz / 64; C = (st & 1) * 32 + (swz % 64) / 2; }
__host__ __device__ __forceinline__ int perm32(int rho) { const int n = rho >> 4, i = rho & 15; return 8 * (i >> 2) + 4 * n + (i & 3); }

struct Unit { int arow0, brow0, orow0, ocol0, aux; };

struct DenseOrder {
    int nM, nN, nwg, G, c;
    __device__ void init(int M, int N, int G_, int c_) { nM = M / BM; nN = N / BM; nwg = nM * nN; G = G_; c = c_; }
    __device__ __forceinline__ bool next(int i, Unit& u) const {
        const long L = (long)i * G + c; if (L >= nwg) return false;
        int wgid = (int)L; { const int q = nwg / NXCD, r = nwg % NXCD, xcd = wgid % NXCD, off = wgid / NXCD; wgid = (xcd < r ? xcd * (q + 1) : r * (q + 1) + (xcd - r) * q) + off; }
        const int nig = WGM * nN, gid = wgid / nig, fm = gid * WGM, gsz = (nM - fm) < WGM ? (nM - fm) : WGM;
        const int pm = fm + ((wgid % nig) % gsz), pn = (wgid % nig) / gsz;
        u.arow0 = pm * BM; u.brow0 = pn * BM; u.orow0 = pm * BM; u.ocol0 = pn * BM; u.aux = 0; return true;
    }
};
struct GroupedOrder {
    const int* tile_exp; int ntiles, nN, G, c;
    __device__ __forceinline__ bool next(int i, Unit& u) const {
        const long L = (long)i * G + c; if (L >= (long)ntiles * nN) return false;
        const int t = (int)(L / nN), pn = (int)(L % nN);
        const int e = tile_exp[t];
        u.arow0 = t * BM; u.brow0 = (e * nN + pn) * BM; u.orow0 = t * BM; u.ocol0 = pn * BM; u.aux = e; return true;
    }
};

__device__ __forceinline__ unsigned cvt_pk_bf16(float lo, float hi) { unsigned r; asm volatile("v_cvt_pk_bf16_f32 %0, %1, %2" : "=v"(r) : "v"(lo), "v"(hi)); return r; }

struct EpiF32 {
    static constexpr bool PERM = false;
    float* C; int ldc;
    __device__ __forceinline__ void operator()(const f32x4 (&acc)[2][2][4][2], const Unit& u, int wr, int wc, int fr, int fq) const {
        const int row0 = u.orow0 + wr * 64 + fr, col0 = u.ocol0 + wc * 32 + 4 * fq;
#pragma unroll
        for (int ai = 0; ai < 2; ++ai)
#pragma unroll
            for (int m = 0; m < 4; ++m) { float* rowp = C + (size_t)(row0 + ai * HALF + m * 16) * ldc + col0;
#pragma unroll
                for (int bj = 0; bj < 2; ++bj)
#pragma unroll
                    for (int n = 0; n < 2; ++n) *(f32x4*)(rowp + bj * HALF + n * 16) = acc[ai][bj][m][n]; }
    }
};
struct EpiBf16 {
    static constexpr bool PERM = true;
    bf16_t* O; int ldc;
    __device__ __forceinline__ void operator()(const f32x4 (&acc)[2][2][4][2], const Unit& u, int wr, int wc, int fr, int fq) const {
        const int row0 = u.orow0 + wr * 64 + fr, col0 = u.ocol0 + wc * 32 + 8 * fq;
#pragma unroll
        for (int ai = 0; ai < 2; ++ai)
#pragma unroll
            for (int m = 0; m < 4; ++m) { bf16_t* rowp = O + (size_t)(row0 + ai * HALF + m * 16) * ldc + col0;
#pragma unroll
                for (int bj = 0; bj < 2; ++bj) { const f32x4 v0 = acc[ai][bj][m][0], v1 = acc[ai][bj][m][1];
                    u32x4 w; w.x = cvt_pk_bf16(v0[0], v0[1]); w.y = cvt_pk_bf16(v0[2], v0[3]); w.z = cvt_pk_bf16(v1[0], v1[1]); w.w = cvt_pk_bf16(v1[2], v1[3]);
                    *(u32x4*)(rowp + bj * HALF) = w; } }
    }
};
struct EpiSwiglu {
    static constexpr bool PERM = false;
    bf16_t* ACT;
    __device__ __forceinline__ void operator()(const f32x4 (&acc)[2][2][4][2], const Unit& u, int wr, int wc, int fr, int fq) const {
        const int row0 = u.orow0 + wr * 64 + fr, pn = u.ocol0 >> 8;
#pragma unroll
        for (int ai = 0; ai < 2; ++ai)
#pragma unroll
            for (int m = 0; m < 4; ++m) { bf16_t* rowp = ACT + (size_t)(row0 + ai * HALF + m * 16) * EH + wc * 16 + 4 * fq;
#pragma unroll
                for (int bj = 0; bj < 2; ++bj) { const f32x4 g = acc[ai][bj][m][0], up = acc[ai][bj][m][1]; float h[4];
#pragma unroll
                    for (int i = 0; i < 4; ++i) h[i] = g[i] / (1.0f + __expf(-g[i])) * up[i];
                    u32x2 w; w.x = cvt_pk_bf16(h[0], h[1]); w.y = cvt_pk_bf16(h[2], h[3]);
                    *(u32x2*)(rowp + (pn * 2 + bj) * 64) = w; } }
    }
};
struct EpiScatter {
    static constexpr bool PERM = true;
    bf16_t* Y2; const int* rowdst;
    __device__ __forceinline__ void operator()(const f32x4 (&acc)[2][2][4][2], const Unit& u, int wr, int wc, int fr, int fq) const {
        const int row0 = u.orow0 + wr * 64 + fr, col0 = u.ocol0 + wc * 32 + 8 * fq;
#pragma unroll
        for (int ai = 0; ai < 2; ++ai)
#pragma unroll
            for (int m = 0; m < 4; ++m) { const int dst = rowdst[row0 + ai * HALF + m * 16];
                if (dst >= 0) { bf16_t* rowp = Y2 + (size_t)dst * DM + col0;
#pragma unroll
                    for (int bj = 0; bj < 2; ++bj) { const f32x4 v0 = acc[ai][bj][m][0], v1 = acc[ai][bj][m][1];
                        u32x4 w; w.x = cvt_pk_bf16(v0[0], v0[1]); w.y = cvt_pk_bf16(v0[2], v0[3]); w.z = cvt_pk_bf16(v1[0], v1[1]); w.w = cvt_pk_bf16(v1[2], v1[3]);
                        *(u32x4*)(rowp + bj * HALF) = w; } } }
    }
};

template <class Epi, class Sched, bool GATHER>
__device__ __forceinline__ void gemm_phase(const int tid_in, LAS unsigned char* lds, const bf16_t* Ag, const bf16_t* Bg, const int K, const int* rowidx, const Sched& S, const Epi& E) {
    int tid_ = tid_in; asm volatile("" : "+v"(tid_));
    const int tid = tid_, wid = __builtin_amdgcn_readfirstlane(tid >> 6), lane = tid & 63, wr = wid >> 2, wc = wid & 3, fr = lane & 15, fq = lane >> 4;
    const int nt = K / BK;
    int RA[2]; unsigned colA[2], voffB[2];
#pragma unroll
    for (int i = 0; i < 2; ++i) { int R, C; stage_rc(tid * 16 + i * 8192, R, C); const int Rb = Epi::PERM ? ((R & ~31) + perm32(R & 31)) : R;
        RA[i] = R; colA[i] = (unsigned)C * 2u; voffB[i] = (unsigned)(Rb * K + C) * 2u; }
    const size_t kstep = (size_t)(BK * 2);
    const size_t hstep = (size_t)HALF * K * 2;
    const unsigned ldsw = (unsigned)wid * 1024u;
    const int aoff = lds_byte(wr * 64 + fr, fq * 8), boff = lds_byte(wc * 32 + fr, fq * 8);
#define PG8_SA(b, h) (((b) * 2 + (h)) * HTB)
#define PG8_SB(b, h) ((4 + (b) * 2 + (h)) * HTB)
#define PG8_STAGE_B(bufoff, gbase) do { _Pragma("unroll") for (int _i = 0; _i < 2; ++_i) \
        __builtin_amdgcn_global_load_lds((const unsigned*)((const char*)(gbase) + voffB[_i]), (LAS unsigned*)(lds + (bufoff) + ldsw + _i * 8192), 16, 0, 0); } while (0)
#define PG8_STAGE_A(bufoff, gbase, o0, o1) do { \
        __builtin_amdgcn_global_load_lds((const unsigned*)((const char*)(gbase) + (o0)), (LAS unsigned*)(lds + (bufoff) + ldsw), 16, 0, 0); \
        __builtin_amdgcn_global_load_lds((const unsigned*)((const char*)(gbase) + (o1)), (LAS unsigned*)(lds + (bufoff) + ldsw + 8192), 16, 0, 0); } while (0)
#define PG8_LDA(dst, b, h) do { _Pragma("unroll") for (int m = 0; m < 4; ++m) _Pragma("unroll") for (int k = 0; k < 2; ++k) dst[m][k] = *(const LAS bf16x8*)(lds + PG8_SA(b, h) + aoff + m * 2048 + k * 1024); } while (0)
#define PG8_LDB(dst, b, h) do { _Pragma("unroll") for (int n = 0; n < 2; ++n) _Pragma("unroll") for (int k = 0; k < 2; ++k) dst[n][k] = *(const LAS bf16x8*)(lds + PG8_SB(b, h) + boff + n * 2048 + k * 1024); } while (0)
#define PG8_MMA(ai, bj, At, Bt) do { __builtin_amdgcn_s_setprio(1); _Pragma("unroll") for (int m = 0; m < 4; ++m) _Pragma("unroll") for (int n = 0; n < 2; ++n) _Pragma("unroll") for (int k = 0; k < 2; ++k) \
        acc[ai][bj][m][n] = __builtin_amdgcn_mfma_f32_16x16x32_bf16(Bt[n][k], At[m][k], acc[ai][bj][m][n], 0, 0, 0); __builtin_amdgcn_s_setprio(0); } while (0)
#define PG8_WAIT_V(n) asm volatile("s_waitcnt vmcnt(" #n ")" ::: "memory")
#define PG8_WAIT_L(n) asm volatile("s_waitcnt lgkmcnt(" #n ")" ::: "memory")
#define PG8_BAR __builtin_amdgcn_s_barrier()
#define PG8_SCHED __builtin_amdgcn_sched_barrier(0)
#define PG8_AOFF(dst, unit) do { if (GATHER) { _Pragma("unroll") for (int _h = 0; _h < 2; ++_h) _Pragma("unroll") for (int _i = 0; _i < 2; ++_i) \
            dst[_h][_i] = (unsigned)rowidx[(unit).arow0 + _h * HALF + RA[_i]] * (unsigned)(K * 2) + colA[_i]; } \
        else { _Pragma("unroll") for (int _h = 0; _h < 2; ++_h) _Pragma("unroll") for (int _i = 0; _i < 2; ++_i) dst[_h][_i] = (unsigned)((_h * HALF + RA[_i]) * K) * 2u + colA[_i]; } } while (0)
    Unit cur, nxt; int ui = 0;
    if (!S.next(0, cur)) return;
    f32x4 acc[2][2][4][2];
#pragma unroll
    for (int a = 0; a < 2; ++a)
#pragma unroll
        for (int b = 0; b < 2; ++b)
#pragma unroll
            for (int m = 0; m < 4; ++m)
#pragma unroll
                for (int n = 0; n < 2; ++n) acc[a][b][m][n] = (f32x4){0.f, 0.f, 0.f, 0.f};
    bf16x8 At[4][2], B0[2][2], B1[2][2];
    unsigned ac[2][2], an[2][2];
    PG8_AOFF(ac, cur);
    const char* cA = (const char*)Ag + (GATHER ? (size_t)0 : (size_t)cur.arow0 * K * 2); const char* cB = (const char*)Bg + (size_t)cur.brow0 * K * 2;
    PG8_STAGE_B(PG8_SB(0, 0), cB); PG8_STAGE_A(PG8_SA(0, 0), cA, ac[0][0], ac[0][1]); PG8_STAGE_B(PG8_SB(0, 1), cB + hstep); PG8_STAGE_A(PG8_SA(0, 1), cA, ac[1][0], ac[1][1]);
    if (wr == 1) PG8_BAR;
    PG8_WAIT_V(4); PG8_BAR;
    PG8_STAGE_B(PG8_SB(1, 0), cB + kstep); PG8_STAGE_A(PG8_SA(1, 0), cA + kstep, ac[0][0], ac[0][1]); PG8_STAGE_B(PG8_SB(1, 1), cB + hstep + kstep);
    PG8_WAIT_V(6); PG8_BAR;
    for (;;) {
        const bool has_next = S.next(ui + 1, nxt);
        if (has_next) { PG8_AOFF(an, nxt); } else {
#pragma unroll
            for (int _h = 0; _h < 2; ++_h)
#pragma unroll
                for (int _i = 0; _i < 2; ++_i) an[_h][_i] = ac[_h][_i]; }
        const char* nA = has_next ? ((const char*)Ag + (GATHER ? (size_t)0 : (size_t)nxt.arow0 * K * 2)) : cA; const char* nB = has_next ? (const char*)Bg + (size_t)nxt.brow0 * K * 2 : cB;
_Pragma("nounroll")
        for (int t = 0; t < nt; t += 2) {
            const bool last = (t == nt - 2);
            const char* a1 = cA + (size_t)(t + 1) * kstep;
            const char* a2 = last ? nA : cA + (size_t)(t + 2) * kstep; const char* b2 = last ? nB : cB + (size_t)(t + 2) * kstep;
            const char* a3 = a2 + kstep; const char* b3 = b2 + kstep;
            const unsigned s00 = last ? an[0][0] : ac[0][0], s01 = last ? an[0][1] : ac[0][1], s10 = last ? an[1][0] : ac[1][0], s11 = last ? an[1][1] : ac[1][1];
            PG8_LDB(B0, 0, 0); PG8_SCHED; PG8_LDA(At, 0, 0); PG8_STAGE_A(PG8_SA(1, 1), a1, ac[1][0], ac[1][1]);
            PG8_WAIT_L(8); PG8_BAR; PG8_WAIT_L(0); PG8_MMA(0, 0, At, B0); PG8_BAR; PG8_SCHED;
            PG8_LDB(B1, 0, 1); PG8_STAGE_B(PG8_SB(0, 0), b2);
            PG8_BAR; PG8_WAIT_L(0); PG8_MMA(0, 1, At, B1); PG8_BAR;
            PG8_LDA(At, 0, 1); PG8_STAGE_A(PG8_SA(0, 0), a2, s00, s01);
            PG8_BAR; PG8_WAIT_L(0); PG8_MMA(1, 0, At, B0); PG8_BAR; PG8_SCHED;
            PG8_STAGE_B(PG8_SB(0, 1), b2 + hstep);
            PG8_WAIT_V(6); PG8_BAR; PG8_MMA(1, 1, At, B1); PG8_BAR;
            PG8_LDB(B0, 1, 0); PG8_SCHED; PG8_LDA(At, 1, 0); PG8_STAGE_A(PG8_SA(0, 1), a2, s10, s11);
            PG8_WAIT_L(8); PG8_BAR; PG8_WAIT_L(0); PG8_MMA(0, 0, At, B0); PG8_BAR; PG8_SCHED;
            PG8_LDB(B1, 1, 1); PG8_STAGE_B(PG8_SB(1, 0), b3);
            PG8_BAR; PG8_WAIT_L(0); PG8_MMA(0, 1, At, B1); PG8_BAR;
            PG8_LDA(At, 1, 1); PG8_STAGE_A(PG8_SA(1, 0), a3, s00, s01);
            PG8_BAR; PG8_WAIT_L(0); PG8_MMA(1, 0, At, B0); PG8_BAR; PG8_SCHED;
            PG8_STAGE_B(PG8_SB(1, 1), b3 + hstep);
            PG8_WAIT_V(6); PG8_BAR; PG8_MMA(1, 1, At, B1); PG8_BAR;
        }
        E(acc, cur, wr, wc, fr, fq);
        if (!has_next) break;
#pragma unroll
        for (int a = 0; a < 2; ++a)
#pragma unroll
            for (int b = 0; b < 2; ++b)
#pragma unroll
                for (int m = 0; m < 4; ++m)
#pragma unroll
                    for (int n = 0; n < 2; ++n) acc[a][b][m][n] = (f32x4){0.f, 0.f, 0.f, 0.f};
        cur = nxt; cA = nA; cB = nB; ++ui;
#pragma unroll
        for (int _h = 0; _h < 2; ++_h)
#pragma unroll
            for (int _i = 0; _i < 2; ++_i) ac[_h][_i] = an[_h][_i];
    }
    PG8_WAIT_V(0);
    if (wr == 0) PG8_BAR;
    PG8_BAR;
#undef PG8_SA
#undef PG8_SB
#undef PG8_STAGE_A
#undef PG8_STAGE_B
#undef PG8_LDA
#undef PG8_LDB
#undef PG8_MMA
#undef PG8_WAIT_V
#undef PG8_WAIT_L
#undef PG8_BAR
#undef PG8_SCHED
#undef PG8_AOFF
}
}

constexpr int NWAVES = 8, NTHR = 512;
constexpr size_t MiB = 1u << 20;
constexpr size_t WS_CTL = 0, CTL_BYTES = 1 * MiB;
constexpr size_t WS_MOD = 1 * MiB;
constexpr size_t WS_WIN = 3 * MiB;
constexpr size_t WS_WOUT = 29 * MiB;
constexpr size_t WS_WR = 37 * MiB;
constexpr size_t WS_HYF = 39 * MiB;
constexpr size_t WS_HYFC = 71 * MiB;
constexpr size_t WS_XC = 73 * MiB;
constexpr size_t WS_EXP1 = 89 * MiB;
constexpr size_t WS_EXP2 = 218 * MiB;
constexpr size_t WS_XM = 283 * MiB;
constexpr size_t WS_EIDX = 419 * MiB;
constexpr size_t WS_WGT = 422 * MiB;
constexpr size_t WS_RNK = 425 * MiB;
constexpr size_t WS_ROWTOK = 428 * MiB;
constexpr size_t WS_ROWDST = 431 * MiB;
constexpr size_t WS_TILEEXP = 434 * MiB;
constexpr size_t WS_BIG = 435 * MiB;
constexpr size_t WS_U = WS_BIG;
constexpr size_t WS_MIX = 877 * MiB;
constexpr size_t WS_VT = 1013 * MiB;
constexpr size_t WS_HV = 1081 * MiB;
constexpr size_t WS_Z2 = 1183 * MiB;
constexpr size_t WS_GDS = 1217 * MiB;
constexpr size_t WS_GSIN = 1285 * MiB;
constexpr size_t WS_GD = 1319 * MiB;
constexpr size_t WS_Y = 1321 * MiB;
constexpr size_t WS_LOGIT = WS_BIG;
constexpr size_t WS_ACT = WS_BIG;
constexpr size_t WS_Y2 = 758 * MiB;
constexpr size_t WS_END = 1982 * MiB;
constexpr int CW_BAR = 4096;
constexpr int CW_CNT = 16384;
constexpr int CW_NTL = 20480;

constexpr int LDS_BYTES = 147456;
constexpr int MISC_OFF = 143360;

struct Frame {
    LAS unsigned char* lds;
    int tid, lane, wave, G, wg;
    const float* const* in;
    float* out; unsigned char* ws; unsigned* ctl;
};
enum { I_X = 0, I_C, I_CTX, I_CCTX, I_WMOD, I_BMOD, I_WIN, I_RPB, I_WA2, I_BA2, I_GNORM, I_HSW, I_HSB, I_HW1, I_HB1, I_HF1, I_HW2, I_HB2, I_HF2, I_HW3, I_HB3, I_HDEC, I_HSKIP,
       I_WOUT, I_LN1G, I_LN1B, I_RW, I_RB, I_WEG, I_WEU, I_WED, I_WSG, I_WSU, I_WSD, I_LN2G, I_LN2B };

__device__ __forceinline__ int row_b(int row) { return row < NLAT ? (row >> 12) : 16; }
__device__ __forceinline__ const float* mod_ptr(const Frame& F, int l, int row) { return (const float*)(F.ws + WS_MOD) + ((size_t)l * 17 + row_b(row)) * 6144; }

template <class RowFn>
__device__ __forceinline__ void tr_item(const float* W, int ldw, int k0, int n0, bf16_t* dst, int ldd, RowFn rf, LAS float* scr, int lane) {
#pragma unroll 8
    for (int i = 0; i < 32; ++i) { const int kk = 2 * i + (lane >> 5); scr[kk * 33 + (lane & 31)] = W[(size_t)(k0 + kk) * ldw + n0 + (lane & 31)]; }
    LDS_WAIT(); asm volatile("" ::: "memory");
    const int c = lane & 7;
#pragma unroll
    for (int j = 0; j < 4; ++j) { const int n = (lane >> 3) + 8 * j; const LAS float* s = scr + (8 * c) * 33 + n;
        u32x4 o; o.x = pk2(s[0 * 33], s[1 * 33]); o.y = pk2(s[2 * 33], s[3 * 33]); o.z = pk2(s[4 * 33], s[5 * 33]); o.w = pk2(s[6 * 33], s[7 * 33]);
        *(u32x4*)(dst + (size_t)rf(n0 + n) * ldd + k0 + 8 * c) = o; }
    LDS_WAIT(); asm volatile("" ::: "memory");
}
struct RowId { __device__ __forceinline__ int operator()(int n) const { return n; } };
struct RowWin { __device__ __forceinline__ int operator()(int n) const { return n >= 2336 ? n - 32 : n; } };
struct RowGU { int up; __device__ __forceinline__ int operator()(int j) const { return (j >> 6) * 128 + ((j & 63) >> 4) * 32 + up * 16 + (j & 15); } };

__device__ __forceinline__ void p0_static_weights(Frame& F) {
    LAS float* scr = (LAS float*)(F.lds + F.wave * 16384);
    const int gw = F.wg * NWAVES + F.wave, NGW = F.G * NWAVES;
    constexpr int I_IN = 16 * 97, I_OUT = 16 * 32, I_R = 16 * 4, PER_L = I_IN + I_OUT + I_R;
    for (int it = gw; it < DEPTH * PER_L; it += NGW) {
        const int l = it / PER_L; int r = it % PER_L;
        if (r < I_IN) { const int kb = r / 97, nb = r % 97; if (nb == 72) continue;
            tr_item(F.in[I_WIN] + (size_t)l * DM * DIN_REF, DIN_REF, kb * 64, nb * 32, (bf16_t*)(F.ws + WS_WIN) + (size_t)l * DIN * DM, DM, RowWin{}, scr, F.lane); continue; }
        r -= I_IN;
        if (r < I_OUT) { const int kb = r / 32, nb = r % 32;
            tr_item(F.in[I_WOUT] + (size_t)l * DM * DM, DM, kb * 64, nb * 32, (bf16_t*)(F.ws + WS_WOUT) + (size_t)l * DM * DM, DM, RowId{}, scr, F.lane); continue; }
        r -= I_OUT;
        { const int kb = r / 4, nb = r % 4;
            tr_item(F.in[I_RW] + (size_t)l * DM * NEXP, NEXP, kb * 64, nb * 32, (bf16_t*)(F.ws + WS_WR) + (size_t)l * 256 * DM, DM, RowId{}, scr, F.lane); }
    }
    const int gt = F.wg * NTHR + F.tid, NGT = F.G * NTHR;
    for (int i = gt; i < DEPTH * 128 * DM / 8; i += NGT) { const int l = i / (128 * DM / 8), r = i % (128 * DM / 8);
        *(u32x4*)((bf16_t*)(F.ws + WS_WR) + ((size_t)l * 256 + 128) * DM + (size_t)r * 8) = (u32x4){0u, 0u, 0u, 0u}; }
    for (int i = gt; i < DEPTH * 256 * DM; i += NGT) {
        const int k = i % DM, n = (i / DM) % 256, l = i / (DM * 256), dir = n >> 7, j = n & 127;
        const float* wi = F.in[I_WIN] + ((size_t)l * DM + k) * DIN_REF + 2304 + dir * 16;
        const float* wa = F.in[I_WA2] + ((size_t)(l * 2 + dir) * 16) * 128 + j;
        float s = 0.f;
#pragma unroll
        for (int r = 0; r < 16; ++r) s += wi[r] * wa[r * 128];
        ((bf16_t*)(F.ws + WS_WIN))[((size_t)l * DIN + 3072 + n) * DM + k] = (bf16_t)f2bf(s);
    }
}
__device__ __forceinline__ void p0_mod(Frame& F) {
    LAS float* sc = (LAS float*)F.lds;
    LAS float* red = (LAS float*)(F.lds + 17 * 1024 * 4);
    for (int i = F.tid; i < 17 * 1024; i += NTHR) { const int r = i >> 10, k = i & 1023; const float v = r < 16 ? F.in[I_C][r * 1024 + k] : F.in[I_CCTX][k]; sc[i] = silu_f(v); }
    __syncthreads();
    const int kq = F.tid >> 7, cl = F.tid & 127;
    for (int u = F.wg; u < DEPTH * 48; u += F.G) {
        const int l = u / 48, col = (u % 48) * 128 + cl;
        const float* w = F.in[I_WMOD] + (size_t)l * DM * 6144 + col;
        float a[17];
#pragma unroll
        for (int r = 0; r < 17; ++r) a[r] = 0.f;
#pragma unroll 4
        for (int k = kq * 256; k < kq * 256 + 256; ++k) { const float wv = w[(size_t)k * 6144];
#pragma unroll
            for (int r = 0; r < 17; ++r) a[r] += sc[r * 1024 + k] * wv; }
#pragma unroll
        for (int r = 0; r < 17; ++r) red[(kq * 17 + r) * 128 + cl] = a[r];
        __syncthreads();
        for (int i = F.tid; i < 17 * 128; i += NTHR) { const int r = i >> 7, c2 = i & 127, cc = (u % 48) * 128 + c2;
            const float s = red[(0 * 17 + r) * 128 + c2] + red[(1 * 17 + r) * 128 + c2] + red[(2 * 17 + r) * 128 + c2] + red[(3 * 17 + r) * 128 + c2] + F.in[I_BMOD][l * 6144 + cc];
            ((float*)(F.ws + WS_MOD))[((size_t)l * 17 + r) * 6144 + cc] = s; }
        __syncthreads();
    }
}
__device__ __forceinline__ void p0_hyena_filters(Frame& F) {
    LAS float* z = (LAS float*)F.lds;
    LAS float* h1 = z + 32 * 33;
    LAS float* h2 = h1 + 32 * 64;
    LAS float* tt = h2 + 32 * 64;
    constexpr int UL = 4096 / 32, UC = 256 / 32, UPL = UL + UC;
    for (int u = F.wg; u < DEPTH * UPL; u += F.G) {
        const int l = u / UPL, r = u % UPL; const bool lat = r < UL; const int L = lat ? 4096 : 256, n0 = (lat ? r : r - UL) * 32;
        __syncthreads();
        for (int i = F.tid; i < 32 * 33; i += NTHR) { const int p = i / 33, e = i % 33, n = n0 + p;
            const float t = (float)n / (float)(L - 1);
            float v;
            if (e == 0) v = t;
            else { const int kb = (e - 1) & 15; const float band = 1e-4f + (float)kb * ((15.0f - 1e-4f) / 15.0f);
                   const float w = 6.283185307179586f * (float)n / (float)L; const float ang = w * band;
                   v = e <= 16 ? __cosf(ang) : -__sinf(ang); }
            z[i] = v; if (e == 0) tt[p] = t; }
        __syncthreads();
        for (int i = F.tid; i < 32 * 64; i += NTHR) { const int p = i >> 6, j = i & 63; float s = F.in[I_HB1][l * 64 + j];
            for (int e = 0; e < 33; ++e) s += z[p * 33 + e] * F.in[I_HW1][((size_t)l * 33 + e) * 64 + j];
            h1[i] = __sinf(F.in[I_HF1][l * 64 + j] * s); }
        __syncthreads();
        for (int i = F.tid; i < 32 * 64; i += NTHR) { const int p = i >> 6, j = i & 63; float s = F.in[I_HB2][l * 64 + j];
            for (int e = 0; e < 64; ++e) s += h1[p * 64 + e] * F.in[I_HW2][((size_t)l * 64 + e) * 64 + j];
            h2[i] = __sinf(F.in[I_HF2][l * 64 + j] * s); }
        __syncthreads();
#pragma unroll 1
        for (int cc = 0; cc < 2; ++cc) {
            const int col = F.tid + cc * 512, o = col >> 9, dir = (col >> 8) & 1, ch = col & 255;
            float a[32];
#pragma unroll
            for (int p = 0; p < 32; ++p) a[p] = 0.f;
            const float* w3 = F.in[I_HW3] + (size_t)l * 64 * 1024 + col;
            for (int k = 0; k < 64; ++k) { const float wv = w3[(size_t)k * 1024];
#pragma unroll
                for (int p = 0; p < 32; ++p) a[p] += h2[p * 64 + k] * wv; }
            const float b3 = F.in[I_HB3][l * 1024 + col], dec = fabsf(F.in[I_HDEC][((size_t)(l * 2 + o) * 2 + dir) * 256 + ch]);
            const float skip = F.in[I_HSKIP][(l * 2 + o) * 256 + ch];
            bf16_t* R = lat ? (bf16_t*)(F.ws + WS_HYF) + ((size_t)(l * 2 + o) * 256 + ch) * 8192 : (bf16_t*)(F.ws + WS_HYFC) + ((size_t)(l * 2 + o) * 256 + ch) * 512;
#pragma unroll
            for (int p = 0; p < 32; ++p) { const int n = n0 + p; float v = (a[p] + b3) * __expf(-tt[p] * dec);
                if (dir == 0) { if (n == 0) v += skip; R[L - n] = (bf16_t)f2bf(v); }
                else { if (n == 0) R[0] = 0; else R[L + n] = (bf16_t)f2bf(v); } }
        }
    }
    __syncthreads();
}
__device__ __forceinline__ void p0_init_rows(Frame& F) {
    const int gw = F.wg * NWAVES + F.wave, NGW = F.G * NWAVES;
    for (int row = gw; row < NROW; row += NGW) {
        const float* src = row < NLAT ? F.in[I_X] + (size_t)row * DM : F.in[I_CTX] + (size_t)(row - NLAT) * DM;
        float* dst = row < NLAT ? F.out + (size_t)row * DM : (float*)(F.ws + WS_XC) + (size_t)(row - NLAT) * DM;
        const float* md = mod_ptr(F, 0, row);
        bf16_t* xm = (bf16_t*)(F.ws + WS_XM) + (size_t)row * DM;
#pragma unroll
        for (int j = 0; j < 4; ++j) { const int c = 4 * F.lane + 256 * j;
            const f32x4 v = *(const f32x4*)(src + c), sh = *(const f32x4*)(md + c), sc = *(const f32x4*)(md + 1024 + c);
            *(f32x4*)(dst + c) = v;
            u32x2 w; w.x = pk2(v[0] * (1.f + sc[0]) + sh[0], v[1] * (1.f + sc[1]) + sh[1]); w.y = pk2(v[2] * (1.f + sc[2]) + sh[2], v[3] * (1.f + sc[3]) + sh[3]);
            *(u32x2*)(xm + c) = w; }
    }
}
__device__ __forceinline__ void p_expert_weights(Frame& F, int l) {
    LAS float* scr = (LAS float*)(F.lds + F.wave * 16384);
    const int gw = F.wg * NWAVES + F.wave, NGW = F.G * NWAVES;
    constexpr int I1 = 16 * 8, I2 = 4 * 32, PER_E = 2 * I1 + I2;
    for (int it = gw; it < NE1 * PER_E; it += NGW) {
        const int e = it / PER_E; int r = it % PER_E;
        bf16_t* d1 = (bf16_t*)(F.ws + WS_EXP1) + (size_t)e * 512 * DM; bf16_t* d2 = (bf16_t*)(F.ws + WS_EXP2) + (size_t)e * DM * EH;
        if (r < 2 * I1) { const int up = r >= I1; if (up) r -= I1; const int kb = r / 8, nb = r % 8;
            const float* src = e < NEXP ? F.in[up ? I_WEU : I_WEG] + ((size_t)l * NEXP + e) * DM * EH : F.in[up ? I_WSU : I_WSG] + (size_t)l * DM * EH;
            tr_item(src, EH, kb * 64, nb * 32, d1, DM, RowGU{up}, scr, F.lane); }
        else { r -= 2 * I1; const int kb = r / 32, nb = r % 32;
            const float* src = e < NEXP ? F.in[I_WED] + ((size_t)l * NEXP + e) * EH * DM : F.in[I_WSD] + (size_t)l * EH * DM;
            tr_item(src, DM, kb * 64, nb * 32, d2, EH, RowId{}, scr, F.lane); }
    }
}

__device__ __forceinline__ f32x4 mfma16(bf16x8 a, bf16x8 b, f32x4 c) { return __builtin_amdgcn_mfma_f32_16x16x32_bf16(a, b, c, 0, 0, 0); }

__device__ __forceinline__ void ph_transposes(Frame& F, int l) {
    LAS bf16_t* tile = (LAS bf16_t*)(F.lds + F.wave * 16384);
    const bf16_t* U = (const bf16_t*)(F.ws + WS_U);
    const int gw = F.wg * NWAVES + F.wave, NGW = F.G * NWAVES;
    const int rsub = F.lane >> 3, cseg = F.lane & 7;
    for (int u = gw; u < 1088 * 20; u += NGW) {
        const int tt = u / 20, blk = u % 20;
        int b, s0, Ls, rowbase, posbase;
        if (tt < 1024) { b = tt >> 6; s0 = (tt & 63) * 64; Ls = SEQ; rowbase = b * SEQ; posbase = 0; }
        else { const int t2 = tt - 1024; b = t2 >> 2; s0 = (t2 & 3) * 64; Ls = CTXL; rowbase = NLAT + b * CTXL; posbase = SEQ; }
        if (blk < 12) {
            const int c0 = blk * 64 + cseg * 8;
            float w0[8], w1[8], w2[8], bb[8];
#pragma unroll
            for (int i = 0; i < 8; ++i) { w0[i] = F.in[I_HSW][(l * 3 + 0) * 768 + c0 + i]; w1[i] = F.in[I_HSW][(l * 3 + 1) * 768 + c0 + i]; w2[i] = F.in[I_HSW][(l * 3 + 2) * 768 + c0 + i]; bb[i] = F.in[I_HSB][l * 768 + c0 + i]; }
#pragma unroll 2
            for (int it = 0; it < 8; ++it) {
                const int sl = rsub + 8 * it, s = s0 + sl;
                const bf16_t* p = U + (size_t)(rowbase + s) * DIN + UHY + c0;
                const u32x4 zc = *(const u32x4*)p;
                u32x4 zm = (u32x4){0u, 0u, 0u, 0u}, zp = (u32x4){0u, 0u, 0u, 0u};
                if (s > 0) zm = *(const u32x4*)(p - DIN);
                if (s < Ls - 1) zp = *(const u32x4*)(p + DIN);
                const unsigned am[4] = {zm.x, zm.y, zm.z, zm.w}, ac[4] = {zc.x, zc.y, zc.z, zc.w}, ap[4] = {zp.x, zp.y, zp.z, zp.w};
#pragma unroll
                for (int i = 0; i < 4; ++i) {
                    const float v0 = bb[2 * i] + w0[2 * i] * bflo(am[i]) + w1[2 * i] * bflo(ac[i]) + w2[2 * i] * bflo(ap[i]);
                    const float v1 = bb[2 * i + 1] + w0[2 * i + 1] * bfhi(am[i]) + w1[2 * i + 1] * bfhi(ac[i]) + w2[2 * i + 1] * bfhi(ap[i]);
                    tile[(cseg * 8 + 2 * i) * 72 + sl] = (bf16_t)f2bf(v0); tile[(cseg * 8 + 2 * i + 1) * 72 + sl] = (bf16_t)f2bf(v1);
                }
            }
        } else {
            const int c0 = (blk - 12) * 64 + cseg * 8;
#pragma unroll 2
            for (int it = 0; it < 8; ++it) {
                const int sl = rsub + 8 * it, s = s0 + sl;
                const u32x4 zc = *(const u32x4*)(U + (size_t)(rowbase + s) * DIN + UV + c0);
                const unsigned ac[4] = {zc.x, zc.y, zc.z, zc.w};
#pragma unroll
                for (int i = 0; i < 4; ++i) { tile[(cseg * 8 + 2 * i) * 72 + sl] = (bf16_t)(ac[i] & 0xffffu); tile[(cseg * 8 + 2 * i + 1) * 72 + sl] = (bf16_t)(ac[i] >> 16); }
            }
        }
        LDS_WAIT(); asm volatile("" ::: "memory");
#pragma unroll 2
        for (int it = 0; it < 8; ++it) {
            const int ch = rsub + 8 * it;
            const u32x4 v = *(const LAS u32x4*)(tile + ch * 72 + cseg * 8);
            bf16_t* dst;
            if (blk < 12) dst = (bf16_t*)(F.ws + WS_HV) + ((size_t)(blk * 64 + ch) * NB + b) * SPB + posbase + s0 + cseg * 8;
            else dst = (bf16_t*)(F.ws + WS_VT) + ((size_t)b * 512 + (blk - 12) * 64 + ch) * SPB + posbase + s0 + cseg * 8;
            *(u32x4*)dst = v;
        }
        LDS_WAIT(); asm volatile("" ::: "memory");
    }
}

template <bool WIN>
__device__ __forceinline__ void na_unit(Frame& F, const LAS float* rpb, int b, int h, int r, int strip) {
    const bf16_t* U = (const bf16_t*)(F.ws + WS_U);
    const bf16_t* VT = (const bf16_t*)(F.ws + WS_VT) + ((size_t)b * 512 + h * 64) * SPB;
    const int i = F.lane & 15, g = F.lane >> 4;
    const int qrow = WIN ? (b * SEQ + r * 64 + strip * 16 + i) : (NLAT + b * CTXL + strip * 16 + i);
    const bf16_t* qp = U + (size_t)qrow * DIN + UQ + h * 64 + 8 * g;
    const bf16x8 q0 = *(const bf16x8*)qp, q1 = *(const bf16x8*)(qp + 32);
    constexpr int NT = WIN ? 32 : 16;
    f32x4 st[NT];
    int kr0 = 0, u0 = 0;
    if (WIN) { kr0 = r - 4; kr0 = kr0 < 0 ? 0 : (kr0 > 56 ? 56 : kr0); u0 = strip == 0 ? 0 : (strip == 1 ? 8 : (strip == 2 ? 24 : 32)); }
    if (WIN) {
#pragma unroll
        for (int kt = 0; kt < 16; ++kt) {
            const int krow = b * SEQ + (kr0 + (kt >> 1)) * 64 + u0 + (kt & 1) * 16 + i;
            const bf16_t* kp = U + (size_t)krow * DIN + UK + h * 64 + 8 * g;
            const bf16x8 k0 = *(const bf16x8*)kp, k1 = *(const bf16x8*)(kp + 32);
            f32x4 a = (f32x4){0.f, 0.f, 0.f, 0.f}; a = mfma16(k0, q0, a); a = mfma16(k1, q1, a); st[kt] = a;
        }
    }
#pragma unroll
    for (int ct = 0; ct < 16; ++ct) {
        const int krow = NLAT + b * CTXL + ct * 16 + i;
        const bf16_t* kp = U + (size_t)krow * DIN + UK + h * 64 + 8 * g;
        const bf16x8 k0 = *(const bf16x8*)kp, k1 = *(const bf16x8*)(kp + 32);
        f32x4 a = (f32x4){0.f, 0.f, 0.f, 0.f}; a = mfma16(k0, q0, a); a = mfma16(k1, q1, a); st[(WIN ? 16 : 0) + ct] = a;
    }
    float mx = -3.0e38f;
    if (WIN) {
        const int c = strip * 16 + i; int kc0 = c - 8; kc0 = kc0 < 0 ? 0 : (kc0 > 48 ? 48 : kc0);
#pragma unroll
        for (int kt = 0; kt < 16; ++kt) {
            const int kr = kr0 + (kt >> 1), dr = kr - r + 7;
#pragma unroll
            for (int e = 0; e < 4; ++e) {
                const int kc = u0 + (kt & 1) * 16 + 4 * g + e; const bool ok = (kc >= kc0) && (kc < kc0 + 16);
                int dc = kc - c + 15; dc = dc < 0 ? 0 : (dc > 30 ? 30 : dc);
                const float s = ok ? (st[kt][e] * 0.125f + rpb[(h * 15 + dr) * 31 + dc]) : -3.0e38f;
                st[kt][e] = s; mx = fmaxf(mx, s);
            }
        }
    }
#pragma unroll
    for (int ct = 0; ct < 16; ++ct)
#pragma unroll
        for (int e = 0; e < 4; ++e) { const float s = st[(WIN ? 16 : 0) + ct][e] * 0.125f; st[(WIN ? 16 : 0) + ct][e] = s; mx = fmaxf(mx, s); }
    mx = fmaxf(mx, shx(mx, 16, F.lane)); mx = fmaxf(mx, shx(mx, 32, F.lane));
    float sum = 0.f;
#pragma unroll
    for (int t = 0; t < NT; ++t)
#pragma unroll
        for (int e = 0; e < 4; ++e) { const float p = __expf(st[t][e] - mx); st[t][e] = p; sum += p; }
    sum += shx(sum, 16, F.lane); sum += shx(sum, 32, F.lane);
    const float inv = 1.0f / sum;
    f32x4 o[4];
#pragma unroll
    for (int d = 0; d < 4; ++d) o[d] = (f32x4){0.f, 0.f, 0.f, 0.f};
#pragma unroll
    for (int c = 0; c < NT / 2; ++c) {
        const f32x4 p0 = st[2 * c], p1 = st[2 * c + 1];
        u32x4 pw; pw.x = pk2(p0[0], p0[1]); pw.y = pk2(p0[2], p0[3]); pw.z = pk2(p1[0], p1[1]); pw.w = pk2(p1[2], p1[3]);
        const bf16x8 pf = __builtin_bit_cast(bf16x8, pw);
        int pos;
        if (WIN && c < 8) pos = (kr0 + c) * 64 + u0 + 4 * g; else pos = SEQ + (c - (WIN ? 8 : 0)) * 32 + 4 * g;
#pragma unroll
        for (int d = 0; d < 4; ++d) {
            const bf16_t* vp = VT + (size_t)(d * 16 + i) * SPB + pos;
            const u32x2 v0 = *(const u32x2*)vp, v1 = *(const u32x2*)(vp + 16);
            const bf16x8 vf = __builtin_bit_cast(bf16x8, ((u32x4){v0.x, v0.y, v1.x, v1.y}));
            o[d] = mfma16(vf, pf, o[d]);
        }
    }
    bf16_t* op = (bf16_t*)(F.ws + WS_MIX) + (size_t)qrow * DM + h * 64 + 4 * g;
#pragma unroll
    for (int d = 0; d < 4; ++d) { u32x2 w; w.x = pk2(o[d][0] * inv, o[d][1] * inv); w.y = pk2(o[d][2] * inv, o[d][3] * inv); *(u32x2*)(op + d * 16) = w; }
}
__device__ __forceinline__ void ph_na(Frame& F, int l, bool last) {
    LAS float* rpb = (LAS float*)(F.lds);
    __syncthreads();
    for (int i = F.tid; i < 8 * 15 * 31; i += NTHR) rpb[i] = F.in[I_RPB][(size_t)l * 8 * 15 * 31 + i];
    __syncthreads();
    const int gw = F.wg * NWAVES + F.wave, NGW = F.G * NWAVES;
    for (int u = gw; u < NB * 8 * 64 * 4; u += NGW) { const int strip = u & 3, r = (u >> 2) & 63, h = (u >> 8) & 7, b = u >> 11; na_unit<true>(F, rpb, b, h, r, strip); }
    if (!last) for (int u = gw; u < NB * 8 * 16; u += NGW) { const int qt = u & 15, h = (u >> 4) & 7, b = u >> 7; na_unit<false>(F, rpb, b, h, 0, qt); }
}

constexpr int GL_LAF = 0, GL_LAB = 8448, GL_Q = 16896, GL_K = 25344;
constexpr int GL_QTF = 33792, GL_KTF = 38912, GL_QTB = 44032, GL_KTB = 49152;
constexpr int GL_KDF = 54272, GL_KDB = 58880;
constexpr int GL_VT = 63488, GL_ATT = 72704;
constexpr int GL_SF = 81920, GL_SB = 87040;
constexpr int GL_O = 92160;
constexpr int GL_SEG = 108800;
__device__ __forceinline__ float log_sigmoid_f(float x) { return fminf(x, 0.f) - log1pf(__expf(-fabsf(x))); }
__device__ __forceinline__ f32x4 mma_lds(const LAS bf16_t* A, int lda, const LAS bf16_t* B, int ldb, int ksteps, f32x4 acc, int lane) {
    const int r = lane & 15, g = lane >> 4;
    for (int ks = 0; ks < ksteps; ++ks) { const bf16x8 a = *(const LAS bf16x8*)(A + r * lda + ks * 32 + 8 * g), b = *(const LAS bf16x8*)(B + r * ldb + ks * 32 + 8 * g); acc = mfma16(a, b, acc); }
    return acc;
}
template <bool FULL>
__device__ __forceinline__ void gla_prep(Frame& F, int l, int b, int cn, int h) {
    const bf16_t* U = (const bf16_t*)(F.ws + WS_U);
    LAS float* LAF = (LAS float*)(F.lds + GL_LAF); LAS float* LAB = (LAS float*)(F.lds + GL_LAB); LAS float* Q = (LAS float*)(F.lds + GL_Q); LAS float* Kk = (LAS float*)(F.lds + GL_K);
    LAS bf16_t* VT = (LAS bf16_t*)(F.lds + GL_VT); LAS float* SEG = (LAS float*)(F.lds + GL_SEG);
    const bool lat = cn >= 4; const int row0 = lat ? b * SEQ + (cn - 4) * 64 : NLAT + b * CTXL + cn * 64;
    const int t = F.tid;
    { const int i = t >> 3, d4 = (t & 7) * 4; const bf16_t* p = U + (size_t)(row0 + i) * DIN;
      const u32x2 wq = *(const u32x2*)(p + UGQ + h * 32 + d4), wk = *(const u32x2*)(p + UGK + h * 32 + d4), wf = *(const u32x2*)(p + ULAF + h * 32 + d4), wb = *(const u32x2*)(p + ULAB + h * 32 + d4);
      const float* ba = F.in[I_BA2] + (size_t)l * 256 + h * 32 + d4;
      const float qs = 0.17677669529663687f;
      Q[i * 33 + d4 + 0] = bflo(wq.x) * qs; Q[i * 33 + d4 + 1] = bfhi(wq.x) * qs; Q[i * 33 + d4 + 2] = bflo(wq.y) * qs; Q[i * 33 + d4 + 3] = bfhi(wq.y) * qs;
      Kk[i * 33 + d4 + 0] = bflo(wk.x); Kk[i * 33 + d4 + 1] = bfhi(wk.x); Kk[i * 33 + d4 + 2] = bflo(wk.y); Kk[i * 33 + d4 + 3] = bfhi(wk.y);
      LAF[i * 33 + d4 + 0] = log_sigmoid_f(bflo(wf.x) + ba[0]) * 0.0625f; LAF[i * 33 + d4 + 1] = log_sigmoid_f(bfhi(wf.x) + ba[1]) * 0.0625f;
      LAF[i * 33 + d4 + 2] = log_sigmoid_f(bflo(wf.y) + ba[2]) * 0.0625f; LAF[i * 33 + d4 + 3] = log_sigmoid_f(bfhi(wf.y) + ba[3]) * 0.0625f;
      LAB[i * 33 + d4 + 0] = log_sigmoid_f(bflo(wb.x) + ba[128]) * 0.0625f; LAB[i * 33 + d4 + 1] = log_sigmoid_f(bfhi(wb.x) + ba[129]) * 0.0625f;
      LAB[i * 33 + d4 + 2] = log_sigmoid_f(bflo(wb.y) + ba[130]) * 0.0625f; LAB[i * 33 + d4 + 3] = log_sigmoid_f(bfhi(wb.y) + ba[131]) * 0.0625f;
      const int dv8 = (t & 7) * 8; const u32x4 wv = *(const u32x4*)(p + UGV + h * 64 + dv8); const unsigned av[4] = {wv.x, wv.y, wv.z, wv.w};
#pragma unroll
      for (int e = 0; e < 4; ++e) { VT[(dv8 + 2 * e) * 72 + i] = (bf16_t)(av[e] & 0xffffu); VT[(dv8 + 2 * e + 1) * 72 + i] = (bf16_t)(av[e] >> 16); }
    }
    __syncthreads();
    if (lat) {
        for (int e = t; e < 64 * 16 * 2; e += NTHR) {
            const int which = e >> 10, i = (e >> 4) & 63, p = e & 15, half = p >> 3, idx = p & 7;
            const float pos = half ? (float)i : (float)(cn - 4);
            const float inv = __expf(-(float)idx * (9.210340371976184f / 8.0f));
            const float sn = __sinf(pos * inv), cs = __cosf(pos * inv);
            LAS float* A = which ? Kk : Q; const int d1 = half * 16 + idx;
            const float x1 = A[i * 33 + d1], x2 = A[i * 33 + d1 + 8];
            A[i * 33 + d1] = x1 * cs - x2 * sn; A[i * 33 + d1 + 8] = x1 * sn + x2 * cs;
        }
    }
    { const int x = t & 63, d = x & 31, dir = x >> 5, seg = t >> 6; LAS float* LA = dir ? LAB : LAF; float run = 0.f;
#pragma unroll
      for (int k = 0; k < 8; ++k) { const int p = seg * 8 + k, i = dir ? 63 - p : p; run += LA[i * 33 + d]; LA[i * 33 + d] = run; }
      SEG[x * 9 + seg] = run;
    }
    __syncthreads();
    { const int x = t & 63, d = x & 31, dir = x >> 5, seg = t >> 6; LAS float* LA = dir ? LAB : LAF; float pre = 0.f;
      for (int s2 = 0; s2 < seg; ++s2) pre += SEG[x * 9 + s2];
#pragma unroll
      for (int k = 0; k < 8; ++k) { const int p = seg * 8 + k, i = dir ? 63 - p : p; LA[i * 33 + d] += pre; }
    }
    __syncthreads();
    LAS bf16_t* QTF = (LAS bf16_t*)(F.lds + GL_QTF); LAS bf16_t* KTF = (LAS bf16_t*)(F.lds + GL_KTF); LAS bf16_t* QTB = (LAS bf16_t*)(F.lds + GL_QTB); LAS bf16_t* KTB = (LAS bf16_t*)(F.lds + GL_KTB);
    LAS bf16_t* KDF = (LAS bf16_t*)(F.lds + GL_KDF); LAS bf16_t* KDB = (LAS bf16_t*)(F.lds + GL_KDB);
    for (int e = t; e < 64 * 32; e += NTHR) {
        const int i = e >> 5, d = e & 31;
        const float bf = LAF[i * 33 + d], bb = LAB[i * 33 + d], bfl = LAF[63 * 33 + d], bbl = LAB[0 * 33 + d], kv = Kk[i * 33 + d];
        KDF[d * 72 + i] = (bf16_t)f2bf(kv * __expf(bfl - bf)); KDB[d * 72 + i] = (bf16_t)f2bf(kv * __expf(bbl - bb));
        if (FULL) { const float qv = Q[i * 33 + d];
            QTF[i * 40 + d] = (bf16_t)f2bf(qv * __expf(bf)); KTF[i * 40 + d] = (bf16_t)f2bf(kv * __expf(-bf));
            QTB[i * 40 + d] = (bf16_t)f2bf(qv * __expf(bb)); KTB[i * 40 + d] = (bf16_t)f2bf(kv * __expf(-bb)); }
    }
    __syncthreads();
}
__device__ __forceinline__ void ph_gla_local(Frame& F, int l) {
    LAS float* LAF = (LAS float*)(F.lds + GL_LAF); LAS float* LAB = (LAS float*)(F.lds + GL_LAB);
    for (int u = F.wg; u < NB * 68 * 4; u += F.G) {
        const int h = u & 3, cn = (u >> 2) % 68, b = (u >> 2) / 68;
        __syncthreads();
        gla_prep<false>(F, l, b, cn, h);
        const int mt = F.wave >> 1, nt = F.wave & 1, g = F.lane >> 4, c = F.lane & 15;
        float* DS = (float*)(F.ws + WS_GDS) + (size_t)u * 2 * 2048;
#pragma unroll
        for (int dir = 0; dir < 2; ++dir) {
            const LAS bf16_t* KD = (const LAS bf16_t*)(F.lds + (dir ? GL_KDB : GL_KDF));
            f32x4 a = (f32x4){0.f, 0.f, 0.f, 0.f};
            a = mma_lds((const LAS bf16_t*)(F.lds + GL_VT) + mt * 16 * 72, 72, KD + nt * 16 * 72, 72, 2, a, F.lane);
#pragma unroll
            for (int e = 0; e < 4; ++e) DS[dir * 2048 + (mt * 16 + 4 * g + e) * 32 + nt * 16 + c] = a[e];
        }
        if (F.tid < 64) { const int d = F.tid & 31, dir = F.tid >> 5; ((float*)(F.ws + WS_GD))[(size_t)u * 64 + F.tid] = __expf(dir ? LAB[0 * 33 + d] : LAF[63 * 33 + d]); }
    }
}
__device__ __forceinline__ void ph_gla_scan(Frame& F) {
    const int gt = F.wg * NTHR + F.tid, NGT = F.G * NTHR;
    const float* DS = (const float*)(F.ws + WS_GDS); const float* GD = (const float*)(F.ws + WS_GD); bf16_t* SIN = (bf16_t*)(F.ws + WS_GSIN);
    for (int w = gt; w < 128 * 1024; w += NGT) {
        const int chain = w >> 10, el = (w & 1023) * 2, dir = chain & 1, h = (chain >> 1) & 3, b = chain >> 3, d = el & 31;
        float s0 = 0.f, s1 = 0.f;
        for (int step = 0; step < 68; ++step) {
            const int cn = dir ? (step < 4 ? 3 - step : 71 - step) : step;
            const size_t u = (size_t)(b * 68 + cn) * 4 + h;
            *(unsigned*)(SIN + (u * 2 + dir) * 2048 + el) = pk2(s0, s1);
            const f32x2 ds = *(const f32x2*)(DS + (u * 2 + dir) * 2048 + el); const f32x2 dd = *(const f32x2*)(GD + u * 64 + dir * 32 + d);
            s0 = dd.x * s0 + ds.x; s1 = dd.y * s1 + ds.y;
        }
    }
}
__device__ __forceinline__ void ph_gla_out(Frame& F, int l, bool last) {
    const bf16_t* U = (const bf16_t*)(F.ws + WS_U);
    for (int u = F.wg; u < NB * 68 * 4; u += F.G) {
        const int h = u & 3, cn = (u >> 2) % 68, b = (u >> 2) / 68;
        if (last && cn < 4) continue;
        __syncthreads();
        gla_prep<true>(F, l, b, cn, h);
        const int t = F.tid;
        { const bf16_t* SIN = (const bf16_t*)(F.ws + WS_GSIN) + (size_t)u * 2 * 2048;
          for (int e = t; e < 2 * 64 * 4; e += NTHR) { const int dir = e >> 8, dv = (e >> 2) & 63, d8 = (e & 3) * 8;
              const u32x4 v = *(const u32x4*)(SIN + dir * 2048 + dv * 32 + d8); *(LAS u32x4*)((LAS bf16_t*)(F.lds + (dir ? GL_SB : GL_SF)) + dv * 40 + d8) = v; } }
        const int g = F.lane >> 4, c = F.lane & 15;
        LAS bf16_t* ATT = (LAS bf16_t*)(F.lds + GL_ATT);
#pragma unroll
        for (int k = 0; k < 2; ++k) { const int tile = F.wave + 8 * k, mt = tile >> 2, nt = tile & 3;
            f32x4 af = (f32x4){0.f, 0.f, 0.f, 0.f}, ab = af;
            af = mma_lds((const LAS bf16_t*)(F.lds + GL_QTF) + mt * 16 * 40, 40, (const LAS bf16_t*)(F.lds + GL_KTF) + nt * 16 * 40, 40, 1, af, F.lane);
            ab = mma_lds((const LAS bf16_t*)(F.lds + GL_QTB) + mt * 16 * 40, 40, (const LAS bf16_t*)(F.lds + GL_KTB) + nt * 16 * 40, 40, 1, ab, F.lane);
#pragma unroll
            for (int e = 0; e < 4; ++e) { const int i = mt * 16 + 4 * g + e, j = nt * 16 + c; const float v = (j <= i ? af[e] : 0.f) + (j >= i ? ab[e] : 0.f); ATT[i * 72 + j] = (bf16_t)f2bf(v); } }
        __syncthreads();
        LAS float* O = (LAS float*)(F.lds + GL_O);
#pragma unroll
        for (int k = 0; k < 2; ++k) { const int tile = F.wave + 8 * k, mt = tile >> 2, nt = tile & 3;
            f32x4 a = (f32x4){0.f, 0.f, 0.f, 0.f};
            a = mma_lds(ATT + mt * 16 * 72, 72, (const LAS bf16_t*)(F.lds + GL_VT) + nt * 16 * 72, 72, 2, a, F.lane);
            a = mma_lds((const LAS bf16_t*)(F.lds + GL_QTF) + mt * 16 * 40, 40, (const LAS bf16_t*)(F.lds + GL_SF) + nt * 16 * 40, 40, 1, a, F.lane);
            a = mma_lds((const LAS bf16_t*)(F.lds + GL_QTB) + mt * 16 * 40, 40, (const LAS bf16_t*)(F.lds + GL_SB) + nt * 16 * 40, 40, 1, a, F.lane);
#pragma unroll
            for (int e = 0; e < 4; ++e) O[(mt * 16 + 4 * g + e) * 65 + nt * 16 + c] = a[e]; }
        __syncthreads();
        { const int i = t >> 3, dv8 = (t & 7) * 8; const bool lat = cn >= 4; const int row = (lat ? b * SEQ + (cn - 4) * 64 : NLAT + b * CTXL + cn * 64) + i;
          float v[8]; float ss = 0.f;
#pragma unroll
          for (int e = 0; e < 8; ++e) { v[e] = O[i * 65 + dv8 + e]; ss += v[e] * v[e]; }
          ss += shx(ss, 1, F.lane); ss += shx(ss, 2, F.lane); ss += shx(ss, 4, F.lane);
          const float rs = 1.0f / sqrtf(ss * (1.0f / 64.0f) + LN_EPS);
          const u32x4 gw = *(const u32x4*)(U + (size_t)row * DIN + UGR + h * 64 + dv8); const unsigned ga[4] = {gw.x, gw.y, gw.z, gw.w};
          const float* gn = F.in[I_GNORM] + l * 64 + dv8;
          float o[8];
#pragma unroll
          for (int e = 0; e < 4; ++e) { o[2 * e] = v[2 * e] * rs * gn[2 * e] * silu_f(bflo(ga[e])); o[2 * e + 1] = v[2 * e + 1] * rs * gn[2 * e + 1] * silu_f(bfhi(ga[e])); }
          u32x4 w; w.x = pk2(o[0], o[1]); w.y = pk2(o[2], o[3]); w.z = pk2(o[4], o[5]); w.w = pk2(o[6], o[7]);
          *(u32x4*)((bf16_t*)(F.ws + WS_MIX) + (size_t)row * DM + 512 + h * 64 + dv8) = w; }
    }
}

template <int L>
__device__ __forceinline__ void hyena_conv(Frame& F, const bf16_t* Rg, const bf16_t* Uin, const bf16_t* Xmul, int pos0, bool final_out, int ch, bf16_t* Zout) {
    constexpr int CS = 2 * L + 16;
    constexpr int NTL = L / 16, J = (NTL >= 64) ? 8 : 2, NGRP = NTL / J;
    LAS bf16_t* Rl = (LAS bf16_t*)F.lds;
    __syncthreads();
    for (int e = F.tid; e < 8 * CS; e += NTHR) { const int rho = e / CS, m = e % CS, src = m - rho; Rl[e] = (src >= 0 && src < 2 * L) ? Rg[src] : (bf16_t)0; }
    __syncthreads();
    const int i = F.lane & 15, g = F.lane >> 4, rho = i & 7;
    const LAS bf16_t* Rc = Rl + rho * CS + rho;
    for (int grp = F.wave; grp < NGRP; grp += NWAVES) {
        f32x4 acc[J];
#pragma unroll
        for (int j = 0; j < J; ++j) acc[j] = (f32x4){0.f, 0.f, 0.f, 0.f};
        const bf16_t* up = Uin + (size_t)i * SPB + pos0 + 8 * g;
        const int tb = grp * J * 16;
#pragma unroll 2
        for (int s0 = 0; s0 < L; s0 += 32) {
            const bf16x8 bfr = *(const bf16x8*)(up + s0);
#pragma unroll
            for (int j = 0; j < J; ++j) { const int m0 = L - (tb + j * 16 - s0) - i + 8 * g;
                const bf16x8 afr = *(const LAS bf16x8*)(Rc + m0);
                acc[j] = mfma16(afr, bfr, acc[j]); }
        }
#pragma unroll
        for (int j = 0; j < J; ++j) { const int t0 = tb + j * 16 + 4 * g;
            const u32x2 xw = *(const u32x2*)(Xmul + (size_t)i * SPB + pos0 + t0);
            const float y0 = acc[j][0] * bflo(xw.x), y1 = acc[j][1] * bfhi(xw.x), y2 = acc[j][2] * bflo(xw.y), y3 = acc[j][3] * bfhi(xw.y);
            if (!final_out) { u32x2 w; w.x = pk2(y0, y1); w.y = pk2(y2, y3); *(u32x2*)(Zout + (size_t)i * SPB + pos0 + t0) = w; }
            else { const int row = (pos0 ? NLAT + i * CTXL : i * SEQ) + t0; bf16_t* mp = (bf16_t*)(F.ws + WS_MIX) + (size_t)row * DM + 768 + ch;
                mp[0] = (bf16_t)f2bf(y0); mp[DM] = (bf16_t)f2bf(y1); mp[2 * DM] = (bf16_t)f2bf(y2); mp[3 * DM] = (bf16_t)f2bf(y3); } }
    }
}
__device__ __forceinline__ void ph_hyena(Frame& F, int l, bool last) {
    const bf16_t* HV = (const bf16_t*)(F.ws + WS_HV); bf16_t* Z2 = (bf16_t*)(F.ws + WS_Z2);
    for (int ch = F.wg; ch < 256; ch += F.G) {
        const bf16_t* v = HV + (size_t)(0 * 256 + ch) * NB * SPB; const bf16_t* x1 = HV + (size_t)(256 + ch) * NB * SPB; const bf16_t* x2 = HV + (size_t)(512 + ch) * NB * SPB;
        bf16_t* z = Z2 + (size_t)ch * NB * SPB;
        const bf16_t* R0 = (const bf16_t*)(F.ws + WS_HYF) + ((size_t)(l * 2 + 0) * 256 + ch) * 8192; const bf16_t* R1 = (const bf16_t*)(F.ws + WS_HYF) + ((size_t)(l * 2 + 1) * 256 + ch) * 8192;
        hyena_conv<4096>(F, R0, v, x1, 0, false, ch, z);
        VM_WAIT(); __syncthreads(); __builtin_amdgcn_fence(__ATOMIC_ACQUIRE, "agent"); VM_WAIT();
        hyena_conv<4096>(F, R1, z, x2, 0, true, ch, z);
        if (!last) {
            const bf16_t* C0 = (const bf16_t*)(F.ws + WS_HYFC) + ((size_t)(l * 2 + 0) * 256 + ch) * 512; const bf16_t* C1 = (const bf16_t*)(F.ws + WS_HYFC) + ((size_t)(l * 2 + 1) * 256 + ch) * 512;
            hyena_conv<256>(F, C0, v, x1, SEQ, false, ch, z);
            VM_WAIT(); __syncthreads(); __builtin_amdgcn_fence(__ATOMIC_ACQUIRE, "agent"); VM_WAIT();
            hyena_conv<256>(F, C1, z, x2, SEQ, true, ch, z);
        }
    }
}

__device__ __forceinline__ void ph_ln1(Frame& F, int l, int ntok) {
    const int gw = F.wg * NWAVES + F.wave, NGW = F.G * NWAVES;
    const float* lg = F.in[I_LN1G] + l * DM; const float* lb = F.in[I_LN1B] + l * DM;
    for (int row = gw; row < ntok; row += NGW) {
        float* xr = row < NLAT ? F.out + (size_t)row * DM : (float*)(F.ws + WS_XC) + (size_t)(row - NLAT) * DM;
        const float* yr = (const float*)(F.ws + WS_Y) + (size_t)row * DM;
        const float* md = mod_ptr(F, l, row);
        bf16_t* xm = (bf16_t*)(F.ws + WS_XM) + (size_t)row * DM;
        f32x4 v[4]; float s = 0.f;
#pragma unroll
        for (int j = 0; j < 4; ++j) { const int c = 4 * F.lane + 256 * j; const f32x4 x = *(const f32x4*)(xr + c), y = *(const f32x4*)(yr + c), g1 = *(const f32x4*)(md + 2048 + c);
            v[j] = x * DN_ALPHA + g1 * y; s += (v[j][0] + v[j][1]) + (v[j][2] + v[j][3]); }
        const float mean = wave_sum(s, F.lane) * (1.f / DM); float s2 = 0.f;
#pragma unroll
        for (int j = 0; j < 4; ++j) { v[j] = v[j] - mean; s2 += (v[j][0] * v[j][0] + v[j][1] * v[j][1]) + (v[j][2] * v[j][2] + v[j][3] * v[j][3]); }
        const float rstd = 1.f / sqrtf(wave_sum(s2, F.lane) * (1.f / DM) + LN_EPS);
#pragma unroll
        for (int j = 0; j < 4; ++j) { const int c = 4 * F.lane + 256 * j; const f32x4 g = *(const f32x4*)(lg + c), bb = *(const f32x4*)(lb + c), sh = *(const f32x4*)(md + 3072 + c), sc = *(const f32x4*)(md + 4096 + c);
            const f32x4 xn = v[j] * rstd * g + bb; *(f32x4*)(xr + c) = xn;
            u32x2 w; w.x = pk2(xn[0] * (1.f + sc[0]) + sh[0], xn[1] * (1.f + sc[1]) + sh[1]); w.y = pk2(xn[2] * (1.f + sc[2]) + sh[2], xn[3] * (1.f + sc[3]) + sh[3]);
            *(u32x2*)(xm + c) = w; }
    }
}
__device__ __forceinline__ void ph_ln2(Frame& F, int l, int ntok, bool last) {
    const int gw = F.wg * NWAVES + F.wave, NGW = F.G * NWAVES;
    const float* lg = F.in[I_LN2G] + l * DM; const float* lb = F.in[I_LN2B] + l * DM;
    for (int row = gw; row < ntok; row += NGW) {
        float* xr = row < NLAT ? F.out + (size_t)row * DM : (float*)(F.ws + WS_XC) + (size_t)(row - NLAT) * DM;
        const bf16_t* y2 = (const bf16_t*)(F.ws + WS_Y2) + (size_t)row * 9 * DM;
        const float* wg = (const float*)(F.ws + WS_WGT) + (size_t)row * 8;
        const float* md = mod_ptr(F, l, row);
        float ff[2][8];
#pragma unroll
        for (int j = 0; j < 2; ++j)
#pragma unroll
            for (int e = 0; e < 8; ++e) ff[j][e] = 0.f;
#pragma unroll
        for (int k = 0; k < 9; ++k) { const float wk = k < 8 ? wg[k] : 1.0f;
#pragma unroll
            for (int j = 0; j < 2; ++j) { const u32x4 q = *(const u32x4*)(y2 + (size_t)k * DM + 8 * F.lane + 512 * j); const unsigned a[4] = {q.x, q.y, q.z, q.w};
#pragma unroll
                for (int e = 0; e < 4; ++e) { ff[j][2 * e] += wk * bflo(a[e]); ff[j][2 * e + 1] += wk * bfhi(a[e]); } } }
        float v[2][8]; float s = 0.f;
#pragma unroll
        for (int j = 0; j < 2; ++j) { const int c = 8 * F.lane + 512 * j;
            const f32x4 x0 = *(const f32x4*)(xr + c), x1 = *(const f32x4*)(xr + c + 4), g0 = *(const f32x4*)(md + 5120 + c), g1 = *(const f32x4*)(md + 5120 + c + 4);
#pragma unroll
            for (int e = 0; e < 4; ++e) { v[j][e] = x0[e] * DN_ALPHA + g0[e] * ff[j][e]; v[j][4 + e] = x1[e] * DN_ALPHA + g1[e] * ff[j][4 + e]; s += v[j][e] + v[j][4 + e]; } }
        const float mean = wave_sum(s, F.lane) * (1.f / DM); float s2 = 0.f;
#pragma unroll
        for (int j = 0; j < 2; ++j)
#pragma unroll
            for (int e = 0; e < 8; ++e) { v[j][e] -= mean; s2 += v[j][e] * v[j][e]; }
        const float rstd = 1.f / sqrtf(wave_sum(s2, F.lane) * (1.f / DM) + LN_EPS);
        const float* mdn = last ? md : mod_ptr(F, l + 1, row);
        bf16_t* xm = (bf16_t*)(F.ws + WS_XM) + (size_t)row * DM;
#pragma unroll
        for (int j = 0; j < 2; ++j) { const int c = 8 * F.lane + 512 * j; float xn[8];
#pragma unroll
            for (int e = 0; e < 8; ++e) xn[e] = v[j][e] * rstd * lg[c + e] + lb[c + e];
            *(f32x4*)(xr + c) = (f32x4){xn[0], xn[1], xn[2], xn[3]}; *(f32x4*)(xr + c + 4) = (f32x4){xn[4], xn[5], xn[6], xn[7]};
            if (!last) { u32x4 w; w.x = pk2(xn[0] * (1.f + mdn[1024 + c + 0]) + mdn[c + 0], xn[1] * (1.f + mdn[1024 + c + 1]) + mdn[c + 1]);
                w.y = pk2(xn[2] * (1.f + mdn[1024 + c + 2]) + mdn[c + 2], xn[3] * (1.f + mdn[1024 + c + 3]) + mdn[c + 3]);
                w.z = pk2(xn[4] * (1.f + mdn[1024 + c + 4]) + mdn[c + 4], xn[5] * (1.f + mdn[1024 + c + 5]) + mdn[c + 5]);
                w.w = pk2(xn[6] * (1.f + mdn[1024 + c + 6]) + mdn[c + 6], xn[7] * (1.f + mdn[1024 + c + 7]) + mdn[c + 7]);
                *(u32x4*)(xm + c) = w; } }
    }
}

__device__ __forceinline__ unsigned f_ord(float f) { const unsigned u = __builtin_bit_cast(unsigned, f); return (u & 0x80000000u) ? ~u : (u | 0x80000000u); }
__device__ __forceinline__ unsigned long long wave_max_u64(unsigned long long v, int lane) {
#pragma unroll
    for (int o = 1; o < 64; o <<= 1) { const unsigned lo = (unsigned)shxi((int)(unsigned)v, o, lane), hi = (unsigned)shxi((int)(unsigned)(v >> 32), o, lane); const unsigned long long w = ((unsigned long long)hi << 32) | lo; v = w > v ? w : v; }
    return v;
}
__device__ __forceinline__ float seg16_max(float v, int lane) { v = fmaxf(v, shx(v, 1, lane)); v = fmaxf(v, shx(v, 2, lane)); v = fmaxf(v, shx(v, 4, lane)); v = fmaxf(v, shx(v, 8, lane)); return v; }
__device__ __forceinline__ int seg16_min_i(int v, int lane) { int w; w = shxi(v, 1, lane); v = w < v ? w : v; w = shxi(v, 2, lane); v = w < v ? w : v; w = shxi(v, 4, lane); v = w < v ? w : v; w = shxi(v, 8, lane); v = w < v ? w : v; return v; }
__device__ __forceinline__ float seg16_top2(float v, int lane) {
    const float m1 = seg16_max(v, lane);
    const int first = seg16_min_i(v == m1 ? (lane & 15) : 99, lane);
    const float m2 = seg16_max((lane & 15) == first ? -3.0e38f : v, lane);
    return m1 + m2;
}
__device__ __forceinline__ void ph_route(Frame& F, int l, int ntok) {
    LAS int* hist = (LAS int*)F.lds;
    LAS int* base = hist + 128;
    LAS unsigned* alist = (LAS unsigned*)(F.lds + 1024);
    const int tpw = (ntok + F.G - 1) / F.G, t0 = F.wg * tpw, t1 = (t0 + tpw) < ntok ? (t0 + tpw) : ntok;
    __syncthreads();
    if (F.tid < 128) hist[F.tid] = 0;
    __syncthreads();
    const float* LG = (const float*)(F.ws + WS_LOGIT); const float* rb = F.in[I_RB] + l * NEXP;
    const float b0 = rb[F.lane], b1 = rb[F.lane + 64];
    for (int tok = t0 + F.wave; tok < t1; tok += NWAVES) {
        const float x0 = LG[(size_t)tok * 256 + F.lane], x1 = LG[(size_t)tok * 256 + 64 + F.lane];
        const float s0 = 1.0f / (1.0f + __expf(-x0)), s1 = 1.0f / (1.0f + __expf(-x1));
        const float e0 = s0 + b0, e1 = s1 + b1;
        const float gs0 = seg16_top2(e0, F.lane), gs1 = seg16_top2(e1, F.lane);
        float gsc[8];
#pragma unroll
        for (int g = 0; g < 4; ++g) { gsc[g] = shf(gs0, g * 16); gsc[4 + g] = shf(gs1, g * 16); }
        unsigned gmask = 0u;
#pragma unroll
        for (int g = 0; g < 8; ++g) { int cnt = 0;
#pragma unroll
            for (int g2 = 0; g2 < 8; ++g2) cnt += (gsc[g2] > gsc[g] || (gsc[g2] == gsc[g] && g2 < g)) ? 1 : 0;
            gmask |= (cnt < 4) ? (1u << g) : 0u; }
        const bool ok0 = (gmask >> (F.lane >> 4)) & 1u, ok1 = (gmask >> (4 + (F.lane >> 4))) & 1u;
        unsigned long long k0 = ok0 ? (((unsigned long long)f_ord(e0) << 32) | (unsigned)(255 - F.lane)) : 0ull;
        unsigned long long k1 = ok1 ? (((unsigned long long)f_ord(e1) << 32) | (unsigned)(255 - 64 - F.lane)) : 0ull;
        int mye = 0; float myw = 0.f; float wsum = 0.f;
#pragma unroll
        for (int k = 0; k < 8; ++k) {
            const unsigned long long best = wave_max_u64(k0 > k1 ? k0 : k1, F.lane);
            const int e = 255 - (int)(best & 0xffu);
            if (k0 == best) k0 = 0ull; if (k1 == best) k1 = 0ull;
            const float sv = shf(e < 64 ? s0 : s1, e & 63);
            wsum += sv; if (F.lane == k) { mye = e; myw = sv; }
        }
        if (F.lane < 8) {
            const int lr = __hip_atomic_fetch_add(&hist[mye], 1, __ATOMIC_RELAXED, __HIP_MEMORY_SCOPE_WORKGROUP);
            alist[(tok - t0) * 8 + F.lane] = (unsigned)mye | ((unsigned)lr << 8);
            ((int*)(F.ws + WS_EIDX))[(size_t)tok * 8 + F.lane] = mye;
            ((float*)(F.ws + WS_WGT))[(size_t)tok * 8 + F.lane] = myw / wsum * 2.5f;
        }
    }
    __syncthreads();
    if (F.tid < 128) { const int hcount = hist[F.tid]; base[F.tid] = hcount ? (int)atomicAdd(F.ctl + CW_CNT + l * 256 + F.tid, (unsigned)hcount) : 0; }
    __syncthreads();
    for (int a = F.tid; a < (t1 - t0) * 8; a += NTHR) { const unsigned v = alist[a]; ((int*)(F.ws + WS_RNK))[(size_t)t0 * 8 + a] = base[v & 0xffu] + (int)(v >> 8); }
}
__device__ __forceinline__ void ph_positions(Frame& F, int l, int ntok) {
    LAS int* cnt = (LAS int*)F.lds;
    LAS int* off = cnt + 132;
    __syncthreads();
    if (F.tid < NE1) cnt[F.tid] = F.tid < NEXP ? (int)__hip_atomic_load(F.ctl + CW_CNT + l * 256 + F.tid, __ATOMIC_RELAXED, __HIP_MEMORY_SCOPE_AGENT) : ntok;
    __syncthreads();
    if (F.tid == 0) { int o = 0; for (int e = 0; e < NE1; ++e) { off[e] = o; o += (cnt[e] + 255) & ~255; } off[NE1] = o; }
    __syncthreads();
    const int gt = F.wg * NTHR + F.tid, NGT = F.G * NTHR;
    int* rowtok = (int*)(F.ws + WS_ROWTOK); int* rowdst = (int*)(F.ws + WS_ROWDST); int* tile_exp = (int*)(F.ws + WS_TILEEXP);
    const int* eidx = (const int*)(F.ws + WS_EIDX); const int* rnk = (const int*)(F.ws + WS_RNK);
    for (int a = gt; a < ntok * 8; a += NGT) { const int tok = a >> 3, k = a & 7; const int pos = off[eidx[a]] + rnk[a]; rowtok[pos] = tok; rowdst[pos] = tok * 9 + k; }
    for (int tok = gt; tok < ntok; tok += NGT) { const int pos = off[NEXP] + tok; rowtok[pos] = tok; rowdst[pos] = tok * 9 + 8; }
    for (int i = gt; i < NE1 * 256; i += NGT) { const int e = i >> 8, p = i & 255; const int row = off[e] + cnt[e] + p; if (row < off[e + 1]) { rowtok[row] = 0; rowdst[row] = -1; } }
    for (int i = gt; i < NE1 * 320; i += NGT) { const int e = i / 320, p = i % 320; const int t = (off[e] >> 8) + p; if (t < (off[e + 1] >> 8)) tile_exp[t] = e; }
    if (gt == 0) F.ctl[CW_NTL + l] = (unsigned)(off[NE1] >> 8);
}

#ifndef MK_MULTI
#define MK_MULTI 0
#endif
constexpr int PH_PER_LAYER = 12, NPHASE = 2 + DEPTH * PH_PER_LAYER;
struct Args { const float* in[36]; float* out; unsigned char* ws; int ph_lo, ph_hi; };

__global__ void __launch_bounds__(NTHR, 2) mk_fwd(Args args) {
    extern __shared__ __attribute__((aligned(16))) unsigned char lds_raw[];
    Frame F;
    F.lds = (LAS unsigned char*)lds_raw;
    F.tid = threadIdx.x; F.lane = F.tid & 63; F.wave = __builtin_amdgcn_readfirstlane(F.tid >> 6);
    const int wave0 = F.wave;
    F.G = gridDim.x; F.wg = blockIdx.x;
    F.in = args.in;
    F.out = args.out; F.ws = args.ws; F.ctl = (unsigned*)(args.ws + WS_CTL);
    volatile LAS unsigned* MISC = (volatile LAS unsigned*)(F.lds + MISC_OFF);
    if (F.tid < 32) MISC[F.tid] = 0u;
    __syncthreads();
    const int lo = args.ph_lo, hi = args.ph_hi;
    const bool single = (hi - lo) > 1;
    XcdBarrier bar; bar.bar = F.ctl + CW_BAR; bar.x = 0; bar.st = nullptr;
    if (single) bar = xcd_barrier_post(F.ctl + CW_BAR, MISC + 8);
#define IN(k) (lo <= (k) && (k) < hi)
#define SEAM(k) do { if (IN(k) && IN((k) + 1)) xcd_barrier(bar); } while (0)
#define FRESH() do { int _ln; asm volatile("v_mbcnt_lo_u32_b32 %0, -1, 0\n\tv_mbcnt_hi_u32_b32 %0, -1, %0" : "=v"(_ln)); int _wv = wave0; asm volatile("" : "+s"(_wv)); F.lane = _ln; F.wave = _wv; F.tid = (_wv << 6) | _ln; \
        unsigned char* _w = args.ws; asm volatile("" : "+s"(_w)); F.ws = _w; F.ctl = (unsigned*)(_w + WS_CTL); float* _o = args.out; asm volatile("" : "+s"(_o)); F.out = _o; } while (0)

    if (IN(0)) { FRESH(); p0_static_weights(F); __syncthreads(); p0_mod(F); __syncthreads(); p0_hyena_filters(F); }
    SEAM(0);
    if (IN(1)) { FRESH(); p0_init_rows(F); }
    SEAM(1);
#pragma unroll 1
    for (int l = 0; l < DEPTH; ++l) {
        const int pb = 2 + l * PH_PER_LAYER; const bool last = (l == DEPTH - 1); const int ntok = last ? NLAT : NROW;
        if (IN(pb + 0)) { FRESH();
            p_expert_weights(F, l); __syncthreads();
            pg8::DenseOrder S; S.init(NROW, DIN, F.G, F.wg); pg8::EpiBf16 E{(bf16_t*)(F.ws + WS_U), DIN};
            pg8::gemm_phase<pg8::EpiBf16, pg8::DenseOrder, false>(F.tid, F.lds, (const bf16_t*)(F.ws + WS_XM), (const bf16_t*)(F.ws + WS_WIN) + (size_t)l * DIN * DM, DM, nullptr, S, E);
        }
        SEAM(pb + 0);
        if (IN(pb + 1)) { FRESH(); ph_transposes(F, l); __syncthreads(); ph_gla_local(F, l); }
        SEAM(pb + 1);
        if (IN(pb + 2)) { FRESH(); ph_na(F, l, last); ph_gla_scan(F); __syncthreads(); ph_hyena(F, l, last); }
        SEAM(pb + 2);
        if (IN(pb + 3)) { FRESH(); ph_gla_out(F, l, last); }
        SEAM(pb + 3);
        if (IN(pb + 4)) { FRESH();
            pg8::DenseOrder S; S.init(ntok, DM, F.G, F.wg); pg8::EpiF32 E{(float*)(F.ws + WS_Y), DM};
            pg8::gemm_phase<pg8::EpiF32, pg8::DenseOrder, false>(F.tid, F.lds, (const bf16_t*)(F.ws + WS_MIX), (const bf16_t*)(F.ws + WS_WOUT) + (size_t)l * DM * DM, DM, nullptr, S, E);
        }
        SEAM(pb + 4);
        if (IN(pb + 5)) { FRESH(); ph_ln1(F, l, ntok); }
        SEAM(pb + 5);
        if (IN(pb + 6)) { FRESH();
            pg8::DenseOrder S; S.init(ntok, 256, F.G, F.wg); pg8::EpiF32 E{(float*)(F.ws + WS_LOGIT), 256};
            pg8::gemm_phase<pg8::EpiF32, pg8::DenseOrder, false>(F.tid, F.lds, (const bf16_t*)(F.ws + WS_XM), (const bf16_t*)(F.ws + WS_WR) + (size_t)l * 256 * DM, DM, nullptr, S, E);
        }
        SEAM(pb + 6);
        if (IN(pb + 7)) { FRESH(); ph_route(F, l, ntok); }
        SEAM(pb + 7);
        if (IN(pb + 8)) { FRESH(); ph_positions(F, l, ntok); }
        SEAM(pb + 8);
        if (IN(pb + 9)) { FRESH();
            const int ntl = (int)__hip_atomic_load(F.ctl + CW_NTL + l, __ATOMIC_RELAXED, __HIP_MEMORY_SCOPE_AGENT);
            pg8::GroupedOrder S{(const int*)(F.ws + WS_TILEEXP), ntl, 2, F.G, F.wg}; pg8::EpiSwiglu E{(bf16_t*)(F.ws + WS_ACT)};
            pg8::gemm_phase<pg8::EpiSwiglu, pg8::GroupedOrder, true>(F.tid, F.lds, (const bf16_t*)(F.ws + WS_XM), (const bf16_t*)(F.ws + WS_EXP1), DM, (const int*)(F.ws + WS_ROWTOK), S, E);
        }
        SEAM(pb + 9);
        if (IN(pb + 10)) { FRESH();
            const int ntl = (int)__hip_atomic_load(F.ctl + CW_NTL + l, __ATOMIC_RELAXED, __HIP_MEMORY_SCOPE_AGENT);
            pg8::GroupedOrder S{(const int*)(F.ws + WS_TILEEXP), ntl, 4, F.G, F.wg}; pg8::EpiScatter E{(bf16_t*)(F.ws + WS_Y2), (const int*)(F.ws + WS_ROWDST)};
            pg8::gemm_phase<pg8::EpiScatter, pg8::GroupedOrder, false>(F.tid, F.lds, (const bf16_t*)(F.ws + WS_ACT), (const bf16_t*)(F.ws + WS_EXP2), EH, nullptr, S, E);
        }
        SEAM(pb + 10);
        if (IN(pb + 11)) { FRESH(); ph_ln2(F, l, ntok, last); }
        SEAM(pb + 11);
    }
#undef IN
#undef SEAM
#undef FRESH
}

extern "C" void kernel_launch(void* const* d_in, const int* in_sizes, int n_in, void* d_out, int out_size, void* d_ws, size_t ws_size, hipStream_t stream) {
    static int grid = 0;
    if (grid == 0) {
        if (n_in != 36 || out_size != NLAT * DM || ws_size < WS_END) { fprintf(stderr, "kernel_launch: unexpected shapes (n_in %d out %d ws %zu need %zu)\n", n_in, out_size, ws_size, (size_t)WS_END); grid = -1; return; }
        int dev = 0, cus = 0, per_cu = 0;
        if (hipGetDevice(&dev) != hipSuccess || hipDeviceGetAttribute(&cus, hipDeviceAttributeMultiprocessorCount, dev) != hipSuccess) { grid = -1; return; }
        if (hipFuncSetAttribute((const void*)mk_fwd, hipFuncAttributeMaxDynamicSharedMemorySize, LDS_BYTES) != hipSuccess) { fprintf(stderr, "kernel_launch: hipFuncSetAttribute failed\n"); grid = -1; return; }
        if (hipOccupancyMaxActiveBlocksPerMultiprocessor(&per_cu, (const void*)mk_fwd, NTHR, LDS_BYTES) != hipSuccess || per_cu < 1) { fprintf(stderr, "kernel_launch: occupancy query says %d\n", per_cu); }
        (void)hipGetLastError();
        grid = cus;
    }
    if (grid < 0) return;
    (void)hipMemsetAsync((char*)d_ws + WS_CTL, 0, CTL_BYTES, stream);
    Args a{};
    for (int i = 0; i < 36; ++i) a.in[i] = (const float*)d_in[i];
    a.out = (float*)d_out; a.ws = (unsigned char*)d_ws;
#if MK_MULTI
    for (int p = 0; p < NPHASE; ++p) { a.ph_lo = p; a.ph_hi = p + 1; hipLaunchKernelGGL(mk_fwd, dim3(grid), dim3(NTHR), LDS_BYTES, stream, a); }
#else
    a.ph_lo = 0; a.ph_hi = NPHASE; hipLaunchKernelGGL(mk_fwd, dim3(grid), dim3(NTHR), LDS_BYTES, stream, a);
#endif
}
```

```cpp
#include <hip/hip_runtime.h>
#include <cstdio>
#include <cstdint>

#define LAS __attribute__((address_space(3)))
#define GAS __attribute__((address_space(1)))
typedef unsigned short bf16_t;
typedef short bf16x8 __attribute__((ext_vector_type(8)));
typedef float f32x4 __attribute__((ext_vector_type(4)));
typedef float f32x2 __attribute__((ext_vector_type(2)));
typedef unsigned u32x4 __attribute__((ext_vector_type(4)));
typedef unsigned u32x2 __attribute__((ext_vector_type(2)));

constexpr int NB = 16, SEQ = 4096, CTXL = 256, DM = 1024, DEPTH = 4;
constexpr int NLAT = NB * SEQ;
constexpr int NCTX = NB * CTXL;
constexpr int NROW = NLAT + NCTX;
constexpr int SPB = SEQ + CTXL;
constexpr int DIN_REF = 3104;
constexpr int DIN = 3328;
constexpr int UQ = 0, UK = 512, UV = 1024, UGQ = 1536, UGK = 1664, UGV = 1792, UGR = 2048, UHY = 2304, ULAF = 3072, ULAB = 3200;
constexpr int NEXP = 128, TOPK = 8, EH = 256;
constexpr int NE1 = NEXP + 1;
constexpr int RMAX = 659712;
constexpr int TMAX = RMAX / 256;
constexpr float LN_EPS = 1e-6f;
constexpr float DN_ALPHA = 1.6817928305074290f;

__device__ __forceinline__ unsigned f2bf(float f) { unsigned u = __builtin_bit_cast(unsigned, f); return (u + 0x7fffu + ((u >> 16) & 1u)) >> 16; }
typedef __bf16 bf16v2 __attribute__((ext_vector_type(2)));
__device__ __forceinline__ unsigned pk2(float lo, float hi) { const f32x2 v = {lo, hi}; const bf16v2 b = __builtin_convertvector(v, bf16v2); return __builtin_bit_cast(unsigned, b); }
__device__ __forceinline__ float bf2f(unsigned short b) { return __builtin_bit_cast(float, ((unsigned)b) << 16); }
__device__ __forceinline__ float bflo(unsigned w) { return __builtin_bit_cast(float, w << 16); }
__device__ __forceinline__ float bfhi(unsigned w) { return __builtin_bit_cast(float, w & 0xffff0000u); }
__device__ __forceinline__ float shx(float v, int o, int lane) { return __builtin_bit_cast(float, __builtin_amdgcn_ds_bpermute((lane ^ o) << 2, __builtin_bit_cast(int, v))); }
__device__ __forceinline__ int shxi(int v, int o, int lane) { return __builtin_amdgcn_ds_bpermute((lane ^ o) << 2, v); }
__device__ __forceinline__ float shf(float v, int src) { return __builtin_bit_cast(float, __builtin_amdgcn_ds_bpermute(src << 2, __builtin_bit_cast(int, v))); }
__device__ __forceinline__ float wave_sum(float v, int lane) {
#pragma unroll
    for (int o = 1; o < 64; o <<= 1) v += shx(v, o, lane);
    return v;
}
__device__ __forceinline__ float silu_f(float x) { return x / (1.0f + __expf(-x)); }
#define LDS_WAIT() asm volatile("s_waitcnt lgkmcnt(0)" ::: "memory")
#define VM_WAIT() asm volatile("s_waitcnt vmcnt(0)" ::: "memory")

#define XB_TMO      128
#define XB_XCNT(j)  (256  + 64 * (j))
#define XB_XSUB(j)  (1280 + 64 * (j))
#define XB_XGEN(j)  (2304 + 64 * (j))
#define XB_TOP      3328
#define XB_TOPGEN   3392
#define XCD_BAR_WORDS 3456
#define XB_SPIN_CAP (1u << 18)

__device__ __forceinline__ unsigned xb_ld(unsigned* p)              { return __hip_atomic_load(p, __ATOMIC_RELAXED, __HIP_MEMORY_SCOPE_AGENT); }
__device__ __forceinline__ unsigned xb_add(unsigned* p, unsigned v) { return __hip_atomic_fetch_add(p, v, __ATOMIC_RELAXED, __HIP_MEMORY_SCOPE_AGENT); }
__device__ __forceinline__ unsigned xb_xcc_id() { return (unsigned)__builtin_amdgcn_s_getreg((3 << 11) | 20) & 0xFu; }
#define XB_SPIN(cond, bar) do { unsigned _sp = 0; while (cond) { __builtin_amdgcn_s_sleep(1); \
    if ((++_sp & 255u) == 0u) { if (xb_ld(&(bar)[XB_TMO])) break; if (_sp > XB_SPIN_CAP) { atomicAdd(&(bar)[XB_TMO], 1u); break; } } } } while (0)

struct XcdBarrier { unsigned* bar; unsigned x; volatile LAS unsigned* st; };

__device__ __forceinline__ XcdBarrier xcd_barrier_post(unsigned* bar, volatile LAS unsigned* st) {
    XcdBarrier b; b.bar = bar; b.x = xb_xcc_id(); b.st = st;
    if (threadIdx.x == 0) (void)xb_add(&bar[XB_XCNT(b.x)], 1u);
    return b;
}
__device__ __forceinline__ void xcd_barrier_complete(unsigned* bar, unsigned x, unsigned& nloc, unsigned& nx) {
    const unsigned G = gridDim.x * gridDim.y * gridDim.z;
    unsigned sum, cnt, mine, sp = 0u;
    for (;;) {
        sum = 0u; cnt = 0u; mine = 0u;
#pragma unroll
        for (unsigned j = 0; j < 16; ++j) { const unsigned c = xb_ld(&bar[XB_XCNT(j)]); sum += c; cnt += (c > 0u) ? 1u : 0u; mine = (j == x) ? c : mine; }
        if (sum == G) break;
        __builtin_amdgcn_s_sleep(1);
        if ((++sp & 255u) == 0u) { if (xb_ld(&bar[XB_TMO])) break; if (sp > XB_SPIN_CAP) { atomicAdd(&bar[XB_TMO], 1u); break; } }
    }
    nloc = mine > 0u ? mine : 1u; nx = cnt > 0u ? cnt : 1u;
}
__device__ __forceinline__ void xcd_barrier(const XcdBarrier& b) {
    asm volatile("s_waitcnt vmcnt(0)" ::: "memory");
    __syncthreads();
    if (threadIdx.x == 0) {
        unsigned* bar = b.bar;
        __builtin_amdgcn_s_waitcnt(0);
        unsigned nloc = b.st[0], nx = b.st[1];
        if (nloc == 0u) { xcd_barrier_complete(bar, b.x, nloc, nx); b.st[0] = nloc; b.st[1] = nx; }
        const unsigned old = xb_add(&bar[XB_XSUB(b.x)], 1u);
        const unsigned gen = old / nloc;
        if (old + 1u == (gen + 1u) * nloc) {
            __builtin_amdgcn_fence(__ATOMIC_RELEASE, "agent");
            asm volatile("s_waitcnt vmcnt(0)" ::: "memory");
            const unsigned og = xb_add(&bar[XB_TOP], 1u);
            const unsigned tg = og / nx;
            if (og + 1u == (tg + 1u) * nx) xb_add(&bar[XB_TOPGEN], 1u);
            else XB_SPIN(xb_ld(&bar[XB_TOPGEN]) == tg, bar);
            __builtin_amdgcn_fence(__ATOMIC_ACQUIRE, "agent");
            xb_add(&bar[XB_XGEN(b.x)], 1u);
            asm volatile("s_waitcnt vmcnt(0)" ::: "memory");
        } else {
            XB_SPIN(xb_ld(&bar[XB_XGEN(b.x)]) == gen, bar);
            __builtin_amdgcn_fence(__ATOMIC_ACQUIRE, "agent");
            asm volatile("s_waitcnt vmcnt(0)" ::: "memory");
        }
    }
    __syncthreads();
}

namespace pg8 {
constexpr int BM = 256, BK = 64, HALF = 128, HTB = HALF * BK * 2, STAGE_BYTES = 8 * HTB, NXCD = 8, WGM = 8;
__host__ __device__ __forceinline__ int lds_byte(int r, int c) { const int st = (r >> 4) * 2 + (c >> 5), rr = r & 15, cc = c & 31, ob = rr * 64 + cc * 2; return st * 1024 + (ob ^ (((ob >> 9) & 1) << 5)); }
__host__ __device__ __forceinline__ void stage_rc(int b, int& R, int& C) { const int st = b / 1024, sb = b % 1024, swz = sb ^ (((sb >> 9) & 1) << 5); R = (st >> 1) * 16 + swz / 64; C = (st & 1) * 32 + (swz % 64) / 2; }
__host__ __device__ __forceinline__ int perm32(int rho) { const int n = rho >> 4, i = rho & 15; return 8 * (i >> 2) + 4 * n + (i & 3); }

struct Unit { int arow0, brow0, orow0, ocol0, aux; };

struct DenseOrder {
    int nM, nN, nwg, G, c;
    __device__ void init(int M, int N, int G_, int c_) { nM = M / BM; nN = N / BM; nwg = nM * nN; G = G_; c = c_; }
    __device__ __forceinline__ bool next(int i, Unit& u) const {
        const long L = (long)i * G + c; if (L >= nwg) return false;
        int wgid = (int)L; { const int q = nwg / NXCD, r = nwg % NXCD, xcd = wgid % NXCD, off = wgid / NXCD; wgid = (xcd < r ? xcd * (q + 1) : r * (q + 1) + (xcd - r) * q) + off; }
        const int nig = WGM * nN, gid = wgid / nig, fm = gid * WGM, gsz = (nM - fm) < WGM ? (nM - fm) : WGM;
        const int pm = fm + ((wgid % nig) % gsz), pn = (wgid % nig) / gsz;
        u.arow0 = pm * BM; u.brow0 = pn * BM; u.orow0 = pm * BM; u.ocol0 = pn * BM; u.aux = 0; return true;
    }
};
struct GroupedOrder {
    const int* tile_exp; int ntiles, nN, G, c;
    __device__ __forceinline__ bool next(int i, Unit& u) const {
        const long L = (long)i * G + c; if (L >= (long)ntiles * nN) return false;
        const int t = (int)(L / nN), pn = (int)(L % nN);
        const int e = tile_exp[t];
        u.arow0 = t * BM; u.brow0 = (e * nN + pn) * BM; u.orow0 = t * BM; u.ocol0 = pn * BM; u.aux = e; return true;
    }
};

__device__ __forceinline__ unsigned cvt_pk_bf16(float lo, float hi) { return pk2(lo, hi); }

struct NoPre {};
struct EpiF32 {
    static constexpr bool PERM = false; typedef NoPre Pre;
    __device__ __forceinline__ Pre prefetch(const Unit&, LAS unsigned char*, int, int, int) const { return Pre{}; }
    float* C; int ldc;
    __device__ __forceinline__ void operator()(const f32x4 (&acc)[2][2][4][2], const Unit& u, int wr, int wc, int fr, int fq, const Pre&) const {
        const int row0 = u.orow0 + wr * 64 + fr, col0 = u.ocol0 + wc * 32 + 4 * fq;
#pragma unroll
        for (int ai = 0; ai < 2; ++ai)
#pragma unroll
            for (int m = 0; m < 4; ++m) { float* rowp = C + (size_t)(row0 + ai * HALF + m * 16) * ldc + col0;
#pragma unroll
                for (int bj = 0; bj < 2; ++bj)
#pragma unroll
                    for (int n = 0; n < 2; ++n) *(f32x4*)(rowp + bj * HALF + n * 16) = acc[ai][bj][m][n]; }
    }
};
struct EpiBf16 {
    static constexpr bool PERM = true; typedef NoPre Pre;
    __device__ __forceinline__ Pre prefetch(const Unit&, LAS unsigned char*, int, int, int) const { return Pre{}; }
    bf16_t* O; int ldc;
    __device__ __forceinline__ void operator()(const f32x4 (&acc)[2][2][4][2], const Unit& u, int wr, int wc, int fr, int fq, const Pre&) const {
        const int row0 = u.orow0 + wr * 64 + fr, col0 = u.ocol0 + wc * 32 + 8 * fq;
#pragma unroll
        for (int ai = 0; ai < 2; ++ai)
#pragma unroll
            for (int m = 0; m < 4; ++m) { bf16_t* rowp = O + (size_t)(row0 + ai * HALF + m * 16) * ldc + col0;
#pragma unroll
                for (int bj = 0; bj < 2; ++bj) { const f32x4 v0 = acc[ai][bj][m][0], v1 = acc[ai][bj][m][1];
                    u32x4 w; w.x = cvt_pk_bf16(v0[0], v0[1]); w.y = cvt_pk_bf16(v0[2], v0[3]); w.z = cvt_pk_bf16(v1[0], v1[1]); w.w = cvt_pk_bf16(v1[2], v1[3]);
                    *(u32x4*)(rowp + bj * HALF) = w; } }
    }
};
struct EpiSwiglu {
    static constexpr bool PERM = false; typedef NoPre Pre;
    __device__ __forceinline__ Pre prefetch(const Unit&, LAS unsigned char*, int, int, int) const { return Pre{}; }
    bf16_t* ACT;
    __device__ __forceinline__ void operator()(const f32x4 (&acc)[2][2][4][2], const Unit& u, int wr, int wc, int fr, int fq, const Pre&) const {
        const int row0 = u.orow0 + wr * 64 + fr, pn = u.ocol0 >> 8;
#pragma unroll
        for (int ai = 0; ai < 2; ++ai)
#pragma unroll
            for (int m = 0; m < 4; ++m) { bf16_t* rowp = ACT + (size_t)(row0 + ai * HALF + m * 16) * EH + wc * 16 + 4 * fq;
#pragma unroll
                for (int bj = 0; bj < 2; ++bj) { const f32x4 g = acc[ai][bj][m][0], up = acc[ai][bj][m][1]; float h[4];
#pragma unroll
                    for (int i = 0; i < 4; ++i) h[i] = g[i] / (1.0f + __expf(-g[i])) * up[i];
                    u32x2 w; w.x = cvt_pk_bf16(h[0], h[1]); w.y = cvt_pk_bf16(h[2], h[3]);
                    *(u32x2*)(rowp + (pn * 2 + bj) * 64) = w; } }
    }
};
constexpr float Y2_SCALE = 16.0f, Y2_INV = 1.0f / 16.0f;
struct EpiScatter {
    static constexpr bool PERM = true;
    struct Pre { const LAS int* tab; };
    unsigned char* Y2; const int* rowdst;
    __device__ __forceinline__ Pre prefetch(const Unit& u, LAS unsigned char* lds, int wid, int lane, int ui) const {
        LAS unsigned char* tab = lds + STAGE_BYTES + (ui & 1) * 1024;
        if (wid < 4) __builtin_amdgcn_global_load_lds((const unsigned*)(rowdst + u.orow0 + wid * 64 + lane), (LAS unsigned*)(tab + wid * 256), 4, 0, 0);
        Pre p; p.tab = (const LAS int*)tab; return p; }
    __device__ __forceinline__ void operator()(const f32x4 (&acc)[2][2][4][2], const Unit& u, int wr, int wc, int fr, int fq, const Pre& pre) const {
        const int col0 = u.ocol0 + wc * 32 + 8 * fq;
#pragma unroll
        for (int ai = 0; ai < 2; ++ai)
#pragma unroll
            for (int m = 0; m < 4; ++m) { const int dst = pre.tab[wr * 64 + fr + ai * HALF + m * 16];
                if (dst >= 0) { unsigned char* rowp = Y2 + (size_t)dst * DM + col0;
#pragma unroll
                    for (int bj = 0; bj < 2; ++bj) { const f32x4 v0 = acc[ai][bj][m][0] * Y2_SCALE, v1 = acc[ai][bj][m][1] * Y2_SCALE;
                        int w0 = 0, w1 = 0;
                        w0 = __builtin_amdgcn_cvt_pk_fp8_f32(v0[0], v0[1], w0, false); w0 = __builtin_amdgcn_cvt_pk_fp8_f32(v0[2], v0[3], w0, true);
                        w1 = __builtin_amdgcn_cvt_pk_fp8_f32(v1[0], v1[1], w1, false); w1 = __builtin_amdgcn_cvt_pk_fp8_f32(v1[2], v1[3], w1, true);
                        *(GAS u32x2*)(rowp + bj * HALF) = (u32x2){(unsigned)w0, (unsigned)w1}; } } }
    }
};

template <class Epi, class Sched, bool GATHER>
__device__ __forceinline__ void gemm_phase(const int tid_in, LAS unsigned char* lds, const bf16_t* Ag, const bf16_t* Bg, const int K, const int* rowidx, const Sched& S, const Epi& E) {
    int tid_ = tid_in; asm volatile("" : "+v"(tid_));
    const int tid = tid_, wid = __builtin_amdgcn_readfirstlane(tid >> 6), lane = tid & 63, wr = wid >> 2, wc = wid & 3, fr = lane & 15, fq = lane >> 4;
    const int nt = K / BK;
    int RA[2]; unsigned colA[2], voffB[2];
#pragma unroll
    for (int i = 0; i < 2; ++i) { int R, C; stage_rc(tid * 16 + i * 8192, R, C); const int Rb = Epi::PERM ? ((R & ~31) + perm32(R & 31)) : R;
        RA[i] = R; colA[i] = (unsigned)C * 2u; voffB[i] = (unsigned)(Rb * K + C) * 2u; }
    const size_t kstep = (size_t)(BK * 2);
    const size_t hstep = (size_t)HALF * K * 2;
    const unsigned ldsw = (unsigned)wid * 1024u;
    const int aoff = lds_byte(wr * 64 + fr, fq * 8), boff = lds_byte(wc * 32 + fr, fq * 8);
#define PG8_SA(b, h) (((b) * 2 + (h)) * HTB)
#define PG8_SB(b, h) ((4 + (b) * 2 + (h)) * HTB)
#define PG8_STAGE_B(bufoff, gbase) do { _Pragma("unroll") for (int _i = 0; _i < 2; ++_i) \
        __builtin_amdgcn_global_load_lds((const unsigned*)((const char*)(gbase) + voffB[_i]), (LAS unsigned*)(lds + (bufoff) + ldsw + _i * 8192), 16, 0, 0); } while (0)
#define PG8_STAGE_A(bufoff, gbase, o0, o1) do { \
        __builtin_amdgcn_global_load_lds((const unsigned*)((const char*)(gbase) + (o0)), (LAS unsigned*)(lds + (bufoff) + ldsw), 16, 0, 0); \
        __builtin_amdgcn_global_load_lds((const unsigned*)((const char*)(gbase) + (o1)), (LAS unsigned*)(lds + (bufoff) + ldsw + 8192), 16, 0, 0); } while (0)
#define PG8_LDA(dst, b, h) do { _Pragma("unroll") for (int m = 0; m < 4; ++m) _Pragma("unroll") for (int k = 0; k < 2; ++k) dst[m][k] = *(const LAS bf16x8*)(lds + PG8_SA(b, h) + aoff + m * 2048 + k * 1024); } while (0)
#define PG8_LDB(dst, b, h) do { _Pragma("unroll") for (int n = 0; n < 2; ++n) _Pragma("unroll") for (int k = 0; k < 2; ++k) dst[n][k] = *(const LAS bf16x8*)(lds + PG8_SB(b, h) + boff + n * 2048 + k * 1024); } while (0)
#define PG8_MMA(ai, bj, At, Bt) do { __builtin_amdgcn_s_setprio(1); _Pragma("unroll") for (int m = 0; m < 4; ++m) _Pragma("unroll") for (int n = 0; n < 2; ++n) _Pragma("unroll") for (int k = 0; k < 2; ++k) \
        acc[ai][bj][m][n] = __builtin_amdgcn_mfma_f32_16x16x32_bf16(Bt[n][k], At[m][k], acc[ai][bj][m][n], 0, 0, 0); __builtin_amdgcn_s_setprio(0); } while (0)
#define PG8_WAIT_V(n) asm volatile("s_waitcnt vmcnt(" #n ")" ::: "memory")
#define PG8_WAIT_L(n) asm volatile("s_waitcnt lgkmcnt(" #n ")" ::: "memory")
#define PG8_BAR __builtin_amdgcn_s_barrier()
#define PG8_SCHED __builtin_amdgcn_sched_barrier(0)
#define PG8_AOFF(dst, unit) do { if (GATHER) { _Pragma("unroll") for (int _h = 0; _h < 2; ++_h) _Pragma("unroll") for (int _i = 0; _i < 2; ++_i) \
            dst[_h][_i] = (unsigned)rowidx[(unit).arow0 + _h * HALF + RA[_i]] * (unsigned)(K * 2) + colA[_i]; } \
        else { _Pragma("unroll") for (int _h = 0; _h < 2; ++_h) _Pragma("unroll") for (int _i = 0; _i < 2; ++_i) dst[_h][_i] = (unsigned)((_h * HALF + RA[_i]) * K) * 2u + colA[_i]; } } while (0)
    Unit cur, nxt; int ui = 0;
    if (!S.next(0, cur)) return;
    f32x4 acc[2][2][4][2];
#pragma unroll
    for (int a = 0; a < 2; ++a)
#pragma unroll
        for (int b = 0; b < 2; ++b)
#pragma unroll
            for (int m = 0; m < 4; ++m)
#pragma unroll
                for (int n = 0; n < 2; ++n) acc[a][b][m][n] = (f32x4){0.f, 0.f, 0.f, 0.f};
    bf16x8 At[4][2], B0[2][2], B1[2][2];
    unsigned ac[2][2], an[2][2];
    PG8_AOFF(ac, cur);
    const char* cA = (const char*)Ag + (GATHER ? (size_t)0 : (size_t)cur.arow0 * K * 2); const char* cB = (const char*)Bg + (size_t)cur.brow0 * K * 2;
    PG8_STAGE_B(PG8_SB(0, 0), cB); PG8_STAGE_A(PG8_SA(0, 0), cA, ac[0][0], ac[0][1]); PG8_STAGE_B(PG8_SB(0, 1), cB + hstep); PG8_STAGE_A(PG8_SA(0, 1), cA, ac[1][0], ac[1][1]);
    if (wr == 1) PG8_BAR;
    PG8_WAIT_V(4); PG8_BAR;
    PG8_STAGE_B(PG8_SB(1, 0), cB + kstep); PG8_STAGE_A(PG8_SA(1, 0), cA + kstep, ac[0][0], ac[0][1]); PG8_STAGE_B(PG8_SB(1, 1), cB + hstep + kstep);
    PG8_WAIT_V(6); PG8_BAR;
    for (;;) {
        const typename Epi::Pre pre = E.prefetch(cur, lds, wid, lane, ui);
        const bool has_next = S.next(ui + 1, nxt);
        if (has_next) { PG8_AOFF(an, nxt); } else {
#pragma unroll
            for (int _h = 0; _h < 2; ++_h)
#pragma unroll
                for (int _i = 0; _i < 2; ++_i) an[_h][_i] = ac[_h][_i]; }
        const char* nA = has_next ? ((const char*)Ag + (GATHER ? (size_t)0 : (size_t)nxt.arow0 * K * 2)) : cA; const char* nB = has_next ? (const char*)Bg + (size_t)nxt.brow0 * K * 2 : cB;
_Pragma("nounroll")
        for (int t = 0; t < nt; t += 2) {
            const bool last = (t == nt - 2);
            const char* a1 = cA + (size_t)(t + 1) * kstep;
            const char* a2 = last ? nA : cA + (size_t)(t + 2) * kstep; const char* b2 = last ? nB : cB + (size_t)(t + 2) * kstep;
            const char* a3 = a2 + kstep; const char* b3 = b2 + kstep;
            const unsigned s00 = last ? an[0][0] : ac[0][0], s01 = last ? an[0][1] : ac[0][1], s10 = last ? an[1][0] : ac[1][0], s11 = last ? an[1][1] : ac[1][1];
            PG8_LDB(B0, 0, 0); PG8_SCHED; PG8_LDA(At, 0, 0); PG8_STAGE_A(PG8_SA(1, 1), a1, ac[1][0], ac[1][1]);
            PG8_WAIT_L(8); PG8_BAR; PG8_WAIT_L(0); PG8_MMA(0, 0, At, B0); PG8_BAR; PG8_SCHED;
            PG8_LDB(B1, 0, 1); PG8_STAGE_B(PG8_SB(0, 0), b2);
            PG8_BAR; PG8_WAIT_L(0); PG8_MMA(0, 1, At, B1); PG8_BAR;
            PG8_LDA(At, 0, 1); PG8_STAGE_A(PG8_SA(0, 0), a2, s00, s01);
            PG8_BAR; PG8_WAIT_L(0); PG8_MMA(1, 0, At, B0); PG8_BAR; PG8_SCHED;
            PG8_STAGE_B(PG8_SB(0, 1), b2 + hstep);
            PG8_WAIT_V(6); PG8_BAR; PG8_MMA(1, 1, At, B1); PG8_BAR;
            PG8_LDB(B0, 1, 0); PG8_SCHED; PG8_LDA(At, 1, 0); PG8_STAGE_A(PG8_SA(0, 1), a2, s10, s11);
            PG8_WAIT_L(8); PG8_BAR; PG8_WAIT_L(0); PG8_MMA(0, 0, At, B0); PG8_BAR; PG8_SCHED;
            PG8_LDB(B1, 1, 1); PG8_STAGE_B(PG8_SB(1, 0), b3);
            PG8_BAR; PG8_WAIT_L(0); PG8_MMA(0, 1, At, B1); PG8_BAR;
            PG8_LDA(At, 1, 1); PG8_STAGE_A(PG8_SA(1, 0), a3, s00, s01);
            PG8_BAR; PG8_WAIT_L(0); PG8_MMA(1, 0, At, B0); PG8_BAR; PG8_SCHED;
            PG8_STAGE_B(PG8_SB(1, 1), b3 + hstep);
            PG8_WAIT_V(6); PG8_BAR; PG8_MMA(1, 1, At, B1); PG8_BAR;
        }
        E(acc, cur, wr, wc, fr, fq, pre);
        if (!has_next) break;
#pragma unroll
        for (int a = 0; a < 2; ++a)
#pragma unroll
            for (int b = 0; b < 2; ++b)
#pragma unroll
                for (int m = 0; m < 4; ++m)
#pragma unroll
                    for (int n = 0; n < 2; ++n) acc[a][b][m][n] = (f32x4){0.f, 0.f, 0.f, 0.f};
        cur = nxt; cA = nA; cB = nB; ++ui;
#pragma unroll
        for (int _h = 0; _h < 2; ++_h)
#pragma unroll
            for (int _i = 0; _i < 2; ++_i) ac[_h][_i] = an[_h][_i];
    }
    PG8_WAIT_V(0);
    if (wr == 0) PG8_BAR;
    PG8_BAR;
#undef PG8_SA
#undef PG8_SB
#undef PG8_STAGE_A
#undef PG8_STAGE_B
#undef PG8_LDA
#undef PG8_LDB
#undef PG8_MMA
#undef PG8_WAIT_V
#undef PG8_WAIT_L
#undef PG8_BAR
#undef PG8_SCHED
#undef PG8_AOFF
}
}

constexpr int NWAVES = 8, NTHR = 512;
constexpr size_t MiB = 1u << 20;
constexpr size_t WS_CTL = 0, CTL_BYTES = 1 * MiB;
constexpr size_t WS_MOD = 1 * MiB;
constexpr size_t WS_WIN = 3 * MiB;
constexpr size_t WS_WOUT = 29 * MiB;
constexpr size_t WS_WR = 37 * MiB;
constexpr size_t WS_HYF = 39 * MiB;
constexpr size_t WS_HYFC = 71 * MiB;
constexpr size_t WS_XC = 73 * MiB;
constexpr size_t WS_EXP1 = 89 * MiB;
constexpr size_t WS_EXP2 = 218 * MiB;
constexpr size_t WS_XM = 283 * MiB;
constexpr size_t WS_EIDX = 419 * MiB;
constexpr size_t WS_WGT = 422 * MiB;
constexpr size_t WS_RNK = 425 * MiB;
constexpr size_t WS_ROWTOK = 428 * MiB;
constexpr size_t WS_ROWDST = 431 * MiB;
constexpr size_t WS_TILEEXP = 434 * MiB;
constexpr size_t WS_BIG = 435 * MiB;
constexpr size_t WS_U = WS_BIG;
constexpr size_t WS_MIX = 877 * MiB;
constexpr size_t WS_VT = 1013 * MiB;
constexpr size_t WS_HV = 1081 * MiB;
constexpr size_t WS_Z2 = 1183 * MiB;
constexpr size_t WS_GDS = 1217 * MiB;
constexpr size_t WS_GSIN = 1285 * MiB;
constexpr size_t WS_GD = 1319 * MiB;
constexpr size_t WS_Y = 1321 * MiB;
constexpr size_t WS_LOGIT = WS_BIG;
constexpr size_t WS_ACT = WS_BIG;
constexpr size_t WS_Y2 = 758 * MiB;
constexpr size_t WS_END = 1982 * MiB;
constexpr int CW_BAR = 4096;
constexpr int CW_CNT = 16384;
constexpr int CW_NTL = 20480;

constexpr int LDS_BYTES = 147456;
constexpr int MISC_OFF = 143360;

struct Frame {
    LAS unsigned char* lds;
    int tid, lane, wave, G, wg;
    const float* const* in;
    float* out; unsigned char* ws; unsigned* ctl;
};
enum { I_X = 0, I_C, I_CTX, I_CCTX, I_WMOD, I_BMOD, I_WIN, I_RPB, I_WA2, I_BA2, I_GNORM, I_HSW, I_HSB, I_HW1, I_HB1, I_HF1, I_HW2, I_HB2, I_HF2, I_HW3, I_HB3, I_HDEC, I_HSKIP,
       I_WOUT, I_LN1G, I_LN1B, I_RW, I_RB, I_WEG, I_WEU, I_WED, I_WSG, I_WSU, I_WSD, I_LN2G, I_LN2B };

__device__ __forceinline__ int row_b(int row) { return row < NLAT ? (row >> 12) : 16; }
__device__ __forceinline__ const float* mod_ptr(const Frame& F, int l, int row) { return (const float*)(F.ws + WS_MOD) + ((size_t)l * 17 + row_b(row)) * 6144; }

template <class RowFn>
__device__ __forceinline__ void tr_item(const float* W, int ldw, int k0, int n0, bf16_t* dst, int ldd, RowFn rf, LAS float* scr, int lane) {
    float tv[32];
    const GAS float* wp = (const GAS float*)(W + (size_t)(k0 + (lane >> 5)) * ldw + n0 + (lane & 31));
#pragma unroll
    for (int i = 0; i < 32; ++i) tv[i] = wp[(size_t)(2 * i) * ldw];
#pragma unroll
    for (int i = 0; i < 32; ++i) scr[(2 * i + (lane >> 5)) * 33 + (lane & 31)] = tv[i];
    LDS_WAIT(); asm volatile("" ::: "memory");
    const int c = lane & 7;
#pragma unroll
    for (int j = 0; j < 4; ++j) { const int n = (lane >> 3) + 8 * j; const LAS float* s = scr + (8 * c) * 33 + n;
        u32x4 o; o.x = pk2(s[0 * 33], s[1 * 33]); o.y = pk2(s[2 * 33], s[3 * 33]); o.z = pk2(s[4 * 33], s[5 * 33]); o.w = pk2(s[6 * 33], s[7 * 33]);
        *(GAS u32x4*)(dst + (size_t)rf(n0 + n) * ldd + k0 + 8 * c) = o; }
    LDS_WAIT(); asm volatile("" ::: "memory");
}
struct RowId { __device__ __forceinline__ int operator()(int n) const { return n; } };
struct RowWin { __device__ __forceinline__ int operator()(int n) const { return n >= 2336 ? n - 32 : n; } };
struct RowGU { int up; __device__ __forceinline__ int operator()(int j) const { return (j >> 6) * 128 + ((j & 63) >> 4) * 32 + up * 16 + (j & 15); } };

__device__ __forceinline__ void p0_static_weights(Frame& F) {
    LAS float* scr = (LAS float*)(F.lds + F.wave * 16384);
    const int gw = F.wg * NWAVES + F.wave, NGW = F.G * NWAVES;
    constexpr int I_IN = 16 * 97, I_OUT = 16 * 32, I_R = 16 * 4, PER_L = I_IN + I_OUT + I_R;
    for (int it = gw; it < DEPTH * PER_L; it += NGW) {
        const int l = it / PER_L; int r = it % PER_L;
        if (r < I_IN) { const int kb = r / 97, nb = r % 97; if (nb == 72) continue;
            tr_item(F.in[I_WIN] + (size_t)l * DM * DIN_REF, DIN_REF, kb * 64, nb * 32, (bf16_t*)(F.ws + WS_WIN) + (size_t)l * DIN * DM, DM, RowWin{}, scr, F.lane); continue; }
        r -= I_IN;
        if (r < I_OUT) { const int kb = r / 32, nb = r % 32;
            tr_item(F.in[I_WOUT] + (size_t)l * DM * DM, DM, kb * 64, nb * 32, (bf16_t*)(F.ws + WS_WOUT) + (size_t)l * DM * DM, DM, RowId{}, scr, F.lane); continue; }
        r -= I_OUT;
        { const int kb = r / 4, nb = r % 4;
            tr_item(F.in[I_RW] + (size_t)l * DM * NEXP, NEXP, kb * 64, nb * 32, (bf16_t*)(F.ws + WS_WR) + (size_t)l * 256 * DM, DM, RowId{}, scr, F.lane); }
    }
    const int gt = F.wg * NTHR + F.tid, NGT = F.G * NTHR;
    for (int i = gt; i < DEPTH * 128 * DM / 8; i += NGT) { const int l = i / (128 * DM / 8), r = i % (128 * DM / 8);
        *(u32x4*)((bf16_t*)(F.ws + WS_WR) + ((size_t)l * 256 + 128) * DM + (size_t)r * 8) = (u32x4){0u, 0u, 0u, 0u}; }
    for (int i = gt; i < DEPTH * 256 * DM; i += NGT) {
        const int k = i % DM, n = (i / DM) % 256, l = i / (DM * 256), dir = n >> 7, j = n & 127;
        const float* wi = F.in[I_WIN] + ((size_t)l * DM + k) * DIN_REF + 2304 + dir * 16;
        const float* wa = F.in[I_WA2] + ((size_t)(l * 2 + dir) * 16) * 128 + j;
        float s = 0.f;
#pragma unroll
        for (int r = 0; r < 16; ++r) s += wi[r] * wa[r * 128];
        ((bf16_t*)(F.ws + WS_WIN))[((size_t)l * DIN + 3072 + n) * DM + k] = (bf16_t)f2bf(s);
    }
}
__device__ __forceinline__ void p0_mod(Frame& F) {
    LAS float* sc = (LAS float*)F.lds;
    LAS float* red = (LAS float*)(F.lds + 17 * 1024 * 4);
    for (int i = F.tid; i < 17 * 1024; i += NTHR) { const int r = i >> 10, k = i & 1023; const float v = r < 16 ? F.in[I_C][r * 1024 + k] : F.in[I_CCTX][k]; sc[i] = silu_f(v); }
    __syncthreads();
    const int kq = F.tid >> 7, cl = F.tid & 127;
    for (int u = F.wg; u < DEPTH * 48; u += F.G) {
        const int l = u / 48, col = (u % 48) * 128 + cl;
        const float* w = F.in[I_WMOD] + (size_t)l * DM * 6144 + col;
        float a[17];
#pragma unroll
        for (int r = 0; r < 17; ++r) a[r] = 0.f;
#pragma unroll 4
        for (int k = kq * 256; k < kq * 256 + 256; ++k) { const float wv = w[(size_t)k * 6144];
#pragma unroll
            for (int r = 0; r < 17; ++r) a[r] += sc[r * 1024 + k] * wv; }
#pragma unroll
        for (int r = 0; r < 17; ++r) red[(kq * 17 + r) * 128 + cl] = a[r];
        __syncthreads();
        for (int i = F.tid; i < 17 * 128; i += NTHR) { const int r = i >> 7, c2 = i & 127, cc = (u % 48) * 128 + c2;
            const float s = red[(0 * 17 + r) * 128 + c2] + red[(1 * 17 + r) * 128 + c2] + red[(2 * 17 + r) * 128 + c2] + red[(3 * 17 + r) * 128 + c2] + F.in[I_BMOD][l * 6144 + cc];
            ((float*)(F.ws + WS_MOD))[((size_t)l * 17 + r) * 6144 + cc] = s; }
        __syncthreads();
    }
}
__device__ __forceinline__ void p0_hyena_filters(Frame& F) {
    LAS float* z = (LAS float*)F.lds;
    LAS float* h1 = z + 32 * 33;
    LAS float* h2 = h1 + 32 * 64;
    LAS float* tt = h2 + 32 * 64;
    constexpr int UL = 4096 / 32, UC = 256 / 32, UPL = UL + UC;
    for (int u = F.wg; u < DEPTH * UPL; u += F.G) {
        const int l = u / UPL, r = u % UPL; const bool lat = r < UL; const int L = lat ? 4096 : 256, n0 = (lat ? r : r - UL) * 32;
        __syncthreads();
        for (int i = F.tid; i < 32 * 33; i += NTHR) { const int p = i / 33, e = i % 33, n = n0 + p;
            const float t = (float)n / (float)(L - 1);
            float v;
            if (e == 0) v = t;
            else { const int kb = (e - 1) & 15; const float band = 1e-4f + (float)kb * ((15.0f - 1e-4f) / 15.0f);
                   const float w = 6.283185307179586f * (float)n / (float)L; const float ang = w * band;
                   v = e <= 16 ? __cosf(ang) : -__sinf(ang); }
            z[i] = v; if (e == 0) tt[p] = t; }
        __syncthreads();
        for (int i = F.tid; i < 32 * 64; i += NTHR) { const int p = i >> 6, j = i & 63; float s = F.in[I_HB1][l * 64 + j];
            for (int e = 0; e < 33; ++e) s += z[p * 33 + e] * F.in[I_HW1][((size_t)l * 33 + e) * 64 + j];
            h1[i] = __sinf(F.in[I_HF1][l * 64 + j] * s); }
        __syncthreads();
        for (int i = F.tid; i < 32 * 64; i += NTHR) { const int p = i >> 6, j = i & 63; float s = F.in[I_HB2][l * 64 + j];
            for (int e = 0; e < 64; ++e) s += h1[p * 64 + e] * F.in[I_HW2][((size_t)l * 64 + e) * 64 + j];
            h2[i] = __sinf(F.in[I_HF2][l * 64 + j] * s); }
        __syncthreads();
#pragma unroll 1
        for (int cc = 0; cc < 2; ++cc) {
            const int col = F.tid + cc * 512, o = col >> 9, dir = (col >> 8) & 1, ch = col & 255;
            float a[32];
#pragma unroll
            for (int p = 0; p < 32; ++p) a[p] = 0.f;
            const float* w3 = F.in[I_HW3] + (size_t)l * 64 * 1024 + col;
            for (int k = 0; k < 64; ++k) { const float wv = w3[(size_t)k * 1024];
#pragma unroll
                for (int p = 0; p < 32; ++p) a[p] += h2[p * 64 + k] * wv; }
            const float b3 = F.in[I_HB3][l * 1024 + col], dec = fabsf(F.in[I_HDEC][((size_t)(l * 2 + o) * 2 + dir) * 256 + ch]);
            const float skip = F.in[I_HSKIP][(l * 2 + o) * 256 + ch];
            bf16_t* R = lat ? (bf16_t*)(F.ws + WS_HYF) + ((size_t)(l * 2 + o) * 256 + ch) * 8192 : (bf16_t*)(F.ws + WS_HYFC) + ((size_t)(l * 2 + o) * 256 + ch) * 512;
#pragma unroll
            for (int p = 0; p < 32; ++p) { const int n = n0 + p; float v = (a[p] + b3) * __expf(-tt[p] * dec);
                if (dir == 0) { if (n == 0) v += skip; R[L - n] = (bf16_t)f2bf(v); }
                else { if (n == 0) R[0] = 0; else R[L + n] = (bf16_t)f2bf(v); } }
        }
    }
    __syncthreads();
}
__device__ __forceinline__ void p0_init_rows(Frame& F) {
    const int gw = F.wg * NWAVES + F.wave, NGW = F.G * NWAVES;
    for (int row = gw; row < NROW; row += NGW) {
        const float* src = row < NLAT ? F.in[I_X] + (size_t)row * DM : F.in[I_CTX] + (size_t)(row - NLAT) * DM;
        float* dst = row < NLAT ? F.out + (size_t)row * DM : (float*)(F.ws + WS_XC) + (size_t)(row - NLAT) * DM;
        const float* md = mod_ptr(F, 0, row);
        bf16_t* xm = (bf16_t*)(F.ws + WS_XM) + (size_t)row * DM;
#pragma unroll
        for (int j = 0; j < 4; ++j) { const int c = 4 * F.lane + 256 * j;
            const f32x4 v = *(const f32x4*)(src + c), sh = *(const f32x4*)(md + c), sc = *(const f32x4*)(md + 1024 + c);
            *(f32x4*)(dst + c) = v;
            u32x2 w; w.x = pk2(v[0] * (1.f + sc[0]) + sh[0], v[1] * (1.f + sc[1]) + sh[1]); w.y = pk2(v[2] * (1.f + sc[2]) + sh[2], v[3] * (1.f + sc[3]) + sh[3]);
            *(u32x2*)(xm + c) = w; }
    }
}
__device__ __forceinline__ void p_expert_weights(Frame& F, int l) {
    LAS float* scr = (LAS float*)(F.lds + F.wave * 16384);
    const int gw = F.wg * NWAVES + F.wave, NGW = F.G * NWAVES;
    constexpr int I1 = 16 * 8, I2 = 4 * 32, PER_E = 2 * I1 + I2;
    for (int it = gw; it < NE1 * PER_E; it += NGW) {
        const int e = it / PER_E; int r = it % PER_E;
        bf16_t* d1 = (bf16_t*)(F.ws + WS_EXP1) + (size_t)e * 512 * DM; bf16_t* d2 = (bf16_t*)(F.ws + WS_EXP2) + (size_t)e * DM * EH;
        if (r < 2 * I1) { const int up = r >= I1; if (up) r -= I1; const int kb = r / 8, nb = r % 8;
            const float* src = e < NEXP ? F.in[up ? I_WEU : I_WEG] + ((size_t)l * NEXP + e) * DM * EH : F.in[up ? I_WSU : I_WSG] + (size_t)l * DM * EH;
            tr_item(src, EH, kb * 64, nb * 32, d1, DM, RowGU{up}, scr, F.lane); }
        else { r -= 2 * I1; const int kb = r / 32, nb = r % 32;
            const float* src = e < NEXP ? F.in[I_WED] + ((size_t)l * NEXP + e) * EH * DM : F.in[I_WSD] + (size_t)l * EH * DM;
            tr_item(src, DM, kb * 64, nb * 32, d2, EH, RowId{}, scr, F.lane); }
    }
}

__device__ __forceinline__ f32x4 mfma16(bf16x8 a, bf16x8 b, f32x4 c) { return __builtin_amdgcn_mfma_f32_16x16x32_bf16(a, b, c, 0, 0, 0); }

__device__ __forceinline__ void ph_transposes(Frame& F, int l) {
    LAS bf16_t* tile = (LAS bf16_t*)(F.lds + F.wave * 16384);
    const bf16_t* U = (const bf16_t*)(F.ws + WS_U);
    const int gw = F.wg * NWAVES + F.wave, NGW = F.G * NWAVES;
    const int rsub = F.lane >> 3, cseg = F.lane & 7;
    for (int u = gw; u < 1088 * 20; u += NGW) {
        const int tt = u / 20, blk = u % 20;
        int b, s0, Ls, rowbase, posbase;
        if (tt < 1024) { b = tt >> 6; s0 = (tt & 63) * 64; Ls = SEQ; rowbase = b * SEQ; posbase = 0; }
        else { const int t2 = tt - 1024; b = t2 >> 2; s0 = (t2 & 3) * 64; Ls = CTXL; rowbase = NLAT + b * CTXL; posbase = SEQ; }
        if (blk < 12) {
            const int c0 = blk * 64 + cseg * 8;
            float w0[8], w1[8], w2[8], bb[8];
#pragma unroll
            for (int i = 0; i < 8; ++i) { w0[i] = F.in[I_HSW][(l * 3 + 0) * 768 + c0 + i]; w1[i] = F.in[I_HSW][(l * 3 + 1) * 768 + c0 + i]; w2[i] = F.in[I_HSW][(l * 3 + 2) * 768 + c0 + i]; bb[i] = F.in[I_HSB][l * 768 + c0 + i]; }
#pragma unroll 2
            for (int it = 0; it < 8; ++it) {
                const int sl = rsub + 8 * it, s = s0 + sl;
                const bf16_t* p = U + (size_t)(rowbase + s) * DIN + UHY + c0;
                const u32x4 zc = *(const u32x4*)p;
                u32x4 zm = (u32x4){0u, 0u, 0u, 0u}, zp = (u32x4){0u, 0u, 0u, 0u};
                if (s > 0) zm = *(const u32x4*)(p - DIN);
                if (s < Ls - 1) zp = *(const u32x4*)(p + DIN);
                const unsigned am[4] = {zm.x, zm.y, zm.z, zm.w}, ac[4] = {zc.x, zc.y, zc.z, zc.w}, ap[4] = {zp.x, zp.y, zp.z, zp.w};
#pragma unroll
                for (int i = 0; i < 4; ++i) {
                    const float v0 = bb[2 * i] + w0[2 * i] * bflo(am[i]) + w1[2 * i] * bflo(ac[i]) + w2[2 * i] * bflo(ap[i]);
                    const float v1 = bb[2 * i + 1] + w0[2 * i + 1] * bfhi(am[i]) + w1[2 * i + 1] * bfhi(ac[i]) + w2[2 * i + 1] * bfhi(ap[i]);
                    tile[(cseg * 8 + 2 * i) * 72 + sl] = (bf16_t)f2bf(v0); tile[(cseg * 8 + 2 * i + 1) * 72 + sl] = (bf16_t)f2bf(v1);
                }
            }
        } else {
            const int c0 = (blk - 12) * 64 + cseg * 8;
#pragma unroll 2
            for (int it = 0; it < 8; ++it) {
                const int sl = rsub + 8 * it, s = s0 + sl;
                const u32x4 zc = *(const u32x4*)(U + (size_t)(rowbase + s) * DIN + UV + c0);
                const unsigned ac[4] = {zc.x, zc.y, zc.z, zc.w};
#pragma unroll
                for (int i = 0; i < 4; ++i) { tile[(cseg * 8 + 2 * i) * 72 + sl] = (bf16_t)(ac[i] & 0xffffu); tile[(cseg * 8 + 2 * i + 1) * 72 + sl] = (bf16_t)(ac[i] >> 16); }
            }
        }
        LDS_WAIT(); asm volatile("" ::: "memory");
#pragma unroll 2
        for (int it = 0; it < 8; ++it) {
            const int ch = rsub + 8 * it;
            const u32x4 v = *(const LAS u32x4*)(tile + ch * 72 + cseg * 8);
            bf16_t* dst;
            if (blk < 12) dst = (bf16_t*)(F.ws + WS_HV) + ((size_t)(blk * 64 + ch) * NB + b) * SPB + posbase + s0 + cseg * 8;
            else dst = (bf16_t*)(F.ws + WS_VT) + ((size_t)b * 512 + (blk - 12) * 64 + ch) * SPB + posbase + s0 + cseg * 8;
            *(u32x4*)dst = v;
        }
        LDS_WAIT(); asm volatile("" ::: "memory");
    }
}

constexpr int NA_RPB = 0, NA_KC = 16384, NA_VC = NA_KC + 256 * 144, NA_END = NA_VC + 64 * 528;
__device__ __forceinline__ bf16x8 gld16(const bf16_t* p) { return *(const GAS bf16x8*)p; }
__device__ __forceinline__ u32x2 gld8(const bf16_t* p) { return *(const GAS u32x2*)p; }
__device__ __forceinline__ const char* uni_ptr(const char* p) { const unsigned long long v = (unsigned long long)p; const unsigned lo = __builtin_amdgcn_readfirstlane((unsigned)v), hi = __builtin_amdgcn_readfirstlane((unsigned)(v >> 32)); return (const char*)(((unsigned long long)hi << 32) | lo); }
__device__ __forceinline__ bf16x8 gld16o(const char* ub, unsigned lo) { return *(const GAS bf16x8*)(ub + (size_t)lo); }
__device__ __forceinline__ u32x2 gld8o(const char* ub, unsigned lo) { return *(const GAS u32x2*)(ub + (size_t)lo); }
template <bool WIN>
__device__ __forceinline__ void na_unit(Frame& F, int b, int h, int r, int strip) {
    const bf16_t* U = (const bf16_t*)(F.ws + WS_U);
    const bf16_t* VT = (const bf16_t*)(F.ws + WS_VT) + ((size_t)b * 512 + h * 64) * SPB;
    const LAS float* rpb = (const LAS float*)(F.lds + NA_RPB);
    const LAS bf16_t* KC = (const LAS bf16_t*)(F.lds + NA_KC); const LAS bf16_t* VC = (const LAS bf16_t*)(F.lds + NA_VC);
    int ln_ = F.lane; asm volatile("" : "+v"(ln_));
    const int i = ln_ & 15, g = ln_ >> 4;
    const int qrow0 = WIN ? (b * SEQ + r * 64 + strip * 16) : (NLAT + b * CTXL + strip * 16);
    const unsigned klo = (unsigned)((i * DIN + 8 * g) * 2), vlo = (unsigned)((i * SPB + 4 * g) * 2);
    const char* qb = uni_ptr((const char*)(U + (size_t)qrow0 * DIN + UQ + h * 64));
    const bf16x8 q0 = gld16o(qb, klo), q1 = gld16o(qb + 64, klo);
    constexpr int NT = WIN ? 32 : 16;
    constexpr int CO = WIN ? 16 : 0;
    f32x4 st[NT];
    int kr0 = 0, u0 = 0;
    if (WIN) { kr0 = r - 4; kr0 = kr0 < 0 ? 0 : (kr0 > 56 ? 56 : kr0); u0 = strip == 0 ? 0 : (strip == 1 ? 8 : (strip == 2 ? 24 : 32)); }
    const char* kbase = uni_ptr((const char*)(U + (size_t)(b * SEQ + kr0 * 64 + u0) * DIN + UK + h * 64));
    const char* vbase = uni_ptr((const char*)(VT + kr0 * 64 + u0));
#define NA_SB() __builtin_amdgcn_sched_barrier(0)
#define NA_KLOAD(buf, grp) do { _Pragma("unroll") for (int t = 0; t < 2; ++t) { const int kt = (grp) * 2 + t; const char* kp = kbase + (size_t)((kt >> 1) * 64 + (kt & 1) * 16) * DIN * 2; buf[t][0] = gld16o(kp, klo); buf[t][1] = gld16o(kp + 64, klo); } } while (0)
#define NA_KMMA(buf, grp) do { _Pragma("unroll") for (int t = 0; t < 2; ++t) { f32x4 a = (f32x4){0.f, 0.f, 0.f, 0.f}; a = mfma16(buf[t][0], q0, a); a = mfma16(buf[t][1], q1, a); st[(grp) * 2 + t] = a; } } while (0)
#define NA_VLOAD(buf, cp) do { _Pragma("unroll") for (int d = 0; d < 4; ++d) { const char* vp = vbase + ((size_t)(d * 16) * SPB + (cp) * 64) * 2; buf[d][0] = gld8o(vp, vlo); buf[d][1] = gld8o(vp + 32, vlo); } } while (0)
#define NA_VMMA(buf, cp) do { const int c = (cp); const f32x4 p0 = st[2 * c], p1 = st[2 * c + 1]; \
        u32x4 pw; pw.x = pk2(p0[0], p0[1]); pw.y = pk2(p0[2], p0[3]); pw.z = pk2(p1[0], p1[1]); pw.w = pk2(p1[2], p1[3]); const bf16x8 pf = __builtin_bit_cast(bf16x8, pw); \
        _Pragma("unroll") for (int d = 0; d < 4; ++d) { const bf16x8 vfr = __builtin_bit_cast(bf16x8, ((u32x4){buf[d][0].x, buf[d][0].y, buf[d][1].x, buf[d][1].y})); o[d] = mfma16(vfr, pf, o[d]); } } while (0)
    bf16x8 ka[2][2], kb[2][2];
    if (WIN) { NA_KLOAD(ka, 0); NA_KLOAD(kb, 1); NA_SB(); }
#pragma unroll
    for (int cg = 0; cg < 8; ++cg) {
        bf16x8 kc[2][2];
#pragma unroll
        for (int t = 0; t < 2; ++t) { const LAS bf16_t* kp = KC + ((cg * 2 + t) * 16 + i) * 72 + 8 * g; kc[t][0] = *(const LAS bf16x8*)kp; kc[t][1] = *(const LAS bf16x8*)(kp + 32); }
#pragma unroll
        for (int t = 0; t < 2; ++t) { f32x4 a = (f32x4){0.f, 0.f, 0.f, 0.f}; a = mfma16(kc[t][0], q0, a); a = mfma16(kc[t][1], q1, a); st[CO + cg * 2 + t] = a; }
        NA_SB();
    }
    u32x2 va[4][2], vb[4][2];
    if (WIN) {
        NA_KMMA(ka, 0); NA_SB(); NA_KLOAD(ka, 2); NA_SB();
        NA_KMMA(kb, 1); NA_SB(); NA_KLOAD(kb, 3); NA_SB();
        NA_KMMA(ka, 2); NA_SB(); NA_KLOAD(ka, 4); NA_SB();
        NA_KMMA(kb, 3); NA_SB(); NA_KLOAD(kb, 5); NA_SB();
        NA_KMMA(ka, 4); NA_SB(); NA_KLOAD(ka, 6); NA_SB();
        NA_KMMA(kb, 5); NA_SB(); NA_KLOAD(kb, 7); NA_SB();
        NA_KMMA(ka, 6); NA_SB(); NA_VLOAD(va, 0); NA_SB();
        NA_KMMA(kb, 7); NA_SB(); NA_VLOAD(vb, 1); NA_SB();
    }
    float mx = -3.0e38f;
    if (WIN) {
        const int c = strip * 16 + i; int kc0 = c - 8; kc0 = kc0 < 0 ? 0 : (kc0 > 48 ? 48 : kc0);
#pragma unroll
        for (int grp = 0; grp < 4; ++grp) {
            float bv[4][4];
#pragma unroll
            for (int t = 0; t < 4; ++t) { const int kt = grp * 4 + t, dr = kr0 + (kt >> 1) - r + 7;
#pragma unroll
                for (int e = 0; e < 4; ++e) { int dc = u0 + (kt & 1) * 16 + 4 * g + e - c + 15; dc = dc < 0 ? 0 : (dc > 30 ? 30 : dc); bv[t][e] = rpb[(h * 15 + dr) * 31 + dc]; } }
#pragma unroll
            for (int t = 0; t < 4; ++t) { const int kt = grp * 4 + t;
#pragma unroll
                for (int e = 0; e < 4; ++e) { const int kc = u0 + (kt & 1) * 16 + 4 * g + e; const bool ok = (kc >= kc0) && (kc < kc0 + 16);
                    const float s = ok ? (st[kt][e] * 0.125f + bv[t][e]) : -3.0e38f; st[kt][e] = s; mx = fmaxf(mx, s); } }
            NA_SB();
        }
    }
#pragma unroll
    for (int ct = 0; ct < 16; ++ct)
#pragma unroll
        for (int e = 0; e < 4; ++e) { const float s = st[CO + ct][e] * 0.125f; st[CO + ct][e] = s; mx = fmaxf(mx, s); }
    mx = fmaxf(mx, shx(mx, 16, ln_)); mx = fmaxf(mx, shx(mx, 32, ln_));
    float sum = 0.f;
#pragma unroll
    for (int t = 0; t < NT; ++t)
#pragma unroll
        for (int e = 0; e < 4; ++e) { const float p = __expf(st[t][e] - mx); st[t][e] = p; sum += p; }
    sum += shx(sum, 16, ln_); sum += shx(sum, 32, ln_);
    const float inv = 1.0f / sum;
    f32x4 o[4];
#pragma unroll
    for (int d = 0; d < 4; ++d) o[d] = (f32x4){0.f, 0.f, 0.f, 0.f};
    NA_SB();
    if (WIN) {
        NA_VMMA(va, 0); NA_SB(); NA_VLOAD(va, 2); NA_SB();
        NA_VMMA(vb, 1); NA_SB(); NA_VLOAD(vb, 3); NA_SB();
        NA_VMMA(va, 2); NA_SB(); NA_VLOAD(va, 4); NA_SB();
        NA_VMMA(vb, 3); NA_SB(); NA_VLOAD(vb, 5); NA_SB();
        NA_VMMA(va, 4); NA_SB(); NA_VLOAD(va, 6); NA_SB();
        NA_VMMA(vb, 5); NA_SB(); NA_VLOAD(vb, 7); NA_SB();
    }
#pragma unroll
    for (int cb = 0; cb < 8; ++cb) {
        u32x2 vc[1][4][2];
#pragma unroll
        for (int cc = 0; cc < 1; ++cc)
#pragma unroll
            for (int d = 0; d < 4; ++d) { const LAS bf16_t* vp = VC + (d * 16 + i) * 264 + (cb + cc) * 32 + 4 * g; vc[cc][d][0] = *(const LAS u32x2*)vp; vc[cc][d][1] = *(const LAS u32x2*)(vp + 16); }
#pragma unroll
        for (int cc = 0; cc < 1; ++cc) { const int c = (WIN ? 8 : 0) + cb + cc; const f32x4 p0 = st[2 * c], p1 = st[2 * c + 1];
            u32x4 pw; pw.x = pk2(p0[0], p0[1]); pw.y = pk2(p0[2], p0[3]); pw.z = pk2(p1[0], p1[1]); pw.w = pk2(p1[2], p1[3]); const bf16x8 pf = __builtin_bit_cast(bf16x8, pw);
#pragma unroll
            for (int d = 0; d < 4; ++d) { const bf16x8 vfr = __builtin_bit_cast(bf16x8, ((u32x4){vc[cc][d][0].x, vc[cc][d][0].y, vc[cc][d][1].x, vc[cc][d][1].y})); o[d] = mfma16(vfr, pf, o[d]); } }
        NA_SB();
    }
    if (WIN) { NA_VMMA(va, 6); NA_SB(); NA_VMMA(vb, 7); NA_SB(); }
    char* op = (char*)uni_ptr((const char*)((bf16_t*)(F.ws + WS_MIX) + (size_t)qrow0 * DM + h * 64)); const unsigned olo = (unsigned)((i * DM + 4 * g) * 2);
#pragma unroll
    for (int d = 0; d < 4; ++d) { u32x2 w; w.x = pk2(o[d][0] * inv, o[d][1] * inv); w.y = pk2(o[d][2] * inv, o[d][3] * inv); *(GAS u32x2*)(op + d * 32 + (size_t)olo) = w; }
#undef NA_SB
#undef NA_KLOAD
#undef NA_KMMA
#undef NA_VLOAD
#undef NA_VMMA
}
__device__ __forceinline__ void ph_na(Frame& F, int l, bool last) {
    LAS float* rpb = (LAS float*)(F.lds + NA_RPB);
    __syncthreads();
    for (int i = F.tid; i < 8 * 15 * 31; i += NTHR) rpb[i] = F.in[I_RPB][(size_t)l * 8 * 15 * 31 + i];
    const bf16_t* U = (const bf16_t*)(F.ws + WS_U);
    for (int job = F.wg; job < NB * 8 * 2; job += F.G) {
        const int half = job & 1, h = (job >> 1) & 7, b = job >> 4;
        __syncthreads();
        { int tz_ = F.tid; asm volatile("" : "+v"(tz_)); const int key = tz_ >> 1, hf = tz_ & 1; const bf16_t* src = U + (size_t)(NLAT + b * CTXL + key) * DIN + UK + h * 64 + hf * 32; LAS bf16_t* dst = (LAS bf16_t*)(F.lds + NA_KC) + key * 72 + hf * 32;
#pragma unroll
          for (int j = 0; j < 4; ++j) *(LAS bf16x8*)(dst + j * 8) = gld16(src + j * 8);
          const int dv = tz_ >> 3, seg = tz_ & 7; const bf16_t* vs = (const bf16_t*)(F.ws + WS_VT) + ((size_t)b * 512 + h * 64 + dv) * SPB + SEQ + seg * 32; LAS bf16_t* vd = (LAS bf16_t*)(F.lds + NA_VC) + dv * 264 + seg * 32;
#pragma unroll
          for (int j = 0; j < 4; ++j) *(LAS bf16x8*)(vd + j * 8) = gld16(vs + j * 8); }
        __syncthreads();
        for (int uu = F.wave; uu < 128; uu += NWAVES) na_unit<true>(F, b, h, half * 32 + (uu >> 2), uu & 3);
        if (!last) na_unit<false>(F, b, h, 0, half * 8 + F.wave);
    }
}

constexpr int GL_LAF = 0, GL_LAB = 8448, GL_Q = 16896, GL_K = 25344;
constexpr int GL_QTF = 33792, GL_KTF = 38912, GL_QTB = 44032, GL_KTB = 49152;
constexpr int GL_KDF = 54272, GL_KDB = 58880;
constexpr int GL_VT = 63488, GL_ATT = 72704;
constexpr int GL_SF = 81920, GL_SB = 87040;
constexpr int GL_O = 92160;
constexpr int GL_SEG = 108800;
__device__ __forceinline__ float log_sigmoid_f(float x) { return fminf(x, 0.f) - log1pf(__expf(-fabsf(x))); }
__device__ __forceinline__ f32x4 mma_lds(const LAS bf16_t* A, int lda, const LAS bf16_t* B, int ldb, int ksteps, f32x4 acc, int lane) {
    const int r = lane & 15, g = lane >> 4;
    for (int ks = 0; ks < ksteps; ++ks) { const bf16x8 a = *(const LAS bf16x8*)(A + r * lda + ks * 32 + 8 * g), b = *(const LAS bf16x8*)(B + r * ldb + ks * 32 + 8 * g); acc = mfma16(a, b, acc); }
    return acc;
}
template <bool FULL>
__device__ __forceinline__ void gla_prep(Frame& F, int l, int b, int cn, int h) {
    const bf16_t* U = (const bf16_t*)(F.ws + WS_U);
    LAS float* LAF = (LAS float*)(F.lds + GL_LAF); LAS float* LAB = (LAS float*)(F.lds + GL_LAB); LAS float* Q = (LAS float*)(F.lds + GL_Q); LAS float* Kk = (LAS float*)(F.lds + GL_K);
    LAS bf16_t* VT = (LAS bf16_t*)(F.lds + GL_VT); LAS float* SEG = (LAS float*)(F.lds + GL_SEG);
    const bool lat = cn >= 4; const int row0 = lat ? b * SEQ + (cn - 4) * 64 : NLAT + b * CTXL + cn * 64;
    const int t = F.tid;
    { const int i = t >> 3, d4 = (t & 7) * 4; const bf16_t* p = U + (size_t)(row0 + i) * DIN;
      const u32x2 wq = *(const u32x2*)(p + UGQ + h * 32 + d4), wk = *(const u32x2*)(p + UGK + h * 32 + d4), wf = *(const u32x2*)(p + ULAF + h * 32 + d4), wb = *(const u32x2*)(p + ULAB + h * 32 + d4);
      const float* ba = F.in[I_BA2] + (size_t)l * 256 + h * 32 + d4;
      const float qs = 0.17677669529663687f;
      Q[i * 33 + d4 + 0] = bflo(wq.x) * qs; Q[i * 33 + d4 + 1] = bfhi(wq.x) * qs; Q[i * 33 + d4 + 2] = bflo(wq.y) * qs; Q[i * 33 + d4 + 3] = bfhi(wq.y) * qs;
      Kk[i * 33 + d4 + 0] = bflo(wk.x); Kk[i * 33 + d4 + 1] = bfhi(wk.x); Kk[i * 33 + d4 + 2] = bflo(wk.y); Kk[i * 33 + d4 + 3] = bfhi(wk.y);
      LAF[i * 33 + d4 + 0] = log_sigmoid_f(bflo(wf.x) + ba[0]) * 0.0625f; LAF[i * 33 + d4 + 1] = log_sigmoid_f(bfhi(wf.x) + ba[1]) * 0.0625f;
      LAF[i * 33 + d4 + 2] = log_sigmoid_f(bflo(wf.y) + ba[2]) * 0.0625f; LAF[i * 33 + d4 + 3] = log_sigmoid_f(bfhi(wf.y) + ba[3]) * 0.0625f;
      LAB[i * 33 + d4 + 0] = log_sigmoid_f(bflo(wb.x) + ba[128]) * 0.0625f; LAB[i * 33 + d4 + 1] = log_sigmoid_f(bfhi(wb.x) + ba[129]) * 0.0625f;
      LAB[i * 33 + d4 + 2] = log_sigmoid_f(bflo(wb.y) + ba[130]) * 0.0625f; LAB[i * 33 + d4 + 3] = log_sigmoid_f(bfhi(wb.y) + ba[131]) * 0.0625f;
      const int dv8 = (t & 7) * 8; const u32x4 wv = *(const u32x4*)(p + UGV + h * 64 + dv8); const unsigned av[4] = {wv.x, wv.y, wv.z, wv.w};
#pragma unroll
      for (int e = 0; e < 4; ++e) { VT[(dv8 + 2 * e) * 72 + i] = (bf16_t)(av[e] & 0xffffu); VT[(dv8 + 2 * e + 1) * 72 + i] = (bf16_t)(av[e] >> 16); }
    }
    __syncthreads();
    if (lat) {
        for (int e = t; e < 64 * 16 * 2; e += NTHR) {
            const int which = e >> 10, i = (e >> 4) & 63, p = e & 15, half = p >> 3, idx = p & 7;
            const float pos = half ? (float)i : (float)(cn - 4);
            const float inv = __expf(-(float)idx * (9.210340371976184f / 8.0f));
            const float sn = __sinf(pos * inv), cs = __cosf(pos * inv);
            LAS float* A = which ? Kk : Q; const int d1 = half * 16 + idx;
            const float x1 = A[i * 33 + d1], x2 = A[i * 33 + d1 + 8];
            A[i * 33 + d1] = x1 * cs - x2 * sn; A[i * 33 + d1 + 8] = x1 * sn + x2 * cs;
        }
    }
    { const int x = t & 63, d = x & 31, dir = x >> 5, seg = t >> 6; LAS float* LA = dir ? LAB : LAF; float run = 0.f;
#pragma unroll
      for (int k = 0; k < 8; ++k) { const int p = seg * 8 + k, i = dir ? 63 - p : p; run += LA[i * 33 + d]; LA[i * 33 + d] = run; }
      SEG[x * 9 + seg] = run;
    }
    __syncthreads();
    { const int x = t & 63, d = x & 31, dir = x >> 5, seg = t >> 6; LAS float* LA = dir ? LAB : LAF; float pre = 0.f;
      for (int s2 = 0; s2 < seg; ++s2) pre += SEG[x * 9 + s2];
#pragma unroll
      for (int k = 0; k < 8; ++k) { const int p = seg * 8 + k, i = dir ? 63 - p : p; LA[i * 33 + d] += pre; }
    }
    __syncthreads();
    LAS bf16_t* QTF = (LAS bf16_t*)(F.lds + GL_QTF); LAS bf16_t* KTF = (LAS bf16_t*)(F.lds + GL_KTF); LAS bf16_t* QTB = (LAS bf16_t*)(F.lds + GL_QTB); LAS bf16_t* KTB = (LAS bf16_t*)(F.lds + GL_KTB);
    LAS bf16_t* KDF = (LAS bf16_t*)(F.lds + GL_KDF); LAS bf16_t* KDB = (LAS bf16_t*)(F.lds + GL_KDB);
    for (int e = t; e < 64 * 32; e += NTHR) {
        const int i = e >> 5, d = e & 31;
        const float bf = LAF[i * 33 + d], bb = LAB[i * 33 + d], bfl = LAF[63 * 33 + d], bbl = LAB[0 * 33 + d], kv = Kk[i * 33 + d];
        KDF[d * 72 + i] = (bf16_t)f2bf(kv * __expf(bfl - bf)); KDB[d * 72 + i] = (bf16_t)f2bf(kv * __expf(bbl - bb));
        if (FULL) { const float qv = Q[i * 33 + d];
            QTF[i * 40 + d] = (bf16_t)f2bf(qv * __expf(bf)); KTF[i * 40 + d] = (bf16_t)f2bf(kv * __expf(-bf));
            QTB[i * 40 + d] = (bf16_t)f2bf(qv * __expf(bb)); KTB[i * 40 + d] = (bf16_t)f2bf(kv * __expf(-bb)); }
    }
    __syncthreads();
}
__device__ __forceinline__ void ph_gla_local(Frame& F, int l) {
    LAS float* LAF = (LAS float*)(F.lds + GL_LAF); LAS float* LAB = (LAS float*)(F.lds + GL_LAB);
    for (int u = F.wg; u < NB * 68 * 4; u += F.G) {
        const int h = u & 3, cn = (u >> 2) % 68, b = (u >> 2) / 68;
        __syncthreads();
        gla_prep<false>(F, l, b, cn, h);
        const int mt = F.wave >> 1, nt = F.wave & 1, g = F.lane >> 4, c = F.lane & 15;
        float* DS = (float*)(F.ws + WS_GDS) + (size_t)u * 2 * 2048;
#pragma unroll
        for (int dir = 0; dir < 2; ++dir) {
            const LAS bf16_t* KD = (const LAS bf16_t*)(F.lds + (dir ? GL_KDB : GL_KDF));
            f32x4 a = (f32x4){0.f, 0.f, 0.f, 0.f};
            a = mma_lds((const LAS bf16_t*)(F.lds + GL_VT) + mt * 16 * 72, 72, KD + nt * 16 * 72, 72, 2, a, F.lane);
#pragma unroll
            for (int e = 0; e < 4; ++e) DS[dir * 2048 + (mt * 16 + 4 * g + e) * 32 + nt * 16 + c] = a[e];
        }
        if (F.tid < 64) { const int d = F.tid & 31, dir = F.tid >> 5; ((float*)(F.ws + WS_GD))[(size_t)u * 64 + F.tid] = __expf(dir ? LAB[0 * 33 + d] : LAF[63 * 33 + d]); }
    }
}
__device__ __forceinline__ void ph_gla_scan(Frame& F) {
    const int gt = F.wg * NTHR + F.tid, NGT = F.G * NTHR;
    const float* DS = (const float*)(F.ws + WS_GDS); const float* GD = (const float*)(F.ws + WS_GD); bf16_t* SIN = (bf16_t*)(F.ws + WS_GSIN);
    for (int w = gt; w < 128 * 1024; w += NGT) {
        const int chain = w >> 10, el = (w & 1023) * 2, dir = chain & 1, h = (chain >> 1) & 3, b = chain >> 3, d = el & 31;
        float s0 = 0.f, s1 = 0.f;
        for (int step = 0; step < 68; ++step) {
            const int cn = dir ? (step < 4 ? 3 - step : 71 - step) : step;
            const size_t u = (size_t)(b * 68 + cn) * 4 + h;
            *(unsigned*)(SIN + (u * 2 + dir) * 2048 + el) = pk2(s0, s1);
            const f32x2 ds = *(const f32x2*)(DS + (u * 2 + dir) * 2048 + el); const f32x2 dd = *(const f32x2*)(GD + u * 64 + dir * 32 + d);
            s0 = dd.x * s0 + ds.x; s1 = dd.y * s1 + ds.y;
        }
    }
}
__device__ __forceinline__ void ph_gla_out(Frame& F, int l, bool last) {
    const bf16_t* U = (const bf16_t*)(F.ws + WS_U);
    for (int u = F.wg; u < NB * 68 * 4; u += F.G) {
        const int h = u & 3, cn = (u >> 2) % 68, b = (u >> 2) / 68;
        if (last && cn < 4) continue;
        __syncthreads();
        gla_prep<true>(F, l, b, cn, h);
        const int t = F.tid;
        { const bf16_t* SIN = (const bf16_t*)(F.ws + WS_GSIN) + (size_t)u * 2 * 2048;
          for (int e = t; e < 2 * 64 * 4; e += NTHR) { const int dir = e >> 8, dv = (e >> 2) & 63, d8 = (e & 3) * 8;
              const u32x4 v = *(const u32x4*)(SIN + dir * 2048 + dv * 32 + d8); *(LAS u32x4*)((LAS bf16_t*)(F.lds + (dir ? GL_SB : GL_SF)) + dv * 40 + d8) = v; } }
        const int g = F.lane >> 4, c = F.lane & 15;
        LAS bf16_t* ATT = (LAS bf16_t*)(F.lds + GL_ATT);
#pragma unroll
        for (int k = 0; k < 2; ++k) { const int tile = F.wave + 8 * k, mt = tile >> 2, nt = tile & 3;
            f32x4 af = (f32x4){0.f, 0.f, 0.f, 0.f}, ab = af;
            af = mma_lds((const LAS bf16_t*)(F.lds + GL_QTF) + mt * 16 * 40, 40, (const LAS bf16_t*)(F.lds + GL_KTF) + nt * 16 * 40, 40, 1, af, F.lane);
            ab = mma_lds((const LAS bf16_t*)(F.lds + GL_QTB) + mt * 16 * 40, 40, (const LAS bf16_t*)(F.lds + GL_KTB) + nt * 16 * 40, 40, 1, ab, F.lane);
#pragma unroll
            for (int e = 0; e < 4; ++e) { const int i = mt * 16 + 4 * g + e, j = nt * 16 + c; const float v = (j <= i ? af[e] : 0.f) + (j >= i ? ab[e] : 0.f); ATT[i * 72 + j] = (bf16_t)f2bf(v); } }
        __syncthreads();
        LAS float* O = (LAS float*)(F.lds + GL_O);
#pragma unroll
        for (int k = 0; k < 2; ++k) { const int tile = F.wave + 8 * k, mt = tile >> 2, nt = tile & 3;
            f32x4 a = (f32x4){0.f, 0.f, 0.f, 0.f};
            a = mma_lds(ATT + mt * 16 * 72, 72, (const LAS bf16_t*)(F.lds + GL_VT) + nt * 16 * 72, 72, 2, a, F.lane);
            a = mma_lds((const LAS bf16_t*)(F.lds + GL_QTF) + mt * 16 * 40, 40, (const LAS bf16_t*)(F.lds + GL_SF) + nt * 16 * 40, 40, 1, a, F.lane);
            a = mma_lds((const LAS bf16_t*)(F.lds + GL_QTB) + mt * 16 * 40, 40, (const LAS bf16_t*)(F.lds + GL_SB) + nt * 16 * 40, 40, 1, a, F.lane);
#pragma unroll
            for (int e = 0; e < 4; ++e) O[(mt * 16 + 4 * g + e) * 65 + nt * 16 + c] = a[e]; }
        __syncthreads();
        { const int i = t >> 3, dv8 = (t & 7) * 8; const bool lat = cn >= 4; const int row = (lat ? b * SEQ + (cn - 4) * 64 : NLAT + b * CTXL + cn * 64) + i;
          float v[8]; float ss = 0.f;
#pragma unroll
          for (int e = 0; e < 8; ++e) { v[e] = O[i * 65 + dv8 + e]; ss += v[e] * v[e]; }
          ss += shx(ss, 1, F.lane); ss += shx(ss, 2, F.lane); ss += shx(ss, 4, F.lane);
          const float rs = 1.0f / sqrtf(ss * (1.0f / 64.0f) + LN_EPS);
          const u32x4 gw = *(const u32x4*)(U + (size_t)row * DIN + UGR + h * 64 + dv8); const unsigned ga[4] = {gw.x, gw.y, gw.z, gw.w};
          const float* gn = F.in[I_GNORM] + l * 64 + dv8;
          float o[8];
#pragma unroll
          for (int e = 0; e < 4; ++e) { o[2 * e] = v[2 * e] * rs * gn[2 * e] * silu_f(bflo(ga[e])); o[2 * e + 1] = v[2 * e + 1] * rs * gn[2 * e + 1] * silu_f(bfhi(ga[e])); }
          u32x4 w; w.x = pk2(o[0], o[1]); w.y = pk2(o[2], o[3]); w.z = pk2(o[4], o[5]); w.w = pk2(o[6], o[7]);
          *(u32x4*)((bf16_t*)(F.ws + WS_MIX) + (size_t)row * DM + 512 + h * 64 + dv8) = w; }
    }
}

template <int L>
__device__ __forceinline__ void hyena_conv(Frame& F, const bf16_t* Rg, const bf16_t* Uin, const bf16_t* Xmul, int pos0, bool final_out, int ch, bf16_t* Zout) {
    constexpr int CS = 2 * L + 16;
    constexpr int NTL = L / 16, J = (NTL >= 64) ? 16 : 2, NGRP = NTL / J, HJ = J / 2, NSTEP = L / 32;
    LAS bf16_t* Rl = (LAS bf16_t*)F.lds;
    __syncthreads();
    for (int c = F.tid; c < 2 * L / 8; c += NTHR) { const u32x4 v = *(const GAS u32x4*)(Rg + 8 * c); const unsigned a[4] = {v.x, v.y, v.z, v.w};
#pragma unroll
        for (int rho = 0; rho < 8; ++rho) { LAS bf16_t* d = Rl + rho * CS + 8 * c + rho;
#pragma unroll
            for (int k = 0; k < 4; ++k) { d[2 * k] = (bf16_t)(a[k] & 0xffffu); d[2 * k + 1] = (bf16_t)(a[k] >> 16); } } }
    __syncthreads();
    int ln_ = F.lane; asm volatile("" : "+v"(ln_));
    const int i = ln_ & 15, g = ln_ >> 4, rho = i & 7;
    const LAS bf16_t* Rc = Rl + rho * CS + rho;
    for (int grp = F.wave; grp < NGRP; grp += NWAVES) {
        f32x4 acc[J]; bf16x8 fr[J];
        const int tb = grp * J * 16;
        const LAS bf16_t* Rb = Rc + (L - tb - i + 8 * g);
#pragma unroll
        for (int j = 0; j < J; ++j) { acc[j] = (f32x4){0.f, 0.f, 0.f, 0.f}; fr[j] = *(const LAS bf16x8*)(Rb - 16 * j); }
        const char* ub = (const char*)(Uin + pos0); const unsigned ulo = (unsigned)((i * SPB + 8 * g) * 2);
        bf16x8 bcur = *(const GAS bf16x8*)(ub + (size_t)ulo);
#pragma unroll 1
        for (int q = 0; q < NSTEP / HJ; ++q) {
#pragma unroll
            for (int m = 0; m < HJ; ++m) {
                const int n = q * HJ + m;
                const int nn = (n + 1 < NSTEP) ? n + 1 : 0;
                const bf16x8 bnext = *(const GAS bf16x8*)(ub + (size_t)(ulo + (unsigned)nn * 64u));
                if (n > 0) { fr[(J - 2 * m) % J] = *(const LAS bf16x8*)(Rb + 32 * n); fr[(J + 1 - 2 * m) % J] = *(const LAS bf16x8*)(Rb + 32 * n - 16); }
#pragma unroll
                for (int j = 0; j < J; ++j) acc[j] = mfma16(fr[(j + J - 2 * m) % J], bcur, acc[j]);
                bcur = bnext;
            }
        }
#pragma unroll
        for (int j = 0; j < J; ++j) { const int t0 = tb + j * 16 + 4 * g;
            const u32x2 xw = *(const GAS u32x2*)(Xmul + (size_t)i * SPB + pos0 + t0);
            const float y0 = acc[j][0] * bflo(xw.x), y1 = acc[j][1] * bfhi(xw.x), y2 = acc[j][2] * bflo(xw.y), y3 = acc[j][3] * bfhi(xw.y);
            if (!final_out) { u32x2 w; w.x = pk2(y0, y1); w.y = pk2(y2, y3); *(GAS u32x2*)(Zout + (size_t)i * SPB + pos0 + t0) = w; }
            else { const int row = (pos0 ? NLAT + i * CTXL : i * SEQ) + t0; GAS bf16_t* mp = (GAS bf16_t*)((bf16_t*)(F.ws + WS_MIX) + (size_t)row * DM + 768 + ch);
                mp[0] = (bf16_t)f2bf(y0); mp[DM] = (bf16_t)f2bf(y1); mp[2 * DM] = (bf16_t)f2bf(y2); mp[3 * DM] = (bf16_t)f2bf(y3); } }
    }
}
__device__ __forceinline__ void ph_hyena(Frame& F, int l, bool last) {
    const bf16_t* HV = (const bf16_t*)(F.ws + WS_HV); bf16_t* Z2 = (bf16_t*)(F.ws + WS_Z2);
    for (int ch = F.wg; ch < 256; ch += F.G) {
        const bf16_t* v = HV + (size_t)(0 * 256 + ch) * NB * SPB; const bf16_t* x1 = HV + (size_t)(256 + ch) * NB * SPB; const bf16_t* x2 = HV + (size_t)(512 + ch) * NB * SPB;
        bf16_t* z = Z2 + (size_t)ch * NB * SPB;
        const bf16_t* R0 = (const bf16_t*)(F.ws + WS_HYF) + ((size_t)(l * 2 + 0) * 256 + ch) * 8192; const bf16_t* R1 = (const bf16_t*)(F.ws + WS_HYF) + ((size_t)(l * 2 + 1) * 256 + ch) * 8192;
        hyena_conv<4096>(F, R0, v, x1, 0, false, ch, z);
        VM_WAIT(); __syncthreads(); __builtin_amdgcn_fence(__ATOMIC_ACQUIRE, "agent"); VM_WAIT();
        hyena_conv<4096>(F, R1, z, x2, 0, true, ch, z);
        if (!last) {
            const bf16_t* C0 = (const bf16_t*)(F.ws + WS_HYFC) + ((size_t)(l * 2 + 0) * 256 + ch) * 512; const bf16_t* C1 = (const bf16_t*)(F.ws + WS_HYFC) + ((size_t)(l * 2 + 1) * 256 + ch) * 512;
            hyena_conv<256>(F, C0, v, x1, SEQ, false, ch, z);
            VM_WAIT(); __syncthreads(); __builtin_amdgcn_fence(__ATOMIC_ACQUIRE, "agent"); VM_WAIT();
            hyena_conv<256>(F, C1, z, x2, SEQ, true, ch, z);
        }
    }
}

__device__ __forceinline__ void ph_ln1(Frame& F, int l, int ntok) {
    const int gw = F.wg * NWAVES + F.wave, NGW = F.G * NWAVES;
    const float* lg = F.in[I_LN1G] + l * DM; const float* lb = F.in[I_LN1B] + l * DM;
    for (int row = gw; row < ntok; row += NGW) {
        float* xr = row < NLAT ? F.out + (size_t)row * DM : (float*)(F.ws + WS_XC) + (size_t)(row - NLAT) * DM;
        const float* yr = (const float*)(F.ws + WS_Y) + (size_t)row * DM;
        const float* md = mod_ptr(F, l, row);
        bf16_t* xm = (bf16_t*)(F.ws + WS_XM) + (size_t)row * DM;
        f32x4 v[4]; float s = 0.f;
#pragma unroll
        for (int j = 0; j < 4; ++j) { const int c = 4 * F.lane + 256 * j; const f32x4 x = *(const f32x4*)(xr + c), y = *(const f32x4*)(yr + c), g1 = *(const f32x4*)(md + 2048 + c);
            v[j] = x * DN_ALPHA + g1 * y; s += (v[j][0] + v[j][1]) + (v[j][2] + v[j][3]); }
        const float mean = wave_sum(s, F.lane) * (1.f / DM); float s2 = 0.f;
#pragma unroll
        for (int j = 0; j < 4; ++j) { v[j] = v[j] - mean; s2 += (v[j][0] * v[j][0] + v[j][1] * v[j][1]) + (v[j][2] * v[j][2] + v[j][3] * v[j][3]); }
        const float rstd = 1.f / sqrtf(wave_sum(s2, F.lane) * (1.f / DM) + LN_EPS);
#pragma unroll
        for (int j = 0; j < 4; ++j) { const int c = 4 * F.lane + 256 * j; const f32x4 g = *(const f32x4*)(lg + c), bb = *(const f32x4*)(lb + c), sh = *(const f32x4*)(md + 3072 + c), sc = *(const f32x4*)(md + 4096 + c);
            const f32x4 xn = v[j] * rstd * g + bb; *(f32x4*)(xr + c) = xn;
            u32x2 w; w.x = pk2(xn[0] * (1.f + sc[0]) + sh[0], xn[1] * (1.f + sc[1]) + sh[1]); w.y = pk2(xn[2] * (1.f + sc[2]) + sh[2], xn[3] * (1.f + sc[3]) + sh[3]);
            *(u32x2*)(xm + c) = w; }
    }
}
__device__ __forceinline__ void ph_ln2(Frame& F, int l, int ntok, bool last) {
    const int gw = F.wg * NWAVES + F.wave, NGW = F.G * NWAVES;
    const float* lg = F.in[I_LN2G] + l * DM; const float* lb = F.in[I_LN2B] + l * DM;
    for (int row = gw; row < ntok; row += NGW) {
        float* xr = (row < NLAT ? F.out + (size_t)row * DM : (float*)(F.ws + WS_XC) + (size_t)(row - NLAT) * DM) + 16 * F.lane;
        const unsigned char* y2 = (const unsigned char*)(F.ws + WS_Y2) + (size_t)row * 9 * DM + 16 * F.lane;
        const float* wg = (const float*)(F.ws + WS_WGT) + (size_t)row * 8;
        const float* md = mod_ptr(F, l, row) + 16 * F.lane;
        float ff[16];
#pragma unroll
        for (int e = 0; e < 16; ++e) ff[e] = 0.f;
        u32x4 q[9];
#pragma unroll
        for (int k = 0; k < 9; ++k) q[k] = *(const GAS u32x4*)(y2 + (size_t)k * DM);
#pragma unroll
        for (int k = 0; k < 9; ++k) { const float wk = (k < 8 ? wg[k] : 1.0f) * pg8::Y2_INV; const unsigned a[4] = {q[k].x, q[k].y, q[k].z, q[k].w};
#pragma unroll
            for (int e = 0; e < 4; ++e) { const f32x2 lo = __builtin_amdgcn_cvt_pk_f32_fp8((int)a[e], false), hi = __builtin_amdgcn_cvt_pk_f32_fp8((int)a[e], true);
                ff[4 * e] += wk * lo.x; ff[4 * e + 1] += wk * lo.y; ff[4 * e + 2] += wk * hi.x; ff[4 * e + 3] += wk * hi.y; } }
        float v[16]; float s = 0.f;
#pragma unroll
        for (int j = 0; j < 4; ++j) { const f32x4 x = *(const GAS f32x4*)(xr + 4 * j), g2 = *(const GAS f32x4*)(md + 5120 + 4 * j);
#pragma unroll
            for (int e = 0; e < 4; ++e) { v[4 * j + e] = x[e] * DN_ALPHA + g2[e] * ff[4 * j + e]; s += v[4 * j + e]; } }
        const float mean = wave_sum(s, F.lane) * (1.f / DM); float s2 = 0.f;
#pragma unroll
        for (int e = 0; e < 16; ++e) { v[e] -= mean; s2 += v[e] * v[e]; }
        const float rstd = 1.f / sqrtf(wave_sum(s2, F.lane) * (1.f / DM) + LN_EPS);
        const float* mdn = (last ? mod_ptr(F, l, row) : mod_ptr(F, l + 1, row)) + 16 * F.lane;
        bf16_t* xm = (bf16_t*)(F.ws + WS_XM) + (size_t)row * DM + 16 * F.lane;
        float xn[16];
#pragma unroll
        for (int j = 0; j < 4; ++j) { const f32x4 g = *(const GAS f32x4*)(lg + 16 * F.lane + 4 * j), bb = *(const GAS f32x4*)(lb + 16 * F.lane + 4 * j);
#pragma unroll
            for (int e = 0; e < 4; ++e) xn[4 * j + e] = v[4 * j + e] * rstd * g[e] + bb[e];
            *(GAS f32x4*)(xr + 4 * j) = (f32x4){xn[4 * j], xn[4 * j + 1], xn[4 * j + 2], xn[4 * j + 3]}; }
        if (!last) {
            unsigned w[8];
#pragma unroll
            for (int j = 0; j < 4; ++j) { const f32x4 sh = *(const GAS f32x4*)(mdn + 4 * j), sc = *(const GAS f32x4*)(mdn + 1024 + 4 * j);
                w[2 * j] = pk2(xn[4 * j] * (1.f + sc[0]) + sh[0], xn[4 * j + 1] * (1.f + sc[1]) + sh[1]); w[2 * j + 1] = pk2(xn[4 * j + 2] * (1.f + sc[2]) + sh[2], xn[4 * j + 3] * (1.f + sc[3]) + sh[3]); }
            *(GAS u32x4*)xm = (u32x4){w[0], w[1], w[2], w[3]}; *(GAS u32x4*)(xm + 8) = (u32x4){w[4], w[5], w[6], w[7]};
        }
    }
}

__device__ __forceinline__ unsigned f_ord(float f) { const unsigned u = __builtin_bit_cast(unsigned, f); return (u & 0x80000000u) ? ~u : (u | 0x80000000u); }
__device__ __forceinline__ unsigned long long wave_max_u64(unsigned long long v, int lane) {
#pragma unroll
    for (int o = 1; o < 64; o <<= 1) { const unsigned lo = (unsigned)shxi((int)(unsigned)v, o, lane), hi = (unsigned)shxi((int)(unsigned)(v >> 32), o, lane); const unsigned long long w = ((unsigned long long)hi << 32) | lo; v = w > v ? w : v; }
    return v;
}
__device__ __forceinline__ float seg16_max(float v, int lane) { v = fmaxf(v, shx(v, 1, lane)); v = fmaxf(v, shx(v, 2, lane)); v = fmaxf(v, shx(v, 4, lane)); v = fmaxf(v, shx(v, 8, lane)); return v; }
__device__ __forceinline__ int seg16_min_i(int v, int lane) { int w; w = shxi(v, 1, lane); v = w < v ? w : v; w = shxi(v, 2, lane); v = w < v ? w : v; w = shxi(v, 4, lane); v = w < v ? w : v; w = shxi(v, 8, lane); v = w < v ? w : v; return v; }
__device__ __forceinline__ float seg16_top2(float v, int lane) {
    const float m1 = seg16_max(v, lane);
    const int first = seg16_min_i(v == m1 ? (lane & 15) : 99, lane);
    const float m2 = seg16_max((lane & 15) == first ? -3.0e38f : v, lane);
    return m1 + m2;
}
__device__ __forceinline__ void ph_route(Frame& F, int l, int ntok) {
    LAS int* hist = (LAS int*)F.lds;
    LAS int* base = hist + 128;
    LAS unsigned* alist = (LAS unsigned*)(F.lds + 1024);
    const int tpw = (ntok + F.G - 1) / F.G, t0 = F.wg * tpw, t1 = (t0 + tpw) < ntok ? (t0 + tpw) : ntok;
    __syncthreads();
    if (F.tid < 128) hist[F.tid] = 0;
    __syncthreads();
    const float* LG = (const float*)(F.ws + WS_LOGIT); const float* rb = F.in[I_RB] + l * NEXP;
    const float b0 = rb[F.lane], b1 = rb[F.lane + 64];
    for (int tok = t0 + F.wave; tok < t1; tok += NWAVES) {
        const float x0 = LG[(size_t)tok * 256 + F.lane], x1 = LG[(size_t)tok * 256 + 64 + F.lane];
        const float s0 = 1.0f / (1.0f + __expf(-x0)), s1 = 1.0f / (1.0f + __expf(-x1));
        const float e0 = s0 + b0, e1 = s1 + b1;
        const float gs0 = seg16_top2(e0, F.lane), gs1 = seg16_top2(e1, F.lane);
        float gsc[8];
#pragma unroll
        for (int g = 0; g < 4; ++g) { gsc[g] = shf(gs0, g * 16); gsc[4 + g] = shf(gs1, g * 16); }
        unsigned gmask = 0u;
#pragma unroll
        for (int g = 0; g < 8; ++g) { int cnt = 0;
#pragma unroll
            for (int g2 = 0; g2 < 8; ++g2) cnt += (gsc[g2] > gsc[g] || (gsc[g2] == gsc[g] && g2 < g)) ? 1 : 0;
            gmask |= (cnt < 4) ? (1u << g) : 0u; }
        const bool ok0 = (gmask >> (F.lane >> 4)) & 1u, ok1 = (gmask >> (4 + (F.lane >> 4))) & 1u;
        unsigned long long k0 = ok0 ? (((unsigned long long)f_ord(e0) << 32) | (unsigned)(255 - F.lane)) : 0ull;
        unsigned long long k1 = ok1 ? (((unsigned long long)f_ord(e1) << 32) | (unsigned)(255 - 64 - F.lane)) : 0ull;
        int mye = 0; float myw = 0.f; float wsum = 0.f;
#pragma unroll
        for (int k = 0; k < 8; ++k) {
            const unsigned long long best = wave_max_u64(k0 > k1 ? k0 : k1, F.lane);
            const int e = 255 - (int)(best & 0xffu);
            if (k0 == best) k0 = 0ull; if (k1 == best) k1 = 0ull;
            const float sv = shf(e < 64 ? s0 : s1, e & 63);
            wsum += sv; if (F.lane == k) { mye = e; myw = sv; }
        }
        if (F.lane < 8) {
            const int lr = __hip_atomic_fetch_add(&hist[mye], 1, __ATOMIC_RELAXED, __HIP_MEMORY_SCOPE_WORKGROUP);
            alist[(tok - t0) * 8 + F.lane] = (unsigned)mye | ((unsigned)lr << 8);
            ((int*)(F.ws + WS_EIDX))[(size_t)tok * 8 + F.lane] = mye;
            ((float*)(F.ws + WS_WGT))[(size_t)tok * 8 + F.lane] = myw / wsum * 2.5f;
        }
    }
    __syncthreads();
    if (F.tid < 128) { const int hcount = hist[F.tid]; base[F.tid] = hcount ? (int)atomicAdd(F.ctl + CW_CNT + l * 256 + F.tid, (unsigned)hcount) : 0; }
    __syncthreads();
    for (int a = F.tid; a < (t1 - t0) * 8; a += NTHR) { const unsigned v = alist[a]; ((int*)(F.ws + WS_RNK))[(size_t)t0 * 8 + a] = base[v & 0xffu] + (int)(v >> 8); }
}
__device__ __forceinline__ void ph_positions(Frame& F, int l, int ntok) {
    LAS int* cnt = (LAS int*)F.lds;
    LAS int* off = cnt + 132;
    __syncthreads();
    if (F.tid < NE1) cnt[F.tid] = F.tid < NEXP ? (int)__hip_atomic_load(F.ctl + CW_CNT + l * 256 + F.tid, __ATOMIC_RELAXED, __HIP_MEMORY_SCOPE_AGENT) : ntok;
    __syncthreads();
    if (F.tid == 0) { int o = 0; for (int e = 0; e < NE1; ++e) { off[e] = o; o += (cnt[e] + 255) & ~255; } off[NE1] = o; }
    __syncthreads();
    const int gt = F.wg * NTHR + F.tid, NGT = F.G * NTHR;
    int* rowtok = (int*)(F.ws + WS_ROWTOK); int* rowdst = (int*)(F.ws + WS_ROWDST); int* tile_exp = (int*)(F.ws + WS_TILEEXP);
    const int* eidx = (const int*)(F.ws + WS_EIDX); const int* rnk = (const int*)(F.ws + WS_RNK);
    for (int a = gt; a < ntok * 8; a += NGT) { const int tok = a >> 3, k = a & 7; const int pos = off[eidx[a]] + rnk[a]; rowtok[pos] = tok; rowdst[pos] = tok * 9 + k; }
    for (int tok = gt; tok < ntok; tok += NGT) { const int pos = off[NEXP] + tok; rowtok[pos] = tok; rowdst[pos] = tok * 9 + 8; }
    for (int i = gt; i < NE1 * 256; i += NGT) { const int e = i >> 8, p = i & 255; const int row = off[e] + cnt[e] + p; if (row < off[e + 1]) { rowtok[row] = 0; rowdst[row] = -1; } }
    for (int i = gt; i < NE1 * 320; i += NGT) { const int e = i / 320, p = i % 320; const int t = (off[e] >> 8) + p; if (t < (off[e + 1] >> 8)) tile_exp[t] = e; }
    if (gt == 0) F.ctl[CW_NTL + l] = (unsigned)(off[NE1] >> 8);
}

#ifndef MK_MULTI
#define MK_MULTI 0
#endif
constexpr int PH_PER_LAYER = 12, NPHASE = 2 + DEPTH * PH_PER_LAYER;
struct Args { const float* in[36]; float* out; unsigned char* ws; int ph_lo, ph_hi; };

__global__ void __launch_bounds__(NTHR, 2) mk_fwd(Args args) {
    extern __shared__ __attribute__((aligned(16))) unsigned char lds_raw[];
    Frame F;
    F.lds = (LAS unsigned char*)lds_raw;
    F.tid = threadIdx.x; F.lane = F.tid & 63; F.wave = __builtin_amdgcn_readfirstlane(F.tid >> 6);
    const int wave0 = F.wave;
    F.G = gridDim.x; F.wg = blockIdx.x;
    F.in = args.in;
    F.out = args.out; F.ws = args.ws; F.ctl = (unsigned*)(args.ws + WS_CTL);
    volatile LAS unsigned* MISC = (volatile LAS unsigned*)(F.lds + MISC_OFF);
    if (F.tid < 32) MISC[F.tid] = 0u;
    __syncthreads();
    const int lo = args.ph_lo, hi = args.ph_hi;
    const bool single = (hi - lo) > 1;
    XcdBarrier bar; bar.bar = F.ctl + CW_BAR; bar.x = 0; bar.st = nullptr;
    if (single) bar = xcd_barrier_post(F.ctl + CW_BAR, MISC + 8);
#define IN(k) (lo <= (k) && (k) < hi)
#ifndef PROBE_MASK
#define PROBE_MASK 0
#endif
#define REP(k) for (int _rep = 0; _rep < (((PROBE_MASK >> (k)) & 1) ? 2 : 1); ++_rep)
#define SEAM(k) do { if (IN(k) && IN((k) + 1)) xcd_barrier(bar); } while (0)
#define FRESH() do { int _ln; asm volatile("v_mbcnt_lo_u32_b32 %0, -1, 0\n\tv_mbcnt_hi_u32_b32 %0, -1, %0" : "=v"(_ln)); int _wv = wave0; asm volatile("" : "+s"(_wv)); F.lane = _ln; F.wave = _wv; F.tid = (_wv << 6) | _ln; \
        unsigned char* _w = args.ws; asm volatile("" : "+s"(_w)); F.ws = _w; F.ctl = (unsigned*)(_w + WS_CTL); float* _o = args.out; asm volatile("" : "+s"(_o)); F.out = _o; } while (0)

    if (IN(0)) { FRESH(); p0_static_weights(F); __syncthreads(); p0_mod(F); __syncthreads(); p0_hyena_filters(F); }
    SEAM(0);
    if (IN(1)) { FRESH(); p0_init_rows(F); }
    SEAM(1);
#pragma unroll 1
    for (int l = 0; l < DEPTH; ++l) {
        const int pb = 2 + l * PH_PER_LAYER; const bool last = (l == DEPTH - 1); const int ntok = last ? NLAT : NROW;
        if (IN(pb + 0)) { FRESH();
            REP(0) { p_expert_weights(F, l); __syncthreads(); }
            pg8::DenseOrder S; S.init(NROW, DIN, F.G, F.wg); pg8::EpiBf16 E{(bf16_t*)(F.ws + WS_U), DIN};
            REP(1) pg8::gemm_phase<pg8::EpiBf16, pg8::DenseOrder, false>(F.tid, F.lds, (const bf16_t*)(F.ws + WS_XM), (const bf16_t*)(F.ws + WS_WIN) + (size_t)l * DIN * DM, DM, nullptr, S, E);
        }
        SEAM(pb + 0);
        if (IN(pb + 1)) { FRESH(); REP(2) { ph_transposes(F, l); __syncthreads(); } REP(3) { ph_gla_local(F, l); __syncthreads(); } }
        SEAM(pb + 1);
        if (IN(pb + 2)) { FRESH(); REP(4) { ph_na(F, l, last); } REP(5) { ph_gla_scan(F); } __syncthreads(); REP(6) { ph_hyena(F, l, last); } }
        SEAM(pb + 2);
        if (IN(pb + 3)) { FRESH(); REP(7) { ph_gla_out(F, l, last); } }
        SEAM(pb + 3);
        if (IN(pb + 4)) { FRESH();
            pg8::DenseOrder S; S.init(ntok, DM, F.G, F.wg); pg8::EpiF32 E{(float*)(F.ws + WS_Y), DM};
            REP(8) pg8::gemm_phase<pg8::EpiF32, pg8::DenseOrder, false>(F.tid, F.lds, (const bf16_t*)(F.ws + WS_MIX), (const bf16_t*)(F.ws + WS_WOUT) + (size_t)l * DM * DM, DM, nullptr, S, E);
        }
        SEAM(pb + 4);
        if (IN(pb + 5)) { FRESH(); ph_ln1(F, l, ntok); }
        SEAM(pb + 5);
        if (IN(pb + 6)) { FRESH();
            pg8::DenseOrder S; S.init(ntok, 256, F.G, F.wg); pg8::EpiF32 E{(float*)(F.ws + WS_LOGIT), 256};
            REP(9) pg8::gemm_phase<pg8::EpiF32, pg8::DenseOrder, false>(F.tid, F.lds, (const bf16_t*)(F.ws + WS_XM), (const bf16_t*)(F.ws + WS_WR) + (size_t)l * 256 * DM, DM, nullptr, S, E);
        }
        SEAM(pb + 6);
        if (IN(pb + 7)) { FRESH(); ph_route(F, l, ntok); }
        SEAM(pb + 7);
        if (IN(pb + 8)) { FRESH(); REP(12) { ph_positions(F, l, ntok); __syncthreads(); } }
        SEAM(pb + 8);
        if (IN(pb + 9)) { FRESH();
            const int ntl = (int)__hip_atomic_load(F.ctl + CW_NTL + l, __ATOMIC_RELAXED, __HIP_MEMORY_SCOPE_AGENT);
            pg8::GroupedOrder S{(const int*)(F.ws + WS_TILEEXP), ntl, 2, F.G, F.wg}; pg8::EpiSwiglu E{(bf16_t*)(F.ws + WS_ACT)};
            REP(10) pg8::gemm_phase<pg8::EpiSwiglu, pg8::GroupedOrder, true>(F.tid, F.lds, (const bf16_t*)(F.ws + WS_XM), (const bf16_t*)(F.ws + WS_EXP1), DM, (const int*)(F.ws + WS_ROWTOK), S, E);
        }
        SEAM(pb + 9);
        if (IN(pb + 10)) { FRESH();
            const int ntl = (int)__hip_atomic_load(F.ctl + CW_NTL + l, __ATOMIC_RELAXED, __HIP_MEMORY_SCOPE_AGENT);
            pg8::GroupedOrder S{(const int*)(F.ws + WS_TILEEXP), ntl, 4, F.G, F.wg}; pg8::EpiScatter E{(unsigned char*)(F.ws + WS_Y2), (const int*)(F.ws + WS_ROWDST)};
            REP(11) pg8::gemm_phase<pg8::EpiScatter, pg8::GroupedOrder, false>(F.tid, F.lds, (const bf16_t*)(F.ws + WS_ACT), (const bf16_t*)(F.ws + WS_EXP2), EH, nullptr, S, E);
        }
        SEAM(pb + 10);
        if (IN(pb + 11)) { FRESH(); ph_ln2(F, l, ntok, last); }
        SEAM(pb + 11);
    }
#undef IN
#undef SEAM
#undef FRESH
}

extern "C" void kernel_launch(void* const* d_in, const int* in_sizes, int n_in, void* d_out, int out_size, void* d_ws, size_t ws_size, hipStream_t stream) {
    static int grid = 0;
    if (grid == 0) {
        if (n_in != 36 || out_size != NLAT * DM || ws_size < WS_END) { fprintf(stderr, "kernel_launch: unexpected shapes (n_in %d out %d ws %zu need %zu)\n", n_in, out_size, ws_size, (size_t)WS_END); grid = -1; return; }
        int dev = 0, cus = 0, per_cu = 0;
        if (hipGetDevice(&dev) != hipSuccess || hipDeviceGetAttribute(&cus, hipDeviceAttributeMultiprocessorCount, dev) != hipSuccess) { grid = -1; return; }
        if (hipFuncSetAttribute((const void*)mk_fwd, hipFuncAttributeMaxDynamicSharedMemorySize, LDS_BYTES) != hipSuccess) { fprintf(stderr, "kernel_launch: hipFuncSetAttribute failed\n"); grid = -1; return; }
        if (hipOccupancyMaxActiveBlocksPerMultiprocessor(&per_cu, (const void*)mk_fwd, NTHR, LDS_BYTES) != hipSuccess || per_cu < 1) { fprintf(stderr, "kernel_launch: occupancy query says %d\n", per_cu); }
        (void)hipGetLastError();
        grid = cus;
    }
    if (grid < 0) return;
    (void)hipMemsetAsync((char*)d_ws + WS_CTL, 0, CTL_BYTES, stream);
    Args a{};
    for (int i = 0; i < 36; ++i) a.in[i] = (const float*)d_in[i];
    a.out = (float*)d_out; a.ws = (unsigned char*)d_ws;
#if MK_MULTI
    for (int p = 0; p < NPHASE; ++p) { a.ph_lo = p; a.ph_hi = p + 1; hipLaunchKernelGGL(mk_fwd, dim3(grid), dim3(NTHR), LDS_BYTES, stream, a); }
#else
    a.ph_lo = 0; a.ph_hi = NPHASE; hipLaunchKernelGGL(mk_fwd, dim3(grid), dim3(NTHR), LDS_BYTES, stream, a);
#endif
}
```

```cpp
#include <hip/hip_runtime.h>
#include <cstdio>
#include <cstdint>

#define LAS __attribute__((address_space(3)))
#define GAS __attribute__((address_space(1)))
typedef unsigned short bf16_t;
typedef short bf16x8 __attribute__((ext_vector_type(8)));
typedef float f32x4 __attribute__((ext_vector_type(4)));
typedef float f32x2 __attribute__((ext_vector_type(2)));
typedef unsigned u32x4 __attribute__((ext_vector_type(4)));
typedef unsigned u32x2 __attribute__((ext_vector_type(2)));

constexpr int NB = 16, SEQ = 4096, CTXL = 256, DM = 1024, DEPTH = 4;
constexpr int NLAT = NB * SEQ;
constexpr int NCTX = NB * CTXL;
constexpr int NROW = NLAT + NCTX;
constexpr int SPB = SEQ + CTXL;
constexpr int DIN_REF = 3104;
constexpr int DIN = 3328;
constexpr int UQ = 0, UK = 512, UV = 1024, UGQ = 1536, UGK = 1664, UGV = 1792, UGR = 2048, UHY = 2304, ULAF = 3072, ULAB = 3200;
constexpr int NEXP = 128, TOPK = 8, EH = 256;
constexpr int NE1 = NEXP + 1;
constexpr int RMAX = 659712;
constexpr int TMAX = RMAX / 256;
constexpr float LN_EPS = 1e-6f;
constexpr float DN_ALPHA = 1.6817928305074290f;

__device__ __forceinline__ unsigned f2bf(float f) { unsigned u = __builtin_bit_cast(unsigned, f); return (u + 0x7fffu + ((u >> 16) & 1u)) >> 16; }
typedef __bf16 bf16v2 __attribute__((ext_vector_type(2)));
__device__ __forceinline__ unsigned pk2(float lo, float hi) { const f32x2 v = {lo, hi}; const bf16v2 b = __builtin_convertvector(v, bf16v2); return __builtin_bit_cast(unsigned, b); }
__device__ __forceinline__ float bf2f(unsigned short b) { return __builtin_bit_cast(float, ((unsigned)b) << 16); }
__device__ __forceinline__ float bflo(unsigned w) { return __builtin_bit_cast(float, w << 16); }
__device__ __forceinline__ float bfhi(unsigned w) { return __builtin_bit_cast(float, w & 0xffff0000u); }
__device__ __forceinline__ float shx(float v, int o, int lane) { return __builtin_bit_cast(float, __builtin_amdgcn_ds_bpermute((lane ^ o) << 2, __builtin_bit_cast(int, v))); }
__device__ __forceinline__ int shxi(int v, int o, int lane) { return __builtin_amdgcn_ds_bpermute((lane ^ o) << 2, v); }
__device__ __forceinline__ float shf(float v, int src) { return __builtin_bit_cast(float, __builtin_amdgcn_ds_bpermute(src << 2, __builtin_bit_cast(int, v))); }
__device__ __forceinline__ float wave_sum(float v, int lane) {
#pragma unroll
    for (int o = 1; o < 64; o <<= 1) v += shx(v, o, lane);
    return v;
}
__device__ __forceinline__ float silu_f(float x) { return x / (1.0f + __expf(-x)); }
#define LDS_WAIT() asm volatile("s_waitcnt lgkmcnt(0)" ::: "memory")
#define VM_WAIT() asm volatile("s_waitcnt vmcnt(0)" ::: "memory")

#define XB_TMO      128
#define XB_XCNT(j)  (256  + 64 * (j))
#define XB_XSUB(j)  (1280 + 64 * (j))
#define XB_XGEN(j)  (2304 + 64 * (j))
#define XB_TOP      3328
#define XB_TOPGEN   3392
#define XCD_BAR_WORDS 3456
#define XB_SPIN_CAP (1u << 18)

__device__ __forceinline__ unsigned xb_ld(unsigned* p)              { return __hip_atomic_load(p, __ATOMIC_RELAXED, __HIP_MEMORY_SCOPE_AGENT); }
__device__ __forceinline__ unsigned xb_add(unsigned* p, unsigned v) { return __hip_atomic_fetch_add(p, v, __ATOMIC_RELAXED, __HIP_MEMORY_SCOPE_AGENT); }
__device__ __forceinline__ unsigned xb_xcc_id() { return (unsigned)__builtin_amdgcn_s_getreg((3 << 11) | 20) & 0xFu; }
#define XB_SPIN(cond, bar) do { unsigned _sp = 0; while (cond) { __builtin_amdgcn_s_sleep(1); \
    if ((++_sp & 255u) == 0u) { if (xb_ld(&(bar)[XB_TMO])) break; if (_sp > XB_SPIN_CAP) { atomicAdd(&(bar)[XB_TMO], 1u); break; } } } } while (0)

struct XcdBarrier { unsigned* bar; unsigned x; volatile LAS unsigned* st; };

__device__ __forceinline__ XcdBarrier xcd_barrier_post(unsigned* bar, volatile LAS unsigned* st) {
    XcdBarrier b; b.bar = bar; b.x = xb_xcc_id(); b.st = st;
    if (threadIdx.x == 0) (void)xb_add(&bar[XB_XCNT(b.x)], 1u);
    return b;
}
__device__ __forceinline__ void xcd_barrier_complete(unsigned* bar, unsigned x, unsigned& nloc, unsigned& nx) {
    const unsigned G = gridDim.x * gridDim.y * gridDim.z;
    unsigned sum, cnt, mine, sp = 0u;
    for (;;) {
        sum = 0u; cnt = 0u; mine = 0u;
#pragma unroll
        for (unsigned j = 0; j < 16; ++j) { const unsigned c = xb_ld(&bar[XB_XCNT(j)]); sum += c; cnt += (c > 0u) ? 1u : 0u; mine = (j == x) ? c : mine; }
        if (sum == G) break;
        __builtin_amdgcn_s_sleep(1);
        if ((++sp & 255u) == 0u) { if (xb_ld(&bar[XB_TMO])) break; if (sp > XB_SPIN_CAP) { atomicAdd(&bar[XB_TMO], 1u); break; } }
    }
    nloc = mine > 0u ? mine : 1u; nx = cnt > 0u ? cnt : 1u;
}
__device__ __forceinline__ void xcd_barrier(const XcdBarrier& b) {
    asm volatile("s_waitcnt vmcnt(0)" ::: "memory");
    __syncthreads();
    if (threadIdx.x == 0) {
        unsigned* bar = b.bar;
        __builtin_amdgcn_s_waitcnt(0);
        unsigned nloc = b.st[0], nx = b.st[1];
        if (nloc == 0u) { xcd_barrier_complete(bar, b.x, nloc, nx); b.st[0] = nloc; b.st[1] = nx; }
        const unsigned old = xb_add(&bar[XB_XSUB(b.x)], 1u);
        const unsigned gen = old / nloc;
        if (old + 1u == (gen + 1u) * nloc) {
            __builtin_amdgcn_fence(__ATOMIC_RELEASE, "agent");
            asm volatile("s_waitcnt vmcnt(0)" ::: "memory");
            const unsigned og = xb_add(&bar[XB_TOP], 1u);
            const unsigned tg = og / nx;
            if (og + 1u == (tg + 1u) * nx) xb_add(&bar[XB_TOPGEN], 1u);
            else XB_SPIN(xb_ld(&bar[XB_TOPGEN]) == tg, bar);
            __builtin_amdgcn_fence(__ATOMIC_ACQUIRE, "agent");
            xb_add(&bar[XB_XGEN(b.x)], 1u);
            asm volatile("s_waitcnt vmcnt(0)" ::: "memory");
        } else {
            XB_SPIN(xb_ld(&bar[XB_XGEN(b.x)]) == gen, bar);
            __builtin_amdgcn_fence(__ATOMIC_ACQUIRE, "agent");
            asm volatile("s_waitcnt vmcnt(0)" ::: "memory");
        }
    }
    __syncthreads();
}

namespace pg8 {
constexpr int BM = 256, BK = 64, HALF = 128, HTB = HALF * BK * 2, STAGE_BYTES = 8 * HTB, NXCD = 8, WGM = 8;
__host__ __device__ __forceinline__ int lds_byte(int r, int c) { const int st = (r >> 4) * 2 + (c >> 5), rr = r & 15, cc = c & 31, ob = rr * 64 + cc * 2; return st * 1024 + (ob ^ (((ob >> 9) & 1) << 5)); }
__host__ __device__ __forceinline__ void stage_rc(int b, int& R, int& C) { const int st = b / 1024, sb = b % 1024, swz = sb ^ (((sb >> 9) & 1) << 5); R = (st >> 1) * 16 + swz / 64; C = (st & 1) * 32 + (swz % 64) / 2; }
__host__ __device__ __forceinline__ int perm32(int rho) { const int n = rho >> 4, i = rho & 15; return 8 * (i >> 2) + 4 * n + (i & 3); }

struct Unit { int arow0, brow0, orow0, ocol0, aux; };

struct DenseOrder {
    int nM, nN, nwg, G, c;
    __device__ void init(int M, int N, int G_, int c_) { nM = M / BM; nN = N / BM; nwg = nM * nN; G = G_; c = c_; }
    __device__ __forceinline__ bool next(int i, Unit& u) const {
        const long L = (long)i * G + c; if (L >= nwg) return false;
        int wgid = (int)L; { const int q = nwg / NXCD, r = nwg % NXCD, xcd = wgid % NXCD, off = wgid / NXCD; wgid = (xcd < r ? xcd * (q + 1) : r * (q + 1) + (xcd - r) * q) + off; }
        const int nig = WGM * nN, gid = wgid / nig, fm = gid * WGM, gsz = (nM - fm) < WGM ? (nM - fm) : WGM;
        const int pm = fm + ((wgid % nig) % gsz), pn = (wgid % nig) / gsz;
        u.arow0 = pm * BM; u.brow0 = pn * BM; u.orow0 = pm * BM; u.ocol0 = pn * BM; u.aux = 0; return true;
    }
};
struct GroupedOrder {
    const int* tile_exp; int nN, nslot, slot, t0, t1;
    __device__ __forceinline__ void init(const int* te, int ntiles, int nN_, int G, int c) {
        tile_exp = te; nN = nN_;
        if ((G & 7) == 0) { const int per = (ntiles + 7) >> 3, x = c & 7; nslot = G >> 3; slot = c >> 3; t0 = x * per; t1 = (t0 + per) < ntiles ? (t0 + per) : ntiles; }
        else { nslot = G; slot = c; t0 = 0; t1 = ntiles; }
    }
    __device__ __forceinline__ bool next(int i, Unit& u) const {
        const int q = i * nslot + slot, t = t0 + q / nN, pn = q % nN;
        if (t >= t1) return false;
        const int e = tile_exp[t];
        u.arow0 = t * BM; u.brow0 = (e * nN + pn) * BM; u.orow0 = t * BM; u.ocol0 = pn * BM; u.aux = e; return true;
    }
};

__device__ __forceinline__ unsigned cvt_pk_bf16(float lo, float hi) { return pk2(lo, hi); }

struct NoPre {};
struct EpiF32 {
    static constexpr bool PERM = false; typedef NoPre Pre;
    __device__ __forceinline__ Pre prefetch(const Unit&, LAS unsigned char*, int, int, int) const { return Pre{}; }
    float* C; int ldc;
    __device__ __forceinline__ void operator()(const f32x4 (&acc)[2][2][4][2], const Unit& u, int wr, int wc, int fr, int fq, const Pre&) const {
        const int row0 = u.orow0 + wr * 64 + fr, col0 = u.ocol0 + wc * 32 + 4 * fq;
#pragma unroll
        for (int ai = 0; ai < 2; ++ai)
#pragma unroll
            for (int m = 0; m < 4; ++m) { float* rowp = C + (size_t)(row0 + ai * HALF + m * 16) * ldc + col0;
#pragma unroll
                for (int bj = 0; bj < 2; ++bj)
#pragma unroll
                    for (int n = 0; n < 2; ++n) *(f32x4*)(rowp + bj * HALF + n * 16) = acc[ai][bj][m][n]; }
    }
};
struct EpiBf16 {
    static constexpr bool PERM = true; typedef NoPre Pre;
    __device__ __forceinline__ Pre prefetch(const Unit&, LAS unsigned char*, int, int, int) const { return Pre{}; }
    bf16_t* O; int ldc;
    __device__ __forceinline__ void operator()(const f32x4 (&acc)[2][2][4][2], const Unit& u, int wr, int wc, int fr, int fq, const Pre&) const {
        const int row0 = u.orow0 + wr * 64 + fr, col0 = u.ocol0 + wc * 32 + 8 * fq;
#pragma unroll
        for (int ai = 0; ai < 2; ++ai)
#pragma unroll
            for (int m = 0; m < 4; ++m) { bf16_t* rowp = O + (size_t)(row0 + ai * HALF + m * 16) * ldc + col0;
#pragma unroll
                for (int bj = 0; bj < 2; ++bj) { const f32x4 v0 = acc[ai][bj][m][0], v1 = acc[ai][bj][m][1];
                    u32x4 w; w.x = cvt_pk_bf16(v0[0], v0[1]); w.y = cvt_pk_bf16(v0[2], v0[3]); w.z = cvt_pk_bf16(v1[0], v1[1]); w.w = cvt_pk_bf16(v1[2], v1[3]);
                    *(u32x4*)(rowp + bj * HALF) = w; } }
    }
};
struct EpiSwiglu {
    static constexpr bool PERM = false; typedef NoPre Pre;
    __device__ __forceinline__ Pre prefetch(const Unit&, LAS unsigned char*, int, int, int) const { return Pre{}; }
    bf16_t* ACT;
    __device__ __forceinline__ void operator()(const f32x4 (&acc)[2][2][4][2], const Unit& u, int wr, int wc, int fr, int fq, const Pre&) const {
        const int row0 = u.orow0 + wr * 64 + fr, pn = u.ocol0 >> 8;
#pragma unroll
        for (int ai = 0; ai < 2; ++ai)
#pragma unroll
            for (int m = 0; m < 4; ++m) { bf16_t* rowp = ACT + (size_t)(row0 + ai * HALF + m * 16) * EH + wc * 16 + 4 * fq;
#pragma unroll
                for (int bj = 0; bj < 2; ++bj) { const f32x4 g = acc[ai][bj][m][0], up = acc[ai][bj][m][1]; float h[4];
#pragma unroll
                    for (int i = 0; i < 4; ++i) h[i] = g[i] / (1.0f + __expf(-g[i])) * up[i];
                    u32x2 w; w.x = cvt_pk_bf16(h[0], h[1]); w.y = cvt_pk_bf16(h[2], h[3]);
                    *(u32x2*)(rowp + (pn * 2 + bj) * 64) = w; } }
    }
};
constexpr float Y2_SCALE = 16.0f, Y2_INV = 1.0f / 16.0f;
struct EpiScatter {
    static constexpr bool PERM = true;
    struct Pre { const LAS int* tab; };
    unsigned char* Y2; const int* rowdst;
    __device__ __forceinline__ Pre prefetch(const Unit& u, LAS unsigned char* lds, int wid, int lane, int ui) const {
        LAS unsigned char* tab = lds + STAGE_BYTES + (ui & 1) * 1024;
        if (wid < 4) __builtin_amdgcn_global_load_lds((const unsigned*)(rowdst + u.orow0 + wid * 64 + lane), (LAS unsigned*)(tab + wid * 256), 4, 0, 0);
        Pre p; p.tab = (const LAS int*)tab; return p; }
    __device__ __forceinline__ void operator()(const f32x4 (&acc)[2][2][4][2], const Unit& u, int wr, int wc, int fr, int fq, const Pre& pre) const {
        const int col0 = u.ocol0 + wc * 32 + 8 * fq;
#pragma unroll
        for (int ai = 0; ai < 2; ++ai)
#pragma unroll
            for (int m = 0; m < 4; ++m) { const int dst = pre.tab[wr * 64 + fr + ai * HALF + m * 16];
                if (dst >= 0) { unsigned char* rowp = Y2 + (size_t)dst * DM + col0;
#pragma unroll
                    for (int bj = 0; bj < 2; ++bj) { const f32x4 v0 = acc[ai][bj][m][0] * Y2_SCALE, v1 = acc[ai][bj][m][1] * Y2_SCALE;
                        int w0 = 0, w1 = 0;
                        w0 = __builtin_amdgcn_cvt_pk_fp8_f32(v0[0], v0[1], w0, false); w0 = __builtin_amdgcn_cvt_pk_fp8_f32(v0[2], v0[3], w0, true);
                        w1 = __builtin_amdgcn_cvt_pk_fp8_f32(v1[0], v1[1], w1, false); w1 = __builtin_amdgcn_cvt_pk_fp8_f32(v1[2], v1[3], w1, true);
                        *(GAS u32x2*)(rowp + bj * HALF) = (u32x2){(unsigned)w0, (unsigned)w1}; } } }
    }
};

template <class Epi, class Sched, bool GATHER, bool ALIGN_EPI = true, bool SP2 = true>
__device__ __forceinline__ void gemm_phase(const int tid_in, LAS unsigned char* lds, const bf16_t* Ag, const bf16_t* Bg, const int K, const int* rowidx, const Sched& S, const Epi& E) {
    int tid_ = tid_in; asm volatile("" : "+v"(tid_));
    const int tid = tid_, wid = __builtin_amdgcn_readfirstlane(tid >> 6), lane = tid & 63, wr = wid >> 2, wc = wid & 3, fr = lane & 15, fq = lane >> 4;
    const int nt = K / BK;
    int RA[2]; unsigned colA[2], voffB[2];
#pragma unroll
    for (int i = 0; i < 2; ++i) { int R, C; stage_rc(tid * 16 + i * 8192, R, C); const int Rb = Epi::PERM ? ((R & ~31) + perm32(R & 31)) : R;
        RA[i] = R; colA[i] = (unsigned)C * 2u; voffB[i] = (unsigned)(Rb * K + C) * 2u; }
    const size_t kstep = (size_t)(BK * 2);
    const size_t hstep = (size_t)HALF * K * 2;
    const unsigned ldsw = (unsigned)wid * 1024u;
    const int aoff = lds_byte(wr * 64 + fr, fq * 8), boff = lds_byte(wc * 32 + fr, fq * 8);
#define PG8_SA(b, h) (((b) * 2 + (h)) * HTB)
#define PG8_SB(b, h) ((4 + (b) * 2 + (h)) * HTB)
#define PG8_STAGE_B(bufoff, gbase) do { _Pragma("unroll") for (int _i = 0; _i < 2; ++_i) \
        __builtin_amdgcn_global_load_lds((const unsigned*)((const char*)(gbase) + voffB[_i]), (LAS unsigned*)(lds + (bufoff) + ldsw + _i * 8192), 16, 0, 0); } while (0)
#define PG8_STAGE_A(bufoff, gbase, o0, o1) do { \
        __builtin_amdgcn_global_load_lds((const unsigned*)((const char*)(gbase) + (o0)), (LAS unsigned*)(lds + (bufoff) + ldsw), 16, 0, 0); \
        __builtin_amdgcn_global_load_lds((const unsigned*)((const char*)(gbase) + (o1)), (LAS unsigned*)(lds + (bufoff) + ldsw + 8192), 16, 0, 0); } while (0)
#define PG8_LDA(dst, b, h) do { _Pragma("unroll") for (int m = 0; m < 4; ++m) _Pragma("unroll") for (int k = 0; k < 2; ++k) dst[m][k] = *(const LAS bf16x8*)(lds + PG8_SA(b, h) + aoff + m * 2048 + k * 1024); } while (0)
#define PG8_LDB(dst, b, h) do { _Pragma("unroll") for (int n = 0; n < 2; ++n) _Pragma("unroll") for (int k = 0; k < 2; ++k) dst[n][k] = *(const LAS bf16x8*)(lds + PG8_SB(b, h) + boff + n * 2048 + k * 1024); } while (0)
#define PG8_MMA(ai, bj, At, Bt) do { __builtin_amdgcn_s_setprio(1); _Pragma("unroll") for (int m = 0; m < 4; ++m) _Pragma("unroll") for (int n = 0; n < 2; ++n) _Pragma("unroll") for (int k = 0; k < 2; ++k) \
        acc[ai][bj][m][n] = __builtin_amdgcn_mfma_f32_16x16x32_bf16(Bt[n][k], At[m][k], acc[ai][bj][m][n], 0, 0, 0); __builtin_amdgcn_s_setprio(0); } while (0)
#define PG8_WAIT_V(n) asm volatile("s_waitcnt vmcnt(" #n ")" ::: "memory")
#define PG8_WAIT_L(n) asm volatile("s_waitcnt lgkmcnt(" #n ")" ::: "memory")
#define PG8_BAR __builtin_amdgcn_s_barrier()
#define PG8_SCHED __builtin_amdgcn_sched_barrier(0)
#define PG8_AOFF(dst, unit) do { if (GATHER) { _Pragma("unroll") for (int _h = 0; _h < 2; ++_h) _Pragma("unroll") for (int _i = 0; _i < 2; ++_i) \
            dst[_h][_i] = (unsigned)rowidx[(unit).arow0 + _h * HALF + RA[_i]] * (unsigned)(K * 2) + colA[_i]; } \
        else { _Pragma("unroll") for (int _h = 0; _h < 2; ++_h) _Pragma("unroll") for (int _i = 0; _i < 2; ++_i) dst[_h][_i] = (unsigned)((_h * HALF + RA[_i]) * K) * 2u + colA[_i]; } } while (0)
    Unit cur, nxt; int ui = 0;
    if (!S.next(0, cur)) return;
    f32x4 acc[2][2][4][2];
#pragma unroll
    for (int a = 0; a < 2; ++a)
#pragma unroll
        for (int b = 0; b < 2; ++b)
#pragma unroll
            for (int m = 0; m < 4; ++m)
#pragma unroll
                for (int n = 0; n < 2; ++n) acc[a][b][m][n] = (f32x4){0.f, 0.f, 0.f, 0.f};
    bf16x8 At[4][2], B0[2][2], B1[2][2];
    unsigned ac[2][2], an[2][2];
    PG8_AOFF(ac, cur);
    const char* cA = (const char*)Ag + (GATHER ? (size_t)0 : (size_t)cur.arow0 * K * 2); const char* cB = (const char*)Bg + (size_t)cur.brow0 * K * 2;
    if constexpr (SP2) {
        PG8_STAGE_B(PG8_SB(0, 0), cB); PG8_STAGE_B(PG8_SB(0, 1), cB + hstep); PG8_STAGE_A(PG8_SA(0, 0), cA, ac[0][0], ac[0][1]); PG8_STAGE_A(PG8_SA(0, 1), cA, ac[1][0], ac[1][1]);
        if (wr == 1) PG8_BAR;
        PG8_WAIT_V(2); PG8_BAR;
        PG8_STAGE_B(PG8_SB(1, 0), cB + kstep); PG8_STAGE_A(PG8_SA(1, 0), cA + kstep, ac[0][0], ac[0][1]); PG8_STAGE_B(PG8_SB(1, 1), cB + hstep + kstep);
        PG8_WAIT_V(6); PG8_BAR;
    } else {
        PG8_STAGE_B(PG8_SB(0, 0), cB); PG8_STAGE_A(PG8_SA(0, 0), cA, ac[0][0], ac[0][1]); PG8_STAGE_B(PG8_SB(0, 1), cB + hstep); PG8_STAGE_A(PG8_SA(0, 1), cA, ac[1][0], ac[1][1]);
        if (wr == 1) PG8_BAR;
        PG8_WAIT_V(4); PG8_BAR;
        PG8_STAGE_B(PG8_SB(1, 0), cB + kstep); PG8_STAGE_A(PG8_SA(1, 0), cA + kstep, ac[0][0], ac[0][1]); PG8_STAGE_B(PG8_SB(1, 1), cB + hstep + kstep);
        PG8_WAIT_V(6); PG8_BAR;
    }
    for (;;) {
        const typename Epi::Pre pre = E.prefetch(cur, lds, wid, lane, ui);
        const bool has_next = S.next(ui + 1, nxt);
        if (has_next) { PG8_AOFF(an, nxt); } else {
#pragma unroll
            for (int _h = 0; _h < 2; ++_h)
#pragma unroll
                for (int _i = 0; _i < 2; ++_i) an[_h][_i] = ac[_h][_i]; }
        const char* nA = has_next ? ((const char*)Ag + (GATHER ? (size_t)0 : (size_t)nxt.arow0 * K * 2)) : cA; const char* nB = has_next ? (const char*)Bg + (size_t)nxt.brow0 * K * 2 : cB;
_Pragma("nounroll")
        for (int t = 0; t < nt; t += 2) {
            const bool last = (t == nt - 2);
            const char* a1 = cA + (size_t)(t + 1) * kstep;
            const char* a2 = last ? nA : cA + (size_t)(t + 2) * kstep; const char* b2 = last ? nB : cB + (size_t)(t + 2) * kstep;
            const char* a3 = a2 + kstep; const char* b3 = b2 + kstep;
            const unsigned s00 = last ? an[0][0] : ac[0][0], s01 = last ? an[0][1] : ac[0][1], s10 = last ? an[1][0] : ac[1][0], s11 = last ? an[1][1] : ac[1][1];
            if constexpr (SP2) {
            PG8_LDB(B0, 0, 0); PG8_LDB(B1, 0, 1); PG8_SCHED; PG8_LDA(At, 0, 0); PG8_STAGE_A(PG8_SA(1, 1), a1, ac[1][0], ac[1][1]);
            PG8_WAIT_V(8); PG8_WAIT_L(0); PG8_BAR; PG8_MMA(0, 0, At, B0); PG8_MMA(0, 1, At, B1); PG8_BAR; PG8_SCHED;
            PG8_LDA(At, 0, 1); PG8_STAGE_B(PG8_SB(0, 0), b2); PG8_STAGE_B(PG8_SB(0, 1), b2 + hstep); PG8_STAGE_A(PG8_SA(0, 0), a2, s00, s01);
            PG8_WAIT_V(8); PG8_WAIT_L(0); PG8_BAR; PG8_MMA(1, 0, At, B0); PG8_MMA(1, 1, At, B1); PG8_BAR; PG8_SCHED;
            PG8_LDB(B0, 1, 0); PG8_LDB(B1, 1, 1); PG8_SCHED; PG8_LDA(At, 1, 0); PG8_STAGE_A(PG8_SA(0, 1), a2, s10, s11);
            PG8_WAIT_V(8); PG8_WAIT_L(0); PG8_BAR; PG8_MMA(0, 0, At, B0); PG8_MMA(0, 1, At, B1); PG8_BAR; PG8_SCHED;
            PG8_LDA(At, 1, 1); PG8_STAGE_B(PG8_SB(1, 0), b3); PG8_STAGE_B(PG8_SB(1, 1), b3 + hstep); PG8_STAGE_A(PG8_SA(1, 0), a3, s00, s01);
            PG8_WAIT_V(8); PG8_WAIT_L(0); PG8_BAR; PG8_MMA(1, 0, At, B0); PG8_MMA(1, 1, At, B1); PG8_BAR; PG8_SCHED;
            } else {
            PG8_LDB(B0, 0, 0); PG8_SCHED; PG8_LDA(At, 0, 0); PG8_STAGE_A(PG8_SA(1, 1), a1, ac[1][0], ac[1][1]);
            PG8_WAIT_L(8); PG8_BAR; PG8_WAIT_L(0); PG8_MMA(0, 0, At, B0); PG8_BAR; PG8_SCHED;
            PG8_LDB(B1, 0, 1); PG8_STAGE_B(PG8_SB(0, 0), b2);
            PG8_BAR; PG8_WAIT_L(0); PG8_MMA(0, 1, At, B1); PG8_BAR;
            PG8_LDA(At, 0, 1); PG8_STAGE_A(PG8_SA(0, 0), a2, s00, s01);
            PG8_BAR; PG8_WAIT_L(0); PG8_MMA(1, 0, At, B0); PG8_BAR; PG8_SCHED;
            PG8_STAGE_B(PG8_SB(0, 1), b2 + hstep);
            PG8_WAIT_V(6); PG8_BAR; PG8_MMA(1, 1, At, B1); PG8_BAR;
            PG8_LDB(B0, 1, 0); PG8_SCHED; PG8_LDA(At, 1, 0); PG8_STAGE_A(PG8_SA(0, 1), a2, s10, s11);
            PG8_WAIT_L(8); PG8_BAR; PG8_WAIT_L(0); PG8_MMA(0, 0, At, B0); PG8_BAR; PG8_SCHED;
            PG8_LDB(B1, 1, 1); PG8_STAGE_B(PG8_SB(1, 0), b3);
            PG8_BAR; PG8_WAIT_L(0); PG8_MMA(0, 1, At, B1); PG8_BAR;
            PG8_LDA(At, 1, 1); PG8_STAGE_A(PG8_SA(1, 0), a3, s00, s01);
            PG8_BAR; PG8_WAIT_L(0); PG8_MMA(1, 0, At, B0); PG8_BAR; PG8_SCHED;
            PG8_STAGE_B(PG8_SB(1, 1), b3 + hstep);
            PG8_WAIT_V(6); PG8_BAR; PG8_MMA(1, 1, At, B1); PG8_BAR;
            }
        }
        if constexpr (ALIGN_EPI) { if (wr == 0) PG8_BAR; }
        E(acc, cur, wr, wc, fr, fq, pre);
        if (!has_next) break;
#pragma unroll
        for (int a = 0; a < 2; ++a)
#pragma unroll
            for (int b = 0; b < 2; ++b)
#pragma unroll
                for (int m = 0; m < 4; ++m)
#pragma unroll
                    for (int n = 0; n < 2; ++n) acc[a][b][m][n] = (f32x4){0.f, 0.f, 0.f, 0.f};
        cur = nxt; cA = nA; cB = nB; ++ui;
#pragma unroll
        for (int _h = 0; _h < 2; ++_h)
#pragma unroll
            for (int _i = 0; _i < 2; ++_i) ac[_h][_i] = an[_h][_i];
        if constexpr (ALIGN_EPI) { if (wr == 1) PG8_BAR; }
    }
    PG8_WAIT_V(0);
    if constexpr (!ALIGN_EPI) { if (wr == 0) PG8_BAR; }
    PG8_BAR;
#undef PG8_SA
#undef PG8_SB
#undef PG8_STAGE_A
#undef PG8_STAGE_B
#undef PG8_LDA
#undef PG8_LDB
#undef PG8_MMA
#undef PG8_WAIT_V
#undef PG8_WAIT_L
#undef PG8_BAR
#undef PG8_SCHED
#undef PG8_AOFF
}
}

constexpr int NWAVES = 8, NTHR = 512;
constexpr size_t MiB = 1u << 20;
constexpr size_t WS_CTL = 0, CTL_BYTES = 1 * MiB;
constexpr size_t WS_MOD = 1 * MiB;
constexpr size_t WS_WIN = 3 * MiB;
constexpr size_t WS_WOUT = 29 * MiB;
constexpr size_t WS_WR = 37 * MiB;
constexpr size_t WS_HYF = 39 * MiB;
constexpr size_t WS_HYFC = 71 * MiB;
constexpr size_t WS_XC = 73 * MiB;
constexpr size_t WS_EXP1 = 89 * MiB;
constexpr size_t WS_EXP2 = 218 * MiB;
constexpr size_t WS_XM = 283 * MiB;
constexpr size_t WS_EIDX = 419 * MiB;
constexpr size_t WS_WGT = 422 * MiB;
constexpr size_t WS_RNK = 425 * MiB;
constexpr size_t WS_ROWTOK = 428 * MiB;
constexpr size_t WS_ROWDST = 431 * MiB;
constexpr size_t WS_TILEEXP = 434 * MiB;
constexpr size_t WS_BIG = 435 * MiB;
constexpr size_t WS_U = WS_BIG;
constexpr size_t WS_MIX = 877 * MiB;
constexpr size_t WS_VT = 1013 * MiB;
constexpr size_t WS_HV = 1081 * MiB;
constexpr size_t WS_Z2 = 1183 * MiB;
constexpr size_t WS_GDS = 1217 * MiB;
constexpr size_t WS_GSIN = 1285 * MiB;
constexpr size_t WS_GD = 1319 * MiB;
constexpr size_t WS_Y = 1321 * MiB;
constexpr size_t WS_LOGIT = WS_BIG;
constexpr size_t WS_ACT = WS_BIG;
constexpr size_t WS_Y2 = 758 * MiB;
constexpr size_t WS_XR = 1600 * MiB;
constexpr size_t WS_END = 1736 * MiB;
constexpr int CW_BAR = 4096;
constexpr int CW_CNT = 16384;
constexpr int CW_NTL = 20480;

constexpr int LDS_BYTES = 147456;
constexpr int MISC_OFF = 143360;

struct Frame {
    LAS unsigned char* lds;
    int tid, lane, wave, G, wg;
    const float* const* in;
    float* out; unsigned char* ws; unsigned* ctl;
};
enum { I_X = 0, I_C, I_CTX, I_CCTX, I_WMOD, I_BMOD, I_WIN, I_RPB, I_WA2, I_BA2, I_GNORM, I_HSW, I_HSB, I_HW1, I_HB1, I_HF1, I_HW2, I_HB2, I_HF2, I_HW3, I_HB3, I_HDEC, I_HSKIP,
       I_WOUT, I_LN1G, I_LN1B, I_RW, I_RB, I_WEG, I_WEU, I_WED, I_WSG, I_WSU, I_WSD, I_LN2G, I_LN2B };

__device__ __forceinline__ int row_b(int row) { return row < NLAT ? (row >> 12) : 16; }
__device__ __forceinline__ const float* mod_ptr(const Frame& F, int l, int row) { return (const float*)(F.ws + WS_MOD) + ((size_t)l * 17 + row_b(row)) * 6144; }

template <class RowFn>
__device__ __forceinline__ void tr_item(const float* W, int ldw, int k0, int n0, bf16_t* dst, int ldd, RowFn rf, LAS float* scr, int lane) {
    float tv[32];
    const GAS float* wp = (const GAS float*)(W + (size_t)(k0 + (lane >> 5)) * ldw + n0 + (lane & 31));
#pragma unroll
    for (int i = 0; i < 32; ++i) tv[i] = wp[(size_t)(2 * i) * ldw];
#pragma unroll
    for (int i = 0; i < 32; ++i) scr[(2 * i + (lane >> 5)) * 33 + (lane & 31)] = tv[i];
    LDS_WAIT(); asm volatile("" ::: "memory");
    const int c = lane & 7;
#pragma unroll
    for (int j = 0; j < 4; ++j) { const int n = (lane >> 3) + 8 * j; const LAS float* s = scr + (8 * c) * 33 + n;
        u32x4 o; o.x = pk2(s[0 * 33], s[1 * 33]); o.y = pk2(s[2 * 33], s[3 * 33]); o.z = pk2(s[4 * 33], s[5 * 33]); o.w = pk2(s[6 * 33], s[7 * 33]);
        *(GAS u32x4*)(dst + (size_t)rf(n0 + n) * ldd + k0 + 8 * c) = o; }
    LDS_WAIT(); asm volatile("" ::: "memory");
}
struct RowId { __device__ __forceinline__ int operator()(int n) const { return n; } };
struct RowWin { __device__ __forceinline__ int operator()(int n) const { return n >= 2336 ? n - 32 : n; } };
struct RowGU { int up; __device__ __forceinline__ int operator()(int j) const { return (j >> 6) * 128 + ((j & 63) >> 4) * 32 + up * 16 + (j & 15); } };

__device__ __forceinline__ void p0_static_weights(Frame& F) {
    LAS float* scr = (LAS float*)(F.lds + F.wave * 16384);
    const int gw = F.wg * NWAVES + F.wave, NGW = F.G * NWAVES;
    constexpr int I_IN = 16 * 97, I_OUT = 16 * 32, I_R = 16 * 4, PER_L = I_IN + I_OUT + I_R;
    for (int it = gw; it < DEPTH * PER_L; it += NGW) {
        const int l = it / PER_L; int r = it % PER_L;
        if (r < I_IN) { const int kb = r / 97, nb = r % 97; if (nb == 72) continue;
            tr_item(F.in[I_WIN] + (size_t)l * DM * DIN_REF, DIN_REF, kb * 64, nb * 32, (bf16_t*)(F.ws + WS_WIN) + (size_t)l * DIN * DM, DM, RowWin{}, scr, F.lane); continue; }
        r -= I_IN;
        if (r < I_OUT) { const int kb = r / 32, nb = r % 32;
            tr_item(F.in[I_WOUT] + (size_t)l * DM * DM, DM, kb * 64, nb * 32, (bf16_t*)(F.ws + WS_WOUT) + (size_t)l * DM * DM, DM, RowId{}, scr, F.lane); continue; }
        r -= I_OUT;
        { const int kb = r / 4, nb = r % 4;
            tr_item(F.in[I_RW] + (size_t)l * DM * NEXP, NEXP, kb * 64, nb * 32, (bf16_t*)(F.ws + WS_WR) + (size_t)l * 256 * DM, DM, RowId{}, scr, F.lane); }
    }
    const int gt = F.wg * NTHR + F.tid, NGT = F.G * NTHR;
    for (int i = gt; i < DEPTH * 128 * DM / 8; i += NGT) { const int l = i / (128 * DM / 8), r = i % (128 * DM / 8);
        *(u32x4*)((bf16_t*)(F.ws + WS_WR) + ((size_t)l * 256 + 128) * DM + (size_t)r * 8) = (u32x4){0u, 0u, 0u, 0u}; }
    for (int i = gt; i < DEPTH * 256 * DM; i += NGT) {
        const int k = i % DM, n = (i / DM) % 256, l = i / (DM * 256), dir = n >> 7, j = n & 127;
        const float* wi = F.in[I_WIN] + ((size_t)l * DM + k) * DIN_REF + 2304 + dir * 16;
        const float* wa = F.in[I_WA2] + ((size_t)(l * 2 + dir) * 16) * 128 + j;
        float s = 0.f;
#pragma unroll
        for (int r = 0; r < 16; ++r) s += wi[r] * wa[r * 128];
        ((bf16_t*)(F.ws + WS_WIN))[((size_t)l * DIN + 3072 + n) * DM + k] = (bf16_t)f2bf(s);
    }
}
__device__ __forceinline__ void p0_mod(Frame& F) {
    LAS float* sc = (LAS float*)F.lds;
    LAS float* red = (LAS float*)(F.lds + 17 * 1024 * 4);
    for (int i = F.tid; i < 17 * 1024; i += NTHR) { const int r = i >> 10, k = i & 1023; const float v = r < 16 ? F.in[I_C][r * 1024 + k] : F.in[I_CCTX][k]; sc[i] = silu_f(v); }
    __syncthreads();
    const int kq = F.tid >> 7, cl = F.tid & 127;
    for (int u = F.wg; u < DEPTH * 48; u += F.G) {
        const int l = u / 48, col = (u % 48) * 128 + cl;
        const float* w = F.in[I_WMOD] + (size_t)l * DM * 6144 + col;
        float a[17];
#pragma unroll
        for (int r = 0; r < 17; ++r) a[r] = 0.f;
#pragma unroll 4
        for (int k = kq * 256; k < kq * 256 + 256; ++k) { const float wv = w[(size_t)k * 6144];
#pragma unroll
            for (int r = 0; r < 17; ++r) a[r] += sc[r * 1024 + k] * wv; }
#pragma unroll
        for (int r = 0; r < 17; ++r) red[(kq * 17 + r) * 128 + cl] = a[r];
        __syncthreads();
        for (int i = F.tid; i < 17 * 128; i += NTHR) { const int r = i >> 7, c2 = i & 127, cc = (u % 48) * 128 + c2;
            const float s = red[(0 * 17 + r) * 128 + c2] + red[(1 * 17 + r) * 128 + c2] + red[(2 * 17 + r) * 128 + c2] + red[(3 * 17 + r) * 128 + c2] + F.in[I_BMOD][l * 6144 + cc];
            ((float*)(F.ws + WS_MOD))[((size_t)l * 17 + r) * 6144 + cc] = s; }
        __syncthreads();
    }
}
__device__ __forceinline__ void p0_hyena_filters(Frame& F) {
    LAS float* z = (LAS float*)F.lds;
    LAS float* h1 = z + 32 * 33;
    LAS float* h2 = h1 + 32 * 64;
    LAS float* tt = h2 + 32 * 64;
    constexpr int UL = 4096 / 32, UC = 256 / 32, UPL = UL + UC;
    for (int u = F.wg; u < DEPTH * UPL; u += F.G) {
        const int l = u / UPL, r = u % UPL; const bool lat = r < UL; const int L = lat ? 4096 : 256, n0 = (lat ? r : r - UL) * 32;
        __syncthreads();
        for (int i = F.tid; i < 32 * 33; i += NTHR) { const int p = i / 33, e = i % 33, n = n0 + p;
            const float t = (float)n / (float)(L - 1);
            float v;
            if (e == 0) v = t;
            else { const int kb = (e - 1) & 15; const float band = 1e-4f + (float)kb * ((15.0f - 1e-4f) / 15.0f);
                   const float w = 6.283185307179586f * (float)n / (float)L; const float ang = w * band;
                   v = e <= 16 ? __cosf(ang) : -__sinf(ang); }
            z[i] = v; if (e == 0) tt[p] = t; }
        __syncthreads();
        for (int i = F.tid; i < 32 * 64; i += NTHR) { const int p = i >> 6, j = i & 63; float s = F.in[I_HB1][l * 64 + j];
            for (int e = 0; e < 33; ++e) s += z[p * 33 + e] * F.in[I_HW1][((size_t)l * 33 + e) * 64 + j];
            h1[i] = __sinf(F.in[I_HF1][l * 64 + j] * s); }
        __syncthreads();
        for (int i = F.tid; i < 32 * 64; i += NTHR) { const int p = i >> 6, j = i & 63; float s = F.in[I_HB2][l * 64 + j];
            for (int e = 0; e < 64; ++e) s += h1[p * 64 + e] * F.in[I_HW2][((size_t)l * 64 + e) * 64 + j];
            h2[i] = __sinf(F.in[I_HF2][l * 64 + j] * s); }
        __syncthreads();
#pragma unroll 1
        for (int cc = 0; cc < 2; ++cc) {
            const int col = F.tid + cc * 512, o = col >> 9, dir = (col >> 8) & 1, ch = col & 255;
            float a[32];
#pragma unroll
            for (int p = 0; p < 32; ++p) a[p] = 0.f;
            const float* w3 = F.in[I_HW3] + (size_t)l * 64 * 1024 + col;
            for (int k = 0; k < 64; ++k) { const float wv = w3[(size_t)k * 1024];
#pragma unroll
                for (int p = 0; p < 32; ++p) a[p] += h2[p * 64 + k] * wv; }
            const float b3 = F.in[I_HB3][l * 1024 + col], dec = fabsf(F.in[I_HDEC][((size_t)(l * 2 + o) * 2 + dir) * 256 + ch]);
            const float skip = F.in[I_HSKIP][(l * 2 + o) * 256 + ch];
            bf16_t* R = lat ? (bf16_t*)(F.ws + WS_HYF) + ((size_t)(l * 2 + o) * 256 + ch) * 8192 : (bf16_t*)(F.ws + WS_HYFC) + ((size_t)(l * 2 + o) * 256 + ch) * 512;
#pragma unroll
            for (int p = 0; p < 32; ++p) { const int n = n0 + p; float v = (a[p] + b3) * __expf(-tt[p] * dec);
                if (dir == 0) { if (n == 0) v += skip; R[L - n] = (bf16_t)f2bf(v); }
                else { if (n == 0) R[0] = 0; else R[L + n] = (bf16_t)f2bf(v); } }
        }
    }
    __syncthreads();
}
__device__ __forceinline__ void p0_init_rows(Frame& F) {
    const int gw = F.wg * NWAVES + F.wave, NGW = F.G * NWAVES;
    for (int row = gw; row < NROW; row += NGW) {
        const float* src = row < NLAT ? F.in[I_X] + (size_t)row * DM : F.in[I_CTX] + (size_t)(row - NLAT) * DM;
        const float* md = mod_ptr(F, 0, row);
        bf16_t* xr = (bf16_t*)(F.ws + WS_XR) + (size_t)row * DM; bf16_t* xm = (bf16_t*)(F.ws + WS_XM) + (size_t)row * DM;
#pragma unroll
        for (int j = 0; j < 4; ++j) { const int c = 4 * F.lane + 256 * j;
            const f32x4 v = *(const GAS f32x4*)(src + c), sh = *(const GAS f32x4*)(md + c), sc = *(const GAS f32x4*)(md + 1024 + c);
            *(GAS u32x2*)(xr + c) = (u32x2){pk2(v[0], v[1]), pk2(v[2], v[3])};
            u32x2 w; w.x = pk2(v[0] * (1.f + sc[0]) + sh[0], v[1] * (1.f + sc[1]) + sh[1]); w.y = pk2(v[2] * (1.f + sc[2]) + sh[2], v[3] * (1.f + sc[3]) + sh[3]);
            *(GAS u32x2*)(xm + c) = w; }
    }
}
__device__ __forceinline__ void p_expert_weights(Frame& F, int l) {
    LAS float* scr = (LAS float*)(F.lds + F.wave * 16384);
    const int gw = F.wg * NWAVES + F.wave, NGW = F.G * NWAVES;
    constexpr int I1 = 16 * 8, I2 = 4 * 32, PER_E = 2 * I1 + I2;
    for (int it = gw; it < NE1 * PER_E; it += NGW) {
        const int e = it / PER_E; int r = it % PER_E;
        bf16_t* d1 = (bf16_t*)(F.ws + WS_EXP1) + (size_t)e * 512 * DM; bf16_t* d2 = (bf16_t*)(F.ws + WS_EXP2) + (size_t)e * DM * EH;
        if (r < 2 * I1) { const int up = r >= I1; if (up) r -= I1; const int kb = r / 8, nb = r % 8;
            const float* src = e < NEXP ? F.in[up ? I_WEU : I_WEG] + ((size_t)l * NEXP + e) * DM * EH : F.in[up ? I_WSU : I_WSG] + (size_t)l * DM * EH;
            tr_item(src, EH, kb * 64, nb * 32, d1, DM, RowGU{up}, scr, F.lane); }
        else { r -= 2 * I1; const int kb = r / 32, nb = r % 32;
            const float* src = e < NEXP ? F.in[I_WED] + ((size_t)l * NEXP + e) * EH * DM : F.in[I_WSD] + (size_t)l * EH * DM;
            tr_item(src, DM, kb * 64, nb * 32, d2, EH, RowId{}, scr, F.lane); }
    }
}

__device__ __forceinline__ f32x4 mfma16(bf16x8 a, bf16x8 b, f32x4 c) { return __builtin_amdgcn_mfma_f32_16x16x32_bf16(a, b, c, 0, 0, 0); }

__device__ __forceinline__ void ph_transposes(Frame& F, int l) {
    LAS bf16_t* tile = (LAS bf16_t*)(F.lds + F.wave * 16384);
    const bf16_t* U = (const bf16_t*)(F.ws + WS_U);
    const int gw = F.wg * NWAVES + F.wave, NGW = F.G * NWAVES;
    const int rsub = F.lane >> 3, cseg = F.lane & 7;
    for (int u = gw; u < 1088 * 20; u += NGW) {
        const int tt = u / 20, blk = u % 20;
        int b, s0, Ls, rowbase, posbase;
        if (tt < 1024) { b = tt >> 6; s0 = (tt & 63) * 64; Ls = SEQ; rowbase = b * SEQ; posbase = 0; }
        else { const int t2 = tt - 1024; b = t2 >> 2; s0 = (t2 & 3) * 64; Ls = CTXL; rowbase = NLAT + b * CTXL; posbase = SEQ; }
        if (blk < 12) {
            const int c0 = blk * 64 + cseg * 8;
            float w0[8], w1[8], w2[8], bb[8];
#pragma unroll
            for (int i = 0; i < 8; ++i) { w0[i] = F.in[I_HSW][(l * 3 + 0) * 768 + c0 + i]; w1[i] = F.in[I_HSW][(l * 3 + 1) * 768 + c0 + i]; w2[i] = F.in[I_HSW][(l * 3 + 2) * 768 + c0 + i]; bb[i] = F.in[I_HSB][l * 768 + c0 + i]; }
#pragma unroll 2
            for (int it = 0; it < 8; ++it) {
                const int sl = rsub + 8 * it, s = s0 + sl;
                const bf16_t* p = U + (size_t)(rowbase + s) * DIN + UHY + c0;
                const u32x4 zc = *(const u32x4*)p;
                u32x4 zm = (u32x4){0u, 0u, 0u, 0u}, zp = (u32x4){0u, 0u, 0u, 0u};
                if (s > 0) zm = *(const u32x4*)(p - DIN);
                if (s < Ls - 1) zp = *(const u32x4*)(p + DIN);
                const unsigned am[4] = {zm.x, zm.y, zm.z, zm.w}, ac[4] = {zc.x, zc.y, zc.z, zc.w}, ap[4] = {zp.x, zp.y, zp.z, zp.w};
#pragma unroll
                for (int i = 0; i < 4; ++i) {
                    const float v0 = bb[2 * i] + w0[2 * i] * bflo(am[i]) + w1[2 * i] * bflo(ac[i]) + w2[2 * i] * bflo(ap[i]);
                    const float v1 = bb[2 * i + 1] + w0[2 * i + 1] * bfhi(am[i]) + w1[2 * i + 1] * bfhi(ac[i]) + w2[2 * i + 1] * bfhi(ap[i]);
                    tile[(cseg * 8 + 2 * i) * 72 + sl] = (bf16_t)f2bf(v0); tile[(cseg * 8 + 2 * i + 1) * 72 + sl] = (bf16_t)f2bf(v1);
                }
            }
        } else {
            const int c0 = (blk - 12) * 64 + cseg * 8;
#pragma unroll 2
            for (int it = 0; it < 8; ++it) {
                const int sl = rsub + 8 * it, s = s0 + sl;
                const u32x4 zc = *(const u32x4*)(U + (size_t)(rowbase + s) * DIN + UV + c0);
                const unsigned ac[4] = {zc.x, zc.y, zc.z, zc.w};
#pragma unroll
                for (int i = 0; i < 4; ++i) { tile[(cseg * 8 + 2 * i) * 72 + sl] = (bf16_t)(ac[i] & 0xffffu); tile[(cseg * 8 + 2 * i + 1) * 72 + sl] = (bf16_t)(ac[i] >> 16); }
            }
        }
        LDS_WAIT(); asm volatile("" ::: "memory");
#pragma unroll 2
        for (int it = 0; it < 8; ++it) {
            const int ch = rsub + 8 * it;
            const u32x4 v = *(const LAS u32x4*)(tile + ch * 72 + cseg * 8);
            bf16_t* dst;
            if (blk < 12) dst = (bf16_t*)(F.ws + WS_HV) + ((size_t)(blk * 64 + ch) * NB + b) * SPB + posbase + s0 + cseg * 8;
            else dst = (bf16_t*)(F.ws + WS_VT) + ((size_t)b * 512 + (blk - 12) * 64 + ch) * SPB + posbase + s0 + cseg * 8;
            *(u32x4*)dst = v;
        }
        LDS_WAIT(); asm volatile("" ::: "memory");
    }
}

constexpr int NA_RPB = 0, NA_KC = 16384, NA_VC = NA_KC + 256 * 144, NA_END = NA_VC + 64 * 528;
__device__ __forceinline__ bf16x8 gld16(const bf16_t* p) { return *(const GAS bf16x8*)p; }
__device__ __forceinline__ u32x2 gld8(const bf16_t* p) { return *(const GAS u32x2*)p; }
__device__ __forceinline__ const char* uni_ptr(const char* p) { const unsigned long long v = (unsigned long long)p; const unsigned lo = __builtin_amdgcn_readfirstlane((unsigned)v), hi = __builtin_amdgcn_readfirstlane((unsigned)(v >> 32)); return (const char*)(((unsigned long long)hi << 32) | lo); }
__device__ __forceinline__ bf16x8 gld16o(const char* ub, unsigned lo) { return *(const GAS bf16x8*)(ub + (size_t)lo); }
__device__ __forceinline__ u32x2 gld8o(const char* ub, unsigned lo) { return *(const GAS u32x2*)(ub + (size_t)lo); }
template <bool WIN>
__device__ __forceinline__ void na_unit(Frame& F, int b, int h, int r, int strip) {
    const bf16_t* U = (const bf16_t*)(F.ws + WS_U);
    const bf16_t* VT = (const bf16_t*)(F.ws + WS_VT) + ((size_t)b * 512 + h * 64) * SPB;
    const LAS float* rpb = (const LAS float*)(F.lds + NA_RPB);
    const LAS bf16_t* KC = (const LAS bf16_t*)(F.lds + NA_KC); const LAS bf16_t* VC = (const LAS bf16_t*)(F.lds + NA_VC);
    int ln_ = F.lane; asm volatile("" : "+v"(ln_));
    const int i = ln_ & 15, g = ln_ >> 4;
    const int qrow0 = WIN ? (b * SEQ + r * 64 + strip * 16) : (NLAT + b * CTXL + strip * 16);
    const unsigned klo = (unsigned)((i * DIN + 8 * g) * 2), vlo = (unsigned)((i * SPB + 4 * g) * 2);
    const char* qb = uni_ptr((const char*)(U + (size_t)qrow0 * DIN + UQ + h * 64));
    const bf16x8 q0 = gld16o(qb, klo), q1 = gld16o(qb + 64, klo);
    constexpr int NT = WIN ? 32 : 16;
    constexpr int CO = WIN ? 16 : 0;
    f32x4 st[NT];
    int kr0 = 0, u0 = 0;
    if (WIN) { kr0 = r - 4; kr0 = kr0 < 0 ? 0 : (kr0 > 56 ? 56 : kr0); u0 = strip == 0 ? 0 : (strip == 1 ? 8 : (strip == 2 ? 24 : 32)); }
    const char* kbase = uni_ptr((const char*)(U + (size_t)(b * SEQ + kr0 * 64 + u0) * DIN + UK + h * 64));
    const char* vbase = uni_ptr((const char*)(VT + kr0 * 64 + u0));
#define NA_SB() __builtin_amdgcn_sched_barrier(0)
#define NA_KLOAD(buf, grp) do { _Pragma("unroll") for (int t = 0; t < 2; ++t) { const int kt = (grp) * 2 + t; const char* kp = kbase + (size_t)((kt >> 1) * 64 + (kt & 1) * 16) * DIN * 2; buf[t][0] = gld16o(kp, klo); buf[t][1] = gld16o(kp + 64, klo); } } while (0)
#define NA_KMMA(buf, grp) do { _Pragma("unroll") for (int t = 0; t < 2; ++t) { f32x4 a = (f32x4){0.f, 0.f, 0.f, 0.f}; a = mfma16(buf[t][0], q0, a); a = mfma16(buf[t][1], q1, a); st[(grp) * 2 + t] = a; } } while (0)
#define NA_VLOAD(buf, cp) do { _Pragma("unroll") for (int d = 0; d < 4; ++d) { const char* vp = vbase + ((size_t)(d * 16) * SPB + (cp) * 64) * 2; buf[d][0] = gld8o(vp, vlo); buf[d][1] = gld8o(vp + 32, vlo); } } while (0)
#define NA_VMMA(buf, cp) do { const int c = (cp); const f32x4 p0 = st[2 * c], p1 = st[2 * c + 1]; \
        u32x4 pw; pw.x = pk2(p0[0], p0[1]); pw.y = pk2(p0[2], p0[3]); pw.z = pk2(p1[0], p1[1]); pw.w = pk2(p1[2], p1[3]); const bf16x8 pf = __builtin_bit_cast(bf16x8, pw); \
        _Pragma("unroll") for (int d = 0; d < 4; ++d) { const bf16x8 vfr = __builtin_bit_cast(bf16x8, ((u32x4){buf[d][0].x, buf[d][0].y, buf[d][1].x, buf[d][1].y})); o[d] = mfma16(vfr, pf, o[d]); } } while (0)
    bf16x8 ka[2][2], kb[2][2];
    if (WIN) { NA_KLOAD(ka, 0); NA_KLOAD(kb, 1); NA_SB(); }
#pragma unroll
    for (int cg = 0; cg < 8; ++cg) {
        bf16x8 kc[2][2];
#pragma unroll
        for (int t = 0; t < 2; ++t) { const LAS bf16_t* kp = KC + ((cg * 2 + t) * 16 + i) * 72 + 8 * g; kc[t][0] = *(const LAS bf16x8*)kp; kc[t][1] = *(const LAS bf16x8*)(kp + 32); }
#pragma unroll
        for (int t = 0; t < 2; ++t) { f32x4 a = (f32x4){0.f, 0.f, 0.f, 0.f}; a = mfma16(kc[t][0], q0, a); a = mfma16(kc[t][1], q1, a); st[CO + cg * 2 + t] = a; }
        NA_SB();
    }
    u32x2 va[4][2], vb[4][2];
    if (WIN) {
        NA_KMMA(ka, 0); NA_SB(); NA_KLOAD(ka, 2); NA_SB();
        NA_KMMA(kb, 1); NA_SB(); NA_KLOAD(kb, 3); NA_SB();
        NA_KMMA(ka, 2); NA_SB(); NA_KLOAD(ka, 4); NA_SB();
        NA_KMMA(kb, 3); NA_SB(); NA_KLOAD(kb, 5); NA_SB();
        NA_KMMA(ka, 4); NA_SB(); NA_KLOAD(ka, 6); NA_SB();
        NA_KMMA(kb, 5); NA_SB(); NA_KLOAD(kb, 7); NA_SB();
        NA_KMMA(ka, 6); NA_SB(); NA_VLOAD(va, 0); NA_SB();
        NA_KMMA(kb, 7); NA_SB(); NA_VLOAD(vb, 1); NA_SB();
    }
    float mx = -3.0e38f;
    if (WIN) {
        const int c = strip * 16 + i; int kc0 = c - 8; kc0 = kc0 < 0 ? 0 : (kc0 > 48 ? 48 : kc0);
#pragma unroll
        for (int grp = 0; grp < 4; ++grp) {
            float bv[4][4];
#pragma unroll
            for (int t = 0; t < 4; ++t) { const int kt = grp * 4 + t, dr = kr0 + (kt >> 1) - r + 7;
#pragma unroll
                for (int e = 0; e < 4; ++e) { int dc = u0 + (kt & 1) * 16 + 4 * g + e - c + 15; dc = dc < 0 ? 0 : (dc > 30 ? 30 : dc); bv[t][e] = rpb[(h * 15 + dr) * 31 + dc]; } }
#pragma unroll
            for (int t = 0; t < 4; ++t) { const int kt = grp * 4 + t;
#pragma unroll
                for (int e = 0; e < 4; ++e) { const int kc = u0 + (kt & 1) * 16 + 4 * g + e; const bool ok = (kc >= kc0) && (kc < kc0 + 16);
                    const float s = ok ? (st[kt][e] * 0.125f + bv[t][e]) : -3.0e38f; st[kt][e] = s; mx = fmaxf(mx, s); } }
            NA_SB();
        }
    }
#pragma unroll
    for (int ct = 0; ct < 16; ++ct)
#pragma unroll
        for (int e = 0; e < 4; ++e) { const float s = st[CO + ct][e] * 0.125f; st[CO + ct][e] = s; mx = fmaxf(mx, s); }
    mx = fmaxf(mx, shx(mx, 16, ln_)); mx = fmaxf(mx, shx(mx, 32, ln_));
    float sum = 0.f;
#pragma unroll
    for (int t = 0; t < NT; ++t)
#pragma unroll
        for (int e = 0; e < 4; ++e) { const float p = __expf(st[t][e] - mx); st[t][e] = p; sum += p; }
    sum += shx(sum, 16, ln_); sum += shx(sum, 32, ln_);
    const float inv = 1.0f / sum;
    f32x4 o[4];
#pragma unroll
    for (int d = 0; d < 4; ++d) o[d] = (f32x4){0.f, 0.f, 0.f, 0.f};
    NA_SB();
    if (WIN) {
        NA_VMMA(va, 0); NA_SB(); NA_VLOAD(va, 2); NA_SB();
        NA_VMMA(vb, 1); NA_SB(); NA_VLOAD(vb, 3); NA_SB();
        NA_VMMA(va, 2); NA_SB(); NA_VLOAD(va, 4); NA_SB();
        NA_VMMA(vb, 3); NA_SB(); NA_VLOAD(vb, 5); NA_SB();
        NA_VMMA(va, 4); NA_SB(); NA_VLOAD(va, 6); NA_SB();
        NA_VMMA(vb, 5); NA_SB(); NA_VLOAD(vb, 7); NA_SB();
    }
#pragma unroll
    for (int cb = 0; cb < 8; ++cb) {
        u32x2 vc[1][4][2];
#pragma unroll
        for (int cc = 0; cc < 1; ++cc)
#pragma unroll
            for (int d = 0; d < 4; ++d) { const LAS bf16_t* vp = VC + (d * 16 + i) * 264 + (cb + cc) * 32 + 4 * g; vc[cc][d][0] = *(const LAS u32x2*)vp; vc[cc][d][1] = *(const LAS u32x2*)(vp + 16); }
#pragma unroll
        for (int cc = 0; cc < 1; ++cc) { const int c = (WIN ? 8 : 0) + cb + cc; const f32x4 p0 = st[2 * c], p1 = st[2 * c + 1];
            u32x4 pw; pw.x = pk2(p0[0], p0[1]); pw.y = pk2(p0[2], p0[3]); pw.z = pk2(p1[0], p1[1]); pw.w = pk2(p1[2], p1[3]); const bf16x8 pf = __builtin_bit_cast(bf16x8, pw);
#pragma unroll
            for (int d = 0; d < 4; ++d) { const bf16x8 vfr = __builtin_bit_cast(bf16x8, ((u32x4){vc[cc][d][0].x, vc[cc][d][0].y, vc[cc][d][1].x, vc[cc][d][1].y})); o[d] = mfma16(vfr, pf, o[d]); } }
        NA_SB();
    }
    if (WIN) { NA_VMMA(va, 6); NA_SB(); NA_VMMA(vb, 7); NA_SB(); }
    char* op = (char*)uni_ptr((const char*)((bf16_t*)(F.ws + WS_MIX) + (size_t)qrow0 * DM + h * 64)); const unsigned olo = (unsigned)((i * DM + 4 * g) * 2);
#pragma unroll
    for (int d = 0; d < 4; ++d) { u32x2 w; w.x = pk2(o[d][0] * inv, o[d][1] * inv); w.y = pk2(o[d][2] * inv, o[d][3] * inv); *(GAS u32x2*)(op + d * 32 + (size_t)olo) = w; }
#undef NA_SB
#undef NA_KLOAD
#undef NA_KMMA
#undef NA_VLOAD
#undef NA_VMMA
}
__device__ __forceinline__ void ph_na(Frame& F, int l, bool last) {
    LAS float* rpb = (LAS float*)(F.lds + NA_RPB);
    __syncthreads();
    for (int i = F.tid; i < 8 * 15 * 31; i += NTHR) rpb[i] = F.in[I_RPB][(size_t)l * 8 * 15 * 31 + i];
    const bf16_t* U = (const bf16_t*)(F.ws + WS_U);
    for (int job = F.wg; job < NB * 8 * 2; job += F.G) {
        const int half = job & 1, h = (job >> 1) & 7, b = job >> 4;
        __syncthreads();
        { int tz_ = F.tid; asm volatile("" : "+v"(tz_)); const int key = tz_ >> 1, hf = tz_ & 1; const bf16_t* src = U + (size_t)(NLAT + b * CTXL + key) * DIN + UK + h * 64 + hf * 32; LAS bf16_t* dst = (LAS bf16_t*)(F.lds + NA_KC) + key * 72 + hf * 32;
#pragma unroll
          for (int j = 0; j < 4; ++j) *(LAS bf16x8*)(dst + j * 8) = gld16(src + j * 8);
          const int dv = tz_ >> 3, seg = tz_ & 7; const bf16_t* vs = (const bf16_t*)(F.ws + WS_VT) + ((size_t)b * 512 + h * 64 + dv) * SPB + SEQ + seg * 32; LAS bf16_t* vd = (LAS bf16_t*)(F.lds + NA_VC) + dv * 264 + seg * 32;
#pragma unroll
          for (int j = 0; j < 4; ++j) *(LAS bf16x8*)(vd + j * 8) = gld16(vs + j * 8); }
        __syncthreads();
        for (int uu = F.wave; uu < 128; uu += NWAVES) na_unit<true>(F, b, h, half * 32 + (uu >> 2), uu & 3);
        if (!last) na_unit<false>(F, b, h, 0, half * 8 + F.wave);
    }
}

constexpr int GL_LAF = 0, GL_LAB = 8448, GL_Q = 16896, GL_K = 25344;
constexpr int GL_QTF = 33792, GL_KTF = 38912, GL_QTB = 44032, GL_KTB = 49152;
constexpr int GL_KDF = 54272, GL_KDB = 58880;
constexpr int GL_VT = 63488, GL_ATT = 72704;
constexpr int GL_SF = 81920, GL_SB = 87040;
constexpr int GL_O = 92160;
constexpr int GL_SEG = 108800;
__device__ __forceinline__ float log_sigmoid_f(float x) { return fminf(x, 0.f) - log1pf(__expf(-fabsf(x))); }
__device__ __forceinline__ f32x4 mma_lds(const LAS bf16_t* A, int lda, const LAS bf16_t* B, int ldb, int ksteps, f32x4 acc, int lane) {
    const int r = lane & 15, g = lane >> 4;
    for (int ks = 0; ks < ksteps; ++ks) { const bf16x8 a = *(const LAS bf16x8*)(A + r * lda + ks * 32 + 8 * g), b = *(const LAS bf16x8*)(B + r * ldb + ks * 32 + 8 * g); acc = mfma16(a, b, acc); }
    return acc;
}
template <bool FULL>
__device__ __forceinline__ void gla_prep(Frame& F, int l, int b, int cn, int h) {
    const bf16_t* U = (const bf16_t*)(F.ws + WS_U);
    LAS float* LAF = (LAS float*)(F.lds + GL_LAF); LAS float* LAB = (LAS float*)(F.lds + GL_LAB); LAS float* Q = (LAS float*)(F.lds + GL_Q); LAS float* Kk = (LAS float*)(F.lds + GL_K);
    LAS bf16_t* VT = (LAS bf16_t*)(F.lds + GL_VT); LAS float* SEG = (LAS float*)(F.lds + GL_SEG);
    const bool lat = cn >= 4; const int row0 = lat ? b * SEQ + (cn - 4) * 64 : NLAT + b * CTXL + cn * 64;
    const int t = F.tid;
    { const int i = t >> 3, d4 = (t & 7) * 4; const bf16_t* p = U + (size_t)(row0 + i) * DIN;
      const u32x2 wq = *(const u32x2*)(p + UGQ + h * 32 + d4), wk = *(const u32x2*)(p + UGK + h * 32 + d4), wf = *(const u32x2*)(p + ULAF + h * 32 + d4), wb = *(const u32x2*)(p + ULAB + h * 32 + d4);
      const float* ba = F.in[I_BA2] + (size_t)l * 256 + h * 32 + d4;
      const float qs = 0.17677669529663687f;
      Q[i * 33 + d4 + 0] = bflo(wq.x) * qs; Q[i * 33 + d4 + 1] = bfhi(wq.x) * qs; Q[i * 33 + d4 + 2] = bflo(wq.y) * qs; Q[i * 33 + d4 + 3] = bfhi(wq.y) * qs;
      Kk[i * 33 + d4 + 0] = bflo(wk.x); Kk[i * 33 + d4 + 1] = bfhi(wk.x); Kk[i * 33 + d4 + 2] = bflo(wk.y); Kk[i * 33 + d4 + 3] = bfhi(wk.y);
      LAF[i * 33 + d4 + 0] = log_sigmoid_f(bflo(wf.x) + ba[0]) * 0.0625f; LAF[i * 33 + d4 + 1] = log_sigmoid_f(bfhi(wf.x) + ba[1]) * 0.0625f;
      LAF[i * 33 + d4 + 2] = log_sigmoid_f(bflo(wf.y) + ba[2]) * 0.0625f; LAF[i * 33 + d4 + 3] = log_sigmoid_f(bfhi(wf.y) + ba[3]) * 0.0625f;
      LAB[i * 33 + d4 + 0] = log_sigmoid_f(bflo(wb.x) + ba[128]) * 0.0625f; LAB[i * 33 + d4 + 1] = log_sigmoid_f(bfhi(wb.x) + ba[129]) * 0.0625f;
      LAB[i * 33 + d4 + 2] = log_sigmoid_f(bflo(wb.y) + ba[130]) * 0.0625f; LAB[i * 33 + d4 + 3] = log_sigmoid_f(bfhi(wb.y) + ba[131]) * 0.0625f;
      const int dv8 = (t & 7) * 8; const u32x4 wv = *(const u32x4*)(p + UGV + h * 64 + dv8); const unsigned av[4] = {wv.x, wv.y, wv.z, wv.w};
#pragma unroll
      for (int e = 0; e < 4; ++e) { VT[(dv8 + 2 * e) * 72 + i] = (bf16_t)(av[e] & 0xffffu); VT[(dv8 + 2 * e + 1) * 72 + i] = (bf16_t)(av[e] >> 16); }
    }
    __syncthreads();
    if (lat) {
        for (int e = t; e < 64 * 16 * 2; e += NTHR) {
            const int which = e >> 10, i = (e >> 4) & 63, p = e & 15, half = p >> 3, idx = p & 7;
            const float pos = half ? (float)i : (float)(cn - 4);
            const float inv = __expf(-(float)idx * (9.210340371976184f / 8.0f));
            const float sn = __sinf(pos * inv), cs = __cosf(pos * inv);
            LAS float* A = which ? Kk : Q; const int d1 = half * 16 + idx;
            const float x1 = A[i * 33 + d1], x2 = A[i * 33 + d1 + 8];
            A[i * 33 + d1] = x1 * cs - x2 * sn; A[i * 33 + d1 + 8] = x1 * sn + x2 * cs;
        }
    }
    { const int x = t & 63, d = x & 31, dir = x >> 5, seg = t >> 6; LAS float* LA = dir ? LAB : LAF; float run = 0.f;
#pragma unroll
      for (int k = 0; k < 8; ++k) { const int p = seg * 8 + k, i = dir ? 63 - p : p; run += LA[i * 33 + d]; LA[i * 33 + d] = run; }
      SEG[x * 9 + seg] = run;
    }
    __syncthreads();
    { const int x = t & 63, d = x & 31, dir = x >> 5, seg = t >> 6; LAS float* LA = dir ? LAB : LAF; float pre = 0.f;
      for (int s2 = 0; s2 < seg; ++s2) pre += SEG[x * 9 + s2];
#pragma unroll
      for (int k = 0; k < 8; ++k) { const int p = seg * 8 + k, i = dir ? 63 - p : p; LA[i * 33 + d] += pre; }
    }
    __syncthreads();
    LAS bf16_t* QTF = (LAS bf16_t*)(F.lds + GL_QTF); LAS bf16_t* KTF = (LAS bf16_t*)(F.lds + GL_KTF); LAS bf16_t* QTB = (LAS bf16_t*)(F.lds + GL_QTB); LAS bf16_t* KTB = (LAS bf16_t*)(F.lds + GL_KTB);
    LAS bf16_t* KDF = (LAS bf16_t*)(F.lds + GL_KDF); LAS bf16_t* KDB = (LAS bf16_t*)(F.lds + GL_KDB);
    for (int e = t; e < 64 * 32; e += NTHR) {
        const int i = e >> 5, d = e & 31;
        const float bf = LAF[i * 33 + d], bb = LAB[i * 33 + d], bfl = LAF[63 * 33 + d], bbl = LAB[0 * 33 + d], kv = Kk[i * 33 + d];
        KDF[d * 72 + i] = (bf16_t)f2bf(kv * __expf(bfl - bf)); KDB[d * 72 + i] = (bf16_t)f2bf(kv * __expf(bbl - bb));
        if (FULL) { const float qv = Q[i * 33 + d];
            QTF[i * 40 + d] = (bf16_t)f2bf(qv * __expf(bf)); KTF[i * 40 + d] = (bf16_t)f2bf(kv * __expf(-bf));
            QTB[i * 40 + d] = (bf16_t)f2bf(qv * __expf(bb)); KTB[i * 40 + d] = (bf16_t)f2bf(kv * __expf(-bb)); }
    }
    __syncthreads();
}
__device__ __forceinline__ void ph_gla_local(Frame& F, int l) {
    LAS float* LAF = (LAS float*)(F.lds + GL_LAF); LAS float* LAB = (LAS float*)(F.lds + GL_LAB);
    for (int u = F.wg; u < NB * 68 * 4; u += F.G) {
        const int h = u & 3, cn = (u >> 2) % 68, b = (u >> 2) / 68;
        __syncthreads();
        gla_prep<false>(F, l, b, cn, h);
        const int mt = F.wave >> 1, nt = F.wave & 1, g = F.lane >> 4, c = F.lane & 15;
        float* DS = (float*)(F.ws + WS_GDS) + (size_t)u * 2 * 2048;
#pragma unroll
        for (int dir = 0; dir < 2; ++dir) {
            const LAS bf16_t* KD = (const LAS bf16_t*)(F.lds + (dir ? GL_KDB : GL_KDF));
            f32x4 a = (f32x4){0.f, 0.f, 0.f, 0.f};
            a = mma_lds((const LAS bf16_t*)(F.lds + GL_VT) + mt * 16 * 72, 72, KD + nt * 16 * 72, 72, 2, a, F.lane);
#pragma unroll
            for (int e = 0; e < 4; ++e) DS[dir * 2048 + (mt * 16 + 4 * g + e) * 32 + nt * 16 + c] = a[e];
        }
        if (F.tid < 64) { const int d = F.tid & 31, dir = F.tid >> 5; ((float*)(F.ws + WS_GD))[(size_t)u * 64 + F.tid] = __expf(dir ? LAB[0 * 33 + d] : LAF[63 * 33 + d]); }
    }
}
__device__ __forceinline__ void ph_gla_scan(Frame& F) {
    const int gt = F.wg * NTHR + F.tid, NGT = F.G * NTHR;
    const float* DS = (const float*)(F.ws + WS_GDS); const float* GD = (const float*)(F.ws + WS_GD); bf16_t* SIN = (bf16_t*)(F.ws + WS_GSIN);
    for (int w = gt; w < 128 * 1024; w += NGT) {
        const int chain = w >> 10, el = (w & 1023) * 2, dir = chain & 1, h = (chain >> 1) & 3, b = chain >> 3, d = el & 31;
        float s0 = 0.f, s1 = 0.f;
        for (int step = 0; step < 68; ++step) {
            const int cn = dir ? (step < 4 ? 3 - step : 71 - step) : step;
            const size_t u = (size_t)(b * 68 + cn) * 4 + h;
            *(unsigned*)(SIN + (u * 2 + dir) * 2048 + el) = pk2(s0, s1);
            const f32x2 ds = *(const f32x2*)(DS + (u * 2 + dir) * 2048 + el); const f32x2 dd = *(const f32x2*)(GD + u * 64 + dir * 32 + d);
            s0 = dd.x * s0 + ds.x; s1 = dd.y * s1 + ds.y;
        }
    }
}
__device__ __forceinline__ void ph_gla_out(Frame& F, int l, bool last) {
    const bf16_t* U = (const bf16_t*)(F.ws + WS_U);
    for (int u = F.wg; u < NB * 68 * 4; u += F.G) {
        const int h = u & 3, cn = (u >> 2) % 68, b = (u >> 2) / 68;
        if (last && cn < 4) continue;
        __syncthreads();
        gla_prep<true>(F, l, b, cn, h);
        const int t = F.tid;
        { const bf16_t* SIN = (const bf16_t*)(F.ws + WS_GSIN) + (size_t)u * 2 * 2048;
          for (int e = t; e < 2 * 64 * 4; e += NTHR) { const int dir = e >> 8, dv = (e >> 2) & 63, d8 = (e & 3) * 8;
              const u32x4 v = *(const u32x4*)(SIN + dir * 2048 + dv * 32 + d8); *(LAS u32x4*)((LAS bf16_t*)(F.lds + (dir ? GL_SB : GL_SF)) + dv * 40 + d8) = v; } }
        const int g = F.lane >> 4, c = F.lane & 15;
        LAS bf16_t* ATT = (LAS bf16_t*)(F.lds + GL_ATT);
#pragma unroll
        for (int k = 0; k < 2; ++k) { const int tile = F.wave + 8 * k, mt = tile >> 2, nt = tile & 3;
            f32x4 af = (f32x4){0.f, 0.f, 0.f, 0.f}, ab = af;
            af = mma_lds((const LAS bf16_t*)(F.lds + GL_QTF) + mt * 16 * 40, 40, (const LAS bf16_t*)(F.lds + GL_KTF) + nt * 16 * 40, 40, 1, af, F.lane);
            ab = mma_lds((const LAS bf16_t*)(F.lds + GL_QTB) + mt * 16 * 40, 40, (const LAS bf16_t*)(F.lds + GL_KTB) + nt * 16 * 40, 40, 1, ab, F.lane);
#pragma unroll
            for (int e = 0; e < 4; ++e) { const int i = mt * 16 + 4 * g + e, j = nt * 16 + c; const float v = (j <= i ? af[e] : 0.f) + (j >= i ? ab[e] : 0.f); ATT[i * 72 + j] = (bf16_t)f2bf(v); } }
        __syncthreads();
        LAS float* O = (LAS float*)(F.lds + GL_O);
#pragma unroll
        for (int k = 0; k < 2; ++k) { const int tile = F.wave + 8 * k, mt = tile >> 2, nt = tile & 3;
            f32x4 a = (f32x4){0.f, 0.f, 0.f, 0.f};
            a = mma_lds(ATT + mt * 16 * 72, 72, (const LAS bf16_t*)(F.lds + GL_VT) + nt * 16 * 72, 72, 2, a, F.lane);
            a = mma_lds((const LAS bf16_t*)(F.lds + GL_QTF) + mt * 16 * 40, 40, (const LAS bf16_t*)(F.lds + GL_SF) + nt * 16 * 40, 40, 1, a, F.lane);
            a = mma_lds((const LAS bf16_t*)(F.lds + GL_QTB) + mt * 16 * 40, 40, (const LAS bf16_t*)(F.lds + GL_SB) + nt * 16 * 40, 40, 1, a, F.lane);
#pragma unroll
            for (int e = 0; e < 4; ++e) O[(mt * 16 + 4 * g + e) * 65 + nt * 16 + c] = a[e]; }
        __syncthreads();
        { const int i = t >> 3, dv8 = (t & 7) * 8; const bool lat = cn >= 4; const int row = (lat ? b * SEQ + (cn - 4) * 64 : NLAT + b * CTXL + cn * 64) + i;
          float v[8]; float ss = 0.f;
#pragma unroll
          for (int e = 0; e < 8; ++e) { v[e] = O[i * 65 + dv8 + e]; ss += v[e] * v[e]; }
          ss += shx(ss, 1, F.lane); ss += shx(ss, 2, F.lane); ss += shx(ss, 4, F.lane);
          const float rs = 1.0f / sqrtf(ss * (1.0f / 64.0f) + LN_EPS);
          const u32x4 gw = *(const u32x4*)(U + (size_t)row * DIN + UGR + h * 64 + dv8); const unsigned ga[4] = {gw.x, gw.y, gw.z, gw.w};
          const float* gn = F.in[I_GNORM] + l * 64 + dv8;
          float o[8];
#pragma unroll
          for (int e = 0; e < 4; ++e) { o[2 * e] = v[2 * e] * rs * gn[2 * e] * silu_f(bflo(ga[e])); o[2 * e + 1] = v[2 * e + 1] * rs * gn[2 * e + 1] * silu_f(bfhi(ga[e])); }
          u32x4 w; w.x = pk2(o[0], o[1]); w.y = pk2(o[2], o[3]); w.z = pk2(o[4], o[5]); w.w = pk2(o[6], o[7]);
          *(u32x4*)((bf16_t*)(F.ws + WS_MIX) + (size_t)row * DM + 512 + h * 64 + dv8) = w; }
    }
}

template <int L>
__device__ __forceinline__ void hyena_conv(Frame& F, const bf16_t* Rg, const bf16_t* Uin, const bf16_t* Xmul, int pos0, bool final_out, int ch, bf16_t* Zout) {
    constexpr int CS = 2 * L + 16;
    constexpr int NTL = L / 16, J = (NTL >= 64) ? 16 : 2, NGRP = NTL / J, HJ = J / 2, NSTEP = L / 32;
    LAS bf16_t* Rl = (LAS bf16_t*)F.lds;
    __syncthreads();
    for (int c = F.tid; c < 2 * L / 8; c += NTHR) { const u32x4 v = *(const GAS u32x4*)(Rg + 8 * c); const unsigned a[4] = {v.x, v.y, v.z, v.w};
#pragma unroll
        for (int rho = 0; rho < 8; ++rho) { LAS bf16_t* d = Rl + rho * CS + 8 * c + rho;
#pragma unroll
            for (int k = 0; k < 4; ++k) { d[2 * k] = (bf16_t)(a[k] & 0xffffu); d[2 * k + 1] = (bf16_t)(a[k] >> 16); } } }
    __syncthreads();
    int ln_ = F.lane; asm volatile("" : "+v"(ln_));
    const int i = ln_ & 15, g = ln_ >> 4, rho = i & 7;
    const LAS bf16_t* Rc = Rl + rho * CS + rho;
    for (int grp = F.wave; grp < NGRP; grp += NWAVES) {
        f32x4 acc[J]; bf16x8 fr[J];
        const int tb = grp * J * 16;
        const LAS bf16_t* Rb = Rc + (L - tb - i + 8 * g);
#pragma unroll
        for (int j = 0; j < J; ++j) { acc[j] = (f32x4){0.f, 0.f, 0.f, 0.f}; fr[j] = *(const LAS bf16x8*)(Rb - 16 * j); }
        const char* ub = (const char*)(Uin + pos0); const unsigned ulo = (unsigned)((i * SPB + 8 * g) * 2);
        bf16x8 bcur = *(const GAS bf16x8*)(ub + (size_t)ulo);
#pragma unroll 1
        for (int q = 0; q < NSTEP / HJ; ++q) {
#pragma unroll
            for (int m = 0; m < HJ; ++m) {
                const int n = q * HJ + m;
                const int nn = (n + 1 < NSTEP) ? n + 1 : 0;
                const bf16x8 bnext = *(const GAS bf16x8*)(ub + (size_t)(ulo + (unsigned)nn * 64u));
                if (n > 0) { fr[(J - 2 * m) % J] = *(const LAS bf16x8*)(Rb + 32 * n); fr[(J + 1 - 2 * m) % J] = *(const LAS bf16x8*)(Rb + 32 * n - 16); }
#pragma unroll
                for (int j = 0; j < J; ++j) acc[j] = mfma16(fr[(j + J - 2 * m) % J], bcur, acc[j]);
                bcur = bnext;
            }
        }
#pragma unroll
        for (int j = 0; j < J; ++j) { const int t0 = tb + j * 16 + 4 * g;
            const u32x2 xw = *(const GAS u32x2*)(Xmul + (size_t)i * SPB + pos0 + t0);
            const float y0 = acc[j][0] * bflo(xw.x), y1 = acc[j][1] * bfhi(xw.x), y2 = acc[j][2] * bflo(xw.y), y3 = acc[j][3] * bfhi(xw.y);
            if (!final_out) { u32x2 w; w.x = pk2(y0, y1); w.y = pk2(y2, y3); *(GAS u32x2*)(Zout + (size_t)i * SPB + pos0 + t0) = w; }
            else { const int row = (pos0 ? NLAT + i * CTXL : i * SEQ) + t0; GAS bf16_t* mp = (GAS bf16_t*)((bf16_t*)(F.ws + WS_MIX) + (size_t)row * DM + 768 + ch);
                mp[0] = (bf16_t)f2bf(y0); mp[DM] = (bf16_t)f2bf(y1); mp[2 * DM] = (bf16_t)f2bf(y2); mp[3 * DM] = (bf16_t)f2bf(y3); } }
    }
}
__device__ __forceinline__ void ph_hyena(Frame& F, int l, bool last) {
    const bf16_t* HV = (const bf16_t*)(F.ws + WS_HV); bf16_t* Z2 = (bf16_t*)(F.ws + WS_Z2);
    for (int ch = F.wg; ch < 256; ch += F.G) {
        const bf16_t* v = HV + (size_t)(0 * 256 + ch) * NB * SPB; const bf16_t* x1 = HV + (size_t)(256 + ch) * NB * SPB; const bf16_t* x2 = HV + (size_t)(512 + ch) * NB * SPB;
        bf16_t* z = Z2 + (size_t)ch * NB * SPB;
        const bf16_t* R0 = (const bf16_t*)(F.ws + WS_HYF) + ((size_t)(l * 2 + 0) * 256 + ch) * 8192; const bf16_t* R1 = (const bf16_t*)(F.ws + WS_HYF) + ((size_t)(l * 2 + 1) * 256 + ch) * 8192;
        hyena_conv<4096>(F, R0, v, x1, 0, false, ch, z);
        VM_WAIT(); __syncthreads(); __builtin_amdgcn_fence(__ATOMIC_ACQUIRE, "agent"); VM_WAIT();
        hyena_conv<4096>(F, R1, z, x2, 0, true, ch, z);
        if (!last) {
            const bf16_t* C0 = (const bf16_t*)(F.ws + WS_HYFC) + ((size_t)(l * 2 + 0) * 256 + ch) * 512; const bf16_t* C1 = (const bf16_t*)(F.ws + WS_HYFC) + ((size_t)(l * 2 + 1) * 256 + ch) * 512;
            hyena_conv<256>(F, C0, v, x1, SEQ, false, ch, z);
            VM_WAIT(); __syncthreads(); __builtin_amdgcn_fence(__ATOMIC_ACQUIRE, "agent"); VM_WAIT();
            hyena_conv<256>(F, C1, z, x2, SEQ, true, ch, z);
        }
    }
}

__device__ __forceinline__ void unpack8(const u32x4 q, float* o) { o[0] = bflo(q.x); o[1] = bfhi(q.x); o[2] = bflo(q.y); o[3] = bfhi(q.y); o[4] = bflo(q.z); o[5] = bfhi(q.z); o[6] = bflo(q.w); o[7] = bfhi(q.w); }
__device__ __forceinline__ void ph_ln1(Frame& F, int l, int ntok) {
    const int gw = F.wg * NWAVES + F.wave, NGW = F.G * NWAVES;
    const float* lg = F.in[I_LN1G] + l * DM + 16 * F.lane; const float* lb = F.in[I_LN1B] + l * DM + 16 * F.lane;
    for (int row = gw; row < ntok; row += NGW) {
        bf16_t* xr = (bf16_t*)(F.ws + WS_XR) + (size_t)row * DM + 16 * F.lane;
        const bf16_t* yr = (const bf16_t*)(F.ws + WS_Y) + (size_t)row * DM + 16 * F.lane;
        const float* md = mod_ptr(F, l, row) + 16 * F.lane;
        bf16_t* xm = (bf16_t*)(F.ws + WS_XM) + (size_t)row * DM + 16 * F.lane;
        const u32x4 xa = *(const GAS u32x4*)xr, xb = *(const GAS u32x4*)(xr + 8), ya = *(const GAS u32x4*)yr, yb = *(const GAS u32x4*)(yr + 8);
        float x[16], y[16], v[16]; unpack8(xa, x); unpack8(xb, x + 8); unpack8(ya, y); unpack8(yb, y + 8);
        float s = 0.f;
#pragma unroll
        for (int j = 0; j < 4; ++j) { const f32x4 g1 = *(const GAS f32x4*)(md + 2048 + 4 * j);
#pragma unroll
            for (int e = 0; e < 4; ++e) { v[4 * j + e] = x[4 * j + e] * DN_ALPHA + g1[e] * y[4 * j + e]; s += v[4 * j + e]; } }
        const float mean = wave_sum(s, F.lane) * (1.f / DM); float s2 = 0.f;
#pragma unroll
        for (int e = 0; e < 16; ++e) { v[e] -= mean; s2 += v[e] * v[e]; }
        const float rstd = 1.f / sqrtf(wave_sum(s2, F.lane) * (1.f / DM) + LN_EPS);
        unsigned wx[8], wm[8];
#pragma unroll
        for (int j = 0; j < 4; ++j) { const f32x4 g = *(const GAS f32x4*)(lg + 4 * j), bb = *(const GAS f32x4*)(lb + 4 * j), sh = *(const GAS f32x4*)(md + 3072 + 4 * j), sc = *(const GAS f32x4*)(md + 4096 + 4 * j);
            float xn[4];
#pragma unroll
            for (int e = 0; e < 4; ++e) xn[e] = v[4 * j + e] * rstd * g[e] + bb[e];
            wx[2 * j] = pk2(xn[0], xn[1]); wx[2 * j + 1] = pk2(xn[2], xn[3]);
            wm[2 * j] = pk2(xn[0] * (1.f + sc[0]) + sh[0], xn[1] * (1.f + sc[1]) + sh[1]); wm[2 * j + 1] = pk2(xn[2] * (1.f + sc[2]) + sh[2], xn[3] * (1.f + sc[3]) + sh[3]); }
        *(GAS u32x4*)xr = (u32x4){wx[0], wx[1], wx[2], wx[3]}; *(GAS u32x4*)(xr + 8) = (u32x4){wx[4], wx[5], wx[6], wx[7]};
        *(GAS u32x4*)xm = (u32x4){wm[0], wm[1], wm[2], wm[3]}; *(GAS u32x4*)(xm + 8) = (u32x4){wm[4], wm[5], wm[6], wm[7]};
    }
}
__device__ __forceinline__ void ph_ln2(Frame& F, int l, int ntok, bool last) {
    const int gw = F.wg * NWAVES + F.wave, NGW = F.G * NWAVES;
    const float* lg = F.in[I_LN2G] + l * DM; const float* lb = F.in[I_LN2B] + l * DM;
    for (int row = gw; row < ntok; row += NGW) {
        bf16_t* xr = (bf16_t*)(F.ws + WS_XR) + (size_t)row * DM + 16 * F.lane;
        const unsigned char* y2 = (const unsigned char*)(F.ws + WS_Y2) + (size_t)row * 9 * DM + 16 * F.lane;
        const float* wg = (const float*)(F.ws + WS_WGT) + (size_t)row * 8;
        const float* md = mod_ptr(F, l, row) + 16 * F.lane;
        float ff[16];
#pragma unroll
        for (int e = 0; e < 16; ++e) ff[e] = 0.f;
        u32x4 q[9];
#pragma unroll
        for (int k = 0; k < 9; ++k) q[k] = *(const GAS u32x4*)(y2 + (size_t)k * DM);
#pragma unroll
        for (int k = 0; k < 9; ++k) { const float wk = (k < 8 ? wg[k] : 1.0f) * pg8::Y2_INV; const unsigned a[4] = {q[k].x, q[k].y, q[k].z, q[k].w};
#pragma unroll
            for (int e = 0; e < 4; ++e) { const f32x2 lo = __builtin_amdgcn_cvt_pk_f32_fp8((int)a[e], false), hi = __builtin_amdgcn_cvt_pk_f32_fp8((int)a[e], true);
                ff[4 * e] += wk * lo.x; ff[4 * e + 1] += wk * lo.y; ff[4 * e + 2] += wk * hi.x; ff[4 * e + 3] += wk * hi.y; } }
        float v[16], xo[16]; float s = 0.f;
        { const u32x4 xa = *(const GAS u32x4*)xr, xb = *(const GAS u32x4*)(xr + 8); unpack8(xa, xo); unpack8(xb, xo + 8); }
#pragma unroll
        for (int j = 0; j < 4; ++j) { const f32x4 g2 = *(const GAS f32x4*)(md + 5120 + 4 * j);
#pragma unroll
            for (int e = 0; e < 4; ++e) { v[4 * j + e] = xo[4 * j + e] * DN_ALPHA + g2[e] * ff[4 * j + e]; s += v[4 * j + e]; } }
        const float mean = wave_sum(s, F.lane) * (1.f / DM); float s2 = 0.f;
#pragma unroll
        for (int e = 0; e < 16; ++e) { v[e] -= mean; s2 += v[e] * v[e]; }
        const float rstd = 1.f / sqrtf(wave_sum(s2, F.lane) * (1.f / DM) + LN_EPS);
        const float* mdn = (last ? mod_ptr(F, l, row) : mod_ptr(F, l + 1, row)) + 16 * F.lane;
        bf16_t* xm = (bf16_t*)(F.ws + WS_XM) + (size_t)row * DM + 16 * F.lane;
        float xn[16];
#pragma unroll
        for (int j = 0; j < 4; ++j) { const f32x4 g = *(const GAS f32x4*)(lg + 16 * F.lane + 4 * j), bb = *(const GAS f32x4*)(lb + 16 * F.lane + 4 * j);
#pragma unroll
            for (int e = 0; e < 4; ++e) xn[4 * j + e] = v[4 * j + e] * rstd * g[e] + bb[e]; }
        if (last) { float* op = F.out + (size_t)row * DM + 16 * F.lane;
#pragma unroll
            for (int j = 0; j < 4; ++j) *(GAS f32x4*)(op + 4 * j) = (f32x4){xn[4 * j], xn[4 * j + 1], xn[4 * j + 2], xn[4 * j + 3]}; }
        else { *(GAS u32x4*)xr = (u32x4){pk2(xn[0], xn[1]), pk2(xn[2], xn[3]), pk2(xn[4], xn[5]), pk2(xn[6], xn[7])}; *(GAS u32x4*)(xr + 8) = (u32x4){pk2(xn[8], xn[9]), pk2(xn[10], xn[11]), pk2(xn[12], xn[13]), pk2(xn[14], xn[15])}; }
        if (!last) {
            unsigned w[8];
#pragma unroll
            for (int j = 0; j < 4; ++j) { const f32x4 sh = *(const GAS f32x4*)(mdn + 4 * j), sc = *(const GAS f32x4*)(mdn + 1024 + 4 * j);
                w[2 * j] = pk2(xn[4 * j] * (1.f + sc[0]) + sh[0], xn[4 * j + 1] * (1.f + sc[1]) + sh[1]); w[2 * j + 1] = pk2(xn[4 * j + 2] * (1.f + sc[2]) + sh[2], xn[4 * j + 3] * (1.f + sc[3]) + sh[3]); }
            *(GAS u32x4*)xm = (u32x4){w[0], w[1], w[2], w[3]}; *(GAS u32x4*)(xm + 8) = (u32x4){w[4], w[5], w[6], w[7]};
        }
    }
}

__device__ __forceinline__ unsigned f_ord(float f) { const unsigned u = __builtin_bit_cast(unsigned, f); return (u & 0x80000000u) ? ~u : (u | 0x80000000u); }
__device__ __forceinline__ unsigned long long wave_max_u64(unsigned long long v, int lane) {
#pragma unroll
    for (int o = 1; o < 64; o <<= 1) { const unsigned lo = (unsigned)shxi((int)(unsigned)v, o, lane), hi = (unsigned)shxi((int)(unsigned)(v >> 32), o, lane); const unsigned long long w = ((unsigned long long)hi << 32) | lo; v = w > v ? w : v; }
    return v;
}
__device__ __forceinline__ float seg16_max(float v, int lane) { v = fmaxf(v, shx(v, 1, lane)); v = fmaxf(v, shx(v, 2, lane)); v = fmaxf(v, shx(v, 4, lane)); v = fmaxf(v, shx(v, 8, lane)); return v; }
__device__ __forceinline__ int seg16_min_i(int v, int lane) { int w; w = shxi(v, 1, lane); v = w < v ? w : v; w = shxi(v, 2, lane); v = w < v ? w : v; w = shxi(v, 4, lane); v = w < v ? w : v; w = shxi(v, 8, lane); v = w < v ? w : v; return v; }
__device__ __forceinline__ float seg16_top2(float v, int lane) {
    const float m1 = seg16_max(v, lane);
    const int first = seg16_min_i(v == m1 ? (lane & 15) : 99, lane);
    const float m2 = seg16_max((lane & 15) == first ? -3.0e38f : v, lane);
    return m1 + m2;
}
__device__ __forceinline__ void ph_route(Frame& F, int l, int ntok) {
    LAS int* hist = (LAS int*)F.lds;
    LAS int* base = hist + 128;
    LAS unsigned* alist = (LAS unsigned*)(F.lds + 1024);
    const int tpw = (ntok + F.G - 1) / F.G, t0 = F.wg * tpw, t1 = (t0 + tpw) < ntok ? (t0 + tpw) : ntok;
    __syncthreads();
    if (F.tid < 128) hist[F.tid] = 0;
    __syncthreads();
    const float* LG = (const float*)(F.ws + WS_LOGIT); const float* rb = F.in[I_RB] + l * NEXP;
    const float b0 = rb[F.lane], b1 = rb[F.lane + 64];
    for (int tok = t0 + F.wave; tok < t1; tok += NWAVES) {
        const float x0 = LG[(size_t)tok * 256 + F.lane], x1 = LG[(size_t)tok * 256 + 64 + F.lane];
        const float s0 = 1.0f / (1.0f + __expf(-x0)), s1 = 1.0f / (1.0f + __expf(-x1));
        const float e0 = s0 + b0, e1 = s1 + b1;
        const float gs0 = seg16_top2(e0, F.lane), gs1 = seg16_top2(e1, F.lane);
        float gsc[8];
#pragma unroll
        for (int g = 0; g < 4; ++g) { gsc[g] = shf(gs0, g * 16); gsc[4 + g] = shf(gs1, g * 16); }
        unsigned gmask = 0u;
#pragma unroll
        for (int g = 0; g < 8; ++g) { int cnt = 0;
#pragma unroll
            for (int g2 = 0; g2 < 8; ++g2) cnt += (gsc[g2] > gsc[g] || (gsc[g2] == gsc[g] && g2 < g)) ? 1 : 0;
            gmask |= (cnt < 4) ? (1u << g) : 0u; }
        const bool ok0 = (gmask >> (F.lane >> 4)) & 1u, ok1 = (gmask >> (4 + (F.lane >> 4))) & 1u;
        unsigned long long k0 = ok0 ? (((unsigned long long)f_ord(e0) << 32) | (unsigned)(255 - F.lane)) : 0ull;
        unsigned long long k1 = ok1 ? (((unsigned long long)f_ord(e1) << 32) | (unsigned)(255 - 64 - F.lane)) : 0ull;
        int mye = 0; float myw = 0.f; float wsum = 0.f;
#pragma unroll
        for (int k = 0; k < 8; ++k) {
            const unsigned long long best = wave_max_u64(k0 > k1 ? k0 : k1, F.lane);
            const int e = 255 - (int)(best & 0xffu);
            if (k0 == best) k0 = 0ull; if (k1 == best) k1 = 0ull;
            const float sv = shf(e < 64 ? s0 : s1, e & 63);
            wsum += sv; if (F.lane == k) { mye = e; myw = sv; }
        }
        if (F.lane < 8) {
            const int lr = __hip_atomic_fetch_add(&hist[mye], 1, __ATOMIC_RELAXED, __HIP_MEMORY_SCOPE_WORKGROUP);
            alist[(tok - t0) * 8 + F.lane] = (unsigned)mye | ((unsigned)lr << 8);
            ((int*)(F.ws + WS_EIDX))[(size_t)tok * 8 + F.lane] = mye;
            ((float*)(F.ws + WS_WGT))[(size_t)tok * 8 + F.lane] = myw / wsum * 2.5f;
        }
    }
    __syncthreads();
    if (F.tid < 128) { const int hcount = hist[F.tid]; base[F.tid] = hcount ? (int)atomicAdd(F.ctl + CW_CNT + l * 256 + F.tid, (unsigned)hcount) : 0; }
    __syncthreads();
    for (int a = F.tid; a < (t1 - t0) * 8; a += NTHR) { const unsigned v = alist[a]; ((int*)(F.ws + WS_RNK))[(size_t)t0 * 8 + a] = base[v & 0xffu] + (int)(v >> 8); }
}
__device__ __forceinline__ void ph_positions(Frame& F, int l, int ntok) {
    LAS int* cnt = (LAS int*)F.lds;
    LAS int* off = cnt + 132;
    __syncthreads();
    if (F.tid < NE1) cnt[F.tid] = F.tid < NEXP ? (int)__hip_atomic_load(F.ctl + CW_CNT + l * 256 + F.tid, __ATOMIC_RELAXED, __HIP_MEMORY_SCOPE_AGENT) : ntok;
    __syncthreads();
    if (F.tid == 0) { int o = 0; for (int e = 0; e < NE1; ++e) { off[e] = o; o += (cnt[e] + 255) & ~255; } off[NE1] = o; }
    __syncthreads();
    const int gt = F.wg * NTHR + F.tid, NGT = F.G * NTHR;
    int* rowtok = (int*)(F.ws + WS_ROWTOK); int* rowdst = (int*)(F.ws + WS_ROWDST); int* tile_exp = (int*)(F.ws + WS_TILEEXP);
    const int* eidx = (const int*)(F.ws + WS_EIDX); const int* rnk = (const int*)(F.ws + WS_RNK);
    for (int a = gt; a < ntok * 8; a += NGT) { const int tok = a >> 3, k = a & 7; const int pos = off[eidx[a]] + rnk[a]; rowtok[pos] = tok; rowdst[pos] = tok * 9 + k; }
    for (int tok = gt; tok < ntok; tok += NGT) { const int pos = off[NEXP] + tok; rowtok[pos] = tok; rowdst[pos] = tok * 9 + 8; }
    for (int i = gt; i < NE1 * 256; i += NGT) { const int e = i >> 8, p = i & 255; const int row = off[e] + cnt[e] + p; if (row < off[e + 1]) { rowtok[row] = 0; rowdst[row] = -1; } }
    for (int i = gt; i < NE1 * 320; i += NGT) { const int e = i / 320, p = i % 320; const int t = (off[e] >> 8) + p; if (t < (off[e + 1] >> 8)) tile_exp[t] = e; }
    if (gt == 0) F.ctl[CW_NTL + l] = (unsigned)(off[NE1] >> 8);
}

#ifndef MK_MULTI
#define MK_MULTI 0
#endif
constexpr int PH_PER_LAYER = 12, NPHASE = 2 + DEPTH * PH_PER_LAYER;
struct Args { const float* in[36]; float* out; unsigned char* ws; int ph_lo, ph_hi; };

__global__ void __launch_bounds__(NTHR, 2) mk_fwd(Args args) {
    extern __shared__ __attribute__((aligned(16))) unsigned char lds_raw[];
    Frame F;
    F.lds = (LAS unsigned char*)lds_raw;
    F.tid = threadIdx.x; F.lane = F.tid & 63; F.wave = __builtin_amdgcn_readfirstlane(F.tid >> 6);
    const int wave0 = F.wave;
    F.G = gridDim.x; F.wg = blockIdx.x;
    F.in = args.in;
    F.out = args.out; F.ws = args.ws; F.ctl = (unsigned*)(args.ws + WS_CTL);
    volatile LAS unsigned* MISC = (volatile LAS unsigned*)(F.lds + MISC_OFF);
    if (F.tid < 32) MISC[F.tid] = 0u;
    __syncthreads();
    const int lo = args.ph_lo, hi = args.ph_hi;
    const bool single = (hi - lo) > 1;
    XcdBarrier bar; bar.bar = F.ctl + CW_BAR; bar.x = 0; bar.st = nullptr;
    if (single) bar = xcd_barrier_post(F.ctl + CW_BAR, MISC + 8);
#define IN(k) (lo <= (k) && (k) < hi)
#ifndef PROBE_MASK
#define PROBE_MASK 0
#endif
#define REP(k) for (int _rep = 0; _rep < (((PROBE_MASK >> (k)) & 1) ? 2 : 1); ++_rep)
#define SEAM(k) do { if (IN(k) && IN((k) + 1)) xcd_barrier(bar); } while (0)
#define FRESH() do { int _ln; asm volatile("v_mbcnt_lo_u32_b32 %0, -1, 0\n\tv_mbcnt_hi_u32_b32 %0, -1, %0" : "=v"(_ln)); int _wv = wave0; asm volatile("" : "+s"(_wv)); F.lane = _ln; F.wave = _wv; F.tid = (_wv << 6) | _ln; \
        unsigned char* _w = args.ws; asm volatile("" : "+s"(_w)); F.ws = _w; F.ctl = (unsigned*)(_w + WS_CTL); float* _o = args.out; asm volatile("" : "+s"(_o)); F.out = _o; } while (0)

    if (IN(0)) { FRESH(); p0_static_weights(F); __syncthreads(); p0_mod(F); __syncthreads(); p0_hyena_filters(F); }
    SEAM(0);
    if (IN(1)) { FRESH(); p0_init_rows(F); }
    SEAM(1);
#pragma unroll 1
    for (int l = 0; l < DEPTH; ++l) {
        const int pb = 2 + l * PH_PER_LAYER; const bool last = (l == DEPTH - 1); const int ntok = last ? NLAT : NROW;
        if (IN(pb + 0)) { FRESH();
            REP(0) { p_expert_weights(F, l); __syncthreads(); }
            pg8::DenseOrder S; S.init(NROW, DIN, F.G, F.wg); pg8::EpiBf16 E{(bf16_t*)(F.ws + WS_U), DIN};
            REP(1) pg8::gemm_phase<pg8::EpiBf16, pg8::DenseOrder, false>(F.tid, F.lds, (const bf16_t*)(F.ws + WS_XM), (const bf16_t*)(F.ws + WS_WIN) + (size_t)l * DIN * DM, DM, nullptr, S, E);
        }
        SEAM(pb + 0);
        if (IN(pb + 1)) { FRESH(); REP(2) { ph_transposes(F, l); __syncthreads(); } REP(3) { ph_gla_local(F, l); __syncthreads(); } }
        SEAM(pb + 1);
        if (IN(pb + 2)) { FRESH(); REP(4) { ph_na(F, l, last); } REP(5) { ph_gla_scan(F); } __syncthreads(); REP(6) { ph_hyena(F, l, last); } }
        SEAM(pb + 2);
        if (IN(pb + 3)) { FRESH(); REP(7) { ph_gla_out(F, l, last); } }
        SEAM(pb + 3);
        if (IN(pb + 4)) { FRESH();
            pg8::DenseOrder S; S.init(ntok, DM, F.G, F.wg); pg8::EpiBf16 E{(bf16_t*)(F.ws + WS_Y), DM};
            REP(8) pg8::gemm_phase<pg8::EpiBf16, pg8::DenseOrder, false>(F.tid, F.lds, (const bf16_t*)(F.ws + WS_MIX), (const bf16_t*)(F.ws + WS_WOUT) + (size_t)l * DM * DM, DM, nullptr, S, E);
        }
        SEAM(pb + 4);
        if (IN(pb + 5)) { FRESH(); ph_ln1(F, l, ntok); }
        SEAM(pb + 5);
        if (IN(pb + 6)) { FRESH();
            pg8::DenseOrder S; S.init(ntok, 256, F.G, F.wg); pg8::EpiF32 E{(float*)(F.ws + WS_LOGIT), 256};
            REP(9) pg8::gemm_phase<pg8::EpiF32, pg8::DenseOrder, false>(F.tid, F.lds, (const bf16_t*)(F.ws + WS_XM), (const bf16_t*)(F.ws + WS_WR) + (size_t)l * 256 * DM, DM, nullptr, S, E);
        }
        SEAM(pb + 6);
        if (IN(pb + 7)) { FRESH(); ph_route(F, l, ntok); }
        SEAM(pb + 7);
        if (IN(pb + 8)) { FRESH(); REP(12) { ph_positions(F, l, ntok); __syncthreads(); } }
        SEAM(pb + 8);
        if (IN(pb + 9)) { FRESH();
            const int ntl = (int)__hip_atomic_load(F.ctl + CW_NTL + l, __ATOMIC_RELAXED, __HIP_MEMORY_SCOPE_AGENT);
            pg8::GroupedOrder S; S.init((const int*)(F.ws + WS_TILEEXP), ntl, 2, F.G, F.wg); pg8::EpiSwiglu E{(bf16_t*)(F.ws + WS_ACT)};
            REP(10) pg8::gemm_phase<pg8::EpiSwiglu, pg8::GroupedOrder, true>(F.tid, F.lds, (const bf16_t*)(F.ws + WS_XM), (const bf16_t*)(F.ws + WS_EXP1), DM, (const int*)(F.ws + WS_ROWTOK), S, E);
        }
        SEAM(pb + 9);
        if (IN(pb + 10)) { FRESH();
            const int ntl = (int)__hip_atomic_load(F.ctl + CW_NTL + l, __ATOMIC_RELAXED, __HIP_MEMORY_SCOPE_AGENT);
            pg8::GroupedOrder S; S.init((const int*)(F.ws + WS_TILEEXP), ntl, 4, F.G, F.wg); pg8::EpiScatter E{(unsigned char*)(F.ws + WS_Y2), (const int*)(F.ws + WS_ROWDST)};
            REP(11) pg8::gemm_phase<pg8::EpiScatter, pg8::GroupedOrder, false>(F.tid, F.lds, (const bf16_t*)(F.ws + WS_ACT), (const bf16_t*)(F.ws + WS_EXP2), EH, nullptr, S, E);
        }
        SEAM(pb + 10);
        if (IN(pb + 11)) { FRESH(); ph_ln2(F, l, ntok, last); }
        SEAM(pb + 11);
    }
#undef IN
#undef SEAM
#undef FRESH
}

extern "C" void kernel_launch(void* const* d_in, const int* in_sizes, int n_in, void* d_out, int out_size, void* d_ws, size_t ws_size, hipStream_t stream) {
    static int grid = 0;
    if (grid == 0) {
        if (n_in != 36 || out_size != NLAT * DM || ws_size < WS_END) { fprintf(stderr, "kernel_launch: unexpected shapes (n_in %d out %d ws %zu need %zu)\n", n_in, out_size, ws_size, (size_t)WS_END); grid = -1; return; }
        int dev = 0, cus = 0, per_cu = 0;
        if (hipGetDevice(&dev) != hipSuccess || hipDeviceGetAttribute(&cus, hipDeviceAttributeMultiprocessorCount, dev) != hipSuccess) { grid = -1; return; }
        if (hipFuncSetAttribute((const void*)mk_fwd, hipFuncAttributeMaxDynamicSharedMemorySize, LDS_BYTES) != hipSuccess) { fprintf(stderr, "kernel_launch: hipFuncSetAttribute failed\n"); grid = -1; return; }
        if (hipOccupancyMaxActiveBlocksPerMultiprocessor(&per_cu, (const void*)mk_fwd, NTHR, LDS_BYTES) != hipSuccess || per_cu < 1) { fprintf(stderr, "kernel_launch: occupancy query says %d\n", per_cu); }
        (void)hipGetLastError();
        grid = cus;
    }
    if (grid < 0) return;
    (void)hipMemsetAsync((char*)d_ws + WS_CTL, 0, CTL_BYTES, stream);
    Args a{};
    for (int i = 0; i < 36; ++i) a.in[i] = (const float*)d_in[i];
    a.out = (float*)d_out; a.ws = (unsigned char*)d_ws;
#if MK_MULTI
    for (int p = 0; p < NPHASE; ++p) { a.ph_lo = p; a.ph_hi = p + 1; hipLaunchKernelGGL(mk_fwd, dim3(grid), dim3(NTHR), LDS_BYTES, stream, a); }
#else
    a.ph_lo = 0; a.ph_hi = NPHASE; hipLaunchKernelGGL(mk_fwd, dim3(grid), dim3(NTHR), LDS_BYTES, stream, a);
#endif
}
```

```cpp
#include <hip/hip_runtime.h>
#include <cstdio>
#include <cstdint>

#define LAS __attribute__((address_space(3)))
#define GAS __attribute__((address_space(1)))
typedef unsigned short bf16_t;
typedef short bf16x8 __attribute__((ext_vector_type(8)));
typedef float f32x4 __attribute__((ext_vector_type(4)));
typedef float f32x2 __attribute__((ext_vector_type(2)));
typedef unsigned u32x4 __attribute__((ext_vector_type(4)));
typedef unsigned u32x2 __attribute__((ext_vector_type(2)));

constexpr int NB = 16, SEQ = 4096, CTXL = 256, DM = 1024, DEPTH = 4;
constexpr int NLAT = NB * SEQ;
constexpr int NCTX = NB * CTXL;
constexpr int NROW = NLAT + NCTX;
constexpr int SPB = SEQ + CTXL;
constexpr int DIN_REF = 3104;
constexpr int DIN = 3328;
constexpr int UQ = 0, UK = 512, UV = 1024, UGQ = 1536, UGK = 1664, UGV = 1792, UGR = 2048, UHY = 2304, ULAF = 3072, ULAB = 3200;
constexpr int NEXP = 128, TOPK = 8, EH = 256;
constexpr int NE1 = NEXP + 1;
constexpr int RMAX = 659712;
constexpr int TMAX = RMAX / 256;
constexpr float LN_EPS = 1e-6f;
constexpr float DN_ALPHA = 1.6817928305074290f;

__device__ __forceinline__ unsigned f2bf(float f) { unsigned u = __builtin_bit_cast(unsigned, f); return (u + 0x7fffu + ((u >> 16) & 1u)) >> 16; }
typedef __bf16 bf16v2 __attribute__((ext_vector_type(2)));
__device__ __forceinline__ unsigned pk2(float lo, float hi) { const f32x2 v = {lo, hi}; const bf16v2 b = __builtin_convertvector(v, bf16v2); return __builtin_bit_cast(unsigned, b); }
__device__ __forceinline__ float bf2f(unsigned short b) { return __builtin_bit_cast(float, ((unsigned)b) << 16); }
__device__ __forceinline__ float bflo(unsigned w) { return __builtin_bit_cast(float, w << 16); }
__device__ __forceinline__ float bfhi(unsigned w) { return __builtin_bit_cast(float, w & 0xffff0000u); }
__device__ __forceinline__ float shx(float v, int o, int lane) { return __builtin_bit_cast(float, __builtin_amdgcn_ds_bpermute((lane ^ o) << 2, __builtin_bit_cast(int, v))); }
__device__ __forceinline__ int shxi(int v, int o, int lane) { return __builtin_amdgcn_ds_bpermute((lane ^ o) << 2, v); }
__device__ __forceinline__ float shf(float v, int src) { return __builtin_bit_cast(float, __builtin_amdgcn_ds_bpermute(src << 2, __builtin_bit_cast(int, v))); }
__device__ __forceinline__ float wave_sum(float v, int lane) {
#pragma unroll
    for (int o = 1; o < 64; o <<= 1) v += shx(v, o, lane);
    return v;
}
__device__ __forceinline__ float silu_f(float x) { return x / (1.0f + __expf(-x)); }
#define LDS_WAIT() asm volatile("s_waitcnt lgkmcnt(0)" ::: "memory")
#define VM_WAIT() asm volatile("s_waitcnt vmcnt(0)" ::: "memory")

#define XB_TMO      128
#define XB_XCNT(j)  (256  + 64 * (j))
#define XB_XSUB(j)  (1280 + 64 * (j))
#define XB_XGEN(j)  (2304 + 64 * (j))
#define XB_TOP      3328
#define XB_TOPGEN   3392
#define XCD_BAR_WORDS 3456
#define XB_SPIN_CAP (1u << 18)

__device__ __forceinline__ unsigned xb_ld(unsigned* p)              { return __hip_atomic_load(p, __ATOMIC_RELAXED, __HIP_MEMORY_SCOPE_AGENT); }
__device__ __forceinline__ unsigned xb_add(unsigned* p, unsigned v) { return __hip_atomic_fetch_add(p, v, __ATOMIC_RELAXED, __HIP_MEMORY_SCOPE_AGENT); }
__device__ __forceinline__ unsigned xb_xcc_id() { return (unsigned)__builtin_amdgcn_s_getreg((3 << 11) | 20) & 0xFu; }
#define XB_SPIN(cond, bar) do { unsigned _sp = 0; while (cond) { __builtin_amdgcn_s_sleep(1); \
    if ((++_sp & 255u) == 0u) { if (xb_ld(&(bar)[XB_TMO])) break; if (_sp > XB_SPIN_CAP) { atomicAdd(&(bar)[XB_TMO], 1u); break; } } } } while (0)

struct XcdBarrier { unsigned* bar; unsigned x; volatile LAS unsigned* st; };

__device__ __forceinline__ XcdBarrier xcd_barrier_post(unsigned* bar, volatile LAS unsigned* st) {
    XcdBarrier b; b.bar = bar; b.x = xb_xcc_id(); b.st = st;
    if (threadIdx.x == 0) (void)xb_add(&bar[XB_XCNT(b.x)], 1u);
    return b;
}
__device__ __forceinline__ void xcd_barrier_complete(unsigned* bar, unsigned x, unsigned& nloc, unsigned& nx) {
    const unsigned G = gridDim.x * gridDim.y * gridDim.z;
    unsigned sum, cnt, mine, sp = 0u;
    for (;;) {
        sum = 0u; cnt = 0u; mine = 0u;
#pragma unroll
        for (unsigned j = 0; j < 16; ++j) { const unsigned c = xb_ld(&bar[XB_XCNT(j)]); sum += c; cnt += (c > 0u) ? 1u : 0u; mine = (j == x) ? c : mine; }
        if (sum == G) break;
        __builtin_amdgcn_s_sleep(1);
        if ((++sp & 255u) == 0u) { if (xb_ld(&bar[XB_TMO])) break; if (sp > XB_SPIN_CAP) { atomicAdd(&bar[XB_TMO], 1u); break; } }
    }
    nloc = mine > 0u ? mine : 1u; nx = cnt > 0u ? cnt : 1u;
}
__device__ __forceinline__ void xcd_barrier(const XcdBarrier& b) {
    asm volatile("s_waitcnt vmcnt(0)" ::: "memory");
    __syncthreads();
    if (threadIdx.x == 0) {
        unsigned* bar = b.bar;
        __builtin_amdgcn_s_waitcnt(0);
        unsigned nloc = b.st[0], nx = b.st[1];
        if (nloc == 0u) { xcd_barrier_complete(bar, b.x, nloc, nx); b.st[0] = nloc; b.st[1] = nx; }
        const unsigned old = xb_add(&bar[XB_XSUB(b.x)], 1u);
        const unsigned gen = old / nloc;
        if (old + 1u == (gen + 1u) * nloc) {
            __builtin_amdgcn_fence(__ATOMIC_RELEASE, "agent");
            asm volatile("s_waitcnt vmcnt(0)" ::: "memory");
            const unsigned og = xb_add(&bar[XB_TOP], 1u);
            const unsigned tg = og / nx;
            if (og + 1u == (tg + 1u) * nx) xb_add(&bar[XB_TOPGEN], 1u);
            else XB_SPIN(xb_ld(&bar[XB_TOPGEN]) == tg, bar);
            __builtin_amdgcn_fence(__ATOMIC_ACQUIRE, "agent");
            xb_add(&bar[XB_XGEN(b.x)], 1u);
            asm volatile("s_waitcnt vmcnt(0)" ::: "memory");
        } else {
            XB_SPIN(xb_ld(&bar[XB_XGEN(b.x)]) == gen, bar);
            __builtin_amdgcn_fence(__ATOMIC_ACQUIRE, "agent");
            asm volatile("s_waitcnt vmcnt(0)" ::: "memory");
        }
    }
    __syncthreads();
}

namespace pg8 {
constexpr int BM = 256, BK = 64, HALF = 128, HTB = HALF * BK * 2, STAGE_BYTES = 8 * HTB, NXCD = 8, WGM = 8;
__host__ __device__ __forceinline__ int lds_byte(int r, int c) { const int st = (r >> 4) * 2 + (c >> 5), rr = r & 15, cc = c & 31, ob = rr * 64 + cc * 2; return st * 1024 + (ob ^ (((ob >> 9) & 1) << 5)); }
__host__ __device__ __forceinline__ void stage_rc(int b, int& R, int& C) { const int st = b / 1024, sb = b % 1024, swz = sb ^ (((sb >> 9) & 1) << 5); R = (st >> 1) * 16 + swz / 64; C = (st & 1) * 32 + (swz % 64) / 2; }
__host__ __device__ __forceinline__ int perm32(int rho) { const int n = rho >> 4, i = rho & 15; return 8 * (i >> 2) + 4 * n + (i & 3); }

struct Unit { int arow0, brow0, orow0, ocol0, aux; };

struct DenseOrder {
    int nM, nN, nwg, G, c;
    __device__ void init(int M, int N, int G_, int c_) { nM = M / BM; nN = N / BM; nwg = nM * nN; G = G_; c = c_; }
    __device__ __forceinline__ bool next(int i, Unit& u) const {
        const long L = (long)i * G + c; if (L >= nwg) return false;
        int wgid = (int)L; { const int q = nwg / NXCD, r = nwg % NXCD, xcd = wgid % NXCD, off = wgid / NXCD; wgid = (xcd < r ? xcd * (q + 1) : r * (q + 1) + (xcd - r) * q) + off; }
        const int nig = WGM * nN, gid = wgid / nig, fm = gid * WGM, gsz = (nM - fm) < WGM ? (nM - fm) : WGM;
        const int pm = fm + ((wgid % nig) % gsz), pn = (wgid % nig) / gsz;
        u.arow0 = pm * BM; u.brow0 = pn * BM; u.orow0 = pm * BM; u.ocol0 = pn * BM; u.aux = 0; return true;
    }
};
struct GroupedOrder {
    const int* tile_exp; int nN, nslot, slot, t0, t1;
    __device__ __forceinline__ void init(const int* te, int ntiles, int nN_, int G, int c) {
        tile_exp = te; nN = nN_;
        if ((G & 7) == 0) { const int per = (ntiles + 7) >> 3, x = c & 7; nslot = G >> 3; slot = c >> 3; t0 = x * per; t1 = (t0 + per) < ntiles ? (t0 + per) : ntiles; }
        else { nslot = G; slot = c; t0 = 0; t1 = ntiles; }
    }
    __device__ __forceinline__ bool next(int i, Unit& u) const {
        const int q = i * nslot + slot, t = t0 + q / nN, pn = q % nN;
        if (t >= t1) return false;
        const int e = tile_exp[t];
        u.arow0 = t * BM; u.brow0 = (e * nN + pn) * BM; u.orow0 = t * BM; u.ocol0 = pn * BM; u.aux = e; return true;
    }
};

__device__ __forceinline__ unsigned cvt_pk_bf16(float lo, float hi) { return pk2(lo, hi); }

struct NoPre {};
struct EpiF32 {
    static constexpr bool PERM = false; typedef NoPre Pre;
    __device__ __forceinline__ Pre prefetch(const Unit&, LAS unsigned char*, int, int, int) const { return Pre{}; }
    float* C; int ldc;
    __device__ __forceinline__ void operator()(const f32x4 (&acc)[2][2][4][2], const Unit& u, int wr, int wc, int fr, int fq, const Pre&) const {
        const int row0 = u.orow0 + wr * 64 + fr, col0 = u.ocol0 + wc * 32 + 4 * fq;
#pragma unroll
        for (int ai = 0; ai < 2; ++ai)
#pragma unroll
            for (int m = 0; m < 4; ++m) { float* rowp = C + (size_t)(row0 + ai * HALF + m * 16) * ldc + col0;
#pragma unroll
                for (int bj = 0; bj < 2; ++bj)
#pragma unroll
                    for (int n = 0; n < 2; ++n) *(f32x4*)(rowp + bj * HALF + n * 16) = acc[ai][bj][m][n]; }
    }
};
struct EpiBf16 {
    static constexpr bool PERM = true; typedef NoPre Pre;
    __device__ __forceinline__ Pre prefetch(const Unit&, LAS unsigned char*, int, int, int) const { return Pre{}; }
    bf16_t* O; int ldc;
    __device__ __forceinline__ void operator()(const f32x4 (&acc)[2][2][4][2], const Unit& u, int wr, int wc, int fr, int fq, const Pre&) const {
        const int row0 = u.orow0 + wr * 64 + fr, col0 = u.ocol0 + wc * 32 + 8 * fq;
#pragma unroll
        for (int ai = 0; ai < 2; ++ai)
#pragma unroll
            for (int m = 0; m < 4; ++m) { bf16_t* rowp = O + (size_t)(row0 + ai * HALF + m * 16) * ldc + col0;
#pragma unroll
                for (int bj = 0; bj < 2; ++bj) { const f32x4 v0 = acc[ai][bj][m][0], v1 = acc[ai][bj][m][1];
                    u32x4 w; w.x = cvt_pk_bf16(v0[0], v0[1]); w.y = cvt_pk_bf16(v0[2], v0[3]); w.z = cvt_pk_bf16(v1[0], v1[1]); w.w = cvt_pk_bf16(v1[2], v1[3]);
                    *(u32x4*)(rowp + bj * HALF) = w; } }
    }
};
struct EpiSwiglu {
    static constexpr bool PERM = false; typedef NoPre Pre;
    __device__ __forceinline__ Pre prefetch(const Unit&, LAS unsigned char*, int, int, int) const { return Pre{}; }
    unsigned char* ACT;
    __device__ __forceinline__ void operator()(const f32x4 (&acc)[2][2][4][2], const Unit& u, int wr, int wc, int fr, int fq, const Pre&) const {
        const int row0 = u.orow0 + wr * 64 + fr, pn = u.ocol0 >> 8;
#pragma unroll
        for (int ai = 0; ai < 2; ++ai)
#pragma unroll
            for (int m = 0; m < 4; ++m) { unsigned char* rowp = ACT + (size_t)(row0 + ai * HALF + m * 16) * EH + wc * 16 + 4 * fq;
#pragma unroll
                for (int bj = 0; bj < 2; ++bj) { const f32x4 g = acc[ai][bj][m][0], up = acc[ai][bj][m][1]; float h[4];
#pragma unroll
                    for (int i = 0; i < 4; ++i) h[i] = g[i] / (1.0f + __expf(-g[i])) * up[i];
                    int w = 0; w = __builtin_amdgcn_cvt_pk_fp8_f32(h[0], h[1], w, false); w = __builtin_amdgcn_cvt_pk_fp8_f32(h[2], h[3], w, true);
                    *(GAS unsigned*)(rowp + (pn * 2 + bj) * 64) = (unsigned)w; } }
    }
};
constexpr float Y2_SCALE = 16.0f, Y2_INV = 1.0f / 16.0f;
struct EpiScatter {
    static constexpr bool PERM = true;
    struct Pre { const LAS int* tab; };
    unsigned char* Y2; const int* rowdst;
    __device__ __forceinline__ Pre prefetch(const Unit& u, LAS unsigned char* lds, int wid, int lane, int ui) const {
        LAS unsigned char* tab = lds + STAGE_BYTES + (ui & 1) * 1024;
        if (wid < 4) __builtin_amdgcn_global_load_lds((const unsigned*)(rowdst + u.orow0 + wid * 64 + lane), (LAS unsigned*)(tab + wid * 256), 4, 0, 0);
        Pre p; p.tab = (const LAS int*)tab; return p; }
    __device__ __forceinline__ void operator()(const f32x4 (&acc)[2][2][4][2], const Unit& u, int wr, int wc, int fr, int fq, const Pre& pre) const {
        const int col0 = u.ocol0 + wc * 32 + 8 * fq;
#pragma unroll
        for (int ai = 0; ai < 2; ++ai)
#pragma unroll
            for (int m = 0; m < 4; ++m) { const int dst = pre.tab[wr * 64 + fr + ai * HALF + m * 16];
                if (dst >= 0) { unsigned char* rowp = Y2 + (size_t)dst * DM + col0;
#pragma unroll
                    for (int bj = 0; bj < 2; ++bj) { const f32x4 v0 = acc[ai][bj][m][0] * Y2_SCALE, v1 = acc[ai][bj][m][1] * Y2_SCALE;
                        int w0 = 0, w1 = 0;
                        w0 = __builtin_amdgcn_cvt_pk_fp8_f32(v0[0], v0[1], w0, false); w0 = __builtin_amdgcn_cvt_pk_fp8_f32(v0[2], v0[3], w0, true);
                        w1 = __builtin_amdgcn_cvt_pk_fp8_f32(v1[0], v1[1], w1, false); w1 = __builtin_amdgcn_cvt_pk_fp8_f32(v1[2], v1[3], w1, true);
                        *(GAS u32x2*)(rowp + bj * HALF) = (u32x2){(unsigned)w0, (unsigned)w1}; } } }
    }
};

typedef int v8i __attribute__((ext_vector_type(8)));
typedef int v4i __attribute__((ext_vector_type(4)));
struct Frag { bf16x8 p[2]; __device__ __forceinline__ bf16x8& operator[](int k) { return p[k]; } __device__ __forceinline__ const bf16x8& operator[](int k) const { return p[k]; } };
template <class Epi, class Sched, bool GATHER, bool F8 = false, bool ALIGN_EPI = true, bool SP2 = true>
__device__ __forceinline__ void gemm_phase(const int tid_in, LAS unsigned char* lds, const void* Ag, const void* Bg, const int K, const int* rowidx, const Sched& S, const Epi& E) {
    int tid_ = tid_in; asm volatile("" : "+v"(tid_));
    const int tid = tid_, wid = __builtin_amdgcn_readfirstlane(tid >> 6), lane = tid & 63, wr = wid >> 2, wc = wid & 3, fr = lane & 15, fq = lane >> 4;
    const int KB = F8 ? K : 2 * K;
    const int nt = KB / 128;
    unsigned voffB[2];
#pragma unroll
    for (int i = 0; i < 2; ++i) { int R, C; stage_rc(tid * 16 + i * 8192, R, C); const int Rb = Epi::PERM ? ((R & ~31) + perm32(R & 31)) : R;
        voffB[i] = (unsigned)(Rb * KB + C * 2); }
    const size_t kstep = (size_t)128;
    const size_t hstep = (size_t)HALF * KB;
    const unsigned ldsw = (unsigned)wid * 1024u;
    const int aoff = F8 ? lds_byte(wr * 64 + fr, 16 * fq) : lds_byte(wr * 64 + fr, fq * 8), boff = F8 ? lds_byte(wc * 32 + fr, 16 * fq) : lds_byte(wc * 32 + fr, fq * 8);
    constexpr int PIECE1 = F8 ? 16 : 1024;
#define PG8_SA(b, h) (((b) * 2 + (h)) * HTB)
#define PG8_SB(b, h) ((4 + (b) * 2 + (h)) * HTB)
#define PG8_STAGE_B(bufoff, gbase) do { _Pragma("unroll") for (int _i = 0; _i < 2; ++_i) \
        __builtin_amdgcn_global_load_lds((const unsigned*)((const char*)(gbase) + voffB[_i]), (LAS unsigned*)(lds + (bufoff) + ldsw + _i * 8192), 16, 0, 0); } while (0)
#define PG8_STAGE_A(bufoff, gbase, o0, o1) do { \
        __builtin_amdgcn_global_load_lds((const unsigned*)((const char*)(gbase) + (o0)), (LAS unsigned*)(lds + (bufoff) + ldsw), 16, 0, 0); \
        __builtin_amdgcn_global_load_lds((const unsigned*)((const char*)(gbase) + (o1)), (LAS unsigned*)(lds + (bufoff) + ldsw + 8192), 16, 0, 0); } while (0)
#define PG8_LDA(dst, b, h) do { _Pragma("unroll") for (int m = 0; m < 4; ++m) { if constexpr (F8) { const v4i _l = *(const LAS v4i*)(lds + PG8_SA(b, h) + aoff + m * 2048), _h = *(const LAS v4i*)(lds + PG8_SA(b, h) + aoff + m * 2048 + PIECE1); dst##8[m] = __builtin_shufflevector(_l, _h, 0, 1, 2, 3, 4, 5, 6, 7); } \
        else { dst[m][0] = *(const LAS bf16x8*)(lds + PG8_SA(b, h) + aoff + m * 2048); dst[m][1] = *(const LAS bf16x8*)(lds + PG8_SA(b, h) + aoff + m * 2048 + PIECE1); } } } while (0)
#define PG8_LDB(dst, b, h) do { _Pragma("unroll") for (int n = 0; n < 2; ++n) { if constexpr (F8) { const v4i _l = *(const LAS v4i*)(lds + PG8_SB(b, h) + boff + n * 2048), _h = *(const LAS v4i*)(lds + PG8_SB(b, h) + boff + n * 2048 + PIECE1); dst##8[n] = __builtin_shufflevector(_l, _h, 0, 1, 2, 3, 4, 5, 6, 7); } \
        else { dst[n][0] = *(const LAS bf16x8*)(lds + PG8_SB(b, h) + boff + n * 2048); dst[n][1] = *(const LAS bf16x8*)(lds + PG8_SB(b, h) + boff + n * 2048 + PIECE1); } } } while (0)
#define PG8_MMA(ai, bj, At, Bt) do { __builtin_amdgcn_s_setprio(1); _Pragma("unroll") for (int m = 0; m < 4; ++m) _Pragma("unroll") for (int n = 0; n < 2; ++n) { \
        if constexpr (F8) acc[ai][bj][m][n] = __builtin_amdgcn_mfma_scale_f32_16x16x128_f8f6f4(Bt##8[n], At##8[m], acc[ai][bj][m][n], 0, 0, 0, 0x7A7A7A7A, 0, 0x7F7F7F7F); \
        else { _Pragma("unroll") for (int k = 0; k < 2; ++k) acc[ai][bj][m][n] = __builtin_amdgcn_mfma_f32_16x16x32_bf16(Bt[n][k], At[m][k], acc[ai][bj][m][n], 0, 0, 0); } } \
        __builtin_amdgcn_s_setprio(0); } while (0)
#define PG8_WAIT_V(n) asm volatile("s_waitcnt vmcnt(" #n ")" ::: "memory")
#define PG8_WAIT_L(n) asm volatile("s_waitcnt lgkmcnt(" #n ")" ::: "memory")
#define PG8_BAR __builtin_amdgcn_s_barrier()
#define PG8_SCHED __builtin_amdgcn_sched_barrier(0)
#define PG8_TAB(par) (lds + STAGE_BYTES + 2048 + (par) * 1024)
#define PG8_TABLOAD(par, row0) do { if (wid < 4) __builtin_amdgcn_global_load_lds((const unsigned*)(rowidx + (row0) + wid * 64 + lane), (LAS unsigned*)(PG8_TAB(par) + wid * 256), 4, 0, 0); } while (0)
#define PG8_AOFF_H(h, par) do { int _tz = tid; asm volatile("" : "+v"(_tz)); _Pragma("unroll") for (int _i = 0; _i < 2; ++_i) { int _R, _C; stage_rc(_tz * 16 + _i * 8192, _R, _C); \
        if (GATHER) ac[h][_i] = ((const LAS unsigned*)PG8_TAB(par))[(h) * HALF + _R] * (unsigned)KB + (unsigned)_C * 2u; \
        else ac[h][_i] = (unsigned)(((h) * HALF + _R) * KB) + (unsigned)_C * 2u; } } while (0)
    static_assert(SP2, "only the two-super-phase K-loop is kept");
    Unit cur, nxt; int ui = 0;
    if (!S.next(0, cur)) return;
    f32x4 acc[2][2][4][2];
#pragma unroll
    for (int a = 0; a < 2; ++a)
#pragma unroll
        for (int b = 0; b < 2; ++b)
#pragma unroll
            for (int m = 0; m < 4; ++m)
#pragma unroll
                for (int n = 0; n < 2; ++n) acc[a][b][m][n] = (f32x4){0.f, 0.f, 0.f, 0.f};
    bf16x8 At[F8 ? 1 : 4][2], B0[F8 ? 1 : 2][2], B1[F8 ? 1 : 2][2];
    v8i At8[F8 ? 4 : 1], B08[F8 ? 2 : 1], B18[F8 ? 2 : 1];
    unsigned ac[2][2];
    if (GATHER) { PG8_TABLOAD(0, cur.arow0); PG8_WAIT_V(0); PG8_BAR; }
    PG8_AOFF_H(0, 0); PG8_AOFF_H(1, 0);
    const char* cA = (const char*)Ag + (GATHER ? (size_t)0 : (size_t)cur.arow0 * KB); const char* cB = (const char*)Bg + (size_t)cur.brow0 * KB;
    PG8_STAGE_B(PG8_SB(0, 0), cB); PG8_STAGE_B(PG8_SB(0, 1), cB + hstep); PG8_STAGE_A(PG8_SA(0, 0), cA, ac[0][0], ac[0][1]); PG8_STAGE_A(PG8_SA(0, 1), cA, ac[1][0], ac[1][1]);
    if (wr == 1) PG8_BAR;
    PG8_WAIT_V(2); PG8_BAR;
    PG8_STAGE_B(PG8_SB(1, 0), cB + kstep); PG8_STAGE_A(PG8_SA(1, 0), cA + kstep, ac[0][0], ac[0][1]); PG8_STAGE_B(PG8_SB(1, 1), cB + hstep + kstep);
    PG8_WAIT_V(6); PG8_BAR;
    for (;;) {
        const typename Epi::Pre pre = E.prefetch(cur, lds, wid, lane, ui);
        const bool has_next = S.next(ui + 1, nxt);
        if (GATHER) { if (has_next) PG8_TABLOAD((ui + 1) & 1, nxt.arow0); }
        const char* nA = has_next ? ((const char*)Ag + (GATHER ? (size_t)0 : (size_t)nxt.arow0 * KB)) : cA; const char* nB = has_next ? (const char*)Bg + (size_t)nxt.brow0 * KB : cB;
_Pragma("nounroll")
        for (int t = 0; t < nt; t += 2) {
            const bool last = (t == nt - 2);
            const char* a1 = cA + (size_t)(t + 1) * kstep;
            const char* a2 = last ? nA : cA + (size_t)(t + 2) * kstep; const char* b2 = last ? nB : cB + (size_t)(t + 2) * kstep;
            const char* a3 = a2 + kstep; const char* b3 = b2 + kstep;
            if (GATHER) { if (last && has_next) { PG8_AOFF_H(0, (ui + 1) & 1); } }
            PG8_LDB(B0, 0, 0); PG8_LDB(B1, 0, 1); PG8_SCHED; PG8_LDA(At, 0, 0); PG8_STAGE_A(PG8_SA(1, 1), a1, ac[1][0], ac[1][1]);
            PG8_WAIT_V(8); PG8_WAIT_L(0); PG8_BAR; PG8_MMA(0, 0, At, B0); PG8_MMA(0, 1, At, B1); PG8_BAR; PG8_SCHED;
            if (GATHER) { if (last && has_next) { PG8_AOFF_H(1, (ui + 1) & 1); } }
            PG8_LDA(At, 0, 1); PG8_STAGE_B(PG8_SB(0, 0), b2); PG8_STAGE_B(PG8_SB(0, 1), b2 + hstep); PG8_STAGE_A(PG8_SA(0, 0), a2, ac[0][0], ac[0][1]);
            PG8_WAIT_V(8); PG8_WAIT_L(0); PG8_BAR; PG8_MMA(1, 0, At, B0); PG8_MMA(1, 1, At, B1); PG8_BAR; PG8_SCHED;
            PG8_LDB(B0, 1, 0); PG8_LDB(B1, 1, 1); PG8_SCHED; PG8_LDA(At, 1, 0); PG8_STAGE_A(PG8_SA(0, 1), a2, ac[1][0], ac[1][1]);
            PG8_WAIT_V(8); PG8_WAIT_L(0); PG8_BAR; PG8_MMA(0, 0, At, B0); PG8_MMA(0, 1, At, B1); PG8_BAR; PG8_SCHED;
            PG8_LDA(At, 1, 1); PG8_STAGE_B(PG8_SB(1, 0), b3); PG8_STAGE_B(PG8_SB(1, 1), b3 + hstep); PG8_STAGE_A(PG8_SA(1, 0), a3, ac[0][0], ac[0][1]);
            PG8_WAIT_V(8); PG8_WAIT_L(0); PG8_BAR; PG8_MMA(1, 0, At, B0); PG8_MMA(1, 1, At, B1); PG8_BAR; PG8_SCHED;
        }
        if constexpr (ALIGN_EPI) { if (wr == 0) PG8_BAR; }
        E(acc, cur, wr, wc, fr, fq, pre);
        if (!has_next) break;
#pragma unroll
        for (int a = 0; a < 2; ++a)
#pragma unroll
            for (int b = 0; b < 2; ++b)
#pragma unroll
                for (int m = 0; m < 4; ++m)
#pragma unroll
                    for (int n = 0; n < 2; ++n) acc[a][b][m][n] = (f32x4){0.f, 0.f, 0.f, 0.f};
        cur = nxt; cA = nA; cB = nB; ++ui;
        if constexpr (ALIGN_EPI) { if (wr == 1) PG8_BAR; }
    }
    PG8_WAIT_V(0);
    if constexpr (!ALIGN_EPI) { if (wr == 0) PG8_BAR; }
    PG8_BAR;
#undef PG8_SA
#undef PG8_SB
#undef PG8_STAGE_A
#undef PG8_STAGE_B
#undef PG8_LDA
#undef PG8_LDB
#undef PG8_MMA
#undef PG8_WAIT_V
#undef PG8_WAIT_L
#undef PG8_BAR
#undef PG8_SCHED
#undef PG8_AOFF_H
#undef PG8_TAB
#undef PG8_TABLOAD
}
}

constexpr int NWAVES = 8, NTHR = 512;
constexpr size_t MiB = 1u << 20;
constexpr size_t WS_CTL = 0, CTL_BYTES = 1 * MiB;
constexpr size_t WS_MOD = 1 * MiB;
constexpr size_t WS_WIN = 3 * MiB;
constexpr size_t WS_WOUT = 29 * MiB;
constexpr size_t WS_WR = 37 * MiB;
constexpr size_t WS_HYF = 39 * MiB;
constexpr size_t WS_HYFC = 71 * MiB;
constexpr size_t WS_XC = 73 * MiB;
constexpr size_t WS_EXP1 = 89 * MiB;
constexpr size_t WS_EXP2 = 218 * MiB;
constexpr size_t WS_XM = 283 * MiB;
constexpr size_t WS_EIDX = 419 * MiB;
constexpr size_t WS_WGT = 422 * MiB;
constexpr size_t WS_RNK = 425 * MiB;
constexpr size_t WS_ROWTOK = 428 * MiB;
constexpr size_t WS_ROWDST = 431 * MiB;
constexpr size_t WS_TILEEXP = 434 * MiB;
constexpr size_t WS_BIG = 435 * MiB;
constexpr size_t WS_U = WS_BIG;
constexpr size_t WS_MIX = 877 * MiB;
constexpr size_t WS_VT = 1013 * MiB;
constexpr size_t WS_HV = 1081 * MiB;
constexpr size_t WS_Z2 = 1183 * MiB;
constexpr size_t WS_GDS = 1217 * MiB;
constexpr size_t WS_GSIN = 1285 * MiB;
constexpr size_t WS_GD = 1319 * MiB;
constexpr size_t WS_Y = 1321 * MiB;
constexpr size_t WS_LOGIT = WS_BIG;
constexpr size_t WS_ACT = WS_BIG;
constexpr size_t WS_Y2 = 758 * MiB;
constexpr size_t WS_XM8 = 1470 * MiB;
constexpr size_t WS_XR = 1600 * MiB;
constexpr size_t WS_END = 1736 * MiB;
constexpr int CW_BAR = 4096;
constexpr int CW_CNT = 16384;
constexpr int CW_NTL = 20480;

constexpr int LDS_BYTES = 147456;
constexpr int MISC_OFF = 143360;

struct Frame {
    LAS unsigned char* lds;
    int tid, lane, wave, G, wg;
    const float* const* in;
    float* out; unsigned char* ws; unsigned* ctl;
};
enum { I_X = 0, I_C, I_CTX, I_CCTX, I_WMOD, I_BMOD, I_WIN, I_RPB, I_WA2, I_BA2, I_GNORM, I_HSW, I_HSB, I_HW1, I_HB1, I_HF1, I_HW2, I_HB2, I_HF2, I_HW3, I_HB3, I_HDEC, I_HSKIP,
       I_WOUT, I_LN1G, I_LN1B, I_RW, I_RB, I_WEG, I_WEU, I_WED, I_WSG, I_WSU, I_WSD, I_LN2G, I_LN2B };

__device__ __forceinline__ int row_b(int row) { return row < NLAT ? (row >> 12) : 16; }
__device__ __forceinline__ const float* mod_ptr(const Frame& F, int l, int row) { return (const float*)(F.ws + WS_MOD) + ((size_t)l * 17 + row_b(row)) * 6144; }

template <class RowFn>
__device__ __forceinline__ void tr_item(const float* W, int ldw, int k0, int n0, bf16_t* dst, int ldd, RowFn rf, LAS float* scr, int lane) {
    float tv[32];
    const GAS float* wp = (const GAS float*)(W + (size_t)(k0 + (lane >> 5)) * ldw + n0 + (lane & 31));
#pragma unroll
    for (int i = 0; i < 32; ++i) tv[i] = wp[(size_t)(2 * i) * ldw];
#pragma unroll
    for (int i = 0; i < 32; ++i) scr[(2 * i + (lane >> 5)) * 33 + (lane & 31)] = tv[i];
    LDS_WAIT(); asm volatile("" ::: "memory");
    const int c = lane & 7;
#pragma unroll
    for (int j = 0; j < 4; ++j) { const int n = (lane >> 3) + 8 * j; const LAS float* s = scr + (8 * c) * 33 + n;
        u32x4 o; o.x = pk2(s[0 * 33], s[1 * 33]); o.y = pk2(s[2 * 33], s[3 * 33]); o.z = pk2(s[4 * 33], s[5 * 33]); o.w = pk2(s[6 * 33], s[7 * 33]);
        *(GAS u32x4*)(dst + (size_t)rf(n0 + n) * ldd + k0 + 8 * c) = o; }
    LDS_WAIT(); asm volatile("" ::: "memory");
}
template <class RowFn>
__device__ __forceinline__ void tr_item8(const float* W, int ldw, int k0, int n0, unsigned char* dst, int ldd, RowFn rf, float scale, LAS float* scr, int lane) {
    float tv[32];
    const GAS float* wp = (const GAS float*)(W + (size_t)(k0 + (lane >> 5)) * ldw + n0 + (lane & 31));
#pragma unroll
    for (int i = 0; i < 32; ++i) tv[i] = wp[(size_t)(2 * i) * ldw];
#pragma unroll
    for (int i = 0; i < 32; ++i) scr[(2 * i + (lane >> 5)) * 33 + (lane & 31)] = tv[i];
    LDS_WAIT(); asm volatile("" ::: "memory");
    const int n = lane >> 1, hf = lane & 1; const LAS float* s = scr + (32 * hf) * 33 + n;
    unsigned w[8];
#pragma unroll
    for (int j = 0; j < 8; ++j) { int v = 0; v = __builtin_amdgcn_cvt_pk_fp8_f32(s[(4 * j) * 33] * scale, s[(4 * j + 1) * 33] * scale, v, false); v = __builtin_amdgcn_cvt_pk_fp8_f32(s[(4 * j + 2) * 33] * scale, s[(4 * j + 3) * 33] * scale, v, true); w[j] = (unsigned)v; }
    unsigned char* d = dst + (size_t)rf(n0 + n) * ldd + k0 + 32 * hf;
    *(GAS u32x4*)d = (u32x4){w[0], w[1], w[2], w[3]}; *(GAS u32x4*)(d + 16) = (u32x4){w[4], w[5], w[6], w[7]};
    LDS_WAIT(); asm volatile("" ::: "memory");
}
struct RowId { __device__ __forceinline__ int operator()(int n) const { return n; } };
struct RowWin { __device__ __forceinline__ int operator()(int n) const { return n >= 2336 ? n - 32 : n; } };
struct RowGU { int up; __device__ __forceinline__ int operator()(int j) const { return (j >> 6) * 128 + ((j & 63) >> 4) * 32 + up * 16 + (j & 15); } };

__device__ __forceinline__ void p0_static_weights(Frame& F) {
    LAS float* scr = (LAS float*)(F.lds + F.wave * 16384);
    const int gw = F.wg * NWAVES + F.wave, NGW = F.G * NWAVES;
    constexpr int I_IN = 16 * 97, I_OUT = 16 * 32, I_R = 16 * 4, PER_L = I_IN + I_OUT + I_R;
    for (int it = gw; it < DEPTH * PER_L; it += NGW) {
        const int l = it / PER_L; int r = it % PER_L;
        if (r < I_IN) { const int kb = r / 97, nb = r % 97; if (nb == 72) continue;
            tr_item(F.in[I_WIN] + (size_t)l * DM * DIN_REF, DIN_REF, kb * 64, nb * 32, (bf16_t*)(F.ws + WS_WIN) + (size_t)l * DIN * DM, DM, RowWin{}, scr, F.lane); continue; }
        r -= I_IN;
        if (r < I_OUT) { const int kb = r / 32, nb = r % 32;
            tr_item(F.in[I_WOUT] + (size_t)l * DM * DM, DM, kb * 64, nb * 32, (bf16_t*)(F.ws + WS_WOUT) + (size_t)l * DM * DM, DM, RowId{}, scr, F.lane); continue; }
        r -= I_OUT;
        { const int kb = r / 4, nb = r % 4;
            tr_item(F.in[I_RW] + (size_t)l * DM * NEXP, NEXP, kb * 64, nb * 32, (bf16_t*)(F.ws + WS_WR) + (size_t)l * 256 * DM, DM, RowId{}, scr, F.lane); }
    }
    const int gt = F.wg * NTHR + F.tid, NGT = F.G * NTHR;
    for (int i = gt; i < DEPTH * 128 * DM / 8; i += NGT) { const int l = i / (128 * DM / 8), r = i % (128 * DM / 8);
        *(u32x4*)((bf16_t*)(F.ws + WS_WR) + ((size_t)l * 256 + 128) * DM + (size_t)r * 8) = (u32x4){0u, 0u, 0u, 0u}; }
    for (int i = gt; i < DEPTH * 256 * DM; i += NGT) {
        const int k = i % DM, n = (i / DM) % 256, l = i / (DM * 256), dir = n >> 7, j = n & 127;
        const float* wi = F.in[I_WIN] + ((size_t)l * DM + k) * DIN_REF + 2304 + dir * 16;
        const float* wa = F.in[I_WA2] + ((size_t)(l * 2 + dir) * 16) * 128 + j;
        float s = 0.f;
#pragma unroll
        for (int r = 0; r < 16; ++r) s += wi[r] * wa[r * 128];
        ((bf16_t*)(F.ws + WS_WIN))[((size_t)l * DIN + 3072 + n) * DM + k] = (bf16_t)f2bf(s);
    }
}
__device__ __forceinline__ void p0_mod(Frame& F) {
    LAS float* sc = (LAS float*)F.lds;
    LAS float* red = (LAS float*)(F.lds + 17 * 1024 * 4);
    for (int i = F.tid; i < 17 * 1024; i += NTHR) { const int r = i >> 10, k = i & 1023; const float v = r < 16 ? F.in[I_C][r * 1024 + k] : F.in[I_CCTX][k]; sc[i] = silu_f(v); }
    __syncthreads();
    const int kq = F.tid >> 7, cl = F.tid & 127;
    for (int u = F.wg; u < DEPTH * 48; u += F.G) {
        const int l = u / 48, col = (u % 48) * 128 + cl;
        const float* w = F.in[I_WMOD] + (size_t)l * DM * 6144 + col;
        float a[17];
#pragma unroll
        for (int r = 0; r < 17; ++r) a[r] = 0.f;
#pragma unroll 4
        for (int k = kq * 256; k < kq * 256 + 256; ++k) { const float wv = w[(size_t)k * 6144];
#pragma unroll
            for (int r = 0; r < 17; ++r) a[r] += sc[r * 1024 + k] * wv; }
#pragma unroll
        for (int r = 0; r < 17; ++r) red[(kq * 17 + r) * 128 + cl] = a[r];
        __syncthreads();
        for (int i = F.tid; i < 17 * 128; i += NTHR) { const int r = i >> 7, c2 = i & 127, cc = (u % 48) * 128 + c2;
            const float s = red[(0 * 17 + r) * 128 + c2] + red[(1 * 17 + r) * 128 + c2] + red[(2 * 17 + r) * 128 + c2] + red[(3 * 17 + r) * 128 + c2] + F.in[I_BMOD][l * 6144 + cc];
            ((float*)(F.ws + WS_MOD))[((size_t)l * 17 + r) * 6144 + cc] = s; }
        __syncthreads();
    }
}
__device__ __forceinline__ void p0_hyena_filters(Frame& F) {
    LAS float* z = (LAS float*)F.lds;
    LAS float* h1 = z + 32 * 33;
    LAS float* h2 = h1 + 32 * 64;
    LAS float* tt = h2 + 32 * 64;
    constexpr int UL = 4096 / 32, UC = 256 / 32, UPL = UL + UC;
    for (int u = F.wg; u < DEPTH * UPL; u += F.G) {
        const int l = u / UPL, r = u % UPL; const bool lat = r < UL; const int L = lat ? 4096 : 256, n0 = (lat ? r : r - UL) * 32;
        __syncthreads();
        for (int i = F.tid; i < 32 * 33; i += NTHR) { const int p = i / 33, e = i % 33, n = n0 + p;
            const float t = (float)n / (float)(L - 1);
            float v;
            if (e == 0) v = t;
            else { const int kb = (e - 1) & 15; const float band = 1e-4f + (float)kb * ((15.0f - 1e-4f) / 15.0f);
                   const float w = 6.283185307179586f * (float)n / (float)L; const float ang = w * band;
                   v = e <= 16 ? __cosf(ang) : -__sinf(ang); }
            z[i] = v; if (e == 0) tt[p] = t; }
        __syncthreads();
        for (int i = F.tid; i < 32 * 64; i += NTHR) { const int p = i >> 6, j = i & 63; float s = F.in[I_HB1][l * 64 + j];
            for (int e = 0; e < 33; ++e) s += z[p * 33 + e] * F.in[I_HW1][((size_t)l * 33 + e) * 64 + j];
            h1[i] = __sinf(F.in[I_HF1][l * 64 + j] * s); }
        __syncthreads();
        for (int i = F.tid; i < 32 * 64; i += NTHR) { const int p = i >> 6, j = i & 63; float s = F.in[I_HB2][l * 64 + j];
            for (int e = 0; e < 64; ++e) s += h1[p * 64 + e] * F.in[I_HW2][((size_t)l * 64 + e) * 64 + j];
            h2[i] = __sinf(F.in[I_HF2][l * 64 + j] * s); }
        __syncthreads();
#pragma unroll 1
        for (int cc = 0; cc < 2; ++cc) {
            const int col = F.tid + cc * 512, o = col >> 9, dir = (col >> 8) & 1, ch = col & 255;
            float a[32];
#pragma unroll
            for (int p = 0; p < 32; ++p) a[p] = 0.f;
            const float* w3 = F.in[I_HW3] + (size_t)l * 64 * 1024 + col;
            for (int k = 0; k < 64; ++k) { const float wv = w3[(size_t)k * 1024];
#pragma unroll
                for (int p = 0; p < 32; ++p) a[p] += h2[p * 64 + k] * wv; }
            const float b3 = F.in[I_HB3][l * 1024 + col], dec = fabsf(F.in[I_HDEC][((size_t)(l * 2 + o) * 2 + dir) * 256 + ch]);
            const float skip = F.in[I_HSKIP][(l * 2 + o) * 256 + ch];
            bf16_t* R = lat ? (bf16_t*)(F.ws + WS_HYF) + ((size_t)(l * 2 + o) * 256 + ch) * 8192 : (bf16_t*)(F.ws + WS_HYFC) + ((size_t)(l * 2 + o) * 256 + ch) * 512;
#pragma unroll
            for (int p = 0; p < 32; ++p) { const int n = n0 + p; float v = (a[p] + b3) * __expf(-tt[p] * dec);
                if (dir == 0) { if (n == 0) v += skip; R[L - n] = (bf16_t)f2bf(v); }
                else { if (n == 0) R[0] = 0; else R[L + n] = (bf16_t)f2bf(v); } }
        }
    }
    __syncthreads();
}
__device__ __forceinline__ void p0_init_rows(Frame& F) {
    const int gw = F.wg * NWAVES + F.wave, NGW = F.G * NWAVES;
    for (int row = gw; row < NROW; row += NGW) {
        const float* src = row < NLAT ? F.in[I_X] + (size_t)row * DM : F.in[I_CTX] + (size_t)(row - NLAT) * DM;
        const float* md = mod_ptr(F, 0, row);
        bf16_t* xr = (bf16_t*)(F.ws + WS_XR) + (size_t)row * DM; bf16_t* xm = (bf16_t*)(F.ws + WS_XM) + (size_t)row * DM;
#pragma unroll
        for (int j = 0; j < 4; ++j) { const int c = 4 * F.lane + 256 * j;
            const f32x4 v = *(const GAS f32x4*)(src + c), sh = *(const GAS f32x4*)(md + c), sc = *(const GAS f32x4*)(md + 1024 + c);
            *(GAS u32x2*)(xr + c) = (u32x2){pk2(v[0], v[1]), pk2(v[2], v[3])};
            u32x2 w; w.x = pk2(v[0] * (1.f + sc[0]) + sh[0], v[1] * (1.f + sc[1]) + sh[1]); w.y = pk2(v[2] * (1.f + sc[2]) + sh[2], v[3] * (1.f + sc[3]) + sh[3]);
            *(GAS u32x2*)(xm + c) = w; }
    }
}
constexpr float WEXP_SCALE = 32.0f;
__device__ __forceinline__ void p_expert_weights(Frame& F, int l) {
    LAS float* scr = (LAS float*)(F.lds + F.wave * 16384);
    const int gw = F.wg * NWAVES + F.wave, NGW = F.G * NWAVES;
    constexpr int I1 = 16 * 8, I2 = 4 * 32, PER_E = 2 * I1 + I2;
    for (int it = gw; it < NE1 * PER_E; it += NGW) {
        const int e = it / PER_E; int r = it % PER_E;
        unsigned char* d1 = (unsigned char*)(F.ws + WS_EXP1) + (size_t)e * 512 * DM; unsigned char* d2 = (unsigned char*)(F.ws + WS_EXP2) + (size_t)e * DM * EH;
        if (r < 2 * I1) { const int up = r >= I1; if (up) r -= I1; const int kb = r / 8, nb = r % 8;
            const float* src = e < NEXP ? F.in[up ? I_WEU : I_WEG] + ((size_t)l * NEXP + e) * DM * EH : F.in[up ? I_WSU : I_WSG] + (size_t)l * DM * EH;
            tr_item8(src, EH, kb * 64, nb * 32, d1, DM, RowGU{up}, WEXP_SCALE, scr, F.lane); }
        else { r -= 2 * I1; const int kb = r / 32, nb = r % 32;
            const float* src = e < NEXP ? F.in[I_WED] + ((size_t)l * NEXP + e) * EH * DM : F.in[I_WSD] + (size_t)l * EH * DM;
            tr_item8(src, DM, kb * 64, nb * 32, d2, EH, RowId{}, WEXP_SCALE, scr, F.lane); }
    }
}

__device__ __forceinline__ f32x4 mfma16(bf16x8 a, bf16x8 b, f32x4 c) { return __builtin_amdgcn_mfma_f32_16x16x32_bf16(a, b, c, 0, 0, 0); }

__device__ __forceinline__ void ph_transposes(Frame& F, int l) {
    LAS bf16_t* tile = (LAS bf16_t*)(F.lds + F.wave * 16384);
    const bf16_t* U = (const bf16_t*)(F.ws + WS_U);
    const int gw = F.wg * NWAVES + F.wave, NGW = F.G * NWAVES;
    const int rsub = F.lane >> 3, cseg = F.lane & 7;
    for (int u = gw; u < 1088 * 20; u += NGW) {
        const int tt = u / 20, blk = u % 20;
        int b, s0, Ls, rowbase, posbase;
        if (tt < 1024) { b = tt >> 6; s0 = (tt & 63) * 64; Ls = SEQ; rowbase = b * SEQ; posbase = 0; }
        else { const int t2 = tt - 1024; b = t2 >> 2; s0 = (t2 & 3) * 64; Ls = CTXL; rowbase = NLAT + b * CTXL; posbase = SEQ; }
        if (blk < 12) {
            const int c0 = blk * 64 + cseg * 8;
            float w0[8], w1[8], w2[8], bb[8];
#pragma unroll
            for (int i = 0; i < 8; ++i) { w0[i] = F.in[I_HSW][(l * 3 + 0) * 768 + c0 + i]; w1[i] = F.in[I_HSW][(l * 3 + 1) * 768 + c0 + i]; w2[i] = F.in[I_HSW][(l * 3 + 2) * 768 + c0 + i]; bb[i] = F.in[I_HSB][l * 768 + c0 + i]; }
#pragma unroll 2
            for (int it = 0; it < 8; ++it) {
                const int sl = rsub + 8 * it, s = s0 + sl;
                const bf16_t* p = U + (size_t)(rowbase + s) * DIN + UHY + c0;
                const u32x4 zc = *(const u32x4*)p;
                u32x4 zm = (u32x4){0u, 0u, 0u, 0u}, zp = (u32x4){0u, 0u, 0u, 0u};
                if (s > 0) zm = *(const u32x4*)(p - DIN);
                if (s < Ls - 1) zp = *(const u32x4*)(p + DIN);
                const unsigned am[4] = {zm.x, zm.y, zm.z, zm.w}, ac[4] = {zc.x, zc.y, zc.z, zc.w}, ap[4] = {zp.x, zp.y, zp.z, zp.w};
#pragma unroll
                for (int i = 0; i < 4; ++i) {
                    const float v0 = bb[2 * i] + w0[2 * i] * bflo(am[i]) + w1[2 * i] * bflo(ac[i]) + w2[2 * i] * bflo(ap[i]);
                    const float v1 = bb[2 * i + 1] + w0[2 * i + 1] * bfhi(am[i]) + w1[2 * i + 1] * bfhi(ac[i]) + w2[2 * i + 1] * bfhi(ap[i]);
                    tile[(cseg * 8 + 2 * i) * 72 + sl] = (bf16_t)f2bf(v0); tile[(cseg * 8 + 2 * i + 1) * 72 + sl] = (bf16_t)f2bf(v1);
                }
            }
        } else {
            const int c0 = (blk - 12) * 64 + cseg * 8;
#pragma unroll 2
            for (int it = 0; it < 8; ++it) {
                const int sl = rsub + 8 * it, s = s0 + sl;
                const u32x4 zc = *(const u32x4*)(U + (size_t)(rowbase + s) * DIN + UV + c0);
                const unsigned ac[4] = {zc.x, zc.y, zc.z, zc.w};
#pragma unroll
                for (int i = 0; i < 4; ++i) { tile[(cseg * 8 + 2 * i) * 72 + sl] = (bf16_t)(ac[i] & 0xffffu); tile[(cseg * 8 + 2 * i + 1) * 72 + sl] = (bf16_t)(ac[i] >> 16); }
            }
        }
        LDS_WAIT(); asm volatile("" ::: "memory");
#pragma unroll 2
        for (int it = 0; it < 8; ++it) {
            const int ch = rsub + 8 * it;
            const u32x4 v = *(const LAS u32x4*)(tile + ch * 72 + cseg * 8);
            bf16_t* dst;
            if (blk < 12) dst = (bf16_t*)(F.ws + WS_HV) + ((size_t)(blk * 64 + ch) * NB + b) * SPB + posbase + s0 + cseg * 8;
            else dst = (bf16_t*)(F.ws + WS_VT) + ((size_t)b * 512 + (blk - 12) * 64 + ch) * SPB + posbase + s0 + cseg * 8;
            *(u32x4*)dst = v;
        }
        LDS_WAIT(); asm volatile("" ::: "memory");
    }
}

constexpr int NA_RPB = 0, NA_KC = 16384, NA_VC = NA_KC + 256 * 144, NA_END = NA_VC + 64 * 528;
__device__ __forceinline__ bf16x8 gld16(const bf16_t* p) { return *(const GAS bf16x8*)p; }
__device__ __forceinline__ u32x2 gld8(const bf16_t* p) { return *(const GAS u32x2*)p; }
__device__ __forceinline__ const char* uni_ptr(const char* p) { const unsigned long long v = (unsigned long long)p; const unsigned lo = __builtin_amdgcn_readfirstlane((unsigned)v), hi = __builtin_amdgcn_readfirstlane((unsigned)(v >> 32)); return (const char*)(((unsigned long long)hi << 32) | lo); }
__device__ __forceinline__ bf16x8 gld16o(const char* ub, unsigned lo) { return *(const GAS bf16x8*)(ub + (size_t)lo); }
__device__ __forceinline__ u32x2 gld8o(const char* ub, unsigned lo) { return *(const GAS u32x2*)(ub + (size_t)lo); }
template <bool WIN>
__device__ __forceinline__ void na_unit(Frame& F, int b, int h, int r, int strip) {
    const bf16_t* U = (const bf16_t*)(F.ws + WS_U);
    const bf16_t* VT = (const bf16_t*)(F.ws + WS_VT) + ((size_t)b * 512 + h * 64) * SPB;
    const LAS float* rpb = (const LAS float*)(F.lds + NA_RPB);
    const LAS bf16_t* KC = (const LAS bf16_t*)(F.lds + NA_KC); const LAS bf16_t* VC = (const LAS bf16_t*)(F.lds + NA_VC);
    int ln_ = F.lane; asm volatile("" : "+v"(ln_));
    const int i = ln_ & 15, g = ln_ >> 4;
    const int qrow0 = WIN ? (b * SEQ + r * 64 + strip * 16) : (NLAT + b * CTXL + strip * 16);
    const unsigned klo = (unsigned)((i * DIN + 8 * g) * 2), vlo = (unsigned)((i * SPB + 4 * g) * 2);
    const char* qb = uni_ptr((const char*)(U + (size_t)qrow0 * DIN + UQ + h * 64));
    const bf16x8 q0 = gld16o(qb, klo), q1 = gld16o(qb + 64, klo);
    constexpr int NT = WIN ? 32 : 16;
    constexpr int CO = WIN ? 16 : 0;
    f32x4 st[NT];
    int kr0 = 0, u0 = 0;
    if (WIN) { kr0 = r - 4; kr0 = kr0 < 0 ? 0 : (kr0 > 56 ? 56 : kr0); u0 = strip == 0 ? 0 : (strip == 1 ? 8 : (strip == 2 ? 24 : 32)); }
    const char* kbase = uni_ptr((const char*)(U + (size_t)(b * SEQ + kr0 * 64 + u0) * DIN + UK + h * 64));
    const char* vbase = uni_ptr((const char*)(VT + kr0 * 64 + u0));
#define NA_SB() __builtin_amdgcn_sched_barrier(0)
#define NA_KLOAD(buf, grp) do { _Pragma("unroll") for (int t = 0; t < 2; ++t) { const int kt = (grp) * 2 + t; const char* kp = kbase + (size_t)((kt >> 1) * 64 + (kt & 1) * 16) * DIN * 2; buf[t][0] = gld16o(kp, klo); buf[t][1] = gld16o(kp + 64, klo); } } while (0)
#define NA_KMMA(buf, grp) do { _Pragma("unroll") for (int t = 0; t < 2; ++t) { f32x4 a = (f32x4){0.f, 0.f, 0.f, 0.f}; a = mfma16(buf[t][0], q0, a); a = mfma16(buf[t][1], q1, a); st[(grp) * 2 + t] = a; } } while (0)
#define NA_VLOAD(buf, cp) do { _Pragma("unroll") for (int d = 0; d < 4; ++d) { const char* vp = vbase + ((size_t)(d * 16) * SPB + (cp) * 64) * 2; buf[d][0] = gld8o(vp, vlo); buf[d][1] = gld8o(vp + 32, vlo); } } while (0)
#define NA_VMMA(buf, cp) do { const int c = (cp); const f32x4 p0 = st[2 * c], p1 = st[2 * c + 1]; \
        u32x4 pw; pw.x = pk2(p0[0], p0[1]); pw.y = pk2(p0[2], p0[3]); pw.z = pk2(p1[0], p1[1]); pw.w = pk2(p1[2], p1[3]); const bf16x8 pf = __builtin_bit_cast(bf16x8, pw); \
        _Pragma("unroll") for (int d = 0; d < 4; ++d) { const bf16x8 vfr = __builtin_bit_cast(bf16x8, ((u32x4){buf[d][0].x, buf[d][0].y, buf[d][1].x, buf[d][1].y})); o[d] = mfma16(vfr, pf, o[d]); } } while (0)
    bf16x8 ka[2][2], kb[2][2];
    if (WIN) { NA_KLOAD(ka, 0); NA_KLOAD(kb, 1); NA_SB(); }
#pragma unroll
    for (int cg = 0; cg < 8; ++cg) {
        bf16x8 kc[2][2];
#pragma unroll
        for (int t = 0; t < 2; ++t) { const LAS bf16_t* kp = KC + ((cg * 2 + t) * 16 + i) * 72 + 8 * g; kc[t][0] = *(const LAS bf16x8*)kp; kc[t][1] = *(const LAS bf16x8*)(kp + 32); }
#pragma unroll
        for (int t = 0; t < 2; ++t) { f32x4 a = (f32x4){0.f, 0.f, 0.f, 0.f}; a = mfma16(kc[t][0], q0, a); a = mfma16(kc[t][1], q1, a); st[CO + cg * 2 + t] = a; }
        NA_SB();
    }
    u32x2 va[4][2], vb[4][2];
    if (WIN) {
        NA_KMMA(ka, 0); NA_SB(); NA_KLOAD(ka, 2); NA_SB();
        NA_KMMA(kb, 1); NA_SB(); NA_KLOAD(kb, 3); NA_SB();
        NA_KMMA(ka, 2); NA_SB(); NA_KLOAD(ka, 4); NA_SB();
        NA_KMMA(kb, 3); NA_SB(); NA_KLOAD(kb, 5); NA_SB();
        NA_KMMA(ka, 4); NA_SB(); NA_KLOAD(ka, 6); NA_SB();
        NA_KMMA(kb, 5); NA_SB(); NA_KLOAD(kb, 7); NA_SB();
        NA_KMMA(ka, 6); NA_SB(); NA_VLOAD(va, 0); NA_SB();
        NA_KMMA(kb, 7); NA_SB(); NA_VLOAD(vb, 1); NA_SB();
    }
    float mx = -3.0e38f;
    if (WIN) {
        const int c = strip * 16 + i; int kc0 = c - 8; kc0 = kc0 < 0 ? 0 : (kc0 > 48 ? 48 : kc0);
#pragma unroll
        for (int grp = 0; grp < 4; ++grp) {
            float bv[4][4];
#pragma unroll
            for (int t = 0; t < 4; ++t) { const int kt = grp * 4 + t, dr = kr0 + (kt >> 1) - r + 7;
#pragma unroll
                for (int e = 0; e < 4; ++e) { int dc = u0 + (kt & 1) * 16 + 4 * g + e - c + 15; dc = dc < 0 ? 0 : (dc > 30 ? 30 : dc); bv[t][e] = rpb[(h * 15 + dr) * 31 + dc]; } }
#pragma unroll
            for (int t = 0; t < 4; ++t) { const int kt = grp * 4 + t;
#pragma unroll
                for (int e = 0; e < 4; ++e) { const int kc = u0 + (kt & 1) * 16 + 4 * g + e; const bool ok = (kc >= kc0) && (kc < kc0 + 16);
                    const float s = ok ? (st[kt][e] * 0.125f + bv[t][e]) : -3.0e38f; st[kt][e] = s; mx = fmaxf(mx, s); } }
            NA_SB();
        }
    }
#pragma unroll
    for (int ct = 0; ct < 16; ++ct)
#pragma unroll
        for (int e = 0; e < 4; ++e) { const float s = st[CO + ct][e] * 0.125f; st[CO + ct][e] = s; mx = fmaxf(mx, s); }
    mx = fmaxf(mx, shx(mx, 16, ln_)); mx = fmaxf(mx, shx(mx, 32, ln_));
    float sum = 0.f;
#pragma unroll
    for (int t = 0; t < NT; ++t)
#pragma unroll
        for (int e = 0; e < 4; ++e) { const float p = __expf(st[t][e] - mx); st[t][e] = p; sum += p; }
    sum += shx(sum, 16, ln_); sum += shx(sum, 32, ln_);
    const float inv = 1.0f / sum;
    f32x4 o[4];
#pragma unroll
    for (int d = 0; d < 4; ++d) o[d] = (f32x4){0.f, 0.f, 0.f, 0.f};
    NA_SB();
    if (WIN) {
        NA_VMMA(va, 0); NA_SB(); NA_VLOAD(va, 2); NA_SB();
        NA_VMMA(vb, 1); NA_SB(); NA_VLOAD(vb, 3); NA_SB();
        NA_VMMA(va, 2); NA_SB(); NA_VLOAD(va, 4); NA_SB();
        NA_VMMA(vb, 3); NA_SB(); NA_VLOAD(vb, 5); NA_SB();
        NA_VMMA(va, 4); NA_SB(); NA_VLOAD(va, 6); NA_SB();
        NA_VMMA(vb, 5); NA_SB(); NA_VLOAD(vb, 7); NA_SB();
    }
#pragma unroll
    for (int cb = 0; cb < 8; ++cb) {
        u32x2 vc[1][4][2];
#pragma unroll
        for (int cc = 0; cc < 1; ++cc)
#pragma unroll
            for (int d = 0; d < 4; ++d) { const LAS bf16_t* vp = VC + (d * 16 + i) * 264 + (cb + cc) * 32 + 4 * g; vc[cc][d][0] = *(const LAS u32x2*)vp; vc[cc][d][1] = *(const LAS u32x2*)(vp + 16); }
#pragma unroll
        for (int cc = 0; cc < 1; ++cc) { const int c = (WIN ? 8 : 0) + cb + cc; const f32x4 p0 = st[2 * c], p1 = st[2 * c + 1];
            u32x4 pw; pw.x = pk2(p0[0], p0[1]); pw.y = pk2(p0[2], p0[3]); pw.z = pk2(p1[0], p1[1]); pw.w = pk2(p1[2], p1[3]); const bf16x8 pf = __builtin_bit_cast(bf16x8, pw);
#pragma unroll
            for (int d = 0; d < 4; ++d) { const bf16x8 vfr = __builtin_bit_cast(bf16x8, ((u32x4){vc[cc][d][0].x, vc[cc][d][0].y, vc[cc][d][1].x, vc[cc][d][1].y})); o[d] = mfma16(vfr, pf, o[d]); } }
        NA_SB();
    }
    if (WIN) { NA_VMMA(va, 6); NA_SB(); NA_VMMA(vb, 7); NA_SB(); }
    char* op = (char*)uni_ptr((const char*)((bf16_t*)(F.ws + WS_MIX) + (size_t)qrow0 * DM + h * 64)); const unsigned olo = (unsigned)((i * DM + 4 * g) * 2);
#pragma unroll
    for (int d = 0; d < 4; ++d) { u32x2 w; w.x = pk2(o[d][0] * inv, o[d][1] * inv); w.y = pk2(o[d][2] * inv, o[d][3] * inv); *(GAS u32x2*)(op + d * 32 + (size_t)olo) = w; }
#undef NA_SB
#undef NA_KLOAD
#undef NA_KMMA
#undef NA_VLOAD
#undef NA_VMMA
}
__device__ __forceinline__ void ph_na(Frame& F, int l, bool last) {
    LAS float* rpb = (LAS float*)(F.lds + NA_RPB);
    __syncthreads();
    for (int i = F.tid; i < 8 * 15 * 31; i += NTHR) rpb[i] = F.in[I_RPB][(size_t)l * 8 * 15 * 31 + i];
    const bf16_t* U = (const bf16_t*)(F.ws + WS_U);
    for (int job = F.wg; job < NB * 8 * 2; job += F.G) {
        const int half = job & 1, h = (job >> 1) & 7, b = job >> 4;
        __syncthreads();
        { int tz_ = F.tid; asm volatile("" : "+v"(tz_)); const int key = tz_ >> 1, hf = tz_ & 1; const bf16_t* src = U + (size_t)(NLAT + b * CTXL + key) * DIN + UK + h * 64 + hf * 32; LAS bf16_t* dst = (LAS bf16_t*)(F.lds + NA_KC) + key * 72 + hf * 32;
#pragma unroll
          for (int j = 0; j < 4; ++j) *(LAS bf16x8*)(dst + j * 8) = gld16(src + j * 8);
          const int dv = tz_ >> 3, seg = tz_ & 7; const bf16_t* vs = (const bf16_t*)(F.ws + WS_VT) + ((size_t)b * 512 + h * 64 + dv) * SPB + SEQ + seg * 32; LAS bf16_t* vd = (LAS bf16_t*)(F.lds + NA_VC) + dv * 264 + seg * 32;
#pragma unroll
          for (int j = 0; j < 4; ++j) *(LAS bf16x8*)(vd + j * 8) = gld16(vs + j * 8); }
        __syncthreads();
        for (int uu = F.wave; uu < 128; uu += NWAVES) na_unit<true>(F, b, h, half * 32 + (uu >> 2), uu & 3);
        if (!last) na_unit<false>(F, b, h, 0, half * 8 + F.wave);
    }
}

constexpr int GL_LAF = 0, GL_LAB = 8448, GL_Q = 16896, GL_K = 25344;
constexpr int GL_QTF = 33792, GL_KTF = 38912, GL_QTB = 44032, GL_KTB = 49152;
constexpr int GL_KDF = 54272, GL_KDB = 58880;
constexpr int GL_VT = 63488, GL_ATT = 72704;
constexpr int GL_SF = 81920, GL_SB = 87040;
constexpr int GL_O = 92160;
constexpr int GL_SEG = 108800;
__device__ __forceinline__ float log_sigmoid_f(float x) { return fminf(x, 0.f) - log1pf(__expf(-fabsf(x))); }
__device__ __forceinline__ f32x4 mma_lds(const LAS bf16_t* A, int lda, const LAS bf16_t* B, int ldb, int ksteps, f32x4 acc, int lane) {
    const int r = lane & 15, g = lane >> 4;
    for (int ks = 0; ks < ksteps; ++ks) { const bf16x8 a = *(const LAS bf16x8*)(A + r * lda + ks * 32 + 8 * g), b = *(const LAS bf16x8*)(B + r * ldb + ks * 32 + 8 * g); acc = mfma16(a, b, acc); }
    return acc;
}
template <bool FULL>
__device__ __forceinline__ void gla_prep(Frame& F, int l, int b, int cn, int h) {
    const bf16_t* U = (const bf16_t*)(F.ws + WS_U);
    LAS float* LAF = (LAS float*)(F.lds + GL_LAF); LAS float* LAB = (LAS float*)(F.lds + GL_LAB); LAS float* Q = (LAS float*)(F.lds + GL_Q); LAS float* Kk = (LAS float*)(F.lds + GL_K);
    LAS bf16_t* VT = (LAS bf16_t*)(F.lds + GL_VT); LAS float* SEG = (LAS float*)(F.lds + GL_SEG);
    const bool lat = cn >= 4; const int row0 = lat ? b * SEQ + (cn - 4) * 64 : NLAT + b * CTXL + cn * 64;
    const int t = F.tid;
    { const int i = t >> 3, d4 = (t & 7) * 4; const bf16_t* p = U + (size_t)(row0 + i) * DIN;
      const u32x2 wq = *(const u32x2*)(p + UGQ + h * 32 + d4), wk = *(const u32x2*)(p + UGK + h * 32 + d4), wf = *(const u32x2*)(p + ULAF + h * 32 + d4), wb = *(const u32x2*)(p + ULAB + h * 32 + d4);
      const float* ba = F.in[I_BA2] + (size_t)l * 256 + h * 32 + d4;
      const float qs = 0.17677669529663687f;
      Q[i * 33 + d4 + 0] = bflo(wq.x) * qs; Q[i * 33 + d4 + 1] = bfhi(wq.x) * qs; Q[i * 33 + d4 + 2] = bflo(wq.y) * qs; Q[i * 33 + d4 + 3] = bfhi(wq.y) * qs;
      Kk[i * 33 + d4 + 0] = bflo(wk.x); Kk[i * 33 + d4 + 1] = bfhi(wk.x); Kk[i * 33 + d4 + 2] = bflo(wk.y); Kk[i * 33 + d4 + 3] = bfhi(wk.y);
      LAF[i * 33 + d4 + 0] = log_sigmoid_f(bflo(wf.x) + ba[0]) * 0.0625f; LAF[i * 33 + d4 + 1] = log_sigmoid_f(bfhi(wf.x) + ba[1]) * 0.0625f;
      LAF[i * 33 + d4 + 2] = log_sigmoid_f(bflo(wf.y) + ba[2]) * 0.0625f; LAF[i * 33 + d4 + 3] = log_sigmoid_f(bfhi(wf.y) + ba[3]) * 0.0625f;
      LAB[i * 33 + d4 + 0] = log_sigmoid_f(bflo(wb.x) + ba[128]) * 0.0625f; LAB[i * 33 + d4 + 1] = log_sigmoid_f(bfhi(wb.x) + ba[129]) * 0.0625f;
      LAB[i * 33 + d4 + 2] = log_sigmoid_f(bflo(wb.y) + ba[130]) * 0.0625f; LAB[i * 33 + d4 + 3] = log_sigmoid_f(bfhi(wb.y) + ba[131]) * 0.0625f;
      const int dv8 = (t & 7) * 8; const u32x4 wv = *(const u32x4*)(p + UGV + h * 64 + dv8); const unsigned av[4] = {wv.x, wv.y, wv.z, wv.w};
#pragma unroll
      for (int e = 0; e < 4; ++e) { VT[(dv8 + 2 * e) * 72 + i] = (bf16_t)(av[e] & 0xffffu); VT[(dv8 + 2 * e + 1) * 72 + i] = (bf16_t)(av[e] >> 16); }
    }
    __syncthreads();
    if (lat) {
        for (int e = t; e < 64 * 16 * 2; e += NTHR) {
            const int which = e >> 10, i = (e >> 4) & 63, p = e & 15, half = p >> 3, idx = p & 7;
            const float pos = half ? (float)i : (float)(cn - 4);
            const float inv = __expf(-(float)idx * (9.210340371976184f / 8.0f));
            const float sn = __sinf(pos * inv), cs = __cosf(pos * inv);
            LAS float* A = which ? Kk : Q; const int d1 = half * 16 + idx;
            const float x1 = A[i * 33 + d1], x2 = A[i * 33 + d1 + 8];
            A[i * 33 + d1] = x1 * cs - x2 * sn; A[i * 33 + d1 + 8] = x1 * sn + x2 * cs;
        }
    }
    { const int x = t & 63, d = x & 31, dir = x >> 5, seg = t >> 6; LAS float* LA = dir ? LAB : LAF; float run = 0.f;
#pragma unroll
      for (int k = 0; k < 8; ++k) { const int p = seg * 8 + k, i = dir ? 63 - p : p; run += LA[i * 33 + d]; LA[i * 33 + d] = run; }
      SEG[x * 9 + seg] = run;
    }
    __syncthreads();
    { const int x = t & 63, d = x & 31, dir = x >> 5, seg = t >> 6; LAS float* LA = dir ? LAB : LAF; float pre = 0.f;
      for (int s2 = 0; s2 < seg; ++s2) pre += SEG[x * 9 + s2];
#pragma unroll
      for (int k = 0; k < 8; ++k) { const int p = seg * 8 + k, i = dir ? 63 - p : p; LA[i * 33 + d] += pre; }
    }
    __syncthreads();
    LAS bf16_t* QTF = (LAS bf16_t*)(F.lds + GL_QTF); LAS bf16_t* KTF = (LAS bf16_t*)(F.lds + GL_KTF); LAS bf16_t* QTB = (LAS bf16_t*)(F.lds + GL_QTB); LAS bf16_t* KTB = (LAS bf16_t*)(F.lds + GL_KTB);
    LAS bf16_t* KDF = (LAS bf16_t*)(F.lds + GL_KDF); LAS bf16_t* KDB = (LAS bf16_t*)(F.lds + GL_KDB);
    for (int e = t; e < 64 * 32; e += NTHR) {
        const int i = e >> 5, d = e & 31;
        const float bf = LAF[i * 33 + d], bb = LAB[i * 33 + d], bfl = LAF[63 * 33 + d], bbl = LAB[0 * 33 + d], kv = Kk[i * 33 + d];
        KDF[d * 72 + i] = (bf16_t)f2bf(kv * __expf(bfl - bf)); KDB[d * 72 + i] = (bf16_t)f2bf(kv * __expf(bbl - bb));
        if (FULL) { const float qv = Q[i * 33 + d];
            QTF[i * 40 + d] = (bf16_t)f2bf(qv * __expf(bf)); KTF[i * 40 + d] = (bf16_t)f2bf(kv * __expf(-bf));
            QTB[i * 40 + d] = (bf16_t)f2bf(qv * __expf(bb)); KTB[i * 40 + d] = (bf16_t)f2bf(kv * __expf(-bb)); }
    }
    __syncthreads();
}
__device__ __forceinline__ void ph_gla_local(Frame& F, int l) {
    LAS float* LAF = (LAS float*)(F.lds + GL_LAF); LAS float* LAB = (LAS float*)(F.lds + GL_LAB);
    for (int u = F.wg; u < NB * 68 * 4; u += F.G) {
        const int h = u & 3, cn = (u >> 2) % 68, b = (u >> 2) / 68;
        __syncthreads();
        gla_prep<false>(F, l, b, cn, h);
        const int mt = F.wave >> 1, nt = F.wave & 1, g = F.lane >> 4, c = F.lane & 15;
        float* DS = (float*)(F.ws + WS_GDS) + (size_t)u * 2 * 2048;
#pragma unroll
        for (int dir = 0; dir < 2; ++dir) {
            const LAS bf16_t* KD = (const LAS bf16_t*)(F.lds + (dir ? GL_KDB : GL_KDF));
            f32x4 a = (f32x4){0.f, 0.f, 0.f, 0.f};
            a = mma_lds((const LAS bf16_t*)(F.lds + GL_VT) + mt * 16 * 72, 72, KD + nt * 16 * 72, 72, 2, a, F.lane);
#pragma unroll
            for (int e = 0; e < 4; ++e) DS[dir * 2048 + (mt * 16 + 4 * g + e) * 32 + nt * 16 + c] = a[e];
        }
        if (F.tid < 64) { const int d = F.tid & 31, dir = F.tid >> 5; ((float*)(F.ws + WS_GD))[(size_t)u * 64 + F.tid] = __expf(dir ? LAB[0 * 33 + d] : LAF[63 * 33 + d]); }
    }
}
__device__ __forceinline__ void ph_gla_scan(Frame& F) {
    const int gt = F.wg * NTHR + F.tid, NGT = F.G * NTHR;
    const float* DS = (const float*)(F.ws + WS_GDS); const float* GD = (const float*)(F.ws + WS_GD); bf16_t* SIN = (bf16_t*)(F.ws + WS_GSIN);
    for (int w = gt; w < 128 * 1024; w += NGT) {
        const int chain = w >> 10, el = (w & 1023) * 2, dir = chain & 1, h = (chain >> 1) & 3, b = chain >> 3, d = el & 31;
        float s0 = 0.f, s1 = 0.f;
        for (int step = 0; step < 68; ++step) {
            const int cn = dir ? (step < 4 ? 3 - step : 71 - step) : step;
            const size_t u = (size_t)(b * 68 + cn) * 4 + h;
            *(unsigned*)(SIN + (u * 2 + dir) * 2048 + el) = pk2(s0, s1);
            const f32x2 ds = *(const f32x2*)(DS + (u * 2 + dir) * 2048 + el); const f32x2 dd = *(const f32x2*)(GD + u * 64 + dir * 32 + d);
            s0 = dd.x * s0 + ds.x; s1 = dd.y * s1 + ds.y;
        }
    }
}
__device__ __forceinline__ void ph_gla_out(Frame& F, int l, bool last) {
    const bf16_t* U = (const bf16_t*)(F.ws + WS_U);
    for (int u = F.wg; u < NB * 68 * 4; u += F.G) {
        const int h = u & 3, cn = (u >> 2) % 68, b = (u >> 2) / 68;
        if (last && cn < 4) continue;
        __syncthreads();
        gla_prep<true>(F, l, b, cn, h);
        const int t = F.tid;
        { const bf16_t* SIN = (const bf16_t*)(F.ws + WS_GSIN) + (size_t)u * 2 * 2048;
          for (int e = t; e < 2 * 64 * 4; e += NTHR) { const int dir = e >> 8, dv = (e >> 2) & 63, d8 = (e & 3) * 8;
              const u32x4 v = *(const u32x4*)(SIN + dir * 2048 + dv * 32 + d8); *(LAS u32x4*)((LAS bf16_t*)(F.lds + (dir ? GL_SB : GL_SF)) + dv * 40 + d8) = v; } }
        const int g = F.lane >> 4, c = F.lane & 15;
        LAS bf16_t* ATT = (LAS bf16_t*)(F.lds + GL_ATT);
#pragma unroll
        for (int k = 0; k < 2; ++k) { const int tile = F.wave + 8 * k, mt = tile >> 2, nt = tile & 3;
            f32x4 af = (f32x4){0.f, 0.f, 0.f, 0.f}, ab = af;
            af = mma_lds((const LAS bf16_t*)(F.lds + GL_QTF) + mt * 16 * 40, 40, (const LAS bf16_t*)(F.lds + GL_KTF) + nt * 16 * 40, 40, 1, af, F.lane);
            ab = mma_lds((const LAS bf16_t*)(F.lds + GL_QTB) + mt * 16 * 40, 40, (const LAS bf16_t*)(F.lds + GL_KTB) + nt * 16 * 40, 40, 1, ab, F.lane);
#pragma unroll
            for (int e = 0; e < 4; ++e) { const int i = mt * 16 + 4 * g + e, j = nt * 16 + c; const float v = (j <= i ? af[e] : 0.f) + (j >= i ? ab[e] : 0.f); ATT[i * 72 + j] = (bf16_t)f2bf(v); } }
        __syncthreads();
        LAS float* O = (LAS float*)(F.lds + GL_O);
#pragma unroll
        for (int k = 0; k < 2; ++k) { const int tile = F.wave + 8 * k, mt = tile >> 2, nt = tile & 3;
            f32x4 a = (f32x4){0.f, 0.f, 0.f, 0.f};
            a = mma_lds(ATT + mt * 16 * 72, 72, (const LAS bf16_t*)(F.lds + GL_VT) + nt * 16 * 72, 72, 2, a, F.lane);
            a = mma_lds((const LAS bf16_t*)(F.lds + GL_QTF) + mt * 16 * 40, 40, (const LAS bf16_t*)(F.lds + GL_SF) + nt * 16 * 40, 40, 1, a, F.lane);
            a = mma_lds((const LAS bf16_t*)(F.lds + GL_QTB) + mt * 16 * 40, 40, (const LAS bf16_t*)(F.lds + GL_SB) + nt * 16 * 40, 40, 1, a, F.lane);
#pragma unroll
            for (int e = 0; e < 4; ++e) O[(mt * 16 + 4 * g + e) * 65 + nt * 16 + c] = a[e]; }
        __syncthreads();
        { const int i = t >> 3, dv8 = (t & 7) * 8; const bool lat = cn >= 4; const int row = (lat ? b * SEQ + (cn - 4) * 64 : NLAT + b * CTXL + cn * 64) + i;
          float v[8]; float ss = 0.f;
#pragma unroll
          for (int e = 0; e < 8; ++e) { v[e] = O[i * 65 + dv8 + e]; ss += v[e] * v[e]; }
          ss += shx(ss, 1, F.lane); ss += shx(ss, 2, F.lane); ss += shx(ss, 4, F.lane);
          const float rs = 1.0f / sqrtf(ss * (1.0f / 64.0f) + LN_EPS);
          const u32x4 gw = *(const u32x4*)(U + (size_t)row * DIN + UGR + h * 64 + dv8); const unsigned ga[4] = {gw.x, gw.y, gw.z, gw.w};
          const float* gn = F.in[I_GNORM] + l * 64 + dv8;
          float o[8];
#pragma unroll
          for (int e = 0; e < 4; ++e) { o[2 * e] = v[2 * e] * rs * gn[2 * e] * silu_f(bflo(ga[e])); o[2 * e + 1] = v[2 * e + 1] * rs * gn[2 * e + 1] * silu_f(bfhi(ga[e])); }
          u32x4 w; w.x = pk2(o[0], o[1]); w.y = pk2(o[2], o[3]); w.z = pk2(o[4], o[5]); w.w = pk2(o[6], o[7]);
          *(u32x4*)((bf16_t*)(F.ws + WS_MIX) + (size_t)row * DM + 512 + h * 64 + dv8) = w; }
    }
}

template <int L>
__device__ __forceinline__ void hyena_conv(Frame& F, const bf16_t* Rg, const bf16_t* Uin, const bf16_t* Xmul, int pos0, bool final_out, int ch, bf16_t* Zout) {
    constexpr int CS = 2 * L + 16;
    constexpr int NTL = L / 16, J = (NTL >= 64) ? 16 : 2, NGRP = NTL / J, HJ = J / 2, NSTEP = L / 32;
    LAS bf16_t* Rl = (LAS bf16_t*)F.lds;
    __syncthreads();
    for (int c = F.tid; c < 2 * L / 8; c += NTHR) { const u32x4 v = *(const GAS u32x4*)(Rg + 8 * c); const unsigned a[4] = {v.x, v.y, v.z, v.w};
#pragma unroll
        for (int rho = 0; rho < 8; ++rho) { LAS bf16_t* d = Rl + rho * CS + 8 * c + rho;
#pragma unroll
            for (int k = 0; k < 4; ++k) { d[2 * k] = (bf16_t)(a[k] & 0xffffu); d[2 * k + 1] = (bf16_t)(a[k] >> 16); } } }
    __syncthreads();
    int ln_ = F.lane; asm volatile("" : "+v"(ln_));
    const int i = ln_ & 15, g = ln_ >> 4, rho = i & 7;
    const LAS bf16_t* Rc = Rl + rho * CS + rho;
    for (int grp = F.wave; grp < NGRP; grp += NWAVES) {
        f32x4 acc[J]; bf16x8 fr[J];
        const int tb = grp * J * 16;
        const LAS bf16_t* Rb = Rc + (L - tb - i + 8 * g);
#pragma unroll
        for (int j = 0; j < J; ++j) { acc[j] = (f32x4){0.f, 0.f, 0.f, 0.f}; fr[j] = *(const LAS bf16x8*)(Rb - 16 * j); }
        const char* ub = (const char*)(Uin + pos0); const unsigned ulo = (unsigned)((i * SPB + 8 * g) * 2);
        bf16x8 bcur = *(const GAS bf16x8*)(ub + (size_t)ulo);
#pragma unroll 1
        for (int q = 0; q < NSTEP / HJ; ++q) {
#pragma unroll
            for (int m = 0; m < HJ; ++m) {
                const int n = q * HJ + m;
                const int nn = (n + 1 < NSTEP) ? n + 1 : 0;
                const bf16x8 bnext = *(const GAS bf16x8*)(ub + (size_t)(ulo + (unsigned)nn * 64u));
                if (n > 0) { fr[(J - 2 * m) % J] = *(const LAS bf16x8*)(Rb + 32 * n); fr[(J + 1 - 2 * m) % J] = *(const LAS bf16x8*)(Rb + 32 * n - 16); }
#pragma unroll
                for (int j = 0; j < J; ++j) acc[j] = mfma16(fr[(j + J - 2 * m) % J], bcur, acc[j]);
                bcur = bnext;
            }
        }
#pragma unroll
        for (int j = 0; j < J; ++j) { const int t0 = tb + j * 16 + 4 * g;
            const u32x2 xw = *(const GAS u32x2*)(Xmul + (size_t)i * SPB + pos0 + t0);
            const float y0 = acc[j][0] * bflo(xw.x), y1 = acc[j][1] * bfhi(xw.x), y2 = acc[j][2] * bflo(xw.y), y3 = acc[j][3] * bfhi(xw.y);
            if (!final_out) { u32x2 w; w.x = pk2(y0, y1); w.y = pk2(y2, y3); *(GAS u32x2*)(Zout + (size_t)i * SPB + pos0 + t0) = w; }
            else { const int row = (pos0 ? NLAT + i * CTXL : i * SEQ) + t0; GAS bf16_t* mp = (GAS bf16_t*)((bf16_t*)(F.ws + WS_MIX) + (size_t)row * DM + 768 + ch);
                mp[0] = (bf16_t)f2bf(y0); mp[DM] = (bf16_t)f2bf(y1); mp[2 * DM] = (bf16_t)f2bf(y2); mp[3 * DM] = (bf16_t)f2bf(y3); } }
    }
}
__device__ __forceinline__ void ph_hyena(Frame& F, int l, bool last) {
    const bf16_t* HV = (const bf16_t*)(F.ws + WS_HV); bf16_t* Z2 = (bf16_t*)(F.ws + WS_Z2);
    for (int ch = F.wg; ch < 256; ch += F.G) {
        const bf16_t* v = HV + (size_t)(0 * 256 + ch) * NB * SPB; const bf16_t* x1 = HV + (size_t)(256 + ch) * NB * SPB; const bf16_t* x2 = HV + (size_t)(512 + ch) * NB * SPB;
        bf16_t* z = Z2 + (size_t)ch * NB * SPB;
        const bf16_t* R0 = (const bf16_t*)(F.ws + WS_HYF) + ((size_t)(l * 2 + 0) * 256 + ch) * 8192; const bf16_t* R1 = (const bf16_t*)(F.ws + WS_HYF) + ((size_t)(l * 2 + 1) * 256 + ch) * 8192;
        hyena_conv<4096>(F, R0, v, x1, 0, false, ch, z);
        VM_WAIT(); __syncthreads(); __builtin_amdgcn_fence(__ATOMIC_ACQUIRE, "agent"); VM_WAIT();
        hyena_conv<4096>(F, R1, z, x2, 0, true, ch, z);
        if (!last) {
            const bf16_t* C0 = (const bf16_t*)(F.ws + WS_HYFC) + ((size_t)(l * 2 + 0) * 256 + ch) * 512; const bf16_t* C1 = (const bf16_t*)(F.ws + WS_HYFC) + ((size_t)(l * 2 + 1) * 256 + ch) * 512;
            hyena_conv<256>(F, C0, v, x1, SEQ, false, ch, z);
            VM_WAIT(); __syncthreads(); __builtin_amdgcn_fence(__ATOMIC_ACQUIRE, "agent"); VM_WAIT();
            hyena_conv<256>(F, C1, z, x2, SEQ, true, ch, z);
        }
    }
}

__device__ __forceinline__ void unpack8(const u32x4 q, float* o) { o[0] = bflo(q.x); o[1] = bfhi(q.x); o[2] = bflo(q.y); o[3] = bfhi(q.y); o[4] = bflo(q.z); o[5] = bfhi(q.z); o[6] = bflo(q.w); o[7] = bfhi(q.w); }
__device__ __forceinline__ void ph_ln1(Frame& F, int l, int ntok) {
    const int gw = F.wg * NWAVES + F.wave, NGW = F.G * NWAVES;
    const float* lg = F.in[I_LN1G] + l * DM + 16 * F.lane; const float* lb = F.in[I_LN1B] + l * DM + 16 * F.lane;
    for (int row = gw; row < ntok; row += NGW) {
        bf16_t* xr = (bf16_t*)(F.ws + WS_XR) + (size_t)row * DM + 16 * F.lane;
        const bf16_t* yr = (const bf16_t*)(F.ws + WS_Y) + (size_t)row * DM + 16 * F.lane;
        const float* md = mod_ptr(F, l, row) + 16 * F.lane;
        bf16_t* xm = (bf16_t*)(F.ws + WS_XM) + (size_t)row * DM + 16 * F.lane;
        const u32x4 xa = *(const GAS u32x4*)xr, xb = *(const GAS u32x4*)(xr + 8), ya = *(const GAS u32x4*)yr, yb = *(const GAS u32x4*)(yr + 8);
        float x[16], y[16], v[16]; unpack8(xa, x); unpack8(xb, x + 8); unpack8(ya, y); unpack8(yb, y + 8);
        float s = 0.f;
#pragma unroll
        for (int j = 0; j < 4; ++j) { const f32x4 g1 = *(const GAS f32x4*)(md + 2048 + 4 * j);
#pragma unroll
            for (int e = 0; e < 4; ++e) { v[4 * j + e] = x[4 * j + e] * DN_ALPHA + g1[e] * y[4 * j + e]; s += v[4 * j + e]; } }
        const float mean = wave_sum(s, F.lane) * (1.f / DM); float s2 = 0.f;
#pragma unroll
        for (int e = 0; e < 16; ++e) { v[e] -= mean; s2 += v[e] * v[e]; }
        const float rstd = 1.f / sqrtf(wave_sum(s2, F.lane) * (1.f / DM) + LN_EPS);
        unsigned wx[8], wm[8]; int w8[4];
#pragma unroll
        for (int j = 0; j < 4; ++j) { const f32x4 g = *(const GAS f32x4*)(lg + 4 * j), bb = *(const GAS f32x4*)(lb + 4 * j), sh = *(const GAS f32x4*)(md + 3072 + 4 * j), sc = *(const GAS f32x4*)(md + 4096 + 4 * j);
            float xn[4];
#pragma unroll
            for (int e = 0; e < 4; ++e) xn[e] = v[4 * j + e] * rstd * g[e] + bb[e];
            wx[2 * j] = pk2(xn[0], xn[1]); wx[2 * j + 1] = pk2(xn[2], xn[3]);
            const float h0 = xn[0] * (1.f + sc[0]) + sh[0], h1 = xn[1] * (1.f + sc[1]) + sh[1], h2 = xn[2] * (1.f + sc[2]) + sh[2], h3 = xn[3] * (1.f + sc[3]) + sh[3];
            wm[2 * j] = pk2(h0, h1); wm[2 * j + 1] = pk2(h2, h3);
            int v = 0; v = __builtin_amdgcn_cvt_pk_fp8_f32(h0, h1, v, false); v = __builtin_amdgcn_cvt_pk_fp8_f32(h2, h3, v, true); w8[j] = v; }
        *(GAS u32x4*)((unsigned char*)(F.ws + WS_XM8) + (size_t)row * DM + 16 * F.lane) = (u32x4){(unsigned)w8[0], (unsigned)w8[1], (unsigned)w8[2], (unsigned)w8[3]};
        *(GAS u32x4*)xr = (u32x4){wx[0], wx[1], wx[2], wx[3]}; *(GAS u32x4*)(xr + 8) = (u32x4){wx[4], wx[5], wx[6], wx[7]};
        *(GAS u32x4*)xm = (u32x4){wm[0], wm[1], wm[2], wm[3]}; *(GAS u32x4*)(xm + 8) = (u32x4){wm[4], wm[5], wm[6], wm[7]};
    }
}
__device__ __forceinline__ void ph_ln2(Frame& F, int l, int ntok, bool last) {
    const int gw = F.wg * NWAVES + F.wave, NGW = F.G * NWAVES;
    const float* lg = F.in[I_LN2G] + l * DM; const float* lb = F.in[I_LN2B] + l * DM;
    for (int row = gw; row < ntok; row += NGW) {
        bf16_t* xr = (bf16_t*)(F.ws + WS_XR) + (size_t)row * DM + 16 * F.lane;
        const unsigned char* y2 = (const unsigned char*)(F.ws + WS_Y2) + (size_t)row * 9 * DM + 16 * F.lane;
        const float* wg = (const float*)(F.ws + WS_WGT) + (size_t)row * 8;
        const float* md = mod_ptr(F, l, row) + 16 * F.lane;
        float ff[16];
#pragma unroll
        for (int e = 0; e < 16; ++e) ff[e] = 0.f;
        u32x4 q[9];
#pragma unroll
        for (int k = 0; k < 9; ++k) q[k] = *(const GAS u32x4*)(y2 + (size_t)k * DM);
#pragma unroll
        for (int k = 0; k < 9; ++k) { const float wk = (k < 8 ? wg[k] : 1.0f) * pg8::Y2_INV; const unsigned a[4] = {q[k].x, q[k].y, q[k].z, q[k].w};
#pragma unroll
            for (int e = 0; e < 4; ++e) { const f32x2 lo = __builtin_amdgcn_cvt_pk_f32_fp8((int)a[e], false), hi = __builtin_amdgcn_cvt_pk_f32_fp8((int)a[e], true);
                ff[4 * e] += wk * lo.x; ff[4 * e + 1] += wk * lo.y; ff[4 * e + 2] += wk * hi.x; ff[4 * e + 3] += wk * hi.y; } }
        float v[16], xo[16]; float s = 0.f;
        { const u32x4 xa = *(const GAS u32x4*)xr, xb = *(const GAS u32x4*)(xr + 8); unpack8(xa, xo); unpack8(xb, xo + 8); }
#pragma unroll
        for (int j = 0; j < 4; ++j) { const f32x4 g2 = *(const GAS f32x4*)(md + 5120 + 4 * j);
#pragma unroll
            for (int e = 0; e < 4; ++e) { v[4 * j + e] = xo[4 * j + e] * DN_ALPHA + g2[e] * ff[4 * j + e]; s += v[4 * j + e]; } }
        const float mean = wave_sum(s, F.lane) * (1.f / DM); float s2 = 0.f;
#pragma unroll
        for (int e = 0; e < 16; ++e) { v[e] -= mean; s2 += v[e] * v[e]; }
        const float rstd = 1.f / sqrtf(wave_sum(s2, F.lane) * (1.f / DM) + LN_EPS);
        const float* mdn = (last ? mod_ptr(F, l, row) : mod_ptr(F, l + 1, row)) + 16 * F.lane;
        bf16_t* xm = (bf16_t*)(F.ws + WS_XM) + (size_t)row * DM + 16 * F.lane;
        float xn[16];
#pragma unroll
        for (int j = 0; j < 4; ++j) { const f32x4 g = *(const GAS f32x4*)(lg + 16 * F.lane + 4 * j), bb = *(const GAS f32x4*)(lb + 16 * F.lane + 4 * j);
#pragma unroll
            for (int e = 0; e < 4; ++e) xn[4 * j + e] = v[4 * j + e] * rstd * g[e] + bb[e]; }
        if (last) { float* op = F.out + (size_t)row * DM + 16 * F.lane;
#pragma unroll
            for (int j = 0; j < 4; ++j) *(GAS f32x4*)(op + 4 * j) = (f32x4){xn[4 * j], xn[4 * j + 1], xn[4 * j + 2], xn[4 * j + 3]}; }
        else { *(GAS u32x4*)xr = (u32x4){pk2(xn[0], xn[1]), pk2(xn[2], xn[3]), pk2(xn[4], xn[5]), pk2(xn[6], xn[7])}; *(GAS u32x4*)(xr + 8) = (u32x4){pk2(xn[8], xn[9]), pk2(xn[10], xn[11]), pk2(xn[12], xn[13]), pk2(xn[14], xn[15])}; }
        if (!last) {
            unsigned w[8];
#pragma unroll
            for (int j = 0; j < 4; ++j) { const f32x4 sh = *(const GAS f32x4*)(mdn + 4 * j), sc = *(const GAS f32x4*)(mdn + 1024 + 4 * j);
                w[2 * j] = pk2(xn[4 * j] * (1.f + sc[0]) + sh[0], xn[4 * j + 1] * (1.f + sc[1]) + sh[1]); w[2 * j + 1] = pk2(xn[4 * j + 2] * (1.f + sc[2]) + sh[2], xn[4 * j + 3] * (1.f + sc[3]) + sh[3]); }
            *(GAS u32x4*)xm = (u32x4){w[0], w[1], w[2], w[3]}; *(GAS u32x4*)(xm + 8) = (u32x4){w[4], w[5], w[6], w[7]};
        }
    }
}

__device__ __forceinline__ unsigned f_ord(float f) { const unsigned u = __builtin_bit_cast(unsigned, f); return (u & 0x80000000u) ? ~u : (u | 0x80000000u); }
__device__ __forceinline__ unsigned long long wave_max_u64(unsigned long long v, int lane) {
#pragma unroll
    for (int o = 1; o < 64; o <<= 1) { const unsigned lo = (unsigned)shxi((int)(unsigned)v, o, lane), hi = (unsigned)shxi((int)(unsigned)(v >> 32), o, lane); const unsigned long long w = ((unsigned long long)hi << 32) | lo; v = w > v ? w : v; }
    return v;
}
__device__ __forceinline__ float seg16_max(float v, int lane) { v = fmaxf(v, shx(v, 1, lane)); v = fmaxf(v, shx(v, 2, lane)); v = fmaxf(v, shx(v, 4, lane)); v = fmaxf(v, shx(v, 8, lane)); return v; }
__device__ __forceinline__ int seg16_min_i(int v, int lane) { int w; w = shxi(v, 1, lane); v = w < v ? w : v; w = shxi(v, 2, lane); v = w < v ? w : v; w = shxi(v, 4, lane); v = w < v ? w : v; w = shxi(v, 8, lane); v = w < v ? w : v; return v; }
__device__ __forceinline__ float seg16_top2(float v, int lane) {
    const float m1 = seg16_max(v, lane);
    const int first = seg16_min_i(v == m1 ? (lane & 15) : 99, lane);
    const float m2 = seg16_max((lane & 15) == first ? -3.0e38f : v, lane);
    return m1 + m2;
}
__device__ __forceinline__ void ph_route(Frame& F, int l, int ntok) {
    LAS int* hist = (LAS int*)F.lds;
    LAS int* base = hist + 128;
    LAS unsigned* alist = (LAS unsigned*)(F.lds + 1024);
    const int tpw = (ntok + F.G - 1) / F.G, t0 = F.wg * tpw, t1 = (t0 + tpw) < ntok ? (t0 + tpw) : ntok;
    __syncthreads();
    if (F.tid < 128) hist[F.tid] = 0;
    __syncthreads();
    const float* LG = (const float*)(F.ws + WS_LOGIT); const float* rb = F.in[I_RB] + l * NEXP;
    const float b0 = rb[F.lane], b1 = rb[F.lane + 64];
    for (int tok = t0 + F.wave; tok < t1; tok += NWAVES) {
        const float x0 = LG[(size_t)tok * 256 + F.lane], x1 = LG[(size_t)tok * 256 + 64 + F.lane];
        const float s0 = 1.0f / (1.0f + __expf(-x0)), s1 = 1.0f / (1.0f + __expf(-x1));
        const float e0 = s0 + b0, e1 = s1 + b1;
        const float gs0 = seg16_top2(e0, F.lane), gs1 = seg16_top2(e1, F.lane);
        float gsc[8];
#pragma unroll
        for (int g = 0; g < 4; ++g) { gsc[g] = shf(gs0, g * 16); gsc[4 + g] = shf(gs1, g * 16); }
        unsigned gmask = 0u;
#pragma unroll
        for (int g = 0; g < 8; ++g) { int cnt = 0;
#pragma unroll
            for (int g2 = 0; g2 < 8; ++g2) cnt += (gsc[g2] > gsc[g] || (gsc[g2] == gsc[g] && g2 < g)) ? 1 : 0;
            gmask |= (cnt < 4) ? (1u << g) : 0u; }
        const bool ok0 = (gmask >> (F.lane >> 4)) & 1u, ok1 = (gmask >> (4 + (F.lane >> 4))) & 1u;
        unsigned long long k0 = ok0 ? (((unsigned long long)f_ord(e0) << 32) | (unsigned)(255 - F.lane)) : 0ull;
        unsigned long long k1 = ok1 ? (((unsigned long long)f_ord(e1) << 32) | (unsigned)(255 - 64 - F.lane)) : 0ull;
        int mye = 0; float myw = 0.f; float wsum = 0.f;
#pragma unroll
        for (int k = 0; k < 8; ++k) {
            const unsigned long long best = wave_max_u64(k0 > k1 ? k0 : k1, F.lane);
            const int e = 255 - (int)(best & 0xffu);
            if (k0 == best) k0 = 0ull; if (k1 == best) k1 = 0ull;
            const float sv = shf(e < 64 ? s0 : s1, e & 63);
            wsum += sv; if (F.lane == k) { mye = e; myw = sv; }
        }
        if (F.lane < 8) {
            const int lr = __hip_atomic_fetch_add(&hist[mye], 1, __ATOMIC_RELAXED, __HIP_MEMORY_SCOPE_WORKGROUP);
            alist[(tok - t0) * 8 + F.lane] = (unsigned)mye | ((unsigned)lr << 8);
            ((int*)(F.ws + WS_EIDX))[(size_t)tok * 8 + F.lane] = mye;
            ((float*)(F.ws + WS_WGT))[(size_t)tok * 8 + F.lane] = myw / wsum * 2.5f;
        }
    }
    __syncthreads();
    if (F.tid < 128) { const int hcount = hist[F.tid]; base[F.tid] = hcount ? (int)atomicAdd(F.ctl + CW_CNT + l * 256 + F.tid, (unsigned)hcount) : 0; }
    __syncthreads();
    for (int a = F.tid; a < (t1 - t0) * 8; a += NTHR) { const unsigned v = alist[a]; ((int*)(F.ws + WS_RNK))[(size_t)t0 * 8 + a] = base[v & 0xffu] + (int)(v >> 8); }
}
__device__ __forceinline__ void ph_positions(Frame& F, int l, int ntok) {
    LAS int* cnt = (LAS int*)F.lds;
    LAS int* off = cnt + 132;
    __syncthreads();
    if (F.tid < NE1) cnt[F.tid] = F.tid < NEXP ? (int)__hip_atomic_load(F.ctl + CW_CNT + l * 256 + F.tid, __ATOMIC_RELAXED, __HIP_MEMORY_SCOPE_AGENT) : ntok;
    __syncthreads();
    if (F.tid == 0) { int o = 0; for (int e = 0; e < NE1; ++e) { off[e] = o; o += (cnt[e] + 255) & ~255; } off[NE1] = o; }
    __syncthreads();
    const int gt = F.wg * NTHR + F.tid, NGT = F.G * NTHR;
    int* rowtok = (int*)(F.ws + WS_ROWTOK); int* rowdst = (int*)(F.ws + WS_ROWDST); int* tile_exp = (int*)(F.ws + WS_TILEEXP);
    const int* eidx = (const int*)(F.ws + WS_EIDX); const int* rnk = (const int*)(F.ws + WS_RNK);
    for (int a = gt; a < ntok * 8; a += NGT) { const int tok = a >> 3, k = a & 7; const int pos = off[eidx[a]] + rnk[a]; rowtok[pos] = tok; rowdst[pos] = tok * 9 + k; }
    for (int tok = gt; tok < ntok; tok += NGT) { const int pos = off[NEXP] + tok; rowtok[pos] = tok; rowdst[pos] = tok * 9 + 8; }
    for (int i = gt; i < NE1 * 256; i += NGT) { const int e = i >> 8, p = i & 255; const int row = off[e] + cnt[e] + p; if (row < off[e + 1]) { rowtok[row] = 0; rowdst[row] = -1; } }
    for (int i = gt; i < NE1 * 320; i += NGT) { const int e = i / 320, p = i % 320; const int t = (off[e] >> 8) + p; if (t < (off[e + 1] >> 8)) tile_exp[t] = e; }
    if (gt == 0) F.ctl[CW_NTL + l] = (unsigned)(off[NE1] >> 8);
}

#ifndef MK_MULTI
#define MK_MULTI 0
#endif
constexpr int PH_PER_LAYER = 12, NPHASE = 2 + DEPTH * PH_PER_LAYER;
struct Args { const float* in[36]; float* out; unsigned char* ws; int ph_lo, ph_hi; };

__global__ void __launch_bounds__(NTHR, 2) mk_fwd(Args args) {
    extern __shared__ __attribute__((aligned(16))) unsigned char lds_raw[];
    Frame F;
    F.lds = (LAS unsigned char*)lds_raw;
    F.tid = threadIdx.x; F.lane = F.tid & 63; F.wave = __builtin_amdgcn_readfirstlane(F.tid >> 6);
    const int wave0 = F.wave;
    F.G = gridDim.x; F.wg = blockIdx.x;
    F.in = args.in;
    F.out = args.out; F.ws = args.ws; F.ctl = (unsigned*)(args.ws + WS_CTL);
    volatile LAS unsigned* MISC = (volatile LAS unsigned*)(F.lds + MISC_OFF);
    if (F.tid < 32) MISC[F.tid] = 0u;
    __syncthreads();
    const int lo = args.ph_lo, hi = args.ph_hi;
    const bool single = (hi - lo) > 1;
    XcdBarrier bar; bar.bar = F.ctl + CW_BAR; bar.x = 0; bar.st = nullptr;
    if (single) bar = xcd_barrier_post(F.ctl + CW_BAR, MISC + 8);
#define IN(k) (lo <= (k) && (k) < hi)
#ifndef PROBE_MASK
#define PROBE_MASK 0
#endif
#define REP(k) for (int _rep = 0; _rep < (((PROBE_MASK >> (k)) & 1) ? 2 : 1); ++_rep)
#define SEAM(k) do { if (IN(k) && IN((k) + 1)) xcd_barrier(bar); } while (0)
#define FRESH() do { int _ln; asm volatile("v_mbcnt_lo_u32_b32 %0, -1, 0\n\tv_mbcnt_hi_u32_b32 %0, -1, %0" : "=v"(_ln)); int _wv = wave0; asm volatile("" : "+s"(_wv)); F.lane = _ln; F.wave = _wv; F.tid = (_wv << 6) | _ln; \
        unsigned char* _w = args.ws; asm volatile("" : "+s"(_w)); F.ws = _w; F.ctl = (unsigned*)(_w + WS_CTL); float* _o = args.out; asm volatile("" : "+s"(_o)); F.out = _o; } while (0)

    if (IN(0)) { FRESH(); p0_static_weights(F); __syncthreads(); p0_mod(F); __syncthreads(); p0_hyena_filters(F); }
    SEAM(0);
    if (IN(1)) { FRESH(); p0_init_rows(F); }
    SEAM(1);
#pragma unroll 1
    for (int l = 0; l < DEPTH; ++l) {
        const int pb = 2 + l * PH_PER_LAYER; const bool last = (l == DEPTH - 1); const int ntok = last ? NLAT : NROW;
        if (IN(pb + 0)) { FRESH();
            REP(0) { p_expert_weights(F, l); __syncthreads(); }
            pg8::DenseOrder S; S.init(NROW, DIN, F.G, F.wg); pg8::EpiBf16 E{(bf16_t*)(F.ws + WS_U), DIN};
            REP(1) pg8::gemm_phase<pg8::EpiBf16, pg8::DenseOrder, false>(F.tid, F.lds, (const bf16_t*)(F.ws + WS_XM), (const bf16_t*)(F.ws + WS_WIN) + (size_t)l * DIN * DM, DM, nullptr, S, E);
        }
        SEAM(pb + 0);
        if (IN(pb + 1)) { FRESH(); REP(2) { ph_transposes(F, l); __syncthreads(); } REP(3) { ph_gla_local(F, l); __syncthreads(); } }
        SEAM(pb + 1);
        if (IN(pb + 2)) { FRESH(); REP(4) { ph_na(F, l, last); } REP(5) { ph_gla_scan(F); } __syncthreads(); REP(6) { ph_hyena(F, l, last); } }
        SEAM(pb + 2);
        if (IN(pb + 3)) { FRESH(); REP(7) { ph_gla_out(F, l, last); } }
        SEAM(pb + 3);
        if (IN(pb + 4)) { FRESH();
            pg8::DenseOrder S; S.init(ntok, DM, F.G, F.wg); pg8::EpiBf16 E{(bf16_t*)(F.ws + WS_Y), DM};
            REP(8) pg8::gemm_phase<pg8::EpiBf16, pg8::DenseOrder, false>(F.tid, F.lds, (const bf16_t*)(F.ws + WS_MIX), (const bf16_t*)(F.ws + WS_WOUT) + (size_t)l * DM * DM, DM, nullptr, S, E);
        }
        SEAM(pb + 4);
        if (IN(pb + 5)) { FRESH(); ph_ln1(F, l, ntok); }
        SEAM(pb + 5);
        if (IN(pb + 6)) { FRESH();
            pg8::DenseOrder S; S.init(ntok, 256, F.G, F.wg); pg8::EpiF32 E{(float*)(F.ws + WS_LOGIT), 256};
            REP(9) pg8::gemm_phase<pg8::EpiF32, pg8::DenseOrder, false>(F.tid, F.lds, (const bf16_t*)(F.ws + WS_XM), (const bf16_t*)(F.ws + WS_WR) + (size_t)l * 256 * DM, DM, nullptr, S, E);
        }
        SEAM(pb + 6);
        if (IN(pb + 7)) { FRESH(); ph_route(F, l, ntok); }
        SEAM(pb + 7);
        if (IN(pb + 8)) { FRESH(); REP(12) { ph_positions(F, l, ntok); __syncthreads(); } }
        SEAM(pb + 8);
        if (IN(pb + 9)) { FRESH();
            const int ntl = (int)__hip_atomic_load(F.ctl + CW_NTL + l, __ATOMIC_RELAXED, __HIP_MEMORY_SCOPE_AGENT);
            pg8::GroupedOrder S; S.init((const int*)(F.ws + WS_TILEEXP), ntl, 2, F.G, F.wg); pg8::EpiSwiglu E{(unsigned char*)(F.ws + WS_ACT)};
            REP(10) pg8::gemm_phase<pg8::EpiSwiglu, pg8::GroupedOrder, true, true>(F.tid, F.lds, (const void*)(F.ws + WS_XM8), (const void*)(F.ws + WS_EXP1), DM, (const int*)(F.ws + WS_ROWTOK), S, E);
        }
        SEAM(pb + 9);
        if (IN(pb + 10)) { FRESH();
            const int ntl = (int)__hip_atomic_load(F.ctl + CW_NTL + l, __ATOMIC_RELAXED, __HIP_MEMORY_SCOPE_AGENT);
            pg8::GroupedOrder S; S.init((const int*)(F.ws + WS_TILEEXP), ntl, 4, F.G, F.wg); pg8::EpiScatter E{(unsigned char*)(F.ws + WS_Y2), (const int*)(F.ws + WS_ROWDST)};
            REP(11) pg8::gemm_phase<pg8::EpiScatter, pg8::GroupedOrder, false, true>(F.tid, F.lds, (const void*)(F.ws + WS_ACT), (const void*)(F.ws + WS_EXP2), EH, nullptr, S, E);
        }
        SEAM(pb + 10);
        if (IN(pb + 11)) { FRESH(); ph_ln2(F, l, ntok, last); }
        SEAM(pb + 11);
    }
#undef IN
#undef SEAM
#undef FRESH
}

extern "C" void kernel_launch(void* const* d_in, const int* in_sizes, int n_in, void* d_out, int out_size, void* d_ws, size_t ws_size, hipStream_t stream) {
    static int grid = 0;
    if (grid == 0) {
        if (n_in != 36 || out_size != NLAT * DM || ws_size < WS_END) { fprintf(stderr, "kernel_launch: unexpected shapes (n_in %d out %d ws %zu need %zu)\n", n_in, out_size, ws_size, (size_t)WS_END); grid = -1; return; }
        int dev = 0, cus = 0, per_cu = 0;
        if (hipGetDevice(&dev) != hipSuccess || hipDeviceGetAttribute(&cus, hipDeviceAttributeMultiprocessorCount, dev) != hipSuccess) { grid = -1; return; }
        if (hipFuncSetAttribute((const void*)mk_fwd, hipFuncAttributeMaxDynamicSharedMemorySize, LDS_BYTES) != hipSuccess) { fprintf(stderr, "kernel_launch: hipFuncSetAttribute failed\n"); grid = -1; return; }
        if (hipOccupancyMaxActiveBlocksPerMultiprocessor(&per_cu, (const void*)mk_fwd, NTHR, LDS_BYTES) != hipSuccess || per_cu < 1) { fprintf(stderr, "kernel_launch: occupancy query says %d\n", per_cu); }
        (void)hipGetLastError();
        grid = cus;
    }
    if (grid < 0) return;
    (void)hipMemsetAsync((char*)d_ws + WS_CTL, 0, CTL_BYTES, stream);
    Args a{};
    for (int i = 0; i < 36; ++i) a.in[i] = (const float*)d_in[i];
    a.out = (float*)d_out; a.ws = (unsigned char*)d_ws;
#if MK_MULTI
    for (int p = 0; p < NPHASE; ++p) { a.ph_lo = p; a.ph_hi = p + 1; hipLaunchKernelGGL(mk_fwd, dim3(grid), dim3(NTHR), LDS_BYTES, stream, a); }
#else
    a.ph_lo = 0; a.ph_hi = NPHASE; hipLaunchKernelGGL(mk_fwd, dim3(grid), dim3(NTHR), LDS_BYTES, stream, a);
#endif
}
```

```cpp
#include <hip/hip_runtime.h>
#include <cstdio>
#include <cstdint>

#define LAS __attribute__((address_space(3)))
#define GAS __attribute__((address_space(1)))
typedef unsigned short bf16_t;
typedef short bf16x8 __attribute__((ext_vector_type(8)));
typedef float f32x4 __attribute__((ext_vector_type(4)));
typedef float f32x2 __attribute__((ext_vector_type(2)));
typedef unsigned u32x4 __attribute__((ext_vector_type(4)));
typedef unsigned u32x2 __attribute__((ext_vector_type(2)));

constexpr int NB = 16, SEQ = 4096, CTXL = 256, DM = 1024, DEPTH = 4;
constexpr int NLAT = NB * SEQ;
constexpr int NCTX = NB * CTXL;
constexpr int NROW = NLAT + NCTX;
constexpr int SPB = SEQ + CTXL;
constexpr int DIN_REF = 3104;
constexpr int DIN = 3328;
constexpr int UQ = 0, UK = 512, UV = 1024, UGQ = 1536, UGK = 1664, UGV = 1792, UGR = 2048, UHY = 2304, ULAF = 3072, ULAB = 3200;
constexpr int NEXP = 128, TOPK = 8, EH = 256;
constexpr int NE1 = NEXP + 1;
constexpr int RMAX = 659712;
constexpr int TMAX = RMAX / 256;
constexpr float LN_EPS = 1e-6f;
constexpr float DN_ALPHA = 1.6817928305074290f;

__device__ __forceinline__ unsigned f2bf(float f) { unsigned u = __builtin_bit_cast(unsigned, f); return (u + 0x7fffu + ((u >> 16) & 1u)) >> 16; }
typedef __bf16 bf16v2 __attribute__((ext_vector_type(2)));
__device__ __forceinline__ unsigned pk2(float lo, float hi) { const f32x2 v = {lo, hi}; const bf16v2 b = __builtin_convertvector(v, bf16v2); return __builtin_bit_cast(unsigned, b); }
__device__ __forceinline__ float bf2f(unsigned short b) { return __builtin_bit_cast(float, ((unsigned)b) << 16); }
__device__ __forceinline__ float bflo(unsigned w) { return __builtin_bit_cast(float, w << 16); }
__device__ __forceinline__ float bfhi(unsigned w) { return __builtin_bit_cast(float, w & 0xffff0000u); }
__device__ __forceinline__ float shx(float v, int o, int lane) { return __builtin_bit_cast(float, __builtin_amdgcn_ds_bpermute((lane ^ o) << 2, __builtin_bit_cast(int, v))); }
__device__ __forceinline__ int shxi(int v, int o, int lane) { return __builtin_amdgcn_ds_bpermute((lane ^ o) << 2, v); }
__device__ __forceinline__ float shf(float v, int src) { return __builtin_bit_cast(float, __builtin_amdgcn_ds_bpermute(src << 2, __builtin_bit_cast(int, v))); }
__device__ __forceinline__ float wave_sum(float v, int lane) {
#pragma unroll
    for (int o = 1; o < 64; o <<= 1) v += shx(v, o, lane);
    return v;
}
__device__ __forceinline__ float silu_f(float x) { return x / (1.0f + __expf(-x)); }
#define LDS_WAIT() asm volatile("s_waitcnt lgkmcnt(0)" ::: "memory")
#define VM_WAIT() asm volatile("s_waitcnt vmcnt(0)" ::: "memory")

#define XB_TMO      128
#define XB_XCNT(j)  (256  + 64 * (j))
#define XB_XSUB(j)  (1280 + 64 * (j))
#define XB_XGEN(j)  (2304 + 64 * (j))
#define XB_TOP      3328
#define XB_TOPGEN   3392
#define XCD_BAR_WORDS 3456
#define XB_SPIN_CAP (1u << 18)

__device__ __forceinline__ unsigned xb_ld(unsigned* p)              { return __hip_atomic_load(p, __ATOMIC_RELAXED, __HIP_MEMORY_SCOPE_AGENT); }
__device__ __forceinline__ unsigned xb_add(unsigned* p, unsigned v) { return __hip_atomic_fetch_add(p, v, __ATOMIC_RELAXED, __HIP_MEMORY_SCOPE_AGENT); }
__device__ __forceinline__ unsigned xb_xcc_id() { return (unsigned)__builtin_amdgcn_s_getreg((3 << 11) | 20) & 0xFu; }
#define XB_SPIN(cond, bar) do { unsigned _sp = 0; while (cond) { __builtin_amdgcn_s_sleep(1); \
    if ((++_sp & 255u) == 0u) { if (xb_ld(&(bar)[XB_TMO])) break; if (_sp > XB_SPIN_CAP) { atomicAdd(&(bar)[XB_TMO], 1u); break; } } } } while (0)

struct XcdBarrier { unsigned* bar; unsigned x; volatile LAS unsigned* st; };

__device__ __forceinline__ XcdBarrier xcd_barrier_post(unsigned* bar, volatile LAS unsigned* st) {
    XcdBarrier b; b.bar = bar; b.x = xb_xcc_id(); b.st = st;
    if (threadIdx.x == 0) (void)xb_add(&bar[XB_XCNT(b.x)], 1u);
    return b;
}
__device__ __forceinline__ void xcd_barrier_complete(unsigned* bar, unsigned x, unsigned& nloc, unsigned& nx) {
    const unsigned G = gridDim.x * gridDim.y * gridDim.z;
    unsigned sum, cnt, mine, sp = 0u;
    for (;;) {
        sum = 0u; cnt = 0u; mine = 0u;
#pragma unroll
        for (unsigned j = 0; j < 16; ++j) { const unsigned c = xb_ld(&bar[XB_XCNT(j)]); sum += c; cnt += (c > 0u) ? 1u : 0u; mine = (j == x) ? c : mine; }
        if (sum == G) break;
        __builtin_amdgcn_s_sleep(1);
        if ((++sp & 255u) == 0u) { if (xb_ld(&bar[XB_TMO])) break; if (sp > XB_SPIN_CAP) { atomicAdd(&bar[XB_TMO], 1u); break; } }
    }
    nloc = mine > 0u ? mine : 1u; nx = cnt > 0u ? cnt : 1u;
}
__device__ __forceinline__ void xcd_barrier(const XcdBarrier& b) {
    asm volatile("s_waitcnt vmcnt(0)" ::: "memory");
    __syncthreads();
    if (threadIdx.x == 0) {
        unsigned* bar = b.bar;
        __builtin_amdgcn_s_waitcnt(0);
        unsigned nloc = b.st[0], nx = b.st[1];
        if (nloc == 0u) { xcd_barrier_complete(bar, b.x, nloc, nx); b.st[0] = nloc; b.st[1] = nx; }
        const unsigned old = xb_add(&bar[XB_XSUB(b.x)], 1u);
        const unsigned gen = old / nloc;
        if (old + 1u == (gen + 1u) * nloc) {
            __builtin_amdgcn_fence(__ATOMIC_RELEASE, "agent");
            asm volatile("s_waitcnt vmcnt(0)" ::: "memory");
            const unsigned og = xb_add(&bar[XB_TOP], 1u);
            const unsigned tg = og / nx;
            if (og + 1u == (tg + 1u) * nx) xb_add(&bar[XB_TOPGEN], 1u);
            else XB_SPIN(xb_ld(&bar[XB_TOPGEN]) == tg, bar);
            __builtin_amdgcn_fence(__ATOMIC_ACQUIRE, "agent");
            xb_add(&bar[XB_XGEN(b.x)], 1u);
            asm volatile("s_waitcnt vmcnt(0)" ::: "memory");
        } else {
            XB_SPIN(xb_ld(&bar[XB_XGEN(b.x)]) == gen, bar);
            __builtin_amdgcn_fence(__ATOMIC_ACQUIRE, "agent");
            asm volatile("s_waitcnt vmcnt(0)" ::: "memory");
        }
    }
    __syncthreads();
}

namespace pg8 {
constexpr int BM = 256, BK = 64, HALF = 128, HTB = HALF * BK * 2, STAGE_BYTES = 8 * HTB, NXCD = 8, WGM = 8;
__host__ __device__ __forceinline__ int lds_byte(int r, int c) { const int st = (r >> 4) * 2 + (c >> 5), rr = r & 15, cc = c & 31, ob = rr * 64 + cc * 2; return st * 1024 + (ob ^ (((ob >> 9) & 1) << 5)); }
__host__ __device__ __forceinline__ void stage_rc(int b, int& R, int& C) { const int st = b / 1024, sb = b % 1024, swz = sb ^ (((sb >> 9) & 1) << 5); R = (st >> 1) * 16 + swz / 64; C = (st & 1) * 32 + (swz % 64) / 2; }
__host__ __device__ __forceinline__ int perm32(int rho) { const int n = rho >> 4, i = rho & 15; return 8 * (i >> 2) + 4 * n + (i & 3); }

struct Unit { int arow0, brow0, orow0, ocol0, aux; };

struct DenseOrder {
    int nM, nN, nwg, G, c;
    __device__ void init(int M, int N, int G_, int c_) { nM = M / BM; nN = N / BM; nwg = nM * nN; G = G_; c = c_; }
    __device__ __forceinline__ bool next(int i, Unit& u) const {
        const long L = (long)i * G + c; if (L >= nwg) return false;
        int wgid = (int)L; { const int q = nwg / NXCD, r = nwg % NXCD, xcd = wgid % NXCD, off = wgid / NXCD; wgid = (xcd < r ? xcd * (q + 1) : r * (q + 1) + (xcd - r) * q) + off; }
        const int nig = WGM * nN, gid = wgid / nig, fm = gid * WGM, gsz = (nM - fm) < WGM ? (nM - fm) : WGM;
        const int pm = fm + ((wgid % nig) % gsz), pn = (wgid % nig) / gsz;
        u.arow0 = pm * BM; u.brow0 = pn * BM; u.orow0 = pm * BM; u.ocol0 = pn * BM; u.aux = 0; return true;
    }
};
struct GroupedOrder {
    const int* tile_exp; int nN, nslot, slot, t0, t1;
    __device__ __forceinline__ void init(const int* te, int ntiles, int nN_, int G, int c) {
        tile_exp = te; nN = nN_;
        if ((G & 7) == 0) { const int per = (ntiles + 7) >> 3, x = c & 7; nslot = G >> 3; slot = c >> 3; t0 = x * per; t1 = (t0 + per) < ntiles ? (t0 + per) : ntiles; }
        else { nslot = G; slot = c; t0 = 0; t1 = ntiles; }
    }
    __device__ __forceinline__ bool next(int i, Unit& u) const {
        const int q = i * nslot + slot, t = t0 + q / nN, pn = q % nN;
        if (t >= t1) return false;
        const int e = tile_exp[t];
        u.arow0 = t * BM; u.brow0 = (e * nN + pn) * BM; u.orow0 = t * BM; u.ocol0 = pn * BM; u.aux = e; return true;
    }
};

__device__ __forceinline__ unsigned cvt_pk_bf16(float lo, float hi) { return pk2(lo, hi); }

struct NoPre {};
struct EpiF32 {
    static constexpr bool PERM = false; typedef NoPre Pre;
    __device__ __forceinline__ Pre prefetch(const Unit&, LAS unsigned char*, int, int, int) const { return Pre{}; }
    float* C; int ldc;
    __device__ __forceinline__ void operator()(const f32x4 (&acc)[2][2][4][2], const Unit& u, int wr, int wc, int fr, int fq, const Pre&) const {
        const int row0 = u.orow0 + wr * 64 + fr, col0 = u.ocol0 + wc * 32 + 4 * fq;
#pragma unroll
        for (int ai = 0; ai < 2; ++ai)
#pragma unroll
            for (int m = 0; m < 4; ++m) { float* rowp = C + (size_t)(row0 + ai * HALF + m * 16) * ldc + col0;
#pragma unroll
                for (int bj = 0; bj < 2; ++bj)
#pragma unroll
                    for (int n = 0; n < 2; ++n) *(f32x4*)(rowp + bj * HALF + n * 16) = acc[ai][bj][m][n]; }
    }
};
struct EpiBf16 {
    static constexpr bool PERM = true; typedef NoPre Pre;
    __device__ __forceinline__ Pre prefetch(const Unit&, LAS unsigned char*, int, int, int) const { return Pre{}; }
    bf16_t* O; int ldc;
    __device__ __forceinline__ void operator()(const f32x4 (&acc)[2][2][4][2], const Unit& u, int wr, int wc, int fr, int fq, const Pre&) const {
        const int row0 = u.orow0 + wr * 64 + fr, col0 = u.ocol0 + wc * 32 + 8 * fq;
#pragma unroll
        for (int ai = 0; ai < 2; ++ai)
#pragma unroll
            for (int m = 0; m < 4; ++m) { bf16_t* rowp = O + (size_t)(row0 + ai * HALF + m * 16) * ldc + col0;
#pragma unroll
                for (int bj = 0; bj < 2; ++bj) { const f32x4 v0 = acc[ai][bj][m][0], v1 = acc[ai][bj][m][1];
                    u32x4 w; w.x = cvt_pk_bf16(v0[0], v0[1]); w.y = cvt_pk_bf16(v0[2], v0[3]); w.z = cvt_pk_bf16(v1[0], v1[1]); w.w = cvt_pk_bf16(v1[2], v1[3]);
                    *(u32x4*)(rowp + bj * HALF) = w; } }
    }
};
struct EpiSwiglu {
    static constexpr bool PERM = false; typedef NoPre Pre;
    __device__ __forceinline__ Pre prefetch(const Unit&, LAS unsigned char*, int, int, int) const { return Pre{}; }
    unsigned char* ACT;
    __device__ __forceinline__ void operator()(const f32x4 (&acc)[2][2][4][2], const Unit& u, int wr, int wc, int fr, int fq, const Pre&) const {
        const int row0 = u.orow0 + wr * 64 + fr, pn = u.ocol0 >> 8;
#pragma unroll
        for (int ai = 0; ai < 2; ++ai)
#pragma unroll
            for (int m = 0; m < 4; ++m) { unsigned char* rowp = ACT + (size_t)(row0 + ai * HALF + m * 16) * EH + wc * 16 + 4 * fq;
#pragma unroll
                for (int bj = 0; bj < 2; ++bj) { const f32x4 g = acc[ai][bj][m][0], up = acc[ai][bj][m][1]; float h[4];
#pragma unroll
                    for (int i = 0; i < 4; ++i) h[i] = g[i] / (1.0f + __expf(-g[i])) * up[i];
                    int w = 0; w = __builtin_amdgcn_cvt_pk_fp8_f32(h[0], h[1], w, false); w = __builtin_amdgcn_cvt_pk_fp8_f32(h[2], h[3], w, true);
                    *(GAS unsigned*)(rowp + (pn * 2 + bj) * 64) = (unsigned)w; } }
    }
};
constexpr float Y2_SCALE = 16.0f, Y2_INV = 1.0f / 16.0f;
struct EpiScatter {
    static constexpr bool PERM = true;
    struct Pre { const LAS int* tab; };
    unsigned char* Y2; const int* rowdst;
    __device__ __forceinline__ Pre prefetch(const Unit& u, LAS unsigned char* lds, int wid, int lane, int ui) const {
        LAS unsigned char* tab = lds + STAGE_BYTES + (ui & 1) * 1024;
        if (wid < 4) __builtin_amdgcn_global_load_lds((const unsigned*)(rowdst + u.orow0 + wid * 64 + lane), (LAS unsigned*)(tab + wid * 256), 4, 0, 0);
        Pre p; p.tab = (const LAS int*)tab; return p; }
    __device__ __forceinline__ void operator()(const f32x4 (&acc)[2][2][4][2], const Unit& u, int wr, int wc, int fr, int fq, const Pre& pre) const {
        const int col0 = u.ocol0 + wc * 32 + 8 * fq;
#pragma unroll
        for (int ai = 0; ai < 2; ++ai)
#pragma unroll
            for (int m = 0; m < 4; ++m) { const int dst = pre.tab[wr * 64 + fr + ai * HALF + m * 16];
                if (dst >= 0) { unsigned char* rowp = Y2 + (size_t)dst * DM + col0;
#pragma unroll
                    for (int bj = 0; bj < 2; ++bj) { const f32x4 v0 = acc[ai][bj][m][0] * Y2_SCALE, v1 = acc[ai][bj][m][1] * Y2_SCALE;
                        int w0 = 0, w1 = 0;
                        w0 = __builtin_amdgcn_cvt_pk_fp8_f32(v0[0], v0[1], w0, false); w0 = __builtin_amdgcn_cvt_pk_fp8_f32(v0[2], v0[3], w0, true);
                        w1 = __builtin_amdgcn_cvt_pk_fp8_f32(v1[0], v1[1], w1, false); w1 = __builtin_amdgcn_cvt_pk_fp8_f32(v1[2], v1[3], w1, true);
                        *(GAS u32x2*)(rowp + bj * HALF) = (u32x2){(unsigned)w0, (unsigned)w1}; } } }
    }
};

typedef int v8i __attribute__((ext_vector_type(8)));
typedef int v4i __attribute__((ext_vector_type(4)));
struct Frag { bf16x8 p[2]; __device__ __forceinline__ bf16x8& operator[](int k) { return p[k]; } __device__ __forceinline__ const bf16x8& operator[](int k) const { return p[k]; } };
template <class Epi, class Sched, bool GATHER, bool F8 = false, bool ALIGN_EPI = true, bool SP2 = true>
__device__ __forceinline__ void gemm_phase(const int tid_in, LAS unsigned char* lds, const void* Ag, const void* Bg, const int K, const int* rowidx, const Sched& S, const Epi& E) {
    int tid_ = tid_in; asm volatile("" : "+v"(tid_));
    const int tid = tid_, wid = __builtin_amdgcn_readfirstlane(tid >> 6), lane = tid & 63, wr = wid >> 2, wc = wid & 3, fr = lane & 15, fq = lane >> 4;
    const int KB = F8 ? K : 2 * K;
    const int nt = KB / 128;
    unsigned voffB[2];
#pragma unroll
    for (int i = 0; i < 2; ++i) { int R, C; stage_rc(tid * 16 + i * 8192, R, C); const int Rb = Epi::PERM ? ((R & ~31) + perm32(R & 31)) : R;
        voffB[i] = (unsigned)(Rb * KB + C * 2); }
    const size_t kstep = (size_t)128;
    const size_t hstep = (size_t)HALF * KB;
    const unsigned ldsw = (unsigned)wid * 1024u;
    const int aoff = F8 ? lds_byte(wr * 64 + fr, 16 * fq) : lds_byte(wr * 64 + fr, fq * 8), boff = F8 ? lds_byte(wc * 32 + fr, 16 * fq) : lds_byte(wc * 32 + fr, fq * 8);
    constexpr int PIECE1 = F8 ? 16 : 1024;
    const int sc_w = 0x7A7A7A7A, sc_a = 0x7F7F7F7F;
#define PG8_SA(b, h) (((b) * 2 + (h)) * HTB)
#define PG8_SB(b, h) ((4 + (b) * 2 + (h)) * HTB)
#define PG8_STAGE_B(bufoff, gbase) do { _Pragma("unroll") for (int _i = 0; _i < 2; ++_i) \
        __builtin_amdgcn_global_load_lds((const unsigned*)((const char*)(gbase) + voffB[_i]), (LAS unsigned*)(lds + (bufoff) + ldsw + _i * 8192), 16, 0, 0); } while (0)
#define PG8_STAGE_A(bufoff, gbase, h) do { const char* _gb = (const char*)(gbase) + (GATHER ? (size_t)0 : (size_t)(h) * hstep); \
        __builtin_amdgcn_global_load_lds((const unsigned*)(_gb + ac[GATHER ? (h) : 0][0]), (LAS unsigned*)(lds + (bufoff) + ldsw), 16, 0, 0); \
        __builtin_amdgcn_global_load_lds((const unsigned*)(_gb + ac[GATHER ? (h) : 0][1]), (LAS unsigned*)(lds + (bufoff) + ldsw + 8192), 16, 0, 0); } while (0)
#define PG8_LDA(dst, b, h) do { _Pragma("unroll") for (int m = 0; m < 4; ++m) { if constexpr (F8) { const v4i _l = *(const LAS v4i*)(lds + PG8_SA(b, h) + aoff + m * 2048), _h = *(const LAS v4i*)(lds + PG8_SA(b, h) + aoff + m * 2048 + PIECE1); dst##8[m] = __builtin_shufflevector(_l, _h, 0, 1, 2, 3, 4, 5, 6, 7); } \
        else { dst[m][0] = *(const LAS bf16x8*)(lds + PG8_SA(b, h) + aoff + m * 2048); dst[m][1] = *(const LAS bf16x8*)(lds + PG8_SA(b, h) + aoff + m * 2048 + PIECE1); } } } while (0)
#define PG8_LDB(dst, b, h) do { _Pragma("unroll") for (int n = 0; n < 2; ++n) { if constexpr (F8) { const v4i _l = *(const LAS v4i*)(lds + PG8_SB(b, h) + boff + n * 2048), _h = *(const LAS v4i*)(lds + PG8_SB(b, h) + boff + n * 2048 + PIECE1); dst##8[n] = __builtin_shufflevector(_l, _h, 0, 1, 2, 3, 4, 5, 6, 7); } \
        else { dst[n][0] = *(const LAS bf16x8*)(lds + PG8_SB(b, h) + boff + n * 2048); dst[n][1] = *(const LAS bf16x8*)(lds + PG8_SB(b, h) + boff + n * 2048 + PIECE1); } } } while (0)
#define PG8_MMA(ai, bj, At, Bt) do { __builtin_amdgcn_s_setprio(1); _Pragma("unroll") for (int m = 0; m < 4; ++m) _Pragma("unroll") for (int n = 0; n < 2; ++n) { \
        if constexpr (F8) asm volatile("v_mfma_scale_f32_16x16x128_f8f6f4 %0, %1, %2, %0, %3, %4 op_sel_hi:[0,0,0]" : "+v"(acc[ai][bj][m][n]) : "v"(Bt##8[n]), "v"(At##8[m]), "v"(sc_w), "v"(sc_a)); \
        else { _Pragma("unroll") for (int k = 0; k < 2; ++k) acc[ai][bj][m][n] = __builtin_amdgcn_mfma_f32_16x16x32_bf16(Bt[n][k], At[m][k], acc[ai][bj][m][n], 0, 0, 0); } } \
        __builtin_amdgcn_s_setprio(0); } while (0)
#define PG8_WAIT_V(n) asm volatile("s_waitcnt vmcnt(" #n ")" ::: "memory")
#define PG8_WAIT_L(n) asm volatile("s_waitcnt lgkmcnt(" #n ")" ::: "memory")
#define PG8_BAR __builtin_amdgcn_s_barrier()
#define PG8_SCHED __builtin_amdgcn_sched_barrier(0)
#define PG8_TAB(par) (lds + STAGE_BYTES + 2048 + (par) * 1024)
#define PG8_TABLOAD(par, row0) do { if (wid < 4) __builtin_amdgcn_global_load_lds((const unsigned*)(rowidx + (row0) + wid * 64 + lane), (LAS unsigned*)(PG8_TAB(par) + wid * 256), 4, 0, 0); } while (0)
#define PG8_AOFF_H(h, par) do { int _tz = tid; asm volatile("" : "+v"(_tz)); _Pragma("unroll") for (int _i = 0; _i < 2; ++_i) { int _R, _C; stage_rc(_tz * 16 + _i * 8192, _R, _C); \
        if (GATHER) ac[h][_i] = ((const LAS unsigned*)PG8_TAB(par))[(h) * HALF + _R] * (unsigned)KB + (unsigned)_C * 2u; \
        else ac[h][_i] = (unsigned)(((h) * HALF + _R) * KB) + (unsigned)_C * 2u; } } while (0)
    static_assert(SP2, "only the two-super-phase K-loop is kept");
    Unit cur, nxt; int ui = 0;
    if (!S.next(0, cur)) return;
    f32x4 acc[2][2][4][2];
#pragma unroll
    for (int a = 0; a < 2; ++a)
#pragma unroll
        for (int b = 0; b < 2; ++b)
#pragma unroll
            for (int m = 0; m < 4; ++m)
#pragma unroll
                for (int n = 0; n < 2; ++n) acc[a][b][m][n] = (f32x4){0.f, 0.f, 0.f, 0.f};
    bf16x8 At[F8 ? 1 : 4][2], B0[F8 ? 1 : 2][2], B1[F8 ? 1 : 2][2];
    v8i At8[F8 ? 4 : 1], B08[F8 ? 2 : 1], B18[F8 ? 2 : 1];
    unsigned ac[GATHER ? 2 : 1][2];
    if (GATHER) { PG8_TABLOAD(0, cur.arow0); PG8_WAIT_V(0); PG8_BAR; }
    PG8_AOFF_H(0, 0); if (GATHER) { PG8_AOFF_H((GATHER ? 1 : 0), 0); }
    const char* cA = (const char*)Ag + (GATHER ? (size_t)0 : (size_t)cur.arow0 * KB); const char* cB = (const char*)Bg + (size_t)cur.brow0 * KB;
    PG8_STAGE_B(PG8_SB(0, 0), cB); PG8_STAGE_B(PG8_SB(0, 1), cB + hstep); PG8_STAGE_A(PG8_SA(0, 0), cA, 0); PG8_STAGE_A(PG8_SA(0, 1), cA, 1);
    if (wr == 1) PG8_BAR;
    PG8_WAIT_V(2); PG8_BAR;
    PG8_STAGE_B(PG8_SB(1, 0), cB + kstep); PG8_STAGE_A(PG8_SA(1, 0), cA + kstep, 0); PG8_STAGE_B(PG8_SB(1, 1), cB + hstep + kstep);
    PG8_WAIT_V(6); PG8_BAR;
    for (;;) {
        const typename Epi::Pre pre = E.prefetch(cur, lds, wid, lane, ui);
        const bool has_next = S.next(ui + 1, nxt);
        if (GATHER) { if (has_next) PG8_TABLOAD((ui + 1) & 1, nxt.arow0); }
        const char* nA = has_next ? ((const char*)Ag + (GATHER ? (size_t)0 : (size_t)nxt.arow0 * KB)) : cA; const char* nB = has_next ? (const char*)Bg + (size_t)nxt.brow0 * KB : cB;
_Pragma("nounroll")
        for (int t = 0; t < nt; t += 2) {
            const bool last = (t == nt - 2);
            const char* a1 = cA + (size_t)(t + 1) * kstep;
            const char* a2 = last ? nA : cA + (size_t)(t + 2) * kstep; const char* b2 = last ? nB : cB + (size_t)(t + 2) * kstep;
            const char* a3 = a2 + kstep; const char* b3 = b2 + kstep;
            if (GATHER) { if (last && has_next) { PG8_AOFF_H(0, (ui + 1) & 1); } }
            PG8_LDB(B0, 0, 0); PG8_LDB(B1, 0, 1); PG8_SCHED; PG8_LDA(At, 0, 0); PG8_STAGE_A(PG8_SA(1, 1), a1, 1);
            PG8_WAIT_V(8); PG8_WAIT_L(0); PG8_BAR; PG8_MMA(0, 0, At, B0); PG8_MMA(0, 1, At, B1); PG8_BAR; PG8_SCHED;
            if (GATHER) { if (last && has_next) { PG8_AOFF_H(1, (ui + 1) & 1); } }
            PG8_LDA(At, 0, 1); PG8_STAGE_B(PG8_SB(0, 0), b2); PG8_STAGE_B(PG8_SB(0, 1), b2 + hstep); PG8_STAGE_A(PG8_SA(0, 0), a2, 0);
            PG8_WAIT_V(8); PG8_WAIT_L(0); PG8_BAR; PG8_MMA(1, 0, At, B0); PG8_MMA(1, 1, At, B1); PG8_BAR; PG8_SCHED;
            PG8_LDB(B0, 1, 0); PG8_LDB(B1, 1, 1); PG8_SCHED; PG8_LDA(At, 1, 0); PG8_STAGE_A(PG8_SA(0, 1), a2, 1);
            PG8_WAIT_V(8); PG8_WAIT_L(0); PG8_BAR; PG8_MMA(0, 0, At, B0); PG8_MMA(0, 1, At, B1); PG8_BAR; PG8_SCHED;
            PG8_LDA(At, 1, 1); PG8_STAGE_B(PG8_SB(1, 0), b3); PG8_STAGE_B(PG8_SB(1, 1), b3 + hstep); PG8_STAGE_A(PG8_SA(1, 0), a3, 0);
            PG8_WAIT_V(8); PG8_WAIT_L(0); PG8_BAR; PG8_MMA(1, 0, At, B0); PG8_MMA(1, 1, At, B1); PG8_BAR; PG8_SCHED;
        }
        if constexpr (ALIGN_EPI) { if (wr == 0) PG8_BAR; }
        E(acc, cur, wr, wc, fr, fq, pre);
        if (!has_next) break;
#pragma unroll
        for (int a = 0; a < 2; ++a)
#pragma unroll
            for (int b = 0; b < 2; ++b)
#pragma unroll
                for (int m = 0; m < 4; ++m)
#pragma unroll
                    for (int n = 0; n < 2; ++n) acc[a][b][m][n] = (f32x4){0.f, 0.f, 0.f, 0.f};
        cur = nxt; cA = nA; cB = nB; ++ui;
        if constexpr (ALIGN_EPI) { if (wr == 1) PG8_BAR; }
    }
    PG8_WAIT_V(0);
    if constexpr (!ALIGN_EPI) { if (wr == 0) PG8_BAR; }
    PG8_BAR;
#undef PG8_SA
#undef PG8_SB
#undef PG8_STAGE_A
#undef PG8_STAGE_B
#undef PG8_LDA
#undef PG8_LDB
#undef PG8_MMA
#undef PG8_WAIT_V
#undef PG8_WAIT_L
#undef PG8_BAR
#undef PG8_SCHED
#undef PG8_AOFF_H
#undef PG8_TAB
#undef PG8_TABLOAD
}
}

constexpr int NWAVES = 8, NTHR = 512;
constexpr size_t MiB = 1u << 20;
constexpr size_t WS_CTL = 0, CTL_BYTES = 1 * MiB;
constexpr size_t WS_MOD = 1 * MiB;
constexpr size_t WS_WIN = 3 * MiB;
constexpr size_t WS_WOUT = 29 * MiB;
constexpr size_t WS_WR = 37 * MiB;
constexpr size_t WS_HYF = 39 * MiB;
constexpr size_t WS_HYFC = 71 * MiB;
constexpr size_t WS_XC = 73 * MiB;
constexpr size_t WS_EXP1 = 89 * MiB;
constexpr size_t WS_EXP2 = 218 * MiB;
constexpr size_t WS_XM = 283 * MiB;
constexpr size_t WS_EIDX = 419 * MiB;
constexpr size_t WS_WGT = 422 * MiB;
constexpr size_t WS_RNK = 425 * MiB;
constexpr size_t WS_ROWTOK = 428 * MiB;
constexpr size_t WS_ROWDST = 431 * MiB;
constexpr size_t WS_TILEEXP = 434 * MiB;
constexpr size_t WS_BIG = 435 * MiB;
constexpr size_t WS_U = WS_BIG;
constexpr size_t WS_MIX = 877 * MiB;
constexpr size_t WS_VT = 1013 * MiB;
constexpr size_t WS_HV = 1081 * MiB;
constexpr size_t WS_Z2 = 1183 * MiB;
constexpr size_t WS_GDS = 1217 * MiB;
constexpr size_t WS_GSIN = 1285 * MiB;
constexpr size_t WS_GD = 1319 * MiB;
constexpr size_t WS_Y = 1321 * MiB;
constexpr size_t WS_LOGIT = WS_BIG;
constexpr size_t WS_ACT = WS_BIG;
constexpr size_t WS_Y2 = 758 * MiB;
constexpr size_t WS_XM8 = 1470 * MiB;
constexpr size_t WS_XR = 1600 * MiB;
constexpr size_t WS_END = 1736 * MiB;
constexpr int CW_BAR = 4096;
constexpr int CW_CNT = 16384;
constexpr int CW_NTL = 20480;

constexpr int LDS_BYTES = 147456;
constexpr int MISC_OFF = 143360;

struct Frame {
    LAS unsigned char* lds;
    int tid, lane, wave, G, wg;
    const float* const* in;
    float* out; unsigned char* ws; unsigned* ctl;
};
enum { I_X = 0, I_C, I_CTX, I_CCTX, I_WMOD, I_BMOD, I_WIN, I_RPB, I_WA2, I_BA2, I_GNORM, I_HSW, I_HSB, I_HW1, I_HB1, I_HF1, I_HW2, I_HB2, I_HF2, I_HW3, I_HB3, I_HDEC, I_HSKIP,
       I_WOUT, I_LN1G, I_LN1B, I_RW, I_RB, I_WEG, I_WEU, I_WED, I_WSG, I_WSU, I_WSD, I_LN2G, I_LN2B };

__device__ __forceinline__ int row_b(int row) { return row < NLAT ? (row >> 12) : 16; }
__device__ __forceinline__ const float* mod_ptr(const Frame& F, int l, int row) { return (const float*)(F.ws + WS_MOD) + ((size_t)l * 17 + row_b(row)) * 6144; }

template <class RowFn>
__device__ __forceinline__ void tr_item(const float* W, int ldw, int k0, int n0, bf16_t* dst, int ldd, RowFn rf, LAS float* scr, int lane) {
    float tv[32];
    const GAS float* wp = (const GAS float*)(W + (size_t)(k0 + (lane >> 5)) * ldw + n0 + (lane & 31));
#pragma unroll
    for (int i = 0; i < 32; ++i) tv[i] = wp[(size_t)(2 * i) * ldw];
#pragma unroll
    for (int i = 0; i < 32; ++i) scr[(2 * i + (lane >> 5)) * 33 + (lane & 31)] = tv[i];
    LDS_WAIT(); asm volatile("" ::: "memory");
    const int c = lane & 7;
#pragma unroll
    for (int j = 0; j < 4; ++j) { const int n = (lane >> 3) + 8 * j; const LAS float* s = scr + (8 * c) * 33 + n;
        u32x4 o; o.x = pk2(s[0 * 33], s[1 * 33]); o.y = pk2(s[2 * 33], s[3 * 33]); o.z = pk2(s[4 * 33], s[5 * 33]); o.w = pk2(s[6 * 33], s[7 * 33]);
        *(GAS u32x4*)(dst + (size_t)rf(n0 + n) * ldd + k0 + 8 * c) = o; }
    LDS_WAIT(); asm volatile("" ::: "memory");
}
template <class RowFn>
__device__ __forceinline__ void tr_item8(const float* W, int ldw, int k0, int n0, unsigned char* dst, int ldd, RowFn rf, float scale, LAS float* scr, int lane) {
    float tv[32];
    const GAS float* wp = (const GAS float*)(W + (size_t)(k0 + (lane >> 5)) * ldw + n0 + (lane & 31));
#pragma unroll
    for (int i = 0; i < 32; ++i) tv[i] = wp[(size_t)(2 * i) * ldw];
#pragma unroll
    for (int i = 0; i < 32; ++i) scr[(2 * i + (lane >> 5)) * 33 + (lane & 31)] = tv[i];
    LDS_WAIT(); asm volatile("" ::: "memory");
    const int n = lane >> 1, hf = lane & 1; const LAS float* s = scr + (32 * hf) * 33 + n;
    unsigned w[8];
#pragma unroll
    for (int j = 0; j < 8; ++j) { int v = 0; v = __builtin_amdgcn_cvt_pk_fp8_f32(s[(4 * j) * 33] * scale, s[(4 * j + 1) * 33] * scale, v, false); v = __builtin_amdgcn_cvt_pk_fp8_f32(s[(4 * j + 2) * 33] * scale, s[(4 * j + 3) * 33] * scale, v, true); w[j] = (unsigned)v; }
    unsigned char* d = dst + (size_t)rf(n0 + n) * ldd + k0 + 32 * hf;
    *(GAS u32x4*)d = (u32x4){w[0], w[1], w[2], w[3]}; *(GAS u32x4*)(d + 16) = (u32x4){w[4], w[5], w[6], w[7]};
    LDS_WAIT(); asm volatile("" ::: "memory");
}
struct RowId { __device__ __forceinline__ int operator()(int n) const { return n; } };
struct RowWin { __device__ __forceinline__ int operator()(int n) const { return n >= 2336 ? n - 32 : n; } };
struct RowGU { int up; __device__ __forceinline__ int operator()(int j) const { return (j >> 6) * 128 + ((j & 63) >> 4) * 32 + up * 16 + (j & 15); } };

__device__ __forceinline__ void p0_static_weights(Frame& F) {
    LAS float* scr = (LAS float*)(F.lds + F.wave * 16384);
    const int gw = F.wg * NWAVES + F.wave, NGW = F.G * NWAVES;
    constexpr int I_IN = 16 * 97, I_OUT = 16 * 32, I_R = 16 * 4, PER_L = I_IN + I_OUT + I_R;
    for (int it = gw; it < DEPTH * PER_L; it += NGW) {
        const int l = it / PER_L; int r = it % PER_L;
        if (r < I_IN) { const int kb = r / 97, nb = r % 97; if (nb == 72) continue;
            tr_item(F.in[I_WIN] + (size_t)l * DM * DIN_REF, DIN_REF, kb * 64, nb * 32, (bf16_t*)(F.ws + WS_WIN) + (size_t)l * DIN * DM, DM, RowWin{}, scr, F.lane); continue; }
        r -= I_IN;
        if (r < I_OUT) { const int kb = r / 32, nb = r % 32;
            tr_item(F.in[I_WOUT] + (size_t)l * DM * DM, DM, kb * 64, nb * 32, (bf16_t*)(F.ws + WS_WOUT) + (size_t)l * DM * DM, DM, RowId{}, scr, F.lane); continue; }
        r -= I_OUT;
        { const int kb = r / 4, nb = r % 4;
            tr_item(F.in[I_RW] + (size_t)l * DM * NEXP, NEXP, kb * 64, nb * 32, (bf16_t*)(F.ws + WS_WR) + (size_t)l * 256 * DM, DM, RowId{}, scr, F.lane); }
    }
    const int gt = F.wg * NTHR + F.tid, NGT = F.G * NTHR;
    for (int i = gt; i < DEPTH * 128 * DM / 8; i += NGT) { const int l = i / (128 * DM / 8), r = i % (128 * DM / 8);
        *(u32x4*)((bf16_t*)(F.ws + WS_WR) + ((size_t)l * 256 + 128) * DM + (size_t)r * 8) = (u32x4){0u, 0u, 0u, 0u}; }
    for (int i = gt; i < DEPTH * 256 * DM; i += NGT) {
        const int k = i % DM, n = (i / DM) % 256, l = i / (DM * 256), dir = n >> 7, j = n & 127;
        const float* wi = F.in[I_WIN] + ((size_t)l * DM + k) * DIN_REF + 2304 + dir * 16;
        const float* wa = F.in[I_WA2] + ((size_t)(l * 2 + dir) * 16) * 128 + j;
        float s = 0.f;
#pragma unroll
        for (int r = 0; r < 16; ++r) s += wi[r] * wa[r * 128];
        ((bf16_t*)(F.ws + WS_WIN))[((size_t)l * DIN + 3072 + n) * DM + k] = (bf16_t)f2bf(s);
    }
}
__device__ __forceinline__ void p0_mod(Frame& F) {
    LAS float* sc = (LAS float*)F.lds;
    LAS float* red = (LAS float*)(F.lds + 17 * 1024 * 4);
    for (int i = F.tid; i < 17 * 1024; i += NTHR) { const int r = i >> 10, k = i & 1023; const float v = r < 16 ? F.in[I_C][r * 1024 + k] : F.in[I_CCTX][k]; sc[i] = silu_f(v); }
    __syncthreads();
    const int kq = F.tid >> 7, cl = F.tid & 127;
    for (int u = F.wg; u < DEPTH * 48; u += F.G) {
        const int l = u / 48, col = (u % 48) * 128 + cl;
        const float* w = F.in[I_WMOD] + (size_t)l * DM * 6144 + col;
        float a[17];
#pragma unroll
        for (int r = 0; r < 17; ++r) a[r] = 0.f;
#pragma unroll 4
        for (int k = kq * 256; k < kq * 256 + 256; ++k) { const float wv = w[(size_t)k * 6144];
#pragma unroll
            for (int r = 0; r < 17; ++r) a[r] += sc[r * 1024 + k] * wv; }
#pragma unroll
        for (int r = 0; r < 17; ++r) red[(kq * 17 + r) * 128 + cl] = a[r];
        __syncthreads();
        for (int i = F.tid; i < 17 * 128; i += NTHR) { const int r = i >> 7, c2 = i & 127, cc = (u % 48) * 128 + c2;
            const float s = red[(0 * 17 + r) * 128 + c2] + red[(1 * 17 + r) * 128 + c2] + red[(2 * 17 + r) * 128 + c2] + red[(3 * 17 + r) * 128 + c2] + F.in[I_BMOD][l * 6144 + cc];
            ((float*)(F.ws + WS_MOD))[((size_t)l * 17 + r) * 6144 + cc] = s; }
        __syncthreads();
    }
}
__device__ __forceinline__ void p0_hyena_filters(Frame& F) {
    LAS float* z = (LAS float*)F.lds;
    LAS float* h1 = z + 32 * 33;
    LAS float* h2 = h1 + 32 * 64;
    LAS float* tt = h2 + 32 * 64;
    constexpr int UL = 4096 / 32, UC = 256 / 32, UPL = UL + UC;
    for (int u = F.wg; u < DEPTH * UPL; u += F.G) {
        const int l = u / UPL, r = u % UPL; const bool lat = r < UL; const int L = lat ? 4096 : 256, n0 = (lat ? r : r - UL) * 32;
        __syncthreads();
        for (int i = F.tid; i < 32 * 33; i += NTHR) { const int p = i / 33, e = i % 33, n = n0 + p;
            const float t = (float)n / (float)(L - 1);
            float v;
            if (e == 0) v = t;
            else { const int kb = (e - 1) & 15; const float band = 1e-4f + (float)kb * ((15.0f - 1e-4f) / 15.0f);
                   const float w = 6.283185307179586f * (float)n / (float)L; const float ang = w * band;
                   v = e <= 16 ? __cosf(ang) : -__sinf(ang); }
            z[i] = v; if (e == 0) tt[p] = t; }
        __syncthreads();
        for (int i = F.tid; i < 32 * 64; i += NTHR) { const int p = i >> 6, j = i & 63; float s = F.in[I_HB1][l * 64 + j];
            for (int e = 0; e < 33; ++e) s += z[p * 33 + e] * F.in[I_HW1][((size_t)l * 33 + e) * 64 + j];
            h1[i] = __sinf(F.in[I_HF1][l * 64 + j] * s); }
        __syncthreads();
        for (int i = F.tid; i < 32 * 64; i += NTHR) { const int p = i >> 6, j = i & 63; float s = F.in[I_HB2][l * 64 + j];
            for (int e = 0; e < 64; ++e) s += h1[p * 64 + e] * F.in[I_HW2][((size_t)l * 64 + e) * 64 + j];
            h2[i] = __sinf(F.in[I_HF2][l * 64 + j] * s); }
        __syncthreads();
#pragma unroll 1
        for (int cc = 0; cc < 2; ++cc) {
            const int col = F.tid + cc * 512, o = col >> 9, dir = (col >> 8) & 1, ch = col & 255;
            float a[32];
#pragma unroll
            for (int p = 0; p < 32; ++p) a[p] = 0.f;
            const float* w3 = F.in[I_HW3] + (size_t)l * 64 * 1024 + col;
            for (int k = 0; k < 64; ++k) { const float wv = w3[(size_t)k * 1024];
#pragma unroll
                for (int p = 0; p < 32; ++p) a[p] += h2[p * 64 + k] * wv; }
            const float b3 = F.in[I_HB3][l * 1024 + col], dec = fabsf(F.in[I_HDEC][((size_t)(l * 2 + o) * 2 + dir) * 256 + ch]);
            const float skip = F.in[I_HSKIP][(l * 2 + o) * 256 + ch];
            bf16_t* R = lat ? (bf16_t*)(F.ws + WS_HYF) + ((size_t)(l * 2 + o) * 256 + ch) * 8192 : (bf16_t*)(F.ws + WS_HYFC) + ((size_t)(l * 2 + o) * 256 + ch) * 512;
#pragma unroll
            for (int p = 0; p < 32; ++p) { const int n = n0 + p; float v = (a[p] + b3) * __expf(-tt[p] * dec);
                if (dir == 0) { if (n == 0) v += skip; R[L - n] = (bf16_t)f2bf(v); }
                else { if (n == 0) R[0] = 0; else R[L + n] = (bf16_t)f2bf(v); } }
        }
    }
    __syncthreads();
}
__device__ __forceinline__ void p0_init_rows(Frame& F) {
    const int gw = F.wg * NWAVES + F.wave, NGW = F.G * NWAVES;
    for (int row = gw; row < NROW; row += NGW) {
        const float* src = row < NLAT ? F.in[I_X] + (size_t)row * DM : F.in[I_CTX] + (size_t)(row - NLAT) * DM;
        const float* md = mod_ptr(F, 0, row);
        bf16_t* xr = (bf16_t*)(F.ws + WS_XR) + (size_t)row * DM; bf16_t* xm = (bf16_t*)(F.ws + WS_XM) + (size_t)row * DM;
#pragma unroll
        for (int j = 0; j < 4; ++j) { const int c = 4 * F.lane + 256 * j;
            const f32x4 v = *(const GAS f32x4*)(src + c), sh = *(const GAS f32x4*)(md + c), sc = *(const GAS f32x4*)(md + 1024 + c);
            *(GAS u32x2*)(xr + c) = (u32x2){pk2(v[0], v[1]), pk2(v[2], v[3])};
            u32x2 w; w.x = pk2(v[0] * (1.f + sc[0]) + sh[0], v[1] * (1.f + sc[1]) + sh[1]); w.y = pk2(v[2] * (1.f + sc[2]) + sh[2], v[3] * (1.f + sc[3]) + sh[3]);
            *(GAS u32x2*)(xm + c) = w; }
    }
}
constexpr float WEXP_SCALE = 32.0f;
__device__ __forceinline__ void p_expert_weights(Frame& F, int l) {
    LAS float* scr = (LAS float*)(F.lds + F.wave * 16384);
    const int gw = F.wg * NWAVES + F.wave, NGW = F.G * NWAVES;
    constexpr int I1 = 16 * 8, I2 = 4 * 32, PER_E = 2 * I1 + I2;
    for (int it = gw; it < NE1 * PER_E; it += NGW) {
        const int e = it / PER_E; int r = it % PER_E;
        unsigned char* d1 = (unsigned char*)(F.ws + WS_EXP1) + (size_t)e * 512 * DM; unsigned char* d2 = (unsigned char*)(F.ws + WS_EXP2) + (size_t)e * DM * EH;
        if (r < 2 * I1) { const int up = r >= I1; if (up) r -= I1; const int kb = r / 8, nb = r % 8;
            const float* src = e < NEXP ? F.in[up ? I_WEU : I_WEG] + ((size_t)l * NEXP + e) * DM * EH : F.in[up ? I_WSU : I_WSG] + (size_t)l * DM * EH;
            tr_item8(src, EH, kb * 64, nb * 32, d1, DM, RowGU{up}, WEXP_SCALE, scr, F.lane); }
        else { r -= 2 * I1; const int kb = r / 32, nb = r % 32;
            const float* src = e < NEXP ? F.in[I_WED] + ((size_t)l * NEXP + e) * EH * DM : F.in[I_WSD] + (size_t)l * EH * DM;
            tr_item8(src, DM, kb * 64, nb * 32, d2, EH, RowId{}, WEXP_SCALE, scr, F.lane); }
    }
}

__device__ __forceinline__ f32x4 mfma16(bf16x8 a, bf16x8 b, f32x4 c) { return __builtin_amdgcn_mfma_f32_16x16x32_bf16(a, b, c, 0, 0, 0); }

__device__ __forceinline__ void ph_transposes(Frame& F, int l) {
    LAS bf16_t* tile = (LAS bf16_t*)(F.lds + F.wave * 16384);
    const bf16_t* U = (const bf16_t*)(F.ws + WS_U);
    const int gw = F.wg * NWAVES + F.wave, NGW = F.G * NWAVES;
    const int rsub = F.lane >> 3, cseg = F.lane & 7;
    for (int u = gw; u < 1088 * 20; u += NGW) {
        const int tt = u / 20, blk = u % 20;
        int b, s0, Ls, rowbase, posbase;
        if (tt < 1024) { b = tt >> 6; s0 = (tt & 63) * 64; Ls = SEQ; rowbase = b * SEQ; posbase = 0; }
        else { const int t2 = tt - 1024; b = t2 >> 2; s0 = (t2 & 3) * 64; Ls = CTXL; rowbase = NLAT + b * CTXL; posbase = SEQ; }
        if (blk < 12) {
            const int c0 = blk * 64 + cseg * 8;
            float w0[8], w1[8], w2[8], bb[8];
#pragma unroll
            for (int i = 0; i < 8; ++i) { w0[i] = F.in[I_HSW][(l * 3 + 0) * 768 + c0 + i]; w1[i] = F.in[I_HSW][(l * 3 + 1) * 768 + c0 + i]; w2[i] = F.in[I_HSW][(l * 3 + 2) * 768 + c0 + i]; bb[i] = F.in[I_HSB][l * 768 + c0 + i]; }
#pragma unroll 2
            for (int it = 0; it < 8; ++it) {
                const int sl = rsub + 8 * it, s = s0 + sl;
                const bf16_t* p = U + (size_t)(rowbase + s) * DIN + UHY + c0;
                const u32x4 zc = *(const u32x4*)p;
                u32x4 zm = (u32x4){0u, 0u, 0u, 0u}, zp = (u32x4){0u, 0u, 0u, 0u};
                if (s > 0) zm = *(const u32x4*)(p - DIN);
                if (s < Ls - 1) zp = *(const u32x4*)(p + DIN);
                const unsigned am[4] = {zm.x, zm.y, zm.z, zm.w}, ac[4] = {zc.x, zc.y, zc.z, zc.w}, ap[4] = {zp.x, zp.y, zp.z, zp.w};
#pragma unroll
                for (int i = 0; i < 4; ++i) {
                    const float v0 = bb[2 * i] + w0[2 * i] * bflo(am[i]) + w1[2 * i] * bflo(ac[i]) + w2[2 * i] * bflo(ap[i]);
                    const float v1 = bb[2 * i + 1] + w0[2 * i + 1] * bfhi(am[i]) + w1[2 * i + 1] * bfhi(ac[i]) + w2[2 * i + 1] * bfhi(ap[i]);
                    tile[(cseg * 8 + 2 * i) * 72 + sl] = (bf16_t)f2bf(v0); tile[(cseg * 8 + 2 * i + 1) * 72 + sl] = (bf16_t)f2bf(v1);
                }
            }
        } else {
            const int c0 = (blk - 12) * 64 + cseg * 8;
#pragma unroll 2
            for (int it = 0; it < 8; ++it) {
                const int sl = rsub + 8 * it, s = s0 + sl;
                const u32x4 zc = *(const u32x4*)(U + (size_t)(rowbase + s) * DIN + UV + c0);
                const unsigned ac[4] = {zc.x, zc.y, zc.z, zc.w};
#pragma unroll
                for (int i = 0; i < 4; ++i) { tile[(cseg * 8 + 2 * i) * 72 + sl] = (bf16_t)(ac[i] & 0xffffu); tile[(cseg * 8 + 2 * i + 1) * 72 + sl] = (bf16_t)(ac[i] >> 16); }
            }
        }
        LDS_WAIT(); asm volatile("" ::: "memory");
#pragma unroll 2
        for (int it = 0; it < 8; ++it) {
            const int ch = rsub + 8 * it;
            const u32x4 v = *(const LAS u32x4*)(tile + ch * 72 + cseg * 8);
            bf16_t* dst;
            if (blk < 12) dst = (bf16_t*)(F.ws + WS_HV) + ((size_t)(blk * 64 + ch) * NB + b) * SPB + posbase + s0 + cseg * 8;
            else dst = (bf16_t*)(F.ws + WS_VT) + ((size_t)b * 512 + (blk - 12) * 64 + ch) * SPB + posbase + s0 + cseg * 8;
            *(u32x4*)dst = v;
        }
        LDS_WAIT(); asm volatile("" ::: "memory");
    }
}

constexpr int NA_RPB = 0, NA_KC = 16384, NA_VC = NA_KC + 256 * 144, NA_END = NA_VC + 64 * 528;
__device__ __forceinline__ bf16x8 gld16(const bf16_t* p) { return *(const GAS bf16x8*)p; }
__device__ __forceinline__ u32x2 gld8(const bf16_t* p) { return *(const GAS u32x2*)p; }
__device__ __forceinline__ const char* uni_ptr(const char* p) { const unsigned long long v = (unsigned long long)p; const unsigned lo = __builtin_amdgcn_readfirstlane((unsigned)v), hi = __builtin_amdgcn_readfirstlane((unsigned)(v >> 32)); return (const char*)(((unsigned long long)hi << 32) | lo); }
__device__ __forceinline__ bf16x8 gld16o(const char* ub, unsigned lo) { return *(const GAS bf16x8*)(ub + (size_t)lo); }
__device__ __forceinline__ u32x2 gld8o(const char* ub, unsigned lo) { return *(const GAS u32x2*)(ub + (size_t)lo); }
template <bool WIN>
__device__ __forceinline__ void na_unit(Frame& F, int b, int h, int r, int strip) {
    const bf16_t* U = (const bf16_t*)(F.ws + WS_U);
    const bf16_t* VT = (const bf16_t*)(F.ws + WS_VT) + ((size_t)b * 512 + h * 64) * SPB;
    const LAS float* rpb = (const LAS float*)(F.lds + NA_RPB);
    const LAS bf16_t* KC = (const LAS bf16_t*)(F.lds + NA_KC); const LAS bf16_t* VC = (const LAS bf16_t*)(F.lds + NA_VC);
    int ln_ = F.lane; asm volatile("" : "+v"(ln_));
    const int i = ln_ & 15, g = ln_ >> 4;
    const int qrow0 = WIN ? (b * SEQ + r * 64 + strip * 16) : (NLAT + b * CTXL + strip * 16);
    const int ki = 8 * (i >> 2) + (i & 3);
    const unsigned qlo = (unsigned)((i * DIN + 8 * g) * 2), klo = (unsigned)((ki * DIN + 8 * g) * 2), vlo = (unsigned)((i * SPB + 8 * g) * 2);
    const char* qb = uni_ptr((const char*)(U + (size_t)qrow0 * DIN + UQ + h * 64));
    const bf16x8 q0 = gld16o(qb, qlo), q1 = gld16o(qb + 64, qlo);
    constexpr int NT = WIN ? 32 : 16;
    constexpr int CO = WIN ? 16 : 0;
    f32x4 st[NT];
    int kr0 = 0, u0 = 0;
    if (WIN) { kr0 = r - 4; kr0 = kr0 < 0 ? 0 : (kr0 > 56 ? 56 : kr0); u0 = strip == 0 ? 0 : (strip == 1 ? 8 : (strip == 2 ? 24 : 32)); }
    const char* kbase = uni_ptr((const char*)(U + (size_t)(b * SEQ + kr0 * 64 + u0) * DIN + UK + h * 64));
    const char* vbase = uni_ptr((const char*)(VT + kr0 * 64 + u0));
#define NA_SB() __builtin_amdgcn_sched_barrier(0)
#define NA_KLOAD(buf, grp) do { _Pragma("unroll") for (int t = 0; t < 2; ++t) { const int kt = (grp) * 2 + t; const char* kp = kbase + (size_t)((kt >> 1) * 64 + (kt & 1) * 4) * DIN * 2; buf[t][0] = gld16o(kp, klo); buf[t][1] = gld16o(kp + 64, klo); } } while (0)
#define NA_KMMA(buf, grp) do { _Pragma("unroll") for (int t = 0; t < 2; ++t) { f32x4 a = (f32x4){0.f, 0.f, 0.f, 0.f}; a = mfma16(buf[t][0], q0, a); a = mfma16(buf[t][1], q1, a); st[(grp) * 2 + t] = a; } } while (0)
#define NA_VLOAD(buf, cp) do { _Pragma("unroll") for (int d = 0; d < 4; ++d) { const char* vp = vbase + ((size_t)(d * 16) * SPB + (cp) * 64) * 2; buf[d] = gld16o(vp, vlo); } } while (0)
#define NA_VMMA(buf, cp) do { const int c = (cp); const f32x4 p0 = st[2 * c], p1 = st[2 * c + 1]; \
        u32x4 pw; pw.x = pk2(p0[0], p0[1]); pw.y = pk2(p0[2], p0[3]); pw.z = pk2(p1[0], p1[1]); pw.w = pk2(p1[2], p1[3]); const bf16x8 pf = __builtin_bit_cast(bf16x8, pw); \
        _Pragma("unroll") for (int d = 0; d < 4; ++d) o[d] = mfma16(buf[d], pf, o[d]); } while (0)
    bf16x8 ka[2][2], kb[2][2];
    if (WIN) { NA_KLOAD(ka, 0); NA_KLOAD(kb, 1); NA_SB(); }
#pragma unroll
    for (int cg = 0; cg < 8; ++cg) {
        bf16x8 kc[2][2];
#pragma unroll
        for (int t = 0; t < 2; ++t) { const LAS bf16_t* kp = KC + (cg * 32 + ki + 4 * t) * 72 + 8 * g; kc[t][0] = *(const LAS bf16x8*)kp; kc[t][1] = *(const LAS bf16x8*)(kp + 32); }
#pragma unroll
        for (int t = 0; t < 2; ++t) { f32x4 a = (f32x4){0.f, 0.f, 0.f, 0.f}; a = mfma16(kc[t][0], q0, a); a = mfma16(kc[t][1], q1, a); st[CO + cg * 2 + t] = a; }
        NA_SB();
    }
    bf16x8 va[4], vb[4];
    if (WIN) {
        NA_KMMA(ka, 0); NA_SB(); NA_KLOAD(ka, 2); NA_SB();
        NA_KMMA(kb, 1); NA_SB(); NA_KLOAD(kb, 3); NA_SB();
        NA_KMMA(ka, 2); NA_SB(); NA_KLOAD(ka, 4); NA_SB();
        NA_KMMA(kb, 3); NA_SB(); NA_KLOAD(kb, 5); NA_SB();
        NA_KMMA(ka, 4); NA_SB(); NA_KLOAD(ka, 6); NA_SB();
        NA_KMMA(kb, 5); NA_SB(); NA_KLOAD(kb, 7); NA_SB();
        NA_KMMA(ka, 6); NA_SB(); NA_VLOAD(va, 0); NA_SB();
        NA_KMMA(kb, 7); NA_SB(); NA_VLOAD(vb, 1); NA_SB();
    }
    float mx = -3.0e38f;
    if (WIN) {
        const int c = strip * 16 + i; int kc0 = c - 8; kc0 = kc0 < 0 ? 0 : (kc0 > 48 ? 48 : kc0);
#pragma unroll
        for (int grp = 0; grp < 4; ++grp) {
            float bv[4][4];
#pragma unroll
            for (int t = 0; t < 4; ++t) { const int kt = grp * 4 + t, dr = kr0 + (kt >> 1) - r + 7;
#pragma unroll
                for (int e = 0; e < 4; ++e) { int dc = u0 + 8 * g + (kt & 1) * 4 + e - c + 15; dc = dc < 0 ? 0 : (dc > 30 ? 30 : dc); bv[t][e] = rpb[(h * 15 + dr) * 31 + dc]; } }
#pragma unroll
            for (int t = 0; t < 4; ++t) { const int kt = grp * 4 + t;
#pragma unroll
                for (int e = 0; e < 4; ++e) { const int kc = u0 + 8 * g + (kt & 1) * 4 + e; const bool ok = (kc >= kc0) && (kc < kc0 + 16);
                    const float s = ok ? (st[kt][e] * 0.125f + bv[t][e]) : -3.0e38f; st[kt][e] = s; mx = fmaxf(mx, s); } }
            NA_SB();
        }
    }
#pragma unroll
    for (int ct = 0; ct < 16; ++ct)
#pragma unroll
        for (int e = 0; e < 4; ++e) { const float s = st[CO + ct][e] * 0.125f; st[CO + ct][e] = s; mx = fmaxf(mx, s); }
    mx = fmaxf(mx, shx(mx, 16, ln_)); mx = fmaxf(mx, shx(mx, 32, ln_));
    float sum = 0.f;
#pragma unroll
    for (int t = 0; t < NT; ++t)
#pragma unroll
        for (int e = 0; e < 4; ++e) { const float p = __expf(st[t][e] - mx); st[t][e] = p; sum += p; }
    sum += shx(sum, 16, ln_); sum += shx(sum, 32, ln_);
    const float inv = 1.0f / sum;
    f32x4 o[4];
#pragma unroll
    for (int d = 0; d < 4; ++d) o[d] = (f32x4){0.f, 0.f, 0.f, 0.f};
    NA_SB();
    if (WIN) {
        NA_VMMA(va, 0); NA_SB(); NA_VLOAD(va, 2); NA_SB();
        NA_VMMA(vb, 1); NA_SB(); NA_VLOAD(vb, 3); NA_SB();
        NA_VMMA(va, 2); NA_SB(); NA_VLOAD(va, 4); NA_SB();
        NA_VMMA(vb, 3); NA_SB(); NA_VLOAD(vb, 5); NA_SB();
        NA_VMMA(va, 4); NA_SB(); NA_VLOAD(va, 6); NA_SB();
        NA_VMMA(vb, 5); NA_SB(); NA_VLOAD(vb, 7); NA_SB();
    }
#pragma unroll
    for (int cb = 0; cb < 8; ++cb) {
        bf16x8 vc[4];
#pragma unroll
        for (int d = 0; d < 4; ++d) vc[d] = *(const LAS bf16x8*)(VC + (d * 16 + i) * 264 + cb * 32 + 8 * g);
        { const int c = (WIN ? 8 : 0) + cb; const f32x4 p0 = st[2 * c], p1 = st[2 * c + 1];
            u32x4 pw; pw.x = pk2(p0[0], p0[1]); pw.y = pk2(p0[2], p0[3]); pw.z = pk2(p1[0], p1[1]); pw.w = pk2(p1[2], p1[3]); const bf16x8 pf = __builtin_bit_cast(bf16x8, pw);
#pragma unroll
            for (int d = 0; d < 4; ++d) o[d] = mfma16(vc[d], pf, o[d]); }
        NA_SB();
    }
    if (WIN) { NA_VMMA(va, 6); NA_SB(); NA_VMMA(vb, 7); NA_SB(); }
    char* op = (char*)uni_ptr((const char*)((bf16_t*)(F.ws + WS_MIX) + (size_t)qrow0 * DM + h * 64)); const unsigned olo = (unsigned)((i * DM + 4 * g) * 2);
#pragma unroll
    for (int d = 0; d < 4; ++d) { u32x2 w; w.x = pk2(o[d][0] * inv, o[d][1] * inv); w.y = pk2(o[d][2] * inv, o[d][3] * inv); *(GAS u32x2*)(op + d * 32 + (size_t)olo) = w; }
#undef NA_SB
#undef NA_KLOAD
#undef NA_KMMA
#undef NA_VLOAD
#undef NA_VMMA
}
__device__ __forceinline__ void ph_na(Frame& F, int l, bool last) {
    LAS float* rpb = (LAS float*)(F.lds + NA_RPB);
    __syncthreads();
    for (int i = F.tid; i < 8 * 15 * 31; i += NTHR) rpb[i] = F.in[I_RPB][(size_t)l * 8 * 15 * 31 + i];
    const bf16_t* U = (const bf16_t*)(F.ws + WS_U);
    for (int job = F.wg; job < NB * 8 * 2; job += F.G) {
        const int half = job & 1, h = (job >> 1) & 7, b = job >> 4;
        __syncthreads();
        { int tz_ = F.tid; asm volatile("" : "+v"(tz_)); const int key = tz_ >> 1, hf = tz_ & 1; const bf16_t* src = U + (size_t)(NLAT + b * CTXL + key) * DIN + UK + h * 64 + hf * 32; LAS bf16_t* dst = (LAS bf16_t*)(F.lds + NA_KC) + key * 72 + hf * 32;
#pragma unroll
          for (int j = 0; j < 4; ++j) *(LAS bf16x8*)(dst + j * 8) = gld16(src + j * 8);
          const int dv = tz_ >> 3, seg = tz_ & 7; const bf16_t* vs = (const bf16_t*)(F.ws + WS_VT) + ((size_t)b * 512 + h * 64 + dv) * SPB + SEQ + seg * 32; LAS bf16_t* vd = (LAS bf16_t*)(F.lds + NA_VC) + dv * 264 + seg * 32;
#pragma unroll
          for (int j = 0; j < 4; ++j) *(LAS bf16x8*)(vd + j * 8) = gld16(vs + j * 8); }
        __syncthreads();
        for (int uu = F.wave; uu < 128; uu += NWAVES) na_unit<true>(F, b, h, half * 32 + (uu >> 2), uu & 3);
        if (!last) na_unit<false>(F, b, h, 0, half * 8 + F.wave);
    }
}

constexpr int GL_LAF = 0, GL_LAB = 8448, GL_Q = 16896, GL_K = 25344;
constexpr int GL_QTF = 33792, GL_KTF = 38912, GL_QTB = 44032, GL_KTB = 49152;
constexpr int GL_KDF = 54272, GL_KDB = 58880;
constexpr int GL_VT = 63488, GL_ATT = 72704;
constexpr int GL_SF = 81920, GL_SB = 87040;
constexpr int GL_O = 92160;
constexpr int GL_SEG = 108800;
__device__ __forceinline__ float log_sigmoid_f(float x) { return fminf(x, 0.f) - log1pf(__expf(-fabsf(x))); }
__device__ __forceinline__ f32x4 mma_lds(const LAS bf16_t* A, int lda, const LAS bf16_t* B, int ldb, int ksteps, f32x4 acc, int lane) {
    const int r = lane & 15, g = lane >> 4;
    for (int ks = 0; ks < ksteps; ++ks) { const bf16x8 a = *(const LAS bf16x8*)(A + r * lda + ks * 32 + 8 * g), b = *(const LAS bf16x8*)(B + r * ldb + ks * 32 + 8 * g); acc = mfma16(a, b, acc); }
    return acc;
}
struct GlaRaw { u32x2 wq, wk, wf, wb; u32x4 wv, gw, sin; };
__device__ __forceinline__ int gla_row0(int b, int cn) { return cn >= 4 ? b * SEQ + (cn - 4) * 64 : NLAT + b * CTXL + cn * 64; }
template <bool FULL>
__device__ __forceinline__ GlaRaw gla_load(Frame& F, int u) {
    const int h = u & 3, cn = (u >> 2) % 68, b = (u >> 2) / 68, t = F.tid, i = t >> 3, d4 = (t & 7) * 4, dv8 = (t & 7) * 8;
    const bf16_t* p = (const bf16_t*)(F.ws + WS_U) + (size_t)(gla_row0(b, cn) + i) * DIN;
    GlaRaw r;
    r.wq = *(const GAS u32x2*)(p + UGQ + h * 32 + d4); r.wk = *(const GAS u32x2*)(p + UGK + h * 32 + d4); r.wf = *(const GAS u32x2*)(p + ULAF + h * 32 + d4); r.wb = *(const GAS u32x2*)(p + ULAB + h * 32 + d4);
    r.wv = *(const GAS u32x4*)(p + UGV + h * 64 + dv8);
    if (FULL) { r.gw = *(const GAS u32x4*)(p + UGR + h * 64 + dv8);
        const int dir = t >> 8, dv = (t >> 2) & 63, d8 = (t & 3) * 8; r.sin = *(const GAS u32x4*)((const bf16_t*)(F.ws + WS_GSIN) + (size_t)u * 2 * 2048 + dir * 2048 + dv * 32 + d8); }
    else { r.gw = (u32x4){0u, 0u, 0u, 0u}; r.sin = r.gw; }
    return r;
}
template <bool FULL>
__device__ __forceinline__ void gla_prep(Frame& F, int l, int b, int cn, int h, const GlaRaw& raw) {
    LAS float* LAF = (LAS float*)(F.lds + GL_LAF); LAS float* LAB = (LAS float*)(F.lds + GL_LAB); LAS float* Q = (LAS float*)(F.lds + GL_Q); LAS float* Kk = (LAS float*)(F.lds + GL_K);
    LAS bf16_t* VT = (LAS bf16_t*)(F.lds + GL_VT); LAS float* SEG = (LAS float*)(F.lds + GL_SEG);
    const bool lat = cn >= 4;
    const int t = F.tid;
    { const int i = t >> 3, d4 = (t & 7) * 4;
      const u32x2 wq = raw.wq, wk = raw.wk, wf = raw.wf, wb = raw.wb;
      const float* ba = F.in[I_BA2] + (size_t)l * 256 + h * 32 + d4;
      const float qs = 0.17677669529663687f;
      Q[i * 33 + d4 + 0] = bflo(wq.x) * qs; Q[i * 33 + d4 + 1] = bfhi(wq.x) * qs; Q[i * 33 + d4 + 2] = bflo(wq.y) * qs; Q[i * 33 + d4 + 3] = bfhi(wq.y) * qs;
      Kk[i * 33 + d4 + 0] = bflo(wk.x); Kk[i * 33 + d4 + 1] = bfhi(wk.x); Kk[i * 33 + d4 + 2] = bflo(wk.y); Kk[i * 33 + d4 + 3] = bfhi(wk.y);
      LAF[i * 33 + d4 + 0] = log_sigmoid_f(bflo(wf.x) + ba[0]) * 0.0625f; LAF[i * 33 + d4 + 1] = log_sigmoid_f(bfhi(wf.x) + ba[1]) * 0.0625f;
      LAF[i * 33 + d4 + 2] = log_sigmoid_f(bflo(wf.y) + ba[2]) * 0.0625f; LAF[i * 33 + d4 + 3] = log_sigmoid_f(bfhi(wf.y) + ba[3]) * 0.0625f;
      LAB[i * 33 + d4 + 0] = log_sigmoid_f(bflo(wb.x) + ba[128]) * 0.0625f; LAB[i * 33 + d4 + 1] = log_sigmoid_f(bfhi(wb.x) + ba[129]) * 0.0625f;
      LAB[i * 33 + d4 + 2] = log_sigmoid_f(bflo(wb.y) + ba[130]) * 0.0625f; LAB[i * 33 + d4 + 3] = log_sigmoid_f(bfhi(wb.y) + ba[131]) * 0.0625f;
      const int dv8 = (t & 7) * 8; const u32x4 wv = raw.wv; const unsigned av[4] = {wv.x, wv.y, wv.z, wv.w};
#pragma unroll
      for (int e = 0; e < 4; ++e) { VT[(dv8 + 2 * e) * 72 + i] = (bf16_t)(av[e] & 0xffffu); VT[(dv8 + 2 * e + 1) * 72 + i] = (bf16_t)(av[e] >> 16); }
    }
    __syncthreads();
    if (lat) {
        for (int e = t; e < 64 * 16 * 2; e += NTHR) {
            const int which = e >> 10, i = (e >> 4) & 63, p = e & 15, half = p >> 3, idx = p & 7;
            const float pos = half ? (float)i : (float)(cn - 4);
            const float inv = __expf(-(float)idx * (9.210340371976184f / 8.0f));
            const float sn = __sinf(pos * inv), cs = __cosf(pos * inv);
            LAS float* A = which ? Kk : Q; const int d1 = half * 16 + idx;
            const float x1 = A[i * 33 + d1], x2 = A[i * 33 + d1 + 8];
            A[i * 33 + d1] = x1 * cs - x2 * sn; A[i * 33 + d1 + 8] = x1 * sn + x2 * cs;
        }
    }
    { const int x = t & 63, d = x & 31, dir = x >> 5, seg = t >> 6; LAS float* LA = dir ? LAB : LAF; float run = 0.f;
#pragma unroll
      for (int k = 0; k < 8; ++k) { const int p = seg * 8 + k, i = dir ? 63 - p : p; run += LA[i * 33 + d]; LA[i * 33 + d] = run; }
      SEG[x * 9 + seg] = run;
    }
    __syncthreads();
    { const int x = t & 63, d = x & 31, dir = x >> 5, seg = t >> 6; LAS float* LA = dir ? LAB : LAF; float pre = 0.f;
      for (int s2 = 0; s2 < seg; ++s2) pre += SEG[x * 9 + s2];
#pragma unroll
      for (int k = 0; k < 8; ++k) { const int p = seg * 8 + k, i = dir ? 63 - p : p; LA[i * 33 + d] += pre; }
    }
    __syncthreads();
    LAS bf16_t* QTF = (LAS bf16_t*)(F.lds + GL_QTF); LAS bf16_t* KTF = (LAS bf16_t*)(F.lds + GL_KTF); LAS bf16_t* QTB = (LAS bf16_t*)(F.lds + GL_QTB); LAS bf16_t* KTB = (LAS bf16_t*)(F.lds + GL_KTB);
    LAS bf16_t* KDF = (LAS bf16_t*)(F.lds + GL_KDF); LAS bf16_t* KDB = (LAS bf16_t*)(F.lds + GL_KDB);
    for (int e = t; e < 64 * 32; e += NTHR) {
        const int i = e >> 5, d = e & 31;
        const float bf = LAF[i * 33 + d], bb = LAB[i * 33 + d], bfl = LAF[63 * 33 + d], bbl = LAB[0 * 33 + d], kv = Kk[i * 33 + d];
        KDF[d * 72 + i] = (bf16_t)f2bf(kv * __expf(bfl - bf)); KDB[d * 72 + i] = (bf16_t)f2bf(kv * __expf(bbl - bb));
        if (FULL) { const float qv = Q[i * 33 + d];
            QTF[i * 40 + d] = (bf16_t)f2bf(qv * __expf(bf)); KTF[i * 40 + d] = (bf16_t)f2bf(kv * __expf(-bf));
            QTB[i * 40 + d] = (bf16_t)f2bf(qv * __expf(bb)); KTB[i * 40 + d] = (bf16_t)f2bf(kv * __expf(-bb)); }
    }
    __syncthreads();
}
__device__ __forceinline__ void ph_gla_local(Frame& F, int l) {
    LAS float* LAF = (LAS float*)(F.lds + GL_LAF); LAS float* LAB = (LAS float*)(F.lds + GL_LAB);
    GlaRaw raw = gla_load<false>(F, F.wg < NB * 68 * 4 ? F.wg : 0);
    for (int u = F.wg; u < NB * 68 * 4; u += F.G) {
        const int h = u & 3, cn = (u >> 2) % 68, b = (u >> 2) / 68;
        const GlaRaw nraw = gla_load<false>(F, (u + F.G) < NB * 68 * 4 ? (u + F.G) : u);
        __syncthreads();
        gla_prep<false>(F, l, b, cn, h, raw);
        raw = nraw;
        const int mt = F.wave >> 1, nt = F.wave & 1, g = F.lane >> 4, c = F.lane & 15;
        float* DS = (float*)(F.ws + WS_GDS) + (size_t)u * 2 * 2048;
#pragma unroll
        for (int dir = 0; dir < 2; ++dir) {
            const LAS bf16_t* KD = (const LAS bf16_t*)(F.lds + (dir ? GL_KDB : GL_KDF));
            f32x4 a = (f32x4){0.f, 0.f, 0.f, 0.f};
            a = mma_lds((const LAS bf16_t*)(F.lds + GL_VT) + mt * 16 * 72, 72, KD + nt * 16 * 72, 72, 2, a, F.lane);
#pragma unroll
            for (int e = 0; e < 4; ++e) DS[dir * 2048 + (mt * 16 + 4 * g + e) * 32 + nt * 16 + c] = a[e];
        }
        if (F.tid < 64) { const int d = F.tid & 31, dir = F.tid >> 5; ((float*)(F.ws + WS_GD))[(size_t)u * 64 + F.tid] = __expf(dir ? LAB[0 * 33 + d] : LAF[63 * 33 + d]); }
    }
}
__device__ __forceinline__ void ph_gla_scan(Frame& F) {
    const int gt = F.wg * NTHR + F.tid, NGT = F.G * NTHR;
    const float* DS = (const float*)(F.ws + WS_GDS); const float* GD = (const float*)(F.ws + WS_GD); bf16_t* SIN = (bf16_t*)(F.ws + WS_GSIN);
    for (int w = gt; w < 128 * 1024; w += NGT) {
        const int chain = w >> 10, el = (w & 1023) * 2, dir = chain & 1, h = (chain >> 1) & 3, b = chain >> 3, d = el & 31;
        float s0 = 0.f, s1 = 0.f;
        for (int step = 0; step < 68; ++step) {
            const int cn = dir ? (step < 4 ? 3 - step : 71 - step) : step;
            const size_t u = (size_t)(b * 68 + cn) * 4 + h;
            *(unsigned*)(SIN + (u * 2 + dir) * 2048 + el) = pk2(s0, s1);
            const f32x2 ds = *(const f32x2*)(DS + (u * 2 + dir) * 2048 + el); const f32x2 dd = *(const f32x2*)(GD + u * 64 + dir * 32 + d);
            s0 = dd.x * s0 + ds.x; s1 = dd.y * s1 + ds.y;
        }
    }
}
__device__ __forceinline__ void ph_gla_out(Frame& F, int l, bool last) {
    const bf16_t* U = (const bf16_t*)(F.ws + WS_U);
#define GLA_NEXT(u0) ({ int _u = (u0); while (_u < NB * 68 * 4 && last && ((_u >> 2) % 68) < 4) _u += F.G; _u; })
    int u = GLA_NEXT(F.wg);
    GlaRaw raw = gla_load<true>(F, u < NB * 68 * 4 ? u : 0);
    for (; u < NB * 68 * 4; ) {
        const int h = u & 3, cn = (u >> 2) % 68, b = (u >> 2) / 68;
        const int un = GLA_NEXT(u + F.G);
        const GlaRaw nraw = gla_load<true>(F, un < NB * 68 * 4 ? un : u);
        __syncthreads();
        gla_prep<true>(F, l, b, cn, h, raw);
        const int t = F.tid;
        { const int dir = t >> 8, dv = (t >> 2) & 63, d8 = (t & 3) * 8; *(LAS u32x4*)((LAS bf16_t*)(F.lds + (dir ? GL_SB : GL_SF)) + dv * 40 + d8) = raw.sin; }
        const int g = F.lane >> 4, c = F.lane & 15;
        LAS bf16_t* ATT = (LAS bf16_t*)(F.lds + GL_ATT);
#pragma unroll
        for (int k = 0; k < 2; ++k) { const int tile = F.wave + 8 * k, mt = tile >> 2, nt = tile & 3;
            f32x4 af = (f32x4){0.f, 0.f, 0.f, 0.f}, ab = af;
            af = mma_lds((const LAS bf16_t*)(F.lds + GL_QTF) + mt * 16 * 40, 40, (const LAS bf16_t*)(F.lds + GL_KTF) + nt * 16 * 40, 40, 1, af, F.lane);
            ab = mma_lds((const LAS bf16_t*)(F.lds + GL_QTB) + mt * 16 * 40, 40, (const LAS bf16_t*)(F.lds + GL_KTB) + nt * 16 * 40, 40, 1, ab, F.lane);
#pragma unroll
            for (int e = 0; e < 4; ++e) { const int i = mt * 16 + 4 * g + e, j = nt * 16 + c; const float v = (j <= i ? af[e] : 0.f) + (j >= i ? ab[e] : 0.f); ATT[i * 72 + j] = (bf16_t)f2bf(v); } }
        __syncthreads();
        LAS float* O = (LAS float*)(F.lds + GL_O);
#pragma unroll
        for (int k = 0; k < 2; ++k) { const int tile = F.wave + 8 * k, mt = tile >> 2, nt = tile & 3;
            f32x4 a = (f32x4){0.f, 0.f, 0.f, 0.f};
            a = mma_lds(ATT + mt * 16 * 72, 72, (const LAS bf16_t*)(F.lds + GL_VT) + nt * 16 * 72, 72, 2, a, F.lane);
            a = mma_lds((const LAS bf16_t*)(F.lds + GL_QTF) + mt * 16 * 40, 40, (const LAS bf16_t*)(F.lds + GL_SF) + nt * 16 * 40, 40, 1, a, F.lane);
            a = mma_lds((const LAS bf16_t*)(F.lds + GL_QTB) + mt * 16 * 40, 40, (const LAS bf16_t*)(F.lds + GL_SB) + nt * 16 * 40, 40, 1, a, F.lane);
#pragma unroll
            for (int e = 0; e < 4; ++e) O[(mt * 16 + 4 * g + e) * 65 + nt * 16 + c] = a[e]; }
        __syncthreads();
        { const int i = t >> 3, dv8 = (t & 7) * 8; const bool lat = cn >= 4; const int row = (lat ? b * SEQ + (cn - 4) * 64 : NLAT + b * CTXL + cn * 64) + i;
          float v[8]; float ss = 0.f;
#pragma unroll
          for (int e = 0; e < 8; ++e) { v[e] = O[i * 65 + dv8 + e]; ss += v[e] * v[e]; }
          ss += shx(ss, 1, F.lane); ss += shx(ss, 2, F.lane); ss += shx(ss, 4, F.lane);
          const float rs = 1.0f / sqrtf(ss * (1.0f / 64.0f) + LN_EPS);
          const u32x4 gw = raw.gw; const unsigned ga[4] = {gw.x, gw.y, gw.z, gw.w};
          const float* gn = F.in[I_GNORM] + l * 64 + dv8;
          float o[8];
#pragma unroll
          for (int e = 0; e < 4; ++e) { o[2 * e] = v[2 * e] * rs * gn[2 * e] * silu_f(bflo(ga[e])); o[2 * e + 1] = v[2 * e + 1] * rs * gn[2 * e + 1] * silu_f(bfhi(ga[e])); }
          u32x4 w; w.x = pk2(o[0], o[1]); w.y = pk2(o[2], o[3]); w.z = pk2(o[4], o[5]); w.w = pk2(o[6], o[7]);
          *(GAS u32x4*)((bf16_t*)(F.ws + WS_MIX) + (size_t)row * DM + 512 + h * 64 + dv8) = w; }
        raw = nraw; u = un;
    }
#undef GLA_NEXT
}

template <int L>
__device__ __forceinline__ void hyena_conv(Frame& F, const bf16_t* Rg, const bf16_t* Uin, const bf16_t* Xmul, int pos0, bool final_out, int ch, bf16_t* Zout) {
    constexpr int CS = 2 * L + 16;
    constexpr int NTL = L / 16, J = (NTL >= 64) ? 16 : 2, NGRP = NTL / J, HJ = J / 2, NSTEP = L / 32;
    LAS bf16_t* Rl = (LAS bf16_t*)F.lds;
    __syncthreads();
    for (int c = F.tid; c < 2 * L / 8; c += NTHR) { const u32x4 v = *(const GAS u32x4*)(Rg + 8 * c); const unsigned a[4] = {v.x, v.y, v.z, v.w};
#pragma unroll
        for (int rho = 0; rho < 8; ++rho) { LAS bf16_t* d = Rl + rho * CS + 8 * c + rho;
#pragma unroll
            for (int k = 0; k < 4; ++k) { d[2 * k] = (bf16_t)(a[k] & 0xffffu); d[2 * k + 1] = (bf16_t)(a[k] >> 16); } } }
    __syncthreads();
    int ln_ = F.lane; asm volatile("" : "+v"(ln_));
    const int i = ln_ & 15, g = ln_ >> 4, rho = i & 7;
    const LAS bf16_t* Rc = Rl + rho * CS + rho;
    for (int grp = F.wave; grp < NGRP; grp += NWAVES) {
        f32x4 acc[J]; bf16x8 fr[J];
        const int tb = grp * J * 16;
        const LAS bf16_t* Rb = Rc + (L - tb - i + 8 * g);
#pragma unroll
        for (int j = 0; j < J; ++j) { acc[j] = (f32x4){0.f, 0.f, 0.f, 0.f}; fr[j] = *(const LAS bf16x8*)(Rb - 16 * j); }
        const char* ub = (const char*)(Uin + pos0); const unsigned ulo = (unsigned)((i * SPB + 8 * g) * 2);
        bf16x8 bcur = *(const GAS bf16x8*)(ub + (size_t)ulo);
#pragma unroll 1
        for (int q = 0; q < NSTEP / HJ; ++q) {
#pragma unroll
            for (int m = 0; m < HJ; ++m) {
                const int n = q * HJ + m;
                const int nn = (n + 1 < NSTEP) ? n + 1 : 0;
                const bf16x8 bnext = *(const GAS bf16x8*)(ub + (size_t)(ulo + (unsigned)nn * 64u));
                if (n > 0) { fr[(J - 2 * m) % J] = *(const LAS bf16x8*)(Rb + 32 * n); fr[(J + 1 - 2 * m) % J] = *(const LAS bf16x8*)(Rb + 32 * n - 16); }
#pragma unroll
                for (int j = 0; j < J; ++j) acc[j] = mfma16(fr[(j + J - 2 * m) % J], bcur, acc[j]);
                bcur = bnext;
            }
        }
#pragma unroll
        for (int j = 0; j < J; ++j) { const int t0 = tb + j * 16 + 4 * g;
            const u32x2 xw = *(const GAS u32x2*)(Xmul + (size_t)i * SPB + pos0 + t0);
            const float y0 = acc[j][0] * bflo(xw.x), y1 = acc[j][1] * bfhi(xw.x), y2 = acc[j][2] * bflo(xw.y), y3 = acc[j][3] * bfhi(xw.y);
            if (!final_out) { u32x2 w; w.x = pk2(y0, y1); w.y = pk2(y2, y3); *(GAS u32x2*)(Zout + (size_t)i * SPB + pos0 + t0) = w; }
            else { const int row = (pos0 ? NLAT + i * CTXL : i * SEQ) + t0; GAS bf16_t* mp = (GAS bf16_t*)((bf16_t*)(F.ws + WS_MIX) + (size_t)row * DM + 768 + ch);
                mp[0] = (bf16_t)f2bf(y0); mp[DM] = (bf16_t)f2bf(y1); mp[2 * DM] = (bf16_t)f2bf(y2); mp[3 * DM] = (bf16_t)f2bf(y3); } }
    }
}
__device__ __forceinline__ void ph_hyena(Frame& F, int l, bool last) {
    const bf16_t* HV = (const bf16_t*)(F.ws + WS_HV); bf16_t* Z2 = (bf16_t*)(F.ws + WS_Z2);
    for (int ch = F.wg; ch < 256; ch += F.G) {
        const bf16_t* v = HV + (size_t)(0 * 256 + ch) * NB * SPB; const bf16_t* x1 = HV + (size_t)(256 + ch) * NB * SPB; const bf16_t* x2 = HV + (size_t)(512 + ch) * NB * SPB;
        bf16_t* z = Z2 + (size_t)ch * NB * SPB;
        const bf16_t* R0 = (const bf16_t*)(F.ws + WS_HYF) + ((size_t)(l * 2 + 0) * 256 + ch) * 8192; const bf16_t* R1 = (const bf16_t*)(F.ws + WS_HYF) + ((size_t)(l * 2 + 1) * 256 + ch) * 8192;
        hyena_conv<4096>(F, R0, v, x1, 0, false, ch, z);
        VM_WAIT(); __syncthreads(); __builtin_amdgcn_fence(__ATOMIC_ACQUIRE, "agent"); VM_WAIT();
        hyena_conv<4096>(F, R1, z, x2, 0, true, ch, z);
        if (!last) {
            const bf16_t* C0 = (const bf16_t*)(F.ws + WS_HYFC) + ((size_t)(l * 2 + 0) * 256 + ch) * 512; const bf16_t* C1 = (const bf16_t*)(F.ws + WS_HYFC) + ((size_t)(l * 2 + 1) * 256 + ch) * 512;
            hyena_conv<256>(F, C0, v, x1, SEQ, false, ch, z);
            VM_WAIT(); __syncthreads(); __builtin_amdgcn_fence(__ATOMIC_ACQUIRE, "agent"); VM_WAIT();
            hyena_conv<256>(F, C1, z, x2, SEQ, true, ch, z);
        }
    }
}

__device__ __forceinline__ void unpack8(const u32x4 q, float* o) { o[0] = bflo(q.x); o[1] = bfhi(q.x); o[2] = bflo(q.y); o[3] = bfhi(q.y); o[4] = bflo(q.z); o[5] = bfhi(q.z); o[6] = bflo(q.w); o[7] = bfhi(q.w); }
__device__ __forceinline__ void ph_ln1(Frame& F, int l, int ntok) {
    const int gw = F.wg * NWAVES + F.wave, NGW = F.G * NWAVES;
    const float* lg = F.in[I_LN1G] + l * DM + 16 * F.lane; const float* lb = F.in[I_LN1B] + l * DM + 16 * F.lane;
    for (int row = gw; row < ntok; row += NGW) {
        bf16_t* xr = (bf16_t*)(F.ws + WS_XR) + (size_t)row * DM + 16 * F.lane;
        const bf16_t* yr = (const bf16_t*)(F.ws + WS_Y) + (size_t)row * DM + 16 * F.lane;
        const float* md = mod_ptr(F, l, row) + 16 * F.lane;
        bf16_t* xm = (bf16_t*)(F.ws + WS_XM) + (size_t)row * DM + 16 * F.lane;
        const u32x4 xa = *(const GAS u32x4*)xr, xb = *(const GAS u32x4*)(xr + 8), ya = *(const GAS u32x4*)yr, yb = *(const GAS u32x4*)(yr + 8);
        float x[16], y[16], v[16]; unpack8(xa, x); unpack8(xb, x + 8); unpack8(ya, y); unpack8(yb, y + 8);
        float s = 0.f;
#pragma unroll
        for (int j = 0; j < 4; ++j) { const f32x4 g1 = *(const GAS f32x4*)(md + 2048 + 4 * j);
#pragma unroll
            for (int e = 0; e < 4; ++e) { v[4 * j + e] = x[4 * j + e] * DN_ALPHA + g1[e] * y[4 * j + e]; s += v[4 * j + e]; } }
        const float mean = wave_sum(s, F.lane) * (1.f / DM); float s2 = 0.f;
#pragma unroll
        for (int e = 0; e < 16; ++e) { v[e] -= mean; s2 += v[e] * v[e]; }
        const float rstd = 1.f / sqrtf(wave_sum(s2, F.lane) * (1.f / DM) + LN_EPS);
        unsigned wx[8], wm[8]; int w8[4];
#pragma unroll
        for (int j = 0; j < 4; ++j) { const f32x4 g = *(const GAS f32x4*)(lg + 4 * j), bb = *(const GAS f32x4*)(lb + 4 * j), sh = *(const GAS f32x4*)(md + 3072 + 4 * j), sc = *(const GAS f32x4*)(md + 4096 + 4 * j);
            float xn[4];
#pragma unroll
            for (int e = 0; e < 4; ++e) xn[e] = v[4 * j + e] * rstd * g[e] + bb[e];
            wx[2 * j] = pk2(xn[0], xn[1]); wx[2 * j + 1] = pk2(xn[2], xn[3]);
            const float h0 = xn[0] * (1.f + sc[0]) + sh[0], h1 = xn[1] * (1.f + sc[1]) + sh[1], h2 = xn[2] * (1.f + sc[2]) + sh[2], h3 = xn[3] * (1.f + sc[3]) + sh[3];
            wm[2 * j] = pk2(h0, h1); wm[2 * j + 1] = pk2(h2, h3);
            int v = 0; v = __builtin_amdgcn_cvt_pk_fp8_f32(h0, h1, v, false); v = __builtin_amdgcn_cvt_pk_fp8_f32(h2, h3, v, true); w8[j] = v; }
        *(GAS u32x4*)((unsigned char*)(F.ws + WS_XM8) + (size_t)row * DM + 16 * F.lane) = (u32x4){(unsigned)w8[0], (unsigned)w8[1], (unsigned)w8[2], (unsigned)w8[3]};
        *(GAS u32x4*)xr = (u32x4){wx[0], wx[1], wx[2], wx[3]}; *(GAS u32x4*)(xr + 8) = (u32x4){wx[4], wx[5], wx[6], wx[7]};
        *(GAS u32x4*)xm = (u32x4){wm[0], wm[1], wm[2], wm[3]}; *(GAS u32x4*)(xm + 8) = (u32x4){wm[4], wm[5], wm[6], wm[7]};
    }
}
__device__ __forceinline__ void ph_ln2(Frame& F, int l, int ntok, bool last) {
    const int gw = F.wg * NWAVES + F.wave, NGW = F.G * NWAVES;
    const float* lg = F.in[I_LN2G] + l * DM; const float* lb = F.in[I_LN2B] + l * DM;
    for (int row = gw; row < ntok; row += NGW) {
        bf16_t* xr = (bf16_t*)(F.ws + WS_XR) + (size_t)row * DM + 16 * F.lane;
        const unsigned char* y2 = (const unsigned char*)(F.ws + WS_Y2) + (size_t)row * 9 * DM + 16 * F.lane;
        const float* wg = (const float*)(F.ws + WS_WGT) + (size_t)row * 8;
        const float* md = mod_ptr(F, l, row) + 16 * F.lane;
        float ff[16];
#pragma unroll
        for (int e = 0; e < 16; ++e) ff[e] = 0.f;
        u32x4 q[9];
#pragma unroll
        for (int k = 0; k < 9; ++k) q[k] = *(const GAS u32x4*)(y2 + (size_t)k * DM);
#pragma unroll
        for (int k = 0; k < 9; ++k) { const float wk = (k < 8 ? wg[k] : 1.0f) * pg8::Y2_INV; const unsigned a[4] = {q[k].x, q[k].y, q[k].z, q[k].w};
#pragma unroll
            for (int e = 0; e < 4; ++e) { const f32x2 lo = __builtin_amdgcn_cvt_pk_f32_fp8((int)a[e], false), hi = __builtin_amdgcn_cvt_pk_f32_fp8((int)a[e], true);
                ff[4 * e] += wk * lo.x; ff[4 * e + 1] += wk * lo.y; ff[4 * e + 2] += wk * hi.x; ff[4 * e + 3] += wk * hi.y; } }
        float v[16], xo[16]; float s = 0.f;
        { const u32x4 xa = *(const GAS u32x4*)xr, xb = *(const GAS u32x4*)(xr + 8); unpack8(xa, xo); unpack8(xb, xo + 8); }
#pragma unroll
        for (int j = 0; j < 4; ++j) { const f32x4 g2 = *(const GAS f32x4*)(md + 5120 + 4 * j);
#pragma unroll
            for (int e = 0; e < 4; ++e) { v[4 * j + e] = xo[4 * j + e] * DN_ALPHA + g2[e] * ff[4 * j + e]; s += v[4 * j + e]; } }
        const float mean = wave_sum(s, F.lane) * (1.f / DM); float s2 = 0.f;
#pragma unroll
        for (int e = 0; e < 16; ++e) { v[e] -= mean; s2 += v[e] * v[e]; }
        const float rstd = 1.f / sqrtf(wave_sum(s2, F.lane) * (1.f / DM) + LN_EPS);
        const float* mdn = (last ? mod_ptr(F, l, row) : mod_ptr(F, l + 1, row)) + 16 * F.lane;
        bf16_t* xm = (bf16_t*)(F.ws + WS_XM) + (size_t)row * DM + 16 * F.lane;
        float xn[16];
#pragma unroll
        for (int j = 0; j < 4; ++j) { const f32x4 g = *(const GAS f32x4*)(lg + 16 * F.lane + 4 * j), bb = *(const GAS f32x4*)(lb + 16 * F.lane + 4 * j);
#pragma unroll
            for (int e = 0; e < 4; ++e) xn[4 * j + e] = v[4 * j + e] * rstd * g[e] + bb[e]; }
        if (last) { float* op = F.out + (size_t)row * DM + 16 * F.lane;
#pragma unroll
            for (int j = 0; j < 4; ++j) *(GAS f32x4*)(op + 4 * j) = (f32x4){xn[4 * j], xn[4 * j + 1], xn[4 * j + 2], xn[4 * j + 3]}; }
        else { *(GAS u32x4*)xr = (u32x4){pk2(xn[0], xn[1]), pk2(xn[2], xn[3]), pk2(xn[4], xn[5]), pk2(xn[6], xn[7])}; *(GAS u32x4*)(xr + 8) = (u32x4){pk2(xn[8], xn[9]), pk2(xn[10], xn[11]), pk2(xn[12], xn[13]), pk2(xn[14], xn[15])}; }
        if (!last) {
            unsigned w[8];
#pragma unroll
            for (int j = 0; j < 4; ++j) { const f32x4 sh = *(const GAS f32x4*)(mdn + 4 * j), sc = *(const GAS f32x4*)(mdn + 1024 + 4 * j);
                w[2 * j] = pk2(xn[4 * j] * (1.f + sc[0]) + sh[0], xn[4 * j + 1] * (1.f + sc[1]) + sh[1]); w[2 * j + 1] = pk2(xn[4 * j + 2] * (1.f + sc[2]) + sh[2], xn[4 * j + 3] * (1.f + sc[3]) + sh[3]); }
            *(GAS u32x4*)xm = (u32x4){w[0], w[1], w[2], w[3]}; *(GAS u32x4*)(xm + 8) = (u32x4){w[4], w[5], w[6], w[7]};
        }
    }
}

__device__ __forceinline__ unsigned f_ord(float f) { const unsigned u = __builtin_bit_cast(unsigned, f); return (u & 0x80000000u) ? ~u : (u | 0x80000000u); }
__device__ __forceinline__ unsigned long long wave_max_u64(unsigned long long v, int lane) {
#pragma unroll
    for (int o = 1; o < 64; o <<= 1) { const unsigned lo = (unsigned)shxi((int)(unsigned)v, o, lane), hi = (unsigned)shxi((int)(unsigned)(v >> 32), o, lane); const unsigned long long w = ((unsigned long long)hi << 32) | lo; v = w > v ? w : v; }
    return v;
}
__device__ __forceinline__ float seg16_max(float v, int lane) { v = fmaxf(v, shx(v, 1, lane)); v = fmaxf(v, shx(v, 2, lane)); v = fmaxf(v, shx(v, 4, lane)); v = fmaxf(v, shx(v, 8, lane)); return v; }
__device__ __forceinline__ int seg16_min_i(int v, int lane) { int w; w = shxi(v, 1, lane); v = w < v ? w : v; w = shxi(v, 2, lane); v = w < v ? w : v; w = shxi(v, 4, lane); v = w < v ? w : v; w = shxi(v, 8, lane); v = w < v ? w : v; return v; }
__device__ __forceinline__ float seg16_top2(float v, int lane) {
    const float m1 = seg16_max(v, lane);
    const int first = seg16_min_i(v == m1 ? (lane & 15) : 99, lane);
    const float m2 = seg16_max((lane & 15) == first ? -3.0e38f : v, lane);
    return m1 + m2;
}
__device__ __forceinline__ void ph_route(Frame& F, int l, int ntok) {
    LAS int* hist = (LAS int*)F.lds;
    LAS int* base = hist + 128;
    LAS unsigned* alist = (LAS unsigned*)(F.lds + 1024);
    const int tpw = (ntok + F.G - 1) / F.G, t0 = F.wg * tpw, t1 = (t0 + tpw) < ntok ? (t0 + tpw) : ntok;
    __syncthreads();
    if (F.tid < 128) hist[F.tid] = 0;
    __syncthreads();
    const float* LG = (const float*)(F.ws + WS_LOGIT); const float* rb = F.in[I_RB] + l * NEXP;
    const float b0 = rb[F.lane], b1 = rb[F.lane + 64];
    for (int tok = t0 + F.wave; tok < t1; tok += NWAVES) {
        const float x0 = LG[(size_t)tok * 256 + F.lane], x1 = LG[(size_t)tok * 256 + 64 + F.lane];
        const float s0 = 1.0f / (1.0f + __expf(-x0)), s1 = 1.0f / (1.0f + __expf(-x1));
        const float e0 = s0 + b0, e1 = s1 + b1;
        const float gs0 = seg16_top2(e0, F.lane), gs1 = seg16_top2(e1, F.lane);
        float gsc[8];
#pragma unroll
        for (int g = 0; g < 4; ++g) { gsc[g] = shf(gs0, g * 16); gsc[4 + g] = shf(gs1, g * 16); }
        unsigned gmask = 0u;
#pragma unroll
        for (int g = 0; g < 8; ++g) { int cnt = 0;
#pragma unroll
            for (int g2 = 0; g2 < 8; ++g2) cnt += (gsc[g2] > gsc[g] || (gsc[g2] == gsc[g] && g2 < g)) ? 1 : 0;
            gmask |= (cnt < 4) ? (1u << g) : 0u; }
        const bool ok0 = (gmask >> (F.lane >> 4)) & 1u, ok1 = (gmask >> (4 + (F.lane >> 4))) & 1u;
        unsigned long long k0 = ok0 ? (((unsigned long long)f_ord(e0) << 32) | (unsigned)(255 - F.lane)) : 0ull;
        unsigned long long k1 = ok1 ? (((unsigned long long)f_ord(e1) << 32) | (unsigned)(255 - 64 - F.lane)) : 0ull;
        int mye = 0; float myw = 0.f; float wsum = 0.f;
#pragma unroll
        for (int k = 0; k < 8; ++k) {
            const unsigned long long best = wave_max_u64(k0 > k1 ? k0 : k1, F.lane);
            const int e = 255 - (int)(best & 0xffu);
            if (k0 == best) k0 = 0ull; if (k1 == best) k1 = 0ull;
            const float sv = shf(e < 64 ? s0 : s1, e & 63);
            wsum += sv; if (F.lane == k) { mye = e; myw = sv; }
        }
        if (F.lane < 8) {
            const int lr = __hip_atomic_fetch_add(&hist[mye], 1, __ATOMIC_RELAXED, __HIP_MEMORY_SCOPE_WORKGROUP);
            alist[(tok - t0) * 8 + F.lane] = (unsigned)mye | ((unsigned)lr << 8);
            ((int*)(F.ws + WS_EIDX))[(size_t)tok * 8 + F.lane] = mye;
            ((float*)(F.ws + WS_WGT))[(size_t)tok * 8 + F.lane] = myw / wsum * 2.5f;
        }
    }
    __syncthreads();
    if (F.tid < 128) { const int hcount = hist[F.tid]; base[F.tid] = hcount ? (int)atomicAdd(F.ctl + CW_CNT + l * 256 + F.tid, (unsigned)hcount) : 0; }
    __syncthreads();
    for (int a = F.tid; a < (t1 - t0) * 8; a += NTHR) { const unsigned v = alist[a]; ((int*)(F.ws + WS_RNK))[(size_t)t0 * 8 + a] = base[v & 0xffu] + (int)(v >> 8); }
}
__device__ __forceinline__ void ph_positions(Frame& F, int l, int ntok) {
    LAS int* cnt = (LAS int*)F.lds;
    LAS int* off = cnt + 132;
    __syncthreads();
    if (F.tid < NE1) cnt[F.tid] = F.tid < NEXP ? (int)__hip_atomic_load(F.ctl + CW_CNT + l * 256 + F.tid, __ATOMIC_RELAXED, __HIP_MEMORY_SCOPE_AGENT) : ntok;
    __syncthreads();
    if (F.tid == 0) { int o = 0; for (int e = 0; e < NE1; ++e) { off[e] = o; o += (cnt[e] + 255) & ~255; } off[NE1] = o; }
    __syncthreads();
    const int gt = F.wg * NTHR + F.tid, NGT = F.G * NTHR;
    int* rowtok = (int*)(F.ws + WS_ROWTOK); int* rowdst = (int*)(F.ws + WS_ROWDST); int* tile_exp = (int*)(F.ws + WS_TILEEXP);
    const int* eidx = (const int*)(F.ws + WS_EIDX); const int* rnk = (const int*)(F.ws + WS_RNK);
    for (int a = gt; a < ntok * 8; a += NGT) { const int tok = a >> 3, k = a & 7; const int pos = off[eidx[a]] + rnk[a]; rowtok[pos] = tok; rowdst[pos] = tok * 9 + k; }
    for (int tok = gt; tok < ntok; tok += NGT) { const int pos = off[NEXP] + tok; rowtok[pos] = tok; rowdst[pos] = tok * 9 + 8; }
    for (int i = gt; i < NE1 * 256; i += NGT) { const int e = i >> 8, p = i & 255; const int row = off[e] + cnt[e] + p; if (row < off[e + 1]) { rowtok[row] = 0; rowdst[row] = -1; } }
    for (int i = gt; i < NE1 * 320; i += NGT) { const int e = i / 320, p = i % 320; const int t = (off[e] >> 8) + p; if (t < (off[e + 1] >> 8)) tile_exp[t] = e; }
    if (gt == 0) F.ctl[CW_NTL + l] = (unsigned)(off[NE1] >> 8);
}

#ifndef MK_MULTI
#define MK_MULTI 0
#endif
constexpr int PH_PER_LAYER = 12, NPHASE = 2 + DEPTH * PH_PER_LAYER;
struct Args { const float* in[36]; float* out; unsigned char* ws; int ph_lo, ph_hi; };

__global__ void __launch_bounds__(NTHR, 2) mk_fwd(Args args) {
    extern __shared__ __attribute__((aligned(16))) unsigned char lds_raw[];
    Frame F;
    F.lds = (LAS unsigned char*)lds_raw;
    F.tid = threadIdx.x; F.lane = F.tid & 63; F.wave = __builtin_amdgcn_readfirstlane(F.tid >> 6);
    const int wave0 = F.wave;
    F.G = gridDim.x; F.wg = blockIdx.x;
    F.in = args.in;
    F.out = args.out; F.ws = args.ws; F.ctl = (unsigned*)(args.ws + WS_CTL);
    volatile LAS unsigned* MISC = (volatile LAS unsigned*)(F.lds + MISC_OFF);
    if (F.tid < 32) MISC[F.tid] = 0u;
    __syncthreads();
    const int lo = args.ph_lo, hi = args.ph_hi;
    const bool single = (hi - lo) > 1;
    XcdBarrier bar; bar.bar = F.ctl + CW_BAR; bar.x = 0; bar.st = nullptr;
    if (single) bar = xcd_barrier_post(F.ctl + CW_BAR, MISC + 8);
#define IN(k) (lo <= (k) && (k) < hi)
#ifndef PROBE_MASK
#define PROBE_MASK 0
#endif
#define REP(k) for (int _rep = 0; _rep < (((PROBE_MASK >> (k)) & 1) ? 2 : 1); ++_rep)
#define SEAM(k) do { if (IN(k) && IN((k) + 1)) xcd_barrier(bar); } while (0)
#define FRESH() do { int _ln; asm volatile("v_mbcnt_lo_u32_b32 %0, -1, 0\n\tv_mbcnt_hi_u32_b32 %0, -1, %0" : "=v"(_ln)); int _wv = wave0; asm volatile("" : "+s"(_wv)); F.lane = _ln; F.wave = _wv; F.tid = (_wv << 6) | _ln; \
        unsigned char* _w = args.ws; asm volatile("" : "+s"(_w)); F.ws = _w; F.ctl = (unsigned*)(_w + WS_CTL); float* _o = args.out; asm volatile("" : "+s"(_o)); F.out = _o; } while (0)

    if (IN(0)) { FRESH(); p0_static_weights(F); __syncthreads(); p0_mod(F); __syncthreads(); p0_hyena_filters(F); }
    SEAM(0);
    if (IN(1)) { FRESH(); p0_init_rows(F); }
    SEAM(1);
#pragma unroll 1
    for (int l = 0; l < DEPTH; ++l) {
        const int pb = 2 + l * PH_PER_LAYER; const bool last = (l == DEPTH - 1); const int ntok = last ? NLAT : NROW;
        if (IN(pb + 0)) { FRESH();
            REP(0) { p_expert_weights(F, l); __syncthreads(); }
            pg8::DenseOrder S; S.init(NROW, DIN, F.G, F.wg); pg8::EpiBf16 E{(bf16_t*)(F.ws + WS_U), DIN};
            REP(1) pg8::gemm_phase<pg8::EpiBf16, pg8::DenseOrder, false>(F.tid, F.lds, (const bf16_t*)(F.ws + WS_XM), (const bf16_t*)(F.ws + WS_WIN) + (size_t)l * DIN * DM, DM, nullptr, S, E);
        }
        SEAM(pb + 0);
        if (IN(pb + 1)) { FRESH(); REP(2) { ph_transposes(F, l); __syncthreads(); } REP(3) { ph_gla_local(F, l); __syncthreads(); } }
        SEAM(pb + 1);
        if (IN(pb + 2)) { FRESH(); REP(4) { ph_na(F, l, last); } REP(5) { ph_gla_scan(F); } __syncthreads(); REP(6) { ph_hyena(F, l, last); } }
        SEAM(pb + 2);
        if (IN(pb + 3)) { FRESH(); REP(7) { ph_gla_out(F, l, last); } }
        SEAM(pb + 3);
        if (IN(pb + 4)) { FRESH();
            pg8::DenseOrder S; S.init(ntok, DM, F.G, F.wg); pg8::EpiBf16 E{(bf16_t*)(F.ws + WS_Y), DM};
            REP(8) pg8::gemm_phase<pg8::EpiBf16, pg8::DenseOrder, false>(F.tid, F.lds, (const bf16_t*)(F.ws + WS_MIX), (const bf16_t*)(F.ws + WS_WOUT) + (size_t)l * DM * DM, DM, nullptr, S, E);
        }
        SEAM(pb + 4);
        if (IN(pb + 5)) { FRESH(); ph_ln1(F, l, ntok); }
        SEAM(pb + 5);
        if (IN(pb + 6)) { FRESH();
            pg8::DenseOrder S; S.init(ntok, 256, F.G, F.wg); pg8::EpiF32 E{(float*)(F.ws + WS_LOGIT), 256};
            REP(9) pg8::gemm_phase<pg8::EpiF32, pg8::DenseOrder, false>(F.tid, F.lds, (const bf16_t*)(F.ws + WS_XM), (const bf16_t*)(F.ws + WS_WR) + (size_t)l * 256 * DM, DM, nullptr, S, E);
        }
        SEAM(pb + 6);
        if (IN(pb + 7)) { FRESH(); ph_route(F, l, ntok); }
        SEAM(pb + 7);
        if (IN(pb + 8)) { FRESH(); REP(12) { ph_positions(F, l, ntok); __syncthreads(); } }
        SEAM(pb + 8);
        if (IN(pb + 9)) { FRESH();
            const int ntl = (int)__hip_atomic_load(F.ctl + CW_NTL + l, __ATOMIC_RELAXED, __HIP_MEMORY_SCOPE_AGENT);
            pg8::GroupedOrder S; S.init((const int*)(F.ws + WS_TILEEXP), ntl, 2, F.G, F.wg); pg8::EpiSwiglu E{(unsigned char*)(F.ws + WS_ACT)};
            REP(10) pg8::gemm_phase<pg8::EpiSwiglu, pg8::GroupedOrder, true, true>(F.tid, F.lds, (const void*)(F.ws + WS_XM8), (const void*)(F.ws + WS_EXP1), DM, (const int*)(F.ws + WS_ROWTOK), S, E);
        }
        SEAM(pb + 9);
        if (IN(pb + 10)) { FRESH();
            const int ntl = (int)__hip_atomic_load(F.ctl + CW_NTL + l, __ATOMIC_RELAXED, __HIP_MEMORY_SCOPE_AGENT);
            pg8::GroupedOrder S; S.init((const int*)(F.ws + WS_TILEEXP), ntl, 4, F.G, F.wg); pg8::EpiScatter E{(unsigned char*)(F.ws + WS_Y2), (const int*)(F.ws + WS_ROWDST)};
            REP(11) pg8::gemm_phase<pg8::EpiScatter, pg8::GroupedOrder, false, true>(F.tid, F.lds, (const void*)(F.ws + WS_ACT), (const void*)(F.ws + WS_EXP2), EH, nullptr, S, E);
        }
        SEAM(pb + 10);
        if (IN(pb + 11)) { FRESH(); ph_ln2(F, l, ntok, last); }
        SEAM(pb + 11);
    }
#undef IN
#undef SEAM
#undef FRESH
}

extern "C" void kernel_launch(void* const* d_in, const int* in_sizes, int n_in, void* d_out, int out_size, void* d_ws, size_t ws_size, hipStream_t stream) {
    static int grid = 0;
    if (grid == 0) {
        if (n_in != 36 || out_size != NLAT * DM || ws_size < WS_END) { fprintf(stderr, "kernel_launch: unexpected shapes (n_in %d out %d ws %zu need %zu)\n", n_in, out_size, ws_size, (size_t)WS_END); grid = -1; return; }
        int dev = 0, cus = 0, per_cu = 0;
        if (hipGetDevice(&dev) != hipSuccess || hipDeviceGetAttribute(&cus, hipDeviceAttributeMultiprocessorCount, dev) != hipSuccess) { grid = -1; return; }
        if (hipFuncSetAttribute((const void*)mk_fwd, hipFuncAttributeMaxDynamicSharedMemorySize, LDS_BYTES) != hipSuccess) { fprintf(stderr, "kernel_launch: hipFuncSetAttribute failed\n"); grid = -1; return; }
        if (hipOccupancyMaxActiveBlocksPerMultiprocessor(&per_cu, (const void*)mk_fwd, NTHR, LDS_BYTES) != hipSuccess || per_cu < 1) { fprintf(stderr, "kernel_launch: occupancy query says %d\n", per_cu); }
        (void)hipGetLastError();
        grid = cus;
    }
    if (grid < 0) return;
    (void)hipMemsetAsync((char*)d_ws + WS_CTL, 0, CTL_BYTES, stream);
    Args a{};
    for (int i = 0; i < 36; ++i) a.in[i] = (const float*)d_in[i];
    a.out = (float*)d_out; a.ws = (unsigned char*)d_ws;
#if MK_MULTI
    for (int p = 0; p < NPHASE; ++p) { a.ph_lo = p; a.ph_hi = p + 1; hipLaunchKernelGGL(mk_fwd, dim3(grid), dim3(NTHR), LDS_BYTES, stream, a); }
#else
    a.ph_lo = 0; a.ph_hi = NPHASE; hipLaunchKernelGGL(mk_fwd, dim3(grid), dim3(NTHR), LDS_BYTES, stream, a);
#endif
}
```

```cpp
#include <hip/hip_runtime.h>
#include <cstdio>
#include <cstdint>

#define LAS __attribute__((address_space(3)))
#define GAS __attribute__((address_space(1)))
typedef unsigned short bf16_t;
typedef short bf16x8 __attribute__((ext_vector_type(8)));
typedef float f32x4 __attribute__((ext_vector_type(4)));
typedef float f32x2 __attribute__((ext_vector_type(2)));
typedef unsigned u32x4 __attribute__((ext_vector_type(4)));
typedef unsigned u32x2 __attribute__((ext_vector_type(2)));

constexpr int NB = 16, SEQ = 4096, CTXL = 256, DM = 1024, DEPTH = 4;
constexpr int NLAT = NB * SEQ;
constexpr int NCTX = NB * CTXL;
constexpr int NROW = NLAT + NCTX;
constexpr int SPB = SEQ + CTXL;
constexpr int DIN_REF = 3104;
constexpr int DIN = 3328;
constexpr int UQ = 0, UK = 512, UV = 1024, UGQ = 1536, UGK = 1664, UGV = 1792, UGR = 2048, UHY = 2304, ULAF = 3072, ULAB = 3200;
constexpr int NEXP = 128, TOPK = 8, EH = 256;
constexpr int NE1 = NEXP + 1;
constexpr int RMAX = 659712;
constexpr int TMAX = RMAX / 256;
constexpr float LN_EPS = 1e-6f;
constexpr float DN_ALPHA = 1.6817928305074290f;

__device__ __forceinline__ unsigned f2bf(float f) { unsigned u = __builtin_bit_cast(unsigned, f); return (u + 0x7fffu + ((u >> 16) & 1u)) >> 16; }
typedef __bf16 bf16v2 __attribute__((ext_vector_type(2)));
__device__ __forceinline__ unsigned pk2(float lo, float hi) { const f32x2 v = {lo, hi}; const bf16v2 b = __builtin_convertvector(v, bf16v2); return __builtin_bit_cast(unsigned, b); }
__device__ __forceinline__ float bf2f(unsigned short b) { return __builtin_bit_cast(float, ((unsigned)b) << 16); }
__device__ __forceinline__ float bflo(unsigned w) { return __builtin_bit_cast(float, w << 16); }
__device__ __forceinline__ float bfhi(unsigned w) { return __builtin_bit_cast(float, w & 0xffff0000u); }
__device__ __forceinline__ float shx(float v, int o, int lane) { return __builtin_bit_cast(float, __builtin_amdgcn_ds_bpermute((lane ^ o) << 2, __builtin_bit_cast(int, v))); }
__device__ __forceinline__ int shxi(int v, int o, int lane) { return __builtin_amdgcn_ds_bpermute((lane ^ o) << 2, v); }
__device__ __forceinline__ float shf(float v, int src) { return __builtin_bit_cast(float, __builtin_amdgcn_ds_bpermute(src << 2, __builtin_bit_cast(int, v))); }
__device__ __forceinline__ float wave_sum(float v, int lane) {
#pragma unroll
    for (int o = 1; o < 64; o <<= 1) v += shx(v, o, lane);
    return v;
}
__device__ __forceinline__ float silu_f(float x) { return x / (1.0f + __expf(-x)); }
#define LDS_WAIT() asm volatile("s_waitcnt lgkmcnt(0)" ::: "memory")
#define VM_WAIT() asm volatile("s_waitcnt vmcnt(0)" ::: "memory")

#define XB_TMO      128
#define XB_XCNT(j)  (256  + 64 * (j))
#define XB_XSUB(j)  (1280 + 64 * (j))
#define XB_XGEN(j)  (2304 + 64 * (j))
#define XB_TOP      3328
#define XB_TOPGEN   3392
#define XCD_BAR_WORDS 3456
#define XB_SPIN_CAP (1u << 18)

__device__ __forceinline__ unsigned xb_ld(unsigned* p)              { return __hip_atomic_load(p, __ATOMIC_RELAXED, __HIP_MEMORY_SCOPE_AGENT); }
__device__ __forceinline__ unsigned xb_add(unsigned* p, unsigned v) { return __hip_atomic_fetch_add(p, v, __ATOMIC_RELAXED, __HIP_MEMORY_SCOPE_AGENT); }
__device__ __forceinline__ unsigned xb_xcc_id() { return (unsigned)__builtin_amdgcn_s_getreg((3 << 11) | 20) & 0xFu; }
#define XB_SPIN(cond, bar) do { unsigned _sp = 0; while (cond) { __builtin_amdgcn_s_sleep(1); \
    if ((++_sp & 255u) == 0u) { if (xb_ld(&(bar)[XB_TMO])) break; if (_sp > XB_SPIN_CAP) { atomicAdd(&(bar)[XB_TMO], 1u); break; } } } } while (0)

struct XcdBarrier { unsigned* bar; unsigned x; volatile LAS unsigned* st; };

__device__ __forceinline__ XcdBarrier xcd_barrier_post(unsigned* bar, volatile LAS unsigned* st) {
    XcdBarrier b; b.bar = bar; b.x = xb_xcc_id(); b.st = st;
    if (threadIdx.x == 0) (void)xb_add(&bar[XB_XCNT(b.x)], 1u);
    return b;
}
__device__ __forceinline__ void xcd_barrier_complete(unsigned* bar, unsigned x, unsigned& nloc, unsigned& nx) {
    const unsigned G = gridDim.x * gridDim.y * gridDim.z;
    unsigned sum, cnt, mine, sp = 0u;
    for (;;) {
        sum = 0u; cnt = 0u; mine = 0u;
#pragma unroll
        for (unsigned j = 0; j < 16; ++j) { const unsigned c = xb_ld(&bar[XB_XCNT(j)]); sum += c; cnt += (c > 0u) ? 1u : 0u; mine = (j == x) ? c : mine; }
        if (sum == G) break;
        __builtin_amdgcn_s_sleep(1);
        if ((++sp & 255u) == 0u) { if (xb_ld(&bar[XB_TMO])) break; if (sp > XB_SPIN_CAP) { atomicAdd(&bar[XB_TMO], 1u); break; } }
    }
    nloc = mine > 0u ? mine : 1u; nx = cnt > 0u ? cnt : 1u;
}
__device__ __forceinline__ void xcd_barrier(const XcdBarrier& b) {
    asm volatile("s_waitcnt vmcnt(0)" ::: "memory");
    __syncthreads();
    if (threadIdx.x == 0) {
        unsigned* bar = b.bar;
        __builtin_amdgcn_s_waitcnt(0);
        unsigned nloc = b.st[0], nx = b.st[1];
        if (nloc == 0u) { xcd_barrier_complete(bar, b.x, nloc, nx); b.st[0] = nloc; b.st[1] = nx; }
        const unsigned old = xb_add(&bar[XB_XSUB(b.x)], 1u);
        const unsigned gen = old / nloc;
        if (old + 1u == (gen + 1u) * nloc) {
            __builtin_amdgcn_fence(__ATOMIC_RELEASE, "agent");
            asm volatile("s_waitcnt vmcnt(0)" ::: "memory");
            const unsigned og = xb_add(&bar[XB_TOP], 1u);
            const unsigned tg = og / nx;
            if (og + 1u == (tg + 1u) * nx) xb_add(&bar[XB_TOPGEN], 1u);
            else XB_SPIN(xb_ld(&bar[XB_TOPGEN]) == tg, bar);
            __builtin_amdgcn_fence(__ATOMIC_ACQUIRE, "agent");
            xb_add(&bar[XB_XGEN(b.x)], 1u);
            asm volatile("s_waitcnt vmcnt(0)" ::: "memory");
        } else {
            XB_SPIN(xb_ld(&bar[XB_XGEN(b.x)]) == gen, bar);
            __builtin_amdgcn_fence(__ATOMIC_ACQUIRE, "agent");
            asm volatile("s_waitcnt vmcnt(0)" ::: "memory");
        }
    }
    __syncthreads();
}

namespace pg8 {
constexpr int BM = 256, BK = 64, HALF = 128, HTB = HALF * BK * 2, STAGE_BYTES = 8 * HTB, NXCD = 8, WGM = 8;
__host__ __device__ __forceinline__ int lds_byte(int r, int c) { const int st = (r >> 4) * 2 + (c >> 5), rr = r & 15, cc = c & 31, ob = rr * 64 + cc * 2; return st * 1024 + (ob ^ (((ob >> 9) & 1) << 5)); }
__host__ __device__ __forceinline__ void stage_rc(int b, int& R, int& C) { const int st = b / 1024, sb = b % 1024, swz = sb ^ (((sb >> 9) & 1) << 5); R = (st >> 1) * 16 + swz / 64; C = (st & 1) * 32 + (swz % 64) / 2; }
__host__ __device__ __forceinline__ int perm32(int rho) { const int n = rho >> 4, i = rho & 15; return 8 * (i >> 2) + 4 * n + (i & 3); }

struct Unit { int arow0, brow0, orow0, ocol0, aux; };

struct DenseOrder {
    int nM, nN, nwg, G, c;
    __device__ void init(int M, int N, int G_, int c_) { nM = M / BM; nN = N / BM; nwg = nM * nN; G = G_; c = c_; }
    __device__ __forceinline__ bool next(int i, Unit& u) const {
        const long L = (long)i * G + c; if (L >= nwg) return false;
        int wgid = (int)L; { const int q = nwg / NXCD, r = nwg % NXCD, xcd = wgid % NXCD, off = wgid / NXCD; wgid = (xcd < r ? xcd * (q + 1) : r * (q + 1) + (xcd - r) * q) + off; }
        const int nig = WGM * nN, gid = wgid / nig, fm = gid * WGM, gsz = (nM - fm) < WGM ? (nM - fm) : WGM;
        const int pm = fm + ((wgid % nig) % gsz), pn = (wgid % nig) / gsz;
        u.arow0 = pm * BM; u.brow0 = pn * BM; u.orow0 = pm * BM; u.ocol0 = pn * BM; u.aux = 0; return true;
    }
};
struct GroupedOrder {
    const int* tile_exp; int nN, nslot, slot, t0, t1;
    __device__ __forceinline__ void init(const int* te, int ntiles, int nN_, int G, int c) {
        tile_exp = te; nN = nN_;
        if ((G & 7) == 0) { const int per = (ntiles + 7) >> 3, x = c & 7; nslot = G >> 3; slot = c >> 3; t0 = x * per; t1 = (t0 + per) < ntiles ? (t0 + per) : ntiles; }
        else { nslot = G; slot = c; t0 = 0; t1 = ntiles; }
    }
    __device__ __forceinline__ bool next(int i, Unit& u) const {
        const int q = i * nslot + slot, t = t0 + q / nN, pn = q % nN;
        if (t >= t1) return false;
        const int e = tile_exp[t];
        u.arow0 = t * BM; u.brow0 = (e * nN + pn) * BM; u.orow0 = t * BM; u.ocol0 = pn * BM; u.aux = e; return true;
    }
};

__device__ __forceinline__ unsigned cvt_pk_bf16(float lo, float hi) { return pk2(lo, hi); }

struct NoPre {};
struct EpiF32 {
    static constexpr bool PERM = false; typedef NoPre Pre;
    __device__ __forceinline__ Pre prefetch(const Unit&, LAS unsigned char*, int, int, int) const { return Pre{}; }
    float* C; int ldc;
    __device__ __forceinline__ void operator()(const f32x4 (&acc)[2][2][4][2], const Unit& u, int wr, int wc, int fr, int fq, const Pre&) const {
        const int row0 = u.orow0 + wr * 64 + fr, col0 = u.ocol0 + wc * 32 + 4 * fq;
#pragma unroll
        for (int ai = 0; ai < 2; ++ai)
#pragma unroll
            for (int m = 0; m < 4; ++m) { float* rowp = C + (size_t)(row0 + ai * HALF + m * 16) * ldc + col0;
#pragma unroll
                for (int bj = 0; bj < 2; ++bj)
#pragma unroll
                    for (int n = 0; n < 2; ++n) *(f32x4*)(rowp + bj * HALF + n * 16) = acc[ai][bj][m][n]; }
    }
};
struct EpiBf16 {
    static constexpr bool PERM = true; typedef NoPre Pre;
    __device__ __forceinline__ Pre prefetch(const Unit&, LAS unsigned char*, int, int, int) const { return Pre{}; }
    bf16_t* O; int ldc;
    __device__ __forceinline__ void operator()(const f32x4 (&acc)[2][2][4][2], const Unit& u, int wr, int wc, int fr, int fq, const Pre&) const {
        const int row0 = u.orow0 + wr * 64 + fr, col0 = u.ocol0 + wc * 32 + 8 * fq;
#pragma unroll
        for (int ai = 0; ai < 2; ++ai)
#pragma unroll
            for (int m = 0; m < 4; ++m) { bf16_t* rowp = O + (size_t)(row0 + ai * HALF + m * 16) * ldc + col0;
#pragma unroll
                for (int bj = 0; bj < 2; ++bj) { const f32x4 v0 = acc[ai][bj][m][0], v1 = acc[ai][bj][m][1];
                    u32x4 w; w.x = cvt_pk_bf16(v0[0], v0[1]); w.y = cvt_pk_bf16(v0[2], v0[3]); w.z = cvt_pk_bf16(v1[0], v1[1]); w.w = cvt_pk_bf16(v1[2], v1[3]);
                    *(u32x4*)(rowp + bj * HALF) = w; } }
    }
};
struct EpiSwiglu {
    static constexpr bool PERM = false; typedef NoPre Pre;
    __device__ __forceinline__ Pre prefetch(const Unit&, LAS unsigned char*, int, int, int) const { return Pre{}; }
    unsigned char* ACT;
    __device__ __forceinline__ void operator()(const f32x4 (&acc)[2][2][4][2], const Unit& u, int wr, int wc, int fr, int fq, const Pre&) const {
        const int row0 = u.orow0 + wr * 64 + fr, pn = u.ocol0 >> 8;
#pragma unroll
        for (int ai = 0; ai < 2; ++ai)
#pragma unroll
            for (int m = 0; m < 4; ++m) { unsigned char* rowp = ACT + (size_t)(row0 + ai * HALF + m * 16) * EH + wc * 16 + 4 * fq;
#pragma unroll
                for (int bj = 0; bj < 2; ++bj) { const f32x4 g = acc[ai][bj][m][0], up = acc[ai][bj][m][1]; float h[4];
#pragma unroll
                    for (int i = 0; i < 4; ++i) h[i] = g[i] / (1.0f + __expf(-g[i])) * up[i];
                    int w = 0; w = __builtin_amdgcn_cvt_pk_fp8_f32(h[0], h[1], w, false); w = __builtin_amdgcn_cvt_pk_fp8_f32(h[2], h[3], w, true);
                    *(GAS unsigned*)(rowp + (pn * 2 + bj) * 64) = (unsigned)w; } }
    }
};
constexpr float Y2_SCALE = 16.0f, Y2_INV = 1.0f / 16.0f;
struct EpiScatter {
    static constexpr bool PERM = true;
    struct Pre { const LAS int* tab; };
    unsigned char* Y2; const int* rowdst;
    __device__ __forceinline__ Pre prefetch(const Unit& u, LAS unsigned char* lds, int wid, int lane, int ui) const {
        LAS unsigned char* tab = lds + STAGE_BYTES + (ui & 1) * 1024;
        if (wid < 4) __builtin_amdgcn_global_load_lds((const unsigned*)(rowdst + u.orow0 + wid * 64 + lane), (LAS unsigned*)(tab + wid * 256), 4, 0, 0);
        Pre p; p.tab = (const LAS int*)tab; return p; }
    __device__ __forceinline__ void operator()(const f32x4 (&acc)[2][2][4][2], const Unit& u, int wr, int wc, int fr, int fq, const Pre& pre) const {
        const int col0 = u.ocol0 + wc * 32 + 8 * fq;
#pragma unroll
        for (int ai = 0; ai < 2; ++ai)
#pragma unroll
            for (int m = 0; m < 4; ++m) { const int dst = pre.tab[wr * 64 + fr + ai * HALF + m * 16];
                if (dst >= 0) { unsigned char* rowp = Y2 + (size_t)dst * DM + col0;
#pragma unroll
                    for (int bj = 0; bj < 2; ++bj) { const f32x4 v0 = acc[ai][bj][m][0] * Y2_SCALE, v1 = acc[ai][bj][m][1] * Y2_SCALE;
                        int w0 = 0, w1 = 0;
                        w0 = __builtin_amdgcn_cvt_pk_fp8_f32(v0[0], v0[1], w0, false); w0 = __builtin_amdgcn_cvt_pk_fp8_f32(v0[2], v0[3], w0, true);
                        w1 = __builtin_amdgcn_cvt_pk_fp8_f32(v1[0], v1[1], w1, false); w1 = __builtin_amdgcn_cvt_pk_fp8_f32(v1[2], v1[3], w1, true);
                        *(GAS u32x2*)(rowp + bj * HALF) = (u32x2){(unsigned)w0, (unsigned)w1}; } } }
    }
};

typedef int v8i __attribute__((ext_vector_type(8)));
typedef int v4i __attribute__((ext_vector_type(4)));
struct Frag { bf16x8 p[2]; __device__ __forceinline__ bf16x8& operator[](int k) { return p[k]; } __device__ __forceinline__ const bf16x8& operator[](int k) const { return p[k]; } };
template <class Epi, class Sched, bool GATHER, bool F8 = false, bool ALIGN_EPI = true, bool SP2 = true>
__device__ __forceinline__ void gemm_phase(const int tid_in, LAS unsigned char* lds, const void* Ag, const void* Bg, const int K, const int* rowidx, const Sched& S, const Epi& E) {
    int tid_ = tid_in; asm volatile("" : "+v"(tid_));
    const int tid = tid_, wid = __builtin_amdgcn_readfirstlane(tid >> 6), lane = tid & 63, wr = wid >> 2, wc = wid & 3, fr = lane & 15, fq = lane >> 4;
    const int KB = F8 ? K : 2 * K;
    const int nt = KB / 128;
    unsigned voffB[2];
#pragma unroll
    for (int i = 0; i < 2; ++i) { int R, C; stage_rc(tid * 16 + i * 8192, R, C); const int Rb = Epi::PERM ? ((R & ~31) + perm32(R & 31)) : R;
        voffB[i] = (unsigned)(Rb * KB + C * 2); }
    const size_t kstep = (size_t)128;
    const size_t hstep = (size_t)HALF * KB;
    const unsigned ldsw = (unsigned)wid * 1024u;
    const int aoff = F8 ? lds_byte(wr * 64 + fr, 16 * fq) : lds_byte(wr * 64 + fr, fq * 8), boff = F8 ? lds_byte(wc * 32 + fr, 16 * fq) : lds_byte(wc * 32 + fr, fq * 8);
    constexpr int PIECE1 = F8 ? 16 : 1024;
    const int sc_w = 0x7A7A7A7A, sc_a = 0x7F7F7F7F;
#define PG8_SA(b, h) (((b) * 2 + (h)) * HTB)
#define PG8_SB(b, h) ((4 + (b) * 2 + (h)) * HTB)
#define PG8_STAGE_B(bufoff, gbase) do { _Pragma("unroll") for (int _i = 0; _i < 2; ++_i) \
        __builtin_amdgcn_global_load_lds((const unsigned*)((const char*)(gbase) + voffB[_i]), (LAS unsigned*)(lds + (bufoff) + ldsw + _i * 8192), 16, 0, 0); } while (0)
#define PG8_STAGE_A(bufoff, gbase, h) do { const char* _gb = (const char*)(gbase) + (GATHER ? (size_t)0 : (size_t)(h) * hstep); \
        __builtin_amdgcn_global_load_lds((const unsigned*)(_gb + ac[GATHER ? (h) : 0][0]), (LAS unsigned*)(lds + (bufoff) + ldsw), 16, 0, 0); \
        __builtin_amdgcn_global_load_lds((const unsigned*)(_gb + ac[GATHER ? (h) : 0][1]), (LAS unsigned*)(lds + (bufoff) + ldsw + 8192), 16, 0, 0); } while (0)
#define PG8_LDA(dst, b, h) do { _Pragma("unroll") for (int m = 0; m < 4; ++m) { if constexpr (F8) { const v4i _l = *(const LAS v4i*)(lds + PG8_SA(b, h) + aoff + m * 2048), _h = *(const LAS v4i*)(lds + PG8_SA(b, h) + aoff + m * 2048 + PIECE1); dst##8[m] = __builtin_shufflevector(_l, _h, 0, 1, 2, 3, 4, 5, 6, 7); } \
        else { dst[m][0] = *(const LAS bf16x8*)(lds + PG8_SA(b, h) + aoff + m * 2048); dst[m][1] = *(const LAS bf16x8*)(lds + PG8_SA(b, h) + aoff + m * 2048 + PIECE1); } } } while (0)
#define PG8_LDB(dst, b, h) do { _Pragma("unroll") for (int n = 0; n < 2; ++n) { if constexpr (F8) { const v4i _l = *(const LAS v4i*)(lds + PG8_SB(b, h) + boff + n * 2048), _h = *(const LAS v4i*)(lds + PG8_SB(b, h) + boff + n * 2048 + PIECE1); dst##8[n] = __builtin_shufflevector(_l, _h, 0, 1, 2, 3, 4, 5, 6, 7); } \
        else { dst[n][0] = *(const LAS bf16x8*)(lds + PG8_SB(b, h) + boff + n * 2048); dst[n][1] = *(const LAS bf16x8*)(lds + PG8_SB(b, h) + boff + n * 2048 + PIECE1); } } } while (0)
#define PG8_MMA(ai, bj, At, Bt) do { __builtin_amdgcn_s_setprio(1); _Pragma("unroll") for (int m = 0; m < 4; ++m) _Pragma("unroll") for (int n = 0; n < 2; ++n) { \
        if constexpr (F8) asm volatile("v_mfma_scale_f32_16x16x128_f8f6f4 %0, %1, %2, %0, %3, %4 op_sel_hi:[0,0,0]" : "+v"(acc[ai][bj][m][n]) : "v"(Bt##8[n]), "v"(At##8[m]), "v"(sc_w), "v"(sc_a)); \
        else { _Pragma("unroll") for (int k = 0; k < 2; ++k) acc[ai][bj][m][n] = __builtin_amdgcn_mfma_f32_16x16x32_bf16(Bt[n][k], At[m][k], acc[ai][bj][m][n], 0, 0, 0); } } \
        __builtin_amdgcn_s_setprio(0); } while (0)
#define PG8_WAIT_V(n) asm volatile("s_waitcnt vmcnt(" #n ")" ::: "memory")
#define PG8_WAIT_L(n) asm volatile("s_waitcnt lgkmcnt(" #n ")" ::: "memory")
#define PG8_BAR __builtin_amdgcn_s_barrier()
#define PG8_SCHED __builtin_amdgcn_sched_barrier(0)
#define PG8_TAB(par) (lds + STAGE_BYTES + 2048 + (par) * 1024)
#define PG8_TABLOAD(par, row0) do { if (wid < 4) __builtin_amdgcn_global_load_lds((const unsigned*)(rowidx + (row0) + wid * 64 + lane), (LAS unsigned*)(PG8_TAB(par) + wid * 256), 4, 0, 0); } while (0)
#define PG8_AOFF_H(h, par) do { int _tz = tid; asm volatile("" : "+v"(_tz)); _Pragma("unroll") for (int _i = 0; _i < 2; ++_i) { int _R, _C; stage_rc(_tz * 16 + _i * 8192, _R, _C); \
        if (GATHER) ac[h][_i] = ((const LAS unsigned*)PG8_TAB(par))[(h) * HALF + _R] * (unsigned)KB + (unsigned)_C * 2u; \
        else ac[h][_i] = (unsigned)(((h) * HALF + _R) * KB) + (unsigned)_C * 2u; } } while (0)
    static_assert(SP2, "only the two-super-phase K-loop is kept");
    Unit cur, nxt; int ui = 0;
    if (!S.next(0, cur)) return;
    f32x4 acc[2][2][4][2];
#pragma unroll
    for (int a = 0; a < 2; ++a)
#pragma unroll
        for (int b = 0; b < 2; ++b)
#pragma unroll
            for (int m = 0; m < 4; ++m)
#pragma unroll
                for (int n = 0; n < 2; ++n) acc[a][b][m][n] = (f32x4){0.f, 0.f, 0.f, 0.f};
    bf16x8 At[F8 ? 1 : 4][2], B0[F8 ? 1 : 2][2], B1[F8 ? 1 : 2][2];
    v8i At8[F8 ? 4 : 1], B08[F8 ? 2 : 1], B18[F8 ? 2 : 1];
    unsigned ac[GATHER ? 2 : 1][2];
    if (GATHER) { PG8_TABLOAD(0, cur.arow0); PG8_WAIT_V(0); PG8_BAR; }
    PG8_AOFF_H(0, 0); if (GATHER) { PG8_AOFF_H((GATHER ? 1 : 0), 0); }
    const char* cA = (const char*)Ag + (GATHER ? (size_t)0 : (size_t)cur.arow0 * KB); const char* cB = (const char*)Bg + (size_t)cur.brow0 * KB;
    PG8_STAGE_B(PG8_SB(0, 0), cB); PG8_STAGE_B(PG8_SB(0, 1), cB + hstep); PG8_STAGE_A(PG8_SA(0, 0), cA, 0); PG8_STAGE_A(PG8_SA(0, 1), cA, 1);
    if (wr == 1) PG8_BAR;
    PG8_WAIT_V(2); PG8_BAR;
    PG8_STAGE_B(PG8_SB(1, 0), cB + kstep); PG8_STAGE_A(PG8_SA(1, 0), cA + kstep, 0); PG8_STAGE_B(PG8_SB(1, 1), cB + hstep + kstep);
    PG8_WAIT_V(6); PG8_BAR;
    for (;;) {
        const typename Epi::Pre pre = E.prefetch(cur, lds, wid, lane, ui);
        const bool has_next = S.next(ui + 1, nxt);
        if (GATHER) { if (has_next) PG8_TABLOAD((ui + 1) & 1, nxt.arow0); }
        const char* nA = has_next ? ((const char*)Ag + (GATHER ? (size_t)0 : (size_t)nxt.arow0 * KB)) : cA; const char* nB = has_next ? (const char*)Bg + (size_t)nxt.brow0 * KB : cB;
_Pragma("nounroll")
        for (int t = 0; t < nt; t += 2) {
            const bool last = (t == nt - 2);
            const char* a1 = cA + (size_t)(t + 1) * kstep;
            const char* a2 = last ? nA : cA + (size_t)(t + 2) * kstep; const char* b2 = last ? nB : cB + (size_t)(t + 2) * kstep;
            const char* a3 = a2 + kstep; const char* b3 = b2 + kstep;
            if (GATHER) { if (last && has_next) { PG8_AOFF_H(0, (ui + 1) & 1); } }
            PG8_LDB(B0, 0, 0); PG8_LDB(B1, 0, 1); PG8_SCHED; PG8_LDA(At, 0, 0); PG8_STAGE_A(PG8_SA(1, 1), a1, 1);
            PG8_WAIT_V(8); PG8_WAIT_L(0); PG8_BAR; PG8_MMA(0, 0, At, B0); PG8_MMA(0, 1, At, B1); PG8_BAR; PG8_SCHED;
            if (GATHER) { if (last && has_next) { PG8_AOFF_H(1, (ui + 1) & 1); } }
            PG8_LDA(At, 0, 1); PG8_STAGE_B(PG8_SB(0, 0), b2); PG8_STAGE_B(PG8_SB(0, 1), b2 + hstep); PG8_STAGE_A(PG8_SA(0, 0), a2, 0);
            PG8_WAIT_V(8); PG8_WAIT_L(0); PG8_BAR; PG8_MMA(1, 0, At, B0); PG8_MMA(1, 1, At, B1); PG8_BAR; PG8_SCHED;
            PG8_LDB(B0, 1, 0); PG8_LDB(B1, 1, 1); PG8_SCHED; PG8_LDA(At, 1, 0); PG8_STAGE_A(PG8_SA(0, 1), a2, 1);
            PG8_WAIT_V(8); PG8_WAIT_L(0); PG8_BAR; PG8_MMA(0, 0, At, B0); PG8_MMA(0, 1, At, B1); PG8_BAR; PG8_SCHED;
            PG8_LDA(At, 1, 1); PG8_STAGE_B(PG8_SB(1, 0), b3); PG8_STAGE_B(PG8_SB(1, 1), b3 + hstep); PG8_STAGE_A(PG8_SA(1, 0), a3, 0);
            PG8_WAIT_V(8); PG8_WAIT_L(0); PG8_BAR; PG8_MMA(1, 0, At, B0); PG8_MMA(1, 1, At, B1); PG8_BAR; PG8_SCHED;
        }
        if constexpr (ALIGN_EPI) { if (wr == 0) PG8_BAR; }
        E(acc, cur, wr, wc, fr, fq, pre);
        if (!has_next) break;
#pragma unroll
        for (int a = 0; a < 2; ++a)
#pragma unroll
            for (int b = 0; b < 2; ++b)
#pragma unroll
                for (int m = 0; m < 4; ++m)
#pragma unroll
                    for (int n = 0; n < 2; ++n) acc[a][b][m][n] = (f32x4){0.f, 0.f, 0.f, 0.f};
        cur = nxt; cA = nA; cB = nB; ++ui;
        if constexpr (ALIGN_EPI) { if (wr == 1) PG8_BAR; }
    }
    PG8_WAIT_V(0);
    if constexpr (!ALIGN_EPI) { if (wr == 0) PG8_BAR; }
    PG8_BAR;
#undef PG8_SA
#undef PG8_SB
#undef PG8_STAGE_A
#undef PG8_STAGE_B
#undef PG8_LDA
#undef PG8_LDB
#undef PG8_MMA
#undef PG8_WAIT_V
#undef PG8_WAIT_L
#undef PG8_BAR
#undef PG8_SCHED
#undef PG8_AOFF_H
#undef PG8_TAB
#undef PG8_TABLOAD
}
}

constexpr int NWAVES = 8, NTHR = 512;
constexpr size_t MiB = 1u << 20;
constexpr size_t WS_CTL = 0, CTL_BYTES = 1 * MiB;
constexpr size_t WS_MOD = 1 * MiB;
constexpr size_t WS_WIN = 3 * MiB;
constexpr size_t WS_WOUT = 29 * MiB;
constexpr size_t WS_WR = 37 * MiB;
constexpr size_t WS_HYF = 39 * MiB;
constexpr size_t WS_HYFC = 71 * MiB;
constexpr size_t WS_XC = 73 * MiB;
constexpr size_t WS_EXP1 = 89 * MiB;
constexpr size_t WS_EXP2 = 218 * MiB;
constexpr size_t WS_XM = 283 * MiB;
constexpr size_t WS_EIDX = 419 * MiB;
constexpr size_t WS_WGT = 422 * MiB;
constexpr size_t WS_RNK = 425 * MiB;
constexpr size_t WS_ROWTOK = 428 * MiB;
constexpr size_t WS_ROWDST = 431 * MiB;
constexpr size_t WS_TILEEXP = 434 * MiB;
constexpr size_t WS_BIG = 435 * MiB;
constexpr size_t WS_U = WS_BIG;
constexpr size_t WS_MIX = 877 * MiB;
constexpr size_t WS_VT = 1013 * MiB;
constexpr size_t WS_HV = 1081 * MiB;
constexpr size_t WS_Z2 = 1183 * MiB;
constexpr size_t WS_GDS = 1217 * MiB;
constexpr size_t WS_GSIN = 1285 * MiB;
constexpr size_t WS_GD = 1319 * MiB;
constexpr size_t WS_Y = 1321 * MiB;
constexpr size_t WS_LOGIT = WS_BIG;
constexpr size_t WS_ACT = WS_BIG;
constexpr size_t WS_Y2 = 758 * MiB;
constexpr size_t WS_XM8 = 1470 * MiB;
constexpr size_t WS_XR = 1600 * MiB;
constexpr size_t WS_END = 1736 * MiB;
constexpr int CW_BAR = 4096;
constexpr int CW_CNT = 16384;
constexpr int CW_NTL = 20480;

constexpr int LDS_BYTES = 147456;
constexpr int MISC_OFF = 143360;

struct Frame {
    LAS unsigned char* lds;
    int tid, lane, wave, G, wg;
    const float* const* in;
    float* out; unsigned char* ws; unsigned* ctl;
};
enum { I_X = 0, I_C, I_CTX, I_CCTX, I_WMOD, I_BMOD, I_WIN, I_RPB, I_WA2, I_BA2, I_GNORM, I_HSW, I_HSB, I_HW1, I_HB1, I_HF1, I_HW2, I_HB2, I_HF2, I_HW3, I_HB3, I_HDEC, I_HSKIP,
       I_WOUT, I_LN1G, I_LN1B, I_RW, I_RB, I_WEG, I_WEU, I_WED, I_WSG, I_WSU, I_WSD, I_LN2G, I_LN2B };

__device__ __forceinline__ int row_b(int row) { return row < NLAT ? (row >> 12) : 16; }
__device__ __forceinline__ const float* mod_ptr(const Frame& F, int l, int row) { return (const float*)(F.ws + WS_MOD) + ((size_t)l * 17 + row_b(row)) * 6144; }

template <class RowFn>
__device__ __forceinline__ void tr_item(const float* W, int ldw, int k0, int n0, bf16_t* dst, int ldd, RowFn rf, LAS float* scr, int lane) {
    float tv[32];
    const GAS float* wp = (const GAS float*)(W + (size_t)(k0 + (lane >> 5)) * ldw + n0 + (lane & 31));
#pragma unroll
    for (int i = 0; i < 32; ++i) tv[i] = wp[(size_t)(2 * i) * ldw];
#pragma unroll
    for (int i = 0; i < 32; ++i) scr[(2 * i + (lane >> 5)) * 33 + (lane & 31)] = tv[i];
    LDS_WAIT(); asm volatile("" ::: "memory");
    const int c = lane & 7;
#pragma unroll
    for (int j = 0; j < 4; ++j) { const int n = (lane >> 3) + 8 * j; const LAS float* s = scr + (8 * c) * 33 + n;
        u32x4 o; o.x = pk2(s[0 * 33], s[1 * 33]); o.y = pk2(s[2 * 33], s[3 * 33]); o.z = pk2(s[4 * 33], s[5 * 33]); o.w = pk2(s[6 * 33], s[7 * 33]);
        *(GAS u32x4*)(dst + (size_t)rf(n0 + n) * ldd + k0 + 8 * c) = o; }
    LDS_WAIT(); asm volatile("" ::: "memory");
}
template <class RowFn>
__device__ __forceinline__ void tr_item8(const float* W, int ldw, int k0, int n0, unsigned char* dst, int ldd, RowFn rf, float scale, LAS float* scr, int lane) {
    float tv[32];
    const GAS float* wp = (const GAS float*)(W + (size_t)(k0 + (lane >> 5)) * ldw + n0 + (lane & 31));
#pragma unroll
    for (int i = 0; i < 32; ++i) tv[i] = wp[(size_t)(2 * i) * ldw];
#pragma unroll
    for (int i = 0; i < 32; ++i) scr[(2 * i + (lane >> 5)) * 33 + (lane & 31)] = tv[i];
    LDS_WAIT(); asm volatile("" ::: "memory");
    const int n = lane >> 1, hf = lane & 1; const LAS float* s = scr + (32 * hf) * 33 + n;
    unsigned w[8];
#pragma unroll
    for (int j = 0; j < 8; ++j) { int v = 0; v = __builtin_amdgcn_cvt_pk_fp8_f32(s[(4 * j) * 33] * scale, s[(4 * j + 1) * 33] * scale, v, false); v = __builtin_amdgcn_cvt_pk_fp8_f32(s[(4 * j + 2) * 33] * scale, s[(4 * j + 3) * 33] * scale, v, true); w[j] = (unsigned)v; }
    unsigned char* d = dst + (size_t)rf(n0 + n) * ldd + k0 + 32 * hf;
    *(GAS u32x4*)d = (u32x4){w[0], w[1], w[2], w[3]}; *(GAS u32x4*)(d + 16) = (u32x4){w[4], w[5], w[6], w[7]};
    LDS_WAIT(); asm volatile("" ::: "memory");
}
struct RowId { __device__ __forceinline__ int operator()(int n) const { return n; } };
struct RowWin { __device__ __forceinline__ int operator()(int n) const { return n >= 2336 ? n - 32 : n; } };
struct RowGU { int up; __device__ __forceinline__ int operator()(int j) const { return (j >> 6) * 128 + ((j & 63) >> 4) * 32 + up * 16 + (j & 15); } };

__device__ __forceinline__ void p0_static_weights(Frame& F) {
    LAS float* scr = (LAS float*)(F.lds + F.wave * 16384);
    const int gw = F.wg * NWAVES + F.wave, NGW = F.G * NWAVES;
    constexpr int I_IN = 16 * 97, I_OUT = 16 * 32, I_R = 16 * 4, PER_L = I_IN + I_OUT + I_R;
    for (int it = gw; it < DEPTH * PER_L; it += NGW) {
        const int l = it / PER_L; int r = it % PER_L;
        if (r < I_IN) { const int kb = r / 97, nb = r % 97; if (nb == 72) continue;
            tr_item(F.in[I_WIN] + (size_t)l * DM * DIN_REF, DIN_REF, kb * 64, nb * 32, (bf16_t*)(F.ws + WS_WIN) + (size_t)l * DIN * DM, DM, RowWin{}, scr, F.lane); continue; }
        r -= I_IN;
        if (r < I_OUT) { const int kb = r / 32, nb = r % 32;
            tr_item(F.in[I_WOUT] + (size_t)l * DM * DM, DM, kb * 64, nb * 32, (bf16_t*)(F.ws + WS_WOUT) + (size_t)l * DM * DM, DM, RowId{}, scr, F.lane); continue; }
        r -= I_OUT;
        { const int kb = r / 4, nb = r % 4;
            tr_item(F.in[I_RW] + (size_t)l * DM * NEXP, NEXP, kb * 64, nb * 32, (bf16_t*)(F.ws + WS_WR) + (size_t)l * 256 * DM, DM, RowId{}, scr, F.lane); }
    }
    const int gt = F.wg * NTHR + F.tid, NGT = F.G * NTHR;
    for (int i = gt; i < DEPTH * 128 * DM / 8; i += NGT) { const int l = i / (128 * DM / 8), r = i % (128 * DM / 8);
        *(u32x4*)((bf16_t*)(F.ws + WS_WR) + ((size_t)l * 256 + 128) * DM + (size_t)r * 8) = (u32x4){0u, 0u, 0u, 0u}; }
    for (int i = gt; i < DEPTH * 256 * DM; i += NGT) {
        const int k = i % DM, n = (i / DM) % 256, l = i / (DM * 256), dir = n >> 7, j = n & 127;
        const float* wi = F.in[I_WIN] + ((size_t)l * DM + k) * DIN_REF + 2304 + dir * 16;
        const float* wa = F.in[I_WA2] + ((size_t)(l * 2 + dir) * 16) * 128 + j;
        float s = 0.f;
#pragma unroll
        for (int r = 0; r < 16; ++r) s += wi[r] * wa[r * 128];
        ((bf16_t*)(F.ws + WS_WIN))[((size_t)l * DIN + 3072 + n) * DM + k] = (bf16_t)f2bf(s);
    }
}
__device__ __forceinline__ void p0_mod(Frame& F) {
    LAS float* sc = (LAS float*)F.lds;
    LAS float* red = (LAS float*)(F.lds + 17 * 1024 * 4);
    for (int i = F.tid; i < 17 * 1024; i += NTHR) { const int r = i >> 10, k = i & 1023; const float v = r < 16 ? F.in[I_C][r * 1024 + k] : F.in[I_CCTX][k]; sc[i] = silu_f(v); }
    __syncthreads();
    const int kq = F.tid >> 7, cl = F.tid & 127;
    for (int u = F.wg; u < DEPTH * 48; u += F.G) {
        const int l = u / 48, col = (u % 48) * 128 + cl;
        const float* w = F.in[I_WMOD] + (size_t)l * DM * 6144 + col;
        float a[17];
#pragma unroll
        for (int r = 0; r < 17; ++r) a[r] = 0.f;
#pragma unroll 4
        for (int k = kq * 256; k < kq * 256 + 256; ++k) { const float wv = w[(size_t)k * 6144];
#pragma unroll
            for (int r = 0; r < 17; ++r) a[r] += sc[r * 1024 + k] * wv; }
#pragma unroll
        for (int r = 0; r < 17; ++r) red[(kq * 17 + r) * 128 + cl] = a[r];
        __syncthreads();
        for (int i = F.tid; i < 17 * 128; i += NTHR) { const int r = i >> 7, c2 = i & 127, cc = (u % 48) * 128 + c2;
            const float s = red[(0 * 17 + r) * 128 + c2] + red[(1 * 17 + r) * 128 + c2] + red[(2 * 17 + r) * 128 + c2] + red[(3 * 17 + r) * 128 + c2] + F.in[I_BMOD][l * 6144 + cc];
            ((float*)(F.ws + WS_MOD))[((size_t)l * 17 + r) * 6144 + cc] = s; }
        __syncthreads();
    }
}
__device__ __forceinline__ void p0_hyena_filters(Frame& F) {
    LAS float* z = (LAS float*)F.lds;
    LAS float* h1 = z + 32 * 33;
    LAS float* h2 = h1 + 32 * 64;
    LAS float* tt = h2 + 32 * 64;
    constexpr int UL = 4096 / 32, UC = 256 / 32, UPL = UL + UC;
    for (int u = F.wg; u < DEPTH * UPL; u += F.G) {
        const int l = u / UPL, r = u % UPL; const bool lat = r < UL; const int L = lat ? 4096 : 256, n0 = (lat ? r : r - UL) * 32;
        __syncthreads();
        for (int i = F.tid; i < 32 * 33; i += NTHR) { const int p = i / 33, e = i % 33, n = n0 + p;
            const float t = (float)n / (float)(L - 1);
            float v;
            if (e == 0) v = t;
            else { const int kb = (e - 1) & 15; const float band = 1e-4f + (float)kb * ((15.0f - 1e-4f) / 15.0f);
                   const float w = 6.283185307179586f * (float)n / (float)L; const float ang = w * band;
                   v = e <= 16 ? __cosf(ang) : -__sinf(ang); }
            z[i] = v; if (e == 0) tt[p] = t; }
        __syncthreads();
        for (int i = F.tid; i < 32 * 64; i += NTHR) { const int p = i >> 6, j = i & 63; float s = F.in[I_HB1][l * 64 + j];
            for (int e = 0; e < 33; ++e) s += z[p * 33 + e] * F.in[I_HW1][((size_t)l * 33 + e) * 64 + j];
            h1[i] = __sinf(F.in[I_HF1][l * 64 + j] * s); }
        __syncthreads();
        for (int i = F.tid; i < 32 * 64; i += NTHR) { const int p = i >> 6, j = i & 63; float s = F.in[I_HB2][l * 64 + j];
            for (int e = 0; e < 64; ++e) s += h1[p * 64 + e] * F.in[I_HW2][((size_t)l * 64 + e) * 64 + j];
            h2[i] = __sinf(F.in[I_HF2][l * 64 + j] * s); }
        __syncthreads();
#pragma unroll 1
        for (int cc = 0; cc < 2; ++cc) {
            const int col = F.tid + cc * 512, o = col >> 9, dir = (col >> 8) & 1, ch = col & 255;
            float a[32];
#pragma unroll
            for (int p = 0; p < 32; ++p) a[p] = 0.f;
            const float* w3 = F.in[I_HW3] + (size_t)l * 64 * 1024 + col;
            for (int k = 0; k < 64; ++k) { const float wv = w3[(size_t)k * 1024];
#pragma unroll
                for (int p = 0; p < 32; ++p) a[p] += h2[p * 64 + k] * wv; }
            const float b3 = F.in[I_HB3][l * 1024 + col], dec = fabsf(F.in[I_HDEC][((size_t)(l * 2 + o) * 2 + dir) * 256 + ch]);
            const float skip = F.in[I_HSKIP][(l * 2 + o) * 256 + ch];
            bf16_t* R = lat ? (bf16_t*)(F.ws + WS_HYF) + ((size_t)(l * 2 + o) * 256 + ch) * 8192 : (bf16_t*)(F.ws + WS_HYFC) + ((size_t)(l * 2 + o) * 256 + ch) * 512;
#pragma unroll
            for (int p = 0; p < 32; ++p) { const int n = n0 + p; float v = (a[p] + b3) * __expf(-tt[p] * dec);
                if (dir == 0) { if (n == 0) v += skip; R[L - n] = (bf16_t)f2bf(v); }
                else { if (n == 0) R[0] = 0; else R[L + n] = (bf16_t)f2bf(v); } }
        }
    }
    __syncthreads();
}
__device__ __forceinline__ void p0_init_rows(Frame& F) {
    const int gw = F.wg * NWAVES + F.wave, NGW = F.G * NWAVES;
    for (int row = gw; row < NROW; row += NGW) {
        const float* src = row < NLAT ? F.in[I_X] + (size_t)row * DM : F.in[I_CTX] + (size_t)(row - NLAT) * DM;
        const float* md = mod_ptr(F, 0, row);
        bf16_t* xr = (bf16_t*)(F.ws + WS_XR) + (size_t)row * DM; bf16_t* xm = (bf16_t*)(F.ws + WS_XM) + (size_t)row * DM;
#pragma unroll
        for (int j = 0; j < 4; ++j) { const int c = 4 * F.lane + 256 * j;
            const f32x4 v = *(const GAS f32x4*)(src + c), sh = *(const GAS f32x4*)(md + c), sc = *(const GAS f32x4*)(md + 1024 + c);
            *(GAS u32x2*)(xr + c) = (u32x2){pk2(v[0], v[1]), pk2(v[2], v[3])};
            u32x2 w; w.x = pk2(v[0] * (1.f + sc[0]) + sh[0], v[1] * (1.f + sc[1]) + sh[1]); w.y = pk2(v[2] * (1.f + sc[2]) + sh[2], v[3] * (1.f + sc[3]) + sh[3]);
            *(GAS u32x2*)(xm + c) = w; }
    }
}
constexpr float WEXP_SCALE = 32.0f;
__device__ __forceinline__ void p_expert_weights(Frame& F, int l) {
    LAS float* scr = (LAS float*)(F.lds + F.wave * 16384);
    const int gw = F.wg * NWAVES + F.wave, NGW = F.G * NWAVES;
    constexpr int I1 = 16 * 8, I2 = 4 * 32, PER_E = 2 * I1 + I2;
    for (int it = gw; it < NE1 * PER_E; it += NGW) {
        const int e = it / PER_E; int r = it % PER_E;
        unsigned char* d1 = (unsigned char*)(F.ws + WS_EXP1) + (size_t)e * 512 * DM; unsigned char* d2 = (unsigned char*)(F.ws + WS_EXP2) + (size_t)e * DM * EH;
        if (r < 2 * I1) { const int up = r >= I1; if (up) r -= I1; const int kb = r / 8, nb = r % 8;
            const float* src = e < NEXP ? F.in[up ? I_WEU : I_WEG] + ((size_t)l * NEXP + e) * DM * EH : F.in[up ? I_WSU : I_WSG] + (size_t)l * DM * EH;
            tr_item8(src, EH, kb * 64, nb * 32, d1, DM, RowGU{up}, WEXP_SCALE, scr, F.lane); }
        else { r -= 2 * I1; const int kb = r / 32, nb = r % 32;
            const float* src = e < NEXP ? F.in[I_WED] + ((size_t)l * NEXP + e) * EH * DM : F.in[I_WSD] + (size_t)l * EH * DM;
            tr_item8(src, DM, kb * 64, nb * 32, d2, EH, RowId{}, WEXP_SCALE, scr, F.lane); }
    }
}

__device__ __forceinline__ f32x4 mfma16(bf16x8 a, bf16x8 b, f32x4 c) { return __builtin_amdgcn_mfma_f32_16x16x32_bf16(a, b, c, 0, 0, 0); }

__device__ __forceinline__ void ph_transposes(Frame& F, int l) {
    LAS bf16_t* tile = (LAS bf16_t*)(F.lds + F.wave * 16384);
    const bf16_t* U = (const bf16_t*)(F.ws + WS_U);
    const int gw = F.wg * NWAVES + F.wave, NGW = F.G * NWAVES;
    const int rsub = F.lane >> 3, cseg = F.lane & 7;
    for (int u = gw; u < 1088 * 20; u += NGW) {
        const int tt = u / 20, blk = u % 20;
        int b, s0, Ls, rowbase, posbase;
        if (tt < 1024) { b = tt >> 6; s0 = (tt & 63) * 64; Ls = SEQ; rowbase = b * SEQ; posbase = 0; }
        else { const int t2 = tt - 1024; b = t2 >> 2; s0 = (t2 & 3) * 64; Ls = CTXL; rowbase = NLAT + b * CTXL; posbase = SEQ; }
        if (blk < 12) {
            const int c0 = blk * 64 + cseg * 8;
            float w0[8], w1[8], w2[8], bb[8];
#pragma unroll
            for (int i = 0; i < 8; ++i) { w0[i] = F.in[I_HSW][(l * 3 + 0) * 768 + c0 + i]; w1[i] = F.in[I_HSW][(l * 3 + 1) * 768 + c0 + i]; w2[i] = F.in[I_HSW][(l * 3 + 2) * 768 + c0 + i]; bb[i] = F.in[I_HSB][l * 768 + c0 + i]; }
#pragma unroll 2
            for (int it = 0; it < 8; ++it) {
                const int sl = rsub + 8 * it, s = s0 + sl;
                const bf16_t* p = U + (size_t)(rowbase + s) * DIN + UHY + c0;
                const u32x4 zc = *(const u32x4*)p;
                u32x4 zm = (u32x4){0u, 0u, 0u, 0u}, zp = (u32x4){0u, 0u, 0u, 0u};
                if (s > 0) zm = *(const u32x4*)(p - DIN);
                if (s < Ls - 1) zp = *(const u32x4*)(p + DIN);
                const unsigned am[4] = {zm.x, zm.y, zm.z, zm.w}, ac[4] = {zc.x, zc.y, zc.z, zc.w}, ap[4] = {zp.x, zp.y, zp.z, zp.w};
#pragma unroll
                for (int i = 0; i < 4; ++i) {
                    const float v0 = bb[2 * i] + w0[2 * i] * bflo(am[i]) + w1[2 * i] * bflo(ac[i]) + w2[2 * i] * bflo(ap[i]);
                    const float v1 = bb[2 * i + 1] + w0[2 * i + 1] * bfhi(am[i]) + w1[2 * i + 1] * bfhi(ac[i]) + w2[2 * i + 1] * bfhi(ap[i]);
                    tile[(cseg * 8 + 2 * i) * 72 + sl] = (bf16_t)f2bf(v0); tile[(cseg * 8 + 2 * i + 1) * 72 + sl] = (bf16_t)f2bf(v1);
                }
            }
        } else {
            const int c0 = (blk - 12) * 64 + cseg * 8;
#pragma unroll 2
            for (int it = 0; it < 8; ++it) {
                const int sl = rsub + 8 * it, s = s0 + sl;
                const u32x4 zc = *(const u32x4*)(U + (size_t)(rowbase + s) * DIN + UV + c0);
                const unsigned ac[4] = {zc.x, zc.y, zc.z, zc.w};
#pragma unroll
                for (int i = 0; i < 4; ++i) { tile[(cseg * 8 + 2 * i) * 72 + sl] = (bf16_t)(ac[i] & 0xffffu); tile[(cseg * 8 + 2 * i + 1) * 72 + sl] = (bf16_t)(ac[i] >> 16); }
            }
        }
        LDS_WAIT(); asm volatile("" ::: "memory");
#pragma unroll 2
        for (int it = 0; it < 8; ++it) {
            const int ch = rsub + 8 * it;
            const u32x4 v = *(const LAS u32x4*)(tile + ch * 72 + cseg * 8);
            bf16_t* dst;
            if (blk < 12) dst = (bf16_t*)(F.ws + WS_HV) + ((size_t)(blk * 64 + ch) * NB + b) * SPB + posbase + s0 + cseg * 8;
            else dst = (bf16_t*)(F.ws + WS_VT) + ((size_t)b * 512 + (blk - 12) * 64 + ch) * SPB + posbase + s0 + cseg * 8;
            *(u32x4*)dst = v;
        }
        LDS_WAIT(); asm volatile("" ::: "memory");
    }
}

constexpr int NA_RPB = 0, NA_KC = 16384, NA_VC = NA_KC + 256 * 144, NA_END = NA_VC + 64 * 528;
__device__ __forceinline__ bf16x8 gld16(const bf16_t* p) { return *(const GAS bf16x8*)p; }
__device__ __forceinline__ u32x2 gld8(const bf16_t* p) { return *(const GAS u32x2*)p; }
__device__ __forceinline__ const char* uni_ptr(const char* p) { const unsigned long long v = (unsigned long long)p; const unsigned lo = __builtin_amdgcn_readfirstlane((unsigned)v), hi = __builtin_amdgcn_readfirstlane((unsigned)(v >> 32)); return (const char*)(((unsigned long long)hi << 32) | lo); }
__device__ __forceinline__ bf16x8 gld16o(const char* ub, unsigned lo) { return *(const GAS bf16x8*)(ub + (size_t)lo); }
__device__ __forceinline__ u32x2 gld8o(const char* ub, unsigned lo) { return *(const GAS u32x2*)(ub + (size_t)lo); }
template <bool WIN>
__device__ __forceinline__ void na_unit(Frame& F, int b, int h, int r, int strip) {
    const bf16_t* U = (const bf16_t*)(F.ws + WS_U);
    const bf16_t* VT = (const bf16_t*)(F.ws + WS_VT) + ((size_t)b * 512 + h * 64) * SPB;
    const LAS float* rpb = (const LAS float*)(F.lds + NA_RPB);
    const LAS bf16_t* KC = (const LAS bf16_t*)(F.lds + NA_KC); const LAS bf16_t* VC = (const LAS bf16_t*)(F.lds + NA_VC);
    int ln_ = F.lane; asm volatile("" : "+v"(ln_));
    const int i = ln_ & 15, g = ln_ >> 4;
    const int qrow0 = WIN ? (b * SEQ + r * 64 + strip * 16) : (NLAT + b * CTXL + strip * 16);
    const int ki = 8 * (i >> 2) + (i & 3);
    const unsigned qlo = (unsigned)((i * DIN + 8 * g) * 2), klo = (unsigned)((ki * DIN + 8 * g) * 2), vlo = (unsigned)((i * SPB + 8 * g) * 2);
    const char* qb = uni_ptr((const char*)(U + (size_t)qrow0 * DIN + UQ + h * 64));
    const bf16x8 q0 = gld16o(qb, qlo), q1 = gld16o(qb + 64, qlo);
    constexpr int NT = WIN ? 32 : 16;
    constexpr int CO = WIN ? 16 : 0;
    f32x4 st[NT];
    int kr0 = 0, u0 = 0;
    if (WIN) { kr0 = r - 4; kr0 = kr0 < 0 ? 0 : (kr0 > 56 ? 56 : kr0); u0 = strip == 0 ? 0 : (strip == 1 ? 8 : (strip == 2 ? 24 : 32)); }
    const char* kbase = uni_ptr((const char*)(U + (size_t)(b * SEQ + kr0 * 64 + u0) * DIN + UK + h * 64));
    const char* vbase = uni_ptr((const char*)(VT + kr0 * 64 + u0));
#define NA_SB() __builtin_amdgcn_sched_barrier(0)
#define NA_KLOAD(buf, grp) do { _Pragma("unroll") for (int t = 0; t < 2; ++t) { const int kt = (grp) * 2 + t; const char* kp = kbase + (size_t)((kt >> 1) * 64 + (kt & 1) * 4) * DIN * 2; buf[t][0] = gld16o(kp, klo); buf[t][1] = gld16o(kp + 64, klo); } } while (0)
#define NA_KMMA(buf, grp) do { _Pragma("unroll") for (int t = 0; t < 2; ++t) { f32x4 a = (f32x4){0.f, 0.f, 0.f, 0.f}; a = mfma16(buf[t][0], q0, a); a = mfma16(buf[t][1], q1, a); st[(grp) * 2 + t] = a; } } while (0)
#define NA_VLOAD(buf, cp) do { _Pragma("unroll") for (int d = 0; d < 4; ++d) { const char* vp = vbase + ((size_t)(d * 16) * SPB + (cp) * 64) * 2; buf[d] = gld16o(vp, vlo); } } while (0)
#define NA_VMMA(buf, cp) do { const int c = (cp); const f32x4 p0 = st[2 * c], p1 = st[2 * c + 1]; \
        u32x4 pw; pw.x = pk2(p0[0], p0[1]); pw.y = pk2(p0[2], p0[3]); pw.z = pk2(p1[0], p1[1]); pw.w = pk2(p1[2], p1[3]); const bf16x8 pf = __builtin_bit_cast(bf16x8, pw); \
        _Pragma("unroll") for (int d = 0; d < 4; ++d) o[d] = mfma16(buf[d], pf, o[d]); } while (0)
    bf16x8 ka[2][2], kb[2][2];
    if (WIN) { NA_KLOAD(ka, 0); NA_KLOAD(kb, 1); NA_SB(); }
#pragma unroll
    for (int cg = 0; cg < 8; ++cg) {
        bf16x8 kc[2][2];
#pragma unroll
        for (int t = 0; t < 2; ++t) { const LAS bf16_t* kp = KC + (cg * 32 + ki + 4 * t) * 72 + 8 * g; kc[t][0] = *(const LAS bf16x8*)kp; kc[t][1] = *(const LAS bf16x8*)(kp + 32); }
#pragma unroll
        for (int t = 0; t < 2; ++t) { f32x4 a = (f32x4){0.f, 0.f, 0.f, 0.f}; a = mfma16(kc[t][0], q0, a); a = mfma16(kc[t][1], q1, a); st[CO + cg * 2 + t] = a; }
        NA_SB();
    }
    bf16x8 va[4], vb[4];
    if (WIN) {
        NA_KMMA(ka, 0); NA_SB(); NA_KLOAD(ka, 2); NA_SB();
        NA_KMMA(kb, 1); NA_SB(); NA_KLOAD(kb, 3); NA_SB();
        NA_KMMA(ka, 2); NA_SB(); NA_KLOAD(ka, 4); NA_SB();
        NA_KMMA(kb, 3); NA_SB(); NA_KLOAD(kb, 5); NA_SB();
        NA_KMMA(ka, 4); NA_SB(); NA_KLOAD(ka, 6); NA_SB();
        NA_KMMA(kb, 5); NA_SB(); NA_KLOAD(kb, 7); NA_SB();
        NA_KMMA(ka, 6); NA_SB(); NA_VLOAD(va, 0); NA_SB();
        NA_KMMA(kb, 7); NA_SB(); NA_VLOAD(vb, 1); NA_SB();
    }
    float mx = -3.0e38f;
    if (WIN) {
        const int c = strip * 16 + i; int kc0 = c - 8; kc0 = kc0 < 0 ? 0 : (kc0 > 48 ? 48 : kc0);
#pragma unroll
        for (int grp = 0; grp < 4; ++grp) {
            float bv[4][4];
#pragma unroll
            for (int t = 0; t < 4; ++t) { const int kt = grp * 4 + t, dr = kr0 + (kt >> 1) - r + 7;
#pragma unroll
                for (int e = 0; e < 4; ++e) { int dc = u0 + 8 * g + (kt & 1) * 4 + e - c + 15; dc = dc < 0 ? 0 : (dc > 30 ? 30 : dc); bv[t][e] = rpb[(h * 15 + dr) * 31 + dc]; } }
#pragma unroll
            for (int t = 0; t < 4; ++t) { const int kt = grp * 4 + t;
#pragma unroll
                for (int e = 0; e < 4; ++e) { const int kc = u0 + 8 * g + (kt & 1) * 4 + e; const bool ok = (kc >= kc0) && (kc < kc0 + 16);
                    const float s = ok ? (st[kt][e] * 0.125f + bv[t][e]) : -3.0e38f; st[kt][e] = s; mx = fmaxf(mx, s); } }
            NA_SB();
        }
    }
#pragma unroll
    for (int ct = 0; ct < 16; ++ct)
#pragma unroll
        for (int e = 0; e < 4; ++e) { const float s = st[CO + ct][e] * 0.125f; st[CO + ct][e] = s; mx = fmaxf(mx, s); }
    mx = fmaxf(mx, shx(mx, 16, ln_)); mx = fmaxf(mx, shx(mx, 32, ln_));
    float sum = 0.f;
#pragma unroll
    for (int t = 0; t < NT; ++t)
#pragma unroll
        for (int e = 0; e < 4; ++e) { const float p = __expf(st[t][e] - mx); st[t][e] = p; sum += p; }
    sum += shx(sum, 16, ln_); sum += shx(sum, 32, ln_);
    const float inv = 1.0f / sum;
    f32x4 o[4];
#pragma unroll
    for (int d = 0; d < 4; ++d) o[d] = (f32x4){0.f, 0.f, 0.f, 0.f};
    NA_SB();
    if (WIN) {
        NA_VMMA(va, 0); NA_SB(); NA_VLOAD(va, 2); NA_SB();
        NA_VMMA(vb, 1); NA_SB(); NA_VLOAD(vb, 3); NA_SB();
        NA_VMMA(va, 2); NA_SB(); NA_VLOAD(va, 4); NA_SB();
        NA_VMMA(vb, 3); NA_SB(); NA_VLOAD(vb, 5); NA_SB();
        NA_VMMA(va, 4); NA_SB(); NA_VLOAD(va, 6); NA_SB();
        NA_VMMA(vb, 5); NA_SB(); NA_VLOAD(vb, 7); NA_SB();
    }
#pragma unroll
    for (int cb = 0; cb < 8; ++cb) {
        bf16x8 vc[4];
#pragma unroll
        for (int d = 0; d < 4; ++d) vc[d] = *(const LAS bf16x8*)(VC + (d * 16 + i) * 264 + cb * 32 + 8 * g);
        { const int c = (WIN ? 8 : 0) + cb; const f32x4 p0 = st[2 * c], p1 = st[2 * c + 1];
            u32x4 pw; pw.x = pk2(p0[0], p0[1]); pw.y = pk2(p0[2], p0[3]); pw.z = pk2(p1[0], p1[1]); pw.w = pk2(p1[2], p1[3]); const bf16x8 pf = __builtin_bit_cast(bf16x8, pw);
#pragma unroll
            for (int d = 0; d < 4; ++d) o[d] = mfma16(vc[d], pf, o[d]); }
        NA_SB();
    }
    if (WIN) { NA_VMMA(va, 6); NA_SB(); NA_VMMA(vb, 7); NA_SB(); }
    char* op = (char*)uni_ptr((const char*)((bf16_t*)(F.ws + WS_MIX) + (size_t)qrow0 * DM + h * 64)); const unsigned olo = (unsigned)((i * DM + 4 * g) * 2);
#pragma unroll
    for (int d = 0; d < 4; ++d) { u32x2 w; w.x = pk2(o[d][0] * inv, o[d][1] * inv); w.y = pk2(o[d][2] * inv, o[d][3] * inv); *(GAS u32x2*)(op + d * 32 + (size_t)olo) = w; }
#undef NA_SB
#undef NA_KLOAD
#undef NA_KMMA
#undef NA_VLOAD
#undef NA_VMMA
}
__device__ __forceinline__ void ph_na(Frame& F, int l, bool last) {
    LAS float* rpb = (LAS float*)(F.lds + NA_RPB);
    __syncthreads();
    for (int i = F.tid; i < 8 * 15 * 31; i += NTHR) rpb[i] = F.in[I_RPB][(size_t)l * 8 * 15 * 31 + i];
    const bf16_t* U = (const bf16_t*)(F.ws + WS_U);
    for (int job = F.wg; job < NB * 8 * 2; job += F.G) {
        const int half = job & 1, h = (job >> 1) & 7, b = job >> 4;
        __syncthreads();
        { int tz_ = F.tid; asm volatile("" : "+v"(tz_)); const int key = tz_ >> 1, hf = tz_ & 1; const bf16_t* src = U + (size_t)(NLAT + b * CTXL + key) * DIN + UK + h * 64 + hf * 32; LAS bf16_t* dst = (LAS bf16_t*)(F.lds + NA_KC) + key * 72 + hf * 32;
#pragma unroll
          for (int j = 0; j < 4; ++j) *(LAS bf16x8*)(dst + j * 8) = gld16(src + j * 8);
          const int dv = tz_ >> 3, seg = tz_ & 7; const bf16_t* vs = (const bf16_t*)(F.ws + WS_VT) + ((size_t)b * 512 + h * 64 + dv) * SPB + SEQ + seg * 32; LAS bf16_t* vd = (LAS bf16_t*)(F.lds + NA_VC) + dv * 264 + seg * 32;
#pragma unroll
          for (int j = 0; j < 4; ++j) *(LAS bf16x8*)(vd + j * 8) = gld16(vs + j * 8); }
        __syncthreads();
        for (int uu = F.wave; uu < 128; uu += NWAVES) na_unit<true>(F, b, h, half * 32 + (uu >> 2), uu & 3);
        if (!last) na_unit<false>(F, b, h, 0, half * 8 + F.wave);
    }
}

__device__ __forceinline__ void ph_hy_transpose(Frame& F, bool last) {
    LAS bf16_t* tile = (LAS bf16_t*)(F.lds + F.wave * 16384);
    const bf16_t* HYO = (const bf16_t*)(F.ws + WS_Y);
    const int gw = F.wg * NWAVES + F.wave, NGW = F.G * NWAVES;
    const int rsub = F.lane >> 3, cseg = F.lane & 7;
    const int ntt = last ? 1024 : 1088;
    for (int u = gw; u < ntt * 4; u += NGW) {
        const int tt = u >> 2, cb = u & 3;
        int b, s0, rowbase, posbase;
        if (tt < 1024) { b = tt >> 6; s0 = (tt & 63) * 64; rowbase = b * SEQ; posbase = 0; }
        else { const int t2 = tt - 1024; b = t2 >> 2; s0 = (t2 & 3) * 64; rowbase = NLAT + b * CTXL; posbase = SEQ; }
#pragma unroll 2
        for (int it = 0; it < 8; ++it) { const int c = rsub + 8 * it;
            const u32x4 v = *(const GAS u32x4*)(HYO + ((size_t)(cb * 64 + c) * NB + b) * SPB + posbase + s0 + cseg * 8); const unsigned a[4] = {v.x, v.y, v.z, v.w};
#pragma unroll
            for (int e = 0; e < 4; ++e) { tile[(cseg * 8 + 2 * e) * 72 + c] = (bf16_t)(a[e] & 0xffffu); tile[(cseg * 8 + 2 * e + 1) * 72 + c] = (bf16_t)(a[e] >> 16); } }
        LDS_WAIT(); asm volatile("" ::: "memory");
#pragma unroll 2
        for (int it = 0; it < 8; ++it) { const int p = rsub + 8 * it;
            const u32x4 v = *(const LAS u32x4*)(tile + p * 72 + cseg * 8);
            *(GAS u32x4*)((bf16_t*)(F.ws + WS_MIX) + (size_t)(rowbase + s0 + p) * DM + 768 + cb * 64 + cseg * 8) = v; }
        LDS_WAIT(); asm volatile("" ::: "memory");
    }
}

constexpr int GL_LAF = 0, GL_LAB = 8448, GL_Q = 16896, GL_K = 25344;
constexpr int GL_QTF = 33792, GL_KTF = 38912, GL_QTB = 44032, GL_KTB = 49152;
constexpr int GL_KDF = 54272, GL_KDB = 58880;
constexpr int GL_VT = 63488, GL_ATT = 72704;
constexpr int GL_SF = 81920, GL_SB = 87040;
constexpr int GL_O = 92160;
constexpr int GL_SEG = 108800;
__device__ __forceinline__ float log_sigmoid_f(float x) { return fminf(x, 0.f) - log1pf(__expf(-fabsf(x))); }
__device__ __forceinline__ f32x4 mma_lds(const LAS bf16_t* A, int lda, const LAS bf16_t* B, int ldb, int ksteps, f32x4 acc, int lane) {
    const int r = lane & 15, g = lane >> 4;
    for (int ks = 0; ks < ksteps; ++ks) { const bf16x8 a = *(const LAS bf16x8*)(A + r * lda + ks * 32 + 8 * g), b = *(const LAS bf16x8*)(B + r * ldb + ks * 32 + 8 * g); acc = mfma16(a, b, acc); }
    return acc;
}
struct GlaRaw { u32x2 wq, wk, wf, wb; u32x4 wv, gw, sin; };
__device__ __forceinline__ int gla_row0(int b, int cn) { return cn >= 4 ? b * SEQ + (cn - 4) * 64 : NLAT + b * CTXL + cn * 64; }
template <bool FULL>
__device__ __forceinline__ GlaRaw gla_load(Frame& F, int u) {
    const int h = u & 3, cn = (u >> 2) % 68, b = (u >> 2) / 68, t = F.tid, i = t >> 3, d4 = (t & 7) * 4, dv8 = (t & 7) * 8;
    const bf16_t* p = (const bf16_t*)(F.ws + WS_U) + (size_t)(gla_row0(b, cn) + i) * DIN;
    GlaRaw r;
    r.wq = *(const GAS u32x2*)(p + UGQ + h * 32 + d4); r.wk = *(const GAS u32x2*)(p + UGK + h * 32 + d4); r.wf = *(const GAS u32x2*)(p + ULAF + h * 32 + d4); r.wb = *(const GAS u32x2*)(p + ULAB + h * 32 + d4);
    r.wv = *(const GAS u32x4*)(p + UGV + h * 64 + dv8);
    if (FULL) { r.gw = *(const GAS u32x4*)(p + UGR + h * 64 + dv8);
        const int dir = t >> 8, dv = (t >> 2) & 63, d8 = (t & 3) * 8; r.sin = *(const GAS u32x4*)((const bf16_t*)(F.ws + WS_GSIN) + (size_t)u * 2 * 2048 + dir * 2048 + dv * 32 + d8); }
    else { r.gw = (u32x4){0u, 0u, 0u, 0u}; r.sin = r.gw; }
    return r;
}
template <bool FULL>
__device__ __forceinline__ void gla_prep(Frame& F, int l, int b, int cn, int h, const GlaRaw& raw) {
    LAS float* LAF = (LAS float*)(F.lds + GL_LAF); LAS float* LAB = (LAS float*)(F.lds + GL_LAB); LAS float* Q = (LAS float*)(F.lds + GL_Q); LAS float* Kk = (LAS float*)(F.lds + GL_K);
    LAS bf16_t* VT = (LAS bf16_t*)(F.lds + GL_VT); LAS float* SEG = (LAS float*)(F.lds + GL_SEG);
    const bool lat = cn >= 4;
    const int t = F.tid;
    { const int i = t >> 3, d4 = (t & 7) * 4;
      const u32x2 wq = raw.wq, wk = raw.wk, wf = raw.wf, wb = raw.wb;
      const float* ba = F.in[I_BA2] + (size_t)l * 256 + h * 32 + d4;
      const float qs = 0.17677669529663687f;
      Q[i * 33 + d4 + 0] = bflo(wq.x) * qs; Q[i * 33 + d4 + 1] = bfhi(wq.x) * qs; Q[i * 33 + d4 + 2] = bflo(wq.y) * qs; Q[i * 33 + d4 + 3] = bfhi(wq.y) * qs;
      Kk[i * 33 + d4 + 0] = bflo(wk.x); Kk[i * 33 + d4 + 1] = bfhi(wk.x); Kk[i * 33 + d4 + 2] = bflo(wk.y); Kk[i * 33 + d4 + 3] = bfhi(wk.y);
      LAF[i * 33 + d4 + 0] = log_sigmoid_f(bflo(wf.x) + ba[0]) * 0.0625f; LAF[i * 33 + d4 + 1] = log_sigmoid_f(bfhi(wf.x) + ba[1]) * 0.0625f;
      LAF[i * 33 + d4 + 2] = log_sigmoid_f(bflo(wf.y) + ba[2]) * 0.0625f; LAF[i * 33 + d4 + 3] = log_sigmoid_f(bfhi(wf.y) + ba[3]) * 0.0625f;
      LAB[i * 33 + d4 + 0] = log_sigmoid_f(bflo(wb.x) + ba[128]) * 0.0625f; LAB[i * 33 + d4 + 1] = log_sigmoid_f(bfhi(wb.x) + ba[129]) * 0.0625f;
      LAB[i * 33 + d4 + 2] = log_sigmoid_f(bflo(wb.y) + ba[130]) * 0.0625f; LAB[i * 33 + d4 + 3] = log_sigmoid_f(bfhi(wb.y) + ba[131]) * 0.0625f;
      const int dv8 = (t & 7) * 8; const u32x4 wv = raw.wv; const unsigned av[4] = {wv.x, wv.y, wv.z, wv.w};
#pragma unroll
      for (int e = 0; e < 4; ++e) { VT[(dv8 + 2 * e) * 72 + i] = (bf16_t)(av[e] & 0xffffu); VT[(dv8 + 2 * e + 1) * 72 + i] = (bf16_t)(av[e] >> 16); }
    }
    __syncthreads();
    if (lat) {
        for (int e = t; e < 64 * 16 * 2; e += NTHR) {
            const int which = e >> 10, i = (e >> 4) & 63, p = e & 15, half = p >> 3, idx = p & 7;
            const float pos = half ? (float)i : (float)(cn - 4);
            const float inv = __expf(-(float)idx * (9.210340371976184f / 8.0f));
            const float sn = __sinf(pos * inv), cs = __cosf(pos * inv);
            LAS float* A = which ? Kk : Q; const int d1 = half * 16 + idx;
            const float x1 = A[i * 33 + d1], x2 = A[i * 33 + d1 + 8];
            A[i * 33 + d1] = x1 * cs - x2 * sn; A[i * 33 + d1 + 8] = x1 * sn + x2 * cs;
        }
    }
    { const int x = t & 63, d = x & 31, dir = x >> 5, seg = t >> 6; LAS float* LA = dir ? LAB : LAF; float run = 0.f;
#pragma unroll
      for (int k = 0; k < 8; ++k) { const int p = seg * 8 + k, i = dir ? 63 - p : p; run += LA[i * 33 + d]; LA[i * 33 + d] = run; }
      SEG[x * 9 + seg] = run;
    }
    __syncthreads();
    { const int x = t & 63, d = x & 31, dir = x >> 5, seg = t >> 6; LAS float* LA = dir ? LAB : LAF; float pre = 0.f;
      for (int s2 = 0; s2 < seg; ++s2) pre += SEG[x * 9 + s2];
#pragma unroll
      for (int k = 0; k < 8; ++k) { const int p = seg * 8 + k, i = dir ? 63 - p : p; LA[i * 33 + d] += pre; }
    }
    __syncthreads();
    LAS bf16_t* QTF = (LAS bf16_t*)(F.lds + GL_QTF); LAS bf16_t* KTF = (LAS bf16_t*)(F.lds + GL_KTF); LAS bf16_t* QTB = (LAS bf16_t*)(F.lds + GL_QTB); LAS bf16_t* KTB = (LAS bf16_t*)(F.lds + GL_KTB);
    LAS bf16_t* KDF = (LAS bf16_t*)(F.lds + GL_KDF); LAS bf16_t* KDB = (LAS bf16_t*)(F.lds + GL_KDB);
    for (int e = t; e < 64 * 32; e += NTHR) {
        const int i = e >> 5, d = e & 31;
        const float bf = LAF[i * 33 + d], bb = LAB[i * 33 + d], bfl = LAF[63 * 33 + d], bbl = LAB[0 * 33 + d], kv = Kk[i * 33 + d];
        KDF[d * 72 + i] = (bf16_t)f2bf(kv * __expf(bfl - bf)); KDB[d * 72 + i] = (bf16_t)f2bf(kv * __expf(bbl - bb));
        if (FULL) { const float qv = Q[i * 33 + d];
            QTF[i * 40 + d] = (bf16_t)f2bf(qv * __expf(bf)); KTF[i * 40 + d] = (bf16_t)f2bf(kv * __expf(-bf));
            QTB[i * 40 + d] = (bf16_t)f2bf(qv * __expf(bb)); KTB[i * 40 + d] = (bf16_t)f2bf(kv * __expf(-bb)); }
    }
    __syncthreads();
}
__device__ __forceinline__ void ph_gla_local(Frame& F, int l) {
    LAS float* LAF = (LAS float*)(F.lds + GL_LAF); LAS float* LAB = (LAS float*)(F.lds + GL_LAB);
    GlaRaw raw = gla_load<false>(F, F.wg < NB * 68 * 4 ? F.wg : 0);
    for (int u = F.wg; u < NB * 68 * 4; u += F.G) {
        const int h = u & 3, cn = (u >> 2) % 68, b = (u >> 2) / 68;
        const GlaRaw nraw = gla_load<false>(F, (u + F.G) < NB * 68 * 4 ? (u + F.G) : u);
        __syncthreads();
        gla_prep<false>(F, l, b, cn, h, raw);
        raw = nraw;
        const int mt = F.wave >> 1, nt = F.wave & 1, g = F.lane >> 4, c = F.lane & 15;
        float* DS = (float*)(F.ws + WS_GDS) + (size_t)u * 2 * 2048;
#pragma unroll
        for (int dir = 0; dir < 2; ++dir) {
            const LAS bf16_t* KD = (const LAS bf16_t*)(F.lds + (dir ? GL_KDB : GL_KDF));
            f32x4 a = (f32x4){0.f, 0.f, 0.f, 0.f};
            a = mma_lds((const LAS bf16_t*)(F.lds + GL_VT) + mt * 16 * 72, 72, KD + nt * 16 * 72, 72, 2, a, F.lane);
#pragma unroll
            for (int e = 0; e < 4; ++e) DS[dir * 2048 + (mt * 16 + 4 * g + e) * 32 + nt * 16 + c] = a[e];
        }
        if (F.tid < 64) { const int d = F.tid & 31, dir = F.tid >> 5; ((float*)(F.ws + WS_GD))[(size_t)u * 64 + F.tid] = __expf(dir ? LAB[0 * 33 + d] : LAF[63 * 33 + d]); }
    }
}
__device__ __forceinline__ void ph_gla_scan(Frame& F) {
    const int gt = F.wg * NTHR + F.tid, NGT = F.G * NTHR;
    const float* DS = (const float*)(F.ws + WS_GDS); const float* GD = (const float*)(F.ws + WS_GD); bf16_t* SIN = (bf16_t*)(F.ws + WS_GSIN);
    for (int w = gt; w < 128 * 1024; w += NGT) {
        const int chain = w >> 10, el = (w & 1023) * 2, dir = chain & 1, h = (chain >> 1) & 3, b = chain >> 3, d = el & 31;
        float s0 = 0.f, s1 = 0.f;
        for (int step = 0; step < 68; ++step) {
            const int cn = dir ? (step < 4 ? 3 - step : 71 - step) : step;
            const size_t u = (size_t)(b * 68 + cn) * 4 + h;
            *(unsigned*)(SIN + (u * 2 + dir) * 2048 + el) = pk2(s0, s1);
            const f32x2 ds = *(const f32x2*)(DS + (u * 2 + dir) * 2048 + el); const f32x2 dd = *(const f32x2*)(GD + u * 64 + dir * 32 + d);
            s0 = dd.x * s0 + ds.x; s1 = dd.y * s1 + ds.y;
        }
    }
}
__device__ __forceinline__ void ph_gla_out(Frame& F, int l, bool last) {
    const bf16_t* U = (const bf16_t*)(F.ws + WS_U);
#define GLA_NEXT(u0) ({ int _u = (u0); while (_u < NB * 68 * 4 && last && ((_u >> 2) % 68) < 4) _u += F.G; _u; })
    int u = GLA_NEXT(F.wg);
    GlaRaw raw = gla_load<true>(F, u < NB * 68 * 4 ? u : 0);
    for (; u < NB * 68 * 4; ) {
        const int h = u & 3, cn = (u >> 2) % 68, b = (u >> 2) / 68;
        const int un = GLA_NEXT(u + F.G);
        const GlaRaw nraw = gla_load<true>(F, un < NB * 68 * 4 ? un : u);
        __syncthreads();
        gla_prep<true>(F, l, b, cn, h, raw);
        const int t = F.tid;
        { const int dir = t >> 8, dv = (t >> 2) & 63, d8 = (t & 3) * 8; *(LAS u32x4*)((LAS bf16_t*)(F.lds + (dir ? GL_SB : GL_SF)) + dv * 40 + d8) = raw.sin; }
        const int g = F.lane >> 4, c = F.lane & 15;
        LAS bf16_t* ATT = (LAS bf16_t*)(F.lds + GL_ATT);
#pragma unroll
        for (int k = 0; k < 2; ++k) { const int tile = F.wave + 8 * k, mt = tile >> 2, nt = tile & 3;
            f32x4 af = (f32x4){0.f, 0.f, 0.f, 0.f}, ab = af;
            af = mma_lds((const LAS bf16_t*)(F.lds + GL_QTF) + mt * 16 * 40, 40, (const LAS bf16_t*)(F.lds + GL_KTF) + nt * 16 * 40, 40, 1, af, F.lane);
            ab = mma_lds((const LAS bf16_t*)(F.lds + GL_QTB) + mt * 16 * 40, 40, (const LAS bf16_t*)(F.lds + GL_KTB) + nt * 16 * 40, 40, 1, ab, F.lane);
#pragma unroll
            for (int e = 0; e < 4; ++e) { const int i = mt * 16 + 4 * g + e, j = nt * 16 + c; const float v = (j <= i ? af[e] : 0.f) + (j >= i ? ab[e] : 0.f); ATT[i * 72 + j] = (bf16_t)f2bf(v); } }
        __syncthreads();
        LAS float* O = (LAS float*)(F.lds + GL_O);
#pragma unroll
        for (int k = 0; k < 2; ++k) { const int tile = F.wave + 8 * k, mt = tile >> 2, nt = tile & 3;
            f32x4 a = (f32x4){0.f, 0.f, 0.f, 0.f};
            a = mma_lds(ATT + mt * 16 * 72, 72, (const LAS bf16_t*)(F.lds + GL_VT) + nt * 16 * 72, 72, 2, a, F.lane);
            a = mma_lds((const LAS bf16_t*)(F.lds + GL_QTF) + mt * 16 * 40, 40, (const LAS bf16_t*)(F.lds + GL_SF) + nt * 16 * 40, 40, 1, a, F.lane);
            a = mma_lds((const LAS bf16_t*)(F.lds + GL_QTB) + mt * 16 * 40, 40, (const LAS bf16_t*)(F.lds + GL_SB) + nt * 16 * 40, 40, 1, a, F.lane);
#pragma unroll
            for (int e = 0; e < 4; ++e) O[(mt * 16 + 4 * g + e) * 65 + nt * 16 + c] = a[e]; }
        __syncthreads();
        { const int i = t >> 3, dv8 = (t & 7) * 8; const bool lat = cn >= 4; const int row = (lat ? b * SEQ + (cn - 4) * 64 : NLAT + b * CTXL + cn * 64) + i;
          float v[8]; float ss = 0.f;
#pragma unroll
          for (int e = 0; e < 8; ++e) { v[e] = O[i * 65 + dv8 + e]; ss += v[e] * v[e]; }
          ss += shx(ss, 1, F.lane); ss += shx(ss, 2, F.lane); ss += shx(ss, 4, F.lane);
          const float rs = 1.0f / sqrtf(ss * (1.0f / 64.0f) + LN_EPS);
          const u32x4 gw = raw.gw; const unsigned ga[4] = {gw.x, gw.y, gw.z, gw.w};
          const float* gn = F.in[I_GNORM] + l * 64 + dv8;
          float o[8];
#pragma unroll
          for (int e = 0; e < 4; ++e) { o[2 * e] = v[2 * e] * rs * gn[2 * e] * silu_f(bflo(ga[e])); o[2 * e + 1] = v[2 * e + 1] * rs * gn[2 * e + 1] * silu_f(bfhi(ga[e])); }
          u32x4 w; w.x = pk2(o[0], o[1]); w.y = pk2(o[2], o[3]); w.z = pk2(o[4], o[5]); w.w = pk2(o[6], o[7]);
          *(GAS u32x4*)((bf16_t*)(F.ws + WS_MIX) + (size_t)row * DM + 512 + h * 64 + dv8) = w; }
        raw = nraw; u = un;
    }
#undef GLA_NEXT
}

template <int L>
__device__ __forceinline__ void hyena_conv(Frame& F, const bf16_t* Rg, const bf16_t* Uin, const bf16_t* Xmul, int pos0, bool final_out, int ch, bf16_t* Zout) {
    constexpr int CS = 2 * L + 16;
    constexpr int NTL = L / 16, J = (NTL >= 64) ? 16 : 2, NGRP = NTL / J, HJ = J / 2, NSTEP = L / 32;
    LAS bf16_t* Rl = (LAS bf16_t*)F.lds;
    __syncthreads();
    for (int c = F.tid; c < 2 * L / 8; c += NTHR) { const u32x4 v = *(const GAS u32x4*)(Rg + 8 * c); const unsigned a[4] = {v.x, v.y, v.z, v.w};
#pragma unroll
        for (int rho = 0; rho < 8; ++rho) { LAS bf16_t* d = Rl + rho * CS + 8 * c + rho;
#pragma unroll
            for (int k = 0; k < 4; ++k) { d[2 * k] = (bf16_t)(a[k] & 0xffffu); d[2 * k + 1] = (bf16_t)(a[k] >> 16); } } }
    __syncthreads();
    int ln_ = F.lane; asm volatile("" : "+v"(ln_));
    const int i = ln_ & 15, g = ln_ >> 4, rho = i & 7;
    const LAS bf16_t* Rc = Rl + rho * CS + rho;
    for (int grp = F.wave; grp < NGRP; grp += NWAVES) {
        f32x4 acc[J]; bf16x8 fr[J];
        const int tb = grp * J * 16;
        const LAS bf16_t* Rb = Rc + (L - tb - i + 8 * g);
#pragma unroll
        for (int j = 0; j < J; ++j) { acc[j] = (f32x4){0.f, 0.f, 0.f, 0.f}; fr[j] = *(const LAS bf16x8*)(Rb - 16 * j); }
        const char* ub = (const char*)(Uin + pos0); const unsigned ulo = (unsigned)((i * SPB + 8 * g) * 2);
        constexpr int PF = (HJ >= 4) ? 4 : 1;
        bf16x8 bq[PF];
#pragma unroll
        for (int p = 0; p < PF; ++p) bq[p] = *(const GAS bf16x8*)(ub + (size_t)(ulo + (unsigned)p * 64u));
#pragma unroll 1
        for (int q = 0; q < NSTEP / HJ; ++q) {
#pragma unroll
            for (int m = 0; m < HJ; ++m) {
                const int n = q * HJ + m;
                const int nn = (n + PF < NSTEP) ? n + PF : 0;
                if (n > 0) { fr[(J - 2 * m) % J] = *(const LAS bf16x8*)(Rb + 32 * n); fr[(J + 1 - 2 * m) % J] = *(const LAS bf16x8*)(Rb + 32 * n - 16); }
                const bf16x8 bcur = bq[m % PF];
#pragma unroll
                for (int jj = 0; jj < J; ++jj) { const int j = (jj + 2) % J; acc[j] = mfma16(fr[(j + J - 2 * m) % J], bcur, acc[j]); }
                bq[m % PF] = *(const GAS bf16x8*)(ub + (size_t)(ulo + (unsigned)nn * 64u));
            }
        }
#pragma unroll
        for (int j = 0; j < J; ++j) { const int t0 = tb + j * 16 + 4 * g;
            const u32x2 xw = *(const GAS u32x2*)(Xmul + (size_t)i * SPB + pos0 + t0);
            const float y0 = acc[j][0] * bflo(xw.x), y1 = acc[j][1] * bfhi(xw.x), y2 = acc[j][2] * bflo(xw.y), y3 = acc[j][3] * bfhi(xw.y);
            if (!final_out) { u32x2 w; w.x = pk2(y0, y1); w.y = pk2(y2, y3); *(GAS u32x2*)(Zout + (size_t)i * SPB + pos0 + t0) = w; }
            else { u32x2 w; w.x = pk2(y0, y1); w.y = pk2(y2, y3); *(GAS u32x2*)((bf16_t*)(F.ws + WS_Y) + ((size_t)ch * NB + i) * SPB + pos0 + t0) = w; } }
    }
}
__device__ __forceinline__ void ph_hyena(Frame& F, int l, bool last) {
    const bf16_t* HV = (const bf16_t*)(F.ws + WS_HV); bf16_t* Z2 = (bf16_t*)(F.ws + WS_Z2);
    for (int ch = F.wg; ch < 256; ch += F.G) {
        const bf16_t* v = HV + (size_t)(0 * 256 + ch) * NB * SPB; const bf16_t* x1 = HV + (size_t)(256 + ch) * NB * SPB; const bf16_t* x2 = HV + (size_t)(512 + ch) * NB * SPB;
        bf16_t* z = Z2 + (size_t)ch * NB * SPB;
        const bf16_t* R0 = (const bf16_t*)(F.ws + WS_HYF) + ((size_t)(l * 2 + 0) * 256 + ch) * 8192; const bf16_t* R1 = (const bf16_t*)(F.ws + WS_HYF) + ((size_t)(l * 2 + 1) * 256 + ch) * 8192;
        hyena_conv<4096>(F, R0, v, x1, 0, false, ch, z);
        VM_WAIT(); __syncthreads(); __builtin_amdgcn_fence(__ATOMIC_ACQUIRE, "agent"); VM_WAIT();
        hyena_conv<4096>(F, R1, z, x2, 0, true, ch, z);
        if (!last) {
            const bf16_t* C0 = (const bf16_t*)(F.ws + WS_HYFC) + ((size_t)(l * 2 + 0) * 256 + ch) * 512; const bf16_t* C1 = (const bf16_t*)(F.ws + WS_HYFC) + ((size_t)(l * 2 + 1) * 256 + ch) * 512;
            hyena_conv<256>(F, C0, v, x1, SEQ, false, ch, z);
            VM_WAIT(); __syncthreads(); __builtin_amdgcn_fence(__ATOMIC_ACQUIRE, "agent"); VM_WAIT();
            hyena_conv<256>(F, C1, z, x2, SEQ, true, ch, z);
        }
    }
}

__device__ __forceinline__ void unpack8(const u32x4 q, float* o) { o[0] = bflo(q.x); o[1] = bfhi(q.x); o[2] = bflo(q.y); o[3] = bfhi(q.y); o[4] = bflo(q.z); o[5] = bfhi(q.z); o[6] = bflo(q.w); o[7] = bfhi(q.w); }
__device__ __forceinline__ void ph_ln1(Frame& F, int l, int ntok) {
    const int gw = F.wg * NWAVES + F.wave, NGW = F.G * NWAVES;
    const float* lg = F.in[I_LN1G] + l * DM + 16 * F.lane; const float* lb = F.in[I_LN1B] + l * DM + 16 * F.lane;
    for (int row = gw; row < ntok; row += NGW) {
        bf16_t* xr = (bf16_t*)(F.ws + WS_XR) + (size_t)row * DM + 16 * F.lane;
        const bf16_t* yr = (const bf16_t*)(F.ws + WS_Y) + (size_t)row * DM + 16 * F.lane;
        const float* md = mod_ptr(F, l, row) + 16 * F.lane;
        bf16_t* xm = (bf16_t*)(F.ws + WS_XM) + (size_t)row * DM + 16 * F.lane;
        const u32x4 xa = *(const GAS u32x4*)xr, xb = *(const GAS u32x4*)(xr + 8), ya = *(const GAS u32x4*)yr, yb = *(const GAS u32x4*)(yr + 8);
        float x[16], y[16], v[16]; unpack8(xa, x); unpack8(xb, x + 8); unpack8(ya, y); unpack8(yb, y + 8);
        float s = 0.f;
#pragma unroll
        for (int j = 0; j < 4; ++j) { const f32x4 g1 = *(const GAS f32x4*)(md + 2048 + 4 * j);
#pragma unroll
            for (int e = 0; e < 4; ++e) { v[4 * j + e] = x[4 * j + e] * DN_ALPHA + g1[e] * y[4 * j + e]; s += v[4 * j + e]; } }
        const float mean = wave_sum(s, F.lane) * (1.f / DM); float s2 = 0.f;
#pragma unroll
        for (int e = 0; e < 16; ++e) { v[e] -= mean; s2 += v[e] * v[e]; }
        const float rstd = 1.f / sqrtf(wave_sum(s2, F.lane) * (1.f / DM) + LN_EPS);
        unsigned wx[8], wm[8]; int w8[4];
#pragma unroll
        for (int j = 0; j < 4; ++j) { const f32x4 g = *(const GAS f32x4*)(lg + 4 * j), bb = *(const GAS f32x4*)(lb + 4 * j), sh = *(const GAS f32x4*)(md + 3072 + 4 * j), sc = *(const GAS f32x4*)(md + 4096 + 4 * j);
            float xn[4];
#pragma unroll
            for (int e = 0; e < 4; ++e) xn[e] = v[4 * j + e] * rstd * g[e] + bb[e];
            wx[2 * j] = pk2(xn[0], xn[1]); wx[2 * j + 1] = pk2(xn[2], xn[3]);
            const float h0 = xn[0] * (1.f + sc[0]) + sh[0], h1 = xn[1] * (1.f + sc[1]) + sh[1], h2 = xn[2] * (1.f + sc[2]) + sh[2], h3 = xn[3] * (1.f + sc[3]) + sh[3];
            wm[2 * j] = pk2(h0, h1); wm[2 * j + 1] = pk2(h2, h3);
            int v = 0; v = __builtin_amdgcn_cvt_pk_fp8_f32(h0, h1, v, false); v = __builtin_amdgcn_cvt_pk_fp8_f32(h2, h3, v, true); w8[j] = v; }
        *(GAS u32x4*)((unsigned char*)(F.ws + WS_XM8) + (size_t)row * DM + 16 * F.lane) = (u32x4){(unsigned)w8[0], (unsigned)w8[1], (unsigned)w8[2], (unsigned)w8[3]};
        *(GAS u32x4*)xr = (u32x4){wx[0], wx[1], wx[2], wx[3]}; *(GAS u32x4*)(xr + 8) = (u32x4){wx[4], wx[5], wx[6], wx[7]};
        *(GAS u32x4*)xm = (u32x4){wm[0], wm[1], wm[2], wm[3]}; *(GAS u32x4*)(xm + 8) = (u32x4){wm[4], wm[5], wm[6], wm[7]};
    }
}
__device__ __forceinline__ void ph_ln2(Frame& F, int l, int ntok, bool last) {
    const int gw = F.wg * NWAVES + F.wave, NGW = F.G * NWAVES;
    const float* lg = F.in[I_LN2G] + l * DM; const float* lb = F.in[I_LN2B] + l * DM;
    for (int row = gw; row < ntok; row += NGW) {
        bf16_t* xr = (bf16_t*)(F.ws + WS_XR) + (size_t)row * DM + 16 * F.lane;
        const unsigned char* y2 = (const unsigned char*)(F.ws + WS_Y2) + (size_t)row * 9 * DM + 16 * F.lane;
        const float* wg = (const float*)(F.ws + WS_WGT) + (size_t)row * 8;
        const float* md = mod_ptr(F, l, row) + 16 * F.lane;
        float ff[16];
#pragma unroll
        for (int e = 0; e < 16; ++e) ff[e] = 0.f;
        u32x4 q[9];
#pragma unroll
        for (int k = 0; k < 9; ++k) q[k] = *(const GAS u32x4*)(y2 + (size_t)k * DM);
#pragma unroll
        for (int k = 0; k < 9; ++k) { const float wk = (k < 8 ? wg[k] : 1.0f) * pg8::Y2_INV; const unsigned a[4] = {q[k].x, q[k].y, q[k].z, q[k].w};
#pragma unroll
            for (int e = 0; e < 4; ++e) { const f32x2 lo = __builtin_amdgcn_cvt_pk_f32_fp8((int)a[e], false), hi = __builtin_amdgcn_cvt_pk_f32_fp8((int)a[e], true);
                ff[4 * e] += wk * lo.x; ff[4 * e + 1] += wk * lo.y; ff[4 * e + 2] += wk * hi.x; ff[4 * e + 3] += wk * hi.y; } }
        float v[16], xo[16]; float s = 0.f;
        { const u32x4 xa = *(const GAS u32x4*)xr, xb = *(const GAS u32x4*)(xr + 8); unpack8(xa, xo); unpack8(xb, xo + 8); }
#pragma unroll
        for (int j = 0; j < 4; ++j) { const f32x4 g2 = *(const GAS f32x4*)(md + 5120 + 4 * j);
#pragma unroll
            for (int e = 0; e < 4; ++e) { v[4 * j + e] = xo[4 * j + e] * DN_ALPHA + g2[e] * ff[4 * j + e]; s += v[4 * j + e]; } }
        const float mean = wave_sum(s, F.lane) * (1.f / DM); float s2 = 0.f;
#pragma unroll
        for (int e = 0; e < 16; ++e) { v[e] -= mean; s2 += v[e] * v[e]; }
        const float rstd = 1.f / sqrtf(wave_sum(s2, F.lane) * (1.f / DM) + LN_EPS);
        const float* mdn = (last ? mod_ptr(F, l, row) : mod_ptr(F, l + 1, row)) + 16 * F.lane;
        bf16_t* xm = (bf16_t*)(F.ws + WS_XM) + (size_t)row * DM + 16 * F.lane;
        float xn[16];
#pragma unroll
        for (int j = 0; j < 4; ++j) { const f32x4 g = *(const GAS f32x4*)(lg + 16 * F.lane + 4 * j), bb = *(const GAS f32x4*)(lb + 16 * F.lane + 4 * j);
#pragma unroll
            for (int e = 0; e < 4; ++e) xn[4 * j + e] = v[4 * j + e] * rstd * g[e] + bb[e]; }
        if (last) { float* op = F.out + (size_t)row * DM + 16 * F.lane;
#pragma unroll
            for (int j = 0; j < 4; ++j) *(GAS f32x4*)(op + 4 * j) = (f32x4){xn[4 * j], xn[4 * j + 1], xn[4 * j + 2], xn[4 * j + 3]}; }
        else { *(GAS u32x4*)xr = (u32x4){pk2(xn[0], xn[1]), pk2(xn[2], xn[3]), pk2(xn[4], xn[5]), pk2(xn[6], xn[7])}; *(GAS u32x4*)(xr + 8) = (u32x4){pk2(xn[8], xn[9]), pk2(xn[10], xn[11]), pk2(xn[12], xn[13]), pk2(xn[14], xn[15])}; }
        if (!last) {
            unsigned w[8];
#pragma unroll
            for (int j = 0; j < 4; ++j) { const f32x4 sh = *(const GAS f32x4*)(mdn + 4 * j), sc = *(const GAS f32x4*)(mdn + 1024 + 4 * j);
                w[2 * j] = pk2(xn[4 * j] * (1.f + sc[0]) + sh[0], xn[4 * j + 1] * (1.f + sc[1]) + sh[1]); w[2 * j + 1] = pk2(xn[4 * j + 2] * (1.f + sc[2]) + sh[2], xn[4 * j + 3] * (1.f + sc[3]) + sh[3]); }
            *(GAS u32x4*)xm = (u32x4){w[0], w[1], w[2], w[3]}; *(GAS u32x4*)(xm + 8) = (u32x4){w[4], w[5], w[6], w[7]};
        }
    }
}

__device__ __forceinline__ unsigned f_ord(float f) { const unsigned u = __builtin_bit_cast(unsigned, f); return (u & 0x80000000u) ? ~u : (u | 0x80000000u); }
__device__ __forceinline__ unsigned long long wave_max_u64(unsigned long long v, int lane) {
#pragma unroll
    for (int o = 1; o < 64; o <<= 1) { const unsigned lo = (unsigned)shxi((int)(unsigned)v, o, lane), hi = (unsigned)shxi((int)(unsigned)(v >> 32), o, lane); const unsigned long long w = ((unsigned long long)hi << 32) | lo; v = w > v ? w : v; }
    return v;
}
__device__ __forceinline__ float seg16_max(float v, int lane) { v = fmaxf(v, shx(v, 1, lane)); v = fmaxf(v, shx(v, 2, lane)); v = fmaxf(v, shx(v, 4, lane)); v = fmaxf(v, shx(v, 8, lane)); return v; }
__device__ __forceinline__ int seg16_min_i(int v, int lane) { int w; w = shxi(v, 1, lane); v = w < v ? w : v; w = shxi(v, 2, lane); v = w < v ? w : v; w = shxi(v, 4, lane); v = w < v ? w : v; w = shxi(v, 8, lane); v = w < v ? w : v; return v; }
__device__ __forceinline__ float seg16_top2(float v, int lane) {
    const float m1 = seg16_max(v, lane);
    const int first = seg16_min_i(v == m1 ? (lane & 15) : 99, lane);
    const float m2 = seg16_max((lane & 15) == first ? -3.0e38f : v, lane);
    return m1 + m2;
}
__device__ __forceinline__ void ph_route(Frame& F, int l, int ntok) {
    LAS int* hist = (LAS int*)F.lds;
    LAS int* base = hist + 128;
    LAS unsigned* alist = (LAS unsigned*)(F.lds + 1024);
    const int tpw = (ntok + F.G - 1) / F.G, t0 = F.wg * tpw, t1 = (t0 + tpw) < ntok ? (t0 + tpw) : ntok;
    __syncthreads();
    if (F.tid < 128) hist[F.tid] = 0;
    __syncthreads();
    const float* LG = (const float*)(F.ws + WS_LOGIT); const float* rb = F.in[I_RB] + l * NEXP;
    const float b0 = rb[F.lane], b1 = rb[F.lane + 64];
    for (int tok = t0 + F.wave; tok < t1; tok += NWAVES) {
        const float x0 = LG[(size_t)tok * 256 + F.lane], x1 = LG[(size_t)tok * 256 + 64 + F.lane];
        const float s0 = 1.0f / (1.0f + __expf(-x0)), s1 = 1.0f / (1.0f + __expf(-x1));
        const float e0 = s0 + b0, e1 = s1 + b1;
        const float gs0 = seg16_top2(e0, F.lane), gs1 = seg16_top2(e1, F.lane);
        float gsc[8];
#pragma unroll
        for (int g = 0; g < 4; ++g) { gsc[g] = shf(gs0, g * 16); gsc[4 + g] = shf(gs1, g * 16); }
        unsigned gmask = 0u;
#pragma unroll
        for (int g = 0; g < 8; ++g) { int cnt = 0;
#pragma unroll
            for (int g2 = 0; g2 < 8; ++g2) cnt += (gsc[g2] > gsc[g] || (gsc[g2] == gsc[g] && g2 < g)) ? 1 : 0;
            gmask |= (cnt < 4) ? (1u << g) : 0u; }
        const bool ok0 = (gmask >> (F.lane >> 4)) & 1u, ok1 = (gmask >> (4 + (F.lane >> 4))) & 1u;
        unsigned long long k0 = ok0 ? (((unsigned long long)f_ord(e0) << 32) | (unsigned)(255 - F.lane)) : 0ull;
        unsigned long long k1 = ok1 ? (((unsigned long long)f_ord(e1) << 32) | (unsigned)(255 - 64 - F.lane)) : 0ull;
        int mye = 0; float myw = 0.f; float wsum = 0.f;
#pragma unroll
        for (int k = 0; k < 8; ++k) {
            const unsigned long long best = wave_max_u64(k0 > k1 ? k0 : k1, F.lane);
            const int e = 255 - (int)(best & 0xffu);
            if (k0 == best) k0 = 0ull; if (k1 == best) k1 = 0ull;
            const float sv = shf(e < 64 ? s0 : s1, e & 63);
            wsum += sv; if (F.lane == k) { mye = e; myw = sv; }
        }
        if (F.lane < 8) {
            const int lr = __hip_atomic_fetch_add(&hist[mye], 1, __ATOMIC_RELAXED, __HIP_MEMORY_SCOPE_WORKGROUP);
            alist[(tok - t0) * 8 + F.lane] = (unsigned)mye | ((unsigned)lr << 8);
            ((int*)(F.ws + WS_EIDX))[(size_t)tok * 8 + F.lane] = mye;
            ((float*)(F.ws + WS_WGT))[(size_t)tok * 8 + F.lane] = myw / wsum * 2.5f;
        }
    }
    __syncthreads();
    if (F.tid < 128) { const int hcount = hist[F.tid]; base[F.tid] = hcount ? (int)atomicAdd(F.ctl + CW_CNT + l * 256 + F.tid, (unsigned)hcount) : 0; }
    __syncthreads();
    for (int a = F.tid; a < (t1 - t0) * 8; a += NTHR) { const unsigned v = alist[a]; ((int*)(F.ws + WS_RNK))[(size_t)t0 * 8 + a] = base[v & 0xffu] + (int)(v >> 8); }
}
__device__ __forceinline__ void ph_positions(Frame& F, int l, int ntok) {
    LAS int* cnt = (LAS int*)F.lds;
    LAS int* off = cnt + 132;
    __syncthreads();
    if (F.tid < NE1) cnt[F.tid] = F.tid < NEXP ? (int)__hip_atomic_load(F.ctl + CW_CNT + l * 256 + F.tid, __ATOMIC_RELAXED, __HIP_MEMORY_SCOPE_AGENT) : ntok;
    __syncthreads();
    if (F.tid == 0) { int o = 0; for (int e = 0; e < NE1; ++e) { off[e] = o; o += (cnt[e] + 255) & ~255; } off[NE1] = o; }
    __syncthreads();
    const int gt = F.wg * NTHR + F.tid, NGT = F.G * NTHR;
    int* rowtok = (int*)(F.ws + WS_ROWTOK); int* rowdst = (int*)(F.ws + WS_ROWDST); int* tile_exp = (int*)(F.ws + WS_TILEEXP);
    const int* eidx = (const int*)(F.ws + WS_EIDX); const int* rnk = (const int*)(F.ws + WS_RNK);
    for (int a = gt; a < ntok * 8; a += NGT) { const int tok = a >> 3, k = a & 7; const int pos = off[eidx[a]] + rnk[a]; rowtok[pos] = tok; rowdst[pos] = tok * 9 + k; }
    for (int tok = gt; tok < ntok; tok += NGT) { const int pos = off[NEXP] + tok; rowtok[pos] = tok; rowdst[pos] = tok * 9 + 8; }
    for (int i = gt; i < NE1 * 256; i += NGT) { const int e = i >> 8, p = i & 255; const int row = off[e] + cnt[e] + p; if (row < off[e + 1]) { rowtok[row] = 0; rowdst[row] = -1; } }
    for (int i = gt; i < NE1 * 320; i += NGT) { const int e = i / 320, p = i % 320; const int t = (off[e] >> 8) + p; if (t < (off[e + 1] >> 8)) tile_exp[t] = e; }
    if (gt == 0) F.ctl[CW_NTL + l] = (unsigned)(off[NE1] >> 8);
}

#ifndef MK_MULTI
#define MK_MULTI 0
#endif
constexpr int PH_PER_LAYER = 12, NPHASE = 2 + DEPTH * PH_PER_LAYER;
struct Args { const float* in[36]; float* out; unsigned char* ws; int ph_lo, ph_hi; };

__global__ void __launch_bounds__(NTHR, 2) mk_fwd(Args args) {
    extern __shared__ __attribute__((aligned(16))) unsigned char lds_raw[];
    Frame F;
    F.lds = (LAS unsigned char*)lds_raw;
    F.tid = threadIdx.x; F.lane = F.tid & 63; F.wave = __builtin_amdgcn_readfirstlane(F.tid >> 6);
    const int wave0 = F.wave;
    F.G = gridDim.x; F.wg = blockIdx.x;
    F.in = args.in;
    F.out = args.out; F.ws = args.ws; F.ctl = (unsigned*)(args.ws + WS_CTL);
    volatile LAS unsigned* MISC = (volatile LAS unsigned*)(F.lds + MISC_OFF);
    if (F.tid < 32) MISC[F.tid] = 0u;
    __syncthreads();
    const int lo = args.ph_lo, hi = args.ph_hi;
    const bool single = (hi - lo) > 1;
    XcdBarrier bar; bar.bar = F.ctl + CW_BAR; bar.x = 0; bar.st = nullptr;
    if (single) bar = xcd_barrier_post(F.ctl + CW_BAR, MISC + 8);
#define IN(k) (lo <= (k) && (k) < hi)
#ifndef PROBE_MASK
#define PROBE_MASK 0
#endif
#define REP(k) for (int _rep = 0; _rep < (((PROBE_MASK >> (k)) & 1) ? 2 : 1); ++_rep)
#define SEAM(k) do { if (IN(k) && IN((k) + 1)) xcd_barrier(bar); } while (0)
#define FRESH() do { int _ln; asm volatile("v_mbcnt_lo_u32_b32 %0, -1, 0\n\tv_mbcnt_hi_u32_b32 %0, -1, %0" : "=v"(_ln)); int _wv = wave0; asm volatile("" : "+s"(_wv)); F.lane = _ln; F.wave = _wv; F.tid = (_wv << 6) | _ln; \
        unsigned char* _w = args.ws; asm volatile("" : "+s"(_w)); F.ws = _w; F.ctl = (unsigned*)(_w + WS_CTL); float* _o = args.out; asm volatile("" : "+s"(_o)); F.out = _o; } while (0)

    if (IN(0)) { FRESH(); p0_static_weights(F); __syncthreads(); p0_mod(F); __syncthreads(); p0_hyena_filters(F); }
    SEAM(0);
    if (IN(1)) { FRESH(); p0_init_rows(F); }
    SEAM(1);
#pragma unroll 1
    for (int l = 0; l < DEPTH; ++l) {
        const int pb = 2 + l * PH_PER_LAYER; const bool last = (l == DEPTH - 1); const int ntok = last ? NLAT : NROW;
        if (IN(pb + 0)) { FRESH();
            REP(0) { p_expert_weights(F, l); __syncthreads(); }
            pg8::DenseOrder S; S.init(NROW, DIN, F.G, F.wg); pg8::EpiBf16 E{(bf16_t*)(F.ws + WS_U), DIN};
            REP(1) pg8::gemm_phase<pg8::EpiBf16, pg8::DenseOrder, false>(F.tid, F.lds, (const bf16_t*)(F.ws + WS_XM), (const bf16_t*)(F.ws + WS_WIN) + (size_t)l * DIN * DM, DM, nullptr, S, E);
        }
        SEAM(pb + 0);
        if (IN(pb + 1)) { FRESH(); REP(2) { ph_transposes(F, l); __syncthreads(); } REP(3) { ph_gla_local(F, l); __syncthreads(); } }
        SEAM(pb + 1);
        if (IN(pb + 2)) { FRESH(); REP(4) { ph_na(F, l, last); } REP(5) { ph_gla_scan(F); } __syncthreads(); REP(6) { ph_hyena(F, l, last); } }
        SEAM(pb + 2);
        if (IN(pb + 3)) { FRESH(); ph_hy_transpose(F, last); __syncthreads(); REP(7) { ph_gla_out(F, l, last); } }
        SEAM(pb + 3);
        if (IN(pb + 4)) { FRESH();
            pg8::DenseOrder S; S.init(ntok, DM, F.G, F.wg); pg8::EpiBf16 E{(bf16_t*)(F.ws + WS_Y), DM};
            REP(8) pg8::gemm_phase<pg8::EpiBf16, pg8::DenseOrder, false>(F.tid, F.lds, (const bf16_t*)(F.ws + WS_MIX), (const bf16_t*)(F.ws + WS_WOUT) + (size_t)l * DM * DM, DM, nullptr, S, E);
        }
        SEAM(pb + 4);
        if (IN(pb + 5)) { FRESH(); ph_ln1(F, l, ntok); }
        SEAM(pb + 5);
        if (IN(pb + 6)) { FRESH();
            pg8::DenseOrder S; S.init(ntok, 256, F.G, F.wg); pg8::EpiF32 E{(float*)(F.ws + WS_LOGIT), 256};
            REP(9) pg8::gemm_phase<pg8::EpiF32, pg8::DenseOrder, false>(F.tid, F.lds, (const bf16_t*)(F.ws + WS_XM), (const bf16_t*)(F.ws + WS_WR) + (size_t)l * 256 * DM, DM, nullptr, S, E);
        }
        SEAM(pb + 6);
        if (IN(pb + 7)) { FRESH(); ph_route(F, l, ntok); }
        SEAM(pb + 7);
        if (IN(pb + 8)) { FRESH(); REP(12) { ph_positions(F, l, ntok); __syncthreads(); } }
        SEAM(pb + 8);
        if (IN(pb + 9)) { FRESH();
            const int ntl = (int)__hip_atomic_load(F.ctl + CW_NTL + l, __ATOMIC_RELAXED, __HIP_MEMORY_SCOPE_AGENT);
            pg8::GroupedOrder S; S.init((const int*)(F.ws + WS_TILEEXP), ntl, 2, F.G, F.wg); pg8::EpiSwiglu E{(unsigned char*)(F.ws + WS_ACT)};
            REP(10) pg8::gemm_phase<pg8::EpiSwiglu, pg8::GroupedOrder, true, true>(F.tid, F.lds, (const void*)(F.ws + WS_XM8), (const void*)(F.ws + WS_EXP1), DM, (const int*)(F.ws + WS_ROWTOK), S, E);
        }
        SEAM(pb + 9);
        if (IN(pb + 10)) { FRESH();
            const int ntl = (int)__hip_atomic_load(F.ctl + CW_NTL + l, __ATOMIC_RELAXED, __HIP_MEMORY_SCOPE_AGENT);
            pg8::GroupedOrder S; S.init((const int*)(F.ws + WS_TILEEXP), ntl, 4, F.G, F.wg); pg8::EpiScatter E{(unsigned char*)(F.ws + WS_Y2), (const int*)(F.ws + WS_ROWDST)};
            REP(11) pg8::gemm_phase<pg8::EpiScatter, pg8::GroupedOrder, false, true>(F.tid, F.lds, (const void*)(F.ws + WS_ACT), (const void*)(F.ws + WS_EXP2), EH, nullptr, S, E);
        }
        SEAM(pb + 10);
        if (IN(pb + 11)) { FRESH(); ph_ln2(F, l, ntok, last); }
        SEAM(pb + 11);
    }
#undef IN
#undef SEAM
#undef FRESH
}

extern "C" void kernel_launch(void* const* d_in, const int* in_sizes, int n_in, void* d_out, int out_size, void* d_ws, size_t ws_size, hipStream_t stream) {
    static int grid = 0;
    if (grid == 0) {
        if (n_in != 36 || out_size != NLAT * DM || ws_size < WS_END) { fprintf(stderr, "kernel_launch: unexpected shapes (n_in %d out %d ws %zu need %zu)\n", n_in, out_size, ws_size, (size_t)WS_END); grid = -1; return; }
        int dev = 0, cus = 0, per_cu = 0;
        if (hipGetDevice(&dev) != hipSuccess || hipDeviceGetAttribute(&cus, hipDeviceAttributeMultiprocessorCount, dev) != hipSuccess) { grid = -1; return; }
        if (hipFuncSetAttribute((const void*)mk_fwd, hipFuncAttributeMaxDynamicSharedMemorySize, LDS_BYTES) != hipSuccess) { fprintf(stderr, "kernel_launch: hipFuncSetAttribute failed\n"); grid = -1; return; }
        if (hipOccupancyMaxActiveBlocksPerMultiprocessor(&per_cu, (const void*)mk_fwd, NTHR, LDS_BYTES) != hipSuccess || per_cu < 1) { fprintf(stderr, "kernel_launch: occupancy query says %d\n", per_cu); }
        (void)hipGetLastError();
        grid = cus;
    }
    if (grid < 0) return;
    (void)hipMemsetAsync((char*)d_ws + WS_CTL, 0, CTL_BYTES, stream);
    Args a{};
    for (int i = 0; i < 36; ++i) a.in[i] = (const float*)d_in[i];
    a.out = (float*)d_out; a.ws = (unsigned char*)d_ws;
#if MK_MULTI
    for (int p = 0; p < NPHASE; ++p) { a.ph_lo = p; a.ph_hi = p + 1; hipLaunchKernelGGL(mk_fwd, dim3(grid), dim3(NTHR), LDS_BYTES, stream, a); }
#else
    a.ph_lo = 0; a.ph_hi = NPHASE; hipLaunchKernelGGL(mk_fwd, dim3(grid), dim3(NTHR), LDS_BYTES, stream, a);
#endif
}
```

```cpp
#include <hip/hip_runtime.h>
#include <cstdio>
#include <cstdint>

#define LAS __attribute__((address_space(3)))
#define GAS __attribute__((address_space(1)))
typedef unsigned short bf16_t;
typedef short bf16x8 __attribute__((ext_vector_type(8)));
typedef float f32x4 __attribute__((ext_vector_type(4)));
typedef float f32x2 __attribute__((ext_vector_type(2)));
typedef unsigned u32x4 __attribute__((ext_vector_type(4)));
typedef unsigned u32x2 __attribute__((ext_vector_type(2)));

constexpr int NB = 16, SEQ = 4096, CTXL = 256, DM = 1024, DEPTH = 4;
constexpr int NLAT = NB * SEQ;
constexpr int NCTX = NB * CTXL;
constexpr int NROW = NLAT + NCTX;
constexpr int SPB = SEQ + CTXL;
constexpr int DIN_REF = 3104;
constexpr int DIN = 3328;
constexpr int UQ = 0, UK = 512, UV = 1024, UGQ = 1536, UGK = 1664, UGV = 1792, UGR = 2048, UHY = 2304, ULAF = 3072, ULAB = 3200;
constexpr int NEXP = 128, TOPK = 8, EH = 256;
constexpr int NE1 = NEXP + 1;
constexpr int RMAX = 659712;
constexpr int TMAX = RMAX / 256;
constexpr float LN_EPS = 1e-6f;
constexpr float DN_ALPHA = 1.6817928305074290f;

__device__ __forceinline__ unsigned f2bf(float f) { unsigned u = __builtin_bit_cast(unsigned, f); return (u + 0x7fffu + ((u >> 16) & 1u)) >> 16; }
typedef __bf16 bf16v2 __attribute__((ext_vector_type(2)));
__device__ __forceinline__ unsigned pk2(float lo, float hi) { const f32x2 v = {lo, hi}; const bf16v2 b = __builtin_convertvector(v, bf16v2); return __builtin_bit_cast(unsigned, b); }
__device__ __forceinline__ float bf2f(unsigned short b) { return __builtin_bit_cast(float, ((unsigned)b) << 16); }
__device__ __forceinline__ float bflo(unsigned w) { return __builtin_bit_cast(float, w << 16); }
__device__ __forceinline__ float bfhi(unsigned w) { return __builtin_bit_cast(float, w & 0xffff0000u); }
__device__ __forceinline__ float shx(float v, int o, int lane) { return __builtin_bit_cast(float, __builtin_amdgcn_ds_bpermute((lane ^ o) << 2, __builtin_bit_cast(int, v))); }
__device__ __forceinline__ int shxi(int v, int o, int lane) { return __builtin_amdgcn_ds_bpermute((lane ^ o) << 2, v); }
__device__ __forceinline__ float shf(float v, int src) { return __builtin_bit_cast(float, __builtin_amdgcn_ds_bpermute(src << 2, __builtin_bit_cast(int, v))); }
__device__ __forceinline__ float wave_sum(float v, int lane) {
#pragma unroll
    for (int o = 1; o < 64; o <<= 1) v += shx(v, o, lane);
    return v;
}
__device__ __forceinline__ void unpack8(const u32x4 q, float* o) { o[0] = bflo(q.x); o[1] = bfhi(q.x); o[2] = bflo(q.y); o[3] = bfhi(q.y); o[4] = bflo(q.z); o[5] = bfhi(q.z); o[6] = bflo(q.w); o[7] = bfhi(q.w); }
__device__ __forceinline__ float silu_f(float x) { return x / (1.0f + __expf(-x)); }
#define LDS_WAIT() asm volatile("s_waitcnt lgkmcnt(0)" ::: "memory")
#define VM_WAIT() asm volatile("s_waitcnt vmcnt(0)" ::: "memory")

#define XB_TMO      128
#define XB_XCNT(j)  (256  + 64 * (j))
#define XB_XSUB(j)  (1280 + 64 * (j))
#define XB_XGEN(j)  (2304 + 64 * (j))
#define XB_TOP      3328
#define XB_TOPGEN   3392
#define XCD_BAR_WORDS 3456
#define XB_SPIN_CAP (1u << 18)

__device__ __forceinline__ unsigned xb_ld(unsigned* p)              { return __hip_atomic_load(p, __ATOMIC_RELAXED, __HIP_MEMORY_SCOPE_AGENT); }
__device__ __forceinline__ unsigned xb_add(unsigned* p, unsigned v) { return __hip_atomic_fetch_add(p, v, __ATOMIC_RELAXED, __HIP_MEMORY_SCOPE_AGENT); }
__device__ __forceinline__ unsigned xb_xcc_id() { return (unsigned)__builtin_amdgcn_s_getreg((3 << 11) | 20) & 0xFu; }
#define XB_SPIN(cond, bar) do { unsigned _sp = 0; while (cond) { __builtin_amdgcn_s_sleep(1); \
    if ((++_sp & 255u) == 0u) { if (xb_ld(&(bar)[XB_TMO])) break; if (_sp > XB_SPIN_CAP) { atomicAdd(&(bar)[XB_TMO], 1u); break; } } } } while (0)

struct XcdBarrier { unsigned* bar; unsigned x; volatile LAS unsigned* st; };

__device__ __forceinline__ XcdBarrier xcd_barrier_post(unsigned* bar, volatile LAS unsigned* st) {
    XcdBarrier b; b.bar = bar; b.x = xb_xcc_id(); b.st = st;
    if (threadIdx.x == 0) (void)xb_add(&bar[XB_XCNT(b.x)], 1u);
    return b;
}
__device__ __forceinline__ void xcd_barrier_complete(unsigned* bar, unsigned x, unsigned& nloc, unsigned& nx) {
    const unsigned G = gridDim.x * gridDim.y * gridDim.z;
    unsigned sum, cnt, mine, sp = 0u;
    for (;;) {
        sum = 0u; cnt = 0u; mine = 0u;
#pragma unroll
        for (unsigned j = 0; j < 16; ++j) { const unsigned c = xb_ld(&bar[XB_XCNT(j)]); sum += c; cnt += (c > 0u) ? 1u : 0u; mine = (j == x) ? c : mine; }
        if (sum == G) break;
        __builtin_amdgcn_s_sleep(1);
        if ((++sp & 255u) == 0u) { if (xb_ld(&bar[XB_TMO])) break; if (sp > XB_SPIN_CAP) { atomicAdd(&bar[XB_TMO], 1u); break; } }
    }
    nloc = mine > 0u ? mine : 1u; nx = cnt > 0u ? cnt : 1u;
}
__device__ __forceinline__ void xcd_barrier(const XcdBarrier& b) {
    asm volatile("s_waitcnt vmcnt(0)" ::: "memory");
    __syncthreads();
    if (threadIdx.x == 0) {
        unsigned* bar = b.bar;
        __builtin_amdgcn_s_waitcnt(0);
        unsigned nloc = b.st[0], nx = b.st[1];
        if (nloc == 0u) { xcd_barrier_complete(bar, b.x, nloc, nx); b.st[0] = nloc; b.st[1] = nx; }
        const unsigned old = xb_add(&bar[XB_XSUB(b.x)], 1u);
        const unsigned gen = old / nloc;
        if (old + 1u == (gen + 1u) * nloc) {
            __builtin_amdgcn_fence(__ATOMIC_RELEASE, "agent");
            asm volatile("s_waitcnt vmcnt(0)" ::: "memory");
            const unsigned og = xb_add(&bar[XB_TOP], 1u);
            const unsigned tg = og / nx;
            if (og + 1u == (tg + 1u) * nx) xb_add(&bar[XB_TOPGEN], 1u);
            else XB_SPIN(xb_ld(&bar[XB_TOPGEN]) == tg, bar);
            __builtin_amdgcn_fence(__ATOMIC_ACQUIRE, "agent");
            xb_add(&bar[XB_XGEN(b.x)], 1u);
            asm volatile("s_waitcnt vmcnt(0)" ::: "memory");
        } else {
            XB_SPIN(xb_ld(&bar[XB_XGEN(b.x)]) == gen, bar);
            __builtin_amdgcn_fence(__ATOMIC_ACQUIRE, "agent");
            asm volatile("s_waitcnt vmcnt(0)" ::: "memory");
        }
    }
    __syncthreads();
}

namespace pg8 {
constexpr int BM = 256, BK = 64, HALF = 128, HTB = HALF * BK * 2, STAGE_BYTES = 8 * HTB, NXCD = 8, WGM = 8;
__host__ __device__ __forceinline__ int lds_byte(int r, int c) { const int st = (r >> 4) * 2 + (c >> 5), rr = r & 15, cc = c & 31, ob = rr * 64 + cc * 2; return st * 1024 + (ob ^ (((ob >> 9) & 1) << 5)); }
__host__ __device__ __forceinline__ void stage_rc(int b, int& R, int& C) { const int st = b / 1024, sb = b % 1024, swz = sb ^ (((sb >> 9) & 1) << 5); R = (st >> 1) * 16 + swz / 64; C = (st & 1) * 32 + (swz % 64) / 2; }
__host__ __device__ __forceinline__ int perm32(int rho) { const int n = rho >> 4, i = rho & 15; return 8 * (i >> 2) + 4 * n + (i & 3); }

struct Unit { int arow0, brow0, orow0, ocol0, aux; };

struct DenseOrder {
    int nM, nN, nwg, G, c;
    __device__ void init(int M, int N, int G_, int c_) { nM = M / BM; nN = N / BM; nwg = nM * nN; G = G_; c = c_; }
    __device__ __forceinline__ bool next(int i, Unit& u) const {
        const long L = (long)i * G + c; if (L >= nwg) return false;
        int wgid = (int)L; { const int q = nwg / NXCD, r = nwg % NXCD, xcd = wgid % NXCD, off = wgid / NXCD; wgid = (xcd < r ? xcd * (q + 1) : r * (q + 1) + (xcd - r) * q) + off; }
        const int nig = WGM * nN, gid = wgid / nig, fm = gid * WGM, gsz = (nM - fm) < WGM ? (nM - fm) : WGM;
        const int pm = fm + ((wgid % nig) % gsz), pn = (wgid % nig) / gsz;
        u.arow0 = pm * BM; u.brow0 = pn * BM; u.orow0 = pm * BM; u.ocol0 = pn * BM; u.aux = 0; return true;
    }
};
struct GroupedOrder {
    const int* tile_exp; int nN, nslot, slot, t0, t1;
    __device__ __forceinline__ void init(const int* te, int ntiles, int nN_, int G, int c) {
        tile_exp = te; nN = nN_;
        if ((G & 7) == 0) { const int per = (ntiles + 7) >> 3, x = c & 7; nslot = G >> 3; slot = c >> 3; t0 = x * per; t1 = (t0 + per) < ntiles ? (t0 + per) : ntiles; }
        else { nslot = G; slot = c; t0 = 0; t1 = ntiles; }
    }
    __device__ __forceinline__ bool next(int i, Unit& u) const {
        const int q = i * nslot + slot, t = t0 + q / nN, pn = q % nN;
        if (t >= t1) return false;
        const int e = tile_exp[t];
        u.arow0 = t * BM; u.brow0 = (e * nN + pn) * BM; u.orow0 = t * BM; u.ocol0 = pn * BM; u.aux = e; return true;
    }
};

__device__ __forceinline__ unsigned cvt_pk_bf16(float lo, float hi) { return pk2(lo, hi); }

struct NoPre {};
struct EpiF32 {
    static constexpr bool PERM = false; typedef NoPre Pre;
    __device__ __forceinline__ Pre prefetch(const Unit&, LAS unsigned char*, int, int, int) const { return Pre{}; }
    float* C; int ldc;
    __device__ __forceinline__ void operator()(const f32x4 (&acc)[2][2][4][2], const Unit& u, int wr, int wc, int fr, int fq, const Pre&) const {
        const int row0 = u.orow0 + wr * 64 + fr, col0 = u.ocol0 + wc * 32 + 4 * fq;
#pragma unroll
        for (int ai = 0; ai < 2; ++ai)
#pragma unroll
            for (int m = 0; m < 4; ++m) { float* rowp = C + (size_t)(row0 + ai * HALF + m * 16) * ldc + col0;
#pragma unroll
                for (int bj = 0; bj < 2; ++bj)
#pragma unroll
                    for (int n = 0; n < 2; ++n) *(f32x4*)(rowp + bj * HALF + n * 16) = acc[ai][bj][m][n]; }
    }
};
struct EpiBf16 {
    static constexpr bool PERM = true; typedef NoPre Pre;
    __device__ __forceinline__ Pre prefetch(const Unit&, LAS unsigned char*, int, int, int) const { return Pre{}; }
    bf16_t* O; int ldc;
    __device__ __forceinline__ void operator()(const f32x4 (&acc)[2][2][4][2], const Unit& u, int wr, int wc, int fr, int fq, const Pre&) const {
        const int row0 = u.orow0 + wr * 64 + fr, col0 = u.ocol0 + wc * 32 + 8 * fq;
#pragma unroll
        for (int ai = 0; ai < 2; ++ai)
#pragma unroll
            for (int m = 0; m < 4; ++m) { bf16_t* rowp = O + (size_t)(row0 + ai * HALF + m * 16) * ldc + col0;
#pragma unroll
                for (int bj = 0; bj < 2; ++bj) { const f32x4 v0 = acc[ai][bj][m][0], v1 = acc[ai][bj][m][1];
                    u32x4 w; w.x = cvt_pk_bf16(v0[0], v0[1]); w.y = cvt_pk_bf16(v0[2], v0[3]); w.z = cvt_pk_bf16(v1[0], v1[1]); w.w = cvt_pk_bf16(v1[2], v1[3]);
                    *(u32x4*)(rowp + bj * HALF) = w; } }
    }
};
struct EpiSwiglu {
    static constexpr bool PERM = false; typedef NoPre Pre;
    __device__ __forceinline__ Pre prefetch(const Unit&, LAS unsigned char*, int, int, int) const { return Pre{}; }
    unsigned char* ACT;
    __device__ __forceinline__ void operator()(const f32x4 (&acc)[2][2][4][2], const Unit& u, int wr, int wc, int fr, int fq, const Pre&) const {
        const int row0 = u.orow0 + wr * 64 + fr, pn = u.ocol0 >> 8;
#pragma unroll
        for (int ai = 0; ai < 2; ++ai)
#pragma unroll
            for (int m = 0; m < 4; ++m) { unsigned char* rowp = ACT + (size_t)(row0 + ai * HALF + m * 16) * EH + wc * 16 + 4 * fq;
#pragma unroll
                for (int bj = 0; bj < 2; ++bj) { const f32x4 g = acc[ai][bj][m][0], up = acc[ai][bj][m][1]; float h[4];
#pragma unroll
                    for (int i = 0; i < 4; ++i) h[i] = g[i] / (1.0f + __expf(-g[i])) * up[i];
                    int w = 0; w = __builtin_amdgcn_cvt_pk_fp8_f32(h[0], h[1], w, false); w = __builtin_amdgcn_cvt_pk_fp8_f32(h[2], h[3], w, true);
                    *(GAS unsigned*)(rowp + (pn * 2 + bj) * 64) = (unsigned)w; } }
    }
};
constexpr float Y2_SCALE = 16.0f, Y2_INV = 1.0f / 16.0f;
struct EpiScatter {
    static constexpr bool PERM = true;
    struct Pre { const LAS int* tab; };
    unsigned char* Y2; const int* rowdst;
    __device__ __forceinline__ Pre prefetch(const Unit& u, LAS unsigned char* lds, int wid, int lane, int ui) const {
        LAS unsigned char* tab = lds + STAGE_BYTES + (ui & 1) * 1024;
        if (wid < 4) __builtin_amdgcn_global_load_lds((const unsigned*)(rowdst + u.orow0 + wid * 64 + lane), (LAS unsigned*)(tab + wid * 256), 4, 0, 0);
        Pre p; p.tab = (const LAS int*)tab; return p; }
    __device__ __forceinline__ void operator()(const f32x4 (&acc)[2][2][4][2], const Unit& u, int wr, int wc, int fr, int fq, const Pre& pre) const {
        const int col0 = u.ocol0 + wc * 32 + 8 * fq;
#pragma unroll
        for (int ai = 0; ai < 2; ++ai)
#pragma unroll
            for (int m = 0; m < 4; ++m) { const int dst = pre.tab[wr * 64 + fr + ai * HALF + m * 16];
                if (dst >= 0) { unsigned char* rowp = Y2 + (size_t)dst * DM + col0;
#pragma unroll
                    for (int bj = 0; bj < 2; ++bj) { const f32x4 v0 = acc[ai][bj][m][0] * Y2_SCALE, v1 = acc[ai][bj][m][1] * Y2_SCALE;
                        int w0 = 0, w1 = 0;
                        w0 = __builtin_amdgcn_cvt_pk_fp8_f32(v0[0], v0[1], w0, false); w0 = __builtin_amdgcn_cvt_pk_fp8_f32(v0[2], v0[3], w0, true);
                        w1 = __builtin_amdgcn_cvt_pk_fp8_f32(v1[0], v1[1], w1, false); w1 = __builtin_amdgcn_cvt_pk_fp8_f32(v1[2], v1[3], w1, true);
                        *(GAS u32x2*)(rowp + bj * HALF) = (u32x2){(unsigned)w0, (unsigned)w1}; } } }
    }
};

typedef int v8i __attribute__((ext_vector_type(8)));
typedef int v4i __attribute__((ext_vector_type(4)));
struct Frag { bf16x8 p[2]; __device__ __forceinline__ bf16x8& operator[](int k) { return p[k]; } __device__ __forceinline__ const bf16x8& operator[](int k) const { return p[k]; } };
template <class Epi, class Sched, bool GATHER, bool F8 = false, bool ALIGN_EPI = true, bool SP2 = true>
__device__ __forceinline__ void gemm_phase(const int tid_in, LAS unsigned char* lds, const void* Ag, const void* Bg, const int K, const int* rowidx, const Sched& S, const Epi& E) {
    int tid_ = tid_in; asm volatile("" : "+v"(tid_));
    const int tid = tid_, wid = __builtin_amdgcn_readfirstlane(tid >> 6), lane = tid & 63, wr = wid >> 2, wc = wid & 3, fr = lane & 15, fq = lane >> 4;
    const int KB = F8 ? K : 2 * K;
    const int nt = KB / 128;
    unsigned voffB[2];
#pragma unroll
    for (int i = 0; i < 2; ++i) { int R, C; stage_rc(tid * 16 + i * 8192, R, C); const int Rb = Epi::PERM ? ((R & ~31) + perm32(R & 31)) : R;
        voffB[i] = (unsigned)(Rb * KB + C * 2); }
    const size_t kstep = (size_t)128;
    const size_t hstep = (size_t)HALF * KB;
    const unsigned ldsw = (unsigned)wid * 1024u;
    const int aoff = F8 ? lds_byte(wr * 64 + fr, 16 * fq) : lds_byte(wr * 64 + fr, fq * 8), boff = F8 ? lds_byte(wc * 32 + fr, 16 * fq) : lds_byte(wc * 32 + fr, fq * 8);
    constexpr int PIECE1 = F8 ? 16 : 1024;
    const int sc_w = 0x7A7A7A7A, sc_a = 0x7F7F7F7F;
#define PG8_SA(b, h) (((b) * 2 + (h)) * HTB)
#define PG8_SB(b, h) ((4 + (b) * 2 + (h)) * HTB)
#define PG8_STAGE_B(bufoff, gbase) do { _Pragma("unroll") for (int _i = 0; _i < 2; ++_i) \
        __builtin_amdgcn_global_load_lds((const unsigned*)((const char*)(gbase) + voffB[_i]), (LAS unsigned*)(lds + (bufoff) + ldsw + _i * 8192), 16, 0, 0); } while (0)
#define PG8_STAGE_A(bufoff, gbase, h) do { const char* _gb = (const char*)(gbase) + (GATHER ? (size_t)0 : (size_t)(h) * hstep); \
        __builtin_amdgcn_global_load_lds((const unsigned*)(_gb + ac[GATHER ? (h) : 0][0]), (LAS unsigned*)(lds + (bufoff) + ldsw), 16, 0, 0); \
        __builtin_amdgcn_global_load_lds((const unsigned*)(_gb + ac[GATHER ? (h) : 0][1]), (LAS unsigned*)(lds + (bufoff) + ldsw + 8192), 16, 0, 0); } while (0)
#define PG8_LDA(dst, b, h) do { _Pragma("unroll") for (int m = 0; m < 4; ++m) { if constexpr (F8) { const v4i _l = *(const LAS v4i*)(lds + PG8_SA(b, h) + aoff + m * 2048), _h = *(const LAS v4i*)(lds + PG8_SA(b, h) + aoff + m * 2048 + PIECE1); dst##8[m] = __builtin_shufflevector(_l, _h, 0, 1, 2, 3, 4, 5, 6, 7); } \
        else { dst[m][0] = *(const LAS bf16x8*)(lds + PG8_SA(b, h) + aoff + m * 2048); dst[m][1] = *(const LAS bf16x8*)(lds + PG8_SA(b, h) + aoff + m * 2048 + PIECE1); } } } while (0)
#define PG8_LDB(dst, b, h) do { _Pragma("unroll") for (int n = 0; n < 2; ++n) { if constexpr (F8) { const v4i _l = *(const LAS v4i*)(lds + PG8_SB(b, h) + boff + n * 2048), _h = *(const LAS v4i*)(lds + PG8_SB(b, h) + boff + n * 2048 + PIECE1); dst##8[n] = __builtin_shufflevector(_l, _h, 0, 1, 2, 3, 4, 5, 6, 7); } \
        else { dst[n][0] = *(const LAS bf16x8*)(lds + PG8_SB(b, h) + boff + n * 2048); dst[n][1] = *(const LAS bf16x8*)(lds + PG8_SB(b, h) + boff + n * 2048 + PIECE1); } } } while (0)
#define PG8_MMA(ai, bj, At, Bt) do { __builtin_amdgcn_s_setprio(1); _Pragma("unroll") for (int m = 0; m < 4; ++m) _Pragma("unroll") for (int n = 0; n < 2; ++n) { \
        if constexpr (F8) asm volatile("v_mfma_scale_f32_16x16x128_f8f6f4 %0, %1, %2, %0, %3, %4 op_sel_hi:[0,0,0]" : "+v"(acc[ai][bj][m][n]) : "v"(Bt##8[n]), "v"(At##8[m]), "v"(sc_w), "v"(sc_a)); \
        else { _Pragma("unroll") for (int k = 0; k < 2; ++k) acc[ai][bj][m][n] = __builtin_amdgcn_mfma_f32_16x16x32_bf16(Bt[n][k], At[m][k], acc[ai][bj][m][n], 0, 0, 0); } } \
        __builtin_amdgcn_s_setprio(0); } while (0)
#define PG8_WAIT_V(n) asm volatile("s_waitcnt vmcnt(" #n ")" ::: "memory")
#define PG8_WAIT_L(n) asm volatile("s_waitcnt lgkmcnt(" #n ")" ::: "memory")
#define PG8_BAR __builtin_amdgcn_s_barrier()
#define PG8_SCHED __builtin_amdgcn_sched_barrier(0)
#define PG8_TAB(par) (lds + STAGE_BYTES + 2048 + (par) * 1024)
#define PG8_TABLOAD(par, row0) do { if (wid < 4) __builtin_amdgcn_global_load_lds((const unsigned*)(rowidx + (row0) + wid * 64 + lane), (LAS unsigned*)(PG8_TAB(par) + wid * 256), 4, 0, 0); } while (0)
#define PG8_AOFF_H(h, par) do { int _tz = tid; asm volatile("" : "+v"(_tz)); _Pragma("unroll") for (int _i = 0; _i < 2; ++_i) { int _R, _C; stage_rc(_tz * 16 + _i * 8192, _R, _C); \
        if (GATHER) ac[h][_i] = ((const LAS unsigned*)PG8_TAB(par))[(h) * HALF + _R] * (unsigned)KB + (unsigned)_C * 2u; \
        else ac[h][_i] = (unsigned)(((h) * HALF + _R) * KB) + (unsigned)_C * 2u; } } while (0)
    static_assert(SP2, "only the two-super-phase K-loop is kept");
    Unit cur, nxt; int ui = 0;
    if (!S.next(0, cur)) return;
    f32x4 acc[2][2][4][2];
#pragma unroll
    for (int a = 0; a < 2; ++a)
#pragma unroll
        for (int b = 0; b < 2; ++b)
#pragma unroll
            for (int m = 0; m < 4; ++m)
#pragma unroll
                for (int n = 0; n < 2; ++n) acc[a][b][m][n] = (f32x4){0.f, 0.f, 0.f, 0.f};
    bf16x8 At[F8 ? 1 : 4][2], B0[F8 ? 1 : 2][2], B1[F8 ? 1 : 2][2];
    v8i At8[F8 ? 4 : 1], B08[F8 ? 2 : 1], B18[F8 ? 2 : 1];
    unsigned ac[GATHER ? 2 : 1][2];
    if (GATHER) { PG8_TABLOAD(0, cur.arow0); PG8_WAIT_V(0); PG8_BAR; }
    PG8_AOFF_H(0, 0); if (GATHER) { PG8_AOFF_H((GATHER ? 1 : 0), 0); }
    const char* cA = (const char*)Ag + (GATHER ? (size_t)0 : (size_t)cur.arow0 * KB); const char* cB = (const char*)Bg + (size_t)cur.brow0 * KB;
    PG8_STAGE_B(PG8_SB(0, 0), cB); PG8_STAGE_B(PG8_SB(0, 1), cB + hstep); PG8_STAGE_A(PG8_SA(0, 0), cA, 0); PG8_STAGE_A(PG8_SA(0, 1), cA, 1);
    if (wr == 1) PG8_BAR;
    PG8_WAIT_V(2); PG8_BAR;
    PG8_STAGE_B(PG8_SB(1, 0), cB + kstep); PG8_STAGE_A(PG8_SA(1, 0), cA + kstep, 0); PG8_STAGE_B(PG8_SB(1, 1), cB + hstep + kstep);
    PG8_WAIT_V(6); PG8_BAR;
    for (;;) {
        const typename Epi::Pre pre = E.prefetch(cur, lds, wid, lane, ui);
        const bool has_next = S.next(ui + 1, nxt);
        if (GATHER) { if (has_next) PG8_TABLOAD((ui + 1) & 1, nxt.arow0); }
        const char* nA = has_next ? ((const char*)Ag + (GATHER ? (size_t)0 : (size_t)nxt.arow0 * KB)) : cA; const char* nB = has_next ? (const char*)Bg + (size_t)nxt.brow0 * KB : cB;
_Pragma("nounroll")
        for (int t = 0; t < nt; t += 2) {
            const bool last = (t == nt - 2);
            const char* a1 = cA + (size_t)(t + 1) * kstep;
            const char* a2 = last ? nA : cA + (size_t)(t + 2) * kstep; const char* b2 = last ? nB : cB + (size_t)(t + 2) * kstep;
            const char* a3 = a2 + kstep; const char* b3 = b2 + kstep;
            if (GATHER) { if (last && has_next) { PG8_AOFF_H(0, (ui + 1) & 1); } }
            PG8_LDB(B0, 0, 0); PG8_LDB(B1, 0, 1); PG8_SCHED; PG8_LDA(At, 0, 0); PG8_STAGE_A(PG8_SA(1, 1), a1, 1);
            PG8_WAIT_V(8); PG8_WAIT_L(0); PG8_BAR; PG8_MMA(0, 0, At, B0); PG8_MMA(0, 1, At, B1); PG8_BAR; PG8_SCHED;
            if (GATHER) { if (last && has_next) { PG8_AOFF_H(1, (ui + 1) & 1); } }
            PG8_LDA(At, 0, 1); PG8_STAGE_B(PG8_SB(0, 0), b2); PG8_STAGE_B(PG8_SB(0, 1), b2 + hstep); PG8_STAGE_A(PG8_SA(0, 0), a2, 0);
            PG8_WAIT_V(8); PG8_WAIT_L(0); PG8_BAR; PG8_MMA(1, 0, At, B0); PG8_MMA(1, 1, At, B1); PG8_BAR; PG8_SCHED;
            PG8_LDB(B0, 1, 0); PG8_LDB(B1, 1, 1); PG8_SCHED; PG8_LDA(At, 1, 0); PG8_STAGE_A(PG8_SA(0, 1), a2, 1);
            PG8_WAIT_V(8); PG8_WAIT_L(0); PG8_BAR; PG8_MMA(0, 0, At, B0); PG8_MMA(0, 1, At, B1); PG8_BAR; PG8_SCHED;
            PG8_LDA(At, 1, 1); PG8_STAGE_B(PG8_SB(1, 0), b3); PG8_STAGE_B(PG8_SB(1, 1), b3 + hstep); PG8_STAGE_A(PG8_SA(1, 0), a3, 0);
            PG8_WAIT_V(8); PG8_WAIT_L(0); PG8_BAR; PG8_MMA(1, 0, At, B0); PG8_MMA(1, 1, At, B1); PG8_BAR; PG8_SCHED;
        }
        if constexpr (ALIGN_EPI) { if (wr == 0) PG8_BAR; }
        E(acc, cur, wr, wc, fr, fq, pre);
        if (!has_next) break;
#pragma unroll
        for (int a = 0; a < 2; ++a)
#pragma unroll
            for (int b = 0; b < 2; ++b)
#pragma unroll
                for (int m = 0; m < 4; ++m)
#pragma unroll
                    for (int n = 0; n < 2; ++n) acc[a][b][m][n] = (f32x4){0.f, 0.f, 0.f, 0.f};
        cur = nxt; cA = nA; cB = nB; ++ui;
        if constexpr (ALIGN_EPI) { if (wr == 1) PG8_BAR; }
    }
    PG8_WAIT_V(0);
    if constexpr (!ALIGN_EPI) { if (wr == 0) PG8_BAR; }
    PG8_BAR;
#undef PG8_SA
#undef PG8_SB
#undef PG8_STAGE_A
#undef PG8_STAGE_B
#undef PG8_LDA
#undef PG8_LDB
#undef PG8_MMA
#undef PG8_WAIT_V
#undef PG8_WAIT_L
#undef PG8_BAR
#undef PG8_SCHED
#undef PG8_AOFF_H
#undef PG8_TAB
#undef PG8_TABLOAD
}
}

constexpr int NWAVES = 8, NTHR = 512;
constexpr size_t MiB = 1u << 20;
constexpr size_t WS_CTL = 0, CTL_BYTES = 1 * MiB;
constexpr size_t WS_MOD = 1 * MiB;
constexpr size_t WS_WIN = 3 * MiB;
constexpr size_t WS_WOUT = 29 * MiB;
constexpr size_t WS_WR = 37 * MiB;
constexpr size_t WS_HYF = 39 * MiB;
constexpr size_t WS_HYFC = 71 * MiB;
constexpr size_t WS_XC = 73 * MiB;
constexpr size_t WS_EXP1 = 89 * MiB;
constexpr size_t WS_EXP2 = 218 * MiB;
constexpr size_t WS_XM = 283 * MiB;
constexpr size_t WS_EIDX = 419 * MiB;
constexpr size_t WS_WGT = 422 * MiB;
constexpr size_t WS_RNK = 425 * MiB;
constexpr size_t WS_ROWTOK = 428 * MiB;
constexpr size_t WS_ROWDST = 431 * MiB;
constexpr size_t WS_TILEEXP = 434 * MiB;
constexpr size_t WS_BIG = 435 * MiB;
constexpr size_t WS_U = WS_BIG;
constexpr size_t WS_MIX = 877 * MiB;
constexpr size_t WS_VT = 1013 * MiB;
constexpr size_t WS_HV = 1081 * MiB;
constexpr size_t WS_Z2 = 1183 * MiB;
constexpr size_t WS_GDS = 1217 * MiB;
constexpr size_t WS_GSIN = 1285 * MiB;
constexpr size_t WS_GD = 1319 * MiB;
constexpr size_t WS_Y = 1321 * MiB;
constexpr size_t WS_LOGIT = WS_BIG;
constexpr size_t WS_ACT = WS_BIG;
constexpr size_t WS_Y2 = 758 * MiB;
constexpr size_t WS_XM8 = 1470 * MiB;
constexpr size_t WS_XR = 1600 * MiB;
constexpr size_t WS_END = 1736 * MiB;
constexpr int CW_BAR = 4096;
constexpr int CW_CNT = 16384;
constexpr int CW_NTL = 20480;

constexpr int LDS_BYTES = 147456;
constexpr int MISC_OFF = 143360;

struct Frame {
    LAS unsigned char* lds;
    int tid, lane, wave, G, wg;
    const float* const* in;
    float* out; unsigned char* ws; unsigned* ctl;
};
enum { I_X = 0, I_C, I_CTX, I_CCTX, I_WMOD, I_BMOD, I_WIN, I_RPB, I_WA2, I_BA2, I_GNORM, I_HSW, I_HSB, I_HW1, I_HB1, I_HF1, I_HW2, I_HB2, I_HF2, I_HW3, I_HB3, I_HDEC, I_HSKIP,
       I_WOUT, I_LN1G, I_LN1B, I_RW, I_RB, I_WEG, I_WEU, I_WED, I_WSG, I_WSU, I_WSD, I_LN2G, I_LN2B };

__device__ __forceinline__ int row_b(int row) { return row < NLAT ? (row >> 12) : 16; }
__device__ __forceinline__ const float* mod_ptr(const Frame& F, int l, int row) { return (const float*)(F.ws + WS_MOD) + ((size_t)l * 17 + row_b(row)) * 6144; }

template <class RowFn>
__device__ __forceinline__ void tr_item(const float* W, int ldw, int k0, int n0, bf16_t* dst, int ldd, RowFn rf, LAS float* scr, int lane) {
    float tv[32];
    const GAS float* wp = (const GAS float*)(W + (size_t)(k0 + (lane >> 5)) * ldw + n0 + (lane & 31));
#pragma unroll
    for (int i = 0; i < 32; ++i) tv[i] = wp[(size_t)(2 * i) * ldw];
#pragma unroll
    for (int i = 0; i < 32; ++i) scr[(2 * i + (lane >> 5)) * 33 + (lane & 31)] = tv[i];
    LDS_WAIT(); asm volatile("" ::: "memory");
    const int c = lane & 7;
#pragma unroll
    for (int j = 0; j < 4; ++j) { const int n = (lane >> 3) + 8 * j; const LAS float* s = scr + (8 * c) * 33 + n;
        u32x4 o; o.x = pk2(s[0 * 33], s[1 * 33]); o.y = pk2(s[2 * 33], s[3 * 33]); o.z = pk2(s[4 * 33], s[5 * 33]); o.w = pk2(s[6 * 33], s[7 * 33]);
        *(GAS u32x4*)(dst + (size_t)rf(n0 + n) * ldd + k0 + 8 * c) = o; }
    LDS_WAIT(); asm volatile("" ::: "memory");
}
template <class RowFn>
__device__ __forceinline__ void tr_item8(const float* W, int ldw, int k0, int n0, unsigned char* dst, int ldd, RowFn rf, float scale, LAS float* scr, int lane) {
    float tv[32];
    const GAS float* wp = (const GAS float*)(W + (size_t)(k0 + (lane >> 5)) * ldw + n0 + (lane & 31));
#pragma unroll
    for (int i = 0; i < 32; ++i) tv[i] = wp[(size_t)(2 * i) * ldw];
#pragma unroll
    for (int i = 0; i < 32; ++i) scr[(2 * i + (lane >> 5)) * 33 + (lane & 31)] = tv[i];
    LDS_WAIT(); asm volatile("" ::: "memory");
    const int n = lane >> 1, hf = lane & 1; const LAS float* s = scr + (32 * hf) * 33 + n;
    unsigned w[8];
#pragma unroll
    for (int j = 0; j < 8; ++j) { int v = 0; v = __builtin_amdgcn_cvt_pk_fp8_f32(s[(4 * j) * 33] * scale, s[(4 * j + 1) * 33] * scale, v, false); v = __builtin_amdgcn_cvt_pk_fp8_f32(s[(4 * j + 2) * 33] * scale, s[(4 * j + 3) * 33] * scale, v, true); w[j] = (unsigned)v; }
    unsigned char* d = dst + (size_t)rf(n0 + n) * ldd + k0 + 32 * hf;
    *(GAS u32x4*)d = (u32x4){w[0], w[1], w[2], w[3]}; *(GAS u32x4*)(d + 16) = (u32x4){w[4], w[5], w[6], w[7]};
    LDS_WAIT(); asm volatile("" ::: "memory");
}
struct RowId { __device__ __forceinline__ int operator()(int n) const { return n; } };
struct RowWin { __device__ __forceinline__ int operator()(int n) const { return n >= 2336 ? n - 32 : n; } };
struct RowGU { int up; __device__ __forceinline__ int operator()(int j) const { return (j >> 6) * 128 + ((j & 63) >> 4) * 32 + up * 16 + (j & 15); } };

__device__ __forceinline__ void p0_static_weights(Frame& F) {
    LAS float* scr = (LAS float*)(F.lds + F.wave * 16384);
    const int gw = F.wg * NWAVES + F.wave, NGW = F.G * NWAVES;
    constexpr int I_IN = 16 * 97, I_OUT = 16 * 32, I_R = 16 * 4, PER_L = I_IN + I_OUT + I_R;
    for (int it = gw; it < DEPTH * PER_L; it += NGW) {
        const int l = it / PER_L; int r = it % PER_L;
        if (r < I_IN) { const int kb = r / 97, nb = r % 97; if (nb == 72) continue;
            tr_item(F.in[I_WIN] + (size_t)l * DM * DIN_REF, DIN_REF, kb * 64, nb * 32, (bf16_t*)(F.ws + WS_WIN) + (size_t)l * DIN * DM, DM, RowWin{}, scr, F.lane); continue; }
        r -= I_IN;
        if (r < I_OUT) { const int kb = r / 32, nb = r % 32;
            tr_item(F.in[I_WOUT] + (size_t)l * DM * DM, DM, kb * 64, nb * 32, (bf16_t*)(F.ws + WS_WOUT) + (size_t)l * DM * DM, DM, RowId{}, scr, F.lane); continue; }
        r -= I_OUT;
        { const int kb = r / 4, nb = r % 4;
            tr_item(F.in[I_RW] + (size_t)l * DM * NEXP, NEXP, kb * 64, nb * 32, (bf16_t*)(F.ws + WS_WR) + (size_t)l * 256 * DM, DM, RowId{}, scr, F.lane); }
    }
    const int gt = F.wg * NTHR + F.tid, NGT = F.G * NTHR;
    for (int i = gt; i < DEPTH * 128 * DM / 8; i += NGT) { const int l = i / (128 * DM / 8), r = i % (128 * DM / 8);
        *(u32x4*)((bf16_t*)(F.ws + WS_WR) + ((size_t)l * 256 + 128) * DM + (size_t)r * 8) = (u32x4){0u, 0u, 0u, 0u}; }
    for (int i = gt; i < DEPTH * 256 * DM; i += NGT) {
        const int k = i % DM, n = (i / DM) % 256, l = i / (DM * 256), dir = n >> 7, j = n & 127;
        const float* wi = F.in[I_WIN] + ((size_t)l * DM + k) * DIN_REF + 2304 + dir * 16;
        const float* wa = F.in[I_WA2] + ((size_t)(l * 2 + dir) * 16) * 128 + j;
        float s = 0.f;
#pragma unroll
        for (int r = 0; r < 16; ++r) s += wi[r] * wa[r * 128];
        ((bf16_t*)(F.ws + WS_WIN))[((size_t)l * DIN + 3072 + n) * DM + k] = (bf16_t)f2bf(s);
    }
}
__device__ __forceinline__ void p0_mod(Frame& F) {
    LAS float* sc = (LAS float*)F.lds;
    LAS float* red = (LAS float*)(F.lds + 17 * 1024 * 4);
    for (int i = F.tid; i < 17 * 1024; i += NTHR) { const int r = i >> 10, k = i & 1023; const float v = r < 16 ? F.in[I_C][r * 1024 + k] : F.in[I_CCTX][k]; sc[i] = silu_f(v); }
    __syncthreads();
    const int kq = F.tid >> 7, cl = F.tid & 127;
    for (int u = F.wg; u < DEPTH * 48; u += F.G) {
        const int l = u / 48, col = (u % 48) * 128 + cl;
        const float* w = F.in[I_WMOD] + (size_t)l * DM * 6144 + col;
        float a[17];
#pragma unroll
        for (int r = 0; r < 17; ++r) a[r] = 0.f;
#pragma unroll 4
        for (int k = kq * 256; k < kq * 256 + 256; ++k) { const float wv = w[(size_t)k * 6144];
#pragma unroll
            for (int r = 0; r < 17; ++r) a[r] += sc[r * 1024 + k] * wv; }
#pragma unroll
        for (int r = 0; r < 17; ++r) red[(kq * 17 + r) * 128 + cl] = a[r];
        __syncthreads();
        for (int i = F.tid; i < 17 * 128; i += NTHR) { const int r = i >> 7, c2 = i & 127, cc = (u % 48) * 128 + c2;
            const float s = red[(0 * 17 + r) * 128 + c2] + red[(1 * 17 + r) * 128 + c2] + red[(2 * 17 + r) * 128 + c2] + red[(3 * 17 + r) * 128 + c2] + F.in[I_BMOD][l * 6144 + cc];
            ((float*)(F.ws + WS_MOD))[((size_t)l * 17 + r) * 6144 + cc] = s; }
        __syncthreads();
    }
}
__device__ __forceinline__ void p0_hyena_filters(Frame& F) {
    LAS float* z = (LAS float*)F.lds;
    LAS float* h1 = z + 32 * 33;
    LAS float* h2 = h1 + 32 * 64;
    LAS float* tt = h2 + 32 * 64;
    constexpr int UL = 4096 / 32, UC = 256 / 32, UPL = UL + UC;
    for (int u = F.wg; u < DEPTH * UPL; u += F.G) {
        const int l = u / UPL, r = u % UPL; const bool lat = r < UL; const int L = lat ? 4096 : 256, n0 = (lat ? r : r - UL) * 32;
        __syncthreads();
        for (int i = F.tid; i < 32 * 33; i += NTHR) { const int p = i / 33, e = i % 33, n = n0 + p;
            const float t = (float)n / (float)(L - 1);
            float v;
            if (e == 0) v = t;
            else { const int kb = (e - 1) & 15; const float band = 1e-4f + (float)kb * ((15.0f - 1e-4f) / 15.0f);
                   const float w = 6.283185307179586f * (float)n / (float)L; const float ang = w * band;
                   v = e <= 16 ? __cosf(ang) : -__sinf(ang); }
            z[i] = v; if (e == 0) tt[p] = t; }
        __syncthreads();
        for (int i = F.tid; i < 32 * 64; i += NTHR) { const int p = i >> 6, j = i & 63; float s = F.in[I_HB1][l * 64 + j];
            for (int e = 0; e < 33; ++e) s += z[p * 33 + e] * F.in[I_HW1][((size_t)l * 33 + e) * 64 + j];
            h1[i] = __sinf(F.in[I_HF1][l * 64 + j] * s); }
        __syncthreads();
        for (int i = F.tid; i < 32 * 64; i += NTHR) { const int p = i >> 6, j = i & 63; float s = F.in[I_HB2][l * 64 + j];
            for (int e = 0; e < 64; ++e) s += h1[p * 64 + e] * F.in[I_HW2][((size_t)l * 64 + e) * 64 + j];
            h2[i] = __sinf(F.in[I_HF2][l * 64 + j] * s); }
        __syncthreads();
#pragma unroll 1
        for (int cc = 0; cc < 2; ++cc) {
            const int col = F.tid + cc * 512, o = col >> 9, dir = (col >> 8) & 1, ch = col & 255;
            float a[32];
#pragma unroll
            for (int p = 0; p < 32; ++p) a[p] = 0.f;
            const float* w3 = F.in[I_HW3] + (size_t)l * 64 * 1024 + col;
            for (int k = 0; k < 64; ++k) { const float wv = w3[(size_t)k * 1024];
#pragma unroll
                for (int p = 0; p < 32; ++p) a[p] += h2[p * 64 + k] * wv; }
            const float b3 = F.in[I_HB3][l * 1024 + col], dec = fabsf(F.in[I_HDEC][((size_t)(l * 2 + o) * 2 + dir) * 256 + ch]);
            const float skip = F.in[I_HSKIP][(l * 2 + o) * 256 + ch];
            bf16_t* R = lat ? (bf16_t*)(F.ws + WS_HYF) + ((size_t)(l * 2 + o) * 256 + ch) * 8192 : (bf16_t*)(F.ws + WS_HYFC) + ((size_t)(l * 2 + o) * 256 + ch) * 512;
#pragma unroll
            for (int p = 0; p < 32; ++p) { const int n = n0 + p; float v = (a[p] + b3) * __expf(-tt[p] * dec);
                if (dir == 0) { if (n == 0) v += skip; R[L - n] = (bf16_t)f2bf(v); }
                else { if (n == 0) R[0] = 0; else R[L + n] = (bf16_t)f2bf(v); } }
        }
    }
    __syncthreads();
}
__device__ __forceinline__ void p0_init_rows(Frame& F) {
    const int gw = F.wg * NWAVES + F.wave, NGW = F.G * NWAVES;
    for (int row = gw; row < NROW; row += NGW) {
        const float* src = row < NLAT ? F.in[I_X] + (size_t)row * DM : F.in[I_CTX] + (size_t)(row - NLAT) * DM;
        const float* md = mod_ptr(F, 0, row);
        bf16_t* xr = (bf16_t*)(F.ws + WS_XR) + (size_t)row * DM; bf16_t* xm = (bf16_t*)(F.ws + WS_XM) + (size_t)row * DM;
#pragma unroll
        for (int j = 0; j < 4; ++j) { const int c = 4 * F.lane + 256 * j;
            const f32x4 v = *(const GAS f32x4*)(src + c), sh = *(const GAS f32x4*)(md + c), sc = *(const GAS f32x4*)(md + 1024 + c);
            *(GAS u32x2*)(xr + c) = (u32x2){pk2(v[0], v[1]), pk2(v[2], v[3])};
            u32x2 w; w.x = pk2(v[0] * (1.f + sc[0]) + sh[0], v[1] * (1.f + sc[1]) + sh[1]); w.y = pk2(v[2] * (1.f + sc[2]) + sh[2], v[3] * (1.f + sc[3]) + sh[3]);
            *(GAS u32x2*)(xm + c) = w; }
    }
}
constexpr float WEXP_SCALE = 32.0f;
__device__ __forceinline__ void p_expert_weights(Frame& F, int l) {
    LAS float* scr = (LAS float*)(F.lds + F.wave * 16384);
    const int gw = F.wg * NWAVES + F.wave, NGW = F.G * NWAVES;
    constexpr int I1 = 16 * 8, I2 = 4 * 32, PER_E = 2 * I1 + I2;
    for (int it = gw; it < NE1 * PER_E; it += NGW) {
        const int e = it / PER_E; int r = it % PER_E;
        unsigned char* d1 = (unsigned char*)(F.ws + WS_EXP1) + (size_t)e * 512 * DM; unsigned char* d2 = (unsigned char*)(F.ws + WS_EXP2) + (size_t)e * DM * EH;
        if (r < 2 * I1) { const int up = r >= I1; if (up) r -= I1; const int kb = r / 8, nb = r % 8;
            const float* src = e < NEXP ? F.in[up ? I_WEU : I_WEG] + ((size_t)l * NEXP + e) * DM * EH : F.in[up ? I_WSU : I_WSG] + (size_t)l * DM * EH;
            tr_item8(src, EH, kb * 64, nb * 32, d1, DM, RowGU{up}, WEXP_SCALE, scr, F.lane); }
        else { r -= 2 * I1; const int kb = r / 32, nb = r % 32;
            const float* src = e < NEXP ? F.in[I_WED] + ((size_t)l * NEXP + e) * EH * DM : F.in[I_WSD] + (size_t)l * EH * DM;
            tr_item8(src, DM, kb * 64, nb * 32, d2, EH, RowId{}, WEXP_SCALE, scr, F.lane); }
    }
}

__device__ __forceinline__ f32x4 mfma16(bf16x8 a, bf16x8 b, f32x4 c) { return __builtin_amdgcn_mfma_f32_16x16x32_bf16(a, b, c, 0, 0, 0); }

__device__ __forceinline__ void ph_transposes(Frame& F, int l) {
    LAS bf16_t* tile = (LAS bf16_t*)(F.lds + F.wave * 16384);
    const bf16_t* U = (const bf16_t*)(F.ws + WS_U);
    const int gw = F.wg * NWAVES + F.wave, NGW = F.G * NWAVES;
    const int rsub = F.lane >> 3, cseg = F.lane & 7;
    for (int u = gw; u < 1088 * 20; u += NGW) {
        const int tt = u / 20, blk = u % 20;
        int b, s0, Ls, rowbase, posbase;
        if (tt < 1024) { b = tt >> 6; s0 = (tt & 63) * 64; Ls = SEQ; rowbase = b * SEQ; posbase = 0; }
        else { const int t2 = tt - 1024; b = t2 >> 2; s0 = (t2 & 3) * 64; Ls = CTXL; rowbase = NLAT + b * CTXL; posbase = SEQ; }
        if (blk < 12) {
            const int c0 = blk * 64 + cseg * 8;
            float w0[8], w1[8], w2[8], bb[8];
#pragma unroll
            for (int i = 0; i < 8; ++i) { w0[i] = F.in[I_HSW][(l * 3 + 0) * 768 + c0 + i]; w1[i] = F.in[I_HSW][(l * 3 + 1) * 768 + c0 + i]; w2[i] = F.in[I_HSW][(l * 3 + 2) * 768 + c0 + i]; bb[i] = F.in[I_HSB][l * 768 + c0 + i]; }
#pragma unroll 2
            for (int it = 0; it < 8; ++it) {
                const int sl = rsub + 8 * it, s = s0 + sl;
                const bf16_t* p = U + (size_t)(rowbase + s) * DIN + UHY + c0;
                const u32x4 zc = *(const u32x4*)p;
                u32x4 zm = (u32x4){0u, 0u, 0u, 0u}, zp = (u32x4){0u, 0u, 0u, 0u};
                if (s > 0) zm = *(const u32x4*)(p - DIN);
                if (s < Ls - 1) zp = *(const u32x4*)(p + DIN);
                const unsigned am[4] = {zm.x, zm.y, zm.z, zm.w}, ac[4] = {zc.x, zc.y, zc.z, zc.w}, ap[4] = {zp.x, zp.y, zp.z, zp.w};
#pragma unroll
                for (int i = 0; i < 4; ++i) {
                    const float v0 = bb[2 * i] + w0[2 * i] * bflo(am[i]) + w1[2 * i] * bflo(ac[i]) + w2[2 * i] * bflo(ap[i]);
                    const float v1 = bb[2 * i + 1] + w0[2 * i + 1] * bfhi(am[i]) + w1[2 * i + 1] * bfhi(ac[i]) + w2[2 * i + 1] * bfhi(ap[i]);
                    tile[(cseg * 8 + 2 * i) * 72 + sl] = (bf16_t)f2bf(v0); tile[(cseg * 8 + 2 * i + 1) * 72 + sl] = (bf16_t)f2bf(v1);
                }
            }
        } else {
            const int c0 = (blk - 12) * 64 + cseg * 8;
#pragma unroll 2
            for (int it = 0; it < 8; ++it) {
                const int sl = rsub + 8 * it, s = s0 + sl;
                const u32x4 zc = *(const u32x4*)(U + (size_t)(rowbase + s) * DIN + UV + c0);
                const unsigned ac[4] = {zc.x, zc.y, zc.z, zc.w};
#pragma unroll
                for (int i = 0; i < 4; ++i) { tile[(cseg * 8 + 2 * i) * 72 + sl] = (bf16_t)(ac[i] & 0xffffu); tile[(cseg * 8 + 2 * i + 1) * 72 + sl] = (bf16_t)(ac[i] >> 16); }
            }
        }
        LDS_WAIT(); asm volatile("" ::: "memory");
#pragma unroll 2
        for (int it = 0; it < 8; ++it) {
            const int ch = rsub + 8 * it;
            const u32x4 v = *(const LAS u32x4*)(tile + ch * 72 + cseg * 8);
            bf16_t* dst;
            if (blk < 12) dst = (bf16_t*)(F.ws + WS_HV) + ((size_t)(blk * 64 + ch) * NB + b) * SPB + posbase + s0 + cseg * 8;
            else dst = (bf16_t*)(F.ws + WS_VT) + ((size_t)b * 512 + (blk - 12) * 64 + ch) * SPB + posbase + s0 + cseg * 8;
            *(u32x4*)dst = v;
        }
        LDS_WAIT(); asm volatile("" ::: "memory");
    }
}

constexpr int NA_RPB = 0, NA_KC = 16384, NA_VC = NA_KC + 256 * 144, NA_END = NA_VC + 64 * 528;
__device__ __forceinline__ bf16x8 gld16(const bf16_t* p) { return *(const GAS bf16x8*)p; }
__device__ __forceinline__ u32x2 gld8(const bf16_t* p) { return *(const GAS u32x2*)p; }
__device__ __forceinline__ const char* uni_ptr(const char* p) { const unsigned long long v = (unsigned long long)p; const unsigned lo = __builtin_amdgcn_readfirstlane((unsigned)v), hi = __builtin_amdgcn_readfirstlane((unsigned)(v >> 32)); return (const char*)(((unsigned long long)hi << 32) | lo); }
__device__ __forceinline__ bf16x8 gld16o(const char* ub, unsigned lo) { return *(const GAS bf16x8*)(ub + (size_t)lo); }
__device__ __forceinline__ u32x2 gld8o(const char* ub, unsigned lo) { return *(const GAS u32x2*)(ub + (size_t)lo); }
template <bool WIN>
__device__ __forceinline__ void na_unit(Frame& F, int b, int h, int r, int strip) {
    const bf16_t* U = (const bf16_t*)(F.ws + WS_U);
    const bf16_t* VT = (const bf16_t*)(F.ws + WS_VT) + ((size_t)b * 512 + h * 64) * SPB;
    const LAS float* rpb = (const LAS float*)(F.lds + NA_RPB);
    const LAS bf16_t* KC = (const LAS bf16_t*)(F.lds + NA_KC); const LAS bf16_t* VC = (const LAS bf16_t*)(F.lds + NA_VC);
    int ln_ = F.lane; asm volatile("" : "+v"(ln_));
    const int i = ln_ & 15, g = ln_ >> 4;
    const int qrow0 = WIN ? (b * SEQ + r * 64 + strip * 16) : (NLAT + b * CTXL + strip * 16);
    const int ki = 8 * (i >> 2) + (i & 3);
    const unsigned qlo = (unsigned)((i * DIN + 8 * g) * 2), klo = (unsigned)((ki * DIN + 8 * g) * 2), vlo = (unsigned)((i * SPB + 8 * g) * 2);
    const char* qb = uni_ptr((const char*)(U + (size_t)qrow0 * DIN + UQ + h * 64));
    const bf16x8 q0 = gld16o(qb, qlo), q1 = gld16o(qb + 64, qlo);
    constexpr int NT = WIN ? 32 : 16;
    constexpr int CO = WIN ? 16 : 0;
    f32x4 st[NT];
    int kr0 = 0, u0 = 0;
    if (WIN) { kr0 = r - 4; kr0 = kr0 < 0 ? 0 : (kr0 > 56 ? 56 : kr0); u0 = strip == 0 ? 0 : (strip == 1 ? 8 : (strip == 2 ? 24 : 32)); }
    const char* kbase = uni_ptr((const char*)(U + (size_t)(b * SEQ + kr0 * 64 + u0) * DIN + UK + h * 64));
    const char* vbase = uni_ptr((const char*)(VT + kr0 * 64 + u0));
#define NA_SB() __builtin_amdgcn_sched_barrier(0)
#define NA_KLOAD(buf, grp) do { _Pragma("unroll") for (int t = 0; t < 2; ++t) { const int kt = (grp) * 2 + t; const char* kp = kbase + (size_t)((kt >> 1) * 64 + (kt & 1) * 4) * DIN * 2; buf[t][0] = gld16o(kp, klo); buf[t][1] = gld16o(kp + 64, klo); } } while (0)
#define NA_KMMA(buf, grp) do { _Pragma("unroll") for (int t = 0; t < 2; ++t) { f32x4 a = (f32x4){0.f, 0.f, 0.f, 0.f}; a = mfma16(buf[t][0], q0, a); a = mfma16(buf[t][1], q1, a); st[(grp) * 2 + t] = a; } } while (0)
#define NA_VLOAD(buf, cp) do { _Pragma("unroll") for (int d = 0; d < 4; ++d) { const char* vp = vbase + ((size_t)(d * 16) * SPB + (cp) * 64) * 2; buf[d] = gld16o(vp, vlo); } } while (0)
#define NA_VMMA(buf, cp) do { const int c = (cp); const f32x4 p0 = st[2 * c], p1 = st[2 * c + 1]; \
        u32x4 pw; pw.x = pk2(p0[0], p0[1]); pw.y = pk2(p0[2], p0[3]); pw.z = pk2(p1[0], p1[1]); pw.w = pk2(p1[2], p1[3]); const bf16x8 pf = __builtin_bit_cast(bf16x8, pw); \
        _Pragma("unroll") for (int d = 0; d < 4; ++d) o[d] = mfma16(buf[d], pf, o[d]); } while (0)
    bf16x8 ka[2][2], kb[2][2];
    if (WIN) { NA_KLOAD(ka, 0); NA_KLOAD(kb, 1); NA_SB(); }
#pragma unroll
    for (int cg = 0; cg < 8; ++cg) {
        bf16x8 kc[2][2];
#pragma unroll
        for (int t = 0; t < 2; ++t) { const LAS bf16_t* kp = KC + (cg * 32 + ki + 4 * t) * 72 + 8 * g; kc[t][0] = *(const LAS bf16x8*)kp; kc[t][1] = *(const LAS bf16x8*)(kp + 32); }
#pragma unroll
        for (int t = 0; t < 2; ++t) { f32x4 a = (f32x4){0.f, 0.f, 0.f, 0.f}; a = mfma16(kc[t][0], q0, a); a = mfma16(kc[t][1], q1, a); st[CO + cg * 2 + t] = a; }
        NA_SB();
    }
    bf16x8 va[4], vb[4];
    if (WIN) {
        NA_KMMA(ka, 0); NA_SB(); NA_KLOAD(ka, 2); NA_SB();
        NA_KMMA(kb, 1); NA_SB(); NA_KLOAD(kb, 3); NA_SB();
        NA_KMMA(ka, 2); NA_SB(); NA_KLOAD(ka, 4); NA_SB();
        NA_KMMA(kb, 3); NA_SB(); NA_KLOAD(kb, 5); NA_SB();
        NA_KMMA(ka, 4); NA_SB(); NA_KLOAD(ka, 6); NA_SB();
        NA_KMMA(kb, 5); NA_SB(); NA_KLOAD(kb, 7); NA_SB();
        NA_KMMA(ka, 6); NA_SB(); NA_VLOAD(va, 0); NA_SB();
        NA_KMMA(kb, 7); NA_SB(); NA_VLOAD(vb, 1); NA_SB();
    }
    float mx = -3.0e38f;
    if (WIN) {
        const int c = strip * 16 + i; int kc0 = c - 8; kc0 = kc0 < 0 ? 0 : (kc0 > 48 ? 48 : kc0);
#pragma unroll
        for (int grp = 0; grp < 4; ++grp) {
            float bv[4][4];
#pragma unroll
            for (int t = 0; t < 4; ++t) { const int kt = grp * 4 + t, dr = kr0 + (kt >> 1) - r + 7;
#pragma unroll
                for (int e = 0; e < 4; ++e) { int dc = u0 + 8 * g + (kt & 1) * 4 + e - c + 15; dc = dc < 0 ? 0 : (dc > 30 ? 30 : dc); bv[t][e] = rpb[(h * 15 + dr) * 31 + dc]; } }
#pragma unroll
            for (int t = 0; t < 4; ++t) { const int kt = grp * 4 + t;
#pragma unroll
                for (int e = 0; e < 4; ++e) { const int kc = u0 + 8 * g + (kt & 1) * 4 + e; const bool ok = (kc >= kc0) && (kc < kc0 + 16);
                    const float s = ok ? (st[kt][e] * 0.125f + bv[t][e]) : -3.0e38f; st[kt][e] = s; mx = fmaxf(mx, s); } }
            NA_SB();
        }
    }
#pragma unroll
    for (int ct = 0; ct < 16; ++ct)
#pragma unroll
        for (int e = 0; e < 4; ++e) { const float s = st[CO + ct][e] * 0.125f; st[CO + ct][e] = s; mx = fmaxf(mx, s); }
    mx = fmaxf(mx, shx(mx, 16, ln_)); mx = fmaxf(mx, shx(mx, 32, ln_));
    float sum = 0.f;
#pragma unroll
    for (int t = 0; t < NT; ++t)
#pragma unroll
        for (int e = 0; e < 4; ++e) { const float p = __expf(st[t][e] - mx); st[t][e] = p; sum += p; }
    sum += shx(sum, 16, ln_); sum += shx(sum, 32, ln_);
    const float inv = 1.0f / sum;
    f32x4 o[4];
#pragma unroll
    for (int d = 0; d < 4; ++d) o[d] = (f32x4){0.f, 0.f, 0.f, 0.f};
    NA_SB();
    if (WIN) {
        NA_VMMA(va, 0); NA_SB(); NA_VLOAD(va, 2); NA_SB();
        NA_VMMA(vb, 1); NA_SB(); NA_VLOAD(vb, 3); NA_SB();
        NA_VMMA(va, 2); NA_SB(); NA_VLOAD(va, 4); NA_SB();
        NA_VMMA(vb, 3); NA_SB(); NA_VLOAD(vb, 5); NA_SB();
        NA_VMMA(va, 4); NA_SB(); NA_VLOAD(va, 6); NA_SB();
        NA_VMMA(vb, 5); NA_SB(); NA_VLOAD(vb, 7); NA_SB();
    }
#pragma unroll
    for (int cb = 0; cb < 8; ++cb) {
        bf16x8 vc[4];
#pragma unroll
        for (int d = 0; d < 4; ++d) vc[d] = *(const LAS bf16x8*)(VC + (d * 16 + i) * 264 + cb * 32 + 8 * g);
        { const int c = (WIN ? 8 : 0) + cb; const f32x4 p0 = st[2 * c], p1 = st[2 * c + 1];
            u32x4 pw; pw.x = pk2(p0[0], p0[1]); pw.y = pk2(p0[2], p0[3]); pw.z = pk2(p1[0], p1[1]); pw.w = pk2(p1[2], p1[3]); const bf16x8 pf = __builtin_bit_cast(bf16x8, pw);
#pragma unroll
            for (int d = 0; d < 4; ++d) o[d] = mfma16(vc[d], pf, o[d]); }
        NA_SB();
    }
    if (WIN) { NA_VMMA(va, 6); NA_SB(); NA_VMMA(vb, 7); NA_SB(); }
    char* op = (char*)uni_ptr((const char*)((bf16_t*)(F.ws + WS_MIX) + (size_t)qrow0 * DM + h * 64)); const unsigned olo = (unsigned)((i * DM + 4 * g) * 2);
#pragma unroll
    for (int d = 0; d < 4; ++d) { u32x2 w; w.x = pk2(o[d][0] * inv, o[d][1] * inv); w.y = pk2(o[d][2] * inv, o[d][3] * inv); *(GAS u32x2*)(op + d * 32 + (size_t)olo) = w; }
#undef NA_SB
#undef NA_KLOAD
#undef NA_KMMA
#undef NA_VLOAD
#undef NA_VMMA
}
__device__ __forceinline__ void ph_na(Frame& F, int l, bool last) {
    LAS float* rpb = (LAS float*)(F.lds + NA_RPB);
    __syncthreads();
    for (int i = F.tid; i < 8 * 15 * 31; i += NTHR) rpb[i] = F.in[I_RPB][(size_t)l * 8 * 15 * 31 + i];
    const bf16_t* U = (const bf16_t*)(F.ws + WS_U);
    for (int job = F.wg; job < NB * 8 * 2; job += F.G) {
        const int half = job & 1, h = (job >> 1) & 7, b = job >> 4;
        __syncthreads();
        { int tz_ = F.tid; asm volatile("" : "+v"(tz_)); const int key = tz_ >> 1, hf = tz_ & 1; const bf16_t* src = U + (size_t)(NLAT + b * CTXL + key) * DIN + UK + h * 64 + hf * 32; LAS bf16_t* dst = (LAS bf16_t*)(F.lds + NA_KC) + key * 72 + hf * 32;
#pragma unroll
          for (int j = 0; j < 4; ++j) *(LAS bf16x8*)(dst + j * 8) = gld16(src + j * 8);
          const int dv = tz_ >> 3, seg = tz_ & 7; const bf16_t* vs = (const bf16_t*)(F.ws + WS_VT) + ((size_t)b * 512 + h * 64 + dv) * SPB + SEQ + seg * 32; LAS bf16_t* vd = (LAS bf16_t*)(F.lds + NA_VC) + dv * 264 + seg * 32;
#pragma unroll
          for (int j = 0; j < 4; ++j) *(LAS bf16x8*)(vd + j * 8) = gld16(vs + j * 8); }
        __syncthreads();
        for (int uu = F.wave; uu < 128; uu += NWAVES) na_unit<true>(F, b, h, half * 32 + (uu >> 2), uu & 3);
        if (!last) na_unit<false>(F, b, h, 0, half * 8 + F.wave);
    }
}

__device__ __forceinline__ void ph_hy_transpose(Frame& F, bool last) {
    LAS bf16_t* tile = (LAS bf16_t*)(F.lds + F.wave * 16384);
    const bf16_t* HYO = (const bf16_t*)(F.ws + WS_Y);
    const int gw = F.wg * NWAVES + F.wave, NGW = F.G * NWAVES;
    const int rsub = F.lane >> 3, cseg = F.lane & 7;
    const int ntt = last ? 1024 : 1088;
    for (int u = gw; u < ntt * 4; u += NGW) {
        const int tt = u >> 2, cb = u & 3;
        int b, s0, rowbase, posbase;
        if (tt < 1024) { b = tt >> 6; s0 = (tt & 63) * 64; rowbase = b * SEQ; posbase = 0; }
        else { const int t2 = tt - 1024; b = t2 >> 2; s0 = (t2 & 3) * 64; rowbase = NLAT + b * CTXL; posbase = SEQ; }
#pragma unroll 2
        for (int it = 0; it < 8; ++it) { const int c = rsub + 8 * it;
            const u32x4 v = *(const GAS u32x4*)(HYO + ((size_t)(cb * 64 + c) * NB + b) * SPB + posbase + s0 + cseg * 8); const unsigned a[4] = {v.x, v.y, v.z, v.w};
#pragma unroll
            for (int e = 0; e < 4; ++e) { tile[(cseg * 8 + 2 * e) * 72 + c] = (bf16_t)(a[e] & 0xffffu); tile[(cseg * 8 + 2 * e + 1) * 72 + c] = (bf16_t)(a[e] >> 16); } }
        LDS_WAIT(); asm volatile("" ::: "memory");
#pragma unroll 2
        for (int it = 0; it < 8; ++it) { const int p = rsub + 8 * it;
            const u32x4 v = *(const LAS u32x4*)(tile + p * 72 + cseg * 8);
            *(GAS u32x4*)((bf16_t*)(F.ws + WS_MIX) + (size_t)(rowbase + s0 + p) * DM + 768 + cb * 64 + cseg * 8) = v; }
        LDS_WAIT(); asm volatile("" ::: "memory");
    }
}

constexpr int G2_LAF = 0, G2_LAB = 8448;
constexpr int G2_QTF = 16896, G2_KTF = 22016, G2_QTB = 27136, G2_KTB = 32256;
constexpr int G2_VT = 37376, G2_ATT = 46592;
constexpr int G2_SF = 55808, G2_SB = 60928;
constexpr int G2_SEG = 66048, G2_HALF = 67328;
__device__ __forceinline__ float log_sigmoid_f(float x) { return fminf(x, 0.f) - log1pf(__expf(-fabsf(x))); }
__device__ __forceinline__ f32x4 mma_lds(const LAS bf16_t* A, int lda, const LAS bf16_t* B, int ldb, int ksteps, f32x4 acc, int lane) {
    const int r = lane & 15, g = lane >> 4;
    for (int ks = 0; ks < ksteps; ++ks) { const bf16x8 a = *(const LAS bf16x8*)(A + r * lda + ks * 32 + 8 * g), b = *(const LAS bf16x8*)(B + r * ldb + ks * 32 + 8 * g); acc = mfma16(a, b, acc); }
    return acc;
}
__device__ __forceinline__ int gla_row0(int b, int cn) { return cn >= 4 ? b * SEQ + (cn - 4) * 64 : NLAT + b * CTXL + cn * 64; }
struct GlaRaw { u32x4 q, k, f, b, v0, v1, g0, g1, s0, s1; };
template <bool FULL>
__device__ __forceinline__ GlaRaw gla_load(Frame& F, int u, int tl) {
    const int h = u & 3, cn = (u >> 2) % 68, b = (u >> 2) / 68, i = tl >> 2, part = tl & 3;
    const bf16_t* p = (const bf16_t*)(F.ws + WS_U) + (size_t)(gla_row0(b, cn) + i) * DIN;
    GlaRaw r;
    r.q = *(const GAS u32x4*)(p + UGQ + h * 32 + part * 8); r.k = *(const GAS u32x4*)(p + UGK + h * 32 + part * 8);
    r.f = *(const GAS u32x4*)(p + ULAF + h * 32 + part * 8); r.b = *(const GAS u32x4*)(p + ULAB + h * 32 + part * 8);
    r.v0 = *(const GAS u32x4*)(p + UGV + h * 64 + part * 16); r.v1 = *(const GAS u32x4*)(p + UGV + h * 64 + part * 16 + 8);
    if (FULL) { r.g0 = *(const GAS u32x4*)(p + UGR + h * 64 + part * 16); r.g1 = *(const GAS u32x4*)(p + UGR + h * 64 + part * 16 + 8);
        const bf16_t* sp = (const bf16_t*)(F.ws + WS_GSIN) + (size_t)u * 2 * 2048 + tl * 16; r.s0 = *(const GAS u32x4*)sp; r.s1 = *(const GAS u32x4*)(sp + 8); }
    else { r.g0 = (u32x4){0u, 0u, 0u, 0u}; r.g1 = r.g0; r.s0 = r.g0; r.s1 = r.g0; }
    return r;
}
template <bool FULL>
__device__ __forceinline__ void gla_prep(Frame& F, LAS unsigned char* L, int l, int u, int tl, const GlaRaw& raw) {
    const int h = u & 3, cn = (u >> 2) % 68, i = tl >> 2, part = tl & 3, d8 = part * 8;
    LAS float* LAF = (LAS float*)(L + G2_LAF); LAS float* LAB = (LAS float*)(L + G2_LAB); LAS bf16_t* VT = (LAS bf16_t*)(L + G2_VT); LAS float* SEG = (LAS float*)(L + G2_SEG);
    float q[8], k[8], tf[8], tb[8];
    unpack8(raw.q, q); unpack8(raw.k, k); unpack8(raw.f, tf); unpack8(raw.b, tb);
    const float* ba = F.in[I_BA2] + (size_t)l * 256 + h * 32 + d8;
#pragma unroll
    for (int e = 0; e < 8; ++e) { q[e] *= 0.17677669529663687f; LAF[i * 33 + d8 + e] = log_sigmoid_f(tf[e] + ba[e]) * 0.0625f; LAB[i * 33 + d8 + e] = log_sigmoid_f(tb[e] + ba[128 + e]) * 0.0625f; }
    if (cn >= 4) {
        const float pos = (part >> 1) ? (float)i : (float)(cn - 4);
#pragma unroll
        for (int e = 0; e < 8; ++e) { const float ang = pos * __expf(-(float)e * (9.210340371976184f / 8.0f)); const float sn = __sinf(ang), cs = __cosf(ang);
            const float qo = shx(q[e], 1, F.lane), ko = shx(k[e], 1, F.lane);
            if (part & 1) { q[e] = qo * sn + q[e] * cs; k[e] = ko * sn + k[e] * cs; } else { q[e] = q[e] * cs - qo * sn; k[e] = k[e] * cs - ko * sn; } }
    }
    { const unsigned a[8] = {raw.v0.x, raw.v0.y, raw.v0.z, raw.v0.w, raw.v1.x, raw.v1.y, raw.v1.z, raw.v1.w};
#pragma unroll
      for (int e = 0; e < 8; ++e) { VT[(part * 16 + 2 * e) * 72 + i] = (bf16_t)(a[e] & 0xffffu); VT[(part * 16 + 2 * e + 1) * 72 + i] = (bf16_t)(a[e] >> 16); } }
    __syncthreads();
    { const int x = tl & 63, d = x & 31, dir = x >> 5, seg = tl >> 6; LAS float* LA = dir ? LAB : LAF; float run = 0.f;
#pragma unroll
      for (int kk = 0; kk < 16; ++kk) { const int p = seg * 16 + kk, ti = dir ? 63 - p : p; run += LA[ti * 33 + d]; LA[ti * 33 + d] = run; }
      SEG[x * 5 + seg] = run; }
    __syncthreads();
    { const int x = tl & 63, d = x & 31, dir = x >> 5, seg = tl >> 6; LAS float* LA = dir ? LAB : LAF; float pre = 0.f;
      for (int s2 = 0; s2 < seg; ++s2) pre += SEG[x * 5 + s2];
#pragma unroll
      for (int kk = 0; kk < 16; ++kk) { const int p = seg * 16 + kk, ti = dir ? 63 - p : p; LA[ti * 33 + d] += pre; } }
    __syncthreads();
    if (FULL) {
        unsigned wqf[4], wkf[4], wqb[4], wkb[4];
#pragma unroll
        for (int e = 0; e < 4; ++e) { const int d = d8 + 2 * e; const float f0 = LAF[i * 33 + d], f1 = LAF[i * 33 + d + 1], b0 = LAB[i * 33 + d], b1 = LAB[i * 33 + d + 1];
            wqf[e] = pk2(q[2 * e] * __expf(f0), q[2 * e + 1] * __expf(f1)); wkf[e] = pk2(k[2 * e] * __expf(-f0), k[2 * e + 1] * __expf(-f1));
            wqb[e] = pk2(q[2 * e] * __expf(b0), q[2 * e + 1] * __expf(b1)); wkb[e] = pk2(k[2 * e] * __expf(-b0), k[2 * e + 1] * __expf(-b1)); }
        *(LAS u32x4*)((LAS bf16_t*)(L + G2_QTF) + i * 40 + d8) = (u32x4){wqf[0], wqf[1], wqf[2], wqf[3]}; *(LAS u32x4*)((LAS bf16_t*)(L + G2_KTF) + i * 40 + d8) = (u32x4){wkf[0], wkf[1], wkf[2], wkf[3]};
        *(LAS u32x4*)((LAS bf16_t*)(L + G2_QTB) + i * 40 + d8) = (u32x4){wqb[0], wqb[1], wqb[2], wqb[3]}; *(LAS u32x4*)((LAS bf16_t*)(L + G2_KTB) + i * 40 + d8) = (u32x4){wkb[0], wkb[1], wkb[2], wkb[3]};
    } else {
        LAS bf16_t* KDF = (LAS bf16_t*)(L + G2_QTF); LAS bf16_t* KDB = (LAS bf16_t*)(L + G2_KTF);
#pragma unroll
        for (int e = 0; e < 8; ++e) { const int d = d8 + e; const float bf = LAF[i * 33 + d], bb = LAB[i * 33 + d], bfl = LAF[63 * 33 + d], bbl = LAB[0 * 33 + d];
            KDF[d * 72 + i] = (bf16_t)f2bf(k[e] * __expf(bfl - bf)); KDB[d * 72 + i] = (bf16_t)f2bf(k[e] * __expf(bbl - bb)); }
    }
    __syncthreads();
}
__device__ __forceinline__ void ph_gla_local(Frame& F, int l) {
    const int hw = F.wave >> 2, wl = F.wave & 3, tl = F.tid & 255; LAS unsigned char* L = F.lds + hw * G2_HALF;
    constexpr int NU = NB * 68 * 4;
    int pp = F.wg;
    GlaRaw raw = gla_load<false>(F, (pp * 2 + hw) < NU ? pp * 2 + hw : 0, tl);
    for (; pp * 2 < NU; pp += F.G) {
        const int u = pp * 2 + hw, un = (pp + F.G) * 2 + hw;
        const GlaRaw nraw = gla_load<false>(F, un < NU ? un : u, tl);
        __syncthreads();
        gla_prep<false>(F, L, l, u, tl, raw);
        const int g = F.lane >> 4, c = F.lane & 15;
        float* DS = (float*)(F.ws + WS_GDS) + (size_t)u * 2 * 2048;
#pragma unroll
        for (int kk = 0; kk < 4; ++kk) { const int tix = wl * 4 + kk, dir = tix >> 3, mt = (tix >> 1) & 3, nt = tix & 1;
            f32x4 a = (f32x4){0.f, 0.f, 0.f, 0.f};
            a = mma_lds((const LAS bf16_t*)(L + G2_VT) + mt * 16 * 72, 72, (const LAS bf16_t*)(L + (dir ? G2_KTF : G2_QTF)) + nt * 16 * 72, 72, 2, a, F.lane);
#pragma unroll
            for (int e = 0; e < 4; ++e) DS[dir * 2048 + (mt * 16 + 4 * g + e) * 32 + nt * 16 + c] = a[e]; }
        if (tl < 64) { const int d = tl & 31, dir = tl >> 5; ((float*)(F.ws + WS_GD))[(size_t)u * 64 + tl] = __expf(dir ? ((LAS float*)(L + G2_LAB))[0 * 33 + d] : ((LAS float*)(L + G2_LAF))[63 * 33 + d]); }
        raw = nraw;
    }
}
__device__ __forceinline__ void ph_gla_scan(Frame& F) {
    const int gt = F.wg * NTHR + F.tid, NGT = F.G * NTHR;
    const float* DS = (const float*)(F.ws + WS_GDS); const float* GD = (const float*)(F.ws + WS_GD); bf16_t* SIN = (bf16_t*)(F.ws + WS_GSIN);
    for (int w = gt; w < 128 * 1024; w += NGT) {
        const int chain = w >> 10, el = (w & 1023) * 2, dir = chain & 1, h = (chain >> 1) & 3, b = chain >> 3, d = el & 31;
        float s0 = 0.f, s1 = 0.f;
        for (int step = 0; step < 68; ++step) {
            const int cn = dir ? (step < 4 ? 3 - step : 71 - step) : step;
            const size_t u = (size_t)(b * 68 + cn) * 4 + h;
            *(unsigned*)(SIN + (u * 2 + dir) * 2048 + el) = pk2(s0, s1);
            const f32x2 ds = *(const f32x2*)(DS + (u * 2 + dir) * 2048 + el); const f32x2 dd = *(const f32x2*)(GD + u * 64 + dir * 32 + d);
            s0 = dd.x * s0 + ds.x; s1 = dd.y * s1 + ds.y;
        }
    }
}
__device__ __forceinline__ void ph_gla_out(Frame& F, int l, bool last) {
    const int hw = F.wave >> 2, wl = F.wave & 3, tl = F.tid & 255; LAS unsigned char* L = F.lds + hw * G2_HALF;
    const int NV = last ? NB * 64 * 4 : NB * 68 * 4;
#define GLA_UNIT(v) (last ? ((((v) >> 8) * 68 + 4 + (((v) & 255) >> 2)) * 4 + ((v) & 3)) : (v))
    int pp = F.wg;
    GlaRaw raw = gla_load<true>(F, GLA_UNIT((pp * 2 + hw) < NV ? pp * 2 + hw : 0), tl);
    for (; pp * 2 < NV; pp += F.G) {
        const int u = GLA_UNIT(pp * 2 + hw), vn = (pp + F.G) * 2 + hw;
        const GlaRaw nraw = gla_load<true>(F, vn < NV ? GLA_UNIT(vn) : u, tl);
        const int h = u & 3, cn = (u >> 2) % 68, b = (u >> 2) / 68;
        __syncthreads();
        gla_prep<true>(F, L, l, u, tl, raw);
        { const int dir = tl >> 7, dv = (tl >> 1) & 63, d16 = (tl & 1) * 16; LAS bf16_t* S = (LAS bf16_t*)(L + (dir ? G2_SB : G2_SF)) + dv * 40 + d16; *(LAS u32x4*)S = raw.s0; *(LAS u32x4*)(S + 8) = raw.s1; }
        const int g = F.lane >> 4, c = F.lane & 15;
        LAS bf16_t* ATT = (LAS bf16_t*)(L + G2_ATT);
#pragma unroll
        for (int kk = 0; kk < 4; ++kk) { const int tile = wl * 4 + kk, mt = tile >> 2, nt = tile & 3;
            f32x4 af = (f32x4){0.f, 0.f, 0.f, 0.f}, ab = af;
            af = mma_lds((const LAS bf16_t*)(L + G2_QTF) + mt * 16 * 40, 40, (const LAS bf16_t*)(L + G2_KTF) + nt * 16 * 40, 40, 1, af, F.lane);
            ab = mma_lds((const LAS bf16_t*)(L + G2_QTB) + mt * 16 * 40, 40, (const LAS bf16_t*)(L + G2_KTB) + nt * 16 * 40, 40, 1, ab, F.lane);
#pragma unroll
            for (int e = 0; e < 4; ++e) { const int ii = mt * 16 + 4 * g + e, j = nt * 16 + c; const float vv = (j <= ii ? af[e] : 0.f) + (j >= ii ? ab[e] : 0.f); ATT[ii * 72 + j] = (bf16_t)f2bf(vv); } }
        __syncthreads();
        LAS float* O = (LAS float*)(L + G2_LAF);
#pragma unroll
        for (int kk = 0; kk < 4; ++kk) { const int tile = wl * 4 + kk, mt = tile >> 2, nt = tile & 3;
            f32x4 a = (f32x4){0.f, 0.f, 0.f, 0.f};
            a = mma_lds(ATT + mt * 16 * 72, 72, (const LAS bf16_t*)(L + G2_VT) + nt * 16 * 72, 72, 2, a, F.lane);
            a = mma_lds((const LAS bf16_t*)(L + G2_QTF) + mt * 16 * 40, 40, (const LAS bf16_t*)(L + G2_SF) + nt * 16 * 40, 40, 1, a, F.lane);
            a = mma_lds((const LAS bf16_t*)(L + G2_QTB) + mt * 16 * 40, 40, (const LAS bf16_t*)(L + G2_SB) + nt * 16 * 40, 40, 1, a, F.lane);
#pragma unroll
            for (int e = 0; e < 4; ++e) O[(mt * 16 + 4 * g + e) * 65 + nt * 16 + c] = a[e]; }
        __syncthreads();
        { const int i = tl >> 2, dv16 = (tl & 3) * 16; const int row = gla_row0(b, cn) + i;
          float v[16], gt[16]; float ss = 0.f;
#pragma unroll
          for (int e = 0; e < 16; ++e) { v[e] = O[i * 65 + dv16 + e]; ss += v[e] * v[e]; }
          ss += shx(ss, 1, F.lane); ss += shx(ss, 2, F.lane);
          const float rs = 1.0f / sqrtf(ss * (1.0f / 64.0f) + LN_EPS);
          unpack8(raw.g0, gt); unpack8(raw.g1, gt + 8);
          const float* gn = F.in[I_GNORM] + l * 64 + dv16;
          unsigned w[8];
#pragma unroll
          for (int e = 0; e < 8; ++e) w[e] = pk2(v[2 * e] * rs * gn[2 * e] * silu_f(gt[2 * e]), v[2 * e + 1] * rs * gn[2 * e + 1] * silu_f(gt[2 * e + 1]));
          bf16_t* mp = (bf16_t*)(F.ws + WS_MIX) + (size_t)row * DM + 512 + h * 64 + dv16;
          *(GAS u32x4*)mp = (u32x4){w[0], w[1], w[2], w[3]}; *(GAS u32x4*)(mp + 8) = (u32x4){w[4], w[5], w[6], w[7]}; }
        raw = nraw;
    }
#undef GLA_UNIT
}

template <int L>
__device__ __forceinline__ void hyena_conv(Frame& F, const bf16_t* Rg, const bf16_t* Uin, const bf16_t* Xmul, int pos0, bool final_out, int ch, bf16_t* Zout) {
    constexpr int CS = 2 * L + 16;
    constexpr int NTL = L / 16, J = (NTL >= 64) ? 16 : 2, NGRP = NTL / J, HJ = J / 2, NSTEP = L / 32;
    LAS bf16_t* Rl = (LAS bf16_t*)F.lds;
    __syncthreads();
    for (int c = F.tid; c < 2 * L / 8; c += NTHR) { const u32x4 v = *(const GAS u32x4*)(Rg + 8 * c); const unsigned a[4] = {v.x, v.y, v.z, v.w};
#pragma unroll
        for (int rho = 0; rho < 8; ++rho) { LAS bf16_t* d = Rl + rho * CS + 8 * c + rho;
#pragma unroll
            for (int k = 0; k < 4; ++k) { d[2 * k] = (bf16_t)(a[k] & 0xffffu); d[2 * k + 1] = (bf16_t)(a[k] >> 16); } } }
    __syncthreads();
    int ln_ = F.lane; asm volatile("" : "+v"(ln_));
    const int i = ln_ & 15, g = ln_ >> 4, rho = i & 7;
    const LAS bf16_t* Rc = Rl + rho * CS + rho;
    for (int grp = F.wave; grp < NGRP; grp += NWAVES) {
        f32x4 acc[J]; bf16x8 fr[J];
        const int tb = grp * J * 16;
        const LAS bf16_t* Rb = Rc + (L - tb - i + 8 * g);
#pragma unroll
        for (int j = 0; j < J; ++j) { acc[j] = (f32x4){0.f, 0.f, 0.f, 0.f}; fr[j] = *(const LAS bf16x8*)(Rb - 16 * j); }
        const char* ub = (const char*)(Uin + pos0); const unsigned ulo = (unsigned)((i * SPB + 8 * g) * 2);
        constexpr int PF = (HJ >= 4) ? 4 : 1;
        bf16x8 bq[PF];
#pragma unroll
        for (int p = 0; p < PF; ++p) bq[p] = *(const GAS bf16x8*)(ub + (size_t)(ulo + (unsigned)p * 64u));
#pragma unroll 1
        for (int q = 0; q < NSTEP / HJ; ++q) {
#pragma unroll
            for (int m = 0; m < HJ; ++m) {
                const int n = q * HJ + m;
                const int nn = (n + PF < NSTEP) ? n + PF : 0;
                if (n > 0) { fr[(J - 2 * m) % J] = *(const LAS bf16x8*)(Rb + 32 * n); fr[(J + 1 - 2 * m) % J] = *(const LAS bf16x8*)(Rb + 32 * n - 16); }
                const bf16x8 bcur = bq[m % PF];
#pragma unroll
                for (int jj = 0; jj < J; ++jj) { const int j = (jj + 2) % J; acc[j] = mfma16(fr[(j + J - 2 * m) % J], bcur, acc[j]); }
                bq[m % PF] = *(const GAS bf16x8*)(ub + (size_t)(ulo + (unsigned)nn * 64u));
            }
        }
#pragma unroll
        for (int j = 0; j < J; ++j) { const int t0 = tb + j * 16 + 4 * g;
            const u32x2 xw = *(const GAS u32x2*)(Xmul + (size_t)i * SPB + pos0 + t0);
            const float y0 = acc[j][0] * bflo(xw.x), y1 = acc[j][1] * bfhi(xw.x), y2 = acc[j][2] * bflo(xw.y), y3 = acc[j][3] * bfhi(xw.y);
            if (!final_out) { u32x2 w; w.x = pk2(y0, y1); w.y = pk2(y2, y3); *(GAS u32x2*)(Zout + (size_t)i * SPB + pos0 + t0) = w; }
            else { u32x2 w; w.x = pk2(y0, y1); w.y = pk2(y2, y3); *(GAS u32x2*)((bf16_t*)(F.ws + WS_Y) + ((size_t)ch * NB + i) * SPB + pos0 + t0) = w; } }
    }
}
__device__ __forceinline__ void ph_hyena(Frame& F, int l, bool last) {
    const bf16_t* HV = (const bf16_t*)(F.ws + WS_HV); bf16_t* Z2 = (bf16_t*)(F.ws + WS_Z2);
    for (int ch = F.wg; ch < 256; ch += F.G) {
        const bf16_t* v = HV + (size_t)(0 * 256 + ch) * NB * SPB; const bf16_t* x1 = HV + (size_t)(256 + ch) * NB * SPB; const bf16_t* x2 = HV + (size_t)(512 + ch) * NB * SPB;
        bf16_t* z = Z2 + (size_t)ch * NB * SPB;
        const bf16_t* R0 = (const bf16_t*)(F.ws + WS_HYF) + ((size_t)(l * 2 + 0) * 256 + ch) * 8192; const bf16_t* R1 = (const bf16_t*)(F.ws + WS_HYF) + ((size_t)(l * 2 + 1) * 256 + ch) * 8192;
        hyena_conv<4096>(F, R0, v, x1, 0, false, ch, z);
        VM_WAIT(); __syncthreads(); __builtin_amdgcn_fence(__ATOMIC_ACQUIRE, "agent"); VM_WAIT();
        hyena_conv<4096>(F, R1, z, x2, 0, true, ch, z);
        if (!last) {
            const bf16_t* C0 = (const bf16_t*)(F.ws + WS_HYFC) + ((size_t)(l * 2 + 0) * 256 + ch) * 512; const bf16_t* C1 = (const bf16_t*)(F.ws + WS_HYFC) + ((size_t)(l * 2 + 1) * 256 + ch) * 512;
            hyena_conv<256>(F, C0, v, x1, SEQ, false, ch, z);
            VM_WAIT(); __syncthreads(); __builtin_amdgcn_fence(__ATOMIC_ACQUIRE, "agent"); VM_WAIT();
            hyena_conv<256>(F, C1, z, x2, SEQ, true, ch, z);
        }
    }
}

__device__ __forceinline__ void ph_ln1(Frame& F, int l, int ntok) {
    const int gw = F.wg * NWAVES + F.wave, NGW = F.G * NWAVES;
    const float* lg = F.in[I_LN1G] + l * DM + 16 * F.lane; const float* lb = F.in[I_LN1B] + l * DM + 16 * F.lane;
    for (int row = gw; row < ntok; row += NGW) {
        bf16_t* xr = (bf16_t*)(F.ws + WS_XR) + (size_t)row * DM + 16 * F.lane;
        const bf16_t* yr = (const bf16_t*)(F.ws + WS_Y) + (size_t)row * DM + 16 * F.lane;
        const float* md = mod_ptr(F, l, row) + 16 * F.lane;
        bf16_t* xm = (bf16_t*)(F.ws + WS_XM) + (size_t)row * DM + 16 * F.lane;
        const u32x4 xa = *(const GAS u32x4*)xr, xb = *(const GAS u32x4*)(xr + 8), ya = *(const GAS u32x4*)yr, yb = *(const GAS u32x4*)(yr + 8);
        float x[16], y[16], v[16]; unpack8(xa, x); unpack8(xb, x + 8); unpack8(ya, y); unpack8(yb, y + 8);
        float s = 0.f;
#pragma unroll
        for (int j = 0; j < 4; ++j) { const f32x4 g1 = *(const GAS f32x4*)(md + 2048 + 4 * j);
#pragma unroll
            for (int e = 0; e < 4; ++e) { v[4 * j + e] = x[4 * j + e] * DN_ALPHA + g1[e] * y[4 * j + e]; s += v[4 * j + e]; } }
        const float mean = wave_sum(s, F.lane) * (1.f / DM); float s2 = 0.f;
#pragma unroll
        for (int e = 0; e < 16; ++e) { v[e] -= mean; s2 += v[e] * v[e]; }
        const float rstd = 1.f / sqrtf(wave_sum(s2, F.lane) * (1.f / DM) + LN_EPS);
        unsigned wx[8], wm[8]; int w8[4];
#pragma unroll
        for (int j = 0; j < 4; ++j) { const f32x4 g = *(const GAS f32x4*)(lg + 4 * j), bb = *(const GAS f32x4*)(lb + 4 * j), sh = *(const GAS f32x4*)(md + 3072 + 4 * j), sc = *(const GAS f32x4*)(md + 4096 + 4 * j);
            float xn[4];
#pragma unroll
            for (int e = 0; e < 4; ++e) xn[e] = v[4 * j + e] * rstd * g[e] + bb[e];
            wx[2 * j] = pk2(xn[0], xn[1]); wx[2 * j + 1] = pk2(xn[2], xn[3]);
            const float h0 = xn[0] * (1.f + sc[0]) + sh[0], h1 = xn[1] * (1.f + sc[1]) + sh[1], h2 = xn[2] * (1.f + sc[2]) + sh[2], h3 = xn[3] * (1.f + sc[3]) + sh[3];
            wm[2 * j] = pk2(h0, h1); wm[2 * j + 1] = pk2(h2, h3);
            int v = 0; v = __builtin_amdgcn_cvt_pk_fp8_f32(h0, h1, v, false); v = __builtin_amdgcn_cvt_pk_fp8_f32(h2, h3, v, true); w8[j] = v; }
        *(GAS u32x4*)((unsigned char*)(F.ws + WS_XM8) + (size_t)row * DM + 16 * F.lane) = (u32x4){(unsigned)w8[0], (unsigned)w8[1], (unsigned)w8[2], (unsigned)w8[3]};
        *(GAS u32x4*)xr = (u32x4){wx[0], wx[1], wx[2], wx[3]}; *(GAS u32x4*)(xr + 8) = (u32x4){wx[4], wx[5], wx[6], wx[7]};
        *(GAS u32x4*)xm = (u32x4){wm[0], wm[1], wm[2], wm[3]}; *(GAS u32x4*)(xm + 8) = (u32x4){wm[4], wm[5], wm[6], wm[7]};
    }
}
__device__ __forceinline__ void ph_ln2(Frame& F, int l, int ntok, bool last) {
    const int gw = F.wg * NWAVES + F.wave, NGW = F.G * NWAVES;
    const float* lg = F.in[I_LN2G] + l * DM; const float* lb = F.in[I_LN2B] + l * DM;
    for (int row = gw; row < ntok; row += NGW) {
        bf16_t* xr = (bf16_t*)(F.ws + WS_XR) + (size_t)row * DM + 16 * F.lane;
        const unsigned char* y2 = (const unsigned char*)(F.ws + WS_Y2) + (size_t)row * 9 * DM + 16 * F.lane;
        const float* wg = (const float*)(F.ws + WS_WGT) + (size_t)row * 8;
        const float* md = mod_ptr(F, l, row) + 16 * F.lane;
        float ff[16];
#pragma unroll
        for (int e = 0; e < 16; ++e) ff[e] = 0.f;
        u32x4 q[9];
#pragma unroll
        for (int k = 0; k < 9; ++k) q[k] = *(const GAS u32x4*)(y2 + (size_t)k * DM);
#pragma unroll
        for (int k = 0; k < 9; ++k) { const float wk = (k < 8 ? wg[k] : 1.0f) * pg8::Y2_INV; const unsigned a[4] = {q[k].x, q[k].y, q[k].z, q[k].w};
#pragma unroll
            for (int e = 0; e < 4; ++e) { const f32x2 lo = __builtin_amdgcn_cvt_pk_f32_fp8((int)a[e], false), hi = __builtin_amdgcn_cvt_pk_f32_fp8((int)a[e], true);
                ff[4 * e] += wk * lo.x; ff[4 * e + 1] += wk * lo.y; ff[4 * e + 2] += wk * hi.x; ff[4 * e + 3] += wk * hi.y; } }
        float v[16], xo[16]; float s = 0.f;
        { const u32x4 xa = *(const GAS u32x4*)xr, xb = *(const GAS u32x4*)(xr + 8); unpack8(xa, xo); unpack8(xb, xo + 8); }
#pragma unroll
        for (int j = 0; j < 4; ++j) { const f32x4 g2 = *(const GAS f32x4*)(md + 5120 + 4 * j);
#pragma unroll
            for (int e = 0; e < 4; ++e) { v[4 * j + e] = xo[4 * j + e] * DN_ALPHA + g2[e] * ff[4 * j + e]; s += v[4 * j + e]; } }
        const float mean = wave_sum(s, F.lane) * (1.f / DM); float s2 = 0.f;
#pragma unroll
        for (int e = 0; e < 16; ++e) { v[e] -= mean; s2 += v[e] * v[e]; }
        const float rstd = 1.f / sqrtf(wave_sum(s2, F.lane) * (1.f / DM) + LN_EPS);
        const float* mdn = (last ? mod_ptr(F, l, row) : mod_ptr(F, l + 1, row)) + 16 * F.lane;
        bf16_t* xm = (bf16_t*)(F.ws + WS_XM) + (size_t)row * DM + 16 * F.lane;
        float xn[16];
#pragma unroll
        for (int j = 0; j < 4; ++j) { const f32x4 g = *(const GAS f32x4*)(lg + 16 * F.lane + 4 * j), bb = *(const GAS f32x4*)(lb + 16 * F.lane + 4 * j);
#pragma unroll
            for (int e = 0; e < 4; ++e) xn[4 * j + e] = v[4 * j + e] * rstd * g[e] + bb[e]; }
        if (last) { float* op = F.out + (size_t)row * DM + 16 * F.lane;
#pragma unroll
            for (int j = 0; j < 4; ++j) *(GAS f32x4*)(op + 4 * j) = (f32x4){xn[4 * j], xn[4 * j + 1], xn[4 * j + 2], xn[4 * j + 3]}; }
        else { *(GAS u32x4*)xr = (u32x4){pk2(xn[0], xn[1]), pk2(xn[2], xn[3]), pk2(xn[4], xn[5]), pk2(xn[6], xn[7])}; *(GAS u32x4*)(xr + 8) = (u32x4){pk2(xn[8], xn[9]), pk2(xn[10], xn[11]), pk2(xn[12], xn[13]), pk2(xn[14], xn[15])}; }
        if (!last) {
            unsigned w[8];
#pragma unroll
            for (int j = 0; j < 4; ++j) { const f32x4 sh = *(const GAS f32x4*)(mdn + 4 * j), sc = *(const GAS f32x4*)(mdn + 1024 + 4 * j);
                w[2 * j] = pk2(xn[4 * j] * (1.f + sc[0]) + sh[0], xn[4 * j + 1] * (1.f + sc[1]) + sh[1]); w[2 * j + 1] = pk2(xn[4 * j + 2] * (1.f + sc[2]) + sh[2], xn[4 * j + 3] * (1.f + sc[3]) + sh[3]); }
            *(GAS u32x4*)xm = (u32x4){w[0], w[1], w[2], w[3]}; *(GAS u32x4*)(xm + 8) = (u32x4){w[4], w[5], w[6], w[7]};
        }
    }
}

__device__ __forceinline__ unsigned f_ord(float f) { const unsigned u = __builtin_bit_cast(unsigned, f); return (u & 0x80000000u) ? ~u : (u | 0x80000000u); }
__device__ __forceinline__ unsigned long long wave_max_u64(unsigned long long v, int lane) {
#pragma unroll
    for (int o = 1; o < 64; o <<= 1) { const unsigned lo = (unsigned)shxi((int)(unsigned)v, o, lane), hi = (unsigned)shxi((int)(unsigned)(v >> 32), o, lane); const unsigned long long w = ((unsigned long long)hi << 32) | lo; v = w > v ? w : v; }
    return v;
}
__device__ __forceinline__ float seg16_max(float v, int lane) { v = fmaxf(v, shx(v, 1, lane)); v = fmaxf(v, shx(v, 2, lane)); v = fmaxf(v, shx(v, 4, lane)); v = fmaxf(v, shx(v, 8, lane)); return v; }
__device__ __forceinline__ int seg16_min_i(int v, int lane) { int w; w = shxi(v, 1, lane); v = w < v ? w : v; w = shxi(v, 2, lane); v = w < v ? w : v; w = shxi(v, 4, lane); v = w < v ? w : v; w = shxi(v, 8, lane); v = w < v ? w : v; return v; }
__device__ __forceinline__ float seg16_top2(float v, int lane) {
    const float m1 = seg16_max(v, lane);
    const int first = seg16_min_i(v == m1 ? (lane & 15) : 99, lane);
    const float m2 = seg16_max((lane & 15) == first ? -3.0e38f : v, lane);
    return m1 + m2;
}
__device__ __forceinline__ void ph_route(Frame& F, int l, int ntok) {
    LAS int* hist = (LAS int*)F.lds;
    LAS int* base = hist + 128;
    LAS unsigned* alist = (LAS unsigned*)(F.lds + 1024);
    const int tpw = (ntok + F.G - 1) / F.G, t0 = F.wg * tpw, t1 = (t0 + tpw) < ntok ? (t0 + tpw) : ntok;
    __syncthreads();
    if (F.tid < 128) hist[F.tid] = 0;
    __syncthreads();
    const float* LG = (const float*)(F.ws + WS_LOGIT); const float* rb = F.in[I_RB] + l * NEXP;
    const float b0 = rb[F.lane], b1 = rb[F.lane + 64];
    for (int tok = t0 + F.wave; tok < t1; tok += NWAVES) {
        const float x0 = LG[(size_t)tok * 256 + F.lane], x1 = LG[(size_t)tok * 256 + 64 + F.lane];
        const float s0 = 1.0f / (1.0f + __expf(-x0)), s1 = 1.0f / (1.0f + __expf(-x1));
        const float e0 = s0 + b0, e1 = s1 + b1;
        const float gs0 = seg16_top2(e0, F.lane), gs1 = seg16_top2(e1, F.lane);
        float gsc[8];
#pragma unroll
        for (int g = 0; g < 4; ++g) { gsc[g] = shf(gs0, g * 16); gsc[4 + g] = shf(gs1, g * 16); }
        unsigned gmask = 0u;
#pragma unroll
        for (int g = 0; g < 8; ++g) { int cnt = 0;
#pragma unroll
            for (int g2 = 0; g2 < 8; ++g2) cnt += (gsc[g2] > gsc[g] || (gsc[g2] == gsc[g] && g2 < g)) ? 1 : 0;
            gmask |= (cnt < 4) ? (1u << g) : 0u; }
        const bool ok0 = (gmask >> (F.lane >> 4)) & 1u, ok1 = (gmask >> (4 + (F.lane >> 4))) & 1u;
        unsigned long long k0 = ok0 ? (((unsigned long long)f_ord(e0) << 32) | (unsigned)(255 - F.lane)) : 0ull;
        unsigned long long k1 = ok1 ? (((unsigned long long)f_ord(e1) << 32) | (unsigned)(255 - 64 - F.lane)) : 0ull;
        int mye = 0; float myw = 0.f; float wsum = 0.f;
#pragma unroll
        for (int k = 0; k < 8; ++k) {
            const unsigned long long best = wave_max_u64(k0 > k1 ? k0 : k1, F.lane);
            const int e = 255 - (int)(best & 0xffu);
            if (k0 == best) k0 = 0ull; if (k1 == best) k1 = 0ull;
            const float sv = shf(e < 64 ? s0 : s1, e & 63);
            wsum += sv; if (F.lane == k) { mye = e; myw = sv; }
        }
        if (F.lane < 8) {
            const int lr = __hip_atomic_fetch_add(&hist[mye], 1, __ATOMIC_RELAXED, __HIP_MEMORY_SCOPE_WORKGROUP);
            alist[(tok - t0) * 8 + F.lane] = (unsigned)mye | ((unsigned)lr << 8);
            ((int*)(F.ws + WS_EIDX))[(size_t)tok * 8 + F.lane] = mye;
            ((float*)(F.ws + WS_WGT))[(size_t)tok * 8 + F.lane] = myw / wsum * 2.5f;
        }
    }
    __syncthreads();
    if (F.tid < 128) { const int hcount = hist[F.tid]; base[F.tid] = hcount ? (int)atomicAdd(F.ctl + CW_CNT + l * 256 + F.tid, (unsigned)hcount) : 0; }
    __syncthreads();
    for (int a = F.tid; a < (t1 - t0) * 8; a += NTHR) { const unsigned v = alist[a]; ((int*)(F.ws + WS_RNK))[(size_t)t0 * 8 + a] = base[v & 0xffu] + (int)(v >> 8); }
}
__device__ __forceinline__ void ph_positions(Frame& F, int l, int ntok) {
    LAS int* cnt = (LAS int*)F.lds;
    LAS int* off = cnt + 132;
    __syncthreads();
    if (F.tid < NE1) cnt[F.tid] = F.tid < NEXP ? (int)__hip_atomic_load(F.ctl + CW_CNT + l * 256 + F.tid, __ATOMIC_RELAXED, __HIP_MEMORY_SCOPE_AGENT) : ntok;
    __syncthreads();
    if (F.tid == 0) { int o = 0; for (int e = 0; e < NE1; ++e) { off[e] = o; o += (cnt[e] + 255) & ~255; } off[NE1] = o; }
    __syncthreads();
    const int gt = F.wg * NTHR + F.tid, NGT = F.G * NTHR;
    int* rowtok = (int*)(F.ws + WS_ROWTOK); int* rowdst = (int*)(F.ws + WS_ROWDST); int* tile_exp = (int*)(F.ws + WS_TILEEXP);
    const int* eidx = (const int*)(F.ws + WS_EIDX); const int* rnk = (const int*)(F.ws + WS_RNK);
    for (int a = gt; a < ntok * 8; a += NGT) { const int tok = a >> 3, k = a & 7; const int pos = off[eidx[a]] + rnk[a]; rowtok[pos] = tok; rowdst[pos] = tok * 9 + k; }
    for (int tok = gt; tok < ntok; tok += NGT) { const int pos = off[NEXP] + tok; rowtok[pos] = tok; rowdst[pos] = tok * 9 + 8; }
    for (int i = gt; i < NE1 * 256; i += NGT) { const int e = i >> 8, p = i & 255; const int row = off[e] + cnt[e] + p; if (row < off[e + 1]) { rowtok[row] = 0; rowdst[row] = -1; } }
    for (int i = gt; i < NE1 * 320; i += NGT) { const int e = i / 320, p = i % 320; const int t = (off[e] >> 8) + p; if (t < (off[e + 1] >> 8)) tile_exp[t] = e; }
    if (gt == 0) F.ctl[CW_NTL + l] = (unsigned)(off[NE1] >> 8);
}

#ifndef MK_MULTI
#define MK_MULTI 0
#endif
constexpr int PH_PER_LAYER = 12, NPHASE = 2 + DEPTH * PH_PER_LAYER;
struct Args { const float* in[36]; float* out; unsigned char* ws; int ph_lo, ph_hi; };

__global__ void __launch_bounds__(NTHR, 2) mk_fwd(Args args) {
    extern __shared__ __attribute__((aligned(16))) unsigned char lds_raw[];
    Frame F;
    F.lds = (LAS unsigned char*)lds_raw;
    F.tid = threadIdx.x; F.lane = F.tid & 63; F.wave = __builtin_amdgcn_readfirstlane(F.tid >> 6);
    const int wave0 = F.wave;
    F.G = gridDim.x; F.wg = blockIdx.x;
    F.in = args.in;
    F.out = args.out; F.ws = args.ws; F.ctl = (unsigned*)(args.ws + WS_CTL);
    volatile LAS unsigned* MISC = (volatile LAS unsigned*)(F.lds + MISC_OFF);
    if (F.tid < 32) MISC[F.tid] = 0u;
    __syncthreads();
    const int lo = args.ph_lo, hi = args.ph_hi;
    const bool single = (hi - lo) > 1;
    XcdBarrier bar; bar.bar = F.ctl + CW_BAR; bar.x = 0; bar.st = nullptr;
    if (single) bar = xcd_barrier_post(F.ctl + CW_BAR, MISC + 8);
#define IN(k) (lo <= (k) && (k) < hi)
#ifndef PROBE_MASK
#define PROBE_MASK 0
#endif
#define REP(k) for (int _rep = 0; _rep < (((PROBE_MASK >> (k)) & 1) ? 2 : 1); ++_rep)
#define SEAM(k) do { if (IN(k) && IN((k) + 1)) xcd_barrier(bar); } while (0)
#define FRESH() do { int _ln; asm volatile("v_mbcnt_lo_u32_b32 %0, -1, 0\n\tv_mbcnt_hi_u32_b32 %0, -1, %0" : "=v"(_ln)); int _wv = wave0; asm volatile("" : "+s"(_wv)); F.lane = _ln; F.wave = _wv; F.tid = (_wv << 6) | _ln; \
        unsigned char* _w = args.ws; asm volatile("" : "+s"(_w)); F.ws = _w; F.ctl = (unsigned*)(_w + WS_CTL); float* _o = args.out; asm volatile("" : "+s"(_o)); F.out = _o; } while (0)

    if (IN(0)) { FRESH(); p0_static_weights(F); __syncthreads(); p0_mod(F); __syncthreads(); p0_hyena_filters(F); }
    SEAM(0);
    if (IN(1)) { FRESH(); p0_init_rows(F); }
    SEAM(1);
#pragma unroll 1
    for (int l = 0; l < DEPTH; ++l) {
        const int pb = 2 + l * PH_PER_LAYER; const bool last = (l == DEPTH - 1); const int ntok = last ? NLAT : NROW;
        if (IN(pb + 0)) { FRESH();
            REP(0) { p_expert_weights(F, l); __syncthreads(); }
            pg8::DenseOrder S; S.init(NROW, DIN, F.G, F.wg); pg8::EpiBf16 E{(bf16_t*)(F.ws + WS_U), DIN};
            REP(1) pg8::gemm_phase<pg8::EpiBf16, pg8::DenseOrder, false>(F.tid, F.lds, (const bf16_t*)(F.ws + WS_XM), (const bf16_t*)(F.ws + WS_WIN) + (size_t)l * DIN * DM, DM, nullptr, S, E);
        }
        SEAM(pb + 0);
        if (IN(pb + 1)) { FRESH(); REP(2) { ph_transposes(F, l); __syncthreads(); } REP(3) { ph_gla_local(F, l); __syncthreads(); } }
        SEAM(pb + 1);
        if (IN(pb + 2)) { FRESH(); REP(4) { ph_na(F, l, last); } REP(5) { ph_gla_scan(F); } __syncthreads(); REP(6) { ph_hyena(F, l, last); } }
        SEAM(pb + 2);
        if (IN(pb + 3)) { FRESH(); ph_hy_transpose(F, last); __syncthreads(); REP(7) { ph_gla_out(F, l, last); } }
        SEAM(pb + 3);
        if (IN(pb + 4)) { FRESH();
            pg8::DenseOrder S; S.init(ntok, DM, F.G, F.wg); pg8::EpiBf16 E{(bf16_t*)(F.ws + WS_Y), DM};
            REP(8) pg8::gemm_phase<pg8::EpiBf16, pg8::DenseOrder, false>(F.tid, F.lds, (const bf16_t*)(F.ws + WS_MIX), (const bf16_t*)(F.ws + WS_WOUT) + (size_t)l * DM * DM, DM, nullptr, S, E);
        }
        SEAM(pb + 4);
        if (IN(pb + 5)) { FRESH(); ph_ln1(F, l, ntok); }
        SEAM(pb + 5);
        if (IN(pb + 6)) { FRESH();
            pg8::DenseOrder S; S.init(ntok, 256, F.G, F.wg); pg8::EpiF32 E{(float*)(F.ws + WS_LOGIT), 256};
            REP(9) pg8::gemm_phase<pg8::EpiF32, pg8::DenseOrder, false>(F.tid, F.lds, (const bf16_t*)(F.ws + WS_XM), (const bf16_t*)(F.ws + WS_WR) + (size_t)l * 256 * DM, DM, nullptr, S, E);
        }
        SEAM(pb + 6);
        if (IN(pb + 7)) { FRESH(); ph_route(F, l, ntok); }
        SEAM(pb + 7);
        if (IN(pb + 8)) { FRESH(); REP(12) { ph_positions(F, l, ntok); __syncthreads(); } }
        SEAM(pb + 8);
        if (IN(pb + 9)) { FRESH();
            const int ntl = (int)__hip_atomic_load(F.ctl + CW_NTL + l, __ATOMIC_RELAXED, __HIP_MEMORY_SCOPE_AGENT);
            pg8::GroupedOrder S; S.init((const int*)(F.ws + WS_TILEEXP), ntl, 2, F.G, F.wg); pg8::EpiSwiglu E{(unsigned char*)(F.ws + WS_ACT)};
            REP(10) pg8::gemm_phase<pg8::EpiSwiglu, pg8::GroupedOrder, true, true>(F.tid, F.lds, (const void*)(F.ws + WS_XM8), (const void*)(F.ws + WS_EXP1), DM, (const int*)(F.ws + WS_ROWTOK), S, E);
        }
        SEAM(pb + 9);
        if (IN(pb + 10)) { FRESH();
            const int ntl = (int)__hip_atomic_load(F.ctl + CW_NTL + l, __ATOMIC_RELAXED, __HIP_MEMORY_SCOPE_AGENT);
            pg8::GroupedOrder S; S.init((const int*)(F.ws + WS_TILEEXP), ntl, 4, F.G, F.wg); pg8::EpiScatter E{(unsigned char*)(F.ws + WS_Y2), (const int*)(F.ws + WS_ROWDST)};
            REP(11) pg8::gemm_phase<pg8::EpiScatter, pg8::GroupedOrder, false, true>(F.tid, F.lds, (const void*)(F.ws + WS_ACT), (const void*)(F.ws + WS_EXP2), EH, nullptr, S, E);
        }
        SEAM(pb + 10);
        if (IN(pb + 11)) { FRESH(); ph_ln2(F, l, ntok, last); }
        SEAM(pb + 11);
    }
#undef IN
#undef SEAM
#undef FRESH
}

extern "C" void kernel_launch(void* const* d_in, const int* in_sizes, int n_in, void* d_out, int out_size, void* d_ws, size_t ws_size, hipStream_t stream) {
    static int grid = 0;
    if (grid == 0) {
        if (n_in != 36 || out_size != NLAT * DM || ws_size < WS_END) { fprintf(stderr, "kernel_launch: unexpected shapes (n_in %d out %d ws %zu need %zu)\n", n_in, out_size, ws_size, (size_t)WS_END); grid = -1; return; }
        int dev = 0, cus = 0, per_cu = 0;
        if (hipGetDevice(&dev) != hipSuccess || hipDeviceGetAttribute(&cus, hipDeviceAttributeMultiprocessorCount, dev) != hipSuccess) { grid = -1; return; }
        if (hipFuncSetAttribute((const void*)mk_fwd, hipFuncAttributeMaxDynamicSharedMemorySize, LDS_BYTES) != hipSuccess) { fprintf(stderr, "kernel_launch: hipFuncSetAttribute failed\n"); grid = -1; return; }
        if (hipOccupancyMaxActiveBlocksPerMultiprocessor(&per_cu, (const void*)mk_fwd, NTHR, LDS_BYTES) != hipSuccess || per_cu < 1) { fprintf(stderr, "kernel_launch: occupancy query says %d\n", per_cu); }
        (void)hipGetLastError();
        grid = cus;
    }
    if (grid < 0) return;
    (void)hipMemsetAsync((char*)d_ws + WS_CTL, 0, CTL_BYTES, stream);
    Args a{};
    for (int i = 0; i < 36; ++i) a.in[i] = (const float*)d_in[i];
    a.out = (float*)d_out; a.ws = (unsigned char*)d_ws;
#if MK_MULTI
    for (int p = 0; p < NPHASE; ++p) { a.ph_lo = p; a.ph_hi = p + 1; hipLaunchKernelGGL(mk_fwd, dim3(grid), dim3(NTHR), LDS_BYTES, stream, a); }
#else
    a.ph_lo = 0; a.ph_hi = NPHASE; hipLaunchKernelGGL(mk_fwd, dim3(grid), dim3(NTHR), LDS_BYTES, stream, a);
#endif
}
```

```cpp
#include <hip/hip_runtime.h>
#include <cstdio>
#include <cstdint>

#define LAS __attribute__((address_space(3)))
#define GAS __attribute__((address_space(1)))
typedef unsigned short bf16_t;
typedef short bf16x8 __attribute__((ext_vector_type(8)));
typedef float f32x4 __attribute__((ext_vector_type(4)));
typedef float f32x2 __attribute__((ext_vector_type(2)));
typedef unsigned u32x4 __attribute__((ext_vector_type(4)));
typedef unsigned u32x2 __attribute__((ext_vector_type(2)));

constexpr int NB = 16, SEQ = 4096, CTXL = 256, DM = 1024, DEPTH = 4;
constexpr int NLAT = NB * SEQ;
constexpr int NCTX = NB * CTXL;
constexpr int NROW = NLAT + NCTX;
constexpr int SPB = SEQ + CTXL;
constexpr int DIN_REF = 3104;
constexpr int DIN = 3328;
constexpr int UQ = 0, UK = 512, UV = 1024, UGQ = 1536, UGK = 1664, UGV = 1792, UGR = 2048, UHY = 2304, ULAF = 3072, ULAB = 3200;
constexpr int NEXP = 128, TOPK = 8, EH = 256;
constexpr int NE1 = NEXP + 1;
constexpr int RMAX = 659712;
constexpr int TMAX = RMAX / 256;
constexpr float LN_EPS = 1e-6f;
constexpr float DN_ALPHA = 1.6817928305074290f;

__device__ __forceinline__ unsigned f2bf(float f) { unsigned u = __builtin_bit_cast(unsigned, f); return (u + 0x7fffu + ((u >> 16) & 1u)) >> 16; }
typedef __bf16 bf16v2 __attribute__((ext_vector_type(2)));
__device__ __forceinline__ unsigned pk2(float lo, float hi) { const f32x2 v = {lo, hi}; const bf16v2 b = __builtin_convertvector(v, bf16v2); return __builtin_bit_cast(unsigned, b); }
__device__ __forceinline__ float bf2f(unsigned short b) { return __builtin_bit_cast(float, ((unsigned)b) << 16); }
__device__ __forceinline__ float bflo(unsigned w) { return __builtin_bit_cast(float, w << 16); }
__device__ __forceinline__ float bfhi(unsigned w) { return __builtin_bit_cast(float, w & 0xffff0000u); }
__device__ __forceinline__ float shx(float v, int o, int lane) { return __builtin_bit_cast(float, __builtin_amdgcn_ds_bpermute((lane ^ o) << 2, __builtin_bit_cast(int, v))); }
__device__ __forceinline__ int shxi(int v, int o, int lane) { return __builtin_amdgcn_ds_bpermute((lane ^ o) << 2, v); }
__device__ __forceinline__ float shf(float v, int src) { return __builtin_bit_cast(float, __builtin_amdgcn_ds_bpermute(src << 2, __builtin_bit_cast(int, v))); }
__device__ __forceinline__ float wave_sum(float v, int lane) {
#pragma unroll
    for (int o = 1; o < 64; o <<= 1) v += shx(v, o, lane);
    return v;
}
__device__ __forceinline__ void unpack8(const u32x4 q, float* o) { o[0] = bflo(q.x); o[1] = bfhi(q.x); o[2] = bflo(q.y); o[3] = bfhi(q.y); o[4] = bflo(q.z); o[5] = bfhi(q.z); o[6] = bflo(q.w); o[7] = bfhi(q.w); }
__device__ __forceinline__ float silu_f(float x) { return x / (1.0f + __expf(-x)); }
#define LDS_WAIT() asm volatile("s_waitcnt lgkmcnt(0)" ::: "memory")
#define VM_WAIT() asm volatile("s_waitcnt vmcnt(0)" ::: "memory")

#define XB_TMO      128
#define XB_XCNT(j)  (256  + 64 * (j))
#define XB_XSUB(j)  (1280 + 64 * (j))
#define XB_XGEN(j)  (2304 + 64 * (j))
#define XB_TOP      3328
#define XB_TOPGEN   3392
#define XCD_BAR_WORDS 3456
#define XB_SPIN_CAP (1u << 18)

__device__ __forceinline__ unsigned xb_ld(unsigned* p)              { return __hip_atomic_load(p, __ATOMIC_RELAXED, __HIP_MEMORY_SCOPE_AGENT); }
__device__ __forceinline__ unsigned xb_add(unsigned* p, unsigned v) { return __hip_atomic_fetch_add(p, v, __ATOMIC_RELAXED, __HIP_MEMORY_SCOPE_AGENT); }
__device__ __forceinline__ unsigned xb_xcc_id() { return (unsigned)__builtin_amdgcn_s_getreg((3 << 11) | 20) & 0xFu; }
#define XB_SPIN(cond, bar) do { unsigned _sp = 0; while (cond) { __builtin_amdgcn_s_sleep(1); \
    if ((++_sp & 255u) == 0u) { if (xb_ld(&(bar)[XB_TMO])) break; if (_sp > XB_SPIN_CAP) { atomicAdd(&(bar)[XB_TMO], 1u); break; } } } } while (0)

struct XcdBarrier { unsigned* bar; unsigned x; volatile LAS unsigned* st; };

__device__ __forceinline__ XcdBarrier xcd_barrier_post(unsigned* bar, volatile LAS unsigned* st) {
    XcdBarrier b; b.bar = bar; b.x = xb_xcc_id(); b.st = st;
    if (threadIdx.x == 0) (void)xb_add(&bar[XB_XCNT(b.x)], 1u);
    return b;
}
__device__ __forceinline__ void xcd_barrier_complete(unsigned* bar, unsigned x, unsigned& nloc, unsigned& nx) {
    const unsigned G = gridDim.x * gridDim.y * gridDim.z;
    unsigned sum, cnt, mine, sp = 0u;
    for (;;) {
        sum = 0u; cnt = 0u; mine = 0u;
#pragma unroll
        for (unsigned j = 0; j < 16; ++j) { const unsigned c = xb_ld(&bar[XB_XCNT(j)]); sum += c; cnt += (c > 0u) ? 1u : 0u; mine = (j == x) ? c : mine; }
        if (sum == G) break;
        __builtin_amdgcn_s_sleep(1);
        if ((++sp & 255u) == 0u) { if (xb_ld(&bar[XB_TMO])) break; if (sp > XB_SPIN_CAP) { atomicAdd(&bar[XB_TMO], 1u); break; } }
    }
    nloc = mine > 0u ? mine : 1u; nx = cnt > 0u ? cnt : 1u;
}
__device__ __forceinline__ void xcd_barrier(const XcdBarrier& b) {
    asm volatile("s_waitcnt vmcnt(0)" ::: "memory");
    __syncthreads();
    if (threadIdx.x == 0) {
        unsigned* bar = b.bar;
        __builtin_amdgcn_s_waitcnt(0);
        unsigned nloc = b.st[0], nx = b.st[1];
        if (nloc == 0u) { xcd_barrier_complete(bar, b.x, nloc, nx); b.st[0] = nloc; b.st[1] = nx; }
        const unsigned old = xb_add(&bar[XB_XSUB(b.x)], 1u);
        const unsigned gen = old / nloc;
        if (old + 1u == (gen + 1u) * nloc) {
            __builtin_amdgcn_fence(__ATOMIC_RELEASE, "agent");
            asm volatile("s_waitcnt vmcnt(0)" ::: "memory");
            const unsigned og = xb_add(&bar[XB_TOP], 1u);
            const unsigned tg = og / nx;
            if (og + 1u == (tg + 1u) * nx) xb_add(&bar[XB_TOPGEN], 1u);
            else XB_SPIN(xb_ld(&bar[XB_TOPGEN]) == tg, bar);
            __builtin_amdgcn_fence(__ATOMIC_ACQUIRE, "agent");
            xb_add(&bar[XB_XGEN(b.x)], 1u);
            asm volatile("s_waitcnt vmcnt(0)" ::: "memory");
        } else {
            XB_SPIN(xb_ld(&bar[XB_XGEN(b.x)]) == gen, bar);
            __builtin_amdgcn_fence(__ATOMIC_ACQUIRE, "agent");
            asm volatile("s_waitcnt vmcnt(0)" ::: "memory");
        }
    }
    __syncthreads();
}

namespace pg8 {
constexpr int BM = 256, BK = 64, HALF = 128, HTB = HALF * BK * 2, STAGE_BYTES = 8 * HTB, NXCD = 8, WGM = 8;
__host__ __device__ __forceinline__ int lds_byte(int r, int c) { const int st = (r >> 4) * 2 + (c >> 5), rr = r & 15, cc = c & 31, ob = rr * 64 + cc * 2; return st * 1024 + (ob ^ (((ob >> 9) & 1) << 5)); }
__host__ __device__ __forceinline__ void stage_rc(int b, int& R, int& C) { const int st = b / 1024, sb = b % 1024, swz = sb ^ (((sb >> 9) & 1) << 5); R = (st >> 1) * 16 + swz / 64; C = (st & 1) * 32 + (swz % 64) / 2; }
__host__ __device__ __forceinline__ int perm32(int rho) { const int n = rho >> 4, i = rho & 15; return 8 * (i >> 2) + 4 * n + (i & 3); }

struct Unit { int arow0, brow0, orow0, ocol0, aux; };

struct DenseOrder {
    int nM, nN, nwg, G, c;
    __device__ void init(int M, int N, int G_, int c_) { nM = M / BM; nN = N / BM; nwg = nM * nN; G = G_; c = c_; }
    __device__ __forceinline__ bool next(int i, Unit& u) const {
        const long L = (long)i * G + c; if (L >= nwg) return false;
        int wgid = (int)L; { const int q = nwg / NXCD, r = nwg % NXCD, xcd = wgid % NXCD, off = wgid / NXCD; wgid = (xcd < r ? xcd * (q + 1) : r * (q + 1) + (xcd - r) * q) + off; }
        const int nig = WGM * nN, gid = wgid / nig, fm = gid * WGM, gsz = (nM - fm) < WGM ? (nM - fm) : WGM;
        const int pm = fm + ((wgid % nig) % gsz), pn = (wgid % nig) / gsz;
        u.arow0 = pm * BM; u.brow0 = pn * BM; u.orow0 = pm * BM; u.ocol0 = pn * BM; u.aux = 0; return true;
    }
};
struct GroupedOrder {
    const LAS unsigned char* tab; int nN, nslot, slot, t0, t1;
    __device__ __forceinline__ void init(int ntiles, int nN_, int G, int c) {
        nN = nN_;
        if ((G & 7) == 0) { const int per = (ntiles + 7) >> 3, x = c & 7; nslot = G >> 3; slot = c >> 3; t0 = x * per; t1 = (t0 + per) < ntiles ? (t0 + per) : ntiles; }
        else { nslot = G; slot = c; t0 = 0; t1 = ntiles; }
    }
    __device__ __forceinline__ void preload(const int* tile_exp, LAS unsigned char* lds_tab, int tid, int nthr) {
        __syncthreads();
        for (int i = tid; i < t1 - t0; i += nthr) lds_tab[i] = (unsigned char)tile_exp[t0 + i];
        __syncthreads();
        tab = lds_tab;
    }
    __device__ __forceinline__ bool next(int i, Unit& u) const {
        const int q = i * nslot + slot, t = t0 + q / nN, pn = q % nN;
        if (t >= t1) return false;
        const int e = (int)tab[t - t0];
        u.arow0 = t * BM; u.brow0 = (e * nN + pn) * BM; u.orow0 = t * BM; u.ocol0 = pn * BM; u.aux = e; return true;
    }
};

__device__ __forceinline__ unsigned cvt_pk_bf16(float lo, float hi) { return pk2(lo, hi); }

struct NoPre {};
struct EpiF32 {
    static constexpr bool PERM = false; typedef NoPre Pre;
    __device__ __forceinline__ Pre prefetch(const Unit&, LAS unsigned char*, int, int, int) const { return Pre{}; }
    float* C; int ldc;
    __device__ __forceinline__ void operator()(const f32x4 (&acc)[2][2][4][2], const Unit& u, int wr, int wc, int fr, int fq, const Pre&) const {
        const int row0 = u.orow0 + wr * 64 + fr, col0 = u.ocol0 + wc * 32 + 4 * fq;
#pragma unroll
        for (int ai = 0; ai < 2; ++ai)
#pragma unroll
            for (int m = 0; m < 4; ++m) { float* rowp = C + (size_t)(row0 + ai * HALF + m * 16) * ldc + col0;
#pragma unroll
                for (int bj = 0; bj < 2; ++bj)
#pragma unroll
                    for (int n = 0; n < 2; ++n) *(f32x4*)(rowp + bj * HALF + n * 16) = acc[ai][bj][m][n]; }
    }
};
struct EpiBf16 {
    static constexpr bool PERM = true; typedef NoPre Pre;
    __device__ __forceinline__ Pre prefetch(const Unit&, LAS unsigned char*, int, int, int) const { return Pre{}; }
    bf16_t* O; int ldc;
    __device__ __forceinline__ void operator()(const f32x4 (&acc)[2][2][4][2], const Unit& u, int wr, int wc, int fr, int fq, const Pre&) const {
        const int row0 = u.orow0 + wr * 64 + fr, col0 = u.ocol0 + wc * 32 + 8 * fq;
#pragma unroll
        for (int ai = 0; ai < 2; ++ai)
#pragma unroll
            for (int m = 0; m < 4; ++m) { bf16_t* rowp = O + (size_t)(row0 + ai * HALF + m * 16) * ldc + col0;
#pragma unroll
                for (int bj = 0; bj < 2; ++bj) { const f32x4 v0 = acc[ai][bj][m][0], v1 = acc[ai][bj][m][1];
                    u32x4 w; w.x = cvt_pk_bf16(v0[0], v0[1]); w.y = cvt_pk_bf16(v0[2], v0[3]); w.z = cvt_pk_bf16(v1[0], v1[1]); w.w = cvt_pk_bf16(v1[2], v1[3]);
                    *(u32x4*)(rowp + bj * HALF) = w; } }
    }
};
struct EpiSwiglu {
    static constexpr bool PERM = true; typedef NoPre Pre;
    __device__ __forceinline__ Pre prefetch(const Unit&, LAS unsigned char*, int, int, int) const { return Pre{}; }
    unsigned char* ACT;
    __device__ __forceinline__ void operator()(const f32x4 (&acc)[2][2][4][2], const Unit& u, int wr, int wc, int fr, int fq, const Pre&) const {
        const int row0 = u.orow0 + wr * 64 + fr, pn = u.ocol0 >> 8;
#pragma unroll
        for (int ai = 0; ai < 2; ++ai)
#pragma unroll
            for (int m = 0; m < 4; ++m) { unsigned char* rowp = ACT + (size_t)(row0 + ai * HALF + m * 16) * EH + pn * 128 + wc * 32 + 8 * fq;
                int w[2];
#pragma unroll
                for (int n = 0; n < 2; ++n) { const f32x4 g = acc[ai][0][m][n], up = acc[ai][1][m][n]; float h[4];
#pragma unroll
                    for (int i = 0; i < 4; ++i) h[i] = g[i] / (1.0f + __expf(-g[i])) * up[i];
                    int v = 0; v = __builtin_amdgcn_cvt_pk_fp8_f32(h[0], h[1], v, false); v = __builtin_amdgcn_cvt_pk_fp8_f32(h[2], h[3], v, true); w[n] = v; }
                *(GAS u32x2*)rowp = (u32x2){(unsigned)w[0], (unsigned)w[1]}; }
    }
};
constexpr float Y2_SCALE = 16.0f, Y2_INV = 1.0f / 16.0f;
struct EpiScatter {
    static constexpr bool PERM = true;
    struct Pre { const LAS int* tab; };
    unsigned char* Y2; const int* rowdst;
    __device__ __forceinline__ Pre prefetch(const Unit& u, LAS unsigned char* lds, int wid, int lane, int ui) const {
        LAS unsigned char* tab = lds + STAGE_BYTES + (ui & 1) * 1024;
        if (wid < 4) __builtin_amdgcn_global_load_lds((const unsigned*)(rowdst + u.orow0 + wid * 64 + lane), (LAS unsigned*)(tab + wid * 256), 4, 0, 0);
        Pre p; p.tab = (const LAS int*)tab; return p; }
    __device__ __forceinline__ void operator()(const f32x4 (&acc)[2][2][4][2], const Unit& u, int wr, int wc, int fr, int fq, const Pre& pre) const {
#pragma unroll
        for (int ai = 0; ai < 2; ++ai)
#pragma unroll
            for (int m = 0; m < 4; ++m) { const int dst = pre.tab[wr * 64 + fr + ai * HALF + m * 16];
                if (dst >= 0) { unsigned char* rowp = Y2 + (size_t)dst * DM + u.ocol0 + wc * 64 + fq * 16;
                    int w[4];
#pragma unroll
                    for (int bj = 0; bj < 2; ++bj) { const f32x4 v0 = acc[ai][bj][m][0] * Y2_SCALE, v1 = acc[ai][bj][m][1] * Y2_SCALE;
                        int w0 = 0, w1 = 0;
                        w0 = __builtin_amdgcn_cvt_pk_fp8_f32(v0[0], v0[1], w0, false); w0 = __builtin_amdgcn_cvt_pk_fp8_f32(v0[2], v0[3], w0, true);
                        w1 = __builtin_amdgcn_cvt_pk_fp8_f32(v1[0], v1[1], w1, false); w1 = __builtin_amdgcn_cvt_pk_fp8_f32(v1[2], v1[3], w1, true);
                        w[2 * bj] = w0; w[2 * bj + 1] = w1; }
                    *(GAS u32x4*)rowp = (u32x4){(unsigned)w[0], (unsigned)w[1], (unsigned)w[2], (unsigned)w[3]}; } }
    }
};

typedef int v8i __attribute__((ext_vector_type(8)));
typedef int v4i __attribute__((ext_vector_type(4)));
struct Frag { bf16x8 p[2]; __device__ __forceinline__ bf16x8& operator[](int k) { return p[k]; } __device__ __forceinline__ const bf16x8& operator[](int k) const { return p[k]; } };
template <class Epi, class Sched, bool GATHER, bool F8 = false, bool ALIGN_EPI = true, bool SP2 = true>
__device__ __forceinline__ void gemm_phase(const int tid_in, LAS unsigned char* lds, const void* Ag, const void* Bg, const int K, const int* rowidx, const Sched& S, const Epi& E) {
    int tid_ = tid_in; asm volatile("" : "+v"(tid_));
    const int tid = tid_, wid = __builtin_amdgcn_readfirstlane(tid >> 6), lane = tid & 63, wr = wid >> 2, wc = wid & 3, fr = lane & 15, fq = lane >> 4;
    const int KB = F8 ? K : 2 * K;
    const int nt = KB / 128;
    unsigned voffB[2];
#pragma unroll
    for (int i = 0; i < 2; ++i) { int R, C; stage_rc(tid * 16 + i * 8192, R, C); const int Rb = Epi::PERM ? ((R & ~31) + perm32(R & 31)) : R;
        voffB[i] = (unsigned)(Rb * KB + C * 2); }
    const size_t kstep = (size_t)128;
    const size_t hstep = (size_t)HALF * KB;
    const unsigned ldsw = (unsigned)wid * 1024u;
    const int aoff = F8 ? lds_byte(wr * 64 + fr, 16 * fq) : lds_byte(wr * 64 + fr, fq * 8), boff = F8 ? lds_byte(wc * 32 + fr, 16 * fq) : lds_byte(wc * 32 + fr, fq * 8);
    constexpr int PIECE1 = F8 ? 16 : 1024;
    const int sc_w = 0x7A7A7A7A, sc_a = 0x7F7F7F7F;
#define PG8_SA(b, h) (((b) * 2 + (h)) * HTB)
#define PG8_SB(b, h) ((4 + (b) * 2 + (h)) * HTB)
#define PG8_STAGE_B(bufoff, gbase) do { _Pragma("unroll") for (int _i = 0; _i < 2; ++_i) \
        __builtin_amdgcn_global_load_lds((const unsigned*)((const char*)(gbase) + voffB[_i]), (LAS unsigned*)(lds + (bufoff) + ldsw + _i * 8192), 16, 0, 0); } while (0)
#define PG8_STAGE_A(bufoff, gbase, h) do { const char* _gb = (const char*)(gbase) + (GATHER ? (size_t)0 : (size_t)(h) * hstep); \
        __builtin_amdgcn_global_load_lds((const unsigned*)(_gb + ac[GATHER ? (h) : 0][0]), (LAS unsigned*)(lds + (bufoff) + ldsw), 16, 0, 0); \
        __builtin_amdgcn_global_load_lds((const unsigned*)(_gb + ac[GATHER ? (h) : 0][1]), (LAS unsigned*)(lds + (bufoff) + ldsw + 8192), 16, 0, 0); } while (0)
#define PG8_LDA(dst, b, h) do { _Pragma("unroll") for (int m = 0; m < 4; ++m) { if constexpr (F8) { const v4i _l = *(const LAS v4i*)(lds + PG8_SA(b, h) + aoff + m * 2048), _h = *(const LAS v4i*)(lds + PG8_SA(b, h) + aoff + m * 2048 + PIECE1); dst##8[m] = __builtin_shufflevector(_l, _h, 0, 1, 2, 3, 4, 5, 6, 7); } \
        else { dst[m][0] = *(const LAS bf16x8*)(lds + PG8_SA(b, h) + aoff + m * 2048); dst[m][1] = *(const LAS bf16x8*)(lds + PG8_SA(b, h) + aoff + m * 2048 + PIECE1); } } } while (0)
#define PG8_LDB(dst, b, h) do { _Pragma("unroll") for (int n = 0; n < 2; ++n) { if constexpr (F8) { const v4i _l = *(const LAS v4i*)(lds + PG8_SB(b, h) + boff + n * 2048), _h = *(const LAS v4i*)(lds + PG8_SB(b, h) + boff + n * 2048 + PIECE1); dst##8[n] = __builtin_shufflevector(_l, _h, 0, 1, 2, 3, 4, 5, 6, 7); } \
        else { dst[n][0] = *(const LAS bf16x8*)(lds + PG8_SB(b, h) + boff + n * 2048); dst[n][1] = *(const LAS bf16x8*)(lds + PG8_SB(b, h) + boff + n * 2048 + PIECE1); } } } while (0)
#define PG8_MMA(ai, bj, At, Bt) do { __builtin_amdgcn_s_setprio(1); _Pragma("unroll") for (int m = 0; m < 4; ++m) _Pragma("unroll") for (int n = 0; n < 2; ++n) { \
        if constexpr (F8) asm volatile("v_mfma_scale_f32_16x16x128_f8f6f4 %0, %1, %2, %0, %3, %4 op_sel_hi:[0,0,0]" : "+v"(acc[ai][bj][m][n]) : "v"(Bt##8[n]), "v"(At##8[m]), "v"(sc_w), "v"(sc_a)); \
        else { _Pragma("unroll") for (int k = 0; k < 2; ++k) acc[ai][bj][m][n] = __builtin_amdgcn_mfma_f32_16x16x32_bf16(Bt[n][k], At[m][k], acc[ai][bj][m][n], 0, 0, 0); } } \
        __builtin_amdgcn_s_setprio(0); } while (0)
#define PG8_WAIT_V(n) asm volatile("s_waitcnt vmcnt(" #n ")" ::: "memory")
#define PG8_WAIT_L(n) asm volatile("s_waitcnt lgkmcnt(" #n ")" ::: "memory")
#define PG8_BAR __builtin_amdgcn_s_barrier()
#define PG8_SCHED __builtin_amdgcn_sched_barrier(0)
#define PG8_TAB(par) (lds + STAGE_BYTES + 2048 + (par) * 1024)
#define PG8_TABLOAD(par, row0) do { if (wid < 4) __builtin_amdgcn_global_load_lds((const unsigned*)(rowidx + (row0) + wid * 64 + lane), (LAS unsigned*)(PG8_TAB(par) + wid * 256), 4, 0, 0); } while (0)
#define PG8_AOFF_H(h, par) do { int _tz = tid; asm volatile("" : "+v"(_tz)); _Pragma("unroll") for (int _i = 0; _i < 2; ++_i) { int _R, _C; stage_rc(_tz * 16 + _i * 8192, _R, _C); \
        if (GATHER) ac[h][_i] = ((const LAS unsigned*)PG8_TAB(par))[(h) * HALF + _R] * (unsigned)KB + (unsigned)_C * 2u; \
        else ac[h][_i] = (unsigned)(((h) * HALF + _R) * KB) + (unsigned)_C * 2u; } } while (0)
    static_assert(SP2, "only the two-super-phase K-loop is kept");
    Unit cur, nxt; int ui = 0;
    if (!S.next(0, cur)) return;
    f32x4 acc[2][2][4][2];
#pragma unroll
    for (int a = 0; a < 2; ++a)
#pragma unroll
        for (int b = 0; b < 2; ++b)
#pragma unroll
            for (int m = 0; m < 4; ++m)
#pragma unroll
                for (int n = 0; n < 2; ++n) acc[a][b][m][n] = (f32x4){0.f, 0.f, 0.f, 0.f};
    bf16x8 At[F8 ? 1 : 4][2], B0[F8 ? 1 : 2][2], B1[F8 ? 1 : 2][2];
    v8i At8[F8 ? 4 : 1], B08[F8 ? 2 : 1], B18[F8 ? 2 : 1];
    unsigned ac[GATHER ? 2 : 1][2];
    if (GATHER) { PG8_TABLOAD(0, cur.arow0); PG8_WAIT_V(0); PG8_BAR; }
    PG8_AOFF_H(0, 0); if (GATHER) { PG8_AOFF_H((GATHER ? 1 : 0), 0); }
    const char* cA = (const char*)Ag + (GATHER ? (size_t)0 : (size_t)cur.arow0 * KB); const char* cB = (const char*)Bg + (size_t)cur.brow0 * KB;
    PG8_STAGE_B(PG8_SB(0, 0), cB); PG8_STAGE_B(PG8_SB(0, 1), cB + hstep); PG8_STAGE_A(PG8_SA(0, 0), cA, 0); PG8_STAGE_A(PG8_SA(0, 1), cA, 1);
    if (wr == 1) PG8_BAR;
    PG8_WAIT_V(2); PG8_BAR;
    PG8_STAGE_B(PG8_SB(1, 0), cB + kstep); PG8_STAGE_A(PG8_SA(1, 0), cA + kstep, 0); PG8_STAGE_B(PG8_SB(1, 1), cB + hstep + kstep);
    PG8_WAIT_V(6); PG8_BAR;
    for (;;) {
        const typename Epi::Pre pre = E.prefetch(cur, lds, wid, lane, ui);
        const bool has_next = S.next(ui + 1, nxt);
        if (GATHER) { if (has_next) PG8_TABLOAD((ui + 1) & 1, nxt.arow0); }
        const char* nA = has_next ? ((const char*)Ag + (GATHER ? (size_t)0 : (size_t)nxt.arow0 * KB)) : cA; const char* nB = has_next ? (const char*)Bg + (size_t)nxt.brow0 * KB : cB;
_Pragma("nounroll")
        for (int t = 0; t < nt; t += 2) {
            const bool last = (t == nt - 2);
            const char* a1 = cA + (size_t)(t + 1) * kstep;
            const char* a2 = last ? nA : cA + (size_t)(t + 2) * kstep; const char* b2 = last ? nB : cB + (size_t)(t + 2) * kstep;
            const char* a3 = a2 + kstep; const char* b3 = b2 + kstep;
            if (GATHER) { if (last && has_next) { PG8_AOFF_H(0, (ui + 1) & 1); } }
            PG8_LDB(B0, 0, 0); PG8_LDB(B1, 0, 1); PG8_SCHED; PG8_LDA(At, 0, 0); PG8_STAGE_A(PG8_SA(1, 1), a1, 1);
            PG8_WAIT_V(8); PG8_WAIT_L(0); PG8_BAR; PG8_MMA(0, 0, At, B0); PG8_MMA(0, 1, At, B1); PG8_BAR; PG8_SCHED;
            if (GATHER) { if (last && has_next) { PG8_AOFF_H(1, (ui + 1) & 1); } }
            PG8_LDA(At, 0, 1); PG8_STAGE_B(PG8_SB(0, 0), b2); PG8_STAGE_B(PG8_SB(0, 1), b2 + hstep); PG8_STAGE_A(PG8_SA(0, 0), a2, 0);
            PG8_WAIT_V(8); PG8_WAIT_L(0); PG8_BAR; PG8_MMA(1, 0, At, B0); PG8_MMA(1, 1, At, B1); PG8_BAR; PG8_SCHED;
            PG8_LDB(B0, 1, 0); PG8_LDB(B1, 1, 1); PG8_SCHED; PG8_LDA(At, 1, 0); PG8_STAGE_A(PG8_SA(0, 1), a2, 1);
            PG8_WAIT_V(8); PG8_WAIT_L(0); PG8_BAR; PG8_MMA(0, 0, At, B0); PG8_MMA(0, 1, At, B1); PG8_BAR; PG8_SCHED;
            PG8_LDA(At, 1, 1); PG8_STAGE_B(PG8_SB(1, 0), b3); PG8_STAGE_B(PG8_SB(1, 1), b3 + hstep); PG8_STAGE_A(PG8_SA(1, 0), a3, 0);
            PG8_WAIT_V(8); PG8_WAIT_L(0); PG8_BAR; PG8_MMA(1, 0, At, B0); PG8_MMA(1, 1, At, B1); PG8_BAR; PG8_SCHED;
        }
        if constexpr (ALIGN_EPI) { if (wr == 0) PG8_BAR; }
        E(acc, cur, wr, wc, fr, fq, pre);
        if (!has_next) break;
#pragma unroll
        for (int a = 0; a < 2; ++a)
#pragma unroll
            for (int b = 0; b < 2; ++b)
#pragma unroll
                for (int m = 0; m < 4; ++m)
#pragma unroll
                    for (int n = 0; n < 2; ++n) acc[a][b][m][n] = (f32x4){0.f, 0.f, 0.f, 0.f};
        cur = nxt; cA = nA; cB = nB; ++ui;
        if constexpr (ALIGN_EPI) { if (wr == 1) PG8_BAR; }
    }
    PG8_WAIT_V(0);
    if constexpr (!ALIGN_EPI) { if (wr == 0) PG8_BAR; }
    PG8_BAR;
#undef PG8_SA
#undef PG8_SB
#undef PG8_STAGE_A
#undef PG8_STAGE_B
#undef PG8_LDA
#undef PG8_LDB
#undef PG8_MMA
#undef PG8_WAIT_V
#undef PG8_WAIT_L
#undef PG8_BAR
#undef PG8_SCHED
#undef PG8_AOFF_H
#undef PG8_TAB
#undef PG8_TABLOAD
}
}

constexpr int NWAVES = 8, NTHR = 512;
constexpr size_t MiB = 1u << 20;
constexpr size_t WS_CTL = 0, CTL_BYTES = 1 * MiB;
constexpr size_t WS_MOD = 1 * MiB;
constexpr size_t WS_WIN = 3 * MiB;
constexpr size_t WS_WOUT = 29 * MiB;
constexpr size_t WS_WR = 37 * MiB;
constexpr size_t WS_HYF = 39 * MiB;
constexpr size_t WS_HYFC = 71 * MiB;
constexpr size_t WS_XC = 73 * MiB;
constexpr size_t WS_EXP1 = 89 * MiB;
constexpr size_t WS_EXP2 = 218 * MiB;
constexpr size_t WS_XM = 283 * MiB;
constexpr size_t WS_EIDX = 419 * MiB;
constexpr size_t WS_WGT = 422 * MiB;
constexpr size_t WS_RNK = 425 * MiB;
constexpr size_t WS_ROWTOK = 428 * MiB;
constexpr size_t WS_ROWDST = 431 * MiB;
constexpr size_t WS_TILEEXP = 434 * MiB;
constexpr size_t WS_BIG = 435 * MiB;
constexpr size_t WS_U = WS_BIG;
constexpr size_t WS_MIX = 877 * MiB;
constexpr size_t WS_VT = 1013 * MiB;
constexpr size_t WS_HV = 1081 * MiB;
constexpr size_t WS_Z2 = 1183 * MiB;
constexpr size_t WS_GDS = 1217 * MiB;
constexpr size_t WS_GSIN = 1285 * MiB;
constexpr size_t WS_GD = 1319 * MiB;
constexpr size_t WS_Y = 1321 * MiB;
constexpr size_t WS_LOGIT = WS_BIG;
constexpr size_t WS_ACT = WS_BIG;
constexpr size_t WS_Y2 = 758 * MiB;
constexpr size_t WS_XM8 = 1470 * MiB;
constexpr size_t WS_XR = 1600 * MiB;
constexpr size_t WS_END = 1736 * MiB;
constexpr int CW_BAR = 4096;
constexpr int CW_CNT = 16384;
constexpr int CW_NTL = 20480;

constexpr int LDS_BYTES = 163840;
constexpr int MISC_OFF = 163584;

struct Frame {
    LAS unsigned char* lds;
    int tid, lane, wave, G, wg;
    const float* const* in;
    float* out; unsigned char* ws; unsigned* ctl;
};
enum { I_X = 0, I_C, I_CTX, I_CCTX, I_WMOD, I_BMOD, I_WIN, I_RPB, I_WA2, I_BA2, I_GNORM, I_HSW, I_HSB, I_HW1, I_HB1, I_HF1, I_HW2, I_HB2, I_HF2, I_HW3, I_HB3, I_HDEC, I_HSKIP,
       I_WOUT, I_LN1G, I_LN1B, I_RW, I_RB, I_WEG, I_WEU, I_WED, I_WSG, I_WSU, I_WSD, I_LN2G, I_LN2B };

__device__ __forceinline__ int row_b(int row) { return row < NLAT ? (row >> 12) : 16; }
__device__ __forceinline__ const float* mod_ptr(const Frame& F, int l, int row) { return (const float*)(F.ws + WS_MOD) + ((size_t)l * 17 + row_b(row)) * 6144; }

template <class RowFn>
__device__ __forceinline__ void tr_item(const float* W, int ldw, int k0, int n0, bf16_t* dst, int ldd, RowFn rf, LAS float* scr, int lane) {
    float tv[32];
    const GAS float* wp = (const GAS float*)(W + (size_t)(k0 + (lane >> 5)) * ldw + n0 + (lane & 31));
#pragma unroll
    for (int i = 0; i < 32; ++i) tv[i] = wp[(size_t)(2 * i) * ldw];
#pragma unroll
    for (int i = 0; i < 32; ++i) scr[(2 * i + (lane >> 5)) * 33 + (lane & 31)] = tv[i];
    LDS_WAIT(); asm volatile("" ::: "memory");
    const int c = lane & 7;
#pragma unroll
    for (int j = 0; j < 4; ++j) { const int n = (lane >> 3) + 8 * j; const LAS float* s = scr + (8 * c) * 33 + n;
        u32x4 o; o.x = pk2(s[0 * 33], s[1 * 33]); o.y = pk2(s[2 * 33], s[3 * 33]); o.z = pk2(s[4 * 33], s[5 * 33]); o.w = pk2(s[6 * 33], s[7 * 33]);
        *(GAS u32x4*)(dst + (size_t)rf(n0 + n) * ldd + k0 + 8 * c) = o; }
    LDS_WAIT(); asm volatile("" ::: "memory");
}
template <class RowFn>
__device__ __forceinline__ void tr_item8(const float* W, int ldw, int k0, int n0, unsigned char* dst, int ldd, RowFn rf, float scale, LAS float* scr, int lane) {
    float tv[32];
    const GAS float* wp = (const GAS float*)(W + (size_t)(k0 + (lane >> 5)) * ldw + n0 + (lane & 31));
#pragma unroll
    for (int i = 0; i < 32; ++i) tv[i] = wp[(size_t)(2 * i) * ldw];
#pragma unroll
    for (int i = 0; i < 32; ++i) scr[(2 * i + (lane >> 5)) * 33 + (lane & 31)] = tv[i];
    LDS_WAIT(); asm volatile("" ::: "memory");
    const int n = lane >> 1, hf = lane & 1; const LAS float* s = scr + (32 * hf) * 33 + n;
    unsigned w[8];
#pragma unroll
    for (int j = 0; j < 8; ++j) { int v = 0; v = __builtin_amdgcn_cvt_pk_fp8_f32(s[(4 * j) * 33] * scale, s[(4 * j + 1) * 33] * scale, v, false); v = __builtin_amdgcn_cvt_pk_fp8_f32(s[(4 * j + 2) * 33] * scale, s[(4 * j + 3) * 33] * scale, v, true); w[j] = (unsigned)v; }
    unsigned char* d = dst + (size_t)rf(n0 + n) * ldd + k0 + 32 * hf;
    *(GAS u32x4*)d = (u32x4){w[0], w[1], w[2], w[3]}; *(GAS u32x4*)(d + 16) = (u32x4){w[4], w[5], w[6], w[7]};
    LDS_WAIT(); asm volatile("" ::: "memory");
}
struct RowId { __device__ __forceinline__ int operator()(int n) const { return n; } };
struct RowWin { __device__ __forceinline__ int operator()(int n) const { return n >= 2336 ? n - 32 : n; } };
struct RowGU { int up; __device__ __forceinline__ int operator()(int j) const { return (j >> 7) * 256 + up * 128 + (j & 127); } };

__device__ __forceinline__ void p0_static_weights(Frame& F) {
    LAS float* scr = (LAS float*)(F.lds + F.wave * 16384);
    const int gw = F.wg * NWAVES + F.wave, NGW = F.G * NWAVES;
    constexpr int I_IN = 16 * 97, I_OUT = 16 * 32, I_R = 16 * 4, PER_L = I_IN + I_OUT + I_R;
    for (int it = gw; it < DEPTH * PER_L; it += NGW) {
        const int l = it / PER_L; int r = it % PER_L;
        if (r < I_IN) { const int kb = r / 97, nb = r % 97; if (nb == 72) continue;
            tr_item(F.in[I_WIN] + (size_t)l * DM * DIN_REF, DIN_REF, kb * 64, nb * 32, (bf16_t*)(F.ws + WS_WIN) + (size_t)l * DIN * DM, DM, RowWin{}, scr, F.lane); continue; }
        r -= I_IN;
        if (r < I_OUT) { const int kb = r / 32, nb = r % 32;
            tr_item(F.in[I_WOUT] + (size_t)l * DM * DM, DM, kb * 64, nb * 32, (bf16_t*)(F.ws + WS_WOUT) + (size_t)l * DM * DM, DM, RowId{}, scr, F.lane); continue; }
        r -= I_OUT;
        { const int kb = r / 4, nb = r % 4;
            tr_item(F.in[I_RW] + (size_t)l * DM * NEXP, NEXP, kb * 64, nb * 32, (bf16_t*)(F.ws + WS_WR) + (size_t)l * 256 * DM, DM, RowId{}, scr, F.lane); }
    }
    const int gt = F.wg * NTHR + F.tid, NGT = F.G * NTHR;
    for (int i = gt; i < DEPTH * 128 * DM / 8; i += NGT) { const int l = i / (128 * DM / 8), r = i % (128 * DM / 8);
        *(u32x4*)((bf16_t*)(F.ws + WS_WR) + ((size_t)l * 256 + 128) * DM + (size_t)r * 8) = (u32x4){0u, 0u, 0u, 0u}; }
    for (int i = gt; i < DEPTH * 256 * DM; i += NGT) {
        const int k = i % DM, n = (i / DM) % 256, l = i / (DM * 256), dir = n >> 7, j = n & 127;
        const float* wi = F.in[I_WIN] + ((size_t)l * DM + k) * DIN_REF + 2304 + dir * 16;
        const float* wa = F.in[I_WA2] + ((size_t)(l * 2 + dir) * 16) * 128 + j;
        float s = 0.f;
#pragma unroll
        for (int r = 0; r < 16; ++r) s += wi[r] * wa[r * 128];
        ((bf16_t*)(F.ws + WS_WIN))[((size_t)l * DIN + 3072 + n) * DM + k] = (bf16_t)f2bf(s);
    }
}
__device__ __forceinline__ void p0_mod(Frame& F) {
    LAS float* sc = (LAS float*)F.lds;
    LAS float* red = (LAS float*)(F.lds + 17 * 1024 * 4);
    for (int i = F.tid; i < 17 * 1024; i += NTHR) { const int r = i >> 10, k = i & 1023; const float v = r < 16 ? F.in[I_C][r * 1024 + k] : F.in[I_CCTX][k]; sc[i] = silu_f(v); }
    __syncthreads();
    const int kq = F.tid >> 7, cl = F.tid & 127;
    for (int u = F.wg; u < DEPTH * 48; u += F.G) {
        const int l = u / 48, col = (u % 48) * 128 + cl;
        const float* w = F.in[I_WMOD] + (size_t)l * DM * 6144 + col;
        float a[17];
#pragma unroll
        for (int r = 0; r < 17; ++r) a[r] = 0.f;
#pragma unroll 4
        for (int k = kq * 256; k < kq * 256 + 256; ++k) { const float wv = w[(size_t)k * 6144];
#pragma unroll
            for (int r = 0; r < 17; ++r) a[r] += sc[r * 1024 + k] * wv; }
#pragma unroll
        for (int r = 0; r < 17; ++r) red[(kq * 17 + r) * 128 + cl] = a[r];
        __syncthreads();
        for (int i = F.tid; i < 17 * 128; i += NTHR) { const int r = i >> 7, c2 = i & 127, cc = (u % 48) * 128 + c2;
            const float s = red[(0 * 17 + r) * 128 + c2] + red[(1 * 17 + r) * 128 + c2] + red[(2 * 17 + r) * 128 + c2] + red[(3 * 17 + r) * 128 + c2] + F.in[I_BMOD][l * 6144 + cc];
            ((float*)(F.ws + WS_MOD))[((size_t)l * 17 + r) * 6144 + cc] = s; }
        __syncthreads();
    }
}
__device__ __forceinline__ void p0_hyena_filters(Frame& F) {
    LAS float* z = (LAS float*)F.lds;
    LAS float* h1 = z + 32 * 33;
    LAS float* h2 = h1 + 32 * 64;
    LAS float* tt = h2 + 32 * 64;
    constexpr int UL = 4096 / 32, UC = 256 / 32, UPL = UL + UC;
    for (int u = F.wg; u < DEPTH * UPL; u += F.G) {
        const int l = u / UPL, r = u % UPL; const bool lat = r < UL; const int L = lat ? 4096 : 256, n0 = (lat ? r : r - UL) * 32;
        __syncthreads();
        for (int i = F.tid; i < 32 * 33; i += NTHR) { const int p = i / 33, e = i % 33, n = n0 + p;
            const float t = (float)n / (float)(L - 1);
            float v;
            if (e == 0) v = t;
            else { const int kb = (e - 1) & 15; const float band = 1e-4f + (float)kb * ((15.0f - 1e-4f) / 15.0f);
                   const float w = 6.283185307179586f * (float)n / (float)L; const float ang = w * band;
                   v = e <= 16 ? __cosf(ang) : -__sinf(ang); }
            z[i] = v; if (e == 0) tt[p] = t; }
        __syncthreads();
        for (int i = F.tid; i < 32 * 64; i += NTHR) { const int p = i >> 6, j = i & 63; float s = F.in[I_HB1][l * 64 + j];
            for (int e = 0; e < 33; ++e) s += z[p * 33 + e] * F.in[I_HW1][((size_t)l * 33 + e) * 64 + j];
            h1[i] = __sinf(F.in[I_HF1][l * 64 + j] * s); }
        __syncthreads();
        for (int i = F.tid; i < 32 * 64; i += NTHR) { const int p = i >> 6, j = i & 63; float s = F.in[I_HB2][l * 64 + j];
            for (int e = 0; e < 64; ++e) s += h1[p * 64 + e] * F.in[I_HW2][((size_t)l * 64 + e) * 64 + j];
            h2[i] = __sinf(F.in[I_HF2][l * 64 + j] * s); }
        __syncthreads();
#pragma unroll 1
        for (int cc = 0; cc < 2; ++cc) {
            const int col = F.tid + cc * 512, o = col >> 9, dir = (col >> 8) & 1, ch = col & 255;
            float a[32];
#pragma unroll
            for (int p = 0; p < 32; ++p) a[p] = 0.f;
            const float* w3 = F.in[I_HW3] + (size_t)l * 64 * 1024 + col;
            for (int k = 0; k < 64; ++k) { const float wv = w3[(size_t)k * 1024];
#pragma unroll
                for (int p = 0; p < 32; ++p) a[p] += h2[p * 64 + k] * wv; }
            const float b3 = F.in[I_HB3][l * 1024 + col], dec = fabsf(F.in[I_HDEC][((size_t)(l * 2 + o) * 2 + dir) * 256 + ch]);
            const float skip = F.in[I_HSKIP][(l * 2 + o) * 256 + ch];
            bf16_t* R = lat ? (bf16_t*)(F.ws + WS_HYF) + ((size_t)(l * 2 + o) * 256 + ch) * 8192 : (bf16_t*)(F.ws + WS_HYFC) + ((size_t)(l * 2 + o) * 256 + ch) * 512;
#pragma unroll
            for (int p = 0; p < 32; ++p) { const int n = n0 + p; float v = (a[p] + b3) * __expf(-tt[p] * dec);
                if (dir == 0) { if (n == 0) v += skip; R[L - n] = (bf16_t)f2bf(v); }
                else { if (n == 0) R[0] = 0; else R[L + n] = (bf16_t)f2bf(v); } }
        }
    }
    __syncthreads();
}
__device__ __forceinline__ void p0_init_rows(Frame& F) {
    const int gw = F.wg * NWAVES + F.wave, NGW = F.G * NWAVES;
    for (int row = gw; row < NROW; row += NGW) {
        const float* src = row < NLAT ? F.in[I_X] + (size_t)row * DM : F.in[I_CTX] + (size_t)(row - NLAT) * DM;
        const float* md = mod_ptr(F, 0, row);
        bf16_t* xr = (bf16_t*)(F.ws + WS_XR) + (size_t)row * DM; bf16_t* xm = (bf16_t*)(F.ws + WS_XM) + (size_t)row * DM;
#pragma unroll
        for (int j = 0; j < 4; ++j) { const int c = 4 * F.lane + 256 * j;
            const f32x4 v = *(const GAS f32x4*)(src + c), sh = *(const GAS f32x4*)(md + c), sc = *(const GAS f32x4*)(md + 1024 + c);
            *(GAS u32x2*)(xr + c) = (u32x2){pk2(v[0], v[1]), pk2(v[2], v[3])};
            u32x2 w; w.x = pk2(v[0] * (1.f + sc[0]) + sh[0], v[1] * (1.f + sc[1]) + sh[1]); w.y = pk2(v[2] * (1.f + sc[2]) + sh[2], v[3] * (1.f + sc[3]) + sh[3]);
            *(GAS u32x2*)(xm + c) = w; }
    }
}
constexpr float WEXP_SCALE = 32.0f;
__device__ __forceinline__ void p_expert_weights(Frame& F, int l) {
    LAS float* scr = (LAS float*)(F.lds + F.wave * 16384);
    const int gw = F.wg * NWAVES + F.wave, NGW = F.G * NWAVES;
    constexpr int I1 = 16 * 8, I2 = 4 * 32, PER_E = 2 * I1 + I2;
    for (int it = gw; it < NE1 * PER_E; it += NGW) {
        const int e = it / PER_E; int r = it % PER_E;
        unsigned char* d1 = (unsigned char*)(F.ws + WS_EXP1) + (size_t)e * 512 * DM; unsigned char* d2 = (unsigned char*)(F.ws + WS_EXP2) + (size_t)e * DM * EH;
        if (r < 2 * I1) { const int up = r >= I1; if (up) r -= I1; const int kb = r / 8, nb = r % 8;
            const float* src = e < NEXP ? F.in[up ? I_WEU : I_WEG] + ((size_t)l * NEXP + e) * DM * EH : F.in[up ? I_WSU : I_WSG] + (size_t)l * DM * EH;
            tr_item8(src, EH, kb * 64, nb * 32, d1, DM, RowGU{up}, WEXP_SCALE, scr, F.lane); }
        else { r -= 2 * I1; const int kb = r / 32, nb = r % 32;
            const float* src = e < NEXP ? F.in[I_WED] + ((size_t)l * NEXP + e) * EH * DM : F.in[I_WSD] + (size_t)l * EH * DM;
            tr_item8(src, DM, kb * 64, nb * 32, d2, EH, RowId{}, WEXP_SCALE, scr, F.lane); }
    }
}

__device__ __forceinline__ f32x4 mfma16(bf16x8 a, bf16x8 b, f32x4 c) { return __builtin_amdgcn_mfma_f32_16x16x32_bf16(a, b, c, 0, 0, 0); }

__device__ __forceinline__ void ph_transposes(Frame& F, int l) {
    LAS bf16_t* tile = (LAS bf16_t*)(F.lds + F.wave * 16384);
    const bf16_t* U = (const bf16_t*)(F.ws + WS_U);
    const int gw = F.wg * NWAVES + F.wave, NGW = F.G * NWAVES;
    const int rsub = F.lane >> 3, cseg = F.lane & 7;
    for (int u = gw; u < 1088 * 20; u += NGW) {
        const int tt = u / 20, blk = u % 20;
        int b, s0, Ls, rowbase, posbase;
        if (tt < 1024) { b = tt >> 6; s0 = (tt & 63) * 64; Ls = SEQ; rowbase = b * SEQ; posbase = 0; }
        else { const int t2 = tt - 1024; b = t2 >> 2; s0 = (t2 & 3) * 64; Ls = CTXL; rowbase = NLAT + b * CTXL; posbase = SEQ; }
        if (blk < 12) {
            const int c0 = blk * 64 + cseg * 8;
            float w0[8], w1[8], w2[8], bb[8];
#pragma unroll
            for (int i = 0; i < 8; ++i) { w0[i] = F.in[I_HSW][(l * 3 + 0) * 768 + c0 + i]; w1[i] = F.in[I_HSW][(l * 3 + 1) * 768 + c0 + i]; w2[i] = F.in[I_HSW][(l * 3 + 2) * 768 + c0 + i]; bb[i] = F.in[I_HSB][l * 768 + c0 + i]; }
#pragma unroll 2
            for (int it = 0; it < 8; ++it) {
                const int sl = rsub + 8 * it, s = s0 + sl;
                const bf16_t* p = U + (size_t)(rowbase + s) * DIN + UHY + c0;
                const u32x4 zc = *(const u32x4*)p;
                u32x4 zm = (u32x4){0u, 0u, 0u, 0u}, zp = (u32x4){0u, 0u, 0u, 0u};
                if (s > 0) zm = *(const u32x4*)(p - DIN);
                if (s < Ls - 1) zp = *(const u32x4*)(p + DIN);
                const unsigned am[4] = {zm.x, zm.y, zm.z, zm.w}, ac[4] = {zc.x, zc.y, zc.z, zc.w}, ap[4] = {zp.x, zp.y, zp.z, zp.w};
#pragma unroll
                for (int i = 0; i < 4; ++i) {
                    const float v0 = bb[2 * i] + w0[2 * i] * bflo(am[i]) + w1[2 * i] * bflo(ac[i]) + w2[2 * i] * bflo(ap[i]);
                    const float v1 = bb[2 * i + 1] + w0[2 * i + 1] * bfhi(am[i]) + w1[2 * i + 1] * bfhi(ac[i]) + w2[2 * i + 1] * bfhi(ap[i]);
                    tile[(cseg * 8 + 2 * i) * 72 + sl] = (bf16_t)f2bf(v0); tile[(cseg * 8 + 2 * i + 1) * 72 + sl] = (bf16_t)f2bf(v1);
                }
            }
        } else {
            const int c0 = (blk - 12) * 64 + cseg * 8;
#pragma unroll 2
            for (int it = 0; it < 8; ++it) {
                const int sl = rsub + 8 * it, s = s0 + sl;
                const u32x4 zc = *(const u32x4*)(U + (size_t)(rowbase + s) * DIN + UV + c0);
                const unsigned ac[4] = {zc.x, zc.y, zc.z, zc.w};
#pragma unroll
                for (int i = 0; i < 4; ++i) { tile[(cseg * 8 + 2 * i) * 72 + sl] = (bf16_t)(ac[i] & 0xffffu); tile[(cseg * 8 + 2 * i + 1) * 72 + sl] = (bf16_t)(ac[i] >> 16); }
            }
        }
        LDS_WAIT(); asm volatile("" ::: "memory");
#pragma unroll 2
        for (int it = 0; it < 8; ++it) {
            const int ch = rsub + 8 * it;
            const u32x4 v = *(const LAS u32x4*)(tile + ch * 72 + cseg * 8);
            bf16_t* dst;
            if (blk < 12) dst = (bf16_t*)(F.ws + WS_HV) + ((size_t)(blk * 64 + ch) * NB + b) * SPB + posbase + s0 + cseg * 8;
            else dst = (bf16_t*)(F.ws + WS_VT) + ((size_t)b * 512 + (blk - 12) * 64 + ch) * SPB + posbase + s0 + cseg * 8;
            *(u32x4*)dst = v;
        }
        LDS_WAIT(); asm volatile("" ::: "memory");
    }
}

constexpr int NA_RPB = 0, NA_KC = 2048, NA_VC = NA_KC + 256 * 144, NA_KR = NA_VC + 64 * 528, NA_END = NA_KR + 9 * 64 * 144;
static_assert(NA_END <= MISC_OFF, "NA LDS map");
__device__ __forceinline__ bf16x8 gld16(const bf16_t* p) { return *(const GAS bf16x8*)p; }
__device__ __forceinline__ u32x2 gld8(const bf16_t* p) { return *(const GAS u32x2*)p; }
__device__ __forceinline__ const char* uni_ptr(const char* p) { const unsigned long long v = (unsigned long long)p; const unsigned lo = __builtin_amdgcn_readfirstlane((unsigned)v), hi = __builtin_amdgcn_readfirstlane((unsigned)(v >> 32)); return (const char*)(((unsigned long long)hi << 32) | lo); }
__device__ __forceinline__ bf16x8 gld16o(const char* ub, unsigned lo) { return *(const GAS bf16x8*)(ub + (size_t)lo); }
__device__ __forceinline__ u32x2 gld8o(const char* ub, unsigned lo) { return *(const GAS u32x2*)(ub + (size_t)lo); }
template <bool WIN>
__device__ __forceinline__ void na_unit(Frame& F, int b, int h, int r, int strip) {
    const bf16_t* U = (const bf16_t*)(F.ws + WS_U);
    const bf16_t* VT = (const bf16_t*)(F.ws + WS_VT) + ((size_t)b * 512 + h * 64) * SPB;
    const LAS float* rpb = (const LAS float*)(F.lds + NA_RPB);
    const LAS bf16_t* KC = (const LAS bf16_t*)(F.lds + NA_KC); const LAS bf16_t* VC = (const LAS bf16_t*)(F.lds + NA_VC);
    int ln_ = F.lane; asm volatile("" : "+v"(ln_));
    const int i = ln_ & 15, g = ln_ >> 4;
    const int qrow0 = WIN ? (b * SEQ + r * 64 + strip * 16) : (NLAT + b * CTXL + strip * 16);
    const int ki = 8 * (i >> 2) + (i & 3);
    const unsigned qlo = (unsigned)((i * DIN + 8 * g) * 2), klo = (unsigned)((ki * DIN + 8 * g) * 2), vlo = (unsigned)((i * SPB + 8 * g) * 2);
    const char* qb = uni_ptr((const char*)(U + (size_t)qrow0 * DIN + UQ + h * 64));
    const bf16x8 q0 = gld16o(qb, qlo), q1 = gld16o(qb + 64, qlo);
    int kr0 = 0, u0 = 0;
    if (WIN) { kr0 = r - 4; kr0 = kr0 < 0 ? 0 : (kr0 > 56 ? 56 : kr0); u0 = strip == 0 ? 0 : (strip == 1 ? 8 : (strip == 2 ? 24 : 32)); }
    const LAS bf16_t* KR = (const LAS bf16_t*)(F.lds + NA_KR);
    const char* vbase = uni_ptr((const char*)(VT + kr0 * 64 + u0));
    f32x4 o[4];
#pragma unroll
    for (int d = 0; d < 4; ++d) o[d] = (f32x4){0.f, 0.f, 0.f, 0.f};
    float lsum = 0.f;
#define NA_SB() __builtin_amdgcn_sched_barrier(0)
#define NA_WLOAD(vb_, cw) do { _Pragma("unroll") for (int d = 0; d < 4; ++d) vb_[d] = gld16o(vbase + ((size_t)(d * 16) * SPB + (cw) * 64) * 2, vlo); } while (0)
#define NA_KRING(kb_, cw) do { const LAS bf16_t* kp = KR + ((((kr0 + (cw)) % 9) * 64 + u0 + ki) * 72 + 8 * g); kb_[0][0] = *(const LAS bf16x8*)kp; kb_[0][1] = *(const LAS bf16x8*)(kp + 32); \
        kb_[1][0] = *(const LAS bf16x8*)(kp + 4 * 72); kb_[1][1] = *(const LAS bf16x8*)(kp + 4 * 72 + 32); } while (0)
#define NA_QK(kb_, s_) do { _Pragma("unroll") for (int t = 0; t < 2; ++t) { f32x4 a = (f32x4){0.f, 0.f, 0.f, 0.f}; a = mfma16(kb_[t][0], q0, a); a = mfma16(kb_[t][1], q1, a); s_[t] = a; } } while (0)
#define NA_PV(s_, vb_) do { u32x4 pw; pw.x = pk2(s_[0][0], s_[0][1]); pw.y = pk2(s_[0][2], s_[0][3]); pw.z = pk2(s_[1][0], s_[1][1]); pw.w = pk2(s_[1][2], s_[1][3]); const bf16x8 pf = __builtin_bit_cast(bf16x8, pw); \
        _Pragma("unroll") for (int d = 0; d < 4; ++d) o[d] = mfma16(vb_[d], pf, o[d]); } while (0)
    bf16x8 vA[4], vB[4], vC[4];
    if (WIN) { NA_WLOAD(vA, 0); NA_WLOAD(vB, 1); NA_WLOAD(vC, 2); NA_SB(); }
#pragma unroll
    for (int cc = 0; cc < 8; ++cc) {
        bf16x8 kc[2][2], vc[4]; f32x4 sc[2];
#pragma unroll
        for (int t = 0; t < 2; ++t) { const LAS bf16_t* kp = KC + (cc * 32 + ki + 4 * t) * 72 + 8 * g; kc[t][0] = *(const LAS bf16x8*)kp; kc[t][1] = *(const LAS bf16x8*)(kp + 32); }
#pragma unroll
        for (int d = 0; d < 4; ++d) vc[d] = *(const LAS bf16x8*)(VC + (d * 16 + i) * 264 + cc * 32 + 8 * g);
        NA_QK(kc, sc);
#pragma unroll
        for (int t = 0; t < 2; ++t)
#pragma unroll
            for (int e = 0; e < 4; ++e) { const float p = __expf(fminf(sc[t][e] * 0.125f, 60.f)); sc[t][e] = p; lsum += p; }
        NA_PV(sc, vc);
    }
    if (WIN) {
        const int c = strip * 16 + i; int kc0 = c - 8; kc0 = kc0 < 0 ? 0 : (kc0 > 48 ? 48 : kc0);
        int dcl[2][4]; bool okm[2][4];
#pragma unroll
        for (int t = 0; t < 2; ++t)
#pragma unroll
            for (int e = 0; e < 4; ++e) { const int kc = u0 + 8 * g + 4 * t + e; okm[t][e] = (kc >= kc0) && (kc < kc0 + 16); int dc = kc - c + 15; dcl[t][e] = dc < 0 ? 0 : (dc > 30 ? 30 : dc); }
#define NA_WCHUNK(vb_, cw) do { bf16x8 kw[2][2]; NA_KRING(kw, cw); f32x4 sw[2]; NA_QK(kw, sw); const LAS float* rp = rpb + (kr0 + (cw) - r + 7) * 31; \
        _Pragma("unroll") for (int t = 0; t < 2; ++t) _Pragma("unroll") for (int e = 0; e < 4; ++e) { const float x = sw[t][e] * 0.125f + rp[dcl[t][e]]; const float p = okm[t][e] ? __expf(fminf(x, 60.f)) : 0.f; sw[t][e] = p; lsum += p; } \
        NA_PV(sw, vb_); } while (0)
        NA_WCHUNK(vA, 0); NA_SB(); NA_WLOAD(vA, 3); NA_SB();
        NA_WCHUNK(vB, 1); NA_SB(); NA_WLOAD(vB, 4); NA_SB();
        NA_WCHUNK(vC, 2); NA_SB(); NA_WLOAD(vC, 5); NA_SB();
        NA_WCHUNK(vA, 3); NA_SB(); NA_WLOAD(vA, 6); NA_SB();
        NA_WCHUNK(vB, 4); NA_SB(); NA_WLOAD(vB, 7); NA_SB();
        NA_WCHUNK(vC, 5); NA_SB();
        NA_WCHUNK(vA, 6); NA_SB();
        NA_WCHUNK(vB, 7); NA_SB();
#undef NA_WCHUNK
    }
    lsum += shx(lsum, 16, ln_); lsum += shx(lsum, 32, ln_);
    const float inv = 1.0f / lsum;
    char* op = (char*)uni_ptr((const char*)((bf16_t*)(F.ws + WS_MIX) + (size_t)qrow0 * DM + h * 64)); const unsigned olo = (unsigned)((i * DM + 4 * g) * 2);
#pragma unroll
    for (int d = 0; d < 4; ++d) { u32x2 w; w.x = pk2(o[d][0] * inv, o[d][1] * inv); w.y = pk2(o[d][2] * inv, o[d][3] * inv); *(GAS u32x2*)(op + d * 32 + (size_t)olo) = w; }
#undef NA_SB
#undef NA_WLOAD
#undef NA_KRING
#undef NA_QK
#undef NA_PV
}
__device__ __forceinline__ int na_kr0(int r) { const int k = r - 4; return k < 0 ? 0 : (k > 56 ? 56 : k); }
__device__ __forceinline__ void ph_na(Frame& F, int l, bool last) {
    const bf16_t* U = (const bf16_t*)(F.ws + WS_U);
    for (int job = F.wg; job < NB * 8 * 2; job += F.G) {
        const int half = job & 1, h = (job >> 1) & 7, b = job >> 4;
        int tz_; asm volatile("v_mbcnt_lo_u32_b32 %0, -1, 0\n\tv_mbcnt_hi_u32_b32 %0, -1, %0" : "=v"(tz_)); tz_ |= F.wave << 6;
        const bf16_t* krow = U + (size_t)(b * SEQ + (tz_ >> 3)) * DIN + UK + h * 64 + (tz_ & 7) * 8;
        LAS bf16_t* kdst = (LAS bf16_t*)(F.lds + NA_KR) + (tz_ >> 3) * 72 + (tz_ & 7) * 8;
        __syncthreads();
        { LAS float* rpb = (LAS float*)(F.lds + NA_RPB); const float* rsrc = F.in[I_RPB] + ((size_t)l * 8 + h) * 15 * 31;
          if (tz_ < 15 * 31) rpb[tz_] = rsrc[tz_];
          const int key = tz_ >> 1, hf = tz_ & 1; const bf16_t* src = U + (size_t)(NLAT + b * CTXL + key) * DIN + UK + h * 64 + hf * 32; LAS bf16_t* dst = (LAS bf16_t*)(F.lds + NA_KC) + key * 72 + hf * 32;
#pragma unroll
          for (int j = 0; j < 4; ++j) *(LAS bf16x8*)(dst + j * 8) = gld16(src + j * 8);
          const int dv = tz_ >> 3, seg = tz_ & 7; const bf16_t* vs = (const bf16_t*)(F.ws + WS_VT) + ((size_t)b * 512 + h * 64 + dv) * SPB + SEQ + seg * 32; LAS bf16_t* vd = (LAS bf16_t*)(F.lds + NA_VC) + dv * 264 + seg * 32;
#pragma unroll
          for (int j = 0; j < 4; ++j) *(LAS bf16x8*)(vd + j * 8) = gld16(vs + j * 8);
          const int lo = na_kr0(half * 32), hi0 = na_kr0(half * 32 + 1) + 7;
          for (int kr = lo; kr <= hi0; ++kr) *(LAS bf16x8*)(kdst + (kr % 9) * 64 * 72) = gld16(krow + (size_t)kr * 64 * DIN); }
        __syncthreads();
        int prev_hi = na_kr0(half * 32 + 1) + 7;
#pragma unroll 1
        for (int s = 0; s < 16; ++s) {
            const int r0 = half * 32 + 2 * s;
            const int nhi = s < 15 ? na_kr0(r0 + 3) + 7 : prev_hi;
            bf16x8 n0 = (bf16x8){0, 0, 0, 0, 0, 0, 0, 0}, n1 = n0;
            if (nhi > prev_hi) n0 = gld16(krow + (size_t)(prev_hi + 1) * 64 * DIN);
            if (nhi > prev_hi + 1) n1 = gld16(krow + (size_t)(prev_hi + 2) * 64 * DIN);
            na_unit<true>(F, b, h, r0 + (F.wave >> 2), F.wave & 3);
            __syncthreads();
            if (nhi > prev_hi) *(LAS bf16x8*)(kdst + ((prev_hi + 1) % 9) * 64 * 72) = n0;
            if (nhi > prev_hi + 1) *(LAS bf16x8*)(kdst + ((prev_hi + 2) % 9) * 64 * 72) = n1;
            __syncthreads();
            prev_hi = nhi;
        }
        if (!last) na_unit<false>(F, b, h, 0, half * 8 + F.wave);
    }
}

__device__ __forceinline__ void ph_hy_transpose(Frame& F, bool last) {
    LAS bf16_t* tile = (LAS bf16_t*)(F.lds + F.wave * 16384);
    const bf16_t* HYO = (const bf16_t*)(F.ws + WS_Y);
    const int gw = F.wg * NWAVES + F.wave, NGW = F.G * NWAVES;
    const int rsub = F.lane >> 3, cseg = F.lane & 7;
    const int ntt = last ? 1024 : 1088;
    for (int u = gw; u < ntt * 4; u += NGW) {
        const int tt = u >> 2, cb = u & 3;
        int b, s0, rowbase, posbase;
        if (tt < 1024) { b = tt >> 6; s0 = (tt & 63) * 64; rowbase = b * SEQ; posbase = 0; }
        else { const int t2 = tt - 1024; b = t2 >> 2; s0 = (t2 & 3) * 64; rowbase = NLAT + b * CTXL; posbase = SEQ; }
#pragma unroll 2
        for (int it = 0; it < 8; ++it) { const int c = rsub + 8 * it;
            const u32x4 v = *(const GAS u32x4*)(HYO + ((size_t)(cb * 64 + c) * NB + b) * SPB + posbase + s0 + cseg * 8); const unsigned a[4] = {v.x, v.y, v.z, v.w};
#pragma unroll
            for (int e = 0; e < 4; ++e) { tile[(cseg * 8 + 2 * e) * 72 + c] = (bf16_t)(a[e] & 0xffffu); tile[(cseg * 8 + 2 * e + 1) * 72 + c] = (bf16_t)(a[e] >> 16); } }
        LDS_WAIT(); asm volatile("" ::: "memory");
#pragma unroll 2
        for (int it = 0; it < 8; ++it) { const int p = rsub + 8 * it;
            const u32x4 v = *(const LAS u32x4*)(tile + p * 72 + cseg * 8);
            *(GAS u32x4*)((bf16_t*)(F.ws + WS_MIX) + (size_t)(rowbase + s0 + p) * DM + 768 + cb * 64 + cseg * 8) = v; }
        LDS_WAIT(); asm volatile("" ::: "memory");
    }
}

constexpr int G2_LAF = 0, G2_LAB = 8448;
constexpr int G2_QTF = 16896, G2_KTF = 22016, G2_QTB = 27136, G2_KTB = 32256;
constexpr int G2_VT = 37376, G2_ATT = 46592;
constexpr int G2_SF = 55808, G2_SB = 60928;
constexpr int G2_SEG = 66048, G2_HALF = 67328;
__device__ __forceinline__ float log_sigmoid_f(float x) { return fminf(x, 0.f) - log1pf(__expf(-fabsf(x))); }
__device__ __forceinline__ f32x4 mma_lds(const LAS bf16_t* A, int lda, const LAS bf16_t* B, int ldb, int ksteps, f32x4 acc, int lane) {
    const int r = lane & 15, g = lane >> 4;
    for (int ks = 0; ks < ksteps; ++ks) { const bf16x8 a = *(const LAS bf16x8*)(A + r * lda + ks * 32 + 8 * g), b = *(const LAS bf16x8*)(B + r * ldb + ks * 32 + 8 * g); acc = mfma16(a, b, acc); }
    return acc;
}
__device__ __forceinline__ int gla_row0(int b, int cn) { return cn >= 4 ? b * SEQ + (cn - 4) * 64 : NLAT + b * CTXL + cn * 64; }
struct GlaRaw { u32x4 q, k, f, b, v0, v1, g0, g1, s0, s1; };
template <bool FULL>
__device__ __forceinline__ GlaRaw gla_load(Frame& F, int u, int tl) {
    const int h = u & 3, cn = (u >> 2) % 68, b = (u >> 2) / 68, i = tl >> 2, part = tl & 3;
    const bf16_t* p = (const bf16_t*)(F.ws + WS_U) + (size_t)(gla_row0(b, cn) + i) * DIN;
    GlaRaw r;
    r.q = *(const GAS u32x4*)(p + UGQ + h * 32 + part * 8); r.k = *(const GAS u32x4*)(p + UGK + h * 32 + part * 8);
    r.f = *(const GAS u32x4*)(p + ULAF + h * 32 + part * 8); r.b = *(const GAS u32x4*)(p + ULAB + h * 32 + part * 8);
    r.v0 = *(const GAS u32x4*)(p + UGV + h * 64 + part * 16); r.v1 = *(const GAS u32x4*)(p + UGV + h * 64 + part * 16 + 8);
    if (FULL) { r.g0 = *(const GAS u32x4*)(p + UGR + h * 64 + part * 16); r.g1 = *(const GAS u32x4*)(p + UGR + h * 64 + part * 16 + 8);
        const bf16_t* sp = (const bf16_t*)(F.ws + WS_GSIN) + (size_t)u * 2 * 2048 + tl * 16; r.s0 = *(const GAS u32x4*)sp; r.s1 = *(const GAS u32x4*)(sp + 8); }
    else { r.g0 = (u32x4){0u, 0u, 0u, 0u}; r.g1 = r.g0; r.s0 = r.g0; r.s1 = r.g0; }
    return r;
}
template <bool FULL>
__device__ __forceinline__ void gla_prep(Frame& F, LAS unsigned char* L, int l, int u, int tl, const GlaRaw& raw) {
    const int h = u & 3, cn = (u >> 2) % 68, i = tl >> 2, part = tl & 3, d8 = part * 8;
    LAS float* LAF = (LAS float*)(L + G2_LAF); LAS float* LAB = (LAS float*)(L + G2_LAB); LAS bf16_t* VT = (LAS bf16_t*)(L + G2_VT); LAS float* SEG = (LAS float*)(L + G2_SEG);
    float q[8], k[8], tf[8], tb[8];
    unpack8(raw.q, q); unpack8(raw.k, k); unpack8(raw.f, tf); unpack8(raw.b, tb);
    const float* ba = F.in[I_BA2] + (size_t)l * 256 + h * 32 + d8;
#pragma unroll
    for (int e = 0; e < 8; ++e) { q[e] *= 0.17677669529663687f; LAF[i * 33 + d8 + e] = log_sigmoid_f(tf[e] + ba[e]) * 0.0625f; LAB[i * 33 + d8 + e] = log_sigmoid_f(tb[e] + ba[128 + e]) * 0.0625f; }
    if (cn >= 4) {
        const float pos = (part >> 1) ? (float)i : (float)(cn - 4);
#pragma unroll
        for (int e = 0; e < 8; ++e) { const float ang = pos * __expf(-(float)e * (9.210340371976184f / 8.0f)); const float sn = __sinf(ang), cs = __cosf(ang);
            const float qo = shx(q[e], 1, F.lane), ko = shx(k[e], 1, F.lane);
            if (part & 1) { q[e] = qo * sn + q[e] * cs; k[e] = ko * sn + k[e] * cs; } else { q[e] = q[e] * cs - qo * sn; k[e] = k[e] * cs - ko * sn; } }
    }
    { const unsigned a[8] = {raw.v0.x, raw.v0.y, raw.v0.z, raw.v0.w, raw.v1.x, raw.v1.y, raw.v1.z, raw.v1.w};
#pragma unroll
      for (int e = 0; e < 8; ++e) { VT[(part * 16 + 2 * e) * 72 + i] = (bf16_t)(a[e] & 0xffffu); VT[(part * 16 + 2 * e + 1) * 72 + i] = (bf16_t)(a[e] >> 16); } }
    __syncthreads();
    { const int x = tl & 63, d = x & 31, dir = x >> 5, seg = tl >> 6; LAS float* LA = dir ? LAB : LAF; float run = 0.f;
#pragma unroll
      for (int kk = 0; kk < 16; ++kk) { const int p = seg * 16 + kk, ti = dir ? 63 - p : p; run += LA[ti * 33 + d]; LA[ti * 33 + d] = run; }
      SEG[x * 5 + seg] = run; }
    __syncthreads();
    { const int x = tl & 63, d = x & 31, dir = x >> 5, seg = tl >> 6; LAS float* LA = dir ? LAB : LAF; float pre = 0.f;
      for (int s2 = 0; s2 < seg; ++s2) pre += SEG[x * 5 + s2];
#pragma unroll
      for (int kk = 0; kk < 16; ++kk) { const int p = seg * 16 + kk, ti = dir ? 63 - p : p; LA[ti * 33 + d] += pre; } }
    __syncthreads();
    if (FULL) {
        unsigned wqf[4], wkf[4], wqb[4], wkb[4];
#pragma unroll
        for (int e = 0; e < 4; ++e) { const int d = d8 + 2 * e; const float f0 = LAF[i * 33 + d], f1 = LAF[i * 33 + d + 1], b0 = LAB[i * 33 + d], b1 = LAB[i * 33 + d + 1];
            wqf[e] = pk2(q[2 * e] * __expf(f0), q[2 * e + 1] * __expf(f1)); wkf[e] = pk2(k[2 * e] * __expf(-f0), k[2 * e + 1] * __expf(-f1));
            wqb[e] = pk2(q[2 * e] * __expf(b0), q[2 * e + 1] * __expf(b1)); wkb[e] = pk2(k[2 * e] * __expf(-b0), k[2 * e + 1] * __expf(-b1)); }
        *(LAS u32x4*)((LAS bf16_t*)(L + G2_QTF) + i * 40 + d8) = (u32x4){wqf[0], wqf[1], wqf[2], wqf[3]}; *(LAS u32x4*)((LAS bf16_t*)(L + G2_KTF) + i * 40 + d8) = (u32x4){wkf[0], wkf[1], wkf[2], wkf[3]};
        *(LAS u32x4*)((LAS bf16_t*)(L + G2_QTB) + i * 40 + d8) = (u32x4){wqb[0], wqb[1], wqb[2], wqb[3]}; *(LAS u32x4*)((LAS bf16_t*)(L + G2_KTB) + i * 40 + d8) = (u32x4){wkb[0], wkb[1], wkb[2], wkb[3]};
    } else {
        LAS bf16_t* KDF = (LAS bf16_t*)(L + G2_QTF); LAS bf16_t* KDB = (LAS bf16_t*)(L + G2_KTF);
#pragma unroll
        for (int e = 0; e < 8; ++e) { const int d = d8 + e; const float bf = LAF[i * 33 + d], bb = LAB[i * 33 + d], bfl = LAF[63 * 33 + d], bbl = LAB[0 * 33 + d];
            KDF[d * 72 + i] = (bf16_t)f2bf(k[e] * __expf(bfl - bf)); KDB[d * 72 + i] = (bf16_t)f2bf(k[e] * __expf(bbl - bb)); }
    }
    __syncthreads();
}
__device__ __forceinline__ void ph_gla_local(Frame& F, int l) {
    const int hw = F.wave >> 2, wl = F.wave & 3, tl = F.tid & 255; LAS unsigned char* L = F.lds + hw * G2_HALF;
    constexpr int NU = NB * 68 * 4;
    int pp = F.wg;
    GlaRaw raw = gla_load<false>(F, (pp * 2 + hw) < NU ? pp * 2 + hw : 0, tl);
    for (; pp * 2 < NU; pp += F.G) {
        const int u = pp * 2 + hw, un = (pp + F.G) * 2 + hw;
        const GlaRaw nraw = gla_load<false>(F, un < NU ? un : u, tl);
        __syncthreads();
        gla_prep<false>(F, L, l, u, tl, raw);
        const int g = F.lane >> 4, c = F.lane & 15;
        float* DS = (float*)(F.ws + WS_GDS) + (size_t)u * 2 * 2048;
#pragma unroll
        for (int kk = 0; kk < 4; ++kk) { const int tix = wl * 4 + kk, dir = tix >> 3, mt = (tix >> 1) & 3, nt = tix & 1;
            f32x4 a = (f32x4){0.f, 0.f, 0.f, 0.f};
            a = mma_lds((const LAS bf16_t*)(L + G2_VT) + mt * 16 * 72, 72, (const LAS bf16_t*)(L + (dir ? G2_KTF : G2_QTF)) + nt * 16 * 72, 72, 2, a, F.lane);
#pragma unroll
            for (int e = 0; e < 4; ++e) DS[dir * 2048 + (mt * 16 + 4 * g + e) * 32 + nt * 16 + c] = a[e]; }
        if (tl < 64) { const int d = tl & 31, dir = tl >> 5; ((float*)(F.ws + WS_GD))[(size_t)u * 64 + tl] = __expf(dir ? ((LAS float*)(L + G2_LAB))[0 * 33 + d] : ((LAS float*)(L + G2_LAF))[63 * 33 + d]); }
        raw = nraw;
    }
}
__device__ __forceinline__ void ph_gla_scan(Frame& F) {
    const int gt = F.wg * NTHR + F.tid, NGT = F.G * NTHR;
    const float* DS = (const float*)(F.ws + WS_GDS); const float* GD = (const float*)(F.ws + WS_GD); bf16_t* SIN = (bf16_t*)(F.ws + WS_GSIN);
    for (int w = gt; w < 128 * 1024; w += NGT) {
        const int chain = w >> 10, el = (w & 1023) * 2, dir = chain & 1, h = (chain >> 1) & 3, b = chain >> 3, d = el & 31;
        float s0 = 0.f, s1 = 0.f;
        for (int step = 0; step < 68; step += 4) {
            f32x2 ds[4], dd[4]; size_t uu[4];
#pragma unroll
            for (int q = 0; q < 4; ++q) { const int st_ = step + q; const int cn = dir ? (st_ < 4 ? 3 - st_ : 71 - st_) : st_;
                uu[q] = (size_t)(b * 68 + cn) * 4 + h;
                ds[q] = *(const GAS f32x2*)(DS + (uu[q] * 2 + dir) * 2048 + el); dd[q] = *(const GAS f32x2*)(GD + uu[q] * 64 + dir * 32 + d); }
#pragma unroll
            for (int q = 0; q < 4; ++q) { *(GAS unsigned*)(SIN + (uu[q] * 2 + dir) * 2048 + el) = pk2(s0, s1); s0 = dd[q].x * s0 + ds[q].x; s1 = dd[q].y * s1 + ds[q].y; }
        }
    }
}
__device__ __forceinline__ void ph_gla_out(Frame& F, int l, bool last) {
    const int hw = F.wave >> 2, wl = F.wave & 3, tl = F.tid & 255; LAS unsigned char* L = F.lds + hw * G2_HALF;
    const int NV = last ? NB * 64 * 4 : NB * 68 * 4;
#define GLA_UNIT(v) (last ? ((((v) >> 8) * 68 + 4 + (((v) & 255) >> 2)) * 4 + ((v) & 3)) : (v))
    int pp = F.wg;
    GlaRaw raw = gla_load<true>(F, GLA_UNIT((pp * 2 + hw) < NV ? pp * 2 + hw : 0), tl);
    for (; pp * 2 < NV; pp += F.G) {
        const int u = GLA_UNIT(pp * 2 + hw), vn = (pp + F.G) * 2 + hw;
        const GlaRaw nraw = gla_load<true>(F, vn < NV ? GLA_UNIT(vn) : u, tl);
        const int h = u & 3, cn = (u >> 2) % 68, b = (u >> 2) / 68;
        __syncthreads();
        gla_prep<true>(F, L, l, u, tl, raw);
        { const int dir = tl >> 7, dv = (tl >> 1) & 63, d16 = (tl & 1) * 16; LAS bf16_t* S = (LAS bf16_t*)(L + (dir ? G2_SB : G2_SF)) + dv * 40 + d16; *(LAS u32x4*)S = raw.s0; *(LAS u32x4*)(S + 8) = raw.s1; }
        const int g = F.lane >> 4, c = F.lane & 15;
        LAS bf16_t* ATT = (LAS bf16_t*)(L + G2_ATT);
#pragma unroll
        for (int kk = 0; kk < 4; ++kk) { const int tile = wl * 4 + kk, mt = tile >> 2, nt = tile & 3;
            f32x4 af = (f32x4){0.f, 0.f, 0.f, 0.f}, ab = af;
            af = mma_lds((const LAS bf16_t*)(L + G2_QTF) + mt * 16 * 40, 40, (const LAS bf16_t*)(L + G2_KTF) + nt * 16 * 40, 40, 1, af, F.lane);
            ab = mma_lds((const LAS bf16_t*)(L + G2_QTB) + mt * 16 * 40, 40, (const LAS bf16_t*)(L + G2_KTB) + nt * 16 * 40, 40, 1, ab, F.lane);
#pragma unroll
            for (int e = 0; e < 4; ++e) { const int ii = mt * 16 + 4 * g + e, j = nt * 16 + c; const float vv = (j <= ii ? af[e] : 0.f) + (j >= ii ? ab[e] : 0.f); ATT[ii * 72 + j] = (bf16_t)f2bf(vv); } }
        __syncthreads();
        LAS float* O = (LAS float*)(L + G2_LAF);
#pragma unroll
        for (int kk = 0; kk < 4; ++kk) { const int tile = wl * 4 + kk, mt = tile >> 2, nt = tile & 3;
            f32x4 a = (f32x4){0.f, 0.f, 0.f, 0.f};
            a = mma_lds(ATT + mt * 16 * 72, 72, (const LAS bf16_t*)(L + G2_VT) + nt * 16 * 72, 72, 2, a, F.lane);
            a = mma_lds((const LAS bf16_t*)(L + G2_QTF) + mt * 16 * 40, 40, (const LAS bf16_t*)(L + G2_SF) + nt * 16 * 40, 40, 1, a, F.lane);
            a = mma_lds((const LAS bf16_t*)(L + G2_QTB) + mt * 16 * 40, 40, (const LAS bf16_t*)(L + G2_SB) + nt * 16 * 40, 40, 1, a, F.lane);
#pragma unroll
            for (int e = 0; e < 4; ++e) O[(mt * 16 + 4 * g + e) * 65 + nt * 16 + c] = a[e]; }
        __syncthreads();
        { const int i = tl >> 2, dv16 = (tl & 3) * 16; const int row = gla_row0(b, cn) + i;
          float v[16], gt[16]; float ss = 0.f;
#pragma unroll
          for (int e = 0; e < 16; ++e) { v[e] = O[i * 65 + dv16 + e]; ss += v[e] * v[e]; }
          ss += shx(ss, 1, F.lane); ss += shx(ss, 2, F.lane);
          const float rs = 1.0f / sqrtf(ss * (1.0f / 64.0f) + LN_EPS);
          unpack8(raw.g0, gt); unpack8(raw.g1, gt + 8);
          const float* gn = F.in[I_GNORM] + l * 64 + dv16;
          unsigned w[8];
#pragma unroll
          for (int e = 0; e < 8; ++e) w[e] = pk2(v[2 * e] * rs * gn[2 * e] * silu_f(gt[2 * e]), v[2 * e + 1] * rs * gn[2 * e + 1] * silu_f(gt[2 * e + 1]));
          bf16_t* mp = (bf16_t*)(F.ws + WS_MIX) + (size_t)row * DM + 512 + h * 64 + dv16;
          *(GAS u32x4*)mp = (u32x4){w[0], w[1], w[2], w[3]}; *(GAS u32x4*)(mp + 8) = (u32x4){w[4], w[5], w[6], w[7]}; }
        raw = nraw;
    }
#undef GLA_UNIT
}

template <int L>
__device__ __forceinline__ void hyena_conv(Frame& F, const bf16_t* Rg, const bf16_t* Uin, const bf16_t* Xmul, int pos0, bool final_out, int ch, bf16_t* Zout) {
    constexpr int CS = 2 * L + 16;
    constexpr int NTL = L / 16, J = (NTL >= 64) ? 16 : 2, NGRP = NTL / J, HJ = J / 2, NSTEP = L / 32;
    LAS bf16_t* Rl = (LAS bf16_t*)F.lds;
    __syncthreads();
    for (int c = F.tid; c < 2 * L / 8; c += NTHR) { const u32x4 v = *(const GAS u32x4*)(Rg + 8 * c); const unsigned a[4] = {v.x, v.y, v.z, v.w};
#pragma unroll
        for (int rho = 0; rho < 8; ++rho) { LAS bf16_t* d = Rl + rho * CS + 8 * c + rho;
#pragma unroll
            for (int k = 0; k < 4; ++k) { d[2 * k] = (bf16_t)(a[k] & 0xffffu); d[2 * k + 1] = (bf16_t)(a[k] >> 16); } } }
    __syncthreads();
    int ln_ = F.lane; asm volatile("" : "+v"(ln_));
    const int i = ln_ & 15, g = ln_ >> 4, rho = i & 7;
    const LAS bf16_t* Rc = Rl + rho * CS + rho;
    for (int grp = F.wave; grp < NGRP; grp += NWAVES) {
        f32x4 acc[J]; bf16x8 fr[J];
        const int tb = grp * J * 16;
        const LAS bf16_t* Rb = Rc + (L - tb - i + 8 * g);
#pragma unroll
        for (int j = 0; j < J; ++j) { acc[j] = (f32x4){0.f, 0.f, 0.f, 0.f}; fr[j] = *(const LAS bf16x8*)(Rb - 16 * j); }
        const char* ub = (const char*)(Uin + pos0); const unsigned ulo = (unsigned)((i * SPB + 8 * g) * 2);
        constexpr int PF = (HJ >= 4) ? 4 : 1;
        bf16x8 bq[PF];
#pragma unroll
        for (int p = 0; p < PF; ++p) bq[p] = *(const GAS bf16x8*)(ub + (size_t)(ulo + (unsigned)p * 64u));
#pragma unroll 1
        for (int q = 0; q < NSTEP / HJ; ++q) {
#pragma unroll
            for (int m = 0; m < HJ; ++m) {
                const int n = q * HJ + m;
                const int nn = (n + PF < NSTEP) ? n + PF : 0;
                if (n > 0) { fr[(J - 2 * m) % J] = *(const LAS bf16x8*)(Rb + 32 * n); fr[(J + 1 - 2 * m) % J] = *(const LAS bf16x8*)(Rb + 32 * n - 16); }
                const bf16x8 bcur = bq[m % PF];
#pragma unroll
                for (int jj = 0; jj < J; ++jj) { const int j = (jj + 2) % J; acc[j] = mfma16(fr[(j + J - 2 * m) % J], bcur, acc[j]); }
                bq[m % PF] = *(const GAS bf16x8*)(ub + (size_t)(ulo + (unsigned)nn * 64u));
            }
        }
#pragma unroll
        for (int j = 0; j < J; ++j) { const int t0 = tb + j * 16 + 4 * g;
            const u32x2 xw = *(const GAS u32x2*)(Xmul + (size_t)i * SPB + pos0 + t0);
            const float y0 = acc[j][0] * bflo(xw.x), y1 = acc[j][1] * bfhi(xw.x), y2 = acc[j][2] * bflo(xw.y), y3 = acc[j][3] * bfhi(xw.y);
            if (!final_out) { u32x2 w; w.x = pk2(y0, y1); w.y = pk2(y2, y3); *(GAS u32x2*)(Zout + (size_t)i * SPB + pos0 + t0) = w; }
            else { u32x2 w; w.x = pk2(y0, y1); w.y = pk2(y2, y3); *(GAS u32x2*)((bf16_t*)(F.ws + WS_Y) + ((size_t)ch * NB + i) * SPB + pos0 + t0) = w; } }
    }
}
__device__ __forceinline__ void ph_hyena(Frame& F, int l, bool last) {
    const bf16_t* HV = (const bf16_t*)(F.ws + WS_HV); bf16_t* Z2 = (bf16_t*)(F.ws + WS_Z2);
    for (int ch = F.wg; ch < 256; ch += F.G) {
        const bf16_t* v = HV + (size_t)(0 * 256 + ch) * NB * SPB; const bf16_t* x1 = HV + (size_t)(256 + ch) * NB * SPB; const bf16_t* x2 = HV + (size_t)(512 + ch) * NB * SPB;
        bf16_t* z = Z2 + (size_t)ch * NB * SPB;
        const bf16_t* R0 = (const bf16_t*)(F.ws + WS_HYF) + ((size_t)(l * 2 + 0) * 256 + ch) * 8192; const bf16_t* R1 = (const bf16_t*)(F.ws + WS_HYF) + ((size_t)(l * 2 + 1) * 256 + ch) * 8192;
        hyena_conv<4096>(F, R0, v, x1, 0, false, ch, z);
        VM_WAIT(); __syncthreads(); __builtin_amdgcn_fence(__ATOMIC_ACQUIRE, "agent"); VM_WAIT();
        hyena_conv<4096>(F, R1, z, x2, 0, true, ch, z);
        if (!last) {
            const bf16_t* C0 = (const bf16_t*)(F.ws + WS_HYFC) + ((size_t)(l * 2 + 0) * 256 + ch) * 512; const bf16_t* C1 = (const bf16_t*)(F.ws + WS_HYFC) + ((size_t)(l * 2 + 1) * 256 + ch) * 512;
            hyena_conv<256>(F, C0, v, x1, SEQ, false, ch, z);
            VM_WAIT(); __syncthreads(); __builtin_amdgcn_fence(__ATOMIC_ACQUIRE, "agent"); VM_WAIT();
            hyena_conv<256>(F, C1, z, x2, SEQ, true, ch, z);
        }
    }
}

__device__ __forceinline__ void ph_ln1(Frame& F, int l, int ntok) {
    const int gw = F.wg * NWAVES + F.wave, NGW = F.G * NWAVES;
    const float* lg = F.in[I_LN1G] + l * DM + 16 * F.lane; const float* lb = F.in[I_LN1B] + l * DM + 16 * F.lane;
    for (int row = gw; row < ntok; row += NGW) {
        bf16_t* xr = (bf16_t*)(F.ws + WS_XR) + (size_t)row * DM + 16 * F.lane;
        const bf16_t* yr = (const bf16_t*)(F.ws + WS_Y) + (size_t)row * DM + 16 * F.lane;
        const float* md = mod_ptr(F, l, row) + 16 * F.lane;
        bf16_t* xm = (bf16_t*)(F.ws + WS_XM) + (size_t)row * DM + 16 * F.lane;
        const u32x4 xa = *(const GAS u32x4*)xr, xb = *(const GAS u32x4*)(xr + 8), ya = *(const GAS u32x4*)yr, yb = *(const GAS u32x4*)(yr + 8);
        float x[16], y[16], v[16]; unpack8(xa, x); unpack8(xb, x + 8); unpack8(ya, y); unpack8(yb, y + 8);
        float s = 0.f;
#pragma unroll
        for (int j = 0; j < 4; ++j) { const f32x4 g1 = *(const GAS f32x4*)(md + 2048 + 4 * j);
#pragma unroll
            for (int e = 0; e < 4; ++e) { v[4 * j + e] = x[4 * j + e] * DN_ALPHA + g1[e] * y[4 * j + e]; s += v[4 * j + e]; } }
        const float mean = wave_sum(s, F.lane) * (1.f / DM); float s2 = 0.f;
#pragma unroll
        for (int e = 0; e < 16; ++e) { v[e] -= mean; s2 += v[e] * v[e]; }
        const float rstd = 1.f / sqrtf(wave_sum(s2, F.lane) * (1.f / DM) + LN_EPS);
        unsigned wx[8], wm[8]; int w8[4];
#pragma unroll
        for (int j = 0; j < 4; ++j) { const f32x4 g = *(const GAS f32x4*)(lg + 4 * j), bb = *(const GAS f32x4*)(lb + 4 * j), sh = *(const GAS f32x4*)(md + 3072 + 4 * j), sc = *(const GAS f32x4*)(md + 4096 + 4 * j);
            float xn[4];
#pragma unroll
            for (int e = 0; e < 4; ++e) xn[e] = v[4 * j + e] * rstd * g[e] + bb[e];
            wx[2 * j] = pk2(xn[0], xn[1]); wx[2 * j + 1] = pk2(xn[2], xn[3]);
            const float h0 = xn[0] * (1.f + sc[0]) + sh[0], h1 = xn[1] * (1.f + sc[1]) + sh[1], h2 = xn[2] * (1.f + sc[2]) + sh[2], h3 = xn[3] * (1.f + sc[3]) + sh[3];
            wm[2 * j] = pk2(h0, h1); wm[2 * j + 1] = pk2(h2, h3);
            int v = 0; v = __builtin_amdgcn_cvt_pk_fp8_f32(h0, h1, v, false); v = __builtin_amdgcn_cvt_pk_fp8_f32(h2, h3, v, true); w8[j] = v; }
        *(GAS u32x4*)((unsigned char*)(F.ws + WS_XM8) + (size_t)row * DM + 16 * F.lane) = (u32x4){(unsigned)w8[0], (unsigned)w8[1], (unsigned)w8[2], (unsigned)w8[3]};
        *(GAS u32x4*)xr = (u32x4){wx[0], wx[1], wx[2], wx[3]}; *(GAS u32x4*)(xr + 8) = (u32x4){wx[4], wx[5], wx[6], wx[7]};
        *(GAS u32x4*)xm = (u32x4){wm[0], wm[1], wm[2], wm[3]}; *(GAS u32x4*)(xm + 8) = (u32x4){wm[4], wm[5], wm[6], wm[7]};
    }
}
__device__ __forceinline__ void ph_ln2(Frame& F, int l, int ntok, bool last) {
    const int gw = F.wg * NWAVES + F.wave, NGW = F.G * NWAVES;
    const int cA = 256 * (F.lane >> 4) + 32 * ((F.lane >> 2) & 3) + 8 * (F.lane & 3);
#define LN2_COL(j) (cA + ((j) < 2 ? 4 * (j) : 128 + 4 * ((j) - 2)))
    const float* lg = F.in[I_LN2G] + l * DM; const float* lb = F.in[I_LN2B] + l * DM;
    for (int row = gw; row < ntok; row += NGW) {
        bf16_t* xr = (bf16_t*)(F.ws + WS_XR) + (size_t)row * DM;
        const unsigned char* y2 = (const unsigned char*)(F.ws + WS_Y2) + (size_t)row * 9 * DM + 16 * F.lane;
        const float* wg = (const float*)(F.ws + WS_WGT) + (size_t)row * 8;
        const float* md = mod_ptr(F, l, row);
        float ff[16];
#pragma unroll
        for (int e = 0; e < 16; ++e) ff[e] = 0.f;
        u32x4 q[9];
#pragma unroll
        for (int k = 0; k < 9; ++k) q[k] = *(const GAS u32x4*)(y2 + (size_t)k * DM);
#pragma unroll
        for (int k = 0; k < 9; ++k) { const float wk = (k < 8 ? wg[k] : 1.0f) * pg8::Y2_INV; const unsigned a[4] = {q[k].x, q[k].y, q[k].z, q[k].w};
#pragma unroll
            for (int e = 0; e < 4; ++e) { const f32x2 lo = __builtin_amdgcn_cvt_pk_f32_fp8((int)a[e], false), hi = __builtin_amdgcn_cvt_pk_f32_fp8((int)a[e], true);
                ff[4 * e] += wk * lo.x; ff[4 * e + 1] += wk * lo.y; ff[4 * e + 2] += wk * hi.x; ff[4 * e + 3] += wk * hi.y; } }
        float v[16], xo[16]; float s = 0.f;
        { const u32x4 xa = *(const GAS u32x4*)(xr + cA), xb = *(const GAS u32x4*)(xr + cA + 128); unpack8(xa, xo); unpack8(xb, xo + 8); }
#pragma unroll
        for (int j = 0; j < 4; ++j) { const f32x4 g2 = *(const GAS f32x4*)(md + 5120 + LN2_COL(j));
#pragma unroll
            for (int e = 0; e < 4; ++e) { v[4 * j + e] = xo[4 * j + e] * DN_ALPHA + g2[e] * ff[4 * j + e]; s += v[4 * j + e]; } }
        const float mean = wave_sum(s, F.lane) * (1.f / DM); float s2 = 0.f;
#pragma unroll
        for (int e = 0; e < 16; ++e) { v[e] -= mean; s2 += v[e] * v[e]; }
        const float rstd = 1.f / sqrtf(wave_sum(s2, F.lane) * (1.f / DM) + LN_EPS);
        const float* mdn = last ? md : mod_ptr(F, l + 1, row);
        float xn[16];
#pragma unroll
        for (int j = 0; j < 4; ++j) { const f32x4 g = *(const GAS f32x4*)(lg + LN2_COL(j)), bb = *(const GAS f32x4*)(lb + LN2_COL(j));
#pragma unroll
            for (int e = 0; e < 4; ++e) xn[4 * j + e] = v[4 * j + e] * rstd * g[e] + bb[e]; }
        if (last) { float* op = F.out + (size_t)row * DM;
#pragma unroll
            for (int j = 0; j < 4; ++j) *(GAS f32x4*)(op + LN2_COL(j)) = (f32x4){xn[4 * j], xn[4 * j + 1], xn[4 * j + 2], xn[4 * j + 3]}; }
        else {
            *(GAS u32x4*)(xr + cA) = (u32x4){pk2(xn[0], xn[1]), pk2(xn[2], xn[3]), pk2(xn[4], xn[5]), pk2(xn[6], xn[7])}; *(GAS u32x4*)(xr + cA + 128) = (u32x4){pk2(xn[8], xn[9]), pk2(xn[10], xn[11]), pk2(xn[12], xn[13]), pk2(xn[14], xn[15])};
            bf16_t* xm = (bf16_t*)(F.ws + WS_XM) + (size_t)row * DM;
            unsigned w[8];
#pragma unroll
            for (int j = 0; j < 4; ++j) { const f32x4 sh = *(const GAS f32x4*)(mdn + LN2_COL(j)), sc = *(const GAS f32x4*)(mdn + 1024 + LN2_COL(j));
                w[2 * j] = pk2(xn[4 * j] * (1.f + sc[0]) + sh[0], xn[4 * j + 1] * (1.f + sc[1]) + sh[1]); w[2 * j + 1] = pk2(xn[4 * j + 2] * (1.f + sc[2]) + sh[2], xn[4 * j + 3] * (1.f + sc[3]) + sh[3]); }
            *(GAS u32x4*)(xm + cA) = (u32x4){w[0], w[1], w[2], w[3]}; *(GAS u32x4*)(xm + cA + 128) = (u32x4){w[4], w[5], w[6], w[7]};
        }
    }
#undef LN2_COL
}

__device__ __forceinline__ unsigned f_ord(float f) { const unsigned u = __builtin_bit_cast(unsigned, f); return (u & 0x80000000u) ? ~u : (u | 0x80000000u); }
__device__ __forceinline__ unsigned long long wave_max_u64(unsigned long long v, int lane) {
#pragma unroll
    for (int o = 1; o < 64; o <<= 1) { const unsigned lo = (unsigned)shxi((int)(unsigned)v, o, lane), hi = (unsigned)shxi((int)(unsigned)(v >> 32), o, lane); const unsigned long long w = ((unsigned long long)hi << 32) | lo; v = w > v ? w : v; }
    return v;
}
__device__ __forceinline__ float seg16_max(float v, int lane) { v = fmaxf(v, shx(v, 1, lane)); v = fmaxf(v, shx(v, 2, lane)); v = fmaxf(v, shx(v, 4, lane)); v = fmaxf(v, shx(v, 8, lane)); return v; }
__device__ __forceinline__ int seg16_min_i(int v, int lane) { int w; w = shxi(v, 1, lane); v = w < v ? w : v; w = shxi(v, 2, lane); v = w < v ? w : v; w = shxi(v, 4, lane); v = w < v ? w : v; w = shxi(v, 8, lane); v = w < v ? w : v; return v; }
__device__ __forceinline__ float seg16_top2(float v, int lane) {
    const float m1 = seg16_max(v, lane);
    const int first = seg16_min_i(v == m1 ? (lane & 15) : 99, lane);
    const float m2 = seg16_max((lane & 15) == first ? -3.0e38f : v, lane);
    return m1 + m2;
}
__device__ __forceinline__ void ph_route(Frame& F, int l, int ntok) {
    LAS int* hist = (LAS int*)F.lds;
    LAS int* base = hist + 128;
    LAS unsigned* alist = (LAS unsigned*)(F.lds + 1024);
    const int tpw = (ntok + F.G - 1) / F.G, t0 = F.wg * tpw, t1 = (t0 + tpw) < ntok ? (t0 + tpw) : ntok;
    __syncthreads();
    if (F.tid < 128) hist[F.tid] = 0;
    __syncthreads();
    const float* LG = (const float*)(F.ws + WS_LOGIT); const float* rb = F.in[I_RB] + l * NEXP;
    const float b0 = rb[F.lane], b1 = rb[F.lane + 64];
    constexpr int RT = 4;
    for (int tb = t0 + F.wave * RT; tb < t1; tb += NWAVES * RT) {
        float s0[RT], s1[RT], e0[RT], e1[RT], gs0[RT], gs1[RT]; unsigned long long k0[RT], k1[RT]; int mye[RT]; float myw[RT], wsum[RT];
#pragma unroll
        for (int j = 0; j < RT; ++j) { const int tok = (tb + j) < t1 ? tb + j : t1 - 1;
            const float x0 = LG[(size_t)tok * 256 + F.lane], x1 = LG[(size_t)tok * 256 + 64 + F.lane];
            s0[j] = 1.0f / (1.0f + __expf(-x0)); s1[j] = 1.0f / (1.0f + __expf(-x1)); e0[j] = s0[j] + b0; e1[j] = s1[j] + b1; }
#pragma unroll
        for (int j = 0; j < RT; ++j) { gs0[j] = seg16_top2(e0[j], F.lane); gs1[j] = seg16_top2(e1[j], F.lane); }
#pragma unroll
        for (int j = 0; j < RT; ++j) {
            float gsc[8];
#pragma unroll
            for (int g = 0; g < 4; ++g) { gsc[g] = shf(gs0[j], g * 16); gsc[4 + g] = shf(gs1[j], g * 16); }
            unsigned gmask = 0u;
#pragma unroll
            for (int g = 0; g < 8; ++g) { int cnt = 0;
#pragma unroll
                for (int g2 = 0; g2 < 8; ++g2) cnt += (gsc[g2] > gsc[g] || (gsc[g2] == gsc[g] && g2 < g)) ? 1 : 0;
                gmask |= (cnt < 4) ? (1u << g) : 0u; }
            const bool ok0 = (gmask >> (F.lane >> 4)) & 1u, ok1 = (gmask >> (4 + (F.lane >> 4))) & 1u;
            k0[j] = ok0 ? (((unsigned long long)f_ord(e0[j]) << 32) | (unsigned)(255 - F.lane)) : 0ull;
            k1[j] = ok1 ? (((unsigned long long)f_ord(e1[j]) << 32) | (unsigned)(255 - 64 - F.lane)) : 0ull;
            mye[j] = 0; myw[j] = 0.f; wsum[j] = 0.f; }
#pragma unroll
        for (int k = 0; k < 8; ++k) {
            unsigned long long best[RT];
#pragma unroll
            for (int j = 0; j < RT; ++j) best[j] = k0[j] > k1[j] ? k0[j] : k1[j];
#pragma unroll
            for (int o = 1; o < 64; o <<= 1) {
#pragma unroll
                for (int j = 0; j < RT; ++j) { const unsigned lo = (unsigned)shxi((int)(unsigned)best[j], o, F.lane), hi = (unsigned)shxi((int)(unsigned)(best[j] >> 32), o, F.lane);
                    const unsigned long long w = ((unsigned long long)hi << 32) | lo; best[j] = w > best[j] ? w : best[j]; } }
#pragma unroll
            for (int j = 0; j < RT; ++j) { const int e = 255 - (int)(best[j] & 0xffu);
                if (k0[j] == best[j]) k0[j] = 0ull; if (k1[j] == best[j]) k1[j] = 0ull;
                const float sv = shf(e < 64 ? s0[j] : s1[j], e & 63);
                wsum[j] += sv; if (F.lane == k) { mye[j] = e; myw[j] = sv; } }
        }
#pragma unroll
        for (int j = 0; j < RT; ++j) { const int tok = tb + j;
            if (tok < t1 && F.lane < 8) {
                const int lr = __hip_atomic_fetch_add(&hist[mye[j]], 1, __ATOMIC_RELAXED, __HIP_MEMORY_SCOPE_WORKGROUP);
                alist[(tok - t0) * 8 + F.lane] = (unsigned)mye[j] | ((unsigned)lr << 8);
                ((int*)(F.ws + WS_EIDX))[(size_t)tok * 8 + F.lane] = mye[j];
                ((float*)(F.ws + WS_WGT))[(size_t)tok * 8 + F.lane] = myw[j] / wsum[j] * 2.5f;
            } }
    }
    __syncthreads();
    if (F.tid < 128) { const int hcount = hist[F.tid]; base[F.tid] = hcount ? (int)atomicAdd(F.ctl + CW_CNT + l * 256 + F.tid, (unsigned)hcount) : 0; }
    __syncthreads();
    for (int a = F.tid; a < (t1 - t0) * 8; a += NTHR) { const unsigned v = alist[a]; ((int*)(F.ws + WS_RNK))[(size_t)t0 * 8 + a] = base[v & 0xffu] + (int)(v >> 8); }
}
__device__ __forceinline__ void ph_positions(Frame& F, int l, int ntok) {
    LAS int* cnt = (LAS int*)F.lds;
    LAS int* off = cnt + 132;
    __syncthreads();
    if (F.tid < NE1) cnt[F.tid] = F.tid < NEXP ? (int)__hip_atomic_load(F.ctl + CW_CNT + l * 256 + F.tid, __ATOMIC_RELAXED, __HIP_MEMORY_SCOPE_AGENT) : ntok;
    __syncthreads();
    if (F.tid == 0) { int o = 0; for (int e = 0; e < NE1; ++e) { off[e] = o; o += (cnt[e] + 255) & ~255; } off[NE1] = o; }
    __syncthreads();
    const int gt = F.wg * NTHR + F.tid, NGT = F.G * NTHR;
    int* rowtok = (int*)(F.ws + WS_ROWTOK); int* rowdst = (int*)(F.ws + WS_ROWDST); int* tile_exp = (int*)(F.ws + WS_TILEEXP);
    const int* eidx = (const int*)(F.ws + WS_EIDX); const int* rnk = (const int*)(F.ws + WS_RNK);
    for (int a = gt; a < ntok * 8; a += NGT) { const int tok = a >> 3, k = a & 7; const int pos = off[eidx[a]] + rnk[a]; rowtok[pos] = tok; rowdst[pos] = tok * 9 + k; }
    for (int tok = gt; tok < ntok; tok += NGT) { const int pos = off[NEXP] + tok; rowtok[pos] = tok; rowdst[pos] = tok * 9 + 8; }
    for (int i = gt; i < NE1 * 256; i += NGT) { const int e = i >> 8, p = i & 255; const int row = off[e] + cnt[e] + p; if (row < off[e + 1]) { rowtok[row] = 0; rowdst[row] = -1; } }
    for (int i = gt; i < NE1 * 320; i += NGT) { const int e = i / 320, p = i % 320; const int t = (off[e] >> 8) + p; if (t < (off[e + 1] >> 8)) tile_exp[t] = e; }
    if (gt == 0) F.ctl[CW_NTL + l] = (unsigned)(off[NE1] >> 8);
}

#ifndef MK_MULTI
#define MK_MULTI 0
#endif
constexpr int PH_PER_LAYER = 12, NPHASE = 2 + DEPTH * PH_PER_LAYER;
struct Args { const float* in[36]; float* out; unsigned char* ws; int ph_lo, ph_hi; };

__global__ void __launch_bounds__(NTHR, 2) mk_fwd(Args args) {
    extern __shared__ __attribute__((aligned(16))) unsigned char lds_raw[];
    Frame F;
    F.lds = (LAS unsigned char*)lds_raw;
    F.tid = threadIdx.x; F.lane = F.tid & 63; F.wave = __builtin_amdgcn_readfirstlane(F.tid >> 6);
    const int wave0 = F.wave;
    F.G = gridDim.x; F.wg = blockIdx.x;
    F.in = args.in;
    F.out = args.out; F.ws = args.ws; F.ctl = (unsigned*)(args.ws + WS_CTL);
    volatile LAS unsigned* MISC = (volatile LAS unsigned*)(F.lds + MISC_OFF);
    if (F.tid < 32) MISC[F.tid] = 0u;
    __syncthreads();
    const int lo = args.ph_lo, hi = args.ph_hi;
    const bool single = (hi - lo) > 1;
    XcdBarrier bar; bar.bar = F.ctl + CW_BAR; bar.x = 0; bar.st = nullptr;
    if (single) bar = xcd_barrier_post(F.ctl + CW_BAR, MISC + 8);
#define IN(k) (lo <= (k) && (k) < hi)
#ifndef PROBE_MASK
#define PROBE_MASK 0
#endif
#define REP(k) for (int _rep = 0; _rep < (((PROBE_MASK >> (k)) & 1) ? 2 : 1); ++_rep)
#define SEAM(k) do { if (IN(k) && IN((k) + 1)) { xcd_barrier(bar); if ((PROBE_MASK >> 15) & 1) xcd_barrier(bar); } } while (0)
#define FRESH() do { int _ln; asm volatile("v_mbcnt_lo_u32_b32 %0, -1, 0\n\tv_mbcnt_hi_u32_b32 %0, -1, %0" : "=v"(_ln)); int _wv = wave0; asm volatile("" : "+s"(_wv)); F.lane = _ln; F.wave = _wv; F.tid = (_wv << 6) | _ln; \
        unsigned char* _w = args.ws; asm volatile("" : "+s"(_w)); F.ws = _w; F.ctl = (unsigned*)(_w + WS_CTL); float* _o = args.out; asm volatile("" : "+s"(_o)); F.out = _o; } while (0)

    if (IN(0)) { FRESH(); p0_static_weights(F); __syncthreads(); p0_mod(F); __syncthreads(); p0_hyena_filters(F); }
    SEAM(0);
    if (IN(1)) { FRESH(); p0_init_rows(F); }
    SEAM(1);
#pragma unroll 1
    for (int l = 0; l < DEPTH; ++l) {
        const int pb = 2 + l * PH_PER_LAYER; const bool last = (l == DEPTH - 1); const int ntok = last ? NLAT : NROW;
        if (IN(pb + 0)) { FRESH();
            REP(0) { p_expert_weights(F, l); __syncthreads(); }
            pg8::DenseOrder S; S.init(NROW, DIN, F.G, F.wg); pg8::EpiBf16 E{(bf16_t*)(F.ws + WS_U), DIN};
            REP(1) pg8::gemm_phase<pg8::EpiBf16, pg8::DenseOrder, false>(F.tid, F.lds, (const bf16_t*)(F.ws + WS_XM), (const bf16_t*)(F.ws + WS_WIN) + (size_t)l * DIN * DM, DM, nullptr, S, E);
        }
        SEAM(pb + 0);
        if (IN(pb + 1)) { FRESH(); REP(2) { ph_transposes(F, l); __syncthreads(); } FRESH(); REP(3) { ph_gla_local(F, l); __syncthreads(); } }
        SEAM(pb + 1);
        if (IN(pb + 2)) { FRESH(); REP(4) { ph_na(F, l, last); } FRESH(); REP(5) { ph_gla_scan(F); } __syncthreads(); FRESH(); REP(6) { ph_hyena(F, l, last); } }
        SEAM(pb + 2);
        if (IN(pb + 3)) { FRESH(); ph_hy_transpose(F, last); __syncthreads(); FRESH(); REP(7) { ph_gla_out(F, l, last); } }
        SEAM(pb + 3);
        if (IN(pb + 4)) { FRESH();
            pg8::DenseOrder S; S.init(ntok, DM, F.G, F.wg); pg8::EpiBf16 E{(bf16_t*)(F.ws + WS_Y), DM};
            REP(8) pg8::gemm_phase<pg8::EpiBf16, pg8::DenseOrder, false>(F.tid, F.lds, (const bf16_t*)(F.ws + WS_MIX), (const bf16_t*)(F.ws + WS_WOUT) + (size_t)l * DM * DM, DM, nullptr, S, E);
        }
        SEAM(pb + 4);
        if (IN(pb + 5)) { FRESH(); ph_ln1(F, l, ntok); }
        SEAM(pb + 5);
        if (IN(pb + 6)) { FRESH();
            pg8::DenseOrder S; S.init(ntok, 256, F.G, F.wg); pg8::EpiF32 E{(float*)(F.ws + WS_LOGIT), 256};
            REP(9) pg8::gemm_phase<pg8::EpiF32, pg8::DenseOrder, false>(F.tid, F.lds, (const bf16_t*)(F.ws + WS_XM), (const bf16_t*)(F.ws + WS_WR) + (size_t)l * 256 * DM, DM, nullptr, S, E);
        }
        SEAM(pb + 6);
        if (IN(pb + 7)) { FRESH(); ph_route(F, l, ntok); }
        SEAM(pb + 7);
        if (IN(pb + 8)) { FRESH(); REP(12) { ph_positions(F, l, ntok); __syncthreads(); } }
        SEAM(pb + 8);
        if (IN(pb + 9)) { FRESH();
            const int ntl = (int)__hip_atomic_load(F.ctl + CW_NTL + l, __ATOMIC_RELAXED, __HIP_MEMORY_SCOPE_AGENT);
            pg8::GroupedOrder S; S.init(ntl, 2, F.G, F.wg); S.preload((const int*)(F.ws + WS_TILEEXP), F.lds + pg8::STAGE_BYTES + 4096, F.tid, NTHR); pg8::EpiSwiglu E{(unsigned char*)(F.ws + WS_ACT)};
            REP(10) pg8::gemm_phase<pg8::EpiSwiglu, pg8::GroupedOrder, true, true>(F.tid, F.lds, (const void*)(F.ws + WS_XM8), (const void*)(F.ws + WS_EXP1), DM, (const int*)(F.ws + WS_ROWTOK), S, E);
        }
        SEAM(pb + 9);
        if (IN(pb + 10)) { FRESH();
            const int ntl = (int)__hip_atomic_load(F.ctl + CW_NTL + l, __ATOMIC_RELAXED, __HIP_MEMORY_SCOPE_AGENT);
            pg8::GroupedOrder S; S.init(ntl, 4, F.G, F.wg); S.preload((const int*)(F.ws + WS_TILEEXP), F.lds + pg8::STAGE_BYTES + 4096, F.tid, NTHR); pg8::EpiScatter E{(unsigned char*)(F.ws + WS_Y2), (const int*)(F.ws + WS_ROWDST)};
            REP(11) pg8::gemm_phase<pg8::EpiScatter, pg8::GroupedOrder, false, true>(F.tid, F.lds, (const void*)(F.ws + WS_ACT), (const void*)(F.ws + WS_EXP2), EH, nullptr, S, E);
        }
        SEAM(pb + 10);
        if (IN(pb + 11)) { FRESH(); ph_ln2(F, l, ntok, last); }
        SEAM(pb + 11);
    }
#undef IN
#undef SEAM
#undef FRESH
}

extern "C" void kernel_launch(void* const* d_in, const int* in_sizes, int n_in, void* d_out, int out_size, void* d_ws, size_t ws_size, hipStream_t stream) {
    static int grid = 0;
    if (grid == 0) {
        if (n_in != 36 || out_size != NLAT * DM || ws_size < WS_END) { fprintf(stderr, "kernel_launch: unexpected shapes (n_in %d out %d ws %zu need %zu)\n", n_in, out_size, ws_size, (size_t)WS_END); grid = -1; return; }
        int dev = 0, cus = 0, per_cu = 0;
        if (hipGetDevice(&dev) != hipSuccess || hipDeviceGetAttribute(&cus, hipDeviceAttributeMultiprocessorCount, dev) != hipSuccess) { grid = -1; return; }
        if (hipFuncSetAttribute((const void*)mk_fwd, hipFuncAttributeMaxDynamicSharedMemorySize, LDS_BYTES) != hipSuccess) { fprintf(stderr, "kernel_launch: hipFuncSetAttribute failed\n"); grid = -1; return; }
        if (hipOccupancyMaxActiveBlocksPerMultiprocessor(&per_cu, (const void*)mk_fwd, NTHR, LDS_BYTES) != hipSuccess || per_cu < 1) { fprintf(stderr, "kernel_launch: occupancy query says %d\n", per_cu); }
        (void)hipGetLastError();
        grid = cus;
    }
    if (grid < 0) return;
    (void)hipMemsetAsync((char*)d_ws + WS_CTL, 0, CTL_BYTES, stream);
    Args a{};
    for (int i = 0; i < 36; ++i) a.in[i] = (const float*)d_in[i];
    a.out = (float*)d_out; a.ws = (unsigned char*)d_ws;
#if MK_MULTI
    for (int p = 0; p < NPHASE; ++p) { a.ph_lo = p; a.ph_hi = p + 1; hipLaunchKernelGGL(mk_fwd, dim3(grid), dim3(NTHR), LDS_BYTES, stream, a); }
#else
    a.ph_lo = 0; a.ph_hi = NPHASE; hipLaunchKernelGGL(mk_fwd, dim3(grid), dim3(NTHR), LDS_BYTES, stream, a);
#endif
}
```

```cpp
#include <hip/hip_runtime.h>
#include <cstdio>
#include <cstdint>

#define LAS __attribute__((address_space(3)))
#define GAS __attribute__((address_space(1)))
typedef unsigned short bf16_t;
typedef short bf16x8 __attribute__((ext_vector_type(8)));
typedef float f32x4 __attribute__((ext_vector_type(4)));
typedef float f32x2 __attribute__((ext_vector_type(2)));
typedef unsigned u32x4 __attribute__((ext_vector_type(4)));
typedef unsigned u32x2 __attribute__((ext_vector_type(2)));

constexpr int NB = 16, SEQ = 4096, CTXL = 256, DM = 1024, DEPTH = 4;
constexpr int NLAT = NB * SEQ;
constexpr int NCTX = NB * CTXL;
constexpr int NROW = NLAT + NCTX;
constexpr int SPB = SEQ + CTXL;
constexpr int DIN_REF = 3104;
constexpr int DIN = 3328;
constexpr int UQ = 0, UK = 512, UV = 1024, UGQ = 1536, UGK = 1664, UGV = 1792, UGR = 2048, UHY = 2304, ULAF = 3072, ULAB = 3200;
constexpr int NEXP = 128, TOPK = 8, EH = 256;
constexpr int NE1 = NEXP + 1;
constexpr int RMAX = 659712;
constexpr int TMAX = RMAX / 256;
constexpr float LN_EPS = 1e-6f;
constexpr float DN_ALPHA = 1.6817928305074290f;

__device__ __forceinline__ unsigned f2bf(float f) { unsigned u = __builtin_bit_cast(unsigned, f); return (u + 0x7fffu + ((u >> 16) & 1u)) >> 16; }
typedef __bf16 bf16v2 __attribute__((ext_vector_type(2)));
__device__ __forceinline__ unsigned pk2(float lo, float hi) { const f32x2 v = {lo, hi}; const bf16v2 b = __builtin_convertvector(v, bf16v2); return __builtin_bit_cast(unsigned, b); }
__device__ __forceinline__ float bf2f(unsigned short b) { return __builtin_bit_cast(float, ((unsigned)b) << 16); }
__device__ __forceinline__ float bflo(unsigned w) { return __builtin_bit_cast(float, w << 16); }
__device__ __forceinline__ float bfhi(unsigned w) { return __builtin_bit_cast(float, w & 0xffff0000u); }
__device__ __forceinline__ float shx(float v, int o, int lane) { return __builtin_bit_cast(float, __builtin_amdgcn_ds_bpermute((lane ^ o) << 2, __builtin_bit_cast(int, v))); }
__device__ __forceinline__ int shxi(int v, int o, int lane) { return __builtin_amdgcn_ds_bpermute((lane ^ o) << 2, v); }
__device__ __forceinline__ float shf(float v, int src) { return __builtin_bit_cast(float, __builtin_amdgcn_ds_bpermute(src << 2, __builtin_bit_cast(int, v))); }
__device__ __forceinline__ float wave_sum(float v, int lane) {
#pragma unroll
    for (int o = 1; o < 64; o <<= 1) v += shx(v, o, lane);
    return v;
}
__device__ __forceinline__ void unpack8(const u32x4 q, float* o) { o[0] = bflo(q.x); o[1] = bfhi(q.x); o[2] = bflo(q.y); o[3] = bfhi(q.y); o[4] = bflo(q.z); o[5] = bfhi(q.z); o[6] = bflo(q.w); o[7] = bfhi(q.w); }
__device__ __forceinline__ float silu_f(float x) { return x / (1.0f + __expf(-x)); }
#define LDS_WAIT() asm volatile("s_waitcnt lgkmcnt(0)" ::: "memory")
#define VM_WAIT() asm volatile("s_waitcnt vmcnt(0)" ::: "memory")

#define XB_TMO      128
#define XB_XCNT(j)  (256  + 64 * (j))
#define XB_XSUB(j)  (1280 + 64 * (j))
#define XB_XGEN(j)  (2304 + 64 * (j))
#define XB_TOP      3328
#define XB_TOPGEN   3392
#define XCD_BAR_WORDS 3456
#define XB_SPIN_CAP (1u << 18)

__device__ __forceinline__ unsigned xb_ld(unsigned* p)              { return __hip_atomic_load(p, __ATOMIC_RELAXED, __HIP_MEMORY_SCOPE_AGENT); }
__device__ __forceinline__ unsigned xb_add(unsigned* p, unsigned v) { return __hip_atomic_fetch_add(p, v, __ATOMIC_RELAXED, __HIP_MEMORY_SCOPE_AGENT); }
__device__ __forceinline__ unsigned xb_xcc_id() { return (unsigned)__builtin_amdgcn_s_getreg((3 << 11) | 20) & 0xFu; }
#define XB_SPIN(cond, bar) do { unsigned _sp = 0; while (cond) { __builtin_amdgcn_s_sleep(1); \
    if ((++_sp & 255u) == 0u) { if (xb_ld(&(bar)[XB_TMO])) break; if (_sp > XB_SPIN_CAP) { atomicAdd(&(bar)[XB_TMO], 1u); break; } } } } while (0)

struct XcdBarrier { unsigned* bar; unsigned x; volatile LAS unsigned* st; };

__device__ __forceinline__ XcdBarrier xcd_barrier_post(unsigned* bar, volatile LAS unsigned* st) {
    XcdBarrier b; b.bar = bar; b.x = xb_xcc_id(); b.st = st;
    if (threadIdx.x == 0) (void)xb_add(&bar[XB_XCNT(b.x)], 1u);
    return b;
}
__device__ __forceinline__ void xcd_barrier_complete(unsigned* bar, unsigned x, unsigned& nloc, unsigned& nx) {
    const unsigned G = gridDim.x * gridDim.y * gridDim.z;
    unsigned sum, cnt, mine, sp = 0u;
    for (;;) {
        sum = 0u; cnt = 0u; mine = 0u;
#pragma unroll
        for (unsigned j = 0; j < 16; ++j) { const unsigned c = xb_ld(&bar[XB_XCNT(j)]); sum += c; cnt += (c > 0u) ? 1u : 0u; mine = (j == x) ? c : mine; }
        if (sum == G) break;
        __builtin_amdgcn_s_sleep(1);
        if ((++sp & 255u) == 0u) { if (xb_ld(&bar[XB_TMO])) break; if (sp > XB_SPIN_CAP) { atomicAdd(&bar[XB_TMO], 1u); break; } }
    }
    nloc = mine > 0u ? mine : 1u; nx = cnt > 0u ? cnt : 1u;
}
__device__ __forceinline__ void xcd_barrier(const XcdBarrier& b) {
    asm volatile("s_waitcnt vmcnt(0)" ::: "memory");
    __syncthreads();
    if (threadIdx.x == 0) {
        unsigned* bar = b.bar;
        __builtin_amdgcn_s_waitcnt(0);
        unsigned nloc = b.st[0], nx = b.st[1];
        if (nloc == 0u) { xcd_barrier_complete(bar, b.x, nloc, nx); b.st[0] = nloc; b.st[1] = nx; }
        const unsigned old = xb_add(&bar[XB_XSUB(b.x)], 1u);
        const unsigned gen = old / nloc;
        if (old + 1u == (gen + 1u) * nloc) {
            __builtin_amdgcn_fence(__ATOMIC_RELEASE, "agent");
            asm volatile("s_waitcnt vmcnt(0)" ::: "memory");
            const unsigned og = xb_add(&bar[XB_TOP], 1u);
            const unsigned tg = og / nx;
            if (og + 1u == (tg + 1u) * nx) xb_add(&bar[XB_TOPGEN], 1u);
            else XB_SPIN(xb_ld(&bar[XB_TOPGEN]) == tg, bar);
            __builtin_amdgcn_fence(__ATOMIC_ACQUIRE, "agent");
            xb_add(&bar[XB_XGEN(b.x)], 1u);
            asm volatile("s_waitcnt vmcnt(0)" ::: "memory");
        } else {
            XB_SPIN(xb_ld(&bar[XB_XGEN(b.x)]) == gen, bar);
            __builtin_amdgcn_fence(__ATOMIC_ACQUIRE, "agent");
            asm volatile("s_waitcnt vmcnt(0)" ::: "memory");
        }
    }
    __syncthreads();
}

namespace pg8 {
constexpr int BM = 256, BK = 64, HALF = 128, HTB = HALF * BK * 2, STAGE_BYTES = 8 * HTB, NXCD = 8, WGM = 8;
__host__ __device__ __forceinline__ int lds_byte(int r, int c) { const int st = (r >> 4) * 2 + (c >> 5), rr = r & 15, cc = c & 31, ob = rr * 64 + cc * 2; return st * 1024 + (ob ^ (((ob >> 9) & 1) << 5)); }
__host__ __device__ __forceinline__ void stage_rc(int b, int& R, int& C) { const int st = b / 1024, sb = b % 1024, swz = sb ^ (((sb >> 9) & 1) << 5); R = (st >> 1) * 16 + swz / 64; C = (st & 1) * 32 + (swz % 64) / 2; }
__host__ __device__ __forceinline__ int perm32(int rho) { const int n = rho >> 4, i = rho & 15; return 8 * (i >> 2) + 4 * n + (i & 3); }

struct Unit { int arow0, brow0, orow0, ocol0, aux; };

struct DenseOrder {
    int nM, nN, nwg, G, c;
    __device__ void init(int M, int N, int G_, int c_) { nM = M / BM; nN = N / BM; nwg = nM * nN; G = G_; c = c_; }
    __device__ __forceinline__ bool next(int i, Unit& u) const {
        const long L = (long)i * G + c; if (L >= nwg) return false;
        int wgid = (int)L; { const int q = nwg / NXCD, r = nwg % NXCD, xcd = wgid % NXCD, off = wgid / NXCD; wgid = (xcd < r ? xcd * (q + 1) : r * (q + 1) + (xcd - r) * q) + off; }
        const int nig = WGM * nN, gid = wgid / nig, fm = gid * WGM, gsz = (nM - fm) < WGM ? (nM - fm) : WGM;
        const int pm = fm + ((wgid % nig) % gsz), pn = (wgid % nig) / gsz;
        u.arow0 = pm * BM; u.brow0 = pn * BM; u.orow0 = pm * BM; u.ocol0 = pn * BM; u.aux = 0; return true;
    }
};
struct GroupedOrder {
    const LAS unsigned char* tab; int nN, nslot, slot, t0, t1;
    __device__ __forceinline__ void init(int ntiles, int nN_, int G, int c) {
        nN = nN_;
        if ((G & 7) == 0) { const int per = (ntiles + 7) >> 3, x = c & 7; nslot = G >> 3; slot = c >> 3; t0 = x * per; t1 = (t0 + per) < ntiles ? (t0 + per) : ntiles; }
        else { nslot = G; slot = c; t0 = 0; t1 = ntiles; }
    }
    __device__ __forceinline__ void preload(const int* tile_exp, LAS unsigned char* lds_tab, int tid, int nthr) {
        __syncthreads();
        for (int i = tid; i < t1 - t0; i += nthr) lds_tab[i] = (unsigned char)tile_exp[t0 + i];
        __syncthreads();
        tab = lds_tab;
    }
    __device__ __forceinline__ bool next(int i, Unit& u) const {
        const int q = i * nslot + slot, t = t0 + q / nN, pn = q % nN;
        if (t >= t1) return false;
        const int e = (int)tab[t - t0];
        u.arow0 = t * BM; u.brow0 = (e * nN + pn) * BM; u.orow0 = t * BM; u.ocol0 = pn * BM; u.aux = e; return true;
    }
};

__device__ __forceinline__ unsigned cvt_pk_bf16(float lo, float hi) { return pk2(lo, hi); }

struct NoPre {};
struct EpiF32 {
    static constexpr bool PERM = false; typedef NoPre Pre;
    __device__ __forceinline__ Pre prefetch(const Unit&, LAS unsigned char*, int, int, int) const { return Pre{}; }
    float* C; int ldc;
    __device__ __forceinline__ void operator()(const f32x4 (&acc)[2][2][4][2], const Unit& u, int wr, int wc, int fr, int fq, const Pre&) const {
        const int row0 = u.orow0 + wr * 64 + fr, col0 = u.ocol0 + wc * 32 + 4 * fq;
#pragma unroll
        for (int ai = 0; ai < 2; ++ai)
#pragma unroll
            for (int m = 0; m < 4; ++m) { float* rowp = C + (size_t)(row0 + ai * HALF + m * 16) * ldc + col0;
#pragma unroll
                for (int bj = 0; bj < 2; ++bj)
#pragma unroll
                    for (int n = 0; n < 2; ++n) *(f32x4*)(rowp + bj * HALF + n * 16) = acc[ai][bj][m][n]; }
    }
};
struct EpiBf16 {
    static constexpr bool PERM = true; typedef NoPre Pre;
    __device__ __forceinline__ Pre prefetch(const Unit&, LAS unsigned char*, int, int, int) const { return Pre{}; }
    bf16_t* O; int ldc;
    __device__ __forceinline__ void operator()(const f32x4 (&acc)[2][2][4][2], const Unit& u, int wr, int wc, int fr, int fq, const Pre&) const {
        const int row0 = u.orow0 + wr * 64 + fr, col0 = u.ocol0 + wc * 32 + 8 * fq;
#pragma unroll
        for (int ai = 0; ai < 2; ++ai)
#pragma unroll
            for (int m = 0; m < 4; ++m) { bf16_t* rowp = O + (size_t)(row0 + ai * HALF + m * 16) * ldc + col0;
#pragma unroll
                for (int bj = 0; bj < 2; ++bj) { const f32x4 v0 = acc[ai][bj][m][0], v1 = acc[ai][bj][m][1];
                    u32x4 w; w.x = cvt_pk_bf16(v0[0], v0[1]); w.y = cvt_pk_bf16(v0[2], v0[3]); w.z = cvt_pk_bf16(v1[0], v1[1]); w.w = cvt_pk_bf16(v1[2], v1[3]);
                    *(u32x4*)(rowp + bj * HALF) = w; } }
    }
};
struct EpiSwiglu {
    static constexpr bool PERM = true; typedef NoPre Pre;
    __device__ __forceinline__ Pre prefetch(const Unit&, LAS unsigned char*, int, int, int) const { return Pre{}; }
    unsigned char* ACT;
    __device__ __forceinline__ void operator()(const f32x4 (&acc)[2][2][4][2], const Unit& u, int wr, int wc, int fr, int fq, const Pre&) const {
        const int row0 = u.orow0 + wr * 64 + fr, pn = u.ocol0 >> 8;
#pragma unroll
        for (int ai = 0; ai < 2; ++ai)
#pragma unroll
            for (int m = 0; m < 4; ++m) { unsigned char* rowp = ACT + (size_t)(row0 + ai * HALF + m * 16) * EH + pn * 128 + wc * 32 + 8 * fq;
                int w[2];
#pragma unroll
                for (int n = 0; n < 2; ++n) { const f32x4 g = acc[ai][0][m][n], up = acc[ai][1][m][n]; float h[4];
#pragma unroll
                    for (int i = 0; i < 4; ++i) h[i] = g[i] / (1.0f + __expf(-g[i])) * up[i];
                    int v = 0; v = __builtin_amdgcn_cvt_pk_fp8_f32(h[0], h[1], v, false); v = __builtin_amdgcn_cvt_pk_fp8_f32(h[2], h[3], v, true); w[n] = v; }
                *(GAS u32x2*)rowp = (u32x2){(unsigned)w[0], (unsigned)w[1]}; }
    }
};
constexpr float Y2_SCALE = 16.0f, Y2_INV = 1.0f / 16.0f;
struct EpiScatter {
    static constexpr bool PERM = true;
    struct Pre { const LAS int* tab; };
    unsigned char* Y2; const int* rowdst;
    __device__ __forceinline__ Pre prefetch(const Unit& u, LAS unsigned char* lds, int wid, int lane, int ui) const {
        LAS unsigned char* tab = lds + STAGE_BYTES + (ui & 1) * 1024;
        if (wid < 4) __builtin_amdgcn_global_load_lds((const unsigned*)(rowdst + u.orow0 + wid * 64 + lane), (LAS unsigned*)(tab + wid * 256), 4, 0, 0);
        Pre p; p.tab = (const LAS int*)tab; return p; }
    __device__ __forceinline__ void operator()(const f32x4 (&acc)[2][2][4][2], const Unit& u, int wr, int wc, int fr, int fq, const Pre& pre) const {
#pragma unroll
        for (int ai = 0; ai < 2; ++ai)
#pragma unroll
            for (int m = 0; m < 4; ++m) { const int dst = pre.tab[wr * 64 + fr + ai * HALF + m * 16];
                if (dst >= 0) { unsigned char* rowp = Y2 + (size_t)dst * DM + u.ocol0 + wc * 64 + fq * 16;
                    int w[4];
#pragma unroll
                    for (int bj = 0; bj < 2; ++bj) { const f32x4 v0 = acc[ai][bj][m][0] * Y2_SCALE, v1 = acc[ai][bj][m][1] * Y2_SCALE;
                        int w0 = 0, w1 = 0;
                        w0 = __builtin_amdgcn_cvt_pk_fp8_f32(v0[0], v0[1], w0, false); w0 = __builtin_amdgcn_cvt_pk_fp8_f32(v0[2], v0[3], w0, true);
                        w1 = __builtin_amdgcn_cvt_pk_fp8_f32(v1[0], v1[1], w1, false); w1 = __builtin_amdgcn_cvt_pk_fp8_f32(v1[2], v1[3], w1, true);
                        w[2 * bj] = w0; w[2 * bj + 1] = w1; }
                    *(GAS u32x4*)rowp = (u32x4){(unsigned)w[0], (unsigned)w[1], (unsigned)w[2], (unsigned)w[3]}; } }
    }
};

typedef int v8i __attribute__((ext_vector_type(8)));
typedef int v4i __attribute__((ext_vector_type(4)));
struct Frag { bf16x8 p[2]; __device__ __forceinline__ bf16x8& operator[](int k) { return p[k]; } __device__ __forceinline__ const bf16x8& operator[](int k) const { return p[k]; } };
template <class Epi, class Sched, bool GATHER, bool F8 = false, bool ALIGN_EPI = true, bool SP2 = true>
__device__ __forceinline__ void gemm_phase(const int tid_in, LAS unsigned char* lds, const void* Ag, const void* Bg, const int K, const int* rowidx, const Sched& S, const Epi& E) {
    int tid_ = tid_in; asm volatile("" : "+v"(tid_));
    const int tid = tid_, wid = __builtin_amdgcn_readfirstlane(tid >> 6), lane = tid & 63, wr = wid >> 2, wc = wid & 3, fr = lane & 15, fq = lane >> 4;
    const int KB = F8 ? K : 2 * K;
    const int nt = KB / 128;
    unsigned voffB[2];
#pragma unroll
    for (int i = 0; i < 2; ++i) { int R, C; stage_rc(tid * 16 + i * 8192, R, C); const int Rb = Epi::PERM ? ((R & ~31) + perm32(R & 31)) : R;
        voffB[i] = (unsigned)(Rb * KB + C * 2); }
    const size_t kstep = (size_t)128;
    const size_t hstep = (size_t)HALF * KB;
    const unsigned ldsw = (unsigned)wid * 1024u;
    const int aoff = F8 ? lds_byte(wr * 64 + fr, 16 * fq) : lds_byte(wr * 64 + fr, fq * 8), boff = F8 ? lds_byte(wc * 32 + fr, 16 * fq) : lds_byte(wc * 32 + fr, fq * 8);
    constexpr int PIECE1 = F8 ? 16 : 1024;
    const int sc_w = 0x7A7A7A7A, sc_a = 0x7F7F7F7F;
#define PG8_SA(b, h) (((b) * 2 + (h)) * HTB)
#define PG8_SB(b, h) ((4 + (b) * 2 + (h)) * HTB)
#define PG8_STAGE_B(bufoff, gbase) do { _Pragma("unroll") for (int _i = 0; _i < 2; ++_i) \
        __builtin_amdgcn_global_load_lds((const unsigned*)((const char*)(gbase) + voffB[_i]), (LAS unsigned*)(lds + (bufoff) + ldsw + _i * 8192), 16, 0, 0); } while (0)
#define PG8_STAGE_A(bufoff, gbase, h) do { const char* _gb = (const char*)(gbase) + (GATHER ? (size_t)0 : (size_t)(h) * hstep); \
        __builtin_amdgcn_global_load_lds((const unsigned*)(_gb + ac[GATHER ? (h) : 0][0]), (LAS unsigned*)(lds + (bufoff) + ldsw), 16, 0, 0); \
        __builtin_amdgcn_global_load_lds((const unsigned*)(_gb + ac[GATHER ? (h) : 0][1]), (LAS unsigned*)(lds + (bufoff) + ldsw + 8192), 16, 0, 0); } while (0)
#define PG8_LDA(dst, b, h) do { _Pragma("unroll") for (int m = 0; m < 4; ++m) { if constexpr (F8) { const v4i _l = *(const LAS v4i*)(lds + PG8_SA(b, h) + aoff + m * 2048), _h = *(const LAS v4i*)(lds + PG8_SA(b, h) + aoff + m * 2048 + PIECE1); dst##8[m] = __builtin_shufflevector(_l, _h, 0, 1, 2, 3, 4, 5, 6, 7); } \
        else { dst[m][0] = *(const LAS bf16x8*)(lds + PG8_SA(b, h) + aoff + m * 2048); dst[m][1] = *(const LAS bf16x8*)(lds + PG8_SA(b, h) + aoff + m * 2048 + PIECE1); } } } while (0)
#define PG8_LDB(dst, b, h) do { _Pragma("unroll") for (int n = 0; n < 2; ++n) { if constexpr (F8) { const v4i _l = *(const LAS v4i*)(lds + PG8_SB(b, h) + boff + n * 2048), _h = *(const LAS v4i*)(lds + PG8_SB(b, h) + boff + n * 2048 + PIECE1); dst##8[n] = __builtin_shufflevector(_l, _h, 0, 1, 2, 3, 4, 5, 6, 7); } \
        else { dst[n][0] = *(const LAS bf16x8*)(lds + PG8_SB(b, h) + boff + n * 2048); dst[n][1] = *(const LAS bf16x8*)(lds + PG8_SB(b, h) + boff + n * 2048 + PIECE1); } } } while (0)
#define PG8_MMA(ai, bj, At, Bt) do { __builtin_amdgcn_s_setprio(1); _Pragma("unroll") for (int m = 0; m < 4; ++m) _Pragma("unroll") for (int n = 0; n < 2; ++n) { \
        if constexpr (F8) asm volatile("v_mfma_scale_f32_16x16x128_f8f6f4 %0, %1, %2, %0, %3, %4 op_sel_hi:[0,0,0]" : "+v"(acc[ai][bj][m][n]) : "v"(Bt##8[n]), "v"(At##8[m]), "v"(sc_w), "v"(sc_a)); \
        else { _Pragma("unroll") for (int k = 0; k < 2; ++k) acc[ai][bj][m][n] = __builtin_amdgcn_mfma_f32_16x16x32_bf16(Bt[n][k], At[m][k], acc[ai][bj][m][n], 0, 0, 0); } } \
        __builtin_amdgcn_s_setprio(0); } while (0)
#define PG8_WAIT_V(n) asm volatile("s_waitcnt vmcnt(" #n ")" ::: "memory")
#define PG8_WAIT_L(n) asm volatile("s_waitcnt lgkmcnt(" #n ")" ::: "memory")
#define PG8_BAR __builtin_amdgcn_s_barrier()
#define PG8_SCHED __builtin_amdgcn_sched_barrier(0)
#define PG8_TAB(par) (lds + STAGE_BYTES + 2048 + (par) * 1024)
#define PG8_TABLOAD(par, row0) do { if (wid < 4) __builtin_amdgcn_global_load_lds((const unsigned*)(rowidx + (row0) + wid * 64 + lane), (LAS unsigned*)(PG8_TAB(par) + wid * 256), 4, 0, 0); } while (0)
#define PG8_AOFF_H(h, par) do { int _tz = tid; asm volatile("" : "+v"(_tz)); _Pragma("unroll") for (int _i = 0; _i < 2; ++_i) { int _R, _C; stage_rc(_tz * 16 + _i * 8192, _R, _C); \
        if (GATHER) ac[h][_i] = ((const LAS unsigned*)PG8_TAB(par))[(h) * HALF + _R] * (unsigned)KB + (unsigned)_C * 2u; \
        else ac[h][_i] = (unsigned)(((h) * HALF + _R) * KB) + (unsigned)_C * 2u; } } while (0)
    static_assert(SP2, "only the two-super-phase K-loop is kept");
    Unit cur, nxt; int ui = 0;
    if (!S.next(0, cur)) return;
    f32x4 acc[2][2][4][2];
#pragma unroll
    for (int a = 0; a < 2; ++a)
#pragma unroll
        for (int b = 0; b < 2; ++b)
#pragma unroll
            for (int m = 0; m < 4; ++m)
#pragma unroll
                for (int n = 0; n < 2; ++n) acc[a][b][m][n] = (f32x4){0.f, 0.f, 0.f, 0.f};
    bf16x8 At[F8 ? 1 : 4][2], B0[F8 ? 1 : 2][2], B1[F8 ? 1 : 2][2];
    v8i At8[F8 ? 4 : 1], B08[F8 ? 2 : 1], B18[F8 ? 2 : 1];
    unsigned ac[GATHER ? 2 : 1][2];
    if (GATHER) { PG8_TABLOAD(0, cur.arow0); PG8_WAIT_V(0); PG8_BAR; }
    PG8_AOFF_H(0, 0); if (GATHER) { PG8_AOFF_H((GATHER ? 1 : 0), 0); }
    const char* cA = (const char*)Ag + (GATHER ? (size_t)0 : (size_t)cur.arow0 * KB); const char* cB = (const char*)Bg + (size_t)cur.brow0 * KB;
    PG8_STAGE_B(PG8_SB(0, 0), cB); PG8_STAGE_B(PG8_SB(0, 1), cB + hstep); PG8_STAGE_A(PG8_SA(0, 0), cA, 0); PG8_STAGE_A(PG8_SA(0, 1), cA, 1);
    if (wr == 1) PG8_BAR;
    PG8_WAIT_V(2); PG8_BAR;
    PG8_STAGE_B(PG8_SB(1, 0), cB + kstep); PG8_STAGE_A(PG8_SA(1, 0), cA + kstep, 0); PG8_STAGE_B(PG8_SB(1, 1), cB + hstep + kstep);
    PG8_WAIT_V(6); PG8_BAR;
    for (;;) {
        const typename Epi::Pre pre = E.prefetch(cur, lds, wid, lane, ui);
        const bool has_next = S.next(ui + 1, nxt);
        if (GATHER) { if (has_next) PG8_TABLOAD((ui + 1) & 1, nxt.arow0); }
        const char* nA = has_next ? ((const char*)Ag + (GATHER ? (size_t)0 : (size_t)nxt.arow0 * KB)) : cA; const char* nB = has_next ? (const char*)Bg + (size_t)nxt.brow0 * KB : cB;
_Pragma("nounroll")
        for (int t = 0; t < nt; t += 2) {
            const bool last = (t == nt - 2);
            const char* a1 = cA + (size_t)(t + 1) * kstep;
            const char* a2 = last ? nA : cA + (size_t)(t + 2) * kstep; const char* b2 = last ? nB : cB + (size_t)(t + 2) * kstep;
            const char* a3 = a2 + kstep; const char* b3 = b2 + kstep;
            if (GATHER) { if (last && has_next) { PG8_AOFF_H(0, (ui + 1) & 1); } }
            PG8_LDB(B0, 0, 0); PG8_LDB(B1, 0, 1); PG8_SCHED; PG8_LDA(At, 0, 0); PG8_STAGE_A(PG8_SA(1, 1), a1, 1);
            PG8_WAIT_V(8); PG8_WAIT_L(0); PG8_BAR; PG8_MMA(0, 0, At, B0); PG8_MMA(0, 1, At, B1); PG8_BAR; PG8_SCHED;
            if (GATHER) { if (last && has_next) { PG8_AOFF_H(1, (ui + 1) & 1); } }
            PG8_LDA(At, 0, 1); PG8_STAGE_B(PG8_SB(0, 0), b2); PG8_STAGE_B(PG8_SB(0, 1), b2 + hstep); PG8_STAGE_A(PG8_SA(0, 0), a2, 0);
            PG8_WAIT_V(8); PG8_WAIT_L(0); PG8_BAR; PG8_MMA(1, 0, At, B0); PG8_MMA(1, 1, At, B1); PG8_BAR; PG8_SCHED;
            PG8_LDB(B0, 1, 0); PG8_LDB(B1, 1, 1); PG8_SCHED; PG8_LDA(At, 1, 0); PG8_STAGE_A(PG8_SA(0, 1), a2, 1);
            PG8_WAIT_V(8); PG8_WAIT_L(0); PG8_BAR; PG8_MMA(0, 0, At, B0); PG8_MMA(0, 1, At, B1); PG8_BAR; PG8_SCHED;
            PG8_LDA(At, 1, 1); PG8_STAGE_B(PG8_SB(1, 0), b3); PG8_STAGE_B(PG8_SB(1, 1), b3 + hstep); PG8_STAGE_A(PG8_SA(1, 0), a3, 0);
            PG8_WAIT_V(8); PG8_WAIT_L(0); PG8_BAR; PG8_MMA(1, 0, At, B0); PG8_MMA(1, 1, At, B1); PG8_BAR; PG8_SCHED;
        }
        if constexpr (ALIGN_EPI) { if (wr == 0) PG8_BAR; }
        E(acc, cur, wr, wc, fr, fq, pre);
        if (!has_next) break;
#pragma unroll
        for (int a = 0; a < 2; ++a)
#pragma unroll
            for (int b = 0; b < 2; ++b)
#pragma unroll
                for (int m = 0; m < 4; ++m)
#pragma unroll
                    for (int n = 0; n < 2; ++n) acc[a][b][m][n] = (f32x4){0.f, 0.f, 0.f, 0.f};
        cur = nxt; cA = nA; cB = nB; ++ui;
        if constexpr (ALIGN_EPI) { if (wr == 1) PG8_BAR; }
    }
    PG8_WAIT_V(0);
    if constexpr (!ALIGN_EPI) { if (wr == 0) PG8_BAR; }
    PG8_BAR;
#undef PG8_SA
#undef PG8_SB
#undef PG8_STAGE_A
#undef PG8_STAGE_B
#undef PG8_LDA
#undef PG8_LDB
#undef PG8_MMA
#undef PG8_WAIT_V
#undef PG8_WAIT_L
#undef PG8_BAR
#undef PG8_SCHED
#undef PG8_AOFF_H
#undef PG8_TAB
#undef PG8_TABLOAD
}
}

constexpr int NWAVES = 8, NTHR = 512;
constexpr size_t MiB = 1u << 20;
constexpr size_t WS_CTL = 0, CTL_BYTES = 1 * MiB;
constexpr size_t WS_MOD = 1 * MiB;
constexpr size_t WS_WIN = 3 * MiB;
constexpr size_t WS_WOUT = 29 * MiB;
constexpr size_t WS_WR = 37 * MiB;
constexpr size_t WS_HYF = 39 * MiB;
constexpr size_t WS_HYFC = 71 * MiB;
constexpr size_t WS_XC = 73 * MiB;
constexpr size_t WS_EXP1 = 89 * MiB;
constexpr size_t WS_EXP2 = 218 * MiB;
constexpr size_t WS_XM = 283 * MiB;
constexpr size_t WS_EIDX = 419 * MiB;
constexpr size_t WS_WGT = 422 * MiB;
constexpr size_t WS_RNK = 425 * MiB;
constexpr size_t WS_ROWTOK = 428 * MiB;
constexpr size_t WS_ROWDST = 431 * MiB;
constexpr size_t WS_TILEEXP = 434 * MiB;
constexpr size_t WS_BIG = 435 * MiB;
constexpr size_t WS_U = WS_BIG;
constexpr size_t WS_MIX = 877 * MiB;
constexpr size_t WS_VT = 1013 * MiB;
constexpr size_t WS_HV = 1081 * MiB;
constexpr size_t WS_Z2 = 1183 * MiB;
constexpr size_t WS_GDS = 1217 * MiB;
constexpr size_t WS_GSIN = 1285 * MiB;
constexpr size_t WS_GD = 1319 * MiB;
constexpr size_t WS_Y = 1321 * MiB;
constexpr size_t WS_LOGIT = WS_BIG;
constexpr size_t WS_ACT = WS_BIG;
constexpr size_t WS_Y2 = 758 * MiB;
constexpr size_t WS_XM8 = 1470 * MiB;
constexpr size_t WS_XR = 1600 * MiB;
constexpr size_t WS_END = 1736 * MiB;
constexpr int CW_BAR = 4096;
constexpr int CW_CNT = 16384;
constexpr int CW_NTL = 20480;

constexpr int LDS_BYTES = 163840;
constexpr int MISC_OFF = 163584;

struct Frame {
    LAS unsigned char* lds;
    int tid, lane, wave, G, wg;
    const float* const* in;
    float* out; unsigned char* ws; unsigned* ctl;
};
enum { I_X = 0, I_C, I_CTX, I_CCTX, I_WMOD, I_BMOD, I_WIN, I_RPB, I_WA2, I_BA2, I_GNORM, I_HSW, I_HSB, I_HW1, I_HB1, I_HF1, I_HW2, I_HB2, I_HF2, I_HW3, I_HB3, I_HDEC, I_HSKIP,
       I_WOUT, I_LN1G, I_LN1B, I_RW, I_RB, I_WEG, I_WEU, I_WED, I_WSG, I_WSU, I_WSD, I_LN2G, I_LN2B };

__device__ __forceinline__ int row_b(int row) { return row < NLAT ? (row >> 12) : 16; }
__device__ __forceinline__ const float* mod_ptr(const Frame& F, int l, int row) { return (const float*)(F.ws + WS_MOD) + ((size_t)l * 17 + row_b(row)) * 6144; }

template <class RowFn>
__device__ __forceinline__ void tr_item(const float* W, int ldw, int k0, int n0, bf16_t* dst, int ldd, RowFn rf, LAS float* scr, int lane) {
    float tv[32];
    const GAS float* wp = (const GAS float*)(W + (size_t)(k0 + (lane >> 5)) * ldw + n0 + (lane & 31));
#pragma unroll
    for (int i = 0; i < 32; ++i) tv[i] = wp[(size_t)(2 * i) * ldw];
#pragma unroll
    for (int i = 0; i < 32; ++i) scr[(2 * i + (lane >> 5)) * 33 + (lane & 31)] = tv[i];
    LDS_WAIT(); asm volatile("" ::: "memory");
    const int c = lane & 7;
#pragma unroll
    for (int j = 0; j < 4; ++j) { const int n = (lane >> 3) + 8 * j; const LAS float* s = scr + (8 * c) * 33 + n;
        u32x4 o; o.x = pk2(s[0 * 33], s[1 * 33]); o.y = pk2(s[2 * 33], s[3 * 33]); o.z = pk2(s[4 * 33], s[5 * 33]); o.w = pk2(s[6 * 33], s[7 * 33]);
        *(GAS u32x4*)(dst + (size_t)rf(n0 + n) * ldd + k0 + 8 * c) = o; }
    LDS_WAIT(); asm volatile("" ::: "memory");
}
template <class RowFn>
__device__ __forceinline__ void tr_item8(const float* W, int ldw, int k0, int n0, unsigned char* dst, int ldd, RowFn rf, float scale, LAS float* scr, int lane) {
    float tv[32];
    const GAS float* wp = (const GAS float*)(W + (size_t)(k0 + (lane >> 5)) * ldw + n0 + (lane & 31));
#pragma unroll
    for (int i = 0; i < 32; ++i) tv[i] = wp[(size_t)(2 * i) * ldw];
#pragma unroll
    for (int i = 0; i < 32; ++i) scr[(2 * i + (lane >> 5)) * 33 + (lane & 31)] = tv[i];
    LDS_WAIT(); asm volatile("" ::: "memory");
    const int n = lane >> 1, hf = lane & 1; const LAS float* s = scr + (32 * hf) * 33 + n;
    unsigned w[8];
#pragma unroll
    for (int j = 0; j < 8; ++j) { int v = 0; v = __builtin_amdgcn_cvt_pk_fp8_f32(s[(4 * j) * 33] * scale, s[(4 * j + 1) * 33] * scale, v, false); v = __builtin_amdgcn_cvt_pk_fp8_f32(s[(4 * j + 2) * 33] * scale, s[(4 * j + 3) * 33] * scale, v, true); w[j] = (unsigned)v; }
    unsigned char* d = dst + (size_t)rf(n0 + n) * ldd + k0 + 32 * hf;
    *(GAS u32x4*)d = (u32x4){w[0], w[1], w[2], w[3]}; *(GAS u32x4*)(d + 16) = (u32x4){w[4], w[5], w[6], w[7]};
    LDS_WAIT(); asm volatile("" ::: "memory");
}
struct RowId { __device__ __forceinline__ int operator()(int n) const { return n; } };
struct RowWin { __device__ __forceinline__ int operator()(int n) const { return n >= 2336 ? n - 32 : n; } };
struct RowGU { int up; __device__ __forceinline__ int operator()(int j) const { return (j >> 7) * 256 + up * 128 + (j & 127); } };

__device__ __forceinline__ void p0_static_weights(Frame& F) {
    LAS float* scr = (LAS float*)(F.lds + F.wave * 16384);
    const int gw = F.wg * NWAVES + F.wave, NGW = F.G * NWAVES;
    constexpr int I_IN = 16 * 97, I_OUT = 16 * 32, I_R = 16 * 4, PER_L = I_IN + I_OUT + I_R;
    for (int it = gw; it < DEPTH * PER_L; it += NGW) {
        const int l = it / PER_L; int r = it % PER_L;
        if (r < I_IN) { const int kb = r / 97, nb = r % 97; if (nb == 72) continue;
            tr_item(F.in[I_WIN] + (size_t)l * DM * DIN_REF, DIN_REF, kb * 64, nb * 32, (bf16_t*)(F.ws + WS_WIN) + (size_t)l * DIN * DM, DM, RowWin{}, scr, F.lane); continue; }
        r -= I_IN;
        if (r < I_OUT) { const int kb = r / 32, nb = r % 32;
            tr_item(F.in[I_WOUT] + (size_t)l * DM * DM, DM, kb * 64, nb * 32, (bf16_t*)(F.ws + WS_WOUT) + (size_t)l * DM * DM, DM, RowId{}, scr, F.lane); continue; }
        r -= I_OUT;
        { const int kb = r / 4, nb = r % 4;
            tr_item(F.in[I_RW] + (size_t)l * DM * NEXP, NEXP, kb * 64, nb * 32, (bf16_t*)(F.ws + WS_WR) + (size_t)l * 256 * DM, DM, RowId{}, scr, F.lane); }
    }
    const int gt = F.wg * NTHR + F.tid, NGT = F.G * NTHR;
    for (int i = gt; i < DEPTH * 128 * DM / 8; i += NGT) { const int l = i / (128 * DM / 8), r = i % (128 * DM / 8);
        *(u32x4*)((bf16_t*)(F.ws + WS_WR) + ((size_t)l * 256 + 128) * DM + (size_t)r * 8) = (u32x4){0u, 0u, 0u, 0u}; }
    for (int i = gt; i < DEPTH * 256 * DM; i += NGT) {
        const int k = i % DM, n = (i / DM) % 256, l = i / (DM * 256), dir = n >> 7, j = n & 127;
        const float* wi = F.in[I_WIN] + ((size_t)l * DM + k) * DIN_REF + 2304 + dir * 16;
        const float* wa = F.in[I_WA2] + ((size_t)(l * 2 + dir) * 16) * 128 + j;
        float s = 0.f;
#pragma unroll
        for (int r = 0; r < 16; ++r) s += wi[r] * wa[r * 128];
        ((bf16_t*)(F.ws + WS_WIN))[((size_t)l * DIN + 3072 + n) * DM + k] = (bf16_t)f2bf(s);
    }
}
__device__ __forceinline__ void p0_mod(Frame& F) {
    LAS float* sc = (LAS float*)F.lds;
    LAS float* red = (LAS float*)(F.lds + 17 * 1024 * 4);
    for (int i = F.tid; i < 17 * 1024; i += NTHR) { const int r = i >> 10, k = i & 1023; const float v = r < 16 ? F.in[I_C][r * 1024 + k] : F.in[I_CCTX][k]; sc[i] = silu_f(v); }
    __syncthreads();
    const int kq = F.tid >> 7, cl = F.tid & 127;
    for (int u = F.wg; u < DEPTH * 48; u += F.G) {
        const int l = u / 48, col = (u % 48) * 128 + cl;
        const float* w = F.in[I_WMOD] + (size_t)l * DM * 6144 + col;
        float a[17];
#pragma unroll
        for (int r = 0; r < 17; ++r) a[r] = 0.f;
        for (int k0 = kq * 256; k0 < kq * 256 + 256; k0 += 16) {
            float wv[16];
#pragma unroll
            for (int q = 0; q < 16; ++q) wv[q] = *(const GAS float*)(w + (size_t)(k0 + q) * 6144);
#pragma unroll
            for (int q = 0; q < 16; ++q)
#pragma unroll
                for (int r = 0; r < 17; ++r) a[r] += sc[r * 1024 + k0 + q] * wv[q]; }
#pragma unroll
        for (int r = 0; r < 17; ++r) red[(kq * 17 + r) * 128 + cl] = a[r];
        __syncthreads();
        for (int i = F.tid; i < 17 * 128; i += NTHR) { const int r = i >> 7, c2 = i & 127, cc = (u % 48) * 128 + c2;
            const float s = red[(0 * 17 + r) * 128 + c2] + red[(1 * 17 + r) * 128 + c2] + red[(2 * 17 + r) * 128 + c2] + red[(3 * 17 + r) * 128 + c2] + F.in[I_BMOD][l * 6144 + cc];
            ((float*)(F.ws + WS_MOD))[((size_t)l * 17 + r) * 6144 + cc] = s; }
        __syncthreads();
    }
}
__device__ __forceinline__ void p0_hyena_filters(Frame& F) {
    LAS float* z = (LAS float*)F.lds;
    LAS float* h1 = z + 33 * 33;
    LAS float* h2 = h1 + 33 * 64;
    LAS float* tt = h2 + 33 * 64;
    LAS float* W1 = tt + 64;
    LAS float* W2 = W1 + 33 * 64;
    constexpr int UL = 4096 / 32, UC = 256 / 32, UPL = UL + UC;
    for (int u = F.wg; u < DEPTH * UPL; u += F.G) {
        const int l = u / UPL, r = u % UPL; const bool lat = r < UL; const int L = lat ? 4096 : 256, n0 = (lat ? r : r - UL) * 32;
        __syncthreads();
        for (int i = F.tid; i < 33 * 64; i += NTHR) W1[i] = F.in[I_HW1][(size_t)l * 33 * 64 + i];
        for (int i = F.tid; i < 64 * 64; i += NTHR) W2[i] = F.in[I_HW2][(size_t)l * 64 * 64 + i];
        for (int i = F.tid; i < 33 * 33; i += NTHR) { const int p = i / 33, e = i % 33, n = n0 + p;
            const float t = (float)n / (float)(L - 1);
            float v;
            if (e == 0) v = t;
            else { const int kb = (e - 1) & 15; const float band = 1e-4f + (float)kb * ((15.0f - 1e-4f) / 15.0f);
                   const float w = 6.283185307179586f * (float)n / (float)L; const float ang = w * band;
                   v = e <= 16 ? __cosf(ang) : -__sinf(ang); }
            z[i] = v; if (e == 0) tt[p] = t; }
        __syncthreads();
        for (int i = F.tid; i < 33 * 64; i += NTHR) { const int p = i >> 6, j = i & 63; float s = F.in[I_HB1][l * 64 + j];
#pragma unroll 11
            for (int e = 0; e < 33; ++e) s += z[p * 33 + e] * W1[e * 64 + j];
            h1[i] = __sinf(F.in[I_HF1][l * 64 + j] * s); }
        __syncthreads();
        for (int i = F.tid; i < 33 * 64; i += NTHR) { const int p = i >> 6, j = i & 63; float s = F.in[I_HB2][l * 64 + j];
#pragma unroll 16
            for (int e = 0; e < 64; ++e) s += h1[p * 64 + e] * W2[e * 64 + j];
            h2[i] = __sinf(F.in[I_HF2][l * 64 + j] * s); }
        __syncthreads();
#pragma unroll 1
        for (int cc = 0; cc < 2; ++cc) {
            const int col = F.tid + cc * 512, o = col >> 9, dir = (col >> 8) & 1, ch = col & 255;
            float a[33];
#pragma unroll
            for (int p = 0; p < 33; ++p) a[p] = 0.f;
            const float* w3 = F.in[I_HW3] + (size_t)l * 64 * 1024 + col;
            for (int k0 = 0; k0 < 64; k0 += 16) { float wv[16];
#pragma unroll
                for (int q = 0; q < 16; ++q) wv[q] = *(const GAS float*)(w3 + (size_t)(k0 + q) * 1024);
#pragma unroll
                for (int q = 0; q < 16; ++q)
#pragma unroll
                    for (int p = 0; p < 33; ++p) a[p] += h2[p * 64 + k0 + q] * wv[q]; }
            const float b3 = F.in[I_HB3][l * 1024 + col], dec = fabsf(F.in[I_HDEC][((size_t)(l * 2 + o) * 2 + dir) * 256 + ch]);
            const float skip = F.in[I_HSKIP][(l * 2 + o) * 256 + ch];
            bf16_t* R = lat ? (bf16_t*)(F.ws + WS_HYF) + ((size_t)(l * 2 + o) * 256 + ch) * 8192 : (bf16_t*)(F.ws + WS_HYFC) + ((size_t)(l * 2 + o) * 256 + ch) * 512;
#pragma unroll
            for (int p = 0; p < 33; ++p) a[p] = (a[p] + b3) * __expf(-tt[p] * dec);
            unsigned w[16];
            if (dir == 0) {
                if (n0 + 32 == L) a[32] = 0.f;
#pragma unroll
                for (int j = 0; j < 16; ++j) w[j] = pk2(a[32 - 2 * j], a[31 - 2 * j]);
                GAS u32x4* dst = (GAS u32x4*)(R + (L - n0 - 32));
                dst[0] = (u32x4){w[0], w[1], w[2], w[3]}; dst[1] = (u32x4){w[4], w[5], w[6], w[7]}; dst[2] = (u32x4){w[8], w[9], w[10], w[11]}; dst[3] = (u32x4){w[12], w[13], w[14], w[15]};
                if (n0 == 0) R[L] = (bf16_t)f2bf(a[0] + skip);
            } else if (n0 > 0) {
#pragma unroll
                for (int j = 0; j < 16; ++j) w[j] = pk2(a[2 * j], a[2 * j + 1]);
                GAS u32x4* dst = (GAS u32x4*)(R + (L + n0));
                dst[0] = (u32x4){w[0], w[1], w[2], w[3]}; dst[1] = (u32x4){w[4], w[5], w[6], w[7]}; dst[2] = (u32x4){w[8], w[9], w[10], w[11]}; dst[3] = (u32x4){w[12], w[13], w[14], w[15]};
            } else {
#pragma unroll
                for (int p = 1; p < 32; ++p) R[L + p] = (bf16_t)f2bf(a[p]);
            }
        }
    }
    __syncthreads();
}
__device__ __forceinline__ void p0_init_rows(Frame& F) {
    const int gw = F.wg * NWAVES + F.wave, NGW = F.G * NWAVES;
    for (int row = gw; row < NROW; row += NGW) {
        const float* src = row < NLAT ? F.in[I_X] + (size_t)row * DM : F.in[I_CTX] + (size_t)(row - NLAT) * DM;
        const float* md = mod_ptr(F, 0, row);
        bf16_t* xr = (bf16_t*)(F.ws + WS_XR) + (size_t)row * DM; bf16_t* xm = (bf16_t*)(F.ws + WS_XM) + (size_t)row * DM;
#pragma unroll
        for (int j = 0; j < 4; ++j) { const int c = 4 * F.lane + 256 * j;
            const f32x4 v = *(const GAS f32x4*)(src + c), sh = *(const GAS f32x4*)(md + c), sc = *(const GAS f32x4*)(md + 1024 + c);
            *(GAS u32x2*)(xr + c) = (u32x2){pk2(v[0], v[1]), pk2(v[2], v[3])};
            u32x2 w; w.x = pk2(v[0] * (1.f + sc[0]) + sh[0], v[1] * (1.f + sc[1]) + sh[1]); w.y = pk2(v[2] * (1.f + sc[2]) + sh[2], v[3] * (1.f + sc[3]) + sh[3]);
            *(GAS u32x2*)(xm + c) = w; }
    }
}
constexpr float WEXP_SCALE = 32.0f;
__device__ __forceinline__ void p_expert_weights(Frame& F, int l) {
    LAS float* scr = (LAS float*)(F.lds + F.wave * 16384);
    const int gw = F.wg * NWAVES + F.wave, NGW = F.G * NWAVES;
    constexpr int I1 = 16 * 8, I2 = 4 * 32, PER_E = 2 * I1 + I2;
    for (int it = gw; it < NE1 * PER_E; it += NGW) {
        const int e = it / PER_E; int r = it % PER_E;
        unsigned char* d1 = (unsigned char*)(F.ws + WS_EXP1) + (size_t)e * 512 * DM; unsigned char* d2 = (unsigned char*)(F.ws + WS_EXP2) + (size_t)e * DM * EH;
        if (r < 2 * I1) { const int up = r >= I1; if (up) r -= I1; const int kb = r / 8, nb = r % 8;
            const float* src = e < NEXP ? F.in[up ? I_WEU : I_WEG] + ((size_t)l * NEXP + e) * DM * EH : F.in[up ? I_WSU : I_WSG] + (size_t)l * DM * EH;
            tr_item8(src, EH, kb * 64, nb * 32, d1, DM, RowGU{up}, WEXP_SCALE, scr, F.lane); }
        else { r -= 2 * I1; const int kb = r / 32, nb = r % 32;
            const float* src = e < NEXP ? F.in[I_WED] + ((size_t)l * NEXP + e) * EH * DM : F.in[I_WSD] + (size_t)l * EH * DM;
            tr_item8(src, DM, kb * 64, nb * 32, d2, EH, RowId{}, WEXP_SCALE, scr, F.lane); }
    }
}

__device__ __forceinline__ f32x4 mfma16(bf16x8 a, bf16x8 b, f32x4 c) { return __builtin_amdgcn_mfma_f32_16x16x32_bf16(a, b, c, 0, 0, 0); }

__device__ __forceinline__ void ph_transposes(Frame& F, int l) {
    LAS bf16_t* tile = (LAS bf16_t*)(F.lds + F.wave * 16384);
    const bf16_t* U = (const bf16_t*)(F.ws + WS_U);
    const int gw = F.wg * NWAVES + F.wave, NGW = F.G * NWAVES;
    const int rsub = F.lane >> 3, cseg = F.lane & 7;
    for (int u = gw; u < 1088 * 20; u += NGW) {
        const int tt = u / 20, blk = u % 20;
        int b, s0, Ls, rowbase, posbase;
        if (tt < 1024) { b = tt >> 6; s0 = (tt & 63) * 64; Ls = SEQ; rowbase = b * SEQ; posbase = 0; }
        else { const int t2 = tt - 1024; b = t2 >> 2; s0 = (t2 & 3) * 64; Ls = CTXL; rowbase = NLAT + b * CTXL; posbase = SEQ; }
        if (blk < 12) {
            const int c0 = blk * 64 + cseg * 8;
            float w0[8], w1[8], w2[8], bb[8];
#pragma unroll
            for (int i = 0; i < 8; ++i) { w0[i] = F.in[I_HSW][(l * 3 + 0) * 768 + c0 + i]; w1[i] = F.in[I_HSW][(l * 3 + 1) * 768 + c0 + i]; w2[i] = F.in[I_HSW][(l * 3 + 2) * 768 + c0 + i]; bb[i] = F.in[I_HSB][l * 768 + c0 + i]; }
#pragma unroll 2
            for (int it = 0; it < 8; ++it) {
                const int sl = rsub + 8 * it, s = s0 + sl;
                const bf16_t* p = U + (size_t)(rowbase + s) * DIN + UHY + c0;
                const u32x4 zc = *(const u32x4*)p;
                u32x4 zm = (u32x4){0u, 0u, 0u, 0u}, zp = (u32x4){0u, 0u, 0u, 0u};
                if (s > 0) zm = *(const u32x4*)(p - DIN);
                if (s < Ls - 1) zp = *(const u32x4*)(p + DIN);
                const unsigned am[4] = {zm.x, zm.y, zm.z, zm.w}, ac[4] = {zc.x, zc.y, zc.z, zc.w}, ap[4] = {zp.x, zp.y, zp.z, zp.w};
#pragma unroll
                for (int i = 0; i < 4; ++i) {
                    const float v0 = bb[2 * i] + w0[2 * i] * bflo(am[i]) + w1[2 * i] * bflo(ac[i]) + w2[2 * i] * bflo(ap[i]);
                    const float v1 = bb[2 * i + 1] + w0[2 * i + 1] * bfhi(am[i]) + w1[2 * i + 1] * bfhi(ac[i]) + w2[2 * i + 1] * bfhi(ap[i]);
                    tile[(cseg * 8 + 2 * i) * 72 + sl] = (bf16_t)f2bf(v0); tile[(cseg * 8 + 2 * i + 1) * 72 + sl] = (bf16_t)f2bf(v1);
                }
            }
        } else {
            const int c0 = (blk - 12) * 64 + cseg * 8;
#pragma unroll 2
            for (int it = 0; it < 8; ++it) {
                const int sl = rsub + 8 * it, s = s0 + sl;
                const u32x4 zc = *(const u32x4*)(U + (size_t)(rowbase + s) * DIN + UV + c0);
                const unsigned ac[4] = {zc.x, zc.y, zc.z, zc.w};
#pragma unroll
                for (int i = 0; i < 4; ++i) { tile[(cseg * 8 + 2 * i) * 72 + sl] = (bf16_t)(ac[i] & 0xffffu); tile[(cseg * 8 + 2 * i + 1) * 72 + sl] = (bf16_t)(ac[i] >> 16); }
            }
        }
        LDS_WAIT(); asm volatile("" ::: "memory");
#pragma unroll 2
        for (int it = 0; it < 8; ++it) {
            const int ch = rsub + 8 * it;
            const u32x4 v = *(const LAS u32x4*)(tile + ch * 72 + cseg * 8);
            bf16_t* dst;
            if (blk < 12) dst = (bf16_t*)(F.ws + WS_HV) + ((size_t)(blk * 64 + ch) * NB + b) * SPB + posbase + s0 + cseg * 8;
            else dst = (bf16_t*)(F.ws + WS_VT) + ((size_t)b * 512 + (blk - 12) * 64 + ch) * SPB + posbase + s0 + cseg * 8;
            *(u32x4*)dst = v;
        }
        LDS_WAIT(); asm volatile("" ::: "memory");
    }
}

constexpr int NA_RPB = 0, NA_KC = 2048, NA_VC = NA_KC + 256 * 144, NA_KR = NA_VC + 64 * 528, NA_END = NA_KR + 9 * 64 * 144;
static_assert(NA_END <= MISC_OFF, "NA LDS map");
__device__ __forceinline__ bf16x8 gld16(const bf16_t* p) { return *(const GAS bf16x8*)p; }
__device__ __forceinline__ u32x2 gld8(const bf16_t* p) { return *(const GAS u32x2*)p; }
__device__ __forceinline__ const char* uni_ptr(const char* p) { const unsigned long long v = (unsigned long long)p; const unsigned lo = __builtin_amdgcn_readfirstlane((unsigned)v), hi = __builtin_amdgcn_readfirstlane((unsigned)(v >> 32)); return (const char*)(((unsigned long long)hi << 32) | lo); }
__device__ __forceinline__ bf16x8 gld16o(const char* ub, unsigned lo) { return *(const GAS bf16x8*)(ub + (size_t)lo); }
__device__ __forceinline__ u32x2 gld8o(const char* ub, unsigned lo) { return *(const GAS u32x2*)(ub + (size_t)lo); }
template <bool WIN>
__device__ __forceinline__ void na_unit(Frame& F, int b, int h, int r, int strip) {
    const bf16_t* U = (const bf16_t*)(F.ws + WS_U);
    const bf16_t* VT = (const bf16_t*)(F.ws + WS_VT) + ((size_t)b * 512 + h * 64) * SPB;
    const LAS float* rpb = (const LAS float*)(F.lds + NA_RPB);
    const LAS bf16_t* KC = (const LAS bf16_t*)(F.lds + NA_KC); const LAS bf16_t* VC = (const LAS bf16_t*)(F.lds + NA_VC);
    int ln_ = F.lane; asm volatile("" : "+v"(ln_));
    const int i = ln_ & 15, g = ln_ >> 4;
    const int qrow0 = WIN ? (b * SEQ + r * 64 + strip * 16) : (NLAT + b * CTXL + strip * 16);
    const int ki = 8 * (i >> 2) + (i & 3);
    const unsigned qlo = (unsigned)((i * DIN + 8 * g) * 2), klo = (unsigned)((ki * DIN + 8 * g) * 2), vlo = (unsigned)((i * SPB + 8 * g) * 2);
    const char* qb = uni_ptr((const char*)(U + (size_t)qrow0 * DIN + UQ + h * 64));
    const bf16x8 q0 = gld16o(qb, qlo), q1 = gld16o(qb + 64, qlo);
    int kr0 = 0, u0 = 0;
    if (WIN) { kr0 = r - 4; kr0 = kr0 < 0 ? 0 : (kr0 > 56 ? 56 : kr0); u0 = strip == 0 ? 0 : (strip == 1 ? 8 : (strip == 2 ? 24 : 32)); }
    const LAS bf16_t* KR = (const LAS bf16_t*)(F.lds + NA_KR);
    const char* vbase = uni_ptr((const char*)(VT + kr0 * 64 + u0));
    f32x4 o[4];
#pragma unroll
    for (int d = 0; d < 4; ++d) o[d] = (f32x4){0.f, 0.f, 0.f, 0.f};
    float lsum = 0.f;
#define NA_SB() __builtin_amdgcn_sched_barrier(0)
#define NA_WLOAD(vb_, cw) do { _Pragma("unroll") for (int d = 0; d < 4; ++d) vb_[d] = gld16o(vbase + ((size_t)(d * 16) * SPB + (cw) * 64) * 2, vlo); } while (0)
#define NA_KRING(kb_, cw) do { const LAS bf16_t* kp = KR + ((((kr0 + (cw)) % 9) * 64 + u0 + ki) * 72 + 8 * g); kb_[0][0] = *(const LAS bf16x8*)kp; kb_[0][1] = *(const LAS bf16x8*)(kp + 32); \
        kb_[1][0] = *(const LAS bf16x8*)(kp + 4 * 72); kb_[1][1] = *(const LAS bf16x8*)(kp + 4 * 72 + 32); } while (0)
#define NA_QK(kb_, s_) do { _Pragma("unroll") for (int t = 0; t < 2; ++t) { f32x4 a = (f32x4){0.f, 0.f, 0.f, 0.f}; a = mfma16(kb_[t][0], q0, a); a = mfma16(kb_[t][1], q1, a); s_[t] = a; } } while (0)
#define NA_PV(s_, vb_) do { u32x4 pw; pw.x = pk2(s_[0][0], s_[0][1]); pw.y = pk2(s_[0][2], s_[0][3]); pw.z = pk2(s_[1][0], s_[1][1]); pw.w = pk2(s_[1][2], s_[1][3]); const bf16x8 pf = __builtin_bit_cast(bf16x8, pw); \
        _Pragma("unroll") for (int d = 0; d < 4; ++d) o[d] = mfma16(vb_[d], pf, o[d]); } while (0)
    bf16x8 vA[4], vB[4], vC[4];
    if (WIN) { NA_WLOAD(vA, 0); NA_WLOAD(vB, 1); NA_WLOAD(vC, 2); NA_SB(); }
#pragma unroll
    for (int cc = 0; cc < 8; ++cc) {
        bf16x8 kc[2][2], vc[4]; f32x4 sc[2];
#pragma unroll
        for (int t = 0; t < 2; ++t) { const LAS bf16_t* kp = KC + (cc * 32 + ki + 4 * t) * 72 + 8 * g; kc[t][0] = *(const LAS bf16x8*)kp; kc[t][1] = *(const LAS bf16x8*)(kp + 32); }
#pragma unroll
        for (int d = 0; d < 4; ++d) vc[d] = *(const LAS bf16x8*)(VC + (d * 16 + i) * 264 + cc * 32 + 8 * g);
        NA_QK(kc, sc);
#pragma unroll
        for (int t = 0; t < 2; ++t)
#pragma unroll
            for (int e = 0; e < 4; ++e) { const float p = __expf(fminf(sc[t][e] * 0.125f, 60.f)); sc[t][e] = p; lsum += p; }
        NA_PV(sc, vc);
    }
    if (WIN) {
        const int c = strip * 16 + i; int kc0 = c - 8; kc0 = kc0 < 0 ? 0 : (kc0 > 48 ? 48 : kc0);
        int dcl[2][4]; bool okm[2][4];
#pragma unroll
        for (int t = 0; t < 2; ++t)
#pragma unroll
            for (int e = 0; e < 4; ++e) { const int kc = u0 + 8 * g + 4 * t + e; okm[t][e] = (kc >= kc0) && (kc < kc0 + 16); int dc = kc - c + 15; dcl[t][e] = dc < 0 ? 0 : (dc > 30 ? 30 : dc); }
#define NA_WCHUNK(vb_, cw) do { bf16x8 kw[2][2]; NA_KRING(kw, cw); f32x4 sw[2]; NA_QK(kw, sw); const LAS float* rp = rpb + (kr0 + (cw) - r + 7) * 31; \
        _Pragma("unroll") for (int t = 0; t < 2; ++t) _Pragma("unroll") for (int e = 0; e < 4; ++e) { const float x = sw[t][e] * 0.125f + rp[dcl[t][e]]; const float p = okm[t][e] ? __expf(fminf(x, 60.f)) : 0.f; sw[t][e] = p; lsum += p; } \
        NA_PV(sw, vb_); } while (0)
        NA_WCHUNK(vA, 0); NA_SB(); NA_WLOAD(vA, 3); NA_SB();
        NA_WCHUNK(vB, 1); NA_SB(); NA_WLOAD(vB, 4); NA_SB();
        NA_WCHUNK(vC, 2); NA_SB(); NA_WLOAD(vC, 5); NA_SB();
        NA_WCHUNK(vA, 3); NA_SB(); NA_WLOAD(vA, 6); NA_SB();
        NA_WCHUNK(vB, 4); NA_SB(); NA_WLOAD(vB, 7); NA_SB();
        NA_WCHUNK(vC, 5); NA_SB();
        NA_WCHUNK(vA, 6); NA_SB();
        NA_WCHUNK(vB, 7); NA_SB();
#undef NA_WCHUNK
    }
    lsum += shx(lsum, 16, ln_); lsum += shx(lsum, 32, ln_);
    const float inv = 1.0f / lsum;
    char* op = (char*)uni_ptr((const char*)((bf16_t*)(F.ws + WS_MIX) + (size_t)qrow0 * DM + h * 64)); const unsigned olo = (unsigned)((i * DM + 4 * g) * 2);
#pragma unroll
    for (int d = 0; d < 4; ++d) { u32x2 w; w.x = pk2(o[d][0] * inv, o[d][1] * inv); w.y = pk2(o[d][2] * inv, o[d][3] * inv); *(GAS u32x2*)(op + d * 32 + (size_t)olo) = w; }
#undef NA_SB
#undef NA_WLOAD
#undef NA_KRING
#undef NA_QK
#undef NA_PV
}
__device__ __forceinline__ int na_kr0(int r) { const int k = r - 4; return k < 0 ? 0 : (k > 56 ? 56 : k); }
__device__ __forceinline__ void ph_na(Frame& F, int l, bool last) {
    const bf16_t* U = (const bf16_t*)(F.ws + WS_U);
    for (int job = F.wg; job < NB * 8 * 2; job += F.G) {
        const int half = job & 1, h = (job >> 1) & 7, b = job >> 4;
        int tz_; asm volatile("v_mbcnt_lo_u32_b32 %0, -1, 0\n\tv_mbcnt_hi_u32_b32 %0, -1, %0" : "=v"(tz_)); tz_ |= F.wave << 6;
        const bf16_t* krow = U + (size_t)(b * SEQ + (tz_ >> 3)) * DIN + UK + h * 64 + (tz_ & 7) * 8;
        LAS bf16_t* kdst = (LAS bf16_t*)(F.lds + NA_KR) + (tz_ >> 3) * 72 + (tz_ & 7) * 8;
        __syncthreads();
        { LAS float* rpb = (LAS float*)(F.lds + NA_RPB); const float* rsrc = F.in[I_RPB] + ((size_t)l * 8 + h) * 15 * 31;
          if (tz_ < 15 * 31) rpb[tz_] = rsrc[tz_];
          const int key = tz_ >> 1, hf = tz_ & 1; const bf16_t* src = U + (size_t)(NLAT + b * CTXL + key) * DIN + UK + h * 64 + hf * 32; LAS bf16_t* dst = (LAS bf16_t*)(F.lds + NA_KC) + key * 72 + hf * 32;
#pragma unroll
          for (int j = 0; j < 4; ++j) *(LAS bf16x8*)(dst + j * 8) = gld16(src + j * 8);
          const int dv = tz_ >> 3, seg = tz_ & 7; const bf16_t* vs = (const bf16_t*)(F.ws + WS_VT) + ((size_t)b * 512 + h * 64 + dv) * SPB + SEQ + seg * 32; LAS bf16_t* vd = (LAS bf16_t*)(F.lds + NA_VC) + dv * 264 + seg * 32;
#pragma unroll
          for (int j = 0; j < 4; ++j) *(LAS bf16x8*)(vd + j * 8) = gld16(vs + j * 8);
          const int lo = na_kr0(half * 32), hi0 = na_kr0(half * 32 + 1) + 7;
          for (int kr = lo; kr <= hi0; ++kr) *(LAS bf16x8*)(kdst + (kr % 9) * 64 * 72) = gld16(krow + (size_t)kr * 64 * DIN); }
        __syncthreads();
        int prev_hi = na_kr0(half * 32 + 1) + 7;
#pragma unroll 1
        for (int s = 0; s < 16; ++s) {
            const int r0 = half * 32 + 2 * s;
            const int nhi = s < 15 ? na_kr0(r0 + 3) + 7 : prev_hi;
            bf16x8 n0 = (bf16x8){0, 0, 0, 0, 0, 0, 0, 0}, n1 = n0;
            if (nhi > prev_hi) n0 = gld16(krow + (size_t)(prev_hi + 1) * 64 * DIN);
            if (nhi > prev_hi + 1) n1 = gld16(krow + (size_t)(prev_hi + 2) * 64 * DIN);
            na_unit<true>(F, b, h, r0 + (F.wave >> 2), F.wave & 3);
            __syncthreads();
            if (nhi > prev_hi) *(LAS bf16x8*)(kdst + ((prev_hi + 1) % 9) * 64 * 72) = n0;
            if (nhi > prev_hi + 1) *(LAS bf16x8*)(kdst + ((prev_hi + 2) % 9) * 64 * 72) = n1;
            __syncthreads();
            prev_hi = nhi;
        }
        if (!last) na_unit<false>(F, b, h, 0, half * 8 + F.wave);
    }
}

__device__ __forceinline__ void ph_hy_transpose(Frame& F, bool last) {
    LAS bf16_t* tile = (LAS bf16_t*)(F.lds + F.wave * 16384);
    const bf16_t* HYO = (const bf16_t*)(F.ws + WS_Y);
    const int gw = F.wg * NWAVES + F.wave, NGW = F.G * NWAVES;
    const int rsub = F.lane >> 3, cseg = F.lane & 7;
    const int ntt = last ? 1024 : 1088;
    for (int u = gw; u < ntt * 4; u += NGW) {
        const int tt = u >> 2, cb = u & 3;
        int b, s0, rowbase, posbase;
        if (tt < 1024) { b = tt >> 6; s0 = (tt & 63) * 64; rowbase = b * SEQ; posbase = 0; }
        else { const int t2 = tt - 1024; b = t2 >> 2; s0 = (t2 & 3) * 64; rowbase = NLAT + b * CTXL; posbase = SEQ; }
#pragma unroll 2
        for (int it = 0; it < 8; ++it) { const int c = rsub + 8 * it;
            const u32x4 v = *(const GAS u32x4*)(HYO + ((size_t)(cb * 64 + c) * NB + b) * SPB + posbase + s0 + cseg * 8); const unsigned a[4] = {v.x, v.y, v.z, v.w};
#pragma unroll
            for (int e = 0; e < 4; ++e) { tile[(cseg * 8 + 2 * e) * 72 + c] = (bf16_t)(a[e] & 0xffffu); tile[(cseg * 8 + 2 * e + 1) * 72 + c] = (bf16_t)(a[e] >> 16); } }
        LDS_WAIT(); asm volatile("" ::: "memory");
#pragma unroll 2
        for (int it = 0; it < 8; ++it) { const int p = rsub + 8 * it;
            const u32x4 v = *(const LAS u32x4*)(tile + p * 72 + cseg * 8);
            *(GAS u32x4*)((bf16_t*)(F.ws + WS_MIX) + (size_t)(rowbase + s0 + p) * DM + 768 + cb * 64 + cseg * 8) = v; }
        LDS_WAIT(); asm volatile("" ::: "memory");
    }
}

constexpr int G2_LAF = 0, G2_LAB = 8448;
constexpr int G2_QTF = 16896, G2_KTF = 22016, G2_QTB = 27136, G2_KTB = 32256;
constexpr int G2_VT = 37376, G2_ATT = 46592;
constexpr int G2_SF = 55808, G2_SB = 60928;
constexpr int G2_SEG = 66048, G2_HALF = 67328;
__device__ __forceinline__ float log_sigmoid_f(float x) { return fminf(x, 0.f) - log1pf(__expf(-fabsf(x))); }
__device__ __forceinline__ f32x4 mma_lds(const LAS bf16_t* A, int lda, const LAS bf16_t* B, int ldb, int ksteps, f32x4 acc, int lane) {
    const int r = lane & 15, g = lane >> 4;
    for (int ks = 0; ks < ksteps; ++ks) { const bf16x8 a = *(const LAS bf16x8*)(A + r * lda + ks * 32 + 8 * g), b = *(const LAS bf16x8*)(B + r * ldb + ks * 32 + 8 * g); acc = mfma16(a, b, acc); }
    return acc;
}
__device__ __forceinline__ int gla_row0(int b, int cn) { return cn >= 4 ? b * SEQ + (cn - 4) * 64 : NLAT + b * CTXL + cn * 64; }
struct GlaRaw { u32x4 q, k, f, b, v0, v1, g0, g1, s0, s1; };
template <bool FULL>
__device__ __forceinline__ GlaRaw gla_load(Frame& F, int u, int tl) {
    const int h = u & 3, cn = (u >> 2) % 68, b = (u >> 2) / 68, i = tl >> 2, part = tl & 3;
    const bf16_t* p = (const bf16_t*)(F.ws + WS_U) + (size_t)(gla_row0(b, cn) + i) * DIN;
    GlaRaw r;
    r.q = *(const GAS u32x4*)(p + UGQ + h * 32 + part * 8); r.k = *(const GAS u32x4*)(p + UGK + h * 32 + part * 8);
    r.f = *(const GAS u32x4*)(p + ULAF + h * 32 + part * 8); r.b = *(const GAS u32x4*)(p + ULAB + h * 32 + part * 8);
    r.v0 = *(const GAS u32x4*)(p + UGV + h * 64 + part * 16); r.v1 = *(const GAS u32x4*)(p + UGV + h * 64 + part * 16 + 8);
    if (FULL) { r.g0 = *(const GAS u32x4*)(p + UGR + h * 64 + part * 16); r.g1 = *(const GAS u32x4*)(p + UGR + h * 64 + part * 16 + 8);
        const bf16_t* sp = (const bf16_t*)(F.ws + WS_GSIN) + (size_t)u * 2 * 2048 + tl * 16; r.s0 = *(const GAS u32x4*)sp; r.s1 = *(const GAS u32x4*)(sp + 8); }
    else { r.g0 = (u32x4){0u, 0u, 0u, 0u}; r.g1 = r.g0; r.s0 = r.g0; r.s1 = r.g0; }
    return r;
}
template <bool FULL>
__device__ __forceinline__ void gla_prep(Frame& F, LAS unsigned char* L, int l, int u, int tl, const GlaRaw& raw) {
    const int h = u & 3, cn = (u >> 2) % 68, i = tl >> 2, part = tl & 3, d8 = part * 8;
    LAS float* LAF = (LAS float*)(L + G2_LAF); LAS float* LAB = (LAS float*)(L + G2_LAB); LAS bf16_t* VT = (LAS bf16_t*)(L + G2_VT); LAS float* SEG = (LAS float*)(L + G2_SEG);
    float q[8], k[8], tf[8], tb[8];
    unpack8(raw.q, q); unpack8(raw.k, k); unpack8(raw.f, tf); unpack8(raw.b, tb);
    const float* ba = F.in[I_BA2] + (size_t)l * 256 + h * 32 + d8;
#pragma unroll
    for (int e = 0; e < 8; ++e) { q[e] *= 0.17677669529663687f; LAF[i * 33 + d8 + e] = log_sigmoid_f(tf[e] + ba[e]) * 0.0625f; LAB[i * 33 + d8 + e] = log_sigmoid_f(tb[e] + ba[128 + e]) * 0.0625f; }
    if (cn >= 4) {
        const float pos = (part >> 1) ? (float)i : (float)(cn - 4);
#pragma unroll
        for (int e = 0; e < 8; ++e) { const float ang = pos * __expf(-(float)e * (9.210340371976184f / 8.0f)); const float sn = __sinf(ang), cs = __cosf(ang);
            const float qo = shx(q[e], 1, F.lane), ko = shx(k[e], 1, F.lane);
            if (part & 1) { q[e] = qo * sn + q[e] * cs; k[e] = ko * sn + k[e] * cs; } else { q[e] = q[e] * cs - qo * sn; k[e] = k[e] * cs - ko * sn; } }
    }
    { const unsigned a[8] = {raw.v0.x, raw.v0.y, raw.v0.z, raw.v0.w, raw.v1.x, raw.v1.y, raw.v1.z, raw.v1.w};
#pragma unroll
      for (int e = 0; e < 8; ++e) { VT[(part * 16 + 2 * e) * 72 + i] = (bf16_t)(a[e] & 0xffffu); VT[(part * 16 + 2 * e + 1) * 72 + i] = (bf16_t)(a[e] >> 16); } }
    __syncthreads();
    { const int x = tl & 63, d = x & 31, dir = x >> 5, seg = tl >> 6; LAS float* LA = dir ? LAB : LAF; float run = 0.f;
#pragma unroll
      for (int kk = 0; kk < 16; ++kk) { const int p = seg * 16 + kk, ti = dir ? 63 - p : p; run += LA[ti * 33 + d]; LA[ti * 33 + d] = run; }
      SEG[x * 5 + seg] = run; }
    __syncthreads();
    { const int x = tl & 63, d = x & 31, dir = x >> 5, seg = tl >> 6; LAS float* LA = dir ? LAB : LAF; float pre = 0.f;
      for (int s2 = 0; s2 < seg; ++s2) pre += SEG[x * 5 + s2];
#pragma unroll
      for (int kk = 0; kk < 16; ++kk) { const int p = seg * 16 + kk, ti = dir ? 63 - p : p; LA[ti * 33 + d] += pre; } }
    __syncthreads();
    if (FULL) {
        unsigned wqf[4], wkf[4], wqb[4], wkb[4];
#pragma unroll
        for (int e = 0; e < 4; ++e) { const int d = d8 + 2 * e; const float f0 = LAF[i * 33 + d], f1 = LAF[i * 33 + d + 1], b0 = LAB[i * 33 + d], b1 = LAB[i * 33 + d + 1];
            wqf[e] = pk2(q[2 * e] * __expf(f0), q[2 * e + 1] * __expf(f1)); wkf[e] = pk2(k[2 * e] * __expf(-f0), k[2 * e + 1] * __expf(-f1));
            wqb[e] = pk2(q[2 * e] * __expf(b0), q[2 * e + 1] * __expf(b1)); wkb[e] = pk2(k[2 * e] * __expf(-b0), k[2 * e + 1] * __expf(-b1)); }
        *(LAS u32x4*)((LAS bf16_t*)(L + G2_QTF) + i * 40 + d8) = (u32x4){wqf[0], wqf[1], wqf[2], wqf[3]}; *(LAS u32x4*)((LAS bf16_t*)(L + G2_KTF) + i * 40 + d8) = (u32x4){wkf[0], wkf[1], wkf[2], wkf[3]};
        *(LAS u32x4*)((LAS bf16_t*)(L + G2_QTB) + i * 40 + d8) = (u32x4){wqb[0], wqb[1], wqb[2], wqb[3]}; *(LAS u32x4*)((LAS bf16_t*)(L + G2_KTB) + i * 40 + d8) = (u32x4){wkb[0], wkb[1], wkb[2], wkb[3]};
    } else {
        LAS bf16_t* KDF = (LAS bf16_t*)(L + G2_QTF); LAS bf16_t* KDB = (LAS bf16_t*)(L + G2_KTF);
#pragma unroll
        for (int e = 0; e < 8; ++e) { const int d = d8 + e; const float bf = LAF[i * 33 + d], bb = LAB[i * 33 + d], bfl = LAF[63 * 33 + d], bbl = LAB[0 * 33 + d];
            KDF[d * 72 + i] = (bf16_t)f2bf(k[e] * __expf(bfl - bf)); KDB[d * 72 + i] = (bf16_t)f2bf(k[e] * __expf(bbl - bb)); }
    }
    __syncthreads();
}
__device__ __forceinline__ void ph_gla_local(Frame& F, int l) {
    const int hw = F.wave >> 2, wl = F.wave & 3, tl = F.tid & 255; LAS unsigned char* L = F.lds + hw * G2_HALF;
    constexpr int NU = NB * 68 * 4;
    int pp = F.wg;
    GlaRaw raw = gla_load<false>(F, (pp * 2 + hw) < NU ? pp * 2 + hw : 0, tl);
    for (; pp * 2 < NU; pp += F.G) {
        const int u = pp * 2 + hw, un = (pp + F.G) * 2 + hw;
        const GlaRaw nraw = gla_load<false>(F, un < NU ? un : u, tl);
        __syncthreads();
        gla_prep<false>(F, L, l, u, tl, raw);
        const int g = F.lane >> 4, c = F.lane & 15;
        float* DS = (float*)(F.ws + WS_GDS) + (size_t)u * 2 * 2048;
#pragma unroll
        for (int kk = 0; kk < 4; ++kk) { const int tix = wl * 4 + kk, dir = tix >> 3, mt = (tix >> 1) & 3, nt = tix & 1;
            f32x4 a = (f32x4){0.f, 0.f, 0.f, 0.f};
            a = mma_lds((const LAS bf16_t*)(L + G2_VT) + mt * 16 * 72, 72, (const LAS bf16_t*)(L + (dir ? G2_KTF : G2_QTF)) + nt * 16 * 72, 72, 2, a, F.lane);
#pragma unroll
            for (int e = 0; e < 4; ++e) DS[dir * 2048 + (mt * 16 + 4 * g + e) * 32 + nt * 16 + c] = a[e]; }
        if (tl < 64) { const int d = tl & 31, dir = tl >> 5; ((float*)(F.ws + WS_GD))[(size_t)u * 64 + tl] = __expf(dir ? ((LAS float*)(L + G2_LAB))[0 * 33 + d] : ((LAS float*)(L + G2_LAF))[63 * 33 + d]); }
        raw = nraw;
    }
}
__device__ __forceinline__ void ph_gla_scan(Frame& F) {
    const int gt = F.wg * NTHR + F.tid, NGT = F.G * NTHR;
    const float* DS = (const float*)(F.ws + WS_GDS); const float* GD = (const float*)(F.ws + WS_GD); bf16_t* SIN = (bf16_t*)(F.ws + WS_GSIN);
    for (int w = gt; w < 128 * 1024; w += NGT) {
        const int chain = w >> 10, el = (w & 1023) * 2, dir = chain & 1, h = (chain >> 1) & 3, b = chain >> 3, d = el & 31;
        float s0 = 0.f, s1 = 0.f;
        for (int step = 0; step < 68; step += 4) {
            f32x2 ds[4], dd[4]; size_t uu[4];
#pragma unroll
            for (int q = 0; q < 4; ++q) { const int st_ = step + q; const int cn = dir ? (st_ < 4 ? 3 - st_ : 71 - st_) : st_;
                uu[q] = (size_t)(b * 68 + cn) * 4 + h;
                ds[q] = *(const GAS f32x2*)(DS + (uu[q] * 2 + dir) * 2048 + el); dd[q] = *(const GAS f32x2*)(GD + uu[q] * 64 + dir * 32 + d); }
#pragma unroll
            for (int q = 0; q < 4; ++q) { *(GAS unsigned*)(SIN + (uu[q] * 2 + dir) * 2048 + el) = pk2(s0, s1); s0 = dd[q].x * s0 + ds[q].x; s1 = dd[q].y * s1 + ds[q].y; }
        }
    }
}
__device__ __forceinline__ void ph_gla_out(Frame& F, int l, bool last) {
    const int hw = F.wave >> 2, wl = F.wave & 3, tl = F.tid & 255; LAS unsigned char* L = F.lds + hw * G2_HALF;
    const int NV = last ? NB * 64 * 4 : NB * 68 * 4;
#define GLA_UNIT(v) (last ? ((((v) >> 8) * 68 + 4 + (((v) & 255) >> 2)) * 4 + ((v) & 3)) : (v))
    int pp = F.wg;
    GlaRaw raw = gla_load<true>(F, GLA_UNIT((pp * 2 + hw) < NV ? pp * 2 + hw : 0), tl);
    for (; pp * 2 < NV; pp += F.G) {
        const int u = GLA_UNIT(pp * 2 + hw), vn = (pp + F.G) * 2 + hw;
        const GlaRaw nraw = gla_load<true>(F, vn < NV ? GLA_UNIT(vn) : u, tl);
        const int h = u & 3, cn = (u >> 2) % 68, b = (u >> 2) / 68;
        __syncthreads();
        gla_prep<true>(F, L, l, u, tl, raw);
        { const int dir = tl >> 7, dv = (tl >> 1) & 63, d16 = (tl & 1) * 16; LAS bf16_t* S = (LAS bf16_t*)(L + (dir ? G2_SB : G2_SF)) + dv * 40 + d16; *(LAS u32x4*)S = raw.s0; *(LAS u32x4*)(S + 8) = raw.s1; }
        const int g = F.lane >> 4, c = F.lane & 15;
        LAS bf16_t* ATT = (LAS bf16_t*)(L + G2_ATT);
#pragma unroll
        for (int kk = 0; kk < 4; ++kk) { const int tile = wl * 4 + kk, mt = tile >> 2, nt = tile & 3;
            f32x4 af = (f32x4){0.f, 0.f, 0.f, 0.f}, ab = af;
            af = mma_lds((const LAS bf16_t*)(L + G2_QTF) + mt * 16 * 40, 40, (const LAS bf16_t*)(L + G2_KTF) + nt * 16 * 40, 40, 1, af, F.lane);
            ab = mma_lds((const LAS bf16_t*)(L + G2_QTB) + mt * 16 * 40, 40, (const LAS bf16_t*)(L + G2_KTB) + nt * 16 * 40, 40, 1, ab, F.lane);
#pragma unroll
            for (int e = 0; e < 4; ++e) { const int ii = mt * 16 + 4 * g + e, j = nt * 16 + c; const float vv = (j <= ii ? af[e] : 0.f) + (j >= ii ? ab[e] : 0.f); ATT[ii * 72 + j] = (bf16_t)f2bf(vv); } }
        __syncthreads();
        LAS float* O = (LAS float*)(L + G2_LAF);
#pragma unroll
        for (int kk = 0; kk < 4; ++kk) { const int tile = wl * 4 + kk, mt = tile >> 2, nt = tile & 3;
            f32x4 a = (f32x4){0.f, 0.f, 0.f, 0.f};
            a = mma_lds(ATT + mt * 16 * 72, 72, (const LAS bf16_t*)(L + G2_VT) + nt * 16 * 72, 72, 2, a, F.lane);
            a = mma_lds((const LAS bf16_t*)(L + G2_QTF) + mt * 16 * 40, 40, (const LAS bf16_t*)(L + G2_SF) + nt * 16 * 40, 40, 1, a, F.lane);
            a = mma_lds((const LAS bf16_t*)(L + G2_QTB) + mt * 16 * 40, 40, (const LAS bf16_t*)(L + G2_SB) + nt * 16 * 40, 40, 1, a, F.lane);
#pragma unroll
            for (int e = 0; e < 4; ++e) O[(mt * 16 + 4 * g + e) * 65 + nt * 16 + c] = a[e]; }
        __syncthreads();
        { const int i = tl >> 2, dv16 = (tl & 3) * 16; const int row = gla_row0(b, cn) + i;
          float v[16], gt[16]; float ss = 0.f;
#pragma unroll
          for (int e = 0; e < 16; ++e) { v[e] = O[i * 65 + dv16 + e]; ss += v[e] * v[e]; }
          ss += shx(ss, 1, F.lane); ss += shx(ss, 2, F.lane);
          const float rs = 1.0f / sqrtf(ss * (1.0f / 64.0f) + LN_EPS);
          unpack8(raw.g0, gt); unpack8(raw.g1, gt + 8);
          const float* gn = F.in[I_GNORM] + l * 64 + dv16;
          unsigned w[8];
#pragma unroll
          for (int e = 0; e < 8; ++e) w[e] = pk2(v[2 * e] * rs * gn[2 * e] * silu_f(gt[2 * e]), v[2 * e + 1] * rs * gn[2 * e + 1] * silu_f(gt[2 * e + 1]));
          bf16_t* mp = (bf16_t*)(F.ws + WS_MIX) + (size_t)row * DM + 512 + h * 64 + dv16;
          *(GAS u32x4*)mp = (u32x4){w[0], w[1], w[2], w[3]}; *(GAS u32x4*)(mp + 8) = (u32x4){w[4], w[5], w[6], w[7]}; }
        raw = nraw;
    }
#undef GLA_UNIT
}

template <int L>
__device__ __forceinline__ void hyena_conv(Frame& F, const bf16_t* Rg, const bf16_t* Uin, const bf16_t* Xmul, int pos0, bool final_out, int ch, bf16_t* Zout) {
    constexpr int CS = 2 * L + 16;
    constexpr int NTL = L / 16, J = (NTL >= 64) ? 16 : 2, NGRP = NTL / J, HJ = J / 2, NSTEP = L / 32;
    LAS bf16_t* Rl = (LAS bf16_t*)F.lds;
    __syncthreads();
    for (int c = F.tid; c < 2 * L / 8; c += NTHR) { const u32x4 v = *(const GAS u32x4*)(Rg + 8 * c); const unsigned a[4] = {v.x, v.y, v.z, v.w};
#pragma unroll
        for (int rho = 0; rho < 8; ++rho) { LAS bf16_t* d = Rl + rho * CS + 8 * c + rho;
#pragma unroll
            for (int k = 0; k < 4; ++k) { d[2 * k] = (bf16_t)(a[k] & 0xffffu); d[2 * k + 1] = (bf16_t)(a[k] >> 16); } } }
    __syncthreads();
    int ln_ = F.lane; asm volatile("" : "+v"(ln_));
    const int i = ln_ & 15, g = ln_ >> 4, rho = i & 7;
    const LAS bf16_t* Rc = Rl + rho * CS + rho;
    for (int grp = F.wave; grp < NGRP; grp += NWAVES) {
        f32x4 acc[J]; bf16x8 fr[J];
        const int tb = grp * J * 16;
        const LAS bf16_t* Rb = Rc + (L - tb - i + 8 * g);
#pragma unroll
        for (int j = 0; j < J; ++j) { acc[j] = (f32x4){0.f, 0.f, 0.f, 0.f}; fr[j] = *(const LAS bf16x8*)(Rb - 16 * j); }
        const char* ub = (const char*)(Uin + pos0); const unsigned ulo = (unsigned)((i * SPB + 8 * g) * 2);
        constexpr int PF = (HJ >= 4) ? 4 : 1;
        bf16x8 bq[PF];
#pragma unroll
        for (int p = 0; p < PF; ++p) bq[p] = *(const GAS bf16x8*)(ub + (size_t)(ulo + (unsigned)p * 64u));
#pragma unroll 1
        for (int q = 0; q < NSTEP / HJ; ++q) {
#pragma unroll
            for (int m = 0; m < HJ; ++m) {
                const int n = q * HJ + m;
                const int nn = (n + PF < NSTEP) ? n + PF : 0;
                if (n > 0) { fr[(J - 2 * m) % J] = *(const LAS bf16x8*)(Rb + 32 * n); fr[(J + 1 - 2 * m) % J] = *(const LAS bf16x8*)(Rb + 32 * n - 16); }
                const bf16x8 bcur = bq[m % PF];
#pragma unroll
                for (int jj = 0; jj < J; ++jj) { const int j = (jj + 2) % J; acc[j] = mfma16(fr[(j + J - 2 * m) % J], bcur, acc[j]); }
                bq[m % PF] = *(const GAS bf16x8*)(ub + (size_t)(ulo + (unsigned)nn * 64u));
            }
        }
#pragma unroll
        for (int j = 0; j < J; ++j) { const int t0 = tb + j * 16 + 4 * g;
            const u32x2 xw = *(const GAS u32x2*)(Xmul + (size_t)i * SPB + pos0 + t0);
            const float y0 = acc[j][0] * bflo(xw.x), y1 = acc[j][1] * bfhi(xw.x), y2 = acc[j][2] * bflo(xw.y), y3 = acc[j][3] * bfhi(xw.y);
            if (!final_out) { u32x2 w; w.x = pk2(y0, y1); w.y = pk2(y2, y3); *(GAS u32x2*)(Zout + (size_t)i * SPB + pos0 + t0) = w; }
            else { u32x2 w; w.x = pk2(y0, y1); w.y = pk2(y2, y3); *(GAS u32x2*)((bf16_t*)(F.ws + WS_Y) + ((size_t)ch * NB + i) * SPB + pos0 + t0) = w; } }
    }
}
__device__ __forceinline__ void ph_hyena(Frame& F, int l, bool last) {
    const bf16_t* HV = (const bf16_t*)(F.ws + WS_HV); bf16_t* Z2 = (bf16_t*)(F.ws + WS_Z2);
    for (int ch = F.wg; ch < 256; ch += F.G) {
        const bf16_t* v = HV + (size_t)(0 * 256 + ch) * NB * SPB; const bf16_t* x1 = HV + (size_t)(256 + ch) * NB * SPB; const bf16_t* x2 = HV + (size_t)(512 + ch) * NB * SPB;
        bf16_t* z = Z2 + (size_t)ch * NB * SPB;
        const bf16_t* R0 = (const bf16_t*)(F.ws + WS_HYF) + ((size_t)(l * 2 + 0) * 256 + ch) * 8192; const bf16_t* R1 = (const bf16_t*)(F.ws + WS_HYF) + ((size_t)(l * 2 + 1) * 256 + ch) * 8192;
        hyena_conv<4096>(F, R0, v, x1, 0, false, ch, z);
        VM_WAIT(); __syncthreads(); __builtin_amdgcn_fence(__ATOMIC_ACQUIRE, "agent"); VM_WAIT();
        hyena_conv<4096>(F, R1, z, x2, 0, true, ch, z);
        if (!last) {
            const bf16_t* C0 = (const bf16_t*)(F.ws + WS_HYFC) + ((size_t)(l * 2 + 0) * 256 + ch) * 512; const bf16_t* C1 = (const bf16_t*)(F.ws + WS_HYFC) + ((size_t)(l * 2 + 1) * 256 + ch) * 512;
            hyena_conv<256>(F, C0, v, x1, SEQ, false, ch, z);
            VM_WAIT(); __syncthreads(); __builtin_amdgcn_fence(__ATOMIC_ACQUIRE, "agent"); VM_WAIT();
            hyena_conv<256>(F, C1, z, x2, SEQ, true, ch, z);
        }
    }
}

__device__ __forceinline__ void ph_ln1(Frame& F, int l, int ntok) {
    const int gw = F.wg * NWAVES + F.wave, NGW = F.G * NWAVES;
    const float* lg = F.in[I_LN1G] + l * DM + 16 * F.lane; const float* lb = F.in[I_LN1B] + l * DM + 16 * F.lane;
    for (int row = gw; row < ntok; row += NGW) {
        bf16_t* xr = (bf16_t*)(F.ws + WS_XR) + (size_t)row * DM + 16 * F.lane;
        const bf16_t* yr = (const bf16_t*)(F.ws + WS_Y) + (size_t)row * DM + 16 * F.lane;
        const float* md = mod_ptr(F, l, row) + 16 * F.lane;
        bf16_t* xm = (bf16_t*)(F.ws + WS_XM) + (size_t)row * DM + 16 * F.lane;
        const u32x4 xa = *(const GAS u32x4*)xr, xb = *(const GAS u32x4*)(xr + 8), ya = *(const GAS u32x4*)yr, yb = *(const GAS u32x4*)(yr + 8);
        float x[16], y[16], v[16]; unpack8(xa, x); unpack8(xb, x + 8); unpack8(ya, y); unpack8(yb, y + 8);
        float s = 0.f;
#pragma unroll
        for (int j = 0; j < 4; ++j) { const f32x4 g1 = *(const GAS f32x4*)(md + 2048 + 4 * j);
#pragma unroll
            for (int e = 0; e < 4; ++e) { v[4 * j + e] = x[4 * j + e] * DN_ALPHA + g1[e] * y[4 * j + e]; s += v[4 * j + e]; } }
        const float mean = wave_sum(s, F.lane) * (1.f / DM); float s2 = 0.f;
#pragma unroll
        for (int e = 0; e < 16; ++e) { v[e] -= mean; s2 += v[e] * v[e]; }
        const float rstd = 1.f / sqrtf(wave_sum(s2, F.lane) * (1.f / DM) + LN_EPS);
        unsigned wx[8], wm[8]; int w8[4];
#pragma unroll
        for (int j = 0; j < 4; ++j) { const f32x4 g = *(const GAS f32x4*)(lg + 4 * j), bb = *(const GAS f32x4*)(lb + 4 * j), sh = *(const GAS f32x4*)(md + 3072 + 4 * j), sc = *(const GAS f32x4*)(md + 4096 + 4 * j);
            float xn[4];
#pragma unroll
            for (int e = 0; e < 4; ++e) xn[e] = v[4 * j + e] * rstd * g[e] + bb[e];
            wx[2 * j] = pk2(xn[0], xn[1]); wx[2 * j + 1] = pk2(xn[2], xn[3]);
            const float h0 = xn[0] * (1.f + sc[0]) + sh[0], h1 = xn[1] * (1.f + sc[1]) + sh[1], h2 = xn[2] * (1.f + sc[2]) + sh[2], h3 = xn[3] * (1.f + sc[3]) + sh[3];
            wm[2 * j] = pk2(h0, h1); wm[2 * j + 1] = pk2(h2, h3);
            int v = 0; v = __builtin_amdgcn_cvt_pk_fp8_f32(h0, h1, v, false); v = __builtin_amdgcn_cvt_pk_fp8_f32(h2, h3, v, true); w8[j] = v; }
        *(GAS u32x4*)((unsigned char*)(F.ws + WS_XM8) + (size_t)row * DM + 16 * F.lane) = (u32x4){(unsigned)w8[0], (unsigned)w8[1], (unsigned)w8[2], (unsigned)w8[3]};
        *(GAS u32x4*)xr = (u32x4){wx[0], wx[1], wx[2], wx[3]}; *(GAS u32x4*)(xr + 8) = (u32x4){wx[4], wx[5], wx[6], wx[7]};
        *(GAS u32x4*)xm = (u32x4){wm[0], wm[1], wm[2], wm[3]}; *(GAS u32x4*)(xm + 8) = (u32x4){wm[4], wm[5], wm[6], wm[7]};
    }
}
__device__ __forceinline__ void ph_ln2(Frame& F, int l, int ntok, bool last) {
    const int gw = F.wg * NWAVES + F.wave, NGW = F.G * NWAVES;
    const int cA = 256 * (F.lane >> 4) + 32 * ((F.lane >> 2) & 3) + 8 * (F.lane & 3);
#define LN2_COL(j) (cA + ((j) < 2 ? 4 * (j) : 128 + 4 * ((j) - 2)))
    const float* lg = F.in[I_LN2G] + l * DM; const float* lb = F.in[I_LN2B] + l * DM;
    for (int row = gw; row < ntok; row += NGW) {
        bf16_t* xr = (bf16_t*)(F.ws + WS_XR) + (size_t)row * DM;
        const unsigned char* y2 = (const unsigned char*)(F.ws + WS_Y2) + (size_t)row * 9 * DM + 16 * F.lane;
        const float* wg = (const float*)(F.ws + WS_WGT) + (size_t)row * 8;
        const float* md = mod_ptr(F, l, row);
        float ff[16];
#pragma unroll
        for (int e = 0; e < 16; ++e) ff[e] = 0.f;
        u32x4 q[9];
#pragma unroll
        for (int k = 0; k < 9; ++k) q[k] = *(const GAS u32x4*)(y2 + (size_t)k * DM);
#pragma unroll
        for (int k = 0; k < 9; ++k) { const float wk = (k < 8 ? wg[k] : 1.0f) * pg8::Y2_INV; const unsigned a[4] = {q[k].x, q[k].y, q[k].z, q[k].w};
#pragma unroll
            for (int e = 0; e < 4; ++e) { const f32x2 lo = __builtin_amdgcn_cvt_pk_f32_fp8((int)a[e], false), hi = __builtin_amdgcn_cvt_pk_f32_fp8((int)a[e], true);
                ff[4 * e] += wk * lo.x; ff[4 * e + 1] += wk * lo.y; ff[4 * e + 2] += wk * hi.x; ff[4 * e + 3] += wk * hi.y; } }
        float v[16], xo[16]; float s = 0.f;
        { const u32x4 xa = *(const GAS u32x4*)(xr + cA), xb = *(const GAS u32x4*)(xr + cA + 128); unpack8(xa, xo); unpack8(xb, xo + 8); }
#pragma unroll
        for (int j = 0; j < 4; ++j) { const f32x4 g2 = *(const GAS f32x4*)(md + 5120 + LN2_COL(j));
#pragma unroll
            for (int e = 0; e < 4; ++e) { v[4 * j + e] = xo[4 * j + e] * DN_ALPHA + g2[e] * ff[4 * j + e]; s += v[4 * j + e]; } }
        const float mean = wave_sum(s, F.lane) * (1.f / DM); float s2 = 0.f;
#pragma unroll
        for (int e = 0; e < 16; ++e) { v[e] -= mean; s2 += v[e] * v[e]; }
        const float rstd = 1.f / sqrtf(wave_sum(s2, F.lane) * (1.f / DM) + LN_EPS);
        const float* mdn = last ? md : mod_ptr(F, l + 1, row);
        float xn[16];
#pragma unroll
        for (int j = 0; j < 4; ++j) { const f32x4 g = *(const GAS f32x4*)(lg + LN2_COL(j)), bb = *(const GAS f32x4*)(lb + LN2_COL(j));
#pragma unroll
            for (int e = 0; e < 4; ++e) xn[4 * j + e] = v[4 * j + e] * rstd * g[e] + bb[e]; }
        if (last) { float* op = F.out + (size_t)row * DM;
#pragma unroll
            for (int j = 0; j < 4; ++j) *(GAS f32x4*)(op + LN2_COL(j)) = (f32x4){xn[4 * j], xn[4 * j + 1], xn[4 * j + 2], xn[4 * j + 3]}; }
        else {
            *(GAS u32x4*)(xr + cA) = (u32x4){pk2(xn[0], xn[1]), pk2(xn[2], xn[3]), pk2(xn[4], xn[5]), pk2(xn[6], xn[7])}; *(GAS u32x4*)(xr + cA + 128) = (u32x4){pk2(xn[8], xn[9]), pk2(xn[10], xn[11]), pk2(xn[12], xn[13]), pk2(xn[14], xn[15])};
            bf16_t* xm = (bf16_t*)(F.ws + WS_XM) + (size_t)row * DM;
            unsigned w[8];
#pragma unroll
            for (int j = 0; j < 4; ++j) { const f32x4 sh = *(const GAS f32x4*)(mdn + LN2_COL(j)), sc = *(const GAS f32x4*)(mdn + 1024 + LN2_COL(j));
                w[2 * j] = pk2(xn[4 * j] * (1.f + sc[0]) + sh[0], xn[4 * j + 1] * (1.f + sc[1]) + sh[1]); w[2 * j + 1] = pk2(xn[4 * j + 2] * (1.f + sc[2]) + sh[2], xn[4 * j + 3] * (1.f + sc[3]) + sh[3]); }
            *(GAS u32x4*)(xm + cA) = (u32x4){w[0], w[1], w[2], w[3]}; *(GAS u32x4*)(xm + cA + 128) = (u32x4){w[4], w[5], w[6], w[7]};
        }
    }
#undef LN2_COL
}

__device__ __forceinline__ unsigned f_ord(float f) { const unsigned u = __builtin_bit_cast(unsigned, f); return (u & 0x80000000u) ? ~u : (u | 0x80000000u); }
__device__ __forceinline__ unsigned long long wave_max_u64(unsigned long long v, int lane) {
#pragma unroll
    for (int o = 1; o < 64; o <<= 1) { const unsigned lo = (unsigned)shxi((int)(unsigned)v, o, lane), hi = (unsigned)shxi((int)(unsigned)(v >> 32), o, lane); const unsigned long long w = ((unsigned long long)hi << 32) | lo; v = w > v ? w : v; }
    return v;
}
__device__ __forceinline__ float seg16_max(float v, int lane) { v = fmaxf(v, shx(v, 1, lane)); v = fmaxf(v, shx(v, 2, lane)); v = fmaxf(v, shx(v, 4, lane)); v = fmaxf(v, shx(v, 8, lane)); return v; }
__device__ __forceinline__ int seg16_min_i(int v, int lane) { int w; w = shxi(v, 1, lane); v = w < v ? w : v; w = shxi(v, 2, lane); v = w < v ? w : v; w = shxi(v, 4, lane); v = w < v ? w : v; w = shxi(v, 8, lane); v = w < v ? w : v; return v; }
__device__ __forceinline__ float seg16_top2(float v, int lane) {
    const float m1 = seg16_max(v, lane);
    const int first = seg16_min_i(v == m1 ? (lane & 15) : 99, lane);
    const float m2 = seg16_max((lane & 15) == first ? -3.0e38f : v, lane);
    return m1 + m2;
}
__device__ __forceinline__ void ph_route(Frame& F, int l, int ntok) {
    LAS int* hist = (LAS int*)F.lds;
    LAS int* base = hist + 128;
    LAS unsigned* alist = (LAS unsigned*)(F.lds + 1024);
    const int tpw = (ntok + F.G - 1) / F.G, t0 = F.wg * tpw, t1 = (t0 + tpw) < ntok ? (t0 + tpw) : ntok;
    __syncthreads();
    if (F.tid < 128) hist[F.tid] = 0;
    __syncthreads();
    const float* LG = (const float*)(F.ws + WS_LOGIT); const float* rb = F.in[I_RB] + l * NEXP;
    const float b0 = rb[F.lane], b1 = rb[F.lane + 64];
    constexpr int RT = 4;
    for (int tb = t0 + F.wave * RT; tb < t1; tb += NWAVES * RT) {
        float s0[RT], s1[RT], e0[RT], e1[RT], gs0[RT], gs1[RT]; unsigned long long k0[RT], k1[RT]; int mye[RT]; float myw[RT], wsum[RT];
#pragma unroll
        for (int j = 0; j < RT; ++j) { const int tok = (tb + j) < t1 ? tb + j : t1 - 1;
            const float x0 = LG[(size_t)tok * 256 + F.lane], x1 = LG[(size_t)tok * 256 + 64 + F.lane];
            s0[j] = 1.0f / (1.0f + __expf(-x0)); s1[j] = 1.0f / (1.0f + __expf(-x1)); e0[j] = s0[j] + b0; e1[j] = s1[j] + b1; }
#pragma unroll
        for (int j = 0; j < RT; ++j) { gs0[j] = seg16_top2(e0[j], F.lane); gs1[j] = seg16_top2(e1[j], F.lane); }
#pragma unroll
        for (int j = 0; j < RT; ++j) {
            float gsc[8];
#pragma unroll
            for (int g = 0; g < 4; ++g) { gsc[g] = shf(gs0[j], g * 16); gsc[4 + g] = shf(gs1[j], g * 16); }
            unsigned gmask = 0u;
#pragma unroll
            for (int g = 0; g < 8; ++g) { int cnt = 0;
#pragma unroll
                for (int g2 = 0; g2 < 8; ++g2) cnt += (gsc[g2] > gsc[g] || (gsc[g2] == gsc[g] && g2 < g)) ? 1 : 0;
                gmask |= (cnt < 4) ? (1u << g) : 0u; }
            const bool ok0 = (gmask >> (F.lane >> 4)) & 1u, ok1 = (gmask >> (4 + (F.lane >> 4))) & 1u;
            k0[j] = ok0 ? (((unsigned long long)f_ord(e0[j]) << 32) | (unsigned)(255 - F.lane)) : 0ull;
            k1[j] = ok1 ? (((unsigned long long)f_ord(e1[j]) << 32) | (unsigned)(255 - 64 - F.lane)) : 0ull;
            mye[j] = 0; myw[j] = 0.f; wsum[j] = 0.f; }
#pragma unroll
        for (int k = 0; k < 8; ++k) {
            unsigned long long best[RT];
#pragma unroll
            for (int j = 0; j < RT; ++j) best[j] = k0[j] > k1[j] ? k0[j] : k1[j];
#pragma unroll
            for (int o = 1; o < 64; o <<= 1) {
#pragma unroll
                for (int j = 0; j < RT; ++j) { const unsigned lo = (unsigned)shxi((int)(unsigned)best[j], o, F.lane), hi = (unsigned)shxi((int)(unsigned)(best[j] >> 32), o, F.lane);
                    const unsigned long long w = ((unsigned long long)hi << 32) | lo; best[j] = w > best[j] ? w : best[j]; } }
#pragma unroll
            for (int j = 0; j < RT; ++j) { const int e = 255 - (int)(best[j] & 0xffu);
                if (k0[j] == best[j]) k0[j] = 0ull; if (k1[j] == best[j]) k1[j] = 0ull;
                const float sv = shf(e < 64 ? s0[j] : s1[j], e & 63);
                wsum[j] += sv; if (F.lane == k) { mye[j] = e; myw[j] = sv; } }
        }
#pragma unroll
        for (int j = 0; j < RT; ++j) { const int tok = tb + j;
            if (tok < t1 && F.lane < 8) {
                const int lr = __hip_atomic_fetch_add(&hist[mye[j]], 1, __ATOMIC_RELAXED, __HIP_MEMORY_SCOPE_WORKGROUP);
                alist[(tok - t0) * 8 + F.lane] = (unsigned)mye[j] | ((unsigned)lr << 8);
                ((int*)(F.ws + WS_EIDX))[(size_t)tok * 8 + F.lane] = mye[j];
                ((float*)(F.ws + WS_WGT))[(size_t)tok * 8 + F.lane] = myw[j] / wsum[j] * 2.5f;
            } }
    }
    __syncthreads();
    if (F.tid < 128) { const int hcount = hist[F.tid]; base[F.tid] = hcount ? (int)atomicAdd(F.ctl + CW_CNT + l * 256 + F.tid, (unsigned)hcount) : 0; }
    __syncthreads();
    for (int a = F.tid; a < (t1 - t0) * 8; a += NTHR) { const unsigned v = alist[a]; ((int*)(F.ws + WS_RNK))[(size_t)t0 * 8 + a] = base[v & 0xffu] + (int)(v >> 8); }
}
__device__ __forceinline__ void ph_positions(Frame& F, int l, int ntok) {
    LAS int* cnt = (LAS int*)F.lds;
    LAS int* off = cnt + 132;
    __syncthreads();
    if (F.tid < NE1) cnt[F.tid] = F.tid < NEXP ? (int)__hip_atomic_load(F.ctl + CW_CNT + l * 256 + F.tid, __ATOMIC_RELAXED, __HIP_MEMORY_SCOPE_AGENT) : ntok;
    __syncthreads();
    if (F.tid == 0) { int o = 0; for (int e = 0; e < NE1; ++e) { off[e] = o; o += (cnt[e] + 255) & ~255; } off[NE1] = o; }
    __syncthreads();
    const int gt = F.wg * NTHR + F.tid, NGT = F.G * NTHR;
    int* rowtok = (int*)(F.ws + WS_ROWTOK); int* rowdst = (int*)(F.ws + WS_ROWDST); int* tile_exp = (int*)(F.ws + WS_TILEEXP);
    const int* eidx = (const int*)(F.ws + WS_EIDX); const int* rnk = (const int*)(F.ws + WS_RNK);
    for (int a = gt; a < ntok * 8; a += NGT) { const int tok = a >> 3, k = a & 7; const int pos = off[eidx[a]] + rnk[a]; rowtok[pos] = tok; rowdst[pos] = tok * 9 + k; }
    for (int tok = gt; tok < ntok; tok += NGT) { const int pos = off[NEXP] + tok; rowtok[pos] = tok; rowdst[pos] = tok * 9 + 8; }
    for (int i = gt; i < NE1 * 256; i += NGT) { const int e = i >> 8, p = i & 255; const int row = off[e] + cnt[e] + p; if (row < off[e + 1]) { rowtok[row] = 0; rowdst[row] = -1; } }
    for (int i = gt; i < NE1 * 320; i += NGT) { const int e = i / 320, p = i % 320; const int t = (off[e] >> 8) + p; if (t < (off[e + 1] >> 8)) tile_exp[t] = e; }
    if (gt == 0) F.ctl[CW_NTL + l] = (unsigned)(off[NE1] >> 8);
}

#ifndef MK_MULTI
#define MK_MULTI 0
#endif
constexpr int PH_PER_LAYER = 12, NPHASE = 2 + DEPTH * PH_PER_LAYER;
struct Args { const float* in[36]; float* out; unsigned char* ws; int ph_lo, ph_hi; };

__global__ void __launch_bounds__(NTHR, 2) mk_fwd(Args args) {
    extern __shared__ __attribute__((aligned(16))) unsigned char lds_raw[];
    Frame F;
    F.lds = (LAS unsigned char*)lds_raw;
    F.tid = threadIdx.x; F.lane = F.tid & 63; F.wave = __builtin_amdgcn_readfirstlane(F.tid >> 6);
    const int wave0 = F.wave;
    F.G = gridDim.x; F.wg = blockIdx.x;
    F.in = args.in;
    F.out = args.out; F.ws = args.ws; F.ctl = (unsigned*)(args.ws + WS_CTL);
    volatile LAS unsigned* MISC = (volatile LAS unsigned*)(F.lds + MISC_OFF);
    if (F.tid < 32) MISC[F.tid] = 0u;
    __syncthreads();
    const int lo = args.ph_lo, hi = args.ph_hi;
    const bool single = (hi - lo) > 1;
    XcdBarrier bar; bar.bar = F.ctl + CW_BAR; bar.x = 0; bar.st = nullptr;
    if (single) bar = xcd_barrier_post(F.ctl + CW_BAR, MISC + 8);
#define IN(k) (lo <= (k) && (k) < hi)
#ifndef PROBE_MASK
#define PROBE_MASK 0
#endif
#define REP(k) for (int _rep = 0; _rep < (((PROBE_MASK >> (k)) & 1) ? 2 : 1); ++_rep)
#define SEAM(k) do { if (IN(k) && IN((k) + 1)) { xcd_barrier(bar); if ((PROBE_MASK >> 15) & 1) xcd_barrier(bar); } } while (0)
#define FRESH() do { int _ln; asm volatile("v_mbcnt_lo_u32_b32 %0, -1, 0\n\tv_mbcnt_hi_u32_b32 %0, -1, %0" : "=v"(_ln)); int _wv = wave0; asm volatile("" : "+s"(_wv)); F.lane = _ln; F.wave = _wv; F.tid = (_wv << 6) | _ln; \
        unsigned char* _w = args.ws; asm volatile("" : "+s"(_w)); F.ws = _w; F.ctl = (unsigned*)(_w + WS_CTL); float* _o = args.out; asm volatile("" : "+s"(_o)); F.out = _o; } while (0)

    if (IN(0)) { FRESH(); REP(13) { p0_static_weights(F); __syncthreads(); p0_mod(F); __syncthreads(); p0_hyena_filters(F); __syncthreads(); } }
    SEAM(0);
    if (IN(1)) { FRESH(); p0_init_rows(F); }
    SEAM(1);
#pragma unroll 1
    for (int l = 0; l < DEPTH; ++l) {
        const int pb = 2 + l * PH_PER_LAYER; const bool last = (l == DEPTH - 1); const int ntok = last ? NLAT : NROW;
        if (IN(pb + 0)) { FRESH();
            REP(0) { p_expert_weights(F, l); __syncthreads(); }
            pg8::DenseOrder S; S.init(NROW, DIN, F.G, F.wg); pg8::EpiBf16 E{(bf16_t*)(F.ws + WS_U), DIN};
            REP(1) pg8::gemm_phase<pg8::EpiBf16, pg8::DenseOrder, false>(F.tid, F.lds, (const bf16_t*)(F.ws + WS_XM), (const bf16_t*)(F.ws + WS_WIN) + (size_t)l * DIN * DM, DM, nullptr, S, E);
        }
        SEAM(pb + 0);
        if (IN(pb + 1)) { FRESH(); REP(2) { ph_transposes(F, l); __syncthreads(); } FRESH(); REP(3) { ph_gla_local(F, l); __syncthreads(); } }
        SEAM(pb + 1);
        if (IN(pb + 2)) { FRESH(); REP(4) { ph_na(F, l, last); } FRESH(); REP(5) { ph_gla_scan(F); } __syncthreads(); FRESH(); REP(6) { ph_hyena(F, l, last); } }
        SEAM(pb + 2);
        if (IN(pb + 3)) { FRESH(); ph_hy_transpose(F, last); __syncthreads(); FRESH(); REP(7) { ph_gla_out(F, l, last); } }
        SEAM(pb + 3);
        if (IN(pb + 4)) { FRESH();
            pg8::DenseOrder S; S.init(ntok, DM, F.G, F.wg); pg8::EpiBf16 E{(bf16_t*)(F.ws + WS_Y), DM};
            REP(8) pg8::gemm_phase<pg8::EpiBf16, pg8::DenseOrder, false>(F.tid, F.lds, (const bf16_t*)(F.ws + WS_MIX), (const bf16_t*)(F.ws + WS_WOUT) + (size_t)l * DM * DM, DM, nullptr, S, E);
        }
        SEAM(pb + 4);
        if (IN(pb + 5)) { FRESH(); ph_ln1(F, l, ntok); }
        SEAM(pb + 5);
        if (IN(pb + 6)) { FRESH();
            pg8::DenseOrder S; S.init(ntok, 256, F.G, F.wg); pg8::EpiF32 E{(float*)(F.ws + WS_LOGIT), 256};
            REP(9) pg8::gemm_phase<pg8::EpiF32, pg8::DenseOrder, false>(F.tid, F.lds, (const bf16_t*)(F.ws + WS_XM), (const bf16_t*)(F.ws + WS_WR) + (size_t)l * 256 * DM, DM, nullptr, S, E);
        }
        SEAM(pb + 6);
        if (IN(pb + 7)) { FRESH(); ph_route(F, l, ntok); }
        SEAM(pb + 7);
        if (IN(pb + 8)) { FRESH(); REP(12) { ph_positions(F, l, ntok); __syncthreads(); } }
        SEAM(pb + 8);
        if (IN(pb + 9)) { FRESH();
            const int ntl = (int)__hip_atomic_load(F.ctl + CW_NTL + l, __ATOMIC_RELAXED, __HIP_MEMORY_SCOPE_AGENT);
            pg8::GroupedOrder S; S.init(ntl, 2, F.G, F.wg); S.preload((const int*)(F.ws + WS_TILEEXP), F.lds + pg8::STAGE_BYTES + 4096, F.tid, NTHR); pg8::EpiSwiglu E{(unsigned char*)(F.ws + WS_ACT)};
            REP(10) pg8::gemm_phase<pg8::EpiSwiglu, pg8::GroupedOrder, true, true>(F.tid, F.lds, (const void*)(F.ws + WS_XM8), (const void*)(F.ws + WS_EXP1), DM, (const int*)(F.ws + WS_ROWTOK), S, E);
        }
        SEAM(pb + 9);
        if (IN(pb + 10)) { FRESH();
            const int ntl = (int)__hip_atomic_load(F.ctl + CW_NTL + l, __ATOMIC_RELAXED, __HIP_MEMORY_SCOPE_AGENT);
            pg8::GroupedOrder S; S.init(ntl, 4, F.G, F.wg); S.preload((const int*)(F.ws + WS_TILEEXP), F.lds + pg8::STAGE_BYTES + 4096, F.tid, NTHR); pg8::EpiScatter E{(unsigned char*)(F.ws + WS_Y2), (const int*)(F.ws + WS_ROWDST)};
            REP(11) pg8::gemm_phase<pg8::EpiScatter, pg8::GroupedOrder, false, true>(F.tid, F.lds, (const void*)(F.ws + WS_ACT), (const void*)(F.ws + WS_EXP2), EH, nullptr, S, E);
        }
        SEAM(pb + 10);
        if (IN(pb + 11)) { FRESH(); ph_ln2(F, l, ntok, last); }
        SEAM(pb + 11);
    }
#undef IN
#undef SEAM
#undef FRESH
}

extern "C" void kernel_launch(void* const* d_in, const int* in_sizes, int n_in, void* d_out, int out_size, void* d_ws, size_t ws_size, hipStream_t stream) {
    static int grid = 0;
    if (grid == 0) {
        if (n_in != 36 || out_size != NLAT * DM || ws_size < WS_END) { fprintf(stderr, "kernel_launch: unexpected shapes (n_in %d out %d ws %zu need %zu)\n", n_in, out_size, ws_size, (size_t)WS_END); grid = -1; return; }
        int dev = 0, cus = 0, per_cu = 0;
        if (hipGetDevice(&dev) != hipSuccess || hipDeviceGetAttribute(&cus, hipDeviceAttributeMultiprocessorCount, dev) != hipSuccess) { grid = -1; return; }
        if (hipFuncSetAttribute((const void*)mk_fwd, hipFuncAttributeMaxDynamicSharedMemorySize, LDS_BYTES) != hipSuccess) { fprintf(stderr, "kernel_launch: hipFuncSetAttribute failed\n"); grid = -1; return; }
        if (hipOccupancyMaxActiveBlocksPerMultiprocessor(&per_cu, (const void*)mk_fwd, NTHR, LDS_BYTES) != hipSuccess || per_cu < 1) { fprintf(stderr, "kernel_launch: occupancy query says %d\n", per_cu); }
        (void)hipGetLastError();
        grid = cus;
    }
    if (grid < 0) return;
    (void)hipMemsetAsync((char*)d_ws + WS_CTL, 0, CTL_BYTES, stream);
    Args a{};
    for (int i = 0; i < 36; ++i) a.in[i] = (const float*)d_in[i];
    a.out = (float*)d_out; a.ws = (unsigned char*)d_ws;
#if MK_MULTI
    for (int p = 0; p < NPHASE; ++p) { a.ph_lo = p; a.ph_hi = p + 1; hipLaunchKernelGGL(mk_fwd, dim3(grid), dim3(NTHR), LDS_BYTES, stream, a); }
#else
    a.ph_lo = 0; a.ph_hi = NPHASE; hipLaunchKernelGGL(mk_fwd, dim3(grid), dim3(NTHR), LDS_BYTES, stream, a);
#endif
}
```

```cpp
#include <hip/hip_runtime.h>
#include <cstdio>
#include <cstdint>

#define LAS __attribute__((address_space(3)))
#define GAS __attribute__((address_space(1)))
typedef unsigned short bf16_t;
typedef short bf16x8 __attribute__((ext_vector_type(8)));
typedef float f32x4 __attribute__((ext_vector_type(4)));
typedef float f32x2 __attribute__((ext_vector_type(2)));
typedef unsigned u32x4 __attribute__((ext_vector_type(4)));
typedef unsigned u32x2 __attribute__((ext_vector_type(2)));

constexpr int NB = 16, SEQ = 4096, CTXL = 256, DM = 1024, DEPTH = 4;
constexpr int NLAT = NB * SEQ;
constexpr int NCTX = NB * CTXL;
constexpr int NROW = NLAT + NCTX;
constexpr int SPB = SEQ + CTXL;
constexpr int DIN_REF = 3104;
constexpr int DIN = 3328;
constexpr int UQ = 0, UK = 512, UV = 1024, UGQ = 1536, UGK = 1664, UGV = 1792, UGR = 2048, UHY = 2304, ULAF = 3072, ULAB = 3200;
constexpr int NEXP = 128, TOPK = 8, EH = 256;
constexpr int NE1 = NEXP + 1;
constexpr int RMAX = 659712;
constexpr int TMAX = RMAX / 256;
constexpr float LN_EPS = 1e-6f;
constexpr float DN_ALPHA = 1.6817928305074290f;

__device__ __forceinline__ unsigned f2bf(float f) { unsigned u = __builtin_bit_cast(unsigned, f); return (u + 0x7fffu + ((u >> 16) & 1u)) >> 16; }
typedef __bf16 bf16v2 __attribute__((ext_vector_type(2)));
__device__ __forceinline__ unsigned pk2(float lo, float hi) { const f32x2 v = {lo, hi}; const bf16v2 b = __builtin_convertvector(v, bf16v2); return __builtin_bit_cast(unsigned, b); }
__device__ __forceinline__ float bf2f(unsigned short b) { return __builtin_bit_cast(float, ((unsigned)b) << 16); }
__device__ __forceinline__ float bflo(unsigned w) { return __builtin_bit_cast(float, w << 16); }
__device__ __forceinline__ float bfhi(unsigned w) { return __builtin_bit_cast(float, w & 0xffff0000u); }
__device__ __forceinline__ float shx(float v, int o, int lane) { return __builtin_bit_cast(float, __builtin_amdgcn_ds_bpermute((lane ^ o) << 2, __builtin_bit_cast(int, v))); }
__device__ __forceinline__ int shxi(int v, int o, int lane) { return __builtin_amdgcn_ds_bpermute((lane ^ o) << 2, v); }
__device__ __forceinline__ float shf(float v, int src) { return __builtin_bit_cast(float, __builtin_amdgcn_ds_bpermute(src << 2, __builtin_bit_cast(int, v))); }
__device__ __forceinline__ float wave_sum(float v, int lane) {
#pragma unroll
    for (int o = 1; o < 64; o <<= 1) v += shx(v, o, lane);
    return v;
}
__device__ __forceinline__ void unpack8(const u32x4 q, float* o) { o[0] = bflo(q.x); o[1] = bfhi(q.x); o[2] = bflo(q.y); o[3] = bfhi(q.y); o[4] = bflo(q.z); o[5] = bfhi(q.z); o[6] = bflo(q.w); o[7] = bfhi(q.w); }
__device__ __forceinline__ float silu_f(float x) { return x * __builtin_amdgcn_rcpf(1.0f + __expf(-x)); }
#define LDS_WAIT() asm volatile("s_waitcnt lgkmcnt(0)" ::: "memory")
#define VM_WAIT() asm volatile("s_waitcnt vmcnt(0)" ::: "memory")

#define XB_TMO      128
#define XB_XCNT(j)  (256  + 64 * (j))
#define XB_XSUB(j)  (1280 + 64 * (j))
#define XB_XGEN(j)  (2304 + 64 * (j))
#define XB_TOP      3328
#define XB_TOPGEN   3392
#define XCD_BAR_WORDS 3456
#define XB_SPIN_CAP (1u << 18)

__device__ __forceinline__ unsigned xb_ld(unsigned* p)              { return __hip_atomic_load(p, __ATOMIC_RELAXED, __HIP_MEMORY_SCOPE_AGENT); }
__device__ __forceinline__ unsigned xb_add(unsigned* p, unsigned v) { return __hip_atomic_fetch_add(p, v, __ATOMIC_RELAXED, __HIP_MEMORY_SCOPE_AGENT); }
__device__ __forceinline__ unsigned xb_xcc_id() { return (unsigned)__builtin_amdgcn_s_getreg((3 << 11) | 20) & 0xFu; }
#define XB_SPIN(cond, bar) do { unsigned _sp = 0; while (cond) { __builtin_amdgcn_s_sleep(1); \
    if ((++_sp & 255u) == 0u) { if (xb_ld(&(bar)[XB_TMO])) break; if (_sp > XB_SPIN_CAP) { atomicAdd(&(bar)[XB_TMO], 1u); break; } } } } while (0)

struct XcdBarrier { unsigned* bar; unsigned x; volatile LAS unsigned* st; };

__device__ __forceinline__ XcdBarrier xcd_barrier_post(unsigned* bar, volatile LAS unsigned* st) {
    XcdBarrier b; b.bar = bar; b.x = xb_xcc_id(); b.st = st;
    if (threadIdx.x == 0) (void)xb_add(&bar[XB_XCNT(b.x)], 1u);
    return b;
}
__device__ __forceinline__ void xcd_barrier_complete(unsigned* bar, unsigned x, unsigned& nloc, unsigned& nx) {
    const unsigned G = gridDim.x * gridDim.y * gridDim.z;
    unsigned sum, cnt, mine, sp = 0u;
    for (;;) {
        sum = 0u; cnt = 0u; mine = 0u;
#pragma unroll
        for (unsigned j = 0; j < 16; ++j) { const unsigned c = xb_ld(&bar[XB_XCNT(j)]); sum += c; cnt += (c > 0u) ? 1u : 0u; mine = (j == x) ? c : mine; }
        if (sum == G) break;
        __builtin_amdgcn_s_sleep(1);
        if ((++sp & 255u) == 0u) { if (xb_ld(&bar[XB_TMO])) break; if (sp > XB_SPIN_CAP) { atomicAdd(&bar[XB_TMO], 1u); break; } }
    }
    nloc = mine > 0u ? mine : 1u; nx = cnt > 0u ? cnt : 1u;
}
__device__ __forceinline__ void xcd_barrier(const XcdBarrier& b) {
    asm volatile("s_waitcnt vmcnt(0)" ::: "memory");
    __syncthreads();
    if (threadIdx.x == 0) {
        unsigned* bar = b.bar;
        __builtin_amdgcn_s_waitcnt(0);
        unsigned nloc = b.st[0], nx = b.st[1];
        if (nloc == 0u) { xcd_barrier_complete(bar, b.x, nloc, nx); b.st[0] = nloc; b.st[1] = nx; }
        const unsigned old = xb_add(&bar[XB_XSUB(b.x)], 1u);
        const unsigned gen = old / nloc;
        if (old + 1u == (gen + 1u) * nloc) {
            __builtin_amdgcn_fence(__ATOMIC_RELEASE, "agent");
            asm volatile("s_waitcnt vmcnt(0)" ::: "memory");
            const unsigned og = xb_add(&bar[XB_TOP], 1u);
            const unsigned tg = og / nx;
            if (og + 1u == (tg + 1u) * nx) xb_add(&bar[XB_TOPGEN], 1u);
            else XB_SPIN(xb_ld(&bar[XB_TOPGEN]) == tg, bar);
            __builtin_amdgcn_fence(__ATOMIC_ACQUIRE, "agent");
            xb_add(&bar[XB_XGEN(b.x)], 1u);
            asm volatile("s_waitcnt vmcnt(0)" ::: "memory");
        } else {
            XB_SPIN(xb_ld(&bar[XB_XGEN(b.x)]) == gen, bar);
            __builtin_amdgcn_fence(__ATOMIC_ACQUIRE, "agent");
            asm volatile("s_waitcnt vmcnt(0)" ::: "memory");
        }
    }
    __syncthreads();
}

namespace pg8 {
constexpr int BM = 256, BK = 64, HALF = 128, HTB = HALF * BK * 2, STAGE_BYTES = 8 * HTB, NXCD = 8, WGM = 8;
__host__ __device__ __forceinline__ int lds_byte(int r, int c) { const int st = (r >> 4) * 2 + (c >> 5), rr = r & 15, cc = c & 31, ob = rr * 64 + cc * 2; return st * 1024 + (ob ^ (((ob >> 9) & 1) << 5)); }
__host__ __device__ __forceinline__ void stage_rc(int b, int& R, int& C) { const int st = b / 1024, sb = b % 1024, swz = sb ^ (((sb >> 9) & 1) << 5); R = (st >> 1) * 16 + swz / 64; C = (st & 1) * 32 + (swz % 64) / 2; }
__host__ __device__ __forceinline__ int perm32(int rho) { const int n = rho >> 4, i = rho & 15; return 8 * (i >> 2) + 4 * n + (i & 3); }

struct Unit { int arow0, brow0, orow0, ocol0, aux; };

struct DenseOrder {
    int nM, nN, nwg, G, c;
    __device__ void init(int M, int N, int G_, int c_) { nM = M / BM; nN = N / BM; nwg = nM * nN; G = G_; c = c_; }
    __device__ __forceinline__ bool next(int i, Unit& u) const {
        const long L = (long)i * G + c; if (L >= nwg) return false;
        int wgid = (int)L; { const int q = nwg / NXCD, r = nwg % NXCD, xcd = wgid % NXCD, off = wgid / NXCD; wgid = (xcd < r ? xcd * (q + 1) : r * (q + 1) + (xcd - r) * q) + off; }
        const int nig = WGM * nN, gid = wgid / nig, fm = gid * WGM, gsz = (nM - fm) < WGM ? (nM - fm) : WGM;
        const int pm = fm + ((wgid % nig) % gsz), pn = (wgid % nig) / gsz;
        u.arow0 = pm * BM; u.brow0 = pn * BM; u.orow0 = pm * BM; u.ocol0 = pn * BM; u.aux = 0; return true;
    }
};
struct GroupedOrder {
    const LAS unsigned char* tab; int nN, nslot, slot, t0, t1;
    __device__ __forceinline__ void init(int ntiles, int nN_, int G, int c) {
        nN = nN_;
        if ((G & 7) == 0) { const int per = (ntiles + 7) >> 3, x = c & 7; nslot = G >> 3; slot = c >> 3; t0 = x * per; t1 = (t0 + per) < ntiles ? (t0 + per) : ntiles; }
        else { nslot = G; slot = c; t0 = 0; t1 = ntiles; }
    }
    __device__ __forceinline__ void preload(const int* tile_exp, LAS unsigned char* lds_tab, int tid, int nthr) {
        __syncthreads();
        for (int i = tid; i < t1 - t0; i += nthr) lds_tab[i] = (unsigned char)tile_exp[t0 + i];
        __syncthreads();
        tab = lds_tab;
    }
    __device__ __forceinline__ bool next(int i, Unit& u) const {
        const int q = i * nslot + slot, t = t0 + q / nN, pn = q % nN;
        if (t >= t1) return false;
        const int e = (int)tab[t - t0];
        u.arow0 = t * BM; u.brow0 = (e * nN + pn) * BM; u.orow0 = t * BM; u.ocol0 = pn * BM; u.aux = e; return true;
    }
};

__device__ __forceinline__ unsigned cvt_pk_bf16(float lo, float hi) { return pk2(lo, hi); }

struct NoPre {};
struct EpiF32 {
    static constexpr bool PERM = false; typedef NoPre Pre;
    __device__ __forceinline__ Pre prefetch(const Unit&, LAS unsigned char*, int, int, int) const { return Pre{}; }
    float* C; int ldc;
    __device__ __forceinline__ void operator()(const f32x4 (&acc)[2][2][4][2], const Unit& u, int wr, int wc, int fr, int fq, const Pre&) const {
        const int row0 = u.orow0 + wr * 64 + fr, col0 = u.ocol0 + wc * 32 + 4 * fq;
#pragma unroll
        for (int ai = 0; ai < 2; ++ai)
#pragma unroll
            for (int m = 0; m < 4; ++m) { float* rowp = C + (size_t)(row0 + ai * HALF + m * 16) * ldc + col0;
#pragma unroll
                for (int bj = 0; bj < 2; ++bj)
#pragma unroll
                    for (int n = 0; n < 2; ++n) *(f32x4*)(rowp + bj * HALF + n * 16) = acc[ai][bj][m][n]; }
    }
};
struct EpiBf16 {
    static constexpr bool PERM = true; typedef NoPre Pre;
    __device__ __forceinline__ Pre prefetch(const Unit&, LAS unsigned char*, int, int, int) const { return Pre{}; }
    bf16_t* O; int ldc;
    __device__ __forceinline__ void operator()(const f32x4 (&acc)[2][2][4][2], const Unit& u, int wr, int wc, int fr, int fq, const Pre&) const {
        const int row0 = u.orow0 + wr * 64 + fr, col0 = u.ocol0 + wc * 32 + 8 * fq;
#pragma unroll
        for (int ai = 0; ai < 2; ++ai)
#pragma unroll
            for (int m = 0; m < 4; ++m) { bf16_t* rowp = O + (size_t)(row0 + ai * HALF + m * 16) * ldc + col0;
#pragma unroll
                for (int bj = 0; bj < 2; ++bj) { const f32x4 v0 = acc[ai][bj][m][0], v1 = acc[ai][bj][m][1];
                    u32x4 w; w.x = cvt_pk_bf16(v0[0], v0[1]); w.y = cvt_pk_bf16(v0[2], v0[3]); w.z = cvt_pk_bf16(v1[0], v1[1]); w.w = cvt_pk_bf16(v1[2], v1[3]);
                    *(u32x4*)(rowp + bj * HALF) = w; } }
    }
};
struct EpiSwiglu {
    static constexpr bool PERM = true; typedef NoPre Pre;
    __device__ __forceinline__ Pre prefetch(const Unit&, LAS unsigned char*, int, int, int) const { return Pre{}; }
    unsigned char* ACT;
    __device__ __forceinline__ void operator()(const f32x4 (&acc)[2][2][4][2], const Unit& u, int wr, int wc, int fr, int fq, const Pre&) const {
        const int row0 = u.orow0 + wr * 64 + fr, pn = u.ocol0 >> 8;
#pragma unroll
        for (int ai = 0; ai < 2; ++ai)
#pragma unroll
            for (int m = 0; m < 4; ++m) { unsigned char* rowp = ACT + (size_t)(row0 + ai * HALF + m * 16) * EH + pn * 128 + wc * 32 + 8 * fq;
                int w[2];
#pragma unroll
                for (int n = 0; n < 2; ++n) { const f32x4 g = acc[ai][0][m][n], up = acc[ai][1][m][n]; float h[4];
#pragma unroll
                    for (int i = 0; i < 4; ++i) h[i] = g[i] * __builtin_amdgcn_rcpf(1.0f + __expf(-g[i])) * up[i];
                    int v = 0; v = __builtin_amdgcn_cvt_pk_fp8_f32(h[0], h[1], v, false); v = __builtin_amdgcn_cvt_pk_fp8_f32(h[2], h[3], v, true); w[n] = v; }
                *(GAS u32x2*)rowp = (u32x2){(unsigned)w[0], (unsigned)w[1]}; }
    }
};
constexpr float Y2_SCALE = 16.0f, Y2_INV = 1.0f / 16.0f;
struct EpiScatter {
    static constexpr bool PERM = true;
    struct Pre { const LAS int* tab; };
    unsigned char* Y2; const int* rowdst;
    __device__ __forceinline__ Pre prefetch(const Unit& u, LAS unsigned char* lds, int wid, int lane, int ui) const {
        LAS unsigned char* tab = lds + STAGE_BYTES + (ui & 1) * 1024;
        if (wid < 4) __builtin_amdgcn_global_load_lds((const unsigned*)(rowdst + u.orow0 + wid * 64 + lane), (LAS unsigned*)(tab + wid * 256), 4, 0, 0);
        Pre p; p.tab = (const LAS int*)tab; return p; }
    __device__ __forceinline__ void operator()(const f32x4 (&acc)[2][2][4][2], const Unit& u, int wr, int wc, int fr, int fq, const Pre& pre) const {
#pragma unroll
        for (int ai = 0; ai < 2; ++ai)
#pragma unroll
            for (int m = 0; m < 4; ++m) { const int dst = pre.tab[wr * 64 + fr + ai * HALF + m * 16];
                if (dst >= 0) { unsigned char* rowp = Y2 + (size_t)dst * DM + u.ocol0 + wc * 64 + fq * 16;
                    int w[4];
#pragma unroll
                    for (int bj = 0; bj < 2; ++bj) { const f32x4 v0 = acc[ai][bj][m][0] * Y2_SCALE, v1 = acc[ai][bj][m][1] * Y2_SCALE;
                        int w0 = 0, w1 = 0;
                        w0 = __builtin_amdgcn_cvt_pk_fp8_f32(v0[0], v0[1], w0, false); w0 = __builtin_amdgcn_cvt_pk_fp8_f32(v0[2], v0[3], w0, true);
                        w1 = __builtin_amdgcn_cvt_pk_fp8_f32(v1[0], v1[1], w1, false); w1 = __builtin_amdgcn_cvt_pk_fp8_f32(v1[2], v1[3], w1, true);
                        w[2 * bj] = w0; w[2 * bj + 1] = w1; }
                    *(GAS u32x4*)rowp = (u32x4){(unsigned)w[0], (unsigned)w[1], (unsigned)w[2], (unsigned)w[3]}; } }
    }
};

typedef int v8i __attribute__((ext_vector_type(8)));
typedef int v4i __attribute__((ext_vector_type(4)));
struct Frag { bf16x8 p[2]; __device__ __forceinline__ bf16x8& operator[](int k) { return p[k]; } __device__ __forceinline__ const bf16x8& operator[](int k) const { return p[k]; } };
template <class Epi, class Sched, bool GATHER, bool F8 = false, bool ALIGN_EPI = true, bool SP2 = true>
__device__ __forceinline__ void gemm_phase(const int tid_in, LAS unsigned char* lds, const void* Ag, const void* Bg, const int K, const int* rowidx, const Sched& S, const Epi& E) {
    int tid_ = tid_in; asm volatile("" : "+v"(tid_));
    const int tid = tid_, wid = __builtin_amdgcn_readfirstlane(tid >> 6), lane = tid & 63, wr = wid >> 2, wc = wid & 3, fr = lane & 15, fq = lane >> 4;
    const int KB = F8 ? K : 2 * K;
    const int nt = KB / 128;
    unsigned voffB[2];
#pragma unroll
    for (int i = 0; i < 2; ++i) { int R, C; stage_rc(tid * 16 + i * 8192, R, C); const int Rb = Epi::PERM ? ((R & ~31) + perm32(R & 31)) : R;
        voffB[i] = (unsigned)(Rb * KB + C * 2); }
    const size_t kstep = (size_t)128;
    const size_t hstep = (size_t)HALF * KB;
    const unsigned ldsw = (unsigned)wid * 1024u;
    const int aoff = F8 ? lds_byte(wr * 64 + fr, 16 * fq) : lds_byte(wr * 64 + fr, fq * 8), boff = F8 ? lds_byte(wc * 32 + fr, 16 * fq) : lds_byte(wc * 32 + fr, fq * 8);
    constexpr int PIECE1 = F8 ? 16 : 1024;
    const int sc_w = 0x7A7A7A7A, sc_a = 0x7F7F7F7F;
#define PG8_SA(b, h) (((b) * 2 + (h)) * HTB)
#define PG8_SB(b, h) ((4 + (b) * 2 + (h)) * HTB)
#define PG8_STAGE_B(bufoff, gbase) do { _Pragma("unroll") for (int _i = 0; _i < 2; ++_i) \
        __builtin_amdgcn_global_load_lds((const unsigned*)((const char*)(gbase) + voffB[_i]), (LAS unsigned*)(lds + (bufoff) + ldsw + _i * 8192), 16, 0, 0); } while (0)
#define PG8_STAGE_A(bufoff, gbase, h) do { const char* _gb = (const char*)(gbase) + (GATHER ? (size_t)0 : (size_t)(h) * hstep); \
        __builtin_amdgcn_global_load_lds((const unsigned*)(_gb + ac[GATHER ? (h) : 0][0]), (LAS unsigned*)(lds + (bufoff) + ldsw), 16, 0, 0); \
        __builtin_amdgcn_global_load_lds((const unsigned*)(_gb + ac[GATHER ? (h) : 0][1]), (LAS unsigned*)(lds + (bufoff) + ldsw + 8192), 16, 0, 0); } while (0)
#define PG8_LDA(dst, b, h) do { _Pragma("unroll") for (int m = 0; m < 4; ++m) { if constexpr (F8) { const v4i _l = *(const LAS v4i*)(lds + PG8_SA(b, h) + aoff + m * 2048), _h = *(const LAS v4i*)(lds + PG8_SA(b, h) + aoff + m * 2048 + PIECE1); dst##8[m] = __builtin_shufflevector(_l, _h, 0, 1, 2, 3, 4, 5, 6, 7); } \
        else { dst[m][0] = *(const LAS bf16x8*)(lds + PG8_SA(b, h) + aoff + m * 2048); dst[m][1] = *(const LAS bf16x8*)(lds + PG8_SA(b, h) + aoff + m * 2048 + PIECE1); } } } while (0)
#define PG8_LDB(dst, b, h) do { _Pragma("unroll") for (int n = 0; n < 2; ++n) { if constexpr (F8) { const v4i _l = *(const LAS v4i*)(lds + PG8_SB(b, h) + boff + n * 2048), _h = *(const LAS v4i*)(lds + PG8_SB(b, h) + boff + n * 2048 + PIECE1); dst##8[n] = __builtin_shufflevector(_l, _h, 0, 1, 2, 3, 4, 5, 6, 7); } \
        else { dst[n][0] = *(const LAS bf16x8*)(lds + PG8_SB(b, h) + boff + n * 2048); dst[n][1] = *(const LAS bf16x8*)(lds + PG8_SB(b, h) + boff + n * 2048 + PIECE1); } } } while (0)
#define PG8_MMA(ai, bj, At, Bt) do { __builtin_amdgcn_s_setprio(1); _Pragma("unroll") for (int m = 0; m < 4; ++m) _Pragma("unroll") for (int n = 0; n < 2; ++n) { \
        if constexpr (F8) asm volatile("v_mfma_scale_f32_16x16x128_f8f6f4 %0, %1, %2, %0, %3, %4 op_sel_hi:[0,0,0]" : "+v"(acc[ai][bj][m][n]) : "v"(Bt##8[n]), "v"(At##8[m]), "v"(sc_w), "v"(sc_a)); \
        else { _Pragma("unroll") for (int k = 0; k < 2; ++k) acc[ai][bj][m][n] = __builtin_amdgcn_mfma_f32_16x16x32_bf16(Bt[n][k], At[m][k], acc[ai][bj][m][n], 0, 0, 0); } } \
        __builtin_amdgcn_s_setprio(0); } while (0)
#define PG8_WAIT_V(n) asm volatile("s_waitcnt vmcnt(" #n ")" ::: "memory")
#define PG8_WAIT_L(n) asm volatile("s_waitcnt lgkmcnt(" #n ")" ::: "memory")
#define PG8_BAR __builtin_amdgcn_s_barrier()
#define PG8_SCHED __builtin_amdgcn_sched_barrier(0)
#define PG8_TAB(par) (lds + STAGE_BYTES + 2048 + (par) * 1024)
#define PG8_TABLOAD(par, row0) do { if (wid < 4) __builtin_amdgcn_global_load_lds((const unsigned*)(rowidx + (row0) + wid * 64 + lane), (LAS unsigned*)(PG8_TAB(par) + wid * 256), 4, 0, 0); } while (0)
#define PG8_AOFF_H(h, par) do { int _tz = tid; asm volatile("" : "+v"(_tz)); _Pragma("unroll") for (int _i = 0; _i < 2; ++_i) { int _R, _C; stage_rc(_tz * 16 + _i * 8192, _R, _C); \
        if (GATHER) ac[h][_i] = ((const LAS unsigned*)PG8_TAB(par))[(h) * HALF + _R] * (unsigned)KB + (unsigned)_C * 2u; \
        else ac[h][_i] = (unsigned)(((h) * HALF + _R) * KB) + (unsigned)_C * 2u; } } while (0)
    static_assert(SP2, "only the two-super-phase K-loop is kept");
    Unit cur, nxt; int ui = 0;
    if (!S.next(0, cur)) return;
    f32x4 acc[2][2][4][2];
#pragma unroll
    for (int a = 0; a < 2; ++a)
#pragma unroll
        for (int b = 0; b < 2; ++b)
#pragma unroll
            for (int m = 0; m < 4; ++m)
#pragma unroll
                for (int n = 0; n < 2; ++n) acc[a][b][m][n] = (f32x4){0.f, 0.f, 0.f, 0.f};
    bf16x8 At[F8 ? 1 : 4][2], B0[F8 ? 1 : 2][2], B1[F8 ? 1 : 2][2];
    v8i At8[F8 ? 4 : 1], B08[F8 ? 2 : 1], B18[F8 ? 2 : 1];
    unsigned ac[GATHER ? 2 : 1][2];
    if (GATHER) { PG8_TABLOAD(0, cur.arow0); PG8_WAIT_V(0); PG8_BAR; }
    PG8_AOFF_H(0, 0); if (GATHER) { PG8_AOFF_H((GATHER ? 1 : 0), 0); }
    const char* cA = (const char*)Ag + (GATHER ? (size_t)0 : (size_t)cur.arow0 * KB); const char* cB = (const char*)Bg + (size_t)cur.brow0 * KB;
    PG8_STAGE_B(PG8_SB(0, 0), cB); PG8_STAGE_B(PG8_SB(0, 1), cB + hstep); PG8_STAGE_A(PG8_SA(0, 0), cA, 0); PG8_STAGE_A(PG8_SA(0, 1), cA, 1);
    if (wr == 1) PG8_BAR;
    PG8_WAIT_V(2); PG8_BAR;
    PG8_STAGE_B(PG8_SB(1, 0), cB + kstep); PG8_STAGE_A(PG8_SA(1, 0), cA + kstep, 0); PG8_STAGE_B(PG8_SB(1, 1), cB + hstep + kstep);
    PG8_WAIT_V(6); PG8_BAR;
    for (;;) {
        const typename Epi::Pre pre = E.prefetch(cur, lds, wid, lane, ui);
        const bool has_next = S.next(ui + 1, nxt);
        if (GATHER) { if (has_next) PG8_TABLOAD((ui + 1) & 1, nxt.arow0); }
        const char* nA = has_next ? ((const char*)Ag + (GATHER ? (size_t)0 : (size_t)nxt.arow0 * KB)) : cA; const char* nB = has_next ? (const char*)Bg + (size_t)nxt.brow0 * KB : cB;
_Pragma("nounroll")
        for (int t = 0; t < nt; t += 2) {
            const bool last = (t == nt - 2);
            const char* a1 = cA + (size_t)(t + 1) * kstep;
            const char* a2 = last ? nA : cA + (size_t)(t + 2) * kstep; const char* b2 = last ? nB : cB + (size_t)(t + 2) * kstep;
            const char* a3 = a2 + kstep; const char* b3 = b2 + kstep;
            if (GATHER) { if (last && has_next) { PG8_AOFF_H(0, (ui + 1) & 1); } }
            PG8_LDB(B0, 0, 0); PG8_LDB(B1, 0, 1); PG8_SCHED; PG8_LDA(At, 0, 0); PG8_STAGE_A(PG8_SA(1, 1), a1, 1);
            PG8_WAIT_V(8); PG8_WAIT_L(0); PG8_BAR; PG8_MMA(0, 0, At, B0); PG8_MMA(0, 1, At, B1); PG8_BAR; PG8_SCHED;
            if (GATHER) { if (last && has_next) { PG8_AOFF_H(1, (ui + 1) & 1); } }
            PG8_LDA(At, 0, 1); PG8_STAGE_B(PG8_SB(0, 0), b2); PG8_STAGE_B(PG8_SB(0, 1), b2 + hstep); PG8_STAGE_A(PG8_SA(0, 0), a2, 0);
            PG8_WAIT_V(8); PG8_WAIT_L(0); PG8_BAR; PG8_MMA(1, 0, At, B0); PG8_MMA(1, 1, At, B1); PG8_BAR; PG8_SCHED;
            PG8_LDB(B0, 1, 0); PG8_LDB(B1, 1, 1); PG8_SCHED; PG8_LDA(At, 1, 0); PG8_STAGE_A(PG8_SA(0, 1), a2, 1);
            PG8_WAIT_V(8); PG8_WAIT_L(0); PG8_BAR; PG8_MMA(0, 0, At, B0); PG8_MMA(0, 1, At, B1); PG8_BAR; PG8_SCHED;
            PG8_LDA(At, 1, 1); PG8_STAGE_B(PG8_SB(1, 0), b3); PG8_STAGE_B(PG8_SB(1, 1), b3 + hstep); PG8_STAGE_A(PG8_SA(1, 0), a3, 0);
            PG8_WAIT_V(8); PG8_WAIT_L(0); PG8_BAR; PG8_MMA(1, 0, At, B0); PG8_MMA(1, 1, At, B1); PG8_BAR; PG8_SCHED;
        }
        if constexpr (ALIGN_EPI) { if (wr == 0) PG8_BAR; }
        E(acc, cur, wr, wc, fr, fq, pre);
        if (!has_next) break;
#pragma unroll
        for (int a = 0; a < 2; ++a)
#pragma unroll
            for (int b = 0; b < 2; ++b)
#pragma unroll
                for (int m = 0; m < 4; ++m)
#pragma unroll
                    for (int n = 0; n < 2; ++n) acc[a][b][m][n] = (f32x4){0.f, 0.f, 0.f, 0.f};
        cur = nxt; cA = nA; cB = nB; ++ui;
        if constexpr (ALIGN_EPI) { if (wr == 1) PG8_BAR; }
    }
    PG8_WAIT_V(0);
    if constexpr (!ALIGN_EPI) { if (wr == 0) PG8_BAR; }
    PG8_BAR;
#undef PG8_SA
#undef PG8_SB
#undef PG8_STAGE_A
#undef PG8_STAGE_B
#undef PG8_LDA
#undef PG8_LDB
#undef PG8_MMA
#undef PG8_WAIT_V
#undef PG8_WAIT_L
#undef PG8_BAR
#undef PG8_SCHED
#undef PG8_AOFF_H
#undef PG8_TAB
#undef PG8_TABLOAD
}
}

constexpr int NWAVES = 8, NTHR = 512;
constexpr size_t MiB = 1u << 20;
constexpr size_t WS_CTL = 0, CTL_BYTES = 1 * MiB;
constexpr size_t WS_MOD = 1 * MiB;
constexpr size_t WS_WIN = 3 * MiB;
constexpr size_t WS_WOUT = 29 * MiB;
constexpr size_t WS_WR = 37 * MiB;
constexpr size_t WS_HYF = 39 * MiB;
constexpr size_t WS_HYFC = 71 * MiB;
constexpr size_t WS_XC = 73 * MiB;
constexpr size_t WS_EXP1 = 89 * MiB;
constexpr size_t WS_EXP2 = 218 * MiB;
constexpr size_t WS_XM = 283 * MiB;
constexpr size_t WS_EIDX = 419 * MiB;
constexpr size_t WS_WGT = 422 * MiB;
constexpr size_t WS_RNK = 425 * MiB;
constexpr size_t WS_ROWTOK = 428 * MiB;
constexpr size_t WS_ROWDST = 431 * MiB;
constexpr size_t WS_TILEEXP = 434 * MiB;
constexpr size_t WS_BIG = 435 * MiB;
constexpr size_t WS_U = WS_BIG;
constexpr size_t WS_MIX = 877 * MiB;
constexpr size_t WS_VT = 1013 * MiB;
constexpr size_t WS_HV = 1081 * MiB;
constexpr size_t WS_Z2 = 1183 * MiB;
constexpr size_t WS_GDS = 1217 * MiB;
constexpr size_t WS_GSIN = 1285 * MiB;
constexpr size_t WS_GD = 1319 * MiB;
constexpr size_t WS_Y = 1321 * MiB;
constexpr size_t WS_LOGIT = WS_BIG;
constexpr size_t WS_ACT = WS_BIG;
constexpr size_t WS_Y2 = 758 * MiB;
constexpr size_t WS_XM8 = 1470 * MiB;
constexpr size_t WS_XR = 1600 * MiB;
constexpr size_t WS_END = 1736 * MiB;
constexpr int CW_BAR = 4096;
constexpr int CW_CNT = 16384;
constexpr int CW_NTL = 20480;

constexpr int LDS_BYTES = 163840;
constexpr int MISC_OFF = 163584;

struct Frame {
    LAS unsigned char* lds;
    int tid, lane, wave, G, wg;
    const float* const* in;
    float* out; unsigned char* ws; unsigned* ctl;
};
enum { I_X = 0, I_C, I_CTX, I_CCTX, I_WMOD, I_BMOD, I_WIN, I_RPB, I_WA2, I_BA2, I_GNORM, I_HSW, I_HSB, I_HW1, I_HB1, I_HF1, I_HW2, I_HB2, I_HF2, I_HW3, I_HB3, I_HDEC, I_HSKIP,
       I_WOUT, I_LN1G, I_LN1B, I_RW, I_RB, I_WEG, I_WEU, I_WED, I_WSG, I_WSU, I_WSD, I_LN2G, I_LN2B };

__device__ __forceinline__ int row_b(int row) { return row < NLAT ? (row >> 12) : 16; }
__device__ __forceinline__ const float* mod_ptr(const Frame& F, int l, int row) { return (const float*)(F.ws + WS_MOD) + ((size_t)l * 17 + row_b(row)) * 6144; }

template <class RowFn>
__device__ __forceinline__ void tr_item(const float* W, int ldw, int k0, int n0, bf16_t* dst, int ldd, RowFn rf, LAS float* scr, int lane) {
    float tv[32];
    const GAS float* wp = (const GAS float*)(W + (size_t)(k0 + (lane >> 5)) * ldw + n0 + (lane & 31));
#pragma unroll
    for (int i = 0; i < 32; ++i) tv[i] = wp[(size_t)(2 * i) * ldw];
#pragma unroll
    for (int i = 0; i < 32; ++i) scr[(2 * i + (lane >> 5)) * 33 + (lane & 31)] = tv[i];
    LDS_WAIT(); asm volatile("" ::: "memory");
    const int c = lane & 7;
#pragma unroll
    for (int j = 0; j < 4; ++j) { const int n = (lane >> 3) + 8 * j; const LAS float* s = scr + (8 * c) * 33 + n;
        u32x4 o; o.x = pk2(s[0 * 33], s[1 * 33]); o.y = pk2(s[2 * 33], s[3 * 33]); o.z = pk2(s[4 * 33], s[5 * 33]); o.w = pk2(s[6 * 33], s[7 * 33]);
        *(GAS u32x4*)(dst + (size_t)rf(n0 + n) * ldd + k0 + 8 * c) = o; }
    LDS_WAIT(); asm volatile("" ::: "memory");
}
template <class RowFn>
__device__ __forceinline__ void tr_item8(const float* W, int ldw, int k0, int n0, unsigned char* dst, int ldd, RowFn rf, float scale, LAS float* scr, int lane) {
    float tv[32];
    const GAS float* wp = (const GAS float*)(W + (size_t)(k0 + (lane >> 5)) * ldw + n0 + (lane & 31));
#pragma unroll
    for (int i = 0; i < 32; ++i) tv[i] = wp[(size_t)(2 * i) * ldw];
#pragma unroll
    for (int i = 0; i < 32; ++i) scr[(2 * i + (lane >> 5)) * 33 + (lane & 31)] = tv[i];
    LDS_WAIT(); asm volatile("" ::: "memory");
    const int n = lane >> 1, hf = lane & 1; const LAS float* s = scr + (32 * hf) * 33 + n;
    unsigned w[8];
#pragma unroll
    for (int j = 0; j < 8; ++j) { int v = 0; v = __builtin_amdgcn_cvt_pk_fp8_f32(s[(4 * j) * 33] * scale, s[(4 * j + 1) * 33] * scale, v, false); v = __builtin_amdgcn_cvt_pk_fp8_f32(s[(4 * j + 2) * 33] * scale, s[(4 * j + 3) * 33] * scale, v, true); w[j] = (unsigned)v; }
    unsigned char* d = dst + (size_t)rf(n0 + n) * ldd + k0 + 32 * hf;
    *(GAS u32x4*)d = (u32x4){w[0], w[1], w[2], w[3]}; *(GAS u32x4*)(d + 16) = (u32x4){w[4], w[5], w[6], w[7]};
    LDS_WAIT(); asm volatile("" ::: "memory");
}
struct RowId { __device__ __forceinline__ int operator()(int n) const { return n; } };
struct RowWin { __device__ __forceinline__ int operator()(int n) const { return n >= 2336 ? n - 32 : n; } };
struct RowGU { int up; __device__ __forceinline__ int operator()(int j) const { return (j >> 7) * 256 + up * 128 + (j & 127); } };

__device__ __forceinline__ void p0_static_weights(Frame& F) {
    LAS float* scr = (LAS float*)(F.lds + F.wave * 16384);
    const int gw = F.wg * NWAVES + F.wave, NGW = F.G * NWAVES;
    constexpr int I_IN = 16 * 97, I_OUT = 16 * 32, I_R = 16 * 4, PER_L = I_IN + I_OUT + I_R;
    for (int it = gw; it < DEPTH * PER_L; it += NGW) {
        const int l = it / PER_L; int r = it % PER_L;
        if (r < I_IN) { const int kb = r / 97, nb = r % 97; if (nb == 72) continue;
            tr_item(F.in[I_WIN] + (size_t)l * DM * DIN_REF, DIN_REF, kb * 64, nb * 32, (bf16_t*)(F.ws + WS_WIN) + (size_t)l * DIN * DM, DM, RowWin{}, scr, F.lane); continue; }
        r -= I_IN;
        if (r < I_OUT) { const int kb = r / 32, nb = r % 32;
            tr_item(F.in[I_WOUT] + (size_t)l * DM * DM, DM, kb * 64, nb * 32, (bf16_t*)(F.ws + WS_WOUT) + (size_t)l * DM * DM, DM, RowId{}, scr, F.lane); continue; }
        r -= I_OUT;
        { const int kb = r / 4, nb = r % 4;
            tr_item(F.in[I_RW] + (size_t)l * DM * NEXP, NEXP, kb * 64, nb * 32, (bf16_t*)(F.ws + WS_WR) + (size_t)l * 256 * DM, DM, RowId{}, scr, F.lane); }
    }
    const int gt = F.wg * NTHR + F.tid, NGT = F.G * NTHR;
    for (int i = gt; i < DEPTH * 128 * DM / 8; i += NGT) { const int l = i / (128 * DM / 8), r = i % (128 * DM / 8);
        *(u32x4*)((bf16_t*)(F.ws + WS_WR) + ((size_t)l * 256 + 128) * DM + (size_t)r * 8) = (u32x4){0u, 0u, 0u, 0u}; }
    for (int i = gt; i < DEPTH * 256 * DM; i += NGT) {
        const int k = i % DM, n = (i / DM) % 256, l = i / (DM * 256), dir = n >> 7, j = n & 127;
        const float* wi = F.in[I_WIN] + ((size_t)l * DM + k) * DIN_REF + 2304 + dir * 16;
        const float* wa = F.in[I_WA2] + ((size_t)(l * 2 + dir) * 16) * 128 + j;
        float s = 0.f;
#pragma unroll
        for (int r = 0; r < 16; ++r) s += wi[r] * wa[r * 128];
        ((bf16_t*)(F.ws + WS_WIN))[((size_t)l * DIN + 3072 + n) * DM + k] = (bf16_t)f2bf(s);
    }
}
__device__ __forceinline__ void p0_mod(Frame& F) {
    LAS float* sc = (LAS float*)F.lds;
    LAS float* red = (LAS float*)(F.lds + 17 * 1024 * 4);
    for (int i = F.tid; i < 17 * 1024; i += NTHR) { const int r = i >> 10, k = i & 1023; const float v = r < 16 ? F.in[I_C][r * 1024 + k] : F.in[I_CCTX][k]; sc[i] = silu_f(v); }
    __syncthreads();
    const int kq = F.tid >> 7, cl = F.tid & 127;
    for (int u = F.wg; u < DEPTH * 48; u += F.G) {
        const int l = u / 48, col = (u % 48) * 128 + cl;
        const float* w = F.in[I_WMOD] + (size_t)l * DM * 6144 + col;
        float a[17];
#pragma unroll
        for (int r = 0; r < 17; ++r) a[r] = 0.f;
        for (int k0 = kq * 256; k0 < kq * 256 + 256; k0 += 16) {
            float wv[16];
#pragma unroll
            for (int q = 0; q < 16; ++q) wv[q] = *(const GAS float*)(w + (size_t)(k0 + q) * 6144);
#pragma unroll
            for (int q = 0; q < 16; ++q)
#pragma unroll
                for (int r = 0; r < 17; ++r) a[r] += sc[r * 1024 + k0 + q] * wv[q]; }
#pragma unroll
        for (int r = 0; r < 17; ++r) red[(kq * 17 + r) * 128 + cl] = a[r];
        __syncthreads();
        for (int i = F.tid; i < 17 * 128; i += NTHR) { const int r = i >> 7, c2 = i & 127, cc = (u % 48) * 128 + c2;
            const float s = red[(0 * 17 + r) * 128 + c2] + red[(1 * 17 + r) * 128 + c2] + red[(2 * 17 + r) * 128 + c2] + red[(3 * 17 + r) * 128 + c2] + F.in[I_BMOD][l * 6144 + cc];
            ((float*)(F.ws + WS_MOD))[((size_t)l * 17 + r) * 6144 + cc] = s; }
        __syncthreads();
    }
}
__device__ __forceinline__ void p0_hyena_filters(Frame& F) {
    LAS float* z = (LAS float*)F.lds;
    LAS float* h1 = z + 33 * 33;
    LAS float* h2 = h1 + 33 * 64;
    LAS float* tt = h2 + 33 * 64;
    LAS float* W1 = tt + 64;
    LAS float* W2 = W1 + 33 * 64;
    constexpr int UL = 4096 / 32, UC = 256 / 32, UPL = UL + UC;
    for (int u = F.wg; u < DEPTH * UPL; u += F.G) {
        const int l = u / UPL, r = u % UPL; const bool lat = r < UL; const int L = lat ? 4096 : 256, n0 = (lat ? r : r - UL) * 32;
        __syncthreads();
        for (int i = F.tid; i < 33 * 64; i += NTHR) W1[i] = F.in[I_HW1][(size_t)l * 33 * 64 + i];
        for (int i = F.tid; i < 64 * 64; i += NTHR) W2[i] = F.in[I_HW2][(size_t)l * 64 * 64 + i];
        for (int i = F.tid; i < 33 * 33; i += NTHR) { const int p = i / 33, e = i % 33, n = n0 + p;
            const float t = (float)n / (float)(L - 1);
            float v;
            if (e == 0) v = t;
            else { const int kb = (e - 1) & 15; const float band = 1e-4f + (float)kb * ((15.0f - 1e-4f) / 15.0f);
                   const float w = 6.283185307179586f * (float)n / (float)L; const float ang = w * band;
                   v = e <= 16 ? __cosf(ang) : -__sinf(ang); }
            z[i] = v; if (e == 0) tt[p] = t; }
        __syncthreads();
        for (int i = F.tid; i < 33 * 64; i += NTHR) { const int p = i >> 6, j = i & 63; float s = F.in[I_HB1][l * 64 + j];
#pragma unroll 11
            for (int e = 0; e < 33; ++e) s += z[p * 33 + e] * W1[e * 64 + j];
            h1[i] = __sinf(F.in[I_HF1][l * 64 + j] * s); }
        __syncthreads();
        for (int i = F.tid; i < 33 * 64; i += NTHR) { const int p = i >> 6, j = i & 63; float s = F.in[I_HB2][l * 64 + j];
#pragma unroll 16
            for (int e = 0; e < 64; ++e) s += h1[p * 64 + e] * W2[e * 64 + j];
            h2[i] = __sinf(F.in[I_HF2][l * 64 + j] * s); }
        __syncthreads();
#pragma unroll 1
        for (int cc = 0; cc < 2; ++cc) {
            const int col = F.tid + cc * 512, o = col >> 9, dir = (col >> 8) & 1, ch = col & 255;
            float a[33];
#pragma unroll
            for (int p = 0; p < 33; ++p) a[p] = 0.f;
            const float* w3 = F.in[I_HW3] + (size_t)l * 64 * 1024 + col;
            for (int k0 = 0; k0 < 64; k0 += 16) { float wv[16];
#pragma unroll
                for (int q = 0; q < 16; ++q) wv[q] = *(const GAS float*)(w3 + (size_t)(k0 + q) * 1024);
#pragma unroll
                for (int q = 0; q < 16; ++q)
#pragma unroll
                    for (int p = 0; p < 33; ++p) a[p] += h2[p * 64 + k0 + q] * wv[q]; }
            const float b3 = F.in[I_HB3][l * 1024 + col], dec = fabsf(F.in[I_HDEC][((size_t)(l * 2 + o) * 2 + dir) * 256 + ch]);
            const float skip = F.in[I_HSKIP][(l * 2 + o) * 256 + ch];
            bf16_t* R = lat ? (bf16_t*)(F.ws + WS_HYF) + ((size_t)(l * 2 + o) * 256 + ch) * 8192 : (bf16_t*)(F.ws + WS_HYFC) + ((size_t)(l * 2 + o) * 256 + ch) * 512;
#pragma unroll
            for (int p = 0; p < 33; ++p) a[p] = (a[p] + b3) * __expf(-tt[p] * dec);
            unsigned w[16];
            if (dir == 0) {
                if (n0 + 32 == L) a[32] = 0.f;
#pragma unroll
                for (int j = 0; j < 16; ++j) w[j] = pk2(a[32 - 2 * j], a[31 - 2 * j]);
                GAS u32x4* dst = (GAS u32x4*)(R + (L - n0 - 32));
                dst[0] = (u32x4){w[0], w[1], w[2], w[3]}; dst[1] = (u32x4){w[4], w[5], w[6], w[7]}; dst[2] = (u32x4){w[8], w[9], w[10], w[11]}; dst[3] = (u32x4){w[12], w[13], w[14], w[15]};
                if (n0 == 0) R[L] = (bf16_t)f2bf(a[0] + skip);
            } else if (n0 > 0) {
#pragma unroll
                for (int j = 0; j < 16; ++j) w[j] = pk2(a[2 * j], a[2 * j + 1]);
                GAS u32x4* dst = (GAS u32x4*)(R + (L + n0));
                dst[0] = (u32x4){w[0], w[1], w[2], w[3]}; dst[1] = (u32x4){w[4], w[5], w[6], w[7]}; dst[2] = (u32x4){w[8], w[9], w[10], w[11]}; dst[3] = (u32x4){w[12], w[13], w[14], w[15]};
            } else {
#pragma unroll
                for (int p = 1; p < 32; ++p) R[L + p] = (bf16_t)f2bf(a[p]);
            }
        }
    }
    __syncthreads();
}
__device__ __forceinline__ void p0_init_rows(Frame& F) {
    const int gw = F.wg * NWAVES + F.wave, NGW = F.G * NWAVES;
    for (int row = gw; row < NROW; row += NGW) {
        const float* src = row < NLAT ? F.in[I_X] + (size_t)row * DM : F.in[I_CTX] + (size_t)(row - NLAT) * DM;
        const float* md = mod_ptr(F, 0, row);
        bf16_t* xr = (bf16_t*)(F.ws + WS_XR) + (size_t)row * DM; bf16_t* xm = (bf16_t*)(F.ws + WS_XM) + (size_t)row * DM;
#pragma unroll
        for (int j = 0; j < 4; ++j) { const int c = 4 * F.lane + 256 * j;
            const f32x4 v = *(const GAS f32x4*)(src + c), sh = *(const GAS f32x4*)(md + c), sc = *(const GAS f32x4*)(md + 1024 + c);
            *(GAS u32x2*)(xr + c) = (u32x2){pk2(v[0], v[1]), pk2(v[2], v[3])};
            u32x2 w; w.x = pk2(v[0] * (1.f + sc[0]) + sh[0], v[1] * (1.f + sc[1]) + sh[1]); w.y = pk2(v[2] * (1.f + sc[2]) + sh[2], v[3] * (1.f + sc[3]) + sh[3]);
            *(GAS u32x2*)(xm + c) = w; }
    }
}
constexpr float WEXP_SCALE = 32.0f;
__device__ __forceinline__ void p_expert_weights(Frame& F, int l) {
    LAS float* scr = (LAS float*)(F.lds + F.wave * 16384);
    const int gw = F.wg * NWAVES + F.wave, NGW = F.G * NWAVES;
    constexpr int I1 = 16 * 8, I2 = 4 * 32, PER_E = 2 * I1 + I2;
    for (int it = gw; it < NE1 * PER_E; it += NGW) {
        const int e = it / PER_E; int r = it % PER_E;
        unsigned char* d1 = (unsigned char*)(F.ws + WS_EXP1) + (size_t)e * 512 * DM; unsigned char* d2 = (unsigned char*)(F.ws + WS_EXP2) + (size_t)e * DM * EH;
        if (r < 2 * I1) { const int up = r >= I1; if (up) r -= I1; const int kb = r / 8, nb = r % 8;
            const float* src = e < NEXP ? F.in[up ? I_WEU : I_WEG] + ((size_t)l * NEXP + e) * DM * EH : F.in[up ? I_WSU : I_WSG] + (size_t)l * DM * EH;
            tr_item8(src, EH, kb * 64, nb * 32, d1, DM, RowGU{up}, WEXP_SCALE, scr, F.lane); }
        else { r -= 2 * I1; const int kb = r / 32, nb = r % 32;
            const float* src = e < NEXP ? F.in[I_WED] + ((size_t)l * NEXP + e) * EH * DM : F.in[I_WSD] + (size_t)l * EH * DM;
            tr_item8(src, DM, kb * 64, nb * 32, d2, EH, RowId{}, WEXP_SCALE, scr, F.lane); }
    }
}

__device__ __forceinline__ f32x4 mfma16(bf16x8 a, bf16x8 b, f32x4 c) { return __builtin_amdgcn_mfma_f32_16x16x32_bf16(a, b, c, 0, 0, 0); }

__device__ __forceinline__ void ph_transposes(Frame& F, int l) {
    LAS bf16_t* tile = (LAS bf16_t*)(F.lds + F.wave * 16384);
    const bf16_t* U = (const bf16_t*)(F.ws + WS_U);
    const int gw = F.wg * NWAVES + F.wave, NGW = F.G * NWAVES;
    const int rsub = F.lane >> 3, cseg = F.lane & 7;
    for (int u = gw; u < 1088 * 20; u += NGW) {
        const int tt = u / 20, blk = u % 20;
        int b, s0, Ls, rowbase, posbase;
        if (tt < 1024) { b = tt >> 6; s0 = (tt & 63) * 64; Ls = SEQ; rowbase = b * SEQ; posbase = 0; }
        else { const int t2 = tt - 1024; b = t2 >> 2; s0 = (t2 & 3) * 64; Ls = CTXL; rowbase = NLAT + b * CTXL; posbase = SEQ; }
        if (blk < 12) {
            const int c0 = blk * 64 + cseg * 8;
            float w0[8], w1[8], w2[8], bb[8];
#pragma unroll
            for (int i = 0; i < 8; ++i) { w0[i] = F.in[I_HSW][(l * 3 + 0) * 768 + c0 + i]; w1[i] = F.in[I_HSW][(l * 3 + 1) * 768 + c0 + i]; w2[i] = F.in[I_HSW][(l * 3 + 2) * 768 + c0 + i]; bb[i] = F.in[I_HSB][l * 768 + c0 + i]; }
#pragma unroll 2
            for (int it = 0; it < 8; ++it) {
                const int sl = rsub + 8 * it, s = s0 + sl;
                const bf16_t* p = U + (size_t)(rowbase + s) * DIN + UHY + c0;
                const u32x4 zc = *(const u32x4*)p;
                u32x4 zm = (u32x4){0u, 0u, 0u, 0u}, zp = (u32x4){0u, 0u, 0u, 0u};
                if (s > 0) zm = *(const u32x4*)(p - DIN);
                if (s < Ls - 1) zp = *(const u32x4*)(p + DIN);
                const unsigned am[4] = {zm.x, zm.y, zm.z, zm.w}, ac[4] = {zc.x, zc.y, zc.z, zc.w}, ap[4] = {zp.x, zp.y, zp.z, zp.w};
#pragma unroll
                for (int i = 0; i < 4; ++i) {
                    const float v0 = bb[2 * i] + w0[2 * i] * bflo(am[i]) + w1[2 * i] * bflo(ac[i]) + w2[2 * i] * bflo(ap[i]);
                    const float v1 = bb[2 * i + 1] + w0[2 * i + 1] * bfhi(am[i]) + w1[2 * i + 1] * bfhi(ac[i]) + w2[2 * i + 1] * bfhi(ap[i]);
                    tile[(cseg * 8 + 2 * i) * 72 + sl] = (bf16_t)f2bf(v0); tile[(cseg * 8 + 2 * i + 1) * 72 + sl] = (bf16_t)f2bf(v1);
                }
            }
        } else {
            const int c0 = (blk - 12) * 64 + cseg * 8;
#pragma unroll 2
            for (int it = 0; it < 8; ++it) {
                const int sl = rsub + 8 * it, s = s0 + sl;
                const u32x4 zc = *(const u32x4*)(U + (size_t)(rowbase + s) * DIN + UV + c0);
                const unsigned ac[4] = {zc.x, zc.y, zc.z, zc.w};
#pragma unroll
                for (int i = 0; i < 4; ++i) { tile[(cseg * 8 + 2 * i) * 72 + sl] = (bf16_t)(ac[i] & 0xffffu); tile[(cseg * 8 + 2 * i + 1) * 72 + sl] = (bf16_t)(ac[i] >> 16); }
            }
        }
        LDS_WAIT(); asm volatile("" ::: "memory");
#pragma unroll 2
        for (int it = 0; it < 8; ++it) {
            const int ch = rsub + 8 * it;
            const u32x4 v = *(const LAS u32x4*)(tile + ch * 72 + cseg * 8);
            bf16_t* dst;
            if (blk < 12) dst = (bf16_t*)(F.ws + WS_HV) + ((size_t)(blk * 64 + ch) * NB + b) * SPB + posbase + s0 + cseg * 8;
            else dst = (bf16_t*)(F.ws + WS_VT) + ((size_t)b * 512 + (blk - 12) * 64 + ch) * SPB + posbase + s0 + cseg * 8;
            *(u32x4*)dst = v;
        }
        LDS_WAIT(); asm volatile("" ::: "memory");
    }
}

constexpr int NA_RPB = 0, NA_KC = 2048, NA_VC = NA_KC + 256 * 144, NA_KR = NA_VC + 64 * 528, NA_END = NA_KR + 9 * 64 * 144;
static_assert(NA_END <= MISC_OFF, "NA LDS map");
__device__ __forceinline__ bf16x8 gld16(const bf16_t* p) { return *(const GAS bf16x8*)p; }
__device__ __forceinline__ u32x2 gld8(const bf16_t* p) { return *(const GAS u32x2*)p; }
__device__ __forceinline__ const char* uni_ptr(const char* p) { const unsigned long long v = (unsigned long long)p; const unsigned lo = __builtin_amdgcn_readfirstlane((unsigned)v), hi = __builtin_amdgcn_readfirstlane((unsigned)(v >> 32)); return (const char*)(((unsigned long long)hi << 32) | lo); }
__device__ __forceinline__ bf16x8 gld16o(const char* ub, unsigned lo) { return *(const GAS bf16x8*)(ub + (size_t)lo); }
__device__ __forceinline__ u32x2 gld8o(const char* ub, unsigned lo) { return *(const GAS u32x2*)(ub + (size_t)lo); }
template <bool WIN>
__device__ __forceinline__ void na_unit(Frame& F, int b, int h, int r, int strip) {
    const bf16_t* U = (const bf16_t*)(F.ws + WS_U);
    const bf16_t* VT = (const bf16_t*)(F.ws + WS_VT) + ((size_t)b * 512 + h * 64) * SPB;
    const LAS float* rpb = (const LAS float*)(F.lds + NA_RPB);
    const LAS bf16_t* KC = (const LAS bf16_t*)(F.lds + NA_KC); const LAS bf16_t* VC = (const LAS bf16_t*)(F.lds + NA_VC);
    int ln_ = F.lane; asm volatile("" : "+v"(ln_));
    const int i = ln_ & 15, g = ln_ >> 4;
    const int qrow0 = WIN ? (b * SEQ + r * 64 + strip * 16) : (NLAT + b * CTXL + strip * 16);
    const int ki = 8 * (i >> 2) + (i & 3);
    const unsigned qlo = (unsigned)((i * DIN + 8 * g) * 2), klo = (unsigned)((ki * DIN + 8 * g) * 2), vlo = (unsigned)((i * SPB + 8 * g) * 2);
    const char* qb = uni_ptr((const char*)(U + (size_t)qrow0 * DIN + UQ + h * 64));
    const bf16x8 q0 = gld16o(qb, qlo), q1 = gld16o(qb + 64, qlo);
    int kr0 = 0, u0 = 0;
    if (WIN) { kr0 = r - 4; kr0 = kr0 < 0 ? 0 : (kr0 > 56 ? 56 : kr0); u0 = strip == 0 ? 0 : (strip == 1 ? 8 : (strip == 2 ? 24 : 32)); }
    const LAS bf16_t* KR = (const LAS bf16_t*)(F.lds + NA_KR);
    const char* vbase = uni_ptr((const char*)(VT + kr0 * 64 + u0));
    f32x4 o[4];
#pragma unroll
    for (int d = 0; d < 4; ++d) o[d] = (f32x4){0.f, 0.f, 0.f, 0.f};
    float lsum = 0.f;
#define NA_SB() __builtin_amdgcn_sched_barrier(0)
#define NA_WLOAD(vb_, cw) do { _Pragma("unroll") for (int d = 0; d < 4; ++d) vb_[d] = gld16o(vbase + ((size_t)(d * 16) * SPB + (cw) * 64) * 2, vlo); } while (0)
#define NA_KRING(kb_, cw) do { const LAS bf16_t* kp = KR + ((((kr0 + (cw)) % 9) * 64 + u0 + ki) * 72 + 8 * g); kb_[0][0] = *(const LAS bf16x8*)kp; kb_[0][1] = *(const LAS bf16x8*)(kp + 32); \
        kb_[1][0] = *(const LAS bf16x8*)(kp + 4 * 72); kb_[1][1] = *(const LAS bf16x8*)(kp + 4 * 72 + 32); } while (0)
#define NA_QK(kb_, s_) do { _Pragma("unroll") for (int t = 0; t < 2; ++t) { f32x4 a = (f32x4){0.f, 0.f, 0.f, 0.f}; a = mfma16(kb_[t][0], q0, a); a = mfma16(kb_[t][1], q1, a); s_[t] = a; } } while (0)
#define NA_PV(s_, vb_) do { u32x4 pw; pw.x = pk2(s_[0][0], s_[0][1]); pw.y = pk2(s_[0][2], s_[0][3]); pw.z = pk2(s_[1][0], s_[1][1]); pw.w = pk2(s_[1][2], s_[1][3]); const bf16x8 pf = __builtin_bit_cast(bf16x8, pw); \
        _Pragma("unroll") for (int d = 0; d < 4; ++d) o[d] = mfma16(vb_[d], pf, o[d]); } while (0)
    bf16x8 vA[4], vB[4], vC[4];
    if (WIN) { NA_WLOAD(vA, 0); NA_WLOAD(vB, 1); NA_WLOAD(vC, 2); NA_SB(); }
#pragma unroll
    for (int cc = 0; cc < 8; ++cc) {
        bf16x8 kc[2][2], vc[4]; f32x4 sc[2];
#pragma unroll
        for (int t = 0; t < 2; ++t) { const LAS bf16_t* kp = KC + (cc * 32 + ki + 4 * t) * 72 + 8 * g; kc[t][0] = *(const LAS bf16x8*)kp; kc[t][1] = *(const LAS bf16x8*)(kp + 32); }
#pragma unroll
        for (int d = 0; d < 4; ++d) vc[d] = *(const LAS bf16x8*)(VC + (d * 16 + i) * 264 + cc * 32 + 8 * g);
        NA_QK(kc, sc);
#pragma unroll
        for (int t = 0; t < 2; ++t)
#pragma unroll
            for (int e = 0; e < 4; ++e) { const float p = __expf(fminf(sc[t][e] * 0.125f, 60.f)); sc[t][e] = p; lsum += p; }
        NA_PV(sc, vc);
    }
    if (WIN) {
        const int c = strip * 16 + i; int kc0 = c - 8; kc0 = kc0 < 0 ? 0 : (kc0 > 48 ? 48 : kc0);
        int dcl[2][4]; bool okm[2][4];
#pragma unroll
        for (int t = 0; t < 2; ++t)
#pragma unroll
            for (int e = 0; e < 4; ++e) { const int kc = u0 + 8 * g + 4 * t + e; okm[t][e] = (kc >= kc0) && (kc < kc0 + 16); int dc = kc - c + 15; dcl[t][e] = dc < 0 ? 0 : (dc > 30 ? 30 : dc); }
#define NA_WCHUNK(vb_, cw) do { bf16x8 kw[2][2]; NA_KRING(kw, cw); f32x4 sw[2]; NA_QK(kw, sw); const LAS float* rp = rpb + (kr0 + (cw) - r + 7) * 31; \
        _Pragma("unroll") for (int t = 0; t < 2; ++t) _Pragma("unroll") for (int e = 0; e < 4; ++e) { const float x = sw[t][e] * 0.125f + rp[dcl[t][e]]; const float p = okm[t][e] ? __expf(fminf(x, 60.f)) : 0.f; sw[t][e] = p; lsum += p; } \
        NA_PV(sw, vb_); } while (0)
        NA_WCHUNK(vA, 0); NA_SB(); NA_WLOAD(vA, 3); NA_SB();
        NA_WCHUNK(vB, 1); NA_SB(); NA_WLOAD(vB, 4); NA_SB();
        NA_WCHUNK(vC, 2); NA_SB(); NA_WLOAD(vC, 5); NA_SB();
        NA_WCHUNK(vA, 3); NA_SB(); NA_WLOAD(vA, 6); NA_SB();
        NA_WCHUNK(vB, 4); NA_SB(); NA_WLOAD(vB, 7); NA_SB();
        NA_WCHUNK(vC, 5); NA_SB();
        NA_WCHUNK(vA, 6); NA_SB();
        NA_WCHUNK(vB, 7); NA_SB();
#undef NA_WCHUNK
    }
    lsum += shx(lsum, 16, ln_); lsum += shx(lsum, 32, ln_);
    const float inv = 1.0f / lsum;
    char* op = (char*)uni_ptr((const char*)((bf16_t*)(F.ws + WS_MIX) + (size_t)qrow0 * DM + h * 64)); const unsigned olo = (unsigned)((i * DM + 4 * g) * 2);
#pragma unroll
    for (int d = 0; d < 4; ++d) { u32x2 w; w.x = pk2(o[d][0] * inv, o[d][1] * inv); w.y = pk2(o[d][2] * inv, o[d][3] * inv); *(GAS u32x2*)(op + d * 32 + (size_t)olo) = w; }
#undef NA_SB
#undef NA_WLOAD
#undef NA_KRING
#undef NA_QK
#undef NA_PV
}
__device__ __forceinline__ int na_kr0(int r) { const int k = r - 4; return k < 0 ? 0 : (k > 56 ? 56 : k); }
__device__ __forceinline__ void ph_na(Frame& F, int l, bool last) {
    const bf16_t* U = (const bf16_t*)(F.ws + WS_U);
    for (int job = F.wg; job < NB * 8 * 2; job += F.G) {
        const int half = job & 1, h = (job >> 1) & 7, b = job >> 4;
        int tz_; asm volatile("v_mbcnt_lo_u32_b32 %0, -1, 0\n\tv_mbcnt_hi_u32_b32 %0, -1, %0" : "=v"(tz_)); tz_ |= F.wave << 6;
        const bf16_t* krow = U + (size_t)(b * SEQ + (tz_ >> 3)) * DIN + UK + h * 64 + (tz_ & 7) * 8;
        LAS bf16_t* kdst = (LAS bf16_t*)(F.lds + NA_KR) + (tz_ >> 3) * 72 + (tz_ & 7) * 8;
        __syncthreads();
        { LAS float* rpb = (LAS float*)(F.lds + NA_RPB); const float* rsrc = F.in[I_RPB] + ((size_t)l * 8 + h) * 15 * 31;
          if (tz_ < 15 * 31) rpb[tz_] = rsrc[tz_];
          const int key = tz_ >> 1, hf = tz_ & 1; const bf16_t* src = U + (size_t)(NLAT + b * CTXL + key) * DIN + UK + h * 64 + hf * 32; LAS bf16_t* dst = (LAS bf16_t*)(F.lds + NA_KC) + key * 72 + hf * 32;
#pragma unroll
          for (int j = 0; j < 4; ++j) *(LAS bf16x8*)(dst + j * 8) = gld16(src + j * 8);
          const int dv = tz_ >> 3, seg = tz_ & 7; const bf16_t* vs = (const bf16_t*)(F.ws + WS_VT) + ((size_t)b * 512 + h * 64 + dv) * SPB + SEQ + seg * 32; LAS bf16_t* vd = (LAS bf16_t*)(F.lds + NA_VC) + dv * 264 + seg * 32;
#pragma unroll
          for (int j = 0; j < 4; ++j) *(LAS bf16x8*)(vd + j * 8) = gld16(vs + j * 8);
          const int lo = na_kr0(half * 32), hi0 = na_kr0(half * 32 + 1) + 7;
          for (int kr = lo; kr <= hi0; ++kr) *(LAS bf16x8*)(kdst + (kr % 9) * 64 * 72) = gld16(krow + (size_t)kr * 64 * DIN); }
        __syncthreads();
        int prev_hi = na_kr0(half * 32 + 1) + 7;
#pragma unroll 1
        for (int s = 0; s < 16; ++s) {
            const int r0 = half * 32 + 2 * s;
            const int nhi = s < 15 ? na_kr0(r0 + 3) + 7 : prev_hi;
            bf16x8 n0 = (bf16x8){0, 0, 0, 0, 0, 0, 0, 0}, n1 = n0;
            if (nhi > prev_hi) n0 = gld16(krow + (size_t)(prev_hi + 1) * 64 * DIN);
            if (nhi > prev_hi + 1) n1 = gld16(krow + (size_t)(prev_hi + 2) * 64 * DIN);
            na_unit<true>(F, b, h, r0 + (F.wave >> 2), F.wave & 3);
            __syncthreads();
            if (nhi > prev_hi) *(LAS bf16x8*)(kdst + ((prev_hi + 1) % 9) * 64 * 72) = n0;
            if (nhi > prev_hi + 1) *(LAS bf16x8*)(kdst + ((prev_hi + 2) % 9) * 64 * 72) = n1;
            __syncthreads();
            prev_hi = nhi;
        }
        if (!last) na_unit<false>(F, b, h, 0, half * 8 + F.wave);
    }
}

__device__ __forceinline__ void ph_hy_transpose(Frame& F, bool last) {
    LAS bf16_t* tile = (LAS bf16_t*)(F.lds + F.wave * 16384);
    const bf16_t* HYO = (const bf16_t*)(F.ws + WS_Y);
    const int gw = F.wg * NWAVES + F.wave, NGW = F.G * NWAVES;
    const int rsub = F.lane >> 3, cseg = F.lane & 7;
    const int ntt = last ? 1024 : 1088;
    for (int u = gw; u < ntt * 4; u += NGW) {
        const int tt = u >> 2, cb = u & 3;
        int b, s0, rowbase, posbase;
        if (tt < 1024) { b = tt >> 6; s0 = (tt & 63) * 64; rowbase = b * SEQ; posbase = 0; }
        else { const int t2 = tt - 1024; b = t2 >> 2; s0 = (t2 & 3) * 64; rowbase = NLAT + b * CTXL; posbase = SEQ; }
#pragma unroll 2
        for (int it = 0; it < 8; ++it) { const int c = rsub + 8 * it;
            const u32x4 v = *(const GAS u32x4*)(HYO + ((size_t)(cb * 64 + c) * NB + b) * SPB + posbase + s0 + cseg * 8); const unsigned a[4] = {v.x, v.y, v.z, v.w};
#pragma unroll
            for (int e = 0; e < 4; ++e) { tile[(cseg * 8 + 2 * e) * 72 + c] = (bf16_t)(a[e] & 0xffffu); tile[(cseg * 8 + 2 * e + 1) * 72 + c] = (bf16_t)(a[e] >> 16); } }
        LDS_WAIT(); asm volatile("" ::: "memory");
#pragma unroll 2
        for (int it = 0; it < 8; ++it) { const int p = rsub + 8 * it;
            const u32x4 v = *(const LAS u32x4*)(tile + p * 72 + cseg * 8);
            *(GAS u32x4*)((bf16_t*)(F.ws + WS_MIX) + (size_t)(rowbase + s0 + p) * DM + 768 + cb * 64 + cseg * 8) = v; }
        LDS_WAIT(); asm volatile("" ::: "memory");
    }
}

constexpr int G2_LAF = 0, G2_LAB = 8448;
constexpr int G2_QTF = 16896, G2_KTF = 22016, G2_QTB = 27136, G2_KTB = 32256;
constexpr int G2_VT = 37376, G2_ATT = 46592;
constexpr int G2_SF = 55808, G2_SB = 60928;
constexpr int G2_SEG = 66048, G2_HALF = 67328;
__device__ __forceinline__ float log_sigmoid_f(float x) { return fminf(x, 0.f) - __logf(1.0f + __expf(-fabsf(x))); }
__device__ __forceinline__ f32x4 mma_lds(const LAS bf16_t* A, int lda, const LAS bf16_t* B, int ldb, int ksteps, f32x4 acc, int lane) {
    const int r = lane & 15, g = lane >> 4;
    for (int ks = 0; ks < ksteps; ++ks) { const bf16x8 a = *(const LAS bf16x8*)(A + r * lda + ks * 32 + 8 * g), b = *(const LAS bf16x8*)(B + r * ldb + ks * 32 + 8 * g); acc = mfma16(a, b, acc); }
    return acc;
}
__device__ __forceinline__ int gla_row0(int b, int cn) { return cn >= 4 ? b * SEQ + (cn - 4) * 64 : NLAT + b * CTXL + cn * 64; }
struct GlaRaw { u32x4 q, k, f, b, v0, v1, g0, g1, s0, s1; };
template <bool FULL>
__device__ __forceinline__ GlaRaw gla_load(Frame& F, int u, int tl) {
    const int h = u & 3, cn = (u >> 2) % 68, b = (u >> 2) / 68, i = tl >> 2, part = tl & 3;
    const bf16_t* p = (const bf16_t*)(F.ws + WS_U) + (size_t)(gla_row0(b, cn) + i) * DIN;
    GlaRaw r;
    r.q = *(const GAS u32x4*)(p + UGQ + h * 32 + part * 8); r.k = *(const GAS u32x4*)(p + UGK + h * 32 + part * 8);
    r.f = *(const GAS u32x4*)(p + ULAF + h * 32 + part * 8); r.b = *(const GAS u32x4*)(p + ULAB + h * 32 + part * 8);
    r.v0 = *(const GAS u32x4*)(p + UGV + h * 64 + part * 16); r.v1 = *(const GAS u32x4*)(p + UGV + h * 64 + part * 16 + 8);
    if (FULL) { r.g0 = *(const GAS u32x4*)(p + UGR + h * 64 + part * 16); r.g1 = *(const GAS u32x4*)(p + UGR + h * 64 + part * 16 + 8);
        const bf16_t* sp = (const bf16_t*)(F.ws + WS_GSIN) + (size_t)u * 2 * 2048 + tl * 16; r.s0 = *(const GAS u32x4*)sp; r.s1 = *(const GAS u32x4*)(sp + 8); }
    else { r.g0 = (u32x4){0u, 0u, 0u, 0u}; r.g1 = r.g0; r.s0 = r.g0; r.s1 = r.g0; }
    return r;
}
template <bool FULL>
__device__ __forceinline__ void gla_prep(Frame& F, LAS unsigned char* L, int l, int u, int tl, const GlaRaw& raw) {
    const int h = u & 3, cn = (u >> 2) % 68, i = tl >> 2, part = tl & 3, d8 = part * 8;
    LAS float* LAF = (LAS float*)(L + G2_LAF); LAS float* LAB = (LAS float*)(L + G2_LAB); LAS bf16_t* VT = (LAS bf16_t*)(L + G2_VT); LAS float* SEG = (LAS float*)(L + G2_SEG);
    float q[8], k[8], tf[8], tb[8];
    unpack8(raw.q, q); unpack8(raw.k, k); unpack8(raw.f, tf); unpack8(raw.b, tb);
    const float* ba = F.in[I_BA2] + (size_t)l * 256 + h * 32 + d8;
#pragma unroll
    for (int e = 0; e < 8; ++e) { q[e] *= 0.17677669529663687f; LAF[i * 33 + d8 + e] = log_sigmoid_f(tf[e] + ba[e]) * 0.0625f; LAB[i * 33 + d8 + e] = log_sigmoid_f(tb[e] + ba[128 + e]) * 0.0625f; }
    if (cn >= 4) {
        const float pos = (part >> 1) ? (float)i : (float)(cn - 4);
#pragma unroll
        for (int e = 0; e < 8; ++e) { const float ang = pos * __expf(-(float)e * (9.210340371976184f / 8.0f)); const float sn = __sinf(ang), cs = __cosf(ang);
            const float qo = shx(q[e], 1, F.lane), ko = shx(k[e], 1, F.lane);
            if (part & 1) { q[e] = qo * sn + q[e] * cs; k[e] = ko * sn + k[e] * cs; } else { q[e] = q[e] * cs - qo * sn; k[e] = k[e] * cs - ko * sn; } }
    }
    { const unsigned a[8] = {raw.v0.x, raw.v0.y, raw.v0.z, raw.v0.w, raw.v1.x, raw.v1.y, raw.v1.z, raw.v1.w};
#pragma unroll
      for (int e = 0; e < 8; ++e) { VT[(part * 16 + 2 * e) * 72 + i] = (bf16_t)(a[e] & 0xffffu); VT[(part * 16 + 2 * e + 1) * 72 + i] = (bf16_t)(a[e] >> 16); } }
    __syncthreads();
    { const int x = tl & 63, d = x & 31, dir = x >> 5, seg = tl >> 6; LAS float* LA = (dir ? LAB : LAF) + d; float cv[16];
#pragma unroll
      for (int kk = 0; kk < 16; ++kk) { const int p = seg * 16 + kk, ti = dir ? 63 - p : p; cv[kk] = LA[ti * 33]; }
#pragma unroll
      for (int kk = 1; kk < 16; ++kk) cv[kk] += cv[kk - 1];
#pragma unroll
      for (int kk = 0; kk < 16; ++kk) { const int p = seg * 16 + kk, ti = dir ? 63 - p : p; LA[ti * 33] = cv[kk]; }
      SEG[x * 5 + seg] = cv[15]; }
    __syncthreads();
    { const int x = tl & 63, d = x & 31, dir = x >> 5, seg = tl >> 6; LAS float* LA = (dir ? LAB : LAF) + d; float cv[16];
      const float t0 = SEG[x * 5 + 0], t1 = SEG[x * 5 + 1], t2 = SEG[x * 5 + 2];
      const float pre = seg == 0 ? 0.f : (seg == 1 ? t0 : (seg == 2 ? t0 + t1 : t0 + t1 + t2));
#pragma unroll
      for (int kk = 0; kk < 16; ++kk) { const int p = seg * 16 + kk, ti = dir ? 63 - p : p; cv[kk] = LA[ti * 33]; }
#pragma unroll
      for (int kk = 0; kk < 16; ++kk) { const int p = seg * 16 + kk, ti = dir ? 63 - p : p; LA[ti * 33] = cv[kk] + pre; } }
    __syncthreads();
    if (FULL) {
        unsigned wqf[4], wkf[4], wqb[4], wkb[4];
#pragma unroll
        for (int e = 0; e < 4; ++e) { const int d = d8 + 2 * e; const float f0 = LAF[i * 33 + d], f1 = LAF[i * 33 + d + 1], b0 = LAB[i * 33 + d], b1 = LAB[i * 33 + d + 1];
            wqf[e] = pk2(q[2 * e] * __expf(f0), q[2 * e + 1] * __expf(f1)); wkf[e] = pk2(k[2 * e] * __expf(-f0), k[2 * e + 1] * __expf(-f1));
            wqb[e] = pk2(q[2 * e] * __expf(b0), q[2 * e + 1] * __expf(b1)); wkb[e] = pk2(k[2 * e] * __expf(-b0), k[2 * e + 1] * __expf(-b1)); }
        *(LAS u32x4*)((LAS bf16_t*)(L + G2_QTF) + i * 40 + d8) = (u32x4){wqf[0], wqf[1], wqf[2], wqf[3]}; *(LAS u32x4*)((LAS bf16_t*)(L + G2_KTF) + i * 40 + d8) = (u32x4){wkf[0], wkf[1], wkf[2], wkf[3]};
        *(LAS u32x4*)((LAS bf16_t*)(L + G2_QTB) + i * 40 + d8) = (u32x4){wqb[0], wqb[1], wqb[2], wqb[3]}; *(LAS u32x4*)((LAS bf16_t*)(L + G2_KTB) + i * 40 + d8) = (u32x4){wkb[0], wkb[1], wkb[2], wkb[3]};
    } else {
        LAS bf16_t* KDF = (LAS bf16_t*)(L + G2_QTF); LAS bf16_t* KDB = (LAS bf16_t*)(L + G2_KTF);
#pragma unroll
        for (int e = 0; e < 8; ++e) { const int d = d8 + e; const float bf = LAF[i * 33 + d], bb = LAB[i * 33 + d], bfl = LAF[63 * 33 + d], bbl = LAB[0 * 33 + d];
            KDF[d * 72 + i] = (bf16_t)f2bf(k[e] * __expf(bfl - bf)); KDB[d * 72 + i] = (bf16_t)f2bf(k[e] * __expf(bbl - bb)); }
    }
    __syncthreads();
}
__device__ __forceinline__ void ph_gla_local(Frame& F, int l) {
    const int hw = F.wave >> 2, wl = F.wave & 3, tl = F.tid & 255; LAS unsigned char* L = F.lds + hw * G2_HALF;
    constexpr int NU = NB * 68 * 4;
    int pp = F.wg;
    GlaRaw raw = gla_load<false>(F, (pp * 2 + hw) < NU ? pp * 2 + hw : 0, tl);
    for (; pp * 2 < NU; pp += F.G) {
        const int u = pp * 2 + hw, un = (pp + F.G) * 2 + hw;
        const GlaRaw nraw = gla_load<false>(F, un < NU ? un : u, tl);
        __syncthreads();
        gla_prep<false>(F, L, l, u, tl, raw);
        const int g = F.lane >> 4, c = F.lane & 15;
        float* DS = (float*)(F.ws + WS_GDS) + (size_t)u * 2 * 2048;
#pragma unroll
        for (int kk = 0; kk < 4; ++kk) { const int tix = wl * 4 + kk, dir = tix >> 3, mt = (tix >> 1) & 3, nt = tix & 1;
            f32x4 a = (f32x4){0.f, 0.f, 0.f, 0.f};
            a = mma_lds((const LAS bf16_t*)(L + G2_VT) + mt * 16 * 72, 72, (const LAS bf16_t*)(L + (dir ? G2_KTF : G2_QTF)) + nt * 16 * 72, 72, 2, a, F.lane);
#pragma unroll
            for (int e = 0; e < 4; ++e) DS[dir * 2048 + (mt * 16 + 4 * g + e) * 32 + nt * 16 + c] = a[e]; }
        if (tl < 64) { const int d = tl & 31, dir = tl >> 5; ((float*)(F.ws + WS_GD))[(size_t)u * 64 + tl] = __expf(dir ? ((LAS float*)(L + G2_LAB))[0 * 33 + d] : ((LAS float*)(L + G2_LAF))[63 * 33 + d]); }
        raw = nraw;
    }
}
__device__ __forceinline__ void ph_gla_scan(Frame& F) {
    const int gt = F.wg * NTHR + F.tid, NGT = F.G * NTHR;
    const float* DS = (const float*)(F.ws + WS_GDS); const float* GD = (const float*)(F.ws + WS_GD); bf16_t* SIN = (bf16_t*)(F.ws + WS_GSIN);
    for (int w = gt; w < 128 * 1024; w += NGT) {
        const int chain = w >> 10, el = (w & 1023) * 2, dir = chain & 1, h = (chain >> 1) & 3, b = chain >> 3, d = el & 31;
        float s0 = 0.f, s1 = 0.f;
        for (int step = 0; step < 68; step += 4) {
            f32x2 ds[4], dd[4]; size_t uu[4];
#pragma unroll
            for (int q = 0; q < 4; ++q) { const int st_ = step + q; const int cn = dir ? (st_ < 4 ? 3 - st_ : 71 - st_) : st_;
                uu[q] = (size_t)(b * 68 + cn) * 4 + h;
                ds[q] = *(const GAS f32x2*)(DS + (uu[q] * 2 + dir) * 2048 + el); dd[q] = *(const GAS f32x2*)(GD + uu[q] * 64 + dir * 32 + d); }
#pragma unroll
            for (int q = 0; q < 4; ++q) { *(GAS unsigned*)(SIN + (uu[q] * 2 + dir) * 2048 + el) = pk2(s0, s1); s0 = dd[q].x * s0 + ds[q].x; s1 = dd[q].y * s1 + ds[q].y; }
        }
    }
}
__device__ __forceinline__ void ph_gla_out(Frame& F, int l, bool last) {
    const int hw = F.wave >> 2, wl = F.wave & 3, tl = F.tid & 255; LAS unsigned char* L = F.lds + hw * G2_HALF;
    const int NV = last ? NB * 64 * 4 : NB * 68 * 4;
#define GLA_UNIT(v) (last ? ((((v) >> 8) * 68 + 4 + (((v) & 255) >> 2)) * 4 + ((v) & 3)) : (v))
    int pp = F.wg;
    GlaRaw raw = gla_load<true>(F, GLA_UNIT((pp * 2 + hw) < NV ? pp * 2 + hw : 0), tl);
    for (; pp * 2 < NV; pp += F.G) {
        const int u = GLA_UNIT(pp * 2 + hw), vn = (pp + F.G) * 2 + hw;
        const GlaRaw nraw = gla_load<true>(F, vn < NV ? GLA_UNIT(vn) : u, tl);
        const int h = u & 3, cn = (u >> 2) % 68, b = (u >> 2) / 68;
        __syncthreads();
        gla_prep<true>(F, L, l, u, tl, raw);
        { const int dir = tl >> 7, dv = (tl >> 1) & 63, d16 = (tl & 1) * 16; LAS bf16_t* S = (LAS bf16_t*)(L + (dir ? G2_SB : G2_SF)) + dv * 40 + d16; *(LAS u32x4*)S = raw.s0; *(LAS u32x4*)(S + 8) = raw.s1; }
        const int g = F.lane >> 4, c = F.lane & 15;
        LAS bf16_t* ATT = (LAS bf16_t*)(L + G2_ATT);
#pragma unroll
        for (int kk = 0; kk < 4; ++kk) { const int tile = wl * 4 + kk, mt = tile >> 2, nt = tile & 3;
            f32x4 af = (f32x4){0.f, 0.f, 0.f, 0.f}, ab = af;
            af = mma_lds((const LAS bf16_t*)(L + G2_QTF) + mt * 16 * 40, 40, (const LAS bf16_t*)(L + G2_KTF) + nt * 16 * 40, 40, 1, af, F.lane);
            ab = mma_lds((const LAS bf16_t*)(L + G2_QTB) + mt * 16 * 40, 40, (const LAS bf16_t*)(L + G2_KTB) + nt * 16 * 40, 40, 1, ab, F.lane);
#pragma unroll
            for (int e = 0; e < 4; ++e) { const int ii = mt * 16 + 4 * g + e, j = nt * 16 + c; const float vv = (j <= ii ? af[e] : 0.f) + (j >= ii ? ab[e] : 0.f); ATT[ii * 72 + j] = (bf16_t)f2bf(vv); } }
        __syncthreads();
        LAS float* O = (LAS float*)(L + G2_LAF);
#pragma unroll
        for (int kk = 0; kk < 4; ++kk) { const int tile = wl * 4 + kk, mt = tile >> 2, nt = tile & 3;
            f32x4 a = (f32x4){0.f, 0.f, 0.f, 0.f};
            a = mma_lds(ATT + mt * 16 * 72, 72, (const LAS bf16_t*)(L + G2_VT) + nt * 16 * 72, 72, 2, a, F.lane);
            a = mma_lds((const LAS bf16_t*)(L + G2_QTF) + mt * 16 * 40, 40, (const LAS bf16_t*)(L + G2_SF) + nt * 16 * 40, 40, 1, a, F.lane);
            a = mma_lds((const LAS bf16_t*)(L + G2_QTB) + mt * 16 * 40, 40, (const LAS bf16_t*)(L + G2_SB) + nt * 16 * 40, 40, 1, a, F.lane);
#pragma unroll
            for (int e = 0; e < 4; ++e) O[(mt * 16 + 4 * g + e) * 65 + nt * 16 + c] = a[e]; }
        __syncthreads();
        { const int i = tl >> 2, dv16 = (tl & 3) * 16; const int row = gla_row0(b, cn) + i;
          float v[16], gt[16]; float ss = 0.f;
#pragma unroll
          for (int e = 0; e < 16; ++e) { v[e] = O[i * 65 + dv16 + e]; ss += v[e] * v[e]; }
          ss += shx(ss, 1, F.lane); ss += shx(ss, 2, F.lane);
          const float rs = 1.0f / sqrtf(ss * (1.0f / 64.0f) + LN_EPS);
          unpack8(raw.g0, gt); unpack8(raw.g1, gt + 8);
          const float* gn = F.in[I_GNORM] + l * 64 + dv16;
          unsigned w[8];
#pragma unroll
          for (int e = 0; e < 8; ++e) w[e] = pk2(v[2 * e] * rs * gn[2 * e] * silu_f(gt[2 * e]), v[2 * e + 1] * rs * gn[2 * e + 1] * silu_f(gt[2 * e + 1]));
          bf16_t* mp = (bf16_t*)(F.ws + WS_MIX) + (size_t)row * DM + 512 + h * 64 + dv16;
          *(GAS u32x4*)mp = (u32x4){w[0], w[1], w[2], w[3]}; *(GAS u32x4*)(mp + 8) = (u32x4){w[4], w[5], w[6], w[7]}; }
        raw = nraw;
    }
#undef GLA_UNIT
}

template <int L>
__device__ __forceinline__ void hyena_conv(Frame& F, const bf16_t* Rg, const bf16_t* Uin, const bf16_t* Xmul, int pos0, bool final_out, int ch, bf16_t* Zout) {
    constexpr int CS = 2 * L + 16;
    constexpr int NTL = L / 16, J = (NTL >= 64) ? 16 : 2, NGRP = NTL / J, HJ = J / 2, NSTEP = L / 32;
    LAS bf16_t* Rl = (LAS bf16_t*)F.lds;
    __syncthreads();
    for (int c = F.tid; c < 2 * L / 8; c += NTHR) { const u32x4 v = *(const GAS u32x4*)(Rg + 8 * c); const unsigned a[4] = {v.x, v.y, v.z, v.w};
#pragma unroll
        for (int rho = 0; rho < 8; ++rho) { LAS bf16_t* d = Rl + rho * CS + 8 * c + rho;
#pragma unroll
            for (int k = 0; k < 4; ++k) { d[2 * k] = (bf16_t)(a[k] & 0xffffu); d[2 * k + 1] = (bf16_t)(a[k] >> 16); } } }
    __syncthreads();
    int ln_ = F.lane; asm volatile("" : "+v"(ln_));
    const int i = ln_ & 15, g = ln_ >> 4, rho = i & 7;
    const LAS bf16_t* Rc = Rl + rho * CS + rho;
    for (int grp = F.wave; grp < NGRP; grp += NWAVES) {
        f32x4 acc[J]; bf16x8 fr[J];
        const int tb = grp * J * 16;
        const LAS bf16_t* Rb = Rc + (L - tb - i + 8 * g);
#pragma unroll
        for (int j = 0; j < J; ++j) { acc[j] = (f32x4){0.f, 0.f, 0.f, 0.f}; fr[j] = *(const LAS bf16x8*)(Rb - 16 * j); }
        const char* ub = (const char*)(Uin + pos0); const unsigned ulo = (unsigned)((i * SPB + 8 * g) * 2);
        constexpr int PF = (HJ >= 4) ? 4 : 1;
        bf16x8 bq[PF];
#pragma unroll
        for (int p = 0; p < PF; ++p) bq[p] = *(const GAS bf16x8*)(ub + (size_t)(ulo + (unsigned)p * 64u));
#pragma unroll 1
        for (int q = 0; q < NSTEP / HJ; ++q) {
#pragma unroll
            for (int m = 0; m < HJ; ++m) {
                const int n = q * HJ + m;
                const int nn = (n + PF < NSTEP) ? n + PF : 0;
                if (n > 0) { fr[(J - 2 * m) % J] = *(const LAS bf16x8*)(Rb + 32 * n); fr[(J + 1 - 2 * m) % J] = *(const LAS bf16x8*)(Rb + 32 * n - 16); }
                const bf16x8 bcur = bq[m % PF];
#pragma unroll
                for (int jj = 0; jj < J; ++jj) { const int j = (jj + 2) % J; acc[j] = mfma16(fr[(j + J - 2 * m) % J], bcur, acc[j]); }
                bq[m % PF] = *(const GAS bf16x8*)(ub + (size_t)(ulo + (unsigned)nn * 64u));
            }
        }
#pragma unroll
        for (int j = 0; j < J; ++j) { const int t0 = tb + j * 16 + 4 * g;
            const u32x2 xw = *(const GAS u32x2*)(Xmul + (size_t)i * SPB + pos0 + t0);
            const float y0 = acc[j][0] * bflo(xw.x), y1 = acc[j][1] * bfhi(xw.x), y2 = acc[j][2] * bflo(xw.y), y3 = acc[j][3] * bfhi(xw.y);
            if (!final_out) { u32x2 w; w.x = pk2(y0, y1); w.y = pk2(y2, y3); *(GAS u32x2*)(Zout + (size_t)i * SPB + pos0 + t0) = w; }
            else { u32x2 w; w.x = pk2(y0, y1); w.y = pk2(y2, y3); *(GAS u32x2*)((bf16_t*)(F.ws + WS_Y) + ((size_t)ch * NB + i) * SPB + pos0 + t0) = w; } }
    }
}
__device__ __forceinline__ void ph_hyena(Frame& F, int l, bool last) {
    const bf16_t* HV = (const bf16_t*)(F.ws + WS_HV); bf16_t* Z2 = (bf16_t*)(F.ws + WS_Z2);
    for (int ch = F.wg; ch < 256; ch += F.G) {
        const bf16_t* v = HV + (size_t)(0 * 256 + ch) * NB * SPB; const bf16_t* x1 = HV + (size_t)(256 + ch) * NB * SPB; const bf16_t* x2 = HV + (size_t)(512 + ch) * NB * SPB;
        bf16_t* z = Z2 + (size_t)ch * NB * SPB;
        const bf16_t* R0 = (const bf16_t*)(F.ws + WS_HYF) + ((size_t)(l * 2 + 0) * 256 + ch) * 8192; const bf16_t* R1 = (const bf16_t*)(F.ws + WS_HYF) + ((size_t)(l * 2 + 1) * 256 + ch) * 8192;
        hyena_conv<4096>(F, R0, v, x1, 0, false, ch, z);
        VM_WAIT(); __syncthreads(); __builtin_amdgcn_fence(__ATOMIC_ACQUIRE, "agent"); VM_WAIT();
        hyena_conv<4096>(F, R1, z, x2, 0, true, ch, z);
        if (!last) {
            const bf16_t* C0 = (const bf16_t*)(F.ws + WS_HYFC) + ((size_t)(l * 2 + 0) * 256 + ch) * 512; const bf16_t* C1 = (const bf16_t*)(F.ws + WS_HYFC) + ((size_t)(l * 2 + 1) * 256 + ch) * 512;
            hyena_conv<256>(F, C0, v, x1, SEQ, false, ch, z);
            VM_WAIT(); __syncthreads(); __builtin_amdgcn_fence(__ATOMIC_ACQUIRE, "agent"); VM_WAIT();
            hyena_conv<256>(F, C1, z, x2, SEQ, true, ch, z);
        }
    }
}

__device__ __forceinline__ void ph_ln1(Frame& F, int l, int ntok) {
    const int gw = F.wg * NWAVES + F.wave, NGW = F.G * NWAVES;
    const float* lg = F.in[I_LN1G] + l * DM + 16 * F.lane; const float* lb = F.in[I_LN1B] + l * DM + 16 * F.lane;
    for (int row = gw; row < ntok; row += NGW) {
        bf16_t* xr = (bf16_t*)(F.ws + WS_XR) + (size_t)row * DM + 16 * F.lane;
        const bf16_t* yr = (const bf16_t*)(F.ws + WS_Y) + (size_t)row * DM + 16 * F.lane;
        const float* md = mod_ptr(F, l, row) + 16 * F.lane;
        bf16_t* xm = (bf16_t*)(F.ws + WS_XM) + (size_t)row * DM + 16 * F.lane;
        const u32x4 xa = *(const GAS u32x4*)xr, xb = *(const GAS u32x4*)(xr + 8), ya = *(const GAS u32x4*)yr, yb = *(const GAS u32x4*)(yr + 8);
        float x[16], y[16], v[16]; unpack8(xa, x); unpack8(xb, x + 8); unpack8(ya, y); unpack8(yb, y + 8);
        float s = 0.f;
#pragma unroll
        for (int j = 0; j < 4; ++j) { const f32x4 g1 = *(const GAS f32x4*)(md + 2048 + 4 * j);
#pragma unroll
            for (int e = 0; e < 4; ++e) { v[4 * j + e] = x[4 * j + e] * DN_ALPHA + g1[e] * y[4 * j + e]; s += v[4 * j + e]; } }
        const float mean = wave_sum(s, F.lane) * (1.f / DM); float s2 = 0.f;
#pragma unroll
        for (int e = 0; e < 16; ++e) { v[e] -= mean; s2 += v[e] * v[e]; }
        const float rstd = 1.f / sqrtf(wave_sum(s2, F.lane) * (1.f / DM) + LN_EPS);
        unsigned wx[8], wm[8]; int w8[4];
#pragma unroll
        for (int j = 0; j < 4; ++j) { const f32x4 g = *(const GAS f32x4*)(lg + 4 * j), bb = *(const GAS f32x4*)(lb + 4 * j), sh = *(const GAS f32x4*)(md + 3072 + 4 * j), sc = *(const GAS f32x4*)(md + 4096 + 4 * j);
            float xn[4];
#pragma unroll
            for (int e = 0; e < 4; ++e) xn[e] = v[4 * j + e] * rstd * g[e] + bb[e];
            wx[2 * j] = pk2(xn[0], xn[1]); wx[2 * j + 1] = pk2(xn[2], xn[3]);
            const float h0 = xn[0] * (1.f + sc[0]) + sh[0], h1 = xn[1] * (1.f + sc[1]) + sh[1], h2 = xn[2] * (1.f + sc[2]) + sh[2], h3 = xn[3] * (1.f + sc[3]) + sh[3];
            wm[2 * j] = pk2(h0, h1); wm[2 * j + 1] = pk2(h2, h3);
            int v = 0; v = __builtin_amdgcn_cvt_pk_fp8_f32(h0, h1, v, false); v = __builtin_amdgcn_cvt_pk_fp8_f32(h2, h3, v, true); w8[j] = v; }
        *(GAS u32x4*)((unsigned char*)(F.ws + WS_XM8) + (size_t)row * DM + 16 * F.lane) = (u32x4){(unsigned)w8[0], (unsigned)w8[1], (unsigned)w8[2], (unsigned)w8[3]};
        *(GAS u32x4*)xr = (u32x4){wx[0], wx[1], wx[2], wx[3]}; *(GAS u32x4*)(xr + 8) = (u32x4){wx[4], wx[5], wx[6], wx[7]};
        *(GAS u32x4*)xm = (u32x4){wm[0], wm[1], wm[2], wm[3]}; *(GAS u32x4*)(xm + 8) = (u32x4){wm[4], wm[5], wm[6], wm[7]};
    }
}
__device__ __forceinline__ void ph_ln2(Frame& F, int l, int ntok, bool last) {
    const int gw = F.wg * NWAVES + F.wave, NGW = F.G * NWAVES;
    const int cA = 256 * (F.lane >> 4) + 32 * ((F.lane >> 2) & 3) + 8 * (F.lane & 3);
#define LN2_COL(j) (cA + ((j) < 2 ? 4 * (j) : 128 + 4 * ((j) - 2)))
    const float* lg = F.in[I_LN2G] + l * DM; const float* lb = F.in[I_LN2B] + l * DM;
    for (int row = gw; row < ntok; row += NGW) {
        bf16_t* xr = (bf16_t*)(F.ws + WS_XR) + (size_t)row * DM;
        const unsigned char* y2 = (const unsigned char*)(F.ws + WS_Y2) + (size_t)row * 9 * DM + 16 * F.lane;
        const float* wg = (const float*)(F.ws + WS_WGT) + (size_t)row * 8;
        const float* md = mod_ptr(F, l, row);
        float ff[16];
#pragma unroll
        for (int e = 0; e < 16; ++e) ff[e] = 0.f;
        u32x4 q[9];
#pragma unroll
        for (int k = 0; k < 9; ++k) q[k] = *(const GAS u32x4*)(y2 + (size_t)k * DM);
#pragma unroll
        for (int k = 0; k < 9; ++k) { const float wk = (k < 8 ? wg[k] : 1.0f) * pg8::Y2_INV; const unsigned a[4] = {q[k].x, q[k].y, q[k].z, q[k].w};
#pragma unroll
            for (int e = 0; e < 4; ++e) { const f32x2 lo = __builtin_amdgcn_cvt_pk_f32_fp8((int)a[e], false), hi = __builtin_amdgcn_cvt_pk_f32_fp8((int)a[e], true);
                ff[4 * e] += wk * lo.x; ff[4 * e + 1] += wk * lo.y; ff[4 * e + 2] += wk * hi.x; ff[4 * e + 3] += wk * hi.y; } }
        float v[16], xo[16]; float s = 0.f;
        { const u32x4 xa = *(const GAS u32x4*)(xr + cA), xb = *(const GAS u32x4*)(xr + cA + 128); unpack8(xa, xo); unpack8(xb, xo + 8); }
#pragma unroll
        for (int j = 0; j < 4; ++j) { const f32x4 g2 = *(const GAS f32x4*)(md + 5120 + LN2_COL(j));
#pragma unroll
            for (int e = 0; e < 4; ++e) { v[4 * j + e] = xo[4 * j + e] * DN_ALPHA + g2[e] * ff[4 * j + e]; s += v[4 * j + e]; } }
        const float mean = wave_sum(s, F.lane) * (1.f / DM); float s2 = 0.f;
#pragma unroll
        for (int e = 0; e < 16; ++e) { v[e] -= mean; s2 += v[e] * v[e]; }
        const float rstd = 1.f / sqrtf(wave_sum(s2, F.lane) * (1.f / DM) + LN_EPS);
        const float* mdn = last ? md : mod_ptr(F, l + 1, row);
        float xn[16];
#pragma unroll
        for (int j = 0; j < 4; ++j) { const f32x4 g = *(const GAS f32x4*)(lg + LN2_COL(j)), bb = *(const GAS f32x4*)(lb + LN2_COL(j));
#pragma unroll
            for (int e = 0; e < 4; ++e) xn[4 * j + e] = v[4 * j + e] * rstd * g[e] + bb[e]; }
        if (last) { float* op = F.out + (size_t)row * DM;
#pragma unroll
            for (int j = 0; j < 4; ++j) *(GAS f32x4*)(op + LN2_COL(j)) = (f32x4){xn[4 * j], xn[4 * j + 1], xn[4 * j + 2], xn[4 * j + 3]}; }
        else {
            *(GAS u32x4*)(xr + cA) = (u32x4){pk2(xn[0], xn[1]), pk2(xn[2], xn[3]), pk2(xn[4], xn[5]), pk2(xn[6], xn[7])}; *(GAS u32x4*)(xr + cA + 128) = (u32x4){pk2(xn[8], xn[9]), pk2(xn[10], xn[11]), pk2(xn[12], xn[13]), pk2(xn[14], xn[15])};
            bf16_t* xm = (bf16_t*)(F.ws + WS_XM) + (size_t)row * DM;
            unsigned w[8];
#pragma unroll
            for (int j = 0; j < 4; ++j) { const f32x4 sh = *(const GAS f32x4*)(mdn + LN2_COL(j)), sc = *(const GAS f32x4*)(mdn + 1024 + LN2_COL(j));
                w[2 * j] = pk2(xn[4 * j] * (1.f + sc[0]) + sh[0], xn[4 * j + 1] * (1.f + sc[1]) + sh[1]); w[2 * j + 1] = pk2(xn[4 * j + 2] * (1.f + sc[2]) + sh[2], xn[4 * j + 3] * (1.f + sc[3]) + sh[3]); }
            *(GAS u32x4*)(xm + cA) = (u32x4){w[0], w[1], w[2], w[3]}; *(GAS u32x4*)(xm + cA + 128) = (u32x4){w[4], w[5], w[6], w[7]};
        }
    }
#undef LN2_COL
}

__device__ __forceinline__ unsigned f_ord(float f) { const unsigned u = __builtin_bit_cast(unsigned, f); return (u & 0x80000000u) ? ~u : (u | 0x80000000u); }
__device__ __forceinline__ unsigned long long wave_max_u64(unsigned long long v, int lane) {
#pragma unroll
    for (int o = 1; o < 64; o <<= 1) { const unsigned lo = (unsigned)shxi((int)(unsigned)v, o, lane), hi = (unsigned)shxi((int)(unsigned)(v >> 32), o, lane); const unsigned long long w = ((unsigned long long)hi << 32) | lo; v = w > v ? w : v; }
    return v;
}
__device__ __forceinline__ float seg16_max(float v, int lane) { v = fmaxf(v, shx(v, 1, lane)); v = fmaxf(v, shx(v, 2, lane)); v = fmaxf(v, shx(v, 4, lane)); v = fmaxf(v, shx(v, 8, lane)); return v; }
__device__ __forceinline__ int seg16_min_i(int v, int lane) { int w; w = shxi(v, 1, lane); v = w < v ? w : v; w = shxi(v, 2, lane); v = w < v ? w : v; w = shxi(v, 4, lane); v = w < v ? w : v; w = shxi(v, 8, lane); v = w < v ? w : v; return v; }
__device__ __forceinline__ float seg16_top2(float v, int lane) {
    const float m1 = seg16_max(v, lane);
    const int first = seg16_min_i(v == m1 ? (lane & 15) : 99, lane);
    const float m2 = seg16_max((lane & 15) == first ? -3.0e38f : v, lane);
    return m1 + m2;
}
__device__ __forceinline__ void ph_route(Frame& F, int l, int ntok) {
    LAS int* hist = (LAS int*)F.lds;
    LAS int* base = hist + 128;
    LAS unsigned* alist = (LAS unsigned*)(F.lds + 1024);
    const int tpw = (ntok + F.G - 1) / F.G, t0 = F.wg * tpw, t1 = (t0 + tpw) < ntok ? (t0 + tpw) : ntok;
    __syncthreads();
    if (F.tid < 128) hist[F.tid] = 0;
    __syncthreads();
    const float* LG = (const float*)(F.ws + WS_LOGIT); const float* rb = F.in[I_RB] + l * NEXP;
    const float b0 = rb[F.lane], b1 = rb[F.lane + 64];
    constexpr int RT = 4;
    for (int tb = t0 + F.wave * RT; tb < t1; tb += NWAVES * RT) {
        float s0[RT], s1[RT], e0[RT], e1[RT], gs0[RT], gs1[RT]; unsigned long long k0[RT], k1[RT]; int mye[RT]; float myw[RT], wsum[RT];
#pragma unroll
        for (int j = 0; j < RT; ++j) { const int tok = (tb + j) < t1 ? tb + j : t1 - 1;
            const float x0 = LG[(size_t)tok * 256 + F.lane], x1 = LG[(size_t)tok * 256 + 64 + F.lane];
            s0[j] = __builtin_amdgcn_rcpf(1.0f + __expf(-x0)); s1[j] = __builtin_amdgcn_rcpf(1.0f + __expf(-x1)); e0[j] = s0[j] + b0; e1[j] = s1[j] + b1; }
#pragma unroll
        for (int j = 0; j < RT; ++j) { gs0[j] = seg16_top2(e0[j], F.lane); gs1[j] = seg16_top2(e1[j], F.lane); }
#pragma unroll
        for (int j = 0; j < RT; ++j) {
            float gsc[8];
#pragma unroll
            for (int g = 0; g < 4; ++g) { gsc[g] = shf(gs0[j], g * 16); gsc[4 + g] = shf(gs1[j], g * 16); }
            unsigned gmask = 0u;
#pragma unroll
            for (int g = 0; g < 8; ++g) { int cnt = 0;
#pragma unroll
                for (int g2 = 0; g2 < 8; ++g2) cnt += (gsc[g2] > gsc[g] || (gsc[g2] == gsc[g] && g2 < g)) ? 1 : 0;
                gmask |= (cnt < 4) ? (1u << g) : 0u; }
            const bool ok0 = (gmask >> (F.lane >> 4)) & 1u, ok1 = (gmask >> (4 + (F.lane >> 4))) & 1u;
            k0[j] = ok0 ? (((unsigned long long)f_ord(e0[j]) << 32) | (unsigned)(255 - F.lane)) : 0ull;
            k1[j] = ok1 ? (((unsigned long long)f_ord(e1[j]) << 32) | (unsigned)(255 - 64 - F.lane)) : 0ull;
            mye[j] = 0; myw[j] = 0.f; wsum[j] = 0.f; }
#pragma unroll
        for (int k = 0; k < 8; ++k) {
            unsigned long long best[RT];
#pragma unroll
            for (int j = 0; j < RT; ++j) best[j] = k0[j] > k1[j] ? k0[j] : k1[j];
#pragma unroll
            for (int o = 1; o < 64; o <<= 1) {
#pragma unroll
                for (int j = 0; j < RT; ++j) { const unsigned lo = (unsigned)shxi((int)(unsigned)best[j], o, F.lane), hi = (unsigned)shxi((int)(unsigned)(best[j] >> 32), o, F.lane);
                    const unsigned long long w = ((unsigned long long)hi << 32) | lo; best[j] = w > best[j] ? w : best[j]; } }
#pragma unroll
            for (int j = 0; j < RT; ++j) { const int e = 255 - (int)(best[j] & 0xffu);
                if (k0[j] == best[j]) k0[j] = 0ull; if (k1[j] == best[j]) k1[j] = 0ull;
                const float sv = shf(e < 64 ? s0[j] : s1[j], e & 63);
                wsum[j] += sv; if (F.lane == k) { mye[j] = e; myw[j] = sv; } }
        }
#pragma unroll
        for (int j = 0; j < RT; ++j) { const int tok = tb + j;
            if (tok < t1 && F.lane < 8) {
                const int lr = __hip_atomic_fetch_add(&hist[mye[j]], 1, __ATOMIC_RELAXED, __HIP_MEMORY_SCOPE_WORKGROUP);
                alist[(tok - t0) * 8 + F.lane] = (unsigned)mye[j] | ((unsigned)lr << 8);
                ((int*)(F.ws + WS_EIDX))[(size_t)tok * 8 + F.lane] = mye[j];
                ((float*)(F.ws + WS_WGT))[(size_t)tok * 8 + F.lane] = myw[j] / wsum[j] * 2.5f;
            } }
    }
    __syncthreads();
    if (F.tid < 128) { const int hcount = hist[F.tid]; base[F.tid] = hcount ? (int)atomicAdd(F.ctl + CW_CNT + l * 256 + F.tid, (unsigned)hcount) : 0; }
    __syncthreads();
    for (int a = F.tid; a < (t1 - t0) * 8; a += NTHR) { const unsigned v = alist[a]; ((int*)(F.ws + WS_RNK))[(size_t)t0 * 8 + a] = base[v & 0xffu] + (int)(v >> 8); }
}
__device__ __forceinline__ void ph_positions(Frame& F, int l, int ntok) {
    LAS int* cnt = (LAS int*)F.lds;
    LAS int* off = cnt + 132;
    __syncthreads();
    if (F.tid < NE1) cnt[F.tid] = F.tid < NEXP ? (int)__hip_atomic_load(F.ctl + CW_CNT + l * 256 + F.tid, __ATOMIC_RELAXED, __HIP_MEMORY_SCOPE_AGENT) : ntok;
    __syncthreads();
    if (F.tid == 0) { int o = 0; for (int e = 0; e < NE1; ++e) { off[e] = o; o += (cnt[e] + 255) & ~255; } off[NE1] = o; }
    __syncthreads();
    const int gt = F.wg * NTHR + F.tid, NGT = F.G * NTHR;
    int* rowtok = (int*)(F.ws + WS_ROWTOK); int* rowdst = (int*)(F.ws + WS_ROWDST); int* tile_exp = (int*)(F.ws + WS_TILEEXP);
    const int* eidx = (const int*)(F.ws + WS_EIDX); const int* rnk = (const int*)(F.ws + WS_RNK);
    for (int a = gt; a < ntok * 8; a += NGT) { const int tok = a >> 3, k = a & 7; const int pos = off[eidx[a]] + rnk[a]; rowtok[pos] = tok; rowdst[pos] = tok * 9 + k; }
    for (int tok = gt; tok < ntok; tok += NGT) { const int pos = off[NEXP] + tok; rowtok[pos] = tok; rowdst[pos] = tok * 9 + 8; }
    for (int i = gt; i < NE1 * 256; i += NGT) { const int e = i >> 8, p = i & 255; const int row = off[e] + cnt[e] + p; if (row < off[e + 1]) { rowtok[row] = 0; rowdst[row] = -1; } }
    for (int i = gt; i < NE1 * 320; i += NGT) { const int e = i / 320, p = i % 320; const int t = (off[e] >> 8) + p; if (t < (off[e + 1] >> 8)) tile_exp[t] = e; }
    if (gt == 0) F.ctl[CW_NTL + l] = (unsigned)(off[NE1] >> 8);
}

#ifndef MK_MULTI
#define MK_MULTI 0
#endif
constexpr int PH_PER_LAYER = 12, NPHASE = 2 + DEPTH * PH_PER_LAYER;
struct Args { const float* in[36]; float* out; unsigned char* ws; int ph_lo, ph_hi; };

__global__ void __launch_bounds__(NTHR, 2) mk_fwd(Args args) {
    extern __shared__ __attribute__((aligned(16))) unsigned char lds_raw[];
    Frame F;
    F.lds = (LAS unsigned char*)lds_raw;
    F.tid = threadIdx.x; F.lane = F.tid & 63; F.wave = __builtin_amdgcn_readfirstlane(F.tid >> 6);
    const int wave0 = F.wave;
    F.G = gridDim.x; F.wg = blockIdx.x;
    F.in = args.in;
    F.out = args.out; F.ws = args.ws; F.ctl = (unsigned*)(args.ws + WS_CTL);
    volatile LAS unsigned* MISC = (volatile LAS unsigned*)(F.lds + MISC_OFF);
    if (F.tid < 32) MISC[F.tid] = 0u;
    __syncthreads();
    const int lo = args.ph_lo, hi = args.ph_hi;
    const bool single = (hi - lo) > 1;
    XcdBarrier bar; bar.bar = F.ctl + CW_BAR; bar.x = 0; bar.st = nullptr;
    if (single) bar = xcd_barrier_post(F.ctl + CW_BAR, MISC + 8);
#define IN(k) (lo <= (k) && (k) < hi)
#ifndef PROBE_MASK
#define PROBE_MASK 0
#endif
#define REP(k) for (int _rep = 0; _rep < (((PROBE_MASK >> (k)) & 1) ? 2 : 1); ++_rep)
#define SEAM(k) do { if (IN(k) && IN((k) + 1)) { xcd_barrier(bar); if ((PROBE_MASK >> 15) & 1) xcd_barrier(bar); } } while (0)
#define FRESH() do { int _ln; asm volatile("v_mbcnt_lo_u32_b32 %0, -1, 0\n\tv_mbcnt_hi_u32_b32 %0, -1, %0" : "=v"(_ln)); int _wv = wave0; asm volatile("" : "+s"(_wv)); F.lane = _ln; F.wave = _wv; F.tid = (_wv << 6) | _ln; \
        unsigned char* _w = args.ws; asm volatile("" : "+s"(_w)); F.ws = _w; F.ctl = (unsigned*)(_w + WS_CTL); float* _o = args.out; asm volatile("" : "+s"(_o)); F.out = _o; } while (0)

    if (IN(0)) { FRESH(); REP(13) { p0_static_weights(F); __syncthreads(); p0_mod(F); __syncthreads(); p0_hyena_filters(F); __syncthreads(); } }
    SEAM(0);
    if (IN(1)) { FRESH(); p0_init_rows(F); }
    SEAM(1);
#pragma unroll 1
    for (int l = 0; l < DEPTH; ++l) {
        const int pb = 2 + l * PH_PER_LAYER; const bool last = (l == DEPTH - 1); const int ntok = last ? NLAT : NROW;
        if (IN(pb + 0)) { FRESH();
            REP(0) { p_expert_weights(F, l); __syncthreads(); }
            pg8::DenseOrder S; S.init(NROW, DIN, F.G, F.wg); pg8::EpiBf16 E{(bf16_t*)(F.ws + WS_U), DIN};
            REP(1) pg8::gemm_phase<pg8::EpiBf16, pg8::DenseOrder, false>(F.tid, F.lds, (const bf16_t*)(F.ws + WS_XM), (const bf16_t*)(F.ws + WS_WIN) + (size_t)l * DIN * DM, DM, nullptr, S, E);
        }
        SEAM(pb + 0);
        if (IN(pb + 1)) { FRESH(); REP(2) { ph_transposes(F, l); __syncthreads(); } FRESH(); REP(3) { ph_gla_local(F, l); __syncthreads(); } }
        SEAM(pb + 1);
        if (IN(pb + 2)) { FRESH(); REP(4) { ph_na(F, l, last); } FRESH(); REP(5) { ph_gla_scan(F); } __syncthreads(); FRESH(); REP(6) { ph_hyena(F, l, last); } }
        SEAM(pb + 2);
        if (IN(pb + 3)) { FRESH(); ph_hy_transpose(F, last); __syncthreads(); FRESH(); REP(7) { ph_gla_out(F, l, last); } }
        SEAM(pb + 3);
        if (IN(pb + 4)) { FRESH();
            pg8::DenseOrder S; S.init(ntok, DM, F.G, F.wg); pg8::EpiBf16 E{(bf16_t*)(F.ws + WS_Y), DM};
            REP(8) pg8::gemm_phase<pg8::EpiBf16, pg8::DenseOrder, false>(F.tid, F.lds, (const bf16_t*)(F.ws + WS_MIX), (const bf16_t*)(F.ws + WS_WOUT) + (size_t)l * DM * DM, DM, nullptr, S, E);
        }
        SEAM(pb + 4);
        if (IN(pb + 5)) { FRESH(); ph_ln1(F, l, ntok); }
        SEAM(pb + 5);
        if (IN(pb + 6)) { FRESH();
            pg8::DenseOrder S; S.init(ntok, 256, F.G, F.wg); pg8::EpiF32 E{(float*)(F.ws + WS_LOGIT), 256};
            REP(9) pg8::gemm_phase<pg8::EpiF32, pg8::DenseOrder, false>(F.tid, F.lds, (const bf16_t*)(F.ws + WS_XM), (const bf16_t*)(F.ws + WS_WR) + (size_t)l * 256 * DM, DM, nullptr, S, E);
        }
        SEAM(pb + 6);
        if (IN(pb + 7)) { FRESH(); ph_route(F, l, ntok); }
        SEAM(pb + 7);
        if (IN(pb + 8)) { FRESH(); REP(12) { ph_positions(F, l, ntok); __syncthreads(); } }
        SEAM(pb + 8);
        if (IN(pb + 9)) { FRESH();
            const int ntl = (int)__hip_atomic_load(F.ctl + CW_NTL + l, __ATOMIC_RELAXED, __HIP_MEMORY_SCOPE_AGENT);
            pg8::GroupedOrder S; S.init(ntl, 2, F.G, F.wg); S.preload((const int*)(F.ws + WS_TILEEXP), F.lds + pg8::STAGE_BYTES + 4096, F.tid, NTHR); pg8::EpiSwiglu E{(unsigned char*)(F.ws + WS_ACT)};
            REP(10) pg8::gemm_phase<pg8::EpiSwiglu, pg8::GroupedOrder, true, true>(F.tid, F.lds, (const void*)(F.ws + WS_XM8), (const void*)(F.ws + WS_EXP1), DM, (const int*)(F.ws + WS_ROWTOK), S, E);
        }
        SEAM(pb + 9);
        if (IN(pb + 10)) { FRESH();
            const int ntl = (int)__hip_atomic_load(F.ctl + CW_NTL + l, __ATOMIC_RELAXED, __HIP_MEMORY_SCOPE_AGENT);
            pg8::GroupedOrder S; S.init(ntl, 4, F.G, F.wg); S.preload((const int*)(F.ws + WS_TILEEXP), F.lds + pg8::STAGE_BYTES + 4096, F.tid, NTHR); pg8::EpiScatter E{(unsigned char*)(F.ws + WS_Y2), (const int*)(F.ws + WS_ROWDST)};
            REP(11) pg8::gemm_phase<pg8::EpiScatter, pg8::GroupedOrder, false, true>(F.tid, F.lds, (const void*)(F.ws + WS_ACT), (const void*)(F.ws + WS_EXP2), EH, nullptr, S, E);
        }
        SEAM(pb + 10);
        if (IN(pb + 11)) { FRESH(); ph_ln2(F, l, ntok, last); }
        SEAM(pb + 11);
    }
#undef IN
#undef SEAM
#undef FRESH
}

extern "C" void kernel_launch(void* const* d_in, const int* in_sizes, int n_in, void* d_out, int out_size, void* d_ws, size_t ws_size, hipStream_t stream) {
    static int grid = 0;
    if (grid == 0) {
        if (n_in != 36 || out_size != NLAT * DM || ws_size < WS_END) { fprintf(stderr, "kernel_launch: unexpected shapes (n_in %d out %d ws %zu need %zu)\n", n_in, out_size, ws_size, (size_t)WS_END); grid = -1; return; }
        int dev = 0, cus = 0, per_cu = 0;
        if (hipGetDevice(&dev) != hipSuccess || hipDeviceGetAttribute(&cus, hipDeviceAttributeMultiprocessorCount, dev) != hipSuccess) { grid = -1; return; }
        if (hipFuncSetAttribute((const void*)mk_fwd, hipFuncAttributeMaxDynamicSharedMemorySize, LDS_BYTES) != hipSuccess) { fprintf(stderr, "kernel_launch: hipFuncSetAttribute failed\n"); grid = -1; return; }
        if (hipOccupancyMaxActiveBlocksPerMultiprocessor(&per_cu, (const void*)mk_fwd, NTHR, LDS_BYTES) != hipSuccess || per_cu < 1) { fprintf(stderr, "kernel_launch: occupancy query says %d\n", per_cu); }
        (void)hipGetLastError();
        grid = cus;
    }
    if (grid < 0) return;
    (void)hipMemsetAsync((char*)d_ws + WS_CTL, 0, CTL_BYTES, stream);
    Args a{};
    for (int i = 0; i < 36; ++i) a.in[i] = (const float*)d_in[i];
    a.out = (float*)d_out; a.ws = (unsigned char*)d_ws;
#if MK_MULTI
    for (int p = 0; p < NPHASE; ++p) { a.ph_lo = p; a.ph_hi = p + 1; hipLaunchKernelGGL(mk_fwd, dim3(grid), dim3(NTHR), LDS_BYTES, stream, a); }
#else
    a.ph_lo = 0; a.ph_hi = NPHASE; hipLaunchKernelGGL(mk_fwd, dim3(grid), dim3(NTHR), LDS_BYTES, stream, a);
#endif
}
```

```cpp
#include <hip/hip_runtime.h>
#include <cstdio>
#include <cstdint>

#define LAS __attribute__((address_space(3)))
#define GAS __attribute__((address_space(1)))
typedef unsigned short bf16_t;
typedef short bf16x8 __attribute__((ext_vector_type(8)));
typedef float f32x4 __attribute__((ext_vector_type(4)));
typedef float f32x2 __attribute__((ext_vector_type(2)));
typedef unsigned u32x4 __attribute__((ext_vector_type(4)));
typedef unsigned u32x2 __attribute__((ext_vector_type(2)));

constexpr int NB = 16, SEQ = 4096, CTXL = 256, DM = 1024, DEPTH = 4;
constexpr int NLAT = NB * SEQ;
constexpr int NCTX = NB * CTXL;
constexpr int NROW = NLAT + NCTX;
constexpr int SPB = SEQ + CTXL;
constexpr int DIN_REF = 3104;
constexpr int DIN = 3328;
constexpr int UQ = 0, UK = 512, UV = 1024, UGQ = 1536, UGK = 1664, UGV = 1792, UGR = 2048, UHY = 2304, ULAF = 3072, ULAB = 3200;
constexpr int NEXP = 128, TOPK = 8, EH = 256;
constexpr int NE1 = NEXP + 1;
constexpr int RMAX = 659712;
constexpr int TMAX = RMAX / 256;
constexpr float LN_EPS = 1e-6f;
constexpr float DN_ALPHA = 1.6817928305074290f;

__device__ __forceinline__ unsigned f2bf(float f) { unsigned u = __builtin_bit_cast(unsigned, f); return (u + 0x7fffu + ((u >> 16) & 1u)) >> 16; }
typedef __bf16 bf16v2 __attribute__((ext_vector_type(2)));
__device__ __forceinline__ unsigned pk2(float lo, float hi) { const f32x2 v = {lo, hi}; const bf16v2 b = __builtin_convertvector(v, bf16v2); return __builtin_bit_cast(unsigned, b); }
__device__ __forceinline__ float bf2f(unsigned short b) { return __builtin_bit_cast(float, ((unsigned)b) << 16); }
__device__ __forceinline__ float bflo(unsigned w) { return __builtin_bit_cast(float, w << 16); }
__device__ __forceinline__ float bfhi(unsigned w) { return __builtin_bit_cast(float, w & 0xffff0000u); }
__device__ __forceinline__ float shx(float v, int o, int lane) { return __builtin_bit_cast(float, __builtin_amdgcn_ds_bpermute((lane ^ o) << 2, __builtin_bit_cast(int, v))); }
__device__ __forceinline__ int shxi(int v, int o, int lane) { return __builtin_amdgcn_ds_bpermute((lane ^ o) << 2, v); }
__device__ __forceinline__ float shf(float v, int src) { return __builtin_bit_cast(float, __builtin_amdgcn_ds_bpermute(src << 2, __builtin_bit_cast(int, v))); }
__device__ __forceinline__ float wave_sum(float v, int lane) {
#pragma unroll
    for (int o = 1; o < 64; o <<= 1) v += shx(v, o, lane);
    return v;
}
__device__ __forceinline__ void unpack8(const u32x4 q, float* o) { o[0] = bflo(q.x); o[1] = bfhi(q.x); o[2] = bflo(q.y); o[3] = bfhi(q.y); o[4] = bflo(q.z); o[5] = bfhi(q.z); o[6] = bflo(q.w); o[7] = bfhi(q.w); }
__device__ __forceinline__ float silu_f(float x) { return x * __builtin_amdgcn_rcpf(1.0f + __expf(-x)); }
#define LDS_WAIT() asm volatile("s_waitcnt lgkmcnt(0)" ::: "memory")
#define VM_WAIT() asm volatile("s_waitcnt vmcnt(0)" ::: "memory")

#define XB_TMO      128
#define XB_XCNT(j)  (256  + 64 * (j))
#define XB_XSUB(j)  (1280 + 64 * (j))
#define XB_XGEN(j)  (2304 + 64 * (j))
#define XB_TOP      3328
#define XB_TOPGEN   3392
#define XCD_BAR_WORDS 3456
#define XB_SPIN_CAP (1u << 18)

__device__ __forceinline__ unsigned xb_ld(unsigned* p)              { return __hip_atomic_load(p, __ATOMIC_RELAXED, __HIP_MEMORY_SCOPE_AGENT); }
__device__ __forceinline__ unsigned xb_add(unsigned* p, unsigned v) { return __hip_atomic_fetch_add(p, v, __ATOMIC_RELAXED, __HIP_MEMORY_SCOPE_AGENT); }
__device__ __forceinline__ unsigned xb_xcc_id() { return (unsigned)__builtin_amdgcn_s_getreg((3 << 11) | 20) & 0xFu; }
#define XB_SPIN(cond, bar) do { unsigned _sp = 0; while (cond) { __builtin_amdgcn_s_sleep(1); \
    if ((++_sp & 255u) == 0u) { if (xb_ld(&(bar)[XB_TMO])) break; if (_sp > XB_SPIN_CAP) { atomicAdd(&(bar)[XB_TMO], 1u); break; } } } } while (0)

struct XcdBarrier { unsigned* bar; unsigned x; volatile LAS unsigned* st; };

__device__ __forceinline__ XcdBarrier xcd_barrier_post(unsigned* bar, volatile LAS unsigned* st) {
    XcdBarrier b; b.bar = bar; b.x = xb_xcc_id(); b.st = st;
    if (threadIdx.x == 0) (void)xb_add(&bar[XB_XCNT(b.x)], 1u);
    return b;
}
__device__ __forceinline__ void xcd_barrier_complete(unsigned* bar, unsigned x, unsigned& nloc, unsigned& nx) {
    const unsigned G = gridDim.x * gridDim.y * gridDim.z;
    unsigned sum, cnt, mine, sp = 0u;
    for (;;) {
        sum = 0u; cnt = 0u; mine = 0u;
#pragma unroll
        for (unsigned j = 0; j < 16; ++j) { const unsigned c = xb_ld(&bar[XB_XCNT(j)]); sum += c; cnt += (c > 0u) ? 1u : 0u; mine = (j == x) ? c : mine; }
        if (sum == G) break;
        __builtin_amdgcn_s_sleep(1);
        if ((++sp & 255u) == 0u) { if (xb_ld(&bar[XB_TMO])) break; if (sp > XB_SPIN_CAP) { atomicAdd(&bar[XB_TMO], 1u); break; } }
    }
    nloc = mine > 0u ? mine : 1u; nx = cnt > 0u ? cnt : 1u;
}
__device__ __forceinline__ void xcd_barrier(const XcdBarrier& b) {
    asm volatile("s_waitcnt vmcnt(0)" ::: "memory");
    __syncthreads();
    if (threadIdx.x == 0) {
        unsigned* bar = b.bar;
        __builtin_amdgcn_s_waitcnt(0);
        unsigned nloc = b.st[0], nx = b.st[1];
        if (nloc == 0u) { xcd_barrier_complete(bar, b.x, nloc, nx); b.st[0] = nloc; b.st[1] = nx; }
        const unsigned old = xb_add(&bar[XB_XSUB(b.x)], 1u);
        const unsigned gen = old / nloc;
        if (old + 1u == (gen + 1u) * nloc) {
            __builtin_amdgcn_fence(__ATOMIC_RELEASE, "agent");
            asm volatile("s_waitcnt vmcnt(0)" ::: "memory");
            const unsigned og = xb_add(&bar[XB_TOP], 1u);
            const unsigned tg = og / nx;
            if (og + 1u == (tg + 1u) * nx) xb_add(&bar[XB_TOPGEN], 1u);
            else XB_SPIN(xb_ld(&bar[XB_TOPGEN]) == tg, bar);
            __builtin_amdgcn_fence(__ATOMIC_ACQUIRE, "agent");
            xb_add(&bar[XB_XGEN(b.x)], 1u);
            asm volatile("s_waitcnt vmcnt(0)" ::: "memory");
        } else {
            XB_SPIN(xb_ld(&bar[XB_XGEN(b.x)]) == gen, bar);
            __builtin_amdgcn_fence(__ATOMIC_ACQUIRE, "agent");
            asm volatile("s_waitcnt vmcnt(0)" ::: "memory");
        }
    }
    __syncthreads();
}

namespace pg8 {
constexpr int BM = 256, BK = 64, HALF = 128, HTB = HALF * BK * 2, STAGE_BYTES = 8 * HTB, NXCD = 8, WGM = 8;
__host__ __device__ __forceinline__ int lds_byte(int r, int c) { const int st = (r >> 4) * 2 + (c >> 5), rr = r & 15, cc = c & 31, ob = rr * 64 + cc * 2; return st * 1024 + (ob ^ (((ob >> 9) & 1) << 5)); }
__host__ __device__ __forceinline__ void stage_rc(int b, int& R, int& C) { const int st = b / 1024, sb = b % 1024, swz = sb ^ (((sb >> 9) & 1) << 5); R = (st >> 1) * 16 + swz / 64; C = (st & 1) * 32 + (swz % 64) / 2; }
__host__ __device__ __forceinline__ int perm32(int rho) { const int n = rho >> 4, i = rho & 15; return 8 * (i >> 2) + 4 * n + (i & 3); }

struct Unit { int arow0, brow0, orow0, ocol0, aux; };

struct DenseOrder {
    int nM, nN, nwg, G, c;
    __device__ void init(int M, int N, int G_, int c_) { nM = M / BM; nN = N / BM; nwg = nM * nN; G = G_; c = c_; }
    __device__ __forceinline__ bool next(int i, Unit& u) const {
        const long L = (long)i * G + c; if (L >= nwg) return false;
        int wgid = (int)L; { const int q = nwg / NXCD, r = nwg % NXCD, xcd = wgid % NXCD, off = wgid / NXCD; wgid = (xcd < r ? xcd * (q + 1) : r * (q + 1) + (xcd - r) * q) + off; }
        const int nig = WGM * nN, gid = wgid / nig, fm = gid * WGM, gsz = (nM - fm) < WGM ? (nM - fm) : WGM;
        const int pm = fm + ((wgid % nig) % gsz), pn = (wgid % nig) / gsz;
        u.arow0 = pm * BM; u.brow0 = pn * BM; u.orow0 = pm * BM; u.ocol0 = pn * BM; u.aux = 0; return true;
    }
};
struct GroupedOrder {
    const LAS unsigned char* tab; int nN, nslot, slot, t0, t1;
    __device__ __forceinline__ void init(int ntiles, int nN_, int G, int c) {
        nN = nN_;
        if ((G & 7) == 0) { const int per = (ntiles + 7) >> 3, x = c & 7; nslot = G >> 3; slot = c >> 3; t0 = x * per; t1 = (t0 + per) < ntiles ? (t0 + per) : ntiles; }
        else { nslot = G; slot = c; t0 = 0; t1 = ntiles; }
    }
    __device__ __forceinline__ void preload(const int* tile_exp, LAS unsigned char* lds_tab, int tid, int nthr) {
        __syncthreads();
        for (int i = tid; i < t1 - t0; i += nthr) lds_tab[i] = (unsigned char)tile_exp[t0 + i];
        __syncthreads();
        tab = lds_tab;
    }
    __device__ __forceinline__ bool next(int i, Unit& u) const {
        const int q = i * nslot + slot, t = t0 + q / nN, pn = q % nN;
        if (t >= t1) return false;
        const int e = (int)tab[t - t0];
        u.arow0 = t * BM; u.brow0 = (e * nN + pn) * BM; u.orow0 = t * BM; u.ocol0 = pn * BM; u.aux = e; return true;
    }
};

template <class Base> struct RangeOrder {
    Base b; int i0, i1;
    __device__ __forceinline__ bool next(int i, Unit& u) const { const int j = i + i0; if (j >= i1) return false; return b.next(j, u); }
};

__device__ __forceinline__ unsigned cvt_pk_bf16(float lo, float hi) { return pk2(lo, hi); }

struct NoPre {};
struct EpiF32 {
    static constexpr bool PERM = false; typedef NoPre Pre;
    __device__ __forceinline__ Pre prefetch(const Unit&, LAS unsigned char*, int, int, int) const { return Pre{}; }
    float* C; int ldc;
    __device__ __forceinline__ void operator()(const f32x4 (&acc)[2][2][4][2], const Unit& u, int wr, int wc, int fr, int fq, const Pre&) const {
        const int row0 = u.orow0 + wr * 64 + fr, col0 = u.ocol0 + wc * 32 + 4 * fq;
#pragma unroll
        for (int ai = 0; ai < 2; ++ai)
#pragma unroll
            for (int m = 0; m < 4; ++m) { float* rowp = C + (size_t)(row0 + ai * HALF + m * 16) * ldc + col0;
#pragma unroll
                for (int bj = 0; bj < 2; ++bj)
#pragma unroll
                    for (int n = 0; n < 2; ++n) *(GAS f32x4*)(rowp + bj * HALF + n * 16) = acc[ai][bj][m][n]; }
    }
};
struct EpiF32H {
    static constexpr bool PERM = false; typedef NoPre Pre;
    __device__ __forceinline__ Pre prefetch(const Unit&, LAS unsigned char*, int, int, int) const { return Pre{}; }
    float* C; int ldc;
    __device__ __forceinline__ void operator()(const f32x4 (&acc)[2][2][4][2], const Unit& u, int wr, int wc, int fr, int fq, const Pre&) const {
        const int row0 = u.orow0 + wr * 64 + fr, col0 = wc * 32 + 4 * fq;
#pragma unroll
        for (int ai = 0; ai < 2; ++ai)
#pragma unroll
            for (int m = 0; m < 4; ++m) { float* rowp = C + (size_t)(row0 + ai * HALF + m * 16) * ldc + col0;
#pragma unroll
                for (int n = 0; n < 2; ++n) *(GAS f32x4*)(rowp + n * 16) = acc[ai][0][m][n]; }
    }
};
struct EpiBf16 {
    static constexpr bool PERM = true; typedef NoPre Pre;
    __device__ __forceinline__ Pre prefetch(const Unit&, LAS unsigned char*, int, int, int) const { return Pre{}; }
    bf16_t* O; int ldc;
    __device__ __forceinline__ void operator()(const f32x4 (&acc)[2][2][4][2], const Unit& u, int wr, int wc, int fr, int fq, const Pre&) const {
        const int row0 = u.orow0 + wr * 64 + fr, col0 = u.ocol0 + wc * 32 + 8 * fq;
#pragma unroll
        for (int ai = 0; ai < 2; ++ai)
#pragma unroll
            for (int m = 0; m < 4; ++m) { bf16_t* rowp = O + (size_t)(row0 + ai * HALF + m * 16) * ldc + col0;
#pragma unroll
                for (int bj = 0; bj < 2; ++bj) { const f32x4 v0 = acc[ai][bj][m][0], v1 = acc[ai][bj][m][1];
                    u32x4 w; w.x = cvt_pk_bf16(v0[0], v0[1]); w.y = cvt_pk_bf16(v0[2], v0[3]); w.z = cvt_pk_bf16(v1[0], v1[1]); w.w = cvt_pk_bf16(v1[2], v1[3]);
                    *(GAS u32x4*)(rowp + bj * HALF) = w; } }
    }
};
struct EpiSwiglu {
    static constexpr bool PERM = true; typedef NoPre Pre;
    __device__ __forceinline__ Pre prefetch(const Unit&, LAS unsigned char*, int, int, int) const { return Pre{}; }
    unsigned char* ACT;
    __device__ __forceinline__ void operator()(const f32x4 (&acc)[2][2][4][2], const Unit& u, int wr, int wc, int fr, int fq, const Pre&) const {
        const int row0 = u.orow0 + wr * 64 + fr, pn = u.ocol0 >> 8;
#pragma unroll
        for (int ai = 0; ai < 2; ++ai)
#pragma unroll
            for (int m = 0; m < 4; ++m) { unsigned char* rowp = ACT + (size_t)(row0 + ai * HALF + m * 16) * EH + pn * 128 + wc * 32 + 8 * fq;
                int w[2];
#pragma unroll
                for (int n = 0; n < 2; ++n) { const f32x4 g = acc[ai][0][m][n], up = acc[ai][1][m][n]; float h[4];
#pragma unroll
                    for (int i = 0; i < 4; ++i) h[i] = g[i] * __builtin_amdgcn_rcpf(1.0f + __expf(-g[i])) * up[i];
                    int v = 0; v = __builtin_amdgcn_cvt_pk_fp8_f32(h[0], h[1], v, false); v = __builtin_amdgcn_cvt_pk_fp8_f32(h[2], h[3], v, true); w[n] = v; }
                *(GAS u32x2*)rowp = (u32x2){(unsigned)w[0], (unsigned)w[1]}; }
    }
};
constexpr float Y2_SCALE = 16.0f, Y2_INV = 1.0f / 16.0f;
struct EpiScatter {
    static constexpr bool PERM = true;
    struct Pre { const LAS int* tab; };
    unsigned char* Y2; const int* rowdst;
    __device__ __forceinline__ Pre prefetch(const Unit& u, LAS unsigned char* lds, int wid, int lane, int ui) const {
        LAS unsigned char* tab = lds + STAGE_BYTES + (ui & 1) * 1024;
        if (wid < 4) __builtin_amdgcn_global_load_lds((const unsigned*)(rowdst + u.orow0 + wid * 64 + lane), (LAS unsigned*)(tab + wid * 256), 4, 0, 0);
        Pre p; p.tab = (const LAS int*)tab; return p; }
    __device__ __forceinline__ void operator()(const f32x4 (&acc)[2][2][4][2], const Unit& u, int wr, int wc, int fr, int fq, const Pre& pre) const {
#pragma unroll
        for (int ai = 0; ai < 2; ++ai)
#pragma unroll
            for (int m = 0; m < 4; ++m) { const int dst = pre.tab[wr * 64 + fr + ai * HALF + m * 16];
                if (dst >= 0) { unsigned char* rowp = Y2 + (size_t)dst * DM + u.ocol0 + wc * 64 + fq * 16;
                    int w[4];
#pragma unroll
                    for (int bj = 0; bj < 2; ++bj) { const f32x4 v0 = acc[ai][bj][m][0] * Y2_SCALE, v1 = acc[ai][bj][m][1] * Y2_SCALE;
                        int w0 = 0, w1 = 0;
                        w0 = __builtin_amdgcn_cvt_pk_fp8_f32(v0[0], v0[1], w0, false); w0 = __builtin_amdgcn_cvt_pk_fp8_f32(v0[2], v0[3], w0, true);
                        w1 = __builtin_amdgcn_cvt_pk_fp8_f32(v1[0], v1[1], w1, false); w1 = __builtin_amdgcn_cvt_pk_fp8_f32(v1[2], v1[3], w1, true);
                        w[2 * bj] = w0; w[2 * bj + 1] = w1; }
                    *(GAS u32x4*)rowp = (u32x4){(unsigned)w[0], (unsigned)w[1], (unsigned)w[2], (unsigned)w[3]}; } }
    }
};

typedef int v8i __attribute__((ext_vector_type(8)));
typedef int v4i __attribute__((ext_vector_type(4)));
struct Frag { bf16x8 p[2]; __device__ __forceinline__ bf16x8& operator[](int k) { return p[k]; } __device__ __forceinline__ const bf16x8& operator[](int k) const { return p[k]; } };
template <class Epi, class Sched, bool GATHER, bool F8 = false, bool ALIGN_EPI = true, bool SP2 = true, bool NHALF = false>
__device__ __forceinline__ void gemm_phase(const int tid_in, LAS unsigned char* lds, const void* Ag, const void* Bg, const int K, const int* rowidx, const Sched& S, const Epi& E) {
    int tid_ = tid_in; asm volatile("" : "+v"(tid_));
    const int tid = tid_, wid = __builtin_amdgcn_readfirstlane(tid >> 6), lane = tid & 63, wr = wid >> 2, wc = wid & 3, fr = lane & 15, fq = lane >> 4;
    const int KB = F8 ? K : 2 * K;
    const int nt = KB / 128;
    unsigned voffB[2];
#pragma unroll
    for (int i = 0; i < 2; ++i) { int R, C; stage_rc(tid * 16 + i * 8192, R, C); const int Rb = Epi::PERM ? ((R & ~31) + perm32(R & 31)) : R;
        voffB[i] = (unsigned)(Rb * KB + C * 2); }
    const size_t kstep = (size_t)128;
    const size_t hstep = (size_t)HALF * KB;
    const unsigned ldsw = (unsigned)wid * 1024u;
    const int aoff = F8 ? lds_byte(wr * 64 + fr, 16 * fq) : lds_byte(wr * 64 + fr, fq * 8), boff = F8 ? lds_byte(wc * 32 + fr, 16 * fq) : lds_byte(wc * 32 + fr, fq * 8);
    constexpr int PIECE1 = F8 ? 16 : 1024;
    const int sc_w = 0x7A7A7A7A, sc_a = 0x7F7F7F7F;
#define PG8_SA(b, h) (((b) * 2 + (h)) * HTB)
#define PG8_SB(b, h) ((4 + (b) * 2 + (h)) * HTB)
#define PG8_STAGE_B(bufoff, gbase) do { _Pragma("unroll") for (int _i = 0; _i < 2; ++_i) \
        __builtin_amdgcn_global_load_lds((const unsigned*)((const char*)(gbase) + voffB[_i]), (LAS unsigned*)(lds + (bufoff) + ldsw + _i * 8192), 16, 0, 0); } while (0)
#define PG8_STAGE_A(bufoff, gbase, h) do { const char* _gb = (const char*)(gbase) + (GATHER ? (size_t)0 : (size_t)(h) * hstep); \
        __builtin_amdgcn_global_load_lds((const unsigned*)(_gb + ac[GATHER ? (h) : 0][0]), (LAS unsigned*)(lds + (bufoff) + ldsw), 16, 0, 0); \
        __builtin_amdgcn_global_load_lds((const unsigned*)(_gb + ac[GATHER ? (h) : 0][1]), (LAS unsigned*)(lds + (bufoff) + ldsw + 8192), 16, 0, 0); } while (0)
#define PG8_LDA(dst, b, h) do { _Pragma("unroll") for (int m = 0; m < 4; ++m) { if constexpr (F8) { const v4i _l = *(const LAS v4i*)(lds + PG8_SA(b, h) + aoff + m * 2048), _h = *(const LAS v4i*)(lds + PG8_SA(b, h) + aoff + m * 2048 + PIECE1); dst##8[m] = __builtin_shufflevector(_l, _h, 0, 1, 2, 3, 4, 5, 6, 7); } \
        else { dst[m][0] = *(const LAS bf16x8*)(lds + PG8_SA(b, h) + aoff + m * 2048); dst[m][1] = *(const LAS bf16x8*)(lds + PG8_SA(b, h) + aoff + m * 2048 + PIECE1); } } } while (0)
#define PG8_LDB(dst, b, h) do { _Pragma("unroll") for (int n = 0; n < 2; ++n) { if constexpr (F8) { const v4i _l = *(const LAS v4i*)(lds + PG8_SB(b, h) + boff + n * 2048), _h = *(const LAS v4i*)(lds + PG8_SB(b, h) + boff + n * 2048 + PIECE1); dst##8[n] = __builtin_shufflevector(_l, _h, 0, 1, 2, 3, 4, 5, 6, 7); } \
        else { dst[n][0] = *(const LAS bf16x8*)(lds + PG8_SB(b, h) + boff + n * 2048); dst[n][1] = *(const LAS bf16x8*)(lds + PG8_SB(b, h) + boff + n * 2048 + PIECE1); } } } while (0)
#define PG8_MMA(ai, bj, At, Bt) do { __builtin_amdgcn_s_setprio(1); _Pragma("unroll") for (int m = 0; m < 4; ++m) _Pragma("unroll") for (int n = 0; n < 2; ++n) { \
        if constexpr (F8) asm volatile("v_mfma_scale_f32_16x16x128_f8f6f4 %0, %1, %2, %0, %3, %4 op_sel_hi:[0,0,0]" : "+v"(acc[ai][bj][m][n]) : "v"(Bt##8[n]), "v"(At##8[m]), "v"(sc_w), "v"(sc_a)); \
        else { _Pragma("unroll") for (int k = 0; k < 2; ++k) acc[ai][bj][m][n] = __builtin_amdgcn_mfma_f32_16x16x32_bf16(Bt[n][k], At[m][k], acc[ai][bj][m][n], 0, 0, 0); } } \
        __builtin_amdgcn_s_setprio(0); } while (0)
#define PG8_WAIT_V(n) asm volatile("s_waitcnt vmcnt(" #n ")" ::: "memory")
#define PG8_WAIT_LOOP do { if constexpr (NHALF) PG8_WAIT_V(6); else PG8_WAIT_V(8); } while (0)
#define PG8_WAIT_L(n) asm volatile("s_waitcnt lgkmcnt(" #n ")" ::: "memory")
#define PG8_BAR __builtin_amdgcn_s_barrier()
#define PG8_SCHED __builtin_amdgcn_sched_barrier(0)
#define PG8_TAB(par) (lds + STAGE_BYTES + 2048 + (par) * 1024)
#define PG8_TABLOAD(par, row0) do { if (wid < 4) __builtin_amdgcn_global_load_lds((const unsigned*)(rowidx + (row0) + wid * 64 + lane), (LAS unsigned*)(PG8_TAB(par) + wid * 256), 4, 0, 0); } while (0)
#define PG8_AOFF_H(h, par) do { int _tz = tid; asm volatile("" : "+v"(_tz)); _Pragma("unroll") for (int _i = 0; _i < 2; ++_i) { int _R, _C; stage_rc(_tz * 16 + _i * 8192, _R, _C); \
        if (GATHER) ac[h][_i] = ((const LAS unsigned*)PG8_TAB(par))[(h) * HALF + _R] * (unsigned)KB + (unsigned)_C * 2u; \
        else ac[h][_i] = (unsigned)(((h) * HALF + _R) * KB) + (unsigned)_C * 2u; } } while (0)
    static_assert(SP2, "only the two-super-phase K-loop is kept");
    Unit cur, nxt; int ui = 0;
    if (!S.next(0, cur)) return;
    f32x4 acc[2][2][4][2];
#pragma unroll
    for (int a = 0; a < 2; ++a)
#pragma unroll
        for (int b = 0; b < 2; ++b)
#pragma unroll
            for (int m = 0; m < 4; ++m)
#pragma unroll
                for (int n = 0; n < 2; ++n) acc[a][b][m][n] = (f32x4){0.f, 0.f, 0.f, 0.f};
    bf16x8 At[F8 ? 1 : 4][2], B0[F8 ? 1 : 2][2], B1[F8 ? 1 : 2][2];
    v8i At8[F8 ? 4 : 1], B08[F8 ? 2 : 1], B18[F8 ? 2 : 1];
    unsigned ac[GATHER ? 2 : 1][2];
    if (GATHER) { PG8_TABLOAD(0, cur.arow0); PG8_WAIT_V(0); PG8_BAR; }
    PG8_AOFF_H(0, 0); if (GATHER) { PG8_AOFF_H((GATHER ? 1 : 0), 0); }
    const char* cA = (const char*)Ag + (GATHER ? (size_t)0 : (size_t)cur.arow0 * KB); const char* cB = (const char*)Bg + (size_t)cur.brow0 * KB;
    PG8_STAGE_B(PG8_SB(0, 0), cB); if constexpr (!NHALF) PG8_STAGE_B(PG8_SB(0, 1), cB + hstep); PG8_STAGE_A(PG8_SA(0, 0), cA, 0); PG8_STAGE_A(PG8_SA(0, 1), cA, 1);
    if (wr == 1) PG8_BAR;
    PG8_WAIT_V(2); PG8_BAR;
    PG8_STAGE_B(PG8_SB(1, 0), cB + kstep); PG8_STAGE_A(PG8_SA(1, 0), cA + kstep, 0); if constexpr (!NHALF) PG8_STAGE_B(PG8_SB(1, 1), cB + hstep + kstep);
    if constexpr (NHALF) PG8_WAIT_V(4); else PG8_WAIT_V(6);
    PG8_BAR;
    for (;;) {
        const typename Epi::Pre pre = E.prefetch(cur, lds, wid, lane, ui);
        const bool has_next = S.next(ui + 1, nxt);
        if (GATHER) { if (has_next) PG8_TABLOAD((ui + 1) & 1, nxt.arow0); }
        const char* nA = has_next ? ((const char*)Ag + (GATHER ? (size_t)0 : (size_t)nxt.arow0 * KB)) : cA; const char* nB = has_next ? (const char*)Bg + (size_t)nxt.brow0 * KB : cB;
_Pragma("nounroll")
        for (int t = 0; t < nt; t += 2) {
            const bool last = (t == nt - 2);
            const char* a1 = cA + (size_t)(t + 1) * kstep;
            const char* a2 = last ? nA : cA + (size_t)(t + 2) * kstep; const char* b2 = last ? nB : cB + (size_t)(t + 2) * kstep;
            const char* a3 = a2 + kstep; const char* b3 = b2 + kstep;
            if (GATHER) { if (last && has_next) { PG8_AOFF_H(0, (ui + 1) & 1); } }
            PG8_LDB(B0, 0, 0); if constexpr (!NHALF) PG8_LDB(B1, 0, 1); PG8_SCHED; PG8_LDA(At, 0, 0); PG8_STAGE_A(PG8_SA(1, 1), a1, 1);
            PG8_WAIT_LOOP; PG8_WAIT_L(0); PG8_BAR; PG8_MMA(0, 0, At, B0); if constexpr (!NHALF) PG8_MMA(0, 1, At, B1); PG8_BAR; PG8_SCHED;
            if (GATHER) { if (last && has_next) { PG8_AOFF_H(1, (ui + 1) & 1); } }
            PG8_LDA(At, 0, 1); PG8_STAGE_B(PG8_SB(0, 0), b2); if constexpr (!NHALF) PG8_STAGE_B(PG8_SB(0, 1), b2 + hstep); PG8_STAGE_A(PG8_SA(0, 0), a2, 0);
            PG8_WAIT_LOOP; PG8_WAIT_L(0); PG8_BAR; PG8_MMA(1, 0, At, B0); if constexpr (!NHALF) PG8_MMA(1, 1, At, B1); PG8_BAR; PG8_SCHED;
            PG8_LDB(B0, 1, 0); if constexpr (!NHALF) PG8_LDB(B1, 1, 1); PG8_SCHED; PG8_LDA(At, 1, 0); PG8_STAGE_A(PG8_SA(0, 1), a2, 1);
            PG8_WAIT_LOOP; PG8_WAIT_L(0); PG8_BAR; PG8_MMA(0, 0, At, B0); if constexpr (!NHALF) PG8_MMA(0, 1, At, B1); PG8_BAR; PG8_SCHED;
            PG8_LDA(At, 1, 1); PG8_STAGE_B(PG8_SB(1, 0), b3); if constexpr (!NHALF) PG8_STAGE_B(PG8_SB(1, 1), b3 + hstep); PG8_STAGE_A(PG8_SA(1, 0), a3, 0);
            PG8_WAIT_LOOP; PG8_WAIT_L(0); PG8_BAR; PG8_MMA(1, 0, At, B0); if constexpr (!NHALF) PG8_MMA(1, 1, At, B1); PG8_BAR; PG8_SCHED;
        }
        if constexpr (ALIGN_EPI) { if (wr == 0) PG8_BAR; }
        E(acc, cur, wr, wc, fr, fq, pre);
        if (!has_next) break;
#pragma unroll
        for (int a = 0; a < 2; ++a)
#pragma unroll
            for (int b = 0; b < 2; ++b)
#pragma unroll
                for (int m = 0; m < 4; ++m)
#pragma unroll
                    for (int n = 0; n < 2; ++n) acc[a][b][m][n] = (f32x4){0.f, 0.f, 0.f, 0.f};
        cur = nxt; cA = nA; cB = nB; ++ui;
        if constexpr (ALIGN_EPI) { if (wr == 1) PG8_BAR; }
    }
    PG8_WAIT_V(0);
    if constexpr (!ALIGN_EPI) { if (wr == 0) PG8_BAR; }
    PG8_BAR;
#undef PG8_SA
#undef PG8_SB
#undef PG8_STAGE_A
#undef PG8_STAGE_B
#undef PG8_LDA
#undef PG8_LDB
#undef PG8_MMA
#undef PG8_WAIT_V
#undef PG8_WAIT_L
#undef PG8_WAIT_LOOP
#undef PG8_BAR
#undef PG8_SCHED
#undef PG8_AOFF_H
#undef PG8_TAB
#undef PG8_TABLOAD
}
}

constexpr int NWAVES = 8, NTHR = 512;
constexpr size_t MiB = 1u << 20;
constexpr size_t WS_CTL = 0, CTL_BYTES = 1 * MiB;
constexpr size_t WS_MOD = 1 * MiB;
constexpr size_t WS_WIN = 3 * MiB;
constexpr size_t WS_WOUT = 29 * MiB;
constexpr size_t WS_WR = 37 * MiB;
constexpr size_t WS_HYF = 39 * MiB;
constexpr size_t WS_HYFC = 71 * MiB;
constexpr size_t WS_XC = 73 * MiB;
constexpr size_t WS_EXP1 = 89 * MiB;
constexpr size_t WS_EXP2 = 218 * MiB;
constexpr size_t WS_XM = 283 * MiB;
constexpr size_t WS_EIDX = 419 * MiB;
constexpr size_t WS_WGT = 422 * MiB;
constexpr size_t WS_RNK = 425 * MiB;
constexpr size_t WS_ROWTOK = 428 * MiB;
constexpr size_t WS_ROWDST = 431 * MiB;
constexpr size_t WS_TILEEXP = 434 * MiB;
constexpr size_t WS_BIG = 435 * MiB;
constexpr size_t WS_U = WS_BIG;
constexpr size_t WS_MIX = 877 * MiB;
constexpr size_t WS_VT = 1013 * MiB;
constexpr size_t WS_HV = 1081 * MiB;
constexpr size_t WS_Z2 = 1183 * MiB;
constexpr size_t WS_GDS = 1217 * MiB;
constexpr size_t WS_GSIN = 1285 * MiB;
constexpr size_t WS_GD = 1319 * MiB;
constexpr size_t WS_Y = 1321 * MiB;
constexpr size_t WS_LOGIT = WS_BIG;
constexpr size_t WS_ACT = WS_BIG;
constexpr size_t WS_Y2 = 758 * MiB;
constexpr size_t WS_XM8 = 1470 * MiB;
constexpr size_t WS_XR = 1600 * MiB;
constexpr size_t WS_END = 1736 * MiB;
constexpr int CW_BAR = 4096;
constexpr int CW_CNT = 16384;
constexpr int CW_NTL = 20480;

constexpr int LDS_BYTES = 163840;
constexpr int MISC_OFF = 163584;

struct Frame {
    LAS unsigned char* lds;
    int tid, lane, wave, G, wg;
    const float* const* in;
    float* out; unsigned char* ws; unsigned* ctl;
};
enum { I_X = 0, I_C, I_CTX, I_CCTX, I_WMOD, I_BMOD, I_WIN, I_RPB, I_WA2, I_BA2, I_GNORM, I_HSW, I_HSB, I_HW1, I_HB1, I_HF1, I_HW2, I_HB2, I_HF2, I_HW3, I_HB3, I_HDEC, I_HSKIP,
       I_WOUT, I_LN1G, I_LN1B, I_RW, I_RB, I_WEG, I_WEU, I_WED, I_WSG, I_WSU, I_WSD, I_LN2G, I_LN2B };

__device__ __forceinline__ int row_b(int row) { return row < NLAT ? (row >> 12) : 16; }
__device__ __forceinline__ const float* mod_ptr(const Frame& F, int l, int row) { return (const float*)(F.ws + WS_MOD) + ((size_t)l * 17 + row_b(row)) * 6144; }

template <class RowFn>
__device__ __forceinline__ void tr_item(const float* W, int ldw, int k0, int n0, bf16_t* dst, int ldd, RowFn rf, LAS float* scr, int lane) {
    float tv[32];
    const GAS float* wp = (const GAS float*)(W + (size_t)(k0 + (lane >> 5)) * ldw + n0 + (lane & 31));
#pragma unroll
    for (int i = 0; i < 32; ++i) tv[i] = wp[(size_t)(2 * i) * ldw];
#pragma unroll
    for (int i = 0; i < 32; ++i) scr[(2 * i + (lane >> 5)) * 33 + (lane & 31)] = tv[i];
    LDS_WAIT(); asm volatile("" ::: "memory");
    const int c = lane & 7;
#pragma unroll
    for (int j = 0; j < 4; ++j) { const int n = (lane >> 3) + 8 * j; const LAS float* s = scr + (8 * c) * 33 + n;
        u32x4 o; o.x = pk2(s[0 * 33], s[1 * 33]); o.y = pk2(s[2 * 33], s[3 * 33]); o.z = pk2(s[4 * 33], s[5 * 33]); o.w = pk2(s[6 * 33], s[7 * 33]);
        *(GAS u32x4*)(dst + (size_t)rf(n0 + n) * ldd + k0 + 8 * c) = o; }
    LDS_WAIT(); asm volatile("" ::: "memory");
}
template <class RowFn>
__device__ __forceinline__ void tr_item8(const float* W, int ldw, int k0, int n0, unsigned char* dst, int ldd, RowFn rf, float scale, LAS float* scr, int lane) {
    float tv[32];
    const GAS float* wp = (const GAS float*)(W + (size_t)(k0 + (lane >> 5)) * ldw + n0 + (lane & 31));
#pragma unroll
    for (int i = 0; i < 32; ++i) tv[i] = wp[(size_t)(2 * i) * ldw];
#pragma unroll
    for (int i = 0; i < 32; ++i) scr[(2 * i + (lane >> 5)) * 33 + (lane & 31)] = tv[i];
    LDS_WAIT(); asm volatile("" ::: "memory");
    const int n = lane >> 1, hf = lane & 1; const LAS float* s = scr + (32 * hf) * 33 + n;
    unsigned w[8];
#pragma unroll
    for (int j = 0; j < 8; ++j) { int v = 0; v = __builtin_amdgcn_cvt_pk_fp8_f32(s[(4 * j) * 33] * scale, s[(4 * j + 1) * 33] * scale, v, false); v = __builtin_amdgcn_cvt_pk_fp8_f32(s[(4 * j + 2) * 33] * scale, s[(4 * j + 3) * 33] * scale, v, true); w[j] = (unsigned)v; }
    unsigned char* d = dst + (size_t)rf(n0 + n) * ldd + k0 + 32 * hf;
    *(GAS u32x4*)d = (u32x4){w[0], w[1], w[2], w[3]}; *(GAS u32x4*)(d + 16) = (u32x4){w[4], w[5], w[6], w[7]};
    LDS_WAIT(); asm volatile("" ::: "memory");
}
struct RowId { __device__ __forceinline__ int operator()(int n) const { return n; } };
struct RowWin { __device__ __forceinline__ int operator()(int n) const { return n >= 2336 ? n - 32 : n; } };
struct RowGU { int up; __device__ __forceinline__ int operator()(int j) const { return (j >> 7) * 256 + up * 128 + (j & 127); } };

__device__ __forceinline__ void p0_static_weights(Frame& F) {
    LAS float* scr = (LAS float*)(F.lds + F.wave * 16384);
    const int gw = F.wg * NWAVES + F.wave, NGW = F.G * NWAVES;
    constexpr int I_IN = 16 * 97, I_OUT = 16 * 32, I_R = 16 * 4, PER_L = I_IN + I_OUT + I_R;
    for (int it = gw; it < DEPTH * PER_L; it += NGW) {
        const int l = it / PER_L; int r = it % PER_L;
        if (r < I_IN) { const int kb = r / 97, nb = r % 97; if (nb == 72) continue;
            tr_item(F.in[I_WIN] + (size_t)l * DM * DIN_REF, DIN_REF, kb * 64, nb * 32, (bf16_t*)(F.ws + WS_WIN) + (size_t)l * DIN * DM, DM, RowWin{}, scr, F.lane); continue; }
        r -= I_IN;
        if (r < I_OUT) { const int kb = r / 32, nb = r % 32;
            tr_item(F.in[I_WOUT] + (size_t)l * DM * DM, DM, kb * 64, nb * 32, (bf16_t*)(F.ws + WS_WOUT) + (size_t)l * DM * DM, DM, RowId{}, scr, F.lane); continue; }
        r -= I_OUT;
        { const int kb = r / 4, nb = r % 4;
            tr_item(F.in[I_RW] + (size_t)l * DM * NEXP, NEXP, kb * 64, nb * 32, (bf16_t*)(F.ws + WS_WR) + (size_t)l * 256 * DM, DM, RowId{}, scr, F.lane); }
    }
    const int gt = F.wg * NTHR + F.tid, NGT = F.G * NTHR;
    for (int i = gt; i < DEPTH * 128 * DM / 8; i += NGT) { const int l = i / (128 * DM / 8), r = i % (128 * DM / 8);
        *(u32x4*)((bf16_t*)(F.ws + WS_WR) + ((size_t)l * 256 + 128) * DM + (size_t)r * 8) = (u32x4){0u, 0u, 0u, 0u}; }
    for (int i = gt; i < DEPTH * 256 * DM; i += NGT) {
        const int k = i % DM, n = (i / DM) % 256, l = i / (DM * 256), dir = n >> 7, j = n & 127;
        const float* wi = F.in[I_WIN] + ((size_t)l * DM + k) * DIN_REF + 2304 + dir * 16;
        const float* wa = F.in[I_WA2] + ((size_t)(l * 2 + dir) * 16) * 128 + j;
        float s = 0.f;
#pragma unroll
        for (int r = 0; r < 16; ++r) s += wi[r] * wa[r * 128];
        ((bf16_t*)(F.ws + WS_WIN))[((size_t)l * DIN + 3072 + n) * DM + k] = (bf16_t)f2bf(s);
    }
}
__device__ __forceinline__ void p0_mod(Frame& F) {
    LAS float* sc = (LAS float*)F.lds;
    LAS float* red = (LAS float*)(F.lds + 17 * 1024 * 4);
    for (int i = F.tid; i < 17 * 1024; i += NTHR) { const int r = i >> 10, k = i & 1023; const float v = r < 16 ? F.in[I_C][r * 1024 + k] : F.in[I_CCTX][k]; sc[i] = silu_f(v); }
    __syncthreads();
    const int kq = F.tid >> 7, cl = F.tid & 127;
    for (int u = F.wg; u < DEPTH * 48; u += F.G) {
        const int l = u / 48, col = (u % 48) * 128 + cl;
        const float* w = F.in[I_WMOD] + (size_t)l * DM * 6144 + col;
        float a[17];
#pragma unroll
        for (int r = 0; r < 17; ++r) a[r] = 0.f;
        for (int k0 = kq * 256; k0 < kq * 256 + 256; k0 += 16) {
            float wv[16];
#pragma unroll
            for (int q = 0; q < 16; ++q) wv[q] = *(const GAS float*)(w + (size_t)(k0 + q) * 6144);
#pragma unroll
            for (int q = 0; q < 16; ++q)
#pragma unroll
                for (int r = 0; r < 17; ++r) a[r] += sc[r * 1024 + k0 + q] * wv[q]; }
#pragma unroll
        for (int r = 0; r < 17; ++r) red[(kq * 17 + r) * 128 + cl] = a[r];
        __syncthreads();
        for (int i = F.tid; i < 17 * 128; i += NTHR) { const int r = i >> 7, c2 = i & 127, cc = (u % 48) * 128 + c2;
            const float s = red[(0 * 17 + r) * 128 + c2] + red[(1 * 17 + r) * 128 + c2] + red[(2 * 17 + r) * 128 + c2] + red[(3 * 17 + r) * 128 + c2] + F.in[I_BMOD][l * 6144 + cc];
            ((float*)(F.ws + WS_MOD))[((size_t)l * 17 + r) * 6144 + cc] = s; }
        __syncthreads();
    }
}
__device__ __forceinline__ void p0_hyena_filters(Frame& F) {
    LAS float* z = (LAS float*)F.lds;
    LAS float* h1 = z + 1092;
    LAS float* h2 = h1 + 33 * 64;
    LAS float* tt = h2 + 33 * 64;
    LAS float* W1 = tt + 64;
    LAS float* W2 = W1 + 33 * 64;
    constexpr int UL = 4096 / 32, UC = 256 / 32, UPL = UL + UC;
    for (int u = F.wg; u < DEPTH * UPL; u += F.G) {
        const int l = u / UPL, r = u % UPL; const bool lat = r < UL; const int L = lat ? 4096 : 256, n0 = (lat ? r : r - UL) * 32;
        __syncthreads();
        for (int i = F.tid; i < 33 * 64; i += NTHR) W1[i] = F.in[I_HW1][(size_t)l * 33 * 64 + i];
        for (int i = F.tid; i < 64 * 64; i += NTHR) W2[i] = F.in[I_HW2][(size_t)l * 64 * 64 + i];
        for (int i = F.tid; i < 33 * 33; i += NTHR) { const int p = i / 33, e = i % 33, n = n0 + p;
            const float t = (float)n / (float)(L - 1);
            float v;
            if (e == 0) v = t;
            else { const int kb = (e - 1) & 15; const float band = 1e-4f + (float)kb * ((15.0f - 1e-4f) / 15.0f);
                   const float w = 6.283185307179586f * (float)n / (float)L; const float ang = w * band;
                   v = e <= 16 ? __cosf(ang) : -__sinf(ang); }
            z[i] = v; if (e == 0) tt[p] = t; }
        __syncthreads();
        for (int i = F.tid; i < 33 * 64; i += NTHR) { const int p = i >> 6, j = i & 63; float s = F.in[I_HB1][l * 64 + j];
#pragma unroll 11
            for (int e = 0; e < 33; ++e) s += z[p * 33 + e] * W1[e * 64 + j];
            h1[i] = __sinf(F.in[I_HF1][l * 64 + j] * s); }
        __syncthreads();
        for (int i = F.tid; i < 33 * 64; i += NTHR) { const int p = i >> 6, j = i & 63; float s = F.in[I_HB2][l * 64 + j];
#pragma unroll 16
            for (int e = 0; e < 64; ++e) s += h1[p * 64 + e] * W2[e * 64 + j];
            h2[i] = __sinf(F.in[I_HF2][l * 64 + j] * s); }
        __syncthreads();
        {
            const int g = F.tid >> 8, col0 = 4 * (F.tid & 255), o = col0 >> 9, dir = (col0 >> 8) & 1, ch0 = col0 & 255;
            const int pb = (dir ? 0 : 1) + 16 * g;
            float a[4][16];
#pragma unroll
            for (int j = 0; j < 4; ++j)
#pragma unroll
                for (int q = 0; q < 16; ++q) a[j][q] = 0.f;
            const float* w3 = F.in[I_HW3] + (size_t)l * 64 * 1024 + col0;
            const LAS float* hp = h2 + pb * 64;
            f32x4 wa[4], wb[4];
#pragma unroll
            for (int q = 0; q < 4; ++q) wa[q] = *(const GAS f32x4*)(w3 + (size_t)q * 1024);
#define HF_BLOCK(wv_, k0_) do { _Pragma("unroll") for (int pi = 0; pi < 16; ++pi) { const f32x4 hv = *(const LAS f32x4*)(hp + pi * 64 + (k0_)); \
                _Pragma("unroll") for (int q = 0; q < 4; ++q) _Pragma("unroll") for (int j = 0; j < 4; ++j) a[j][pi] += hv[q] * wv_[q][j]; } } while (0)
#pragma unroll 1
            for (int k0 = 0; k0 < 64; k0 += 8) {
#pragma unroll
                for (int q = 0; q < 4; ++q) wb[q] = *(const GAS f32x4*)(w3 + (size_t)(k0 + 4 + q) * 1024);
                __builtin_amdgcn_sched_barrier(0);
                HF_BLOCK(wa, k0);
                __builtin_amdgcn_sched_barrier(0);
                { const int kn = k0 + 8 < 64 ? k0 + 8 : k0;
#pragma unroll
                  for (int q = 0; q < 4; ++q) wa[q] = *(const GAS f32x4*)(w3 + (size_t)(kn + q) * 1024); }
                __builtin_amdgcn_sched_barrier(0);
                HF_BLOCK(wb, k0 + 4);
                __builtin_amdgcn_sched_barrier(0);
            }
#undef HF_BLOCK
            const f32x4 b3 = *(const GAS f32x4*)(F.in[I_HB3] + l * 1024 + col0), dc = *(const GAS f32x4*)(F.in[I_HDEC] + ((size_t)(l * 2 + o) * 2 + dir) * 256 + ch0);
            float a0[4] = {0.f, 0.f, 0.f, 0.f};
            if (n0 == 0 && dir == 0 && g == 0) {
                for (int k = 0; k < 64; ++k) { const f32x4 wv = *(const GAS f32x4*)(w3 + (size_t)k * 1024); const float hv = h2[k];
#pragma unroll
                    for (int j = 0; j < 4; ++j) a0[j] += hv * wv[j]; } }
#pragma unroll
            for (int j = 0; j < 4; ++j) {
                const float dec = fabsf(dc[j]);
                bf16_t* R = lat ? (bf16_t*)(F.ws + WS_HYF) + ((size_t)(l * 2 + o) * 256 + ch0 + j) * 8192 : (bf16_t*)(F.ws + WS_HYFC) + ((size_t)(l * 2 + o) * 256 + ch0 + j) * 512;
                float v[16];
#pragma unroll
                for (int pi = 0; pi < 16; ++pi) v[pi] = (a[j][pi] + b3[j]) * __expf(-tt[pb + pi] * dec);
                unsigned w[8];
                if (dir == 0) {
                    if (n0 + 32 == L && g == 1) v[15] = 0.f;
#pragma unroll
                    for (int q = 0; q < 8; ++q) w[q] = pk2(v[15 - 2 * q], v[14 - 2 * q]);
                    GAS u32x4* dst = (GAS u32x4*)(R + (L - n0 - 32) + 16 * (1 - g));
                    dst[0] = (u32x4){w[0], w[1], w[2], w[3]}; dst[1] = (u32x4){w[4], w[5], w[6], w[7]};
                    if (n0 == 0 && g == 0) R[L] = (bf16_t)f2bf((a0[j] + b3[j]) * __expf(-tt[0] * dec) + F.in[I_HSKIP][(l * 2 + o) * 256 + ch0 + j]);
                } else if (n0 > 0 || g == 1) {
#pragma unroll
                    for (int q = 0; q < 8; ++q) w[q] = pk2(v[2 * q], v[2 * q + 1]);
                    GAS u32x4* dst = (GAS u32x4*)(R + (L + n0) + 16 * g);
                    dst[0] = (u32x4){w[0], w[1], w[2], w[3]}; dst[1] = (u32x4){w[4], w[5], w[6], w[7]};
                } else {
#pragma unroll
                    for (int pi = 1; pi < 16; ++pi) R[L + pi] = (bf16_t)f2bf(v[pi]);
                }
            }
        }
    }
    __syncthreads();
}
__device__ __forceinline__ void p0_init_rows(Frame& F) {
    const int gw = F.wg * NWAVES + F.wave, NGW = F.G * NWAVES;
    for (int row = gw; row < NROW; row += NGW) {
        const float* src = row < NLAT ? F.in[I_X] + (size_t)row * DM : F.in[I_CTX] + (size_t)(row - NLAT) * DM;
        const float* md = mod_ptr(F, 0, row);
        bf16_t* xr = (bf16_t*)(F.ws + WS_XR) + (size_t)row * DM; bf16_t* xm = (bf16_t*)(F.ws + WS_XM) + (size_t)row * DM;
#pragma unroll
        for (int j = 0; j < 4; ++j) { const int c = 4 * F.lane + 256 * j;
            const f32x4 v = *(const GAS f32x4*)(src + c), sh = *(const GAS f32x4*)(md + c), sc = *(const GAS f32x4*)(md + 1024 + c);
            *(GAS u32x2*)(xr + c) = (u32x2){pk2(v[0], v[1]), pk2(v[2], v[3])};
            u32x2 w; w.x = pk2(v[0] * (1.f + sc[0]) + sh[0], v[1] * (1.f + sc[1]) + sh[1]); w.y = pk2(v[2] * (1.f + sc[2]) + sh[2], v[3] * (1.f + sc[3]) + sh[3]);
            *(GAS u32x2*)(xm + c) = w; }
    }
}
constexpr float WEXP_SCALE = 32.0f;
__device__ __forceinline__ void p_expert_weights(Frame& F, int l) {
    LAS float* scr = (LAS float*)(F.lds + F.wave * 16384);
    const int gw = F.wg * NWAVES + F.wave, NGW = F.G * NWAVES;
    constexpr int I1 = 16 * 8, I2 = 4 * 32, PER_E = 2 * I1 + I2;
    for (int it = gw; it < NE1 * PER_E; it += NGW) {
        const int e = it / PER_E; int r = it % PER_E;
        unsigned char* d1 = (unsigned char*)(F.ws + WS_EXP1) + (size_t)e * 512 * DM; unsigned char* d2 = (unsigned char*)(F.ws + WS_EXP2) + (size_t)e * DM * EH;
        if (r < 2 * I1) { const int up = r >= I1; if (up) r -= I1; const int kb = r / 8, nb = r % 8;
            const float* src = e < NEXP ? F.in[up ? I_WEU : I_WEG] + ((size_t)l * NEXP + e) * DM * EH : F.in[up ? I_WSU : I_WSG] + (size_t)l * DM * EH;
            tr_item8(src, EH, kb * 64, nb * 32, d1, DM, RowGU{up}, WEXP_SCALE, scr, F.lane); }
        else { r -= 2 * I1; const int kb = r / 32, nb = r % 32;
            const float* src = e < NEXP ? F.in[I_WED] + ((size_t)l * NEXP + e) * EH * DM : F.in[I_WSD] + (size_t)l * EH * DM;
            tr_item8(src, DM, kb * 64, nb * 32, d2, EH, RowId{}, WEXP_SCALE, scr, F.lane); }
    }
}

__device__ __forceinline__ f32x4 mfma16(bf16x8 a, bf16x8 b, f32x4 c) { return __builtin_amdgcn_mfma_f32_16x16x32_bf16(a, b, c, 0, 0, 0); }

__device__ __forceinline__ void ph_transposes(Frame& F, int l) {
    LAS bf16_t* tile = (LAS bf16_t*)(F.lds + F.wave * 16384);
    const bf16_t* U = (const bf16_t*)(F.ws + WS_U);
    const int gw = F.wg * NWAVES + F.wave, NGW = F.G * NWAVES;
    const int rsub = F.lane >> 3, cseg = F.lane & 7;
    for (int u = gw; u < 1088 * 20; u += NGW) {
        const int tt = u / 20, blk = u % 20;
        int b, s0, Ls, rowbase, posbase;
        if (tt < 1024) { b = tt >> 6; s0 = (tt & 63) * 64; Ls = SEQ; rowbase = b * SEQ; posbase = 0; }
        else { const int t2 = tt - 1024; b = t2 >> 2; s0 = (t2 & 3) * 64; Ls = CTXL; rowbase = NLAT + b * CTXL; posbase = SEQ; }
        if (blk < 12) {
            const int c0 = blk * 64 + cseg * 8;
            float w0[8], w1[8], w2[8], bb[8];
#pragma unroll
            for (int i = 0; i < 8; ++i) { w0[i] = F.in[I_HSW][(l * 3 + 0) * 768 + c0 + i]; w1[i] = F.in[I_HSW][(l * 3 + 1) * 768 + c0 + i]; w2[i] = F.in[I_HSW][(l * 3 + 2) * 768 + c0 + i]; bb[i] = F.in[I_HSB][l * 768 + c0 + i]; }
#pragma unroll 2
            for (int it = 0; it < 8; ++it) {
                const int sl = rsub + 8 * it, s = s0 + sl;
                const bf16_t* p = U + (size_t)(rowbase + s) * DIN + UHY + c0;
                const u32x4 zc = *(const GAS u32x4*)p;
                u32x4 zm = (u32x4){0u, 0u, 0u, 0u}, zp = (u32x4){0u, 0u, 0u, 0u};
                if (s > 0) zm = *(const GAS u32x4*)(p - DIN);
                if (s < Ls - 1) zp = *(const GAS u32x4*)(p + DIN);
                const unsigned am[4] = {zm.x, zm.y, zm.z, zm.w}, ac[4] = {zc.x, zc.y, zc.z, zc.w}, ap[4] = {zp.x, zp.y, zp.z, zp.w};
#pragma unroll
                for (int i = 0; i < 4; ++i) {
                    const float v0 = bb[2 * i] + w0[2 * i] * bflo(am[i]) + w1[2 * i] * bflo(ac[i]) + w2[2 * i] * bflo(ap[i]);
                    const float v1 = bb[2 * i + 1] + w0[2 * i + 1] * bfhi(am[i]) + w1[2 * i + 1] * bfhi(ac[i]) + w2[2 * i + 1] * bfhi(ap[i]);
                    tile[(cseg * 8 + 2 * i) * 72 + sl] = (bf16_t)f2bf(v0); tile[(cseg * 8 + 2 * i + 1) * 72 + sl] = (bf16_t)f2bf(v1);
                }
            }
        } else {
            const int c0 = (blk - 12) * 64 + cseg * 8;
#pragma unroll 2
            for (int it = 0; it < 8; ++it) {
                const int sl = rsub + 8 * it, s = s0 + sl;
                const u32x4 zc = *(const GAS u32x4*)(U + (size_t)(rowbase + s) * DIN + UV + c0);
                const unsigned ac[4] = {zc.x, zc.y, zc.z, zc.w};
#pragma unroll
                for (int i = 0; i < 4; ++i) { tile[(cseg * 8 + 2 * i) * 72 + sl] = (bf16_t)(ac[i] & 0xffffu); tile[(cseg * 8 + 2 * i + 1) * 72 + sl] = (bf16_t)(ac[i] >> 16); }
            }
        }
        LDS_WAIT(); asm volatile("" ::: "memory");
#pragma unroll 2
        for (int it = 0; it < 8; ++it) {
            const int ch = rsub + 8 * it;
            const u32x4 v = *(const LAS u32x4*)(tile + ch * 72 + cseg * 8);
            bf16_t* dst;
            if (blk < 12) dst = (bf16_t*)(F.ws + WS_HV) + ((size_t)(blk * 64 + ch) * NB + b) * SPB + posbase + s0 + cseg * 8;
            else dst = (bf16_t*)(F.ws + WS_VT) + ((size_t)b * 512 + (blk - 12) * 64 + ch) * SPB + posbase + s0 + cseg * 8;
            *(GAS u32x4*)dst = v;
        }
        LDS_WAIT(); asm volatile("" ::: "memory");
    }
}

constexpr int NA_RPB = 0, NA_KC = 2048, NA_VC = NA_KC + 256 * 144, NA_KR = NA_VC + 64 * 528, NA_END = NA_KR + 9 * 64 * 144;
static_assert(NA_END <= MISC_OFF, "NA LDS map");
__device__ __forceinline__ bf16x8 gld16(const bf16_t* p) { return *(const GAS bf16x8*)p; }
__device__ __forceinline__ u32x2 gld8(const bf16_t* p) { return *(const GAS u32x2*)p; }
__device__ __forceinline__ const char* uni_ptr(const char* p) { const unsigned long long v = (unsigned long long)p; const unsigned lo = __builtin_amdgcn_readfirstlane((unsigned)v), hi = __builtin_amdgcn_readfirstlane((unsigned)(v >> 32)); return (const char*)(((unsigned long long)hi << 32) | lo); }
__device__ __forceinline__ bf16x8 gld16o(const char* ub, unsigned lo) { return *(const GAS bf16x8*)(ub + (size_t)lo); }
__device__ __forceinline__ u32x2 gld8o(const char* ub, unsigned lo) { return *(const GAS u32x2*)(ub + (size_t)lo); }
template <bool WIN>
__device__ __forceinline__ void na_unit(Frame& F, int b, int h, int r, int strip) {
    const bf16_t* U = (const bf16_t*)(F.ws + WS_U);
    const bf16_t* VT = (const bf16_t*)(F.ws + WS_VT) + ((size_t)b * 512 + h * 64) * SPB;
    const LAS float* rpb = (const LAS float*)(F.lds + NA_RPB);
    const LAS bf16_t* KC = (const LAS bf16_t*)(F.lds + NA_KC); const LAS bf16_t* VC = (const LAS bf16_t*)(F.lds + NA_VC);
    int ln_ = F.lane; asm volatile("" : "+v"(ln_));
    const int i = ln_ & 15, g = ln_ >> 4;
    const int qrow0 = WIN ? (b * SEQ + r * 64 + strip * 16) : (NLAT + b * CTXL + strip * 16);
    const int ki = 8 * (i >> 2) + (i & 3);
    const unsigned qlo = (unsigned)((i * DIN + 8 * g) * 2), klo = (unsigned)((ki * DIN + 8 * g) * 2), vlo = (unsigned)((i * SPB + 8 * g) * 2);
    const char* qb = uni_ptr((const char*)(U + (size_t)qrow0 * DIN + UQ + h * 64));
    const bf16x8 q0 = gld16o(qb, qlo), q1 = gld16o(qb + 64, qlo);
    int kr0 = 0, u0 = 0;
    if (WIN) { kr0 = r - 4; kr0 = kr0 < 0 ? 0 : (kr0 > 56 ? 56 : kr0); u0 = strip == 0 ? 0 : (strip == 1 ? 8 : (strip == 2 ? 24 : 32)); }
    const LAS bf16_t* KR = (const LAS bf16_t*)(F.lds + NA_KR);
    const char* vbase = uni_ptr((const char*)(VT + kr0 * 64 + u0));
    f32x4 o[4];
#pragma unroll
    for (int d = 0; d < 4; ++d) o[d] = (f32x4){0.f, 0.f, 0.f, 0.f};
    float lsum = 0.f;
#define NA_SB() __builtin_amdgcn_sched_barrier(0)
#define NA_WLOAD(vb_, cw) do { _Pragma("unroll") for (int d = 0; d < 4; ++d) vb_[d] = gld16o(vbase + ((size_t)(d * 16) * SPB + (cw) * 64) * 2, vlo); } while (0)
#define NA_KRING(kb_, cw) do { const LAS bf16_t* kp = KR + ((((kr0 + (cw)) % 9) * 64 + u0 + ki) * 72 + 8 * g); kb_[0][0] = *(const LAS bf16x8*)kp; kb_[0][1] = *(const LAS bf16x8*)(kp + 32); \
        kb_[1][0] = *(const LAS bf16x8*)(kp + 4 * 72); kb_[1][1] = *(const LAS bf16x8*)(kp + 4 * 72 + 32); } while (0)
#define NA_QK(kb_, s_) do { _Pragma("unroll") for (int t = 0; t < 2; ++t) { f32x4 a = (f32x4){0.f, 0.f, 0.f, 0.f}; a = mfma16(kb_[t][0], q0, a); a = mfma16(kb_[t][1], q1, a); s_[t] = a; } } while (0)
#define NA_PV(s_, vb_) do { u32x4 pw; pw.x = pk2(s_[0][0], s_[0][1]); pw.y = pk2(s_[0][2], s_[0][3]); pw.z = pk2(s_[1][0], s_[1][1]); pw.w = pk2(s_[1][2], s_[1][3]); const bf16x8 pf = __builtin_bit_cast(bf16x8, pw); \
        _Pragma("unroll") for (int d = 0; d < 4; ++d) o[d] = mfma16(vb_[d], pf, o[d]); } while (0)
    bf16x8 vA[4], vB[4], vC[4];
    if (WIN) { NA_WLOAD(vA, 0); NA_WLOAD(vB, 1); NA_WLOAD(vC, 2); NA_SB(); }
#pragma unroll
    for (int cc = 0; cc < 8; ++cc) {
        bf16x8 kc[2][2], vc[4]; f32x4 sc[2];
#pragma unroll
        for (int t = 0; t < 2; ++t) { const LAS bf16_t* kp = KC + (cc * 32 + ki + 4 * t) * 72 + 8 * g; kc[t][0] = *(const LAS bf16x8*)kp; kc[t][1] = *(const LAS bf16x8*)(kp + 32); }
#pragma unroll
        for (int d = 0; d < 4; ++d) vc[d] = *(const LAS bf16x8*)(VC + (d * 16 + i) * 264 + cc * 32 + 8 * g);
        NA_QK(kc, sc);
#pragma unroll
        for (int t = 0; t < 2; ++t)
#pragma unroll
            for (int e = 0; e < 4; ++e) { const float p = __expf(fminf(sc[t][e] * 0.125f, 60.f)); sc[t][e] = p; lsum += p; }
        NA_PV(sc, vc);
    }
    if (WIN) {
        const int c = strip * 16 + i; int kc0 = c - 8; kc0 = kc0 < 0 ? 0 : (kc0 > 48 ? 48 : kc0);
        int dcl[2][4]; bool okm[2][4];
#pragma unroll
        for (int t = 0; t < 2; ++t)
#pragma unroll
            for (int e = 0; e < 4; ++e) { const int kc = u0 + 8 * g + 4 * t + e; okm[t][e] = (kc >= kc0) && (kc < kc0 + 16); int dc = kc - c + 15; dcl[t][e] = dc < 0 ? 0 : (dc > 30 ? 30 : dc); }
#define NA_WCHUNK(vb_, cw) do { bf16x8 kw[2][2]; NA_KRING(kw, cw); f32x4 sw[2]; NA_QK(kw, sw); const LAS float* rp = rpb + (kr0 + (cw) - r + 7) * 31; \
        _Pragma("unroll") for (int t = 0; t < 2; ++t) _Pragma("unroll") for (int e = 0; e < 4; ++e) { const float x = sw[t][e] * 0.125f + rp[dcl[t][e]]; const float p = okm[t][e] ? __expf(fminf(x, 60.f)) : 0.f; sw[t][e] = p; lsum += p; } \
        NA_PV(sw, vb_); } while (0)
        NA_WCHUNK(vA, 0); NA_SB(); NA_WLOAD(vA, 3); NA_SB();
        NA_WCHUNK(vB, 1); NA_SB(); NA_WLOAD(vB, 4); NA_SB();
        NA_WCHUNK(vC, 2); NA_SB(); NA_WLOAD(vC, 5); NA_SB();
        NA_WCHUNK(vA, 3); NA_SB(); NA_WLOAD(vA, 6); NA_SB();
        NA_WCHUNK(vB, 4); NA_SB(); NA_WLOAD(vB, 7); NA_SB();
        NA_WCHUNK(vC, 5); NA_SB();
        NA_WCHUNK(vA, 6); NA_SB();
        NA_WCHUNK(vB, 7); NA_SB();
#undef NA_WCHUNK
    }
    lsum += shx(lsum, 16, ln_); lsum += shx(lsum, 32, ln_);
    const float inv = 1.0f / lsum;
    char* op = (char*)uni_ptr((const char*)((bf16_t*)(F.ws + WS_MIX) + (size_t)qrow0 * DM + h * 64)); const unsigned olo = (unsigned)((i * DM + 4 * g) * 2);
#pragma unroll
    for (int d = 0; d < 4; ++d) { u32x2 w; w.x = pk2(o[d][0] * inv, o[d][1] * inv); w.y = pk2(o[d][2] * inv, o[d][3] * inv); *(GAS u32x2*)(op + d * 32 + (size_t)olo) = w; }
#undef NA_SB
#undef NA_WLOAD
#undef NA_KRING
#undef NA_QK
#undef NA_PV
}
__device__ __forceinline__ int na_kr0(int r) { const int k = r - 4; return k < 0 ? 0 : (k > 56 ? 56 : k); }
__device__ __forceinline__ void ph_na(Frame& F, int l, bool last) {
    const bf16_t* U = (const bf16_t*)(F.ws + WS_U);
    for (int job = F.wg; job < NB * 8 * 2; job += F.G) {
        const int half = job & 1, h = (job >> 1) & 7, b = job >> 4;
        int tz_; asm volatile("v_mbcnt_lo_u32_b32 %0, -1, 0\n\tv_mbcnt_hi_u32_b32 %0, -1, %0" : "=v"(tz_)); tz_ |= F.wave << 6;
        const bf16_t* krow = U + (size_t)(b * SEQ + (tz_ >> 3)) * DIN + UK + h * 64 + (tz_ & 7) * 8;
        LAS bf16_t* kdst = (LAS bf16_t*)(F.lds + NA_KR) + (tz_ >> 3) * 72 + (tz_ & 7) * 8;
        __syncthreads();
        { LAS float* rpb = (LAS float*)(F.lds + NA_RPB); const float* rsrc = F.in[I_RPB] + ((size_t)l * 8 + h) * 15 * 31;
          if (tz_ < 15 * 31) rpb[tz_] = rsrc[tz_];
          const int key = tz_ >> 1, hf = tz_ & 1; const bf16_t* src = U + (size_t)(NLAT + b * CTXL + key) * DIN + UK + h * 64 + hf * 32; LAS bf16_t* dst = (LAS bf16_t*)(F.lds + NA_KC) + key * 72 + hf * 32;
#pragma unroll
          for (int j = 0; j < 4; ++j) *(LAS bf16x8*)(dst + j * 8) = gld16(src + j * 8);
          const int dv = tz_ >> 3, seg = tz_ & 7; const bf16_t* vs = (const bf16_t*)(F.ws + WS_VT) + ((size_t)b * 512 + h * 64 + dv) * SPB + SEQ + seg * 32; LAS bf16_t* vd = (LAS bf16_t*)(F.lds + NA_VC) + dv * 264 + seg * 32;
#pragma unroll
          for (int j = 0; j < 4; ++j) *(LAS bf16x8*)(vd + j * 8) = gld16(vs + j * 8);
          const int lo = na_kr0(half * 32), hi0 = na_kr0(half * 32 + 1) + 7;
          for (int kr = lo; kr <= hi0; ++kr) *(LAS bf16x8*)(kdst + (kr % 9) * 64 * 72) = gld16(krow + (size_t)kr * 64 * DIN); }
        __syncthreads();
        int prev_hi = na_kr0(half * 32 + 1) + 7;
#pragma unroll 1
        for (int s = 0; s < 16; ++s) {
            const int r0 = half * 32 + 2 * s;
            const int nhi = s < 15 ? na_kr0(r0 + 3) + 7 : prev_hi;
            bf16x8 n0 = (bf16x8){0, 0, 0, 0, 0, 0, 0, 0}, n1 = n0;
            if (nhi > prev_hi) n0 = gld16(krow + (size_t)(prev_hi + 1) * 64 * DIN);
            if (nhi > prev_hi + 1) n1 = gld16(krow + (size_t)(prev_hi + 2) * 64 * DIN);
            na_unit<true>(F, b, h, r0 + (F.wave >> 2), F.wave & 3);
            __syncthreads();
            if (nhi > prev_hi) *(LAS bf16x8*)(kdst + ((prev_hi + 1) % 9) * 64 * 72) = n0;
            if (nhi > prev_hi + 1) *(LAS bf16x8*)(kdst + ((prev_hi + 2) % 9) * 64 * 72) = n1;
            __syncthreads();
            prev_hi = nhi;
        }
        if (!last) na_unit<false>(F, b, h, 0, half * 8 + F.wave);
    }
}

__device__ __forceinline__ void ph_hy_transpose(Frame& F, bool last) {
    LAS bf16_t* tile = (LAS bf16_t*)(F.lds + F.wave * 16384);
    const bf16_t* HYO = (const bf16_t*)(F.ws + WS_Y);
    const int gw = F.wg * NWAVES + F.wave, NGW = F.G * NWAVES;
    const int rsub = F.lane >> 3, cseg = F.lane & 7;
    const int ntt = last ? 1024 : 1088;
    for (int u = gw; u < ntt * 4; u += NGW) {
        const int tt = u >> 2, cb = u & 3;
        int b, s0, rowbase, posbase;
        if (tt < 1024) { b = tt >> 6; s0 = (tt & 63) * 64; rowbase = b * SEQ; posbase = 0; }
        else { const int t2 = tt - 1024; b = t2 >> 2; s0 = (t2 & 3) * 64; rowbase = NLAT + b * CTXL; posbase = SEQ; }
#pragma unroll 2
        for (int it = 0; it < 8; ++it) { const int c = rsub + 8 * it;
            const u32x4 v = *(const GAS u32x4*)(HYO + ((size_t)(cb * 64 + c) * NB + b) * SPB + posbase + s0 + cseg * 8); const unsigned a[4] = {v.x, v.y, v.z, v.w};
#pragma unroll
            for (int e = 0; e < 4; ++e) { tile[(cseg * 8 + 2 * e) * 72 + c] = (bf16_t)(a[e] & 0xffffu); tile[(cseg * 8 + 2 * e + 1) * 72 + c] = (bf16_t)(a[e] >> 16); } }
        LDS_WAIT(); asm volatile("" ::: "memory");
#pragma unroll 2
        for (int it = 0; it < 8; ++it) { const int p = rsub + 8 * it;
            const u32x4 v = *(const LAS u32x4*)(tile + p * 72 + cseg * 8);
            *(GAS u32x4*)((bf16_t*)(F.ws + WS_MIX) + (size_t)(rowbase + s0 + p) * DM + 768 + cb * 64 + cseg * 8) = v; }
        LDS_WAIT(); asm volatile("" ::: "memory");
    }
}

constexpr int G2_LAF = 0, G2_LAB = 8448;
constexpr int G2_QTF = 16896, G2_KTF = 22016, G2_QTB = 27136, G2_KTB = 32256;
constexpr int G2_VT = 37376, G2_ATT = 46592;
constexpr int G2_SF = 55808, G2_SB = 60928;
constexpr int G2_SEG = 66048, G2_HALF = 67328;
__device__ __forceinline__ float log_sigmoid_f(float x) { return fminf(x, 0.f) - __logf(1.0f + __expf(-fabsf(x))); }
__device__ __forceinline__ f32x4 mma_lds(const LAS bf16_t* A, int lda, const LAS bf16_t* B, int ldb, int ksteps, f32x4 acc, int lane) {
    const int r = lane & 15, g = lane >> 4;
    for (int ks = 0; ks < ksteps; ++ks) { const bf16x8 a = *(const LAS bf16x8*)(A + r * lda + ks * 32 + 8 * g), b = *(const LAS bf16x8*)(B + r * ldb + ks * 32 + 8 * g); acc = mfma16(a, b, acc); }
    return acc;
}
__device__ __forceinline__ int gla_row0(int b, int cn) { return cn >= 4 ? b * SEQ + (cn - 4) * 64 : NLAT + b * CTXL + cn * 64; }
struct GlaRaw { u32x4 q, k, f, b, v0, v1, g0, g1, s0, s1; };
template <bool FULL>
__device__ __forceinline__ GlaRaw gla_load(Frame& F, int u, int tl) {
    const int h = u & 3, cn = (u >> 2) % 68, b = (u >> 2) / 68, i = tl >> 2, part = tl & 3;
    const bf16_t* p = (const bf16_t*)(F.ws + WS_U) + (size_t)(gla_row0(b, cn) + i) * DIN;
    GlaRaw r;
    r.q = *(const GAS u32x4*)(p + UGQ + h * 32 + part * 8); r.k = *(const GAS u32x4*)(p + UGK + h * 32 + part * 8);
    r.f = *(const GAS u32x4*)(p + ULAF + h * 32 + part * 8); r.b = *(const GAS u32x4*)(p + ULAB + h * 32 + part * 8);
    r.v0 = *(const GAS u32x4*)(p + UGV + h * 64 + part * 16); r.v1 = *(const GAS u32x4*)(p + UGV + h * 64 + part * 16 + 8);
    if (FULL) { r.g0 = *(const GAS u32x4*)(p + UGR + h * 64 + part * 16); r.g1 = *(const GAS u32x4*)(p + UGR + h * 64 + part * 16 + 8);
        const bf16_t* sp = (const bf16_t*)(F.ws + WS_GSIN) + (size_t)u * 2 * 2048 + tl * 16; r.s0 = *(const GAS u32x4*)sp; r.s1 = *(const GAS u32x4*)(sp + 8); }
    else { r.g0 = (u32x4){0u, 0u, 0u, 0u}; r.g1 = r.g0; r.s0 = r.g0; r.s1 = r.g0; }
    return r;
}
template <bool FULL>
__device__ __forceinline__ void gla_prep(Frame& F, LAS unsigned char* L, int l, int u, int tl, const GlaRaw& raw) {
    const int h = u & 3, cn = (u >> 2) % 68, i = tl >> 2, part = tl & 3, d8 = part * 8;
    LAS float* LAF = (LAS float*)(L + G2_LAF); LAS float* LAB = (LAS float*)(L + G2_LAB); LAS bf16_t* VT = (LAS bf16_t*)(L + G2_VT); LAS float* SEG = (LAS float*)(L + G2_SEG);
    float q[8], k[8], tf[8], tb[8];
    unpack8(raw.q, q); unpack8(raw.k, k); unpack8(raw.f, tf); unpack8(raw.b, tb);
    const float* ba = F.in[I_BA2] + (size_t)l * 256 + h * 32 + d8;
#pragma unroll
    for (int e = 0; e < 8; ++e) { q[e] *= 0.17677669529663687f; LAF[i * 33 + d8 + e] = log_sigmoid_f(tf[e] + ba[e]) * 0.0625f; LAB[i * 33 + d8 + e] = log_sigmoid_f(tb[e] + ba[128 + e]) * 0.0625f; }
    if (cn >= 4) {
        const float pos = (part >> 1) ? (float)i : (float)(cn - 4);
#pragma unroll
        for (int e = 0; e < 8; ++e) { const float ang = pos * __expf(-(float)e * (9.210340371976184f / 8.0f)); const float sn = __sinf(ang), cs = __cosf(ang);
            const float qo = shx(q[e], 1, F.lane), ko = shx(k[e], 1, F.lane);
            if (part & 1) { q[e] = qo * sn + q[e] * cs; k[e] = ko * sn + k[e] * cs; } else { q[e] = q[e] * cs - qo * sn; k[e] = k[e] * cs - ko * sn; } }
    }
    { const unsigned a[8] = {raw.v0.x, raw.v0.y, raw.v0.z, raw.v0.w, raw.v1.x, raw.v1.y, raw.v1.z, raw.v1.w};
#pragma unroll
      for (int e = 0; e < 8; ++e) { VT[(part * 16 + 2 * e) * 72 + i] = (bf16_t)(a[e] & 0xffffu); VT[(part * 16 + 2 * e + 1) * 72 + i] = (bf16_t)(a[e] >> 16); } }
    __syncthreads();
    { const int x = tl & 63, d = x & 31, dir = x >> 5, seg = tl >> 6; LAS float* LA = (dir ? LAB : LAF) + d; float cv[16];
#pragma unroll
      for (int kk = 0; kk < 16; ++kk) { const int p = seg * 16 + kk, ti = dir ? 63 - p : p; cv[kk] = LA[ti * 33]; }
#pragma unroll
      for (int kk = 1; kk < 16; ++kk) cv[kk] += cv[kk - 1];
#pragma unroll
      for (int kk = 0; kk < 16; ++kk) { const int p = seg * 16 + kk, ti = dir ? 63 - p : p; LA[ti * 33] = cv[kk]; }
      SEG[x * 5 + seg] = cv[15]; }
    __syncthreads();
    { const int x = tl & 63, d = x & 31, dir = x >> 5, seg = tl >> 6; LAS float* LA = (dir ? LAB : LAF) + d; float cv[16];
      const float t0 = SEG[x * 5 + 0], t1 = SEG[x * 5 + 1], t2 = SEG[x * 5 + 2];
      const float pre = seg == 0 ? 0.f : (seg == 1 ? t0 : (seg == 2 ? t0 + t1 : t0 + t1 + t2));
#pragma unroll
      for (int kk = 0; kk < 16; ++kk) { const int p = seg * 16 + kk, ti = dir ? 63 - p : p; cv[kk] = LA[ti * 33]; }
#pragma unroll
      for (int kk = 0; kk < 16; ++kk) { const int p = seg * 16 + kk, ti = dir ? 63 - p : p; LA[ti * 33] = cv[kk] + pre; } }
    __syncthreads();
    if (FULL) {
        unsigned wqf[4], wkf[4], wqb[4], wkb[4];
#pragma unroll
        for (int e = 0; e < 4; ++e) { const int d = d8 + 2 * e; const float f0 = LAF[i * 33 + d], f1 = LAF[i * 33 + d + 1], b0 = LAB[i * 33 + d], b1 = LAB[i * 33 + d + 1];
            wqf[e] = pk2(q[2 * e] * __expf(f0), q[2 * e + 1] * __expf(f1)); wkf[e] = pk2(k[2 * e] * __expf(-f0), k[2 * e + 1] * __expf(-f1));
            wqb[e] = pk2(q[2 * e] * __expf(b0), q[2 * e + 1] * __expf(b1)); wkb[e] = pk2(k[2 * e] * __expf(-b0), k[2 * e + 1] * __expf(-b1)); }
        *(LAS u32x4*)((LAS bf16_t*)(L + G2_QTF) + i * 40 + d8) = (u32x4){wqf[0], wqf[1], wqf[2], wqf[3]}; *(LAS u32x4*)((LAS bf16_t*)(L + G2_KTF) + i * 40 + d8) = (u32x4){wkf[0], wkf[1], wkf[2], wkf[3]};
        *(LAS u32x4*)((LAS bf16_t*)(L + G2_QTB) + i * 40 + d8) = (u32x4){wqb[0], wqb[1], wqb[2], wqb[3]}; *(LAS u32x4*)((LAS bf16_t*)(L + G2_KTB) + i * 40 + d8) = (u32x4){wkb[0], wkb[1], wkb[2], wkb[3]};
    } else {
        LAS bf16_t* KDF = (LAS bf16_t*)(L + G2_QTF); LAS bf16_t* KDB = (LAS bf16_t*)(L + G2_KTF);
#pragma unroll
        for (int e = 0; e < 8; ++e) { const int d = d8 + e; const float bf = LAF[i * 33 + d], bb = LAB[i * 33 + d], bfl = LAF[63 * 33 + d], bbl = LAB[0 * 33 + d];
            KDF[d * 72 + i] = (bf16_t)f2bf(k[e] * __expf(bfl - bf)); KDB[d * 72 + i] = (bf16_t)f2bf(k[e] * __expf(bbl - bb)); }
    }
    __syncthreads();
}
__device__ __forceinline__ void ph_gla_local(Frame& F, int l) {
    const int hw = F.wave >> 2, wl = F.wave & 3, tl = F.tid & 255; LAS unsigned char* L = F.lds + hw * G2_HALF;
    constexpr int NU = NB * 68 * 4;
    int pp = F.wg;
    GlaRaw raw = gla_load<false>(F, (pp * 2 + hw) < NU ? pp * 2 + hw : 0, tl);
    for (; pp * 2 < NU; pp += F.G) {
        const int u = pp * 2 + hw, un = (pp + F.G) * 2 + hw;
        const GlaRaw nraw = gla_load<false>(F, un < NU ? un : u, tl);
        __syncthreads();
        gla_prep<false>(F, L, l, u, tl, raw);
        const int g = F.lane >> 4, c = F.lane & 15;
        float* DS = (float*)(F.ws + WS_GDS) + (size_t)u * 2 * 2048;
#pragma unroll
        for (int kk = 0; kk < 4; ++kk) { const int tix = wl * 4 + kk, dir = tix >> 3, mt = (tix >> 1) & 3, nt = tix & 1;
            f32x4 a = (f32x4){0.f, 0.f, 0.f, 0.f};
            a = mma_lds((const LAS bf16_t*)(L + G2_VT) + mt * 16 * 72, 72, (const LAS bf16_t*)(L + (dir ? G2_KTF : G2_QTF)) + nt * 16 * 72, 72, 2, a, F.lane);
#pragma unroll
            for (int e = 0; e < 4; ++e) DS[dir * 2048 + (mt * 16 + 4 * g + e) * 32 + nt * 16 + c] = a[e]; }
        if (tl < 64) { const int d = tl & 31, dir = tl >> 5; ((float*)(F.ws + WS_GD))[(size_t)u * 64 + tl] = __expf(dir ? ((LAS float*)(L + G2_LAB))[0 * 33 + d] : ((LAS float*)(L + G2_LAF))[63 * 33 + d]); }
        raw = nraw;
    }
}
__device__ __forceinline__ void ph_gla_scan(Frame& F) {
    const int gt = F.wg * NTHR + F.tid, NGT = F.G * NTHR;
    const float* DS = (const float*)(F.ws + WS_GDS); const float* GD = (const float*)(F.ws + WS_GD); bf16_t* SIN = (bf16_t*)(F.ws + WS_GSIN);
    for (int w = gt; w < 128 * 1024; w += NGT) {
        const int chain = w >> 10, el = (w & 1023) * 2, dir = chain & 1, h = (chain >> 1) & 3, b = chain >> 3, d = el & 31;
        float s0 = 0.f, s1 = 0.f;
        for (int step = 0; step < 68; step += 4) {
            f32x2 ds[4], dd[4]; size_t uu[4];
#pragma unroll
            for (int q = 0; q < 4; ++q) { const int st_ = step + q; const int cn = dir ? (st_ < 4 ? 3 - st_ : 71 - st_) : st_;
                uu[q] = (size_t)(b * 68 + cn) * 4 + h;
                ds[q] = *(const GAS f32x2*)(DS + (uu[q] * 2 + dir) * 2048 + el); dd[q] = *(const GAS f32x2*)(GD + uu[q] * 64 + dir * 32 + d); }
#pragma unroll
            for (int q = 0; q < 4; ++q) { *(GAS unsigned*)(SIN + (uu[q] * 2 + dir) * 2048 + el) = pk2(s0, s1); s0 = dd[q].x * s0 + ds[q].x; s1 = dd[q].y * s1 + ds[q].y; }
        }
    }
}
__device__ __forceinline__ void ph_gla_out(Frame& F, int l, bool last) {
    const int hw = F.wave >> 2, wl = F.wave & 3, tl = F.tid & 255; LAS unsigned char* L = F.lds + hw * G2_HALF;
    const int NV = last ? NB * 64 * 4 : NB * 68 * 4;
#define GLA_UNIT(v) (last ? ((((v) >> 8) * 68 + 4 + (((v) & 255) >> 2)) * 4 + ((v) & 3)) : (v))
    int pp = F.wg;
    GlaRaw raw = gla_load<true>(F, GLA_UNIT((pp * 2 + hw) < NV ? pp * 2 + hw : 0), tl);
    for (; pp * 2 < NV; pp += F.G) {
        const int u = GLA_UNIT(pp * 2 + hw), vn = (pp + F.G) * 2 + hw;
        const GlaRaw nraw = gla_load<true>(F, vn < NV ? GLA_UNIT(vn) : u, tl);
        const int h = u & 3, cn = (u >> 2) % 68, b = (u >> 2) / 68;
        __syncthreads();
        gla_prep<true>(F, L, l, u, tl, raw);
        { const int dir = tl >> 7, dv = (tl >> 1) & 63, d16 = (tl & 1) * 16; LAS bf16_t* S = (LAS bf16_t*)(L + (dir ? G2_SB : G2_SF)) + dv * 40 + d16; *(LAS u32x4*)S = raw.s0; *(LAS u32x4*)(S + 8) = raw.s1; }
        const int g = F.lane >> 4, c = F.lane & 15;
        LAS bf16_t* ATT = (LAS bf16_t*)(L + G2_ATT);
#pragma unroll
        for (int kk = 0; kk < 4; ++kk) { const int tile = wl * 4 + kk, mt = tile >> 2, nt = tile & 3;
            f32x4 af = (f32x4){0.f, 0.f, 0.f, 0.f}, ab = af;
            af = mma_lds((const LAS bf16_t*)(L + G2_QTF) + mt * 16 * 40, 40, (const LAS bf16_t*)(L + G2_KTF) + nt * 16 * 40, 40, 1, af, F.lane);
            ab = mma_lds((const LAS bf16_t*)(L + G2_QTB) + mt * 16 * 40, 40, (const LAS bf16_t*)(L + G2_KTB) + nt * 16 * 40, 40, 1, ab, F.lane);
#pragma unroll
            for (int e = 0; e < 4; ++e) { const int ii = mt * 16 + 4 * g + e, j = nt * 16 + c; const float vv = (j <= ii ? af[e] : 0.f) + (j >= ii ? ab[e] : 0.f); ATT[ii * 72 + j] = (bf16_t)f2bf(vv); } }
        __syncthreads();
        LAS float* O = (LAS float*)(L + G2_LAF);
#pragma unroll
        for (int kk = 0; kk < 4; ++kk) { const int tile = wl * 4 + kk, mt = tile >> 2, nt = tile & 3;
            f32x4 a = (f32x4){0.f, 0.f, 0.f, 0.f};
            a = mma_lds(ATT + mt * 16 * 72, 72, (const LAS bf16_t*)(L + G2_VT) + nt * 16 * 72, 72, 2, a, F.lane);
            a = mma_lds((const LAS bf16_t*)(L + G2_QTF) + mt * 16 * 40, 40, (const LAS bf16_t*)(L + G2_SF) + nt * 16 * 40, 40, 1, a, F.lane);
            a = mma_lds((const LAS bf16_t*)(L + G2_QTB) + mt * 16 * 40, 40, (const LAS bf16_t*)(L + G2_SB) + nt * 16 * 40, 40, 1, a, F.lane);
#pragma unroll
            for (int e = 0; e < 4; ++e) O[(mt * 16 + 4 * g + e) * 65 + nt * 16 + c] = a[e]; }
        __syncthreads();
        { const int i = tl >> 2, dv16 = (tl & 3) * 16; const int row = gla_row0(b, cn) + i;
          float v[16], gt[16]; float ss = 0.f;
#pragma unroll
          for (int e = 0; e < 16; ++e) { v[e] = O[i * 65 + dv16 + e]; ss += v[e] * v[e]; }
          ss += shx(ss, 1, F.lane); ss += shx(ss, 2, F.lane);
          const float rs = 1.0f / sqrtf(ss * (1.0f / 64.0f) + LN_EPS);
          unpack8(raw.g0, gt); unpack8(raw.g1, gt + 8);
          const float* gn = F.in[I_GNORM] + l * 64 + dv16;
          unsigned w[8];
#pragma unroll
          for (int e = 0; e < 8; ++e) w[e] = pk2(v[2 * e] * rs * gn[2 * e] * silu_f(gt[2 * e]), v[2 * e + 1] * rs * gn[2 * e + 1] * silu_f(gt[2 * e + 1]));
          bf16_t* mp = (bf16_t*)(F.ws + WS_MIX) + (size_t)row * DM + 512 + h * 64 + dv16;
          *(GAS u32x4*)mp = (u32x4){w[0], w[1], w[2], w[3]}; *(GAS u32x4*)(mp + 8) = (u32x4){w[4], w[5], w[6], w[7]}; }
        raw = nraw;
    }
#undef GLA_UNIT
}

template <int L>
__device__ __forceinline__ void hyena_conv(Frame& F, const bf16_t* Rg, const bf16_t* Uin, const bf16_t* Xmul, int pos0, bool final_out, int ch, bf16_t* Zout) {
    constexpr int CS = 2 * L + 16;
    constexpr int NTL = L / 16, J = (NTL >= 64) ? 16 : 2, NGRP = NTL / J, HJ = J / 2, NSTEP = L / 32;
    LAS bf16_t* Rl = (LAS bf16_t*)F.lds;
    __syncthreads();
    for (int c = F.tid; c < 2 * L / 8; c += NTHR) { const u32x4 v = *(const GAS u32x4*)(Rg + 8 * c); const unsigned a[4] = {v.x, v.y, v.z, v.w};
#pragma unroll
        for (int rho = 0; rho < 8; ++rho) { LAS bf16_t* d = Rl + rho * CS + 8 * c + rho;
#pragma unroll
            for (int k = 0; k < 4; ++k) { d[2 * k] = (bf16_t)(a[k] & 0xffffu); d[2 * k + 1] = (bf16_t)(a[k] >> 16); } } }
    __syncthreads();
    int ln_ = F.lane; asm volatile("" : "+v"(ln_));
    const int i = ln_ & 15, g = ln_ >> 4, rho = i & 7;
    const LAS bf16_t* Rc = Rl + rho * CS + rho;
    for (int grp = F.wave; grp < NGRP; grp += NWAVES) {
        f32x4 acc[J]; bf16x8 fr[J];
        const int tb = grp * J * 16;
        const LAS bf16_t* Rb = Rc + (L - tb - i + 8 * g);
#pragma unroll
        for (int j = 0; j < J; ++j) { acc[j] = (f32x4){0.f, 0.f, 0.f, 0.f}; fr[j] = *(const LAS bf16x8*)(Rb - 16 * j); }
        const char* ub = (const char*)(Uin + pos0); const unsigned ulo = (unsigned)((i * SPB + 8 * g) * 2);
        constexpr int PF = (HJ >= 4) ? 4 : 1;
        bf16x8 bq[PF];
#pragma unroll
        for (int p = 0; p < PF; ++p) bq[p] = *(const GAS bf16x8*)(ub + (size_t)(ulo + (unsigned)p * 64u));
#pragma unroll 1
        for (int q = 0; q < NSTEP / HJ; ++q) {
#pragma unroll
            for (int m = 0; m < HJ; ++m) {
                const int n = q * HJ + m;
                const int nn = (n + PF < NSTEP) ? n + PF : 0;
                if (n > 0) { fr[(J - 2 * m) % J] = *(const LAS bf16x8*)(Rb + 32 * n); fr[(J + 1 - 2 * m) % J] = *(const LAS bf16x8*)(Rb + 32 * n - 16); }
                const bf16x8 bcur = bq[m % PF];
#pragma unroll
                for (int jj = 0; jj < J; ++jj) { const int j = (jj + 2) % J; acc[j] = mfma16(fr[(j + J - 2 * m) % J], bcur, acc[j]); }
                bq[m % PF] = *(const GAS bf16x8*)(ub + (size_t)(ulo + (unsigned)nn * 64u));
            }
        }
#pragma unroll
        for (int j = 0; j < J; ++j) { const int t0 = tb + j * 16 + 4 * g;
            const u32x2 xw = *(const GAS u32x2*)(Xmul + (size_t)i * SPB + pos0 + t0);
            const float y0 = acc[j][0] * bflo(xw.x), y1 = acc[j][1] * bfhi(xw.x), y2 = acc[j][2] * bflo(xw.y), y3 = acc[j][3] * bfhi(xw.y);
            if (!final_out) { u32x2 w; w.x = pk2(y0, y1); w.y = pk2(y2, y3); *(GAS u32x2*)(Zout + (size_t)i * SPB + pos0 + t0) = w; }
            else { u32x2 w; w.x = pk2(y0, y1); w.y = pk2(y2, y3); *(GAS u32x2*)((bf16_t*)(F.ws + WS_Y) + ((size_t)ch * NB + i) * SPB + pos0 + t0) = w; } }
    }
}
__device__ __forceinline__ void ph_hyena(Frame& F, int l, bool last) {
    const bf16_t* HV = (const bf16_t*)(F.ws + WS_HV); bf16_t* Z2 = (bf16_t*)(F.ws + WS_Z2);
    for (int ch = F.wg; ch < 256; ch += F.G) {
        const bf16_t* v = HV + (size_t)(0 * 256 + ch) * NB * SPB; const bf16_t* x1 = HV + (size_t)(256 + ch) * NB * SPB; const bf16_t* x2 = HV + (size_t)(512 + ch) * NB * SPB;
        bf16_t* z = Z2 + (size_t)ch * NB * SPB;
        const bf16_t* R0 = (const bf16_t*)(F.ws + WS_HYF) + ((size_t)(l * 2 + 0) * 256 + ch) * 8192; const bf16_t* R1 = (const bf16_t*)(F.ws + WS_HYF) + ((size_t)(l * 2 + 1) * 256 + ch) * 8192;
        hyena_conv<4096>(F, R0, v, x1, 0, false, ch, z);
        VM_WAIT(); __syncthreads(); __builtin_amdgcn_fence(__ATOMIC_ACQUIRE, "agent"); VM_WAIT();
        hyena_conv<4096>(F, R1, z, x2, 0, true, ch, z);
        if (!last) {
            const bf16_t* C0 = (const bf16_t*)(F.ws + WS_HYFC) + ((size_t)(l * 2 + 0) * 256 + ch) * 512; const bf16_t* C1 = (const bf16_t*)(F.ws + WS_HYFC) + ((size_t)(l * 2 + 1) * 256 + ch) * 512;
            hyena_conv<256>(F, C0, v, x1, SEQ, false, ch, z);
            VM_WAIT(); __syncthreads(); __builtin_amdgcn_fence(__ATOMIC_ACQUIRE, "agent"); VM_WAIT();
            hyena_conv<256>(F, C1, z, x2, SEQ, true, ch, z);
        }
    }
}

__device__ __forceinline__ void ph_ln1(Frame& F, int l, int ntok) {
    const int gw = F.wg * NWAVES + F.wave, NGW = F.G * NWAVES;
    const float* lg = F.in[I_LN1G] + l * DM + 16 * F.lane; const float* lb = F.in[I_LN1B] + l * DM + 16 * F.lane;
    for (int row = gw; row < ntok; row += NGW) {
        bf16_t* xr = (bf16_t*)(F.ws + WS_XR) + (size_t)row * DM + 16 * F.lane;
        const bf16_t* yr = (const bf16_t*)(F.ws + WS_Y) + (size_t)row * DM + 16 * F.lane;
        const float* md = mod_ptr(F, l, row) + 16 * F.lane;
        bf16_t* xm = (bf16_t*)(F.ws + WS_XM) + (size_t)row * DM + 16 * F.lane;
        const u32x4 xa = *(const GAS u32x4*)xr, xb = *(const GAS u32x4*)(xr + 8), ya = *(const GAS u32x4*)yr, yb = *(const GAS u32x4*)(yr + 8);
        float x[16], y[16], v[16]; unpack8(xa, x); unpack8(xb, x + 8); unpack8(ya, y); unpack8(yb, y + 8);
        float s = 0.f;
#pragma unroll
        for (int j = 0; j < 4; ++j) { const f32x4 g1 = *(const GAS f32x4*)(md + 2048 + 4 * j);
#pragma unroll
            for (int e = 0; e < 4; ++e) { v[4 * j + e] = x[4 * j + e] * DN_ALPHA + g1[e] * y[4 * j + e]; s += v[4 * j + e]; } }
        const float mean = wave_sum(s, F.lane) * (1.f / DM); float s2 = 0.f;
#pragma unroll
        for (int e = 0; e < 16; ++e) { v[e] -= mean; s2 += v[e] * v[e]; }
        const float rstd = 1.f / sqrtf(wave_sum(s2, F.lane) * (1.f / DM) + LN_EPS);
        unsigned wx[8], wm[8]; int w8[4];
#pragma unroll
        for (int j = 0; j < 4; ++j) { const f32x4 g = *(const GAS f32x4*)(lg + 4 * j), bb = *(const GAS f32x4*)(lb + 4 * j), sh = *(const GAS f32x4*)(md + 3072 + 4 * j), sc = *(const GAS f32x4*)(md + 4096 + 4 * j);
            float xn[4];
#pragma unroll
            for (int e = 0; e < 4; ++e) xn[e] = v[4 * j + e] * rstd * g[e] + bb[e];
            wx[2 * j] = pk2(xn[0], xn[1]); wx[2 * j + 1] = pk2(xn[2], xn[3]);
            const float h0 = xn[0] * (1.f + sc[0]) + sh[0], h1 = xn[1] * (1.f + sc[1]) + sh[1], h2 = xn[2] * (1.f + sc[2]) + sh[2], h3 = xn[3] * (1.f + sc[3]) + sh[3];
            wm[2 * j] = pk2(h0, h1); wm[2 * j + 1] = pk2(h2, h3);
            int v = 0; v = __builtin_amdgcn_cvt_pk_fp8_f32(h0, h1, v, false); v = __builtin_amdgcn_cvt_pk_fp8_f32(h2, h3, v, true); w8[j] = v; }
        *(GAS u32x4*)((unsigned char*)(F.ws + WS_XM8) + (size_t)row * DM + 16 * F.lane) = (u32x4){(unsigned)w8[0], (unsigned)w8[1], (unsigned)w8[2], (unsigned)w8[3]};
        *(GAS u32x4*)xr = (u32x4){wx[0], wx[1], wx[2], wx[3]}; *(GAS u32x4*)(xr + 8) = (u32x4){wx[4], wx[5], wx[6], wx[7]};
        *(GAS u32x4*)xm = (u32x4){wm[0], wm[1], wm[2], wm[3]}; *(GAS u32x4*)(xm + 8) = (u32x4){wm[4], wm[5], wm[6], wm[7]};
    }
}
__device__ __forceinline__ void ph_ln2(Frame& F, int l, int ntok, bool last) {
    const int gw = F.wg * NWAVES + F.wave, NGW = F.G * NWAVES;
    const int cA = 256 * (F.lane >> 4) + 32 * ((F.lane >> 2) & 3) + 8 * (F.lane & 3);
#define LN2_COL(j) (cA + ((j) < 2 ? 4 * (j) : 128 + 4 * ((j) - 2)))
    const float* lg = F.in[I_LN2G] + l * DM; const float* lb = F.in[I_LN2B] + l * DM;
    for (int row = gw; row < ntok; row += NGW) {
        bf16_t* xr = (bf16_t*)(F.ws + WS_XR) + (size_t)row * DM;
        const unsigned char* y2 = (const unsigned char*)(F.ws + WS_Y2) + (size_t)row * 9 * DM + 16 * F.lane;
        const float* wg = (const float*)(F.ws + WS_WGT) + (size_t)row * 8;
        const float* md = mod_ptr(F, l, row);
        float ff[16];
#pragma unroll
        for (int e = 0; e < 16; ++e) ff[e] = 0.f;
        u32x4 q[9];
#pragma unroll
        for (int k = 0; k < 9; ++k) q[k] = *(const GAS u32x4*)(y2 + (size_t)k * DM);
#pragma unroll
        for (int k = 0; k < 9; ++k) { const float wk = (k < 8 ? wg[k] : 1.0f) * pg8::Y2_INV; const unsigned a[4] = {q[k].x, q[k].y, q[k].z, q[k].w};
#pragma unroll
            for (int e = 0; e < 4; ++e) { const f32x2 lo = __builtin_amdgcn_cvt_pk_f32_fp8((int)a[e], false), hi = __builtin_amdgcn_cvt_pk_f32_fp8((int)a[e], true);
                ff[4 * e] += wk * lo.x; ff[4 * e + 1] += wk * lo.y; ff[4 * e + 2] += wk * hi.x; ff[4 * e + 3] += wk * hi.y; } }
        float v[16], xo[16]; float s = 0.f;
        { const u32x4 xa = *(const GAS u32x4*)(xr + cA), xb = *(const GAS u32x4*)(xr + cA + 128); unpack8(xa, xo); unpack8(xb, xo + 8); }
#pragma unroll
        for (int j = 0; j < 4; ++j) { const f32x4 g2 = *(const GAS f32x4*)(md + 5120 + LN2_COL(j));
#pragma unroll
            for (int e = 0; e < 4; ++e) { v[4 * j + e] = xo[4 * j + e] * DN_ALPHA + g2[e] * ff[4 * j + e]; s += v[4 * j + e]; } }
        const float mean = wave_sum(s, F.lane) * (1.f / DM); float s2 = 0.f;
#pragma unroll
        for (int e = 0; e < 16; ++e) { v[e] -= mean; s2 += v[e] * v[e]; }
        const float rstd = 1.f / sqrtf(wave_sum(s2, F.lane) * (1.f / DM) + LN_EPS);
        const float* mdn = last ? md : mod_ptr(F, l + 1, row);
        float xn[16];
#pragma unroll
        for (int j = 0; j < 4; ++j) { const f32x4 g = *(const GAS f32x4*)(lg + LN2_COL(j)), bb = *(const GAS f32x4*)(lb + LN2_COL(j));
#pragma unroll
            for (int e = 0; e < 4; ++e) xn[4 * j + e] = v[4 * j + e] * rstd * g[e] + bb[e]; }
        if (last) { float* op = F.out + (size_t)row * DM;
#pragma unroll
            for (int j = 0; j < 4; ++j) *(GAS f32x4*)(op + LN2_COL(j)) = (f32x4){xn[4 * j], xn[4 * j + 1], xn[4 * j + 2], xn[4 * j + 3]}; }
        else {
            *(GAS u32x4*)(xr + cA) = (u32x4){pk2(xn[0], xn[1]), pk2(xn[2], xn[3]), pk2(xn[4], xn[5]), pk2(xn[6], xn[7])}; *(GAS u32x4*)(xr + cA + 128) = (u32x4){pk2(xn[8], xn[9]), pk2(xn[10], xn[11]), pk2(xn[12], xn[13]), pk2(xn[14], xn[15])};
            bf16_t* xm = (bf16_t*)(F.ws + WS_XM) + (size_t)row * DM;
            unsigned w[8];
#pragma unroll
            for (int j = 0; j < 4; ++j) { const f32x4 sh = *(const GAS f32x4*)(mdn + LN2_COL(j)), sc = *(const GAS f32x4*)(mdn + 1024 + LN2_COL(j));
                w[2 * j] = pk2(xn[4 * j] * (1.f + sc[0]) + sh[0], xn[4 * j + 1] * (1.f + sc[1]) + sh[1]); w[2 * j + 1] = pk2(xn[4 * j + 2] * (1.f + sc[2]) + sh[2], xn[4 * j + 3] * (1.f + sc[3]) + sh[3]); }
            *(GAS u32x4*)(xm + cA) = (u32x4){w[0], w[1], w[2], w[3]}; *(GAS u32x4*)(xm + cA + 128) = (u32x4){w[4], w[5], w[6], w[7]};
        }
    }
#undef LN2_COL
}

__device__ __forceinline__ unsigned f_ord(float f) { const unsigned u = __builtin_bit_cast(unsigned, f); return (u & 0x80000000u) ? ~u : (u | 0x80000000u); }
__device__ __forceinline__ unsigned long long wave_max_u64(unsigned long long v, int lane) {
#pragma unroll
    for (int o = 1; o < 64; o <<= 1) { const unsigned lo = (unsigned)shxi((int)(unsigned)v, o, lane), hi = (unsigned)shxi((int)(unsigned)(v >> 32), o, lane); const unsigned long long w = ((unsigned long long)hi << 32) | lo; v = w > v ? w : v; }
    return v;
}
__device__ __forceinline__ float seg16_max(float v, int lane) { v = fmaxf(v, shx(v, 1, lane)); v = fmaxf(v, shx(v, 2, lane)); v = fmaxf(v, shx(v, 4, lane)); v = fmaxf(v, shx(v, 8, lane)); return v; }
__device__ __forceinline__ int seg16_min_i(int v, int lane) { int w; w = shxi(v, 1, lane); v = w < v ? w : v; w = shxi(v, 2, lane); v = w < v ? w : v; w = shxi(v, 4, lane); v = w < v ? w : v; w = shxi(v, 8, lane); v = w < v ? w : v; return v; }
__device__ __forceinline__ float seg16_top2(float v, int lane) {
    const float m1 = seg16_max(v, lane);
    const int first = seg16_min_i(v == m1 ? (lane & 15) : 99, lane);
    const float m2 = seg16_max((lane & 15) == first ? -3.0e38f : v, lane);
    return m1 + m2;
}
__device__ __forceinline__ void ph_route(Frame& F, int l, int ntok) {
    LAS int* hist = (LAS int*)F.lds;
    LAS int* base = hist + 128;
    LAS unsigned* alist = (LAS unsigned*)(F.lds + 1024);
    const int tpw = (ntok + F.G - 1) / F.G, t0 = F.wg * tpw, t1 = (t0 + tpw) < ntok ? (t0 + tpw) : ntok;
    __syncthreads();
    if (F.tid < 128) hist[F.tid] = 0;
    __syncthreads();
    const float* LG = (const float*)(F.ws + WS_LOGIT); const float* rb = F.in[I_RB] + l * NEXP;
    const float b0 = rb[F.lane], b1 = rb[F.lane + 64];
    constexpr int RT = 4;
    for (int tb = t0 + F.wave * RT; tb < t1; tb += NWAVES * RT) {
        float s0[RT], s1[RT], e0[RT], e1[RT], gs0[RT], gs1[RT]; unsigned long long k0[RT], k1[RT]; int mye[RT]; float myw[RT], wsum[RT];
#pragma unroll
        for (int j = 0; j < RT; ++j) { const int tok = (tb + j) < t1 ? tb + j : t1 - 1;
            const float x0 = LG[(size_t)tok * 256 + F.lane], x1 = LG[(size_t)tok * 256 + 64 + F.lane];
            s0[j] = __builtin_amdgcn_rcpf(1.0f + __expf(-x0)); s1[j] = __builtin_amdgcn_rcpf(1.0f + __expf(-x1)); e0[j] = s0[j] + b0; e1[j] = s1[j] + b1; }
#pragma unroll
        for (int j = 0; j < RT; ++j) { gs0[j] = seg16_top2(e0[j], F.lane); gs1[j] = seg16_top2(e1[j], F.lane); }
#pragma unroll
        for (int j = 0; j < RT; ++j) {
            float gsc[8];
#pragma unroll
            for (int g = 0; g < 4; ++g) { gsc[g] = shf(gs0[j], g * 16); gsc[4 + g] = shf(gs1[j], g * 16); }
            unsigned gmask = 0u;
#pragma unroll
            for (int g = 0; g < 8; ++g) { int cnt = 0;
#pragma unroll
                for (int g2 = 0; g2 < 8; ++g2) cnt += (gsc[g2] > gsc[g] || (gsc[g2] == gsc[g] && g2 < g)) ? 1 : 0;
                gmask |= (cnt < 4) ? (1u << g) : 0u; }
            const bool ok0 = (gmask >> (F.lane >> 4)) & 1u, ok1 = (gmask >> (4 + (F.lane >> 4))) & 1u;
            k0[j] = ok0 ? (((unsigned long long)f_ord(e0[j]) << 32) | (unsigned)(255 - F.lane)) : 0ull;
            k1[j] = ok1 ? (((unsigned long long)f_ord(e1[j]) << 32) | (unsigned)(255 - 64 - F.lane)) : 0ull;
            mye[j] = 0; myw[j] = 0.f; wsum[j] = 0.f; }
#pragma unroll
        for (int k = 0; k < 8; ++k) {
            unsigned long long best[RT];
#pragma unroll
            for (int j = 0; j < RT; ++j) best[j] = k0[j] > k1[j] ? k0[j] : k1[j];
#pragma unroll
            for (int o = 1; o < 64; o <<= 1) {
#pragma unroll
                for (int j = 0; j < RT; ++j) { const unsigned lo = (unsigned)shxi((int)(unsigned)best[j], o, F.lane), hi = (unsigned)shxi((int)(unsigned)(best[j] >> 32), o, F.lane);
                    const unsigned long long w = ((unsigned long long)hi << 32) | lo; best[j] = w > best[j] ? w : best[j]; } }
#pragma unroll
            for (int j = 0; j < RT; ++j) { const int e = 255 - (int)(best[j] & 0xffu);
                if (k0[j] == best[j]) k0[j] = 0ull; if (k1[j] == best[j]) k1[j] = 0ull;
                const float sv = shf(e < 64 ? s0[j] : s1[j], e & 63);
                wsum[j] += sv; if (F.lane == k) { mye[j] = e; myw[j] = sv; } }
        }
#pragma unroll
        for (int j = 0; j < RT; ++j) { const int tok = tb + j;
            if (tok < t1 && F.lane < 8) {
                const int lr = __hip_atomic_fetch_add(&hist[mye[j]], 1, __ATOMIC_RELAXED, __HIP_MEMORY_SCOPE_WORKGROUP);
                alist[(tok - t0) * 8 + F.lane] = (unsigned)mye[j] | ((unsigned)lr << 8);
                ((int*)(F.ws + WS_EIDX))[(size_t)tok * 8 + F.lane] = mye[j];
                ((float*)(F.ws + WS_WGT))[(size_t)tok * 8 + F.lane] = myw[j] / wsum[j] * 2.5f;
            } }
    }
    __syncthreads();
    if (F.tid < 128) { const int hcount = hist[F.tid]; base[F.tid] = hcount ? (int)atomicAdd(F.ctl + CW_CNT + l * 256 + F.tid, (unsigned)hcount) : 0; }
    __syncthreads();
    for (int a = F.tid; a < (t1 - t0) * 8; a += NTHR) { const unsigned v = alist[a]; ((int*)(F.ws + WS_RNK))[(size_t)t0 * 8 + a] = base[v & 0xffu] + (int)(v >> 8); }
}
__device__ __forceinline__ void ph_positions(Frame& F, int l, int ntok) {
    LAS int* cnt = (LAS int*)F.lds;
    LAS int* off = cnt + 132;
    __syncthreads();
    if (F.tid < NE1) cnt[F.tid] = F.tid < NEXP ? (int)__hip_atomic_load(F.ctl + CW_CNT + l * 256 + F.tid, __ATOMIC_RELAXED, __HIP_MEMORY_SCOPE_AGENT) : ntok;
    __syncthreads();
    if (F.tid == 0) { int o = 0; for (int e = 0; e < NE1; ++e) { off[e] = o; o += (cnt[e] + 255) & ~255; } off[NE1] = o; }
    __syncthreads();
    const int gt = F.wg * NTHR + F.tid, NGT = F.G * NTHR;
    int* rowtok = (int*)(F.ws + WS_ROWTOK); int* rowdst = (int*)(F.ws + WS_ROWDST); int* tile_exp = (int*)(F.ws + WS_TILEEXP);
    const int* eidx = (const int*)(F.ws + WS_EIDX); const int* rnk = (const int*)(F.ws + WS_RNK);
    for (int a = gt; a < ntok * 8; a += NGT) { const int tok = a >> 3, k = a & 7; const int pos = off[eidx[a]] + rnk[a]; rowtok[pos] = tok; rowdst[pos] = tok * 9 + k; }
    for (int tok = gt; tok < ntok; tok += NGT) { const int pos = off[NEXP] + tok; rowtok[pos] = tok; rowdst[pos] = tok * 9 + 8; }
    for (int i = gt; i < NE1 * 256; i += NGT) { const int e = i >> 8, p = i & 255; const int row = off[e] + cnt[e] + p; if (row < off[e + 1]) { rowtok[row] = 0; rowdst[row] = -1; } }
    for (int i = gt; i < NE1 * 320; i += NGT) { const int e = i / 320, p = i % 320; const int t = (off[e] >> 8) + p; if (t < (off[e + 1] >> 8)) tile_exp[t] = e; }
    if (gt == 0) F.ctl[CW_NTL + l] = (unsigned)(off[NE1] >> 8);
}

#ifndef MK_MULTI
#define MK_MULTI 0
#endif
constexpr int PH_PER_LAYER = 12, NPHASE = 2 + DEPTH * PH_PER_LAYER;
struct Args { const float* in[36]; float* out; unsigned char* ws; int ph_lo, ph_hi; };

__global__ void __launch_bounds__(NTHR, 2) mk_fwd(Args args) {
    extern __shared__ __attribute__((aligned(16))) unsigned char lds_raw[];
    Frame F;
    F.lds = (LAS unsigned char*)lds_raw;
    F.tid = threadIdx.x; F.lane = F.tid & 63; F.wave = __builtin_amdgcn_readfirstlane(F.tid >> 6);
    const int wave0 = F.wave;
    F.G = gridDim.x; F.wg = blockIdx.x;
    F.in = args.in;
    F.out = args.out; F.ws = args.ws; F.ctl = (unsigned*)(args.ws + WS_CTL);
    volatile LAS unsigned* MISC = (volatile LAS unsigned*)(F.lds + MISC_OFF);
    if (F.tid < 32) MISC[F.tid] = 0u;
    __syncthreads();
    const int lo = args.ph_lo, hi = args.ph_hi;
    const bool single = (hi - lo) > 1;
    XcdBarrier bar; bar.bar = F.ctl + CW_BAR; bar.x = 0; bar.st = nullptr;
    if (single) bar = xcd_barrier_post(F.ctl + CW_BAR, MISC + 8);
#define IN(k) (lo <= (k) && (k) < hi)
#ifndef PROBE_MASK
#define PROBE_MASK 0
#endif
#define REP(k) for (int _rep = 0; _rep < (((PROBE_MASK >> (k)) & 1) ? 2 : 1); ++_rep)
#define SEAM(k) do { if (IN(k) && IN((k) + 1)) { xcd_barrier(bar); if ((PROBE_MASK >> 15) & 1) xcd_barrier(bar); } } while (0)
#define FRESH() do { int _ln; asm volatile("v_mbcnt_lo_u32_b32 %0, -1, 0\n\tv_mbcnt_hi_u32_b32 %0, -1, %0" : "=v"(_ln)); int _wv = wave0; asm volatile("" : "+s"(_wv)); F.lane = _ln; F.wave = _wv; F.tid = (_wv << 6) | _ln; \
        unsigned char* _w = args.ws; asm volatile("" : "+s"(_w)); F.ws = _w; F.ctl = (unsigned*)(_w + WS_CTL); float* _o = args.out; asm volatile("" : "+s"(_o)); F.out = _o; } while (0)

    if (IN(0)) { FRESH(); REP(13) { p0_static_weights(F); __syncthreads(); } REP(14) { p0_mod(F); __syncthreads(); } FRESH(); REP(16) { p0_hyena_filters(F); __syncthreads(); } }
    SEAM(0);
    if (IN(1)) { FRESH(); p0_init_rows(F); }
    SEAM(1);
#pragma unroll 1
    for (int l = 0; l < DEPTH; ++l) {
        const int pb = 2 + l * PH_PER_LAYER; const bool last = (l == DEPTH - 1); const int ntok = last ? NLAT : NROW;
        if (IN(pb + 0)) { FRESH();
            REP(0) { p_expert_weights(F, l); __syncthreads(); }
            pg8::DenseOrder S; S.init(NROW, DIN, F.G, F.wg); pg8::EpiBf16 E{(bf16_t*)(F.ws + WS_U), DIN};
            REP(1) pg8::gemm_phase<pg8::EpiBf16, pg8::DenseOrder, false>(F.tid, F.lds, (const bf16_t*)(F.ws + WS_XM), (const bf16_t*)(F.ws + WS_WIN) + (size_t)l * DIN * DM, DM, nullptr, S, E);
        }
        SEAM(pb + 0);
        if (IN(pb + 1)) { FRESH(); REP(2) { ph_transposes(F, l); __syncthreads(); } FRESH(); REP(3) { ph_gla_local(F, l); __syncthreads(); } }
        SEAM(pb + 1);
        if (IN(pb + 2)) { FRESH(); REP(4) { ph_na(F, l, last); } FRESH(); REP(5) { ph_gla_scan(F); } __syncthreads(); FRESH(); REP(6) { ph_hyena(F, l, last); } }
        SEAM(pb + 2);
        if (IN(pb + 3)) { FRESH(); ph_hy_transpose(F, last); __syncthreads(); FRESH(); REP(7) { ph_gla_out(F, l, last); } }
        SEAM(pb + 3);
        if (IN(pb + 4)) { FRESH();
            pg8::DenseOrder S; S.init(ntok, DM, F.G, F.wg); pg8::EpiBf16 E{(bf16_t*)(F.ws + WS_Y), DM};
            REP(8) pg8::gemm_phase<pg8::EpiBf16, pg8::DenseOrder, false>(F.tid, F.lds, (const bf16_t*)(F.ws + WS_MIX), (const bf16_t*)(F.ws + WS_WOUT) + (size_t)l * DM * DM, DM, nullptr, S, E);
        }
        SEAM(pb + 4);
        if (IN(pb + 5)) { FRESH(); ph_ln1(F, l, ntok); }
        SEAM(pb + 5);
        if (IN(pb + 6)) { FRESH();
            pg8::DenseOrder S; S.init(ntok, 256, F.G, F.wg); pg8::EpiF32H E{(float*)(F.ws + WS_LOGIT), 256};
            REP(9) pg8::gemm_phase<pg8::EpiF32H, pg8::DenseOrder, false, false, true, true, true>(F.tid, F.lds, (const bf16_t*)(F.ws + WS_XM), (const bf16_t*)(F.ws + WS_WR) + (size_t)l * 256 * DM, DM, nullptr, S, E);
        }
        SEAM(pb + 6);
        if (IN(pb + 7)) { FRESH(); ph_route(F, l, ntok); }
        SEAM(pb + 7);
        if (IN(pb + 8)) { FRESH(); REP(12) { ph_positions(F, l, ntok); __syncthreads(); } }
        SEAM(pb + 8);
        if (IN(pb + 9)) { FRESH();
            const int ntl = (int)__hip_atomic_load(F.ctl + CW_NTL + l, __ATOMIC_RELAXED, __HIP_MEMORY_SCOPE_AGENT);
            pg8::GroupedOrder S; S.init(ntl, 2, F.G, F.wg); S.preload((const int*)(F.ws + WS_TILEEXP), F.lds + pg8::STAGE_BYTES + 4096, F.tid, NTHR); pg8::EpiSwiglu E{(unsigned char*)(F.ws + WS_ACT)};
            REP(10) pg8::gemm_phase<pg8::EpiSwiglu, pg8::GroupedOrder, true, true>(F.tid, F.lds, (const void*)(F.ws + WS_XM8), (const void*)(F.ws + WS_EXP1), DM, (const int*)(F.ws + WS_ROWTOK), S, E);
        }
        SEAM(pb + 9);
        if (IN(pb + 10)) { FRESH();
            const int ntl = (int)__hip_atomic_load(F.ctl + CW_NTL + l, __ATOMIC_RELAXED, __HIP_MEMORY_SCOPE_AGENT);
            pg8::GroupedOrder S; S.init(ntl, 4, F.G, F.wg); S.preload((const int*)(F.ws + WS_TILEEXP), F.lds + pg8::STAGE_BYTES + 4096, F.tid, NTHR); pg8::EpiScatter E{(unsigned char*)(F.ws + WS_Y2), (const int*)(F.ws + WS_ROWDST)};
            REP(11) pg8::gemm_phase<pg8::EpiScatter, pg8::GroupedOrder, false, true>(F.tid, F.lds, (const void*)(F.ws + WS_ACT), (const void*)(F.ws + WS_EXP2), EH, nullptr, S, E);
        }
        SEAM(pb + 10);
        if (IN(pb + 11)) { FRESH(); ph_ln2(F, l, ntok, last); }
        SEAM(pb + 11);
    }
#undef IN
#undef SEAM
#undef FRESH
}

extern "C" void kernel_launch(void* const* d_in, const int* in_sizes, int n_in, void* d_out, int out_size, void* d_ws, size_t ws_size, hipStream_t stream) {
    static int grid = 0;
    if (grid == 0) {
        if (n_in != 36 || out_size != NLAT * DM || ws_size < WS_END) { fprintf(stderr, "kernel_launch: unexpected shapes (n_in %d out %d ws %zu need %zu)\n", n_in, out_size, ws_size, (size_t)WS_END); grid = -1; return; }
        int dev = 0, cus = 0, per_cu = 0;
        if (hipGetDevice(&dev) != hipSuccess || hipDeviceGetAttribute(&cus, hipDeviceAttributeMultiprocessorCount, dev) != hipSuccess) { grid = -1; return; }
        if (hipFuncSetAttribute((const void*)mk_fwd, hipFuncAttributeMaxDynamicSharedMemorySize, LDS_BYTES) != hipSuccess) { fprintf(stderr, "kernel_launch: hipFuncSetAttribute failed\n"); grid = -1; return; }
        if (hipOccupancyMaxActiveBlocksPerMultiprocessor(&per_cu, (const void*)mk_fwd, NTHR, LDS_BYTES) != hipSuccess || per_cu < 1) { fprintf(stderr, "kernel_launch: occupancy query says %d\n", per_cu); }
        (void)hipGetLastError();
        grid = cus;
    }
    if (grid < 0) return;
    (void)hipMemsetAsync((char*)d_ws + WS_CTL, 0, CTL_BYTES, stream);
    Args a{};
    for (int i = 0; i < 36; ++i) a.in[i] = (const float*)d_in[i];
    a.out = (float*)d_out; a.ws = (unsigned char*)d_ws;
#if MK_MULTI
    for (int p = 0; p < NPHASE; ++p) { a.ph_lo = p; a.ph_hi = p + 1; hipLaunchKernelGGL(mk_fwd, dim3(grid), dim3(NTHR), LDS_BYTES, stream, a); }
#else
    a.ph_lo = 0; a.ph_hi = NPHASE; hipLaunchKernelGGL(mk_fwd, dim3(grid), dim3(NTHR), LDS_BYTES, stream, a);
#endif
}
```

```cpp
#include <hip/hip_runtime.h>
#include <cstdio>
#include <cstdint>

#define LAS __attribute__((address_space(3)))
#define GAS __attribute__((address_space(1)))
typedef unsigned short bf16_t;
typedef short bf16x8 __attribute__((ext_vector_type(8)));
typedef float f32x4 __attribute__((ext_vector_type(4)));
typedef float f32x2 __attribute__((ext_vector_type(2)));
typedef unsigned u32x4 __attribute__((ext_vector_type(4)));
typedef unsigned u32x2 __attribute__((ext_vector_type(2)));

constexpr int NB = 16, SEQ = 4096, CTXL = 256, DM = 1024, DEPTH = 4;
constexpr int NLAT = NB * SEQ;
constexpr int NCTX = NB * CTXL;
constexpr int NROW = NLAT + NCTX;
constexpr int SPB = SEQ + CTXL;
constexpr int DIN_REF = 3104;
constexpr int DIN = 3328;
constexpr int UQ = 0, UK = 512, UV = 1024, UGQ = 1536, UGK = 1664, UGV = 1792, UGR = 2048, UHY = 2304, ULAF = 3072, ULAB = 3200;
constexpr int NEXP = 128, TOPK = 8, EH = 256;
constexpr int NE1 = NEXP + 1;
constexpr int RMAX = 659712;
constexpr int TMAX = RMAX / 256;
constexpr float LN_EPS = 1e-6f;
constexpr float DN_ALPHA = 1.6817928305074290f;

__device__ __forceinline__ unsigned f2bf(float f) { unsigned u = __builtin_bit_cast(unsigned, f); return (u + 0x7fffu + ((u >> 16) & 1u)) >> 16; }
typedef __bf16 bf16v2 __attribute__((ext_vector_type(2)));
__device__ __forceinline__ unsigned pk2(float lo, float hi) { const f32x2 v = {lo, hi}; const bf16v2 b = __builtin_convertvector(v, bf16v2); return __builtin_bit_cast(unsigned, b); }
__device__ __forceinline__ float bf2f(unsigned short b) { return __builtin_bit_cast(float, ((unsigned)b) << 16); }
__device__ __forceinline__ float bflo(unsigned w) { return __builtin_bit_cast(float, w << 16); }
__device__ __forceinline__ float bfhi(unsigned w) { return __builtin_bit_cast(float, w & 0xffff0000u); }
__device__ __forceinline__ float shx(float v, int o, int lane) { return __builtin_bit_cast(float, __builtin_amdgcn_ds_bpermute((lane ^ o) << 2, __builtin_bit_cast(int, v))); }
__device__ __forceinline__ int shxi(int v, int o, int lane) { return __builtin_amdgcn_ds_bpermute((lane ^ o) << 2, v); }
__device__ __forceinline__ float shf(float v, int src) { return __builtin_bit_cast(float, __builtin_amdgcn_ds_bpermute(src << 2, __builtin_bit_cast(int, v))); }
__device__ __forceinline__ float wave_sum(float v, int lane) {
#pragma unroll
    for (int o = 1; o < 64; o <<= 1) v += shx(v, o, lane);
    return v;
}
__device__ __forceinline__ void unpack8(const u32x4 q, float* o) { o[0] = bflo(q.x); o[1] = bfhi(q.x); o[2] = bflo(q.y); o[3] = bfhi(q.y); o[4] = bflo(q.z); o[5] = bfhi(q.z); o[6] = bflo(q.w); o[7] = bfhi(q.w); }
__device__ __forceinline__ float silu_f(float x) { return x * __builtin_amdgcn_rcpf(1.0f + __expf(-x)); }
#define LDS_WAIT() asm volatile("s_waitcnt lgkmcnt(0)" ::: "memory")
#define VM_WAIT() asm volatile("s_waitcnt vmcnt(0)" ::: "memory")

#define XB_TMO      128
#define XB_XCNT(j)  (256  + 64 * (j))
#define XB_XSUB(j)  (1280 + 64 * (j))
#define XB_XGEN(j)  (2304 + 64 * (j))
#define XB_TOP      3328
#define XB_TOPGEN   3392
#define XCD_BAR_WORDS 3456
#define XB_SPIN_CAP (1u << 18)

__device__ __forceinline__ unsigned xb_ld(unsigned* p)              { return __hip_atomic_load(p, __ATOMIC_RELAXED, __HIP_MEMORY_SCOPE_AGENT); }
__device__ __forceinline__ unsigned xb_add(unsigned* p, unsigned v) { return __hip_atomic_fetch_add(p, v, __ATOMIC_RELAXED, __HIP_MEMORY_SCOPE_AGENT); }
__device__ __forceinline__ unsigned xb_xcc_id() { return (unsigned)__builtin_amdgcn_s_getreg((3 << 11) | 20) & 0xFu; }
#define XB_SPIN(cond, bar) do { unsigned _sp = 0; while (cond) { __builtin_amdgcn_s_sleep(1); \
    if ((++_sp & 255u) == 0u) { if (xb_ld(&(bar)[XB_TMO])) break; if (_sp > XB_SPIN_CAP) { atomicAdd(&(bar)[XB_TMO], 1u); break; } } } } while (0)

struct XcdBarrier { unsigned* bar; unsigned x; volatile LAS unsigned* st; };

__device__ __forceinline__ XcdBarrier xcd_barrier_post(unsigned* bar, volatile LAS unsigned* st) {
    XcdBarrier b; b.bar = bar; b.x = xb_xcc_id(); b.st = st;
    if (threadIdx.x == 0) (void)xb_add(&bar[XB_XCNT(b.x)], 1u);
    return b;
}
__device__ __forceinline__ void xcd_barrier_complete(unsigned* bar, unsigned x, unsigned& nloc, unsigned& nx) {
    const unsigned G = gridDim.x * gridDim.y * gridDim.z;
    unsigned sum, cnt, mine, sp = 0u;
    for (;;) {
        sum = 0u; cnt = 0u; mine = 0u;
#pragma unroll
        for (unsigned j = 0; j < 16; ++j) { const unsigned c = xb_ld(&bar[XB_XCNT(j)]); sum += c; cnt += (c > 0u) ? 1u : 0u; mine = (j == x) ? c : mine; }
        if (sum == G) break;
        __builtin_amdgcn_s_sleep(1);
        if ((++sp & 255u) == 0u) { if (xb_ld(&bar[XB_TMO])) break; if (sp > XB_SPIN_CAP) { atomicAdd(&bar[XB_TMO], 1u); break; } }
    }
    nloc = mine > 0u ? mine : 1u; nx = cnt > 0u ? cnt : 1u;
}
__device__ __forceinline__ void xcd_barrier(const XcdBarrier& b) {
    asm volatile("s_waitcnt vmcnt(0)" ::: "memory");
    __syncthreads();
    if (threadIdx.x == 0) {
        unsigned* bar = b.bar;
        __builtin_amdgcn_s_waitcnt(0);
        unsigned nloc = b.st[0], nx = b.st[1];
        if (nloc == 0u) { xcd_barrier_complete(bar, b.x, nloc, nx); b.st[0] = nloc; b.st[1] = nx; }
        const unsigned old = xb_add(&bar[XB_XSUB(b.x)], 1u);
        const unsigned gen = old / nloc;
        if (old + 1u == (gen + 1u) * nloc) {
            __builtin_amdgcn_fence(__ATOMIC_RELEASE, "agent");
            asm volatile("s_waitcnt vmcnt(0)" ::: "memory");
            const unsigned og = xb_add(&bar[XB_TOP], 1u);
            const unsigned tg = og / nx;
            if (og + 1u == (tg + 1u) * nx) xb_add(&bar[XB_TOPGEN], 1u);
            else XB_SPIN(xb_ld(&bar[XB_TOPGEN]) == tg, bar);
            __builtin_amdgcn_fence(__ATOMIC_ACQUIRE, "agent");
            xb_add(&bar[XB_XGEN(b.x)], 1u);
            asm volatile("s_waitcnt vmcnt(0)" ::: "memory");
        } else {
            XB_SPIN(xb_ld(&bar[XB_XGEN(b.x)]) == gen, bar);
            __builtin_amdgcn_fence(__ATOMIC_ACQUIRE, "agent");
            asm volatile("s_waitcnt vmcnt(0)" ::: "memory");
        }
    }
    __syncthreads();
}

namespace pg8 {
constexpr int BM = 256, BK = 64, HALF = 128, HTB = HALF * BK * 2, STAGE_BYTES = 8 * HTB, NXCD = 8, WGM = 8;
__host__ __device__ __forceinline__ int lds_byte(int r, int c) { const int st = (r >> 4) * 2 + (c >> 5), rr = r & 15, cc = c & 31, ob = rr * 64 + cc * 2; return st * 1024 + (ob ^ (((ob >> 9) & 1) << 5)); }
__host__ __device__ __forceinline__ void stage_rc(int b, int& R, int& C) { const int st = b / 1024, sb = b % 1024, swz = sb ^ (((sb >> 9) & 1) << 5); R = (st >> 1) * 16 + swz / 64; C = (st & 1) * 32 + (swz % 64) / 2; }
__host__ __device__ __forceinline__ int perm32(int rho) { const int n = rho >> 4, i = rho & 15; return 8 * (i >> 2) + 4 * n + (i & 3); }

struct Unit { int arow0, brow0, orow0, ocol0, aux; };

struct DenseOrder {
    int nM, nN, nwg, G, c;
    __device__ void init(int M, int N, int G_, int c_) { nM = M / BM; nN = N / BM; nwg = nM * nN; G = G_; c = c_; }
    __device__ __forceinline__ bool next(int i, Unit& u) const {
        const long L = (long)i * G + c; if (L >= nwg) return false;
        int wgid = (int)L; { const int q = nwg / NXCD, r = nwg % NXCD, xcd = wgid % NXCD, off = wgid / NXCD; wgid = (xcd < r ? xcd * (q + 1) : r * (q + 1) + (xcd - r) * q) + off; }
        const int nig = WGM * nN, gid = wgid / nig, fm = gid * WGM, gsz = (nM - fm) < WGM ? (nM - fm) : WGM;
        const int pm = fm + ((wgid % nig) % gsz), pn = (wgid % nig) / gsz;
        u.arow0 = pm * BM; u.brow0 = pn * BM; u.orow0 = pm * BM; u.ocol0 = pn * BM; u.aux = 0; return true;
    }
};
struct GroupedOrder {
    const LAS unsigned char* tab; int nN, nslot, slot, t0, t1;
    __device__ __forceinline__ void init(int ntiles, int nN_, int G, int c) {
        nN = nN_;
        if ((G & 7) == 0) { const int per = (ntiles + 7) >> 3, x = c & 7; nslot = G >> 3; slot = c >> 3; t0 = x * per; t1 = (t0 + per) < ntiles ? (t0 + per) : ntiles; }
        else { nslot = G; slot = c; t0 = 0; t1 = ntiles; }
    }
    __device__ __forceinline__ void preload(const int* tile_exp, LAS unsigned char* lds_tab, int tid, int nthr) {
        __syncthreads();
        for (int i = tid; i < t1 - t0; i += nthr) lds_tab[i] = (unsigned char)tile_exp[t0 + i];
        __syncthreads();
        tab = lds_tab;
    }
    __device__ __forceinline__ bool next(int i, Unit& u) const {
        const int q = i * nslot + slot, t = t0 + q / nN, pn = q % nN;
        if (t >= t1) return false;
        const int e = (int)tab[t - t0];
        u.arow0 = t * BM; u.brow0 = (e * nN + pn) * BM; u.orow0 = t * BM; u.ocol0 = pn * BM; u.aux = e; return true;
    }
};

template <class Base> struct RangeOrder {
    Base b; int i0, i1;
    __device__ __forceinline__ bool next(int i, Unit& u) const { const int j = i + i0; if (j >= i1) return false; return b.next(j, u); }
};

__device__ __forceinline__ unsigned cvt_pk_bf16(float lo, float hi) { return pk2(lo, hi); }

struct NoPre {};
struct EpiF32 {
    static constexpr bool PERM = false; static constexpr int SCW = 0x7A7A7A7A; typedef NoPre Pre;
    __device__ __forceinline__ Pre prefetch(const Unit&, LAS unsigned char*, int, int, int) const { return Pre{}; }
    float* C; int ldc;
    __device__ __forceinline__ void operator()(const f32x4 (&acc)[2][2][4][2], const Unit& u, int wr, int wc, int fr, int fq, const Pre&) const {
        const int row0 = u.orow0 + wr * 64 + fr, col0 = u.ocol0 + wc * 32 + 4 * fq;
#pragma unroll
        for (int ai = 0; ai < 2; ++ai)
#pragma unroll
            for (int m = 0; m < 4; ++m) { float* rowp = C + (size_t)(row0 + ai * HALF + m * 16) * ldc + col0;
#pragma unroll
                for (int bj = 0; bj < 2; ++bj)
#pragma unroll
                    for (int n = 0; n < 2; ++n) *(GAS f32x4*)(rowp + bj * HALF + n * 16) = acc[ai][bj][m][n]; }
    }
};
struct EpiF32H {
    static constexpr bool PERM = false; static constexpr int SCW = 0x7A7A7A7A; typedef NoPre Pre;
    __device__ __forceinline__ Pre prefetch(const Unit&, LAS unsigned char*, int, int, int) const { return Pre{}; }
    float* C; int ldc;
    __device__ __forceinline__ void operator()(const f32x4 (&acc)[2][2][4][2], const Unit& u, int wr, int wc, int fr, int fq, const Pre&) const {
        const int row0 = u.orow0 + wr * 64 + fr, col0 = wc * 32 + 4 * fq;
#pragma unroll
        for (int ai = 0; ai < 2; ++ai)
#pragma unroll
            for (int m = 0; m < 4; ++m) { float* rowp = C + (size_t)(row0 + ai * HALF + m * 16) * ldc + col0;
#pragma unroll
                for (int n = 0; n < 2; ++n) *(GAS f32x4*)(rowp + n * 16) = acc[ai][0][m][n]; }
    }
};
struct EpiBf16 {
    static constexpr bool PERM = true; static constexpr int SCW = 0x7A7A7A7A; typedef NoPre Pre;
    __device__ __forceinline__ Pre prefetch(const Unit&, LAS unsigned char*, int, int, int) const { return Pre{}; }
    bf16_t* O; int ldc;
    __device__ __forceinline__ void operator()(const f32x4 (&acc)[2][2][4][2], const Unit& u, int wr, int wc, int fr, int fq, const Pre&) const {
        const int row0 = u.orow0 + wr * 64 + fr, col0 = u.ocol0 + wc * 32 + 8 * fq;
#pragma unroll
        for (int ai = 0; ai < 2; ++ai)
#pragma unroll
            for (int m = 0; m < 4; ++m) { bf16_t* rowp = O + (size_t)(row0 + ai * HALF + m * 16) * ldc + col0;
#pragma unroll
                for (int bj = 0; bj < 2; ++bj) { const f32x4 v0 = acc[ai][bj][m][0], v1 = acc[ai][bj][m][1];
                    u32x4 w; w.x = cvt_pk_bf16(v0[0], v0[1]); w.y = cvt_pk_bf16(v0[2], v0[3]); w.z = cvt_pk_bf16(v1[0], v1[1]); w.w = cvt_pk_bf16(v1[2], v1[3]);
                    *(GAS u32x4*)(rowp + bj * HALF) = w; } }
    }
};
struct EpiSwiglu {
    static constexpr bool PERM = true; static constexpr int SCW = 0x7A7A7A7A; typedef NoPre Pre;
    __device__ __forceinline__ Pre prefetch(const Unit&, LAS unsigned char*, int, int, int) const { return Pre{}; }
    unsigned char* ACT;
    __device__ __forceinline__ void operator()(const f32x4 (&acc)[2][2][4][2], const Unit& u, int wr, int wc, int fr, int fq, const Pre&) const {
        const int row0 = u.orow0 + wr * 64 + fr, pn = u.ocol0 >> 8;
#pragma unroll
        for (int ai = 0; ai < 2; ++ai)
#pragma unroll
            for (int m = 0; m < 4; ++m) { unsigned char* rowp = ACT + (size_t)(row0 + ai * HALF + m * 16) * EH + pn * 128 + wc * 32 + 8 * fq;
                int w[2];
#pragma unroll
                for (int n = 0; n < 2; ++n) { const f32x4 g = acc[ai][0][m][n], up = acc[ai][1][m][n];
                    f32x4 e;
#pragma unroll
                    for (int i = 0; i < 4; ++i) e[i] = __builtin_amdgcn_exp2f(-g[i]);
                    const f32x4 d = e + 1.0f; f32x4 r;
#pragma unroll
                    for (int i = 0; i < 4; ++i) r[i] = __builtin_amdgcn_rcpf(d[i]);
                    const f32x4 h = (g * up) * r;
                    int v = 0; v = __builtin_amdgcn_cvt_pk_fp8_f32(h[0], h[1], v, false); v = __builtin_amdgcn_cvt_pk_fp8_f32(h[2], h[3], v, true); w[n] = v; }
                *(GAS u32x2*)rowp = (u32x2){(unsigned)w[0], (unsigned)w[1]}; }
    }
};
constexpr float Y2_SCALE = 16.0f, Y2_INV = 1.0f / 16.0f;
struct EpiScatter {
    static constexpr bool PERM = true; static constexpr int SCW = 0x7E7E7E7E;
    struct Pre { const LAS int* tab; };
    unsigned char* Y2; const int* rowdst;
    __device__ __forceinline__ Pre prefetch(const Unit& u, LAS unsigned char* lds, int wid, int lane, int ui) const {
        LAS unsigned char* tab = lds + STAGE_BYTES + (ui & 1) * 1024;
        if (wid < 4) __builtin_amdgcn_global_load_lds((const unsigned*)(rowdst + u.orow0 + wid * 64 + lane), (LAS unsigned*)(tab + wid * 256), 4, 0, 0);
        Pre p; p.tab = (const LAS int*)tab; return p; }
    __device__ __forceinline__ void operator()(const f32x4 (&acc)[2][2][4][2], const Unit& u, int wr, int wc, int fr, int fq, const Pre& pre) const {
#pragma unroll
        for (int ai = 0; ai < 2; ++ai)
#pragma unroll
            for (int m = 0; m < 4; ++m) { const int dst = pre.tab[wr * 64 + fr + ai * HALF + m * 16];
                if (dst >= 0) { unsigned char* rowp = Y2 + (size_t)dst * DM + u.ocol0 + wc * 64 + fq * 16;
                    int w[4];
#pragma unroll
                    for (int bj = 0; bj < 2; ++bj) { const f32x4 v0 = acc[ai][bj][m][0], v1 = acc[ai][bj][m][1];
                        int w0 = 0, w1 = 0;
                        w0 = __builtin_amdgcn_cvt_pk_fp8_f32(v0[0], v0[1], w0, false); w0 = __builtin_amdgcn_cvt_pk_fp8_f32(v0[2], v0[3], w0, true);
                        w1 = __builtin_amdgcn_cvt_pk_fp8_f32(v1[0], v1[1], w1, false); w1 = __builtin_amdgcn_cvt_pk_fp8_f32(v1[2], v1[3], w1, true);
                        w[2 * bj] = w0; w[2 * bj + 1] = w1; }
                    *(GAS u32x4*)rowp = (u32x4){(unsigned)w[0], (unsigned)w[1], (unsigned)w[2], (unsigned)w[3]}; } }
    }
};

typedef int v8i __attribute__((ext_vector_type(8)));
typedef int v4i __attribute__((ext_vector_type(4)));
struct Frag { bf16x8 p[2]; __device__ __forceinline__ bf16x8& operator[](int k) { return p[k]; } __device__ __forceinline__ const bf16x8& operator[](int k) const { return p[k]; } };
template <class Epi, class Sched, bool GATHER, bool F8 = false, bool ALIGN_EPI = true, bool SP2 = true, bool NHALF = false>
__device__ __forceinline__ void gemm_phase(const int tid_in, LAS unsigned char* lds, const void* Ag, const void* Bg, const int K, const int* rowidx, const Sched& S, const Epi& E) {
    int tid_ = tid_in; asm volatile("" : "+v"(tid_));
    const int tid = tid_, wid = __builtin_amdgcn_readfirstlane(tid >> 6), lane = tid & 63, wr = wid >> 2, wc = wid & 3, fr = lane & 15, fq = lane >> 4;
    const int KB = F8 ? K : 2 * K;
    const int nt = KB / 128;
    unsigned voffB[2];
#pragma unroll
    for (int i = 0; i < 2; ++i) { int R, C; stage_rc(tid * 16 + i * 8192, R, C); const int Rb = Epi::PERM ? ((R & ~31) + perm32(R & 31)) : R;
        voffB[i] = (unsigned)(Rb * KB + C * 2); }
    const size_t kstep = (size_t)128;
    const size_t hstep = (size_t)HALF * KB;
    const unsigned ldsw = (unsigned)wid * 1024u;
    const int aoff = F8 ? lds_byte(wr * 64 + fr, 16 * fq) : lds_byte(wr * 64 + fr, fq * 8), boff = F8 ? lds_byte(wc * 32 + fr, 16 * fq) : lds_byte(wc * 32 + fr, fq * 8);
    constexpr int PIECE1 = F8 ? 16 : 1024;
    const int sc_w = Epi::SCW, sc_a = 0x7F7F7F7F;
#define PG8_SA(b, h) (((b) * 2 + (h)) * HTB)
#define PG8_SB(b, h) ((4 + (b) * 2 + (h)) * HTB)
#define PG8_STAGE_B(bufoff, gbase) do { _Pragma("unroll") for (int _i = 0; _i < 2; ++_i) \
        __builtin_amdgcn_global_load_lds((const unsigned*)((const char*)(gbase) + voffB[_i]), (LAS unsigned*)(lds + (bufoff) + ldsw + _i * 8192), 16, 0, 0); } while (0)
#define PG8_STAGE_A(bufoff, gbase, h) do { const char* _gb = (const char*)(gbase) + (GATHER ? (size_t)0 : (size_t)(h) * hstep); \
        __builtin_amdgcn_global_load_lds((const unsigned*)(_gb + ac[GATHER ? (h) : 0][0]), (LAS unsigned*)(lds + (bufoff) + ldsw), 16, 0, 0); \
        __builtin_amdgcn_global_load_lds((const unsigned*)(_gb + ac[GATHER ? (h) : 0][1]), (LAS unsigned*)(lds + (bufoff) + ldsw + 8192), 16, 0, 0); } while (0)
#define PG8_LDA(dst, b, h) do { _Pragma("unroll") for (int m = 0; m < 4; ++m) { if constexpr (F8) { const v4i _l = *(const LAS v4i*)(lds + PG8_SA(b, h) + aoff + m * 2048), _h = *(const LAS v4i*)(lds + PG8_SA(b, h) + aoff + m * 2048 + PIECE1); dst##8[m] = __builtin_shufflevector(_l, _h, 0, 1, 2, 3, 4, 5, 6, 7); } \
        else { dst[m][0] = *(const LAS bf16x8*)(lds + PG8_SA(b, h) + aoff + m * 2048); dst[m][1] = *(const LAS bf16x8*)(lds + PG8_SA(b, h) + aoff + m * 2048 + PIECE1); } } } while (0)
#define PG8_LDB(dst, b, h) do { _Pragma("unroll") for (int n = 0; n < 2; ++n) { if constexpr (F8) { const v4i _l = *(const LAS v4i*)(lds + PG8_SB(b, h) + boff + n * 2048), _h = *(const LAS v4i*)(lds + PG8_SB(b, h) + boff + n * 2048 + PIECE1); dst##8[n] = __builtin_shufflevector(_l, _h, 0, 1, 2, 3, 4, 5, 6, 7); } \
        else { dst[n][0] = *(const LAS bf16x8*)(lds + PG8_SB(b, h) + boff + n * 2048); dst[n][1] = *(const LAS bf16x8*)(lds + PG8_SB(b, h) + boff + n * 2048 + PIECE1); } } } while (0)
#define PG8_MMA(ai, bj, At, Bt) do { __builtin_amdgcn_s_setprio(1); _Pragma("unroll") for (int m = 0; m < 4; ++m) _Pragma("unroll") for (int n = 0; n < 2; ++n) { \
        if constexpr (F8) asm volatile("v_mfma_scale_f32_16x16x128_f8f6f4 %0, %1, %2, %0, %3, %4 op_sel_hi:[0,0,0]" : "+v"(acc[ai][bj][m][n]) : "v"(Bt##8[n]), "v"(At##8[m]), "v"(sc_w), "v"(sc_a)); \
        else { _Pragma("unroll") for (int k = 0; k < 2; ++k) acc[ai][bj][m][n] = __builtin_amdgcn_mfma_f32_16x16x32_bf16(Bt[n][k], At[m][k], acc[ai][bj][m][n], 0, 0, 0); } } \
        __builtin_amdgcn_s_setprio(0); } while (0)
#define PG8_WAIT_V(n) asm volatile("s_waitcnt vmcnt(" #n ")" ::: "memory")
#define PG8_WAIT_LOOP do { if constexpr (NHALF) PG8_WAIT_V(6); else PG8_WAIT_V(8); } while (0)
#define PG8_WAIT_L(n) asm volatile("s_waitcnt lgkmcnt(" #n ")" ::: "memory")
#define PG8_BAR __builtin_amdgcn_s_barrier()
#define PG8_SCHED __builtin_amdgcn_sched_barrier(0)
#define PG8_TAB(par) (lds + STAGE_BYTES + 2048 + (par) * 1024)
#define PG8_TABLOAD(par, row0) do { if (wid < 4) __builtin_amdgcn_global_load_lds((const unsigned*)(rowidx + (row0) + wid * 64 + lane), (LAS unsigned*)(PG8_TAB(par) + wid * 256), 4, 0, 0); } while (0)
#define PG8_AOFF_H(h, par) do { int _tz = tid; asm volatile("" : "+v"(_tz)); _Pragma("unroll") for (int _i = 0; _i < 2; ++_i) { int _R, _C; stage_rc(_tz * 16 + _i * 8192, _R, _C); \
        if (GATHER) ac[h][_i] = ((const LAS unsigned*)PG8_TAB(par))[(h) * HALF + _R] * (unsigned)KB + (unsigned)_C * 2u; \
        else ac[h][_i] = (unsigned)(((h) * HALF + _R) * KB) + (unsigned)_C * 2u; } } while (0)
    static_assert(SP2, "only the two-super-phase K-loop is kept");
    Unit cur, nxt; int ui = 0;
    if (!S.next(0, cur)) return;
    f32x4 acc[2][2][4][2];
#pragma unroll
    for (int a = 0; a < 2; ++a)
#pragma unroll
        for (int b = 0; b < 2; ++b)
#pragma unroll
            for (int m = 0; m < 4; ++m)
#pragma unroll
                for (int n = 0; n < 2; ++n) acc[a][b][m][n] = (f32x4){0.f, 0.f, 0.f, 0.f};
    bf16x8 At[F8 ? 1 : 4][2], B0[F8 ? 1 : 2][2], B1[F8 ? 1 : 2][2];
    v8i At8[F8 ? 4 : 1], B08[F8 ? 2 : 1], B18[F8 ? 2 : 1];
    unsigned ac[GATHER ? 2 : 1][2];
    if (GATHER) { PG8_TABLOAD(0, cur.arow0); PG8_WAIT_V(0); PG8_BAR; }
    PG8_AOFF_H(0, 0); if (GATHER) { PG8_AOFF_H((GATHER ? 1 : 0), 0); }
    const char* cA = (const char*)Ag + (GATHER ? (size_t)0 : (size_t)cur.arow0 * KB); const char* cB = (const char*)Bg + (size_t)cur.brow0 * KB;
    PG8_STAGE_B(PG8_SB(0, 0), cB); if constexpr (!NHALF) PG8_STAGE_B(PG8_SB(0, 1), cB + hstep); PG8_STAGE_A(PG8_SA(0, 0), cA, 0); PG8_STAGE_A(PG8_SA(0, 1), cA, 1);
    if (wr == 1) PG8_BAR;
    PG8_WAIT_V(2); PG8_BAR;
    PG8_STAGE_B(PG8_SB(1, 0), cB + kstep); PG8_STAGE_A(PG8_SA(1, 0), cA + kstep, 0); if constexpr (!NHALF) PG8_STAGE_B(PG8_SB(1, 1), cB + hstep + kstep);
    if constexpr (NHALF) PG8_WAIT_V(4); else PG8_WAIT_V(6);
    PG8_BAR;
    for (;;) {
        const typename Epi::Pre pre = E.prefetch(cur, lds, wid, lane, ui);
        const bool has_next = S.next(ui + 1, nxt);
        if (GATHER) { if (has_next) PG8_TABLOAD((ui + 1) & 1, nxt.arow0); }
        const char* nA = has_next ? ((const char*)Ag + (GATHER ? (size_t)0 : (size_t)nxt.arow0 * KB)) : cA; const char* nB = has_next ? (const char*)Bg + (size_t)nxt.brow0 * KB : cB;
_Pragma("nounroll")
        for (int t = 0; t < nt; t += 2) {
            const bool last = (t == nt - 2);
            const char* a1 = cA + (size_t)(t + 1) * kstep;
            const char* a2 = last ? nA : cA + (size_t)(t + 2) * kstep; const char* b2 = last ? nB : cB + (size_t)(t + 2) * kstep;
            const char* a3 = a2 + kstep; const char* b3 = b2 + kstep;
            if (GATHER) { if (last && has_next) { PG8_AOFF_H(0, (ui + 1) & 1); } }
            PG8_LDB(B0, 0, 0); if constexpr (!NHALF) PG8_LDB(B1, 0, 1); PG8_SCHED; PG8_LDA(At, 0, 0); PG8_STAGE_A(PG8_SA(1, 1), a1, 1);
            PG8_WAIT_LOOP; PG8_WAIT_L(0); PG8_BAR; PG8_MMA(0, 0, At, B0); if constexpr (!NHALF) PG8_MMA(0, 1, At, B1); PG8_BAR; PG8_SCHED;
            if (GATHER) { if (last && has_next) { PG8_AOFF_H(1, (ui + 1) & 1); } }
            PG8_LDA(At, 0, 1); PG8_STAGE_B(PG8_SB(0, 0), b2); if constexpr (!NHALF) PG8_STAGE_B(PG8_SB(0, 1), b2 + hstep); PG8_STAGE_A(PG8_SA(0, 0), a2, 0);
            PG8_WAIT_LOOP; PG8_WAIT_L(0); PG8_BAR; PG8_MMA(1, 0, At, B0); if constexpr (!NHALF) PG8_MMA(1, 1, At, B1); PG8_BAR; PG8_SCHED;
            PG8_LDB(B0, 1, 0); if constexpr (!NHALF) PG8_LDB(B1, 1, 1); PG8_SCHED; PG8_LDA(At, 1, 0); PG8_STAGE_A(PG8_SA(0, 1), a2, 1);
            PG8_WAIT_LOOP; PG8_WAIT_L(0); PG8_BAR; PG8_MMA(0, 0, At, B0); if constexpr (!NHALF) PG8_MMA(0, 1, At, B1); PG8_BAR; PG8_SCHED;
            PG8_LDA(At, 1, 1); PG8_STAGE_B(PG8_SB(1, 0), b3); if constexpr (!NHALF) PG8_STAGE_B(PG8_SB(1, 1), b3 + hstep); PG8_STAGE_A(PG8_SA(1, 0), a3, 0);
            PG8_WAIT_LOOP; PG8_WAIT_L(0); PG8_BAR; PG8_MMA(1, 0, At, B0); if constexpr (!NHALF) PG8_MMA(1, 1, At, B1); PG8_BAR; PG8_SCHED;
        }
        if constexpr (ALIGN_EPI) { if (wr == 0) PG8_BAR; }
        E(acc, cur, wr, wc, fr, fq, pre);
        if (!has_next) break;
#pragma unroll
        for (int a = 0; a < 2; ++a)
#pragma unroll
            for (int b = 0; b < 2; ++b)
#pragma unroll
                for (int m = 0; m < 4; ++m)
#pragma unroll
                    for (int n = 0; n < 2; ++n) acc[a][b][m][n] = (f32x4){0.f, 0.f, 0.f, 0.f};
        cur = nxt; cA = nA; cB = nB; ++ui;
        if constexpr (ALIGN_EPI) { if (wr == 1) PG8_BAR; }
    }
    PG8_WAIT_V(0);
    if constexpr (!ALIGN_EPI) { if (wr == 0) PG8_BAR; }
    PG8_BAR;
#undef PG8_SA
#undef PG8_SB
#undef PG8_STAGE_A
#undef PG8_STAGE_B
#undef PG8_LDA
#undef PG8_LDB
#undef PG8_MMA
#undef PG8_WAIT_V
#undef PG8_WAIT_L
#undef PG8_WAIT_LOOP
#undef PG8_BAR
#undef PG8_SCHED
#undef PG8_AOFF_H
#undef PG8_TAB
#undef PG8_TABLOAD
}
}

constexpr int NWAVES = 8, NTHR = 512;
constexpr size_t MiB = 1u << 20;
constexpr size_t WS_CTL = 0, CTL_BYTES = 1 * MiB;
constexpr size_t WS_MOD = 1 * MiB;
constexpr size_t WS_WIN = 3 * MiB;
constexpr size_t WS_WOUT = 29 * MiB;
constexpr size_t WS_WR = 37 * MiB;
constexpr size_t WS_HYF = 39 * MiB;
constexpr size_t WS_HYFC = 71 * MiB;
constexpr size_t WS_XC = 73 * MiB;
constexpr size_t WS_EXP1 = 89 * MiB;
constexpr size_t WS_EXP2 = 218 * MiB;
constexpr size_t WS_XM = 283 * MiB;
constexpr size_t WS_EIDX = 419 * MiB;
constexpr size_t WS_WGT = 422 * MiB;
constexpr size_t WS_RNK = 425 * MiB;
constexpr size_t WS_ROWTOK = 428 * MiB;
constexpr size_t WS_ROWDST = 431 * MiB;
constexpr size_t WS_TILEEXP = 434 * MiB;
constexpr size_t WS_BIG = 435 * MiB;
constexpr size_t WS_U = WS_BIG;
constexpr size_t WS_MIX = 877 * MiB;
constexpr size_t WS_VT = 1013 * MiB;
constexpr size_t WS_HV = 1081 * MiB;
constexpr size_t WS_Z2 = 1183 * MiB;
constexpr size_t WS_GDS = 1217 * MiB;
constexpr size_t WS_GSIN = 1285 * MiB;
constexpr size_t WS_GD = 1319 * MiB;
constexpr size_t WS_Y = 1321 * MiB;
constexpr size_t WS_LOGIT = WS_BIG;
constexpr size_t WS_ACT = WS_BIG;
constexpr size_t WS_Y2 = 758 * MiB;
constexpr size_t WS_XM8 = 1470 * MiB;
constexpr size_t WS_XR = 1600 * MiB;
constexpr size_t WS_END = 1736 * MiB;
constexpr int CW_BAR = 4096;
constexpr int CW_CNT = 16384;
constexpr int CW_NTL = 20480;

constexpr int LDS_BYTES = 163840;
constexpr int MISC_OFF = 163584;

struct Frame {
    LAS unsigned char* lds;
    int tid, lane, wave, G, wg;
    const float* const* in;
    float* out; unsigned char* ws; unsigned* ctl;
};
enum { I_X = 0, I_C, I_CTX, I_CCTX, I_WMOD, I_BMOD, I_WIN, I_RPB, I_WA2, I_BA2, I_GNORM, I_HSW, I_HSB, I_HW1, I_HB1, I_HF1, I_HW2, I_HB2, I_HF2, I_HW3, I_HB3, I_HDEC, I_HSKIP,
       I_WOUT, I_LN1G, I_LN1B, I_RW, I_RB, I_WEG, I_WEU, I_WED, I_WSG, I_WSU, I_WSD, I_LN2G, I_LN2B };

__device__ __forceinline__ int row_b(int row) { return row < NLAT ? (row >> 12) : 16; }
__device__ __forceinline__ const float* mod_ptr(const Frame& F, int l, int row) { return (const float*)(F.ws + WS_MOD) + ((size_t)l * 17 + row_b(row)) * 6144; }

template <class RowFn>
__device__ __forceinline__ void tr_item(const float* W, int ldw, int k0, int n0, bf16_t* dst, int ldd, RowFn rf, LAS float* scr, int lane) {
    float tv[32];
    const GAS float* wp = (const GAS float*)(W + (size_t)(k0 + (lane >> 5)) * ldw + n0 + (lane & 31));
#pragma unroll
    for (int i = 0; i < 32; ++i) tv[i] = wp[(size_t)(2 * i) * ldw];
#pragma unroll
    for (int i = 0; i < 32; ++i) scr[(2 * i + (lane >> 5)) * 33 + (lane & 31)] = tv[i];
    LDS_WAIT(); asm volatile("" ::: "memory");
    const int c = lane & 7;
#pragma unroll
    for (int j = 0; j < 4; ++j) { const int n = (lane >> 3) + 8 * j; const LAS float* s = scr + (8 * c) * 33 + n;
        u32x4 o; o.x = pk2(s[0 * 33], s[1 * 33]); o.y = pk2(s[2 * 33], s[3 * 33]); o.z = pk2(s[4 * 33], s[5 * 33]); o.w = pk2(s[6 * 33], s[7 * 33]);
        *(GAS u32x4*)(dst + (size_t)rf(n0 + n) * ldd + k0 + 8 * c) = o; }
    LDS_WAIT(); asm volatile("" ::: "memory");
}
template <class RowFn>
__device__ __forceinline__ void tr_item8(const float* W, int ldw, int k0, int n0, unsigned char* dst, int ldd, RowFn rf, float scale, LAS float* scr, int lane) {
    float tv[32];
    const GAS float* wp = (const GAS float*)(W + (size_t)(k0 + (lane >> 5)) * ldw + n0 + (lane & 31));
#pragma unroll
    for (int i = 0; i < 32; ++i) tv[i] = wp[(size_t)(2 * i) * ldw];
#pragma unroll
    for (int i = 0; i < 32; ++i) scr[(2 * i + (lane >> 5)) * 33 + (lane & 31)] = tv[i];
    LDS_WAIT(); asm volatile("" ::: "memory");
    const int n = lane >> 1, hf = lane & 1; const LAS float* s = scr + (32 * hf) * 33 + n;
    unsigned w[8];
#pragma unroll
    for (int j = 0; j < 8; ++j) { int v = 0; v = __builtin_amdgcn_cvt_pk_fp8_f32(s[(4 * j) * 33] * scale, s[(4 * j + 1) * 33] * scale, v, false); v = __builtin_amdgcn_cvt_pk_fp8_f32(s[(4 * j + 2) * 33] * scale, s[(4 * j + 3) * 33] * scale, v, true); w[j] = (unsigned)v; }
    unsigned char* d = dst + (size_t)rf(n0 + n) * ldd + k0 + 32 * hf;
    *(GAS u32x4*)d = (u32x4){w[0], w[1], w[2], w[3]}; *(GAS u32x4*)(d + 16) = (u32x4){w[4], w[5], w[6], w[7]};
    LDS_WAIT(); asm volatile("" ::: "memory");
}
struct RowId { __device__ __forceinline__ int operator()(int n) const { return n; } };
struct RowWin { __device__ __forceinline__ int operator()(int n) const { return n >= 2336 ? n - 32 : n; } };
struct RowGU { int up; __device__ __forceinline__ int operator()(int j) const { return (j >> 7) * 256 + up * 128 + (j & 127); } };

__device__ __forceinline__ void p0_static_weights(Frame& F) {
    LAS float* scr = (LAS float*)(F.lds + F.wave * 16384);
    const int gw = F.wg * NWAVES + F.wave, NGW = F.G * NWAVES;
    constexpr int I_IN = 16 * 97, I_OUT = 16 * 32, I_R = 16 * 4, PER_L = I_IN + I_OUT + I_R;
    for (int it = gw; it < DEPTH * PER_L; it += NGW) {
        const int l = it / PER_L; int r = it % PER_L;
        if (r < I_IN) { const int kb = r / 97, nb = r % 97; if (nb == 72) continue;
            tr_item(F.in[I_WIN] + (size_t)l * DM * DIN_REF, DIN_REF, kb * 64, nb * 32, (bf16_t*)(F.ws + WS_WIN) + (size_t)l * DIN * DM, DM, RowWin{}, scr, F.lane); continue; }
        r -= I_IN;
        if (r < I_OUT) { const int kb = r / 32, nb = r % 32;
            tr_item(F.in[I_WOUT] + (size_t)l * DM * DM, DM, kb * 64, nb * 32, (bf16_t*)(F.ws + WS_WOUT) + (size_t)l * DM * DM, DM, RowId{}, scr, F.lane); continue; }
        r -= I_OUT;
        { const int kb = r / 4, nb = r % 4;
            tr_item(F.in[I_RW] + (size_t)l * DM * NEXP, NEXP, kb * 64, nb * 32, (bf16_t*)(F.ws + WS_WR) + (size_t)l * 256 * DM, DM, RowId{}, scr, F.lane); }
    }
    const int gt = F.wg * NTHR + F.tid, NGT = F.G * NTHR;
    for (int i = gt; i < DEPTH * 128 * DM / 8; i += NGT) { const int l = i / (128 * DM / 8), r = i % (128 * DM / 8);
        *(u32x4*)((bf16_t*)(F.ws + WS_WR) + ((size_t)l * 256 + 128) * DM + (size_t)r * 8) = (u32x4){0u, 0u, 0u, 0u}; }
    for (int i = gt; i < DEPTH * 256 * DM; i += NGT) {
        const int k = i % DM, n = (i / DM) % 256, l = i / (DM * 256), dir = n >> 7, j = n & 127;
        const float* wi = F.in[I_WIN] + ((size_t)l * DM + k) * DIN_REF + 2304 + dir * 16;
        const float* wa = F.in[I_WA2] + ((size_t)(l * 2 + dir) * 16) * 128 + j;
        float s = 0.f;
#pragma unroll
        for (int r = 0; r < 16; ++r) s += wi[r] * wa[r * 128];
        ((bf16_t*)(F.ws + WS_WIN))[((size_t)l * DIN + 3072 + n) * DM + k] = (bf16_t)f2bf(s);
    }
}
__device__ __forceinline__ void p0_mod(Frame& F) {
    LAS float* sc = (LAS float*)F.lds;
    LAS float* red = (LAS float*)(F.lds + 17 * 1024 * 4);
    for (int i = F.tid; i < 17 * 1024; i += NTHR) { const int r = i >> 10, k = i & 1023; const float v = r < 16 ? F.in[I_C][r * 1024 + k] : F.in[I_CCTX][k]; sc[i] = silu_f(v); }
    __syncthreads();
    const int kq = F.tid >> 7, cl = F.tid & 127;
    for (int u = F.wg; u < DEPTH * 48; u += F.G) {
        const int l = u / 48, col = (u % 48) * 128 + cl;
        const float* w = F.in[I_WMOD] + (size_t)l * DM * 6144 + col;
        float a[17];
#pragma unroll
        for (int r = 0; r < 17; ++r) a[r] = 0.f;
        for (int k0 = kq * 256; k0 < kq * 256 + 256; k0 += 16) {
            float wv[16];
#pragma unroll
            for (int q = 0; q < 16; ++q) wv[q] = *(const GAS float*)(w + (size_t)(k0 + q) * 6144);
#pragma unroll
            for (int q = 0; q < 16; ++q)
#pragma unroll
                for (int r = 0; r < 17; ++r) a[r] += sc[r * 1024 + k0 + q] * wv[q]; }
#pragma unroll
        for (int r = 0; r < 17; ++r) red[(kq * 17 + r) * 128 + cl] = a[r];
        __syncthreads();
        for (int i = F.tid; i < 17 * 128; i += NTHR) { const int r = i >> 7, c2 = i & 127, cc = (u % 48) * 128 + c2;
            const float s = red[(0 * 17 + r) * 128 + c2] + red[(1 * 17 + r) * 128 + c2] + red[(2 * 17 + r) * 128 + c2] + red[(3 * 17 + r) * 128 + c2] + F.in[I_BMOD][l * 6144 + cc];
            ((float*)(F.ws + WS_MOD))[((size_t)l * 17 + r) * 6144 + cc] = s; }
        __syncthreads();
    }
}
__device__ __forceinline__ void p0_hyena_filters(Frame& F) {
    LAS float* z = (LAS float*)F.lds;
    LAS float* h1 = z + 1092;
    LAS float* h2 = h1 + 33 * 64;
    LAS float* tt = h2 + 33 * 64;
    LAS float* W1 = tt + 64;
    LAS float* W2 = W1 + 33 * 64;
    constexpr int UL = 4096 / 32, UC = 256 / 32, UPL = UL + UC;
    for (int u = F.wg; u < DEPTH * UPL; u += F.G) {
        const int l = u / UPL, r = u % UPL; const bool lat = r < UL; const int L = lat ? 4096 : 256, n0 = (lat ? r : r - UL) * 32;
        __syncthreads();
        for (int i = F.tid; i < 33 * 64; i += NTHR) W1[i] = F.in[I_HW1][(size_t)l * 33 * 64 + i];
        for (int i = F.tid; i < 64 * 64; i += NTHR) W2[i] = F.in[I_HW2][(size_t)l * 64 * 64 + i];
        for (int i = F.tid; i < 33 * 33; i += NTHR) { const int p = i / 33, e = i % 33, n = n0 + p;
            const float t = (float)n / (float)(L - 1);
            float v;
            if (e == 0) v = t;
            else { const int kb = (e - 1) & 15; const float band = 1e-4f + (float)kb * ((15.0f - 1e-4f) / 15.0f);
                   const float w = 6.283185307179586f * (float)n / (float)L; const float ang = w * band;
                   v = e <= 16 ? __cosf(ang) : -__sinf(ang); }
            z[i] = v; if (e == 0) tt[p] = t; }
        __syncthreads();
        for (int i = F.tid; i < 33 * 64; i += NTHR) { const int p = i >> 6, j = i & 63; float s = F.in[I_HB1][l * 64 + j];
#pragma unroll 11
            for (int e = 0; e < 33; ++e) s += z[p * 33 + e] * W1[e * 64 + j];
            h1[i] = __sinf(F.in[I_HF1][l * 64 + j] * s); }
        __syncthreads();
        for (int i = F.tid; i < 33 * 64; i += NTHR) { const int p = i >> 6, j = i & 63; float s = F.in[I_HB2][l * 64 + j];
#pragma unroll 16
            for (int e = 0; e < 64; ++e) s += h1[p * 64 + e] * W2[e * 64 + j];
            h2[i] = __sinf(F.in[I_HF2][l * 64 + j] * s); }
        __syncthreads();
        {
            const int g = F.tid >> 8, col0 = 4 * (F.tid & 255), o = col0 >> 9, dir = (col0 >> 8) & 1, ch0 = col0 & 255;
            const int pb = (dir ? 0 : 1) + 16 * g;
            float a[4][16];
#pragma unroll
            for (int j = 0; j < 4; ++j)
#pragma unroll
                for (int q = 0; q < 16; ++q) a[j][q] = 0.f;
            const float* w3 = F.in[I_HW3] + (size_t)l * 64 * 1024 + col0;
            const LAS float* hp = h2 + pb * 64;
            f32x4 wa[4], wb[4];
#pragma unroll
            for (int q = 0; q < 4; ++q) wa[q] = *(const GAS f32x4*)(w3 + (size_t)q * 1024);
#define HF_BLOCK(wv_, k0_) do { _Pragma("unroll") for (int pi = 0; pi < 16; ++pi) { const f32x4 hv = *(const LAS f32x4*)(hp + pi * 64 + (k0_)); \
                _Pragma("unroll") for (int q = 0; q < 4; ++q) _Pragma("unroll") for (int j = 0; j < 4; ++j) a[j][pi] += hv[q] * wv_[q][j]; } } while (0)
#pragma unroll 1
            for (int k0 = 0; k0 < 64; k0 += 8) {
#pragma unroll
                for (int q = 0; q < 4; ++q) wb[q] = *(const GAS f32x4*)(w3 + (size_t)(k0 + 4 + q) * 1024);
                __builtin_amdgcn_sched_barrier(0);
                HF_BLOCK(wa, k0);
                __builtin_amdgcn_sched_barrier(0);
                { const int kn = k0 + 8 < 64 ? k0 + 8 : k0;
#pragma unroll
                  for (int q = 0; q < 4; ++q) wa[q] = *(const GAS f32x4*)(w3 + (size_t)(kn + q) * 1024); }
                __builtin_amdgcn_sched_barrier(0);
                HF_BLOCK(wb, k0 + 4);
                __builtin_amdgcn_sched_barrier(0);
            }
#undef HF_BLOCK
            const f32x4 b3 = *(const GAS f32x4*)(F.in[I_HB3] + l * 1024 + col0), dc = *(const GAS f32x4*)(F.in[I_HDEC] + ((size_t)(l * 2 + o) * 2 + dir) * 256 + ch0);
            float a0[4] = {0.f, 0.f, 0.f, 0.f};
            if (n0 == 0 && dir == 0 && g == 0) {
                for (int k = 0; k < 64; ++k) { const f32x4 wv = *(const GAS f32x4*)(w3 + (size_t)k * 1024); const float hv = h2[k];
#pragma unroll
                    for (int j = 0; j < 4; ++j) a0[j] += hv * wv[j]; } }
#pragma unroll
            for (int j = 0; j < 4; ++j) {
                const float dec = fabsf(dc[j]);
                bf16_t* R = lat ? (bf16_t*)(F.ws + WS_HYF) + ((size_t)(l * 2 + o) * 256 + ch0 + j) * 8192 : (bf16_t*)(F.ws + WS_HYFC) + ((size_t)(l * 2 + o) * 256 + ch0 + j) * 512;
                float v[16];
#pragma unroll
                for (int pi = 0; pi < 16; ++pi) v[pi] = (a[j][pi] + b3[j]) * __expf(-tt[pb + pi] * dec);
                unsigned w[8];
                if (dir == 0) {
                    if (n0 + 32 == L && g == 1) v[15] = 0.f;
#pragma unroll
                    for (int q = 0; q < 8; ++q) w[q] = pk2(v[15 - 2 * q], v[14 - 2 * q]);
                    GAS u32x4* dst = (GAS u32x4*)(R + (L - n0 - 32) + 16 * (1 - g));
                    dst[0] = (u32x4){w[0], w[1], w[2], w[3]}; dst[1] = (u32x4){w[4], w[5], w[6], w[7]};
                    if (n0 == 0 && g == 0) R[L] = (bf16_t)f2bf((a0[j] + b3[j]) * __expf(-tt[0] * dec) + F.in[I_HSKIP][(l * 2 + o) * 256 + ch0 + j]);
                } else if (n0 > 0 || g == 1) {
#pragma unroll
                    for (int q = 0; q < 8; ++q) w[q] = pk2(v[2 * q], v[2 * q + 1]);
                    GAS u32x4* dst = (GAS u32x4*)(R + (L + n0) + 16 * g);
                    dst[0] = (u32x4){w[0], w[1], w[2], w[3]}; dst[1] = (u32x4){w[4], w[5], w[6], w[7]};
                } else {
#pragma unroll
                    for (int pi = 1; pi < 16; ++pi) R[L + pi] = (bf16_t)f2bf(v[pi]);
                }
            }
        }
    }
    __syncthreads();
}
__device__ __forceinline__ void p0_init_rows(Frame& F) {
    const int gw = F.wg * NWAVES + F.wave, NGW = F.G * NWAVES;
    for (int row = gw; row < NROW; row += NGW) {
        const float* src = row < NLAT ? F.in[I_X] + (size_t)row * DM : F.in[I_CTX] + (size_t)(row - NLAT) * DM;
        const float* md = mod_ptr(F, 0, row);
        bf16_t* xr = (bf16_t*)(F.ws + WS_XR) + (size_t)row * DM; bf16_t* xm = (bf16_t*)(F.ws + WS_XM) + (size_t)row * DM;
#pragma unroll
        for (int j = 0; j < 4; ++j) { const int c = 4 * F.lane + 256 * j;
            const f32x4 v = *(const GAS f32x4*)(src + c), sh = *(const GAS f32x4*)(md + c), sc = *(const GAS f32x4*)(md + 1024 + c);
            *(GAS u32x2*)(xr + c) = (u32x2){pk2(v[0], v[1]), pk2(v[2], v[3])};
            u32x2 w; w.x = pk2(v[0] * (1.f + sc[0]) + sh[0], v[1] * (1.f + sc[1]) + sh[1]); w.y = pk2(v[2] * (1.f + sc[2]) + sh[2], v[3] * (1.f + sc[3]) + sh[3]);
            *(GAS u32x2*)(xm + c) = w; }
    }
}
constexpr float WEXP_SCALE = 32.0f;
__device__ __forceinline__ void p_expert_weights(Frame& F, int l) {
    LAS float* scr = (LAS float*)(F.lds + F.wave * 16384);
    const int gw = F.wg * NWAVES + F.wave, NGW = F.G * NWAVES;
    constexpr int I1 = 16 * 8, I2 = 4 * 32, PER_E = 2 * I1 + I2;
    for (int it = gw; it < NE1 * PER_E; it += NGW) {
        const int e = it / PER_E; int r = it % PER_E;
        unsigned char* d1 = (unsigned char*)(F.ws + WS_EXP1) + (size_t)e * 512 * DM; unsigned char* d2 = (unsigned char*)(F.ws + WS_EXP2) + (size_t)e * DM * EH;
        if (r < 2 * I1) { const int up = r >= I1; if (up) r -= I1; const int kb = r / 8, nb = r % 8;
            const float* src = e < NEXP ? F.in[up ? I_WEU : I_WEG] + ((size_t)l * NEXP + e) * DM * EH : F.in[up ? I_WSU : I_WSG] + (size_t)l * DM * EH;
            tr_item8(src, EH, kb * 64, nb * 32, d1, DM, RowGU{up}, up ? WEXP_SCALE * 0.6931471805599453f : WEXP_SCALE * 1.4426950408889634f, scr, F.lane); }
        else { r -= 2 * I1; const int kb = r / 32, nb = r % 32;
            const float* src = e < NEXP ? F.in[I_WED] + ((size_t)l * NEXP + e) * EH * DM : F.in[I_WSD] + (size_t)l * EH * DM;
            tr_item8(src, DM, kb * 64, nb * 32, d2, EH, RowId{}, WEXP_SCALE, scr, F.lane); }
    }
}

__device__ __forceinline__ f32x4 mfma16(bf16x8 a, bf16x8 b, f32x4 c) { return __builtin_amdgcn_mfma_f32_16x16x32_bf16(a, b, c, 0, 0, 0); }

__device__ __forceinline__ void ph_transposes(Frame& F, int l) {
    LAS bf16_t* tile = (LAS bf16_t*)(F.lds + F.wave * 16384);
    const bf16_t* U = (const bf16_t*)(F.ws + WS_U);
    const int gw = F.wg * NWAVES + F.wave, NGW = F.G * NWAVES;
    const int rsub = F.lane >> 3, cseg = F.lane & 7;
    for (int u = gw; u < 1088 * 20; u += NGW) {
        const int tt = u / 20, blk = u % 20;
        int b, s0, Ls, rowbase, posbase;
        if (tt < 1024) { b = tt >> 6; s0 = (tt & 63) * 64; Ls = SEQ; rowbase = b * SEQ; posbase = 0; }
        else { const int t2 = tt - 1024; b = t2 >> 2; s0 = (t2 & 3) * 64; Ls = CTXL; rowbase = NLAT + b * CTXL; posbase = SEQ; }
        if (blk < 12) {
            const int c0 = blk * 64 + cseg * 8;
            float w0[8], w1[8], w2[8], bb[8];
#pragma unroll
            for (int i = 0; i < 8; ++i) { w0[i] = F.in[I_HSW][(l * 3 + 0) * 768 + c0 + i]; w1[i] = F.in[I_HSW][(l * 3 + 1) * 768 + c0 + i]; w2[i] = F.in[I_HSW][(l * 3 + 2) * 768 + c0 + i]; bb[i] = F.in[I_HSB][l * 768 + c0 + i]; }
#pragma unroll 2
            for (int it = 0; it < 8; ++it) {
                const int sl = rsub + 8 * it, s = s0 + sl;
                const bf16_t* p = U + (size_t)(rowbase + s) * DIN + UHY + c0;
                const u32x4 zc = *(const GAS u32x4*)p;
                u32x4 zm = (u32x4){0u, 0u, 0u, 0u}, zp = (u32x4){0u, 0u, 0u, 0u};
                if (s > 0) zm = *(const GAS u32x4*)(p - DIN);
                if (s < Ls - 1) zp = *(const GAS u32x4*)(p + DIN);
                const unsigned am[4] = {zm.x, zm.y, zm.z, zm.w}, ac[4] = {zc.x, zc.y, zc.z, zc.w}, ap[4] = {zp.x, zp.y, zp.z, zp.w};
#pragma unroll
                for (int i = 0; i < 4; ++i) {
                    const float v0 = bb[2 * i] + w0[2 * i] * bflo(am[i]) + w1[2 * i] * bflo(ac[i]) + w2[2 * i] * bflo(ap[i]);
                    const float v1 = bb[2 * i + 1] + w0[2 * i + 1] * bfhi(am[i]) + w1[2 * i + 1] * bfhi(ac[i]) + w2[2 * i + 1] * bfhi(ap[i]);
                    tile[(cseg * 8 + 2 * i) * 72 + sl] = (bf16_t)f2bf(v0); tile[(cseg * 8 + 2 * i + 1) * 72 + sl] = (bf16_t)f2bf(v1);
                }
            }
        } else {
            const int c0 = (blk - 12) * 64 + cseg * 8;
#pragma unroll 2
            for (int it = 0; it < 8; ++it) {
                const int sl = rsub + 8 * it, s = s0 + sl;
                const u32x4 zc = *(const GAS u32x4*)(U + (size_t)(rowbase + s) * DIN + UV + c0);
                const unsigned ac[4] = {zc.x, zc.y, zc.z, zc.w};
#pragma unroll
                for (int i = 0; i < 4; ++i) { tile[(cseg * 8 + 2 * i) * 72 + sl] = (bf16_t)(ac[i] & 0xffffu); tile[(cseg * 8 + 2 * i + 1) * 72 + sl] = (bf16_t)(ac[i] >> 16); }
            }
        }
        LDS_WAIT(); asm volatile("" ::: "memory");
#pragma unroll 2
        for (int it = 0; it < 8; ++it) {
            const int ch = rsub + 8 * it;
            const u32x4 v = *(const LAS u32x4*)(tile + ch * 72 + cseg * 8);
            bf16_t* dst;
            if (blk < 12) dst = (bf16_t*)(F.ws + WS_HV) + ((size_t)(blk * 64 + ch) * NB + b) * SPB + posbase + s0 + cseg * 8;
            else dst = (bf16_t*)(F.ws + WS_VT) + ((size_t)b * 512 + (blk - 12) * 64 + ch) * SPB + posbase + s0 + cseg * 8;
            *(GAS u32x4*)dst = v;
        }
        LDS_WAIT(); asm volatile("" ::: "memory");
    }
}

constexpr int NA_RPB = 0, NA_KC = 2048, NA_VC = NA_KC + 256 * 144, NA_KR = NA_VC + 64 * 528, NA_END = NA_KR + 9 * 64 * 144;
static_assert(NA_END <= MISC_OFF, "NA LDS map");
__device__ __forceinline__ bf16x8 gld16(const bf16_t* p) { return *(const GAS bf16x8*)p; }
__device__ __forceinline__ u32x2 gld8(const bf16_t* p) { return *(const GAS u32x2*)p; }
__device__ __forceinline__ const char* uni_ptr(const char* p) { const unsigned long long v = (unsigned long long)p; const unsigned lo = __builtin_amdgcn_readfirstlane((unsigned)v), hi = __builtin_amdgcn_readfirstlane((unsigned)(v >> 32)); return (const char*)(((unsigned long long)hi << 32) | lo); }
__device__ __forceinline__ bf16x8 gld16o(const char* ub, unsigned lo) { return *(const GAS bf16x8*)(ub + (size_t)lo); }
__device__ __forceinline__ u32x2 gld8o(const char* ub, unsigned lo) { return *(const GAS u32x2*)(ub + (size_t)lo); }
template <bool WIN>
__device__ __forceinline__ void na_unit(Frame& F, int b, int h, int r, int strip) {
    const bf16_t* U = (const bf16_t*)(F.ws + WS_U);
    const bf16_t* VT = (const bf16_t*)(F.ws + WS_VT) + ((size_t)b * 512 + h * 64) * SPB;
    const LAS float* rpb = (const LAS float*)(F.lds + NA_RPB);
    const LAS bf16_t* KC = (const LAS bf16_t*)(F.lds + NA_KC); const LAS bf16_t* VC = (const LAS bf16_t*)(F.lds + NA_VC);
    int ln_ = F.lane; asm volatile("" : "+v"(ln_));
    const int i = ln_ & 15, g = ln_ >> 4;
    const int qrow0 = WIN ? (b * SEQ + r * 64 + strip * 16) : (NLAT + b * CTXL + strip * 16);
    const int ki = 8 * (i >> 2) + (i & 3);
    const unsigned qlo = (unsigned)((i * DIN + 8 * g) * 2), klo = (unsigned)((ki * DIN + 8 * g) * 2), vlo = (unsigned)((i * SPB + 8 * g) * 2);
    const char* qb = uni_ptr((const char*)(U + (size_t)qrow0 * DIN + UQ + h * 64));
    const bf16x8 q0 = gld16o(qb, qlo), q1 = gld16o(qb + 64, qlo);
    int kr0 = 0, u0 = 0;
    if (WIN) { kr0 = r - 4; kr0 = kr0 < 0 ? 0 : (kr0 > 56 ? 56 : kr0); u0 = strip == 0 ? 0 : (strip == 1 ? 8 : (strip == 2 ? 24 : 32)); }
    const LAS bf16_t* KR = (const LAS bf16_t*)(F.lds + NA_KR);
    const char* vbase = uni_ptr((const char*)(VT + kr0 * 64 + u0));
    f32x4 o[4];
#pragma unroll
    for (int d = 0; d < 4; ++d) o[d] = (f32x4){0.f, 0.f, 0.f, 0.f};
    float lsum = 0.f;
#define NA_SB() __builtin_amdgcn_sched_barrier(0)
#define NA_WLOAD(vb_, cw) do { _Pragma("unroll") for (int d = 0; d < 4; ++d) vb_[d] = gld16o(vbase + ((size_t)(d * 16) * SPB + (cw) * 64) * 2, vlo); } while (0)
#define NA_KRING(kb_, cw) do { const LAS bf16_t* kp = KR + ((((kr0 + (cw)) % 9) * 64 + u0 + ki) * 72 + 8 * g); kb_[0][0] = *(const LAS bf16x8*)kp; kb_[0][1] = *(const LAS bf16x8*)(kp + 32); \
        kb_[1][0] = *(const LAS bf16x8*)(kp + 4 * 72); kb_[1][1] = *(const LAS bf16x8*)(kp + 4 * 72 + 32); } while (0)
#define NA_QK(kb_, s_) do { _Pragma("unroll") for (int t = 0; t < 2; ++t) { f32x4 a = (f32x4){0.f, 0.f, 0.f, 0.f}; a = mfma16(kb_[t][0], q0, a); a = mfma16(kb_[t][1], q1, a); s_[t] = a; } } while (0)
#define NA_PV(s_, vb_) do { u32x4 pw; pw.x = pk2(s_[0][0], s_[0][1]); pw.y = pk2(s_[0][2], s_[0][3]); pw.z = pk2(s_[1][0], s_[1][1]); pw.w = pk2(s_[1][2], s_[1][3]); const bf16x8 pf = __builtin_bit_cast(bf16x8, pw); \
        _Pragma("unroll") for (int d = 0; d < 4; ++d) o[d] = mfma16(vb_[d], pf, o[d]); } while (0)
    bf16x8 vA[4], vB[4], vC[4];
    if (WIN) { NA_WLOAD(vA, 0); NA_WLOAD(vB, 1); NA_WLOAD(vC, 2); NA_SB(); }
#pragma unroll
    for (int cc = 0; cc < 8; ++cc) {
        bf16x8 kc[2][2], vc[4]; f32x4 sc[2];
#pragma unroll
        for (int t = 0; t < 2; ++t) { const LAS bf16_t* kp = KC + (cc * 32 + ki + 4 * t) * 72 + 8 * g; kc[t][0] = *(const LAS bf16x8*)kp; kc[t][1] = *(const LAS bf16x8*)(kp + 32); }
#pragma unroll
        for (int d = 0; d < 4; ++d) vc[d] = *(const LAS bf16x8*)(VC + (d * 16 + i) * 264 + cc * 32 + 8 * g);
        NA_QK(kc, sc);
#pragma unroll
        for (int t = 0; t < 2; ++t)
#pragma unroll
            for (int e = 0; e < 4; ++e) { const float p = __expf(fminf(sc[t][e] * 0.125f, 60.f)); sc[t][e] = p; lsum += p; }
        NA_PV(sc, vc);
    }
    if (WIN) {
        const int c = strip * 16 + i; int kc0 = c - 8; kc0 = kc0 < 0 ? 0 : (kc0 > 48 ? 48 : kc0);
        int dcl[2][4]; bool okm[2][4];
#pragma unroll
        for (int t = 0; t < 2; ++t)
#pragma unroll
            for (int e = 0; e < 4; ++e) { const int kc = u0 + 8 * g + 4 * t + e; okm[t][e] = (kc >= kc0) && (kc < kc0 + 16); int dc = kc - c + 15; dcl[t][e] = dc < 0 ? 0 : (dc > 30 ? 30 : dc); }
#define NA_WCHUNK(vb_, cw) do { bf16x8 kw[2][2]; NA_KRING(kw, cw); f32x4 sw[2]; NA_QK(kw, sw); const LAS float* rp = rpb + (kr0 + (cw) - r + 7) * 31; \
        _Pragma("unroll") for (int t = 0; t < 2; ++t) _Pragma("unroll") for (int e = 0; e < 4; ++e) { const float x = sw[t][e] * 0.125f + rp[dcl[t][e]]; const float p = okm[t][e] ? __expf(fminf(x, 60.f)) : 0.f; sw[t][e] = p; lsum += p; } \
        NA_PV(sw, vb_); } while (0)
        NA_WCHUNK(vA, 0); NA_SB(); NA_WLOAD(vA, 3); NA_SB();
        NA_WCHUNK(vB, 1); NA_SB(); NA_WLOAD(vB, 4); NA_SB();
        NA_WCHUNK(vC, 2); NA_SB(); NA_WLOAD(vC, 5); NA_SB();
        NA_WCHUNK(vA, 3); NA_SB(); NA_WLOAD(vA, 6); NA_SB();
        NA_WCHUNK(vB, 4); NA_SB(); NA_WLOAD(vB, 7); NA_SB();
        NA_WCHUNK(vC, 5); NA_SB();
        NA_WCHUNK(vA, 6); NA_SB();
        NA_WCHUNK(vB, 7); NA_SB();
#undef NA_WCHUNK
    }
    lsum += shx(lsum, 16, ln_); lsum += shx(lsum, 32, ln_);
    const float inv = 1.0f / lsum;
    char* op = (char*)uni_ptr((const char*)((bf16_t*)(F.ws + WS_MIX) + (size_t)qrow0 * DM + h * 64)); const unsigned olo = (unsigned)((i * DM + 4 * g) * 2);
#pragma unroll
    for (int d = 0; d < 4; ++d) { u32x2 w; w.x = pk2(o[d][0] * inv, o[d][1] * inv); w.y = pk2(o[d][2] * inv, o[d][3] * inv); *(GAS u32x2*)(op + d * 32 + (size_t)olo) = w; }
#undef NA_SB
#undef NA_WLOAD
#undef NA_KRING
#undef NA_QK
#undef NA_PV
}
__device__ __forceinline__ int na_kr0(int r) { const int k = r - 4; return k < 0 ? 0 : (k > 56 ? 56 : k); }
__device__ __forceinline__ void ph_na(Frame& F, int l, bool last) {
    const bf16_t* U = (const bf16_t*)(F.ws + WS_U);
    for (int job = F.wg; job < NB * 8 * 2; job += F.G) {
        const int half = job & 1, h = (job >> 1) & 7, b = job >> 4;
        int tz_; asm volatile("v_mbcnt_lo_u32_b32 %0, -1, 0\n\tv_mbcnt_hi_u32_b32 %0, -1, %0" : "=v"(tz_)); tz_ |= F.wave << 6;
        const bf16_t* krow = U + (size_t)(b * SEQ + (tz_ >> 3)) * DIN + UK + h * 64 + (tz_ & 7) * 8;
        LAS bf16_t* kdst = (LAS bf16_t*)(F.lds + NA_KR) + (tz_ >> 3) * 72 + (tz_ & 7) * 8;
        __syncthreads();
        { LAS float* rpb = (LAS float*)(F.lds + NA_RPB); const float* rsrc = F.in[I_RPB] + ((size_t)l * 8 + h) * 15 * 31;
          if (tz_ < 15 * 31) rpb[tz_] = rsrc[tz_];
          const int key = tz_ >> 1, hf = tz_ & 1; const bf16_t* src = U + (size_t)(NLAT + b * CTXL + key) * DIN + UK + h * 64 + hf * 32; LAS bf16_t* dst = (LAS bf16_t*)(F.lds + NA_KC) + key * 72 + hf * 32;
#pragma unroll
          for (int j = 0; j < 4; ++j) *(LAS bf16x8*)(dst + j * 8) = gld16(src + j * 8);
          const int dv = tz_ >> 3, seg = tz_ & 7; const bf16_t* vs = (const bf16_t*)(F.ws + WS_VT) + ((size_t)b * 512 + h * 64 + dv) * SPB + SEQ + seg * 32; LAS bf16_t* vd = (LAS bf16_t*)(F.lds + NA_VC) + dv * 264 + seg * 32;
#pragma unroll
          for (int j = 0; j < 4; ++j) *(LAS bf16x8*)(vd + j * 8) = gld16(vs + j * 8);
          const int lo = na_kr0(half * 32), hi0 = na_kr0(half * 32 + 1) + 7;
          for (int kr = lo; kr <= hi0; ++kr) *(LAS bf16x8*)(kdst + (kr % 9) * 64 * 72) = gld16(krow + (size_t)kr * 64 * DIN); }
        __syncthreads();
        int prev_hi = na_kr0(half * 32 + 1) + 7;
#pragma unroll 1
        for (int s = 0; s < 16; ++s) {
            const int r0 = half * 32 + 2 * s;
            const int nhi = s < 15 ? na_kr0(r0 + 3) + 7 : prev_hi;
            bf16x8 n0 = (bf16x8){0, 0, 0, 0, 0, 0, 0, 0}, n1 = n0;
            if (nhi > prev_hi) n0 = gld16(krow + (size_t)(prev_hi + 1) * 64 * DIN);
            if (nhi > prev_hi + 1) n1 = gld16(krow + (size_t)(prev_hi + 2) * 64 * DIN);
            na_unit<true>(F, b, h, r0 + (F.wave >> 2), F.wave & 3);
            __syncthreads();
            if (nhi > prev_hi) *(LAS bf16x8*)(kdst + ((prev_hi + 1) % 9) * 64 * 72) = n0;
            if (nhi > prev_hi + 1) *(LAS bf16x8*)(kdst + ((prev_hi + 2) % 9) * 64 * 72) = n1;
            __syncthreads();
            prev_hi = nhi;
        }
        if (!last) na_unit<false>(F, b, h, 0, half * 8 + F.wave);
    }
}

__device__ __forceinline__ void ph_hy_transpose(Frame& F, bool last) {
    LAS bf16_t* tile = (LAS bf16_t*)(F.lds + F.wave * 16384);
    const bf16_t* HYO = (const bf16_t*)(F.ws + WS_Y);
    const int gw = F.wg * NWAVES + F.wave, NGW = F.G * NWAVES;
    const int rsub = F.lane >> 3, cseg = F.lane & 7;
    const int ntt = last ? 1024 : 1088;
    for (int u = gw; u < ntt * 4; u += NGW) {
        const int tt = u >> 2, cb = u & 3;
        int b, s0, rowbase, posbase;
        if (tt < 1024) { b = tt >> 6; s0 = (tt & 63) * 64; rowbase = b * SEQ; posbase = 0; }
        else { const int t2 = tt - 1024; b = t2 >> 2; s0 = (t2 & 3) * 64; rowbase = NLAT + b * CTXL; posbase = SEQ; }
#pragma unroll 2
        for (int it = 0; it < 8; ++it) { const int c = rsub + 8 * it;
            const u32x4 v = *(const GAS u32x4*)(HYO + ((size_t)(cb * 64 + c) * NB + b) * SPB + posbase + s0 + cseg * 8); const unsigned a[4] = {v.x, v.y, v.z, v.w};
#pragma unroll
            for (int e = 0; e < 4; ++e) { tile[(cseg * 8 + 2 * e) * 72 + c] = (bf16_t)(a[e] & 0xffffu); tile[(cseg * 8 + 2 * e + 1) * 72 + c] = (bf16_t)(a[e] >> 16); } }
        LDS_WAIT(); asm volatile("" ::: "memory");
#pragma unroll 2
        for (int it = 0; it < 8; ++it) { const int p = rsub + 8 * it;
            const u32x4 v = *(const LAS u32x4*)(tile + p * 72 + cseg * 8);
            *(GAS u32x4*)((bf16_t*)(F.ws + WS_MIX) + (size_t)(rowbase + s0 + p) * DM + 768 + cb * 64 + cseg * 8) = v; }
        LDS_WAIT(); asm volatile("" ::: "memory");
    }
}

constexpr int G2_LAF = 0, G2_LAB = 8448;
constexpr int G2_QTF = 16896, G2_KTF = 22016, G2_QTB = 27136, G2_KTB = 32256;
constexpr int G2_VT = 37376, G2_ATT = 46592;
constexpr int G2_SF = 55808, G2_SB = 60928;
constexpr int G2_SEG = 66048, G2_HALF = 67328;
__device__ __forceinline__ float log_sigmoid_f(float x) { return fminf(x, 0.f) - __logf(1.0f + __expf(-fabsf(x))); }
__device__ __forceinline__ f32x4 mma_lds(const LAS bf16_t* A, int lda, const LAS bf16_t* B, int ldb, int ksteps, f32x4 acc, int lane) {
    const int r = lane & 15, g = lane >> 4;
    for (int ks = 0; ks < ksteps; ++ks) { const bf16x8 a = *(const LAS bf16x8*)(A + r * lda + ks * 32 + 8 * g), b = *(const LAS bf16x8*)(B + r * ldb + ks * 32 + 8 * g); acc = mfma16(a, b, acc); }
    return acc;
}
__device__ __forceinline__ int gla_row0(int b, int cn) { return cn >= 4 ? b * SEQ + (cn - 4) * 64 : NLAT + b * CTXL + cn * 64; }
struct GlaRaw { u32x4 q, k, f, b, v0, v1, g0, g1, s0, s1; };
template <bool FULL>
__device__ __forceinline__ GlaRaw gla_load(Frame& F, int u, int tl) {
    const int h = u & 3, cn = (u >> 2) % 68, b = (u >> 2) / 68, i = tl >> 2, part = tl & 3;
    const bf16_t* p = (const bf16_t*)(F.ws + WS_U) + (size_t)(gla_row0(b, cn) + i) * DIN;
    GlaRaw r;
    r.q = *(const GAS u32x4*)(p + UGQ + h * 32 + part * 8); r.k = *(const GAS u32x4*)(p + UGK + h * 32 + part * 8);
    r.f = *(const GAS u32x4*)(p + ULAF + h * 32 + part * 8); r.b = *(const GAS u32x4*)(p + ULAB + h * 32 + part * 8);
    r.v0 = *(const GAS u32x4*)(p + UGV + h * 64 + part * 16); r.v1 = *(const GAS u32x4*)(p + UGV + h * 64 + part * 16 + 8);
    if (FULL) { r.g0 = *(const GAS u32x4*)(p + UGR + h * 64 + part * 16); r.g1 = *(const GAS u32x4*)(p + UGR + h * 64 + part * 16 + 8);
        const bf16_t* sp = (const bf16_t*)(F.ws + WS_GSIN) + (size_t)u * 2 * 2048 + tl * 16; r.s0 = *(const GAS u32x4*)sp; r.s1 = *(const GAS u32x4*)(sp + 8); }
    else { r.g0 = (u32x4){0u, 0u, 0u, 0u}; r.g1 = r.g0; r.s0 = r.g0; r.s1 = r.g0; }
    return r;
}
template <bool FULL>
__device__ __forceinline__ void gla_prep(Frame& F, LAS unsigned char* L, int l, int u, int tl, const GlaRaw& raw) {
    const int h = u & 3, cn = (u >> 2) % 68, i = tl >> 2, part = tl & 3, d8 = part * 8;
    LAS float* LAF = (LAS float*)(L + G2_LAF); LAS float* LAB = (LAS float*)(L + G2_LAB); LAS bf16_t* VT = (LAS bf16_t*)(L + G2_VT); LAS float* SEG = (LAS float*)(L + G2_SEG);
    float q[8], k[8], tf[8], tb[8];
    unpack8(raw.q, q); unpack8(raw.k, k); unpack8(raw.f, tf); unpack8(raw.b, tb);
    const float* ba = F.in[I_BA2] + (size_t)l * 256 + h * 32 + d8;
#pragma unroll
    for (int e = 0; e < 8; ++e) { q[e] *= 0.17677669529663687f; LAF[i * 33 + d8 + e] = log_sigmoid_f(tf[e] + ba[e]) * 0.0625f; LAB[i * 33 + d8 + e] = log_sigmoid_f(tb[e] + ba[128 + e]) * 0.0625f; }
    if (cn >= 4) {
        const float pos = (part >> 1) ? (float)i : (float)(cn - 4);
#pragma unroll
        for (int e = 0; e < 8; ++e) { const float ang = pos * __expf(-(float)e * (9.210340371976184f / 8.0f)); const float sn = __sinf(ang), cs = __cosf(ang);
            const float qo = shx(q[e], 1, F.lane), ko = shx(k[e], 1, F.lane);
            if (part & 1) { q[e] = qo * sn + q[e] * cs; k[e] = ko * sn + k[e] * cs; } else { q[e] = q[e] * cs - qo * sn; k[e] = k[e] * cs - ko * sn; } }
    }
    { const unsigned a[8] = {raw.v0.x, raw.v0.y, raw.v0.z, raw.v0.w, raw.v1.x, raw.v1.y, raw.v1.z, raw.v1.w};
#pragma unroll
      for (int e = 0; e < 8; ++e) { VT[(part * 16 + 2 * e) * 72 + i] = (bf16_t)(a[e] & 0xffffu); VT[(part * 16 + 2 * e + 1) * 72 + i] = (bf16_t)(a[e] >> 16); } }
    __syncthreads();
    { const int x = tl & 63, d = x & 31, dir = x >> 5, seg = tl >> 6; LAS float* LA = (dir ? LAB : LAF) + d; float cv[16];
#pragma unroll
      for (int kk = 0; kk < 16; ++kk) { const int p = seg * 16 + kk, ti = dir ? 63 - p : p; cv[kk] = LA[ti * 33]; }
#pragma unroll
      for (int kk = 1; kk < 16; ++kk) cv[kk] += cv[kk - 1];
#pragma unroll
      for (int kk = 0; kk < 16; ++kk) { const int p = seg * 16 + kk, ti = dir ? 63 - p : p; LA[ti * 33] = cv[kk]; }
      SEG[x * 5 + seg] = cv[15]; }
    __syncthreads();
    { const int x = tl & 63, d = x & 31, dir = x >> 5, seg = tl >> 6; LAS float* LA = (dir ? LAB : LAF) + d; float cv[16];
      const float t0 = SEG[x * 5 + 0], t1 = SEG[x * 5 + 1], t2 = SEG[x * 5 + 2];
      const float pre = seg == 0 ? 0.f : (seg == 1 ? t0 : (seg == 2 ? t0 + t1 : t0 + t1 + t2));
#pragma unroll
      for (int kk = 0; kk < 16; ++kk) { const int p = seg * 16 + kk, ti = dir ? 63 - p : p; cv[kk] = LA[ti * 33]; }
#pragma unroll
      for (int kk = 0; kk < 16; ++kk) { const int p = seg * 16 + kk, ti = dir ? 63 - p : p; LA[ti * 33] = cv[kk] + pre; } }
    __syncthreads();
    if (FULL) {
        unsigned wqf[4], wkf[4], wqb[4], wkb[4];
#pragma unroll
        for (int e = 0; e < 4; ++e) { const int d = d8 + 2 * e; const float f0 = LAF[i * 33 + d], f1 = LAF[i * 33 + d + 1], b0 = LAB[i * 33 + d], b1 = LAB[i * 33 + d + 1];
            wqf[e] = pk2(q[2 * e] * __expf(f0), q[2 * e + 1] * __expf(f1)); wkf[e] = pk2(k[2 * e] * __expf(-f0), k[2 * e + 1] * __expf(-f1));
            wqb[e] = pk2(q[2 * e] * __expf(b0), q[2 * e + 1] * __expf(b1)); wkb[e] = pk2(k[2 * e] * __expf(-b0), k[2 * e + 1] * __expf(-b1)); }
        *(LAS u32x4*)((LAS bf16_t*)(L + G2_QTF) + i * 40 + d8) = (u32x4){wqf[0], wqf[1], wqf[2], wqf[3]}; *(LAS u32x4*)((LAS bf16_t*)(L + G2_KTF) + i * 40 + d8) = (u32x4){wkf[0], wkf[1], wkf[2], wkf[3]};
        *(LAS u32x4*)((LAS bf16_t*)(L + G2_QTB) + i * 40 + d8) = (u32x4){wqb[0], wqb[1], wqb[2], wqb[3]}; *(LAS u32x4*)((LAS bf16_t*)(L + G2_KTB) + i * 40 + d8) = (u32x4){wkb[0], wkb[1], wkb[2], wkb[3]};
    } else {
        LAS bf16_t* KDF = (LAS bf16_t*)(L + G2_QTF); LAS bf16_t* KDB = (LAS bf16_t*)(L + G2_KTF);
#pragma unroll
        for (int e = 0; e < 8; ++e) { const int d = d8 + e; const float bf = LAF[i * 33 + d], bb = LAB[i * 33 + d], bfl = LAF[63 * 33 + d], bbl = LAB[0 * 33 + d];
            KDF[d * 72 + i] = (bf16_t)f2bf(k[e] * __expf(bfl - bf)); KDB[d * 72 + i] = (bf16_t)f2bf(k[e] * __expf(bbl - bb)); }
    }
    __syncthreads();
}
__device__ __forceinline__ void ph_gla_local(Frame& F, int l) {
    const int hw = F.wave >> 2, wl = F.wave & 3, tl = F.tid & 255; LAS unsigned char* L = F.lds + hw * G2_HALF;
    constexpr int NU = NB * 68 * 4;
    int pp = F.wg;
    GlaRaw raw = gla_load<false>(F, (pp * 2 + hw) < NU ? pp * 2 + hw : 0, tl);
    for (; pp * 2 < NU; pp += F.G) {
        const int u = pp * 2 + hw, un = (pp + F.G) * 2 + hw;
        const GlaRaw nraw = gla_load<false>(F, un < NU ? un : u, tl);
        __syncthreads();
        gla_prep<false>(F, L, l, u, tl, raw);
        const int g = F.lane >> 4, c = F.lane & 15;
        float* DS = (float*)(F.ws + WS_GDS) + (size_t)u * 2 * 2048;
#pragma unroll
        for (int kk = 0; kk < 4; ++kk) { const int tix = wl * 4 + kk, dir = tix >> 3, mt = (tix >> 1) & 3, nt = tix & 1;
            f32x4 a = (f32x4){0.f, 0.f, 0.f, 0.f};
            a = mma_lds((const LAS bf16_t*)(L + G2_VT) + mt * 16 * 72, 72, (const LAS bf16_t*)(L + (dir ? G2_KTF : G2_QTF)) + nt * 16 * 72, 72, 2, a, F.lane);
#pragma unroll
            for (int e = 0; e < 4; ++e) DS[dir * 2048 + (mt * 16 + 4 * g + e) * 32 + nt * 16 + c] = a[e]; }
        if (tl < 64) { const int d = tl & 31, dir = tl >> 5; ((float*)(F.ws + WS_GD))[(size_t)u * 64 + tl] = __expf(dir ? ((LAS float*)(L + G2_LAB))[0 * 33 + d] : ((LAS float*)(L + G2_LAF))[63 * 33 + d]); }
        raw = nraw;
    }
}
__device__ __forceinline__ void ph_gla_scan(Frame& F) {
    const int gt = F.wg * NTHR + F.tid, NGT = F.G * NTHR;
    const float* DS = (const float*)(F.ws + WS_GDS); const float* GD = (const float*)(F.ws + WS_GD); bf16_t* SIN = (bf16_t*)(F.ws + WS_GSIN);
    for (int w = gt; w < 128 * 1024; w += NGT) {
        const int chain = w >> 10, el = (w & 1023) * 2, dir = chain & 1, h = (chain >> 1) & 3, b = chain >> 3, d = el & 31;
        float s0 = 0.f, s1 = 0.f;
        for (int step = 0; step < 68; step += 4) {
            f32x2 ds[4], dd[4]; size_t uu[4];
#pragma unroll
            for (int q = 0; q < 4; ++q) { const int st_ = step + q; const int cn = dir ? (st_ < 4 ? 3 - st_ : 71 - st_) : st_;
                uu[q] = (size_t)(b * 68 + cn) * 4 + h;
                ds[q] = *(const GAS f32x2*)(DS + (uu[q] * 2 + dir) * 2048 + el); dd[q] = *(const GAS f32x2*)(GD + uu[q] * 64 + dir * 32 + d); }
#pragma unroll
            for (int q = 0; q < 4; ++q) { *(GAS unsigned*)(SIN + (uu[q] * 2 + dir) * 2048 + el) = pk2(s0, s1); s0 = dd[q].x * s0 + ds[q].x; s1 = dd[q].y * s1 + ds[q].y; }
        }
    }
}
__device__ __forceinline__ void ph_gla_out(Frame& F, int l, bool last) {
    const int hw = F.wave >> 2, wl = F.wave & 3, tl = F.tid & 255; LAS unsigned char* L = F.lds + hw * G2_HALF;
    const int NV = last ? NB * 64 * 4 : NB * 68 * 4;
#define GLA_UNIT(v) (last ? ((((v) >> 8) * 68 + 4 + (((v) & 255) >> 2)) * 4 + ((v) & 3)) : (v))
    int pp = F.wg;
    GlaRaw raw = gla_load<true>(F, GLA_UNIT((pp * 2 + hw) < NV ? pp * 2 + hw : 0), tl);
    for (; pp * 2 < NV; pp += F.G) {
        const int u = GLA_UNIT(pp * 2 + hw), vn = (pp + F.G) * 2 + hw;
        const GlaRaw nraw = gla_load<true>(F, vn < NV ? GLA_UNIT(vn) : u, tl);
        const int h = u & 3, cn = (u >> 2) % 68, b = (u >> 2) / 68;
        __syncthreads();
        gla_prep<true>(F, L, l, u, tl, raw);
        { const int dir = tl >> 7, dv = (tl >> 1) & 63, d16 = (tl & 1) * 16; LAS bf16_t* S = (LAS bf16_t*)(L + (dir ? G2_SB : G2_SF)) + dv * 40 + d16; *(LAS u32x4*)S = raw.s0; *(LAS u32x4*)(S + 8) = raw.s1; }
        const int g = F.lane >> 4, c = F.lane & 15;
        LAS bf16_t* ATT = (LAS bf16_t*)(L + G2_ATT);
#pragma unroll
        for (int kk = 0; kk < 4; ++kk) { const int tile = wl * 4 + kk, mt = tile >> 2, nt = tile & 3;
            f32x4 af = (f32x4){0.f, 0.f, 0.f, 0.f}, ab = af;
            af = mma_lds((const LAS bf16_t*)(L + G2_QTF) + mt * 16 * 40, 40, (const LAS bf16_t*)(L + G2_KTF) + nt * 16 * 40, 40, 1, af, F.lane);
            ab = mma_lds((const LAS bf16_t*)(L + G2_QTB) + mt * 16 * 40, 40, (const LAS bf16_t*)(L + G2_KTB) + nt * 16 * 40, 40, 1, ab, F.lane);
#pragma unroll
            for (int e = 0; e < 4; ++e) { const int ii = mt * 16 + 4 * g + e, j = nt * 16 + c; const float vv = (j <= ii ? af[e] : 0.f) + (j >= ii ? ab[e] : 0.f); ATT[ii * 72 + j] = (bf16_t)f2bf(vv); } }
        __syncthreads();
        LAS float* O = (LAS float*)(L + G2_LAF);
#pragma unroll
        for (int kk = 0; kk < 4; ++kk) { const int tile = wl * 4 + kk, mt = tile >> 2, nt = tile & 3;
            f32x4 a = (f32x4){0.f, 0.f, 0.f, 0.f};
            a = mma_lds(ATT + mt * 16 * 72, 72, (const LAS bf16_t*)(L + G2_VT) + nt * 16 * 72, 72, 2, a, F.lane);
            a = mma_lds((const LAS bf16_t*)(L + G2_QTF) + mt * 16 * 40, 40, (const LAS bf16_t*)(L + G2_SF) + nt * 16 * 40, 40, 1, a, F.lane);
            a = mma_lds((const LAS bf16_t*)(L + G2_QTB) + mt * 16 * 40, 40, (const LAS bf16_t*)(L + G2_SB) + nt * 16 * 40, 40, 1, a, F.lane);
#pragma unroll
            for (int e = 0; e < 4; ++e) O[(mt * 16 + 4 * g + e) * 65 + nt * 16 + c] = a[e]; }
        __syncthreads();
        { const int i = tl >> 2, dv16 = (tl & 3) * 16; const int row = gla_row0(b, cn) + i;
          float v[16], gt[16]; float ss = 0.f;
#pragma unroll
          for (int e = 0; e < 16; ++e) { v[e] = O[i * 65 + dv16 + e]; ss += v[e] * v[e]; }
          ss += shx(ss, 1, F.lane); ss += shx(ss, 2, F.lane);
          const float rs = 1.0f / sqrtf(ss * (1.0f / 64.0f) + LN_EPS);
          unpack8(raw.g0, gt); unpack8(raw.g1, gt + 8);
          const float* gn = F.in[I_GNORM] + l * 64 + dv16;
          unsigned w[8];
#pragma unroll
          for (int e = 0; e < 8; ++e) w[e] = pk2(v[2 * e] * rs * gn[2 * e] * silu_f(gt[2 * e]), v[2 * e + 1] * rs * gn[2 * e + 1] * silu_f(gt[2 * e + 1]));
          bf16_t* mp = (bf16_t*)(F.ws + WS_MIX) + (size_t)row * DM + 512 + h * 64 + dv16;
          *(GAS u32x4*)mp = (u32x4){w[0], w[1], w[2], w[3]}; *(GAS u32x4*)(mp + 8) = (u32x4){w[4], w[5], w[6], w[7]}; }
        raw = nraw;
    }
#undef GLA_UNIT
}

template <int L>
__device__ __forceinline__ void hyena_conv(Frame& F, const bf16_t* Rg, const bf16_t* Uin, const bf16_t* Xmul, int pos0, bool final_out, int ch, bf16_t* Zout) {
    constexpr int CS = 2 * L + 16;
    constexpr int NTL = L / 16, J = (NTL >= 64) ? 16 : 2, NGRP = NTL / J, HJ = J / 2, NSTEP = L / 32;
    LAS bf16_t* Rl = (LAS bf16_t*)F.lds;
    __syncthreads();
    for (int c = F.tid; c < 2 * L / 8; c += NTHR) { const u32x4 v = *(const GAS u32x4*)(Rg + 8 * c); const unsigned a[4] = {v.x, v.y, v.z, v.w};
#pragma unroll
        for (int rho = 0; rho < 8; ++rho) { LAS bf16_t* d = Rl + rho * CS + 8 * c + rho;
#pragma unroll
            for (int k = 0; k < 4; ++k) { d[2 * k] = (bf16_t)(a[k] & 0xffffu); d[2 * k + 1] = (bf16_t)(a[k] >> 16); } } }
    __syncthreads();
    int ln_ = F.lane; asm volatile("" : "+v"(ln_));
    const int i = ln_ & 15, g = ln_ >> 4, rho = i & 7;
    const LAS bf16_t* Rc = Rl + rho * CS + rho;
    for (int grp = F.wave; grp < NGRP; grp += NWAVES) {
        f32x4 acc[J]; bf16x8 fr[J];
        const int tb = grp * J * 16;
        const LAS bf16_t* Rb = Rc + (L - tb - i + 8 * g);
#pragma unroll
        for (int j = 0; j < J; ++j) { acc[j] = (f32x4){0.f, 0.f, 0.f, 0.f}; fr[j] = *(const LAS bf16x8*)(Rb - 16 * j); }
        const char* ub = (const char*)(Uin + pos0); const unsigned ulo = (unsigned)((i * SPB + 8 * g) * 2);
        constexpr int PF = (HJ >= 4) ? 4 : 1;
        bf16x8 bq[PF];
#pragma unroll
        for (int p = 0; p < PF; ++p) bq[p] = *(const GAS bf16x8*)(ub + (size_t)(ulo + (unsigned)p * 64u));
#pragma unroll 1
        for (int q = 0; q < NSTEP / HJ; ++q) {
#pragma unroll
            for (int m = 0; m < HJ; ++m) {
                const int n = q * HJ + m;
                const int nn = (n + PF < NSTEP) ? n + PF : 0;
                if (n > 0) { fr[(J - 2 * m) % J] = *(const LAS bf16x8*)(Rb + 32 * n); fr[(J + 1 - 2 * m) % J] = *(const LAS bf16x8*)(Rb + 32 * n - 16); }
                const bf16x8 bcur = bq[m % PF];
#pragma unroll
                for (int jj = 0; jj < J; ++jj) { const int j = (jj + 2) % J; acc[j] = mfma16(fr[(j + J - 2 * m) % J], bcur, acc[j]); }
                bq[m % PF] = *(const GAS bf16x8*)(ub + (size_t)(ulo + (unsigned)nn * 64u));
            }
        }
#pragma unroll
        for (int j = 0; j < J; ++j) { const int t0 = tb + j * 16 + 4 * g;
            const u32x2 xw = *(const GAS u32x2*)(Xmul + (size_t)i * SPB + pos0 + t0);
            const float y0 = acc[j][0] * bflo(xw.x), y1 = acc[j][1] * bfhi(xw.x), y2 = acc[j][2] * bflo(xw.y), y3 = acc[j][3] * bfhi(xw.y);
            if (!final_out) { u32x2 w; w.x = pk2(y0, y1); w.y = pk2(y2, y3); *(GAS u32x2*)(Zout + (size_t)i * SPB + pos0 + t0) = w; }
            else { u32x2 w; w.x = pk2(y0, y1); w.y = pk2(y2, y3); *(GAS u32x2*)((bf16_t*)(F.ws + WS_Y) + ((size_t)ch * NB + i) * SPB + pos0 + t0) = w; } }
    }
}
__device__ __forceinline__ void ph_hyena(Frame& F, int l, bool last) {
    const bf16_t* HV = (const bf16_t*)(F.ws + WS_HV); bf16_t* Z2 = (bf16_t*)(F.ws + WS_Z2);
    for (int ch = F.wg; ch < 256; ch += F.G) {
        const bf16_t* v = HV + (size_t)(0 * 256 + ch) * NB * SPB; const bf16_t* x1 = HV + (size_t)(256 + ch) * NB * SPB; const bf16_t* x2 = HV + (size_t)(512 + ch) * NB * SPB;
        bf16_t* z = Z2 + (size_t)ch * NB * SPB;
        const bf16_t* R0 = (const bf16_t*)(F.ws + WS_HYF) + ((size_t)(l * 2 + 0) * 256 + ch) * 8192; const bf16_t* R1 = (const bf16_t*)(F.ws + WS_HYF) + ((size_t)(l * 2 + 1) * 256 + ch) * 8192;
        hyena_conv<4096>(F, R0, v, x1, 0, false, ch, z);
        VM_WAIT(); __syncthreads(); __builtin_amdgcn_fence(__ATOMIC_ACQUIRE, "agent"); VM_WAIT();
        hyena_conv<4096>(F, R1, z, x2, 0, true, ch, z);
        if (!last) {
            const bf16_t* C0 = (const bf16_t*)(F.ws + WS_HYFC) + ((size_t)(l * 2 + 0) * 256 + ch) * 512; const bf16_t* C1 = (const bf16_t*)(F.ws + WS_HYFC) + ((size_t)(l * 2 + 1) * 256 + ch) * 512;
            hyena_conv<256>(F, C0, v, x1, SEQ, false, ch, z);
            VM_WAIT(); __syncthreads(); __builtin_amdgcn_fence(__ATOMIC_ACQUIRE, "agent"); VM_WAIT();
            hyena_conv<256>(F, C1, z, x2, SEQ, true, ch, z);
        }
    }
}

__device__ __forceinline__ void ph_ln1(Frame& F, int l, int ntok) {
    const int gw = F.wg * NWAVES + F.wave, NGW = F.G * NWAVES;
    const float* lg = F.in[I_LN1G] + l * DM + 16 * F.lane; const float* lb = F.in[I_LN1B] + l * DM + 16 * F.lane;
    for (int row = gw; row < ntok; row += NGW) {
        bf16_t* xr = (bf16_t*)(F.ws + WS_XR) + (size_t)row * DM + 16 * F.lane;
        const bf16_t* yr = (const bf16_t*)(F.ws + WS_Y) + (size_t)row * DM + 16 * F.lane;
        const float* md = mod_ptr(F, l, row) + 16 * F.lane;
        bf16_t* xm = (bf16_t*)(F.ws + WS_XM) + (size_t)row * DM + 16 * F.lane;
        const u32x4 xa = *(const GAS u32x4*)xr, xb = *(const GAS u32x4*)(xr + 8), ya = *(const GAS u32x4*)yr, yb = *(const GAS u32x4*)(yr + 8);
        float x[16], y[16], v[16]; unpack8(xa, x); unpack8(xb, x + 8); unpack8(ya, y); unpack8(yb, y + 8);
        float s = 0.f;
#pragma unroll
        for (int j = 0; j < 4; ++j) { const f32x4 g1 = *(const GAS f32x4*)(md + 2048 + 4 * j);
#pragma unroll
            for (int e = 0; e < 4; ++e) { v[4 * j + e] = x[4 * j + e] * DN_ALPHA + g1[e] * y[4 * j + e]; s += v[4 * j + e]; } }
        const float mean = wave_sum(s, F.lane) * (1.f / DM); float s2 = 0.f;
#pragma unroll
        for (int e = 0; e < 16; ++e) { v[e] -= mean; s2 += v[e] * v[e]; }
        const float rstd = 1.f / sqrtf(wave_sum(s2, F.lane) * (1.f / DM) + LN_EPS);
        unsigned wx[8], wm[8]; int w8[4];
#pragma unroll
        for (int j = 0; j < 4; ++j) { const f32x4 g = *(const GAS f32x4*)(lg + 4 * j), bb = *(const GAS f32x4*)(lb + 4 * j), sh = *(const GAS f32x4*)(md + 3072 + 4 * j), sc = *(const GAS f32x4*)(md + 4096 + 4 * j);
            float xn[4];
#pragma unroll
            for (int e = 0; e < 4; ++e) xn[e] = v[4 * j + e] * rstd * g[e] + bb[e];
            wx[2 * j] = pk2(xn[0], xn[1]); wx[2 * j + 1] = pk2(xn[2], xn[3]);
            const float h0 = xn[0] * (1.f + sc[0]) + sh[0], h1 = xn[1] * (1.f + sc[1]) + sh[1], h2 = xn[2] * (1.f + sc[2]) + sh[2], h3 = xn[3] * (1.f + sc[3]) + sh[3];
            wm[2 * j] = pk2(h0, h1); wm[2 * j + 1] = pk2(h2, h3);
            int v = 0; v = __builtin_amdgcn_cvt_pk_fp8_f32(h0, h1, v, false); v = __builtin_amdgcn_cvt_pk_fp8_f32(h2, h3, v, true); w8[j] = v; }
        *(GAS u32x4*)((unsigned char*)(F.ws + WS_XM8) + (size_t)row * DM + 16 * F.lane) = (u32x4){(unsigned)w8[0], (unsigned)w8[1], (unsigned)w8[2], (unsigned)w8[3]};
        *(GAS u32x4*)xr = (u32x4){wx[0], wx[1], wx[2], wx[3]}; *(GAS u32x4*)(xr + 8) = (u32x4){wx[4], wx[5], wx[6], wx[7]};
        *(GAS u32x4*)xm = (u32x4){wm[0], wm[1], wm[2], wm[3]}; *(GAS u32x4*)(xm + 8) = (u32x4){wm[4], wm[5], wm[6], wm[7]};
    }
}
__device__ __forceinline__ void ph_ln2(Frame& F, int l, int ntok, bool last) {
    const int gw = F.wg * NWAVES + F.wave, NGW = F.G * NWAVES;
    const int cA = 256 * (F.lane >> 4) + 32 * ((F.lane >> 2) & 3) + 8 * (F.lane & 3);
#define LN2_COL(j) (cA + ((j) < 2 ? 4 * (j) : 128 + 4 * ((j) - 2)))
    const float* lg = F.in[I_LN2G] + l * DM; const float* lb = F.in[I_LN2B] + l * DM;
    for (int row = gw; row < ntok; row += NGW) {
        bf16_t* xr = (bf16_t*)(F.ws + WS_XR) + (size_t)row * DM;
        const unsigned char* y2 = (const unsigned char*)(F.ws + WS_Y2) + (size_t)row * 9 * DM + 16 * F.lane;
        const float* wg = (const float*)(F.ws + WS_WGT) + (size_t)row * 8;
        const float* md = mod_ptr(F, l, row);
        float ff[16];
#pragma unroll
        for (int e = 0; e < 16; ++e) ff[e] = 0.f;
        u32x4 q[9];
#pragma unroll
        for (int k = 0; k < 9; ++k) q[k] = *(const GAS u32x4*)(y2 + (size_t)k * DM);
#pragma unroll
        for (int k = 0; k < 9; ++k) { const float wk = (k < 8 ? wg[k] : 1.0f) * pg8::Y2_INV; const unsigned a[4] = {q[k].x, q[k].y, q[k].z, q[k].w};
#pragma unroll
            for (int e = 0; e < 4; ++e) { const f32x2 lo = __builtin_amdgcn_cvt_pk_f32_fp8((int)a[e], false), hi = __builtin_amdgcn_cvt_pk_f32_fp8((int)a[e], true);
                ff[4 * e] += wk * lo.x; ff[4 * e + 1] += wk * lo.y; ff[4 * e + 2] += wk * hi.x; ff[4 * e + 3] += wk * hi.y; } }
        float v[16], xo[16]; float s = 0.f;
        { const u32x4 xa = *(const GAS u32x4*)(xr + cA), xb = *(const GAS u32x4*)(xr + cA + 128); unpack8(xa, xo); unpack8(xb, xo + 8); }
#pragma unroll
        for (int j = 0; j < 4; ++j) { const f32x4 g2 = *(const GAS f32x4*)(md + 5120 + LN2_COL(j));
#pragma unroll
            for (int e = 0; e < 4; ++e) { v[4 * j + e] = xo[4 * j + e] * DN_ALPHA + g2[e] * ff[4 * j + e]; s += v[4 * j + e]; } }
        const float mean = wave_sum(s, F.lane) * (1.f / DM); float s2 = 0.f;
#pragma unroll
        for (int e = 0; e < 16; ++e) { v[e] -= mean; s2 += v[e] * v[e]; }
        const float rstd = 1.f / sqrtf(wave_sum(s2, F.lane) * (1.f / DM) + LN_EPS);
        const float* mdn = last ? md : mod_ptr(F, l + 1, row);
        float xn[16];
#pragma unroll
        for (int j = 0; j < 4; ++j) { const f32x4 g = *(const GAS f32x4*)(lg + LN2_COL(j)), bb = *(const GAS f32x4*)(lb + LN2_COL(j));
#pragma unroll
            for (int e = 0; e < 4; ++e) xn[4 * j + e] = v[4 * j + e] * rstd * g[e] + bb[e]; }
        if (last) { float* op = F.out + (size_t)row * DM;
#pragma unroll
            for (int j = 0; j < 4; ++j) *(GAS f32x4*)(op + LN2_COL(j)) = (f32x4){xn[4 * j], xn[4 * j + 1], xn[4 * j + 2], xn[4 * j + 3]}; }
        else {
            *(GAS u32x4*)(xr + cA) = (u32x4){pk2(xn[0], xn[1]), pk2(xn[2], xn[3]), pk2(xn[4], xn[5]), pk2(xn[6], xn[7])}; *(GAS u32x4*)(xr + cA + 128) = (u32x4){pk2(xn[8], xn[9]), pk2(xn[10], xn[11]), pk2(xn[12], xn[13]), pk2(xn[14], xn[15])};
            bf16_t* xm = (bf16_t*)(F.ws + WS_XM) + (size_t)row * DM;
            unsigned w[8];
#pragma unroll
            for (int j = 0; j < 4; ++j) { const f32x4 sh = *(const GAS f32x4*)(mdn + LN2_COL(j)), sc = *(const GAS f32x4*)(mdn + 1024 + LN2_COL(j));
                w[2 * j] = pk2(xn[4 * j] * (1.f + sc[0]) + sh[0], xn[4 * j + 1] * (1.f + sc[1]) + sh[1]); w[2 * j + 1] = pk2(xn[4 * j + 2] * (1.f + sc[2]) + sh[2], xn[4 * j + 3] * (1.f + sc[3]) + sh[3]); }
            *(GAS u32x4*)(xm + cA) = (u32x4){w[0], w[1], w[2], w[3]}; *(GAS u32x4*)(xm + cA + 128) = (u32x4){w[4], w[5], w[6], w[7]};
        }
    }
#undef LN2_COL
}

__device__ __forceinline__ unsigned f_ord(float f) { const unsigned u = __builtin_bit_cast(unsigned, f); return (u & 0x80000000u) ? ~u : (u | 0x80000000u); }
__device__ __forceinline__ unsigned long long wave_max_u64(unsigned long long v, int lane) {
#pragma unroll
    for (int o = 1; o < 64; o <<= 1) { const unsigned lo = (unsigned)shxi((int)(unsigned)v, o, lane), hi = (unsigned)shxi((int)(unsigned)(v >> 32), o, lane); const unsigned long long w = ((unsigned long long)hi << 32) | lo; v = w > v ? w : v; }
    return v;
}
__device__ __forceinline__ float seg16_max(float v, int lane) { v = fmaxf(v, shx(v, 1, lane)); v = fmaxf(v, shx(v, 2, lane)); v = fmaxf(v, shx(v, 4, lane)); v = fmaxf(v, shx(v, 8, lane)); return v; }
__device__ __forceinline__ int seg16_min_i(int v, int lane) { int w; w = shxi(v, 1, lane); v = w < v ? w : v; w = shxi(v, 2, lane); v = w < v ? w : v; w = shxi(v, 4, lane); v = w < v ? w : v; w = shxi(v, 8, lane); v = w < v ? w : v; return v; }
__device__ __forceinline__ float seg16_top2(float v, int lane) {
    const float m1 = seg16_max(v, lane);
    const int first = seg16_min_i(v == m1 ? (lane & 15) : 99, lane);
    const float m2 = seg16_max((lane & 15) == first ? -3.0e38f : v, lane);
    return m1 + m2;
}
__device__ __forceinline__ void ph_route(Frame& F, int l, int ntok) {
    LAS int* hist = (LAS int*)F.lds;
    LAS int* base = hist + 128;
    LAS unsigned* alist = (LAS unsigned*)(F.lds + 1024);
    const int tpw = (ntok + F.G - 1) / F.G, t0 = F.wg * tpw, t1 = (t0 + tpw) < ntok ? (t0 + tpw) : ntok;
    __syncthreads();
    if (F.tid < 128) hist[F.tid] = 0;
    __syncthreads();
    const float* LG = (const float*)(F.ws + WS_LOGIT); const float* rb = F.in[I_RB] + l * NEXP;
    const float b0 = rb[F.lane], b1 = rb[F.lane + 64];
    constexpr int RT = 4;
    for (int tb = t0 + F.wave * RT; tb < t1; tb += NWAVES * RT) {
        float s0[RT], s1[RT], e0[RT], e1[RT], gs0[RT], gs1[RT]; unsigned long long k0[RT], k1[RT]; int mye[RT]; float myw[RT], wsum[RT];
#pragma unroll
        for (int j = 0; j < RT; ++j) { const int tok = (tb + j) < t1 ? tb + j : t1 - 1;
            const float x0 = LG[(size_t)tok * 256 + F.lane], x1 = LG[(size_t)tok * 256 + 64 + F.lane];
            s0[j] = __builtin_amdgcn_rcpf(1.0f + __expf(-x0)); s1[j] = __builtin_amdgcn_rcpf(1.0f + __expf(-x1)); e0[j] = s0[j] + b0; e1[j] = s1[j] + b1; }
#pragma unroll
        for (int j = 0; j < RT; ++j) { gs0[j] = seg16_top2(e0[j], F.lane); gs1[j] = seg16_top2(e1[j], F.lane); }
#pragma unroll
        for (int j = 0; j < RT; ++j) {
            float gsc[8];
#pragma unroll
            for (int g = 0; g < 4; ++g) { gsc[g] = shf(gs0[j], g * 16); gsc[4 + g] = shf(gs1[j], g * 16); }
            unsigned gmask = 0u;
#pragma unroll
            for (int g = 0; g < 8; ++g) { int cnt = 0;
#pragma unroll
                for (int g2 = 0; g2 < 8; ++g2) cnt += (gsc[g2] > gsc[g] || (gsc[g2] == gsc[g] && g2 < g)) ? 1 : 0;
                gmask |= (cnt < 4) ? (1u << g) : 0u; }
            const bool ok0 = (gmask >> (F.lane >> 4)) & 1u, ok1 = (gmask >> (4 + (F.lane >> 4))) & 1u;
            k0[j] = ok0 ? (((unsigned long long)f_ord(e0[j]) << 32) | (unsigned)(255 - F.lane)) : 0ull;
            k1[j] = ok1 ? (((unsigned long long)f_ord(e1[j]) << 32) | (unsigned)(255 - 64 - F.lane)) : 0ull;
            mye[j] = 0; myw[j] = 0.f; wsum[j] = 0.f; }
#pragma unroll
        for (int k = 0; k < 8; ++k) {
            unsigned long long best[RT];
#pragma unroll
            for (int j = 0; j < RT; ++j) best[j] = k0[j] > k1[j] ? k0[j] : k1[j];
#pragma unroll
            for (int o = 1; o < 64; o <<= 1) {
#pragma unroll
                for (int j = 0; j < RT; ++j) { const unsigned lo = (unsigned)shxi((int)(unsigned)best[j], o, F.lane), hi = (unsigned)shxi((int)(unsigned)(best[j] >> 32), o, F.lane);
                    const unsigned long long w = ((unsigned long long)hi << 32) | lo; best[j] = w > best[j] ? w : best[j]; } }
#pragma unroll
            for (int j = 0; j < RT; ++j) { const int e = 255 - (int)(best[j] & 0xffu);
                if (k0[j] == best[j]) k0[j] = 0ull; if (k1[j] == best[j]) k1[j] = 0ull;
                const float sv = shf(e < 64 ? s0[j] : s1[j], e & 63);
                wsum[j] += sv; if (F.lane == k) { mye[j] = e; myw[j] = sv; } }
        }
#pragma unroll
        for (int j = 0; j < RT; ++j) { const int tok = tb + j;
            if (tok < t1 && F.lane < 8) {
                const int lr = __hip_atomic_fetch_add(&hist[mye[j]], 1, __ATOMIC_RELAXED, __HIP_MEMORY_SCOPE_WORKGROUP);
                alist[(tok - t0) * 8 + F.lane] = (unsigned)mye[j] | ((unsigned)lr << 8);
                ((int*)(F.ws + WS_EIDX))[(size_t)tok * 8 + F.lane] = mye[j];
                ((float*)(F.ws + WS_WGT))[(size_t)tok * 8 + F.lane] = myw[j] / wsum[j] * 2.5f;
            } }
    }
    __syncthreads();
    if (F.tid < 128) { const int hcount = hist[F.tid]; base[F.tid] = hcount ? (int)atomicAdd(F.ctl + CW_CNT + l * 256 + F.tid, (unsigned)hcount) : 0; }
    __syncthreads();
    for (int a = F.tid; a < (t1 - t0) * 8; a += NTHR) { const unsigned v = alist[a]; ((int*)(F.ws + WS_RNK))[(size_t)t0 * 8 + a] = base[v & 0xffu] + (int)(v >> 8); }
}
__device__ __forceinline__ void ph_positions(Frame& F, int l, int ntok) {
    LAS int* cnt = (LAS int*)F.lds;
    LAS int* off = cnt + 132;
    __syncthreads();
    if (F.tid < NE1) cnt[F.tid] = F.tid < NEXP ? (int)__hip_atomic_load(F.ctl + CW_CNT + l * 256 + F.tid, __ATOMIC_RELAXED, __HIP_MEMORY_SCOPE_AGENT) : ntok;
    __syncthreads();
    if (F.tid == 0) { int o = 0; for (int e = 0; e < NE1; ++e) { off[e] = o; o += (cnt[e] + 255) & ~255; } off[NE1] = o; }
    __syncthreads();
    const int gt = F.wg * NTHR + F.tid, NGT = F.G * NTHR;
    int* rowtok = (int*)(F.ws + WS_ROWTOK); int* rowdst = (int*)(F.ws + WS_ROWDST); int* tile_exp = (int*)(F.ws + WS_TILEEXP);
    const int* eidx = (const int*)(F.ws + WS_EIDX); const int* rnk = (const int*)(F.ws + WS_RNK);
    for (int a = gt; a < ntok * 8; a += NGT) { const int tok = a >> 3, k = a & 7; const int pos = off[eidx[a]] + rnk[a]; rowtok[pos] = tok; rowdst[pos] = tok * 9 + k; }
    for (int tok = gt; tok < ntok; tok += NGT) { const int pos = off[NEXP] + tok; rowtok[pos] = tok; rowdst[pos] = tok * 9 + 8; }
    for (int i = gt; i < NE1 * 256; i += NGT) { const int e = i >> 8, p = i & 255; const int row = off[e] + cnt[e] + p; if (row < off[e + 1]) { rowtok[row] = 0; rowdst[row] = -1; } }
    for (int i = gt; i < NE1 * 320; i += NGT) { const int e = i / 320, p = i % 320; const int t = (off[e] >> 8) + p; if (t < (off[e + 1] >> 8)) tile_exp[t] = e; }
    if (gt == 0) F.ctl[CW_NTL + l] = (unsigned)(off[NE1] >> 8);
}

#ifndef MK_MULTI
#define MK_MULTI 0
#endif
constexpr int PH_PER_LAYER = 12, NPHASE = 2 + DEPTH * PH_PER_LAYER;
struct Args { const float* in[36]; float* out; unsigned char* ws; int ph_lo, ph_hi; };

__global__ void __launch_bounds__(NTHR, 2) mk_fwd(Args args) {
    extern __shared__ __attribute__((aligned(16))) unsigned char lds_raw[];
    Frame F;
    F.lds = (LAS unsigned char*)lds_raw;
    F.tid = threadIdx.x; F.lane = F.tid & 63; F.wave = __builtin_amdgcn_readfirstlane(F.tid >> 6);
    const int wave0 = F.wave;
    F.G = gridDim.x; F.wg = blockIdx.x;
    F.in = args.in;
    F.out = args.out; F.ws = args.ws; F.ctl = (unsigned*)(args.ws + WS_CTL);
    volatile LAS unsigned* MISC = (volatile LAS unsigned*)(F.lds + MISC_OFF);
    if (F.tid < 32) MISC[F.tid] = 0u;
    __syncthreads();
    const int lo = args.ph_lo, hi = args.ph_hi;
    const bool single = (hi - lo) > 1;
    XcdBarrier bar; bar.bar = F.ctl + CW_BAR; bar.x = 0; bar.st = nullptr;
    if (single) bar = xcd_barrier_post(F.ctl + CW_BAR, MISC + 8);
#define IN(k) (lo <= (k) && (k) < hi)
#ifndef PROBE_MASK
#define PROBE_MASK 0
#endif
#define REP(k) for (int _rep = 0; _rep < (((PROBE_MASK >> (k)) & 1) ? 2 : 1); ++_rep)
#define SEAM(k) do { if (IN(k) && IN((k) + 1)) { xcd_barrier(bar); if ((PROBE_MASK >> 15) & 1) xcd_barrier(bar); } } while (0)
#define FRESH() do { int _ln; asm volatile("v_mbcnt_lo_u32_b32 %0, -1, 0\n\tv_mbcnt_hi_u32_b32 %0, -1, %0" : "=v"(_ln)); int _wv = wave0; asm volatile("" : "+s"(_wv)); F.lane = _ln; F.wave = _wv; F.tid = (_wv << 6) | _ln; \
        unsigned char* _w = args.ws; asm volatile("" : "+s"(_w)); F.ws = _w; F.ctl = (unsigned*)(_w + WS_CTL); float* _o = args.out; asm volatile("" : "+s"(_o)); F.out = _o; } while (0)

    if (IN(0)) { FRESH(); REP(13) { p0_static_weights(F); __syncthreads(); } REP(14) { p0_mod(F); __syncthreads(); } FRESH(); REP(16) { p0_hyena_filters(F); __syncthreads(); } }
    SEAM(0);
    if (IN(1)) { FRESH(); p0_init_rows(F); }
    SEAM(1);
#pragma unroll 1
    for (int l = 0; l < DEPTH; ++l) {
        const int pb = 2 + l * PH_PER_LAYER; const bool last = (l == DEPTH - 1); const int ntok = last ? NLAT : NROW;
        if (IN(pb + 0)) { FRESH();
            REP(0) { p_expert_weights(F, l); __syncthreads(); }
            pg8::DenseOrder S; S.init(NROW, DIN, F.G, F.wg); pg8::EpiBf16 E{(bf16_t*)(F.ws + WS_U), DIN};
            REP(1) pg8::gemm_phase<pg8::EpiBf16, pg8::DenseOrder, false>(F.tid, F.lds, (const bf16_t*)(F.ws + WS_XM), (const bf16_t*)(F.ws + WS_WIN) + (size_t)l * DIN * DM, DM, nullptr, S, E);
        }
        SEAM(pb + 0);
        if (IN(pb + 1)) { FRESH(); REP(2) { ph_transposes(F, l); __syncthreads(); } FRESH(); REP(3) { ph_gla_local(F, l); __syncthreads(); } }
        SEAM(pb + 1);
        if (IN(pb + 2)) { FRESH(); REP(4) { ph_na(F, l, last); } FRESH(); REP(5) { ph_gla_scan(F); } __syncthreads(); FRESH(); REP(6) { ph_hyena(F, l, last); } }
        SEAM(pb + 2);
        if (IN(pb + 3)) { FRESH(); ph_hy_transpose(F, last); __syncthreads(); FRESH(); REP(7) { ph_gla_out(F, l, last); } }
        SEAM(pb + 3);
        if (IN(pb + 4)) { FRESH();
            pg8::DenseOrder S; S.init(ntok, DM, F.G, F.wg); pg8::EpiBf16 E{(bf16_t*)(F.ws + WS_Y), DM};
            REP(8) pg8::gemm_phase<pg8::EpiBf16, pg8::DenseOrder, false>(F.tid, F.lds, (const bf16_t*)(F.ws + WS_MIX), (const bf16_t*)(F.ws + WS_WOUT) + (size_t)l * DM * DM, DM, nullptr, S, E);
        }
        SEAM(pb + 4);
        if (IN(pb + 5)) { FRESH(); ph_ln1(F, l, ntok); }
        SEAM(pb + 5);
        if (IN(pb + 6)) { FRESH();
            pg8::DenseOrder S; S.init(ntok, 256, F.G, F.wg); pg8::EpiF32H E{(float*)(F.ws + WS_LOGIT), 256};
            REP(9) pg8::gemm_phase<pg8::EpiF32H, pg8::DenseOrder, false, false, true, true, true>(F.tid, F.lds, (const bf16_t*)(F.ws + WS_XM), (const bf16_t*)(F.ws + WS_WR) + (size_t)l * 256 * DM, DM, nullptr, S, E);
        }
        SEAM(pb + 6);
        if (IN(pb + 7)) { FRESH(); ph_route(F, l, ntok); }
        SEAM(pb + 7);
        if (IN(pb + 8)) { FRESH(); REP(12) { ph_positions(F, l, ntok); __syncthreads(); } }
        SEAM(pb + 8);
        if (IN(pb + 9)) { FRESH();
            const int ntl = (int)__hip_atomic_load(F.ctl + CW_NTL + l, __ATOMIC_RELAXED, __HIP_MEMORY_SCOPE_AGENT);
            pg8::GroupedOrder S; S.init(ntl, 2, F.G, F.wg); S.preload((const int*)(F.ws + WS_TILEEXP), F.lds + pg8::STAGE_BYTES + 4096, F.tid, NTHR); pg8::EpiSwiglu E{(unsigned char*)(F.ws + WS_ACT)};
            REP(10) pg8::gemm_phase<pg8::EpiSwiglu, pg8::GroupedOrder, true, true>(F.tid, F.lds, (const void*)(F.ws + WS_XM8), (const void*)(F.ws + WS_EXP1), DM, (const int*)(F.ws + WS_ROWTOK), S, E);
        }
        SEAM(pb + 9);
        if (IN(pb + 10)) { FRESH();
            const int ntl = (int)__hip_atomic_load(F.ctl + CW_NTL + l, __ATOMIC_RELAXED, __HIP_MEMORY_SCOPE_AGENT);
            pg8::GroupedOrder S; S.init(ntl, 4, F.G, F.wg); S.preload((const int*)(F.ws + WS_TILEEXP), F.lds + pg8::STAGE_BYTES + 4096, F.tid, NTHR); pg8::EpiScatter E{(unsigned char*)(F.ws + WS_Y2), (const int*)(F.ws + WS_ROWDST)};
            REP(11) pg8::gemm_phase<pg8::EpiScatter, pg8::GroupedOrder, false, true>(F.tid, F.lds, (const void*)(F.ws + WS_ACT), (const void*)(F.ws + WS_EXP2), EH, nullptr, S, E);
        }
        SEAM(pb + 10);
        if (IN(pb + 11)) { FRESH(); ph_ln2(F, l, ntok, last); }
        SEAM(pb + 11);
    }
#undef IN
#undef SEAM
#undef FRESH
}

extern "C" void kernel_launch(void* const* d_in, const int* in_sizes, int n_in, void* d_out, int out_size, void* d_ws, size_t ws_size, hipStream_t stream) {
    static int grid = 0;
    if (grid == 0) {
        if (n_in != 36 || out_size != NLAT * DM || ws_size < WS_END) { fprintf(stderr, "kernel_launch: unexpected shapes (n_in %d out %d ws %zu need %zu)\n", n_in, out_size, ws_size, (size_t)WS_END); grid = -1; return; }
        int dev = 0, cus = 0, per_cu = 0;
        if (hipGetDevice(&dev) != hipSuccess || hipDeviceGetAttribute(&cus, hipDeviceAttributeMultiprocessorCount, dev) != hipSuccess) { grid = -1; return; }
        if (hipFuncSetAttribute((const void*)mk_fwd, hipFuncAttributeMaxDynamicSharedMemorySize, LDS_BYTES) != hipSuccess) { fprintf(stderr, "kernel_launch: hipFuncSetAttribute failed\n"); grid = -1; return; }
        if (hipOccupancyMaxActiveBlocksPerMultiprocessor(&per_cu, (const void*)mk_fwd, NTHR, LDS_BYTES) != hipSuccess || per_cu < 1) { fprintf(stderr, "kernel_launch: occupancy query says %d\n", per_cu); }
        (void)hipGetLastError();
        grid = cus;
    }
    if (grid < 0) return;
    (void)hipMemsetAsync((char*)d_ws + WS_CTL, 0, CTL_BYTES, stream);
    Args a{};
    for (int i = 0; i < 36; ++i) a.in[i] = (const float*)d_in[i];
    a.out = (float*)d_out; a.ws = (unsigned char*)d_ws;
#if MK_MULTI
    for (int p = 0; p < NPHASE; ++p) { a.ph_lo = p; a.ph_hi = p + 1; hipLaunchKernelGGL(mk_fwd, dim3(grid), dim3(NTHR), LDS_BYTES, stream, a); }
#else
    a.ph_lo = 0; a.ph_hi = NPHASE; hipLaunchKernelGGL(mk_fwd, dim3(grid), dim3(NTHR), LDS_BYTES, stream, a);
#endif
}
```

```cpp
#include <hip/hip_runtime.h>
#include <cstdio>
#include <cstdint>

#define LAS __attribute__((address_space(3)))
#define GAS __attribute__((address_space(1)))
typedef unsigned short bf16_t;
typedef short bf16x8 __attribute__((ext_vector_type(8)));
typedef float f32x4 __attribute__((ext_vector_type(4)));
typedef float f32x2 __attribute__((ext_vector_type(2)));
typedef unsigned u32x4 __attribute__((ext_vector_type(4)));
typedef unsigned u32x2 __attribute__((ext_vector_type(2)));

constexpr int NB = 16, SEQ = 4096, CTXL = 256, DM = 1024, DEPTH = 4;
constexpr int NLAT = NB * SEQ;
constexpr int NCTX = NB * CTXL;
constexpr int NROW = NLAT + NCTX;
constexpr int SPB = SEQ + CTXL;
constexpr int DIN_REF = 3104;
constexpr int DIN = 3328;
constexpr int UQ = 0, UK = 512, UV = 1024, UGQ = 1536, UGK = 1664, UGV = 1792, UGR = 2048, UHY = 2304, ULAF = 3072, ULAB = 3200;
constexpr int NEXP = 128, TOPK = 8, EH = 256;
constexpr int NE1 = NEXP + 1;
constexpr int RMAX = 659712;
constexpr int TMAX = RMAX / 256;
constexpr float LN_EPS = 1e-6f;
constexpr float DN_ALPHA = 1.6817928305074290f;

__device__ __forceinline__ unsigned f2bf(float f) { unsigned u = __builtin_bit_cast(unsigned, f); return (u + 0x7fffu + ((u >> 16) & 1u)) >> 16; }
typedef __bf16 bf16v2 __attribute__((ext_vector_type(2)));
__device__ __forceinline__ unsigned pk2(float lo, float hi) { const f32x2 v = {lo, hi}; const bf16v2 b = __builtin_convertvector(v, bf16v2); return __builtin_bit_cast(unsigned, b); }
__device__ __forceinline__ float bf2f(unsigned short b) { return __builtin_bit_cast(float, ((unsigned)b) << 16); }
__device__ __forceinline__ float bflo(unsigned w) { return __builtin_bit_cast(float, w << 16); }
__device__ __forceinline__ float bfhi(unsigned w) { return __builtin_bit_cast(float, w & 0xffff0000u); }
__device__ __forceinline__ float shx(float v, int o, int lane) { return __builtin_bit_cast(float, __builtin_amdgcn_ds_bpermute((lane ^ o) << 2, __builtin_bit_cast(int, v))); }
__device__ __forceinline__ int shxi(int v, int o, int lane) { return __builtin_amdgcn_ds_bpermute((lane ^ o) << 2, v); }
__device__ __forceinline__ float shf(float v, int src) { return __builtin_bit_cast(float, __builtin_amdgcn_ds_bpermute(src << 2, __builtin_bit_cast(int, v))); }
__device__ __forceinline__ float wave_sum(float v, int lane) {
#pragma unroll
    for (int o = 1; o < 64; o <<= 1) v += shx(v, o, lane);
    return v;
}
__device__ __forceinline__ void unpack8(const u32x4 q, float* o) { o[0] = bflo(q.x); o[1] = bfhi(q.x); o[2] = bflo(q.y); o[3] = bfhi(q.y); o[4] = bflo(q.z); o[5] = bfhi(q.z); o[6] = bflo(q.w); o[7] = bfhi(q.w); }
__device__ __forceinline__ float silu_f(float x) { return x * __builtin_amdgcn_rcpf(1.0f + __expf(-x)); }
#define LDS_WAIT() asm volatile("s_waitcnt lgkmcnt(0)" ::: "memory")
#define VM_WAIT() asm volatile("s_waitcnt vmcnt(0)" ::: "memory")

#define XB_TMO      128
#define XB_XCNT(j)  (256  + 64 * (j))
#define XB_XSUB(j)  (1280 + 64 * (j))
#define XB_XGEN(j)  (2304 + 64 * (j))
#define XB_TOP      3328
#define XB_TOPGEN   3392
#define XCD_BAR_WORDS 3456
#define XB_SPIN_CAP (1u << 18)

__device__ __forceinline__ unsigned xb_ld(unsigned* p)              { return __hip_atomic_load(p, __ATOMIC_RELAXED, __HIP_MEMORY_SCOPE_AGENT); }
__device__ __forceinline__ unsigned xb_add(unsigned* p, unsigned v) { return __hip_atomic_fetch_add(p, v, __ATOMIC_RELAXED, __HIP_MEMORY_SCOPE_AGENT); }
__device__ __forceinline__ unsigned xb_xcc_id() { return (unsigned)__builtin_amdgcn_s_getreg((3 << 11) | 20) & 0xFu; }
#define XB_SPIN(cond, bar) do { unsigned _sp = 0; while (cond) { __builtin_amdgcn_s_sleep(1); \
    if ((++_sp & 255u) == 0u) { if (xb_ld(&(bar)[XB_TMO])) break; if (_sp > XB_SPIN_CAP) { atomicAdd(&(bar)[XB_TMO], 1u); break; } } } } while (0)

struct XcdBarrier { unsigned* bar; unsigned x; volatile LAS unsigned* st; };

__device__ __forceinline__ XcdBarrier xcd_barrier_post(unsigned* bar, volatile LAS unsigned* st) {
    XcdBarrier b; b.bar = bar; b.x = xb_xcc_id(); b.st = st;
    if (threadIdx.x == 0) (void)xb_add(&bar[XB_XCNT(b.x)], 1u);
    return b;
}
__device__ __forceinline__ void xcd_barrier_complete(unsigned* bar, unsigned x, unsigned& nloc, unsigned& nx) {
    const unsigned G = gridDim.x * gridDim.y * gridDim.z;
    unsigned sum, cnt, mine, sp = 0u;
    for (;;) {
        sum = 0u; cnt = 0u; mine = 0u;
#pragma unroll
        for (unsigned j = 0; j < 16; ++j) { const unsigned c = xb_ld(&bar[XB_XCNT(j)]); sum += c; cnt += (c > 0u) ? 1u : 0u; mine = (j == x) ? c : mine; }
        if (sum == G) break;
        __builtin_amdgcn_s_sleep(1);
        if ((++sp & 255u) == 0u) { if (xb_ld(&bar[XB_TMO])) break; if (sp > XB_SPIN_CAP) { atomicAdd(&bar[XB_TMO], 1u); break; } }
    }
    nloc = mine > 0u ? mine : 1u; nx = cnt > 0u ? cnt : 1u;
}
__device__ __forceinline__ void xcd_barrier(const XcdBarrier& b) {
    asm volatile("s_waitcnt vmcnt(0)" ::: "memory");
    __syncthreads();
    if (threadIdx.x == 0) {
        unsigned* bar = b.bar;
        __builtin_amdgcn_s_waitcnt(0);
        unsigned nloc = b.st[0], nx = b.st[1];
        if (nloc == 0u) { xcd_barrier_complete(bar, b.x, nloc, nx); b.st[0] = nloc; b.st[1] = nx; }
        const unsigned old = xb_add(&bar[XB_XSUB(b.x)], 1u);
        const unsigned gen = old / nloc;
        if (old + 1u == (gen + 1u) * nloc) {
            __builtin_amdgcn_fence(__ATOMIC_RELEASE, "agent");
            asm volatile("s_waitcnt vmcnt(0)" ::: "memory");
            const unsigned og = xb_add(&bar[XB_TOP], 1u);
            const unsigned tg = og / nx;
            if (og + 1u == (tg + 1u) * nx) xb_add(&bar[XB_TOPGEN], 1u);
            else XB_SPIN(xb_ld(&bar[XB_TOPGEN]) == tg, bar);
            __builtin_amdgcn_fence(__ATOMIC_ACQUIRE, "agent");
            xb_add(&bar[XB_XGEN(b.x)], 1u);
            asm volatile("s_waitcnt vmcnt(0)" ::: "memory");
        } else {
            XB_SPIN(xb_ld(&bar[XB_XGEN(b.x)]) == gen, bar);
            __builtin_amdgcn_fence(__ATOMIC_ACQUIRE, "agent");
            asm volatile("s_waitcnt vmcnt(0)" ::: "memory");
        }
    }
    __syncthreads();
}

namespace pg8 {
constexpr int BM = 256, BK = 64, HALF = 128, HTB = HALF * BK * 2, STAGE_BYTES = 8 * HTB, NXCD = 8, WGM = 8;
__host__ __device__ __forceinline__ int lds_byte(int r, int c) { const int st = (r >> 4) * 2 + (c >> 5), rr = r & 15, cc = c & 31, ob = rr * 64 + cc * 2; return st * 1024 + (ob ^ (((ob >> 9) & 1) << 5)); }
__host__ __device__ __forceinline__ void stage_rc(int b, int& R, int& C) { const int st = b / 1024, sb = b % 1024, swz = sb ^ (((sb >> 9) & 1) << 5); R = (st >> 1) * 16 + swz / 64; C = (st & 1) * 32 + (swz % 64) / 2; }
__host__ __device__ __forceinline__ int perm32(int rho) { const int n = rho >> 4, i = rho & 15; return 8 * (i >> 2) + 4 * n + (i & 3); }

struct Unit { int arow0, brow0, orow0, ocol0, aux; };

struct DenseOrder {
    int nM, nN, nwg, G, c;
    __device__ void init(int M, int N, int G_, int c_) { nM = M / BM; nN = N / BM; nwg = nM * nN; G = G_; c = c_; }
    __device__ __forceinline__ bool next(int i, Unit& u) const {
        const long L = (long)i * G + c; if (L >= nwg) return false;
        int wgid = (int)L; { const int q = nwg / NXCD, r = nwg % NXCD, xcd = wgid % NXCD, off = wgid / NXCD; wgid = (xcd < r ? xcd * (q + 1) : r * (q + 1) + (xcd - r) * q) + off; }
        const int nig = WGM * nN, gid = wgid / nig, fm = gid * WGM, gsz = (nM - fm) < WGM ? (nM - fm) : WGM;
        const int pm = fm + ((wgid % nig) % gsz), pn = (wgid % nig) / gsz;
        u.arow0 = pm * BM; u.brow0 = pn * BM; u.orow0 = pm * BM; u.ocol0 = pn * BM; u.aux = 0; return true;
    }
};
struct GroupedOrder {
    const LAS unsigned char* tab; int nN, nslot, slot, t0, t1;
    __device__ __forceinline__ void init(int ntiles, int nN_, int G, int c) {
        nN = nN_;
        if ((G & 7) == 0) { const int per = (ntiles + 7) >> 3, x = c & 7; nslot = G >> 3; slot = c >> 3; t0 = x * per; t1 = (t0 + per) < ntiles ? (t0 + per) : ntiles; }
        else { nslot = G; slot = c; t0 = 0; t1 = ntiles; }
    }
    __device__ __forceinline__ void preload(const int* tile_exp, LAS unsigned char* lds_tab, int tid, int nthr) {
        __syncthreads();
        for (int i = tid; i < t1 - t0; i += nthr) lds_tab[i] = (unsigned char)tile_exp[t0 + i];
        __syncthreads();
        tab = lds_tab;
    }
    __device__ __forceinline__ bool next(int i, Unit& u) const {
        const int q = i * nslot + slot, t = t0 + q / nN, pn = q % nN;
        if (t >= t1) return false;
        const int e = (int)tab[t - t0];
        u.arow0 = t * BM; u.brow0 = (e * nN + pn) * BM; u.orow0 = t * BM; u.ocol0 = pn * BM; u.aux = e; return true;
    }
};

template <class Base> struct RangeOrder {
    Base b; int i0, i1;
    __device__ __forceinline__ bool next(int i, Unit& u) const { const int j = i + i0; if (j >= i1) return false; return b.next(j, u); }
};

__device__ __forceinline__ unsigned cvt_pk_bf16(float lo, float hi) { return pk2(lo, hi); }

struct NoPre {};
struct EpiF32 {
    static constexpr bool PERM = false; static constexpr int SCW = 0x7A7A7A7A; typedef NoPre Pre;
    __device__ __forceinline__ Pre prefetch(const Unit&, LAS unsigned char*, int, int, int) const { return Pre{}; }
    float* C; int ldc;
    __device__ __forceinline__ void operator()(const f32x4 (&acc)[2][2][4][2], const Unit& u, int wr, int wc, int fr, int fq, const Pre&) const {
        const int row0 = u.orow0 + wr * 64 + fr, col0 = u.ocol0 + wc * 32 + 4 * fq;
#pragma unroll
        for (int ai = 0; ai < 2; ++ai)
#pragma unroll
            for (int m = 0; m < 4; ++m) { float* rowp = C + (size_t)(row0 + ai * HALF + m * 16) * ldc + col0;
#pragma unroll
                for (int bj = 0; bj < 2; ++bj)
#pragma unroll
                    for (int n = 0; n < 2; ++n) *(GAS f32x4*)(rowp + bj * HALF + n * 16) = acc[ai][bj][m][n]; }
    }
};
struct EpiF32H {
    static constexpr bool PERM = false; static constexpr int SCW = 0x7A7A7A7A; typedef NoPre Pre;
    __device__ __forceinline__ Pre prefetch(const Unit&, LAS unsigned char*, int, int, int) const { return Pre{}; }
    float* C; int ldc;
    __device__ __forceinline__ void operator()(const f32x4 (&acc)[2][2][4][2], const Unit& u, int wr, int wc, int fr, int fq, const Pre&) const {
        const int row0 = u.orow0 + wr * 64 + fr, col0 = wc * 32 + 4 * fq;
#pragma unroll
        for (int ai = 0; ai < 2; ++ai)
#pragma unroll
            for (int m = 0; m < 4; ++m) { float* rowp = C + (size_t)(row0 + ai * HALF + m * 16) * ldc + col0;
#pragma unroll
                for (int n = 0; n < 2; ++n) *(GAS f32x4*)(rowp + n * 16) = acc[ai][0][m][n]; }
    }
};
struct EpiBf16 {
    static constexpr bool PERM = true; static constexpr int SCW = 0x7A7A7A7A; typedef NoPre Pre;
    __device__ __forceinline__ Pre prefetch(const Unit&, LAS unsigned char*, int, int, int) const { return Pre{}; }
    bf16_t* O; int ldc;
    __device__ __forceinline__ void operator()(const f32x4 (&acc)[2][2][4][2], const Unit& u, int wr, int wc, int fr, int fq, const Pre&) const {
        const int row0 = u.orow0 + wr * 64 + fr, col0 = u.ocol0 + wc * 32 + 8 * fq;
#pragma unroll
        for (int ai = 0; ai < 2; ++ai)
#pragma unroll
            for (int m = 0; m < 4; ++m) { bf16_t* rowp = O + (size_t)(row0 + ai * HALF + m * 16) * ldc + col0;
#pragma unroll
                for (int bj = 0; bj < 2; ++bj) { const f32x4 v0 = acc[ai][bj][m][0], v1 = acc[ai][bj][m][1];
                    u32x4 w; w.x = cvt_pk_bf16(v0[0], v0[1]); w.y = cvt_pk_bf16(v0[2], v0[3]); w.z = cvt_pk_bf16(v1[0], v1[1]); w.w = cvt_pk_bf16(v1[2], v1[3]);
                    *(GAS u32x4*)(rowp + bj * HALF) = w; } }
    }
};
struct EpiSwiglu {
    static constexpr bool PERM = true; static constexpr int SCW = 0x7A7A7A7A; typedef NoPre Pre;
    __device__ __forceinline__ Pre prefetch(const Unit&, LAS unsigned char*, int, int, int) const { return Pre{}; }
    unsigned char* ACT;
    __device__ __forceinline__ void operator()(const f32x4 (&acc)[2][2][4][2], const Unit& u, int wr, int wc, int fr, int fq, const Pre&) const {
        const int row0 = u.orow0 + wr * 64 + fr, pn = u.ocol0 >> 8;
#pragma unroll
        for (int ai = 0; ai < 2; ++ai)
#pragma unroll
            for (int m = 0; m < 4; ++m) { unsigned char* rowp = ACT + (size_t)(row0 + ai * HALF + m * 16) * EH + pn * 128 + wc * 32 + 8 * fq;
                int w[2];
#pragma unroll
                for (int n = 0; n < 2; ++n) { const f32x4 g = acc[ai][0][m][n], up = acc[ai][1][m][n];
                    f32x4 e;
#pragma unroll
                    for (int i = 0; i < 4; ++i) e[i] = __builtin_amdgcn_exp2f(-g[i]);
                    const f32x4 d = e + 1.0f; f32x4 r;
#pragma unroll
                    for (int i = 0; i < 4; ++i) r[i] = __builtin_amdgcn_rcpf(d[i]);
                    const f32x4 h = (g * up) * r;
                    int v = 0; v = __builtin_amdgcn_cvt_pk_fp8_f32(h[0], h[1], v, false); v = __builtin_amdgcn_cvt_pk_fp8_f32(h[2], h[3], v, true); w[n] = v; }
                *(GAS u32x2*)rowp = (u32x2){(unsigned)w[0], (unsigned)w[1]}; }
    }
};
constexpr float Y2_SCALE = 16.0f, Y2_INV = 1.0f / 16.0f;
struct EpiScatter {
    static constexpr bool PERM = true; static constexpr int SCW = 0x7E7E7E7E;
    struct Pre { const LAS int* tab; };
    unsigned char* Y2; const int* rowdst;
    __device__ __forceinline__ Pre prefetch(const Unit& u, LAS unsigned char* lds, int wid, int lane, int ui) const {
        LAS unsigned char* tab = lds + STAGE_BYTES + (ui & 1) * 1024;
        if (wid < 4) __builtin_amdgcn_global_load_lds((const unsigned*)(rowdst + u.orow0 + wid * 64 + lane), (LAS unsigned*)(tab + wid * 256), 4, 0, 0);
        Pre p; p.tab = (const LAS int*)tab; return p; }
    __device__ __forceinline__ void operator()(const f32x4 (&acc)[2][2][4][2], const Unit& u, int wr, int wc, int fr, int fq, const Pre& pre) const {
#pragma unroll
        for (int ai = 0; ai < 2; ++ai)
#pragma unroll
            for (int m = 0; m < 4; ++m) { const int dst = pre.tab[wr * 64 + fr + ai * HALF + m * 16];
                if (dst >= 0) { unsigned char* rowp = Y2 + (size_t)dst * DM + u.ocol0 + wc * 64 + fq * 16;
                    int w[4];
#pragma unroll
                    for (int bj = 0; bj < 2; ++bj) { const f32x4 v0 = acc[ai][bj][m][0], v1 = acc[ai][bj][m][1];
                        int w0 = 0, w1 = 0;
                        w0 = __builtin_amdgcn_cvt_pk_fp8_f32(v0[0], v0[1], w0, false); w0 = __builtin_amdgcn_cvt_pk_fp8_f32(v0[2], v0[3], w0, true);
                        w1 = __builtin_amdgcn_cvt_pk_fp8_f32(v1[0], v1[1], w1, false); w1 = __builtin_amdgcn_cvt_pk_fp8_f32(v1[2], v1[3], w1, true);
                        w[2 * bj] = w0; w[2 * bj + 1] = w1; }
                    *(GAS u32x4*)rowp = (u32x4){(unsigned)w[0], (unsigned)w[1], (unsigned)w[2], (unsigned)w[3]}; } }
    }
};

typedef int v8i __attribute__((ext_vector_type(8)));
typedef int v4i __attribute__((ext_vector_type(4)));
struct Frag { bf16x8 p[2]; __device__ __forceinline__ bf16x8& operator[](int k) { return p[k]; } __device__ __forceinline__ const bf16x8& operator[](int k) const { return p[k]; } };
template <class Epi, class Sched, bool GATHER, bool F8 = false, bool ALIGN_EPI = true, bool SP2 = true, bool NHALF = false>
__device__ __forceinline__ void gemm_phase(const int tid_in, LAS unsigned char* lds, const void* Ag, const void* Bg, const int K, const int* rowidx, const Sched& S, const Epi& E) {
    int tid_ = tid_in; asm volatile("" : "+v"(tid_));
    const int tid = tid_, wid = __builtin_amdgcn_readfirstlane(tid >> 6), lane = tid & 63, wr = wid >> 2, wc = wid & 3, fr = lane & 15, fq = lane >> 4;
    const int KB = F8 ? K : 2 * K;
    const int nt = KB / 128;
    unsigned voffB[2];
#pragma unroll
    for (int i = 0; i < 2; ++i) { int R, C; stage_rc(tid * 16 + i * 8192, R, C); const int Rb = Epi::PERM ? ((R & ~31) + perm32(R & 31)) : R;
        voffB[i] = (unsigned)(Rb * KB + C * 2); }
    const size_t kstep = (size_t)128;
    const size_t hstep = (size_t)HALF * KB;
    const unsigned ldsw = (unsigned)wid * 1024u;
    const int aoff = F8 ? lds_byte(wr * 64 + fr, 16 * fq) : lds_byte(wr * 64 + fr, fq * 8), boff = F8 ? lds_byte(wc * 32 + fr, 16 * fq) : lds_byte(wc * 32 + fr, fq * 8);
    constexpr int PIECE1 = F8 ? 16 : 1024;
    const int sc_w = Epi::SCW, sc_a = 0x7F7F7F7F;
#define PG8_SA(b, h) (((b) * 2 + (h)) * HTB)
#define PG8_SB(b, h) ((4 + (b) * 2 + (h)) * HTB)
#define PG8_STAGE_B(bufoff, gbase) do { _Pragma("unroll") for (int _i = 0; _i < 2; ++_i) \
        __builtin_amdgcn_global_load_lds((const unsigned*)((const char*)(gbase) + voffB[_i]), (LAS unsigned*)(lds + (bufoff) + ldsw + _i * 8192), 16, 0, 0); } while (0)
#define PG8_STAGE_A(bufoff, gbase, h) do { const char* _gb = (const char*)(gbase) + (GATHER ? (size_t)0 : (size_t)(h) * hstep); \
        __builtin_amdgcn_global_load_lds((const unsigned*)(_gb + ac[GATHER ? (h) : 0][0]), (LAS unsigned*)(lds + (bufoff) + ldsw), 16, 0, 0); \
        __builtin_amdgcn_global_load_lds((const unsigned*)(_gb + ac[GATHER ? (h) : 0][1]), (LAS unsigned*)(lds + (bufoff) + ldsw + 8192), 16, 0, 0); } while (0)
#define PG8_LDA(dst, b, h) do { _Pragma("unroll") for (int m = 0; m < 4; ++m) { if constexpr (F8) { const v4i _l = *(const LAS v4i*)(lds + PG8_SA(b, h) + aoff + m * 2048), _h = *(const LAS v4i*)(lds + PG8_SA(b, h) + aoff + m * 2048 + PIECE1); dst##8[m] = __builtin_shufflevector(_l, _h, 0, 1, 2, 3, 4, 5, 6, 7); } \
        else { dst[m][0] = *(const LAS bf16x8*)(lds + PG8_SA(b, h) + aoff + m * 2048); dst[m][1] = *(const LAS bf16x8*)(lds + PG8_SA(b, h) + aoff + m * 2048 + PIECE1); } } } while (0)
#define PG8_LDB(dst, b, h) do { _Pragma("unroll") for (int n = 0; n < 2; ++n) { if constexpr (F8) { const v4i _l = *(const LAS v4i*)(lds + PG8_SB(b, h) + boff + n * 2048), _h = *(const LAS v4i*)(lds + PG8_SB(b, h) + boff + n * 2048 + PIECE1); dst##8[n] = __builtin_shufflevector(_l, _h, 0, 1, 2, 3, 4, 5, 6, 7); } \
        else { dst[n][0] = *(const LAS bf16x8*)(lds + PG8_SB(b, h) + boff + n * 2048); dst[n][1] = *(const LAS bf16x8*)(lds + PG8_SB(b, h) + boff + n * 2048 + PIECE1); } } } while (0)
#define PG8_MMA(ai, bj, At, Bt) do { __builtin_amdgcn_s_setprio(1); _Pragma("unroll") for (int m = 0; m < 4; ++m) _Pragma("unroll") for (int n = 0; n < 2; ++n) { \
        if constexpr (F8) asm volatile("v_mfma_scale_f32_16x16x128_f8f6f4 %0, %1, %2, %0, %3, %4 op_sel_hi:[0,0,0]" : "+v"(acc[ai][bj][m][n]) : "v"(Bt##8[n]), "v"(At##8[m]), "v"(sc_w), "v"(sc_a)); \
        else { _Pragma("unroll") for (int k = 0; k < 2; ++k) acc[ai][bj][m][n] = __builtin_amdgcn_mfma_f32_16x16x32_bf16(Bt[n][k], At[m][k], acc[ai][bj][m][n], 0, 0, 0); } } \
        __builtin_amdgcn_s_setprio(0); } while (0)
#define PG8_WAIT_V(n) asm volatile("s_waitcnt vmcnt(" #n ")" ::: "memory")
#define PG8_WAIT_LOOP do { if constexpr (NHALF) PG8_WAIT_V(6); else PG8_WAIT_V(8); } while (0)
#define PG8_WAIT_L(n) asm volatile("s_waitcnt lgkmcnt(" #n ")" ::: "memory")
#define PG8_BAR __builtin_amdgcn_s_barrier()
#define PG8_SCHED __builtin_amdgcn_sched_barrier(0)
#define PG8_TAB(par) (lds + STAGE_BYTES + 2048 + (par) * 1024)
#define PG8_TABLOAD(par, row0) do { if (wid < 4) __builtin_amdgcn_global_load_lds((const unsigned*)(rowidx + (row0) + wid * 64 + lane), (LAS unsigned*)(PG8_TAB(par) + wid * 256), 4, 0, 0); } while (0)
#define PG8_AOFF_H(h, par) do { int _tz = tid; asm volatile("" : "+v"(_tz)); _Pragma("unroll") for (int _i = 0; _i < 2; ++_i) { int _R, _C; stage_rc(_tz * 16 + _i * 8192, _R, _C); \
        if (GATHER) ac[h][_i] = ((const LAS unsigned*)PG8_TAB(par))[(h) * HALF + _R] * (unsigned)KB + (unsigned)_C * 2u; \
        else ac[h][_i] = (unsigned)(((h) * HALF + _R) * KB) + (unsigned)_C * 2u; } } while (0)
    static_assert(SP2, "only the two-super-phase K-loop is kept");
    Unit cur, nxt; int ui = 0;
    if (!S.next(0, cur)) return;
    f32x4 acc[2][2][4][2];
#pragma unroll
    for (int a = 0; a < 2; ++a)
#pragma unroll
        for (int b = 0; b < 2; ++b)
#pragma unroll
            for (int m = 0; m < 4; ++m)
#pragma unroll
                for (int n = 0; n < 2; ++n) acc[a][b][m][n] = (f32x4){0.f, 0.f, 0.f, 0.f};
    bf16x8 At[F8 ? 1 : 4][2], B0[F8 ? 1 : 2][2], B1[F8 ? 1 : 2][2];
    v8i At8[F8 ? 4 : 1], B08[F8 ? 2 : 1], B18[F8 ? 2 : 1];
    unsigned ac[GATHER ? 2 : 1][2];
    if (GATHER) { PG8_TABLOAD(0, cur.arow0); PG8_WAIT_V(0); PG8_BAR; }
    PG8_AOFF_H(0, 0); if (GATHER) { PG8_AOFF_H((GATHER ? 1 : 0), 0); }
    const char* cA = (const char*)Ag + (GATHER ? (size_t)0 : (size_t)cur.arow0 * KB); const char* cB = (const char*)Bg + (size_t)cur.brow0 * KB;
    PG8_STAGE_B(PG8_SB(0, 0), cB); if constexpr (!NHALF) PG8_STAGE_B(PG8_SB(0, 1), cB + hstep); PG8_STAGE_A(PG8_SA(0, 0), cA, 0); PG8_STAGE_A(PG8_SA(0, 1), cA, 1);
    if (wr == 1) PG8_BAR;
    PG8_WAIT_V(2); PG8_BAR;
    PG8_STAGE_B(PG8_SB(1, 0), cB + kstep); PG8_STAGE_A(PG8_SA(1, 0), cA + kstep, 0); if constexpr (!NHALF) PG8_STAGE_B(PG8_SB(1, 1), cB + hstep + kstep);
    if constexpr (NHALF) PG8_WAIT_V(4); else PG8_WAIT_V(6);
    PG8_BAR;
    for (;;) {
        const typename Epi::Pre pre = E.prefetch(cur, lds, wid, lane, ui);
        const bool has_next = S.next(ui + 1, nxt);
        if (GATHER) { if (has_next) PG8_TABLOAD((ui + 1) & 1, nxt.arow0); }
        const char* nA = has_next ? ((const char*)Ag + (GATHER ? (size_t)0 : (size_t)nxt.arow0 * KB)) : cA; const char* nB = has_next ? (const char*)Bg + (size_t)nxt.brow0 * KB : cB;
_Pragma("nounroll")
        for (int t = 0; t < nt; t += 2) {
            const bool last = (t == nt - 2);
            const char* a1 = cA + (size_t)(t + 1) * kstep;
            const char* a2 = last ? nA : cA + (size_t)(t + 2) * kstep; const char* b2 = last ? nB : cB + (size_t)(t + 2) * kstep;
            const char* a3 = a2 + kstep; const char* b3 = b2 + kstep;
            if (GATHER) { if (last && has_next) { PG8_AOFF_H(0, (ui + 1) & 1); } }
            PG8_LDB(B0, 0, 0); if constexpr (!NHALF) PG8_LDB(B1, 0, 1); PG8_SCHED; PG8_LDA(At, 0, 0); PG8_STAGE_A(PG8_SA(1, 1), a1, 1);
            PG8_WAIT_LOOP; PG8_WAIT_L(0); PG8_BAR; PG8_MMA(0, 0, At, B0); if constexpr (!NHALF) PG8_MMA(0, 1, At, B1); PG8_BAR; PG8_SCHED;
            if (GATHER) { if (last && has_next) { PG8_AOFF_H(1, (ui + 1) & 1); } }
            PG8_LDA(At, 0, 1); PG8_STAGE_B(PG8_SB(0, 0), b2); if constexpr (!NHALF) PG8_STAGE_B(PG8_SB(0, 1), b2 + hstep); PG8_STAGE_A(PG8_SA(0, 0), a2, 0);
            PG8_WAIT_LOOP; PG8_WAIT_L(0); PG8_BAR; PG8_MMA(1, 0, At, B0); if constexpr (!NHALF) PG8_MMA(1, 1, At, B1); PG8_BAR; PG8_SCHED;
            PG8_LDB(B0, 1, 0); if constexpr (!NHALF) PG8_LDB(B1, 1, 1); PG8_SCHED; PG8_LDA(At, 1, 0); PG8_STAGE_A(PG8_SA(0, 1), a2, 1);
            PG8_WAIT_LOOP; PG8_WAIT_L(0); PG8_BAR; PG8_MMA(0, 0, At, B0); if constexpr (!NHALF) PG8_MMA(0, 1, At, B1); PG8_BAR; PG8_SCHED;
            PG8_LDA(At, 1, 1); PG8_STAGE_B(PG8_SB(1, 0), b3); if constexpr (!NHALF) PG8_STAGE_B(PG8_SB(1, 1), b3 + hstep); PG8_STAGE_A(PG8_SA(1, 0), a3, 0);
            PG8_WAIT_LOOP; PG8_WAIT_L(0); PG8_BAR; PG8_MMA(1, 0, At, B0); if constexpr (!NHALF) PG8_MMA(1, 1, At, B1); PG8_BAR; PG8_SCHED;
        }
        if constexpr (ALIGN_EPI) { if (wr == 0) PG8_BAR; }
        E(acc, cur, wr, wc, fr, fq, pre);
        if (!has_next) break;
#pragma unroll
        for (int a = 0; a < 2; ++a)
#pragma unroll
            for (int b = 0; b < 2; ++b)
#pragma unroll
                for (int m = 0; m < 4; ++m)
#pragma unroll
                    for (int n = 0; n < 2; ++n) acc[a][b][m][n] = (f32x4){0.f, 0.f, 0.f, 0.f};
        cur = nxt; cA = nA; cB = nB; ++ui;
        if constexpr (ALIGN_EPI) { if (wr == 1) PG8_BAR; }
    }
    PG8_WAIT_V(0);
    if constexpr (!ALIGN_EPI) { if (wr == 0) PG8_BAR; }
    PG8_BAR;
#undef PG8_SA
#undef PG8_SB
#undef PG8_STAGE_A
#undef PG8_STAGE_B
#undef PG8_LDA
#undef PG8_LDB
#undef PG8_MMA
#undef PG8_WAIT_V
#undef PG8_WAIT_L
#undef PG8_WAIT_LOOP
#undef PG8_BAR
#undef PG8_SCHED
#undef PG8_AOFF_H
#undef PG8_TAB
#undef PG8_TABLOAD
}
}

constexpr int NWAVES = 8, NTHR = 512;
constexpr size_t MiB = 1u << 20;
constexpr size_t WS_CTL = 0, CTL_BYTES = 1 * MiB;
constexpr size_t WS_MOD = 1 * MiB;
constexpr size_t WS_WIN = 3 * MiB;
constexpr size_t WS_WOUT = 29 * MiB;
constexpr size_t WS_WR = 37 * MiB;
constexpr size_t WS_HYF = 39 * MiB;
constexpr size_t WS_HYFC = 71 * MiB;
constexpr size_t WS_XC = 73 * MiB;
constexpr size_t WS_EXP1 = 89 * MiB;
constexpr size_t WS_EXP2 = 218 * MiB;
constexpr size_t WS_XM = 283 * MiB;
constexpr size_t WS_EIDX = 419 * MiB;
constexpr size_t WS_WGT = 422 * MiB;
constexpr size_t WS_RNK = 425 * MiB;
constexpr size_t WS_ROWTOK = 428 * MiB;
constexpr size_t WS_ROWDST = 431 * MiB;
constexpr size_t WS_TILEEXP = 434 * MiB;
constexpr size_t WS_BIG = 435 * MiB;
constexpr size_t WS_U = WS_BIG;
constexpr size_t WS_MIX = 877 * MiB;
constexpr size_t WS_VT = 1013 * MiB;
constexpr size_t WS_HV = 1081 * MiB;
constexpr size_t WS_Z2 = 1183 * MiB;
constexpr size_t WS_GDS = 1217 * MiB;
constexpr size_t WS_GSIN = 1285 * MiB;
constexpr size_t WS_GD = 1319 * MiB;
constexpr size_t WS_Y = 1321 * MiB;
constexpr size_t WS_LOGIT = WS_BIG;
constexpr size_t WS_ACT = WS_BIG;
constexpr size_t WS_Y2 = 758 * MiB;
constexpr size_t WS_XM8 = 1470 * MiB;
constexpr size_t WS_XR = 1600 * MiB;
constexpr size_t WS_END = 1736 * MiB;
constexpr int CW_BAR = 4096;
constexpr int CW_CNT = 16384;
constexpr int CW_NTL = 20480;

constexpr int LDS_BYTES = 163840;
constexpr int MISC_OFF = 163584;

struct Frame {
    LAS unsigned char* lds;
    int tid, lane, wave, G, wg;
    const float* const* in;
    float* out; unsigned char* ws; unsigned* ctl;
};
enum { I_X = 0, I_C, I_CTX, I_CCTX, I_WMOD, I_BMOD, I_WIN, I_RPB, I_WA2, I_BA2, I_GNORM, I_HSW, I_HSB, I_HW1, I_HB1, I_HF1, I_HW2, I_HB2, I_HF2, I_HW3, I_HB3, I_HDEC, I_HSKIP,
       I_WOUT, I_LN1G, I_LN1B, I_RW, I_RB, I_WEG, I_WEU, I_WED, I_WSG, I_WSU, I_WSD, I_LN2G, I_LN2B };

__device__ __forceinline__ int row_b(int row) { return row < NLAT ? (row >> 12) : 16; }
__device__ __forceinline__ const float* mod_ptr(const Frame& F, int l, int row) { return (const float*)(F.ws + WS_MOD) + ((size_t)l * 17 + row_b(row)) * 6144; }

constexpr float NA_QSCALE = 0.125f * 1.4426950408889634f, NA_CLAMP = 60.0f * 1.4426950408889634f;
template <class RowFn>
__device__ __forceinline__ void tr_item(const float* W, int ldw, int k0, int n0, bf16_t* dst, int ldd, RowFn rf, LAS float* scr, int lane, float scale = 1.0f) {
    float tv[32];
    const GAS float* wp = (const GAS float*)(W + (size_t)(k0 + (lane >> 5)) * ldw + n0 + (lane & 31));
#pragma unroll
    for (int i = 0; i < 32; ++i) tv[i] = wp[(size_t)(2 * i) * ldw];
#pragma unroll
    for (int i = 0; i < 32; ++i) scr[(2 * i + (lane >> 5)) * 33 + (lane & 31)] = tv[i];
    LDS_WAIT(); asm volatile("" ::: "memory");
    const int c = lane & 7;
#pragma unroll
    for (int j = 0; j < 4; ++j) { const int n = (lane >> 3) + 8 * j; const LAS float* s = scr + (8 * c) * 33 + n;
        u32x4 o; o.x = pk2(s[0 * 33] * scale, s[1 * 33] * scale); o.y = pk2(s[2 * 33] * scale, s[3 * 33] * scale); o.z = pk2(s[4 * 33] * scale, s[5 * 33] * scale); o.w = pk2(s[6 * 33] * scale, s[7 * 33] * scale);
        *(GAS u32x4*)(dst + (size_t)rf(n0 + n) * ldd + k0 + 8 * c) = o; }
    LDS_WAIT(); asm volatile("" ::: "memory");
}
template <class RowFn>
__device__ __forceinline__ void tr_item8(const float* W, int ldw, int k0, int n0, unsigned char* dst, int ldd, RowFn rf, float scale, LAS float* scr, int lane) {
    float tv[32];
    const GAS float* wp = (const GAS float*)(W + (size_t)(k0 + (lane >> 5)) * ldw + n0 + (lane & 31));
#pragma unroll
    for (int i = 0; i < 32; ++i) tv[i] = wp[(size_t)(2 * i) * ldw];
#pragma unroll
    for (int i = 0; i < 32; ++i) scr[(2 * i + (lane >> 5)) * 33 + (lane & 31)] = tv[i];
    LDS_WAIT(); asm volatile("" ::: "memory");
    const int n = lane >> 1, hf = lane & 1; const LAS float* s = scr + (32 * hf) * 33 + n;
    unsigned w[8];
#pragma unroll
    for (int j = 0; j < 8; ++j) { int v = 0; v = __builtin_amdgcn_cvt_pk_fp8_f32(s[(4 * j) * 33] * scale, s[(4 * j + 1) * 33] * scale, v, false); v = __builtin_amdgcn_cvt_pk_fp8_f32(s[(4 * j + 2) * 33] * scale, s[(4 * j + 3) * 33] * scale, v, true); w[j] = (unsigned)v; }
    unsigned char* d = dst + (size_t)rf(n0 + n) * ldd + k0 + 32 * hf;
    *(GAS u32x4*)d = (u32x4){w[0], w[1], w[2], w[3]}; *(GAS u32x4*)(d + 16) = (u32x4){w[4], w[5], w[6], w[7]};
    LDS_WAIT(); asm volatile("" ::: "memory");
}
struct RowId { __device__ __forceinline__ int operator()(int n) const { return n; } };
struct RowWin { __device__ __forceinline__ int operator()(int n) const { return n >= 2336 ? n - 32 : n; } };
struct RowGU { int up; __device__ __forceinline__ int operator()(int j) const { return (j >> 7) * 256 + up * 128 + (j & 127); } };

__device__ __forceinline__ void p0_static_weights(Frame& F) {
    LAS float* scr = (LAS float*)(F.lds + F.wave * 16384);
    const int gw = F.wg * NWAVES + F.wave, NGW = F.G * NWAVES;
    constexpr int I_IN = 16 * 97, I_OUT = 16 * 32, I_R = 16 * 4, PER_L = I_IN + I_OUT + I_R;
    for (int it = gw; it < DEPTH * PER_L; it += NGW) {
        const int l = it / PER_L; int r = it % PER_L;
        if (r < I_IN) { const int kb = r / 97, nb = r % 97; if (nb == 72) continue;
            tr_item(F.in[I_WIN] + (size_t)l * DM * DIN_REF, DIN_REF, kb * 64, nb * 32, (bf16_t*)(F.ws + WS_WIN) + (size_t)l * DIN * DM, DM, RowWin{}, scr, F.lane, nb < 16 ? NA_QSCALE : 1.0f); continue; }
        r -= I_IN;
        if (r < I_OUT) { const int kb = r / 32, nb = r % 32;
            tr_item(F.in[I_WOUT] + (size_t)l * DM * DM, DM, kb * 64, nb * 32, (bf16_t*)(F.ws + WS_WOUT) + (size_t)l * DM * DM, DM, RowId{}, scr, F.lane); continue; }
        r -= I_OUT;
        { const int kb = r / 4, nb = r % 4;
            tr_item(F.in[I_RW] + (size_t)l * DM * NEXP, NEXP, kb * 64, nb * 32, (bf16_t*)(F.ws + WS_WR) + (size_t)l * 256 * DM, DM, RowId{}, scr, F.lane); }
    }
    const int gt = F.wg * NTHR + F.tid, NGT = F.G * NTHR;
    for (int i = gt; i < DEPTH * 128 * DM / 8; i += NGT) { const int l = i / (128 * DM / 8), r = i % (128 * DM / 8);
        *(u32x4*)((bf16_t*)(F.ws + WS_WR) + ((size_t)l * 256 + 128) * DM + (size_t)r * 8) = (u32x4){0u, 0u, 0u, 0u}; }
    for (int i = gt; i < DEPTH * 256 * DM; i += NGT) {
        const int k = i % DM, n = (i / DM) % 256, l = i / (DM * 256), dir = n >> 7, j = n & 127;
        const float* wi = F.in[I_WIN] + ((size_t)l * DM + k) * DIN_REF + 2304 + dir * 16;
        const float* wa = F.in[I_WA2] + ((size_t)(l * 2 + dir) * 16) * 128 + j;
        float s = 0.f;
#pragma unroll
        for (int r = 0; r < 16; ++r) s += wi[r] * wa[r * 128];
        ((bf16_t*)(F.ws + WS_WIN))[((size_t)l * DIN + 3072 + n) * DM + k] = (bf16_t)f2bf(s);
    }
}
__device__ __forceinline__ void p0_mod(Frame& F) {
    LAS float* sc = (LAS float*)F.lds;
    LAS float* red = (LAS float*)(F.lds + 17 * 1024 * 4);
    for (int i = F.tid; i < 17 * 1024; i += NTHR) { const int r = i >> 10, k = i & 1023; const float v = r < 16 ? F.in[I_C][r * 1024 + k] : F.in[I_CCTX][k]; sc[i] = silu_f(v); }
    __syncthreads();
    const int kq = F.tid >> 7, cl = F.tid & 127;
    for (int u = F.wg; u < DEPTH * 48; u += F.G) {
        const int l = u / 48, col = (u % 48) * 128 + cl;
        const float* w = F.in[I_WMOD] + (size_t)l * DM * 6144 + col;
        float a[17];
#pragma unroll
        for (int r = 0; r < 17; ++r) a[r] = 0.f;
        for (int k0 = kq * 256; k0 < kq * 256 + 256; k0 += 16) {
            float wv[16];
#pragma unroll
            for (int q = 0; q < 16; ++q) wv[q] = *(const GAS float*)(w + (size_t)(k0 + q) * 6144);
#pragma unroll
            for (int q = 0; q < 16; ++q)
#pragma unroll
                for (int r = 0; r < 17; ++r) a[r] += sc[r * 1024 + k0 + q] * wv[q]; }
#pragma unroll
        for (int r = 0; r < 17; ++r) red[(kq * 17 + r) * 128 + cl] = a[r];
        __syncthreads();
        for (int i = F.tid; i < 17 * 128; i += NTHR) { const int r = i >> 7, c2 = i & 127, cc = (u % 48) * 128 + c2;
            const float s = red[(0 * 17 + r) * 128 + c2] + red[(1 * 17 + r) * 128 + c2] + red[(2 * 17 + r) * 128 + c2] + red[(3 * 17 + r) * 128 + c2] + F.in[I_BMOD][l * 6144 + cc];
            ((float*)(F.ws + WS_MOD))[((size_t)l * 17 + r) * 6144 + cc] = s; }
        __syncthreads();
    }
}
__device__ __forceinline__ void p0_hyena_filters(Frame& F) {
    LAS float* z = (LAS float*)F.lds;
    LAS float* h1 = z + 1092;
    LAS float* h2 = h1 + 33 * 64;
    LAS float* tt = h2 + 33 * 64;
    LAS float* W1 = tt + 64;
    LAS float* W2 = W1 + 33 * 64;
    constexpr int UL = 4096 / 32, UC = 256 / 32, UPL = UL + UC;
    for (int u = F.wg; u < DEPTH * UPL; u += F.G) {
        const int l = u / UPL, r = u % UPL; const bool lat = r < UL; const int L = lat ? 4096 : 256, n0 = (lat ? r : r - UL) * 32;
        __syncthreads();
        for (int i = F.tid; i < 33 * 64; i += NTHR) W1[i] = F.in[I_HW1][(size_t)l * 33 * 64 + i];
        for (int i = F.tid; i < 64 * 64; i += NTHR) W2[i] = F.in[I_HW2][(size_t)l * 64 * 64 + i];
        for (int i = F.tid; i < 33 * 33; i += NTHR) { const int p = i / 33, e = i % 33, n = n0 + p;
            const float t = (float)n / (float)(L - 1);
            float v;
            if (e == 0) v = t;
            else { const int kb = (e - 1) & 15; const float band = 1e-4f + (float)kb * ((15.0f - 1e-4f) / 15.0f);
                   const float w = 6.283185307179586f * (float)n / (float)L; const float ang = w * band;
                   v = e <= 16 ? __cosf(ang) : -__sinf(ang); }
            z[i] = v; if (e == 0) tt[p] = t; }
        __syncthreads();
        for (int i = F.tid; i < 33 * 64; i += NTHR) { const int p = i >> 6, j = i & 63; float s = F.in[I_HB1][l * 64 + j];
#pragma unroll 11
            for (int e = 0; e < 33; ++e) s += z[p * 33 + e] * W1[e * 64 + j];
            h1[i] = __sinf(F.in[I_HF1][l * 64 + j] * s); }
        __syncthreads();
        for (int i = F.tid; i < 33 * 64; i += NTHR) { const int p = i >> 6, j = i & 63; float s = F.in[I_HB2][l * 64 + j];
#pragma unroll 16
            for (int e = 0; e < 64; ++e) s += h1[p * 64 + e] * W2[e * 64 + j];
            h2[i] = __sinf(F.in[I_HF2][l * 64 + j] * s); }
        __syncthreads();
        {
            const int g = F.tid >> 8, col0 = 4 * (F.tid & 255), o = col0 >> 9, dir = (col0 >> 8) & 1, ch0 = col0 & 255;
            const int pb = (dir ? 0 : 1) + 16 * g;
            float a[4][16];
#pragma unroll
            for (int j = 0; j < 4; ++j)
#pragma unroll
                for (int q = 0; q < 16; ++q) a[j][q] = 0.f;
            const float* w3 = F.in[I_HW3] + (size_t)l * 64 * 1024 + col0;
            const LAS float* hp = h2 + pb * 64;
            f32x4 wa[4], wb[4];
#pragma unroll
            for (int q = 0; q < 4; ++q) wa[q] = *(const GAS f32x4*)(w3 + (size_t)q * 1024);
#define HF_BLOCK(wv_, k0_) do { _Pragma("unroll") for (int pi = 0; pi < 16; ++pi) { const f32x4 hv = *(const LAS f32x4*)(hp + pi * 64 + (k0_)); \
                _Pragma("unroll") for (int q = 0; q < 4; ++q) _Pragma("unroll") for (int j = 0; j < 4; ++j) a[j][pi] += hv[q] * wv_[q][j]; } } while (0)
#pragma unroll 1
            for (int k0 = 0; k0 < 64; k0 += 8) {
#pragma unroll
                for (int q = 0; q < 4; ++q) wb[q] = *(const GAS f32x4*)(w3 + (size_t)(k0 + 4 + q) * 1024);
                __builtin_amdgcn_sched_barrier(0);
                HF_BLOCK(wa, k0);
                __builtin_amdgcn_sched_barrier(0);
                { const int kn = k0 + 8 < 64 ? k0 + 8 : k0;
#pragma unroll
                  for (int q = 0; q < 4; ++q) wa[q] = *(const GAS f32x4*)(w3 + (size_t)(kn + q) * 1024); }
                __builtin_amdgcn_sched_barrier(0);
                HF_BLOCK(wb, k0 + 4);
                __builtin_amdgcn_sched_barrier(0);
            }
#undef HF_BLOCK
            const f32x4 b3 = *(const GAS f32x4*)(F.in[I_HB3] + l * 1024 + col0), dc = *(const GAS f32x4*)(F.in[I_HDEC] + ((size_t)(l * 2 + o) * 2 + dir) * 256 + ch0);
            float a0[4] = {0.f, 0.f, 0.f, 0.f};
            if (n0 == 0 && dir == 0 && g == 0) {
                for (int k = 0; k < 64; ++k) { const f32x4 wv = *(const GAS f32x4*)(w3 + (size_t)k * 1024); const float hv = h2[k];
#pragma unroll
                    for (int j = 0; j < 4; ++j) a0[j] += hv * wv[j]; } }
#pragma unroll
            for (int j = 0; j < 4; ++j) {
                const float dec = fabsf(dc[j]);
                bf16_t* R = lat ? (bf16_t*)(F.ws + WS_HYF) + ((size_t)(l * 2 + o) * 256 + ch0 + j) * 8192 : (bf16_t*)(F.ws + WS_HYFC) + ((size_t)(l * 2 + o) * 256 + ch0 + j) * 512;
                float v[16];
#pragma unroll
                for (int pi = 0; pi < 16; ++pi) v[pi] = (a[j][pi] + b3[j]) * __expf(-tt[pb + pi] * dec);
                unsigned w[8];
                if (dir == 0) {
                    if (n0 + 32 == L && g == 1) v[15] = 0.f;
#pragma unroll
                    for (int q = 0; q < 8; ++q) w[q] = pk2(v[15 - 2 * q], v[14 - 2 * q]);
                    GAS u32x4* dst = (GAS u32x4*)(R + (L - n0 - 32) + 16 * (1 - g));
                    dst[0] = (u32x4){w[0], w[1], w[2], w[3]}; dst[1] = (u32x4){w[4], w[5], w[6], w[7]};
                    if (n0 == 0 && g == 0) R[L] = (bf16_t)f2bf((a0[j] + b3[j]) * __expf(-tt[0] * dec) + F.in[I_HSKIP][(l * 2 + o) * 256 + ch0 + j]);
                } else if (n0 > 0 || g == 1) {
#pragma unroll
                    for (int q = 0; q < 8; ++q) w[q] = pk2(v[2 * q], v[2 * q + 1]);
                    GAS u32x4* dst = (GAS u32x4*)(R + (L + n0) + 16 * g);
                    dst[0] = (u32x4){w[0], w[1], w[2], w[3]}; dst[1] = (u32x4){w[4], w[5], w[6], w[7]};
                } else {
#pragma unroll
                    for (int pi = 1; pi < 16; ++pi) R[L + pi] = (bf16_t)f2bf(v[pi]);
                }
            }
        }
    }
    __syncthreads();
}
__device__ __forceinline__ void p0_init_rows(Frame& F) {
    const int gw = F.wg * NWAVES + F.wave, NGW = F.G * NWAVES;
    for (int row = gw; row < NROW; row += NGW) {
        const float* src = row < NLAT ? F.in[I_X] + (size_t)row * DM : F.in[I_CTX] + (size_t)(row - NLAT) * DM;
        const float* md = mod_ptr(F, 0, row);
        bf16_t* xr = (bf16_t*)(F.ws + WS_XR) + (size_t)row * DM; bf16_t* xm = (bf16_t*)(F.ws + WS_XM) + (size_t)row * DM;
#pragma unroll
        for (int j = 0; j < 4; ++j) { const int c = 4 * F.lane + 256 * j;
            const f32x4 v = *(const GAS f32x4*)(src + c), sh = *(const GAS f32x4*)(md + c), sc = *(const GAS f32x4*)(md + 1024 + c);
            *(GAS u32x2*)(xr + c) = (u32x2){pk2(v[0], v[1]), pk2(v[2], v[3])};
            u32x2 w; w.x = pk2(v[0] * (1.f + sc[0]) + sh[0], v[1] * (1.f + sc[1]) + sh[1]); w.y = pk2(v[2] * (1.f + sc[2]) + sh[2], v[3] * (1.f + sc[3]) + sh[3]);
            *(GAS u32x2*)(xm + c) = w; }
    }
}
constexpr float WEXP_SCALE = 32.0f;
__device__ __forceinline__ void p_expert_weights(Frame& F, int l) {
    LAS float* scr = (LAS float*)(F.lds + F.wave * 16384);
    const int gw = F.wg * NWAVES + F.wave, NGW = F.G * NWAVES;
    constexpr int I1 = 16 * 8, I2 = 4 * 32, PER_E = 2 * I1 + I2;
    for (int it = gw; it < NE1 * PER_E; it += NGW) {
        const int e = it / PER_E; int r = it % PER_E;
        unsigned char* d1 = (unsigned char*)(F.ws + WS_EXP1) + (size_t)e * 512 * DM; unsigned char* d2 = (unsigned char*)(F.ws + WS_EXP2) + (size_t)e * DM * EH;
        if (r < 2 * I1) { const int up = r >= I1; if (up) r -= I1; const int kb = r / 8, nb = r % 8;
            const float* src = e < NEXP ? F.in[up ? I_WEU : I_WEG] + ((size_t)l * NEXP + e) * DM * EH : F.in[up ? I_WSU : I_WSG] + (size_t)l * DM * EH;
            tr_item8(src, EH, kb * 64, nb * 32, d1, DM, RowGU{up}, up ? WEXP_SCALE * 0.6931471805599453f : WEXP_SCALE * 1.4426950408889634f, scr, F.lane); }
        else { r -= 2 * I1; const int kb = r / 32, nb = r % 32;
            const float* src = e < NEXP ? F.in[I_WED] + ((size_t)l * NEXP + e) * EH * DM : F.in[I_WSD] + (size_t)l * EH * DM;
            tr_item8(src, DM, kb * 64, nb * 32, d2, EH, RowId{}, WEXP_SCALE, scr, F.lane); }
    }
}

__device__ __forceinline__ f32x4 mfma16(bf16x8 a, bf16x8 b, f32x4 c) { return __builtin_amdgcn_mfma_f32_16x16x32_bf16(a, b, c, 0, 0, 0); }

__device__ __forceinline__ void ph_transposes(Frame& F, int l) {
    LAS bf16_t* tile = (LAS bf16_t*)(F.lds + F.wave * 16384);
    const bf16_t* U = (const bf16_t*)(F.ws + WS_U);
    const int gw = F.wg * NWAVES + F.wave, NGW = F.G * NWAVES;
    const int rsub = F.lane >> 3, cseg = F.lane & 7;
    for (int u = gw; u < 1088 * 20; u += NGW) {
        const int tt = u / 20, blk = u % 20;
        int b, s0, Ls, rowbase, posbase;
        if (tt < 1024) { b = tt >> 6; s0 = (tt & 63) * 64; Ls = SEQ; rowbase = b * SEQ; posbase = 0; }
        else { const int t2 = tt - 1024; b = t2 >> 2; s0 = (t2 & 3) * 64; Ls = CTXL; rowbase = NLAT + b * CTXL; posbase = SEQ; }
        if (blk < 12) {
            constexpr int HT = 80;
            float w0[8], w1[8], w2[8], bb[8];
#pragma unroll
            for (int it = 0; it < 8; ++it) { const int col = blk * 64 + rsub + 8 * it; w0[it] = F.in[I_HSW][(l * 3 + 0) * 768 + col]; w1[it] = F.in[I_HSW][(l * 3 + 1) * 768 + col]; w2[it] = F.in[I_HSW][(l * 3 + 2) * 768 + col]; bb[it] = F.in[I_HSB][l * 768 + col]; }
            const bf16_t* p0 = U + (size_t)(rowbase + s0 + rsub) * DIN + UHY + blk * 64 + cseg * 8;
            u32x4 zc[8];
#pragma unroll
            for (int it = 0; it < 8; ++it) zc[it] = *(const GAS u32x4*)(p0 + (size_t)(8 * it) * DIN);
            u32x4 zh = (u32x4){0u, 0u, 0u, 0u};
            if (F.lane < 16) { const int hs = F.lane < 8 ? s0 - 1 : s0 + 64; if (hs >= 0 && hs < Ls) zh = *(const GAS u32x4*)(U + (size_t)(rowbase + hs) * DIN + UHY + blk * 64 + cseg * 8); }
#pragma unroll
            for (int it = 0; it < 8; ++it) { const unsigned a[4] = {zc[it].x, zc[it].y, zc[it].z, zc[it].w}; LAS bf16_t* d = tile + (cseg * 8) * HT + 8 + rsub + 8 * it;
#pragma unroll
                for (int i = 0; i < 4; ++i) { d[(2 * i) * HT] = (bf16_t)(a[i] & 0xffffu); d[(2 * i + 1) * HT] = (bf16_t)(a[i] >> 16); } }
            if (F.lane < 16) { const unsigned a[4] = {zh.x, zh.y, zh.z, zh.w}; LAS bf16_t* d = tile + (cseg * 8) * HT + (F.lane < 8 ? 7 : 72);
#pragma unroll
                for (int i = 0; i < 4; ++i) { d[(2 * i) * HT] = (bf16_t)(a[i] & 0xffffu); d[(2 * i + 1) * HT] = (bf16_t)(a[i] >> 16); } }
            LDS_WAIT(); asm volatile("" ::: "memory");
#pragma unroll
            for (int it = 0; it < 8; ++it) {
                const int ch = rsub + 8 * it; const LAS bf16_t* r = tile + ch * HT + 8 + cseg * 8;
                const u32x4 v = *(const LAS u32x4*)r; const unsigned hm = r[-1], hp = r[8];
                float x[10]; x[0] = __builtin_bit_cast(float, hm << 16); x[9] = __builtin_bit_cast(float, hp << 16);
                x[1] = bflo(v.x); x[2] = bfhi(v.x); x[3] = bflo(v.y); x[4] = bfhi(v.y); x[5] = bflo(v.z); x[6] = bfhi(v.z); x[7] = bflo(v.w); x[8] = bfhi(v.w);
                unsigned w[4];
#pragma unroll
                for (int i = 0; i < 4; ++i) w[i] = pk2(bb[it] + w0[it] * x[2 * i] + w1[it] * x[2 * i + 1] + w2[it] * x[2 * i + 2], bb[it] + w0[it] * x[2 * i + 1] + w1[it] * x[2 * i + 2] + w2[it] * x[2 * i + 3]);
                *(GAS u32x4*)((bf16_t*)(F.ws + WS_HV) + ((size_t)(blk * 64 + ch) * NB + b) * SPB + posbase + s0 + cseg * 8) = (u32x4){w[0], w[1], w[2], w[3]};
            }
            LDS_WAIT(); asm volatile("" ::: "memory");
            continue;
        } else {
            const int c0 = (blk - 12) * 64 + cseg * 8;
#pragma unroll
            for (int it = 0; it < 8; ++it) {
                const int sl = rsub + 8 * it, s = s0 + sl;
                const u32x4 zc = *(const GAS u32x4*)(U + (size_t)(rowbase + s) * DIN + UV + c0);
                const unsigned ac[4] = {zc.x, zc.y, zc.z, zc.w};
#pragma unroll
                for (int i = 0; i < 4; ++i) { tile[(cseg * 8 + 2 * i) * 72 + sl] = (bf16_t)(ac[i] & 0xffffu); tile[(cseg * 8 + 2 * i + 1) * 72 + sl] = (bf16_t)(ac[i] >> 16); }
            }
        }
        LDS_WAIT(); asm volatile("" ::: "memory");
#pragma unroll 2
        for (int it = 0; it < 8; ++it) {
            const int ch = rsub + 8 * it;
            const u32x4 v = *(const LAS u32x4*)(tile + ch * 72 + cseg * 8);
            bf16_t* dst;
            if (blk < 12) dst = (bf16_t*)(F.ws + WS_HV) + ((size_t)(blk * 64 + ch) * NB + b) * SPB + posbase + s0 + cseg * 8;
            else dst = (bf16_t*)(F.ws + WS_VT) + ((size_t)b * 512 + (blk - 12) * 64 + ch) * SPB + posbase + s0 + cseg * 8;
            *(GAS u32x4*)dst = v;
        }
        LDS_WAIT(); asm volatile("" ::: "memory");
    }
}

constexpr int NA_RPB = 0, NA_KC = 2048, NA_VC = NA_KC + 256 * 144, NA_KR = NA_VC + 64 * 528, NA_END = NA_KR + 9 * 64 * 144;
static_assert(NA_END <= MISC_OFF, "NA LDS map");
__device__ __forceinline__ bf16x8 gld16(const bf16_t* p) { return *(const GAS bf16x8*)p; }
__device__ __forceinline__ u32x2 gld8(const bf16_t* p) { return *(const GAS u32x2*)p; }
__device__ __forceinline__ const char* uni_ptr(const char* p) { const unsigned long long v = (unsigned long long)p; const unsigned lo = __builtin_amdgcn_readfirstlane((unsigned)v), hi = __builtin_amdgcn_readfirstlane((unsigned)(v >> 32)); return (const char*)(((unsigned long long)hi << 32) | lo); }
__device__ __forceinline__ bf16x8 gld16o(const char* ub, unsigned lo) { return *(const GAS bf16x8*)(ub + (size_t)lo); }
__device__ __forceinline__ u32x2 gld8o(const char* ub, unsigned lo) { return *(const GAS u32x2*)(ub + (size_t)lo); }
template <bool WIN>
__device__ __forceinline__ void na_unit(Frame& F, int b, int h, int r, int strip) {
    const bf16_t* U = (const bf16_t*)(F.ws + WS_U);
    const bf16_t* VT = (const bf16_t*)(F.ws + WS_VT) + ((size_t)b * 512 + h * 64) * SPB;
    const LAS float* rpb = (const LAS float*)(F.lds + NA_RPB);
    const LAS bf16_t* KC = (const LAS bf16_t*)(F.lds + NA_KC); const LAS bf16_t* VC = (const LAS bf16_t*)(F.lds + NA_VC);
    int ln_ = F.lane; asm volatile("" : "+v"(ln_));
    const int i = ln_ & 15, g = ln_ >> 4;
    const int qrow0 = WIN ? (b * SEQ + r * 64 + strip * 16) : (NLAT + b * CTXL + strip * 16);
    const int ki = 8 * (i >> 2) + (i & 3);
    const unsigned qlo = (unsigned)((i * DIN + 8 * g) * 2), klo = (unsigned)((ki * DIN + 8 * g) * 2), vlo = (unsigned)((i * SPB + 8 * g) * 2);
    const char* qb = uni_ptr((const char*)(U + (size_t)qrow0 * DIN + UQ + h * 64));
    const bf16x8 q0 = gld16o(qb, qlo), q1 = gld16o(qb + 64, qlo);
    int kr0 = 0, u0 = 0;
    if (WIN) { kr0 = r - 4; kr0 = kr0 < 0 ? 0 : (kr0 > 56 ? 56 : kr0); u0 = strip == 0 ? 0 : (strip == 1 ? 8 : (strip == 2 ? 24 : 32)); }
    const LAS bf16_t* KR = (const LAS bf16_t*)(F.lds + NA_KR);
    const char* vbase = uni_ptr((const char*)(VT + kr0 * 64 + u0));
    f32x4 o[4];
#pragma unroll
    for (int d = 0; d < 4; ++d) o[d] = (f32x4){0.f, 0.f, 0.f, 0.f};
    float lsum = 0.f;
#define NA_SB() __builtin_amdgcn_sched_barrier(0)
#define NA_WLOAD(vb_, cw) do { _Pragma("unroll") for (int d = 0; d < 4; ++d) vb_[d] = gld16o(vbase + ((size_t)(d * 16) * SPB + (cw) * 64) * 2, vlo); } while (0)
#define NA_KRING(kb_, cw) do { const LAS bf16_t* kp = KR + ((((kr0 + (cw)) % 9) * 64 + u0 + ki) * 72 + 8 * g); kb_[0][0] = *(const LAS bf16x8*)kp; kb_[0][1] = *(const LAS bf16x8*)(kp + 32); \
        kb_[1][0] = *(const LAS bf16x8*)(kp + 4 * 72); kb_[1][1] = *(const LAS bf16x8*)(kp + 4 * 72 + 32); } while (0)
#define NA_QK(kb_, s_) do { _Pragma("unroll") for (int t = 0; t < 2; ++t) { f32x4 a = (f32x4){0.f, 0.f, 0.f, 0.f}; a = mfma16(kb_[t][0], q0, a); a = mfma16(kb_[t][1], q1, a); s_[t] = a; } } while (0)
#define NA_PV(s_, vb_) do { u32x4 pw; pw.x = pk2(s_[0][0], s_[0][1]); pw.y = pk2(s_[0][2], s_[0][3]); pw.z = pk2(s_[1][0], s_[1][1]); pw.w = pk2(s_[1][2], s_[1][3]); const bf16x8 pf = __builtin_bit_cast(bf16x8, pw); \
        _Pragma("unroll") for (int d = 0; d < 4; ++d) o[d] = mfma16(vb_[d], pf, o[d]); } while (0)
    bf16x8 vA[4], vB[4], vC[4];
    if (WIN) { NA_WLOAD(vA, 0); NA_WLOAD(vB, 1); NA_WLOAD(vC, 2); NA_SB(); }
#pragma unroll
    for (int cc = 0; cc < 8; ++cc) {
        bf16x8 kc[2][2], vc[4]; f32x4 sc[2];
#pragma unroll
        for (int t = 0; t < 2; ++t) { const LAS bf16_t* kp = KC + (cc * 32 + ki + 4 * t) * 72 + 8 * g; kc[t][0] = *(const LAS bf16x8*)kp; kc[t][1] = *(const LAS bf16x8*)(kp + 32); }
#pragma unroll
        for (int d = 0; d < 4; ++d) vc[d] = *(const LAS bf16x8*)(VC + (d * 16 + i) * 264 + cc * 32 + 8 * g);
        NA_QK(kc, sc);
#pragma unroll
        for (int t = 0; t < 2; ++t)
#pragma unroll
            for (int e = 0; e < 4; ++e) { const float p = __builtin_amdgcn_exp2f(fminf(sc[t][e], NA_CLAMP)); sc[t][e] = p; lsum += p; }
        NA_PV(sc, vc);
    }
    if (WIN) {
        const int c = strip * 16 + i; int kc0 = c - 8; kc0 = kc0 < 0 ? 0 : (kc0 > 48 ? 48 : kc0);
        int dcl[2][4]; bool okm[2][4];
#pragma unroll
        for (int t = 0; t < 2; ++t)
#pragma unroll
            for (int e = 0; e < 4; ++e) { const int kc = u0 + 8 * g + 4 * t + e; okm[t][e] = (kc >= kc0) && (kc < kc0 + 16); int dc = kc - c + 15; dcl[t][e] = okm[t][e] ? (dc < 0 ? 0 : (dc > 30 ? 30 : dc)) : 31; }
#define NA_WCHUNK(vb_, cw) do { bf16x8 kw[2][2]; NA_KRING(kw, cw); f32x4 sw[2]; NA_QK(kw, sw); const LAS float* rp = rpb + (kr0 + (cw) - r + 7) * 32; \
        _Pragma("unroll") for (int t = 0; t < 2; ++t) _Pragma("unroll") for (int e = 0; e < 4; ++e) { const float x = sw[t][e] + rp[dcl[t][e]]; const float p = __builtin_amdgcn_exp2f(fminf(x, NA_CLAMP)); sw[t][e] = p; lsum += p; } \
        NA_PV(sw, vb_); } while (0)
        NA_WCHUNK(vA, 0); NA_SB(); NA_WLOAD(vA, 3); NA_SB();
        NA_WCHUNK(vB, 1); NA_SB(); NA_WLOAD(vB, 4); NA_SB();
        NA_WCHUNK(vC, 2); NA_SB(); NA_WLOAD(vC, 5); NA_SB();
        NA_WCHUNK(vA, 3); NA_SB(); NA_WLOAD(vA, 6); NA_SB();
        NA_WCHUNK(vB, 4); NA_SB(); NA_WLOAD(vB, 7); NA_SB();
        NA_WCHUNK(vC, 5); NA_SB();
        NA_WCHUNK(vA, 6); NA_SB();
        NA_WCHUNK(vB, 7); NA_SB();
#undef NA_WCHUNK
    }
    lsum += shx(lsum, 16, ln_); lsum += shx(lsum, 32, ln_);
    const float inv = 1.0f / lsum;
    char* op = (char*)uni_ptr((const char*)((bf16_t*)(F.ws + WS_MIX) + (size_t)qrow0 * DM + h * 64)); const unsigned olo = (unsigned)((i * DM + 4 * g) * 2);
#pragma unroll
    for (int d = 0; d < 4; ++d) { u32x2 w; w.x = pk2(o[d][0] * inv, o[d][1] * inv); w.y = pk2(o[d][2] * inv, o[d][3] * inv); *(GAS u32x2*)(op + d * 32 + (size_t)olo) = w; }
#undef NA_SB
#undef NA_WLOAD
#undef NA_KRING
#undef NA_QK
#undef NA_PV
}
__device__ __forceinline__ int na_kr0(int r) { const int k = r - 4; return k < 0 ? 0 : (k > 56 ? 56 : k); }
__device__ __forceinline__ void ph_na(Frame& F, int l, bool last) {
    const bf16_t* U = (const bf16_t*)(F.ws + WS_U);
    for (int job = F.wg; job < NB * 8 * 2; job += F.G) {
        const int half = job & 1, h = (job >> 1) & 7, b = job >> 4;
        int tz_; asm volatile("v_mbcnt_lo_u32_b32 %0, -1, 0\n\tv_mbcnt_hi_u32_b32 %0, -1, %0" : "=v"(tz_)); tz_ |= F.wave << 6;
        const bf16_t* krow = U + (size_t)(b * SEQ + (tz_ >> 3)) * DIN + UK + h * 64 + (tz_ & 7) * 8;
        LAS bf16_t* kdst = (LAS bf16_t*)(F.lds + NA_KR) + (tz_ >> 3) * 72 + (tz_ & 7) * 8;
        __syncthreads();
        { LAS float* rpb = (LAS float*)(F.lds + NA_RPB); const float* rsrc = F.in[I_RPB] + ((size_t)l * 8 + h) * 15 * 31;
          if (tz_ < 15 * 32) rpb[tz_] = (tz_ & 31) < 31 ? rsrc[(tz_ >> 5) * 31 + (tz_ & 31)] * 1.4426950408889634f : -1e30f;
          const int key = tz_ >> 1, hf = tz_ & 1; const bf16_t* src = U + (size_t)(NLAT + b * CTXL + key) * DIN + UK + h * 64 + hf * 32; LAS bf16_t* dst = (LAS bf16_t*)(F.lds + NA_KC) + key * 72 + hf * 32;
#pragma unroll
          for (int j = 0; j < 4; ++j) *(LAS bf16x8*)(dst + j * 8) = gld16(src + j * 8);
          const int dv = tz_ >> 3, seg = tz_ & 7; const bf16_t* vs = (const bf16_t*)(F.ws + WS_VT) + ((size_t)b * 512 + h * 64 + dv) * SPB + SEQ + seg * 32; LAS bf16_t* vd = (LAS bf16_t*)(F.lds + NA_VC) + dv * 264 + seg * 32;
#pragma unroll
          for (int j = 0; j < 4; ++j) *(LAS bf16x8*)(vd + j * 8) = gld16(vs + j * 8);
          const int lo = na_kr0(half * 32), hi0 = na_kr0(half * 32 + 1) + 7;
          for (int kr = lo; kr <= hi0; ++kr) *(LAS bf16x8*)(kdst + (kr % 9) * 64 * 72) = gld16(krow + (size_t)kr * 64 * DIN); }
        __syncthreads();
        int prev_hi = na_kr0(half * 32 + 1) + 7;
#pragma unroll 1
        for (int s = 0; s < 16; ++s) {
            const int r0 = half * 32 + 2 * s;
            const int nhi = s < 15 ? na_kr0(r0 + 3) + 7 : prev_hi;
            bf16x8 n0 = (bf16x8){0, 0, 0, 0, 0, 0, 0, 0}, n1 = n0;
            if (nhi > prev_hi) n0 = gld16(krow + (size_t)(prev_hi + 1) * 64 * DIN);
            if (nhi > prev_hi + 1) n1 = gld16(krow + (size_t)(prev_hi + 2) * 64 * DIN);
            na_unit<true>(F, b, h, r0 + (F.wave >> 2), F.wave & 3);
            __syncthreads();
            if (nhi > prev_hi) *(LAS bf16x8*)(kdst + ((prev_hi + 1) % 9) * 64 * 72) = n0;
            if (nhi > prev_hi + 1) *(LAS bf16x8*)(kdst + ((prev_hi + 2) % 9) * 64 * 72) = n1;
            __syncthreads();
            prev_hi = nhi;
        }
        if (!last) na_unit<false>(F, b, h, 0, half * 8 + F.wave);
    }
}

__device__ __forceinline__ void ph_hy_transpose(Frame& F, bool last) {
    LAS bf16_t* tile = (LAS bf16_t*)(F.lds + F.wave * 16384);
    const bf16_t* HYO = (const bf16_t*)(F.ws + WS_Y);
    const int gw = F.wg * NWAVES + F.wave, NGW = F.G * NWAVES;
    const int rsub = F.lane >> 3, cseg = F.lane & 7;
    const int ntt = last ? 1024 : 1088;
    for (int u = gw; u < ntt * 4; u += NGW) {
        const int tt = u >> 2, cb = u & 3;
        int b, s0, rowbase, posbase;
        if (tt < 1024) { b = tt >> 6; s0 = (tt & 63) * 64; rowbase = b * SEQ; posbase = 0; }
        else { const int t2 = tt - 1024; b = t2 >> 2; s0 = (t2 & 3) * 64; rowbase = NLAT + b * CTXL; posbase = SEQ; }
#pragma unroll 2
        for (int it = 0; it < 8; ++it) { const int c = rsub + 8 * it;
            const u32x4 v = *(const GAS u32x4*)(HYO + ((size_t)(cb * 64 + c) * NB + b) * SPB + posbase + s0 + cseg * 8); const unsigned a[4] = {v.x, v.y, v.z, v.w};
#pragma unroll
            for (int e = 0; e < 4; ++e) { tile[(cseg * 8 + 2 * e) * 72 + c] = (bf16_t)(a[e] & 0xffffu); tile[(cseg * 8 + 2 * e + 1) * 72 + c] = (bf16_t)(a[e] >> 16); } }
        LDS_WAIT(); asm volatile("" ::: "memory");
#pragma unroll 2
        for (int it = 0; it < 8; ++it) { const int p = rsub + 8 * it;
            const u32x4 v = *(const LAS u32x4*)(tile + p * 72 + cseg * 8);
            *(GAS u32x4*)((bf16_t*)(F.ws + WS_MIX) + (size_t)(rowbase + s0 + p) * DM + 768 + cb * 64 + cseg * 8) = v; }
        LDS_WAIT(); asm volatile("" ::: "memory");
    }
}

constexpr int G2_LAF = 0, G2_LAB = 8448;
constexpr int G2_QTF = 16896, G2_KTF = 22016, G2_QTB = 27136, G2_KTB = 32256;
constexpr int G2_VT = 37376, G2_ATT = 46592;
constexpr int G2_SF = 55808, G2_SB = 60928;
constexpr int G2_SEG = 66048, G2_HALF = 67328;
__device__ __forceinline__ float log_sigmoid_f(float x) { return fminf(x, 0.f) - __logf(1.0f + __expf(-fabsf(x))); }
__device__ __forceinline__ f32x4 mma_lds(const LAS bf16_t* A, int lda, const LAS bf16_t* B, int ldb, int ksteps, f32x4 acc, int lane) {
    const int r = lane & 15, g = lane >> 4;
    for (int ks = 0; ks < ksteps; ++ks) { const bf16x8 a = *(const LAS bf16x8*)(A + r * lda + ks * 32 + 8 * g), b = *(const LAS bf16x8*)(B + r * ldb + ks * 32 + 8 * g); acc = mfma16(a, b, acc); }
    return acc;
}
__device__ __forceinline__ int gla_row0(int b, int cn) { return cn >= 4 ? b * SEQ + (cn - 4) * 64 : NLAT + b * CTXL + cn * 64; }
struct GlaRaw { u32x4 q, k, f, b, v0, v1, g0, g1, s0, s1; };
template <bool FULL>
__device__ __forceinline__ GlaRaw gla_load(Frame& F, int u, int tl) {
    const int h = u & 3, cn = (u >> 2) % 68, b = (u >> 2) / 68, i = tl >> 2, part = tl & 3;
    const bf16_t* p = (const bf16_t*)(F.ws + WS_U) + (size_t)(gla_row0(b, cn) + i) * DIN;
    GlaRaw r;
    r.q = *(const GAS u32x4*)(p + UGQ + h * 32 + part * 8); r.k = *(const GAS u32x4*)(p + UGK + h * 32 + part * 8);
    r.f = *(const GAS u32x4*)(p + ULAF + h * 32 + part * 8); r.b = *(const GAS u32x4*)(p + ULAB + h * 32 + part * 8);
    r.v0 = *(const GAS u32x4*)(p + UGV + h * 64 + part * 16); r.v1 = *(const GAS u32x4*)(p + UGV + h * 64 + part * 16 + 8);
    if (FULL) { r.g0 = *(const GAS u32x4*)(p + UGR + h * 64 + part * 16); r.g1 = *(const GAS u32x4*)(p + UGR + h * 64 + part * 16 + 8);
        const bf16_t* sp = (const bf16_t*)(F.ws + WS_GSIN) + (size_t)u * 2 * 2048 + tl * 16; r.s0 = *(const GAS u32x4*)sp; r.s1 = *(const GAS u32x4*)(sp + 8); }
    else { r.g0 = (u32x4){0u, 0u, 0u, 0u}; r.g1 = r.g0; r.s0 = r.g0; r.s1 = r.g0; }
    return r;
}
template <bool FULL>
__device__ __forceinline__ void gla_prep(Frame& F, LAS unsigned char* L, int l, int u, int tl, const GlaRaw& raw) {
    const int h = u & 3, cn = (u >> 2) % 68, i = tl >> 2, part = tl & 3, d8 = part * 8;
    LAS float* LAF = (LAS float*)(L + G2_LAF); LAS float* LAB = (LAS float*)(L + G2_LAB); LAS bf16_t* VT = (LAS bf16_t*)(L + G2_VT); LAS float* SEG = (LAS float*)(L + G2_SEG);
    float q[8], k[8], tf[8], tb[8];
    unpack8(raw.q, q); unpack8(raw.k, k); unpack8(raw.f, tf); unpack8(raw.b, tb);
    const float* ba = F.in[I_BA2] + (size_t)l * 256 + h * 32 + d8;
#pragma unroll
    for (int e = 0; e < 8; ++e) { q[e] *= 0.17677669529663687f; LAF[i * 33 + d8 + e] = log_sigmoid_f(tf[e] + ba[e]) * 0.0625f; LAB[i * 33 + d8 + e] = log_sigmoid_f(tb[e] + ba[128 + e]) * 0.0625f; }
    if (cn >= 4) {
        const float pos = (part >> 1) ? (float)i : (float)(cn - 4);
#pragma unroll
        for (int e = 0; e < 8; ++e) { const float ang = pos * __expf(-(float)e * (9.210340371976184f / 8.0f)); const float sn = __sinf(ang), cs = __cosf(ang);
            const float qo = shx(q[e], 1, F.lane), ko = shx(k[e], 1, F.lane);
            if (part & 1) { q[e] = qo * sn + q[e] * cs; k[e] = ko * sn + k[e] * cs; } else { q[e] = q[e] * cs - qo * sn; k[e] = k[e] * cs - ko * sn; } }
    }
    { const unsigned a[8] = {raw.v0.x, raw.v0.y, raw.v0.z, raw.v0.w, raw.v1.x, raw.v1.y, raw.v1.z, raw.v1.w};
#pragma unroll
      for (int e = 0; e < 8; ++e) { VT[(part * 16 + 2 * e) * 72 + i] = (bf16_t)(a[e] & 0xffffu); VT[(part * 16 + 2 * e + 1) * 72 + i] = (bf16_t)(a[e] >> 16); } }
    __syncthreads();
    { const int x = tl & 63, d = x & 31, dir = x >> 5, seg = tl >> 6; LAS float* LA = (dir ? LAB : LAF) + d; float cv[16];
#pragma unroll
      for (int kk = 0; kk < 16; ++kk) { const int p = seg * 16 + kk, ti = dir ? 63 - p : p; cv[kk] = LA[ti * 33]; }
#pragma unroll
      for (int kk = 1; kk < 16; ++kk) cv[kk] += cv[kk - 1];
#pragma unroll
      for (int kk = 0; kk < 16; ++kk) { const int p = seg * 16 + kk, ti = dir ? 63 - p : p; LA[ti * 33] = cv[kk]; }
      SEG[x * 5 + seg] = cv[15]; }
    __syncthreads();
    { const int x = tl & 63, d = x & 31, dir = x >> 5, seg = tl >> 6; LAS float* LA = (dir ? LAB : LAF) + d; float cv[16];
      const float t0 = SEG[x * 5 + 0], t1 = SEG[x * 5 + 1], t2 = SEG[x * 5 + 2];
      const float pre = seg == 0 ? 0.f : (seg == 1 ? t0 : (seg == 2 ? t0 + t1 : t0 + t1 + t2));
#pragma unroll
      for (int kk = 0; kk < 16; ++kk) { const int p = seg * 16 + kk, ti = dir ? 63 - p : p; cv[kk] = LA[ti * 33]; }
#pragma unroll
      for (int kk = 0; kk < 16; ++kk) { const int p = seg * 16 + kk, ti = dir ? 63 - p : p; LA[ti * 33] = cv[kk] + pre; } }
    __syncthreads();
    if (FULL) {
        unsigned wqf[4], wkf[4], wqb[4], wkb[4];
#pragma unroll
        for (int e = 0; e < 4; ++e) { const int d = d8 + 2 * e; const float f0 = LAF[i * 33 + d], f1 = LAF[i * 33 + d + 1], b0 = LAB[i * 33 + d], b1 = LAB[i * 33 + d + 1];
            wqf[e] = pk2(q[2 * e] * __expf(f0), q[2 * e + 1] * __expf(f1)); wkf[e] = pk2(k[2 * e] * __expf(-f0), k[2 * e + 1] * __expf(-f1));
            wqb[e] = pk2(q[2 * e] * __expf(b0), q[2 * e + 1] * __expf(b1)); wkb[e] = pk2(k[2 * e] * __expf(-b0), k[2 * e + 1] * __expf(-b1)); }
        *(LAS u32x4*)((LAS bf16_t*)(L + G2_QTF) + i * 40 + d8) = (u32x4){wqf[0], wqf[1], wqf[2], wqf[3]}; *(LAS u32x4*)((LAS bf16_t*)(L + G2_KTF) + i * 40 + d8) = (u32x4){wkf[0], wkf[1], wkf[2], wkf[3]};
        *(LAS u32x4*)((LAS bf16_t*)(L + G2_QTB) + i * 40 + d8) = (u32x4){wqb[0], wqb[1], wqb[2], wqb[3]}; *(LAS u32x4*)((LAS bf16_t*)(L + G2_KTB) + i * 40 + d8) = (u32x4){wkb[0], wkb[1], wkb[2], wkb[3]};
    } else {
        LAS bf16_t* KDF = (LAS bf16_t*)(L + G2_QTF); LAS bf16_t* KDB = (LAS bf16_t*)(L + G2_KTF);
#pragma unroll
        for (int e = 0; e < 8; ++e) { const int d = d8 + e; const float bf = LAF[i * 33 + d], bb = LAB[i * 33 + d], bfl = LAF[63 * 33 + d], bbl = LAB[0 * 33 + d];
            KDF[d * 72 + i] = (bf16_t)f2bf(k[e] * __expf(bfl - bf)); KDB[d * 72 + i] = (bf16_t)f2bf(k[e] * __expf(bbl - bb)); }
    }
    __syncthreads();
}
__device__ __forceinline__ void ph_gla_local(Frame& F, int l) {
    const int hw = F.wave >> 2, wl = F.wave & 3, tl = F.tid & 255; LAS unsigned char* L = F.lds + hw * G2_HALF;
    constexpr int NU = NB * 68 * 4;
    int pp = F.wg;
    GlaRaw raw = gla_load<false>(F, (pp * 2 + hw) < NU ? pp * 2 + hw : 0, tl);
    for (; pp * 2 < NU; pp += F.G) {
        const int u = pp * 2 + hw, un = (pp + F.G) * 2 + hw;
        const GlaRaw nraw = gla_load<false>(F, un < NU ? un : u, tl);
        __syncthreads();
        gla_prep<false>(F, L, l, u, tl, raw);
        const int g = F.lane >> 4, c = F.lane & 15;
        float* DS = (float*)(F.ws + WS_GDS) + (size_t)u * 2 * 2048;
#pragma unroll
        for (int kk = 0; kk < 4; ++kk) { const int tix = wl * 4 + kk, dir = tix >> 3, mt = (tix >> 1) & 3, nt = tix & 1;
            f32x4 a = (f32x4){0.f, 0.f, 0.f, 0.f};
            a = mma_lds((const LAS bf16_t*)(L + G2_VT) + mt * 16 * 72, 72, (const LAS bf16_t*)(L + (dir ? G2_KTF : G2_QTF)) + nt * 16 * 72, 72, 2, a, F.lane);
#pragma unroll
            for (int e = 0; e < 4; ++e) DS[dir * 2048 + (mt * 16 + 4 * g + e) * 32 + nt * 16 + c] = a[e]; }
        if (tl < 64) { const int d = tl & 31, dir = tl >> 5; ((float*)(F.ws + WS_GD))[(size_t)u * 64 + tl] = __expf(dir ? ((LAS float*)(L + G2_LAB))[0 * 33 + d] : ((LAS float*)(L + G2_LAF))[63 * 33 + d]); }
        raw = nraw;
    }
}
__device__ __forceinline__ void ph_gla_scan(Frame& F) {
    const int gt = F.wg * NTHR + F.tid, NGT = F.G * NTHR;
    const float* DS = (const float*)(F.ws + WS_GDS); const float* GD = (const float*)(F.ws + WS_GD); bf16_t* SIN = (bf16_t*)(F.ws + WS_GSIN);
    for (int w = gt; w < 128 * 1024; w += NGT) {
        const int chain = w >> 10, el = (w & 1023) * 2, dir = chain & 1, h = (chain >> 1) & 3, b = chain >> 3, d = el & 31;
        float s0 = 0.f, s1 = 0.f;
        for (int step = 0; step < 68; step += 4) {
            f32x2 ds[4], dd[4]; size_t uu[4];
#pragma unroll
            for (int q = 0; q < 4; ++q) { const int st_ = step + q; const int cn = dir ? (st_ < 4 ? 3 - st_ : 71 - st_) : st_;
                uu[q] = (size_t)(b * 68 + cn) * 4 + h;
                ds[q] = *(const GAS f32x2*)(DS + (uu[q] * 2 + dir) * 2048 + el); dd[q] = *(const GAS f32x2*)(GD + uu[q] * 64 + dir * 32 + d); }
#pragma unroll
            for (int q = 0; q < 4; ++q) { *(GAS unsigned*)(SIN + (uu[q] * 2 + dir) * 2048 + el) = pk2(s0, s1); s0 = dd[q].x * s0 + ds[q].x; s1 = dd[q].y * s1 + ds[q].y; }
        }
    }
}
__device__ __forceinline__ void ph_gla_out(Frame& F, int l, bool last) {
    const int hw = F.wave >> 2, wl = F.wave & 3, tl = F.tid & 255; LAS unsigned char* L = F.lds + hw * G2_HALF;
    const int NV = last ? NB * 64 * 4 : NB * 68 * 4;
#define GLA_UNIT(v) (last ? ((((v) >> 8) * 68 + 4 + (((v) & 255) >> 2)) * 4 + ((v) & 3)) : (v))
    int pp = F.wg;
    GlaRaw raw = gla_load<true>(F, GLA_UNIT((pp * 2 + hw) < NV ? pp * 2 + hw : 0), tl);
    for (; pp * 2 < NV; pp += F.G) {
        const int u = GLA_UNIT(pp * 2 + hw), vn = (pp + F.G) * 2 + hw;
        const GlaRaw nraw = gla_load<true>(F, vn < NV ? GLA_UNIT(vn) : u, tl);
        const int h = u & 3, cn = (u >> 2) % 68, b = (u >> 2) / 68;
        __syncthreads();
        gla_prep<true>(F, L, l, u, tl, raw);
        { const int dir = tl >> 7, dv = (tl >> 1) & 63, d16 = (tl & 1) * 16; LAS bf16_t* S = (LAS bf16_t*)(L + (dir ? G2_SB : G2_SF)) + dv * 40 + d16; *(LAS u32x4*)S = raw.s0; *(LAS u32x4*)(S + 8) = raw.s1; }
        const int g = F.lane >> 4, c = F.lane & 15;
        LAS bf16_t* ATT = (LAS bf16_t*)(L + G2_ATT);
#pragma unroll
        for (int kk = 0; kk < 4; ++kk) { const int tile = wl * 4 + kk, mt = tile >> 2, nt = tile & 3;
            f32x4 af = (f32x4){0.f, 0.f, 0.f, 0.f}, ab = af;
            af = mma_lds((const LAS bf16_t*)(L + G2_QTF) + mt * 16 * 40, 40, (const LAS bf16_t*)(L + G2_KTF) + nt * 16 * 40, 40, 1, af, F.lane);
            ab = mma_lds((const LAS bf16_t*)(L + G2_QTB) + mt * 16 * 40, 40, (const LAS bf16_t*)(L + G2_KTB) + nt * 16 * 40, 40, 1, ab, F.lane);
#pragma unroll
            for (int e = 0; e < 4; ++e) { const int ii = mt * 16 + 4 * g + e, j = nt * 16 + c; const float vv = (j <= ii ? af[e] : 0.f) + (j >= ii ? ab[e] : 0.f); ATT[ii * 72 + j] = (bf16_t)f2bf(vv); } }
        __syncthreads();
        LAS float* O = (LAS float*)(L + G2_LAF);
#pragma unroll
        for (int kk = 0; kk < 4; ++kk) { const int tile = wl * 4 + kk, mt = tile >> 2, nt = tile & 3;
            f32x4 a = (f32x4){0.f, 0.f, 0.f, 0.f};
            a = mma_lds(ATT + mt * 16 * 72, 72, (const LAS bf16_t*)(L + G2_VT) + nt * 16 * 72, 72, 2, a, F.lane);
            a = mma_lds((const LAS bf16_t*)(L + G2_QTF) + mt * 16 * 40, 40, (const LAS bf16_t*)(L + G2_SF) + nt * 16 * 40, 40, 1, a, F.lane);
            a = mma_lds((const LAS bf16_t*)(L + G2_QTB) + mt * 16 * 40, 40, (const LAS bf16_t*)(L + G2_SB) + nt * 16 * 40, 40, 1, a, F.lane);
#pragma unroll
            for (int e = 0; e < 4; ++e) O[(mt * 16 + 4 * g + e) * 65 + nt * 16 + c] = a[e]; }
        __syncthreads();
        { const int i = tl >> 2, dv16 = (tl & 3) * 16; const int row = gla_row0(b, cn) + i;
          float v[16], gt[16]; float ss = 0.f;
#pragma unroll
          for (int e = 0; e < 16; ++e) { v[e] = O[i * 65 + dv16 + e]; ss += v[e] * v[e]; }
          ss += shx(ss, 1, F.lane); ss += shx(ss, 2, F.lane);
          const float rs = 1.0f / sqrtf(ss * (1.0f / 64.0f) + LN_EPS);
          unpack8(raw.g0, gt); unpack8(raw.g1, gt + 8);
          const float* gn = F.in[I_GNORM] + l * 64 + dv16;
          unsigned w[8];
#pragma unroll
          for (int e = 0; e < 8; ++e) w[e] = pk2(v[2 * e] * rs * gn[2 * e] * silu_f(gt[2 * e]), v[2 * e + 1] * rs * gn[2 * e + 1] * silu_f(gt[2 * e + 1]));
          bf16_t* mp = (bf16_t*)(F.ws + WS_MIX) + (size_t)row * DM + 512 + h * 64 + dv16;
          *(GAS u32x4*)mp = (u32x4){w[0], w[1], w[2], w[3]}; *(GAS u32x4*)(mp + 8) = (u32x4){w[4], w[5], w[6], w[7]}; }
        raw = nraw;
    }
#undef GLA_UNIT
}

template <int L>
__device__ __forceinline__ void hyena_conv(Frame& F, const bf16_t* Rg, const bf16_t* Uin, const bf16_t* Xmul, int pos0, bool final_out, int ch, bf16_t* Zout) {
    constexpr int CS = 2 * L + 16;
    constexpr int NTL = L / 16, J = (NTL >= 64) ? 16 : 2, NGRP = NTL / J, HJ = J / 2, NSTEP = L / 32;
    LAS bf16_t* Rl = (LAS bf16_t*)F.lds;
    __syncthreads();
    for (int c = F.tid; c < 2 * L / 8; c += NTHR) { const u32x4 v = *(const GAS u32x4*)(Rg + 8 * c); const unsigned a[4] = {v.x, v.y, v.z, v.w};
#pragma unroll
        for (int rho = 0; rho < 8; ++rho) { LAS bf16_t* d = Rl + rho * CS + 8 * c + rho;
#pragma unroll
            for (int k = 0; k < 4; ++k) { d[2 * k] = (bf16_t)(a[k] & 0xffffu); d[2 * k + 1] = (bf16_t)(a[k] >> 16); } } }
    __syncthreads();
    int ln_ = F.lane; asm volatile("" : "+v"(ln_));
    const int i = ln_ & 15, g = ln_ >> 4, rho = i & 7;
    const LAS bf16_t* Rc = Rl + rho * CS + rho;
    for (int grp = F.wave; grp < NGRP; grp += NWAVES) {
        f32x4 acc[J]; bf16x8 fr[J];
        const int tb = grp * J * 16;
        const LAS bf16_t* Rb = Rc + (L - tb - i + 8 * g);
#pragma unroll
        for (int j = 0; j < J; ++j) { acc[j] = (f32x4){0.f, 0.f, 0.f, 0.f}; fr[j] = *(const LAS bf16x8*)(Rb - 16 * j); }
        const char* ub = (const char*)(Uin + pos0); const unsigned ulo = (unsigned)((i * SPB + 8 * g) * 2);
        constexpr int PF = (HJ >= 4) ? 4 : 1;
        bf16x8 bq[PF];
#pragma unroll
        for (int p = 0; p < PF; ++p) bq[p] = *(const GAS bf16x8*)(ub + (size_t)(ulo + (unsigned)p * 64u));
#pragma unroll 1
        for (int q = 0; q < NSTEP / HJ; ++q) {
#pragma unroll
            for (int m = 0; m < HJ; ++m) {
                const int n = q * HJ + m;
                const int nn = (n + PF < NSTEP) ? n + PF : 0;
                if (n > 0) { fr[(J - 2 * m) % J] = *(const LAS bf16x8*)(Rb + 32 * n); fr[(J + 1 - 2 * m) % J] = *(const LAS bf16x8*)(Rb + 32 * n - 16); }
                const bf16x8 bcur = bq[m % PF];
#pragma unroll
                for (int jj = 0; jj < J; ++jj) { const int j = (jj + 2) % J; acc[j] = mfma16(fr[(j + J - 2 * m) % J], bcur, acc[j]); }
                bq[m % PF] = *(const GAS bf16x8*)(ub + (size_t)(ulo + (unsigned)nn * 64u));
            }
        }
#pragma unroll
        for (int j = 0; j < J; ++j) { const int t0 = tb + j * 16 + 4 * g;
            const u32x2 xw = *(const GAS u32x2*)(Xmul + (size_t)i * SPB + pos0 + t0);
            const float y0 = acc[j][0] * bflo(xw.x), y1 = acc[j][1] * bfhi(xw.x), y2 = acc[j][2] * bflo(xw.y), y3 = acc[j][3] * bfhi(xw.y);
            if (!final_out) { u32x2 w; w.x = pk2(y0, y1); w.y = pk2(y2, y3); *(GAS u32x2*)(Zout + (size_t)i * SPB + pos0 + t0) = w; }
            else { u32x2 w; w.x = pk2(y0, y1); w.y = pk2(y2, y3); *(GAS u32x2*)((bf16_t*)(F.ws + WS_Y) + ((size_t)ch * NB + i) * SPB + pos0 + t0) = w; } }
    }
}
__device__ __forceinline__ void ph_hyena(Frame& F, int l, bool last) {
    const bf16_t* HV = (const bf16_t*)(F.ws + WS_HV); bf16_t* Z2 = (bf16_t*)(F.ws + WS_Z2);
    for (int ch = F.wg; ch < 256; ch += F.G) {
        const bf16_t* v = HV + (size_t)(0 * 256 + ch) * NB * SPB; const bf16_t* x1 = HV + (size_t)(256 + ch) * NB * SPB; const bf16_t* x2 = HV + (size_t)(512 + ch) * NB * SPB;
        bf16_t* z = Z2 + (size_t)ch * NB * SPB;
        const bf16_t* R0 = (const bf16_t*)(F.ws + WS_HYF) + ((size_t)(l * 2 + 0) * 256 + ch) * 8192; const bf16_t* R1 = (const bf16_t*)(F.ws + WS_HYF) + ((size_t)(l * 2 + 1) * 256 + ch) * 8192;
        hyena_conv<4096>(F, R0, v, x1, 0, false, ch, z);
        VM_WAIT(); __syncthreads(); __builtin_amdgcn_fence(__ATOMIC_ACQUIRE, "agent"); VM_WAIT();
        hyena_conv<4096>(F, R1, z, x2, 0, true, ch, z);
        if (!last) {
            const bf16_t* C0 = (const bf16_t*)(F.ws + WS_HYFC) + ((size_t)(l * 2 + 0) * 256 + ch) * 512; const bf16_t* C1 = (const bf16_t*)(F.ws + WS_HYFC) + ((size_t)(l * 2 + 1) * 256 + ch) * 512;
            hyena_conv<256>(F, C0, v, x1, SEQ, false, ch, z);
            VM_WAIT(); __syncthreads(); __builtin_amdgcn_fence(__ATOMIC_ACQUIRE, "agent"); VM_WAIT();
            hyena_conv<256>(F, C1, z, x2, SEQ, true, ch, z);
        }
    }
}

__device__ __forceinline__ void ph_ln1(Frame& F, int l, int ntok) {
    const int gw = F.wg * NWAVES + F.wave, NGW = F.G * NWAVES;
    const float* lg = F.in[I_LN1G] + l * DM + 16 * F.lane; const float* lb = F.in[I_LN1B] + l * DM + 16 * F.lane;
    for (int row = gw; row < ntok; row += NGW) {
        bf16_t* xr = (bf16_t*)(F.ws + WS_XR) + (size_t)row * DM + 16 * F.lane;
        const bf16_t* yr = (const bf16_t*)(F.ws + WS_Y) + (size_t)row * DM + 16 * F.lane;
        const float* md = mod_ptr(F, l, row) + 16 * F.lane;
        bf16_t* xm = (bf16_t*)(F.ws + WS_XM) + (size_t)row * DM + 16 * F.lane;
        const u32x4 xa = *(const GAS u32x4*)xr, xb = *(const GAS u32x4*)(xr + 8), ya = *(const GAS u32x4*)yr, yb = *(const GAS u32x4*)(yr + 8);
        float x[16], y[16], v[16]; unpack8(xa, x); unpack8(xb, x + 8); unpack8(ya, y); unpack8(yb, y + 8);
        float s = 0.f;
#pragma unroll
        for (int j = 0; j < 4; ++j) { const f32x4 g1 = *(const GAS f32x4*)(md + 2048 + 4 * j);
#pragma unroll
            for (int e = 0; e < 4; ++e) { v[4 * j + e] = x[4 * j + e] * DN_ALPHA + g1[e] * y[4 * j + e]; s += v[4 * j + e]; } }
        const float mean = wave_sum(s, F.lane) * (1.f / DM); float s2 = 0.f;
#pragma unroll
        for (int e = 0; e < 16; ++e) { v[e] -= mean; s2 += v[e] * v[e]; }
        const float rstd = 1.f / sqrtf(wave_sum(s2, F.lane) * (1.f / DM) + LN_EPS);
        unsigned wx[8], wm[8]; int w8[4];
#pragma unroll
        for (int j = 0; j < 4; ++j) { const f32x4 g = *(const GAS f32x4*)(lg + 4 * j), bb = *(const GAS f32x4*)(lb + 4 * j), sh = *(const GAS f32x4*)(md + 3072 + 4 * j), sc = *(const GAS f32x4*)(md + 4096 + 4 * j);
            float xn[4];
#pragma unroll
            for (int e = 0; e < 4; ++e) xn[e] = v[4 * j + e] * rstd * g[e] + bb[e];
            wx[2 * j] = pk2(xn[0], xn[1]); wx[2 * j + 1] = pk2(xn[2], xn[3]);
            const float h0 = xn[0] * (1.f + sc[0]) + sh[0], h1 = xn[1] * (1.f + sc[1]) + sh[1], h2 = xn[2] * (1.f + sc[2]) + sh[2], h3 = xn[3] * (1.f + sc[3]) + sh[3];
            wm[2 * j] = pk2(h0, h1); wm[2 * j + 1] = pk2(h2, h3);
            int v = 0; v = __builtin_amdgcn_cvt_pk_fp8_f32(h0, h1, v, false); v = __builtin_amdgcn_cvt_pk_fp8_f32(h2, h3, v, true); w8[j] = v; }
        *(GAS u32x4*)((unsigned char*)(F.ws + WS_XM8) + (size_t)row * DM + 16 * F.lane) = (u32x4){(unsigned)w8[0], (unsigned)w8[1], (unsigned)w8[2], (unsigned)w8[3]};
        *(GAS u32x4*)xr = (u32x4){wx[0], wx[1], wx[2], wx[3]}; *(GAS u32x4*)(xr + 8) = (u32x4){wx[4], wx[5], wx[6], wx[7]};
        *(GAS u32x4*)xm = (u32x4){wm[0], wm[1], wm[2], wm[3]}; *(GAS u32x4*)(xm + 8) = (u32x4){wm[4], wm[5], wm[6], wm[7]};
    }
}
__device__ __forceinline__ void ph_ln2(Frame& F, int l, int ntok, bool last) {
    const int gw = F.wg * NWAVES + F.wave, NGW = F.G * NWAVES;
    const int cA = 256 * (F.lane >> 4) + 32 * ((F.lane >> 2) & 3) + 8 * (F.lane & 3);
#define LN2_COL(j) (cA + ((j) < 2 ? 4 * (j) : 128 + 4 * ((j) - 2)))
    const float* lg = F.in[I_LN2G] + l * DM; const float* lb = F.in[I_LN2B] + l * DM;
    for (int row = gw; row < ntok; row += NGW) {
        bf16_t* xr = (bf16_t*)(F.ws + WS_XR) + (size_t)row * DM;
        const unsigned char* y2 = (const unsigned char*)(F.ws + WS_Y2) + (size_t)row * 9 * DM + 16 * F.lane;
        const float* wg = (const float*)(F.ws + WS_WGT) + (size_t)row * 8;
        const float* md = mod_ptr(F, l, row);
        float ff[16];
#pragma unroll
        for (int e = 0; e < 16; ++e) ff[e] = 0.f;
        u32x4 q[9];
#pragma unroll
        for (int k = 0; k < 9; ++k) q[k] = *(const GAS u32x4*)(y2 + (size_t)k * DM);
#pragma unroll
        for (int k = 0; k < 9; ++k) { const float wk = (k < 8 ? wg[k] : 1.0f) * pg8::Y2_INV; const unsigned a[4] = {q[k].x, q[k].y, q[k].z, q[k].w};
#pragma unroll
            for (int e = 0; e < 4; ++e) { const f32x2 lo = __builtin_amdgcn_cvt_pk_f32_fp8((int)a[e], false), hi = __builtin_amdgcn_cvt_pk_f32_fp8((int)a[e], true);
                ff[4 * e] += wk * lo.x; ff[4 * e + 1] += wk * lo.y; ff[4 * e + 2] += wk * hi.x; ff[4 * e + 3] += wk * hi.y; } }
        float v[16], xo[16]; float s = 0.f;
        { const u32x4 xa = *(const GAS u32x4*)(xr + cA), xb = *(const GAS u32x4*)(xr + cA + 128); unpack8(xa, xo); unpack8(xb, xo + 8); }
#pragma unroll
        for (int j = 0; j < 4; ++j) { const f32x4 g2 = *(const GAS f32x4*)(md + 5120 + LN2_COL(j));
#pragma unroll
            for (int e = 0; e < 4; ++e) { v[4 * j + e] = xo[4 * j + e] * DN_ALPHA + g2[e] * ff[4 * j + e]; s += v[4 * j + e]; } }
        const float mean = wave_sum(s, F.lane) * (1.f / DM); float s2 = 0.f;
#pragma unroll
        for (int e = 0; e < 16; ++e) { v[e] -= mean; s2 += v[e] * v[e]; }
        const float rstd = 1.f / sqrtf(wave_sum(s2, F.lane) * (1.f / DM) + LN_EPS);
        const float* mdn = last ? md : mod_ptr(F, l + 1, row);
        float xn[16];
#pragma unroll
        for (int j = 0; j < 4; ++j) { const f32x4 g = *(const GAS f32x4*)(lg + LN2_COL(j)), bb = *(const GAS f32x4*)(lb + LN2_COL(j));
#pragma unroll
            for (int e = 0; e < 4; ++e) xn[4 * j + e] = v[4 * j + e] * rstd * g[e] + bb[e]; }
        if (last) { float* op = F.out + (size_t)row * DM;
#pragma unroll
            for (int j = 0; j < 4; ++j) *(GAS f32x4*)(op + LN2_COL(j)) = (f32x4){xn[4 * j], xn[4 * j + 1], xn[4 * j + 2], xn[4 * j + 3]}; }
        else {
            *(GAS u32x4*)(xr + cA) = (u32x4){pk2(xn[0], xn[1]), pk2(xn[2], xn[3]), pk2(xn[4], xn[5]), pk2(xn[6], xn[7])}; *(GAS u32x4*)(xr + cA + 128) = (u32x4){pk2(xn[8], xn[9]), pk2(xn[10], xn[11]), pk2(xn[12], xn[13]), pk2(xn[14], xn[15])};
            bf16_t* xm = (bf16_t*)(F.ws + WS_XM) + (size_t)row * DM;
            unsigned w[8];
#pragma unroll
            for (int j = 0; j < 4; ++j) { const f32x4 sh = *(const GAS f32x4*)(mdn + LN2_COL(j)), sc = *(const GAS f32x4*)(mdn + 1024 + LN2_COL(j));
                w[2 * j] = pk2(xn[4 * j] * (1.f + sc[0]) + sh[0], xn[4 * j + 1] * (1.f + sc[1]) + sh[1]); w[2 * j + 1] = pk2(xn[4 * j + 2] * (1.f + sc[2]) + sh[2], xn[4 * j + 3] * (1.f + sc[3]) + sh[3]); }
            *(GAS u32x4*)(xm + cA) = (u32x4){w[0], w[1], w[2], w[3]}; *(GAS u32x4*)(xm + cA + 128) = (u32x4){w[4], w[5], w[6], w[7]};
        }
    }
#undef LN2_COL
}

__device__ __forceinline__ unsigned f_ord(float f) { const unsigned u = __builtin_bit_cast(unsigned, f); return (u & 0x80000000u) ? ~u : (u | 0x80000000u); }
__device__ __forceinline__ unsigned long long wave_max_u64(unsigned long long v, int lane) {
#pragma unroll
    for (int o = 1; o < 64; o <<= 1) { const unsigned lo = (unsigned)shxi((int)(unsigned)v, o, lane), hi = (unsigned)shxi((int)(unsigned)(v >> 32), o, lane); const unsigned long long w = ((unsigned long long)hi << 32) | lo; v = w > v ? w : v; }
    return v;
}
__device__ __forceinline__ float seg16_max(float v, int lane) { v = fmaxf(v, shx(v, 1, lane)); v = fmaxf(v, shx(v, 2, lane)); v = fmaxf(v, shx(v, 4, lane)); v = fmaxf(v, shx(v, 8, lane)); return v; }
__device__ __forceinline__ int seg16_min_i(int v, int lane) { int w; w = shxi(v, 1, lane); v = w < v ? w : v; w = shxi(v, 2, lane); v = w < v ? w : v; w = shxi(v, 4, lane); v = w < v ? w : v; w = shxi(v, 8, lane); v = w < v ? w : v; return v; }
__device__ __forceinline__ float seg16_top2(float v, int lane) {
    const float m1 = seg16_max(v, lane);
    const int first = seg16_min_i(v == m1 ? (lane & 15) : 99, lane);
    const float m2 = seg16_max((lane & 15) == first ? -3.0e38f : v, lane);
    return m1 + m2;
}
__device__ __forceinline__ void ph_route(Frame& F, int l, int ntok) {
    LAS int* hist = (LAS int*)F.lds;
    LAS int* base = hist + 128;
    LAS unsigned* alist = (LAS unsigned*)(F.lds + 1024);
    const int tpw = (ntok + F.G - 1) / F.G, t0 = F.wg * tpw, t1 = (t0 + tpw) < ntok ? (t0 + tpw) : ntok;
    __syncthreads();
    if (F.tid < 128) hist[F.tid] = 0;
    __syncthreads();
    const float* LG = (const float*)(F.ws + WS_LOGIT); const float* rb = F.in[I_RB] + l * NEXP;
    const float b0 = rb[F.lane], b1 = rb[F.lane + 64];
    constexpr int RT = 4;
    for (int tb = t0 + F.wave * RT; tb < t1; tb += NWAVES * RT) {
        float s0[RT], s1[RT], e0[RT], e1[RT], gs0[RT], gs1[RT]; unsigned long long k0[RT], k1[RT]; int mye[RT]; float myw[RT], wsum[RT];
#pragma unroll
        for (int j = 0; j < RT; ++j) { const int tok = (tb + j) < t1 ? tb + j : t1 - 1;
            const float x0 = LG[(size_t)tok * 256 + F.lane], x1 = LG[(size_t)tok * 256 + 64 + F.lane];
            s0[j] = __builtin_amdgcn_rcpf(1.0f + __expf(-x0)); s1[j] = __builtin_amdgcn_rcpf(1.0f + __expf(-x1)); e0[j] = s0[j] + b0; e1[j] = s1[j] + b1; }
#pragma unroll
        for (int j = 0; j < RT; ++j) { gs0[j] = seg16_top2(e0[j], F.lane); gs1[j] = seg16_top2(e1[j], F.lane); }
#pragma unroll
        for (int j = 0; j < RT; ++j) {
            float gsc[8];
#pragma unroll
            for (int g = 0; g < 4; ++g) { gsc[g] = shf(gs0[j], g * 16); gsc[4 + g] = shf(gs1[j], g * 16); }
            unsigned gmask = 0u;
#pragma unroll
            for (int g = 0; g < 8; ++g) { int cnt = 0;
#pragma unroll
                for (int g2 = 0; g2 < 8; ++g2) cnt += (gsc[g2] > gsc[g] || (gsc[g2] == gsc[g] && g2 < g)) ? 1 : 0;
                gmask |= (cnt < 4) ? (1u << g) : 0u; }
            const bool ok0 = (gmask >> (F.lane >> 4)) & 1u, ok1 = (gmask >> (4 + (F.lane >> 4))) & 1u;
            k0[j] = ok0 ? (((unsigned long long)f_ord(e0[j]) << 32) | (unsigned)(255 - F.lane)) : 0ull;
            k1[j] = ok1 ? (((unsigned long long)f_ord(e1[j]) << 32) | (unsigned)(255 - 64 - F.lane)) : 0ull;
            mye[j] = 0; myw[j] = 0.f; wsum[j] = 0.f; }
#pragma unroll
        for (int k = 0; k < 8; ++k) {
            unsigned long long best[RT];
#pragma unroll
            for (int j = 0; j < RT; ++j) best[j] = k0[j] > k1[j] ? k0[j] : k1[j];
#pragma unroll
            for (int o = 1; o < 64; o <<= 1) {
#pragma unroll
                for (int j = 0; j < RT; ++j) { const unsigned lo = (unsigned)shxi((int)(unsigned)best[j], o, F.lane), hi = (unsigned)shxi((int)(unsigned)(best[j] >> 32), o, F.lane);
                    const unsigned long long w = ((unsigned long long)hi << 32) | lo; best[j] = w > best[j] ? w : best[j]; } }
#pragma unroll
            for (int j = 0; j < RT; ++j) { const int e = 255 - (int)(best[j] & 0xffu);
                if (k0[j] == best[j]) k0[j] = 0ull; if (k1[j] == best[j]) k1[j] = 0ull;
                const float sv = shf(e < 64 ? s0[j] : s1[j], e & 63);
                wsum[j] += sv; if (F.lane == k) { mye[j] = e; myw[j] = sv; } }
        }
#pragma unroll
        for (int j = 0; j < RT; ++j) { const int tok = tb + j;
            if (tok < t1 && F.lane < 8) {
                const int lr = __hip_atomic_fetch_add(&hist[mye[j]], 1, __ATOMIC_RELAXED, __HIP_MEMORY_SCOPE_WORKGROUP);
                alist[(tok - t0) * 8 + F.lane] = (unsigned)mye[j] | ((unsigned)lr << 8);
                ((int*)(F.ws + WS_EIDX))[(size_t)tok * 8 + F.lane] = mye[j];
                ((float*)(F.ws + WS_WGT))[(size_t)tok * 8 + F.lane] = myw[j] / wsum[j] * 2.5f;
            } }
    }
    __syncthreads();
    if (F.tid < 128) { const int hcount = hist[F.tid]; base[F.tid] = hcount ? (int)atomicAdd(F.ctl + CW_CNT + l * 256 + F.tid, (unsigned)hcount) : 0; }
    __syncthreads();
    for (int a = F.tid; a < (t1 - t0) * 8; a += NTHR) { const unsigned v = alist[a]; ((int*)(F.ws + WS_RNK))[(size_t)t0 * 8 + a] = base[v & 0xffu] + (int)(v >> 8); }
}
__device__ __forceinline__ void ph_positions(Frame& F, int l, int ntok) {
    LAS int* cnt = (LAS int*)F.lds;
    LAS int* off = cnt + 132;
    __syncthreads();
    if (F.tid < NE1) cnt[F.tid] = F.tid < NEXP ? (int)__hip_atomic_load(F.ctl + CW_CNT + l * 256 + F.tid, __ATOMIC_RELAXED, __HIP_MEMORY_SCOPE_AGENT) : ntok;
    __syncthreads();
    if (F.tid == 0) { int o = 0; for (int e = 0; e < NE1; ++e) { off[e] = o; o += (cnt[e] + 255) & ~255; } off[NE1] = o; }
    __syncthreads();
    const int gt = F.wg * NTHR + F.tid, NGT = F.G * NTHR;
    int* rowtok = (int*)(F.ws + WS_ROWTOK); int* rowdst = (int*)(F.ws + WS_ROWDST); int* tile_exp = (int*)(F.ws + WS_TILEEXP);
    const int* eidx = (const int*)(F.ws + WS_EIDX); const int* rnk = (const int*)(F.ws + WS_RNK);
    for (int a = gt; a < ntok * 8; a += NGT) { const int tok = a >> 3, k = a & 7; const int pos = off[eidx[a]] + rnk[a]; rowtok[pos] = tok; rowdst[pos] = tok * 9 + k; }
    for (int tok = gt; tok < ntok; tok += NGT) { const int pos = off[NEXP] + tok; rowtok[pos] = tok; rowdst[pos] = tok * 9 + 8; }
    for (int i = gt; i < NE1 * 256; i += NGT) { const int e = i >> 8, p = i & 255; const int row = off[e] + cnt[e] + p; if (row < off[e + 1]) { rowtok[row] = 0; rowdst[row] = -1; } }
    for (int i = gt; i < NE1 * 320; i += NGT) { const int e = i / 320, p = i % 320; const int t = (off[e] >> 8) + p; if (t < (off[e + 1] >> 8)) tile_exp[t] = e; }
    if (gt == 0) F.ctl[CW_NTL + l] = (unsigned)(off[NE1] >> 8);
}

#ifndef MK_MULTI
#define MK_MULTI 0
#endif
constexpr int PH_PER_LAYER = 12, NPHASE = 2 + DEPTH * PH_PER_LAYER;
struct Args { const float* in[36]; float* out; unsigned char* ws; int ph_lo, ph_hi; };

__global__ void __launch_bounds__(NTHR, 2) mk_fwd(Args args) {
    extern __shared__ __attribute__((aligned(16))) unsigned char lds_raw[];
    Frame F;
    F.lds = (LAS unsigned char*)lds_raw;
    F.tid = threadIdx.x; F.lane = F.tid & 63; F.wave = __builtin_amdgcn_readfirstlane(F.tid >> 6);
    const int wave0 = F.wave;
    F.G = gridDim.x; F.wg = blockIdx.x;
    F.in = args.in;
    F.out = args.out; F.ws = args.ws; F.ctl = (unsigned*)(args.ws + WS_CTL);
    volatile LAS unsigned* MISC = (volatile LAS unsigned*)(F.lds + MISC_OFF);
    if (F.tid < 32) MISC[F.tid] = 0u;
    __syncthreads();
    const int lo = args.ph_lo, hi = args.ph_hi;
    const bool single = (hi - lo) > 1;
    XcdBarrier bar; bar.bar = F.ctl + CW_BAR; bar.x = 0; bar.st = nullptr;
    if (single) bar = xcd_barrier_post(F.ctl + CW_BAR, MISC + 8);
#define IN(k) (lo <= (k) && (k) < hi)
#ifndef PROBE_MASK
#define PROBE_MASK 0
#endif
#define REP(k) for (int _rep = 0; _rep < (((PROBE_MASK >> (k)) & 1) ? 2 : 1); ++_rep)
#define SEAM(k) do { if (IN(k) && IN((k) + 1)) { xcd_barrier(bar); if ((PROBE_MASK >> 15) & 1) xcd_barrier(bar); } } while (0)
#define FRESH() do { int _ln; asm volatile("v_mbcnt_lo_u32_b32 %0, -1, 0\n\tv_mbcnt_hi_u32_b32 %0, -1, %0" : "=v"(_ln)); int _wv = wave0; asm volatile("" : "+s"(_wv)); F.lane = _ln; F.wave = _wv; F.tid = (_wv << 6) | _ln; \
        unsigned char* _w = args.ws; asm volatile("" : "+s"(_w)); F.ws = _w; F.ctl = (unsigned*)(_w + WS_CTL); float* _o = args.out; asm volatile("" : "+s"(_o)); F.out = _o; } while (0)

    if (IN(0)) { FRESH(); REP(13) { p0_static_weights(F); __syncthreads(); } REP(14) { p0_mod(F); __syncthreads(); } FRESH(); REP(16) { p0_hyena_filters(F); __syncthreads(); } }
    SEAM(0);
    if (IN(1)) { FRESH(); p0_init_rows(F); }
    SEAM(1);
#pragma unroll 1
    for (int l = 0; l < DEPTH; ++l) {
        const int pb = 2 + l * PH_PER_LAYER; const bool last = (l == DEPTH - 1); const int ntok = last ? NLAT : NROW;
        if (IN(pb + 0)) { FRESH();
            REP(0) { p_expert_weights(F, l); __syncthreads(); }
            pg8::DenseOrder S; S.init(NROW, DIN, F.G, F.wg); pg8::EpiBf16 E{(bf16_t*)(F.ws + WS_U), DIN};
            REP(1) pg8::gemm_phase<pg8::EpiBf16, pg8::DenseOrder, false>(F.tid, F.lds, (const bf16_t*)(F.ws + WS_XM), (const bf16_t*)(F.ws + WS_WIN) + (size_t)l * DIN * DM, DM, nullptr, S, E);
        }
        SEAM(pb + 0);
        if (IN(pb + 1)) { FRESH(); REP(2) { ph_transposes(F, l); __syncthreads(); } FRESH(); REP(3) { ph_gla_local(F, l); __syncthreads(); } }
        SEAM(pb + 1);
        if (IN(pb + 2)) { FRESH(); REP(4) { ph_na(F, l, last); } FRESH(); REP(5) { ph_gla_scan(F); } __syncthreads(); FRESH(); REP(6) { ph_hyena(F, l, last); } }
        SEAM(pb + 2);
        if (IN(pb + 3)) { FRESH(); ph_hy_transpose(F, last); __syncthreads(); FRESH(); REP(7) { ph_gla_out(F, l, last); } }
        SEAM(pb + 3);
        if (IN(pb + 4)) { FRESH();
            pg8::DenseOrder S; S.init(ntok, DM, F.G, F.wg); pg8::EpiBf16 E{(bf16_t*)(F.ws + WS_Y), DM};
            REP(8) pg8::gemm_phase<pg8::EpiBf16, pg8::DenseOrder, false>(F.tid, F.lds, (const bf16_t*)(F.ws + WS_MIX), (const bf16_t*)(F.ws + WS_WOUT) + (size_t)l * DM * DM, DM, nullptr, S, E);
        }
        SEAM(pb + 4);
        if (IN(pb + 5)) { FRESH(); ph_ln1(F, l, ntok); }
        SEAM(pb + 5);
        if (IN(pb + 6)) { FRESH();
            pg8::DenseOrder S; S.init(ntok, 256, F.G, F.wg); pg8::EpiF32H E{(float*)(F.ws + WS_LOGIT), 256};
            REP(9) pg8::gemm_phase<pg8::EpiF32H, pg8::DenseOrder, false, false, true, true, true>(F.tid, F.lds, (const bf16_t*)(F.ws + WS_XM), (const bf16_t*)(F.ws + WS_WR) + (size_t)l * 256 * DM, DM, nullptr, S, E);
        }
        SEAM(pb + 6);
        if (IN(pb + 7)) { FRESH(); ph_route(F, l, ntok); }
        SEAM(pb + 7);
        if (IN(pb + 8)) { FRESH(); REP(12) { ph_positions(F, l, ntok); __syncthreads(); } }
        SEAM(pb + 8);
        if (IN(pb + 9)) { FRESH();
            const int ntl = (int)__hip_atomic_load(F.ctl + CW_NTL + l, __ATOMIC_RELAXED, __HIP_MEMORY_SCOPE_AGENT);
            pg8::GroupedOrder S; S.init(ntl, 2, F.G, F.wg); S.preload((const int*)(F.ws + WS_TILEEXP), F.lds + pg8::STAGE_BYTES + 4096, F.tid, NTHR); pg8::EpiSwiglu E{(unsigned char*)(F.ws + WS_ACT)};
            REP(10) pg8::gemm_phase<pg8::EpiSwiglu, pg8::GroupedOrder, true, true>(F.tid, F.lds, (const void*)(F.ws + WS_XM8), (const void*)(F.ws + WS_EXP1), DM, (const int*)(F.ws + WS_ROWTOK), S, E);
        }
        SEAM(pb + 9);
        if (IN(pb + 10)) { FRESH();
            const int ntl = (int)__hip_atomic_load(F.ctl + CW_NTL + l, __ATOMIC_RELAXED, __HIP_MEMORY_SCOPE_AGENT);
            pg8::GroupedOrder S; S.init(ntl, 4, F.G, F.wg); S.preload((const int*)(F.ws + WS_TILEEXP), F.lds + pg8::STAGE_BYTES + 4096, F.tid, NTHR); pg8::EpiScatter E{(unsigned char*)(F.ws + WS_Y2), (const int*)(F.ws + WS_ROWDST)};
            REP(11) pg8::gemm_phase<pg8::EpiScatter, pg8::GroupedOrder, false, true>(F.tid, F.lds, (const void*)(F.ws + WS_ACT), (const void*)(F.ws + WS_EXP2), EH, nullptr, S, E);
        }
        SEAM(pb + 10);
        if (IN(pb + 11)) { FRESH(); ph_ln2(F, l, ntok, last); }
        SEAM(pb + 11);
    }
#undef IN
#undef SEAM
#undef FRESH
}

extern "C" void kernel_launch(void* const* d_in, const int* in_sizes, int n_in, void* d_out, int out_size, void* d_ws, size_t ws_size, hipStream_t stream) {
    static int grid = 0;
    if (grid == 0) {
        if (n_in != 36 || out_size != NLAT * DM || ws_size < WS_END) { fprintf(stderr, "kernel_launch: unexpected shapes (n_in %d out %d ws %zu need %zu)\n", n_in, out_size, ws_size, (size_t)WS_END); grid = -1; return; }
        int dev = 0, cus = 0, per_cu = 0;
        if (hipGetDevice(&dev) != hipSuccess || hipDeviceGetAttribute(&cus, hipDeviceAttributeMultiprocessorCount, dev) != hipSuccess) { grid = -1; return; }
        if (hipFuncSetAttribute((const void*)mk_fwd, hipFuncAttributeMaxDynamicSharedMemorySize, LDS_BYTES) != hipSuccess) { fprintf(stderr, "kernel_launch: hipFuncSetAttribute failed\n"); grid = -1; return; }
        if (hipOccupancyMaxActiveBlocksPerMultiprocessor(&per_cu, (const void*)mk_fwd, NTHR, LDS_BYTES) != hipSuccess || per_cu < 1) { fprintf(stderr, "kernel_launch: occupancy query says %d\n", per_cu); }
        (void)hipGetLastError();
        grid = cus;
    }
    if (grid < 0) return;
    (void)hipMemsetAsync((char*)d_ws + WS_CTL, 0, CTL_BYTES, stream);
    Args a{};
    for (int i = 0; i < 36; ++i) a.in[i] = (const float*)d_in[i];
    a.out = (float*)d_out; a.ws = (unsigned char*)d_ws;
#if MK_MULTI
    for (int p = 0; p < NPHASE; ++p) { a.ph_lo = p; a.ph_hi = p + 1; hipLaunchKernelGGL(mk_fwd, dim3(grid), dim3(NTHR), LDS_BYTES, stream, a); }
#else
    a.ph_lo = 0; a.ph_hi = NPHASE; hipLaunchKernelGGL(mk_fwd, dim3(grid), dim3(NTHR), LDS_BYTES, stream, a);
#endif
}
```

```cpp
#include <hip/hip_runtime.h>
#include <cstdio>
#include <cstdint>

#define LAS __attribute__((address_space(3)))
#define GAS __attribute__((address_space(1)))
typedef unsigned short bf16_t;
typedef short bf16x8 __attribute__((ext_vector_type(8)));
typedef float f32x4 __attribute__((ext_vector_type(4)));
typedef float f32x2 __attribute__((ext_vector_type(2)));
typedef unsigned u32x4 __attribute__((ext_vector_type(4)));
typedef unsigned u32x2 __attribute__((ext_vector_type(2)));

constexpr int NB = 16, SEQ = 4096, CTXL = 256, DM = 1024, DEPTH = 4;
constexpr int NLAT = NB * SEQ;
constexpr int NCTX = NB * CTXL;
constexpr int NROW = NLAT + NCTX;
constexpr int SPB = SEQ + CTXL;
constexpr int DIN_REF = 3104;
constexpr int DIN = 3328;
constexpr int UQ = 0, UK = 512, UV = 1024, UGQ = 1536, UGK = 1664, UGV = 1792, UGR = 2048, UHY = 2304, ULAF = 3072, ULAB = 3200;
constexpr int NEXP = 128, TOPK = 8, EH = 256;
constexpr int NE1 = NEXP + 1;
constexpr int RMAX = 659712;
constexpr int TMAX = RMAX / 256;
constexpr float LN_EPS = 1e-6f;
constexpr float DN_ALPHA = 1.6817928305074290f;

__device__ __forceinline__ unsigned f2bf(float f) { unsigned u = __builtin_bit_cast(unsigned, f); return (u + 0x7fffu + ((u >> 16) & 1u)) >> 16; }
typedef __bf16 bf16v2 __attribute__((ext_vector_type(2)));
__device__ __forceinline__ unsigned pk2(float lo, float hi) { const f32x2 v = {lo, hi}; const bf16v2 b = __builtin_convertvector(v, bf16v2); return __builtin_bit_cast(unsigned, b); }
__device__ __forceinline__ float bf2f(unsigned short b) { return __builtin_bit_cast(float, ((unsigned)b) << 16); }
__device__ __forceinline__ float bflo(unsigned w) { return __builtin_bit_cast(float, w << 16); }
__device__ __forceinline__ float bfhi(unsigned w) { return __builtin_bit_cast(float, w & 0xffff0000u); }
__device__ __forceinline__ float shx(float v, int o, int lane) { return __builtin_bit_cast(float, __builtin_amdgcn_ds_bpermute((lane ^ o) << 2, __builtin_bit_cast(int, v))); }
__device__ __forceinline__ int shxi(int v, int o, int lane) { return __builtin_amdgcn_ds_bpermute((lane ^ o) << 2, v); }
__device__ __forceinline__ float shf(float v, int src) { return __builtin_bit_cast(float, __builtin_amdgcn_ds_bpermute(src << 2, __builtin_bit_cast(int, v))); }
__device__ __forceinline__ float wave_sum(float v, int lane) {
#pragma unroll
    for (int o = 1; o < 64; o <<= 1) v += shx(v, o, lane);
    return v;
}
__device__ __forceinline__ void unpack8(const u32x4 q, float* o) { o[0] = bflo(q.x); o[1] = bfhi(q.x); o[2] = bflo(q.y); o[3] = bfhi(q.y); o[4] = bflo(q.z); o[5] = bfhi(q.z); o[6] = bflo(q.w); o[7] = bfhi(q.w); }
__device__ __forceinline__ float silu_f(float x) { return x * __builtin_amdgcn_rcpf(1.0f + __expf(-x)); }
#define LDS_WAIT() asm volatile("s_waitcnt lgkmcnt(0)" ::: "memory")
#define VM_WAIT() asm volatile("s_waitcnt vmcnt(0)" ::: "memory")

#define XB_TMO      128
#define XB_XCNT(j)  (256  + 64 * (j))
#define XB_XSUB(j)  (1280 + 64 * (j))
#define XB_XGEN(j)  (2304 + 64 * (j))
#define XB_TOP      3328
#define XB_TOPGEN   3392
#define XCD_BAR_WORDS 3456
#define XB_SPIN_CAP (1u << 18)

__device__ __forceinline__ unsigned xb_ld(unsigned* p)              { return __hip_atomic_load(p, __ATOMIC_RELAXED, __HIP_MEMORY_SCOPE_AGENT); }
__device__ __forceinline__ unsigned xb_add(unsigned* p, unsigned v) { return __hip_atomic_fetch_add(p, v, __ATOMIC_RELAXED, __HIP_MEMORY_SCOPE_AGENT); }
__device__ __forceinline__ unsigned xb_xcc_id() { return (unsigned)__builtin_amdgcn_s_getreg((3 << 11) | 20) & 0xFu; }
#define XB_SPIN(cond, bar) do { unsigned _sp = 0; while (cond) { __builtin_amdgcn_s_sleep(1); \
    if ((++_sp & 255u) == 0u) { if (xb_ld(&(bar)[XB_TMO])) break; if (_sp > XB_SPIN_CAP) { atomicAdd(&(bar)[XB_TMO], 1u); break; } } } } while (0)

struct XcdBarrier { unsigned* bar; unsigned x; volatile LAS unsigned* st; };

__device__ __forceinline__ XcdBarrier xcd_barrier_post(unsigned* bar, volatile LAS unsigned* st) {
    XcdBarrier b; b.bar = bar; b.x = xb_xcc_id(); b.st = st;
    if (threadIdx.x == 0) (void)xb_add(&bar[XB_XCNT(b.x)], 1u);
    return b;
}
__device__ __forceinline__ void xcd_barrier_complete(unsigned* bar, unsigned x, unsigned& nloc, unsigned& nx) {
    const unsigned G = gridDim.x * gridDim.y * gridDim.z;
    unsigned sum, cnt, mine, sp = 0u;
    for (;;) {
        sum = 0u; cnt = 0u; mine = 0u;
#pragma unroll
        for (unsigned j = 0; j < 16; ++j) { const unsigned c = xb_ld(&bar[XB_XCNT(j)]); sum += c; cnt += (c > 0u) ? 1u : 0u; mine = (j == x) ? c : mine; }
        if (sum == G) break;
        __builtin_amdgcn_s_sleep(1);
        if ((++sp & 255u) == 0u) { if (xb_ld(&bar[XB_TMO])) break; if (sp > XB_SPIN_CAP) { atomicAdd(&bar[XB_TMO], 1u); break; } }
    }
    nloc = mine > 0u ? mine : 1u; nx = cnt > 0u ? cnt : 1u;
}
__device__ __forceinline__ void xcd_barrier(const XcdBarrier& b) {
    asm volatile("s_waitcnt vmcnt(0)" ::: "memory");
    __syncthreads();
    if (threadIdx.x == 0) {
        unsigned* bar = b.bar;
        __builtin_amdgcn_s_waitcnt(0);
        unsigned nloc = b.st[0], nx = b.st[1];
        if (nloc == 0u) { xcd_barrier_complete(bar, b.x, nloc, nx); b.st[0] = nloc; b.st[1] = nx; }
        const unsigned old = xb_add(&bar[XB_XSUB(b.x)], 1u);
        const unsigned gen = old / nloc;
        if (old + 1u == (gen + 1u) * nloc) {
            __builtin_amdgcn_fence(__ATOMIC_RELEASE, "agent");
            asm volatile("s_waitcnt vmcnt(0)" ::: "memory");
            const unsigned og = xb_add(&bar[XB_TOP], 1u);
            const unsigned tg = og / nx;
            if (og + 1u == (tg + 1u) * nx) xb_add(&bar[XB_TOPGEN], 1u);
            else XB_SPIN(xb_ld(&bar[XB_TOPGEN]) == tg, bar);
            __builtin_amdgcn_fence(__ATOMIC_ACQUIRE, "agent");
            xb_add(&bar[XB_XGEN(b.x)], 1u);
            asm volatile("s_waitcnt vmcnt(0)" ::: "memory");
        } else {
            XB_SPIN(xb_ld(&bar[XB_XGEN(b.x)]) == gen, bar);
            __builtin_amdgcn_fence(__ATOMIC_ACQUIRE, "agent");
            asm volatile("s_waitcnt vmcnt(0)" ::: "memory");
        }
    }
    __syncthreads();
}

namespace pg8 {
constexpr int BM = 256, BK = 64, HALF = 128, HTB = HALF * BK * 2, STAGE_BYTES = 8 * HTB, NXCD = 8, WGM = 8;
__host__ __device__ __forceinline__ int lds_byte(int r, int c) { const int st = (r >> 4) * 2 + (c >> 5), rr = r & 15, cc = c & 31, ob = rr * 64 + cc * 2; return st * 1024 + (ob ^ (((ob >> 9) & 1) << 5)); }
__host__ __device__ __forceinline__ void stage_rc(int b, int& R, int& C) { const int st = b / 1024, sb = b % 1024, swz = sb ^ (((sb >> 9) & 1) << 5); R = (st >> 1) * 16 + swz / 64; C = (st & 1) * 32 + (swz % 64) / 2; }
__host__ __device__ __forceinline__ int perm32(int rho) { const int n = rho >> 4, i = rho & 15; return 8 * (i >> 2) + 4 * n + (i & 3); }

struct Unit { int arow0, brow0, orow0, ocol0, aux; };

struct DenseOrder {
    int nM, nN, nwg, G, c;
    __device__ void init(int M, int N, int G_, int c_) { nM = M / BM; nN = N / BM; nwg = nM * nN; G = G_; c = c_; }
    __device__ __forceinline__ bool next(int i, Unit& u) const {
        const long L = (long)i * G + c; if (L >= nwg) return false;
        int wgid = (int)L; { const int q = nwg / NXCD, r = nwg % NXCD, xcd = wgid % NXCD, off = wgid / NXCD; wgid = (xcd < r ? xcd * (q + 1) : r * (q + 1) + (xcd - r) * q) + off; }
        const int nig = WGM * nN, gid = wgid / nig, fm = gid * WGM, gsz = (nM - fm) < WGM ? (nM - fm) : WGM;
        const int pm = fm + ((wgid % nig) % gsz), pn = (wgid % nig) / gsz;
        u.arow0 = pm * BM; u.brow0 = pn * BM; u.orow0 = pm * BM; u.ocol0 = pn * BM; u.aux = 0; return true;
    }
};
struct GroupedOrder {
    const LAS unsigned char* tab; int nN, nslot, slot, t0, t1;
    __device__ __forceinline__ void init(int ntiles, int nN_, int G, int c) {
        nN = nN_;
        if ((G & 7) == 0) { const int per = (ntiles + 7) >> 3, x = c & 7; nslot = G >> 3; slot = c >> 3; t0 = x * per; t1 = (t0 + per) < ntiles ? (t0 + per) : ntiles; }
        else { nslot = G; slot = c; t0 = 0; t1 = ntiles; }
    }
    __device__ __forceinline__ void preload(const int* tile_exp, LAS unsigned char* lds_tab, int tid, int nthr) {
        __syncthreads();
        for (int i = tid; i < t1 - t0; i += nthr) lds_tab[i] = (unsigned char)tile_exp[t0 + i];
        __syncthreads();
        tab = lds_tab;
    }
    __device__ __forceinline__ bool next(int i, Unit& u) const {
        const int q = i * nslot + slot, t = t0 + q / nN, pn = q % nN;
        if (t >= t1) return false;
        const int e = (int)tab[t - t0];
        u.arow0 = t * BM; u.brow0 = (e * nN + pn) * BM; u.orow0 = t * BM; u.ocol0 = pn * BM; u.aux = e; return true;
    }
};

template <class Base> struct RangeOrder {
    Base b; int i0, i1;
    __device__ __forceinline__ bool next(int i, Unit& u) const { const int j = i + i0; if (j >= i1) return false; return b.next(j, u); }
};

__device__ __forceinline__ unsigned cvt_pk_bf16(float lo, float hi) { return pk2(lo, hi); }

struct NoPre {};
struct EpiF32 {
    static constexpr bool PERM = false; static constexpr int SCW = 0x7A7A7A7A; typedef NoPre Pre;
    __device__ __forceinline__ Pre prefetch(const Unit&, LAS unsigned char*, int, int, int) const { return Pre{}; }
    float* C; int ldc;
    __device__ __forceinline__ void operator()(const f32x4 (&acc)[2][2][4][2], const Unit& u, int wr, int wc, int fr, int fq, const Pre&) const {
        const int row0 = u.orow0 + wr * 64 + fr, col0 = u.ocol0 + wc * 32 + 4 * fq;
#pragma unroll
        for (int ai = 0; ai < 2; ++ai)
#pragma unroll
            for (int m = 0; m < 4; ++m) { float* rowp = C + (size_t)(row0 + ai * HALF + m * 16) * ldc + col0;
#pragma unroll
                for (int bj = 0; bj < 2; ++bj)
#pragma unroll
                    for (int n = 0; n < 2; ++n) *(GAS f32x4*)(rowp + bj * HALF + n * 16) = acc[ai][bj][m][n]; }
    }
};
struct EpiF32H {
    static constexpr bool PERM = false; static constexpr int SCW = 0x7A7A7A7A; typedef NoPre Pre;
    __device__ __forceinline__ Pre prefetch(const Unit&, LAS unsigned char*, int, int, int) const { return Pre{}; }
    float* C; int ldc;
    __device__ __forceinline__ void operator()(const f32x4 (&acc)[2][2][4][2], const Unit& u, int wr, int wc, int fr, int fq, const Pre&) const {
        const int row0 = u.orow0 + wr * 64 + fr, col0 = wc * 32 + 4 * fq;
#pragma unroll
        for (int ai = 0; ai < 2; ++ai)
#pragma unroll
            for (int m = 0; m < 4; ++m) { float* rowp = C + (size_t)(row0 + ai * HALF + m * 16) * ldc + col0;
#pragma unroll
                for (int n = 0; n < 2; ++n) *(GAS f32x4*)(rowp + n * 16) = acc[ai][0][m][n]; }
    }
};
struct EpiBf16 {
    static constexpr bool PERM = true; static constexpr int SCW = 0x7A7A7A7A; typedef NoPre Pre;
    __device__ __forceinline__ Pre prefetch(const Unit&, LAS unsigned char*, int, int, int) const { return Pre{}; }
    bf16_t* O; int ldc;
    __device__ __forceinline__ void operator()(const f32x4 (&acc)[2][2][4][2], const Unit& u, int wr, int wc, int fr, int fq, const Pre&) const {
        const int row0 = u.orow0 + wr * 64 + fr, col0 = u.ocol0 + wc * 32 + 8 * fq;
#pragma unroll
        for (int ai = 0; ai < 2; ++ai)
#pragma unroll
            for (int m = 0; m < 4; ++m) { bf16_t* rowp = O + (size_t)(row0 + ai * HALF + m * 16) * ldc + col0;
#pragma unroll
                for (int bj = 0; bj < 2; ++bj) { const f32x4 v0 = acc[ai][bj][m][0], v1 = acc[ai][bj][m][1];
                    u32x4 w; w.x = cvt_pk_bf16(v0[0], v0[1]); w.y = cvt_pk_bf16(v0[2], v0[3]); w.z = cvt_pk_bf16(v1[0], v1[1]); w.w = cvt_pk_bf16(v1[2], v1[3]);
                    *(GAS u32x4*)(rowp + bj * HALF) = w; } }
    }
};
struct EpiSwiglu {
    static constexpr bool PERM = true; static constexpr int SCW = 0x7A7A7A7A; typedef NoPre Pre;
    __device__ __forceinline__ Pre prefetch(const Unit&, LAS unsigned char*, int, int, int) const { return Pre{}; }
    unsigned char* ACT;
    __device__ __forceinline__ void operator()(const f32x4 (&acc)[2][2][4][2], const Unit& u, int wr, int wc, int fr, int fq, const Pre&) const {
        const int row0 = u.orow0 + wr * 64 + fr, pn = u.ocol0 >> 8;
#pragma unroll
        for (int ai = 0; ai < 2; ++ai)
#pragma unroll
            for (int m = 0; m < 4; ++m) { unsigned char* rowp = ACT + (size_t)(row0 + ai * HALF + m * 16) * EH + pn * 128 + wc * 32 + 8 * fq;
                int w[2];
#pragma unroll
                for (int n = 0; n < 2; ++n) { const f32x4 g = acc[ai][0][m][n], up = acc[ai][1][m][n];
                    f32x4 e;
#pragma unroll
                    for (int i = 0; i < 4; ++i) e[i] = __builtin_amdgcn_exp2f(-g[i]);
                    const f32x4 d = e + 1.0f; f32x4 r;
#pragma unroll
                    for (int i = 0; i < 4; ++i) r[i] = __builtin_amdgcn_rcpf(d[i]);
                    const f32x4 h = (g * up) * r;
                    int v = 0; v = __builtin_amdgcn_cvt_pk_fp8_f32(h[0], h[1], v, false); v = __builtin_amdgcn_cvt_pk_fp8_f32(h[2], h[3], v, true); w[n] = v; }
                *(GAS u32x2*)rowp = (u32x2){(unsigned)w[0], (unsigned)w[1]}; }
    }
};
constexpr float Y2_SCALE = 16.0f, Y2_INV = 1.0f / 16.0f;
struct EpiScatter {
    static constexpr bool PERM = true; static constexpr int SCW = 0x7E7E7E7E;
    struct Pre { const LAS int* tab; };
    unsigned char* Y2; const int* rowdst;
    __device__ __forceinline__ Pre prefetch(const Unit& u, LAS unsigned char* lds, int wid, int lane, int ui) const {
        LAS unsigned char* tab = lds + STAGE_BYTES + (ui & 1) * 1024;
        if (wid < 4) __builtin_amdgcn_global_load_lds((const unsigned*)(rowdst + u.orow0 + wid * 64 + lane), (LAS unsigned*)(tab + wid * 256), 4, 0, 0);
        Pre p; p.tab = (const LAS int*)tab; return p; }
    __device__ __forceinline__ void operator()(const f32x4 (&acc)[2][2][4][2], const Unit& u, int wr, int wc, int fr, int fq, const Pre& pre) const {
#pragma unroll
        for (int ai = 0; ai < 2; ++ai)
#pragma unroll
            for (int m = 0; m < 4; ++m) { const int dst = pre.tab[wr * 64 + fr + ai * HALF + m * 16];
                if (dst >= 0) { unsigned char* rowp = Y2 + (size_t)dst * DM + u.ocol0 + wc * 64 + fq * 16;
                    int w[4];
#pragma unroll
                    for (int bj = 0; bj < 2; ++bj) { const f32x4 v0 = acc[ai][bj][m][0], v1 = acc[ai][bj][m][1];
                        int w0 = 0, w1 = 0;
                        w0 = __builtin_amdgcn_cvt_pk_fp8_f32(v0[0], v0[1], w0, false); w0 = __builtin_amdgcn_cvt_pk_fp8_f32(v0[2], v0[3], w0, true);
                        w1 = __builtin_amdgcn_cvt_pk_fp8_f32(v1[0], v1[1], w1, false); w1 = __builtin_amdgcn_cvt_pk_fp8_f32(v1[2], v1[3], w1, true);
                        w[2 * bj] = w0; w[2 * bj + 1] = w1; }
                    *(GAS u32x4*)rowp = (u32x4){(unsigned)w[0], (unsigned)w[1], (unsigned)w[2], (unsigned)w[3]}; } }
    }
};

typedef int v8i __attribute__((ext_vector_type(8)));
typedef int v4i __attribute__((ext_vector_type(4)));
struct Frag { bf16x8 p[2]; __device__ __forceinline__ bf16x8& operator[](int k) { return p[k]; } __device__ __forceinline__ const bf16x8& operator[](int k) const { return p[k]; } };
template <class Epi, class Sched, bool GATHER, bool F8 = false, bool ALIGN_EPI = true, bool SP2 = true, bool NHALF = false>
__device__ __forceinline__ void gemm_phase(const int tid_in, LAS unsigned char* lds, const void* Ag, const void* Bg, const int K, const int* rowidx, const Sched& S, const Epi& E) {
    int tid_ = tid_in; asm volatile("" : "+v"(tid_));
    const int tid = tid_, wid = __builtin_amdgcn_readfirstlane(tid >> 6), lane = tid & 63, wr = wid >> 2, wc = wid & 3, fr = lane & 15, fq = lane >> 4;
    const int KB = F8 ? K : 2 * K;
    const int nt = KB / 128;
    unsigned voffB[2];
#pragma unroll
    for (int i = 0; i < 2; ++i) { int R, C; stage_rc(tid * 16 + i * 8192, R, C); const int Rb = Epi::PERM ? ((R & ~31) + perm32(R & 31)) : R;
        voffB[i] = (unsigned)(Rb * KB + C * 2); }
    const size_t kstep = (size_t)128;
    const size_t hstep = (size_t)HALF * KB;
    const unsigned ldsw = (unsigned)wid * 1024u;
    const int aoff = F8 ? lds_byte(wr * 64 + fr, 16 * fq) : lds_byte(wr * 64 + fr, fq * 8), boff = F8 ? lds_byte(wc * 32 + fr, 16 * fq) : lds_byte(wc * 32 + fr, fq * 8);
    constexpr int PIECE1 = F8 ? 16 : 1024;
    const int sc_w = Epi::SCW, sc_a = 0x7F7F7F7F;
#define PG8_SA(b, h) (((b) * 2 + (h)) * HTB)
#define PG8_SB(b, h) ((4 + (b) * 2 + (h)) * HTB)
#define PG8_STAGE_B(bufoff, gbase) do { _Pragma("unroll") for (int _i = 0; _i < 2; ++_i) \
        __builtin_amdgcn_global_load_lds((const unsigned*)((const char*)(gbase) + voffB[_i]), (LAS unsigned*)(lds + (bufoff) + ldsw + _i * 8192), 16, 0, 0); } while (0)
#define PG8_STAGE_A(bufoff, gbase, h) do { const char* _gb = (const char*)(gbase) + (GATHER ? (size_t)0 : (size_t)(h) * hstep); \
        __builtin_amdgcn_global_load_lds((const unsigned*)(_gb + ac[GATHER ? (h) : 0][0]), (LAS unsigned*)(lds + (bufoff) + ldsw), 16, 0, 0); \
        __builtin_amdgcn_global_load_lds((const unsigned*)(_gb + ac[GATHER ? (h) : 0][1]), (LAS unsigned*)(lds + (bufoff) + ldsw + 8192), 16, 0, 0); } while (0)
#define PG8_LDA(dst, b, h) do { _Pragma("unroll") for (int m = 0; m < 4; ++m) { if constexpr (F8) { const v4i _l = *(const LAS v4i*)(lds + PG8_SA(b, h) + aoff + m * 2048), _h = *(const LAS v4i*)(lds + PG8_SA(b, h) + aoff + m * 2048 + PIECE1); dst##8[m] = __builtin_shufflevector(_l, _h, 0, 1, 2, 3, 4, 5, 6, 7); } \
        else { dst[m][0] = *(const LAS bf16x8*)(lds + PG8_SA(b, h) + aoff + m * 2048); dst[m][1] = *(const LAS bf16x8*)(lds + PG8_SA(b, h) + aoff + m * 2048 + PIECE1); } } } while (0)
#define PG8_LDB(dst, b, h) do { _Pragma("unroll") for (int n = 0; n < 2; ++n) { if constexpr (F8) { const v4i _l = *(const LAS v4i*)(lds + PG8_SB(b, h) + boff + n * 2048), _h = *(const LAS v4i*)(lds + PG8_SB(b, h) + boff + n * 2048 + PIECE1); dst##8[n] = __builtin_shufflevector(_l, _h, 0, 1, 2, 3, 4, 5, 6, 7); } \
        else { dst[n][0] = *(const LAS bf16x8*)(lds + PG8_SB(b, h) + boff + n * 2048); dst[n][1] = *(const LAS bf16x8*)(lds + PG8_SB(b, h) + boff + n * 2048 + PIECE1); } } } while (0)
#define PG8_MMA(ai, bj, At, Bt) do { __builtin_amdgcn_s_setprio(1); _Pragma("unroll") for (int m = 0; m < 4; ++m) _Pragma("unroll") for (int n = 0; n < 2; ++n) { \
        if constexpr (F8) asm volatile("v_mfma_scale_f32_16x16x128_f8f6f4 %0, %1, %2, %0, %3, %4 op_sel_hi:[0,0,0]" : "+v"(acc[ai][bj][m][n]) : "v"(Bt##8[n]), "v"(At##8[m]), "v"(sc_w), "v"(sc_a)); \
        else { _Pragma("unroll") for (int k = 0; k < 2; ++k) acc[ai][bj][m][n] = __builtin_amdgcn_mfma_f32_16x16x32_bf16(Bt[n][k], At[m][k], acc[ai][bj][m][n], 0, 0, 0); } } \
        __builtin_amdgcn_s_setprio(0); } while (0)
#define PG8_WAIT_V(n) asm volatile("s_waitcnt vmcnt(" #n ")" ::: "memory")
#define PG8_WAIT_LOOP do { if constexpr (NHALF) PG8_WAIT_V(6); else PG8_WAIT_V(8); } while (0)
#define PG8_WAIT_L(n) asm volatile("s_waitcnt lgkmcnt(" #n ")" ::: "memory")
#define PG8_BAR __builtin_amdgcn_s_barrier()
#define PG8_SCHED __builtin_amdgcn_sched_barrier(0)
#define PG8_TAB(par) (lds + STAGE_BYTES + 2048 + (par) * 1024)
#define PG8_TABLOAD(par, row0) do { if (wid < 4) __builtin_amdgcn_global_load_lds((const unsigned*)(rowidx + (row0) + wid * 64 + lane), (LAS unsigned*)(PG8_TAB(par) + wid * 256), 4, 0, 0); } while (0)
#define PG8_AOFF_H(h, par) do { int _tz = tid; asm volatile("" : "+v"(_tz)); _Pragma("unroll") for (int _i = 0; _i < 2; ++_i) { int _R, _C; stage_rc(_tz * 16 + _i * 8192, _R, _C); \
        if (GATHER) ac[h][_i] = ((const LAS unsigned*)PG8_TAB(par))[(h) * HALF + _R] * (unsigned)KB + (unsigned)_C * 2u; \
        else ac[h][_i] = (unsigned)(((h) * HALF + _R) * KB) + (unsigned)_C * 2u; } } while (0)
    static_assert(SP2, "only the two-super-phase K-loop is kept");
    Unit cur, nxt; int ui = 0;
    if (!S.next(0, cur)) return;
    f32x4 acc[2][2][4][2];
#pragma unroll
    for (int a = 0; a < 2; ++a)
#pragma unroll
        for (int b = 0; b < 2; ++b)
#pragma unroll
            for (int m = 0; m < 4; ++m)
#pragma unroll
                for (int n = 0; n < 2; ++n) acc[a][b][m][n] = (f32x4){0.f, 0.f, 0.f, 0.f};
    bf16x8 At[F8 ? 1 : 4][2], B0[F8 ? 1 : 2][2], B1[F8 ? 1 : 2][2];
    v8i At8[F8 ? 4 : 1], B08[F8 ? 2 : 1], B18[F8 ? 2 : 1];
    unsigned ac[GATHER ? 2 : 1][2];
    if (GATHER) { PG8_TABLOAD(0, cur.arow0); PG8_WAIT_V(0); PG8_BAR; }
    PG8_AOFF_H(0, 0); if (GATHER) { PG8_AOFF_H((GATHER ? 1 : 0), 0); }
    const char* cA = (const char*)Ag + (GATHER ? (size_t)0 : (size_t)cur.arow0 * KB); const char* cB = (const char*)Bg + (size_t)cur.brow0 * KB;
    PG8_STAGE_B(PG8_SB(0, 0), cB); if constexpr (!NHALF) PG8_STAGE_B(PG8_SB(0, 1), cB + hstep); PG8_STAGE_A(PG8_SA(0, 0), cA, 0); PG8_STAGE_A(PG8_SA(0, 1), cA, 1);
    if (wr == 1) PG8_BAR;
    PG8_WAIT_V(2); PG8_BAR;
    PG8_STAGE_B(PG8_SB(1, 0), cB + kstep); PG8_STAGE_A(PG8_SA(1, 0), cA + kstep, 0); if constexpr (!NHALF) PG8_STAGE_B(PG8_SB(1, 1), cB + hstep + kstep);
    if constexpr (NHALF) PG8_WAIT_V(4); else PG8_WAIT_V(6);
    PG8_BAR;
    for (;;) {
        const typename Epi::Pre pre = E.prefetch(cur, lds, wid, lane, ui);
        const bool has_next = S.next(ui + 1, nxt);
        if (GATHER) { if (has_next) PG8_TABLOAD((ui + 1) & 1, nxt.arow0); }
        const char* nA = has_next ? ((const char*)Ag + (GATHER ? (size_t)0 : (size_t)nxt.arow0 * KB)) : cA; const char* nB = has_next ? (const char*)Bg + (size_t)nxt.brow0 * KB : cB;
_Pragma("nounroll")
        for (int t = 0; t < nt; t += 2) {
            const bool last = (t == nt - 2);
            const char* a1 = cA + (size_t)(t + 1) * kstep;
            const char* a2 = last ? nA : cA + (size_t)(t + 2) * kstep; const char* b2 = last ? nB : cB + (size_t)(t + 2) * kstep;
            const char* a3 = a2 + kstep; const char* b3 = b2 + kstep;
            if (GATHER) { if (last && has_next) { PG8_AOFF_H(0, (ui + 1) & 1); } }
            PG8_LDB(B0, 0, 0); if constexpr (!NHALF) PG8_LDB(B1, 0, 1); PG8_SCHED; PG8_LDA(At, 0, 0); PG8_STAGE_A(PG8_SA(1, 1), a1, 1);
            PG8_WAIT_LOOP; PG8_WAIT_L(0); PG8_BAR; PG8_MMA(0, 0, At, B0); if constexpr (!NHALF) PG8_MMA(0, 1, At, B1); PG8_BAR; PG8_SCHED;
            if (GATHER) { if (last && has_next) { PG8_AOFF_H(1, (ui + 1) & 1); } }
            PG8_LDA(At, 0, 1); PG8_STAGE_B(PG8_SB(0, 0), b2); if constexpr (!NHALF) PG8_STAGE_B(PG8_SB(0, 1), b2 + hstep); PG8_STAGE_A(PG8_SA(0, 0), a2, 0);
            PG8_WAIT_LOOP; PG8_WAIT_L(0); PG8_BAR; PG8_MMA(1, 0, At, B0); if constexpr (!NHALF) PG8_MMA(1, 1, At, B1); PG8_BAR; PG8_SCHED;
            PG8_LDB(B0, 1, 0); if constexpr (!NHALF) PG8_LDB(B1, 1, 1); PG8_SCHED; PG8_LDA(At, 1, 0); PG8_STAGE_A(PG8_SA(0, 1), a2, 1);
            PG8_WAIT_LOOP; PG8_WAIT_L(0); PG8_BAR; PG8_MMA(0, 0, At, B0); if constexpr (!NHALF) PG8_MMA(0, 1, At, B1); PG8_BAR; PG8_SCHED;
            PG8_LDA(At, 1, 1); PG8_STAGE_B(PG8_SB(1, 0), b3); if constexpr (!NHALF) PG8_STAGE_B(PG8_SB(1, 1), b3 + hstep); PG8_STAGE_A(PG8_SA(1, 0), a3, 0);
            PG8_WAIT_LOOP; PG8_WAIT_L(0); PG8_BAR; PG8_MMA(1, 0, At, B0); if constexpr (!NHALF) PG8_MMA(1, 1, At, B1); PG8_BAR; PG8_SCHED;
        }
        if constexpr (ALIGN_EPI) { if (wr == 0) PG8_BAR; }
        E(acc, cur, wr, wc, fr, fq, pre);
        if (!has_next) break;
#pragma unroll
        for (int a = 0; a < 2; ++a)
#pragma unroll
            for (int b = 0; b < 2; ++b)
#pragma unroll
                for (int m = 0; m < 4; ++m)
#pragma unroll
                    for (int n = 0; n < 2; ++n) acc[a][b][m][n] = (f32x4){0.f, 0.f, 0.f, 0.f};
        cur = nxt; cA = nA; cB = nB; ++ui;
        if constexpr (ALIGN_EPI) { if (wr == 1) PG8_BAR; }
    }
    PG8_WAIT_V(0);
    if constexpr (!ALIGN_EPI) { if (wr == 0) PG8_BAR; }
    PG8_BAR;
#undef PG8_SA
#undef PG8_SB
#undef PG8_STAGE_A
#undef PG8_STAGE_B
#undef PG8_LDA
#undef PG8_LDB
#undef PG8_MMA
#undef PG8_WAIT_V
#undef PG8_WAIT_L
#undef PG8_WAIT_LOOP
#undef PG8_BAR
#undef PG8_SCHED
#undef PG8_AOFF_H
#undef PG8_TAB
#undef PG8_TABLOAD
}
}

constexpr int NWAVES = 8, NTHR = 512;
constexpr size_t MiB = 1u << 20;
constexpr size_t WS_CTL = 0, CTL_BYTES = 1 * MiB;
constexpr size_t WS_MOD = 1 * MiB;
constexpr size_t WS_WIN = 3 * MiB;
constexpr size_t WS_WOUT = 29 * MiB;
constexpr size_t WS_WR = 37 * MiB;
constexpr size_t WS_HYF = 39 * MiB;
constexpr size_t WS_HYFC = 71 * MiB;
constexpr size_t WS_XC = 73 * MiB;
constexpr size_t WS_EXP1 = 89 * MiB;
constexpr size_t WS_EXP2 = 218 * MiB;
constexpr size_t WS_XM = 283 * MiB;
constexpr size_t WS_EIDX = 419 * MiB;
constexpr size_t WS_WGT = 422 * MiB;
constexpr size_t WS_RNK = 425 * MiB;
constexpr size_t WS_ROWTOK = 428 * MiB;
constexpr size_t WS_ROWDST = 431 * MiB;
constexpr size_t WS_TILEEXP = 434 * MiB;
constexpr size_t WS_BIG = 435 * MiB;
constexpr size_t WS_U = WS_BIG;
constexpr size_t WS_MIX = 877 * MiB;
constexpr size_t WS_VT = 1013 * MiB;
constexpr size_t WS_HV = 1081 * MiB;
constexpr size_t WS_Z2 = 1183 * MiB;
constexpr size_t WS_GDS = 1217 * MiB;
constexpr size_t WS_GSIN = 1285 * MiB;
constexpr size_t WS_GD = 1319 * MiB;
constexpr size_t WS_Y = 1321 * MiB;
constexpr size_t WS_LOGIT = WS_BIG;
constexpr size_t WS_ACT = WS_BIG;
constexpr size_t WS_Y2 = 758 * MiB;
constexpr size_t WS_XM8 = 1470 * MiB;
constexpr size_t WS_XR = 1600 * MiB;
constexpr size_t WS_END = 1736 * MiB;
constexpr int CW_BAR = 4096;
constexpr int CW_CNT = 16384;
constexpr int CW_NTL = 20480;

constexpr int LDS_BYTES = 163840;
constexpr int MISC_OFF = 163584;

struct Frame {
    LAS unsigned char* lds;
    int tid, lane, wave, G, wg;
    const float* const* in;
    float* out; unsigned char* ws; unsigned* ctl;
};
enum { I_X = 0, I_C, I_CTX, I_CCTX, I_WMOD, I_BMOD, I_WIN, I_RPB, I_WA2, I_BA2, I_GNORM, I_HSW, I_HSB, I_HW1, I_HB1, I_HF1, I_HW2, I_HB2, I_HF2, I_HW3, I_HB3, I_HDEC, I_HSKIP,
       I_WOUT, I_LN1G, I_LN1B, I_RW, I_RB, I_WEG, I_WEU, I_WED, I_WSG, I_WSU, I_WSD, I_LN2G, I_LN2B };

__device__ __forceinline__ int row_b(int row) { return row < NLAT ? (row >> 12) : 16; }
__device__ __forceinline__ const float* mod_ptr(const Frame& F, int l, int row) { return (const float*)(F.ws + WS_MOD) + ((size_t)l * 17 + row_b(row)) * 6144; }

constexpr float NA_QSCALE = 0.125f * 1.4426950408889634f, NA_CLAMP = 60.0f * 1.4426950408889634f;
template <class RowFn>
__device__ __forceinline__ void tr_item(const float* W, int ldw, int k0, int n0, bf16_t* dst, int ldd, RowFn rf, LAS float* scr, int lane, float scale = 1.0f) {
    float tv[32];
    const GAS float* wp = (const GAS float*)(W + (size_t)(k0 + (lane >> 5)) * ldw + n0 + (lane & 31));
#pragma unroll
    for (int i = 0; i < 32; ++i) tv[i] = wp[(size_t)(2 * i) * ldw];
#pragma unroll
    for (int i = 0; i < 32; ++i) scr[(2 * i + (lane >> 5)) * 33 + (lane & 31)] = tv[i];
    LDS_WAIT(); asm volatile("" ::: "memory");
    const int c = lane & 7;
#pragma unroll
    for (int j = 0; j < 4; ++j) { const int n = (lane >> 3) + 8 * j; const LAS float* s = scr + (8 * c) * 33 + n;
        u32x4 o; o.x = pk2(s[0 * 33] * scale, s[1 * 33] * scale); o.y = pk2(s[2 * 33] * scale, s[3 * 33] * scale); o.z = pk2(s[4 * 33] * scale, s[5 * 33] * scale); o.w = pk2(s[6 * 33] * scale, s[7 * 33] * scale);
        *(GAS u32x4*)(dst + (size_t)rf(n0 + n) * ldd + k0 + 8 * c) = o; }
    LDS_WAIT(); asm volatile("" ::: "memory");
}
template <class RowFn>
__device__ __forceinline__ void tr_item8(const float* W, int ldw, int k0, int n0, unsigned char* dst, int ldd, RowFn rf, float scale, LAS float* scr, int lane) {
    float tv[32];
    const GAS float* wp = (const GAS float*)(W + (size_t)(k0 + (lane >> 5)) * ldw + n0 + (lane & 31));
#pragma unroll
    for (int i = 0; i < 32; ++i) tv[i] = wp[(size_t)(2 * i) * ldw];
#pragma unroll
    for (int i = 0; i < 32; ++i) scr[(2 * i + (lane >> 5)) * 33 + (lane & 31)] = tv[i];
    LDS_WAIT(); asm volatile("" ::: "memory");
    const int n = lane >> 1, hf = lane & 1; const LAS float* s = scr + (32 * hf) * 33 + n;
    unsigned w[8];
#pragma unroll
    for (int j = 0; j < 8; ++j) { int v = 0; v = __builtin_amdgcn_cvt_pk_fp8_f32(s[(4 * j) * 33] * scale, s[(4 * j + 1) * 33] * scale, v, false); v = __builtin_amdgcn_cvt_pk_fp8_f32(s[(4 * j + 2) * 33] * scale, s[(4 * j + 3) * 33] * scale, v, true); w[j] = (unsigned)v; }
    unsigned char* d = dst + (size_t)rf(n0 + n) * ldd + k0 + 32 * hf;
    *(GAS u32x4*)d = (u32x4){w[0], w[1], w[2], w[3]}; *(GAS u32x4*)(d + 16) = (u32x4){w[4], w[5], w[6], w[7]};
    LDS_WAIT(); asm volatile("" ::: "memory");
}
struct RowId { __device__ __forceinline__ int operator()(int n) const { return n; } };
struct RowWin { __device__ __forceinline__ int operator()(int n) const { return n >= 2336 ? n - 32 : n; } };
struct RowGU { int up; __device__ __forceinline__ int operator()(int j) const { return (j >> 7) * 256 + up * 128 + (j & 127); } };

__device__ __forceinline__ void p0_static_weights(Frame& F) {
    LAS float* scr = (LAS float*)(F.lds + F.wave * 16384);
    const int gw = F.wg * NWAVES + F.wave, NGW = F.G * NWAVES;
    constexpr int I_IN = 16 * 97, I_OUT = 16 * 32, I_R = 16 * 4, PER_L = I_IN + I_OUT + I_R;
    for (int it = gw; it < DEPTH * PER_L; it += NGW) {
        const int l = it / PER_L; int r = it % PER_L;
        if (r < I_IN) { const int kb = r / 97, nb = r % 97; if (nb == 72) continue;
            tr_item(F.in[I_WIN] + (size_t)l * DM * DIN_REF, DIN_REF, kb * 64, nb * 32, (bf16_t*)(F.ws + WS_WIN) + (size_t)l * DIN * DM, DM, RowWin{}, scr, F.lane, nb < 16 ? NA_QSCALE : 1.0f); continue; }
        r -= I_IN;
        if (r < I_OUT) { const int kb = r / 32, nb = r % 32;
            tr_item(F.in[I_WOUT] + (size_t)l * DM * DM, DM, kb * 64, nb * 32, (bf16_t*)(F.ws + WS_WOUT) + (size_t)l * DM * DM, DM, RowId{}, scr, F.lane); continue; }
        r -= I_OUT;
        { const int kb = r / 4, nb = r % 4;
            tr_item(F.in[I_RW] + (size_t)l * DM * NEXP, NEXP, kb * 64, nb * 32, (bf16_t*)(F.ws + WS_WR) + (size_t)l * 256 * DM, DM, RowId{}, scr, F.lane); }
    }
    const int gt = F.wg * NTHR + F.tid, NGT = F.G * NTHR;
    for (int i = gt; i < DEPTH * 128 * DM / 8; i += NGT) { const int l = i / (128 * DM / 8), r = i % (128 * DM / 8);
        *(u32x4*)((bf16_t*)(F.ws + WS_WR) + ((size_t)l * 256 + 128) * DM + (size_t)r * 8) = (u32x4){0u, 0u, 0u, 0u}; }
    for (int i = gt; i < DEPTH * 256 * DM; i += NGT) {
        const int k = i % DM, n = (i / DM) % 256, l = i / (DM * 256), dir = n >> 7, j = n & 127;
        const float* wi = F.in[I_WIN] + ((size_t)l * DM + k) * DIN_REF + 2304 + dir * 16;
        const float* wa = F.in[I_WA2] + ((size_t)(l * 2 + dir) * 16) * 128 + j;
        float s = 0.f;
#pragma unroll
        for (int r = 0; r < 16; ++r) s += wi[r] * wa[r * 128];
        ((bf16_t*)(F.ws + WS_WIN))[((size_t)l * DIN + 3072 + n) * DM + k] = (bf16_t)f2bf(s);
    }
}
__device__ __forceinline__ void p0_mod(Frame& F) {
    LAS float* sc = (LAS float*)F.lds;
    LAS float* red = (LAS float*)(F.lds + 17 * 1024 * 4);
    for (int i = F.tid; i < 17 * 1024; i += NTHR) { const int r = i >> 10, k = i & 1023; const float v = r < 16 ? F.in[I_C][r * 1024 + k] : F.in[I_CCTX][k]; sc[i] = silu_f(v); }
    __syncthreads();
    const int kq = F.tid >> 7, cl = F.tid & 127;
    for (int u = F.wg; u < DEPTH * 48; u += F.G) {
        const int l = u / 48, col = (u % 48) * 128 + cl;
        const float* w = F.in[I_WMOD] + (size_t)l * DM * 6144 + col;
        float a[17];
#pragma unroll
        for (int r = 0; r < 17; ++r) a[r] = 0.f;
        for (int k0 = kq * 256; k0 < kq * 256 + 256; k0 += 16) {
            float wv[16];
#pragma unroll
            for (int q = 0; q < 16; ++q) wv[q] = *(const GAS float*)(w + (size_t)(k0 + q) * 6144);
#pragma unroll
            for (int q = 0; q < 16; ++q)
#pragma unroll
                for (int r = 0; r < 17; ++r) a[r] += sc[r * 1024 + k0 + q] * wv[q]; }
#pragma unroll
        for (int r = 0; r < 17; ++r) red[(kq * 17 + r) * 128 + cl] = a[r];
        __syncthreads();
        for (int i = F.tid; i < 17 * 128; i += NTHR) { const int r = i >> 7, c2 = i & 127, cc = (u % 48) * 128 + c2;
            const float s = red[(0 * 17 + r) * 128 + c2] + red[(1 * 17 + r) * 128 + c2] + red[(2 * 17 + r) * 128 + c2] + red[(3 * 17 + r) * 128 + c2] + F.in[I_BMOD][l * 6144 + cc];
            ((float*)(F.ws + WS_MOD))[((size_t)l * 17 + r) * 6144 + cc] = s; }
        __syncthreads();
    }
}
__device__ __forceinline__ void p0_hyena_filters(Frame& F) {
    LAS float* z = (LAS float*)F.lds;
    LAS float* h1 = z + 1092;
    LAS float* h2 = h1 + 33 * 64;
    LAS float* tt = h2 + 33 * 64;
    LAS float* W1 = tt + 64;
    LAS float* W2 = W1 + 33 * 64;
    constexpr int UL = 4096 / 32, UC = 256 / 32, UPL = UL + UC;
    for (int u = F.wg; u < DEPTH * UPL; u += F.G) {
        const int l = u / UPL, r = u % UPL; const bool lat = r < UL; const int L = lat ? 4096 : 256, n0 = (lat ? r : r - UL) * 32;
        __syncthreads();
        for (int i = F.tid; i < 33 * 64; i += NTHR) W1[i] = F.in[I_HW1][(size_t)l * 33 * 64 + i];
        for (int i = F.tid; i < 64 * 64; i += NTHR) W2[i] = F.in[I_HW2][(size_t)l * 64 * 64 + i];
        for (int i = F.tid; i < 33 * 33; i += NTHR) { const int p = i / 33, e = i % 33, n = n0 + p;
            const float t = (float)n / (float)(L - 1);
            float v;
            if (e == 0) v = t;
            else { const int kb = (e - 1) & 15; const float band = 1e-4f + (float)kb * ((15.0f - 1e-4f) / 15.0f);
                   const float w = 6.283185307179586f * (float)n / (float)L; const float ang = w * band;
                   v = e <= 16 ? __cosf(ang) : -__sinf(ang); }
            z[i] = v; if (e == 0) tt[p] = t; }
        __syncthreads();
        for (int i = F.tid; i < 33 * 64; i += NTHR) { const int p = i >> 6, j = i & 63; float s = F.in[I_HB1][l * 64 + j];
#pragma unroll 11
            for (int e = 0; e < 33; ++e) s += z[p * 33 + e] * W1[e * 64 + j];
            h1[i] = __sinf(F.in[I_HF1][l * 64 + j] * s); }
        __syncthreads();
        for (int i = F.tid; i < 33 * 64; i += NTHR) { const int p = i >> 6, j = i & 63; float s = F.in[I_HB2][l * 64 + j];
#pragma unroll 16
            for (int e = 0; e < 64; ++e) s += h1[p * 64 + e] * W2[e * 64 + j];
            h2[i] = __sinf(F.in[I_HF2][l * 64 + j] * s); }
        __syncthreads();
        {
            const int g = F.tid >> 8, col0 = 4 * (F.tid & 255), o = col0 >> 9, dir = (col0 >> 8) & 1, ch0 = col0 & 255;
            const int pb = (dir ? 0 : 1) + 16 * g;
            float a[4][16];
#pragma unroll
            for (int j = 0; j < 4; ++j)
#pragma unroll
                for (int q = 0; q < 16; ++q) a[j][q] = 0.f;
            const float* w3 = F.in[I_HW3] + (size_t)l * 64 * 1024 + col0;
            const LAS float* hp = h2 + pb * 64;
            f32x4 wa[4], wb[4];
#pragma unroll
            for (int q = 0; q < 4; ++q) wa[q] = *(const GAS f32x4*)(w3 + (size_t)q * 1024);
#define HF_BLOCK(wv_, k0_) do { _Pragma("unroll") for (int pi = 0; pi < 16; ++pi) { const f32x4 hv = *(const LAS f32x4*)(hp + pi * 64 + (k0_)); \
                _Pragma("unroll") for (int q = 0; q < 4; ++q) _Pragma("unroll") for (int j = 0; j < 4; ++j) a[j][pi] += hv[q] * wv_[q][j]; } } while (0)
#pragma unroll 1
            for (int k0 = 0; k0 < 64; k0 += 8) {
#pragma unroll
                for (int q = 0; q < 4; ++q) wb[q] = *(const GAS f32x4*)(w3 + (size_t)(k0 + 4 + q) * 1024);
                __builtin_amdgcn_sched_barrier(0);
                HF_BLOCK(wa, k0);
                __builtin_amdgcn_sched_barrier(0);
                { const int kn = k0 + 8 < 64 ? k0 + 8 : k0;
#pragma unroll
                  for (int q = 0; q < 4; ++q) wa[q] = *(const GAS f32x4*)(w3 + (size_t)(kn + q) * 1024); }
                __builtin_amdgcn_sched_barrier(0);
                HF_BLOCK(wb, k0 + 4);
                __builtin_amdgcn_sched_barrier(0);
            }
#undef HF_BLOCK
            const f32x4 b3 = *(const GAS f32x4*)(F.in[I_HB3] + l * 1024 + col0), dc = *(const GAS f32x4*)(F.in[I_HDEC] + ((size_t)(l * 2 + o) * 2 + dir) * 256 + ch0);
            float a0[4] = {0.f, 0.f, 0.f, 0.f};
            if (n0 == 0 && dir == 0 && g == 0) {
                for (int k = 0; k < 64; ++k) { const f32x4 wv = *(const GAS f32x4*)(w3 + (size_t)k * 1024); const float hv = h2[k];
#pragma unroll
                    for (int j = 0; j < 4; ++j) a0[j] += hv * wv[j]; } }
#pragma unroll
            for (int j = 0; j < 4; ++j) {
                const float dec = fabsf(dc[j]);
                bf16_t* R = lat ? (bf16_t*)(F.ws + WS_HYF) + ((size_t)(l * 2 + o) * 256 + ch0 + j) * 8192 : (bf16_t*)(F.ws + WS_HYFC) + ((size_t)(l * 2 + o) * 256 + ch0 + j) * 512;
                float v[16];
#pragma unroll
                for (int pi = 0; pi < 16; ++pi) v[pi] = (a[j][pi] + b3[j]) * __expf(-tt[pb + pi] * dec);
                unsigned w[8];
                if (dir == 0) {
                    if (n0 + 32 == L && g == 1) v[15] = 0.f;
#pragma unroll
                    for (int q = 0; q < 8; ++q) w[q] = pk2(v[15 - 2 * q], v[14 - 2 * q]);
                    GAS u32x4* dst = (GAS u32x4*)(R + (L - n0 - 32) + 16 * (1 - g));
                    dst[0] = (u32x4){w[0], w[1], w[2], w[3]}; dst[1] = (u32x4){w[4], w[5], w[6], w[7]};
                    if (n0 == 0 && g == 0) R[L] = (bf16_t)f2bf((a0[j] + b3[j]) * __expf(-tt[0] * dec) + F.in[I_HSKIP][(l * 2 + o) * 256 + ch0 + j]);
                } else if (n0 > 0 || g == 1) {
#pragma unroll
                    for (int q = 0; q < 8; ++q) w[q] = pk2(v[2 * q], v[2 * q + 1]);
                    GAS u32x4* dst = (GAS u32x4*)(R + (L + n0) + 16 * g);
                    dst[0] = (u32x4){w[0], w[1], w[2], w[3]}; dst[1] = (u32x4){w[4], w[5], w[6], w[7]};
                } else {
#pragma unroll
                    for (int pi = 1; pi < 16; ++pi) R[L + pi] = (bf16_t)f2bf(v[pi]);
                }
            }
        }
    }
    __syncthreads();
}
__device__ __forceinline__ void p0_init_rows(Frame& F) {
    const int gw = F.wg * NWAVES + F.wave, NGW = F.G * NWAVES;
    for (int row = gw; row < NROW; row += NGW) {
        const float* src = row < NLAT ? F.in[I_X] + (size_t)row * DM : F.in[I_CTX] + (size_t)(row - NLAT) * DM;
        const float* md = mod_ptr(F, 0, row);
        bf16_t* xr = (bf16_t*)(F.ws + WS_XR) + (size_t)row * DM; bf16_t* xm = (bf16_t*)(F.ws + WS_XM) + (size_t)row * DM;
#pragma unroll
        for (int j = 0; j < 4; ++j) { const int c = 4 * F.lane + 256 * j;
            const f32x4 v = *(const GAS f32x4*)(src + c), sh = *(const GAS f32x4*)(md + c), sc = *(const GAS f32x4*)(md + 1024 + c);
            *(GAS u32x2*)(xr + c) = (u32x2){pk2(v[0], v[1]), pk2(v[2], v[3])};
            u32x2 w; w.x = pk2(v[0] * (1.f + sc[0]) + sh[0], v[1] * (1.f + sc[1]) + sh[1]); w.y = pk2(v[2] * (1.f + sc[2]) + sh[2], v[3] * (1.f + sc[3]) + sh[3]);
            *(GAS u32x2*)(xm + c) = w; }
    }
}
constexpr float WEXP_SCALE = 32.0f;
__device__ __forceinline__ void p_expert_weights(Frame& F, int l) {
    LAS float* scr = (LAS float*)(F.lds + F.wave * 16384);
    const int gw = F.wg * NWAVES + F.wave, NGW = F.G * NWAVES;
    constexpr int I1 = 16 * 8, I2 = 4 * 32, PER_E = 2 * I1 + I2;
    for (int it = gw; it < NE1 * PER_E; it += NGW) {
        const int e = it / PER_E; int r = it % PER_E;
        unsigned char* d1 = (unsigned char*)(F.ws + WS_EXP1) + (size_t)e * 512 * DM; unsigned char* d2 = (unsigned char*)(F.ws + WS_EXP2) + (size_t)e * DM * EH;
        if (r < 2 * I1) { const int up = r >= I1; if (up) r -= I1; const int kb = r / 8, nb = r % 8;
            const float* src = e < NEXP ? F.in[up ? I_WEU : I_WEG] + ((size_t)l * NEXP + e) * DM * EH : F.in[up ? I_WSU : I_WSG] + (size_t)l * DM * EH;
            tr_item8(src, EH, kb * 64, nb * 32, d1, DM, RowGU{up}, up ? WEXP_SCALE * 0.6931471805599453f : WEXP_SCALE * 1.4426950408889634f, scr, F.lane); }
        else { r -= 2 * I1; const int kb = r / 32, nb = r % 32;
            const float* src = e < NEXP ? F.in[I_WED] + ((size_t)l * NEXP + e) * EH * DM : F.in[I_WSD] + (size_t)l * EH * DM;
            tr_item8(src, DM, kb * 64, nb * 32, d2, EH, RowId{}, WEXP_SCALE, scr, F.lane); }
    }
}

__device__ __forceinline__ f32x4 mfma16(bf16x8 a, bf16x8 b, f32x4 c) { return __builtin_amdgcn_mfma_f32_16x16x32_bf16(a, b, c, 0, 0, 0); }

__device__ __forceinline__ void ph_transposes(Frame& F, int l) {
    LAS bf16_t* tile = (LAS bf16_t*)(F.lds + F.wave * 16384);
    const bf16_t* U = (const bf16_t*)(F.ws + WS_U);
    const int gw = F.wg * NWAVES + F.wave, NGW = F.G * NWAVES;
    const int rsub = F.lane >> 3, cseg = F.lane & 7;
    for (int u = gw; u < 1088 * 20; u += NGW) {
        const int tt = u / 20, blk = u % 20;
        int b, s0, Ls, rowbase, posbase;
        if (tt < 1024) { b = tt >> 6; s0 = (tt & 63) * 64; Ls = SEQ; rowbase = b * SEQ; posbase = 0; }
        else { const int t2 = tt - 1024; b = t2 >> 2; s0 = (t2 & 3) * 64; Ls = CTXL; rowbase = NLAT + b * CTXL; posbase = SEQ; }
        if (blk < 12) {
            constexpr int HT = 80;
            float w0[8], w1[8], w2[8], bb[8];
#pragma unroll
            for (int it = 0; it < 8; ++it) { const int col = blk * 64 + rsub + 8 * it; w0[it] = F.in[I_HSW][(l * 3 + 0) * 768 + col]; w1[it] = F.in[I_HSW][(l * 3 + 1) * 768 + col]; w2[it] = F.in[I_HSW][(l * 3 + 2) * 768 + col]; bb[it] = F.in[I_HSB][l * 768 + col]; }
            const bf16_t* p0 = U + (size_t)(rowbase + s0 + rsub) * DIN + UHY + blk * 64 + cseg * 8;
            u32x4 zc[8];
#pragma unroll
            for (int it = 0; it < 8; ++it) zc[it] = *(const GAS u32x4*)(p0 + (size_t)(8 * it) * DIN);
            u32x4 zh = (u32x4){0u, 0u, 0u, 0u};
            if (F.lane < 16) { const int hs = F.lane < 8 ? s0 - 1 : s0 + 64; if (hs >= 0 && hs < Ls) zh = *(const GAS u32x4*)(U + (size_t)(rowbase + hs) * DIN + UHY + blk * 64 + cseg * 8); }
#pragma unroll
            for (int it = 0; it < 8; ++it) { const unsigned a[4] = {zc[it].x, zc[it].y, zc[it].z, zc[it].w}; LAS bf16_t* d = tile + (cseg * 8) * HT + 8 + rsub + 8 * it;
#pragma unroll
                for (int i = 0; i < 4; ++i) { d[(2 * i) * HT] = (bf16_t)(a[i] & 0xffffu); d[(2 * i + 1) * HT] = (bf16_t)(a[i] >> 16); } }
            if (F.lane < 16) { const unsigned a[4] = {zh.x, zh.y, zh.z, zh.w}; LAS bf16_t* d = tile + (cseg * 8) * HT + (F.lane < 8 ? 7 : 72);
#pragma unroll
                for (int i = 0; i < 4; ++i) { d[(2 * i) * HT] = (bf16_t)(a[i] & 0xffffu); d[(2 * i + 1) * HT] = (bf16_t)(a[i] >> 16); } }
            LDS_WAIT(); asm volatile("" ::: "memory");
#pragma unroll
            for (int it = 0; it < 8; ++it) {
                const int ch = rsub + 8 * it; const LAS bf16_t* r = tile + ch * HT + 8 + cseg * 8;
                const u32x4 v = *(const LAS u32x4*)r; const unsigned hm = r[-1], hp = r[8];
                float x[10]; x[0] = __builtin_bit_cast(float, hm << 16); x[9] = __builtin_bit_cast(float, hp << 16);
                x[1] = bflo(v.x); x[2] = bfhi(v.x); x[3] = bflo(v.y); x[4] = bfhi(v.y); x[5] = bflo(v.z); x[6] = bfhi(v.z); x[7] = bflo(v.w); x[8] = bfhi(v.w);
                unsigned w[4];
#pragma unroll
                for (int i = 0; i < 4; ++i) w[i] = pk2(bb[it] + w0[it] * x[2 * i] + w1[it] * x[2 * i + 1] + w2[it] * x[2 * i + 2], bb[it] + w0[it] * x[2 * i + 1] + w1[it] * x[2 * i + 2] + w2[it] * x[2 * i + 3]);
                *(GAS u32x4*)((bf16_t*)(F.ws + WS_HV) + ((size_t)(blk * 64 + ch) * NB + b) * SPB + posbase + s0 + cseg * 8) = (u32x4){w[0], w[1], w[2], w[3]};
            }
            LDS_WAIT(); asm volatile("" ::: "memory");
            continue;
        } else {
            const int c0 = (blk - 12) * 64 + cseg * 8;
#pragma unroll
            for (int it = 0; it < 8; ++it) {
                const int sl = rsub + 8 * it, s = s0 + sl;
                const u32x4 zc = *(const GAS u32x4*)(U + (size_t)(rowbase + s) * DIN + UV + c0);
                const unsigned ac[4] = {zc.x, zc.y, zc.z, zc.w};
#pragma unroll
                for (int i = 0; i < 4; ++i) { tile[(cseg * 8 + 2 * i) * 72 + sl] = (bf16_t)(ac[i] & 0xffffu); tile[(cseg * 8 + 2 * i + 1) * 72 + sl] = (bf16_t)(ac[i] >> 16); }
            }
        }
        LDS_WAIT(); asm volatile("" ::: "memory");
#pragma unroll 2
        for (int it = 0; it < 8; ++it) {
            const int ch = rsub + 8 * it;
            const u32x4 v = *(const LAS u32x4*)(tile + ch * 72 + cseg * 8);
            bf16_t* dst;
            if (blk < 12) dst = (bf16_t*)(F.ws + WS_HV) + ((size_t)(blk * 64 + ch) * NB + b) * SPB + posbase + s0 + cseg * 8;
            else dst = (bf16_t*)(F.ws + WS_VT) + ((size_t)b * 512 + (blk - 12) * 64 + ch) * SPB + posbase + s0 + cseg * 8;
            *(GAS u32x4*)dst = v;
        }
        LDS_WAIT(); asm volatile("" ::: "memory");
    }
}

constexpr int NA_RPB = 0, NA_KC = 2048, NA_VC = NA_KC + 256 * 144, NA_KR = NA_VC + 64 * 528, NA_END = NA_KR + 9 * 64 * 144;
static_assert(NA_END <= MISC_OFF, "NA LDS map");
__device__ __forceinline__ bf16x8 gld16(const bf16_t* p) { return *(const GAS bf16x8*)p; }
__device__ __forceinline__ u32x2 gld8(const bf16_t* p) { return *(const GAS u32x2*)p; }
__device__ __forceinline__ const char* uni_ptr(const char* p) { const unsigned long long v = (unsigned long long)p; const unsigned lo = __builtin_amdgcn_readfirstlane((unsigned)v), hi = __builtin_amdgcn_readfirstlane((unsigned)(v >> 32)); return (const char*)(((unsigned long long)hi << 32) | lo); }
__device__ __forceinline__ bf16x8 gld16o(const char* ub, unsigned lo) { return *(const GAS bf16x8*)(ub + (size_t)lo); }
__device__ __forceinline__ u32x2 gld8o(const char* ub, unsigned lo) { return *(const GAS u32x2*)(ub + (size_t)lo); }
template <bool WIN>
__device__ __forceinline__ void na_unit(Frame& F, int b, int h, int r, int strip) {
    const bf16_t* U = (const bf16_t*)(F.ws + WS_U);
    const bf16_t* VT = (const bf16_t*)(F.ws + WS_VT) + ((size_t)b * 512 + h * 64) * SPB;
    const LAS float* rpb = (const LAS float*)(F.lds + NA_RPB);
    const LAS bf16_t* KC = (const LAS bf16_t*)(F.lds + NA_KC); const LAS bf16_t* VC = (const LAS bf16_t*)(F.lds + NA_VC);
    int ln_ = F.lane; asm volatile("" : "+v"(ln_));
    const int i = ln_ & 15, g = ln_ >> 4;
    const int qrow0 = WIN ? (b * SEQ + r * 64 + strip * 16) : (NLAT + b * CTXL + strip * 16);
    const int ki = 8 * (i >> 2) + (i & 3);
    const unsigned qlo = (unsigned)((i * DIN + 8 * g) * 2), klo = (unsigned)((ki * DIN + 8 * g) * 2), vlo = (unsigned)((i * SPB + 8 * g) * 2);
    const char* qb = uni_ptr((const char*)(U + (size_t)qrow0 * DIN + UQ + h * 64));
    const bf16x8 q0 = gld16o(qb, qlo), q1 = gld16o(qb + 64, qlo);
    int kr0 = 0, u0 = 0;
    if (WIN) { kr0 = r - 4; kr0 = kr0 < 0 ? 0 : (kr0 > 56 ? 56 : kr0); u0 = strip == 0 ? 0 : (strip == 1 ? 8 : (strip == 2 ? 24 : 32)); }
    const LAS bf16_t* KR = (const LAS bf16_t*)(F.lds + NA_KR);
    const char* vbase = uni_ptr((const char*)(VT + kr0 * 64 + u0));
    f32x4 o[4];
#pragma unroll
    for (int d = 0; d < 4; ++d) o[d] = (f32x4){0.f, 0.f, 0.f, 0.f};
    float lsum = 0.f;
#define NA_SB() __builtin_amdgcn_sched_barrier(0)
#define NA_WLOAD(vb_, cw) do { _Pragma("unroll") for (int d = 0; d < 4; ++d) vb_[d] = gld16o(vbase + ((size_t)(d * 16) * SPB + (cw) * 64) * 2, vlo); } while (0)
#define NA_KRING(kb_, cw) do { const LAS bf16_t* kp = KR + ((((kr0 + (cw)) % 9) * 64 + u0 + ki) * 72 + 8 * g); kb_[0][0] = *(const LAS bf16x8*)kp; kb_[0][1] = *(const LAS bf16x8*)(kp + 32); \
        kb_[1][0] = *(const LAS bf16x8*)(kp + 4 * 72); kb_[1][1] = *(const LAS bf16x8*)(kp + 4 * 72 + 32); } while (0)
#define NA_QK(kb_, s_) do { _Pragma("unroll") for (int t = 0; t < 2; ++t) { f32x4 a = (f32x4){0.f, 0.f, 0.f, 0.f}; a = mfma16(kb_[t][0], q0, a); a = mfma16(kb_[t][1], q1, a); s_[t] = a; } } while (0)
#define NA_PV(s_, vb_) do { u32x4 pw; pw.x = pk2(s_[0][0], s_[0][1]); pw.y = pk2(s_[0][2], s_[0][3]); pw.z = pk2(s_[1][0], s_[1][1]); pw.w = pk2(s_[1][2], s_[1][3]); const bf16x8 pf = __builtin_bit_cast(bf16x8, pw); \
        _Pragma("unroll") for (int d = 0; d < 4; ++d) o[d] = mfma16(vb_[d], pf, o[d]); } while (0)
    bf16x8 vA[4], vB[4], vC[4];
    if (WIN) { NA_WLOAD(vA, 0); NA_WLOAD(vB, 1); NA_WLOAD(vC, 2); NA_SB(); }
#pragma unroll
    for (int cc = 0; cc < 8; ++cc) {
        bf16x8 kc[2][2], vc[4]; f32x4 sc[2];
#pragma unroll
        for (int t = 0; t < 2; ++t) { const LAS bf16_t* kp = KC + (cc * 32 + ki + 4 * t) * 72 + 8 * g; kc[t][0] = *(const LAS bf16x8*)kp; kc[t][1] = *(const LAS bf16x8*)(kp + 32); }
#pragma unroll
        for (int d = 0; d < 4; ++d) vc[d] = *(const LAS bf16x8*)(VC + (d * 16 + i) * 264 + cc * 32 + 8 * g);
        NA_QK(kc, sc);
#pragma unroll
        for (int t = 0; t < 2; ++t)
#pragma unroll
            for (int e = 0; e < 4; ++e) { const float p = __builtin_amdgcn_exp2f(fminf(sc[t][e], NA_CLAMP)); sc[t][e] = p; lsum += p; }
        NA_PV(sc, vc);
    }
    if (WIN) {
        const int c = strip * 16 + i; int kc0 = c - 8; kc0 = kc0 < 0 ? 0 : (kc0 > 48 ? 48 : kc0);
        int dcl[2][4]; bool okm[2][4];
#pragma unroll
        for (int t = 0; t < 2; ++t)
#pragma unroll
            for (int e = 0; e < 4; ++e) { const int kc = u0 + 8 * g + 4 * t + e; okm[t][e] = (kc >= kc0) && (kc < kc0 + 16); int dc = kc - c + 15; dcl[t][e] = okm[t][e] ? (dc < 0 ? 0 : (dc > 30 ? 30 : dc)) : 31; }
#define NA_WCHUNK(vb_, cw) do { bf16x8 kw[2][2]; NA_KRING(kw, cw); f32x4 sw[2]; NA_QK(kw, sw); const LAS float* rp = rpb + (kr0 + (cw) - r + 7) * 32; \
        _Pragma("unroll") for (int t = 0; t < 2; ++t) _Pragma("unroll") for (int e = 0; e < 4; ++e) { const float x = sw[t][e] + rp[dcl[t][e]]; const float p = __builtin_amdgcn_exp2f(fminf(x, NA_CLAMP)); sw[t][e] = p; lsum += p; } \
        NA_PV(sw, vb_); } while (0)
        NA_WCHUNK(vA, 0); NA_SB(); NA_WLOAD(vA, 3); NA_SB();
        NA_WCHUNK(vB, 1); NA_SB(); NA_WLOAD(vB, 4); NA_SB();
        NA_WCHUNK(vC, 2); NA_SB(); NA_WLOAD(vC, 5); NA_SB();
        NA_WCHUNK(vA, 3); NA_SB(); NA_WLOAD(vA, 6); NA_SB();
        NA_WCHUNK(vB, 4); NA_SB(); NA_WLOAD(vB, 7); NA_SB();
        NA_WCHUNK(vC, 5); NA_SB();
        NA_WCHUNK(vA, 6); NA_SB();
        NA_WCHUNK(vB, 7); NA_SB();
#undef NA_WCHUNK
    }
    lsum += shx(lsum, 16, ln_); lsum += shx(lsum, 32, ln_);
    const float inv = 1.0f / lsum;
    char* op = (char*)uni_ptr((const char*)((bf16_t*)(F.ws + WS_MIX) + (size_t)qrow0 * DM + h * 64)); const unsigned olo = (unsigned)((i * DM + 4 * g) * 2);
#pragma unroll
    for (int d = 0; d < 4; ++d) { u32x2 w; w.x = pk2(o[d][0] * inv, o[d][1] * inv); w.y = pk2(o[d][2] * inv, o[d][3] * inv); *(GAS u32x2*)(op + d * 32 + (size_t)olo) = w; }
#undef NA_SB
#undef NA_WLOAD
#undef NA_KRING
#undef NA_QK
#undef NA_PV
}
__device__ __forceinline__ int na_kr0(int r) { const int k = r - 4; return k < 0 ? 0 : (k > 56 ? 56 : k); }
__device__ __forceinline__ void ph_na(Frame& F, int l, bool last) {
    const bf16_t* U = (const bf16_t*)(F.ws + WS_U);
    for (int job = F.wg; job < NB * 8 * 2; job += F.G) {
        const int half = job & 1, h = (job >> 1) & 7, b = job >> 4;
        int tz_; asm volatile("v_mbcnt_lo_u32_b32 %0, -1, 0\n\tv_mbcnt_hi_u32_b32 %0, -1, %0" : "=v"(tz_)); tz_ |= F.wave << 6;
        const bf16_t* krow = U + (size_t)(b * SEQ + (tz_ >> 3)) * DIN + UK + h * 64 + (tz_ & 7) * 8;
        LAS bf16_t* kdst = (LAS bf16_t*)(F.lds + NA_KR) + (tz_ >> 3) * 72 + (tz_ & 7) * 8;
        __syncthreads();
        { LAS float* rpb = (LAS float*)(F.lds + NA_RPB); const float* rsrc = F.in[I_RPB] + ((size_t)l * 8 + h) * 15 * 31;
          if (tz_ < 15 * 32) rpb[tz_] = (tz_ & 31) < 31 ? rsrc[(tz_ >> 5) * 31 + (tz_ & 31)] * 1.4426950408889634f : -1e30f;
          const int key = tz_ >> 1, hf = tz_ & 1; const bf16_t* src = U + (size_t)(NLAT + b * CTXL + key) * DIN + UK + h * 64 + hf * 32; LAS bf16_t* dst = (LAS bf16_t*)(F.lds + NA_KC) + key * 72 + hf * 32;
#pragma unroll
          for (int j = 0; j < 4; ++j) *(LAS bf16x8*)(dst + j * 8) = gld16(src + j * 8);
          const int dv = tz_ >> 3, seg = tz_ & 7; const bf16_t* vs = (const bf16_t*)(F.ws + WS_VT) + ((size_t)b * 512 + h * 64 + dv) * SPB + SEQ + seg * 32; LAS bf16_t* vd = (LAS bf16_t*)(F.lds + NA_VC) + dv * 264 + seg * 32;
#pragma unroll
          for (int j = 0; j < 4; ++j) *(LAS bf16x8*)(vd + j * 8) = gld16(vs + j * 8);
          const int lo = na_kr0(half * 32), hi0 = na_kr0(half * 32 + 1) + 7;
          for (int kr = lo; kr <= hi0; ++kr) *(LAS bf16x8*)(kdst + (kr % 9) * 64 * 72) = gld16(krow + (size_t)kr * 64 * DIN); }
        __syncthreads();
        int prev_hi = na_kr0(half * 32 + 1) + 7;
#pragma unroll 1
        for (int s = 0; s < 16; ++s) {
            const int r0 = half * 32 + 2 * s;
            const int nhi = s < 15 ? na_kr0(r0 + 3) + 7 : prev_hi;
            bf16x8 n0 = (bf16x8){0, 0, 0, 0, 0, 0, 0, 0}, n1 = n0;
            if (nhi > prev_hi) n0 = gld16(krow + (size_t)(prev_hi + 1) * 64 * DIN);
            if (nhi > prev_hi + 1) n1 = gld16(krow + (size_t)(prev_hi + 2) * 64 * DIN);
            na_unit<true>(F, b, h, r0 + (F.wave >> 2), F.wave & 3);
            __syncthreads();
            if (nhi > prev_hi) *(LAS bf16x8*)(kdst + ((prev_hi + 1) % 9) * 64 * 72) = n0;
            if (nhi > prev_hi + 1) *(LAS bf16x8*)(kdst + ((prev_hi + 2) % 9) * 64 * 72) = n1;
            __syncthreads();
            prev_hi = nhi;
        }
        if (!last) na_unit<false>(F, b, h, 0, half * 8 + F.wave);
    }
}

__device__ __forceinline__ void ph_hy_transpose(Frame& F, bool last) {
    LAS bf16_t* tile = (LAS bf16_t*)(F.lds + F.wave * 16384);
    const bf16_t* HYO = (const bf16_t*)(F.ws + WS_Y);
    const int gw = F.wg * NWAVES + F.wave, NGW = F.G * NWAVES;
    const int rsub = F.lane >> 3, cseg = F.lane & 7;
    const int ntt = last ? 1024 : 1088;
    for (int u = gw; u < ntt * 4; u += NGW) {
        const int tt = u >> 2, cb = u & 3;
        int b, s0, rowbase, posbase;
        if (tt < 1024) { b = tt >> 6; s0 = (tt & 63) * 64; rowbase = b * SEQ; posbase = 0; }
        else { const int t2 = tt - 1024; b = t2 >> 2; s0 = (t2 & 3) * 64; rowbase = NLAT + b * CTXL; posbase = SEQ; }
#pragma unroll 2
        for (int it = 0; it < 8; ++it) { const int c = rsub + 8 * it;
            const u32x4 v = *(const GAS u32x4*)(HYO + ((size_t)(cb * 64 + c) * NB + b) * SPB + posbase + s0 + cseg * 8); const unsigned a[4] = {v.x, v.y, v.z, v.w};
#pragma unroll
            for (int e = 0; e < 4; ++e) { tile[(cseg * 8 + 2 * e) * 72 + c] = (bf16_t)(a[e] & 0xffffu); tile[(cseg * 8 + 2 * e + 1) * 72 + c] = (bf16_t)(a[e] >> 16); } }
        LDS_WAIT(); asm volatile("" ::: "memory");
#pragma unroll 2
        for (int it = 0; it < 8; ++it) { const int p = rsub + 8 * it;
            const u32x4 v = *(const LAS u32x4*)(tile + p * 72 + cseg * 8);
            *(GAS u32x4*)((bf16_t*)(F.ws + WS_MIX) + (size_t)(rowbase + s0 + p) * DM + 768 + cb * 64 + cseg * 8) = v; }
        LDS_WAIT(); asm volatile("" ::: "memory");
    }
}

constexpr int G2_LAF = 0, G2_LAB = 8448;
constexpr int G2_QTF = 16896, G2_KTF = 22016, G2_QTB = 27136, G2_KTB = 32256;
constexpr int G2_VT = 37376, G2_ATT = 46592;
constexpr int G2_SF = 55808, G2_SB = 60928;
constexpr int G2_SEG = 66048, G2_HALF = 67328;
__device__ __forceinline__ float log_sigmoid_f(float x) { return fminf(x, 0.f) - __logf(1.0f + __expf(-fabsf(x))); }
__device__ __forceinline__ f32x4 mma_lds(const LAS bf16_t* A, int lda, const LAS bf16_t* B, int ldb, int ksteps, f32x4 acc, int lane) {
    const int r = lane & 15, g = lane >> 4;
    for (int ks = 0; ks < ksteps; ++ks) { const bf16x8 a = *(const LAS bf16x8*)(A + r * lda + ks * 32 + 8 * g), b = *(const LAS bf16x8*)(B + r * ldb + ks * 32 + 8 * g); acc = mfma16(a, b, acc); }
    return acc;
}
__device__ __forceinline__ int gla_row0(int b, int cn) { return cn >= 4 ? b * SEQ + (cn - 4) * 64 : NLAT + b * CTXL + cn * 64; }
struct GlaRaw { u32x4 q, k, f, b, v0, v1, g0, g1, s0, s1; };
template <bool FULL>
__device__ __forceinline__ GlaRaw gla_load(Frame& F, int u, int tl) {
    const int h = u & 3, cn = (u >> 2) % 68, b = (u >> 2) / 68, i = tl >> 2, part = tl & 3;
    const bf16_t* p = (const bf16_t*)(F.ws + WS_U) + (size_t)(gla_row0(b, cn) + i) * DIN;
    GlaRaw r;
    r.q = *(const GAS u32x4*)(p + UGQ + h * 32 + part * 8); r.k = *(const GAS u32x4*)(p + UGK + h * 32 + part * 8);
    r.f = *(const GAS u32x4*)(p + ULAF + h * 32 + part * 8); r.b = *(const GAS u32x4*)(p + ULAB + h * 32 + part * 8);
    r.v0 = *(const GAS u32x4*)(p + UGV + h * 64 + part * 16); r.v1 = *(const GAS u32x4*)(p + UGV + h * 64 + part * 16 + 8);
    if (FULL) { r.g0 = *(const GAS u32x4*)(p + UGR + h * 64 + part * 16); r.g1 = *(const GAS u32x4*)(p + UGR + h * 64 + part * 16 + 8);
        const bf16_t* sp = (const bf16_t*)(F.ws + WS_GSIN) + (size_t)u * 2 * 2048 + tl * 16; r.s0 = *(const GAS u32x4*)sp; r.s1 = *(const GAS u32x4*)(sp + 8); }
    else { r.g0 = (u32x4){0u, 0u, 0u, 0u}; r.g1 = r.g0; r.s0 = r.g0; r.s1 = r.g0; }
    return r;
}
template <bool FULL>
__device__ __forceinline__ void gla_prep(Frame& F, LAS unsigned char* L, int l, int u, int tl, const GlaRaw& raw) {
    const int h = u & 3, cn = (u >> 2) % 68, i = tl >> 2, part = tl & 3, d8 = part * 8;
    LAS float* LAF = (LAS float*)(L + G2_LAF); LAS float* LAB = (LAS float*)(L + G2_LAB); LAS bf16_t* VT = (LAS bf16_t*)(L + G2_VT); LAS float* SEG = (LAS float*)(L + G2_SEG);
    float q[8], k[8], tf[8], tb[8];
    unpack8(raw.q, q); unpack8(raw.k, k); unpack8(raw.f, tf); unpack8(raw.b, tb);
    const float* ba = F.in[I_BA2] + (size_t)l * 256 + h * 32 + d8;
#pragma unroll
    for (int e = 0; e < 8; ++e) { q[e] *= 0.17677669529663687f; LAF[i * 33 + d8 + e] = log_sigmoid_f(tf[e] + ba[e]) * 0.0625f; LAB[i * 33 + d8 + e] = log_sigmoid_f(tb[e] + ba[128 + e]) * 0.0625f; }
    if (cn >= 4) {
        const float pos = (part >> 1) ? (float)i : (float)(cn - 4);
#pragma unroll
        for (int e = 0; e < 8; ++e) { const float ang = pos * __expf(-(float)e * (9.210340371976184f / 8.0f)); const float sn = __sinf(ang), cs = __cosf(ang);
            const float qo = shx(q[e], 1, F.lane), ko = shx(k[e], 1, F.lane);
            if (part & 1) { q[e] = qo * sn + q[e] * cs; k[e] = ko * sn + k[e] * cs; } else { q[e] = q[e] * cs - qo * sn; k[e] = k[e] * cs - ko * sn; } }
    }
    { const unsigned a[8] = {raw.v0.x, raw.v0.y, raw.v0.z, raw.v0.w, raw.v1.x, raw.v1.y, raw.v1.z, raw.v1.w};
#pragma unroll
      for (int e = 0; e < 8; ++e) { VT[(part * 16 + 2 * e) * 72 + i] = (bf16_t)(a[e] & 0xffffu); VT[(part * 16 + 2 * e + 1) * 72 + i] = (bf16_t)(a[e] >> 16); } }
    __syncthreads();
    { const int x = tl & 63, d = x & 31, dir = x >> 5, seg = tl >> 6; LAS float* LA = (dir ? LAB : LAF) + d; float cv[16];
#pragma unroll
      for (int kk = 0; kk < 16; ++kk) { const int p = seg * 16 + kk, ti = dir ? 63 - p : p; cv[kk] = LA[ti * 33]; }
#pragma unroll
      for (int kk = 1; kk < 16; ++kk) cv[kk] += cv[kk - 1];
#pragma unroll
      for (int kk = 0; kk < 16; ++kk) { const int p = seg * 16 + kk, ti = dir ? 63 - p : p; LA[ti * 33] = cv[kk]; }
      SEG[x * 5 + seg] = cv[15]; }
    __syncthreads();
    { const int x = tl & 63, d = x & 31, dir = x >> 5, seg = tl >> 6; LAS float* LA = (dir ? LAB : LAF) + d; float cv[16];
      const float t0 = SEG[x * 5 + 0], t1 = SEG[x * 5 + 1], t2 = SEG[x * 5 + 2];
      const float pre = seg == 0 ? 0.f : (seg == 1 ? t0 : (seg == 2 ? t0 + t1 : t0 + t1 + t2));
#pragma unroll
      for (int kk = 0; kk < 16; ++kk) { const int p = seg * 16 + kk, ti = dir ? 63 - p : p; cv[kk] = LA[ti * 33]; }
#pragma unroll
      for (int kk = 0; kk < 16; ++kk) { const int p = seg * 16 + kk, ti = dir ? 63 - p : p; LA[ti * 33] = cv[kk] + pre; } }
    __syncthreads();
    if (FULL) {
        unsigned wqf[4], wkf[4], wqb[4], wkb[4];
#pragma unroll
        for (int e = 0; e < 4; ++e) { const int d = d8 + 2 * e; const float f0 = LAF[i * 33 + d], f1 = LAF[i * 33 + d + 1], b0 = LAB[i * 33 + d], b1 = LAB[i * 33 + d + 1];
            wqf[e] = pk2(q[2 * e] * __expf(f0), q[2 * e + 1] * __expf(f1)); wkf[e] = pk2(k[2 * e] * __expf(-f0), k[2 * e + 1] * __expf(-f1));
            wqb[e] = pk2(q[2 * e] * __expf(b0), q[2 * e + 1] * __expf(b1)); wkb[e] = pk2(k[2 * e] * __expf(-b0), k[2 * e + 1] * __expf(-b1)); }
        *(LAS u32x4*)((LAS bf16_t*)(L + G2_QTF) + i * 40 + d8) = (u32x4){wqf[0], wqf[1], wqf[2], wqf[3]}; *(LAS u32x4*)((LAS bf16_t*)(L + G2_KTF) + i * 40 + d8) = (u32x4){wkf[0], wkf[1], wkf[2], wkf[3]};
        *(LAS u32x4*)((LAS bf16_t*)(L + G2_QTB) + i * 40 + d8) = (u32x4){wqb[0], wqb[1], wqb[2], wqb[3]}; *(LAS u32x4*)((LAS bf16_t*)(L + G2_KTB) + i * 40 + d8) = (u32x4){wkb[0], wkb[1], wkb[2], wkb[3]};
    } else {
        LAS bf16_t* KDF = (LAS bf16_t*)(L + G2_QTF); LAS bf16_t* KDB = (LAS bf16_t*)(L + G2_KTF);
#pragma unroll
        for (int e = 0; e < 8; ++e) { const int d = d8 + e; const float bf = LAF[i * 33 + d], bb = LAB[i * 33 + d], bfl = LAF[63 * 33 + d], bbl = LAB[0 * 33 + d];
            KDF[d * 72 + i] = (bf16_t)f2bf(k[e] * __expf(bfl - bf)); KDB[d * 72 + i] = (bf16_t)f2bf(k[e] * __expf(bbl - bb)); }
    }
    __syncthreads();
}
__device__ __forceinline__ void ph_gla_local(Frame& F, int l) {
    const int hw = F.wave >> 2, wl = F.wave & 3, tl = F.tid & 255; LAS unsigned char* L = F.lds + hw * G2_HALF;
    constexpr int NU = NB * 68 * 4;
    int pp = F.wg;
    GlaRaw raw = gla_load<false>(F, (pp * 2 + hw) < NU ? pp * 2 + hw : 0, tl);
    for (; pp * 2 < NU; pp += F.G) {
        const int u = pp * 2 + hw, un = (pp + F.G) * 2 + hw;
        const GlaRaw nraw = gla_load<false>(F, un < NU ? un : u, tl);
        __syncthreads();
        gla_prep<false>(F, L, l, u, tl, raw);
        const int g = F.lane >> 4, c = F.lane & 15;
        float* DS = (float*)(F.ws + WS_GDS) + (size_t)u * 2 * 2048;
#pragma unroll
        for (int kk = 0; kk < 4; ++kk) { const int tix = wl * 4 + kk, dir = tix >> 3, mt = (tix >> 1) & 3, nt = tix & 1;
            f32x4 a = (f32x4){0.f, 0.f, 0.f, 0.f};
            a = mma_lds((const LAS bf16_t*)(L + G2_VT) + mt * 16 * 72, 72, (const LAS bf16_t*)(L + (dir ? G2_KTF : G2_QTF)) + nt * 16 * 72, 72, 2, a, F.lane);
#pragma unroll
            for (int e = 0; e < 4; ++e) DS[dir * 2048 + (mt * 16 + 4 * g + e) * 32 + nt * 16 + c] = a[e]; }
        if (tl < 64) { const int d = tl & 31, dir = tl >> 5; ((float*)(F.ws + WS_GD))[(size_t)u * 64 + tl] = __expf(dir ? ((LAS float*)(L + G2_LAB))[0 * 33 + d] : ((LAS float*)(L + G2_LAF))[63 * 33 + d]); }
        raw = nraw;
    }
}
__device__ __forceinline__ void ph_gla_scan(Frame& F) {
    const int gt = F.wg * NTHR + F.tid, NGT = F.G * NTHR;
    const float* DS = (const float*)(F.ws + WS_GDS); const float* GD = (const float*)(F.ws + WS_GD); bf16_t* SIN = (bf16_t*)(F.ws + WS_GSIN);
    for (int w = gt; w < 128 * 1024; w += NGT) {
        const int chain = w >> 10, el = (w & 1023) * 2, dir = chain & 1, h = (chain >> 1) & 3, b = chain >> 3, d = el & 31;
        float s0 = 0.f, s1 = 0.f;
        for (int step = 0; step < 68; step += 4) {
            f32x2 ds[4], dd[4]; size_t uu[4];
#pragma unroll
            for (int q = 0; q < 4; ++q) { const int st_ = step + q; const int cn = dir ? (st_ < 4 ? 3 - st_ : 71 - st_) : st_;
                uu[q] = (size_t)(b * 68 + cn) * 4 + h;
                ds[q] = *(const GAS f32x2*)(DS + (uu[q] * 2 + dir) * 2048 + el); dd[q] = *(const GAS f32x2*)(GD + uu[q] * 64 + dir * 32 + d); }
#pragma unroll
            for (int q = 0; q < 4; ++q) { *(GAS unsigned*)(SIN + (uu[q] * 2 + dir) * 2048 + el) = pk2(s0, s1); s0 = dd[q].x * s0 + ds[q].x; s1 = dd[q].y * s1 + ds[q].y; }
        }
    }
}
__device__ __forceinline__ void ph_gla_out(Frame& F, int l, bool last) {
    const int hw = F.wave >> 2, wl = F.wave & 3, tl = F.tid & 255; LAS unsigned char* L = F.lds + hw * G2_HALF;
    const int NV = last ? NB * 64 * 4 : NB * 68 * 4;
#define GLA_UNIT(v) (last ? ((((v) >> 8) * 68 + 4 + (((v) & 255) >> 2)) * 4 + ((v) & 3)) : (v))
    int pp = F.wg;
    GlaRaw raw = gla_load<true>(F, GLA_UNIT((pp * 2 + hw) < NV ? pp * 2 + hw : 0), tl);
    for (; pp * 2 < NV; pp += F.G) {
        const int u = GLA_UNIT(pp * 2 + hw), vn = (pp + F.G) * 2 + hw;
        const GlaRaw nraw = gla_load<true>(F, vn < NV ? GLA_UNIT(vn) : u, tl);
        const int h = u & 3, cn = (u >> 2) % 68, b = (u >> 2) / 68;
        __syncthreads();
        gla_prep<true>(F, L, l, u, tl, raw);
        { const int dir = tl >> 7, dv = (tl >> 1) & 63, d16 = (tl & 1) * 16; LAS bf16_t* S = (LAS bf16_t*)(L + (dir ? G2_SB : G2_SF)) + dv * 40 + d16; *(LAS u32x4*)S = raw.s0; *(LAS u32x4*)(S + 8) = raw.s1; }
        const int g = F.lane >> 4, c = F.lane & 15;
        LAS bf16_t* ATT = (LAS bf16_t*)(L + G2_ATT);
#pragma unroll
        for (int kk = 0; kk < 4; ++kk) { const int tile = wl * 4 + kk, mt = tile >> 2, nt = tile & 3;
            f32x4 af = (f32x4){0.f, 0.f, 0.f, 0.f}, ab = af;
            af = mma_lds((const LAS bf16_t*)(L + G2_QTF) + mt * 16 * 40, 40, (const LAS bf16_t*)(L + G2_KTF) + nt * 16 * 40, 40, 1, af, F.lane);
            ab = mma_lds((const LAS bf16_t*)(L + G2_QTB) + mt * 16 * 40, 40, (const LAS bf16_t*)(L + G2_KTB) + nt * 16 * 40, 40, 1, ab, F.lane);
#pragma unroll
            for (int e = 0; e < 4; ++e) { const int ii = mt * 16 + 4 * g + e, j = nt * 16 + c; const float vv = (j <= ii ? af[e] : 0.f) + (j >= ii ? ab[e] : 0.f); ATT[ii * 72 + j] = (bf16_t)f2bf(vv); } }
        __syncthreads();
        LAS float* O = (LAS float*)(L + G2_LAF);
#pragma unroll
        for (int kk = 0; kk < 4; ++kk) { const int tile = wl * 4 + kk, mt = tile >> 2, nt = tile & 3;
            f32x4 a = (f32x4){0.f, 0.f, 0.f, 0.f};
            a = mma_lds(ATT + mt * 16 * 72, 72, (const LAS bf16_t*)(L + G2_VT) + nt * 16 * 72, 72, 2, a, F.lane);
            a = mma_lds((const LAS bf16_t*)(L + G2_QTF) + mt * 16 * 40, 40, (const LAS bf16_t*)(L + G2_SF) + nt * 16 * 40, 40, 1, a, F.lane);
            a = mma_lds((const LAS bf16_t*)(L + G2_QTB) + mt * 16 * 40, 40, (const LAS bf16_t*)(L + G2_SB) + nt * 16 * 40, 40, 1, a, F.lane);
#pragma unroll
            for (int e = 0; e < 4; ++e) O[(mt * 16 + 4 * g + e) * 65 + nt * 16 + c] = a[e]; }
        __syncthreads();
        { const int i = tl >> 2, dv16 = (tl & 3) * 16; const int row = gla_row0(b, cn) + i;
          float v[16], gt[16]; float ss = 0.f;
#pragma unroll
          for (int e = 0; e < 16; ++e) { v[e] = O[i * 65 + dv16 + e]; ss += v[e] * v[e]; }
          ss += shx(ss, 1, F.lane); ss += shx(ss, 2, F.lane);
          const float rs = 1.0f / sqrtf(ss * (1.0f / 64.0f) + LN_EPS);
          unpack8(raw.g0, gt); unpack8(raw.g1, gt + 8);
          const float* gn = F.in[I_GNORM] + l * 64 + dv16;
          unsigned w[8];
#pragma unroll
          for (int e = 0; e < 8; ++e) w[e] = pk2(v[2 * e] * rs * gn[2 * e] * silu_f(gt[2 * e]), v[2 * e + 1] * rs * gn[2 * e + 1] * silu_f(gt[2 * e + 1]));
          bf16_t* mp = (bf16_t*)(F.ws + WS_MIX) + (size_t)row * DM + 512 + h * 64 + dv16;
          *(GAS u32x4*)mp = (u32x4){w[0], w[1], w[2], w[3]}; *(GAS u32x4*)(mp + 8) = (u32x4){w[4], w[5], w[6], w[7]}; }
        raw = nraw;
    }
#undef GLA_UNIT
}

template <int L>
__device__ __forceinline__ void hyena_conv(Frame& F, const bf16_t* Rg, const bf16_t* Uin, const bf16_t* Xmul, int pos0, bool final_out, int ch, bf16_t* Zout) {
    constexpr int CS = 2 * L + 16;
    constexpr int NTL = L / 16, J = (NTL >= 64) ? 16 : 2, NGRP = NTL / J, HJ = J / 2, NSTEP = L / 32;
    LAS bf16_t* Rl = (LAS bf16_t*)F.lds;
    __syncthreads();
    for (int c = F.tid; c < 2 * L / 8; c += NTHR) { const u32x4 v = *(const GAS u32x4*)(Rg + 8 * c); const unsigned a[4] = {v.x, v.y, v.z, v.w};
#pragma unroll
        for (int rho = 0; rho < 8; ++rho) { LAS bf16_t* d = Rl + rho * CS + 8 * c + rho;
#pragma unroll
            for (int k = 0; k < 4; ++k) { d[2 * k] = (bf16_t)(a[k] & 0xffffu); d[2 * k + 1] = (bf16_t)(a[k] >> 16); } } }
    __syncthreads();
    int ln_ = F.lane; asm volatile("" : "+v"(ln_));
    const int i = ln_ & 15, g = ln_ >> 4, rho = i & 7;
    const LAS bf16_t* Rc = Rl + rho * CS + rho;
    for (int grp = F.wave; grp < NGRP; grp += NWAVES) {
        f32x4 acc[J]; bf16x8 fr[J];
        const int tb = grp * J * 16;
        const LAS bf16_t* Rb = Rc + (L - tb - i + 8 * g);
#pragma unroll
        for (int j = 0; j < J; ++j) { acc[j] = (f32x4){0.f, 0.f, 0.f, 0.f}; fr[j] = *(const LAS bf16x8*)(Rb - 16 * j); }
        const char* ub = (const char*)(Uin + pos0); const unsigned ulo = (unsigned)((i * SPB + 8 * g) * 2);
        constexpr int PF = (HJ >= 4) ? 4 : 1;
        bf16x8 bq[PF];
#pragma unroll
        for (int p = 0; p < PF; ++p) bq[p] = *(const GAS bf16x8*)(ub + (size_t)(ulo + (unsigned)p * 64u));
#pragma unroll 1
        for (int q = 0; q < NSTEP / HJ; ++q) {
#pragma unroll
            for (int m = 0; m < HJ; ++m) {
                const int n = q * HJ + m;
                const int nn = (n + PF < NSTEP) ? n + PF : 0;
                if (n > 0) { fr[(J - 2 * m) % J] = *(const LAS bf16x8*)(Rb + 32 * n); fr[(J + 1 - 2 * m) % J] = *(const LAS bf16x8*)(Rb + 32 * n - 16); }
                const bf16x8 bcur = bq[m % PF];
#pragma unroll
                for (int jj = 0; jj < J; ++jj) { const int j = (jj + 2) % J; acc[j] = mfma16(fr[(j + J - 2 * m) % J], bcur, acc[j]); }
                bq[m % PF] = *(const GAS bf16x8*)(ub + (size_t)(ulo + (unsigned)nn * 64u));
            }
        }
#pragma unroll
        for (int j = 0; j < J; ++j) { const int t0 = tb + j * 16 + 4 * g;
            const u32x2 xw = *(const GAS u32x2*)(Xmul + (size_t)i * SPB + pos0 + t0);
            const float y0 = acc[j][0] * bflo(xw.x), y1 = acc[j][1] * bfhi(xw.x), y2 = acc[j][2] * bflo(xw.y), y3 = acc[j][3] * bfhi(xw.y);
            if (!final_out) { u32x2 w; w.x = pk2(y0, y1); w.y = pk2(y2, y3); *(GAS u32x2*)(Zout + (size_t)i * SPB + pos0 + t0) = w; }
            else { u32x2 w; w.x = pk2(y0, y1); w.y = pk2(y2, y3); *(GAS u32x2*)((bf16_t*)(F.ws + WS_Y) + ((size_t)ch * NB + i) * SPB + pos0 + t0) = w; } }
    }
}
__device__ __forceinline__ void ph_hyena(Frame& F, int l, bool last) {
    const bf16_t* HV = (const bf16_t*)(F.ws + WS_HV); bf16_t* Z2 = (bf16_t*)(F.ws + WS_Z2);
    for (int ch = F.wg; ch < 256; ch += F.G) {
        const bf16_t* v = HV + (size_t)(0 * 256 + ch) * NB * SPB; const bf16_t* x1 = HV + (size_t)(256 + ch) * NB * SPB; const bf16_t* x2 = HV + (size_t)(512 + ch) * NB * SPB;
        bf16_t* z = Z2 + (size_t)ch * NB * SPB;
        const bf16_t* R0 = (const bf16_t*)(F.ws + WS_HYF) + ((size_t)(l * 2 + 0) * 256 + ch) * 8192; const bf16_t* R1 = (const bf16_t*)(F.ws + WS_HYF) + ((size_t)(l * 2 + 1) * 256 + ch) * 8192;
        hyena_conv<4096>(F, R0, v, x1, 0, false, ch, z);
        VM_WAIT(); __syncthreads(); __builtin_amdgcn_fence(__ATOMIC_ACQUIRE, "agent"); VM_WAIT();
        hyena_conv<4096>(F, R1, z, x2, 0, true, ch, z);
        if (!last) {
            const bf16_t* C0 = (const bf16_t*)(F.ws + WS_HYFC) + ((size_t)(l * 2 + 0) * 256 + ch) * 512; const bf16_t* C1 = (const bf16_t*)(F.ws + WS_HYFC) + ((size_t)(l * 2 + 1) * 256 + ch) * 512;
            hyena_conv<256>(F, C0, v, x1, SEQ, false, ch, z);
            VM_WAIT(); __syncthreads(); __builtin_amdgcn_fence(__ATOMIC_ACQUIRE, "agent"); VM_WAIT();
            hyena_conv<256>(F, C1, z, x2, SEQ, true, ch, z);
        }
    }
}

__device__ __forceinline__ void ph_ln1(Frame& F, int l, int ntok) {
    const int gw = F.wg * NWAVES + F.wave, NGW = F.G * NWAVES;
    const float* lg = F.in[I_LN1G] + l * DM + 16 * F.lane; const float* lb = F.in[I_LN1B] + l * DM + 16 * F.lane;
    for (int row = gw; row < ntok; row += NGW) {
        bf16_t* xr = (bf16_t*)(F.ws + WS_XR) + (size_t)row * DM + 16 * F.lane;
        const bf16_t* yr = (const bf16_t*)(F.ws + WS_Y) + (size_t)row * DM + 16 * F.lane;
        const float* md = mod_ptr(F, l, row) + 16 * F.lane;
        bf16_t* xm = (bf16_t*)(F.ws + WS_XM) + (size_t)row * DM + 16 * F.lane;
        const u32x4 xa = *(const GAS u32x4*)xr, xb = *(const GAS u32x4*)(xr + 8), ya = *(const GAS u32x4*)yr, yb = *(const GAS u32x4*)(yr + 8);
        float x[16], y[16], v[16]; unpack8(xa, x); unpack8(xb, x + 8); unpack8(ya, y); unpack8(yb, y + 8);
        float s = 0.f;
#pragma unroll
        for (int j = 0; j < 4; ++j) { const f32x4 g1 = *(const GAS f32x4*)(md + 2048 + 4 * j);
#pragma unroll
            for (int e = 0; e < 4; ++e) { v[4 * j + e] = x[4 * j + e] * DN_ALPHA + g1[e] * y[4 * j + e]; s += v[4 * j + e]; } }
        const float mean = wave_sum(s, F.lane) * (1.f / DM); float s2 = 0.f;
#pragma unroll
        for (int e = 0; e < 16; ++e) { v[e] -= mean; s2 += v[e] * v[e]; }
        const float rstd = 1.f / sqrtf(wave_sum(s2, F.lane) * (1.f / DM) + LN_EPS);
        unsigned wx[8], wm[8]; int w8[4];
#pragma unroll
        for (int j = 0; j < 4; ++j) { const f32x4 g = *(const GAS f32x4*)(lg + 4 * j), bb = *(const GAS f32x4*)(lb + 4 * j), sh = *(const GAS f32x4*)(md + 3072 + 4 * j), sc = *(const GAS f32x4*)(md + 4096 + 4 * j);
            float xn[4];
#pragma unroll
            for (int e = 0; e < 4; ++e) xn[e] = v[4 * j + e] * rstd * g[e] + bb[e];
            wx[2 * j] = pk2(xn[0], xn[1]); wx[2 * j + 1] = pk2(xn[2], xn[3]);
            const float h0 = xn[0] * (1.f + sc[0]) + sh[0], h1 = xn[1] * (1.f + sc[1]) + sh[1], h2 = xn[2] * (1.f + sc[2]) + sh[2], h3 = xn[3] * (1.f + sc[3]) + sh[3];
            wm[2 * j] = pk2(h0, h1); wm[2 * j + 1] = pk2(h2, h3);
            int v = 0; v = __builtin_amdgcn_cvt_pk_fp8_f32(h0, h1, v, false); v = __builtin_amdgcn_cvt_pk_fp8_f32(h2, h3, v, true); w8[j] = v; }
        *(GAS u32x4*)((unsigned char*)(F.ws + WS_XM8) + (size_t)row * DM + 16 * F.lane) = (u32x4){(unsigned)w8[0], (unsigned)w8[1], (unsigned)w8[2], (unsigned)w8[3]};
        *(GAS u32x4*)xr = (u32x4){wx[0], wx[1], wx[2], wx[3]}; *(GAS u32x4*)(xr + 8) = (u32x4){wx[4], wx[5], wx[6], wx[7]};
        *(GAS u32x4*)xm = (u32x4){wm[0], wm[1], wm[2], wm[3]}; *(GAS u32x4*)(xm + 8) = (u32x4){wm[4], wm[5], wm[6], wm[7]};
    }
}
__device__ __forceinline__ void ph_ln2(Frame& F, int l, int ntok, bool last) {
    const int gw = F.wg * NWAVES + F.wave, NGW = F.G * NWAVES;
    const int cA = 256 * (F.lane >> 4) + 32 * ((F.lane >> 2) & 3) + 8 * (F.lane & 3);
#define LN2_COL(j) (cA + ((j) < 2 ? 4 * (j) : 128 + 4 * ((j) - 2)))
    const float* lg = F.in[I_LN2G] + l * DM; const float* lb = F.in[I_LN2B] + l * DM;
    for (int row = gw; row < ntok; row += NGW) {
        bf16_t* xr = (bf16_t*)(F.ws + WS_XR) + (size_t)row * DM;
        const unsigned char* y2 = (const unsigned char*)(F.ws + WS_Y2) + (size_t)row * 9 * DM + 16 * F.lane;
        const float* wg = (const float*)(F.ws + WS_WGT) + (size_t)row * 8;
        const float* md = mod_ptr(F, l, row);
        float ff[16];
#pragma unroll
        for (int e = 0; e < 16; ++e) ff[e] = 0.f;
        u32x4 q[9];
#pragma unroll
        for (int k = 0; k < 9; ++k) q[k] = *(const GAS u32x4*)(y2 + (size_t)k * DM);
#pragma unroll
        for (int k = 0; k < 9; ++k) { const float wk = (k < 8 ? wg[k] : 1.0f) * pg8::Y2_INV; const unsigned a[4] = {q[k].x, q[k].y, q[k].z, q[k].w};
#pragma unroll
            for (int e = 0; e < 4; ++e) { const f32x2 lo = __builtin_amdgcn_cvt_pk_f32_fp8((int)a[e], false), hi = __builtin_amdgcn_cvt_pk_f32_fp8((int)a[e], true);
                ff[4 * e] += wk * lo.x; ff[4 * e + 1] += wk * lo.y; ff[4 * e + 2] += wk * hi.x; ff[4 * e + 3] += wk * hi.y; } }
        float v[16], xo[16]; float s = 0.f;
        { const u32x4 xa = *(const GAS u32x4*)(xr + cA), xb = *(const GAS u32x4*)(xr + cA + 128); unpack8(xa, xo); unpack8(xb, xo + 8); }
#pragma unroll
        for (int j = 0; j < 4; ++j) { const f32x4 g2 = *(const GAS f32x4*)(md + 5120 + LN2_COL(j));
#pragma unroll
            for (int e = 0; e < 4; ++e) { v[4 * j + e] = xo[4 * j + e] * DN_ALPHA + g2[e] * ff[4 * j + e]; s += v[4 * j + e]; } }
        const float mean = wave_sum(s, F.lane) * (1.f / DM); float s2 = 0.f;
#pragma unroll
        for (int e = 0; e < 16; ++e) { v[e] -= mean; s2 += v[e] * v[e]; }
        const float rstd = 1.f / sqrtf(wave_sum(s2, F.lane) * (1.f / DM) + LN_EPS);
        const float* mdn = last ? md : mod_ptr(F, l + 1, row);
        float xn[16];
#pragma unroll
        for (int j = 0; j < 4; ++j) { const f32x4 g = *(const GAS f32x4*)(lg + LN2_COL(j)), bb = *(const GAS f32x4*)(lb + LN2_COL(j));
#pragma unroll
            for (int e = 0; e < 4; ++e) xn[4 * j + e] = v[4 * j + e] * rstd * g[e] + bb[e]; }
        if (last) { float* op = F.out + (size_t)row * DM;
#pragma unroll
            for (int j = 0; j < 4; ++j) *(GAS f32x4*)(op + LN2_COL(j)) = (f32x4){xn[4 * j], xn[4 * j + 1], xn[4 * j + 2], xn[4 * j + 3]}; }
        else {
            *(GAS u32x4*)(xr + cA) = (u32x4){pk2(xn[0], xn[1]), pk2(xn[2], xn[3]), pk2(xn[4], xn[5]), pk2(xn[6], xn[7])}; *(GAS u32x4*)(xr + cA + 128) = (u32x4){pk2(xn[8], xn[9]), pk2(xn[10], xn[11]), pk2(xn[12], xn[13]), pk2(xn[14], xn[15])};
            bf16_t* xm = (bf16_t*)(F.ws + WS_XM) + (size_t)row * DM;
            unsigned w[8];
#pragma unroll
            for (int j = 0; j < 4; ++j) { const f32x4 sh = *(const GAS f32x4*)(mdn + LN2_COL(j)), sc = *(const GAS f32x4*)(mdn + 1024 + LN2_COL(j));
                w[2 * j] = pk2(xn[4 * j] * (1.f + sc[0]) + sh[0], xn[4 * j + 1] * (1.f + sc[1]) + sh[1]); w[2 * j + 1] = pk2(xn[4 * j + 2] * (1.f + sc[2]) + sh[2], xn[4 * j + 3] * (1.f + sc[3]) + sh[3]); }
            *(GAS u32x4*)(xm + cA) = (u32x4){w[0], w[1], w[2], w[3]}; *(GAS u32x4*)(xm + cA + 128) = (u32x4){w[4], w[5], w[6], w[7]};
        }
    }
#undef LN2_COL
}

__device__ __forceinline__ unsigned f_ord(float f) { const unsigned u = __builtin_bit_cast(unsigned, f); return (u & 0x80000000u) ? ~u : (u | 0x80000000u); }
__device__ __forceinline__ unsigned long long wave_max_u64(unsigned long long v, int lane) {
#pragma unroll
    for (int o = 1; o < 64; o <<= 1) { const unsigned lo = (unsigned)shxi((int)(unsigned)v, o, lane), hi = (unsigned)shxi((int)(unsigned)(v >> 32), o, lane); const unsigned long long w = ((unsigned long long)hi << 32) | lo; v = w > v ? w : v; }
    return v;
}
__device__ __forceinline__ float seg16_max(float v, int lane) { v = fmaxf(v, shx(v, 1, lane)); v = fmaxf(v, shx(v, 2, lane)); v = fmaxf(v, shx(v, 4, lane)); v = fmaxf(v, shx(v, 8, lane)); return v; }
__device__ __forceinline__ int seg16_min_i(int v, int lane) { int w; w = shxi(v, 1, lane); v = w < v ? w : v; w = shxi(v, 2, lane); v = w < v ? w : v; w = shxi(v, 4, lane); v = w < v ? w : v; w = shxi(v, 8, lane); v = w < v ? w : v; return v; }
template <int CTRL> __device__ __forceinline__ int dpp_i(int v) { return __builtin_amdgcn_update_dpp(0, v, CTRL, 0xf, 0xf, true); }
__device__ __forceinline__ unsigned row_max_u(unsigned v) { unsigned w; w = (unsigned)dpp_i<0xB1>((int)v); v = w > v ? w : v; w = (unsigned)dpp_i<0x4E>((int)v); v = w > v ? w : v; w = (unsigned)dpp_i<0x141>((int)v); v = w > v ? w : v; w = (unsigned)dpp_i<0x140>((int)v); v = w > v ? w : v; return v; }
__device__ __forceinline__ float row_max_f(float v) { v = fmaxf(v, __builtin_bit_cast(float, dpp_i<0xB1>(__builtin_bit_cast(int, v)))); v = fmaxf(v, __builtin_bit_cast(float, dpp_i<0x4E>(__builtin_bit_cast(int, v)))); v = fmaxf(v, __builtin_bit_cast(float, dpp_i<0x141>(__builtin_bit_cast(int, v)))); v = fmaxf(v, __builtin_bit_cast(float, dpp_i<0x140>(__builtin_bit_cast(int, v)))); return v; }
__device__ __forceinline__ int row_min_i(int v) { int w; w = dpp_i<0xB1>(v); v = w < v ? w : v; w = dpp_i<0x4E>(v); v = w < v ? w : v; w = dpp_i<0x141>(v); v = w < v ? w : v; w = dpp_i<0x140>(v); v = w < v ? w : v; return v; }
__device__ __forceinline__ float rdlane_f(float v, int l) { return __builtin_bit_cast(float, __builtin_amdgcn_readlane(__builtin_bit_cast(int, v), l)); }
__device__ __forceinline__ unsigned wave_max_u(unsigned v) {
    v = row_max_u(v);
    const unsigned a = (unsigned)__builtin_amdgcn_readlane((int)v, 0), b = (unsigned)__builtin_amdgcn_readlane((int)v, 16), c = (unsigned)__builtin_amdgcn_readlane((int)v, 32), d = (unsigned)__builtin_amdgcn_readlane((int)v, 48);
    const unsigned ab = a > b ? a : b, cd = c > d ? c : d; return ab > cd ? ab : cd;
}
__device__ __forceinline__ float row_top2(float v, int l16) {
    const float m1 = row_max_f(v);
    const int first = row_min_i(v == m1 ? l16 : 99);
    const float m2 = row_max_f(l16 == first ? -3.0e38f : v);
    return m1 + m2;
}
__device__ __forceinline__ float seg16_top2(float v, int lane) {
    const float m1 = seg16_max(v, lane);
    const int first = seg16_min_i(v == m1 ? (lane & 15) : 99, lane);
    const float m2 = seg16_max((lane & 15) == first ? -3.0e38f : v, lane);
    return m1 + m2;
}
__device__ __forceinline__ void ph_route(Frame& F, int l, int ntok) {
    LAS int* hist = (LAS int*)F.lds;
    LAS int* base = hist + 128;
    LAS unsigned* alist = (LAS unsigned*)(F.lds + 1024);
    const int tpw = (ntok + F.G - 1) / F.G, t0 = F.wg * tpw, t1 = (t0 + tpw) < ntok ? (t0 + tpw) : ntok;
    __syncthreads();
    if (F.tid < 128) hist[F.tid] = 0;
    __syncthreads();
    const float* LG = (const float*)(F.ws + WS_LOGIT); const float* rb = F.in[I_RB] + l * NEXP;
    const float b0 = rb[F.lane], b1 = rb[F.lane + 64];
    constexpr int RT = 4;
    for (int tb = t0 + F.wave * RT; tb < t1; tb += NWAVES * RT) {
        float s0[RT], s1[RT], e0[RT], e1[RT], gs0[RT], gs1[RT]; unsigned h0[RT], h1[RT]; int mye[RT]; float myw[RT], wsum[RT];
#pragma unroll
        for (int j = 0; j < RT; ++j) { const int tok = (tb + j) < t1 ? tb + j : t1 - 1;
            const float x0 = LG[(size_t)tok * 256 + F.lane], x1 = LG[(size_t)tok * 256 + 64 + F.lane];
            s0[j] = __builtin_amdgcn_rcpf(1.0f + __expf(-x0)); s1[j] = __builtin_amdgcn_rcpf(1.0f + __expf(-x1)); e0[j] = s0[j] + b0; e1[j] = s1[j] + b1; }
#pragma unroll
        for (int j = 0; j < RT; ++j) { gs0[j] = row_top2(e0[j], F.lane & 15); gs1[j] = row_top2(e1[j], F.lane & 15); }
#pragma unroll
        for (int j = 0; j < RT; ++j) {
            float gsc[8];
#pragma unroll
            for (int g = 0; g < 4; ++g) { gsc[g] = rdlane_f(gs0[j], g * 16); gsc[4 + g] = rdlane_f(gs1[j], g * 16); }
            unsigned gmask = 0u;
#pragma unroll
            for (int g = 0; g < 8; ++g) { int cnt = 0;
#pragma unroll
                for (int g2 = 0; g2 < 8; ++g2) cnt += (gsc[g2] > gsc[g] || (gsc[g2] == gsc[g] && g2 < g)) ? 1 : 0;
                gmask |= (cnt < 4) ? (1u << g) : 0u; }
            const bool ok0 = (gmask >> (F.lane >> 4)) & 1u, ok1 = (gmask >> (4 + (F.lane >> 4))) & 1u;
            h0[j] = ok0 ? f_ord(e0[j]) : 0u; h1[j] = ok1 ? f_ord(e1[j]) : 0u;
            mye[j] = 0; myw[j] = 0.f; wsum[j] = 0.f; }
#pragma unroll
        for (int k = 0; k < 8; ++k) {
#pragma unroll
            for (int j = 0; j < RT; ++j) {
                const unsigned bh = h0[j] >= h1[j] ? h0[j] : h1[j];
                const unsigned H = wave_max_u(bh);
                const unsigned mylo = h0[j] == H ? (unsigned)(255 - F.lane) : (h1[j] == H ? (unsigned)(255 - 64 - F.lane) : 0u);
                const unsigned Lm = wave_max_u(mylo);
                const int e = 255 - (int)Lm;
                if (e < 64) { if (F.lane == e) h0[j] = 0u; } else { if (F.lane == e - 64) h1[j] = 0u; }
                const float sv = e < 64 ? rdlane_f(s0[j], e) : rdlane_f(s1[j], e - 64);
                wsum[j] += sv; if (F.lane == k) { mye[j] = e; myw[j] = sv; } }
        }
#pragma unroll
        for (int j = 0; j < RT; ++j) { const int tok = tb + j;
            if (tok < t1 && F.lane < 8) {
                const int lr = __hip_atomic_fetch_add(&hist[mye[j]], 1, __ATOMIC_RELAXED, __HIP_MEMORY_SCOPE_WORKGROUP);
                alist[(tok - t0) * 8 + F.lane] = (unsigned)mye[j] | ((unsigned)lr << 8);
                ((int*)(F.ws + WS_EIDX))[(size_t)tok * 8 + F.lane] = mye[j];
                ((float*)(F.ws + WS_WGT))[(size_t)tok * 8 + F.lane] = myw[j] / wsum[j] * 2.5f;
            } }
    }
    __syncthreads();
    if (F.tid < 128) { const int hcount = hist[F.tid]; base[F.tid] = hcount ? (int)atomicAdd(F.ctl + CW_CNT + l * 256 + F.tid, (unsigned)hcount) : 0; }
    __syncthreads();
    for (int a = F.tid; a < (t1 - t0) * 8; a += NTHR) { const unsigned v = alist[a]; ((int*)(F.ws + WS_RNK))[(size_t)t0 * 8 + a] = base[v & 0xffu] + (int)(v >> 8); }
}
__device__ __forceinline__ void ph_positions(Frame& F, int l, int ntok) {
    LAS int* cnt = (LAS int*)F.lds;
    LAS int* off = cnt + 132;
    __syncthreads();
    if (F.tid < NE1) cnt[F.tid] = F.tid < NEXP ? (int)__hip_atomic_load(F.ctl + CW_CNT + l * 256 + F.tid, __ATOMIC_RELAXED, __HIP_MEMORY_SCOPE_AGENT) : ntok;
    __syncthreads();
    if (F.tid == 0) { int o = 0; for (int e = 0; e < NE1; ++e) { off[e] = o; o += (cnt[e] + 255) & ~255; } off[NE1] = o; }
    __syncthreads();
    const int gt = F.wg * NTHR + F.tid, NGT = F.G * NTHR;
    int* rowtok = (int*)(F.ws + WS_ROWTOK); int* rowdst = (int*)(F.ws + WS_ROWDST); int* tile_exp = (int*)(F.ws + WS_TILEEXP);
    const int* eidx = (const int*)(F.ws + WS_EIDX); const int* rnk = (const int*)(F.ws + WS_RNK);
    for (int a = gt; a < ntok * 8; a += NGT) { const int tok = a >> 3, k = a & 7; const int pos = off[eidx[a]] + rnk[a]; rowtok[pos] = tok; rowdst[pos] = tok * 9 + k; }
    for (int tok = gt; tok < ntok; tok += NGT) { const int pos = off[NEXP] + tok; rowtok[pos] = tok; rowdst[pos] = tok * 9 + 8; }
    for (int i = gt; i < NE1 * 256; i += NGT) { const int e = i >> 8, p = i & 255; const int row = off[e] + cnt[e] + p; if (row < off[e + 1]) { rowtok[row] = 0; rowdst[row] = -1; } }
    for (int i = gt; i < NE1 * 320; i += NGT) { const int e = i / 320, p = i % 320; const int t = (off[e] >> 8) + p; if (t < (off[e + 1] >> 8)) tile_exp[t] = e; }
    if (gt == 0) F.ctl[CW_NTL + l] = (unsigned)(off[NE1] >> 8);
}

#ifndef MK_MULTI
#define MK_MULTI 0
#endif
constexpr int PH_PER_LAYER = 12, NPHASE = 2 + DEPTH * PH_PER_LAYER;
struct Args { const float* in[36]; float* out; unsigned char* ws; int ph_lo, ph_hi; };

__global__ void __launch_bounds__(NTHR, 2) mk_fwd(Args args) {
    extern __shared__ __attribute__((aligned(16))) unsigned char lds_raw[];
    Frame F;
    F.lds = (LAS unsigned char*)lds_raw;
    F.tid = threadIdx.x; F.lane = F.tid & 63; F.wave = __builtin_amdgcn_readfirstlane(F.tid >> 6);
    const int wave0 = F.wave;
    F.G = gridDim.x; F.wg = blockIdx.x;
    F.in = args.in;
    F.out = args.out; F.ws = args.ws; F.ctl = (unsigned*)(args.ws + WS_CTL);
    volatile LAS unsigned* MISC = (volatile LAS unsigned*)(F.lds + MISC_OFF);
    if (F.tid < 32) MISC[F.tid] = 0u;
    __syncthreads();
    const int lo = args.ph_lo, hi = args.ph_hi;
    const bool single = (hi - lo) > 1;
    XcdBarrier bar; bar.bar = F.ctl + CW_BAR; bar.x = 0; bar.st = nullptr;
    if (single) bar = xcd_barrier_post(F.ctl + CW_BAR, MISC + 8);
#define IN(k) (lo <= (k) && (k) < hi)
#ifndef PROBE_MASK
#define PROBE_MASK 0
#endif
#define REP(k) for (int _rep = 0; _rep < (((PROBE_MASK >> (k)) & 1) ? 2 : 1); ++_rep)
#define SEAM(k) do { if (IN(k) && IN((k) + 1)) { xcd_barrier(bar); if ((PROBE_MASK >> 15) & 1) xcd_barrier(bar); } } while (0)
#define FRESH() do { int _ln; asm volatile("v_mbcnt_lo_u32_b32 %0, -1, 0\n\tv_mbcnt_hi_u32_b32 %0, -1, %0" : "=v"(_ln)); int _wv = wave0; asm volatile("" : "+s"(_wv)); F.lane = _ln; F.wave = _wv; F.tid = (_wv << 6) | _ln; \
        unsigned char* _w = args.ws; asm volatile("" : "+s"(_w)); F.ws = _w; F.ctl = (unsigned*)(_w + WS_CTL); float* _o = args.out; asm volatile("" : "+s"(_o)); F.out = _o; } while (0)

    if (IN(0)) { FRESH(); REP(13) { p0_static_weights(F); __syncthreads(); } REP(14) { p0_mod(F); __syncthreads(); } FRESH(); REP(16) { p0_hyena_filters(F); __syncthreads(); } }
    SEAM(0);
    if (IN(1)) { FRESH(); p0_init_rows(F); }
    SEAM(1);
#pragma unroll 1
    for (int l = 0; l < DEPTH; ++l) {
        const int pb = 2 + l * PH_PER_LAYER; const bool last = (l == DEPTH - 1); const int ntok = last ? NLAT : NROW;
        if (IN(pb + 0)) { FRESH();
            REP(0) { p_expert_weights(F, l); __syncthreads(); }
            pg8::DenseOrder S; S.init(NROW, DIN, F.G, F.wg); pg8::EpiBf16 E{(bf16_t*)(F.ws + WS_U), DIN};
            REP(1) pg8::gemm_phase<pg8::EpiBf16, pg8::DenseOrder, false>(F.tid, F.lds, (const bf16_t*)(F.ws + WS_XM), (const bf16_t*)(F.ws + WS_WIN) + (size_t)l * DIN * DM, DM, nullptr, S, E);
        }
        SEAM(pb + 0);
        if (IN(pb + 1)) { FRESH(); REP(2) { ph_transposes(F, l); __syncthreads(); } FRESH(); REP(3) { ph_gla_local(F, l); __syncthreads(); } }
        SEAM(pb + 1);
        if (IN(pb + 2)) { FRESH(); REP(4) { ph_na(F, l, last); } FRESH(); REP(5) { ph_gla_scan(F); } __syncthreads(); FRESH(); REP(6) { ph_hyena(F, l, last); } }
        SEAM(pb + 2);
        if (IN(pb + 3)) { FRESH(); ph_hy_transpose(F, last); __syncthreads(); FRESH(); REP(7) { ph_gla_out(F, l, last); } }
        SEAM(pb + 3);
        if (IN(pb + 4)) { FRESH();
            pg8::DenseOrder S; S.init(ntok, DM, F.G, F.wg); pg8::EpiBf16 E{(bf16_t*)(F.ws + WS_Y), DM};
            REP(8) pg8::gemm_phase<pg8::EpiBf16, pg8::DenseOrder, false>(F.tid, F.lds, (const bf16_t*)(F.ws + WS_MIX), (const bf16_t*)(F.ws + WS_WOUT) + (size_t)l * DM * DM, DM, nullptr, S, E);
        }
        SEAM(pb + 4);
        if (IN(pb + 5)) { FRESH(); ph_ln1(F, l, ntok); }
        SEAM(pb + 5);
        if (IN(pb + 6)) { FRESH();
            pg8::DenseOrder S; S.init(ntok, 256, F.G, F.wg); pg8::EpiF32H E{(float*)(F.ws + WS_LOGIT), 256};
            REP(9) pg8::gemm_phase<pg8::EpiF32H, pg8::DenseOrder, false, false, true, true, true>(F.tid, F.lds, (const bf16_t*)(F.ws + WS_XM), (const bf16_t*)(F.ws + WS_WR) + (size_t)l * 256 * DM, DM, nullptr, S, E);
        }
        SEAM(pb + 6);
        if (IN(pb + 7)) { FRESH(); ph_route(F, l, ntok); }
        SEAM(pb + 7);
        if (IN(pb + 8)) { FRESH(); REP(12) { ph_positions(F, l, ntok); __syncthreads(); } }
        SEAM(pb + 8);
        if (IN(pb + 9)) { FRESH();
            const int ntl = (int)__hip_atomic_load(F.ctl + CW_NTL + l, __ATOMIC_RELAXED, __HIP_MEMORY_SCOPE_AGENT);
            pg8::GroupedOrder S; S.init(ntl, 2, F.G, F.wg); S.preload((const int*)(F.ws + WS_TILEEXP), F.lds + pg8::STAGE_BYTES + 4096, F.tid, NTHR); pg8::EpiSwiglu E{(unsigned char*)(F.ws + WS_ACT)};
            REP(10) pg8::gemm_phase<pg8::EpiSwiglu, pg8::GroupedOrder, true, true>(F.tid, F.lds, (const void*)(F.ws + WS_XM8), (const void*)(F.ws + WS_EXP1), DM, (const int*)(F.ws + WS_ROWTOK), S, E);
        }
        SEAM(pb + 9);
        if (IN(pb + 10)) { FRESH();
            const int ntl = (int)__hip_atomic_load(F.ctl + CW_NTL + l, __ATOMIC_RELAXED, __HIP_MEMORY_SCOPE_AGENT);
            pg8::GroupedOrder S; S.init(ntl, 4, F.G, F.wg); S.preload((const int*)(F.ws + WS_TILEEXP), F.lds + pg8::STAGE_BYTES + 4096, F.tid, NTHR); pg8::EpiScatter E{(unsigned char*)(F.ws + WS_Y2), (const int*)(F.ws + WS_ROWDST)};
            REP(11) pg8::gemm_phase<pg8::EpiScatter, pg8::GroupedOrder, false, true>(F.tid, F.lds, (const void*)(F.ws + WS_ACT), (const void*)(F.ws + WS_EXP2), EH, nullptr, S, E);
        }
        SEAM(pb + 10);
        if (IN(pb + 11)) { FRESH(); ph_ln2(F, l, ntok, last); }
        SEAM(pb + 11);
    }
#undef IN
#undef SEAM
#undef FRESH
}

extern "C" void kernel_launch(void* const* d_in, const int* in_sizes, int n_in, void* d_out, int out_size, void* d_ws, size_t ws_size, hipStream_t stream) {
    static int grid = 0;
    if (grid == 0) {
        if (n_in != 36 || out_size != NLAT * DM || ws_size < WS_END) { fprintf(stderr, "kernel_launch: unexpected shapes (n_in %d out %d ws %zu need %zu)\n", n_in, out_size, ws_size, (size_t)WS_END); grid = -1; return; }
        int dev = 0, cus = 0, per_cu = 0;
        if (hipGetDevice(&dev) != hipSuccess || hipDeviceGetAttribute(&cus, hipDeviceAttributeMultiprocessorCount, dev) != hipSuccess) { grid = -1; return; }
        if (hipFuncSetAttribute((const void*)mk_fwd, hipFuncAttributeMaxDynamicSharedMemorySize, LDS_BYTES) != hipSuccess) { fprintf(stderr, "kernel_launch: hipFuncSetAttribute failed\n"); grid = -1; return; }
        if (hipOccupancyMaxActiveBlocksPerMultiprocessor(&per_cu, (const void*)mk_fwd, NTHR, LDS_BYTES) != hipSuccess || per_cu < 1) { fprintf(stderr, "kernel_launch: occupancy query says %d\n", per_cu); }
        (void)hipGetLastError();
        grid = cus;
    }
    if (grid < 0) return;
    (void)hipMemsetAsync((char*)d_ws + WS_CTL, 0, CTL_BYTES, stream);
    Args a{};
    for (int i = 0; i < 36; ++i) a.in[i] = (const float*)d_in[i];
    a.out = (float*)d_out; a.ws = (unsigned char*)d_ws;
#if MK_MULTI
    for (int p = 0; p < NPHASE; ++p) { a.ph_lo = p; a.ph_hi = p + 1; hipLaunchKernelGGL(mk_fwd, dim3(grid), dim3(NTHR), LDS_BYTES, stream, a); }
#else
    a.ph_lo = 0; a.ph_hi = NPHASE; hipLaunchKernelGGL(mk_fwd, dim3(grid), dim3(NTHR), LDS_BYTES, stream, a);
#endif
}
```

```cpp
#include <hip/hip_runtime.h>
#include <cstdio>
#include <cstdint>

#define LAS __attribute__((address_space(3)))
#define GAS __attribute__((address_space(1)))
typedef unsigned short bf16_t;
typedef short bf16x8 __attribute__((ext_vector_type(8)));
typedef float f32x4 __attribute__((ext_vector_type(4)));
typedef float f32x2 __attribute__((ext_vector_type(2)));
typedef unsigned u32x4 __attribute__((ext_vector_type(4)));
typedef unsigned u32x2 __attribute__((ext_vector_type(2)));

constexpr int NB = 16, SEQ = 4096, CTXL = 256, DM = 1024, DEPTH = 4;
constexpr int NLAT = NB * SEQ;
constexpr int NCTX = NB * CTXL;
constexpr int NROW = NLAT + NCTX;
constexpr int SPB = SEQ + CTXL;
constexpr int DIN_REF = 3104;
constexpr int DIN = 3328;
constexpr int UQ = 0, UK = 512, UV = 1024, UGQ = 1536, UGK = 1664, UGV = 1792, UGR = 2048, UHY = 2304, ULAF = 3072, ULAB = 3200;
constexpr int NEXP = 128, TOPK = 8, EH = 256;
constexpr int NE1 = NEXP + 1;
constexpr int RMAX = 659712;
constexpr int TMAX = RMAX / 256;
constexpr float LN_EPS = 1e-6f;
constexpr float DN_ALPHA = 1.6817928305074290f;

__device__ __forceinline__ unsigned f2bf(float f) { unsigned u = __builtin_bit_cast(unsigned, f); return (u + 0x7fffu + ((u >> 16) & 1u)) >> 16; }
typedef __bf16 bf16v2 __attribute__((ext_vector_type(2)));
__device__ __forceinline__ unsigned pk2(float lo, float hi) { const f32x2 v = {lo, hi}; const bf16v2 b = __builtin_convertvector(v, bf16v2); return __builtin_bit_cast(unsigned, b); }
__device__ __forceinline__ float bf2f(unsigned short b) { return __builtin_bit_cast(float, ((unsigned)b) << 16); }
__device__ __forceinline__ float bflo(unsigned w) { return __builtin_bit_cast(float, w << 16); }
__device__ __forceinline__ float bfhi(unsigned w) { return __builtin_bit_cast(float, w & 0xffff0000u); }
__device__ __forceinline__ float shx(float v, int o, int lane) { return __builtin_bit_cast(float, __builtin_amdgcn_ds_bpermute((lane ^ o) << 2, __builtin_bit_cast(int, v))); }
__device__ __forceinline__ int shxi(int v, int o, int lane) { return __builtin_amdgcn_ds_bpermute((lane ^ o) << 2, v); }
__device__ __forceinline__ float shf(float v, int src) { return __builtin_bit_cast(float, __builtin_amdgcn_ds_bpermute(src << 2, __builtin_bit_cast(int, v))); }
__device__ __forceinline__ float wave_sum(float v, int lane) {
#pragma unroll
    for (int o = 1; o < 64; o <<= 1) v += shx(v, o, lane);
    return v;
}
__device__ __forceinline__ void unpack8(const u32x4 q, float* o) { o[0] = bflo(q.x); o[1] = bfhi(q.x); o[2] = bflo(q.y); o[3] = bfhi(q.y); o[4] = bflo(q.z); o[5] = bfhi(q.z); o[6] = bflo(q.w); o[7] = bfhi(q.w); }
__device__ __forceinline__ float silu_f(float x) { return x * __builtin_amdgcn_rcpf(1.0f + __expf(-x)); }
#define LDS_WAIT() asm volatile("s_waitcnt lgkmcnt(0)" ::: "memory")
#define VM_WAIT() asm volatile("s_waitcnt vmcnt(0)" ::: "memory")

#define XB_TMO      128
#define XB_XCNT(j)  (256  + 64 * (j))
#define XB_XSUB(j)  (1280 + 64 * (j))
#define XB_XGEN(j)  (2304 + 64 * (j))
#define XB_TOP      3328
#define XB_TOPGEN   3392
#define XCD_BAR_WORDS 3456
#define XB_SPIN_CAP (1u << 18)

__device__ __forceinline__ unsigned xb_ld(unsigned* p)              { return __hip_atomic_load(p, __ATOMIC_RELAXED, __HIP_MEMORY_SCOPE_AGENT); }
__device__ __forceinline__ unsigned xb_add(unsigned* p, unsigned v) { return __hip_atomic_fetch_add(p, v, __ATOMIC_RELAXED, __HIP_MEMORY_SCOPE_AGENT); }
__device__ __forceinline__ unsigned xb_xcc_id() { return (unsigned)__builtin_amdgcn_s_getreg((3 << 11) | 20) & 0xFu; }
#define XB_SPIN(cond, bar) do { unsigned _sp = 0; while (cond) { __builtin_amdgcn_s_sleep(1); \
    if ((++_sp & 255u) == 0u) { if (xb_ld(&(bar)[XB_TMO])) break; if (_sp > XB_SPIN_CAP) { atomicAdd(&(bar)[XB_TMO], 1u); break; } } } } while (0)

struct XcdBarrier { unsigned* bar; unsigned x; volatile LAS unsigned* st; };

__device__ __forceinline__ XcdBarrier xcd_barrier_post(unsigned* bar, volatile LAS unsigned* st) {
    XcdBarrier b; b.bar = bar; b.x = xb_xcc_id(); b.st = st;
    if (threadIdx.x == 0) (void)xb_add(&bar[XB_XCNT(b.x)], 1u);
    return b;
}
__device__ __forceinline__ void xcd_barrier_complete(unsigned* bar, unsigned x, unsigned& nloc, unsigned& nx) {
    const unsigned G = gridDim.x * gridDim.y * gridDim.z;
    unsigned sum, cnt, mine, sp = 0u;
    for (;;) {
        sum = 0u; cnt = 0u; mine = 0u;
#pragma unroll
        for (unsigned j = 0; j < 16; ++j) { const unsigned c = xb_ld(&bar[XB_XCNT(j)]); sum += c; cnt += (c > 0u) ? 1u : 0u; mine = (j == x) ? c : mine; }
        if (sum == G) break;
        __builtin_amdgcn_s_sleep(1);
        if ((++sp & 255u) == 0u) { if (xb_ld(&bar[XB_TMO])) break; if (sp > XB_SPIN_CAP) { atomicAdd(&bar[XB_TMO], 1u); break; } }
    }
    nloc = mine > 0u ? mine : 1u; nx = cnt > 0u ? cnt : 1u;
}
__device__ __forceinline__ void xcd_barrier(const XcdBarrier& b) {
    asm volatile("s_waitcnt vmcnt(0)" ::: "memory");
    __syncthreads();
    if (threadIdx.x == 0) {
        unsigned* bar = b.bar;
        __builtin_amdgcn_s_waitcnt(0);
        unsigned nloc = b.st[0], nx = b.st[1];
        if (nloc == 0u) { xcd_barrier_complete(bar, b.x, nloc, nx); b.st[0] = nloc; b.st[1] = nx; }
        const unsigned old = xb_add(&bar[XB_XSUB(b.x)], 1u);
        const unsigned gen = old / nloc;
        if (old + 1u == (gen + 1u) * nloc) {
            __builtin_amdgcn_fence(__ATOMIC_RELEASE, "agent");
            asm volatile("s_waitcnt vmcnt(0)" ::: "memory");
            const unsigned og = xb_add(&bar[XB_TOP], 1u);
            const unsigned tg = og / nx;
            if (og + 1u == (tg + 1u) * nx) xb_add(&bar[XB_TOPGEN], 1u);
            else XB_SPIN(xb_ld(&bar[XB_TOPGEN]) == tg, bar);
            __builtin_amdgcn_fence(__ATOMIC_ACQUIRE, "agent");
            xb_add(&bar[XB_XGEN(b.x)], 1u);
            asm volatile("s_waitcnt vmcnt(0)" ::: "memory");
        } else {
            XB_SPIN(xb_ld(&bar[XB_XGEN(b.x)]) == gen, bar);
            __builtin_amdgcn_fence(__ATOMIC_ACQUIRE, "agent");
            asm volatile("s_waitcnt vmcnt(0)" ::: "memory");
        }
    }
    __syncthreads();
}

namespace pg8 {
constexpr int BM = 256, BK = 64, HALF = 128, HTB = HALF * BK * 2, STAGE_BYTES = 8 * HTB, NXCD = 8, WGM = 8;
__host__ __device__ __forceinline__ int lds_byte(int r, int c) { const int st = (r >> 4) * 2 + (c >> 5), rr = r & 15, cc = c & 31, ob = rr * 64 + cc * 2; return st * 1024 + (ob ^ (((ob >> 9) & 1) << 5)); }
__host__ __device__ __forceinline__ void stage_rc(int b, int& R, int& C) { const int st = b / 1024, sb = b % 1024, swz = sb ^ (((sb >> 9) & 1) << 5); R = (st >> 1) * 16 + swz / 64; C = (st & 1) * 32 + (swz % 64) / 2; }
__host__ __device__ __forceinline__ int perm32(int rho) { const int n = rho >> 4, i = rho & 15; return 8 * (i >> 2) + 4 * n + (i & 3); }

struct Unit { int arow0, brow0, orow0, ocol0, aux; };

struct DenseOrder {
    int nM, nN, nwg, G, c;
    __device__ void init(int M, int N, int G_, int c_) { nM = M / BM; nN = N / BM; nwg = nM * nN; G = G_; c = c_; }
    __device__ __forceinline__ bool next(int i, Unit& u) const {
        const long L = (long)i * G + c; if (L >= nwg) return false;
        int wgid = (int)L; { const int q = nwg / NXCD, r = nwg % NXCD, xcd = wgid % NXCD, off = wgid / NXCD; wgid = (xcd < r ? xcd * (q + 1) : r * (q + 1) + (xcd - r) * q) + off; }
        const int nig = WGM * nN, gid = wgid / nig, fm = gid * WGM, gsz = (nM - fm) < WGM ? (nM - fm) : WGM;
        const int pm = fm + ((wgid % nig) % gsz), pn = (wgid % nig) / gsz;
        u.arow0 = pm * BM; u.brow0 = pn * BM; u.orow0 = pm * BM; u.ocol0 = pn * BM; u.aux = 0; return true;
    }
};
struct GroupedOrder {
    const LAS unsigned char* tab; int nN, nslot, slot, t0, t1;
    __device__ __forceinline__ void init(int ntiles, int nN_, int G, int c) {
        nN = nN_;
        if ((G & 7) == 0) { const int per = (ntiles + 7) >> 3, x = c & 7; nslot = G >> 3; slot = c >> 3; t0 = x * per; t1 = (t0 + per) < ntiles ? (t0 + per) : ntiles; }
        else { nslot = G; slot = c; t0 = 0; t1 = ntiles; }
    }
    __device__ __forceinline__ void preload(const int* tile_exp, LAS unsigned char* lds_tab, int tid, int nthr) {
        __syncthreads();
        for (int i = tid; i < t1 - t0; i += nthr) lds_tab[i] = (unsigned char)tile_exp[t0 + i];
        __syncthreads();
        tab = lds_tab;
    }
    __device__ __forceinline__ bool next(int i, Unit& u) const {
        const int q = i * nslot + slot, t = t0 + q / nN, pn = q % nN;
        if (t >= t1) return false;
        const int e = (int)tab[t - t0];
        u.arow0 = t * BM; u.brow0 = (e * nN + pn) * BM; u.orow0 = t * BM; u.ocol0 = pn * BM; u.aux = e; return true;
    }
};

template <class Base> struct RangeOrder {
    Base b; int i0, i1;
    __device__ __forceinline__ bool next(int i, Unit& u) const { const int j = i + i0; if (j >= i1) return false; return b.next(j, u); }
};

__device__ __forceinline__ unsigned cvt_pk_bf16(float lo, float hi) { return pk2(lo, hi); }

struct NoPre {};
struct EpiF32 {
    static constexpr bool PERM = false; static constexpr int SCW = 0x7A7A7A7A; typedef NoPre Pre;
    __device__ __forceinline__ Pre prefetch(const Unit&, LAS unsigned char*, int, int, int) const { return Pre{}; }
    float* C; int ldc;
    __device__ __forceinline__ void operator()(const f32x4 (&acc)[2][2][4][2], const Unit& u, int wr, int wc, int fr, int fq, const Pre&, bool drain) const {
        if (drain) asm volatile("s_waitcnt vmcnt(0)" ::: "memory");
        const int row0 = u.orow0 + wr * 64 + fr, col0 = u.ocol0 + wc * 32 + 4 * fq;
#pragma unroll
        for (int ai = 0; ai < 2; ++ai)
#pragma unroll
            for (int m = 0; m < 4; ++m) { float* rowp = C + (size_t)(row0 + ai * HALF + m * 16) * ldc + col0;
#pragma unroll
                for (int bj = 0; bj < 2; ++bj)
#pragma unroll
                    for (int n = 0; n < 2; ++n) *(GAS f32x4*)(rowp + bj * HALF + n * 16) = acc[ai][bj][m][n]; }
    }
};
struct EpiF32H {
    static constexpr bool PERM = false; static constexpr int SCW = 0x7A7A7A7A; typedef NoPre Pre;
    __device__ __forceinline__ Pre prefetch(const Unit&, LAS unsigned char*, int, int, int) const { return Pre{}; }
    float* C; int ldc;
    __device__ __forceinline__ void operator()(const f32x4 (&acc)[2][2][4][2], const Unit& u, int wr, int wc, int fr, int fq, const Pre&, bool drain) const {
        if (drain) asm volatile("s_waitcnt vmcnt(0)" ::: "memory");
        const int row0 = u.orow0 + wr * 64 + fr, col0 = wc * 32 + 4 * fq;
#pragma unroll
        for (int ai = 0; ai < 2; ++ai)
#pragma unroll
            for (int m = 0; m < 4; ++m) { float* rowp = C + (size_t)(row0 + ai * HALF + m * 16) * ldc + col0;
#pragma unroll
                for (int n = 0; n < 2; ++n) *(GAS f32x4*)(rowp + n * 16) = acc[ai][0][m][n]; }
    }
};
struct EpiBf16 {
    static constexpr bool PERM = true; static constexpr int SCW = 0x7A7A7A7A; typedef NoPre Pre;
    __device__ __forceinline__ Pre prefetch(const Unit&, LAS unsigned char*, int, int, int) const { return Pre{}; }
    bf16_t* O; int ldc;
    __device__ __forceinline__ void operator()(const f32x4 (&acc)[2][2][4][2], const Unit& u, int wr, int wc, int fr, int fq, const Pre&, bool drain) const {
        const int row0 = u.orow0 + wr * 64 + fr, col0 = u.ocol0 + wc * 32 + 8 * fq;
        u32x4 w[2][4][2];
#pragma unroll
        for (int ai = 0; ai < 2; ++ai)
#pragma unroll
            for (int m = 0; m < 4; ++m)
#pragma unroll
                for (int bj = 0; bj < 2; ++bj) { const f32x4 v0 = acc[ai][bj][m][0], v1 = acc[ai][bj][m][1];
                    w[ai][m][bj].x = cvt_pk_bf16(v0[0], v0[1]); w[ai][m][bj].y = cvt_pk_bf16(v0[2], v0[3]); w[ai][m][bj].z = cvt_pk_bf16(v1[0], v1[1]); w[ai][m][bj].w = cvt_pk_bf16(v1[2], v1[3]); }
        if (drain) asm volatile("s_waitcnt vmcnt(0)" ::: "memory");
#pragma unroll
        for (int ai = 0; ai < 2; ++ai)
#pragma unroll
            for (int m = 0; m < 4; ++m) { bf16_t* rowp = O + (size_t)(row0 + ai * HALF + m * 16) * ldc + col0;
#pragma unroll
                for (int bj = 0; bj < 2; ++bj) *(GAS u32x4*)(rowp + bj * HALF) = w[ai][m][bj]; }
    }
};
struct EpiSwiglu {
    static constexpr bool PERM = true; static constexpr int SCW = 0x7A7A7A7A; typedef NoPre Pre;
    __device__ __forceinline__ Pre prefetch(const Unit&, LAS unsigned char*, int, int, int) const { return Pre{}; }
    unsigned char* ACT;
    __device__ __forceinline__ void operator()(const f32x4 (&acc)[2][2][4][2], const Unit& u, int wr, int wc, int fr, int fq, const Pre&, bool drain) const {
        const int row0 = u.orow0 + wr * 64 + fr, pn = u.ocol0 >> 8;
        u32x2 o[2][4];
#pragma unroll
        for (int ai = 0; ai < 2; ++ai)
#pragma unroll
            for (int m = 0; m < 4; ++m) {
                int w[2];
#pragma unroll
                for (int n = 0; n < 2; ++n) { const f32x4 g = acc[ai][0][m][n], up = acc[ai][1][m][n];
                    f32x4 e;
#pragma unroll
                    for (int i = 0; i < 4; ++i) e[i] = __builtin_amdgcn_exp2f(-g[i]);
                    const f32x4 d = e + 1.0f; f32x4 r;
#pragma unroll
                    for (int i = 0; i < 4; ++i) r[i] = __builtin_amdgcn_rcpf(d[i]);
                    const f32x4 h = (g * up) * r;
                    int v = 0; v = __builtin_amdgcn_cvt_pk_fp8_f32(h[0], h[1], v, false); v = __builtin_amdgcn_cvt_pk_fp8_f32(h[2], h[3], v, true); w[n] = v; }
                o[ai][m] = (u32x2){(unsigned)w[0], (unsigned)w[1]}; }
        if (drain) asm volatile("s_waitcnt vmcnt(0)" ::: "memory");
#pragma unroll
        for (int ai = 0; ai < 2; ++ai)
#pragma unroll
            for (int m = 0; m < 4; ++m) *(GAS u32x2*)(ACT + (size_t)(row0 + ai * HALF + m * 16) * EH + pn * 128 + wc * 32 + 8 * fq) = o[ai][m];
    }
};
constexpr float Y2_SCALE = 16.0f, Y2_INV = 1.0f / 16.0f;
struct EpiScatter {
    static constexpr bool PERM = true; static constexpr int SCW = 0x7E7E7E7E;
    struct Pre { const LAS int* tab; };
    unsigned char* Y2; const int* rowdst;
    __device__ __forceinline__ Pre prefetch(const Unit& u, LAS unsigned char* lds, int wid, int lane, int ui) const {
        LAS unsigned char* tab = lds + STAGE_BYTES + (ui & 1) * 1024;
        if (wid < 4) __builtin_amdgcn_global_load_lds((const unsigned*)(rowdst + u.orow0 + wid * 64 + lane), (LAS unsigned*)(tab + wid * 256), 4, 0, 0);
        Pre p; p.tab = (const LAS int*)tab; return p; }
    __device__ __forceinline__ void operator()(const f32x4 (&acc)[2][2][4][2], const Unit& u, int wr, int wc, int fr, int fq, const Pre& pre, bool drain) const {
        u32x4 o[2][4]; int dst[2][4];
#pragma unroll
        for (int ai = 0; ai < 2; ++ai)
#pragma unroll
            for (int m = 0; m < 4; ++m) { dst[ai][m] = pre.tab[wr * 64 + fr + ai * HALF + m * 16];
                int w[4];
#pragma unroll
                for (int bj = 0; bj < 2; ++bj) { const f32x4 v0 = acc[ai][bj][m][0], v1 = acc[ai][bj][m][1];
                    int w0 = 0, w1 = 0;
                    w0 = __builtin_amdgcn_cvt_pk_fp8_f32(v0[0], v0[1], w0, false); w0 = __builtin_amdgcn_cvt_pk_fp8_f32(v0[2], v0[3], w0, true);
                    w1 = __builtin_amdgcn_cvt_pk_fp8_f32(v1[0], v1[1], w1, false); w1 = __builtin_amdgcn_cvt_pk_fp8_f32(v1[2], v1[3], w1, true);
                    w[2 * bj] = w0; w[2 * bj + 1] = w1; }
                o[ai][m] = (u32x4){(unsigned)w[0], (unsigned)w[1], (unsigned)w[2], (unsigned)w[3]}; }
        if (drain) asm volatile("s_waitcnt vmcnt(0)" ::: "memory");
#pragma unroll
        for (int ai = 0; ai < 2; ++ai)
#pragma unroll
            for (int m = 0; m < 4; ++m)
                if (dst[ai][m] >= 0) *(GAS u32x4*)(Y2 + (size_t)dst[ai][m] * DM + u.ocol0 + wc * 64 + fq * 16) = o[ai][m];
    }
};

typedef int v8i __attribute__((ext_vector_type(8)));
typedef int v4i __attribute__((ext_vector_type(4)));
struct Frag { bf16x8 p[2]; __device__ __forceinline__ bf16x8& operator[](int k) { return p[k]; } __device__ __forceinline__ const bf16x8& operator[](int k) const { return p[k]; } };
template <class Epi, class Sched, bool GATHER, bool F8 = false, bool ALIGN_EPI = true, bool SP2 = true, bool NHALF = false>
__device__ __forceinline__ void gemm_phase(const int tid_in, LAS unsigned char* lds, const void* Ag, const void* Bg, const int K, const int* rowidx, const Sched& S, const Epi& E) {
    int tid_ = tid_in; asm volatile("" : "+v"(tid_));
    const int tid = tid_, wid = __builtin_amdgcn_readfirstlane(tid >> 6), lane = tid & 63, wr = wid >> 2, wc = wid & 3, fr = lane & 15, fq = lane >> 4;
    const int KB = F8 ? K : 2 * K;
    const int nt = KB / 128;
    unsigned voffB[2];
#pragma unroll
    for (int i = 0; i < 2; ++i) { int R, C; stage_rc(tid * 16 + i * 8192, R, C); const int Rb = Epi::PERM ? ((R & ~31) + perm32(R & 31)) : R;
        voffB[i] = (unsigned)(Rb * KB + C * 2); }
    const size_t kstep = (size_t)128;
    const size_t hstep = (size_t)HALF * KB;
    const unsigned ldsw = (unsigned)wid * 1024u;
    const int aoff = F8 ? lds_byte(wr * 64 + fr, 16 * fq) : lds_byte(wr * 64 + fr, fq * 8), boff = F8 ? lds_byte(wc * 32 + fr, 16 * fq) : lds_byte(wc * 32 + fr, fq * 8);
    constexpr int PIECE1 = F8 ? 16 : 1024;
    const int sc_w = Epi::SCW, sc_a = 0x7F7F7F7F;
#define PG8_SA(b, h) (((b) * 2 + (h)) * HTB)
#define PG8_SB(b, h) ((4 + (b) * 2 + (h)) * HTB)
#define PG8_STAGE_B(bufoff, gbase) do { _Pragma("unroll") for (int _i = 0; _i < 2; ++_i) \
        __builtin_amdgcn_global_load_lds((const unsigned*)((const char*)(gbase) + voffB[_i]), (LAS unsigned*)(lds + (bufoff) + ldsw + _i * 8192), 16, 0, 0); } while (0)
#define PG8_STAGE_A(bufoff, gbase, h) do { const char* _gb = (const char*)(gbase) + (GATHER ? (size_t)0 : (size_t)(h) * hstep); \
        __builtin_amdgcn_global_load_lds((const unsigned*)(_gb + ac[GATHER ? (h) : 0][0]), (LAS unsigned*)(lds + (bufoff) + ldsw), 16, 0, 0); \
        __builtin_amdgcn_global_load_lds((const unsigned*)(_gb + ac[GATHER ? (h) : 0][1]), (LAS unsigned*)(lds + (bufoff) + ldsw + 8192), 16, 0, 0); } while (0)
#define PG8_LDA(dst, b, h) do { _Pragma("unroll") for (int m = 0; m < 4; ++m) { if constexpr (F8) { const v4i _l = *(const LAS v4i*)(lds + PG8_SA(b, h) + aoff + m * 2048), _h = *(const LAS v4i*)(lds + PG8_SA(b, h) + aoff + m * 2048 + PIECE1); dst##8[m] = __builtin_shufflevector(_l, _h, 0, 1, 2, 3, 4, 5, 6, 7); } \
        else { dst[m][0] = *(const LAS bf16x8*)(lds + PG8_SA(b, h) + aoff + m * 2048); dst[m][1] = *(const LAS bf16x8*)(lds + PG8_SA(b, h) + aoff + m * 2048 + PIECE1); } } } while (0)
#define PG8_LDB(dst, b, h) do { _Pragma("unroll") for (int n = 0; n < 2; ++n) { if constexpr (F8) { const v4i _l = *(const LAS v4i*)(lds + PG8_SB(b, h) + boff + n * 2048), _h = *(const LAS v4i*)(lds + PG8_SB(b, h) + boff + n * 2048 + PIECE1); dst##8[n] = __builtin_shufflevector(_l, _h, 0, 1, 2, 3, 4, 5, 6, 7); } \
        else { dst[n][0] = *(const LAS bf16x8*)(lds + PG8_SB(b, h) + boff + n * 2048); dst[n][1] = *(const LAS bf16x8*)(lds + PG8_SB(b, h) + boff + n * 2048 + PIECE1); } } } while (0)
#define PG8_MMA(ai, bj, At, Bt) do { __builtin_amdgcn_s_setprio(1); _Pragma("unroll") for (int m = 0; m < 4; ++m) _Pragma("unroll") for (int n = 0; n < 2; ++n) { \
        if constexpr (F8) asm volatile("v_mfma_scale_f32_16x16x128_f8f6f4 %0, %1, %2, %0, %3, %4 op_sel_hi:[0,0,0]" : "+v"(acc[ai][bj][m][n]) : "v"(Bt##8[n]), "v"(At##8[m]), "v"(sc_w), "v"(sc_a)); \
        else { _Pragma("unroll") for (int k = 0; k < 2; ++k) acc[ai][bj][m][n] = __builtin_amdgcn_mfma_f32_16x16x32_bf16(Bt[n][k], At[m][k], acc[ai][bj][m][n], 0, 0, 0); } } \
        __builtin_amdgcn_s_setprio(0); } while (0)
#define PG8_WAIT_V(n) asm volatile("s_waitcnt vmcnt(" #n ")" ::: "memory")
#define PG8_WAIT_LOOP do { if constexpr (NHALF) PG8_WAIT_V(6); else PG8_WAIT_V(8); } while (0)
#define PG8_WAIT_L(n) asm volatile("s_waitcnt lgkmcnt(" #n ")" ::: "memory")
#define PG8_BAR __builtin_amdgcn_s_barrier()
#define PG8_SCHED __builtin_amdgcn_sched_barrier(0)
#define PG8_TAB(par) (lds + STAGE_BYTES + 2048 + (par) * 1024)
#define PG8_TABLOAD(par, row0) do { if (wid < 4) __builtin_amdgcn_global_load_lds((const unsigned*)(rowidx + (row0) + wid * 64 + lane), (LAS unsigned*)(PG8_TAB(par) + wid * 256), 4, 0, 0); } while (0)
#define PG8_AOFF_H(h, par) do { int _tz = tid; asm volatile("" : "+v"(_tz)); _Pragma("unroll") for (int _i = 0; _i < 2; ++_i) { int _R, _C; stage_rc(_tz * 16 + _i * 8192, _R, _C); \
        if (GATHER) ac[h][_i] = ((const LAS unsigned*)PG8_TAB(par))[(h) * HALF + _R] * (unsigned)KB + (unsigned)_C * 2u; \
        else ac[h][_i] = (unsigned)(((h) * HALF + _R) * KB) + (unsigned)_C * 2u; } } while (0)
    static_assert(SP2, "only the two-super-phase K-loop is kept");
    Unit cur, nxt; int ui = 0;
    if (!S.next(0, cur)) return;
    f32x4 acc[2][2][4][2];
#pragma unroll
    for (int a = 0; a < 2; ++a)
#pragma unroll
        for (int b = 0; b < 2; ++b)
#pragma unroll
            for (int m = 0; m < 4; ++m)
#pragma unroll
                for (int n = 0; n < 2; ++n) acc[a][b][m][n] = (f32x4){0.f, 0.f, 0.f, 0.f};
    bf16x8 At[F8 ? 1 : 4][2], B0[F8 ? 1 : 2][2], B1[F8 ? 1 : 2][2];
    v8i At8[F8 ? 4 : 1], B08[F8 ? 2 : 1], B18[F8 ? 2 : 1];
    unsigned ac[GATHER ? 2 : 1][2];
    if (GATHER) { PG8_TABLOAD(0, cur.arow0); PG8_WAIT_V(0); PG8_BAR; }
    PG8_AOFF_H(0, 0); if (GATHER) { PG8_AOFF_H((GATHER ? 1 : 0), 0); }
    const char* cA = (const char*)Ag + (GATHER ? (size_t)0 : (size_t)cur.arow0 * KB); const char* cB = (const char*)Bg + (size_t)cur.brow0 * KB;
    PG8_STAGE_B(PG8_SB(0, 0), cB); if constexpr (!NHALF) PG8_STAGE_B(PG8_SB(0, 1), cB + hstep); PG8_STAGE_A(PG8_SA(0, 0), cA, 0); PG8_STAGE_A(PG8_SA(0, 1), cA, 1);
    if (wr == 1) PG8_BAR;
    PG8_WAIT_V(2); PG8_BAR;
    PG8_STAGE_B(PG8_SB(1, 0), cB + kstep); PG8_STAGE_A(PG8_SA(1, 0), cA + kstep, 0); if constexpr (!NHALF) PG8_STAGE_B(PG8_SB(1, 1), cB + hstep + kstep);
    if constexpr (NHALF) PG8_WAIT_V(4); else PG8_WAIT_V(6);
    PG8_BAR;
    for (;;) {
        const typename Epi::Pre pre = E.prefetch(cur, lds, wid, lane, ui);
        const bool has_next = S.next(ui + 1, nxt);
        if (GATHER) { if (has_next) PG8_TABLOAD((ui + 1) & 1, nxt.arow0); }
        const char* nA = has_next ? ((const char*)Ag + (GATHER ? (size_t)0 : (size_t)nxt.arow0 * KB)) : cA; const char* nB = has_next ? (const char*)Bg + (size_t)nxt.brow0 * KB : cB;
_Pragma("nounroll")
        for (int t = 0; t < nt; t += 2) {
            const bool last = (t == nt - 2);
            const bool skipw = (t == 0) && (ui > 0);
            const char* a1 = cA + (size_t)(t + 1) * kstep;
            const char* a2 = last ? nA : cA + (size_t)(t + 2) * kstep; const char* b2 = last ? nB : cB + (size_t)(t + 2) * kstep;
            const char* a3 = a2 + kstep; const char* b3 = b2 + kstep;
            if (GATHER) { if (last && has_next) { PG8_AOFF_H(0, (ui + 1) & 1); } }
            PG8_LDB(B0, 0, 0); if constexpr (!NHALF) PG8_LDB(B1, 0, 1); PG8_SCHED; PG8_LDA(At, 0, 0); PG8_STAGE_A(PG8_SA(1, 1), a1, 1);
            if (!skipw) PG8_WAIT_LOOP; PG8_WAIT_L(0); PG8_BAR; PG8_MMA(0, 0, At, B0); if constexpr (!NHALF) PG8_MMA(0, 1, At, B1); PG8_BAR; PG8_SCHED;
            if (GATHER) { if (last && has_next) { PG8_AOFF_H(1, (ui + 1) & 1); } }
            PG8_LDA(At, 0, 1); PG8_STAGE_B(PG8_SB(0, 0), b2); if constexpr (!NHALF) PG8_STAGE_B(PG8_SB(0, 1), b2 + hstep); PG8_STAGE_A(PG8_SA(0, 0), a2, 0);
            if (!skipw) PG8_WAIT_LOOP; PG8_WAIT_L(0); PG8_BAR; PG8_MMA(1, 0, At, B0); if constexpr (!NHALF) PG8_MMA(1, 1, At, B1); PG8_BAR; PG8_SCHED;
            PG8_LDB(B0, 1, 0); if constexpr (!NHALF) PG8_LDB(B1, 1, 1); PG8_SCHED; PG8_LDA(At, 1, 0); PG8_STAGE_A(PG8_SA(0, 1), a2, 1);
            if (!skipw) PG8_WAIT_LOOP; PG8_WAIT_L(0); PG8_BAR; PG8_MMA(0, 0, At, B0); if constexpr (!NHALF) PG8_MMA(0, 1, At, B1); PG8_BAR; PG8_SCHED;
            PG8_LDA(At, 1, 1); PG8_STAGE_B(PG8_SB(1, 0), b3); if constexpr (!NHALF) PG8_STAGE_B(PG8_SB(1, 1), b3 + hstep); PG8_STAGE_A(PG8_SA(1, 0), a3, 0);
            PG8_WAIT_LOOP; PG8_WAIT_L(0); PG8_BAR; PG8_MMA(1, 0, At, B0); if constexpr (!NHALF) PG8_MMA(1, 1, At, B1); PG8_BAR; PG8_SCHED;
        }
        if constexpr (ALIGN_EPI) { if (wr == 0) PG8_BAR; }
        E(acc, cur, wr, wc, fr, fq, pre, has_next);
        if (!has_next) break;
#pragma unroll
        for (int a = 0; a < 2; ++a)
#pragma unroll
            for (int b = 0; b < 2; ++b)
#pragma unroll
                for (int m = 0; m < 4; ++m)
#pragma unroll
                    for (int n = 0; n < 2; ++n) acc[a][b][m][n] = (f32x4){0.f, 0.f, 0.f, 0.f};
        cur = nxt; cA = nA; cB = nB; ++ui;
        if constexpr (ALIGN_EPI) { if (wr == 1) PG8_BAR; }
    }
    PG8_WAIT_V(0);
    if constexpr (!ALIGN_EPI) { if (wr == 0) PG8_BAR; }
    PG8_BAR;
#undef PG8_SA
#undef PG8_SB
#undef PG8_STAGE_A
#undef PG8_STAGE_B
#undef PG8_LDA
#undef PG8_LDB
#undef PG8_MMA
#undef PG8_WAIT_V
#undef PG8_WAIT_L
#undef PG8_WAIT_LOOP
#undef PG8_BAR
#undef PG8_SCHED
#undef PG8_AOFF_H
#undef PG8_TAB
#undef PG8_TABLOAD
}
}

constexpr int NWAVES = 8, NTHR = 512;
constexpr size_t MiB = 1u << 20;
constexpr size_t WS_CTL = 0, CTL_BYTES = 1 * MiB;
constexpr size_t WS_MOD = 1 * MiB;
constexpr size_t WS_WIN = 3 * MiB;
constexpr size_t WS_WOUT = 29 * MiB;
constexpr size_t WS_WR = 37 * MiB;
constexpr size_t WS_HYF = 39 * MiB;
constexpr size_t WS_HYFC = 71 * MiB;
constexpr size_t WS_XC = 73 * MiB;
constexpr size_t WS_EXP1 = 89 * MiB;
constexpr size_t WS_EXP2 = 218 * MiB;
constexpr size_t WS_XM = 283 * MiB;
constexpr size_t WS_EIDX = 419 * MiB;
constexpr size_t WS_WGT = 422 * MiB;
constexpr size_t WS_RNK = 425 * MiB;
constexpr size_t WS_ROWTOK = 428 * MiB;
constexpr size_t WS_ROWDST = 431 * MiB;
constexpr size_t WS_TILEEXP = 434 * MiB;
constexpr size_t WS_BIG = 435 * MiB;
constexpr size_t WS_U = WS_BIG;
constexpr size_t WS_MIX = 877 * MiB;
constexpr size_t WS_VT = 1013 * MiB;
constexpr size_t WS_HV = 1081 * MiB;
constexpr size_t WS_Z2 = 1183 * MiB;
constexpr size_t WS_GDS = 1217 * MiB;
constexpr size_t WS_GSIN = 1285 * MiB;
constexpr size_t WS_GD = 1319 * MiB;
constexpr size_t WS_Y = 1321 * MiB;
constexpr size_t WS_LOGIT = WS_BIG;
constexpr size_t WS_ACT = WS_BIG;
constexpr size_t WS_Y2 = 758 * MiB;
constexpr size_t WS_XM8 = 1470 * MiB;
constexpr size_t WS_XR = 1600 * MiB;
constexpr size_t WS_END = 1736 * MiB;
constexpr int CW_BAR = 4096;
constexpr int CW_CNT = 16384;
constexpr int CW_NTL = 20480;

constexpr int LDS_BYTES = 163840;
constexpr int MISC_OFF = 163584;

struct Frame {
    LAS unsigned char* lds;
    int tid, lane, wave, G, wg;
    const float* const* in;
    float* out; unsigned char* ws; unsigned* ctl;
};
enum { I_X = 0, I_C, I_CTX, I_CCTX, I_WMOD, I_BMOD, I_WIN, I_RPB, I_WA2, I_BA2, I_GNORM, I_HSW, I_HSB, I_HW1, I_HB1, I_HF1, I_HW2, I_HB2, I_HF2, I_HW3, I_HB3, I_HDEC, I_HSKIP,
       I_WOUT, I_LN1G, I_LN1B, I_RW, I_RB, I_WEG, I_WEU, I_WED, I_WSG, I_WSU, I_WSD, I_LN2G, I_LN2B };

__device__ __forceinline__ int row_b(int row) { return row < NLAT ? (row >> 12) : 16; }
__device__ __forceinline__ const float* mod_ptr(const Frame& F, int l, int row) { return (const float*)(F.ws + WS_MOD) + ((size_t)l * 17 + row_b(row)) * 6144; }

constexpr float NA_QSCALE = 0.125f * 1.4426950408889634f, NA_CLAMP = 60.0f * 1.4426950408889634f;
template <class RowFn>
__device__ __forceinline__ void tr_item(const float* W, int ldw, int k0, int n0, bf16_t* dst, int ldd, RowFn rf, LAS float* scr, int lane, float scale = 1.0f) {
    float tv[32];
    const GAS float* wp = (const GAS float*)(W + (size_t)(k0 + (lane >> 5)) * ldw + n0 + (lane & 31));
#pragma unroll
    for (int i = 0; i < 32; ++i) tv[i] = wp[(size_t)(2 * i) * ldw];
#pragma unroll
    for (int i = 0; i < 32; ++i) scr[(2 * i + (lane >> 5)) * 33 + (lane & 31)] = tv[i];
    LDS_WAIT(); asm volatile("" ::: "memory");
    const int c = lane & 7;
#pragma unroll
    for (int j = 0; j < 4; ++j) { const int n = (lane >> 3) + 8 * j; const LAS float* s = scr + (8 * c) * 33 + n;
        u32x4 o; o.x = pk2(s[0 * 33] * scale, s[1 * 33] * scale); o.y = pk2(s[2 * 33] * scale, s[3 * 33] * scale); o.z = pk2(s[4 * 33] * scale, s[5 * 33] * scale); o.w = pk2(s[6 * 33] * scale, s[7 * 33] * scale);
        *(GAS u32x4*)(dst + (size_t)rf(n0 + n) * ldd + k0 + 8 * c) = o; }
    LDS_WAIT(); asm volatile("" ::: "memory");
}
template <class RowFn>
__device__ __forceinline__ void tr_item8(const float* W, int ldw, int k0, int n0, unsigned char* dst, int ldd, RowFn rf, float scale, LAS float* scr, int lane) {
    float tv[32];
    const GAS float* wp = (const GAS float*)(W + (size_t)(k0 + (lane >> 5)) * ldw + n0 + (lane & 31));
#pragma unroll
    for (int i = 0; i < 32; ++i) tv[i] = wp[(size_t)(2 * i) * ldw];
#pragma unroll
    for (int i = 0; i < 32; ++i) scr[(2 * i + (lane >> 5)) * 33 + (lane & 31)] = tv[i];
    LDS_WAIT(); asm volatile("" ::: "memory");
    const int n = lane >> 1, hf = lane & 1; const LAS float* s = scr + (32 * hf) * 33 + n;
    unsigned w[8];
#pragma unroll
    for (int j = 0; j < 8; ++j) { int v = 0; v = __builtin_amdgcn_cvt_pk_fp8_f32(s[(4 * j) * 33] * scale, s[(4 * j + 1) * 33] * scale, v, false); v = __builtin_amdgcn_cvt_pk_fp8_f32(s[(4 * j + 2) * 33] * scale, s[(4 * j + 3) * 33] * scale, v, true); w[j] = (unsigned)v; }
    unsigned char* d = dst + (size_t)rf(n0 + n) * ldd + k0 + 32 * hf;
    *(GAS u32x4*)d = (u32x4){w[0], w[1], w[2], w[3]}; *(GAS u32x4*)(d + 16) = (u32x4){w[4], w[5], w[6], w[7]};
    LDS_WAIT(); asm volatile("" ::: "memory");
}
struct RowId { __device__ __forceinline__ int operator()(int n) const { return n; } };
struct RowWin { __device__ __forceinline__ int operator()(int n) const { return n >= 2336 ? n - 32 : n; } };
struct RowGU { int up; __device__ __forceinline__ int operator()(int j) const { return (j >> 7) * 256 + up * 128 + (j & 127); } };

__device__ __forceinline__ void p0_static_weights(Frame& F) {
    LAS float* scr = (LAS float*)(F.lds + F.wave * 16384);
    const int gw = F.wg * NWAVES + F.wave, NGW = F.G * NWAVES;
    constexpr int I_IN = 16 * 97, I_OUT = 16 * 32, I_R = 16 * 4, PER_L = I_IN + I_OUT + I_R;
    for (int it = gw; it < DEPTH * PER_L; it += NGW) {
        const int l = it / PER_L; int r = it % PER_L;
        if (r < I_IN) { const int kb = r / 97, nb = r % 97; if (nb == 72) continue;
            tr_item(F.in[I_WIN] + (size_t)l * DM * DIN_REF, DIN_REF, kb * 64, nb * 32, (bf16_t*)(F.ws + WS_WIN) + (size_t)l * DIN * DM, DM, RowWin{}, scr, F.lane, nb < 16 ? NA_QSCALE : 1.0f); continue; }
        r -= I_IN;
        if (r < I_OUT) { const int kb = r / 32, nb = r % 32;
            tr_item(F.in[I_WOUT] + (size_t)l * DM * DM, DM, kb * 64, nb * 32, (bf16_t*)(F.ws + WS_WOUT) + (size_t)l * DM * DM, DM, RowId{}, scr, F.lane); continue; }
        r -= I_OUT;
        { const int kb = r / 4, nb = r % 4;
            tr_item(F.in[I_RW] + (size_t)l * DM * NEXP, NEXP, kb * 64, nb * 32, (bf16_t*)(F.ws + WS_WR) + (size_t)l * 256 * DM, DM, RowId{}, scr, F.lane); }
    }
    const int gt = F.wg * NTHR + F.tid, NGT = F.G * NTHR;
    for (int i = gt; i < DEPTH * 128 * DM / 8; i += NGT) { const int l = i / (128 * DM / 8), r = i % (128 * DM / 8);
        *(u32x4*)((bf16_t*)(F.ws + WS_WR) + ((size_t)l * 256 + 128) * DM + (size_t)r * 8) = (u32x4){0u, 0u, 0u, 0u}; }
    for (int i = gt; i < DEPTH * 256 * DM; i += NGT) {
        const int k = i % DM, n = (i / DM) % 256, l = i / (DM * 256), dir = n >> 7, j = n & 127;
        const float* wi = F.in[I_WIN] + ((size_t)l * DM + k) * DIN_REF + 2304 + dir * 16;
        const float* wa = F.in[I_WA2] + ((size_t)(l * 2 + dir) * 16) * 128 + j;
        float s = 0.f;
#pragma unroll
        for (int r = 0; r < 16; ++r) s += wi[r] * wa[r * 128];
        ((bf16_t*)(F.ws + WS_WIN))[((size_t)l * DIN + 3072 + n) * DM + k] = (bf16_t)f2bf(s);
    }
}
__device__ __forceinline__ void p0_mod(Frame& F) {
    LAS float* sc = (LAS float*)F.lds;
    LAS float* red = (LAS float*)(F.lds + 17 * 1024 * 4);
    for (int i = F.tid; i < 17 * 1024; i += NTHR) { const int r = i >> 10, k = i & 1023; const float v = r < 16 ? F.in[I_C][r * 1024 + k] : F.in[I_CCTX][k]; sc[i] = silu_f(v); }
    __syncthreads();
    const int kq = F.tid >> 7, cl = F.tid & 127;
    for (int u = F.wg; u < DEPTH * 48; u += F.G) {
        const int l = u / 48, col = (u % 48) * 128 + cl;
        const float* w = F.in[I_WMOD] + (size_t)l * DM * 6144 + col;
        float a[17];
#pragma unroll
        for (int r = 0; r < 17; ++r) a[r] = 0.f;
        for (int k0 = kq * 256; k0 < kq * 256 + 256; k0 += 16) {
            float wv[16];
#pragma unroll
            for (int q = 0; q < 16; ++q) wv[q] = *(const GAS float*)(w + (size_t)(k0 + q) * 6144);
#pragma unroll
            for (int q = 0; q < 16; ++q)
#pragma unroll
                for (int r = 0; r < 17; ++r) a[r] += sc[r * 1024 + k0 + q] * wv[q]; }
#pragma unroll
        for (int r = 0; r < 17; ++r) red[(kq * 17 + r) * 128 + cl] = a[r];
        __syncthreads();
        for (int i = F.tid; i < 17 * 128; i += NTHR) { const int r = i >> 7, c2 = i & 127, cc = (u % 48) * 128 + c2;
            const float s = red[(0 * 17 + r) * 128 + c2] + red[(1 * 17 + r) * 128 + c2] + red[(2 * 17 + r) * 128 + c2] + red[(3 * 17 + r) * 128 + c2] + F.in[I_BMOD][l * 6144 + cc];
            ((float*)(F.ws + WS_MOD))[((size_t)l * 17 + r) * 6144 + cc] = s; }
        __syncthreads();
    }
}
__device__ __forceinline__ void p0_hyena_filters(Frame& F) {
    LAS float* z = (LAS float*)F.lds;
    LAS float* h1 = z + 1092;
    LAS float* h2 = h1 + 33 * 64;
    LAS float* tt = h2 + 33 * 64;
    LAS float* W1 = tt + 64;
    LAS float* W2 = W1 + 33 * 64;
    constexpr int UL = 4096 / 32, UC = 256 / 32, UPL = UL + UC;
    for (int u = F.wg; u < DEPTH * UPL; u += F.G) {
        const int l = u / UPL, r = u % UPL; const bool lat = r < UL; const int L = lat ? 4096 : 256, n0 = (lat ? r : r - UL) * 32;
        __syncthreads();
        for (int i = F.tid; i < 33 * 64; i += NTHR) W1[i] = F.in[I_HW1][(size_t)l * 33 * 64 + i];
        for (int i = F.tid; i < 64 * 64; i += NTHR) W2[i] = F.in[I_HW2][(size_t)l * 64 * 64 + i];
        for (int i = F.tid; i < 33 * 33; i += NTHR) { const int p = i / 33, e = i % 33, n = n0 + p;
            const float t = (float)n / (float)(L - 1);
            float v;
            if (e == 0) v = t;
            else { const int kb = (e - 1) & 15; const float band = 1e-4f + (float)kb * ((15.0f - 1e-4f) / 15.0f);
                   const float w = 6.283185307179586f * (float)n / (float)L; const float ang = w * band;
                   v = e <= 16 ? __cosf(ang) : -__sinf(ang); }
            z[i] = v; if (e == 0) tt[p] = t; }
        __syncthreads();
        for (int i = F.tid; i < 33 * 64; i += NTHR) { const int p = i >> 6, j = i & 63; float s = F.in[I_HB1][l * 64 + j];
#pragma unroll 11
            for (int e = 0; e < 33; ++e) s += z[p * 33 + e] * W1[e * 64 + j];
            h1[i] = __sinf(F.in[I_HF1][l * 64 + j] * s); }
        __syncthreads();
        for (int i = F.tid; i < 33 * 64; i += NTHR) { const int p = i >> 6, j = i & 63; float s = F.in[I_HB2][l * 64 + j];
#pragma unroll 16
            for (int e = 0; e < 64; ++e) s += h1[p * 64 + e] * W2[e * 64 + j];
            h2[i] = __sinf(F.in[I_HF2][l * 64 + j] * s); }
        __syncthreads();
        {
            const int g = F.tid >> 8, col0 = 4 * (F.tid & 255), o = col0 >> 9, dir = (col0 >> 8) & 1, ch0 = col0 & 255;
            const int pb = (dir ? 0 : 1) + 16 * g;
            float a[4][16];
#pragma unroll
            for (int j = 0; j < 4; ++j)
#pragma unroll
                for (int q = 0; q < 16; ++q) a[j][q] = 0.f;
            const float* w3 = F.in[I_HW3] + (size_t)l * 64 * 1024 + col0;
            const LAS float* hp = h2 + pb * 64;
            f32x4 wa[4], wb[4];
#pragma unroll
            for (int q = 0; q < 4; ++q) wa[q] = *(const GAS f32x4*)(w3 + (size_t)q * 1024);
#define HF_BLOCK(wv_, k0_) do { _Pragma("unroll") for (int pi = 0; pi < 16; ++pi) { const f32x4 hv = *(const LAS f32x4*)(hp + pi * 64 + (k0_)); \
                _Pragma("unroll") for (int q = 0; q < 4; ++q) _Pragma("unroll") for (int j = 0; j < 4; ++j) a[j][pi] += hv[q] * wv_[q][j]; } } while (0)
#pragma unroll 1
            for (int k0 = 0; k0 < 64; k0 += 8) {
#pragma unroll
                for (int q = 0; q < 4; ++q) wb[q] = *(const GAS f32x4*)(w3 + (size_t)(k0 + 4 + q) * 1024);
                __builtin_amdgcn_sched_barrier(0);
                HF_BLOCK(wa, k0);
                __builtin_amdgcn_sched_barrier(0);
                { const int kn = k0 + 8 < 64 ? k0 + 8 : k0;
#pragma unroll
                  for (int q = 0; q < 4; ++q) wa[q] = *(const GAS f32x4*)(w3 + (size_t)(kn + q) * 1024); }
                __builtin_amdgcn_sched_barrier(0);
                HF_BLOCK(wb, k0 + 4);
                __builtin_amdgcn_sched_barrier(0);
            }
#undef HF_BLOCK
            const f32x4 b3 = *(const GAS f32x4*)(F.in[I_HB3] + l * 1024 + col0), dc = *(const GAS f32x4*)(F.in[I_HDEC] + ((size_t)(l * 2 + o) * 2 + dir) * 256 + ch0);
            float a0[4] = {0.f, 0.f, 0.f, 0.f};
            if (n0 == 0 && dir == 0 && g == 0) {
                for (int k = 0; k < 64; ++k) { const f32x4 wv = *(const GAS f32x4*)(w3 + (size_t)k * 1024); const float hv = h2[k];
#pragma unroll
                    for (int j = 0; j < 4; ++j) a0[j] += hv * wv[j]; } }
#pragma unroll
            for (int j = 0; j < 4; ++j) {
                const float dec = fabsf(dc[j]);
                bf16_t* R = lat ? (bf16_t*)(F.ws + WS_HYF) + ((size_t)(l * 2 + o) * 256 + ch0 + j) * 8192 : (bf16_t*)(F.ws + WS_HYFC) + ((size_t)(l * 2 + o) * 256 + ch0 + j) * 512;
                float v[16];
#pragma unroll
                for (int pi = 0; pi < 16; ++pi) v[pi] = (a[j][pi] + b3[j]) * __expf(-tt[pb + pi] * dec);
                unsigned w[8];
                if (dir == 0) {
                    if (n0 + 32 == L && g == 1) v[15] = 0.f;
#pragma unroll
                    for (int q = 0; q < 8; ++q) w[q] = pk2(v[15 - 2 * q], v[14 - 2 * q]);
                    GAS u32x4* dst = (GAS u32x4*)(R + (L - n0 - 32) + 16 * (1 - g));
                    dst[0] = (u32x4){w[0], w[1], w[2], w[3]}; dst[1] = (u32x4){w[4], w[5], w[6], w[7]};
                    if (n0 == 0 && g == 0) R[L] = (bf16_t)f2bf((a0[j] + b3[j]) * __expf(-tt[0] * dec) + F.in[I_HSKIP][(l * 2 + o) * 256 + ch0 + j]);
                } else if (n0 > 0 || g == 1) {
#pragma unroll
                    for (int q = 0; q < 8; ++q) w[q] = pk2(v[2 * q], v[2 * q + 1]);
                    GAS u32x4* dst = (GAS u32x4*)(R + (L + n0) + 16 * g);
                    dst[0] = (u32x4){w[0], w[1], w[2], w[3]}; dst[1] = (u32x4){w[4], w[5], w[6], w[7]};
                } else {
#pragma unroll
                    for (int pi = 1; pi < 16; ++pi) R[L + pi] = (bf16_t)f2bf(v[pi]);
                }
            }
        }
    }
    __syncthreads();
}
__device__ __forceinline__ void p0_init_rows(Frame& F) {
    const int gw = F.wg * NWAVES + F.wave, NGW = F.G * NWAVES;
    for (int row = gw; row < NROW; row += NGW) {
        const float* src = row < NLAT ? F.in[I_X] + (size_t)row * DM : F.in[I_CTX] + (size_t)(row - NLAT) * DM;
        const float* md = mod_ptr(F, 0, row);
        bf16_t* xr = (bf16_t*)(F.ws + WS_XR) + (size_t)row * DM; bf16_t* xm = (bf16_t*)(F.ws + WS_XM) + (size_t)row * DM;
#pragma unroll
        for (int j = 0; j < 4; ++j) { const int c = 4 * F.lane + 256 * j;
            const f32x4 v = *(const GAS f32x4*)(src + c), sh = *(const GAS f32x4*)(md + c), sc = *(const GAS f32x4*)(md + 1024 + c);
            *(GAS u32x2*)(xr + c) = (u32x2){pk2(v[0], v[1]), pk2(v[2], v[3])};
            u32x2 w; w.x = pk2(v[0] * (1.f + sc[0]) + sh[0], v[1] * (1.f + sc[1]) + sh[1]); w.y = pk2(v[2] * (1.f + sc[2]) + sh[2], v[3] * (1.f + sc[3]) + sh[3]);
            *(GAS u32x2*)(xm + c) = w; }
    }
}
constexpr float WEXP_SCALE = 32.0f;
__device__ __forceinline__ void p_expert_weights(Frame& F, int l) {
    LAS float* scr = (LAS float*)(F.lds + F.wave * 16384);
    const int gw = F.wg * NWAVES + F.wave, NGW = F.G * NWAVES;
    constexpr int I1 = 16 * 8, I2 = 4 * 32, PER_E = 2 * I1 + I2;
    for (int it = gw; it < NE1 * PER_E; it += NGW) {
        const int e = it / PER_E; int r = it % PER_E;
        unsigned char* d1 = (unsigned char*)(F.ws + WS_EXP1) + (size_t)e * 512 * DM; unsigned char* d2 = (unsigned char*)(F.ws + WS_EXP2) + (size_t)e * DM * EH;
        if (r < 2 * I1) { const int up = r >= I1; if (up) r -= I1; const int kb = r / 8, nb = r % 8;
            const float* src = e < NEXP ? F.in[up ? I_WEU : I_WEG] + ((size_t)l * NEXP + e) * DM * EH : F.in[up ? I_WSU : I_WSG] + (size_t)l * DM * EH;
            tr_item8(src, EH, kb * 64, nb * 32, d1, DM, RowGU{up}, up ? WEXP_SCALE * 0.6931471805599453f : WEXP_SCALE * 1.4426950408889634f, scr, F.lane); }
        else { r -= 2 * I1; const int kb = r / 32, nb = r % 32;
            const float* src = e < NEXP ? F.in[I_WED] + ((size_t)l * NEXP + e) * EH * DM : F.in[I_WSD] + (size_t)l * EH * DM;
            tr_item8(src, DM, kb * 64, nb * 32, d2, EH, RowId{}, WEXP_SCALE, scr, F.lane); }
    }
}

__device__ __forceinline__ f32x4 mfma16(bf16x8 a, bf16x8 b, f32x4 c) { return __builtin_amdgcn_mfma_f32_16x16x32_bf16(a, b, c, 0, 0, 0); }

__device__ __forceinline__ void ph_transposes(Frame& F, int l) {
    LAS bf16_t* tile = (LAS bf16_t*)(F.lds + F.wave * 16384);
    const bf16_t* U = (const bf16_t*)(F.ws + WS_U);
    const int gw = F.wg * NWAVES + F.wave, NGW = F.G * NWAVES;
    const int rsub = F.lane >> 3, cseg = F.lane & 7;
    for (int u = gw; u < 1088 * 20; u += NGW) {
        const int tt = u / 20, blk = u % 20;
        int b, s0, Ls, rowbase, posbase;
        if (tt < 1024) { b = tt >> 6; s0 = (tt & 63) * 64; Ls = SEQ; rowbase = b * SEQ; posbase = 0; }
        else { const int t2 = tt - 1024; b = t2 >> 2; s0 = (t2 & 3) * 64; Ls = CTXL; rowbase = NLAT + b * CTXL; posbase = SEQ; }
        if (blk < 12) {
            constexpr int HT = 80;
            float w0[8], w1[8], w2[8], bb[8];
#pragma unroll
            for (int it = 0; it < 8; ++it) { const int col = blk * 64 + rsub + 8 * it; w0[it] = F.in[I_HSW][(l * 3 + 0) * 768 + col]; w1[it] = F.in[I_HSW][(l * 3 + 1) * 768 + col]; w2[it] = F.in[I_HSW][(l * 3 + 2) * 768 + col]; bb[it] = F.in[I_HSB][l * 768 + col]; }
            const bf16_t* p0 = U + (size_t)(rowbase + s0 + rsub) * DIN + UHY + blk * 64 + cseg * 8;
            u32x4 zc[8];
#pragma unroll
            for (int it = 0; it < 8; ++it) zc[it] = *(const GAS u32x4*)(p0 + (size_t)(8 * it) * DIN);
            u32x4 zh = (u32x4){0u, 0u, 0u, 0u};
            if (F.lane < 16) { const int hs = F.lane < 8 ? s0 - 1 : s0 + 64; if (hs >= 0 && hs < Ls) zh = *(const GAS u32x4*)(U + (size_t)(rowbase + hs) * DIN + UHY + blk * 64 + cseg * 8); }
#pragma unroll
            for (int it = 0; it < 8; ++it) { const unsigned a[4] = {zc[it].x, zc[it].y, zc[it].z, zc[it].w}; LAS bf16_t* d = tile + (cseg * 8) * HT + 8 + rsub + 8 * it;
#pragma unroll
                for (int i = 0; i < 4; ++i) { d[(2 * i) * HT] = (bf16_t)(a[i] & 0xffffu); d[(2 * i + 1) * HT] = (bf16_t)(a[i] >> 16); } }
            if (F.lane < 16) { const unsigned a[4] = {zh.x, zh.y, zh.z, zh.w}; LAS bf16_t* d = tile + (cseg * 8) * HT + (F.lane < 8 ? 7 : 72);
#pragma unroll
                for (int i = 0; i < 4; ++i) { d[(2 * i) * HT] = (bf16_t)(a[i] & 0xffffu); d[(2 * i + 1) * HT] = (bf16_t)(a[i] >> 16); } }
            LDS_WAIT(); asm volatile("" ::: "memory");
#pragma unroll
            for (int it = 0; it < 8; ++it) {
                const int ch = rsub + 8 * it; const LAS bf16_t* r = tile + ch * HT + 8 + cseg * 8;
                const u32x4 v = *(const LAS u32x4*)r; const unsigned hm = r[-1], hp = r[8];
                float x[10]; x[0] = __builtin_bit_cast(float, hm << 16); x[9] = __builtin_bit_cast(float, hp << 16);
                x[1] = bflo(v.x); x[2] = bfhi(v.x); x[3] = bflo(v.y); x[4] = bfhi(v.y); x[5] = bflo(v.z); x[6] = bfhi(v.z); x[7] = bflo(v.w); x[8] = bfhi(v.w);
                unsigned w[4];
#pragma unroll
                for (int i = 0; i < 4; ++i) w[i] = pk2(bb[it] + w0[it] * x[2 * i] + w1[it] * x[2 * i + 1] + w2[it] * x[2 * i + 2], bb[it] + w0[it] * x[2 * i + 1] + w1[it] * x[2 * i + 2] + w2[it] * x[2 * i + 3]);
                *(GAS u32x4*)((bf16_t*)(F.ws + WS_HV) + ((size_t)(blk * 64 + ch) * NB + b) * SPB + posbase + s0 + cseg * 8) = (u32x4){w[0], w[1], w[2], w[3]};
            }
            LDS_WAIT(); asm volatile("" ::: "memory");
            continue;
        } else {
            const int c0 = (blk - 12) * 64 + cseg * 8;
#pragma unroll
            for (int it = 0; it < 8; ++it) {
                const int sl = rsub + 8 * it, s = s0 + sl;
                const u32x4 zc = *(const GAS u32x4*)(U + (size_t)(rowbase + s) * DIN + UV + c0);
                const unsigned ac[4] = {zc.x, zc.y, zc.z, zc.w};
#pragma unroll
                for (int i = 0; i < 4; ++i) { tile[(cseg * 8 + 2 * i) * 72 + sl] = (bf16_t)(ac[i] & 0xffffu); tile[(cseg * 8 + 2 * i + 1) * 72 + sl] = (bf16_t)(ac[i] >> 16); }
            }
        }
        LDS_WAIT(); asm volatile("" ::: "memory");
#pragma unroll 2
        for (int it = 0; it < 8; ++it) {
            const int ch = rsub + 8 * it;
            const u32x4 v = *(const LAS u32x4*)(tile + ch * 72 + cseg * 8);
            bf16_t* dst;
            if (blk < 12) dst = (bf16_t*)(F.ws + WS_HV) + ((size_t)(blk * 64 + ch) * NB + b) * SPB + posbase + s0 + cseg * 8;
            else dst = (bf16_t*)(F.ws + WS_VT) + ((size_t)b * 512 + (blk - 12) * 64 + ch) * SPB + posbase + s0 + cseg * 8;
            *(GAS u32x4*)dst = v;
        }
        LDS_WAIT(); asm volatile("" ::: "memory");
    }
}

constexpr int NA_RPB = 0, NA_KC = 2048, NA_VC = NA_KC + 256 * 144, NA_KR = NA_VC + 64 * 528, NA_END = NA_KR + 9 * 64 * 144;
static_assert(NA_END <= MISC_OFF, "NA LDS map");
__device__ __forceinline__ bf16x8 gld16(const bf16_t* p) { return *(const GAS bf16x8*)p; }
__device__ __forceinline__ u32x2 gld8(const bf16_t* p) { return *(const GAS u32x2*)p; }
__device__ __forceinline__ const char* uni_ptr(const char* p) { const unsigned long long v = (unsigned long long)p; const unsigned lo = __builtin_amdgcn_readfirstlane((unsigned)v), hi = __builtin_amdgcn_readfirstlane((unsigned)(v >> 32)); return (const char*)(((unsigned long long)hi << 32) | lo); }
__device__ __forceinline__ bf16x8 gld16o(const char* ub, unsigned lo) { return *(const GAS bf16x8*)(ub + (size_t)lo); }
__device__ __forceinline__ u32x2 gld8o(const char* ub, unsigned lo) { return *(const GAS u32x2*)(ub + (size_t)lo); }
template <bool WIN>
__device__ __forceinline__ void na_unit(Frame& F, int b, int h, int r, int strip) {
    const bf16_t* U = (const bf16_t*)(F.ws + WS_U);
    const bf16_t* VT = (const bf16_t*)(F.ws + WS_VT) + ((size_t)b * 512 + h * 64) * SPB;
    const LAS float* rpb = (const LAS float*)(F.lds + NA_RPB);
    const LAS bf16_t* KC = (const LAS bf16_t*)(F.lds + NA_KC); const LAS bf16_t* VC = (const LAS bf16_t*)(F.lds + NA_VC);
    int ln_ = F.lane; asm volatile("" : "+v"(ln_));
    const int i = ln_ & 15, g = ln_ >> 4;
    const int qrow0 = WIN ? (b * SEQ + r * 64 + strip * 16) : (NLAT + b * CTXL + strip * 16);
    const int ki = 8 * (i >> 2) + (i & 3);
    const unsigned qlo = (unsigned)((i * DIN + 8 * g) * 2), klo = (unsigned)((ki * DIN + 8 * g) * 2), vlo = (unsigned)((i * SPB + 8 * g) * 2);
    const char* qb = uni_ptr((const char*)(U + (size_t)qrow0 * DIN + UQ + h * 64));
    const bf16x8 q0 = gld16o(qb, qlo), q1 = gld16o(qb + 64, qlo);
    int kr0 = 0, u0 = 0;
    if (WIN) { kr0 = r - 4; kr0 = kr0 < 0 ? 0 : (kr0 > 56 ? 56 : kr0); u0 = strip == 0 ? 0 : (strip == 1 ? 8 : (strip == 2 ? 24 : 32)); }
    const LAS bf16_t* KR = (const LAS bf16_t*)(F.lds + NA_KR);
    const char* vbase = uni_ptr((const char*)(VT + kr0 * 64 + u0));
    f32x4 o[4];
#pragma unroll
    for (int d = 0; d < 4; ++d) o[d] = (f32x4){0.f, 0.f, 0.f, 0.f};
    float lsum = 0.f;
#define NA_SB() __builtin_amdgcn_sched_barrier(0)
#define NA_WLOAD(vb_, cw) do { _Pragma("unroll") for (int d = 0; d < 4; ++d) vb_[d] = gld16o(vbase + ((size_t)(d * 16) * SPB + (cw) * 64) * 2, vlo); } while (0)
#define NA_KRING(kb_, cw) do { const LAS bf16_t* kp = KR + ((((kr0 + (cw)) % 9) * 64 + u0 + ki) * 72 + 8 * g); kb_[0][0] = *(const LAS bf16x8*)kp; kb_[0][1] = *(const LAS bf16x8*)(kp + 32); \
        kb_[1][0] = *(const LAS bf16x8*)(kp + 4 * 72); kb_[1][1] = *(const LAS bf16x8*)(kp + 4 * 72 + 32); } while (0)
#define NA_QK(kb_, s_) do { _Pragma("unroll") for (int t = 0; t < 2; ++t) { f32x4 a = (f32x4){0.f, 0.f, 0.f, 0.f}; a = mfma16(kb_[t][0], q0, a); a = mfma16(kb_[t][1], q1, a); s_[t] = a; } } while (0)
#define NA_PV(s_, vb_) do { u32x4 pw; pw.x = pk2(s_[0][0], s_[0][1]); pw.y = pk2(s_[0][2], s_[0][3]); pw.z = pk2(s_[1][0], s_[1][1]); pw.w = pk2(s_[1][2], s_[1][3]); const bf16x8 pf = __builtin_bit_cast(bf16x8, pw); \
        _Pragma("unroll") for (int d = 0; d < 4; ++d) o[d] = mfma16(vb_[d], pf, o[d]); } while (0)
    bf16x8 vA[4], vB[4], vC[4];
    if (WIN) { NA_WLOAD(vA, 0); NA_WLOAD(vB, 1); NA_WLOAD(vC, 2); NA_SB(); }
#pragma unroll
    for (int cc = 0; cc < 8; ++cc) {
        bf16x8 kc[2][2], vc[4]; f32x4 sc[2];
#pragma unroll
        for (int t = 0; t < 2; ++t) { const LAS bf16_t* kp = KC + (cc * 32 + ki + 4 * t) * 72 + 8 * g; kc[t][0] = *(const LAS bf16x8*)kp; kc[t][1] = *(const LAS bf16x8*)(kp + 32); }
#pragma unroll
        for (int d = 0; d < 4; ++d) vc[d] = *(const LAS bf16x8*)(VC + (d * 16 + i) * 264 + cc * 32 + 8 * g);
        NA_QK(kc, sc);
#pragma unroll
        for (int t = 0; t < 2; ++t)
#pragma unroll
            for (int e = 0; e < 4; ++e) { const float p = __builtin_amdgcn_exp2f(fminf(sc[t][e], NA_CLAMP)); sc[t][e] = p; lsum += p; }
        NA_PV(sc, vc);
    }
    if (WIN) {
        const int c = strip * 16 + i; int kc0 = c - 8; kc0 = kc0 < 0 ? 0 : (kc0 > 48 ? 48 : kc0);
        int dcl[2][4]; bool okm[2][4];
#pragma unroll
        for (int t = 0; t < 2; ++t)
#pragma unroll
            for (int e = 0; e < 4; ++e) { const int kc = u0 + 8 * g + 4 * t + e; okm[t][e] = (kc >= kc0) && (kc < kc0 + 16); int dc = kc - c + 15; dcl[t][e] = okm[t][e] ? (dc < 0 ? 0 : (dc > 30 ? 30 : dc)) : 31; }
#define NA_WCHUNK(vb_, cw) do { bf16x8 kw[2][2]; NA_KRING(kw, cw); f32x4 sw[2]; NA_QK(kw, sw); const LAS float* rp = rpb + (kr0 + (cw) - r + 7) * 32; \
        _Pragma("unroll") for (int t = 0; t < 2; ++t) _Pragma("unroll") for (int e = 0; e < 4; ++e) { const float x = sw[t][e] + rp[dcl[t][e]]; const float p = __builtin_amdgcn_exp2f(fminf(x, NA_CLAMP)); sw[t][e] = p; lsum += p; } \
        NA_PV(sw, vb_); } while (0)
        NA_WCHUNK(vA, 0); NA_SB(); NA_WLOAD(vA, 3); NA_SB();
        NA_WCHUNK(vB, 1); NA_SB(); NA_WLOAD(vB, 4); NA_SB();
        NA_WCHUNK(vC, 2); NA_SB(); NA_WLOAD(vC, 5); NA_SB();
        NA_WCHUNK(vA, 3); NA_SB(); NA_WLOAD(vA, 6); NA_SB();
        NA_WCHUNK(vB, 4); NA_SB(); NA_WLOAD(vB, 7); NA_SB();
        NA_WCHUNK(vC, 5); NA_SB();
        NA_WCHUNK(vA, 6); NA_SB();
        NA_WCHUNK(vB, 7); NA_SB();
#undef NA_WCHUNK
    }
    lsum += shx(lsum, 16, ln_); lsum += shx(lsum, 32, ln_);
    const float inv = 1.0f / lsum;
    char* op = (char*)uni_ptr((const char*)((bf16_t*)(F.ws + WS_MIX) + (size_t)qrow0 * DM + h * 64)); const unsigned olo = (unsigned)((i * DM + 4 * g) * 2);
#pragma unroll
    for (int d = 0; d < 4; ++d) { u32x2 w; w.x = pk2(o[d][0] * inv, o[d][1] * inv); w.y = pk2(o[d][2] * inv, o[d][3] * inv); *(GAS u32x2*)(op + d * 32 + (size_t)olo) = w; }
#undef NA_SB
#undef NA_WLOAD
#undef NA_KRING
#undef NA_QK
#undef NA_PV
}
__device__ __forceinline__ int na_kr0(int r) { const int k = r - 4; return k < 0 ? 0 : (k > 56 ? 56 : k); }
__device__ __forceinline__ void ph_na(Frame& F, int l, bool last) {
    const bf16_t* U = (const bf16_t*)(F.ws + WS_U);
    for (int job = F.wg; job < NB * 8 * 2; job += F.G) {
        const int half = job & 1, h = (job >> 1) & 7, b = job >> 4;
        int tz_; asm volatile("v_mbcnt_lo_u32_b32 %0, -1, 0\n\tv_mbcnt_hi_u32_b32 %0, -1, %0" : "=v"(tz_)); tz_ |= F.wave << 6;
        const bf16_t* krow = U + (size_t)(b * SEQ + (tz_ >> 3)) * DIN + UK + h * 64 + (tz_ & 7) * 8;
        LAS bf16_t* kdst = (LAS bf16_t*)(F.lds + NA_KR) + (tz_ >> 3) * 72 + (tz_ & 7) * 8;
        __syncthreads();
        { LAS float* rpb = (LAS float*)(F.lds + NA_RPB); const float* rsrc = F.in[I_RPB] + ((size_t)l * 8 + h) * 15 * 31;
          if (tz_ < 15 * 32) rpb[tz_] = (tz_ & 31) < 31 ? rsrc[(tz_ >> 5) * 31 + (tz_ & 31)] * 1.4426950408889634f : -1e30f;
          const int key = tz_ >> 1, hf = tz_ & 1; const bf16_t* src = U + (size_t)(NLAT + b * CTXL + key) * DIN + UK + h * 64 + hf * 32; LAS bf16_t* dst = (LAS bf16_t*)(F.lds + NA_KC) + key * 72 + hf * 32;
#pragma unroll
          for (int j = 0; j < 4; ++j) *(LAS bf16x8*)(dst + j * 8) = gld16(src + j * 8);
          const int dv = tz_ >> 3, seg = tz_ & 7; const bf16_t* vs = (const bf16_t*)(F.ws + WS_VT) + ((size_t)b * 512 + h * 64 + dv) * SPB + SEQ + seg * 32; LAS bf16_t* vd = (LAS bf16_t*)(F.lds + NA_VC) + dv * 264 + seg * 32;
#pragma unroll
          for (int j = 0; j < 4; ++j) *(LAS bf16x8*)(vd + j * 8) = gld16(vs + j * 8);
          const int lo = na_kr0(half * 32), hi0 = na_kr0(half * 32 + 1) + 7;
          for (int kr = lo; kr <= hi0; ++kr) *(LAS bf16x8*)(kdst + (kr % 9) * 64 * 72) = gld16(krow + (size_t)kr * 64 * DIN); }
        __syncthreads();
        int prev_hi = na_kr0(half * 32 + 1) + 7;
#pragma unroll 1
        for (int s = 0; s < 16; ++s) {
            const int r0 = half * 32 + 2 * s;
            const int nhi = s < 15 ? na_kr0(r0 + 3) + 7 : prev_hi;
            bf16x8 n0 = (bf16x8){0, 0, 0, 0, 0, 0, 0, 0}, n1 = n0;
            if (nhi > prev_hi) n0 = gld16(krow + (size_t)(prev_hi + 1) * 64 * DIN);
            if (nhi > prev_hi + 1) n1 = gld16(krow + (size_t)(prev_hi + 2) * 64 * DIN);
            na_unit<true>(F, b, h, r0 + (F.wave >> 2), F.wave & 3);
            __syncthreads();
            if (nhi > prev_hi) *(LAS bf16x8*)(kdst + ((prev_hi + 1) % 9) * 64 * 72) = n0;
            if (nhi > prev_hi + 1) *(LAS bf16x8*)(kdst + ((prev_hi + 2) % 9) * 64 * 72) = n1;
            __syncthreads();
            prev_hi = nhi;
        }
        if (!last) na_unit<false>(F, b, h, 0, half * 8 + F.wave);
    }
}

__device__ __forceinline__ void ph_hy_transpose(Frame& F, bool last) {
    LAS bf16_t* tile = (LAS bf16_t*)(F.lds + F.wave * 16384);
    const bf16_t* HYO = (const bf16_t*)(F.ws + WS_Y);
    const int gw = F.wg * NWAVES + F.wave, NGW = F.G * NWAVES;
    const int rsub = F.lane >> 3, cseg = F.lane & 7;
    const int ntt = last ? 1024 : 1088;
    for (int u = gw; u < ntt * 4; u += NGW) {
        const int tt = u >> 2, cb = u & 3;
        int b, s0, rowbase, posbase;
        if (tt < 1024) { b = tt >> 6; s0 = (tt & 63) * 64; rowbase = b * SEQ; posbase = 0; }
        else { const int t2 = tt - 1024; b = t2 >> 2; s0 = (t2 & 3) * 64; rowbase = NLAT + b * CTXL; posbase = SEQ; }
#pragma unroll 2
        for (int it = 0; it < 8; ++it) { const int c = rsub + 8 * it;
            const u32x4 v = *(const GAS u32x4*)(HYO + ((size_t)(cb * 64 + c) * NB + b) * SPB + posbase + s0 + cseg * 8); const unsigned a[4] = {v.x, v.y, v.z, v.w};
#pragma unroll
            for (int e = 0; e < 4; ++e) { tile[(cseg * 8 + 2 * e) * 72 + c] = (bf16_t)(a[e] & 0xffffu); tile[(cseg * 8 + 2 * e + 1) * 72 + c] = (bf16_t)(a[e] >> 16); } }
        LDS_WAIT(); asm volatile("" ::: "memory");
#pragma unroll 2
        for (int it = 0; it < 8; ++it) { const int p = rsub + 8 * it;
            const u32x4 v = *(const LAS u32x4*)(tile + p * 72 + cseg * 8);
            *(GAS u32x4*)((bf16_t*)(F.ws + WS_MIX) + (size_t)(rowbase + s0 + p) * DM + 768 + cb * 64 + cseg * 8) = v; }
        LDS_WAIT(); asm volatile("" ::: "memory");
    }
}

constexpr int G2_LAF = 0, G2_LAB = 8448;
constexpr int G2_QTF = 16896, G2_KTF = 22016, G2_QTB = 27136, G2_KTB = 32256;
constexpr int G2_VT = 37376, G2_ATT = 46592;
constexpr int G2_SF = 55808, G2_SB = 60928;
constexpr int G2_SEG = 66048, G2_HALF = 67328;
__device__ __forceinline__ float log_sigmoid_f(float x) { return fminf(x, 0.f) - __logf(1.0f + __expf(-fabsf(x))); }
__device__ __forceinline__ f32x4 mma_lds(const LAS bf16_t* A, int lda, const LAS bf16_t* B, int ldb, int ksteps, f32x4 acc, int lane) {
    const int r = lane & 15, g = lane >> 4;
    for (int ks = 0; ks < ksteps; ++ks) { const bf16x8 a = *(const LAS bf16x8*)(A + r * lda + ks * 32 + 8 * g), b = *(const LAS bf16x8*)(B + r * ldb + ks * 32 + 8 * g); acc = mfma16(a, b, acc); }
    return acc;
}
__device__ __forceinline__ int gla_row0(int b, int cn) { return cn >= 4 ? b * SEQ + (cn - 4) * 64 : NLAT + b * CTXL + cn * 64; }
struct GlaRaw { u32x4 q, k, f, b, v0, v1, g0, g1, s0, s1; };
template <bool FULL>
__device__ __forceinline__ GlaRaw gla_load(Frame& F, int u, int tl) {
    const int h = u & 3, cn = (u >> 2) % 68, b = (u >> 2) / 68, i = tl >> 2, part = tl & 3;
    const bf16_t* p = (const bf16_t*)(F.ws + WS_U) + (size_t)(gla_row0(b, cn) + i) * DIN;
    GlaRaw r;
    r.q = *(const GAS u32x4*)(p + UGQ + h * 32 + part * 8); r.k = *(const GAS u32x4*)(p + UGK + h * 32 + part * 8);
    r.f = *(const GAS u32x4*)(p + ULAF + h * 32 + part * 8); r.b = *(const GAS u32x4*)(p + ULAB + h * 32 + part * 8);
    r.v0 = *(const GAS u32x4*)(p + UGV + h * 64 + part * 16); r.v1 = *(const GAS u32x4*)(p + UGV + h * 64 + part * 16 + 8);
    if (FULL) { r.g0 = *(const GAS u32x4*)(p + UGR + h * 64 + part * 16); r.g1 = *(const GAS u32x4*)(p + UGR + h * 64 + part * 16 + 8);
        const bf16_t* sp = (const bf16_t*)(F.ws + WS_GSIN) + (size_t)u * 2 * 2048 + tl * 16; r.s0 = *(const GAS u32x4*)sp; r.s1 = *(const GAS u32x4*)(sp + 8); }
    else { r.g0 = (u32x4){0u, 0u, 0u, 0u}; r.g1 = r.g0; r.s0 = r.g0; r.s1 = r.g0; }
    return r;
}
template <bool FULL>
__device__ __forceinline__ void gla_prep(Frame& F, LAS unsigned char* L, int l, int u, int tl, const GlaRaw& raw) {
    const int h = u & 3, cn = (u >> 2) % 68, i = tl >> 2, part = tl & 3, d8 = part * 8;
    LAS float* LAF = (LAS float*)(L + G2_LAF); LAS float* LAB = (LAS float*)(L + G2_LAB); LAS bf16_t* VT = (LAS bf16_t*)(L + G2_VT); LAS float* SEG = (LAS float*)(L + G2_SEG);
    float q[8], k[8], tf[8], tb[8];
    unpack8(raw.q, q); unpack8(raw.k, k); unpack8(raw.f, tf); unpack8(raw.b, tb);
    const float* ba = F.in[I_BA2] + (size_t)l * 256 + h * 32 + d8;
#pragma unroll
    for (int e = 0; e < 8; ++e) { q[e] *= 0.17677669529663687f; LAF[i * 33 + d8 + e] = log_sigmoid_f(tf[e] + ba[e]) * 0.0625f; LAB[i * 33 + d8 + e] = log_sigmoid_f(tb[e] + ba[128 + e]) * 0.0625f; }
    if (cn >= 4) {
        const float pos = (part >> 1) ? (float)i : (float)(cn - 4);
#pragma unroll
        for (int e = 0; e < 8; ++e) { const float ang = pos * __expf(-(float)e * (9.210340371976184f / 8.0f)); const float sn = __sinf(ang), cs = __cosf(ang);
            const float qo = shx(q[e], 1, F.lane), ko = shx(k[e], 1, F.lane);
            if (part & 1) { q[e] = qo * sn + q[e] * cs; k[e] = ko * sn + k[e] * cs; } else { q[e] = q[e] * cs - qo * sn; k[e] = k[e] * cs - ko * sn; } }
    }
    { const unsigned a[8] = {raw.v0.x, raw.v0.y, raw.v0.z, raw.v0.w, raw.v1.x, raw.v1.y, raw.v1.z, raw.v1.w};
#pragma unroll
      for (int e = 0; e < 8; ++e) { VT[(part * 16 + 2 * e) * 72 + i] = (bf16_t)(a[e] & 0xffffu); VT[(part * 16 + 2 * e + 1) * 72 + i] = (bf16_t)(a[e] >> 16); } }
    __syncthreads();
    { const int x = tl & 63, d = x & 31, dir = x >> 5, seg = tl >> 6; LAS float* LA = (dir ? LAB : LAF) + d; float cv[16];
#pragma unroll
      for (int kk = 0; kk < 16; ++kk) { const int p = seg * 16 + kk, ti = dir ? 63 - p : p; cv[kk] = LA[ti * 33]; }
#pragma unroll
      for (int kk = 1; kk < 16; ++kk) cv[kk] += cv[kk - 1];
#pragma unroll
      for (int kk = 0; kk < 16; ++kk) { const int p = seg * 16 + kk, ti = dir ? 63 - p : p; LA[ti * 33] = cv[kk]; }
      SEG[x * 5 + seg] = cv[15]; }
    __syncthreads();
    { const int x = tl & 63, d = x & 31, dir = x >> 5, seg = tl >> 6; LAS float* LA = (dir ? LAB : LAF) + d; float cv[16];
      const float t0 = SEG[x * 5 + 0], t1 = SEG[x * 5 + 1], t2 = SEG[x * 5 + 2];
      const float pre = seg == 0 ? 0.f : (seg == 1 ? t0 : (seg == 2 ? t0 + t1 : t0 + t1 + t2));
#pragma unroll
      for (int kk = 0; kk < 16; ++kk) { const int p = seg * 16 + kk, ti = dir ? 63 - p : p; cv[kk] = LA[ti * 33]; }
#pragma unroll
      for (int kk = 0; kk < 16; ++kk) { const int p = seg * 16 + kk, ti = dir ? 63 - p : p; LA[ti * 33] = cv[kk] + pre; } }
    __syncthreads();
    if (FULL) {
        unsigned wqf[4], wkf[4], wqb[4], wkb[4];
#pragma unroll
        for (int e = 0; e < 4; ++e) { const int d = d8 + 2 * e; const float f0 = LAF[i * 33 + d], f1 = LAF[i * 33 + d + 1], b0 = LAB[i * 33 + d], b1 = LAB[i * 33 + d + 1];
            wqf[e] = pk2(q[2 * e] * __expf(f0), q[2 * e + 1] * __expf(f1)); wkf[e] = pk2(k[2 * e] * __expf(-f0), k[2 * e + 1] * __expf(-f1));
            wqb[e] = pk2(q[2 * e] * __expf(b0), q[2 * e + 1] * __expf(b1)); wkb[e] = pk2(k[2 * e] * __expf(-b0), k[2 * e + 1] * __expf(-b1)); }
        *(LAS u32x4*)((LAS bf16_t*)(L + G2_QTF) + i * 40 + d8) = (u32x4){wqf[0], wqf[1], wqf[2], wqf[3]}; *(LAS u32x4*)((LAS bf16_t*)(L + G2_KTF) + i * 40 + d8) = (u32x4){wkf[0], wkf[1], wkf[2], wkf[3]};
        *(LAS u32x4*)((LAS bf16_t*)(L + G2_QTB) + i * 40 + d8) = (u32x4){wqb[0], wqb[1], wqb[2], wqb[3]}; *(LAS u32x4*)((LAS bf16_t*)(L + G2_KTB) + i * 40 + d8) = (u32x4){wkb[0], wkb[1], wkb[2], wkb[3]};
    } else {
        LAS bf16_t* KDF = (LAS bf16_t*)(L + G2_QTF); LAS bf16_t* KDB = (LAS bf16_t*)(L + G2_KTF);
#pragma unroll
        for (int e = 0; e < 8; ++e) { const int d = d8 + e; const float bf = LAF[i * 33 + d], bb = LAB[i * 33 + d], bfl = LAF[63 * 33 + d], bbl = LAB[0 * 33 + d];
            KDF[d * 72 + i] = (bf16_t)f2bf(k[e] * __expf(bfl - bf)); KDB[d * 72 + i] = (bf16_t)f2bf(k[e] * __expf(bbl - bb)); }
    }
    __syncthreads();
}
__device__ __forceinline__ void ph_gla_local(Frame& F, int l) {
    const int hw = F.wave >> 2, wl = F.wave & 3, tl = F.tid & 255; LAS unsigned char* L = F.lds + hw * G2_HALF;
    constexpr int NU = NB * 68 * 4;
    int pp = F.wg;
    GlaRaw raw = gla_load<false>(F, (pp * 2 + hw) < NU ? pp * 2 + hw : 0, tl);
    for (; pp * 2 < NU; pp += F.G) {
        const int u = pp * 2 + hw, un = (pp + F.G) * 2 + hw;
        const GlaRaw nraw = gla_load<false>(F, un < NU ? un : u, tl);
        __syncthreads();
        gla_prep<false>(F, L, l, u, tl, raw);
        const int g = F.lane >> 4, c = F.lane & 15;
        float* DS = (float*)(F.ws + WS_GDS) + (size_t)u * 2 * 2048;
#pragma unroll
        for (int kk = 0; kk < 4; ++kk) { const int tix = wl * 4 + kk, dir = tix >> 3, mt = (tix >> 1) & 3, nt = tix & 1;
            f32x4 a = (f32x4){0.f, 0.f, 0.f, 0.f};
            a = mma_lds((const LAS bf16_t*)(L + G2_VT) + mt * 16 * 72, 72, (const LAS bf16_t*)(L + (dir ? G2_KTF : G2_QTF)) + nt * 16 * 72, 72, 2, a, F.lane);
#pragma unroll
            for (int e = 0; e < 4; ++e) DS[dir * 2048 + (mt * 16 + 4 * g + e) * 32 + nt * 16 + c] = a[e]; }
        if (tl < 64) { const int d = tl & 31, dir = tl >> 5; ((float*)(F.ws + WS_GD))[(size_t)u * 64 + tl] = __expf(dir ? ((LAS float*)(L + G2_LAB))[0 * 33 + d] : ((LAS float*)(L + G2_LAF))[63 * 33 + d]); }
        raw = nraw;
    }
}
__device__ __forceinline__ void ph_gla_scan(Frame& F) {
    const int gt = F.wg * NTHR + F.tid, NGT = F.G * NTHR;
    const float* DS = (const float*)(F.ws + WS_GDS); const float* GD = (const float*)(F.ws + WS_GD); bf16_t* SIN = (bf16_t*)(F.ws + WS_GSIN);
    for (int w = gt; w < 128 * 1024; w += NGT) {
        const int chain = w >> 10, el = (w & 1023) * 2, dir = chain & 1, h = (chain >> 1) & 3, b = chain >> 3, d = el & 31;
        float s0 = 0.f, s1 = 0.f;
        for (int step = 0; step < 68; step += 4) {
            f32x2 ds[4], dd[4]; size_t uu[4];
#pragma unroll
            for (int q = 0; q < 4; ++q) { const int st_ = step + q; const int cn = dir ? (st_ < 4 ? 3 - st_ : 71 - st_) : st_;
                uu[q] = (size_t)(b * 68 + cn) * 4 + h;
                ds[q] = *(const GAS f32x2*)(DS + (uu[q] * 2 + dir) * 2048 + el); dd[q] = *(const GAS f32x2*)(GD + uu[q] * 64 + dir * 32 + d); }
#pragma unroll
            for (int q = 0; q < 4; ++q) { *(GAS unsigned*)(SIN + (uu[q] * 2 + dir) * 2048 + el) = pk2(s0, s1); s0 = dd[q].x * s0 + ds[q].x; s1 = dd[q].y * s1 + ds[q].y; }
        }
    }
}
__device__ __forceinline__ void ph_gla_out(Frame& F, int l, bool last) {
    const int hw = F.wave >> 2, wl = F.wave & 3, tl = F.tid & 255; LAS unsigned char* L = F.lds + hw * G2_HALF;
    const int NV = last ? NB * 64 * 4 : NB * 68 * 4;
#define GLA_UNIT(v) (last ? ((((v) >> 8) * 68 + 4 + (((v) & 255) >> 2)) * 4 + ((v) & 3)) : (v))
    int pp = F.wg;
    GlaRaw raw = gla_load<true>(F, GLA_UNIT((pp * 2 + hw) < NV ? pp * 2 + hw : 0), tl);
    for (; pp * 2 < NV; pp += F.G) {
        const int u = GLA_UNIT(pp * 2 + hw), vn = (pp + F.G) * 2 + hw;
        const GlaRaw nraw = gla_load<true>(F, vn < NV ? GLA_UNIT(vn) : u, tl);
        const int h = u & 3, cn = (u >> 2) % 68, b = (u >> 2) / 68;
        __syncthreads();
        gla_prep<true>(F, L, l, u, tl, raw);
        { const int dir = tl >> 7, dv = (tl >> 1) & 63, d16 = (tl & 1) * 16; LAS bf16_t* S = (LAS bf16_t*)(L + (dir ? G2_SB : G2_SF)) + dv * 40 + d16; *(LAS u32x4*)S = raw.s0; *(LAS u32x4*)(S + 8) = raw.s1; }
        const int g = F.lane >> 4, c = F.lane & 15;
        LAS bf16_t* ATT = (LAS bf16_t*)(L + G2_ATT);
#pragma unroll
        for (int kk = 0; kk < 4; ++kk) { const int tile = wl * 4 + kk, mt = tile >> 2, nt = tile & 3;
            f32x4 af = (f32x4){0.f, 0.f, 0.f, 0.f}, ab = af;
            af = mma_lds((const LAS bf16_t*)(L + G2_QTF) + mt * 16 * 40, 40, (const LAS bf16_t*)(L + G2_KTF) + nt * 16 * 40, 40, 1, af, F.lane);
            ab = mma_lds((const LAS bf16_t*)(L + G2_QTB) + mt * 16 * 40, 40, (const LAS bf16_t*)(L + G2_KTB) + nt * 16 * 40, 40, 1, ab, F.lane);
#pragma unroll
            for (int e = 0; e < 4; ++e) { const int ii = mt * 16 + 4 * g + e, j = nt * 16 + c; const float vv = (j <= ii ? af[e] : 0.f) + (j >= ii ? ab[e] : 0.f); ATT[ii * 72 + j] = (bf16_t)f2bf(vv); } }
        __syncthreads();
        LAS float* O = (LAS float*)(L + G2_LAF);
#pragma unroll
        for (int kk = 0; kk < 4; ++kk) { const int tile = wl * 4 + kk, mt = tile >> 2, nt = tile & 3;
            f32x4 a = (f32x4){0.f, 0.f, 0.f, 0.f};
            a = mma_lds(ATT + mt * 16 * 72, 72, (const LAS bf16_t*)(L + G2_VT) + nt * 16 * 72, 72, 2, a, F.lane);
            a = mma_lds((const LAS bf16_t*)(L + G2_QTF) + mt * 16 * 40, 40, (const LAS bf16_t*)(L + G2_SF) + nt * 16 * 40, 40, 1, a, F.lane);
            a = mma_lds((const LAS bf16_t*)(L + G2_QTB) + mt * 16 * 40, 40, (const LAS bf16_t*)(L + G2_SB) + nt * 16 * 40, 40, 1, a, F.lane);
#pragma unroll
            for (int e = 0; e < 4; ++e) O[(mt * 16 + 4 * g + e) * 65 + nt * 16 + c] = a[e]; }
        __syncthreads();
        { const int i = tl >> 2, dv16 = (tl & 3) * 16; const int row = gla_row0(b, cn) + i;
          float v[16], gt[16]; float ss = 0.f;
#pragma unroll
          for (int e = 0; e < 16; ++e) { v[e] = O[i * 65 + dv16 + e]; ss += v[e] * v[e]; }
          ss += shx(ss, 1, F.lane); ss += shx(ss, 2, F.lane);
          const float rs = 1.0f / sqrtf(ss * (1.0f / 64.0f) + LN_EPS);
          unpack8(raw.g0, gt); unpack8(raw.g1, gt + 8);
          const float* gn = F.in[I_GNORM] + l * 64 + dv16;
          unsigned w[8];
#pragma unroll
          for (int e = 0; e < 8; ++e) w[e] = pk2(v[2 * e] * rs * gn[2 * e] * silu_f(gt[2 * e]), v[2 * e + 1] * rs * gn[2 * e + 1] * silu_f(gt[2 * e + 1]));
          bf16_t* mp = (bf16_t*)(F.ws + WS_MIX) + (size_t)row * DM + 512 + h * 64 + dv16;
          *(GAS u32x4*)mp = (u32x4){w[0], w[1], w[2], w[3]}; *(GAS u32x4*)(mp + 8) = (u32x4){w[4], w[5], w[6], w[7]}; }
        raw = nraw;
    }
#undef GLA_UNIT
}

template <int L>
__device__ __forceinline__ void hyena_conv(Frame& F, const bf16_t* Rg, const bf16_t* Uin, const bf16_t* Xmul, int pos0, bool final_out, int ch, bf16_t* Zout) {
    constexpr int CS = 2 * L + 16;
    constexpr int NTL = L / 16, J = (NTL >= 64) ? 16 : 2, NGRP = NTL / J, HJ = J / 2, NSTEP = L / 32;
    LAS bf16_t* Rl = (LAS bf16_t*)F.lds;
    __syncthreads();
    for (int c = F.tid; c < 2 * L / 8; c += NTHR) { const u32x4 v = *(const GAS u32x4*)(Rg + 8 * c); const unsigned a[4] = {v.x, v.y, v.z, v.w};
#pragma unroll
        for (int rho = 0; rho < 8; ++rho) { LAS bf16_t* d = Rl + rho * CS + 8 * c + rho;
#pragma unroll
            for (int k = 0; k < 4; ++k) { d[2 * k] = (bf16_t)(a[k] & 0xffffu); d[2 * k + 1] = (bf16_t)(a[k] >> 16); } } }
    __syncthreads();
    int ln_ = F.lane; asm volatile("" : "+v"(ln_));
    const int i = ln_ & 15, g = ln_ >> 4, rho = i & 7;
    const LAS bf16_t* Rc = Rl + rho * CS + rho;
    for (int grp = F.wave; grp < NGRP; grp += NWAVES) {
        f32x4 acc[J]; bf16x8 fr[J];
        const int tb = grp * J * 16;
        const LAS bf16_t* Rb = Rc + (L - tb - i + 8 * g);
#pragma unroll
        for (int j = 0; j < J; ++j) { acc[j] = (f32x4){0.f, 0.f, 0.f, 0.f}; fr[j] = *(const LAS bf16x8*)(Rb - 16 * j); }
        const char* ub = (const char*)(Uin + pos0); const unsigned ulo = (unsigned)((i * SPB + 8 * g) * 2);
        constexpr int PF = (HJ >= 4) ? 4 : 1;
        bf16x8 bq[PF];
#pragma unroll
        for (int p = 0; p < PF; ++p) bq[p] = *(const GAS bf16x8*)(ub + (size_t)(ulo + (unsigned)p * 64u));
#pragma unroll 1
        for (int q = 0; q < NSTEP / HJ; ++q) {
#pragma unroll
            for (int m = 0; m < HJ; ++m) {
                const int n = q * HJ + m;
                const int nn = (n + PF < NSTEP) ? n + PF : 0;
                if (n > 0) { fr[(J - 2 * m) % J] = *(const LAS bf16x8*)(Rb + 32 * n); fr[(J + 1 - 2 * m) % J] = *(const LAS bf16x8*)(Rb + 32 * n - 16); }
                const bf16x8 bcur = bq[m % PF];
#pragma unroll
                for (int jj = 0; jj < J; ++jj) { const int j = (jj + 2) % J; acc[j] = mfma16(fr[(j + J - 2 * m) % J], bcur, acc[j]); }
                bq[m % PF] = *(const GAS bf16x8*)(ub + (size_t)(ulo + (unsigned)nn * 64u));
            }
        }
#pragma unroll
        for (int j = 0; j < J; ++j) { const int t0 = tb + j * 16 + 4 * g;
            const u32x2 xw = *(const GAS u32x2*)(Xmul + (size_t)i * SPB + pos0 + t0);
            const float y0 = acc[j][0] * bflo(xw.x), y1 = acc[j][1] * bfhi(xw.x), y2 = acc[j][2] * bflo(xw.y), y3 = acc[j][3] * bfhi(xw.y);
            if (!final_out) { u32x2 w; w.x = pk2(y0, y1); w.y = pk2(y2, y3); *(GAS u32x2*)(Zout + (size_t)i * SPB + pos0 + t0) = w; }
            else { u32x2 w; w.x = pk2(y0, y1); w.y = pk2(y2, y3); *(GAS u32x2*)((bf16_t*)(F.ws + WS_Y) + ((size_t)ch * NB + i) * SPB + pos0 + t0) = w; } }
    }
}
__device__ __forceinline__ void ph_hyena(Frame& F, int l, bool last) {
    const bf16_t* HV = (const bf16_t*)(F.ws + WS_HV); bf16_t* Z2 = (bf16_t*)(F.ws + WS_Z2);
    for (int ch = F.wg; ch < 256; ch += F.G) {
        const bf16_t* v = HV + (size_t)(0 * 256 + ch) * NB * SPB; const bf16_t* x1 = HV + (size_t)(256 + ch) * NB * SPB; const bf16_t* x2 = HV + (size_t)(512 + ch) * NB * SPB;
        bf16_t* z = Z2 + (size_t)ch * NB * SPB;
        const bf16_t* R0 = (const bf16_t*)(F.ws + WS_HYF) + ((size_t)(l * 2 + 0) * 256 + ch) * 8192; const bf16_t* R1 = (const bf16_t*)(F.ws + WS_HYF) + ((size_t)(l * 2 + 1) * 256 + ch) * 8192;
        hyena_conv<4096>(F, R0, v, x1, 0, false, ch, z);
        VM_WAIT(); __syncthreads(); __builtin_amdgcn_fence(__ATOMIC_ACQUIRE, "agent"); VM_WAIT();
        hyena_conv<4096>(F, R1, z, x2, 0, true, ch, z);
        if (!last) {
            const bf16_t* C0 = (const bf16_t*)(F.ws + WS_HYFC) + ((size_t)(l * 2 + 0) * 256 + ch) * 512; const bf16_t* C1 = (const bf16_t*)(F.ws + WS_HYFC) + ((size_t)(l * 2 + 1) * 256 + ch) * 512;
            hyena_conv<256>(F, C0, v, x1, SEQ, false, ch, z);
            VM_WAIT(); __syncthreads(); __builtin_amdgcn_fence(__ATOMIC_ACQUIRE, "agent"); VM_WAIT();
            hyena_conv<256>(F, C1, z, x2, SEQ, true, ch, z);
        }
    }
}

__device__ __forceinline__ void ph_ln1(Frame& F, int l, int ntok) {
    const int gw = F.wg * NWAVES + F.wave, NGW = F.G * NWAVES;
    const float* lg = F.in[I_LN1G] + l * DM + 16 * F.lane; const float* lb = F.in[I_LN1B] + l * DM + 16 * F.lane;
    for (int row = gw; row < ntok; row += NGW) {
        bf16_t* xr = (bf16_t*)(F.ws + WS_XR) + (size_t)row * DM + 16 * F.lane;
        const bf16_t* yr = (const bf16_t*)(F.ws + WS_Y) + (size_t)row * DM + 16 * F.lane;
        const float* md = mod_ptr(F, l, row) + 16 * F.lane;
        bf16_t* xm = (bf16_t*)(F.ws + WS_XM) + (size_t)row * DM + 16 * F.lane;
        const u32x4 xa = *(const GAS u32x4*)xr, xb = *(const GAS u32x4*)(xr + 8), ya = *(const GAS u32x4*)yr, yb = *(const GAS u32x4*)(yr + 8);
        float x[16], y[16], v[16]; unpack8(xa, x); unpack8(xb, x + 8); unpack8(ya, y); unpack8(yb, y + 8);
        float s = 0.f;
#pragma unroll
        for (int j = 0; j < 4; ++j) { const f32x4 g1 = *(const GAS f32x4*)(md + 2048 + 4 * j);
#pragma unroll
            for (int e = 0; e < 4; ++e) { v[4 * j + e] = x[4 * j + e] * DN_ALPHA + g1[e] * y[4 * j + e]; s += v[4 * j + e]; } }
        const float mean = wave_sum(s, F.lane) * (1.f / DM); float s2 = 0.f;
#pragma unroll
        for (int e = 0; e < 16; ++e) { v[e] -= mean; s2 += v[e] * v[e]; }
        const float rstd = 1.f / sqrtf(wave_sum(s2, F.lane) * (1.f / DM) + LN_EPS);
        unsigned wx[8], wm[8]; int w8[4];
#pragma unroll
        for (int j = 0; j < 4; ++j) { const f32x4 g = *(const GAS f32x4*)(lg + 4 * j), bb = *(const GAS f32x4*)(lb + 4 * j), sh = *(const GAS f32x4*)(md + 3072 + 4 * j), sc = *(const GAS f32x4*)(md + 4096 + 4 * j);
            float xn[4];
#pragma unroll
            for (int e = 0; e < 4; ++e) xn[e] = v[4 * j + e] * rstd * g[e] + bb[e];
            wx[2 * j] = pk2(xn[0], xn[1]); wx[2 * j + 1] = pk2(xn[2], xn[3]);
            const float h0 = xn[0] * (1.f + sc[0]) + sh[0], h1 = xn[1] * (1.f + sc[1]) + sh[1], h2 = xn[2] * (1.f + sc[2]) + sh[2], h3 = xn[3] * (1.f + sc[3]) + sh[3];
            wm[2 * j] = pk2(h0, h1); wm[2 * j + 1] = pk2(h2, h3);
            int v = 0; v = __builtin_amdgcn_cvt_pk_fp8_f32(h0, h1, v, false); v = __builtin_amdgcn_cvt_pk_fp8_f32(h2, h3, v, true); w8[j] = v; }
        *(GAS u32x4*)((unsigned char*)(F.ws + WS_XM8) + (size_t)row * DM + 16 * F.lane) = (u32x4){(unsigned)w8[0], (unsigned)w8[1], (unsigned)w8[2], (unsigned)w8[3]};
        *(GAS u32x4*)xr = (u32x4){wx[0], wx[1], wx[2], wx[3]}; *(GAS u32x4*)(xr + 8) = (u32x4){wx[4], wx[5], wx[6], wx[7]};
        *(GAS u32x4*)xm = (u32x4){wm[0], wm[1], wm[2], wm[3]}; *(GAS u32x4*)(xm + 8) = (u32x4){wm[4], wm[5], wm[6], wm[7]};
    }
}
__device__ __forceinline__ void ph_ln2(Frame& F, int l, int ntok, bool last) {
    const int gw = F.wg * NWAVES + F.wave, NGW = F.G * NWAVES;
    const int cA = 256 * (F.lane >> 4) + 32 * ((F.lane >> 2) & 3) + 8 * (F.lane & 3);
#define LN2_COL(j) (cA + ((j) < 2 ? 4 * (j) : 128 + 4 * ((j) - 2)))
    const float* lg = F.in[I_LN2G] + l * DM; const float* lb = F.in[I_LN2B] + l * DM;
    for (int row = gw; row < ntok; row += NGW) {
        bf16_t* xr = (bf16_t*)(F.ws + WS_XR) + (size_t)row * DM;
        const unsigned char* y2 = (const unsigned char*)(F.ws + WS_Y2) + (size_t)row * 9 * DM + 16 * F.lane;
        const float* wg = (const float*)(F.ws + WS_WGT) + (size_t)row * 8;
        const float* md = mod_ptr(F, l, row);
        float ff[16];
#pragma unroll
        for (int e = 0; e < 16; ++e) ff[e] = 0.f;
        u32x4 q[9];
#pragma unroll
        for (int k = 0; k < 9; ++k) q[k] = *(const GAS u32x4*)(y2 + (size_t)k * DM);
#pragma unroll
        for (int k = 0; k < 9; ++k) { const float wk = (k < 8 ? wg[k] : 1.0f) * pg8::Y2_INV; const unsigned a[4] = {q[k].x, q[k].y, q[k].z, q[k].w};
#pragma unroll
            for (int e = 0; e < 4; ++e) { const f32x2 lo = __builtin_amdgcn_cvt_pk_f32_fp8((int)a[e], false), hi = __builtin_amdgcn_cvt_pk_f32_fp8((int)a[e], true);
                ff[4 * e] += wk * lo.x; ff[4 * e + 1] += wk * lo.y; ff[4 * e + 2] += wk * hi.x; ff[4 * e + 3] += wk * hi.y; } }
        float v[16], xo[16]; float s = 0.f;
        { const u32x4 xa = *(const GAS u32x4*)(xr + cA), xb = *(const GAS u32x4*)(xr + cA + 128); unpack8(xa, xo); unpack8(xb, xo + 8); }
#pragma unroll
        for (int j = 0; j < 4; ++j) { const f32x4 g2 = *(const GAS f32x4*)(md + 5120 + LN2_COL(j));
#pragma unroll
            for (int e = 0; e < 4; ++e) { v[4 * j + e] = xo[4 * j + e] * DN_ALPHA + g2[e] * ff[4 * j + e]; s += v[4 * j + e]; } }
        const float mean = wave_sum(s, F.lane) * (1.f / DM); float s2 = 0.f;
#pragma unroll
        for (int e = 0; e < 16; ++e) { v[e] -= mean; s2 += v[e] * v[e]; }
        const float rstd = 1.f / sqrtf(wave_sum(s2, F.lane) * (1.f / DM) + LN_EPS);
        const float* mdn = last ? md : mod_ptr(F, l + 1, row);
        float xn[16];
#pragma unroll
        for (int j = 0; j < 4; ++j) { const f32x4 g = *(const GAS f32x4*)(lg + LN2_COL(j)), bb = *(const GAS f32x4*)(lb + LN2_COL(j));
#pragma unroll
            for (int e = 0; e < 4; ++e) xn[4 * j + e] = v[4 * j + e] * rstd * g[e] + bb[e]; }
        if (last) { float* op = F.out + (size_t)row * DM;
#pragma unroll
            for (int j = 0; j < 4; ++j) *(GAS f32x4*)(op + LN2_COL(j)) = (f32x4){xn[4 * j], xn[4 * j + 1], xn[4 * j + 2], xn[4 * j + 3]}; }
        else {
            *(GAS u32x4*)(xr + cA) = (u32x4){pk2(xn[0], xn[1]), pk2(xn[2], xn[3]), pk2(xn[4], xn[5]), pk2(xn[6], xn[7])}; *(GAS u32x4*)(xr + cA + 128) = (u32x4){pk2(xn[8], xn[9]), pk2(xn[10], xn[11]), pk2(xn[12], xn[13]), pk2(xn[14], xn[15])};
            bf16_t* xm = (bf16_t*)(F.ws + WS_XM) + (size_t)row * DM;
            unsigned w[8];
#pragma unroll
            for (int j = 0; j < 4; ++j) { const f32x4 sh = *(const GAS f32x4*)(mdn + LN2_COL(j)), sc = *(const GAS f32x4*)(mdn + 1024 + LN2_COL(j));
                w[2 * j] = pk2(xn[4 * j] * (1.f + sc[0]) + sh[0], xn[4 * j + 1] * (1.f + sc[1]) + sh[1]); w[2 * j + 1] = pk2(xn[4 * j + 2] * (1.f + sc[2]) + sh[2], xn[4 * j + 3] * (1.f + sc[3]) + sh[3]); }
            *(GAS u32x4*)(xm + cA) = (u32x4){w[0], w[1], w[2], w[3]}; *(GAS u32x4*)(xm + cA + 128) = (u32x4){w[4], w[5], w[6], w[7]};
        }
    }
#undef LN2_COL
}

__device__ __forceinline__ unsigned f_ord(float f) { const unsigned u = __builtin_bit_cast(unsigned, f); return (u & 0x80000000u) ? ~u : (u | 0x80000000u); }
__device__ __forceinline__ unsigned long long wave_max_u64(unsigned long long v, int lane) {
#pragma unroll
    for (int o = 1; o < 64; o <<= 1) { const unsigned lo = (unsigned)shxi((int)(unsigned)v, o, lane), hi = (unsigned)shxi((int)(unsigned)(v >> 32), o, lane); const unsigned long long w = ((unsigned long long)hi << 32) | lo; v = w > v ? w : v; }
    return v;
}
__device__ __forceinline__ float seg16_max(float v, int lane) { v = fmaxf(v, shx(v, 1, lane)); v = fmaxf(v, shx(v, 2, lane)); v = fmaxf(v, shx(v, 4, lane)); v = fmaxf(v, shx(v, 8, lane)); return v; }
__device__ __forceinline__ int seg16_min_i(int v, int lane) { int w; w = shxi(v, 1, lane); v = w < v ? w : v; w = shxi(v, 2, lane); v = w < v ? w : v; w = shxi(v, 4, lane); v = w < v ? w : v; w = shxi(v, 8, lane); v = w < v ? w : v; return v; }
template <int CTRL> __device__ __forceinline__ int dpp_i(int v) { return __builtin_amdgcn_update_dpp(0, v, CTRL, 0xf, 0xf, true); }
__device__ __forceinline__ unsigned row_max_u(unsigned v) { unsigned w; w = (unsigned)dpp_i<0xB1>((int)v); v = w > v ? w : v; w = (unsigned)dpp_i<0x4E>((int)v); v = w > v ? w : v; w = (unsigned)dpp_i<0x141>((int)v); v = w > v ? w : v; w = (unsigned)dpp_i<0x140>((int)v); v = w > v ? w : v; return v; }
__device__ __forceinline__ float row_max_f(float v) { v = fmaxf(v, __builtin_bit_cast(float, dpp_i<0xB1>(__builtin_bit_cast(int, v)))); v = fmaxf(v, __builtin_bit_cast(float, dpp_i<0x4E>(__builtin_bit_cast(int, v)))); v = fmaxf(v, __builtin_bit_cast(float, dpp_i<0x141>(__builtin_bit_cast(int, v)))); v = fmaxf(v, __builtin_bit_cast(float, dpp_i<0x140>(__builtin_bit_cast(int, v)))); return v; }
__device__ __forceinline__ int row_min_i(int v) { int w; w = dpp_i<0xB1>(v); v = w < v ? w : v; w = dpp_i<0x4E>(v); v = w < v ? w : v; w = dpp_i<0x141>(v); v = w < v ? w : v; w = dpp_i<0x140>(v); v = w < v ? w : v; return v; }
__device__ __forceinline__ float rdlane_f(float v, int l) { return __builtin_bit_cast(float, __builtin_amdgcn_readlane(__builtin_bit_cast(int, v), l)); }
__device__ __forceinline__ unsigned wave_max_u(unsigned v) {
    v = row_max_u(v);
    const unsigned a = (unsigned)__builtin_amdgcn_readlane((int)v, 0), b = (unsigned)__builtin_amdgcn_readlane((int)v, 16), c = (unsigned)__builtin_amdgcn_readlane((int)v, 32), d = (unsigned)__builtin_amdgcn_readlane((int)v, 48);
    const unsigned ab = a > b ? a : b, cd = c > d ? c : d; return ab > cd ? ab : cd;
}
__device__ __forceinline__ float row_top2(float v, int l16) {
    const float m1 = row_max_f(v);
    const int first = row_min_i(v == m1 ? l16 : 99);
    const float m2 = row_max_f(l16 == first ? -3.0e38f : v);
    return m1 + m2;
}
__device__ __forceinline__ float seg16_top2(float v, int lane) {
    const float m1 = seg16_max(v, lane);
    const int first = seg16_min_i(v == m1 ? (lane & 15) : 99, lane);
    const float m2 = seg16_max((lane & 15) == first ? -3.0e38f : v, lane);
    return m1 + m2;
}
__device__ __forceinline__ void ph_route(Frame& F, int l, int ntok) {
    LAS int* hist = (LAS int*)F.lds;
    LAS int* base = hist + 128;
    LAS unsigned* alist = (LAS unsigned*)(F.lds + 1024);
    const int tpw = (ntok + F.G - 1) / F.G, t0 = F.wg * tpw, t1 = (t0 + tpw) < ntok ? (t0 + tpw) : ntok;
    __syncthreads();
    if (F.tid < 128) hist[F.tid] = 0;
    __syncthreads();
    const float* LG = (const float*)(F.ws + WS_LOGIT); const float* rb = F.in[I_RB] + l * NEXP;
    const float b0 = rb[F.lane], b1 = rb[F.lane + 64];
    constexpr int RT = 4;
    for (int tb = t0 + F.wave * RT; tb < t1; tb += NWAVES * RT) {
        float s0[RT], s1[RT], e0[RT], e1[RT], gs0[RT], gs1[RT]; unsigned h0[RT], h1[RT]; int mye[RT]; float myw[RT], wsum[RT];
#pragma unroll
        for (int j = 0; j < RT; ++j) { const int tok = (tb + j) < t1 ? tb + j : t1 - 1;
            const float x0 = LG[(size_t)tok * 256 + F.lane], x1 = LG[(size_t)tok * 256 + 64 + F.lane];
            s0[j] = __builtin_amdgcn_rcpf(1.0f + __expf(-x0)); s1[j] = __builtin_amdgcn_rcpf(1.0f + __expf(-x1)); e0[j] = s0[j] + b0; e1[j] = s1[j] + b1; }
#pragma unroll
        for (int j = 0; j < RT; ++j) { gs0[j] = row_top2(e0[j], F.lane & 15); gs1[j] = row_top2(e1[j], F.lane & 15); }
#pragma unroll
        for (int j = 0; j < RT; ++j) {
            float gsc[8];
#pragma unroll
            for (int g = 0; g < 4; ++g) { gsc[g] = rdlane_f(gs0[j], g * 16); gsc[4 + g] = rdlane_f(gs1[j], g * 16); }
            unsigned gmask = 0u;
#pragma unroll
            for (int g = 0; g < 8; ++g) { int cnt = 0;
#pragma unroll
                for (int g2 = 0; g2 < 8; ++g2) cnt += (gsc[g2] > gsc[g] || (gsc[g2] == gsc[g] && g2 < g)) ? 1 : 0;
                gmask |= (cnt < 4) ? (1u << g) : 0u; }
            const bool ok0 = (gmask >> (F.lane >> 4)) & 1u, ok1 = (gmask >> (4 + (F.lane >> 4))) & 1u;
            h0[j] = ok0 ? f_ord(e0[j]) : 0u; h1[j] = ok1 ? f_ord(e1[j]) : 0u;
            mye[j] = 0; myw[j] = 0.f; wsum[j] = 0.f; }
#pragma unroll
        for (int k = 0; k < 8; ++k) {
#pragma unroll
            for (int j = 0; j < RT; ++j) {
                const unsigned bh = h0[j] >= h1[j] ? h0[j] : h1[j];
                const unsigned H = wave_max_u(bh);
                const unsigned mylo = h0[j] == H ? (unsigned)(255 - F.lane) : (h1[j] == H ? (unsigned)(255 - 64 - F.lane) : 0u);
                const unsigned Lm = wave_max_u(mylo);
                const int e = 255 - (int)Lm;
                if (e < 64) { if (F.lane == e) h0[j] = 0u; } else { if (F.lane == e - 64) h1[j] = 0u; }
                const float sv = e < 64 ? rdlane_f(s0[j], e) : rdlane_f(s1[j], e - 64);
                wsum[j] += sv; if (F.lane == k) { mye[j] = e; myw[j] = sv; } }
        }
#pragma unroll
        for (int j = 0; j < RT; ++j) { const int tok = tb + j;
            if (tok < t1 && F.lane < 8) {
                const int lr = __hip_atomic_fetch_add(&hist[mye[j]], 1, __ATOMIC_RELAXED, __HIP_MEMORY_SCOPE_WORKGROUP);
                alist[(tok - t0) * 8 + F.lane] = (unsigned)mye[j] | ((unsigned)lr << 8);
                ((int*)(F.ws + WS_EIDX))[(size_t)tok * 8 + F.lane] = mye[j];
                ((float*)(F.ws + WS_WGT))[(size_t)tok * 8 + F.lane] = myw[j] / wsum[j] * 2.5f;
            } }
    }
    __syncthreads();
    if (F.tid < 128) { const int hcount = hist[F.tid]; base[F.tid] = hcount ? (int)atomicAdd(F.ctl + CW_CNT + l * 256 + F.tid, (unsigned)hcount) : 0; }
    __syncthreads();
    for (int a = F.tid; a < (t1 - t0) * 8; a += NTHR) { const unsigned v = alist[a]; ((int*)(F.ws + WS_RNK))[(size_t)t0 * 8 + a] = base[v & 0xffu] + (int)(v >> 8); }
}
__device__ __forceinline__ void ph_positions(Frame& F, int l, int ntok) {
    LAS int* cnt = (LAS int*)F.lds;
    LAS int* off = cnt + 132;
    __syncthreads();
    if (F.tid < NE1) cnt[F.tid] = F.tid < NEXP ? (int)__hip_atomic_load(F.ctl + CW_CNT + l * 256 + F.tid, __ATOMIC_RELAXED, __HIP_MEMORY_SCOPE_AGENT) : ntok;
    __syncthreads();
    if (F.tid == 0) { int o = 0; for (int e = 0; e < NE1; ++e) { off[e] = o; o += (cnt[e] + 255) & ~255; } off[NE1] = o; }
    __syncthreads();
    const int gt = F.wg * NTHR + F.tid, NGT = F.G * NTHR;
    int* rowtok = (int*)(F.ws + WS_ROWTOK); int* rowdst = (int*)(F.ws + WS_ROWDST); int* tile_exp = (int*)(F.ws + WS_TILEEXP);
    const int* eidx = (const int*)(F.ws + WS_EIDX); const int* rnk = (const int*)(F.ws + WS_RNK);
    for (int a = gt; a < ntok * 8; a += NGT) { const int tok = a >> 3, k = a & 7; const int pos = off[eidx[a]] + rnk[a]; rowtok[pos] = tok; rowdst[pos] = tok * 9 + k; }
    for (int tok = gt; tok < ntok; tok += NGT) { const int pos = off[NEXP] + tok; rowtok[pos] = tok; rowdst[pos] = tok * 9 + 8; }
    for (int i = gt; i < NE1 * 256; i += NGT) { const int e = i >> 8, p = i & 255; const int row = off[e] + cnt[e] + p; if (row < off[e + 1]) { rowtok[row] = 0; rowdst[row] = -1; } }
    for (int i = gt; i < NE1 * 320; i += NGT) { const int e = i / 320, p = i % 320; const int t = (off[e] >> 8) + p; if (t < (off[e + 1] >> 8)) tile_exp[t] = e; }
    if (gt == 0) F.ctl[CW_NTL + l] = (unsigned)(off[NE1] >> 8);
}

#ifndef MK_MULTI
#define MK_MULTI 0
#endif
constexpr int PH_PER_LAYER = 12, NPHASE = 2 + DEPTH * PH_PER_LAYER;
struct Args { const float* in[36]; float* out; unsigned char* ws; int ph_lo, ph_hi; };

__global__ void __launch_bounds__(NTHR, 2) mk_fwd(Args args) {
    extern __shared__ __attribute__((aligned(16))) unsigned char lds_raw[];
    Frame F;
    F.lds = (LAS unsigned char*)lds_raw;
    F.tid = threadIdx.x; F.lane = F.tid & 63; F.wave = __builtin_amdgcn_readfirstlane(F.tid >> 6);
    const int wave0 = F.wave;
    F.G = gridDim.x; F.wg = blockIdx.x;
    F.in = args.in;
    F.out = args.out; F.ws = args.ws; F.ctl = (unsigned*)(args.ws + WS_CTL);
    volatile LAS unsigned* MISC = (volatile LAS unsigned*)(F.lds + MISC_OFF);
    if (F.tid < 32) MISC[F.tid] = 0u;
    __syncthreads();
    const int lo = args.ph_lo, hi = args.ph_hi;
    const bool single = (hi - lo) > 1;
    XcdBarrier bar; bar.bar = F.ctl + CW_BAR; bar.x = 0; bar.st = nullptr;
    if (single) bar = xcd_barrier_post(F.ctl + CW_BAR, MISC + 8);
#define IN(k) (lo <= (k) && (k) < hi)
#ifndef PROBE_MASK
#define PROBE_MASK 0
#endif
#define REP(k) for (int _rep = 0; _rep < (((PROBE_MASK >> (k)) & 1) ? 2 : 1); ++_rep)
#define SEAM(k) do { if (IN(k) && IN((k) + 1)) { xcd_barrier(bar); if ((PROBE_MASK >> 15) & 1) xcd_barrier(bar); } } while (0)
#define FRESH() do { int _ln; asm volatile("v_mbcnt_lo_u32_b32 %0, -1, 0\n\tv_mbcnt_hi_u32_b32 %0, -1, %0" : "=v"(_ln)); int _wv = wave0; asm volatile("" : "+s"(_wv)); F.lane = _ln; F.wave = _wv; F.tid = (_wv << 6) | _ln; \
        unsigned char* _w = args.ws; asm volatile("" : "+s"(_w)); F.ws = _w; F.ctl = (unsigned*)(_w + WS_CTL); float* _o = args.out; asm volatile("" : "+s"(_o)); F.out = _o; } while (0)

    if (IN(0)) { FRESH(); REP(13) { p0_static_weights(F); __syncthreads(); } REP(14) { p0_mod(F); __syncthreads(); } FRESH(); REP(16) { p0_hyena_filters(F); __syncthreads(); } }
    SEAM(0);
    if (IN(1)) { FRESH(); p0_init_rows(F); }
    SEAM(1);
#pragma unroll 1
    for (int l = 0; l < DEPTH; ++l) {
        const int pb = 2 + l * PH_PER_LAYER; const bool last = (l == DEPTH - 1); const int ntok = last ? NLAT : NROW;
        if (IN(pb + 0)) { FRESH();
            REP(0) { p_expert_weights(F, l); __syncthreads(); }
            pg8::DenseOrder S; S.init(NROW, DIN, F.G, F.wg); pg8::EpiBf16 E{(bf16_t*)(F.ws + WS_U), DIN};
            REP(1) pg8::gemm_phase<pg8::EpiBf16, pg8::DenseOrder, false>(F.tid, F.lds, (const bf16_t*)(F.ws + WS_XM), (const bf16_t*)(F.ws + WS_WIN) + (size_t)l * DIN * DM, DM, nullptr, S, E);
        }
        SEAM(pb + 0);
        if (IN(pb + 1)) { FRESH(); REP(2) { ph_transposes(F, l); __syncthreads(); } FRESH(); REP(3) { ph_gla_local(F, l); __syncthreads(); } }
        SEAM(pb + 1);
        if (IN(pb + 2)) { FRESH(); REP(4) { ph_na(F, l, last); } FRESH(); REP(5) { ph_gla_scan(F); } __syncthreads(); FRESH(); REP(6) { ph_hyena(F, l, last); } }
        SEAM(pb + 2);
        if (IN(pb + 3)) { FRESH(); ph_hy_transpose(F, last); __syncthreads(); FRESH(); REP(7) { ph_gla_out(F, l, last); } }
        SEAM(pb + 3);
        if (IN(pb + 4)) { FRESH();
            pg8::DenseOrder S; S.init(ntok, DM, F.G, F.wg); pg8::EpiBf16 E{(bf16_t*)(F.ws + WS_Y), DM};
            REP(8) pg8::gemm_phase<pg8::EpiBf16, pg8::DenseOrder, false>(F.tid, F.lds, (const bf16_t*)(F.ws + WS_MIX), (const bf16_t*)(F.ws + WS_WOUT) + (size_t)l * DM * DM, DM, nullptr, S, E);
        }
        SEAM(pb + 4);
        if (IN(pb + 5)) { FRESH(); ph_ln1(F, l, ntok); }
        SEAM(pb + 5);
        if (IN(pb + 6)) { FRESH();
            pg8::DenseOrder S; S.init(ntok, 256, F.G, F.wg); pg8::EpiF32H E{(float*)(F.ws + WS_LOGIT), 256};
            REP(9) pg8::gemm_phase<pg8::EpiF32H, pg8::DenseOrder, false, false, true, true, true>(F.tid, F.lds, (const bf16_t*)(F.ws + WS_XM), (const bf16_t*)(F.ws + WS_WR) + (size_t)l * 256 * DM, DM, nullptr, S, E);
        }
        SEAM(pb + 6);
        if (IN(pb + 7)) { FRESH(); ph_route(F, l, ntok); }
        SEAM(pb + 7);
        if (IN(pb + 8)) { FRESH(); REP(12) { ph_positions(F, l, ntok); __syncthreads(); } }
        SEAM(pb + 8);
        if (IN(pb + 9)) { FRESH();
            const int ntl = (int)__hip_atomic_load(F.ctl + CW_NTL + l, __ATOMIC_RELAXED, __HIP_MEMORY_SCOPE_AGENT);
            pg8::GroupedOrder S; S.init(ntl, 2, F.G, F.wg); S.preload((const int*)(F.ws + WS_TILEEXP), F.lds + pg8::STAGE_BYTES + 4096, F.tid, NTHR); pg8::EpiSwiglu E{(unsigned char*)(F.ws + WS_ACT)};
            REP(10) pg8::gemm_phase<pg8::EpiSwiglu, pg8::GroupedOrder, true, true>(F.tid, F.lds, (const void*)(F.ws + WS_XM8), (const void*)(F.ws + WS_EXP1), DM, (const int*)(F.ws + WS_ROWTOK), S, E);
        }
        SEAM(pb + 9);
        if (IN(pb + 10)) { FRESH();
            const int ntl = (int)__hip_atomic_load(F.ctl + CW_NTL + l, __ATOMIC_RELAXED, __HIP_MEMORY_SCOPE_AGENT);
            pg8::GroupedOrder S; S.init(ntl, 4, F.G, F.wg); S.preload((const int*)(F.ws + WS_TILEEXP), F.lds + pg8::STAGE_BYTES + 4096, F.tid, NTHR); pg8::EpiScatter E{(unsigned char*)(F.ws + WS_Y2), (const int*)(F.ws + WS_ROWDST)};
            REP(11) pg8::gemm_phase<pg8::EpiScatter, pg8::GroupedOrder, false, true>(F.tid, F.lds, (const void*)(F.ws + WS_ACT), (const void*)(F.ws + WS_EXP2), EH, nullptr, S, E);
        }
        SEAM(pb + 10);
        if (IN(pb + 11)) { FRESH(); ph_ln2(F, l, ntok, last); }
        SEAM(pb + 11);
    }
#undef IN
#undef SEAM
#undef FRESH
}

extern "C" void kernel_launch(void* const* d_in, const int* in_sizes, int n_in, void* d_out, int out_size, void* d_ws, size_t ws_size, hipStream_t stream) {
    static int grid = 0;
    if (grid == 0) {
        if (n_in != 36 || out_size != NLAT * DM || ws_size < WS_END) { fprintf(stderr, "kernel_launch: unexpected shapes (n_in %d out %d ws %zu need %zu)\n", n_in, out_size, ws_size, (size_t)WS_END); grid = -1; return; }
        int dev = 0, cus = 0, per_cu = 0;
        if (hipGetDevice(&dev) != hipSuccess || hipDeviceGetAttribute(&cus, hipDeviceAttributeMultiprocessorCount, dev) != hipSuccess) { grid = -1; return; }
        if (hipFuncSetAttribute((const void*)mk_fwd, hipFuncAttributeMaxDynamicSharedMemorySize, LDS_BYTES) != hipSuccess) { fprintf(stderr, "kernel_launch: hipFuncSetAttribute failed\n"); grid = -1; return; }
        if (hipOccupancyMaxActiveBlocksPerMultiprocessor(&per_cu, (const void*)mk_fwd, NTHR, LDS_BYTES) != hipSuccess || per_cu < 1) { fprintf(stderr, "kernel_launch: occupancy query says %d\n", per_cu); }
        (void)hipGetLastError();
        grid = cus;
    }
    if (grid < 0) return;
    (void)hipMemsetAsync((char*)d_ws + WS_CTL, 0, CTL_BYTES, stream);
    Args a{};
    for (int i = 0; i < 36; ++i) a.in[i] = (const float*)d_in[i];
    a.out = (float*)d_out; a.ws = (unsigned char*)d_ws;
#if MK_MULTI
    for (int p = 0; p < NPHASE; ++p) { a.ph_lo = p; a.ph_hi = p + 1; hipLaunchKernelGGL(mk_fwd, dim3(grid), dim3(NTHR), LDS_BYTES, stream, a); }
#else
    a.ph_lo = 0; a.ph_hi = NPHASE; hipLaunchKernelGGL(mk_fwd, dim3(grid), dim3(NTHR), LDS_BYTES, stream, a);
#endif
}
```

```cpp
#include <hip/hip_runtime.h>
#include <cstdio>
#include <cstdint>

#define LAS __attribute__((address_space(3)))
#define GAS __attribute__((address_space(1)))
typedef unsigned short bf16_t;
typedef short bf16x8 __attribute__((ext_vector_type(8)));
typedef float f32x4 __attribute__((ext_vector_type(4)));
typedef float f32x2 __attribute__((ext_vector_type(2)));
typedef unsigned u32x4 __attribute__((ext_vector_type(4)));
typedef unsigned u32x2 __attribute__((ext_vector_type(2)));

constexpr int NB = 16, SEQ = 4096, CTXL = 256, DM = 1024, DEPTH = 4;
constexpr int NLAT = NB * SEQ;
constexpr int NCTX = NB * CTXL;
constexpr int NROW = NLAT + NCTX;
constexpr int SPB = SEQ + CTXL;
constexpr int DIN_REF = 3104;
constexpr int DIN = 3328;
constexpr int UQ = 0, UK = 512, UV = 1024, UGQ = 1536, UGK = 1664, UGV = 1792, UGR = 2048, UHY = 2304, ULAF = 3072, ULAB = 3200;
constexpr int NEXP = 128, TOPK = 8, EH = 256;
constexpr int NE1 = NEXP + 1;
constexpr int RMAX = 659712;
constexpr int TMAX = RMAX / 256;
constexpr float LN_EPS = 1e-6f;
constexpr float DN_ALPHA = 1.6817928305074290f;

__device__ __forceinline__ unsigned f2bf(float f) { unsigned u = __builtin_bit_cast(unsigned, f); return (u + 0x7fffu + ((u >> 16) & 1u)) >> 16; }
typedef __bf16 bf16v2 __attribute__((ext_vector_type(2)));
__device__ __forceinline__ unsigned pk2(float lo, float hi) { const f32x2 v = {lo, hi}; const bf16v2 b = __builtin_convertvector(v, bf16v2); return __builtin_bit_cast(unsigned, b); }
__device__ __forceinline__ float bf2f(unsigned short b) { return __builtin_bit_cast(float, ((unsigned)b) << 16); }
__device__ __forceinline__ float bflo(unsigned w) { return __builtin_bit_cast(float, w << 16); }
__device__ __forceinline__ float bfhi(unsigned w) { return __builtin_bit_cast(float, w & 0xffff0000u); }
__device__ __forceinline__ float shx(float v, int o, int lane) { return __builtin_bit_cast(float, __builtin_amdgcn_ds_bpermute((lane ^ o) << 2, __builtin_bit_cast(int, v))); }
__device__ __forceinline__ int shxi(int v, int o, int lane) { return __builtin_amdgcn_ds_bpermute((lane ^ o) << 2, v); }
__device__ __forceinline__ float shf(float v, int src) { return __builtin_bit_cast(float, __builtin_amdgcn_ds_bpermute(src << 2, __builtin_bit_cast(int, v))); }
__device__ __forceinline__ float wave_sum(float v, int lane) {
#pragma unroll
    for (int o = 1; o < 64; o <<= 1) v += shx(v, o, lane);
    return v;
}
__device__ __forceinline__ void unpack8(const u32x4 q, float* o) { o[0] = bflo(q.x); o[1] = bfhi(q.x); o[2] = bflo(q.y); o[3] = bfhi(q.y); o[4] = bflo(q.z); o[5] = bfhi(q.z); o[6] = bflo(q.w); o[7] = bfhi(q.w); }
__device__ __forceinline__ float silu_f(float x) { return x * __builtin_amdgcn_rcpf(1.0f + __expf(-x)); }
#define LDS_WAIT() asm volatile("s_waitcnt lgkmcnt(0)" ::: "memory")
#define VM_WAIT() asm volatile("s_waitcnt vmcnt(0)" ::: "memory")

#define XB_TMO      128
#define XB_XCNT(j)  (256  + 64 * (j))
#define XB_XSUB(j)  (1280 + 64 * (j))
#define XB_XGEN(j)  (2304 + 64 * (j))
#define XB_TOP      3328
#define XB_TOPGEN   3392
#define XCD_BAR_WORDS 3456
#define XB_SPIN_CAP (1u << 18)

__device__ __forceinline__ unsigned xb_ld(unsigned* p)              { return __hip_atomic_load(p, __ATOMIC_RELAXED, __HIP_MEMORY_SCOPE_AGENT); }
__device__ __forceinline__ unsigned xb_add(unsigned* p, unsigned v) { return __hip_atomic_fetch_add(p, v, __ATOMIC_RELAXED, __HIP_MEMORY_SCOPE_AGENT); }
__device__ __forceinline__ unsigned xb_xcc_id() { return (unsigned)__builtin_amdgcn_s_getreg((3 << 11) | 20) & 0xFu; }
#define XB_SPIN(cond, bar) do { unsigned _sp = 0; while (cond) { __builtin_amdgcn_s_sleep(1); \
    if ((++_sp & 255u) == 0u) { if (xb_ld(&(bar)[XB_TMO])) break; if (_sp > XB_SPIN_CAP) { atomicAdd(&(bar)[XB_TMO], 1u); break; } } } } while (0)

struct XcdBarrier { unsigned* bar; unsigned x; volatile LAS unsigned* st; };

__device__ __forceinline__ XcdBarrier xcd_barrier_post(unsigned* bar, volatile LAS unsigned* st) {
    XcdBarrier b; b.bar = bar; b.x = xb_xcc_id(); b.st = st;
    if (threadIdx.x == 0) (void)xb_add(&bar[XB_XCNT(b.x)], 1u);
    return b;
}
__device__ __forceinline__ void xcd_barrier_complete(unsigned* bar, unsigned x, unsigned& nloc, unsigned& nx) {
    const unsigned G = gridDim.x * gridDim.y * gridDim.z;
    unsigned sum, cnt, mine, sp = 0u;
    for (;;) {
        sum = 0u; cnt = 0u; mine = 0u;
#pragma unroll
        for (unsigned j = 0; j < 16; ++j) { const unsigned c = xb_ld(&bar[XB_XCNT(j)]); sum += c; cnt += (c > 0u) ? 1u : 0u; mine = (j == x) ? c : mine; }
        if (sum == G) break;
        __builtin_amdgcn_s_sleep(1);
        if ((++sp & 255u) == 0u) { if (xb_ld(&bar[XB_TMO])) break; if (sp > XB_SPIN_CAP) { atomicAdd(&bar[XB_TMO], 1u); break; } }
    }
    nloc = mine > 0u ? mine : 1u; nx = cnt > 0u ? cnt : 1u;
}
__device__ __forceinline__ void xcd_barrier(const XcdBarrier& b) {
    asm volatile("s_waitcnt vmcnt(0)" ::: "memory");
    __syncthreads();
    if (threadIdx.x == 0) {
        unsigned* bar = b.bar;
        __builtin_amdgcn_s_waitcnt(0);
        unsigned nloc = b.st[0], nx = b.st[1];
        if (nloc == 0u) { xcd_barrier_complete(bar, b.x, nloc, nx); b.st[0] = nloc; b.st[1] = nx; }
        const unsigned old = xb_add(&bar[XB_XSUB(b.x)], 1u);
        const unsigned gen = old / nloc;
        if (old + 1u == (gen + 1u) * nloc) {
            __builtin_amdgcn_fence(__ATOMIC_RELEASE, "agent");
            asm volatile("s_waitcnt vmcnt(0)" ::: "memory");
            const unsigned og = xb_add(&bar[XB_TOP], 1u);
            const unsigned tg = og / nx;
            if (og + 1u == (tg + 1u) * nx) xb_add(&bar[XB_TOPGEN], 1u);
            else XB_SPIN(xb_ld(&bar[XB_TOPGEN]) == tg, bar);
            __builtin_amdgcn_fence(__ATOMIC_ACQUIRE, "agent");
            xb_add(&bar[XB_XGEN(b.x)], 1u);
            asm volatile("s_waitcnt vmcnt(0)" ::: "memory");
        } else {
            XB_SPIN(xb_ld(&bar[XB_XGEN(b.x)]) == gen, bar);
            __builtin_amdgcn_fence(__ATOMIC_ACQUIRE, "agent");
            asm volatile("s_waitcnt vmcnt(0)" ::: "memory");
        }
    }
    __syncthreads();
}

namespace pg8 {
constexpr int BM = 256, BK = 64, HALF = 128, HTB = HALF * BK * 2, STAGE_BYTES = 8 * HTB, NXCD = 8, WGM = 8;
__host__ __device__ __forceinline__ int lds_byte(int r, int c) { const int st = (r >> 4) * 2 + (c >> 5), rr = r & 15, cc = c & 31, ob = rr * 64 + cc * 2; return st * 1024 + (ob ^ (((ob >> 9) & 1) << 5)); }
__host__ __device__ __forceinline__ void stage_rc(int b, int& R, int& C) { const int st = b / 1024, sb = b % 1024, swz = sb ^ (((sb >> 9) & 1) << 5); R = (st >> 1) * 16 + swz / 64; C = (st & 1) * 32 + (swz % 64) / 2; }
__host__ __device__ __forceinline__ int perm32(int rho) { const int n = rho >> 4, i = rho & 15; return 8 * (i >> 2) + 4 * n + (i & 3); }

struct Unit { int arow0, brow0, orow0, ocol0, aux; };

struct DenseOrder {
    int nM, nN, nwg, G, c;
    __device__ void init(int M, int N, int G_, int c_) { nM = M / BM; nN = N / BM; nwg = nM * nN; G = G_; c = c_; }
    __device__ __forceinline__ bool next(int i, Unit& u) const {
        const long L = (long)i * G + c; if (L >= nwg) return false;
        int wgid = (int)L; { const int q = nwg / NXCD, r = nwg % NXCD, xcd = wgid % NXCD, off = wgid / NXCD; wgid = (xcd < r ? xcd * (q + 1) : r * (q + 1) + (xcd - r) * q) + off; }
        const int nig = WGM * nN, gid = wgid / nig, fm = gid * WGM, gsz = (nM - fm) < WGM ? (nM - fm) : WGM;
        const int pm = fm + ((wgid % nig) % gsz), pn = (wgid % nig) / gsz;
        u.arow0 = pm * BM; u.brow0 = pn * BM; u.orow0 = pm * BM; u.ocol0 = pn * BM; u.aux = 0; return true;
    }
};
struct GroupedOrder {
    const LAS unsigned char* tab; int nN, nslot, slot, t0, t1;
    __device__ __forceinline__ void init(int ntiles, int nN_, int G, int c) {
        nN = nN_;
        if ((G & 7) == 0) { const int per = (ntiles + 7) >> 3, x = c & 7; nslot = G >> 3; slot = c >> 3; t0 = x * per; t1 = (t0 + per) < ntiles ? (t0 + per) : ntiles; }
        else { nslot = G; slot = c; t0 = 0; t1 = ntiles; }
    }
    __device__ __forceinline__ void preload(const int* tile_exp, LAS unsigned char* lds_tab, int tid, int nthr) {
        __syncthreads();
        for (int i = tid; i < t1 - t0; i += nthr) lds_tab[i] = (unsigned char)tile_exp[t0 + i];
        __syncthreads();
        tab = lds_tab;
    }
    __device__ __forceinline__ bool next(int i, Unit& u) const {
        const int q = i * nslot + slot, t = t0 + q / nN, pn = q % nN;
        if (t >= t1) return false;
        const int e = (int)tab[t - t0];
        u.arow0 = t * BM; u.brow0 = (e * nN + pn) * BM; u.orow0 = t * BM; u.ocol0 = pn * BM; u.aux = e; return true;
    }
};

template <class Base> struct RangeOrder {
    Base b; int i0, i1;
    __device__ __forceinline__ bool next(int i, Unit& u) const { const int j = i + i0; if (j >= i1) return false; return b.next(j, u); }
};

__device__ __forceinline__ unsigned cvt_pk_bf16(float lo, float hi) { return pk2(lo, hi); }

struct NoPre {};
struct EpiF32 {
    static constexpr bool PERM = false; static constexpr int SCW = 0x7A7A7A7A; typedef NoPre Pre;
    __device__ __forceinline__ Pre prefetch(const Unit&, LAS unsigned char*, int, int, int) const { return Pre{}; }
    float* C; int ldc;
    __device__ __forceinline__ void operator()(const f32x4 (&acc)[2][2][4][2], const Unit& u, int wr, int wc, int fr, int fq, const Pre&, bool drain) const {
        if (drain) asm volatile("s_waitcnt vmcnt(0)" ::: "memory");
        const int row0 = u.orow0 + wr * 64 + fr, col0 = u.ocol0 + wc * 32 + 4 * fq;
#pragma unroll
        for (int ai = 0; ai < 2; ++ai)
#pragma unroll
            for (int m = 0; m < 4; ++m) { float* rowp = C + (size_t)(row0 + ai * HALF + m * 16) * ldc + col0;
#pragma unroll
                for (int bj = 0; bj < 2; ++bj)
#pragma unroll
                    for (int n = 0; n < 2; ++n) *(GAS f32x4*)(rowp + bj * HALF + n * 16) = acc[ai][bj][m][n]; }
    }
};
struct EpiF32H {
    static constexpr bool PERM = false; static constexpr int SCW = 0x7A7A7A7A; typedef NoPre Pre;
    __device__ __forceinline__ Pre prefetch(const Unit&, LAS unsigned char*, int, int, int) const { return Pre{}; }
    float* C; int ldc;
    __device__ __forceinline__ void operator()(const f32x4 (&acc)[2][2][4][2], const Unit& u, int wr, int wc, int fr, int fq, const Pre&, bool drain) const {
        if (drain) asm volatile("s_waitcnt vmcnt(0)" ::: "memory");
        const int row0 = u.orow0 + wr * 64 + fr, col0 = wc * 32 + 4 * fq;
#pragma unroll
        for (int ai = 0; ai < 2; ++ai)
#pragma unroll
            for (int m = 0; m < 4; ++m) { float* rowp = C + (size_t)(row0 + ai * HALF + m * 16) * ldc + col0;
#pragma unroll
                for (int n = 0; n < 2; ++n) *(GAS f32x4*)(rowp + n * 16) = acc[ai][0][m][n]; }
    }
};
struct EpiBf16 {
    static constexpr bool PERM = true; static constexpr int SCW = 0x7A7A7A7A; typedef NoPre Pre;
    __device__ __forceinline__ Pre prefetch(const Unit&, LAS unsigned char*, int, int, int) const { return Pre{}; }
    bf16_t* O; int ldc;
    __device__ __forceinline__ void operator()(const f32x4 (&acc)[2][2][4][2], const Unit& u, int wr, int wc, int fr, int fq, const Pre&, bool drain) const {
        const int row0 = u.orow0 + wr * 64 + fr, col0 = u.ocol0 + wc * 32 + 8 * fq;
        u32x4 w[2][4][2];
#pragma unroll
        for (int ai = 0; ai < 2; ++ai)
#pragma unroll
            for (int m = 0; m < 4; ++m)
#pragma unroll
                for (int bj = 0; bj < 2; ++bj) { const f32x4 v0 = acc[ai][bj][m][0], v1 = acc[ai][bj][m][1];
                    w[ai][m][bj].x = cvt_pk_bf16(v0[0], v0[1]); w[ai][m][bj].y = cvt_pk_bf16(v0[2], v0[3]); w[ai][m][bj].z = cvt_pk_bf16(v1[0], v1[1]); w[ai][m][bj].w = cvt_pk_bf16(v1[2], v1[3]); }
        if (drain) asm volatile("s_waitcnt vmcnt(0)" ::: "memory");
#pragma unroll
        for (int ai = 0; ai < 2; ++ai)
#pragma unroll
            for (int m = 0; m < 4; ++m) { bf16_t* rowp = O + (size_t)(row0 + ai * HALF + m * 16) * ldc + col0;
#pragma unroll
                for (int bj = 0; bj < 2; ++bj) *(GAS u32x4*)(rowp + bj * HALF) = w[ai][m][bj]; }
    }
};
struct EpiSwiglu {
    static constexpr bool PERM = true; static constexpr int SCW = 0x7A7A7A7A; typedef NoPre Pre;
    __device__ __forceinline__ Pre prefetch(const Unit&, LAS unsigned char*, int, int, int) const { return Pre{}; }
    unsigned char* ACT;
    __device__ __forceinline__ void operator()(const f32x4 (&acc)[2][2][4][2], const Unit& u, int wr, int wc, int fr, int fq, const Pre&, bool drain) const {
        const int row0 = u.orow0 + wr * 64 + fr, pn = u.ocol0 >> 8;
        u32x2 o[2][4];
#pragma unroll
        for (int ai = 0; ai < 2; ++ai)
#pragma unroll
            for (int m = 0; m < 4; ++m) {
                int w[2];
#pragma unroll
                for (int n = 0; n < 2; ++n) { const f32x4 g = acc[ai][0][m][n], up = acc[ai][1][m][n];
                    f32x4 e;
#pragma unroll
                    for (int i = 0; i < 4; ++i) e[i] = __builtin_amdgcn_exp2f(-g[i]);
                    const f32x4 d = e + 1.0f; f32x4 r;
#pragma unroll
                    for (int i = 0; i < 4; ++i) r[i] = __builtin_amdgcn_rcpf(d[i]);
                    const f32x4 h = (g * up) * r;
                    int v = 0; v = __builtin_amdgcn_cvt_pk_fp8_f32(h[0], h[1], v, false); v = __builtin_amdgcn_cvt_pk_fp8_f32(h[2], h[3], v, true); w[n] = v; }
                o[ai][m] = (u32x2){(unsigned)w[0], (unsigned)w[1]}; }
        if (drain) asm volatile("s_waitcnt vmcnt(0)" ::: "memory");
#pragma unroll
        for (int ai = 0; ai < 2; ++ai)
#pragma unroll
            for (int m = 0; m < 4; ++m) *(GAS u32x2*)(ACT + (size_t)(row0 + ai * HALF + m * 16) * EH + pn * 128 + wc * 32 + 8 * fq) = o[ai][m];
    }
};
constexpr float Y2_SCALE = 16.0f, Y2_INV = 1.0f / 16.0f;
struct EpiScatter {
    static constexpr bool PERM = true; static constexpr int SCW = 0x7E7E7E7E;
    struct Pre { const LAS int* tab; };
    unsigned char* Y2; const int* rowdst;
    __device__ __forceinline__ Pre prefetch(const Unit& u, LAS unsigned char* lds, int wid, int lane, int ui) const {
        LAS unsigned char* tab = lds + STAGE_BYTES + (ui & 1) * 1024;
        if (wid < 4) __builtin_amdgcn_global_load_lds((const unsigned*)(rowdst + u.orow0 + wid * 64 + lane), (LAS unsigned*)(tab + wid * 256), 4, 0, 0);
        Pre p; p.tab = (const LAS int*)tab; return p; }
    __device__ __forceinline__ void operator()(const f32x4 (&acc)[2][2][4][2], const Unit& u, int wr, int wc, int fr, int fq, const Pre& pre, bool drain) const {
        u32x4 o[2][4]; int dst[2][4];
#pragma unroll
        for (int ai = 0; ai < 2; ++ai)
#pragma unroll
            for (int m = 0; m < 4; ++m) { dst[ai][m] = pre.tab[wr * 64 + fr + ai * HALF + m * 16];
                int w[4];
#pragma unroll
                for (int bj = 0; bj < 2; ++bj) { const f32x4 v0 = acc[ai][bj][m][0], v1 = acc[ai][bj][m][1];
                    int w0 = 0, w1 = 0;
                    w0 = __builtin_amdgcn_cvt_pk_fp8_f32(v0[0], v0[1], w0, false); w0 = __builtin_amdgcn_cvt_pk_fp8_f32(v0[2], v0[3], w0, true);
                    w1 = __builtin_amdgcn_cvt_pk_fp8_f32(v1[0], v1[1], w1, false); w1 = __builtin_amdgcn_cvt_pk_fp8_f32(v1[2], v1[3], w1, true);
                    w[2 * bj] = w0; w[2 * bj + 1] = w1; }
                o[ai][m] = (u32x4){(unsigned)w[0], (unsigned)w[1], (unsigned)w[2], (unsigned)w[3]}; }
        if (drain) asm volatile("s_waitcnt vmcnt(0)" ::: "memory");
#pragma unroll
        for (int ai = 0; ai < 2; ++ai)
#pragma unroll
            for (int m = 0; m < 4; ++m)
                if (dst[ai][m] >= 0) *(GAS u32x4*)(Y2 + (size_t)dst[ai][m] * DM + u.ocol0 + wc * 64 + fq * 16) = o[ai][m];
    }
};

typedef int v8i __attribute__((ext_vector_type(8)));
typedef int v4i __attribute__((ext_vector_type(4)));
struct Frag { bf16x8 p[2]; __device__ __forceinline__ bf16x8& operator[](int k) { return p[k]; } __device__ __forceinline__ const bf16x8& operator[](int k) const { return p[k]; } };
template <class Epi, class Sched, bool GATHER, bool F8 = false, bool ALIGN_EPI = true, bool SP2 = true, bool NHALF = false>
__device__ __forceinline__ void gemm_phase(const int tid_in, LAS unsigned char* lds, const void* Ag, const void* Bg, const int K, const int* rowidx, const Sched& S, const Epi& E) {
    int tid_ = tid_in; asm volatile("" : "+v"(tid_));
    const int tid = tid_, wid = __builtin_amdgcn_readfirstlane(tid >> 6), lane = tid & 63, wr = wid >> 2, wc = wid & 3, fr = lane & 15, fq = lane >> 4;
    const int KB = F8 ? K : 2 * K;
    const int nt = KB / 128;
    unsigned voffB[2];
#pragma unroll
    for (int i = 0; i < 2; ++i) { int R, C; stage_rc(tid * 16 + i * 8192, R, C); const int Rb = Epi::PERM ? ((R & ~31) + perm32(R & 31)) : R;
        voffB[i] = (unsigned)(Rb * KB + C * 2); }
    const size_t kstep = (size_t)128;
    const size_t hstep = (size_t)HALF * KB;
    const unsigned ldsw = (unsigned)wid * 1024u;
    const int aoff = F8 ? lds_byte(wr * 64 + fr, 16 * fq) : lds_byte(wr * 64 + fr, fq * 8), boff = F8 ? lds_byte(wc * 32 + fr, 16 * fq) : lds_byte(wc * 32 + fr, fq * 8);
    constexpr int PIECE1 = F8 ? 16 : 1024;
    const int sc_w = Epi::SCW, sc_a = 0x7F7F7F7F;
#define PG8_SA(b, h) (((b) * 2 + (h)) * HTB)
#define PG8_SB(b, h) ((4 + (b) * 2 + (h)) * HTB)
#define PG8_STAGE_B(bufoff, gbase) do { _Pragma("unroll") for (int _i = 0; _i < 2; ++_i) \
        __builtin_amdgcn_global_load_lds((const unsigned*)((const char*)(gbase) + voffB[_i]), (LAS unsigned*)(lds + (bufoff) + ldsw + _i * 8192), 16, 0, 0); } while (0)
#define PG8_STAGE_A(bufoff, gbase, h) do { const char* _gb = (const char*)(gbase) + (GATHER ? (size_t)0 : (size_t)(h) * hstep); \
        __builtin_amdgcn_global_load_lds((const unsigned*)(_gb + ac[GATHER ? (h) : 0][0]), (LAS unsigned*)(lds + (bufoff) + ldsw), 16, 0, 0); \
        __builtin_amdgcn_global_load_lds((const unsigned*)(_gb + ac[GATHER ? (h) : 0][1]), (LAS unsigned*)(lds + (bufoff) + ldsw + 8192), 16, 0, 0); } while (0)
#define PG8_LDA(dst, b, h) do { _Pragma("unroll") for (int m = 0; m < 4; ++m) { if constexpr (F8) { const v4i _l = *(const LAS v4i*)(lds + PG8_SA(b, h) + aoff + m * 2048), _h = *(const LAS v4i*)(lds + PG8_SA(b, h) + aoff + m * 2048 + PIECE1); dst##8[m] = __builtin_shufflevector(_l, _h, 0, 1, 2, 3, 4, 5, 6, 7); } \
        else { dst[m][0] = *(const LAS bf16x8*)(lds + PG8_SA(b, h) + aoff + m * 2048); dst[m][1] = *(const LAS bf16x8*)(lds + PG8_SA(b, h) + aoff + m * 2048 + PIECE1); } } } while (0)
#define PG8_LDB(dst, b, h) do { _Pragma("unroll") for (int n = 0; n < 2; ++n) { if constexpr (F8) { const v4i _l = *(const LAS v4i*)(lds + PG8_SB(b, h) + boff + n * 2048), _h = *(const LAS v4i*)(lds + PG8_SB(b, h) + boff + n * 2048 + PIECE1); dst##8[n] = __builtin_shufflevector(_l, _h, 0, 1, 2, 3, 4, 5, 6, 7); } \
        else { dst[n][0] = *(const LAS bf16x8*)(lds + PG8_SB(b, h) + boff + n * 2048); dst[n][1] = *(const LAS bf16x8*)(lds + PG8_SB(b, h) + boff + n * 2048 + PIECE1); } } } while (0)
#define PG8_MMA(ai, bj, At, Bt) do { __builtin_amdgcn_s_setprio(1); _Pragma("unroll") for (int m = 0; m < 4; ++m) _Pragma("unroll") for (int n = 0; n < 2; ++n) { \
        if constexpr (F8) asm volatile("v_mfma_scale_f32_16x16x128_f8f6f4 %0, %1, %2, %0, %3, %4 op_sel_hi:[0,0,0]" : "+v"(acc[ai][bj][m][n]) : "v"(Bt##8[n]), "v"(At##8[m]), "v"(sc_w), "v"(sc_a)); \
        else { _Pragma("unroll") for (int k = 0; k < 2; ++k) acc[ai][bj][m][n] = __builtin_amdgcn_mfma_f32_16x16x32_bf16(Bt[n][k], At[m][k], acc[ai][bj][m][n], 0, 0, 0); } } \
        __builtin_amdgcn_s_setprio(0); } while (0)
#define PG8_WAIT_V(n) asm volatile("s_waitcnt vmcnt(" #n ")" ::: "memory")
#define PG8_WAIT_LOOP do { if constexpr (NHALF) PG8_WAIT_V(6); else PG8_WAIT_V(8); } while (0)
#define PG8_WAIT_L(n) asm volatile("s_waitcnt lgkmcnt(" #n ")" ::: "memory")
#define PG8_BAR __builtin_amdgcn_s_barrier()
#define PG8_SCHED __builtin_amdgcn_sched_barrier(0)
#define PG8_TAB(par) (lds + STAGE_BYTES + 2048 + (par) * 1024)
#define PG8_TABLOAD(par, row0) do { if (wid < 4) __builtin_amdgcn_global_load_lds((const unsigned*)(rowidx + (row0) + wid * 64 + lane), (LAS unsigned*)(PG8_TAB(par) + wid * 256), 4, 0, 0); } while (0)
#define PG8_AOFF_H(h, par) do { int _tz = tid; asm volatile("" : "+v"(_tz)); _Pragma("unroll") for (int _i = 0; _i < 2; ++_i) { int _R, _C; stage_rc(_tz * 16 + _i * 8192, _R, _C); \
        if (GATHER) ac[h][_i] = ((const LAS unsigned*)PG8_TAB(par))[(h) * HALF + _R] * (unsigned)KB + (unsigned)_C * 2u; \
        else ac[h][_i] = (unsigned)(((h) * HALF + _R) * KB) + (unsigned)_C * 2u; } } while (0)
    static_assert(SP2, "only the two-super-phase K-loop is kept");
    Unit cur, nxt; int ui = 0;
    if (!S.next(0, cur)) return;
    f32x4 acc[2][2][4][2];
#pragma unroll
    for (int a = 0; a < 2; ++a)
#pragma unroll
        for (int b = 0; b < 2; ++b)
#pragma unroll
            for (int m = 0; m < 4; ++m)
#pragma unroll
                for (int n = 0; n < 2; ++n) acc[a][b][m][n] = (f32x4){0.f, 0.f, 0.f, 0.f};
    bf16x8 At[F8 ? 1 : 4][2], B0[F8 ? 1 : 2][2], B1[F8 ? 1 : 2][2];
    v8i At8[F8 ? 4 : 1], B08[F8 ? 2 : 1], B18[F8 ? 2 : 1];
    unsigned ac[GATHER ? 2 : 1][2];
    if (GATHER) { PG8_TABLOAD(0, cur.arow0); PG8_WAIT_V(0); PG8_BAR; }
    PG8_AOFF_H(0, 0); if (GATHER) { PG8_AOFF_H((GATHER ? 1 : 0), 0); }
    const char* cA = (const char*)Ag + (GATHER ? (size_t)0 : (size_t)cur.arow0 * KB); const char* cB = (const char*)Bg + (size_t)cur.brow0 * KB;
    PG8_STAGE_B(PG8_SB(0, 0), cB); if constexpr (!NHALF) PG8_STAGE_B(PG8_SB(0, 1), cB + hstep); PG8_STAGE_A(PG8_SA(0, 0), cA, 0); PG8_STAGE_A(PG8_SA(0, 1), cA, 1);
    if (wr == 1) PG8_BAR;
    PG8_WAIT_V(2); PG8_BAR;
    PG8_STAGE_B(PG8_SB(1, 0), cB + kstep); PG8_STAGE_A(PG8_SA(1, 0), cA + kstep, 0); if constexpr (!NHALF) PG8_STAGE_B(PG8_SB(1, 1), cB + hstep + kstep);
    if constexpr (NHALF) PG8_WAIT_V(4); else PG8_WAIT_V(6);
    PG8_BAR;
    for (;;) {
        const typename Epi::Pre pre = E.prefetch(cur, lds, wid, lane, ui);
        const bool has_next = S.next(ui + 1, nxt);
        if (GATHER) { if (has_next) PG8_TABLOAD((ui + 1) & 1, nxt.arow0); }
        const char* nA = has_next ? ((const char*)Ag + (GATHER ? (size_t)0 : (size_t)nxt.arow0 * KB)) : cA; const char* nB = has_next ? (const char*)Bg + (size_t)nxt.brow0 * KB : cB;
_Pragma("nounroll")
        for (int t = 0; t < nt; t += 2) {
            const bool last = (t == nt - 2);
            const bool skipw = (t == 0) && (ui > 0);
            const char* a1 = cA + (size_t)(t + 1) * kstep;
            const char* a2 = last ? nA : cA + (size_t)(t + 2) * kstep; const char* b2 = last ? nB : cB + (size_t)(t + 2) * kstep;
            const char* a3 = a2 + kstep; const char* b3 = b2 + kstep;
            if (GATHER) { if (last && has_next) { PG8_AOFF_H(0, (ui + 1) & 1); } }
            PG8_LDB(B0, 0, 0); if constexpr (!NHALF) PG8_LDB(B1, 0, 1); PG8_SCHED; PG8_LDA(At, 0, 0); PG8_STAGE_A(PG8_SA(1, 1), a1, 1);
            if (!skipw) PG8_WAIT_LOOP; PG8_WAIT_L(0); PG8_BAR; PG8_MMA(0, 0, At, B0); if constexpr (!NHALF) PG8_MMA(0, 1, At, B1); PG8_BAR; PG8_SCHED;
            if (GATHER) { if (last && has_next) { PG8_AOFF_H(1, (ui + 1) & 1); } }
            PG8_LDA(At, 0, 1); PG8_STAGE_B(PG8_SB(0, 0), b2); if constexpr (!NHALF) PG8_STAGE_B(PG8_SB(0, 1), b2 + hstep); PG8_STAGE_A(PG8_SA(0, 0), a2, 0);
            if (!skipw) PG8_WAIT_LOOP; PG8_WAIT_L(0); PG8_BAR; PG8_MMA(1, 0, At, B0); if constexpr (!NHALF) PG8_MMA(1, 1, At, B1); PG8_BAR; PG8_SCHED;
            PG8_LDB(B0, 1, 0); if constexpr (!NHALF) PG8_LDB(B1, 1, 1); PG8_SCHED; PG8_LDA(At, 1, 0); PG8_STAGE_A(PG8_SA(0, 1), a2, 1);
            if (!skipw) PG8_WAIT_LOOP; PG8_WAIT_L(0); PG8_BAR; PG8_MMA(0, 0, At, B0); if constexpr (!NHALF) PG8_MMA(0, 1, At, B1); PG8_BAR; PG8_SCHED;
            PG8_LDA(At, 1, 1); PG8_STAGE_B(PG8_SB(1, 0), b3); if constexpr (!NHALF) PG8_STAGE_B(PG8_SB(1, 1), b3 + hstep); PG8_STAGE_A(PG8_SA(1, 0), a3, 0);
            PG8_WAIT_LOOP; PG8_WAIT_L(0); PG8_BAR; PG8_MMA(1, 0, At, B0); if constexpr (!NHALF) PG8_MMA(1, 1, At, B1); PG8_BAR; PG8_SCHED;
        }
        if constexpr (ALIGN_EPI) { if (wr == 0) PG8_BAR; }
        E(acc, cur, wr, wc, fr, fq, pre, has_next);
        if (!has_next) break;
#pragma unroll
        for (int a = 0; a < 2; ++a)
#pragma unroll
            for (int b = 0; b < 2; ++b)
#pragma unroll
                for (int m = 0; m < 4; ++m)
#pragma unroll
                    for (int n = 0; n < 2; ++n) acc[a][b][m][n] = (f32x4){0.f, 0.f, 0.f, 0.f};
        cur = nxt; cA = nA; cB = nB; ++ui;
        if constexpr (ALIGN_EPI) { if (wr == 1) PG8_BAR; }
    }
    PG8_WAIT_V(0);
    if constexpr (!ALIGN_EPI) { if (wr == 0) PG8_BAR; }
    PG8_BAR;
#undef PG8_SA
#undef PG8_SB
#undef PG8_STAGE_A
#undef PG8_STAGE_B
#undef PG8_LDA
#undef PG8_LDB
#undef PG8_MMA
#undef PG8_WAIT_V
#undef PG8_WAIT_L
#undef PG8_WAIT_LOOP
#undef PG8_BAR
#undef PG8_SCHED
#undef PG8_AOFF_H
#undef PG8_TAB
#undef PG8_TABLOAD
}
}

constexpr int NWAVES = 8, NTHR = 512;
constexpr size_t MiB = 1u << 20;
constexpr size_t WS_CTL = 0, CTL_BYTES = 1 * MiB;
constexpr size_t WS_MOD = 1 * MiB;
constexpr size_t WS_WIN = 3 * MiB;
constexpr size_t WS_WOUT = 29 * MiB;
constexpr size_t WS_WR = 37 * MiB;
constexpr size_t WS_HYF = 39 * MiB;
constexpr size_t WS_HYFC = 71 * MiB;
constexpr size_t WS_XC = 73 * MiB;
constexpr size_t WS_EXP1 = 89 * MiB;
constexpr size_t WS_EXP2 = 218 * MiB;
constexpr size_t WS_XM = 283 * MiB;
constexpr size_t WS_EIDX = 419 * MiB;
constexpr size_t WS_WGT = 422 * MiB;
constexpr size_t WS_RNK = 425 * MiB;
constexpr size_t WS_ROWTOK = 428 * MiB;
constexpr size_t WS_ROWDST = 431 * MiB;
constexpr size_t WS_TILEEXP = 434 * MiB;
constexpr size_t WS_BIG = 435 * MiB;
constexpr size_t WS_U = WS_BIG;
constexpr size_t WS_MIX = 877 * MiB;
constexpr size_t WS_VT = 1013 * MiB;
constexpr size_t WS_HV = 1081 * MiB;
constexpr size_t WS_Z2 = 1183 * MiB;
constexpr size_t WS_GDS = 1217 * MiB;
constexpr size_t WS_GSIN = 1285 * MiB;
constexpr size_t WS_GD = 1319 * MiB;
constexpr size_t WS_Y = 1321 * MiB;
constexpr size_t WS_LOGIT = WS_BIG;
constexpr size_t WS_ACT = WS_BIG;
constexpr size_t WS_Y2 = 758 * MiB;
constexpr size_t WS_XM8 = 1470 * MiB;
constexpr size_t WS_XR = 1600 * MiB;
constexpr size_t WS_END = 1736 * MiB;
constexpr int CW_BAR = 4096;
constexpr int CW_CNT = 16384;
constexpr int CW_NTL = 20480;

constexpr int LDS_BYTES = 163840;
constexpr int MISC_OFF = 163584;

struct Frame {
    LAS unsigned char* lds;
    int tid, lane, wave, G, wg;
    const float* const* in;
    float* out; unsigned char* ws; unsigned* ctl;
};
enum { I_X = 0, I_C, I_CTX, I_CCTX, I_WMOD, I_BMOD, I_WIN, I_RPB, I_WA2, I_BA2, I_GNORM, I_HSW, I_HSB, I_HW1, I_HB1, I_HF1, I_HW2, I_HB2, I_HF2, I_HW3, I_HB3, I_HDEC, I_HSKIP,
       I_WOUT, I_LN1G, I_LN1B, I_RW, I_RB, I_WEG, I_WEU, I_WED, I_WSG, I_WSU, I_WSD, I_LN2G, I_LN2B };

__device__ __forceinline__ int row_b(int row) { return row < NLAT ? (row >> 12) : 16; }
__device__ __forceinline__ const float* mod_ptr(const Frame& F, int l, int row) { return (const float*)(F.ws + WS_MOD) + ((size_t)l * 17 + row_b(row)) * 6144; }

constexpr float NA_QSCALE = 0.125f * 1.4426950408889634f, NA_CLAMP = 60.0f * 1.4426950408889634f;
template <class RowFn>
__device__ __forceinline__ void tr_item(const float* W, int ldw, int k0, int n0, bf16_t* dst, int ldd, RowFn rf, LAS float* scr, int lane, float scale = 1.0f) {
    float tv[32];
    const GAS float* wp = (const GAS float*)(W + (size_t)(k0 + (lane >> 5)) * ldw + n0 + (lane & 31));
#pragma unroll
    for (int i = 0; i < 32; ++i) tv[i] = __builtin_nontemporal_load(wp + (size_t)(2 * i) * ldw);
#pragma unroll
    for (int i = 0; i < 32; ++i) scr[(2 * i + (lane >> 5)) * 33 + (lane & 31)] = tv[i];
    LDS_WAIT(); asm volatile("" ::: "memory");
    const int c = lane & 7;
#pragma unroll
    for (int j = 0; j < 4; ++j) { const int n = (lane >> 3) + 8 * j; const LAS float* s = scr + (8 * c) * 33 + n;
        u32x4 o; o.x = pk2(s[0 * 33] * scale, s[1 * 33] * scale); o.y = pk2(s[2 * 33] * scale, s[3 * 33] * scale); o.z = pk2(s[4 * 33] * scale, s[5 * 33] * scale); o.w = pk2(s[6 * 33] * scale, s[7 * 33] * scale);
        *(GAS u32x4*)(dst + (size_t)rf(n0 + n) * ldd + k0 + 8 * c) = o; }
    LDS_WAIT(); asm volatile("" ::: "memory");
}
template <class RowFn>
__device__ __forceinline__ void tr_item8(const float* W, int ldw, int k0, int n0, unsigned char* dst, int ldd, RowFn rf, float scale, LAS float* scr, int lane) {
    float tv[32];
    const GAS float* wp = (const GAS float*)(W + (size_t)(k0 + (lane >> 5)) * ldw + n0 + (lane & 31));
#pragma unroll
    for (int i = 0; i < 32; ++i) tv[i] = __builtin_nontemporal_load(wp + (size_t)(2 * i) * ldw);
#pragma unroll
    for (int i = 0; i < 32; ++i) scr[(2 * i + (lane >> 5)) * 33 + (lane & 31)] = tv[i];
    LDS_WAIT(); asm volatile("" ::: "memory");
    const int n = lane >> 1, hf = lane & 1; const LAS float* s = scr + (32 * hf) * 33 + n;
    unsigned w[8];
#pragma unroll
    for (int j = 0; j < 8; ++j) { int v = 0; v = __builtin_amdgcn_cvt_pk_fp8_f32(s[(4 * j) * 33] * scale, s[(4 * j + 1) * 33] * scale, v, false); v = __builtin_amdgcn_cvt_pk_fp8_f32(s[(4 * j + 2) * 33] * scale, s[(4 * j + 3) * 33] * scale, v, true); w[j] = (unsigned)v; }
    unsigned char* d = dst + (size_t)rf(n0 + n) * ldd + k0 + 32 * hf;
    *(GAS u32x4*)d = (u32x4){w[0], w[1], w[2], w[3]}; *(GAS u32x4*)(d + 16) = (u32x4){w[4], w[5], w[6], w[7]};
    LDS_WAIT(); asm volatile("" ::: "memory");
}
struct RowId { __device__ __forceinline__ int operator()(int n) const { return n; } };
struct RowWin { __device__ __forceinline__ int operator()(int n) const { return n >= 2336 ? n - 32 : n; } };
struct RowGU { int up; __device__ __forceinline__ int operator()(int j) const { return (j >> 7) * 256 + up * 128 + (j & 127); } };

__device__ __forceinline__ void p0_static_weights(Frame& F) {
    LAS float* scr = (LAS float*)(F.lds + F.wave * 16384);
    const int gw = F.wg * NWAVES + F.wave, NGW = F.G * NWAVES;
    constexpr int I_IN = 16 * 97, I_OUT = 16 * 32, I_R = 16 * 4, PER_L = I_IN + I_OUT + I_R;
    for (int it = gw; it < DEPTH * PER_L; it += NGW) {
        const int l = it / PER_L; int r = it % PER_L;
        if (r < I_IN) { const int kb = r / 97, nb = r % 97; if (nb == 72) continue;
            tr_item(F.in[I_WIN] + (size_t)l * DM * DIN_REF, DIN_REF, kb * 64, nb * 32, (bf16_t*)(F.ws + WS_WIN) + (size_t)l * DIN * DM, DM, RowWin{}, scr, F.lane, nb < 16 ? NA_QSCALE : 1.0f); continue; }
        r -= I_IN;
        if (r < I_OUT) { const int kb = r / 32, nb = r % 32;
            tr_item(F.in[I_WOUT] + (size_t)l * DM * DM, DM, kb * 64, nb * 32, (bf16_t*)(F.ws + WS_WOUT) + (size_t)l * DM * DM, DM, RowId{}, scr, F.lane); continue; }
        r -= I_OUT;
        { const int kb = r / 4, nb = r % 4;
            tr_item(F.in[I_RW] + (size_t)l * DM * NEXP, NEXP, kb * 64, nb * 32, (bf16_t*)(F.ws + WS_WR) + (size_t)l * 256 * DM, DM, RowId{}, scr, F.lane); }
    }
    const int gt = F.wg * NTHR + F.tid, NGT = F.G * NTHR;
    for (int i = gt; i < DEPTH * 128 * DM / 8; i += NGT) { const int l = i / (128 * DM / 8), r = i % (128 * DM / 8);
        *(u32x4*)((bf16_t*)(F.ws + WS_WR) + ((size_t)l * 256 + 128) * DM + (size_t)r * 8) = (u32x4){0u, 0u, 0u, 0u}; }
    for (int i = gt; i < DEPTH * 256 * DM; i += NGT) {
        const int k = i % DM, n = (i / DM) % 256, l = i / (DM * 256), dir = n >> 7, j = n & 127;
        const float* wi = F.in[I_WIN] + ((size_t)l * DM + k) * DIN_REF + 2304 + dir * 16;
        const float* wa = F.in[I_WA2] + ((size_t)(l * 2 + dir) * 16) * 128 + j;
        float s = 0.f;
#pragma unroll
        for (int r = 0; r < 16; ++r) s += wi[r] * wa[r * 128];
        ((bf16_t*)(F.ws + WS_WIN))[((size_t)l * DIN + 3072 + n) * DM + k] = (bf16_t)f2bf(s);
    }
}
__device__ __forceinline__ void p0_mod(Frame& F) {
    LAS float* sc = (LAS float*)F.lds;
    LAS float* red = (LAS float*)(F.lds + 17 * 1024 * 4);
    for (int i = F.tid; i < 17 * 1024; i += NTHR) { const int r = i >> 10, k = i & 1023; const float v = r < 16 ? F.in[I_C][r * 1024 + k] : F.in[I_CCTX][k]; sc[i] = silu_f(v); }
    __syncthreads();
    const int kq = F.tid >> 7, cl = F.tid & 127;
    for (int u = F.wg; u < DEPTH * 48; u += F.G) {
        const int l = u / 48, col = (u % 48) * 128 + cl;
        const float* w = F.in[I_WMOD] + (size_t)l * DM * 6144 + col;
        float a[17];
#pragma unroll
        for (int r = 0; r < 17; ++r) a[r] = 0.f;
        for (int k0 = kq * 256; k0 < kq * 256 + 256; k0 += 16) {
            float wv[16];
#pragma unroll
            for (int q = 0; q < 16; ++q) wv[q] = *(const GAS float*)(w + (size_t)(k0 + q) * 6144);
#pragma unroll
            for (int q = 0; q < 16; ++q)
#pragma unroll
                for (int r = 0; r < 17; ++r) a[r] += sc[r * 1024 + k0 + q] * wv[q]; }
#pragma unroll
        for (int r = 0; r < 17; ++r) red[(kq * 17 + r) * 128 + cl] = a[r];
        __syncthreads();
        for (int i = F.tid; i < 17 * 128; i += NTHR) { const int r = i >> 7, c2 = i & 127, cc = (u % 48) * 128 + c2;
            const float s = red[(0 * 17 + r) * 128 + c2] + red[(1 * 17 + r) * 128 + c2] + red[(2 * 17 + r) * 128 + c2] + red[(3 * 17 + r) * 128 + c2] + F.in[I_BMOD][l * 6144 + cc];
            ((float*)(F.ws + WS_MOD))[((size_t)l * 17 + r) * 6144 + cc] = s; }
        __syncthreads();
    }
}
__device__ __forceinline__ void p0_hyena_filters(Frame& F) {
    LAS float* z = (LAS float*)F.lds;
    LAS float* h1 = z + 1092;
    LAS float* h2 = h1 + 33 * 64;
    LAS float* tt = h2 + 33 * 64;
    LAS float* W1 = tt + 64;
    LAS float* W2 = W1 + 33 * 64;
    constexpr int UL = 4096 / 32, UC = 256 / 32, UPL = UL + UC;
    for (int u = F.wg; u < DEPTH * UPL; u += F.G) {
        const int l = u / UPL, r = u % UPL; const bool lat = r < UL; const int L = lat ? 4096 : 256, n0 = (lat ? r : r - UL) * 32;
        __syncthreads();
        for (int i = F.tid; i < 33 * 64; i += NTHR) W1[i] = F.in[I_HW1][(size_t)l * 33 * 64 + i];
        for (int i = F.tid; i < 64 * 64; i += NTHR) W2[i] = F.in[I_HW2][(size_t)l * 64 * 64 + i];
        for (int i = F.tid; i < 33 * 33; i += NTHR) { const int p = i / 33, e = i % 33, n = n0 + p;
            const float t = (float)n / (float)(L - 1);
            float v;
            if (e == 0) v = t;
            else { const int kb = (e - 1) & 15; const float band = 1e-4f + (float)kb * ((15.0f - 1e-4f) / 15.0f);
                   const float w = 6.283185307179586f * (float)n / (float)L; const float ang = w * band;
                   v = e <= 16 ? __cosf(ang) : -__sinf(ang); }
            z[i] = v; if (e == 0) tt[p] = t; }
        __syncthreads();
        for (int i = F.tid; i < 33 * 64; i += NTHR) { const int p = i >> 6, j = i & 63; float s = F.in[I_HB1][l * 64 + j];
#pragma unroll 11
            for (int e = 0; e < 33; ++e) s += z[p * 33 + e] * W1[e * 64 + j];
            h1[i] = __sinf(F.in[I_HF1][l * 64 + j] * s); }
        __syncthreads();
        for (int i = F.tid; i < 33 * 64; i += NTHR) { const int p = i >> 6, j = i & 63; float s = F.in[I_HB2][l * 64 + j];
#pragma unroll 16
            for (int e = 0; e < 64; ++e) s += h1[p * 64 + e] * W2[e * 64 + j];
            h2[i] = __sinf(F.in[I_HF2][l * 64 + j] * s); }
        __syncthreads();
        {
            const int g = F.tid >> 8, col0 = 4 * (F.tid & 255), o = col0 >> 9, dir = (col0 >> 8) & 1, ch0 = col0 & 255;
            const int pb = (dir ? 0 : 1) + 16 * g;
            float a[4][16];
#pragma unroll
            for (int j = 0; j < 4; ++j)
#pragma unroll
                for (int q = 0; q < 16; ++q) a[j][q] = 0.f;
            const float* w3 = F.in[I_HW3] + (size_t)l * 64 * 1024 + col0;
            const LAS float* hp = h2 + pb * 64;
            f32x4 wa[4], wb[4];
#pragma unroll
            for (int q = 0; q < 4; ++q) wa[q] = *(const GAS f32x4*)(w3 + (size_t)q * 1024);
#define HF_BLOCK(wv_, k0_) do { _Pragma("unroll") for (int pi = 0; pi < 16; ++pi) { const f32x4 hv = *(const LAS f32x4*)(hp + pi * 64 + (k0_)); \
                _Pragma("unroll") for (int q = 0; q < 4; ++q) _Pragma("unroll") for (int j = 0; j < 4; ++j) a[j][pi] += hv[q] * wv_[q][j]; } } while (0)
#pragma unroll 1
            for (int k0 = 0; k0 < 64; k0 += 8) {
#pragma unroll
                for (int q = 0; q < 4; ++q) wb[q] = *(const GAS f32x4*)(w3 + (size_t)(k0 + 4 + q) * 1024);
                __builtin_amdgcn_sched_barrier(0);
                HF_BLOCK(wa, k0);
                __builtin_amdgcn_sched_barrier(0);
                { const int kn = k0 + 8 < 64 ? k0 + 8 : k0;
#pragma unroll
                  for (int q = 0; q < 4; ++q) wa[q] = *(const GAS f32x4*)(w3 + (size_t)(kn + q) * 1024); }
                __builtin_amdgcn_sched_barrier(0);
                HF_BLOCK(wb, k0 + 4);
                __builtin_amdgcn_sched_barrier(0);
            }
#undef HF_BLOCK
            const f32x4 b3 = *(const GAS f32x4*)(F.in[I_HB3] + l * 1024 + col0), dc = *(const GAS f32x4*)(F.in[I_HDEC] + ((size_t)(l * 2 + o) * 2 + dir) * 256 + ch0);
            float a0[4] = {0.f, 0.f, 0.f, 0.f};
            if (n0 == 0 && dir == 0 && g == 0) {
                for (int k = 0; k < 64; ++k) { const f32x4 wv = *(const GAS f32x4*)(w3 + (size_t)k * 1024); const float hv = h2[k];
#pragma unroll
                    for (int j = 0; j < 4; ++j) a0[j] += hv * wv[j]; } }
#pragma unroll
            for (int j = 0; j < 4; ++j) {
                const float dec = fabsf(dc[j]);
                bf16_t* R = lat ? (bf16_t*)(F.ws + WS_HYF) + ((size_t)(l * 2 + o) * 256 + ch0 + j) * 8192 : (bf16_t*)(F.ws + WS_HYFC) + ((size_t)(l * 2 + o) * 256 + ch0 + j) * 512;
                float v[16];
#pragma unroll
                for (int pi = 0; pi < 16; ++pi) v[pi] = (a[j][pi] + b3[j]) * __expf(-tt[pb + pi] * dec);
                unsigned w[8];
                if (dir == 0) {
                    if (n0 + 32 == L && g == 1) v[15] = 0.f;
#pragma unroll
                    for (int q = 0; q < 8; ++q) w[q] = pk2(v[15 - 2 * q], v[14 - 2 * q]);
                    GAS u32x4* dst = (GAS u32x4*)(R + (L - n0 - 32) + 16 * (1 - g));
                    dst[0] = (u32x4){w[0], w[1], w[2], w[3]}; dst[1] = (u32x4){w[4], w[5], w[6], w[7]};
                    if (n0 == 0 && g == 0) R[L] = (bf16_t)f2bf((a0[j] + b3[j]) * __expf(-tt[0] * dec) + F.in[I_HSKIP][(l * 2 + o) * 256 + ch0 + j]);
                } else if (n0 > 0 || g == 1) {
#pragma unroll
                    for (int q = 0; q < 8; ++q) w[q] = pk2(v[2 * q], v[2 * q + 1]);
                    GAS u32x4* dst = (GAS u32x4*)(R + (L + n0) + 16 * g);
                    dst[0] = (u32x4){w[0], w[1], w[2], w[3]}; dst[1] = (u32x4){w[4], w[5], w[6], w[7]};
                } else {
#pragma unroll
                    for (int pi = 1; pi < 16; ++pi) R[L + pi] = (bf16_t)f2bf(v[pi]);
                }
            }
        }
    }
    __syncthreads();
}
__device__ __forceinline__ void p0_init_rows(Frame& F) {
    const int gw = F.wg * NWAVES + F.wave, NGW = F.G * NWAVES;
    for (int row = gw; row < NROW; row += NGW) {
        const float* src = row < NLAT ? F.in[I_X] + (size_t)row * DM : F.in[I_CTX] + (size_t)(row - NLAT) * DM;
        const float* md = mod_ptr(F, 0, row);
        bf16_t* xr = (bf16_t*)(F.ws + WS_XR) + (size_t)row * DM; bf16_t* xm = (bf16_t*)(F.ws + WS_XM) + (size_t)row * DM;
#pragma unroll
        for (int j = 0; j < 4; ++j) { const int c = 4 * F.lane + 256 * j;
            const f32x4 v = __builtin_nontemporal_load((const GAS f32x4*)(src + c)), sh = *(const GAS f32x4*)(md + c), sc = *(const GAS f32x4*)(md + 1024 + c);
            *(GAS u32x2*)(xr + c) = (u32x2){pk2(v[0], v[1]), pk2(v[2], v[3])};
            u32x2 w; w.x = pk2(v[0] * (1.f + sc[0]) + sh[0], v[1] * (1.f + sc[1]) + sh[1]); w.y = pk2(v[2] * (1.f + sc[2]) + sh[2], v[3] * (1.f + sc[3]) + sh[3]);
            *(GAS u32x2*)(xm + c) = w; }
    }
}
constexpr float WEXP_SCALE = 32.0f;
__device__ __forceinline__ void p_expert_weights(Frame& F, int l) {
    LAS float* scr = (LAS float*)(F.lds + F.wave * 16384);
    const int gw = F.wg * NWAVES + F.wave, NGW = F.G * NWAVES;
    constexpr int I1 = 16 * 8, I2 = 4 * 32, PER_E = 2 * I1 + I2;
    for (int it = gw; it < NE1 * PER_E; it += NGW) {
        const int e = it / PER_E; int r = it % PER_E;
        unsigned char* d1 = (unsigned char*)(F.ws + WS_EXP1) + (size_t)e * 512 * DM; unsigned char* d2 = (unsigned char*)(F.ws + WS_EXP2) + (size_t)e * DM * EH;
        if (r < 2 * I1) { const int up = r >= I1; if (up) r -= I1; const int kb = r / 8, nb = r % 8;
            const float* src = e < NEXP ? F.in[up ? I_WEU : I_WEG] + ((size_t)l * NEXP + e) * DM * EH : F.in[up ? I_WSU : I_WSG] + (size_t)l * DM * EH;
            tr_item8(src, EH, kb * 64, nb * 32, d1, DM, RowGU{up}, up ? WEXP_SCALE * 0.6931471805599453f : WEXP_SCALE * 1.4426950408889634f, scr, F.lane); }
        else { r -= 2 * I1; const int kb = r / 32, nb = r % 32;
            const float* src = e < NEXP ? F.in[I_WED] + ((size_t)l * NEXP + e) * EH * DM : F.in[I_WSD] + (size_t)l * EH * DM;
            tr_item8(src, DM, kb * 64, nb * 32, d2, EH, RowId{}, WEXP_SCALE, scr, F.lane); }
    }
}

__device__ __forceinline__ f32x4 mfma16(bf16x8 a, bf16x8 b, f32x4 c) { return __builtin_amdgcn_mfma_f32_16x16x32_bf16(a, b, c, 0, 0, 0); }

__device__ __forceinline__ void ph_transposes(Frame& F, int l) {
    LAS bf16_t* tile = (LAS bf16_t*)(F.lds + F.wave * 16384);
    const bf16_t* U = (const bf16_t*)(F.ws + WS_U);
    const int gw = F.wg * NWAVES + F.wave, NGW = F.G * NWAVES;
    const int rsub = F.lane >> 3, cseg = F.lane & 7;
    for (int u = gw; u < 1088 * 20; u += NGW) {
        const int tt = u / 20, blk = u % 20;
        int b, s0, Ls, rowbase, posbase;
        if (tt < 1024) { b = tt >> 6; s0 = (tt & 63) * 64; Ls = SEQ; rowbase = b * SEQ; posbase = 0; }
        else { const int t2 = tt - 1024; b = t2 >> 2; s0 = (t2 & 3) * 64; Ls = CTXL; rowbase = NLAT + b * CTXL; posbase = SEQ; }
        if (blk < 12) {
            constexpr int HT = 80;
            float w0[8], w1[8], w2[8], bb[8];
#pragma unroll
            for (int it = 0; it < 8; ++it) { const int col = blk * 64 + rsub + 8 * it; w0[it] = F.in[I_HSW][(l * 3 + 0) * 768 + col]; w1[it] = F.in[I_HSW][(l * 3 + 1) * 768 + col]; w2[it] = F.in[I_HSW][(l * 3 + 2) * 768 + col]; bb[it] = F.in[I_HSB][l * 768 + col]; }
            const bf16_t* p0 = U + (size_t)(rowbase + s0 + rsub) * DIN + UHY + blk * 64 + cseg * 8;
            u32x4 zc[8];
#pragma unroll
            for (int it = 0; it < 8; ++it) zc[it] = *(const GAS u32x4*)(p0 + (size_t)(8 * it) * DIN);
            u32x4 zh = (u32x4){0u, 0u, 0u, 0u};
            if (F.lane < 16) { const int hs = F.lane < 8 ? s0 - 1 : s0 + 64; if (hs >= 0 && hs < Ls) zh = *(const GAS u32x4*)(U + (size_t)(rowbase + hs) * DIN + UHY + blk * 64 + cseg * 8); }
#pragma unroll
            for (int it = 0; it < 8; ++it) { const unsigned a[4] = {zc[it].x, zc[it].y, zc[it].z, zc[it].w}; LAS bf16_t* d = tile + (cseg * 8) * HT + 8 + rsub + 8 * it;
#pragma unroll
                for (int i = 0; i < 4; ++i) { d[(2 * i) * HT] = (bf16_t)(a[i] & 0xffffu); d[(2 * i + 1) * HT] = (bf16_t)(a[i] >> 16); } }
            if (F.lane < 16) { const unsigned a[4] = {zh.x, zh.y, zh.z, zh.w}; LAS bf16_t* d = tile + (cseg * 8) * HT + (F.lane < 8 ? 7 : 72);
#pragma unroll
                for (int i = 0; i < 4; ++i) { d[(2 * i) * HT] = (bf16_t)(a[i] & 0xffffu); d[(2 * i + 1) * HT] = (bf16_t)(a[i] >> 16); } }
            LDS_WAIT(); asm volatile("" ::: "memory");
#pragma unroll
            for (int it = 0; it < 8; ++it) {
                const int ch = rsub + 8 * it; const LAS bf16_t* r = tile + ch * HT + 8 + cseg * 8;
                const u32x4 v = *(const LAS u32x4*)r; const unsigned hm = r[-1], hp = r[8];
                float x[10]; x[0] = __builtin_bit_cast(float, hm << 16); x[9] = __builtin_bit_cast(float, hp << 16);
                x[1] = bflo(v.x); x[2] = bfhi(v.x); x[3] = bflo(v.y); x[4] = bfhi(v.y); x[5] = bflo(v.z); x[6] = bfhi(v.z); x[7] = bflo(v.w); x[8] = bfhi(v.w);
                unsigned w[4];
#pragma unroll
                for (int i = 0; i < 4; ++i) w[i] = pk2(bb[it] + w0[it] * x[2 * i] + w1[it] * x[2 * i + 1] + w2[it] * x[2 * i + 2], bb[it] + w0[it] * x[2 * i + 1] + w1[it] * x[2 * i + 2] + w2[it] * x[2 * i + 3]);
                *(GAS u32x4*)((bf16_t*)(F.ws + WS_HV) + ((size_t)(blk * 64 + ch) * NB + b) * SPB + posbase + s0 + cseg * 8) = (u32x4){w[0], w[1], w[2], w[3]};
            }
            LDS_WAIT(); asm volatile("" ::: "memory");
            continue;
        } else {
            const int c0 = (blk - 12) * 64 + cseg * 8;
#pragma unroll
            for (int it = 0; it < 8; ++it) {
                const int sl = rsub + 8 * it, s = s0 + sl;
                const u32x4 zc = *(const GAS u32x4*)(U + (size_t)(rowbase + s) * DIN + UV + c0);
                const unsigned ac[4] = {zc.x, zc.y, zc.z, zc.w};
#pragma unroll
                for (int i = 0; i < 4; ++i) { tile[(cseg * 8 + 2 * i) * 72 + sl] = (bf16_t)(ac[i] & 0xffffu); tile[(cseg * 8 + 2 * i + 1) * 72 + sl] = (bf16_t)(ac[i] >> 16); }
            }
        }
        LDS_WAIT(); asm volatile("" ::: "memory");
#pragma unroll 2
        for (int it = 0; it < 8; ++it) {
            const int ch = rsub + 8 * it;
            const u32x4 v = *(const LAS u32x4*)(tile + ch * 72 + cseg * 8);
            bf16_t* dst;
            if (blk < 12) dst = (bf16_t*)(F.ws + WS_HV) + ((size_t)(blk * 64 + ch) * NB + b) * SPB + posbase + s0 + cseg * 8;
            else dst = (bf16_t*)(F.ws + WS_VT) + ((size_t)b * 512 + (blk - 12) * 64 + ch) * SPB + posbase + s0 + cseg * 8;
            *(GAS u32x4*)dst = v;
        }
        LDS_WAIT(); asm volatile("" ::: "memory");
    }
}

constexpr int NA_RPB = 0, NA_KC = 2048, NA_VC = NA_KC + 256 * 144, NA_KR = NA_VC + 64 * 528, NA_END = NA_KR + 9 * 64 * 144;
static_assert(NA_END <= MISC_OFF, "NA LDS map");
__device__ __forceinline__ bf16x8 gld16(const bf16_t* p) { return *(const GAS bf16x8*)p; }
__device__ __forceinline__ u32x2 gld8(const bf16_t* p) { return *(const GAS u32x2*)p; }
__device__ __forceinline__ const char* uni_ptr(const char* p) { const unsigned long long v = (unsigned long long)p; const unsigned lo = __builtin_amdgcn_readfirstlane((unsigned)v), hi = __builtin_amdgcn_readfirstlane((unsigned)(v >> 32)); return (const char*)(((unsigned long long)hi << 32) | lo); }
__device__ __forceinline__ bf16x8 gld16o(const char* ub, unsigned lo) { return *(const GAS bf16x8*)(ub + (size_t)lo); }
__device__ __forceinline__ u32x2 gld8o(const char* ub, unsigned lo) { return *(const GAS u32x2*)(ub + (size_t)lo); }
template <bool WIN>
__device__ __forceinline__ void na_unit(Frame& F, int b, int h, int r, int strip) {
    const bf16_t* U = (const bf16_t*)(F.ws + WS_U);
    const bf16_t* VT = (const bf16_t*)(F.ws + WS_VT) + ((size_t)b * 512 + h * 64) * SPB;
    const LAS float* rpb = (const LAS float*)(F.lds + NA_RPB);
    const LAS bf16_t* KC = (const LAS bf16_t*)(F.lds + NA_KC); const LAS bf16_t* VC = (const LAS bf16_t*)(F.lds + NA_VC);
    int ln_ = F.lane; asm volatile("" : "+v"(ln_));
    const int i = ln_ & 15, g = ln_ >> 4;
    const int qrow0 = WIN ? (b * SEQ + r * 64 + strip * 16) : (NLAT + b * CTXL + strip * 16);
    const int ki = 8 * (i >> 2) + (i & 3);
    const unsigned qlo = (unsigned)((i * DIN + 8 * g) * 2), klo = (unsigned)((ki * DIN + 8 * g) * 2), vlo = (unsigned)((i * SPB + 8 * g) * 2);
    const char* qb = uni_ptr((const char*)(U + (size_t)qrow0 * DIN + UQ + h * 64));
    const bf16x8 q0 = gld16o(qb, qlo), q1 = gld16o(qb + 64, qlo);
    int kr0 = 0, u0 = 0;
    if (WIN) { kr0 = r - 4; kr0 = kr0 < 0 ? 0 : (kr0 > 56 ? 56 : kr0); u0 = strip == 0 ? 0 : (strip == 1 ? 8 : (strip == 2 ? 24 : 32)); }
    const LAS bf16_t* KR = (const LAS bf16_t*)(F.lds + NA_KR);
    const char* vbase = uni_ptr((const char*)(VT + kr0 * 64 + u0));
    f32x4 o[4];
#pragma unroll
    for (int d = 0; d < 4; ++d) o[d] = (f32x4){0.f, 0.f, 0.f, 0.f};
    float lsum = 0.f;
#define NA_SB() __builtin_amdgcn_sched_barrier(0)
#define NA_WLOAD(vb_, cw) do { _Pragma("unroll") for (int d = 0; d < 4; ++d) vb_[d] = gld16o(vbase + ((size_t)(d * 16) * SPB + (cw) * 64) * 2, vlo); } while (0)
#define NA_KRING(kb_, cw) do { const LAS bf16_t* kp = KR + ((((kr0 + (cw)) % 9) * 64 + u0 + ki) * 72 + 8 * g); kb_[0][0] = *(const LAS bf16x8*)kp; kb_[0][1] = *(const LAS bf16x8*)(kp + 32); \
        kb_[1][0] = *(const LAS bf16x8*)(kp + 4 * 72); kb_[1][1] = *(const LAS bf16x8*)(kp + 4 * 72 + 32); } while (0)
#define NA_QK(kb_, s_) do { _Pragma("unroll") for (int t = 0; t < 2; ++t) { f32x4 a = (f32x4){0.f, 0.f, 0.f, 0.f}; a = mfma16(kb_[t][0], q0, a); a = mfma16(kb_[t][1], q1, a); s_[t] = a; } } while (0)
#define NA_PV(s_, vb_) do { u32x4 pw; pw.x = pk2(s_[0][0], s_[0][1]); pw.y = pk2(s_[0][2], s_[0][3]); pw.z = pk2(s_[1][0], s_[1][1]); pw.w = pk2(s_[1][2], s_[1][3]); const bf16x8 pf = __builtin_bit_cast(bf16x8, pw); \
        _Pragma("unroll") for (int d = 0; d < 4; ++d) o[d] = mfma16(vb_[d], pf, o[d]); } while (0)
    bf16x8 vA[4], vB[4], vC[4];
    if (WIN) { NA_WLOAD(vA, 0); NA_WLOAD(vB, 1); NA_WLOAD(vC, 2); NA_SB(); }
#pragma unroll
    for (int cc = 0; cc < 8; ++cc) {
        bf16x8 kc[2][2], vc[4]; f32x4 sc[2];
#pragma unroll
        for (int t = 0; t < 2; ++t) { const LAS bf16_t* kp = KC + (cc * 32 + ki + 4 * t) * 72 + 8 * g; kc[t][0] = *(const LAS bf16x8*)kp; kc[t][1] = *(const LAS bf16x8*)(kp + 32); }
#pragma unroll
        for (int d = 0; d < 4; ++d) vc[d] = *(const LAS bf16x8*)(VC + (d * 16 + i) * 264 + cc * 32 + 8 * g);
        NA_QK(kc, sc);
#pragma unroll
        for (int t = 0; t < 2; ++t)
#pragma unroll
            for (int e = 0; e < 4; ++e) { const float p = __builtin_amdgcn_exp2f(fminf(sc[t][e], NA_CLAMP)); sc[t][e] = p; lsum += p; }
        NA_PV(sc, vc);
    }
    if (WIN) {
        const int c = strip * 16 + i; int kc0 = c - 8; kc0 = kc0 < 0 ? 0 : (kc0 > 48 ? 48 : kc0);
        int dcl[2][4]; bool okm[2][4];
#pragma unroll
        for (int t = 0; t < 2; ++t)
#pragma unroll
            for (int e = 0; e < 4; ++e) { const int kc = u0 + 8 * g + 4 * t + e; okm[t][e] = (kc >= kc0) && (kc < kc0 + 16); int dc = kc - c + 15; dcl[t][e] = okm[t][e] ? (dc < 0 ? 0 : (dc > 30 ? 30 : dc)) : 31; }
#define NA_WCHUNK(vb_, cw) do { bf16x8 kw[2][2]; NA_KRING(kw, cw); f32x4 sw[2]; NA_QK(kw, sw); const LAS float* rp = rpb + (kr0 + (cw) - r + 7) * 32; \
        _Pragma("unroll") for (int t = 0; t < 2; ++t) _Pragma("unroll") for (int e = 0; e < 4; ++e) { const float x = sw[t][e] + rp[dcl[t][e]]; const float p = __builtin_amdgcn_exp2f(fminf(x, NA_CLAMP)); sw[t][e] = p; lsum += p; } \
        NA_PV(sw, vb_); } while (0)
        NA_WCHUNK(vA, 0); NA_SB(); NA_WLOAD(vA, 3); NA_SB();
        NA_WCHUNK(vB, 1); NA_SB(); NA_WLOAD(vB, 4); NA_SB();
        NA_WCHUNK(vC, 2); NA_SB(); NA_WLOAD(vC, 5); NA_SB();
        NA_WCHUNK(vA, 3); NA_SB(); NA_WLOAD(vA, 6); NA_SB();
        NA_WCHUNK(vB, 4); NA_SB(); NA_WLOAD(vB, 7); NA_SB();
        NA_WCHUNK(vC, 5); NA_SB();
        NA_WCHUNK(vA, 6); NA_SB();
        NA_WCHUNK(vB, 7); NA_SB();
#undef NA_WCHUNK
    }
    lsum += shx(lsum, 16, ln_); lsum += shx(lsum, 32, ln_);
    const float inv = 1.0f / lsum;
    char* op = (char*)uni_ptr((const char*)((bf16_t*)(F.ws + WS_MIX) + (size_t)qrow0 * DM + h * 64)); const unsigned olo = (unsigned)((i * DM + 4 * g) * 2);
#pragma unroll
    for (int d = 0; d < 4; ++d) { u32x2 w; w.x = pk2(o[d][0] * inv, o[d][1] * inv); w.y = pk2(o[d][2] * inv, o[d][3] * inv); *(GAS u32x2*)(op + d * 32 + (size_t)olo) = w; }
#undef NA_SB
#undef NA_WLOAD
#undef NA_KRING
#undef NA_QK
#undef NA_PV
}
__device__ __forceinline__ int na_kr0(int r) { const int k = r - 4; return k < 0 ? 0 : (k > 56 ? 56 : k); }
__device__ __forceinline__ void ph_na(Frame& F, int l, bool last) {
    const bf16_t* U = (const bf16_t*)(F.ws + WS_U);
    for (int job = F.wg; job < NB * 8 * 2; job += F.G) {
        const int half = job & 1, h = (job >> 1) & 7, b = job >> 4;
        int tz_; asm volatile("v_mbcnt_lo_u32_b32 %0, -1, 0\n\tv_mbcnt_hi_u32_b32 %0, -1, %0" : "=v"(tz_)); tz_ |= F.wave << 6;
        const bf16_t* krow = U + (size_t)(b * SEQ + (tz_ >> 3)) * DIN + UK + h * 64 + (tz_ & 7) * 8;
        LAS bf16_t* kdst = (LAS bf16_t*)(F.lds + NA_KR) + (tz_ >> 3) * 72 + (tz_ & 7) * 8;
        __syncthreads();
        { LAS float* rpb = (LAS float*)(F.lds + NA_RPB); const float* rsrc = F.in[I_RPB] + ((size_t)l * 8 + h) * 15 * 31;
          if (tz_ < 15 * 32) rpb[tz_] = (tz_ & 31) < 31 ? rsrc[(tz_ >> 5) * 31 + (tz_ & 31)] * 1.4426950408889634f : -1e30f;
          const int key = tz_ >> 1, hf = tz_ & 1; const bf16_t* src = U + (size_t)(NLAT + b * CTXL + key) * DIN + UK + h * 64 + hf * 32; LAS bf16_t* dst = (LAS bf16_t*)(F.lds + NA_KC) + key * 72 + hf * 32;
#pragma unroll
          for (int j = 0; j < 4; ++j) *(LAS bf16x8*)(dst + j * 8) = gld16(src + j * 8);
          const int dv = tz_ >> 3, seg = tz_ & 7; const bf16_t* vs = (const bf16_t*)(F.ws + WS_VT) + ((size_t)b * 512 + h * 64 + dv) * SPB + SEQ + seg * 32; LAS bf16_t* vd = (LAS bf16_t*)(F.lds + NA_VC) + dv * 264 + seg * 32;
#pragma unroll
          for (int j = 0; j < 4; ++j) *(LAS bf16x8*)(vd + j * 8) = gld16(vs + j * 8);
          const int lo = na_kr0(half * 32), hi0 = na_kr0(half * 32 + 1) + 7;
          for (int kr = lo; kr <= hi0; ++kr) *(LAS bf16x8*)(kdst + (kr % 9) * 64 * 72) = gld16(krow + (size_t)kr * 64 * DIN); }
        __syncthreads();
        int prev_hi = na_kr0(half * 32 + 1) + 7;
#pragma unroll 1
        for (int s = 0; s < 16; ++s) {
            const int r0 = half * 32 + 2 * s;
            const int nhi = s < 15 ? na_kr0(r0 + 3) + 7 : prev_hi;
            bf16x8 n0 = (bf16x8){0, 0, 0, 0, 0, 0, 0, 0}, n1 = n0;
            if (nhi > prev_hi) n0 = gld16(krow + (size_t)(prev_hi + 1) * 64 * DIN);
            if (nhi > prev_hi + 1) n1 = gld16(krow + (size_t)(prev_hi + 2) * 64 * DIN);
            na_unit<true>(F, b, h, r0 + (F.wave >> 2), F.wave & 3);
            __syncthreads();
            if (nhi > prev_hi) *(LAS bf16x8*)(kdst + ((prev_hi + 1) % 9) * 64 * 72) = n0;
            if (nhi > prev_hi + 1) *(LAS bf16x8*)(kdst + ((prev_hi + 2) % 9) * 64 * 72) = n1;
            __syncthreads();
            prev_hi = nhi;
        }
        if (!last) na_unit<false>(F, b, h, 0, half * 8 + F.wave);
    }
}

__device__ __forceinline__ void ph_hy_transpose(Frame& F, bool last) {
    LAS bf16_t* tile = (LAS bf16_t*)(F.lds + F.wave * 16384);
    const bf16_t* HYO = (const bf16_t*)(F.ws + WS_Y);
    const int gw = F.wg * NWAVES + F.wave, NGW = F.G * NWAVES;
    const int rsub = F.lane >> 3, cseg = F.lane & 7;
    const int ntt = last ? 1024 : 1088;
    for (int u = gw; u < ntt * 4; u += NGW) {
        const int tt = u >> 2, cb = u & 3;
        int b, s0, rowbase, posbase;
        if (tt < 1024) { b = tt >> 6; s0 = (tt & 63) * 64; rowbase = b * SEQ; posbase = 0; }
        else { const int t2 = tt - 1024; b = t2 >> 2; s0 = (t2 & 3) * 64; rowbase = NLAT + b * CTXL; posbase = SEQ; }
#pragma unroll 2
        for (int it = 0; it < 8; ++it) { const int c = rsub + 8 * it;
            const u32x4 v = *(const GAS u32x4*)(HYO + ((size_t)(cb * 64 + c) * NB + b) * SPB + posbase + s0 + cseg * 8); const unsigned a[4] = {v.x, v.y, v.z, v.w};
#pragma unroll
            for (int e = 0; e < 4; ++e) { tile[(cseg * 8 + 2 * e) * 72 + c] = (bf16_t)(a[e] & 0xffffu); tile[(cseg * 8 + 2 * e + 1) * 72 + c] = (bf16_t)(a[e] >> 16); } }
        LDS_WAIT(); asm volatile("" ::: "memory");
#pragma unroll 2
        for (int it = 0; it < 8; ++it) { const int p = rsub + 8 * it;
            const u32x4 v = *(const LAS u32x4*)(tile + p * 72 + cseg * 8);
            *(GAS u32x4*)((bf16_t*)(F.ws + WS_MIX) + (size_t)(rowbase + s0 + p) * DM + 768 + cb * 64 + cseg * 8) = v; }
        LDS_WAIT(); asm volatile("" ::: "memory");
    }
}

constexpr int G2_LAF = 0, G2_LAB = 8448;
constexpr int G2_QTF = 16896, G2_KTF = 22016, G2_QTB = 27136, G2_KTB = 32256;
constexpr int G2_VT = 37376, G2_ATT = 46592;
constexpr int G2_SF = 55808, G2_SB = 60928;
constexpr int G2_SEG = 66048, G2_HALF = 67328;
__device__ __forceinline__ float log_sigmoid_f(float x) { return fminf(x, 0.f) - __logf(1.0f + __expf(-fabsf(x))); }
__device__ __forceinline__ f32x4 mma_lds(const LAS bf16_t* A, int lda, const LAS bf16_t* B, int ldb, int ksteps, f32x4 acc, int lane) {
    const int r = lane & 15, g = lane >> 4;
    for (int ks = 0; ks < ksteps; ++ks) { const bf16x8 a = *(const LAS bf16x8*)(A + r * lda + ks * 32 + 8 * g), b = *(const LAS bf16x8*)(B + r * ldb + ks * 32 + 8 * g); acc = mfma16(a, b, acc); }
    return acc;
}
__device__ __forceinline__ int gla_row0(int b, int cn) { return cn >= 4 ? b * SEQ + (cn - 4) * 64 : NLAT + b * CTXL + cn * 64; }
struct GlaRaw { u32x4 q, k, f, b, v0, v1, g0, g1, s0, s1; };
template <bool FULL>
__device__ __forceinline__ GlaRaw gla_load(Frame& F, int u, int tl) {
    const int h = u & 3, cn = (u >> 2) % 68, b = (u >> 2) / 68, i = tl >> 2, part = tl & 3;
    const bf16_t* p = (const bf16_t*)(F.ws + WS_U) + (size_t)(gla_row0(b, cn) + i) * DIN;
    GlaRaw r;
    r.q = *(const GAS u32x4*)(p + UGQ + h * 32 + part * 8); r.k = *(const GAS u32x4*)(p + UGK + h * 32 + part * 8);
    r.f = *(const GAS u32x4*)(p + ULAF + h * 32 + part * 8); r.b = *(const GAS u32x4*)(p + ULAB + h * 32 + part * 8);
    r.v0 = *(const GAS u32x4*)(p + UGV + h * 64 + part * 16); r.v1 = *(const GAS u32x4*)(p + UGV + h * 64 + part * 16 + 8);
    if (FULL) { r.g0 = *(const GAS u32x4*)(p + UGR + h * 64 + part * 16); r.g1 = *(const GAS u32x4*)(p + UGR + h * 64 + part * 16 + 8);
        const bf16_t* sp = (const bf16_t*)(F.ws + WS_GSIN) + (size_t)u * 2 * 2048 + tl * 16; r.s0 = *(const GAS u32x4*)sp; r.s1 = *(const GAS u32x4*)(sp + 8); }
    else { r.g0 = (u32x4){0u, 0u, 0u, 0u}; r.g1 = r.g0; r.s0 = r.g0; r.s1 = r.g0; }
    return r;
}
template <bool FULL>
__device__ __forceinline__ void gla_prep(Frame& F, LAS unsigned char* L, int l, int u, int tl, const GlaRaw& raw) {
    const int h = u & 3, cn = (u >> 2) % 68, i = tl >> 2, part = tl & 3, d8 = part * 8;
    LAS float* LAF = (LAS float*)(L + G2_LAF); LAS float* LAB = (LAS float*)(L + G2_LAB); LAS bf16_t* VT = (LAS bf16_t*)(L + G2_VT); LAS float* SEG = (LAS float*)(L + G2_SEG);
    float q[8], k[8], tf[8], tb[8];
    unpack8(raw.q, q); unpack8(raw.k, k); unpack8(raw.f, tf); unpack8(raw.b, tb);
    const float* ba = F.in[I_BA2] + (size_t)l * 256 + h * 32 + d8;
#pragma unroll
    for (int e = 0; e < 8; ++e) { q[e] *= 0.17677669529663687f; LAF[i * 33 + d8 + e] = log_sigmoid_f(tf[e] + ba[e]) * 0.0625f; LAB[i * 33 + d8 + e] = log_sigmoid_f(tb[e] + ba[128 + e]) * 0.0625f; }
    if (cn >= 4) {
        const float pos = (part >> 1) ? (float)i : (float)(cn - 4);
#pragma unroll
        for (int e = 0; e < 8; ++e) { const float ang = pos * __expf(-(float)e * (9.210340371976184f / 8.0f)); const float sn = __sinf(ang), cs = __cosf(ang);
            const float qo = shx(q[e], 1, F.lane), ko = shx(k[e], 1, F.lane);
            if (part & 1) { q[e] = qo * sn + q[e] * cs; k[e] = ko * sn + k[e] * cs; } else { q[e] = q[e] * cs - qo * sn; k[e] = k[e] * cs - ko * sn; } }
    }
    { const unsigned a[8] = {raw.v0.x, raw.v0.y, raw.v0.z, raw.v0.w, raw.v1.x, raw.v1.y, raw.v1.z, raw.v1.w};
#pragma unroll
      for (int e = 0; e < 8; ++e) { VT[(part * 16 + 2 * e) * 72 + i] = (bf16_t)(a[e] & 0xffffu); VT[(part * 16 + 2 * e + 1) * 72 + i] = (bf16_t)(a[e] >> 16); } }
    __syncthreads();
    { const int x = tl & 63, d = x & 31, dir = x >> 5, seg = tl >> 6; LAS float* LA = (dir ? LAB : LAF) + d; float cv[16];
#pragma unroll
      for (int kk = 0; kk < 16; ++kk) { const int p = seg * 16 + kk, ti = dir ? 63 - p : p; cv[kk] = LA[ti * 33]; }
#pragma unroll
      for (int kk = 1; kk < 16; ++kk) cv[kk] += cv[kk - 1];
#pragma unroll
      for (int kk = 0; kk < 16; ++kk) { const int p = seg * 16 + kk, ti = dir ? 63 - p : p; LA[ti * 33] = cv[kk]; }
      SEG[x * 5 + seg] = cv[15]; }
    __syncthreads();
    { const int x = tl & 63, d = x & 31, dir = x >> 5, seg = tl >> 6; LAS float* LA = (dir ? LAB : LAF) + d; float cv[16];
      const float t0 = SEG[x * 5 + 0], t1 = SEG[x * 5 + 1], t2 = SEG[x * 5 + 2];
      const float pre = seg == 0 ? 0.f : (seg == 1 ? t0 : (seg == 2 ? t0 + t1 : t0 + t1 + t2));
#pragma unroll
      for (int kk = 0; kk < 16; ++kk) { const int p = seg * 16 + kk, ti = dir ? 63 - p : p; cv[kk] = LA[ti * 33]; }
#pragma unroll
      for (int kk = 0; kk < 16; ++kk) { const int p = seg * 16 + kk, ti = dir ? 63 - p : p; LA[ti * 33] = cv[kk] + pre; } }
    __syncthreads();
    if (FULL) {
        unsigned wqf[4], wkf[4], wqb[4], wkb[4];
#pragma unroll
        for (int e = 0; e < 4; ++e) { const int d = d8 + 2 * e; const float f0 = LAF[i * 33 + d], f1 = LAF[i * 33 + d + 1], b0 = LAB[i * 33 + d], b1 = LAB[i * 33 + d + 1];
            wqf[e] = pk2(q[2 * e] * __expf(f0), q[2 * e + 1] * __expf(f1)); wkf[e] = pk2(k[2 * e] * __expf(-f0), k[2 * e + 1] * __expf(-f1));
            wqb[e] = pk2(q[2 * e] * __expf(b0), q[2 * e + 1] * __expf(b1)); wkb[e] = pk2(k[2 * e] * __expf(-b0), k[2 * e + 1] * __expf(-b1)); }
        *(LAS u32x4*)((LAS bf16_t*)(L + G2_QTF) + i * 40 + d8) = (u32x4){wqf[0], wqf[1], wqf[2], wqf[3]}; *(LAS u32x4*)((LAS bf16_t*)(L + G2_KTF) + i * 40 + d8) = (u32x4){wkf[0], wkf[1], wkf[2], wkf[3]};
        *(LAS u32x4*)((LAS bf16_t*)(L + G2_QTB) + i * 40 + d8) = (u32x4){wqb[0], wqb[1], wqb[2], wqb[3]}; *(LAS u32x4*)((LAS bf16_t*)(L + G2_KTB) + i * 40 + d8) = (u32x4){wkb[0], wkb[1], wkb[2], wkb[3]};
    } else {
        LAS bf16_t* KDF = (LAS bf16_t*)(L + G2_QTF); LAS bf16_t* KDB = (LAS bf16_t*)(L + G2_KTF);
#pragma unroll
        for (int e = 0; e < 8; ++e) { const int d = d8 + e; const float bf = LAF[i * 33 + d], bb = LAB[i * 33 + d], bfl = LAF[63 * 33 + d], bbl = LAB[0 * 33 + d];
            KDF[d * 72 + i] = (bf16_t)f2bf(k[e] * __expf(bfl - bf)); KDB[d * 72 + i] = (bf16_t)f2bf(k[e] * __expf(bbl - bb)); }
    }
    __syncthreads();
}
__device__ __forceinline__ void ph_gla_local(Frame& F, int l) {
    const int hw = F.wave >> 2, wl = F.wave & 3, tl = F.tid & 255; LAS unsigned char* L = F.lds + hw * G2_HALF;
    constexpr int NU = NB * 68 * 4;
    int pp = F.wg;
    GlaRaw raw = gla_load<false>(F, (pp * 2 + hw) < NU ? pp * 2 + hw : 0, tl);
    for (; pp * 2 < NU; pp += F.G) {
        const int u = pp * 2 + hw, un = (pp + F.G) * 2 + hw;
        const GlaRaw nraw = gla_load<false>(F, un < NU ? un : u, tl);
        __syncthreads();
        gla_prep<false>(F, L, l, u, tl, raw);
        const int g = F.lane >> 4, c = F.lane & 15;
        float* DS = (float*)(F.ws + WS_GDS) + (size_t)u * 2 * 2048;
#pragma unroll
        for (int kk = 0; kk < 4; ++kk) { const int tix = wl * 4 + kk, dir = tix >> 3, mt = (tix >> 1) & 3, nt = tix & 1;
            f32x4 a = (f32x4){0.f, 0.f, 0.f, 0.f};
            a = mma_lds((const LAS bf16_t*)(L + G2_VT) + mt * 16 * 72, 72, (const LAS bf16_t*)(L + (dir ? G2_KTF : G2_QTF)) + nt * 16 * 72, 72, 2, a, F.lane);
#pragma unroll
            for (int e = 0; e < 4; ++e) DS[dir * 2048 + (mt * 16 + 4 * g + e) * 32 + nt * 16 + c] = a[e]; }
        if (tl < 64) { const int d = tl & 31, dir = tl >> 5; ((float*)(F.ws + WS_GD))[(size_t)u * 64 + tl] = __expf(dir ? ((LAS float*)(L + G2_LAB))[0 * 33 + d] : ((LAS float*)(L + G2_LAF))[63 * 33 + d]); }
        raw = nraw;
    }
}
__device__ __forceinline__ void ph_gla_scan(Frame& F) {
    const int gt = F.wg * NTHR + F.tid, NGT = F.G * NTHR;
    const float* DS = (const float*)(F.ws + WS_GDS); const float* GD = (const float*)(F.ws + WS_GD); bf16_t* SIN = (bf16_t*)(F.ws + WS_GSIN);
    for (int w = gt; w < 128 * 1024; w += NGT) {
        const int chain = w >> 10, el = (w & 1023) * 2, dir = chain & 1, h = (chain >> 1) & 3, b = chain >> 3, d = el & 31;
        float s0 = 0.f, s1 = 0.f;
        for (int step = 0; step < 68; step += 4) {
            f32x2 ds[4], dd[4]; size_t uu[4];
#pragma unroll
            for (int q = 0; q < 4; ++q) { const int st_ = step + q; const int cn = dir ? (st_ < 4 ? 3 - st_ : 71 - st_) : st_;
                uu[q] = (size_t)(b * 68 + cn) * 4 + h;
                ds[q] = *(const GAS f32x2*)(DS + (uu[q] * 2 + dir) * 2048 + el); dd[q] = *(const GAS f32x2*)(GD + uu[q] * 64 + dir * 32 + d); }
#pragma unroll
            for (int q = 0; q < 4; ++q) { *(GAS unsigned*)(SIN + (uu[q] * 2 + dir) * 2048 + el) = pk2(s0, s1); s0 = dd[q].x * s0 + ds[q].x; s1 = dd[q].y * s1 + ds[q].y; }
        }
    }
}
__device__ __forceinline__ void ph_gla_out(Frame& F, int l, bool last) {
    const int hw = F.wave >> 2, wl = F.wave & 3, tl = F.tid & 255; LAS unsigned char* L = F.lds + hw * G2_HALF;
    const int NV = last ? NB * 64 * 4 : NB * 68 * 4;
#define GLA_UNIT(v) (last ? ((((v) >> 8) * 68 + 4 + (((v) & 255) >> 2)) * 4 + ((v) & 3)) : (v))
    int pp = F.wg;
    GlaRaw raw = gla_load<true>(F, GLA_UNIT((pp * 2 + hw) < NV ? pp * 2 + hw : 0), tl);
    for (; pp * 2 < NV; pp += F.G) {
        const int u = GLA_UNIT(pp * 2 + hw), vn = (pp + F.G) * 2 + hw;
        const GlaRaw nraw = gla_load<true>(F, vn < NV ? GLA_UNIT(vn) : u, tl);
        const int h = u & 3, cn = (u >> 2) % 68, b = (u >> 2) / 68;
        __syncthreads();
        gla_prep<true>(F, L, l, u, tl, raw);
        { const int dir = tl >> 7, dv = (tl >> 1) & 63, d16 = (tl & 1) * 16; LAS bf16_t* S = (LAS bf16_t*)(L + (dir ? G2_SB : G2_SF)) + dv * 40 + d16; *(LAS u32x4*)S = raw.s0; *(LAS u32x4*)(S + 8) = raw.s1; }
        const int g = F.lane >> 4, c = F.lane & 15;
        LAS bf16_t* ATT = (LAS bf16_t*)(L + G2_ATT);
#pragma unroll
        for (int kk = 0; kk < 4; ++kk) { const int tile = wl * 4 + kk, mt = tile >> 2, nt = tile & 3;
            f32x4 af = (f32x4){0.f, 0.f, 0.f, 0.f}, ab = af;
            af = mma_lds((const LAS bf16_t*)(L + G2_QTF) + mt * 16 * 40, 40, (const LAS bf16_t*)(L + G2_KTF) + nt * 16 * 40, 40, 1, af, F.lane);
            ab = mma_lds((const LAS bf16_t*)(L + G2_QTB) + mt * 16 * 40, 40, (const LAS bf16_t*)(L + G2_KTB) + nt * 16 * 40, 40, 1, ab, F.lane);
#pragma unroll
            for (int e = 0; e < 4; ++e) { const int ii = mt * 16 + 4 * g + e, j = nt * 16 + c; const float vv = (j <= ii ? af[e] : 0.f) + (j >= ii ? ab[e] : 0.f); ATT[ii * 72 + j] = (bf16_t)f2bf(vv); } }
        __syncthreads();
        LAS float* O = (LAS float*)(L + G2_LAF);
#pragma unroll
        for (int kk = 0; kk < 4; ++kk) { const int tile = wl * 4 + kk, mt = tile >> 2, nt = tile & 3;
            f32x4 a = (f32x4){0.f, 0.f, 0.f, 0.f};
            a = mma_lds(ATT + mt * 16 * 72, 72, (const LAS bf16_t*)(L + G2_VT) + nt * 16 * 72, 72, 2, a, F.lane);
            a = mma_lds((const LAS bf16_t*)(L + G2_QTF) + mt * 16 * 40, 40, (const LAS bf16_t*)(L + G2_SF) + nt * 16 * 40, 40, 1, a, F.lane);
            a = mma_lds((const LAS bf16_t*)(L + G2_QTB) + mt * 16 * 40, 40, (const LAS bf16_t*)(L + G2_SB) + nt * 16 * 40, 40, 1, a, F.lane);
#pragma unroll
            for (int e = 0; e < 4; ++e) O[(mt * 16 + 4 * g + e) * 65 + nt * 16 + c] = a[e]; }
        __syncthreads();
        { const int i = tl >> 2, dv16 = (tl & 3) * 16; const int row = gla_row0(b, cn) + i;
          float v[16], gt[16]; float ss = 0.f;
#pragma unroll
          for (int e = 0; e < 16; ++e) { v[e] = O[i * 65 + dv16 + e]; ss += v[e] * v[e]; }
          ss += shx(ss, 1, F.lane); ss += shx(ss, 2, F.lane);
          const float rs = 1.0f / sqrtf(ss * (1.0f / 64.0f) + LN_EPS);
          unpack8(raw.g0, gt); unpack8(raw.g1, gt + 8);
          const float* gn = F.in[I_GNORM] + l * 64 + dv16;
          unsigned w[8];
#pragma unroll
          for (int e = 0; e < 8; ++e) w[e] = pk2(v[2 * e] * rs * gn[2 * e] * silu_f(gt[2 * e]), v[2 * e + 1] * rs * gn[2 * e + 1] * silu_f(gt[2 * e + 1]));
          bf16_t* mp = (bf16_t*)(F.ws + WS_MIX) + (size_t)row * DM + 512 + h * 64 + dv16;
          *(GAS u32x4*)mp = (u32x4){w[0], w[1], w[2], w[3]}; *(GAS u32x4*)(mp + 8) = (u32x4){w[4], w[5], w[6], w[7]}; }
        raw = nraw;
    }
#undef GLA_UNIT
}

template <int L>
__device__ __forceinline__ void hyena_conv(Frame& F, const bf16_t* Rg, const bf16_t* Uin, const bf16_t* Xmul, int pos0, bool final_out, int ch, bf16_t* Zout) {
    constexpr int CS = 2 * L + 16;
    constexpr int NTL = L / 16, J = (NTL >= 64) ? 16 : 2, NGRP = NTL / J, HJ = J / 2, NSTEP = L / 32;
    LAS bf16_t* Rl = (LAS bf16_t*)F.lds;
    __syncthreads();
    for (int c = F.tid; c < 2 * L / 8; c += NTHR) { const u32x4 v = *(const GAS u32x4*)(Rg + 8 * c); const unsigned a[4] = {v.x, v.y, v.z, v.w};
#pragma unroll
        for (int rho = 0; rho < 8; ++rho) { LAS bf16_t* d = Rl + rho * CS + 8 * c + rho;
#pragma unroll
            for (int k = 0; k < 4; ++k) { d[2 * k] = (bf16_t)(a[k] & 0xffffu); d[2 * k + 1] = (bf16_t)(a[k] >> 16); } } }
    __syncthreads();
    int ln_ = F.lane; asm volatile("" : "+v"(ln_));
    const int i = ln_ & 15, g = ln_ >> 4, rho = i & 7;
    const LAS bf16_t* Rc = Rl + rho * CS + rho;
    for (int grp = F.wave; grp < NGRP; grp += NWAVES) {
        f32x4 acc[J]; bf16x8 fr[J];
        const int tb = grp * J * 16;
        const LAS bf16_t* Rb = Rc + (L - tb - i + 8 * g);
#pragma unroll
        for (int j = 0; j < J; ++j) { acc[j] = (f32x4){0.f, 0.f, 0.f, 0.f}; fr[j] = *(const LAS bf16x8*)(Rb - 16 * j); }
        const char* ub = (const char*)(Uin + pos0); const unsigned ulo = (unsigned)((i * SPB + 8 * g) * 2);
        constexpr int PF = (HJ >= 4) ? 4 : 1;
        bf16x8 bq[PF];
#pragma unroll
        for (int p = 0; p < PF; ++p) bq[p] = *(const GAS bf16x8*)(ub + (size_t)(ulo + (unsigned)p * 64u));
#pragma unroll 1
        for (int q = 0; q < NSTEP / HJ; ++q) {
#pragma unroll
            for (int m = 0; m < HJ; ++m) {
                const int n = q * HJ + m;
                const int nn = (n + PF < NSTEP) ? n + PF : 0;
                if (n > 0) { fr[(J - 2 * m) % J] = *(const LAS bf16x8*)(Rb + 32 * n); fr[(J + 1 - 2 * m) % J] = *(const LAS bf16x8*)(Rb + 32 * n - 16); }
                const bf16x8 bcur = bq[m % PF];
#pragma unroll
                for (int jj = 0; jj < J; ++jj) { const int j = (jj + 2) % J; acc[j] = mfma16(fr[(j + J - 2 * m) % J], bcur, acc[j]); }
                bq[m % PF] = *(const GAS bf16x8*)(ub + (size_t)(ulo + (unsigned)nn * 64u));
            }
        }
#pragma unroll
        for (int j = 0; j < J; ++j) { const int t0 = tb + j * 16 + 4 * g;
            const u32x2 xw = *(const GAS u32x2*)(Xmul + (size_t)i * SPB + pos0 + t0);
            const float y0 = acc[j][0] * bflo(xw.x), y1 = acc[j][1] * bfhi(xw.x), y2 = acc[j][2] * bflo(xw.y), y3 = acc[j][3] * bfhi(xw.y);
            if (!final_out) { u32x2 w; w.x = pk2(y0, y1); w.y = pk2(y2, y3); *(GAS u32x2*)(Zout + (size_t)i * SPB + pos0 + t0) = w; }
            else { u32x2 w; w.x = pk2(y0, y1); w.y = pk2(y2, y3); *(GAS u32x2*)((bf16_t*)(F.ws + WS_Y) + ((size_t)ch * NB + i) * SPB + pos0 + t0) = w; } }
    }
}
__device__ __forceinline__ void ph_hyena(Frame& F, int l, bool last) {
    const bf16_t* HV = (const bf16_t*)(F.ws + WS_HV); bf16_t* Z2 = (bf16_t*)(F.ws + WS_Z2);
    for (int ch = F.wg; ch < 256; ch += F.G) {
        const bf16_t* v = HV + (size_t)(0 * 256 + ch) * NB * SPB; const bf16_t* x1 = HV + (size_t)(256 + ch) * NB * SPB; const bf16_t* x2 = HV + (size_t)(512 + ch) * NB * SPB;
        bf16_t* z = Z2 + (size_t)ch * NB * SPB;
        const bf16_t* R0 = (const bf16_t*)(F.ws + WS_HYF) + ((size_t)(l * 2 + 0) * 256 + ch) * 8192; const bf16_t* R1 = (const bf16_t*)(F.ws + WS_HYF) + ((size_t)(l * 2 + 1) * 256 + ch) * 8192;
        hyena_conv<4096>(F, R0, v, x1, 0, false, ch, z);
        VM_WAIT(); __syncthreads(); __builtin_amdgcn_fence(__ATOMIC_ACQUIRE, "agent"); VM_WAIT();
        hyena_conv<4096>(F, R1, z, x2, 0, true, ch, z);
        if (!last) {
            const bf16_t* C0 = (const bf16_t*)(F.ws + WS_HYFC) + ((size_t)(l * 2 + 0) * 256 + ch) * 512; const bf16_t* C1 = (const bf16_t*)(F.ws + WS_HYFC) + ((size_t)(l * 2 + 1) * 256 + ch) * 512;
            hyena_conv<256>(F, C0, v, x1, SEQ, false, ch, z);
            VM_WAIT(); __syncthreads(); __builtin_amdgcn_fence(__ATOMIC_ACQUIRE, "agent"); VM_WAIT();
            hyena_conv<256>(F, C1, z, x2, SEQ, true, ch, z);
        }
    }
}

__device__ __forceinline__ void ph_ln1(Frame& F, int l, int ntok) {
    const int gw = F.wg * NWAVES + F.wave, NGW = F.G * NWAVES;
    const float* lg = F.in[I_LN1G] + l * DM + 16 * F.lane; const float* lb = F.in[I_LN1B] + l * DM + 16 * F.lane;
    for (int row = gw; row < ntok; row += NGW) {
        bf16_t* xr = (bf16_t*)(F.ws + WS_XR) + (size_t)row * DM + 16 * F.lane;
        const bf16_t* yr = (const bf16_t*)(F.ws + WS_Y) + (size_t)row * DM + 16 * F.lane;
        const float* md = mod_ptr(F, l, row) + 16 * F.lane;
        bf16_t* xm = (bf16_t*)(F.ws + WS_XM) + (size_t)row * DM + 16 * F.lane;
        const u32x4 xa = __builtin_nontemporal_load((const GAS u32x4*)xr), xb = __builtin_nontemporal_load((const GAS u32x4*)(xr + 8)), ya = __builtin_nontemporal_load((const GAS u32x4*)yr), yb = __builtin_nontemporal_load((const GAS u32x4*)(yr + 8));
        float x[16], y[16], v[16]; unpack8(xa, x); unpack8(xb, x + 8); unpack8(ya, y); unpack8(yb, y + 8);
        float s = 0.f;
#pragma unroll
        for (int j = 0; j < 4; ++j) { const f32x4 g1 = *(const GAS f32x4*)(md + 2048 + 4 * j);
#pragma unroll
            for (int e = 0; e < 4; ++e) { v[4 * j + e] = x[4 * j + e] * DN_ALPHA + g1[e] * y[4 * j + e]; s += v[4 * j + e]; } }
        const float mean = wave_sum(s, F.lane) * (1.f / DM); float s2 = 0.f;
#pragma unroll
        for (int e = 0; e < 16; ++e) { v[e] -= mean; s2 += v[e] * v[e]; }
        const float rstd = 1.f / sqrtf(wave_sum(s2, F.lane) * (1.f / DM) + LN_EPS);
        unsigned wx[8], wm[8]; int w8[4];
#pragma unroll
        for (int j = 0; j < 4; ++j) { const f32x4 g = *(const GAS f32x4*)(lg + 4 * j), bb = *(const GAS f32x4*)(lb + 4 * j), sh = *(const GAS f32x4*)(md + 3072 + 4 * j), sc = *(const GAS f32x4*)(md + 4096 + 4 * j);
            float xn[4];
#pragma unroll
            for (int e = 0; e < 4; ++e) xn[e] = v[4 * j + e] * rstd * g[e] + bb[e];
            wx[2 * j] = pk2(xn[0], xn[1]); wx[2 * j + 1] = pk2(xn[2], xn[3]);
            const float h0 = xn[0] * (1.f + sc[0]) + sh[0], h1 = xn[1] * (1.f + sc[1]) + sh[1], h2 = xn[2] * (1.f + sc[2]) + sh[2], h3 = xn[3] * (1.f + sc[3]) + sh[3];
            wm[2 * j] = pk2(h0, h1); wm[2 * j + 1] = pk2(h2, h3);
            int v = 0; v = __builtin_amdgcn_cvt_pk_fp8_f32(h0, h1, v, false); v = __builtin_amdgcn_cvt_pk_fp8_f32(h2, h3, v, true); w8[j] = v; }
        *(GAS u32x4*)((unsigned char*)(F.ws + WS_XM8) + (size_t)row * DM + 16 * F.lane) = (u32x4){(unsigned)w8[0], (unsigned)w8[1], (unsigned)w8[2], (unsigned)w8[3]};
        *(GAS u32x4*)xr = (u32x4){wx[0], wx[1], wx[2], wx[3]}; *(GAS u32x4*)(xr + 8) = (u32x4){wx[4], wx[5], wx[6], wx[7]};
        *(GAS u32x4*)xm = (u32x4){wm[0], wm[1], wm[2], wm[3]}; *(GAS u32x4*)(xm + 8) = (u32x4){wm[4], wm[5], wm[6], wm[7]};
    }
}
__device__ __forceinline__ void ph_ln2(Frame& F, int l, int ntok, bool last) {
    const int gw = F.wg * NWAVES + F.wave, NGW = F.G * NWAVES;
    const int cA = 256 * (F.lane >> 4) + 32 * ((F.lane >> 2) & 3) + 8 * (F.lane & 3);
#define LN2_COL(j) (cA + ((j) < 2 ? 4 * (j) : 128 + 4 * ((j) - 2)))
    const float* lg = F.in[I_LN2G] + l * DM; const float* lb = F.in[I_LN2B] + l * DM;
    for (int row = gw; row < ntok; row += NGW) {
        bf16_t* xr = (bf16_t*)(F.ws + WS_XR) + (size_t)row * DM;
        const unsigned char* y2 = (const unsigned char*)(F.ws + WS_Y2) + (size_t)row * 9 * DM + 16 * F.lane;
        const float* wg = (const float*)(F.ws + WS_WGT) + (size_t)row * 8;
        const float* md = mod_ptr(F, l, row);
        float ff[16];
#pragma unroll
        for (int e = 0; e < 16; ++e) ff[e] = 0.f;
        u32x4 q[9];
#pragma unroll
        for (int k = 0; k < 9; ++k) q[k] = __builtin_nontemporal_load((const GAS u32x4*)(y2 + (size_t)k * DM));
#pragma unroll
        for (int k = 0; k < 9; ++k) { const float wk = (k < 8 ? wg[k] : 1.0f) * pg8::Y2_INV; const unsigned a[4] = {q[k].x, q[k].y, q[k].z, q[k].w};
#pragma unroll
            for (int e = 0; e < 4; ++e) { const f32x2 lo = __builtin_amdgcn_cvt_pk_f32_fp8((int)a[e], false), hi = __builtin_amdgcn_cvt_pk_f32_fp8((int)a[e], true);
                ff[4 * e] += wk * lo.x; ff[4 * e + 1] += wk * lo.y; ff[4 * e + 2] += wk * hi.x; ff[4 * e + 3] += wk * hi.y; } }
        float v[16], xo[16]; float s = 0.f;
        { const u32x4 xa = __builtin_nontemporal_load((const GAS u32x4*)(xr + cA)), xb = __builtin_nontemporal_load((const GAS u32x4*)(xr + cA + 128)); unpack8(xa, xo); unpack8(xb, xo + 8); }
#pragma unroll
        for (int j = 0; j < 4; ++j) { const f32x4 g2 = *(const GAS f32x4*)(md + 5120 + LN2_COL(j));
#pragma unroll
            for (int e = 0; e < 4; ++e) { v[4 * j + e] = xo[4 * j + e] * DN_ALPHA + g2[e] * ff[4 * j + e]; s += v[4 * j + e]; } }
        const float mean = wave_sum(s, F.lane) * (1.f / DM); float s2 = 0.f;
#pragma unroll
        for (int e = 0; e < 16; ++e) { v[e] -= mean; s2 += v[e] * v[e]; }
        const float rstd = 1.f / sqrtf(wave_sum(s2, F.lane) * (1.f / DM) + LN_EPS);
        const float* mdn = last ? md : mod_ptr(F, l + 1, row);
        float xn[16];
#pragma unroll
        for (int j = 0; j < 4; ++j) { const f32x4 g = *(const GAS f32x4*)(lg + LN2_COL(j)), bb = *(const GAS f32x4*)(lb + LN2_COL(j));
#pragma unroll
            for (int e = 0; e < 4; ++e) xn[4 * j + e] = v[4 * j + e] * rstd * g[e] + bb[e]; }
        if (last) { float* op = F.out + (size_t)row * DM;
#pragma unroll
            for (int j = 0; j < 4; ++j) *(GAS f32x4*)(op + LN2_COL(j)) = (f32x4){xn[4 * j], xn[4 * j + 1], xn[4 * j + 2], xn[4 * j + 3]}; }
        else {
            *(GAS u32x4*)(xr + cA) = (u32x4){pk2(xn[0], xn[1]), pk2(xn[2], xn[3]), pk2(xn[4], xn[5]), pk2(xn[6], xn[7])}; *(GAS u32x4*)(xr + cA + 128) = (u32x4){pk2(xn[8], xn[9]), pk2(xn[10], xn[11]), pk2(xn[12], xn[13]), pk2(xn[14], xn[15])};
            bf16_t* xm = (bf16_t*)(F.ws + WS_XM) + (size_t)row * DM;
            unsigned w[8];
#pragma unroll
            for (int j = 0; j < 4; ++j) { const f32x4 sh = *(const GAS f32x4*)(mdn + LN2_COL(j)), sc = *(const GAS f32x4*)(mdn + 1024 + LN2_COL(j));
                w[2 * j] = pk2(xn[4 * j] * (1.f + sc[0]) + sh[0], xn[4 * j + 1] * (1.f + sc[1]) + sh[1]); w[2 * j + 1] = pk2(xn[4 * j + 2] * (1.f + sc[2]) + sh[2], xn[4 * j + 3] * (1.f + sc[3]) + sh[3]); }
            *(GAS u32x4*)(xm + cA) = (u32x4){w[0], w[1], w[2], w[3]}; *(GAS u32x4*)(xm + cA + 128) = (u32x4){w[4], w[5], w[6], w[7]};
        }
    }
#undef LN2_COL
}

__device__ __forceinline__ unsigned f_ord(float f) { const unsigned u = __builtin_bit_cast(unsigned, f); return (u & 0x80000000u) ? ~u : (u | 0x80000000u); }
__device__ __forceinline__ unsigned long long wave_max_u64(unsigned long long v, int lane) {
#pragma unroll
    for (int o = 1; o < 64; o <<= 1) { const unsigned lo = (unsigned)shxi((int)(unsigned)v, o, lane), hi = (unsigned)shxi((int)(unsigned)(v >> 32), o, lane); const unsigned long long w = ((unsigned long long)hi << 32) | lo; v = w > v ? w : v; }
    return v;
}
__device__ __forceinline__ float seg16_max(float v, int lane) { v = fmaxf(v, shx(v, 1, lane)); v = fmaxf(v, shx(v, 2, lane)); v = fmaxf(v, shx(v, 4, lane)); v = fmaxf(v, shx(v, 8, lane)); return v; }
__device__ __forceinline__ int seg16_min_i(int v, int lane) { int w; w = shxi(v, 1, lane); v = w < v ? w : v; w = shxi(v, 2, lane); v = w < v ? w : v; w = shxi(v, 4, lane); v = w < v ? w : v; w = shxi(v, 8, lane); v = w < v ? w : v; return v; }
template <int CTRL> __device__ __forceinline__ int dpp_i(int v) { return __builtin_amdgcn_update_dpp(0, v, CTRL, 0xf, 0xf, true); }
__device__ __forceinline__ unsigned row_max_u(unsigned v) { unsigned w; w = (unsigned)dpp_i<0xB1>((int)v); v = w > v ? w : v; w = (unsigned)dpp_i<0x4E>((int)v); v = w > v ? w : v; w = (unsigned)dpp_i<0x141>((int)v); v = w > v ? w : v; w = (unsigned)dpp_i<0x140>((int)v); v = w > v ? w : v; return v; }
__device__ __forceinline__ float row_max_f(float v) { v = fmaxf(v, __builtin_bit_cast(float, dpp_i<0xB1>(__builtin_bit_cast(int, v)))); v = fmaxf(v, __builtin_bit_cast(float, dpp_i<0x4E>(__builtin_bit_cast(int, v)))); v = fmaxf(v, __builtin_bit_cast(float, dpp_i<0x141>(__builtin_bit_cast(int, v)))); v = fmaxf(v, __builtin_bit_cast(float, dpp_i<0x140>(__builtin_bit_cast(int, v)))); return v; }
__device__ __forceinline__ int row_min_i(int v) { int w; w = dpp_i<0xB1>(v); v = w < v ? w : v; w = dpp_i<0x4E>(v); v = w < v ? w : v; w = dpp_i<0x141>(v); v = w < v ? w : v; w = dpp_i<0x140>(v); v = w < v ? w : v; return v; }
__device__ __forceinline__ float rdlane_f(float v, int l) { return __builtin_bit_cast(float, __builtin_amdgcn_readlane(__builtin_bit_cast(int, v), l)); }
__device__ __forceinline__ unsigned wave_max_u(unsigned v) {
    v = row_max_u(v);
    const unsigned a = (unsigned)__builtin_amdgcn_readlane((int)v, 0), b = (unsigned)__builtin_amdgcn_readlane((int)v, 16), c = (unsigned)__builtin_amdgcn_readlane((int)v, 32), d = (unsigned)__builtin_amdgcn_readlane((int)v, 48);
    const unsigned ab = a > b ? a : b, cd = c > d ? c : d; return ab > cd ? ab : cd;
}
__device__ __forceinline__ float row_top2(float v, int l16) {
    const float m1 = row_max_f(v);
    const int first = row_min_i(v == m1 ? l16 : 99);
    const float m2 = row_max_f(l16 == first ? -3.0e38f : v);
    return m1 + m2;
}
__device__ __forceinline__ float seg16_top2(float v, int lane) {
    const float m1 = seg16_max(v, lane);
    const int first = seg16_min_i(v == m1 ? (lane & 15) : 99, lane);
    const float m2 = seg16_max((lane & 15) == first ? -3.0e38f : v, lane);
    return m1 + m2;
}
__device__ __forceinline__ void ph_route(Frame& F, int l, int ntok) {
    LAS int* hist = (LAS int*)F.lds;
    LAS int* base = hist + 128;
    LAS unsigned* alist = (LAS unsigned*)(F.lds + 1024);
    const int tpw = (ntok + F.G - 1) / F.G, t0 = F.wg * tpw, t1 = (t0 + tpw) < ntok ? (t0 + tpw) : ntok;
    __syncthreads();
    if (F.tid < 128) hist[F.tid] = 0;
    __syncthreads();
    const float* LG = (const float*)(F.ws + WS_LOGIT); const float* rb = F.in[I_RB] + l * NEXP;
    const float b0 = rb[F.lane], b1 = rb[F.lane + 64];
    constexpr int RT = 4;
    for (int tb = t0 + F.wave * RT; tb < t1; tb += NWAVES * RT) {
        float s0[RT], s1[RT], e0[RT], e1[RT], gs0[RT], gs1[RT]; unsigned h0[RT], h1[RT]; int mye[RT]; float myw[RT], wsum[RT];
#pragma unroll
        for (int j = 0; j < RT; ++j) { const int tok = (tb + j) < t1 ? tb + j : t1 - 1;
            const float x0 = LG[(size_t)tok * 256 + F.lane], x1 = LG[(size_t)tok * 256 + 64 + F.lane];
            s0[j] = __builtin_amdgcn_rcpf(1.0f + __expf(-x0)); s1[j] = __builtin_amdgcn_rcpf(1.0f + __expf(-x1)); e0[j] = s0[j] + b0; e1[j] = s1[j] + b1; }
#pragma unroll
        for (int j = 0; j < RT; ++j) { gs0[j] = row_top2(e0[j], F.lane & 15); gs1[j] = row_top2(e1[j], F.lane & 15); }
#pragma unroll
        for (int j = 0; j < RT; ++j) {
            float gsc[8];
#pragma unroll
            for (int g = 0; g < 4; ++g) { gsc[g] = rdlane_f(gs0[j], g * 16); gsc[4 + g] = rdlane_f(gs1[j], g * 16); }
            unsigned gmask = 0u;
#pragma unroll
            for (int g = 0; g < 8; ++g) { int cnt = 0;
#pragma unroll
                for (int g2 = 0; g2 < 8; ++g2) cnt += (gsc[g2] > gsc[g] || (gsc[g2] == gsc[g] && g2 < g)) ? 1 : 0;
                gmask |= (cnt < 4) ? (1u << g) : 0u; }
            const bool ok0 = (gmask >> (F.lane >> 4)) & 1u, ok1 = (gmask >> (4 + (F.lane >> 4))) & 1u;
            h0[j] = ok0 ? f_ord(e0[j]) : 0u; h1[j] = ok1 ? f_ord(e1[j]) : 0u;
            mye[j] = 0; myw[j] = 0.f; wsum[j] = 0.f; }
#pragma unroll
        for (int k = 0; k < 8; ++k) {
#pragma unroll
            for (int j = 0; j < RT; ++j) {
                const unsigned bh = h0[j] >= h1[j] ? h0[j] : h1[j];
                const unsigned H = wave_max_u(bh);
                const unsigned mylo = h0[j] == H ? (unsigned)(255 - F.lane) : (h1[j] == H ? (unsigned)(255 - 64 - F.lane) : 0u);
                const unsigned Lm = wave_max_u(mylo);
                const int e = 255 - (int)Lm;
                if (e < 64) { if (F.lane == e) h0[j] = 0u; } else { if (F.lane == e - 64) h1[j] = 0u; }
                const float sv = e < 64 ? rdlane_f(s0[j], e) : rdlane_f(s1[j], e - 64);
                wsum[j] += sv; if (F.lane == k) { mye[j] = e; myw[j] = sv; } }
        }
#pragma unroll
        for (int j = 0; j < RT; ++j) { const int tok = tb + j;
            if (tok < t1 && F.lane < 8) {
                const int lr = __hip_atomic_fetch_add(&hist[mye[j]], 1, __ATOMIC_RELAXED, __HIP_MEMORY_SCOPE_WORKGROUP);
                alist[(tok - t0) * 8 + F.lane] = (unsigned)mye[j] | ((unsigned)lr << 8);
                ((int*)(F.ws + WS_EIDX))[(size_t)tok * 8 + F.lane] = mye[j];
                ((float*)(F.ws + WS_WGT))[(size_t)tok * 8 + F.lane] = myw[j] / wsum[j] * 2.5f;
            } }
    }
    __syncthreads();
    if (F.tid < 128) { const int hcount = hist[F.tid]; base[F.tid] = hcount ? (int)atomicAdd(F.ctl + CW_CNT + l * 256 + F.tid, (unsigned)hcount) : 0; }
    __syncthreads();
    for (int a = F.tid; a < (t1 - t0) * 8; a += NTHR) { const unsigned v = alist[a]; ((int*)(F.ws + WS_RNK))[(size_t)t0 * 8 + a] = base[v & 0xffu] + (int)(v >> 8); }
}
__device__ __forceinline__ void ph_positions(Frame& F, int l, int ntok) {
    LAS int* cnt = (LAS int*)F.lds;
    LAS int* off = cnt + 132;
    __syncthreads();
    if (F.tid < NE1) cnt[F.tid] = F.tid < NEXP ? (int)__hip_atomic_load(F.ctl + CW_CNT + l * 256 + F.tid, __ATOMIC_RELAXED, __HIP_MEMORY_SCOPE_AGENT) : ntok;
    __syncthreads();
    if (F.tid == 0) { int o = 0; for (int e = 0; e < NE1; ++e) { off[e] = o; o += (cnt[e] + 255) & ~255; } off[NE1] = o; }
    __syncthreads();
    const int gt = F.wg * NTHR + F.tid, NGT = F.G * NTHR;
    int* rowtok = (int*)(F.ws + WS_ROWTOK); int* rowdst = (int*)(F.ws + WS_ROWDST); int* tile_exp = (int*)(F.ws + WS_TILEEXP);
    const int* eidx = (const int*)(F.ws + WS_EIDX); const int* rnk = (const int*)(F.ws + WS_RNK);
    for (int a = gt; a < ntok * 8; a += NGT) { const int tok = a >> 3, k = a & 7; const int pos = off[eidx[a]] + rnk[a]; rowtok[pos] = tok; rowdst[pos] = tok * 9 + k; }
    for (int tok = gt; tok < ntok; tok += NGT) { const int pos = off[NEXP] + tok; rowtok[pos] = tok; rowdst[pos] = tok * 9 + 8; }
    for (int i = gt; i < NE1 * 256; i += NGT) { const int e = i >> 8, p = i & 255; const int row = off[e] + cnt[e] + p; if (row < off[e + 1]) { rowtok[row] = 0; rowdst[row] = -1; } }
    for (int i = gt; i < NE1 * 320; i += NGT) { const int e = i / 320, p = i % 320; const int t = (off[e] >> 8) + p; if (t < (off[e + 1] >> 8)) tile_exp[t] = e; }
    if (gt == 0) F.ctl[CW_NTL + l] = (unsigned)(off[NE1] >> 8);
}

#ifndef MK_MULTI
#define MK_MULTI 0
#endif
constexpr int PH_PER_LAYER = 12, NPHASE = 2 + DEPTH * PH_PER_LAYER;
struct Args { const float* in[36]; float* out; unsigned char* ws; int ph_lo, ph_hi; };

__global__ void __launch_bounds__(NTHR, 2) mk_fwd(Args args) {
    extern __shared__ __attribute__((aligned(16))) unsigned char lds_raw[];
    Frame F;
    F.lds = (LAS unsigned char*)lds_raw;
    F.tid = threadIdx.x; F.lane = F.tid & 63; F.wave = __builtin_amdgcn_readfirstlane(F.tid >> 6);
    const int wave0 = F.wave;
    F.G = gridDim.x; F.wg = blockIdx.x;
    F.in = args.in;
    F.out = args.out; F.ws = args.ws; F.ctl = (unsigned*)(args.ws + WS_CTL);
    volatile LAS unsigned* MISC = (volatile LAS unsigned*)(F.lds + MISC_OFF);
    if (F.tid < 32) MISC[F.tid] = 0u;
    __syncthreads();
    const int lo = args.ph_lo, hi = args.ph_hi;
    const bool single = (hi - lo) > 1;
    XcdBarrier bar; bar.bar = F.ctl + CW_BAR; bar.x = 0; bar.st = nullptr;
    if (single) bar = xcd_barrier_post(F.ctl + CW_BAR, MISC + 8);
#define IN(k) (lo <= (k) && (k) < hi)
#ifndef PROBE_MASK
#define PROBE_MASK 0
#endif
#define REP(k) for (int _rep = 0; _rep < (((PROBE_MASK >> (k)) & 1) ? 2 : 1); ++_rep)
#define SEAM(k) do { if (IN(k) && IN((k) + 1)) { xcd_barrier(bar); if ((PROBE_MASK >> 15) & 1) xcd_barrier(bar); } } while (0)
#define FRESH() do { int _ln; asm volatile("v_mbcnt_lo_u32_b32 %0, -1, 0\n\tv_mbcnt_hi_u32_b32 %0, -1, %0" : "=v"(_ln)); int _wv = wave0; asm volatile("" : "+s"(_wv)); F.lane = _ln; F.wave = _wv; F.tid = (_wv << 6) | _ln; \
        unsigned char* _w = args.ws; asm volatile("" : "+s"(_w)); F.ws = _w; F.ctl = (unsigned*)(_w + WS_CTL); float* _o = args.out; asm volatile("" : "+s"(_o)); F.out = _o; } while (0)

    if (IN(0)) { FRESH(); REP(13) { p0_static_weights(F); __syncthreads(); } REP(14) { p0_mod(F); __syncthreads(); } FRESH(); REP(16) { p0_hyena_filters(F); __syncthreads(); } }
    SEAM(0);
    if (IN(1)) { FRESH(); p0_init_rows(F); }
    SEAM(1);
#pragma unroll 1
    for (int l = 0; l < DEPTH; ++l) {
        const int pb = 2 + l * PH_PER_LAYER; const bool last = (l == DEPTH - 1); const int ntok = last ? NLAT : NROW;
        if (IN(pb + 0)) { FRESH();
            REP(0) { p_expert_weights(F, l); __syncthreads(); }
            pg8::DenseOrder S; S.init(NROW, DIN, F.G, F.wg); pg8::EpiBf16 E{(bf16_t*)(F.ws + WS_U), DIN};
            REP(1) pg8::gemm_phase<pg8::EpiBf16, pg8::DenseOrder, false>(F.tid, F.lds, (const bf16_t*)(F.ws + WS_XM), (const bf16_t*)(F.ws + WS_WIN) + (size_t)l * DIN * DM, DM, nullptr, S, E);
        }
        SEAM(pb + 0);
        if (IN(pb + 1)) { FRESH(); REP(2) { ph_transposes(F, l); __syncthreads(); } FRESH(); REP(3) { ph_gla_local(F, l); __syncthreads(); } }
        SEAM(pb + 1);
        if (IN(pb + 2)) { FRESH(); REP(4) { ph_na(F, l, last); } FRESH(); REP(5) { ph_gla_scan(F); } __syncthreads(); FRESH(); REP(6) { ph_hyena(F, l, last); } }
        SEAM(pb + 2);
        if (IN(pb + 3)) { FRESH(); ph_hy_transpose(F, last); __syncthreads(); FRESH(); REP(7) { ph_gla_out(F, l, last); } }
        SEAM(pb + 3);
        if (IN(pb + 4)) { FRESH();
            pg8::DenseOrder S; S.init(ntok, DM, F.G, F.wg); pg8::EpiBf16 E{(bf16_t*)(F.ws + WS_Y), DM};
            REP(8) pg8::gemm_phase<pg8::EpiBf16, pg8::DenseOrder, false>(F.tid, F.lds, (const bf16_t*)(F.ws + WS_MIX), (const bf16_t*)(F.ws + WS_WOUT) + (size_t)l * DM * DM, DM, nullptr, S, E);
        }
        SEAM(pb + 4);
        if (IN(pb + 5)) { FRESH(); ph_ln1(F, l, ntok); }
        SEAM(pb + 5);
        if (IN(pb + 6)) { FRESH();
            pg8::DenseOrder S; S.init(ntok, 256, F.G, F.wg); pg8::EpiF32H E{(float*)(F.ws + WS_LOGIT), 256};
            REP(9) pg8::gemm_phase<pg8::EpiF32H, pg8::DenseOrder, false, false, true, true, true>(F.tid, F.lds, (const bf16_t*)(F.ws + WS_XM), (const bf16_t*)(F.ws + WS_WR) + (size_t)l * 256 * DM, DM, nullptr, S, E);
        }
        SEAM(pb + 6);
        if (IN(pb + 7)) { FRESH(); ph_route(F, l, ntok); }
        SEAM(pb + 7);
        if (IN(pb + 8)) { FRESH(); REP(12) { ph_positions(F, l, ntok); __syncthreads(); } }
        SEAM(pb + 8);
        if (IN(pb + 9)) { FRESH();
            const int ntl = (int)__hip_atomic_load(F.ctl + CW_NTL + l, __ATOMIC_RELAXED, __HIP_MEMORY_SCOPE_AGENT);
            pg8::GroupedOrder S; S.init(ntl, 2, F.G, F.wg); S.preload((const int*)(F.ws + WS_TILEEXP), F.lds + pg8::STAGE_BYTES + 4096, F.tid, NTHR); pg8::EpiSwiglu E{(unsigned char*)(F.ws + WS_ACT)};
            REP(10) pg8::gemm_phase<pg8::EpiSwiglu, pg8::GroupedOrder, true, true>(F.tid, F.lds, (const void*)(F.ws + WS_XM8), (const void*)(F.ws + WS_EXP1), DM, (const int*)(F.ws + WS_ROWTOK), S, E);
        }
        SEAM(pb + 9);
        if (IN(pb + 10)) { FRESH();
            const int ntl = (int)__hip_atomic_load(F.ctl + CW_NTL + l, __ATOMIC_RELAXED, __HIP_MEMORY_SCOPE_AGENT);
            pg8::GroupedOrder S; S.init(ntl, 4, F.G, F.wg); S.preload((const int*)(F.ws + WS_TILEEXP), F.lds + pg8::STAGE_BYTES + 4096, F.tid, NTHR); pg8::EpiScatter E{(unsigned char*)(F.ws + WS_Y2), (const int*)(F.ws + WS_ROWDST)};
            REP(11) pg8::gemm_phase<pg8::EpiScatter, pg8::GroupedOrder, false, true>(F.tid, F.lds, (const void*)(F.ws + WS_ACT), (const void*)(F.ws + WS_EXP2), EH, nullptr, S, E);
        }
        SEAM(pb + 10);
        if (IN(pb + 11)) { FRESH(); ph_ln2(F, l, ntok, last); }
        SEAM(pb + 11);
    }
#undef IN
#undef SEAM
#undef FRESH
}

extern "C" void kernel_launch(void* const* d_in, const int* in_sizes, int n_in, void* d_out, int out_size, void* d_ws, size_t ws_size, hipStream_t stream) {
    static int grid = 0;
    if (grid == 0) {
        if (n_in != 36 || out_size != NLAT * DM || ws_size < WS_END) { fprintf(stderr, "kernel_launch: unexpected shapes (n_in %d out %d ws %zu need %zu)\n", n_in, out_size, ws_size, (size_t)WS_END); grid = -1; return; }
        int dev = 0, cus = 0, per_cu = 0;
        if (hipGetDevice(&dev) != hipSuccess || hipDeviceGetAttribute(&cus, hipDeviceAttributeMultiprocessorCount, dev) != hipSuccess) { grid = -1; return; }
        if (hipFuncSetAttribute((const void*)mk_fwd, hipFuncAttributeMaxDynamicSharedMemorySize, LDS_BYTES) != hipSuccess) { fprintf(stderr, "kernel_launch: hipFuncSetAttribute failed\n"); grid = -1; return; }
        if (hipOccupancyMaxActiveBlocksPerMultiprocessor(&per_cu, (const void*)mk_fwd, NTHR, LDS_BYTES) != hipSuccess || per_cu < 1) { fprintf(stderr, "kernel_launch: occupancy query says %d\n", per_cu); }
        (void)hipGetLastError();
        grid = cus;
    }
    if (grid < 0) return;
    (void)hipMemsetAsync((char*)d_ws + WS_CTL, 0, CTL_BYTES, stream);
    Args a{};
    for (int i = 0; i < 36; ++i) a.in[i] = (const float*)d_in[i];
    a.out = (float*)d_out; a.ws = (unsigned char*)d_ws;
#if MK_MULTI
    for (int p = 0; p < NPHASE; ++p) { a.ph_lo = p; a.ph_hi = p + 1; hipLaunchKernelGGL(mk_fwd, dim3(grid), dim3(NTHR), LDS_BYTES, stream, a); }
#else
    a.ph_lo = 0; a.ph_hi = NPHASE; hipLaunchKernelGGL(mk_fwd, dim3(grid), dim3(NTHR), LDS_BYTES, stream, a);
#endif
}
```

```cpp
#include <hip/hip_runtime.h>
#include <cstdio>
#include <cstdint>

#define LAS __attribute__((address_space(3)))
#define GAS __attribute__((address_space(1)))
typedef unsigned short bf16_t;
typedef short bf16x8 __attribute__((ext_vector_type(8)));
typedef float f32x4 __attribute__((ext_vector_type(4)));
typedef float f32x2 __attribute__((ext_vector_type(2)));
typedef unsigned u32x4 __attribute__((ext_vector_type(4)));
typedef unsigned u32x2 __attribute__((ext_vector_type(2)));

constexpr int NB = 16, SEQ = 4096, CTXL = 256, DM = 1024, DEPTH = 4;
constexpr int NLAT = NB * SEQ;
constexpr int NCTX = NB * CTXL;
constexpr int NROW = NLAT + NCTX;
constexpr int SPB = SEQ + CTXL;
constexpr int DIN_REF = 3104;
constexpr int DIN = 3328;
constexpr int UQ = 0, UK = 512, UV = 1024, UGQ = 1536, UGK = 1664, UGV = 1792, UGR = 2048, UHY = 2304, ULAF = 3072, ULAB = 3200;
constexpr int NEXP = 128, TOPK = 8, EH = 256;
constexpr int NE1 = NEXP + 1;
constexpr int RMAX = 659712;
constexpr int TMAX = RMAX / 256;
constexpr float LN_EPS = 1e-6f;
constexpr float DN_ALPHA = 1.6817928305074290f;

__device__ __forceinline__ unsigned f2bf(float f) { unsigned u = __builtin_bit_cast(unsigned, f); return (u + 0x7fffu + ((u >> 16) & 1u)) >> 16; }
typedef __bf16 bf16v2 __attribute__((ext_vector_type(2)));
__device__ __forceinline__ unsigned pk2(float lo, float hi) { const f32x2 v = {lo, hi}; const bf16v2 b = __builtin_convertvector(v, bf16v2); return __builtin_bit_cast(unsigned, b); }
__device__ __forceinline__ float bf2f(unsigned short b) { return __builtin_bit_cast(float, ((unsigned)b) << 16); }
__device__ __forceinline__ float bflo(unsigned w) { return __builtin_bit_cast(float, w << 16); }
__device__ __forceinline__ float bfhi(unsigned w) { return __builtin_bit_cast(float, w & 0xffff0000u); }
__device__ __forceinline__ float shx(float v, int o, int lane) { return __builtin_bit_cast(float, __builtin_amdgcn_ds_bpermute((lane ^ o) << 2, __builtin_bit_cast(int, v))); }
__device__ __forceinline__ int shxi(int v, int o, int lane) { return __builtin_amdgcn_ds_bpermute((lane ^ o) << 2, v); }
__device__ __forceinline__ float shf(float v, int src) { return __builtin_bit_cast(float, __builtin_amdgcn_ds_bpermute(src << 2, __builtin_bit_cast(int, v))); }
__device__ __forceinline__ float wave_sum(float v, int lane) {
#pragma unroll
    for (int o = 1; o < 64; o <<= 1) v += shx(v, o, lane);
    return v;
}
__device__ __forceinline__ void unpack8(const u32x4 q, float* o) { o[0] = bflo(q.x); o[1] = bfhi(q.x); o[2] = bflo(q.y); o[3] = bfhi(q.y); o[4] = bflo(q.z); o[5] = bfhi(q.z); o[6] = bflo(q.w); o[7] = bfhi(q.w); }
__device__ __forceinline__ float silu_f(float x) { return x * __builtin_amdgcn_rcpf(1.0f + __expf(-x)); }
#define LDS_WAIT() asm volatile("s_waitcnt lgkmcnt(0)" ::: "memory")
#define VM_WAIT() asm volatile("s_waitcnt vmcnt(0)" ::: "memory")

#define XB_TMO      128
#define XB_XCNT(j)  (256  + 64 * (j))
#define XB_XSUB(j)  (1280 + 64 * (j))
#define XB_XGEN(j)  (2304 + 64 * (j))
#define XB_TOP      3328
#define XB_TOPGEN   3392
#define XCD_BAR_WORDS 3456
#define XB_SPIN_CAP (1u << 18)

__device__ __forceinline__ unsigned xb_ld(unsigned* p)              { return __hip_atomic_load(p, __ATOMIC_RELAXED, __HIP_MEMORY_SCOPE_AGENT); }
__device__ __forceinline__ unsigned xb_add(unsigned* p, unsigned v) { return __hip_atomic_fetch_add(p, v, __ATOMIC_RELAXED, __HIP_MEMORY_SCOPE_AGENT); }
__device__ __forceinline__ unsigned xb_xcc_id() { return (unsigned)__builtin_amdgcn_s_getreg((3 << 11) | 20) & 0xFu; }
#define XB_SPIN(cond, bar) do { unsigned _sp = 0; while (cond) { __builtin_amdgcn_s_sleep(1); \
    if ((++_sp & 255u) == 0u) { if (xb_ld(&(bar)[XB_TMO])) break; if (_sp > XB_SPIN_CAP) { atomicAdd(&(bar)[XB_TMO], 1u); break; } } } } while (0)

struct XcdBarrier { unsigned* bar; unsigned x; volatile LAS unsigned* st; };

__device__ __forceinline__ XcdBarrier xcd_barrier_post(unsigned* bar, volatile LAS unsigned* st) {
    XcdBarrier b; b.bar = bar; b.x = xb_xcc_id(); b.st = st;
    if (threadIdx.x == 0) (void)xb_add(&bar[XB_XCNT(b.x)], 1u);
    return b;
}
__device__ __forceinline__ void xcd_barrier_complete(unsigned* bar, unsigned x, unsigned& nloc, unsigned& nx) {
    const unsigned G = gridDim.x * gridDim.y * gridDim.z;
    unsigned sum, cnt, mine, sp = 0u;
    for (;;) {
        sum = 0u; cnt = 0u; mine = 0u;
#pragma unroll
        for (unsigned j = 0; j < 16; ++j) { const unsigned c = xb_ld(&bar[XB_XCNT(j)]); sum += c; cnt += (c > 0u) ? 1u : 0u; mine = (j == x) ? c : mine; }
        if (sum == G) break;
        __builtin_amdgcn_s_sleep(1);
        if ((++sp & 255u) == 0u) { if (xb_ld(&bar[XB_TMO])) break; if (sp > XB_SPIN_CAP) { atomicAdd(&bar[XB_TMO], 1u); break; } }
    }
    nloc = mine > 0u ? mine : 1u; nx = cnt > 0u ? cnt : 1u;
}
__device__ __forceinline__ void xcd_barrier(const XcdBarrier& b) {
    asm volatile("s_waitcnt vmcnt(0)" ::: "memory");
    __syncthreads();
    if (threadIdx.x == 0) {
        unsigned* bar = b.bar;
        __builtin_amdgcn_s_waitcnt(0);
        unsigned nloc = b.st[0], nx = b.st[1];
        if (nloc == 0u) { xcd_barrier_complete(bar, b.x, nloc, nx); b.st[0] = nloc; b.st[1] = nx; }
        const unsigned old = xb_add(&bar[XB_XSUB(b.x)], 1u);
        const unsigned gen = old / nloc;
        if (old + 1u == (gen + 1u) * nloc) {
            __builtin_amdgcn_fence(__ATOMIC_RELEASE, "agent");
            asm volatile("s_waitcnt vmcnt(0)" ::: "memory");
            const unsigned og = xb_add(&bar[XB_TOP], 1u);
            const unsigned tg = og / nx;
            if (og + 1u == (tg + 1u) * nx) xb_add(&bar[XB_TOPGEN], 1u);
            else XB_SPIN(xb_ld(&bar[XB_TOPGEN]) == tg, bar);
            __builtin_amdgcn_fence(__ATOMIC_ACQUIRE, "agent");
            xb_add(&bar[XB_XGEN(b.x)], 1u);
            asm volatile("s_waitcnt vmcnt(0)" ::: "memory");
        } else {
            XB_SPIN(xb_ld(&bar[XB_XGEN(b.x)]) == gen, bar);
            __builtin_amdgcn_fence(__ATOMIC_ACQUIRE, "agent");
            asm volatile("s_waitcnt vmcnt(0)" ::: "memory");
        }
    }
    __syncthreads();
}

namespace pg8 {
constexpr int BM = 256, BK = 64, HALF = 128, HTB = HALF * BK * 2, STAGE_BYTES = 8 * HTB, NXCD = 8, WGM = 8;
__host__ __device__ __forceinline__ int lds_byte(int r, int c) { const int st = (r >> 4) * 2 + (c >> 5), rr = r & 15, cc = c & 31, ob = rr * 64 + cc * 2; return st * 1024 + (ob ^ (((ob >> 9) & 1) << 5)); }
__host__ __device__ __forceinline__ void stage_rc(int b, int& R, int& C) { const int st = b / 1024, sb = b % 1024, swz = sb ^ (((sb >> 9) & 1) << 5); R = (st >> 1) * 16 + swz / 64; C = (st & 1) * 32 + (swz % 64) / 2; }
__host__ __device__ __forceinline__ int perm32(int rho) { const int n = rho >> 4, i = rho & 15; return 8 * (i >> 2) + 4 * n + (i & 3); }

struct Unit { int arow0, brow0, orow0, ocol0, aux; };

struct DenseOrder {
    int nM, nN, nwg, G, c;
    __device__ void init(int M, int N, int G_, int c_) { nM = M / BM; nN = N / BM; nwg = nM * nN; G = G_; c = c_; }
    __device__ __forceinline__ bool next(int i, Unit& u) const {
        const long L = (long)i * G + c; if (L >= nwg) return false;
        int wgid = (int)L; { const int q = nwg / NXCD, r = nwg % NXCD, xcd = wgid % NXCD, off = wgid / NXCD; wgid = (xcd < r ? xcd * (q + 1) : r * (q + 1) + (xcd - r) * q) + off; }
        const int nig = WGM * nN, gid = wgid / nig, fm = gid * WGM, gsz = (nM - fm) < WGM ? (nM - fm) : WGM;
        const int pm = fm + ((wgid % nig) % gsz), pn = (wgid % nig) / gsz;
        u.arow0 = pm * BM; u.brow0 = pn * BM; u.orow0 = pm * BM; u.ocol0 = pn * BM; u.aux = 0; return true;
    }
};
struct GroupedOrder {
    const LAS unsigned char* tab; int nN, nslot, slot, t0, t1;
    __device__ __forceinline__ void init(int ntiles, int nN_, int G, int c) {
        nN = nN_;
        if ((G & 7) == 0) { const int per = (ntiles + 7) >> 3, x = c & 7; nslot = G >> 3; slot = c >> 3; t0 = x * per; t1 = (t0 + per) < ntiles ? (t0 + per) : ntiles; }
        else { nslot = G; slot = c; t0 = 0; t1 = ntiles; }
    }
    __device__ __forceinline__ void preload(const int* tile_exp, LAS unsigned char* lds_tab, int tid, int nthr) {
        __syncthreads();
        for (int i = tid; i < t1 - t0; i += nthr) lds_tab[i] = (unsigned char)tile_exp[t0 + i];
        __syncthreads();
        tab = lds_tab;
    }
    __device__ __forceinline__ bool next(int i, Unit& u) const {
        const int q = i * nslot + slot, t = t0 + q / nN, pn = q % nN;
        if (t >= t1) return false;
        const int e = (int)tab[t - t0];
        u.arow0 = t * BM; u.brow0 = (e * nN + pn) * BM; u.orow0 = t * BM; u.ocol0 = pn * BM; u.aux = e; return true;
    }
};

struct RouterOrder {
    DenseOrder b;
    __device__ __forceinline__ bool next(int i, Unit& u) const { if (!b.next(i, u)) return false; const int pm = u.arow0 >> 8; u.brow0 = (pm < 256 ? (pm >> 4) : 16) * 128; return true; }
};
template <class Base> struct RangeOrder {
    Base b; int i0, i1;
    __device__ __forceinline__ bool next(int i, Unit& u) const { const int j = i + i0; if (j >= i1) return false; return b.next(j, u); }
};

__device__ __forceinline__ unsigned cvt_pk_bf16(float lo, float hi) { return pk2(lo, hi); }

struct NoPre {};
struct EpiF32 {
    static constexpr bool PERM = false; static constexpr int SCW = 0x7A7A7A7A; typedef NoPre Pre;
    __device__ __forceinline__ Pre prefetch(const Unit&, LAS unsigned char*, int, int, int) const { return Pre{}; }
    float* C; int ldc;
    __device__ __forceinline__ void operator()(const f32x4 (&acc)[2][2][4][2], const Unit& u, int wr, int wc, int fr, int fq, const Pre&, bool drain) const {
        if (drain) asm volatile("s_waitcnt vmcnt(0)" ::: "memory");
        const int row0 = u.orow0 + wr * 64 + fr, col0 = u.ocol0 + wc * 32 + 4 * fq;
#pragma unroll
        for (int ai = 0; ai < 2; ++ai)
#pragma unroll
            for (int m = 0; m < 4; ++m) { float* rowp = C + (size_t)(row0 + ai * HALF + m * 16) * ldc + col0;
#pragma unroll
                for (int bj = 0; bj < 2; ++bj)
#pragma unroll
                    for (int n = 0; n < 2; ++n) *(GAS f32x4*)(rowp + bj * HALF + n * 16) = acc[ai][bj][m][n]; }
    }
};
struct EpiF32H {
    static constexpr bool PERM = false; static constexpr int SCW = 0x7A7A7A7A; typedef NoPre Pre;
    __device__ __forceinline__ Pre prefetch(const Unit&, LAS unsigned char*, int, int, int) const { return Pre{}; }
    float* C; int ldc;
    __device__ __forceinline__ void operator()(const f32x4 (&acc)[2][2][4][2], const Unit& u, int wr, int wc, int fr, int fq, const Pre&, bool drain) const {
        if (drain) asm volatile("s_waitcnt vmcnt(0)" ::: "memory");
        const int row0 = u.orow0 + wr * 64 + fr, col0 = wc * 32 + 4 * fq;
#pragma unroll
        for (int ai = 0; ai < 2; ++ai)
#pragma unroll
            for (int m = 0; m < 4; ++m) { float* rowp = C + (size_t)(row0 + ai * HALF + m * 16) * ldc + col0;
#pragma unroll
                for (int n = 0; n < 2; ++n) *(GAS f32x4*)(rowp + n * 16) = acc[ai][0][m][n]; }
    }
};
struct EpiBf16 {
    static constexpr bool PERM = true; static constexpr int SCW = 0x7A7A7A7A; typedef NoPre Pre;
    __device__ __forceinline__ Pre prefetch(const Unit&, LAS unsigned char*, int, int, int) const { return Pre{}; }
    bf16_t* O; int ldc;
    __device__ __forceinline__ void operator()(const f32x4 (&acc)[2][2][4][2], const Unit& u, int wr, int wc, int fr, int fq, const Pre&, bool drain) const {
        const int row0 = u.orow0 + wr * 64 + fr, col0 = u.ocol0 + wc * 32 + 8 * fq;
        u32x4 w[2][4][2];
#pragma unroll
        for (int ai = 0; ai < 2; ++ai)
#pragma unroll
            for (int m = 0; m < 4; ++m)
#pragma unroll
                for (int bj = 0; bj < 2; ++bj) { const f32x4 v0 = acc[ai][bj][m][0], v1 = acc[ai][bj][m][1];
                    w[ai][m][bj].x = cvt_pk_bf16(v0[0], v0[1]); w[ai][m][bj].y = cvt_pk_bf16(v0[2], v0[3]); w[ai][m][bj].z = cvt_pk_bf16(v1[0], v1[1]); w[ai][m][bj].w = cvt_pk_bf16(v1[2], v1[3]); }
        if (drain) asm volatile("s_waitcnt vmcnt(0)" ::: "memory");
#pragma unroll
        for (int ai = 0; ai < 2; ++ai)
#pragma unroll
            for (int m = 0; m < 4; ++m) { bf16_t* rowp = O + (size_t)(row0 + ai * HALF + m * 16) * ldc + col0;
#pragma unroll
                for (int bj = 0; bj < 2; ++bj) *(GAS u32x4*)(rowp + bj * HALF) = w[ai][m][bj]; }
    }
};
struct EpiY8 {
    static constexpr bool PERM = true; static constexpr int SCW = 0x7A7A7A7A; typedef NoPre Pre;
    __device__ __forceinline__ Pre prefetch(const Unit&, LAS unsigned char*, int, int, int) const { return Pre{}; }
    unsigned char* O; int ldc;
    __device__ __forceinline__ void operator()(const f32x4 (&acc)[2][2][4][2], const Unit& u, int wr, int wc, int fr, int fq, const Pre&, bool drain) const {
        const int row0 = u.orow0 + wr * 64 + fr;
        u32x4 o[2][4];
#pragma unroll
        for (int ai = 0; ai < 2; ++ai)
#pragma unroll
            for (int m = 0; m < 4; ++m) { int w[4];
#pragma unroll
                for (int bj = 0; bj < 2; ++bj) { const f32x4 v0 = acc[ai][bj][m][0], v1 = acc[ai][bj][m][1];
                    int w0 = 0, w1 = 0;
                    w0 = __builtin_amdgcn_cvt_pk_fp8_f32(v0[0], v0[1], w0, false); w0 = __builtin_amdgcn_cvt_pk_fp8_f32(v0[2], v0[3], w0, true);
                    w1 = __builtin_amdgcn_cvt_pk_fp8_f32(v1[0], v1[1], w1, false); w1 = __builtin_amdgcn_cvt_pk_fp8_f32(v1[2], v1[3], w1, true);
                    w[2 * bj] = w0; w[2 * bj + 1] = w1; }
                o[ai][m] = (u32x4){(unsigned)w[0], (unsigned)w[1], (unsigned)w[2], (unsigned)w[3]}; }
        if (drain) asm volatile("s_waitcnt vmcnt(0)" ::: "memory");
#pragma unroll
        for (int ai = 0; ai < 2; ++ai)
#pragma unroll
            for (int m = 0; m < 4; ++m) *(GAS u32x4*)(O + (size_t)(row0 + ai * HALF + m * 16) * ldc + u.ocol0 + wc * 64 + fq * 16) = o[ai][m];
    }
};
struct EpiSwiglu {
    static constexpr bool PERM = true; static constexpr int SCW = 0x7A7A7A7A; typedef NoPre Pre;
    __device__ __forceinline__ Pre prefetch(const Unit&, LAS unsigned char*, int, int, int) const { return Pre{}; }
    unsigned char* ACT;
    __device__ __forceinline__ void operator()(const f32x4 (&acc)[2][2][4][2], const Unit& u, int wr, int wc, int fr, int fq, const Pre&, bool drain) const {
        const int row0 = u.orow0 + wr * 64 + fr, pn = u.ocol0 >> 8;
        u32x2 o[2][4];
#pragma unroll
        for (int ai = 0; ai < 2; ++ai)
#pragma unroll
            for (int m = 0; m < 4; ++m) {
                int w[2];
#pragma unroll
                for (int n = 0; n < 2; ++n) { const f32x4 g = acc[ai][0][m][n], up = acc[ai][1][m][n];
                    f32x4 e;
#pragma unroll
                    for (int i = 0; i < 4; ++i) e[i] = __builtin_amdgcn_exp2f(-g[i]);
                    const f32x4 d = e + 1.0f; f32x4 r;
#pragma unroll
                    for (int i = 0; i < 4; ++i) r[i] = __builtin_amdgcn_rcpf(d[i]);
                    const f32x4 h = (g * up) * r;
                    int v = 0; v = __builtin_amdgcn_cvt_pk_fp8_f32(h[0], h[1], v, false); v = __builtin_amdgcn_cvt_pk_fp8_f32(h[2], h[3], v, true); w[n] = v; }
                o[ai][m] = (u32x2){(unsigned)w[0], (unsigned)w[1]}; }
        if (drain) asm volatile("s_waitcnt vmcnt(0)" ::: "memory");
#pragma unroll
        for (int ai = 0; ai < 2; ++ai)
#pragma unroll
            for (int m = 0; m < 4; ++m) *(GAS u32x2*)(ACT + (size_t)(row0 + ai * HALF + m * 16) * EH + pn * 128 + wc * 32 + 8 * fq) = o[ai][m];
    }
};
constexpr float Y2_SCALE = 8.0f, Y2_INV = 1.0f / 8.0f;
struct EpiScatter {
    static constexpr bool PERM = true; static constexpr int SCW = 0x7D7D7D7D;
    struct Pre { const LAS int* tab; };
    unsigned char* Y2; const int* rowdst;
    __device__ __forceinline__ Pre prefetch(const Unit& u, LAS unsigned char* lds, int wid, int lane, int ui) const {
        LAS unsigned char* tab = lds + STAGE_BYTES + (ui & 1) * 1024;
        if (wid < 4) __builtin_amdgcn_global_load_lds((const unsigned*)(rowdst + u.orow0 + wid * 64 + lane), (LAS unsigned*)(tab + wid * 256), 4, 0, 0);
        Pre p; p.tab = (const LAS int*)tab; return p; }
    __device__ __forceinline__ void operator()(const f32x4 (&acc)[2][2][4][2], const Unit& u, int wr, int wc, int fr, int fq, const Pre& pre, bool drain) const {
        if (u.aux == 128) {
            u32x4 o[2][4];
#pragma unroll
            for (int ai = 0; ai < 2; ++ai)
#pragma unroll
                for (int m = 0; m < 4; ++m) { int w[4];
#pragma unroll
                    for (int bj = 0; bj < 2; ++bj) { const f32x4 v0 = acc[ai][bj][m][0], v1 = acc[ai][bj][m][1];
                        int w0 = 0, w1 = 0;
                        w0 = __builtin_amdgcn_cvt_pk_fp8_f32(v0[0], v0[1], w0, false); w0 = __builtin_amdgcn_cvt_pk_fp8_f32(v0[2], v0[3], w0, true);
                        w1 = __builtin_amdgcn_cvt_pk_fp8_f32(v1[0], v1[1], w1, false); w1 = __builtin_amdgcn_cvt_pk_fp8_f32(v1[2], v1[3], w1, true);
                        w[2 * bj] = w0; w[2 * bj + 1] = w1; }
                    o[ai][m] = (u32x4){(unsigned)w[0], (unsigned)w[1], (unsigned)w[2], (unsigned)w[3]}; }
            if (drain) asm volatile("s_waitcnt vmcnt(0)" ::: "memory");
#pragma unroll
            for (int ai = 0; ai < 2; ++ai)
#pragma unroll
                for (int m = 0; m < 4; ++m) { const int dst = pre.tab[wr * 64 + fr + ai * HALF + m * 16];
                    if (dst >= 0) *(GAS u32x4*)(Y2 + (size_t)dst * 512 + u.ocol0 + wc * 64 + fq * 16) = o[ai][m]; }
        } else {
            u32x2 o[2][4];
#pragma unroll
            for (int ai = 0; ai < 2; ++ai)
#pragma unroll
                for (int m = 0; m < 4; ++m) { unsigned w[2];
#pragma unroll
                    for (int bj = 0; bj < 2; ++bj) { const f32x4 v0 = acc[ai][bj][m][0], v1 = acc[ai][bj][m][1];
                        unsigned x = 0u;
                        x = __builtin_amdgcn_cvt_scalef32_pk_fp4_f32(x, v0[0], v0[1], 1.0f, 0); x = __builtin_amdgcn_cvt_scalef32_pk_fp4_f32(x, v0[2], v0[3], 1.0f, 1);
                        x = __builtin_amdgcn_cvt_scalef32_pk_fp4_f32(x, v1[0], v1[1], 1.0f, 2); x = __builtin_amdgcn_cvt_scalef32_pk_fp4_f32(x, v1[2], v1[3], 1.0f, 3);
                        w[bj] = x; }
                    o[ai][m] = (u32x2){w[0], w[1]}; }
            if (drain) asm volatile("s_waitcnt vmcnt(0)" ::: "memory");
#pragma unroll
            for (int ai = 0; ai < 2; ++ai)
#pragma unroll
                for (int m = 0; m < 4; ++m) { const int dst = pre.tab[wr * 64 + fr + ai * HALF + m * 16];
                    if (dst >= 0) *(GAS u32x2*)(Y2 + (size_t)dst * 512 + (u.ocol0 >> 1) + wc * 32 + fq * 8) = o[ai][m]; }
        }
    }
};

typedef int v8i __attribute__((ext_vector_type(8)));
typedef int v4i __attribute__((ext_vector_type(4)));
struct Frag { bf16x8 p[2]; __device__ __forceinline__ bf16x8& operator[](int k) { return p[k]; } __device__ __forceinline__ const bf16x8& operator[](int k) const { return p[k]; } };
template <class Epi, class Sched, bool GATHER, bool F8 = false, bool ALIGN_EPI = true, bool SP2 = true, bool NHALF = false>
__device__ __forceinline__ void gemm_phase(const int tid_in, LAS unsigned char* lds, const void* Ag, const void* Bg, const int K, const int* rowidx, const Sched& S, const Epi& E) {
    int tid_ = tid_in; asm volatile("" : "+v"(tid_));
    const int tid = tid_, wid = __builtin_amdgcn_readfirstlane(tid >> 6), lane = tid & 63, wr = wid >> 2, wc = wid & 3, fr = lane & 15, fq = lane >> 4;
    const int KB = F8 ? K : 2 * K;
    const int nt = KB / 128;
    unsigned voffB[2];
#pragma unroll
    for (int i = 0; i < 2; ++i) { int R, C; stage_rc(tid * 16 + i * 8192, R, C); const int Rb = Epi::PERM ? ((R & ~31) + perm32(R & 31)) : R;
        voffB[i] = (unsigned)(Rb * KB + C * 2); }
    const size_t kstep = (size_t)128;
    const size_t hstep = (size_t)HALF * KB;
    const unsigned ldsw = (unsigned)wid * 1024u;
    const int aoff = F8 ? lds_byte(wr * 64 + fr, 16 * fq) : lds_byte(wr * 64 + fr, fq * 8), boff = F8 ? lds_byte(wc * 32 + fr, 16 * fq) : lds_byte(wc * 32 + fr, fq * 8);
    constexpr int PIECE1 = F8 ? 16 : 1024;
    const int sc_w = Epi::SCW, sc_a = 0x7F7F7F7F;
#define PG8_SA(b, h) (((b) * 2 + (h)) * HTB)
#define PG8_SB(b, h) ((4 + (b) * 2 + (h)) * HTB)
#define PG8_STAGE_B(bufoff, gbase) do { _Pragma("unroll") for (int _i = 0; _i < 2; ++_i) \
        __builtin_amdgcn_global_load_lds((const unsigned*)((const char*)(gbase) + voffB[_i]), (LAS unsigned*)(lds + (bufoff) + ldsw + _i * 8192), 16, 0, 0); } while (0)
#define PG8_STAGE_A(bufoff, gbase, h) do { const char* _gb = (const char*)(gbase) + (GATHER ? (size_t)0 : (size_t)(h) * hstep); \
        __builtin_amdgcn_global_load_lds((const unsigned*)(_gb + ac[GATHER ? (h) : 0][0]), (LAS unsigned*)(lds + (bufoff) + ldsw), 16, 0, 0); \
        __builtin_amdgcn_global_load_lds((const unsigned*)(_gb + ac[GATHER ? (h) : 0][1]), (LAS unsigned*)(lds + (bufoff) + ldsw + 8192), 16, 0, 0); } while (0)
#define PG8_LDA(dst, b, h) do { _Pragma("unroll") for (int m = 0; m < 4; ++m) { if constexpr (F8) { const v4i _l = *(const LAS v4i*)(lds + PG8_SA(b, h) + aoff + m * 2048), _h = *(const LAS v4i*)(lds + PG8_SA(b, h) + aoff + m * 2048 + PIECE1); dst##8[m] = __builtin_shufflevector(_l, _h, 0, 1, 2, 3, 4, 5, 6, 7); } \
        else { dst[m][0] = *(const LAS bf16x8*)(lds + PG8_SA(b, h) + aoff + m * 2048); dst[m][1] = *(const LAS bf16x8*)(lds + PG8_SA(b, h) + aoff + m * 2048 + PIECE1); } } } while (0)
#define PG8_LDB(dst, b, h) do { _Pragma("unroll") for (int n = 0; n < 2; ++n) { if constexpr (F8) { const v4i _l = *(const LAS v4i*)(lds + PG8_SB(b, h) + boff + n * 2048), _h = *(const LAS v4i*)(lds + PG8_SB(b, h) + boff + n * 2048 + PIECE1); dst##8[n] = __builtin_shufflevector(_l, _h, 0, 1, 2, 3, 4, 5, 6, 7); } \
        else { dst[n][0] = *(const LAS bf16x8*)(lds + PG8_SB(b, h) + boff + n * 2048); dst[n][1] = *(const LAS bf16x8*)(lds + PG8_SB(b, h) + boff + n * 2048 + PIECE1); } } } while (0)
#define PG8_MMA(ai, bj, At, Bt) do { __builtin_amdgcn_s_setprio(1); _Pragma("unroll") for (int m = 0; m < 4; ++m) _Pragma("unroll") for (int n = 0; n < 2; ++n) { \
        if constexpr (F8) asm volatile("v_mfma_scale_f32_16x16x128_f8f6f4 %0, %1, %2, %0, %3, %4 op_sel_hi:[0,0,0]" : "+v"(acc[ai][bj][m][n]) : "v"(Bt##8[n]), "v"(At##8[m]), "v"(sc_w), "v"(sc_a)); \
        else { _Pragma("unroll") for (int k = 0; k < 2; ++k) acc[ai][bj][m][n] = __builtin_amdgcn_mfma_f32_16x16x32_bf16(Bt[n][k], At[m][k], acc[ai][bj][m][n], 0, 0, 0); } } \
        __builtin_amdgcn_s_setprio(0); } while (0)
#define PG8_WAIT_V(n) asm volatile("s_waitcnt vmcnt(" #n ")" ::: "memory")
#define PG8_WAIT_LOOP do { if constexpr (NHALF) PG8_WAIT_V(6); else PG8_WAIT_V(8); } while (0)
#define PG8_WAIT_L(n) asm volatile("s_waitcnt lgkmcnt(" #n ")" ::: "memory")
#define PG8_BAR __builtin_amdgcn_s_barrier()
#define PG8_SCHED __builtin_amdgcn_sched_barrier(0)
#define PG8_TAB(par) (lds + STAGE_BYTES + 2048 + (par) * 1024)
#define PG8_TABLOAD(par, row0) do { if (wid < 4) __builtin_amdgcn_global_load_lds((const unsigned*)(rowidx + (row0) + wid * 64 + lane), (LAS unsigned*)(PG8_TAB(par) + wid * 256), 4, 0, 0); } while (0)
#define PG8_AOFF_H(h, par) do { int _tz = tid; asm volatile("" : "+v"(_tz)); _Pragma("unroll") for (int _i = 0; _i < 2; ++_i) { int _R, _C; stage_rc(_tz * 16 + _i * 8192, _R, _C); \
        if (GATHER) ac[h][_i] = ((const LAS unsigned*)PG8_TAB(par))[(h) * HALF + _R] * (unsigned)KB + (unsigned)_C * 2u; \
        else ac[h][_i] = (unsigned)(((h) * HALF + _R) * KB) + (unsigned)_C * 2u; } } while (0)
    static_assert(SP2, "only the two-super-phase K-loop is kept");
    Unit cur, nxt; int ui = 0;
    if (!S.next(0, cur)) return;
    f32x4 acc[2][2][4][2];
#pragma unroll
    for (int a = 0; a < 2; ++a)
#pragma unroll
        for (int b = 0; b < 2; ++b)
#pragma unroll
            for (int m = 0; m < 4; ++m)
#pragma unroll
                for (int n = 0; n < 2; ++n) acc[a][b][m][n] = (f32x4){0.f, 0.f, 0.f, 0.f};
    bf16x8 At[F8 ? 1 : 4][2], B0[F8 ? 1 : 2][2], B1[F8 ? 1 : 2][2];
    v8i At8[F8 ? 4 : 1], B08[F8 ? 2 : 1], B18[F8 ? 2 : 1];
    unsigned ac[GATHER ? 2 : 1][2];
    if (GATHER) { PG8_TABLOAD(0, cur.arow0); PG8_WAIT_V(0); PG8_BAR; }
    PG8_AOFF_H(0, 0); if (GATHER) { PG8_AOFF_H((GATHER ? 1 : 0), 0); }
    const char* cA = (const char*)Ag + (GATHER ? (size_t)0 : (size_t)cur.arow0 * KB); const char* cB = (const char*)Bg + (size_t)cur.brow0 * KB;
    PG8_STAGE_B(PG8_SB(0, 0), cB); if constexpr (!NHALF) PG8_STAGE_B(PG8_SB(0, 1), cB + hstep); PG8_STAGE_A(PG8_SA(0, 0), cA, 0); PG8_STAGE_A(PG8_SA(0, 1), cA, 1);
    if (wr == 1) PG8_BAR;
    PG8_WAIT_V(2); PG8_BAR;
    PG8_STAGE_B(PG8_SB(1, 0), cB + kstep); PG8_STAGE_A(PG8_SA(1, 0), cA + kstep, 0); if constexpr (!NHALF) PG8_STAGE_B(PG8_SB(1, 1), cB + hstep + kstep);
    if constexpr (NHALF) PG8_WAIT_V(4); else PG8_WAIT_V(6);
    PG8_BAR;
    for (;;) {
        const typename Epi::Pre pre = E.prefetch(cur, lds, wid, lane, ui);
        const bool has_next = S.next(ui + 1, nxt);
        if (GATHER) { if (has_next) PG8_TABLOAD((ui + 1) & 1, nxt.arow0); }
        const char* nA = has_next ? ((const char*)Ag + (GATHER ? (size_t)0 : (size_t)nxt.arow0 * KB)) : cA; const char* nB = has_next ? (const char*)Bg + (size_t)nxt.brow0 * KB : cB;
_Pragma("nounroll")
        for (int t = 0; t < nt; t += 2) {
            const bool last = (t == nt - 2);
            const bool skipw = (t == 0) && (ui > 0);
            const char* a1 = cA + (size_t)(t + 1) * kstep;
            const char* a2 = last ? nA : cA + (size_t)(t + 2) * kstep; const char* b2 = last ? nB : cB + (size_t)(t + 2) * kstep;
            const char* a3 = a2 + kstep; const char* b3 = b2 + kstep;
            if (GATHER) { if (last && has_next) { PG8_AOFF_H(0, (ui + 1) & 1); } }
            PG8_LDB(B0, 0, 0); if constexpr (!NHALF) PG8_LDB(B1, 0, 1); PG8_SCHED; PG8_LDA(At, 0, 0); PG8_STAGE_A(PG8_SA(1, 1), a1, 1);
            if (!skipw) PG8_WAIT_LOOP; PG8_WAIT_L(0); PG8_BAR; PG8_MMA(0, 0, At, B0); if constexpr (!NHALF) PG8_MMA(0, 1, At, B1); PG8_BAR; PG8_SCHED;
            if (GATHER) { if (last && has_next) { PG8_AOFF_H(1, (ui + 1) & 1); } }
            PG8_LDA(At, 0, 1); PG8_STAGE_B(PG8_SB(0, 0), b2); if constexpr (!NHALF) PG8_STAGE_B(PG8_SB(0, 1), b2 + hstep); PG8_STAGE_A(PG8_SA(0, 0), a2, 0);
            if (!skipw) PG8_WAIT_LOOP; PG8_WAIT_L(0); PG8_BAR; PG8_MMA(1, 0, At, B0); if constexpr (!NHALF) PG8_MMA(1, 1, At, B1); PG8_BAR; PG8_SCHED;
            PG8_LDB(B0, 1, 0); if constexpr (!NHALF) PG8_LDB(B1, 1, 1); PG8_SCHED; PG8_LDA(At, 1, 0); PG8_STAGE_A(PG8_SA(0, 1), a2, 1);
            if (!skipw) PG8_WAIT_LOOP; PG8_WAIT_L(0); PG8_BAR; PG8_MMA(0, 0, At, B0); if constexpr (!NHALF) PG8_MMA(0, 1, At, B1); PG8_BAR; PG8_SCHED;
            PG8_LDA(At, 1, 1); PG8_STAGE_B(PG8_SB(1, 0), b3); if constexpr (!NHALF) PG8_STAGE_B(PG8_SB(1, 1), b3 + hstep); PG8_STAGE_A(PG8_SA(1, 0), a3, 0);
            PG8_WAIT_LOOP; PG8_WAIT_L(0); PG8_BAR; PG8_MMA(1, 0, At, B0); if constexpr (!NHALF) PG8_MMA(1, 1, At, B1); PG8_BAR; PG8_SCHED;
        }
        if constexpr (ALIGN_EPI) { if (wr == 0) PG8_BAR; }
        E(acc, cur, wr, wc, fr, fq, pre, has_next);
        if (!has_next) break;
#pragma unroll
        for (int a = 0; a < 2; ++a)
#pragma unroll
            for (int b = 0; b < 2; ++b)
#pragma unroll
                for (int m = 0; m < 4; ++m)
#pragma unroll
                    for (int n = 0; n < 2; ++n) acc[a][b][m][n] = (f32x4){0.f, 0.f, 0.f, 0.f};
        cur = nxt; cA = nA; cB = nB; ++ui;
        if constexpr (ALIGN_EPI) { if (wr == 1) PG8_BAR; }
    }
    PG8_WAIT_V(0);
    if constexpr (!ALIGN_EPI) { if (wr == 0) PG8_BAR; }
    PG8_BAR;
#undef PG8_SA
#undef PG8_SB
#undef PG8_STAGE_A
#undef PG8_STAGE_B
#undef PG8_LDA
#undef PG8_LDB
#undef PG8_MMA
#undef PG8_WAIT_V
#undef PG8_WAIT_L
#undef PG8_WAIT_LOOP
#undef PG8_BAR
#undef PG8_SCHED
#undef PG8_AOFF_H
#undef PG8_TAB
#undef PG8_TABLOAD
}
}

constexpr int NWAVES = 8, NTHR = 512;
constexpr size_t MiB = 1u << 20;
constexpr size_t WS_CTL = 0, CTL_BYTES = 1 * MiB;
constexpr size_t WS_MOD = 1 * MiB;
constexpr size_t WS_WIN = 3 * MiB;
constexpr size_t WS_WOUT = 29 * MiB;
constexpr size_t WS_WR = 37 * MiB;
constexpr size_t WS_HYF = 39 * MiB;
constexpr size_t WS_HYFC = 71 * MiB;
constexpr size_t WS_XC = 73 * MiB;
constexpr size_t WS_EXP1 = 89 * MiB;
constexpr size_t WS_EXP2 = 218 * MiB;
constexpr size_t WS_XM = 283 * MiB;
constexpr size_t WS_EIDX = 419 * MiB;
constexpr size_t WS_WGT = 422 * MiB;
constexpr size_t WS_RNK = 425 * MiB;
constexpr size_t WS_ROWTOK = 428 * MiB;
constexpr size_t WS_ROWDST = 431 * MiB;
constexpr size_t WS_TILEEXP = 434 * MiB;
constexpr size_t WS_BIG = 435 * MiB;
constexpr size_t WS_U = WS_BIG;
constexpr size_t WS_MIX = 877 * MiB;
constexpr size_t WS_VT = 1013 * MiB;
constexpr size_t WS_HV = 1081 * MiB;
constexpr size_t WS_Z2 = 1183 * MiB;
constexpr size_t WS_GDS = 1217 * MiB;
constexpr size_t WS_GSIN = 1285 * MiB;
constexpr size_t WS_GD = 1319 * MiB;
constexpr size_t WS_Y = 1321 * MiB;
constexpr size_t WS_LOGIT = WS_BIG;
constexpr size_t WS_ACT = WS_BIG;
constexpr size_t WS_Y2 = 758 * MiB;
constexpr size_t WS_XM8 = 1470 * MiB;
constexpr size_t WS_WRB = 1540 * MiB;
constexpr size_t WS_RBIAS = 1558 * MiB;
constexpr size_t WS_XR = 1600 * MiB;
constexpr size_t WS_END = 1736 * MiB;
constexpr int CW_BAR = 4096;
constexpr int CW_CNT = 16384;
constexpr int CW_NTL = 20480;

constexpr int LDS_BYTES = 163840;
constexpr int MISC_OFF = 163584;

struct Frame {
    LAS unsigned char* lds;
    int tid, lane, wave, G, wg;
    const float* const* in;
    float* out; unsigned char* ws; unsigned* ctl;
};
enum { I_X = 0, I_C, I_CTX, I_CCTX, I_WMOD, I_BMOD, I_WIN, I_RPB, I_WA2, I_BA2, I_GNORM, I_HSW, I_HSB, I_HW1, I_HB1, I_HF1, I_HW2, I_HB2, I_HF2, I_HW3, I_HB3, I_HDEC, I_HSKIP,
       I_WOUT, I_LN1G, I_LN1B, I_RW, I_RB, I_WEG, I_WEU, I_WED, I_WSG, I_WSU, I_WSD, I_LN2G, I_LN2B };

__device__ __forceinline__ int row_b(int row) { return row < NLAT ? (row >> 12) : 16; }
__device__ __forceinline__ const float* mod_ptr(const Frame& F, int l, int row) { return (const float*)(F.ws + WS_MOD) + ((size_t)l * 17 + row_b(row)) * 6144; }

constexpr float NA_QSCALE = 0.125f * 1.4426950408889634f, NA_CLAMP = 60.0f * 1.4426950408889634f;
template <class RowFn>
__device__ __forceinline__ void tr_item(const float* W, int ldw, int k0, int n0, bf16_t* dst, int ldd, RowFn rf, LAS float* scr, int lane, float scale = 1.0f) {
    float tv[32];
    const GAS float* wp = (const GAS float*)(W + (size_t)(k0 + (lane >> 5)) * ldw + n0 + (lane & 31));
#pragma unroll
    for (int i = 0; i < 32; ++i) tv[i] = __builtin_nontemporal_load(wp + (size_t)(2 * i) * ldw);
#pragma unroll
    for (int i = 0; i < 32; ++i) scr[(2 * i + (lane >> 5)) * 33 + (lane & 31)] = tv[i];
    LDS_WAIT(); asm volatile("" ::: "memory");
    const int c = lane & 7;
#pragma unroll
    for (int j = 0; j < 4; ++j) { const int n = (lane >> 3) + 8 * j; const LAS float* s = scr + (8 * c) * 33 + n;
        u32x4 o; o.x = pk2(s[0 * 33] * scale, s[1 * 33] * scale); o.y = pk2(s[2 * 33] * scale, s[3 * 33] * scale); o.z = pk2(s[4 * 33] * scale, s[5 * 33] * scale); o.w = pk2(s[6 * 33] * scale, s[7 * 33] * scale);
        *(GAS u32x4*)(dst + (size_t)rf(n0 + n) * ldd + k0 + 8 * c) = o; }
    LDS_WAIT(); asm volatile("" ::: "memory");
}
template <class RowFn>
__device__ __forceinline__ void tr_item_ks(const float* W, int ldw, int k0, int n0, bf16_t* dst, int ldd, RowFn rf, LAS float* scr, int lane, const float* ksc) {
    float tv[32];
    const GAS float* wp = (const GAS float*)(W + (size_t)(k0 + (lane >> 5)) * ldw + n0 + (lane & 31));
#pragma unroll
    for (int i = 0; i < 32; ++i) tv[i] = wp[(size_t)(2 * i) * ldw];
#pragma unroll
    for (int i = 0; i < 32; ++i) scr[(2 * i + (lane >> 5)) * 33 + (lane & 31)] = tv[i] * (1.0f + ksc[2 * i + (lane >> 5)]);
    LDS_WAIT(); asm volatile("" ::: "memory");
    const int c = lane & 7;
#pragma unroll
    for (int j = 0; j < 4; ++j) { const int n = (lane >> 3) + 8 * j; const LAS float* s = scr + (8 * c) * 33 + n;
        u32x4 o; o.x = pk2(s[0 * 33], s[1 * 33]); o.y = pk2(s[2 * 33], s[3 * 33]); o.z = pk2(s[4 * 33], s[5 * 33]); o.w = pk2(s[6 * 33], s[7 * 33]);
        *(GAS u32x4*)(dst + (size_t)rf(n0 + n) * ldd + k0 + 8 * c) = o; }
    LDS_WAIT(); asm volatile("" ::: "memory");
}
template <class RowFn>
__device__ __forceinline__ void tr_item8(const float* W, int ldw, int k0, int n0, unsigned char* dst, int ldd, RowFn rf, float scale, LAS float* scr, int lane) {
    float tv[32];
    const GAS float* wp = (const GAS float*)(W + (size_t)(k0 + (lane >> 5)) * ldw + n0 + (lane & 31));
#pragma unroll
    for (int i = 0; i < 32; ++i) tv[i] = __builtin_nontemporal_load(wp + (size_t)(2 * i) * ldw);
#pragma unroll
    for (int i = 0; i < 32; ++i) scr[(2 * i + (lane >> 5)) * 33 + (lane & 31)] = tv[i];
    LDS_WAIT(); asm volatile("" ::: "memory");
    const int n = lane >> 1, hf = lane & 1; const LAS float* s = scr + (32 * hf) * 33 + n;
    unsigned w[8];
#pragma unroll
    for (int j = 0; j < 8; ++j) { int v = 0; v = __builtin_amdgcn_cvt_pk_fp8_f32(s[(4 * j) * 33] * scale, s[(4 * j + 1) * 33] * scale, v, false); v = __builtin_amdgcn_cvt_pk_fp8_f32(s[(4 * j + 2) * 33] * scale, s[(4 * j + 3) * 33] * scale, v, true); w[j] = (unsigned)v; }
    unsigned char* d = dst + (size_t)rf(n0 + n) * ldd + k0 + 32 * hf;
    *(GAS u32x4*)d = (u32x4){w[0], w[1], w[2], w[3]}; *(GAS u32x4*)(d + 16) = (u32x4){w[4], w[5], w[6], w[7]};
    LDS_WAIT(); asm volatile("" ::: "memory");
}
struct RowId { __device__ __forceinline__ int operator()(int n) const { return n; } };
struct RowWin { __device__ __forceinline__ int operator()(int n) const { return n >= 2336 ? n - 32 : n; } };
struct RowGU { int up; __device__ __forceinline__ int operator()(int j) const { return (j >> 7) * 256 + up * 128 + (j & 127); } };

__device__ __forceinline__ void p0_static_weights(Frame& F) {
    LAS float* scr = (LAS float*)(F.lds + F.wave * 16384);
    const int gw = F.wg * NWAVES + F.wave, NGW = F.G * NWAVES;
    constexpr int I_IN = 16 * 97, I_OUT = 16 * 32, I_R = 16 * 4, PER_L = I_IN + I_OUT + I_R;
    for (int it = gw; it < DEPTH * PER_L; it += NGW) {
        const int l = it / PER_L; int r = it % PER_L;
        if (r < I_IN) { const int kb = r / 97, nb = r % 97; if (nb == 72) continue;
            tr_item(F.in[I_WIN] + (size_t)l * DM * DIN_REF, DIN_REF, kb * 64, nb * 32, (bf16_t*)(F.ws + WS_WIN) + (size_t)l * DIN * DM, DM, RowWin{}, scr, F.lane, nb < 16 ? NA_QSCALE : 1.0f); continue; }
        r -= I_IN;
        if (r < I_OUT) { const int kb = r / 32, nb = r % 32;
            tr_item(F.in[I_WOUT] + (size_t)l * DM * DM, DM, kb * 64, nb * 32, (bf16_t*)(F.ws + WS_WOUT) + (size_t)l * DM * DM, DM, RowId{}, scr, F.lane); continue; }
        r -= I_OUT;
        { const int kb = r / 4, nb = r % 4;
            tr_item(F.in[I_RW] + (size_t)l * DM * NEXP, NEXP, kb * 64, nb * 32, (bf16_t*)(F.ws + WS_WR) + (size_t)l * 256 * DM, DM, RowId{}, scr, F.lane); }
    }
    const int gt = F.wg * NTHR + F.tid, NGT = F.G * NTHR;
    for (int i = gt; i < DEPTH * 128 * DM / 8; i += NGT) { const int l = i / (128 * DM / 8), r = i % (128 * DM / 8);
        *(u32x4*)((bf16_t*)(F.ws + WS_WR) + ((size_t)l * 256 + 128) * DM + (size_t)r * 8) = (u32x4){0u, 0u, 0u, 0u}; }
    for (int i = gt; i < DEPTH * 256 * DM; i += NGT) {
        const int k = i % DM, n = (i / DM) % 256, l = i / (DM * 256), dir = n >> 7, j = n & 127;
        const float* wi = F.in[I_WIN] + ((size_t)l * DM + k) * DIN_REF + 2304 + dir * 16;
        const float* wa = F.in[I_WA2] + ((size_t)(l * 2 + dir) * 16) * 128 + j;
        float s = 0.f;
#pragma unroll
        for (int r = 0; r < 16; ++r) s += wi[r] * wa[r * 128];
        ((bf16_t*)(F.ws + WS_WIN))[((size_t)l * DIN + 3072 + n) * DM + k] = (bf16_t)f2bf(s);
    }
}
__device__ __forceinline__ void p0_mod(Frame& F) {
    LAS float* sc = (LAS float*)F.lds;
    LAS float* red = (LAS float*)(F.lds + 17 * 1024 * 4);
    for (int i = F.tid; i < 17 * 1024; i += NTHR) { const int r = i >> 10, k = i & 1023; const float v = r < 16 ? F.in[I_C][r * 1024 + k] : F.in[I_CCTX][k]; sc[i] = silu_f(v); }
    __syncthreads();
    const int kq = F.tid >> 7, cl = F.tid & 127;
    for (int u = F.wg; u < DEPTH * 48; u += F.G) {
        const int l = u / 48, col = (u % 48) * 128 + cl;
        const float* w = F.in[I_WMOD] + (size_t)l * DM * 6144 + col;
        float a[17];
#pragma unroll
        for (int r = 0; r < 17; ++r) a[r] = 0.f;
        for (int k0 = kq * 256; k0 < kq * 256 + 256; k0 += 16) {
            float wv[16];
#pragma unroll
            for (int q = 0; q < 16; ++q) wv[q] = *(const GAS float*)(w + (size_t)(k0 + q) * 6144);
#pragma unroll
            for (int q = 0; q < 16; ++q)
#pragma unroll
                for (int r = 0; r < 17; ++r) a[r] += sc[r * 1024 + k0 + q] * wv[q]; }
#pragma unroll
        for (int r = 0; r < 17; ++r) red[(kq * 17 + r) * 128 + cl] = a[r];
        __syncthreads();
        for (int i = F.tid; i < 17 * 128; i += NTHR) { const int r = i >> 7, c2 = i & 127, cc = (u % 48) * 128 + c2;
            const float s = red[(0 * 17 + r) * 128 + c2] + red[(1 * 17 + r) * 128 + c2] + red[(2 * 17 + r) * 128 + c2] + red[(3 * 17 + r) * 128 + c2] + F.in[I_BMOD][l * 6144 + cc];
            ((float*)(F.ws + WS_MOD))[((size_t)l * 17 + r) * 6144 + cc] = s; }
        __syncthreads();
    }
}
__device__ __forceinline__ void p0_hyena_filters(Frame& F) {
    LAS float* z = (LAS float*)F.lds;
    LAS float* h1 = z + 1092;
    LAS float* h2 = h1 + 33 * 64;
    LAS float* tt = h2 + 33 * 64;
    LAS float* W1 = tt + 64;
    LAS float* W2 = W1 + 33 * 64;
    constexpr int UL = 4096 / 32, UC = 256 / 32, UPL = UL + UC;
    for (int u = F.wg; u < DEPTH * UPL; u += F.G) {
        const int l = u / UPL, r = u % UPL; const bool lat = r < UL; const int L = lat ? 4096 : 256, n0 = (lat ? r : r - UL) * 32;
        __syncthreads();
        for (int i = F.tid; i < 33 * 64; i += NTHR) W1[i] = F.in[I_HW1][(size_t)l * 33 * 64 + i];
        for (int i = F.tid; i < 64 * 64; i += NTHR) W2[i] = F.in[I_HW2][(size_t)l * 64 * 64 + i];
        for (int i = F.tid; i < 33 * 33; i += NTHR) { const int p = i / 33, e = i % 33, n = n0 + p;
            const float t = (float)n / (float)(L - 1);
            float v;
            if (e == 0) v = t;
            else { const int kb = (e - 1) & 15; const float band = 1e-4f + (float)kb * ((15.0f - 1e-4f) / 15.0f);
                   const float w = 6.283185307179586f * (float)n / (float)L; const float ang = w * band;
                   v = e <= 16 ? __cosf(ang) : -__sinf(ang); }
            z[i] = v; if (e == 0) tt[p] = t; }
        __syncthreads();
        for (int i = F.tid; i < 33 * 64; i += NTHR) { const int p = i >> 6, j = i & 63; float s = F.in[I_HB1][l * 64 + j];
#pragma unroll 11
            for (int e = 0; e < 33; ++e) s += z[p * 33 + e] * W1[e * 64 + j];
            h1[i] = __sinf(F.in[I_HF1][l * 64 + j] * s); }
        __syncthreads();
        for (int i = F.tid; i < 33 * 64; i += NTHR) { const int p = i >> 6, j = i & 63; float s = F.in[I_HB2][l * 64 + j];
#pragma unroll 16
            for (int e = 0; e < 64; ++e) s += h1[p * 64 + e] * W2[e * 64 + j];
            h2[i] = __sinf(F.in[I_HF2][l * 64 + j] * s); }
        __syncthreads();
        {
            const int g = F.tid >> 8, col0 = 4 * (F.tid & 255), o = col0 >> 9, dir = (col0 >> 8) & 1, ch0 = col0 & 255;
            const int pb = (dir ? 0 : 1) + 16 * g;
            float a[4][16];
#pragma unroll
            for (int j = 0; j < 4; ++j)
#pragma unroll
                for (int q = 0; q < 16; ++q) a[j][q] = 0.f;
            const float* w3 = F.in[I_HW3] + (size_t)l * 64 * 1024 + col0;
            const LAS float* hp = h2 + pb * 64;
            f32x4 wa[4], wb[4];
#pragma unroll
            for (int q = 0; q < 4; ++q) wa[q] = *(const GAS f32x4*)(w3 + (size_t)q * 1024);
#define HF_BLOCK(wv_, k0_) do { _Pragma("unroll") for (int pi = 0; pi < 16; ++pi) { const f32x4 hv = *(const LAS f32x4*)(hp + pi * 64 + (k0_)); \
                _Pragma("unroll") for (int q = 0; q < 4; ++q) _Pragma("unroll") for (int j = 0; j < 4; ++j) a[j][pi] += hv[q] * wv_[q][j]; } } while (0)
#pragma unroll 1
            for (int k0 = 0; k0 < 64; k0 += 8) {
#pragma unroll
                for (int q = 0; q < 4; ++q) wb[q] = *(const GAS f32x4*)(w3 + (size_t)(k0 + 4 + q) * 1024);
                __builtin_amdgcn_sched_barrier(0);
                HF_BLOCK(wa, k0);
                __builtin_amdgcn_sched_barrier(0);
                { const int kn = k0 + 8 < 64 ? k0 + 8 : k0;
#pragma unroll
                  for (int q = 0; q < 4; ++q) wa[q] = *(const GAS f32x4*)(w3 + (size_t)(kn + q) * 1024); }
                __builtin_amdgcn_sched_barrier(0);
                HF_BLOCK(wb, k0 + 4);
                __builtin_amdgcn_sched_barrier(0);
            }
#undef HF_BLOCK
            const f32x4 b3 = *(const GAS f32x4*)(F.in[I_HB3] + l * 1024 + col0), dc = *(const GAS f32x4*)(F.in[I_HDEC] + ((size_t)(l * 2 + o) * 2 + dir) * 256 + ch0);
            float a0[4] = {0.f, 0.f, 0.f, 0.f};
            if (n0 == 0 && dir == 0 && g == 0) {
                for (int k = 0; k < 64; ++k) { const f32x4 wv = *(const GAS f32x4*)(w3 + (size_t)k * 1024); const float hv = h2[k];
#pragma unroll
                    for (int j = 0; j < 4; ++j) a0[j] += hv * wv[j]; } }
#pragma unroll
            for (int j = 0; j < 4; ++j) {
                const float dec = fabsf(dc[j]);
                bf16_t* R = lat ? (bf16_t*)(F.ws + WS_HYF) + ((size_t)(l * 2 + o) * 256 + ch0 + j) * 8192 : (bf16_t*)(F.ws + WS_HYFC) + ((size_t)(l * 2 + o) * 256 + ch0 + j) * 512;
                float v[16];
#pragma unroll
                for (int pi = 0; pi < 16; ++pi) v[pi] = (a[j][pi] + b3[j]) * __expf(-tt[pb + pi] * dec);
                unsigned w[8];
                if (dir == 0) {
                    if (n0 + 32 == L && g == 1) v[15] = 0.f;
#pragma unroll
                    for (int q = 0; q < 8; ++q) w[q] = pk2(v[15 - 2 * q], v[14 - 2 * q]);
                    GAS u32x4* dst = (GAS u32x4*)(R + (L - n0 - 32) + 16 * (1 - g));
                    dst[0] = (u32x4){w[0], w[1], w[2], w[3]}; dst[1] = (u32x4){w[4], w[5], w[6], w[7]};
                    if (n0 == 0 && g == 0) R[L] = (bf16_t)f2bf((a0[j] + b3[j]) * __expf(-tt[0] * dec) + F.in[I_HSKIP][(l * 2 + o) * 256 + ch0 + j]);
                } else if (n0 > 0 || g == 1) {
#pragma unroll
                    for (int q = 0; q < 8; ++q) w[q] = pk2(v[2 * q], v[2 * q + 1]);
                    GAS u32x4* dst = (GAS u32x4*)(R + (L + n0) + 16 * g);
                    dst[0] = (u32x4){w[0], w[1], w[2], w[3]}; dst[1] = (u32x4){w[4], w[5], w[6], w[7]};
                } else {
#pragma unroll
                    for (int pi = 1; pi < 16; ++pi) R[L + pi] = (bf16_t)f2bf(v[pi]);
                }
            }
        }
    }
    __syncthreads();
}
__device__ __forceinline__ void p0_init_rows(Frame& F) {
    const int gw = F.wg * NWAVES + F.wave, NGW = F.G * NWAVES;
    for (int row = gw; row < NROW; row += NGW) {
        const float* src = row < NLAT ? F.in[I_X] + (size_t)row * DM : F.in[I_CTX] + (size_t)(row - NLAT) * DM;
        const float* md = mod_ptr(F, 0, row);
        bf16_t* xm = (bf16_t*)(F.ws + WS_XM) + (size_t)row * DM;
#pragma unroll
        for (int j = 0; j < 4; ++j) { const int c = 4 * F.lane + 256 * j;
            const f32x4 v = __builtin_nontemporal_load((const GAS f32x4*)(src + c)), sh = *(const GAS f32x4*)(md + c), sc = *(const GAS f32x4*)(md + 1024 + c);
            u32x2 w; w.x = pk2(v[0] * (1.f + sc[0]) + sh[0], v[1] * (1.f + sc[1]) + sh[1]); w.y = pk2(v[2] * (1.f + sc[2]) + sh[2], v[3] * (1.f + sc[3]) + sh[3]);
            *(GAS u32x2*)(xm + c) = w; }
    }
}
__device__ __forceinline__ void p1_router_weights(Frame& F) {
    LAS float* scr = (LAS float*)(F.lds + F.wave * 16384);
    const int gw = F.wg * NWAVES + F.wave, NGW = F.G * NWAVES;
    const float* MOD = (const float*)(F.ws + WS_MOD);
    for (int it = gw; it < DEPTH * 17 * 64; it += NGW) {
        const int lb = it >> 6, l = lb / 17, kb = (it & 63) >> 2, nb = it & 3;
        tr_item_ks(F.in[I_RW] + (size_t)l * DM * NEXP, NEXP, kb * 64, nb * 32, (bf16_t*)(F.ws + WS_WRB) + (size_t)lb * 128 * DM, DM, RowId{}, scr, F.lane, MOD + (size_t)lb * 6144 + 4096 + kb * 64); }
    for (int it = gw; it < DEPTH * 17 * 8; it += NGW) {
        const int lb = it >> 3, l = lb / 17, n = (it & 7) * 16 + (F.lane & 15), kq = F.lane >> 4;
        const float* sh = MOD + (size_t)lb * 6144 + 3072 + kq * 256; const float* w = F.in[I_RW] + (size_t)l * DM * NEXP + (size_t)(kq * 256) * NEXP + n;
        float a = 0.f;
#pragma unroll 8
        for (int k = 0; k < 256; ++k) a += sh[k] * w[(size_t)k * NEXP];
        a += shx(a, 16, F.lane); a += shx(a, 32, F.lane);
        if (kq == 0) ((float*)(F.ws + WS_RBIAS))[(size_t)lb * 128 + n] = a; }
}
constexpr float WEXP_SCALE = 32.0f;
__device__ __forceinline__ void p_expert_weights(Frame& F, int l) {
    LAS float* scr = (LAS float*)(F.lds + F.wave * 16384);
    const int gw = F.wg * NWAVES + F.wave, NGW = F.G * NWAVES;
    constexpr int I1 = 16 * 8, I2 = 4 * 32, PER_E = 2 * I1 + I2;
    for (int it = gw; it < NE1 * PER_E; it += NGW) {
        const int e = it / PER_E; int r = it % PER_E;
        unsigned char* d1 = (unsigned char*)(F.ws + WS_EXP1) + (size_t)e * 512 * DM; unsigned char* d2 = (unsigned char*)(F.ws + WS_EXP2) + (size_t)e * DM * EH;
        if (r < 2 * I1) { const int up = r >= I1; if (up) r -= I1; const int kb = r / 8, nb = r % 8;
            const float* src = e < NEXP ? F.in[up ? I_WEU : I_WEG] + ((size_t)l * NEXP + e) * DM * EH : F.in[up ? I_WSU : I_WSG] + (size_t)l * DM * EH;
            tr_item8(src, EH, kb * 64, nb * 32, d1, DM, RowGU{up}, up ? WEXP_SCALE * 0.6931471805599453f : WEXP_SCALE * 1.4426950408889634f, scr, F.lane); }
        else { r -= 2 * I1; const int kb = r / 32, nb = r % 32;
            const float* src = e < NEXP ? F.in[I_WED] + ((size_t)l * NEXP + e) * EH * DM : F.in[I_WSD] + (size_t)l * EH * DM;
            tr_item8(src, DM, kb * 64, nb * 32, d2, EH, RowId{}, WEXP_SCALE, scr, F.lane); }
    }
}

__device__ __forceinline__ f32x4 mfma16(bf16x8 a, bf16x8 b, f32x4 c) { return __builtin_amdgcn_mfma_f32_16x16x32_bf16(a, b, c, 0, 0, 0); }

__device__ __forceinline__ void ph_transposes(Frame& F, int l) {
    LAS bf16_t* tile = (LAS bf16_t*)(F.lds + F.wave * 16384);
    const bf16_t* U = (const bf16_t*)(F.ws + WS_U);
    const int gw = F.wg * NWAVES + F.wave, NGW = F.G * NWAVES;
    const int rsub = F.lane >> 3, cseg = F.lane & 7;
    for (int u = gw; u < 1088 * 20; u += NGW) {
        const int tt = u / 20, blk = u % 20;
        int b, s0, Ls, rowbase, posbase;
        if (tt < 1024) { b = tt >> 6; s0 = (tt & 63) * 64; Ls = SEQ; rowbase = b * SEQ; posbase = 0; }
        else { const int t2 = tt - 1024; b = t2 >> 2; s0 = (t2 & 3) * 64; Ls = CTXL; rowbase = NLAT + b * CTXL; posbase = SEQ; }
        if (blk < 12) {
            constexpr int HT = 80;
            float w0[8], w1[8], w2[8], bb[8];
#pragma unroll
            for (int it = 0; it < 8; ++it) { const int col = blk * 64 + rsub + 8 * it; w0[it] = F.in[I_HSW][(l * 3 + 0) * 768 + col]; w1[it] = F.in[I_HSW][(l * 3 + 1) * 768 + col]; w2[it] = F.in[I_HSW][(l * 3 + 2) * 768 + col]; bb[it] = F.in[I_HSB][l * 768 + col]; }
            const bf16_t* p0 = U + (size_t)(rowbase + s0 + rsub) * DIN + UHY + blk * 64 + cseg * 8;
            u32x4 zc[8];
#pragma unroll
            for (int it = 0; it < 8; ++it) zc[it] = *(const GAS u32x4*)(p0 + (size_t)(8 * it) * DIN);
            u32x4 zh = (u32x4){0u, 0u, 0u, 0u};
            if (F.lane < 16) { const int hs = F.lane < 8 ? s0 - 1 : s0 + 64; if (hs >= 0 && hs < Ls) zh = *(const GAS u32x4*)(U + (size_t)(rowbase + hs) * DIN + UHY + blk * 64 + cseg * 8); }
#pragma unroll
            for (int it = 0; it < 8; ++it) { const unsigned a[4] = {zc[it].x, zc[it].y, zc[it].z, zc[it].w}; LAS bf16_t* d = tile + (cseg * 8) * HT + 8 + rsub + 8 * it;
#pragma unroll
                for (int i = 0; i < 4; ++i) { d[(2 * i) * HT] = (bf16_t)(a[i] & 0xffffu); d[(2 * i + 1) * HT] = (bf16_t)(a[i] >> 16); } }
            if (F.lane < 16) { const unsigned a[4] = {zh.x, zh.y, zh.z, zh.w}; LAS bf16_t* d = tile + (cseg * 8) * HT + (F.lane < 8 ? 7 : 72);
#pragma unroll
                for (int i = 0; i < 4; ++i) { d[(2 * i) * HT] = (bf16_t)(a[i] & 0xffffu); d[(2 * i + 1) * HT] = (bf16_t)(a[i] >> 16); } }
            LDS_WAIT(); asm volatile("" ::: "memory");
#pragma unroll
            for (int it = 0; it < 8; ++it) {
                const int ch = rsub + 8 * it; const LAS bf16_t* r = tile + ch * HT + 8 + cseg * 8;
                const u32x4 v = *(const LAS u32x4*)r; const unsigned hm = r[-1], hp = r[8];
                float x[10]; x[0] = __builtin_bit_cast(float, hm << 16); x[9] = __builtin_bit_cast(float, hp << 16);
                x[1] = bflo(v.x); x[2] = bfhi(v.x); x[3] = bflo(v.y); x[4] = bfhi(v.y); x[5] = bflo(v.z); x[6] = bfhi(v.z); x[7] = bflo(v.w); x[8] = bfhi(v.w);
                unsigned w[4];
#pragma unroll
                for (int i = 0; i < 4; ++i) w[i] = pk2(bb[it] + w0[it] * x[2 * i] + w1[it] * x[2 * i + 1] + w2[it] * x[2 * i + 2], bb[it] + w0[it] * x[2 * i + 1] + w1[it] * x[2 * i + 2] + w2[it] * x[2 * i + 3]);
                *(GAS u32x4*)((bf16_t*)(F.ws + WS_HV) + ((size_t)(blk * 64 + ch) * NB + b) * SPB + posbase + s0 + cseg * 8) = (u32x4){w[0], w[1], w[2], w[3]};
            }
            LDS_WAIT(); asm volatile("" ::: "memory");
            continue;
        } else {
            const int c0 = (blk - 12) * 64 + cseg * 8;
#pragma unroll
            for (int it = 0; it < 8; ++it) {
                const int sl = rsub + 8 * it, s = s0 + sl;
                const u32x4 zc = *(const GAS u32x4*)(U + (size_t)(rowbase + s) * DIN + UV + c0);
                const unsigned ac[4] = {zc.x, zc.y, zc.z, zc.w};
#pragma unroll
                for (int i = 0; i < 4; ++i) { tile[(cseg * 8 + 2 * i) * 72 + sl] = (bf16_t)(ac[i] & 0xffffu); tile[(cseg * 8 + 2 * i + 1) * 72 + sl] = (bf16_t)(ac[i] >> 16); }
            }
        }
        LDS_WAIT(); asm volatile("" ::: "memory");
#pragma unroll 2
        for (int it = 0; it < 8; ++it) {
            const int ch = rsub + 8 * it;
            const u32x4 v = *(const LAS u32x4*)(tile + ch * 72 + cseg * 8);
            bf16_t* dst;
            if (blk < 12) dst = (bf16_t*)(F.ws + WS_HV) + ((size_t)(blk * 64 + ch) * NB + b) * SPB + posbase + s0 + cseg * 8;
            else dst = (bf16_t*)(F.ws + WS_VT) + ((size_t)b * 512 + (blk - 12) * 64 + ch) * SPB + posbase + s0 + cseg * 8;
            *(GAS u32x4*)dst = v;
        }
        LDS_WAIT(); asm volatile("" ::: "memory");
    }
}

constexpr int NA_RPB = 0, NA_KC = 2048, NA_VC = NA_KC + 256 * 144, NA_KR = NA_VC + 64 * 528, NA_END = NA_KR + 9 * 64 * 144;
static_assert(NA_END <= MISC_OFF, "NA LDS map");
__device__ __forceinline__ bf16x8 gld16(const bf16_t* p) { return *(const GAS bf16x8*)p; }
__device__ __forceinline__ u32x2 gld8(const bf16_t* p) { return *(const GAS u32x2*)p; }
__device__ __forceinline__ const char* uni_ptr(const char* p) { const unsigned long long v = (unsigned long long)p; const unsigned lo = __builtin_amdgcn_readfirstlane((unsigned)v), hi = __builtin_amdgcn_readfirstlane((unsigned)(v >> 32)); return (const char*)(((unsigned long long)hi << 32) | lo); }
__device__ __forceinline__ bf16x8 gld16o(const char* ub, unsigned lo) { return *(const GAS bf16x8*)(ub + (size_t)lo); }
__device__ __forceinline__ u32x2 gld8o(const char* ub, unsigned lo) { return *(const GAS u32x2*)(ub + (size_t)lo); }
template <bool WIN>
__device__ __forceinline__ void na_unit(Frame& F, int b, int h, int r, int strip) {
    const bf16_t* U = (const bf16_t*)(F.ws + WS_U);
    const bf16_t* VT = (const bf16_t*)(F.ws + WS_VT) + ((size_t)b * 512 + h * 64) * SPB;
    const LAS float* rpb = (const LAS float*)(F.lds + NA_RPB);
    const LAS bf16_t* KC = (const LAS bf16_t*)(F.lds + NA_KC); const LAS bf16_t* VC = (const LAS bf16_t*)(F.lds + NA_VC);
    int ln_ = F.lane; asm volatile("" : "+v"(ln_));
    const int i = ln_ & 15, g = ln_ >> 4;
    const int qrow0 = WIN ? (b * SEQ + r * 64 + strip * 16) : (NLAT + b * CTXL + strip * 16);
    const int ki = 8 * (i >> 2) + (i & 3);
    const unsigned qlo = (unsigned)((i * DIN + 8 * g) * 2), klo = (unsigned)((ki * DIN + 8 * g) * 2), vlo = (unsigned)((i * SPB + 8 * g) * 2);
    const char* qb = uni_ptr((const char*)(U + (size_t)qrow0 * DIN + UQ + h * 64));
    const bf16x8 q0 = gld16o(qb, qlo), q1 = gld16o(qb + 64, qlo);
    int kr0 = 0, u0 = 0;
    if (WIN) { kr0 = r - 4; kr0 = kr0 < 0 ? 0 : (kr0 > 56 ? 56 : kr0); u0 = strip == 0 ? 0 : (strip == 1 ? 8 : (strip == 2 ? 24 : 32)); }
    const LAS bf16_t* KR = (const LAS bf16_t*)(F.lds + NA_KR);
    const char* vbase = uni_ptr((const char*)(VT + kr0 * 64 + u0));
    f32x4 o[4];
#pragma unroll
    for (int d = 0; d < 4; ++d) o[d] = (f32x4){0.f, 0.f, 0.f, 0.f};
    float lsum = 0.f;
#define NA_SB() __builtin_amdgcn_sched_barrier(0)
#define NA_WLOAD(vb_, cw) do { _Pragma("unroll") for (int d = 0; d < 4; ++d) vb_[d] = gld16o(vbase + ((size_t)(d * 16) * SPB + (cw) * 64) * 2, vlo); } while (0)
#define NA_KRING(kb_, cw) do { const LAS bf16_t* kp = KR + ((((kr0 + (cw)) % 9) * 64 + u0 + ki) * 72 + 8 * g); kb_[0][0] = *(const LAS bf16x8*)kp; kb_[0][1] = *(const LAS bf16x8*)(kp + 32); \
        kb_[1][0] = *(const LAS bf16x8*)(kp + 4 * 72); kb_[1][1] = *(const LAS bf16x8*)(kp + 4 * 72 + 32); } while (0)
#define NA_QK(kb_, s_) do { _Pragma("unroll") for (int t = 0; t < 2; ++t) { f32x4 a = (f32x4){0.f, 0.f, 0.f, 0.f}; a = mfma16(kb_[t][0], q0, a); a = mfma16(kb_[t][1], q1, a); s_[t] = a; } } while (0)
#define NA_PV(s_, vb_) do { u32x4 pw; pw.x = pk2(s_[0][0], s_[0][1]); pw.y = pk2(s_[0][2], s_[0][3]); pw.z = pk2(s_[1][0], s_[1][1]); pw.w = pk2(s_[1][2], s_[1][3]); const bf16x8 pf = __builtin_bit_cast(bf16x8, pw); \
        _Pragma("unroll") for (int d = 0; d < 4; ++d) o[d] = mfma16(vb_[d], pf, o[d]); } while (0)
    bf16x8 vA[4], vB[4], vC[4];
    if (WIN) { NA_WLOAD(vA, 0); NA_WLOAD(vB, 1); NA_WLOAD(vC, 2); NA_SB(); }
#pragma unroll
    for (int cc = 0; cc < 8; ++cc) {
        bf16x8 kc[2][2], vc[4]; f32x4 sc[2];
#pragma unroll
        for (int t = 0; t < 2; ++t) { const LAS bf16_t* kp = KC + (cc * 32 + ki + 4 * t) * 72 + 8 * g; kc[t][0] = *(const LAS bf16x8*)kp; kc[t][1] = *(const LAS bf16x8*)(kp + 32); }
#pragma unroll
        for (int d = 0; d < 4; ++d) vc[d] = *(const LAS bf16x8*)(VC + (d * 16 + i) * 264 + cc * 32 + 8 * g);
        NA_QK(kc, sc);
#pragma unroll
        for (int t = 0; t < 2; ++t)
#pragma unroll
            for (int e = 0; e < 4; ++e) { const float p = __builtin_amdgcn_exp2f(fminf(sc[t][e], NA_CLAMP)); sc[t][e] = p; lsum += p; }
        NA_PV(sc, vc);
    }
    if (WIN) {
        const int c = strip * 16 + i; int kc0 = c - 8; kc0 = kc0 < 0 ? 0 : (kc0 > 48 ? 48 : kc0);
        int dcl[2][4]; bool okm[2][4];
#pragma unroll
        for (int t = 0; t < 2; ++t)
#pragma unroll
            for (int e = 0; e < 4; ++e) { const int kc = u0 + 8 * g + 4 * t + e; okm[t][e] = (kc >= kc0) && (kc < kc0 + 16); int dc = kc - c + 15; dcl[t][e] = okm[t][e] ? (dc < 0 ? 0 : (dc > 30 ? 30 : dc)) : 31; }
#define NA_WCHUNK(vb_, cw) do { bf16x8 kw[2][2]; NA_KRING(kw, cw); f32x4 sw[2]; NA_QK(kw, sw); const LAS float* rp = rpb + (kr0 + (cw) - r + 7) * 32; \
        _Pragma("unroll") for (int t = 0; t < 2; ++t) _Pragma("unroll") for (int e = 0; e < 4; ++e) { const float x = sw[t][e] + rp[dcl[t][e]]; const float p = __builtin_amdgcn_exp2f(fminf(x, NA_CLAMP)); sw[t][e] = p; lsum += p; } \
        NA_PV(sw, vb_); } while (0)
        NA_WCHUNK(vA, 0); NA_SB(); NA_WLOAD(vA, 3); NA_SB();
        NA_WCHUNK(vB, 1); NA_SB(); NA_WLOAD(vB, 4); NA_SB();
        NA_WCHUNK(vC, 2); NA_SB(); NA_WLOAD(vC, 5); NA_SB();
        NA_WCHUNK(vA, 3); NA_SB(); NA_WLOAD(vA, 6); NA_SB();
        NA_WCHUNK(vB, 4); NA_SB(); NA_WLOAD(vB, 7); NA_SB();
        NA_WCHUNK(vC, 5); NA_SB();
        NA_WCHUNK(vA, 6); NA_SB();
        NA_WCHUNK(vB, 7); NA_SB();
#undef NA_WCHUNK
    }
    lsum += shx(lsum, 16, ln_); lsum += shx(lsum, 32, ln_);
    const float inv = 1.0f / lsum;
    char* op = (char*)uni_ptr((const char*)((bf16_t*)(F.ws + WS_MIX) + (size_t)qrow0 * DM + h * 64)); const unsigned olo = (unsigned)((i * DM + 4 * g) * 2);
#pragma unroll
    for (int d = 0; d < 4; ++d) { u32x2 w; w.x = pk2(o[d][0] * inv, o[d][1] * inv); w.y = pk2(o[d][2] * inv, o[d][3] * inv); *(GAS u32x2*)(op + d * 32 + (size_t)olo) = w; }
#undef NA_SB
#undef NA_WLOAD
#undef NA_KRING
#undef NA_QK
#undef NA_PV
}
__device__ __forceinline__ int na_kr0(int r) { const int k = r - 4; return k < 0 ? 0 : (k > 56 ? 56 : k); }
__device__ __forceinline__ void ph_na(Frame& F, int l, bool last) {
    const bf16_t* U = (const bf16_t*)(F.ws + WS_U);
    for (int job = F.wg; job < NB * 8 * 2; job += F.G) {
        const int half = job & 1, h = (job >> 1) & 7, b = job >> 4;
        int tz_; asm volatile("v_mbcnt_lo_u32_b32 %0, -1, 0\n\tv_mbcnt_hi_u32_b32 %0, -1, %0" : "=v"(tz_)); tz_ |= F.wave << 6;
        const bf16_t* krow = U + (size_t)(b * SEQ + (tz_ >> 3)) * DIN + UK + h * 64 + (tz_ & 7) * 8;
        LAS bf16_t* kdst = (LAS bf16_t*)(F.lds + NA_KR) + (tz_ >> 3) * 72 + (tz_ & 7) * 8;
        __syncthreads();
        { LAS float* rpb = (LAS float*)(F.lds + NA_RPB); const float* rsrc = F.in[I_RPB] + ((size_t)l * 8 + h) * 15 * 31;
          if (tz_ < 15 * 32) rpb[tz_] = (tz_ & 31) < 31 ? rsrc[(tz_ >> 5) * 31 + (tz_ & 31)] * 1.4426950408889634f : -1e30f;
          const int key = tz_ >> 1, hf = tz_ & 1; const bf16_t* src = U + (size_t)(NLAT + b * CTXL + key) * DIN + UK + h * 64 + hf * 32; LAS bf16_t* dst = (LAS bf16_t*)(F.lds + NA_KC) + key * 72 + hf * 32;
#pragma unroll
          for (int j = 0; j < 4; ++j) *(LAS bf16x8*)(dst + j * 8) = gld16(src + j * 8);
          const int dv = tz_ >> 3, seg = tz_ & 7; const bf16_t* vs = (const bf16_t*)(F.ws + WS_VT) + ((size_t)b * 512 + h * 64 + dv) * SPB + SEQ + seg * 32; LAS bf16_t* vd = (LAS bf16_t*)(F.lds + NA_VC) + dv * 264 + seg * 32;
#pragma unroll
          for (int j = 0; j < 4; ++j) *(LAS bf16x8*)(vd + j * 8) = gld16(vs + j * 8);
          const int lo = na_kr0(half * 32), hi0 = na_kr0(half * 32 + 1) + 7;
          for (int kr = lo; kr <= hi0; ++kr) *(LAS bf16x8*)(kdst + (kr % 9) * 64 * 72) = gld16(krow + (size_t)kr * 64 * DIN); }
        __syncthreads();
        int prev_hi = na_kr0(half * 32 + 1) + 7;
#pragma unroll 1
        for (int s = 0; s < 16; ++s) {
            const int r0 = half * 32 + 2 * s;
            const int nhi = s < 15 ? na_kr0(r0 + 3) + 7 : prev_hi;
            bf16x8 n0 = (bf16x8){0, 0, 0, 0, 0, 0, 0, 0}, n1 = n0;
            if (nhi > prev_hi) n0 = gld16(krow + (size_t)(prev_hi + 1) * 64 * DIN);
            if (nhi > prev_hi + 1) n1 = gld16(krow + (size_t)(prev_hi + 2) * 64 * DIN);
            na_unit<true>(F, b, h, r0 + (F.wave >> 2), F.wave & 3);
            __syncthreads();
            if (nhi > prev_hi) *(LAS bf16x8*)(kdst + ((prev_hi + 1) % 9) * 64 * 72) = n0;
            if (nhi > prev_hi + 1) *(LAS bf16x8*)(kdst + ((prev_hi + 2) % 9) * 64 * 72) = n1;
            __syncthreads();
            prev_hi = nhi;
        }
        if (!last) na_unit<false>(F, b, h, 0, half * 8 + F.wave);
    }
}

__device__ __forceinline__ void ph_hy_transpose(Frame& F, bool last) {
    LAS bf16_t* tile = (LAS bf16_t*)(F.lds + F.wave * 16384);
    const bf16_t* HYO = (const bf16_t*)(F.ws + WS_Y);
    const int gw = F.wg * NWAVES + F.wave, NGW = F.G * NWAVES;
    const int rsub = F.lane >> 3, cseg = F.lane & 7;
    const int ntt = last ? 1024 : 1088;
    for (int u = gw; u < ntt * 4; u += NGW) {
        const int tt = u >> 2, cb = u & 3;
        int b, s0, rowbase, posbase;
        if (tt < 1024) { b = tt >> 6; s0 = (tt & 63) * 64; rowbase = b * SEQ; posbase = 0; }
        else { const int t2 = tt - 1024; b = t2 >> 2; s0 = (t2 & 3) * 64; rowbase = NLAT + b * CTXL; posbase = SEQ; }
#pragma unroll 2
        for (int it = 0; it < 8; ++it) { const int c = rsub + 8 * it;
            const u32x4 v = *(const GAS u32x4*)(HYO + ((size_t)(cb * 64 + c) * NB + b) * SPB + posbase + s0 + cseg * 8); const unsigned a[4] = {v.x, v.y, v.z, v.w};
#pragma unroll
            for (int e = 0; e < 4; ++e) { tile[(cseg * 8 + 2 * e) * 72 + c] = (bf16_t)(a[e] & 0xffffu); tile[(cseg * 8 + 2 * e + 1) * 72 + c] = (bf16_t)(a[e] >> 16); } }
        LDS_WAIT(); asm volatile("" ::: "memory");
#pragma unroll 2
        for (int it = 0; it < 8; ++it) { const int p = rsub + 8 * it;
            const u32x4 v = *(const LAS u32x4*)(tile + p * 72 + cseg * 8);
            *(GAS u32x4*)((bf16_t*)(F.ws + WS_MIX) + (size_t)(rowbase + s0 + p) * DM + 768 + cb * 64 + cseg * 8) = v; }
        LDS_WAIT(); asm volatile("" ::: "memory");
    }
}

constexpr int G2_LAF = 0, G2_LAB = 8448;
constexpr int G2_QTF = 16896, G2_KTF = 22016, G2_QTB = 27136, G2_KTB = 32256;
constexpr int G2_VT = 37376, G2_ATT = 46592;
constexpr int G2_SF = 55808, G2_SB = 60928;
constexpr int G2_SEG = 66048, G2_HALF = 67328;
__device__ __forceinline__ float log_sigmoid_f(float x) { return fminf(x, 0.f) - __logf(1.0f + __expf(-fabsf(x))); }
__device__ __forceinline__ f32x4 mma_lds(const LAS bf16_t* A, int lda, const LAS bf16_t* B, int ldb, int ksteps, f32x4 acc, int lane) {
    const int r = lane & 15, g = lane >> 4;
    for (int ks = 0; ks < ksteps; ++ks) { const bf16x8 a = *(const LAS bf16x8*)(A + r * lda + ks * 32 + 8 * g), b = *(const LAS bf16x8*)(B + r * ldb + ks * 32 + 8 * g); acc = mfma16(a, b, acc); }
    return acc;
}
__device__ __forceinline__ int gla_row0(int b, int cn) { return cn >= 4 ? b * SEQ + (cn - 4) * 64 : NLAT + b * CTXL + cn * 64; }
struct GlaRaw { u32x4 q, k, f, b, v0, v1, g0, g1, s0, s1; };
template <bool FULL>
__device__ __forceinline__ GlaRaw gla_load(Frame& F, int u, int tl) {
    const int h = u & 3, cn = (u >> 2) % 68, b = (u >> 2) / 68, i = tl >> 2, part = tl & 3;
    const bf16_t* p = (const bf16_t*)(F.ws + WS_U) + (size_t)(gla_row0(b, cn) + i) * DIN;
    GlaRaw r;
    r.q = *(const GAS u32x4*)(p + UGQ + h * 32 + part * 8); r.k = *(const GAS u32x4*)(p + UGK + h * 32 + part * 8);
    r.f = *(const GAS u32x4*)(p + ULAF + h * 32 + part * 8); r.b = *(const GAS u32x4*)(p + ULAB + h * 32 + part * 8);
    r.v0 = *(const GAS u32x4*)(p + UGV + h * 64 + part * 16); r.v1 = *(const GAS u32x4*)(p + UGV + h * 64 + part * 16 + 8);
    if (FULL) { r.g0 = *(const GAS u32x4*)(p + UGR + h * 64 + part * 16); r.g1 = *(const GAS u32x4*)(p + UGR + h * 64 + part * 16 + 8);
        const bf16_t* sp = (const bf16_t*)(F.ws + WS_GSIN) + (size_t)u * 2 * 2048 + tl * 16; r.s0 = *(const GAS u32x4*)sp; r.s1 = *(const GAS u32x4*)(sp + 8); }
    else { r.g0 = (u32x4){0u, 0u, 0u, 0u}; r.g1 = r.g0; r.s0 = r.g0; r.s1 = r.g0; }
    return r;
}
template <bool FULL>
__device__ __forceinline__ void gla_prep(Frame& F, LAS unsigned char* L, int l, int u, int tl, const GlaRaw& raw) {
    const int h = u & 3, cn = (u >> 2) % 68, i = tl >> 2, part = tl & 3, d8 = part * 8;
    LAS float* LAF = (LAS float*)(L + G2_LAF); LAS float* LAB = (LAS float*)(L + G2_LAB); LAS bf16_t* VT = (LAS bf16_t*)(L + G2_VT); LAS float* SEG = (LAS float*)(L + G2_SEG);
    float q[8], k[8], tf[8], tb[8];
    unpack8(raw.q, q); unpack8(raw.k, k); unpack8(raw.f, tf); unpack8(raw.b, tb);
    const float* ba = F.in[I_BA2] + (size_t)l * 256 + h * 32 + d8;
#pragma unroll
    for (int e = 0; e < 8; ++e) { q[e] *= 0.17677669529663687f; LAF[i * 33 + d8 + e] = log_sigmoid_f(tf[e] + ba[e]) * 0.0625f; LAB[i * 33 + d8 + e] = log_sigmoid_f(tb[e] + ba[128 + e]) * 0.0625f; }
    if (cn >= 4) {
        const float pos = (part >> 1) ? (float)i : (float)(cn - 4);
#pragma unroll
        for (int e = 0; e < 8; ++e) { const float ang = pos * __expf(-(float)e * (9.210340371976184f / 8.0f)); const float sn = __sinf(ang), cs = __cosf(ang);
            const float qo = shx(q[e], 1, F.lane), ko = shx(k[e], 1, F.lane);
            if (part & 1) { q[e] = qo * sn + q[e] * cs; k[e] = ko * sn + k[e] * cs; } else { q[e] = q[e] * cs - qo * sn; k[e] = k[e] * cs - ko * sn; } }
    }
    { const unsigned a[8] = {raw.v0.x, raw.v0.y, raw.v0.z, raw.v0.w, raw.v1.x, raw.v1.y, raw.v1.z, raw.v1.w};
#pragma unroll
      for (int e = 0; e < 8; ++e) { VT[(part * 16 + 2 * e) * 72 + i] = (bf16_t)(a[e] & 0xffffu); VT[(part * 16 + 2 * e + 1) * 72 + i] = (bf16_t)(a[e] >> 16); } }
    __syncthreads();
    { const int x = tl & 63, d = x & 31, dir = x >> 5, seg = tl >> 6; LAS float* LA = (dir ? LAB : LAF) + d; float cv[16];
#pragma unroll
      for (int kk = 0; kk < 16; ++kk) { const int p = seg * 16 + kk, ti = dir ? 63 - p : p; cv[kk] = LA[ti * 33]; }
#pragma unroll
      for (int kk = 1; kk < 16; ++kk) cv[kk] += cv[kk - 1];
#pragma unroll
      for (int kk = 0; kk < 16; ++kk) { const int p = seg * 16 + kk, ti = dir ? 63 - p : p; LA[ti * 33] = cv[kk]; }
      SEG[x * 5 + seg] = cv[15]; }
    __syncthreads();
    { const int x = tl & 63, d = x & 31, dir = x >> 5, seg = tl >> 6; LAS float* LA = (dir ? LAB : LAF) + d; float cv[16];
      const float t0 = SEG[x * 5 + 0], t1 = SEG[x * 5 + 1], t2 = SEG[x * 5 + 2];
      const float pre = seg == 0 ? 0.f : (seg == 1 ? t0 : (seg == 2 ? t0 + t1 : t0 + t1 + t2));
#pragma unroll
      for (int kk = 0; kk < 16; ++kk) { const int p = seg * 16 + kk, ti = dir ? 63 - p : p; cv[kk] = LA[ti * 33]; }
#pragma unroll
      for (int kk = 0; kk < 16; ++kk) { const int p = seg * 16 + kk, ti = dir ? 63 - p : p; LA[ti * 33] = cv[kk] + pre; } }
    __syncthreads();
    if (FULL) {
        unsigned wqf[4], wkf[4], wqb[4], wkb[4];
#pragma unroll
        for (int e = 0; e < 4; ++e) { const int d = d8 + 2 * e; const float f0 = LAF[i * 33 + d], f1 = LAF[i * 33 + d + 1], b0 = LAB[i * 33 + d], b1 = LAB[i * 33 + d + 1];
            wqf[e] = pk2(q[2 * e] * __expf(f0), q[2 * e + 1] * __expf(f1)); wkf[e] = pk2(k[2 * e] * __expf(-f0), k[2 * e + 1] * __expf(-f1));
            wqb[e] = pk2(q[2 * e] * __expf(b0), q[2 * e + 1] * __expf(b1)); wkb[e] = pk2(k[2 * e] * __expf(-b0), k[2 * e + 1] * __expf(-b1)); }
        *(LAS u32x4*)((LAS bf16_t*)(L + G2_QTF) + i * 40 + d8) = (u32x4){wqf[0], wqf[1], wqf[2], wqf[3]}; *(LAS u32x4*)((LAS bf16_t*)(L + G2_KTF) + i * 40 + d8) = (u32x4){wkf[0], wkf[1], wkf[2], wkf[3]};
        *(LAS u32x4*)((LAS bf16_t*)(L + G2_QTB) + i * 40 + d8) = (u32x4){wqb[0], wqb[1], wqb[2], wqb[3]}; *(LAS u32x4*)((LAS bf16_t*)(L + G2_KTB) + i * 40 + d8) = (u32x4){wkb[0], wkb[1], wkb[2], wkb[3]};
    } else {
        LAS bf16_t* KDF = (LAS bf16_t*)(L + G2_QTF); LAS bf16_t* KDB = (LAS bf16_t*)(L + G2_KTF);
#pragma unroll
        for (int e = 0; e < 8; ++e) { const int d = d8 + e; const float bf = LAF[i * 33 + d], bb = LAB[i * 33 + d], bfl = LAF[63 * 33 + d], bbl = LAB[0 * 33 + d];
            KDF[d * 72 + i] = (bf16_t)f2bf(k[e] * __expf(bfl - bf)); KDB[d * 72 + i] = (bf16_t)f2bf(k[e] * __expf(bbl - bb)); }
    }
    __syncthreads();
}
__device__ __forceinline__ void ph_gla_local(Frame& F, int l) {
    const int hw = F.wave >> 2, wl = F.wave & 3, tl = F.tid & 255; LAS unsigned char* L = F.lds + hw * G2_HALF;
    constexpr int NU = NB * 68 * 4;
    int pp = F.wg;
    GlaRaw raw = gla_load<false>(F, (pp * 2 + hw) < NU ? pp * 2 + hw : 0, tl);
    for (; pp * 2 < NU; pp += F.G) {
        const int u = pp * 2 + hw, un = (pp + F.G) * 2 + hw;
        const GlaRaw nraw = gla_load<false>(F, un < NU ? un : u, tl);
        __syncthreads();
        gla_prep<false>(F, L, l, u, tl, raw);
        const int g = F.lane >> 4, c = F.lane & 15;
        float* DS = (float*)(F.ws + WS_GDS) + (size_t)u * 2 * 2048;
#pragma unroll
        for (int kk = 0; kk < 4; ++kk) { const int tix = wl * 4 + kk, dir = tix >> 3, mt = (tix >> 1) & 3, nt = tix & 1;
            f32x4 a = (f32x4){0.f, 0.f, 0.f, 0.f};
            a = mma_lds((const LAS bf16_t*)(L + G2_VT) + mt * 16 * 72, 72, (const LAS bf16_t*)(L + (dir ? G2_KTF : G2_QTF)) + nt * 16 * 72, 72, 2, a, F.lane);
#pragma unroll
            for (int e = 0; e < 4; ++e) DS[dir * 2048 + (mt * 16 + 4 * g + e) * 32 + nt * 16 + c] = a[e]; }
        if (tl < 64) { const int d = tl & 31, dir = tl >> 5; ((float*)(F.ws + WS_GD))[(size_t)u * 64 + tl] = __expf(dir ? ((LAS float*)(L + G2_LAB))[0 * 33 + d] : ((LAS float*)(L + G2_LAF))[63 * 33 + d]); }
        raw = nraw;
    }
}
__device__ __forceinline__ void ph_gla_scan(Frame& F) {
    const int gt = F.wg * NTHR + F.tid, NGT = F.G * NTHR;
    const float* DS = (const float*)(F.ws + WS_GDS); const float* GD = (const float*)(F.ws + WS_GD); bf16_t* SIN = (bf16_t*)(F.ws + WS_GSIN);
    for (int w = gt; w < 128 * 1024; w += NGT) {
        const int chain = w >> 10, el = (w & 1023) * 2, dir = chain & 1, h = (chain >> 1) & 3, b = chain >> 3, d = el & 31;
        float s0 = 0.f, s1 = 0.f;
        for (int step = 0; step < 68; step += 4) {
            f32x2 ds[4], dd[4]; size_t uu[4];
#pragma unroll
            for (int q = 0; q < 4; ++q) { const int st_ = step + q; const int cn = dir ? (st_ < 4 ? 3 - st_ : 71 - st_) : st_;
                uu[q] = (size_t)(b * 68 + cn) * 4 + h;
                ds[q] = *(const GAS f32x2*)(DS + (uu[q] * 2 + dir) * 2048 + el); dd[q] = *(const GAS f32x2*)(GD + uu[q] * 64 + dir * 32 + d); }
#pragma unroll
            for (int q = 0; q < 4; ++q) { *(GAS unsigned*)(SIN + (uu[q] * 2 + dir) * 2048 + el) = pk2(s0, s1); s0 = dd[q].x * s0 + ds[q].x; s1 = dd[q].y * s1 + ds[q].y; }
        }
    }
}
__device__ __forceinline__ void ph_gla_out(Frame& F, int l, bool last) {
    const int hw = F.wave >> 2, wl = F.wave & 3, tl = F.tid & 255; LAS unsigned char* L = F.lds + hw * G2_HALF;
    const int NV = last ? NB * 64 * 4 : NB * 68 * 4;
#define GLA_UNIT(v) (last ? ((((v) >> 8) * 68 + 4 + (((v) & 255) >> 2)) * 4 + ((v) & 3)) : (v))
    int pp = F.wg;
    GlaRaw raw = gla_load<true>(F, GLA_UNIT((pp * 2 + hw) < NV ? pp * 2 + hw : 0), tl);
    for (; pp * 2 < NV; pp += F.G) {
        const int u = GLA_UNIT(pp * 2 + hw), vn = (pp + F.G) * 2 + hw;
        const GlaRaw nraw = gla_load<true>(F, vn < NV ? GLA_UNIT(vn) : u, tl);
        const int h = u & 3, cn = (u >> 2) % 68, b = (u >> 2) / 68;
        __syncthreads();
        gla_prep<true>(F, L, l, u, tl, raw);
        { const int dir = tl >> 7, dv = (tl >> 1) & 63, d16 = (tl & 1) * 16; LAS bf16_t* S = (LAS bf16_t*)(L + (dir ? G2_SB : G2_SF)) + dv * 40 + d16; *(LAS u32x4*)S = raw.s0; *(LAS u32x4*)(S + 8) = raw.s1; }
        const int g = F.lane >> 4, c = F.lane & 15;
        LAS bf16_t* ATT = (LAS bf16_t*)(L + G2_ATT);
#pragma unroll
        for (int kk = 0; kk < 4; ++kk) { const int tile = wl * 4 + kk, mt = tile >> 2, nt = tile & 3;
            f32x4 af = (f32x4){0.f, 0.f, 0.f, 0.f}, ab = af;
            af = mma_lds((const LAS bf16_t*)(L + G2_QTF) + mt * 16 * 40, 40, (const LAS bf16_t*)(L + G2_KTF) + nt * 16 * 40, 40, 1, af, F.lane);
            ab = mma_lds((const LAS bf16_t*)(L + G2_QTB) + mt * 16 * 40, 40, (const LAS bf16_t*)(L + G2_KTB) + nt * 16 * 40, 40, 1, ab, F.lane);
#pragma unroll
            for (int e = 0; e < 4; ++e) { const int ii = mt * 16 + 4 * g + e, j = nt * 16 + c; const float vv = (j <= ii ? af[e] : 0.f) + (j >= ii ? ab[e] : 0.f); ATT[ii * 72 + j] = (bf16_t)f2bf(vv); } }
        __syncthreads();
        LAS float* O = (LAS float*)(L + G2_LAF);
#pragma unroll
        for (int kk = 0; kk < 4; ++kk) { const int tile = wl * 4 + kk, mt = tile >> 2, nt = tile & 3;
            f32x4 a = (f32x4){0.f, 0.f, 0.f, 0.f};
            a = mma_lds(ATT + mt * 16 * 72, 72, (const LAS bf16_t*)(L + G2_VT) + nt * 16 * 72, 72, 2, a, F.lane);
            a = mma_lds((const LAS bf16_t*)(L + G2_QTF) + mt * 16 * 40, 40, (const LAS bf16_t*)(L + G2_SF) + nt * 16 * 40, 40, 1, a, F.lane);
            a = mma_lds((const LAS bf16_t*)(L + G2_QTB) + mt * 16 * 40, 40, (const LAS bf16_t*)(L + G2_SB) + nt * 16 * 40, 40, 1, a, F.lane);
#pragma unroll
            for (int e = 0; e < 4; ++e) O[(mt * 16 + 4 * g + e) * 65 + nt * 16 + c] = a[e]; }
        __syncthreads();
        { const int i = tl >> 2, dv16 = (tl & 3) * 16; const int row = gla_row0(b, cn) + i;
          float v[16], gt[16]; float ss = 0.f;
#pragma unroll
          for (int e = 0; e < 16; ++e) { v[e] = O[i * 65 + dv16 + e]; ss += v[e] * v[e]; }
          ss += shx(ss, 1, F.lane); ss += shx(ss, 2, F.lane);
          const float rs = 1.0f / sqrtf(ss * (1.0f / 64.0f) + LN_EPS);
          unpack8(raw.g0, gt); unpack8(raw.g1, gt + 8);
          const float* gn = F.in[I_GNORM] + l * 64 + dv16;
          unsigned w[8];
#pragma unroll
          for (int e = 0; e < 8; ++e) w[e] = pk2(v[2 * e] * rs * gn[2 * e] * silu_f(gt[2 * e]), v[2 * e + 1] * rs * gn[2 * e + 1] * silu_f(gt[2 * e + 1]));
          bf16_t* mp = (bf16_t*)(F.ws + WS_MIX) + (size_t)row * DM + 512 + h * 64 + dv16;
          *(GAS u32x4*)mp = (u32x4){w[0], w[1], w[2], w[3]}; *(GAS u32x4*)(mp + 8) = (u32x4){w[4], w[5], w[6], w[7]}; }
        raw = nraw;
    }
#undef GLA_UNIT
}

template <int L>
__device__ __forceinline__ void hyena_conv(Frame& F, const bf16_t* Rg, const bf16_t* Uin, const bf16_t* Xmul, int pos0, bool final_out, int ch, bf16_t* Zout) {
    constexpr int CS = 2 * L + 16;
    constexpr int NTL = L / 16, J = (NTL >= 64) ? 16 : 2, NGRP = NTL / J, HJ = J / 2, NSTEP = L / 32;
    LAS bf16_t* Rl = (LAS bf16_t*)F.lds;
    __syncthreads();
    for (int c = F.tid; c < 2 * L / 8; c += NTHR) { const u32x4 v = *(const GAS u32x4*)(Rg + 8 * c); const unsigned a[4] = {v.x, v.y, v.z, v.w};
#pragma unroll
        for (int rho = 0; rho < 8; ++rho) { LAS bf16_t* d = Rl + rho * CS + 8 * c + rho;
#pragma unroll
            for (int k = 0; k < 4; ++k) { d[2 * k] = (bf16_t)(a[k] & 0xffffu); d[2 * k + 1] = (bf16_t)(a[k] >> 16); } } }
    __syncthreads();
    int ln_ = F.lane; asm volatile("" : "+v"(ln_));
    const int i = ln_ & 15, g = ln_ >> 4, rho = i & 7;
    const LAS bf16_t* Rc = Rl + rho * CS + rho;
    for (int grp = F.wave; grp < NGRP; grp += NWAVES) {
        f32x4 acc[J]; bf16x8 fr[J];
        const int tb = grp * J * 16;
        const LAS bf16_t* Rb = Rc + (L - tb - i + 8 * g);
#pragma unroll
        for (int j = 0; j < J; ++j) { acc[j] = (f32x4){0.f, 0.f, 0.f, 0.f}; fr[j] = *(const LAS bf16x8*)(Rb - 16 * j); }
        const char* ub = (const char*)(Uin + pos0); const unsigned ulo = (unsigned)((i * SPB + 8 * g) * 2);
        constexpr int PF = (HJ >= 4) ? 4 : 1;
        bf16x8 bq[PF];
#pragma unroll
        for (int p = 0; p < PF; ++p) bq[p] = *(const GAS bf16x8*)(ub + (size_t)(ulo + (unsigned)p * 64u));
#pragma unroll 1
        for (int q = 0; q < NSTEP / HJ; ++q) {
#pragma unroll
            for (int m = 0; m < HJ; ++m) {
                const int n = q * HJ + m;
                const int nn = (n + PF < NSTEP) ? n + PF : 0;
                if (n > 0) { fr[(J - 2 * m) % J] = *(const LAS bf16x8*)(Rb + 32 * n); fr[(J + 1 - 2 * m) % J] = *(const LAS bf16x8*)(Rb + 32 * n - 16); }
                const bf16x8 bcur = bq[m % PF];
#pragma unroll
                for (int jj = 0; jj < J; ++jj) { const int j = (jj + 2) % J; acc[j] = mfma16(fr[(j + J - 2 * m) % J], bcur, acc[j]); }
                bq[m % PF] = *(const GAS bf16x8*)(ub + (size_t)(ulo + (unsigned)nn * 64u));
            }
        }
#pragma unroll
        for (int j = 0; j < J; ++j) { const int t0 = tb + j * 16 + 4 * g;
            const u32x2 xw = *(const GAS u32x2*)(Xmul + (size_t)i * SPB + pos0 + t0);
            const float y0 = acc[j][0] * bflo(xw.x), y1 = acc[j][1] * bfhi(xw.x), y2 = acc[j][2] * bflo(xw.y), y3 = acc[j][3] * bfhi(xw.y);
            if (!final_out) { u32x2 w; w.x = pk2(y0, y1); w.y = pk2(y2, y3); *(GAS u32x2*)(Zout + (size_t)i * SPB + pos0 + t0) = w; }
            else { u32x2 w; w.x = pk2(y0, y1); w.y = pk2(y2, y3); *(GAS u32x2*)((bf16_t*)(F.ws + WS_Y) + ((size_t)ch * NB + i) * SPB + pos0 + t0) = w; } }
    }
}
__device__ __forceinline__ void ph_hyena(Frame& F, int l, bool last) {
    const bf16_t* HV = (const bf16_t*)(F.ws + WS_HV); bf16_t* Z2 = (bf16_t*)(F.ws + WS_Z2);
    for (int ch = F.wg; ch < 256; ch += F.G) {
        const bf16_t* v = HV + (size_t)(0 * 256 + ch) * NB * SPB; const bf16_t* x1 = HV + (size_t)(256 + ch) * NB * SPB; const bf16_t* x2 = HV + (size_t)(512 + ch) * NB * SPB;
        bf16_t* z = Z2 + (size_t)ch * NB * SPB;
        const bf16_t* R0 = (const bf16_t*)(F.ws + WS_HYF) + ((size_t)(l * 2 + 0) * 256 + ch) * 8192; const bf16_t* R1 = (const bf16_t*)(F.ws + WS_HYF) + ((size_t)(l * 2 + 1) * 256 + ch) * 8192;
        hyena_conv<4096>(F, R0, v, x1, 0, false, ch, z);
        VM_WAIT(); __syncthreads(); __builtin_amdgcn_fence(__ATOMIC_ACQUIRE, "agent"); VM_WAIT();
        hyena_conv<4096>(F, R1, z, x2, 0, true, ch, z);
        if (!last) {
            const bf16_t* C0 = (const bf16_t*)(F.ws + WS_HYFC) + ((size_t)(l * 2 + 0) * 256 + ch) * 512; const bf16_t* C1 = (const bf16_t*)(F.ws + WS_HYFC) + ((size_t)(l * 2 + 1) * 256 + ch) * 512;
            hyena_conv<256>(F, C0, v, x1, SEQ, false, ch, z);
            VM_WAIT(); __syncthreads(); __builtin_amdgcn_fence(__ATOMIC_ACQUIRE, "agent"); VM_WAIT();
            hyena_conv<256>(F, C1, z, x2, SEQ, true, ch, z);
        }
    }
}

__device__ __forceinline__ void ph_ln1(Frame& F, int l, int ntok) {
    const int gw = F.wg * NWAVES + F.wave, NGW = F.G * NWAVES;
    const int cA = 256 * (F.lane >> 4) + 32 * ((F.lane >> 2) & 3) + 8 * (F.lane & 3);
#define LN1_COL(j) (cA + ((j) < 2 ? 4 * (j) : 128 + 4 * ((j) - 2)))
    const float* lg = F.in[I_LN1G] + l * DM; const float* lb = F.in[I_LN1B] + l * DM;
    for (int row = gw; row < ntok; row += NGW) {
        bf16_t* xr = (bf16_t*)(F.ws + WS_XR) + (size_t)row * DM;
        const unsigned char* yr = (const unsigned char*)(F.ws + WS_Y) + (size_t)row * DM + 16 * F.lane;
        const float* md = mod_ptr(F, l, row);
        const u32x4 ya = __builtin_nontemporal_load((const GAS u32x4*)yr);
        float x[16], y[16], v[16];
        if (l == 0) {
            const float* src = (row < NLAT ? F.in[I_X] + (size_t)row * DM : F.in[I_CTX] + (size_t)(row - NLAT) * DM) + cA;
            const f32x4 a0 = __builtin_nontemporal_load((const GAS f32x4*)src), a1 = __builtin_nontemporal_load((const GAS f32x4*)(src + 4)), a2 = __builtin_nontemporal_load((const GAS f32x4*)(src + 128)), a3 = __builtin_nontemporal_load((const GAS f32x4*)(src + 132));
#pragma unroll
            for (int e = 0; e < 4; ++e) { x[e] = a0[e]; x[4 + e] = a1[e]; x[8 + e] = a2[e]; x[12 + e] = a3[e]; }
        } else {
            const u32x4 xa = __builtin_nontemporal_load((const GAS u32x4*)(xr + cA)), xb = __builtin_nontemporal_load((const GAS u32x4*)(xr + cA + 128)); unpack8(xa, x); unpack8(xb, x + 8); }
        { const unsigned a[4] = {ya.x, ya.y, ya.z, ya.w};
#pragma unroll
          for (int e = 0; e < 4; ++e) { const f32x2 lo = __builtin_amdgcn_cvt_pk_f32_fp8((int)a[e], false), hi = __builtin_amdgcn_cvt_pk_f32_fp8((int)a[e], true); y[4 * e] = lo.x; y[4 * e + 1] = lo.y; y[4 * e + 2] = hi.x; y[4 * e + 3] = hi.y; } }
        float s = 0.f;
#pragma unroll
        for (int j = 0; j < 4; ++j) { const f32x4 g1 = *(const GAS f32x4*)(md + 2048 + LN1_COL(j));
#pragma unroll
            for (int e = 0; e < 4; ++e) { v[4 * j + e] = x[4 * j + e] * DN_ALPHA + g1[e] * y[4 * j + e]; s += v[4 * j + e]; } }
        const float mean = wave_sum(s, F.lane) * (1.f / DM); float s2 = 0.f;
#pragma unroll
        for (int e = 0; e < 16; ++e) { v[e] -= mean; s2 += v[e] * v[e]; }
        const float rstd = 1.f / sqrtf(wave_sum(s2, F.lane) * (1.f / DM) + LN_EPS);
        unsigned wx[8]; int w8[4];
#pragma unroll
        for (int j = 0; j < 4; ++j) { const f32x4 g = *(const GAS f32x4*)(lg + LN1_COL(j)), bb = *(const GAS f32x4*)(lb + LN1_COL(j)), sh = *(const GAS f32x4*)(md + 3072 + LN1_COL(j)), sc = *(const GAS f32x4*)(md + 4096 + LN1_COL(j));
            float xn[4];
#pragma unroll
            for (int e = 0; e < 4; ++e) xn[e] = v[4 * j + e] * rstd * g[e] + bb[e];
            wx[2 * j] = pk2(xn[0], xn[1]); wx[2 * j + 1] = pk2(xn[2], xn[3]);
            const float h0 = xn[0] * (1.f + sc[0]) + sh[0], h1 = xn[1] * (1.f + sc[1]) + sh[1], h2 = xn[2] * (1.f + sc[2]) + sh[2], h3 = xn[3] * (1.f + sc[3]) + sh[3];
            int v = 0; v = __builtin_amdgcn_cvt_pk_fp8_f32(h0, h1, v, false); v = __builtin_amdgcn_cvt_pk_fp8_f32(h2, h3, v, true); w8[j] = v; }
        unsigned char* x8 = (unsigned char*)(F.ws + WS_XM8) + (size_t)row * DM;
        *(GAS u32x2*)(x8 + cA) = (u32x2){(unsigned)w8[0], (unsigned)w8[1]}; *(GAS u32x2*)(x8 + cA + 128) = (u32x2){(unsigned)w8[2], (unsigned)w8[3]};
        *(GAS u32x4*)(xr + cA) = (u32x4){wx[0], wx[1], wx[2], wx[3]}; *(GAS u32x4*)(xr + cA + 128) = (u32x4){wx[4], wx[5], wx[6], wx[7]};
    }
#undef LN1_COL
}
__device__ __forceinline__ void ph_ln2(Frame& F, int l, int ntok, bool last) {
    const int gw = F.wg * NWAVES + F.wave, NGW = F.G * NWAVES;
    const int cA = 256 * (F.lane >> 4) + 32 * ((F.lane >> 2) & 3) + 8 * (F.lane & 3);
#define LN2_COL(j) (cA + ((j) < 2 ? 4 * (j) : 128 + 4 * ((j) - 2)))
    const float* lg = F.in[I_LN2G] + l * DM; const float* lb = F.in[I_LN2B] + l * DM;
    for (int row = gw; row < ntok; row += NGW) {
        bf16_t* xr = (bf16_t*)(F.ws + WS_XR) + (size_t)row * DM;
        const unsigned char* y2 = (const unsigned char*)(F.ws + WS_Y2) + (size_t)row * 5120;
        const float* wg = (const float*)(F.ws + WS_WGT) + (size_t)row * 8;
        const float* md = mod_ptr(F, l, row);
        float ff[16];
#pragma unroll
        for (int e = 0; e < 16; ++e) ff[e] = 0.f;
        u32x2 q[8];
#pragma unroll
        for (int k = 0; k < 8; ++k) q[k] = __builtin_nontemporal_load((const GAS u32x2*)(y2 + k * 512 + 8 * F.lane));
        const u32x4 qs = __builtin_nontemporal_load((const GAS u32x4*)(y2 + 4096 + 16 * F.lane));
        { const unsigned a[4] = {qs.x, qs.y, qs.z, qs.w};
#pragma unroll
          for (int e = 0; e < 4; ++e) { const f32x2 lo = __builtin_amdgcn_cvt_pk_f32_fp8((int)a[e], false), hi = __builtin_amdgcn_cvt_pk_f32_fp8((int)a[e], true);
              ff[4 * e] += pg8::Y2_INV * lo.x; ff[4 * e + 1] += pg8::Y2_INV * lo.y; ff[4 * e + 2] += pg8::Y2_INV * hi.x; ff[4 * e + 3] += pg8::Y2_INV * hi.y; } }
#pragma unroll
        for (int k = 0; k < 8; ++k) { const float wk = wg[k] * pg8::Y2_INV; const unsigned a[2] = {q[k].x, q[k].y};
#pragma unroll
            for (int h = 0; h < 2; ++h) {
                const f32x2 p0 = __builtin_amdgcn_cvt_scalef32_pk_f32_fp4(a[h], 1.0f, 0), p1 = __builtin_amdgcn_cvt_scalef32_pk_f32_fp4(a[h], 1.0f, 1), p2 = __builtin_amdgcn_cvt_scalef32_pk_f32_fp4(a[h], 1.0f, 2), p3 = __builtin_amdgcn_cvt_scalef32_pk_f32_fp4(a[h], 1.0f, 3);
                ff[8 * h] += wk * p0.x; ff[8 * h + 1] += wk * p0.y; ff[8 * h + 2] += wk * p1.x; ff[8 * h + 3] += wk * p1.y; ff[8 * h + 4] += wk * p2.x; ff[8 * h + 5] += wk * p2.y; ff[8 * h + 6] += wk * p3.x; ff[8 * h + 7] += wk * p3.y; } }
        float v[16], xo[16]; float s = 0.f;
        { const u32x4 xa = __builtin_nontemporal_load((const GAS u32x4*)(xr + cA)), xb = __builtin_nontemporal_load((const GAS u32x4*)(xr + cA + 128)); unpack8(xa, xo); unpack8(xb, xo + 8); }
#pragma unroll
        for (int j = 0; j < 4; ++j) { const f32x4 g2 = *(const GAS f32x4*)(md + 5120 + LN2_COL(j));
#pragma unroll
            for (int e = 0; e < 4; ++e) { v[4 * j + e] = xo[4 * j + e] * DN_ALPHA + g2[e] * ff[4 * j + e]; s += v[4 * j + e]; } }
        const float mean = wave_sum(s, F.lane) * (1.f / DM); float s2 = 0.f;
#pragma unroll
        for (int e = 0; e < 16; ++e) { v[e] -= mean; s2 += v[e] * v[e]; }
        const float rstd = 1.f / sqrtf(wave_sum(s2, F.lane) * (1.f / DM) + LN_EPS);
        const float* mdn = last ? md : mod_ptr(F, l + 1, row);
        float xn[16];
#pragma unroll
        for (int j = 0; j < 4; ++j) { const f32x4 g = *(const GAS f32x4*)(lg + LN2_COL(j)), bb = *(const GAS f32x4*)(lb + LN2_COL(j));
#pragma unroll
            for (int e = 0; e < 4; ++e) xn[4 * j + e] = v[4 * j + e] * rstd * g[e] + bb[e]; }
        if (last) { float* op = F.out + (size_t)row * DM;
#pragma unroll
            for (int j = 0; j < 4; ++j) *(GAS f32x4*)(op + LN2_COL(j)) = (f32x4){xn[4 * j], xn[4 * j + 1], xn[4 * j + 2], xn[4 * j + 3]}; }
        else {
            *(GAS u32x4*)(xr + cA) = (u32x4){pk2(xn[0], xn[1]), pk2(xn[2], xn[3]), pk2(xn[4], xn[5]), pk2(xn[6], xn[7])}; *(GAS u32x4*)(xr + cA + 128) = (u32x4){pk2(xn[8], xn[9]), pk2(xn[10], xn[11]), pk2(xn[12], xn[13]), pk2(xn[14], xn[15])};
            bf16_t* xm = (bf16_t*)(F.ws + WS_XM) + (size_t)row * DM;
            unsigned w[8];
#pragma unroll
            for (int j = 0; j < 4; ++j) { const f32x4 sh = *(const GAS f32x4*)(mdn + LN2_COL(j)), sc = *(const GAS f32x4*)(mdn + 1024 + LN2_COL(j));
                w[2 * j] = pk2(xn[4 * j] * (1.f + sc[0]) + sh[0], xn[4 * j + 1] * (1.f + sc[1]) + sh[1]); w[2 * j + 1] = pk2(xn[4 * j + 2] * (1.f + sc[2]) + sh[2], xn[4 * j + 3] * (1.f + sc[3]) + sh[3]); }
            *(GAS u32x4*)(xm + cA) = (u32x4){w[0], w[1], w[2], w[3]}; *(GAS u32x4*)(xm + cA + 128) = (u32x4){w[4], w[5], w[6], w[7]};
        }
    }
#undef LN2_COL
}

__device__ __forceinline__ unsigned f_ord(float f) { const unsigned u = __builtin_bit_cast(unsigned, f); return (u & 0x80000000u) ? ~u : (u | 0x80000000u); }
__device__ __forceinline__ unsigned long long wave_max_u64(unsigned long long v, int lane) {
#pragma unroll
    for (int o = 1; o < 64; o <<= 1) { const unsigned lo = (unsigned)shxi((int)(unsigned)v, o, lane), hi = (unsigned)shxi((int)(unsigned)(v >> 32), o, lane); const unsigned long long w = ((unsigned long long)hi << 32) | lo; v = w > v ? w : v; }
    return v;
}
__device__ __forceinline__ float seg16_max(float v, int lane) { v = fmaxf(v, shx(v, 1, lane)); v = fmaxf(v, shx(v, 2, lane)); v = fmaxf(v, shx(v, 4, lane)); v = fmaxf(v, shx(v, 8, lane)); return v; }
__device__ __forceinline__ int seg16_min_i(int v, int lane) { int w; w = shxi(v, 1, lane); v = w < v ? w : v; w = shxi(v, 2, lane); v = w < v ? w : v; w = shxi(v, 4, lane); v = w < v ? w : v; w = shxi(v, 8, lane); v = w < v ? w : v; return v; }
template <int CTRL> __device__ __forceinline__ int dpp_i(int v) { return __builtin_amdgcn_update_dpp(0, v, CTRL, 0xf, 0xf, true); }
__device__ __forceinline__ unsigned row_max_u(unsigned v) { unsigned w; w = (unsigned)dpp_i<0xB1>((int)v); v = w > v ? w : v; w = (unsigned)dpp_i<0x4E>((int)v); v = w > v ? w : v; w = (unsigned)dpp_i<0x141>((int)v); v = w > v ? w : v; w = (unsigned)dpp_i<0x140>((int)v); v = w > v ? w : v; return v; }
__device__ __forceinline__ float row_max_f(float v) { v = fmaxf(v, __builtin_bit_cast(float, dpp_i<0xB1>(__builtin_bit_cast(int, v)))); v = fmaxf(v, __builtin_bit_cast(float, dpp_i<0x4E>(__builtin_bit_cast(int, v)))); v = fmaxf(v, __builtin_bit_cast(float, dpp_i<0x141>(__builtin_bit_cast(int, v)))); v = fmaxf(v, __builtin_bit_cast(float, dpp_i<0x140>(__builtin_bit_cast(int, v)))); return v; }
__device__ __forceinline__ int row_min_i(int v) { int w; w = dpp_i<0xB1>(v); v = w < v ? w : v; w = dpp_i<0x4E>(v); v = w < v ? w : v; w = dpp_i<0x141>(v); v = w < v ? w : v; w = dpp_i<0x140>(v); v = w < v ? w : v; return v; }
__device__ __forceinline__ float rdlane_f(float v, int l) { return __builtin_bit_cast(float, __builtin_amdgcn_readlane(__builtin_bit_cast(int, v), l)); }
__device__ __forceinline__ unsigned wave_max_u(unsigned v) {
    v = row_max_u(v);
    const unsigned a = (unsigned)__builtin_amdgcn_readlane((int)v, 0), b = (unsigned)__builtin_amdgcn_readlane((int)v, 16), c = (unsigned)__builtin_amdgcn_readlane((int)v, 32), d = (unsigned)__builtin_amdgcn_readlane((int)v, 48);
    const unsigned ab = a > b ? a : b, cd = c > d ? c : d; return ab > cd ? ab : cd;
}
__device__ __forceinline__ float row_top2(float v, int l16) {
    const float m1 = row_max_f(v);
    const int first = row_min_i(v == m1 ? l16 : 99);
    const float m2 = row_max_f(l16 == first ? -3.0e38f : v);
    return m1 + m2;
}
__device__ __forceinline__ float seg16_top2(float v, int lane) {
    const float m1 = seg16_max(v, lane);
    const int first = seg16_min_i(v == m1 ? (lane & 15) : 99, lane);
    const float m2 = seg16_max((lane & 15) == first ? -3.0e38f : v, lane);
    return m1 + m2;
}
__device__ __forceinline__ void ph_route(Frame& F, int l, int ntok) {
    LAS int* hist = (LAS int*)F.lds;
    LAS int* base = hist + 128;
    LAS unsigned* alist = (LAS unsigned*)(F.lds + 1024);
    const int tpw = (ntok + F.G - 1) / F.G, t0 = F.wg * tpw, t1 = (t0 + tpw) < ntok ? (t0 + tpw) : ntok;
    __syncthreads();
    if (F.tid < 128) hist[F.tid] = 0;
    __syncthreads();
    const float* LG = (const float*)(F.ws + WS_LOGIT); const float* rb = F.in[I_RB] + l * NEXP;
    const float b0 = rb[F.lane], b1 = rb[F.lane + 64];
    constexpr int RT = 4;
    for (int tb = t0 + F.wave * RT; tb < t1; tb += NWAVES * RT) {
        float s0[RT], s1[RT], e0[RT], e1[RT], gs0[RT], gs1[RT]; unsigned h0[RT], h1[RT]; int mye[RT]; float myw[RT], wsum[RT];
#pragma unroll
        for (int j = 0; j < RT; ++j) { const int tok = (tb + j) < t1 ? tb + j : t1 - 1;
            const float x0 = LG[(size_t)tok * 256 + F.lane], x1 = LG[(size_t)tok * 256 + 64 + F.lane];
            const float* rbs = (const float*)(F.ws + WS_RBIAS) + (size_t)(l * 17 + row_b(tok)) * 128; const float y0 = x0 + rbs[F.lane], y1 = x1 + rbs[64 + F.lane];
            s0[j] = __builtin_amdgcn_rcpf(1.0f + __expf(-y0)); s1[j] = __builtin_amdgcn_rcpf(1.0f + __expf(-y1)); e0[j] = s0[j] + b0; e1[j] = s1[j] + b1; }
#pragma unroll
        for (int j = 0; j < RT; ++j) { gs0[j] = row_top2(e0[j], F.lane & 15); gs1[j] = row_top2(e1[j], F.lane & 15); }
#pragma unroll
        for (int j = 0; j < RT; ++j) {
            float gsc[8];
#pragma unroll
            for (int g = 0; g < 4; ++g) { gsc[g] = rdlane_f(gs0[j], g * 16); gsc[4 + g] = rdlane_f(gs1[j], g * 16); }
            unsigned gmask = 0u;
#pragma unroll
            for (int g = 0; g < 8; ++g) { int cnt = 0;
#pragma unroll
                for (int g2 = 0; g2 < 8; ++g2) cnt += (gsc[g2] > gsc[g] || (gsc[g2] == gsc[g] && g2 < g)) ? 1 : 0;
                gmask |= (cnt < 4) ? (1u << g) : 0u; }
            const bool ok0 = (gmask >> (F.lane >> 4)) & 1u, ok1 = (gmask >> (4 + (F.lane >> 4))) & 1u;
            h0[j] = ok0 ? f_ord(e0[j]) : 0u; h1[j] = ok1 ? f_ord(e1[j]) : 0u;
            mye[j] = 0; myw[j] = 0.f; wsum[j] = 0.f; }
#pragma unroll
        for (int k = 0; k < 8; ++k) {
#pragma unroll
            for (int j = 0; j < RT; ++j) {
                const unsigned bh = h0[j] >= h1[j] ? h0[j] : h1[j];
                const unsigned H = wave_max_u(bh);
                const unsigned mylo = h0[j] == H ? (unsigned)(255 - F.lane) : (h1[j] == H ? (unsigned)(255 - 64 - F.lane) : 0u);
                const unsigned Lm = wave_max_u(mylo);
                const int e = 255 - (int)Lm;
                if (e < 64) { if (F.lane == e) h0[j] = 0u; } else { if (F.lane == e - 64) h1[j] = 0u; }
                const float sv = e < 64 ? rdlane_f(s0[j], e) : rdlane_f(s1[j], e - 64);
                wsum[j] += sv; if (F.lane == k) { mye[j] = e; myw[j] = sv; } }
        }
#pragma unroll
        for (int j = 0; j < RT; ++j) { const int tok = tb + j;
            if (tok < t1 && F.lane < 8) {
                const int lr = __hip_atomic_fetch_add(&hist[mye[j]], 1, __ATOMIC_RELAXED, __HIP_MEMORY_SCOPE_WORKGROUP);
                alist[(tok - t0) * 8 + F.lane] = (unsigned)mye[j] | ((unsigned)lr << 8);
                ((int*)(F.ws + WS_EIDX))[(size_t)tok * 8 + F.lane] = mye[j];
                ((float*)(F.ws + WS_WGT))[(size_t)tok * 8 + F.lane] = myw[j] / wsum[j] * 2.5f;
            } }
    }
    __syncthreads();
    if (F.tid < 128) { const int hcount = hist[F.tid]; base[F.tid] = hcount ? (int)atomicAdd(F.ctl + CW_CNT + l * 256 + F.tid, (unsigned)hcount) : 0; }
    __syncthreads();
    for (int a = F.tid; a < (t1 - t0) * 8; a += NTHR) { const unsigned v = alist[a]; ((int*)(F.ws + WS_RNK))[(size_t)t0 * 8 + a] = base[v & 0xffu] + (int)(v >> 8); }
}
__device__ __forceinline__ void ph_positions(Frame& F, int l, int ntok) {
    LAS int* cnt = (LAS int*)F.lds;
    LAS int* off = cnt + 132;
    __syncthreads();
    if (F.tid < NE1) cnt[F.tid] = F.tid < NEXP ? (int)__hip_atomic_load(F.ctl + CW_CNT + l * 256 + F.tid, __ATOMIC_RELAXED, __HIP_MEMORY_SCOPE_AGENT) : ntok;
    __syncthreads();
    if (F.tid == 0) { int o = 0; for (int e = 0; e < NE1; ++e) { off[e] = o; o += (cnt[e] + 255) & ~255; } off[NE1] = o; }
    __syncthreads();
    const int gt = F.wg * NTHR + F.tid, NGT = F.G * NTHR;
    int* rowtok = (int*)(F.ws + WS_ROWTOK); int* rowdst = (int*)(F.ws + WS_ROWDST); int* tile_exp = (int*)(F.ws + WS_TILEEXP);
    const int* eidx = (const int*)(F.ws + WS_EIDX); const int* rnk = (const int*)(F.ws + WS_RNK);
    for (int a = gt; a < ntok * 8; a += NGT) { const int tok = a >> 3, k = a & 7; const int pos = off[eidx[a]] + rnk[a]; rowtok[pos] = tok; rowdst[pos] = tok * 10 + k; }
    for (int tok = gt; tok < ntok; tok += NGT) { const int pos = off[NEXP] + tok; rowtok[pos] = tok; rowdst[pos] = tok * 10 + 8; }
    for (int i = gt; i < NE1 * 256; i += NGT) { const int e = i >> 8, p = i & 255; const int row = off[e] + cnt[e] + p; if (row < off[e + 1]) { rowtok[row] = 0; rowdst[row] = -1; } }
    for (int i = gt; i < NE1 * 320; i += NGT) { const int e = i / 320, p = i % 320; const int t = (off[e] >> 8) + p; if (t < (off[e + 1] >> 8)) tile_exp[t] = e; }
    if (gt == 0) F.ctl[CW_NTL + l] = (unsigned)(off[NE1] >> 8);
}

#ifndef MK_MULTI
#define MK_MULTI 0
#endif
constexpr int PH_PER_LAYER = 12, NPHASE = 2 + DEPTH * PH_PER_LAYER;
struct Args { const float* in[36]; float* out; unsigned char* ws; int ph_lo, ph_hi; };

__global__ void __launch_bounds__(NTHR, 2) mk_fwd(Args args) {
    extern __shared__ __attribute__((aligned(16))) unsigned char lds_raw[];
    Frame F;
    F.lds = (LAS unsigned char*)lds_raw;
    F.tid = threadIdx.x; F.lane = F.tid & 63; F.wave = __builtin_amdgcn_readfirstlane(F.tid >> 6);
    const int wave0 = F.wave;
    F.G = gridDim.x; F.wg = blockIdx.x;
    F.in = args.in;
    F.out = args.out; F.ws = args.ws; F.ctl = (unsigned*)(args.ws + WS_CTL);
    volatile LAS unsigned* MISC = (volatile LAS unsigned*)(F.lds + MISC_OFF);
    if (F.tid < 32) MISC[F.tid] = 0u;
    __syncthreads();
    const int lo = args.ph_lo, hi = args.ph_hi;
    const bool single = (hi - lo) > 1;
    XcdBarrier bar; bar.bar = F.ctl + CW_BAR; bar.x = 0; bar.st = nullptr;
    if (single) bar = xcd_barrier_post(F.ctl + CW_BAR, MISC + 8);
#define IN(k) (lo <= (k) && (k) < hi)
#ifndef PROBE_MASK
#define PROBE_MASK 0
#endif
#define REP(k) for (int _rep = 0; _rep < (((PROBE_MASK >> (k)) & 1) ? 2 : 1); ++_rep)
#define SEAM(k) do { if (IN(k) && IN((k) + 1)) { xcd_barrier(bar); if ((PROBE_MASK >> 15) & 1) xcd_barrier(bar); } } while (0)
#define FRESH() do { int _ln; asm volatile("v_mbcnt_lo_u32_b32 %0, -1, 0\n\tv_mbcnt_hi_u32_b32 %0, -1, %0" : "=v"(_ln)); int _wv = wave0; asm volatile("" : "+s"(_wv)); F.lane = _ln; F.wave = _wv; F.tid = (_wv << 6) | _ln; \
        unsigned char* _w = args.ws; asm volatile("" : "+s"(_w)); F.ws = _w; F.ctl = (unsigned*)(_w + WS_CTL); float* _o = args.out; asm volatile("" : "+s"(_o)); F.out = _o; } while (0)

    if (IN(0)) { FRESH(); REP(13) { p0_static_weights(F); __syncthreads(); } REP(14) { p0_mod(F); __syncthreads(); } FRESH(); REP(16) { p0_hyena_filters(F); __syncthreads(); } }
    SEAM(0);
    if (IN(1)) { FRESH(); p0_init_rows(F); __syncthreads(); FRESH(); p1_router_weights(F); }
    SEAM(1);
#pragma unroll 1
    for (int l = 0; l < DEPTH; ++l) {
        const int pb = 2 + l * PH_PER_LAYER; const bool last = (l == DEPTH - 1); const int ntok = last ? NLAT : NROW;
        if (IN(pb + 0)) { FRESH();
            REP(0) { p_expert_weights(F, l); __syncthreads(); }
            pg8::DenseOrder S; S.init(NROW, DIN, F.G, F.wg); pg8::EpiBf16 E{(bf16_t*)(F.ws + WS_U), DIN};
            REP(1) pg8::gemm_phase<pg8::EpiBf16, pg8::DenseOrder, false>(F.tid, F.lds, (const bf16_t*)(F.ws + WS_XM), (const bf16_t*)(F.ws + WS_WIN) + (size_t)l * DIN * DM, DM, nullptr, S, E);
        }
        SEAM(pb + 0);
        if (IN(pb + 1)) { FRESH(); REP(2) { ph_transposes(F, l); __syncthreads(); } FRESH(); REP(3) { ph_gla_local(F, l); __syncthreads(); } }
        SEAM(pb + 1);
        if (IN(pb + 2)) { FRESH(); REP(4) { ph_na(F, l, last); } FRESH(); REP(5) { ph_gla_scan(F); } __syncthreads(); FRESH(); REP(6) { ph_hyena(F, l, last); } }
        SEAM(pb + 2);
        if (IN(pb + 3)) { FRESH(); ph_hy_transpose(F, last); __syncthreads(); FRESH(); REP(7) { ph_gla_out(F, l, last); } }
        SEAM(pb + 3);
        if (IN(pb + 4)) { FRESH();
            pg8::DenseOrder S; S.init(ntok, DM, F.G, F.wg); pg8::EpiY8 E{(unsigned char*)(F.ws + WS_Y), DM};
            REP(8) pg8::gemm_phase<pg8::EpiY8, pg8::DenseOrder, false>(F.tid, F.lds, (const bf16_t*)(F.ws + WS_MIX), (const bf16_t*)(F.ws + WS_WOUT) + (size_t)l * DM * DM, DM, nullptr, S, E);
        }
        SEAM(pb + 4);
        if (IN(pb + 5)) { FRESH(); ph_ln1(F, l, ntok); }
        SEAM(pb + 5);
        if (IN(pb + 6)) { FRESH();
            pg8::RouterOrder S; S.b.init(ntok, 256, F.G, F.wg); pg8::EpiF32H E{(float*)(F.ws + WS_LOGIT), 256};
            REP(9) pg8::gemm_phase<pg8::EpiF32H, pg8::RouterOrder, false, false, true, true, true>(F.tid, F.lds, (const bf16_t*)(F.ws + WS_XR), (const bf16_t*)(F.ws + WS_WRB) + (size_t)l * 17 * 128 * DM, DM, nullptr, S, E);
        }
        SEAM(pb + 6);
        if (IN(pb + 7)) { FRESH(); ph_route(F, l, ntok); }
        SEAM(pb + 7);
        if (IN(pb + 8)) { FRESH(); REP(12) { ph_positions(F, l, ntok); __syncthreads(); } }
        SEAM(pb + 8);
        if (IN(pb + 9)) { FRESH();
            const int ntl = (int)__hip_atomic_load(F.ctl + CW_NTL + l, __ATOMIC_RELAXED, __HIP_MEMORY_SCOPE_AGENT);
            pg8::GroupedOrder S; S.init(ntl, 2, F.G, F.wg); S.preload((const int*)(F.ws + WS_TILEEXP), F.lds + pg8::STAGE_BYTES + 4096, F.tid, NTHR); pg8::EpiSwiglu E{(unsigned char*)(F.ws + WS_ACT)};
            REP(10) pg8::gemm_phase<pg8::EpiSwiglu, pg8::GroupedOrder, true, true>(F.tid, F.lds, (const void*)(F.ws + WS_XM8), (const void*)(F.ws + WS_EXP1), DM, (const int*)(F.ws + WS_ROWTOK), S, E);
        }
        SEAM(pb + 9);
        if (IN(pb + 10)) { FRESH();
            const int ntl = (int)__hip_atomic_load(F.ctl + CW_NTL + l, __ATOMIC_RELAXED, __HIP_MEMORY_SCOPE_AGENT);
            pg8::GroupedOrder S; S.init(ntl, 4, F.G, F.wg); S.preload((const int*)(F.ws + WS_TILEEXP), F.lds + pg8::STAGE_BYTES + 4096, F.tid, NTHR); pg8::EpiScatter E{(unsigned char*)(F.ws + WS_Y2), (const int*)(F.ws + WS_ROWDST)};
            REP(11) pg8::gemm_phase<pg8::EpiScatter, pg8::GroupedOrder, false, true>(F.tid, F.lds, (const void*)(F.ws + WS_ACT), (const void*)(F.ws + WS_EXP2), EH, nullptr, S, E);
        }
        SEAM(pb + 10);
        if (IN(pb + 11)) { FRESH(); ph_ln2(F, l, ntok, last); }
        SEAM(pb + 11);
    }
#undef IN
#undef SEAM
#undef FRESH
}

extern "C" void kernel_launch(void* const* d_in, const int* in_sizes, int n_in, void* d_out, int out_size, void* d_ws, size_t ws_size, hipStream_t stream) {
    static int grid = 0;
    if (grid == 0) {
        if (n_in != 36 || out_size != NLAT * DM || ws_size < WS_END) { fprintf(stderr, "kernel_launch: unexpected shapes (n_in %d out %d ws %zu need %zu)\n", n_in, out_size, ws_size, (size_t)WS_END); grid = -1; return; }
        int dev = 0, cus = 0, per_cu = 0;
        if (hipGetDevice(&dev) != hipSuccess || hipDeviceGetAttribute(&cus, hipDeviceAttributeMultiprocessorCount, dev) != hipSuccess) { grid = -1; return; }
        if (hipFuncSetAttribute((const void*)mk_fwd, hipFuncAttributeMaxDynamicSharedMemorySize, LDS_BYTES) != hipSuccess) { fprintf(stderr, "kernel_launch: hipFuncSetAttribute failed\n"); grid = -1; return; }
        if (hipOccupancyMaxActiveBlocksPerMultiprocessor(&per_cu, (const void*)mk_fwd, NTHR, LDS_BYTES) != hipSuccess || per_cu < 1) { fprintf(stderr, "kernel_launch: occupancy query says %d\n", per_cu); }
        (void)hipGetLastError();
        grid = cus;
    }
    if (grid < 0) return;
    (void)hipMemsetAsync((char*)d_ws + WS_CTL, 0, CTL_BYTES, stream);
    Args a{};
    for (int i = 0; i < 36; ++i) a.in[i] = (const float*)d_in[i];
    a.out = (float*)d_out; a.ws = (unsigned char*)d_ws;
#if MK_MULTI
    for (int p = 0; p < NPHASE; ++p) { a.ph_lo = p; a.ph_hi = p + 1; hipLaunchKernelGGL(mk_fwd, dim3(grid), dim3(NTHR), LDS_BYTES, stream, a); }
#else
    a.ph_lo = 0; a.ph_hi = NPHASE; hipLaunchKernelGGL(mk_fwd, dim3(grid), dim3(NTHR), LDS_BYTES, stream, a);
#endif
}
```

```cpp
#include <hip/hip_runtime.h>
#include <cstdio>
#include <cstdint>

#define LAS __attribute__((address_space(3)))
#define GAS __attribute__((address_space(1)))
typedef unsigned short bf16_t;
typedef short bf16x8 __attribute__((ext_vector_type(8)));
typedef float f32x4 __attribute__((ext_vector_type(4)));
typedef float f32x2 __attribute__((ext_vector_type(2)));
typedef unsigned u32x4 __attribute__((ext_vector_type(4)));
typedef unsigned u32x2 __attribute__((ext_vector_type(2)));

constexpr int NB = 16, SEQ = 4096, CTXL = 256, DM = 1024, DEPTH = 4;
constexpr int NLAT = NB * SEQ;
constexpr int NCTX = NB * CTXL;
constexpr int NROW = NLAT + NCTX;
constexpr int SPB = SEQ + CTXL;
constexpr int DIN_REF = 3104;
constexpr int DIN = 3328;
constexpr int UQ = 0, UK = 512, UV = 1024, UGQ = 1536, UGK = 1664, UGV = 1792, UGR = 2048, UHY = 2304, ULAF = 3072, ULAB = 3200;
constexpr int NEXP = 128, TOPK = 8, EH = 256;
constexpr int NE1 = NEXP + 1;
constexpr int RMAX = 659712;
constexpr int TMAX = RMAX / 256;
constexpr float LN_EPS = 1e-6f;
constexpr float DN_ALPHA = 1.6817928305074290f;

__device__ __forceinline__ unsigned f2bf(float f) { unsigned u = __builtin_bit_cast(unsigned, f); return (u + 0x7fffu + ((u >> 16) & 1u)) >> 16; }
typedef __bf16 bf16v2 __attribute__((ext_vector_type(2)));
__device__ __forceinline__ unsigned pk2(float lo, float hi) { const f32x2 v = {lo, hi}; const bf16v2 b = __builtin_convertvector(v, bf16v2); return __builtin_bit_cast(unsigned, b); }
__device__ __forceinline__ float bf2f(unsigned short b) { return __builtin_bit_cast(float, ((unsigned)b) << 16); }
__device__ __forceinline__ float bflo(unsigned w) { return __builtin_bit_cast(float, w << 16); }
__device__ __forceinline__ float bfhi(unsigned w) { return __builtin_bit_cast(float, w & 0xffff0000u); }
__device__ __forceinline__ float shx(float v, int o, int lane) { return __builtin_bit_cast(float, __builtin_amdgcn_ds_bpermute((lane ^ o) << 2, __builtin_bit_cast(int, v))); }
__device__ __forceinline__ int shxi(int v, int o, int lane) { return __builtin_amdgcn_ds_bpermute((lane ^ o) << 2, v); }
__device__ __forceinline__ float shf(float v, int src) { return __builtin_bit_cast(float, __builtin_amdgcn_ds_bpermute(src << 2, __builtin_bit_cast(int, v))); }
__device__ __forceinline__ float wave_sum(float v, int lane) {
#pragma unroll
    for (int o = 1; o < 64; o <<= 1) v += shx(v, o, lane);
    return v;
}
__device__ __forceinline__ void unpack8(const u32x4 q, float* o) { o[0] = bflo(q.x); o[1] = bfhi(q.x); o[2] = bflo(q.y); o[3] = bfhi(q.y); o[4] = bflo(q.z); o[5] = bfhi(q.z); o[6] = bflo(q.w); o[7] = bfhi(q.w); }
__device__ __forceinline__ float silu_f(float x) { return x * __builtin_amdgcn_rcpf(1.0f + __expf(-x)); }
#define LDS_WAIT() asm volatile("s_waitcnt lgkmcnt(0)" ::: "memory")
#define VM_WAIT() asm volatile("s_waitcnt vmcnt(0)" ::: "memory")

#define XB_TMO      128
#define XB_XCNT(j)  (256  + 64 * (j))
#define XB_XSUB(j)  (1280 + 64 * (j))
#define XB_XGEN(j)  (2304 + 64 * (j))
#define XB_TOP      3328
#define XB_TOPGEN   3392
#define XCD_BAR_WORDS 3456
#define XB_SPIN_CAP (1u << 18)

__device__ __forceinline__ unsigned xb_ld(unsigned* p)              { return __hip_atomic_load(p, __ATOMIC_RELAXED, __HIP_MEMORY_SCOPE_AGENT); }
__device__ __forceinline__ unsigned xb_add(unsigned* p, unsigned v) { return __hip_atomic_fetch_add(p, v, __ATOMIC_RELAXED, __HIP_MEMORY_SCOPE_AGENT); }
__device__ __forceinline__ unsigned xb_xcc_id() { return (unsigned)__builtin_amdgcn_s_getreg((3 << 11) | 20) & 0xFu; }
#define XB_SPIN(cond, bar) do { unsigned _sp = 0; while (cond) { __builtin_amdgcn_s_sleep(1); \
    if ((++_sp & 255u) == 0u) { if (xb_ld(&(bar)[XB_TMO])) break; if (_sp > XB_SPIN_CAP) { atomicAdd(&(bar)[XB_TMO], 1u); break; } } } } while (0)

struct XcdBarrier { unsigned* bar; unsigned x; volatile LAS unsigned* st; };

__device__ __forceinline__ XcdBarrier xcd_barrier_post(unsigned* bar, volatile LAS unsigned* st) {
    XcdBarrier b; b.bar = bar; b.x = xb_xcc_id(); b.st = st;
    if (threadIdx.x == 0) (void)xb_add(&bar[XB_XCNT(b.x)], 1u);
    return b;
}
__device__ __forceinline__ void xcd_barrier_complete(unsigned* bar, unsigned x, unsigned& nloc, unsigned& nx) {
    const unsigned G = gridDim.x * gridDim.y * gridDim.z;
    unsigned sum, cnt, mine, sp = 0u;
    for (;;) {
        sum = 0u; cnt = 0u; mine = 0u;
#pragma unroll
        for (unsigned j = 0; j < 16; ++j) { const unsigned c = xb_ld(&bar[XB_XCNT(j)]); sum += c; cnt += (c > 0u) ? 1u : 0u; mine = (j == x) ? c : mine; }
        if (sum == G) break;
        __builtin_amdgcn_s_sleep(1);
        if ((++sp & 255u) == 0u) { if (xb_ld(&bar[XB_TMO])) break; if (sp > XB_SPIN_CAP) { atomicAdd(&bar[XB_TMO], 1u); break; } }
    }
    nloc = mine > 0u ? mine : 1u; nx = cnt > 0u ? cnt : 1u;
}
__device__ __forceinline__ void xcd_barrier(const XcdBarrier& b) {
    asm volatile("s_waitcnt vmcnt(0)" ::: "memory");
    __syncthreads();
    if (threadIdx.x == 0) {
        unsigned* bar = b.bar;
        __builtin_amdgcn_s_waitcnt(0);
        unsigned nloc = b.st[0], nx = b.st[1];
        if (nloc == 0u) { xcd_barrier_complete(bar, b.x, nloc, nx); b.st[0] = nloc; b.st[1] = nx; }
        const unsigned old = xb_add(&bar[XB_XSUB(b.x)], 1u);
        const unsigned gen = old / nloc;
        if (old + 1u == (gen + 1u) * nloc) {
            __builtin_amdgcn_fence(__ATOMIC_RELEASE, "agent");
            asm volatile("s_waitcnt vmcnt(0)" ::: "memory");
            const unsigned og = xb_add(&bar[XB_TOP], 1u);
            const unsigned tg = og / nx;
            if (og + 1u == (tg + 1u) * nx) xb_add(&bar[XB_TOPGEN], 1u);
            else XB_SPIN(xb_ld(&bar[XB_TOPGEN]) == tg, bar);
            __builtin_amdgcn_fence(__ATOMIC_ACQUIRE, "agent");
            xb_add(&bar[XB_XGEN(b.x)], 1u);
            asm volatile("s_waitcnt vmcnt(0)" ::: "memory");
        } else {
            XB_SPIN(xb_ld(&bar[XB_XGEN(b.x)]) == gen, bar);
            __builtin_amdgcn_fence(__ATOMIC_ACQUIRE, "agent");
            asm volatile("s_waitcnt vmcnt(0)" ::: "memory");
        }
    }
    __syncthreads();
}

namespace pg8 {
constexpr int BM = 256, BK = 64, HALF = 128, HTB = HALF * BK * 2, STAGE_BYTES = 8 * HTB, NXCD = 8, WGM = 8;
__host__ __device__ __forceinline__ int lds_byte(int r, int c) { const int st = (r >> 4) * 2 + (c >> 5), rr = r & 15, cc = c & 31, ob = rr * 64 + cc * 2; return st * 1024 + (ob ^ (((ob >> 9) & 1) << 5)); }
__host__ __device__ __forceinline__ void stage_rc(int b, int& R, int& C) { const int st = b / 1024, sb = b % 1024, swz = sb ^ (((sb >> 9) & 1) << 5); R = (st >> 1) * 16 + swz / 64; C = (st & 1) * 32 + (swz % 64) / 2; }
__host__ __device__ __forceinline__ int perm32(int rho) { const int n = rho >> 4, i = rho & 15; return 8 * (i >> 2) + 4 * n + (i & 3); }

struct Unit { int arow0, brow0, orow0, ocol0, aux; };

struct DenseOrder {
    int nM, nN, nwg, G, c;
    __device__ void init(int M, int N, int G_, int c_) { nM = M / BM; nN = N / BM; nwg = nM * nN; G = G_; c = c_; }
    __device__ __forceinline__ bool next(int i, Unit& u) const {
        const long L = (long)i * G + c; if (L >= nwg) return false;
        int wgid = (int)L; { const int q = nwg / NXCD, r = nwg % NXCD, xcd = wgid % NXCD, off = wgid / NXCD; wgid = (xcd < r ? xcd * (q + 1) : r * (q + 1) + (xcd - r) * q) + off; }
        const int nig = WGM * nN, gid = wgid / nig, fm = gid * WGM, gsz = (nM - fm) < WGM ? (nM - fm) : WGM;
        const int pm = fm + ((wgid % nig) % gsz), pn = (wgid % nig) / gsz;
        u.arow0 = pm * BM; u.brow0 = pn * BM; u.orow0 = pm * BM; u.ocol0 = pn * BM; u.aux = 0; return true;
    }
};
struct GroupedOrder {
    const LAS unsigned char* tab; int nN, nslot, slot, t0, t1;
    __device__ __forceinline__ void init(int ntiles, int nN_, int G, int c) {
        nN = nN_;
        if ((G & 7) == 0) { const int per = (ntiles + 7) >> 3, x = c & 7; nslot = G >> 3; slot = c >> 3; t0 = x * per; t1 = (t0 + per) < ntiles ? (t0 + per) : ntiles; }
        else { nslot = G; slot = c; t0 = 0; t1 = ntiles; }
    }
    __device__ __forceinline__ void preload(const int* tile_exp, LAS unsigned char* lds_tab, int tid, int nthr) {
        __syncthreads();
        for (int i = tid; i < t1 - t0; i += nthr) lds_tab[i] = (unsigned char)tile_exp[t0 + i];
        __syncthreads();
        tab = lds_tab;
    }
    __device__ __forceinline__ bool next(int i, Unit& u) const {
        const int q = i * nslot + slot, t = t0 + q / nN, pn = q % nN;
        if (t >= t1) return false;
        const int e = (int)tab[t - t0];
        u.arow0 = t * BM; u.brow0 = (e * nN + pn) * BM; u.orow0 = t * BM; u.ocol0 = pn * BM; u.aux = e; return true;
    }
};

struct RouterOrder {
    DenseOrder b;
    __device__ __forceinline__ bool next(int i, Unit& u) const { if (!b.next(i, u)) return false; const int pm = u.arow0 >> 8; u.brow0 = (pm < 256 ? (pm >> 4) : 16) * 128; return true; }
};
struct ColMapOrder {
    DenseOrder b; unsigned long long map;
    __device__ __forceinline__ bool next(int i, Unit& u) const { if (!b.next(i, u)) return false; const int ph = (int)((map >> ((u.ocol0 >> 8) * 4)) & 15ull); u.brow0 = ph * BM; u.ocol0 = ph * BM; return true; }
};
template <class Base> struct RangeOrder {
    Base b; int i0, i1;
    __device__ __forceinline__ bool next(int i, Unit& u) const { const int j = i + i0; if (j >= i1) return false; return b.next(j, u); }
};

__device__ __forceinline__ unsigned cvt_pk_bf16(float lo, float hi) { return pk2(lo, hi); }

struct NoPre {};
struct EpiF32 {
    static constexpr bool PERM = false; static constexpr int SCW = 0x7A7A7A7A; typedef NoPre Pre;
    __device__ __forceinline__ Pre prefetch(const Unit&, LAS unsigned char*, int, int, int) const { return Pre{}; }
    float* C; int ldc;
    __device__ __forceinline__ void operator()(const f32x4 (&acc)[2][2][4][2], const Unit& u, int wr, int wc, int fr, int fq, const Pre&, bool drain) const {
        if (drain) asm volatile("s_waitcnt vmcnt(0)" ::: "memory");
        const int row0 = u.orow0 + wr * 64 + fr, col0 = u.ocol0 + wc * 32 + 4 * fq;
#pragma unroll
        for (int ai = 0; ai < 2; ++ai)
#pragma unroll
            for (int m = 0; m < 4; ++m) { float* rowp = C + (size_t)(row0 + ai * HALF + m * 16) * ldc + col0;
#pragma unroll
                for (int bj = 0; bj < 2; ++bj)
#pragma unroll
                    for (int n = 0; n < 2; ++n) *(GAS f32x4*)(rowp + bj * HALF + n * 16) = acc[ai][bj][m][n]; }
    }
};
struct EpiF32H {
    static constexpr bool PERM = false; static constexpr int SCW = 0x7A7A7A7A; typedef NoPre Pre;
    __device__ __forceinline__ Pre prefetch(const Unit&, LAS unsigned char*, int, int, int) const { return Pre{}; }
    float* C; int ldc;
    __device__ __forceinline__ void operator()(const f32x4 (&acc)[2][2][4][2], const Unit& u, int wr, int wc, int fr, int fq, const Pre&, bool drain) const {
        if (drain) asm volatile("s_waitcnt vmcnt(0)" ::: "memory");
        const int row0 = u.orow0 + wr * 64 + fr, col0 = wc * 32 + 4 * fq;
#pragma unroll
        for (int ai = 0; ai < 2; ++ai)
#pragma unroll
            for (int m = 0; m < 4; ++m) { float* rowp = C + (size_t)(row0 + ai * HALF + m * 16) * ldc + col0;
#pragma unroll
                for (int n = 0; n < 2; ++n) *(GAS f32x4*)(rowp + n * 16) = acc[ai][0][m][n]; }
    }
};
struct EpiBf16 {
    static constexpr bool PERM = true; static constexpr int SCW = 0x7A7A7A7A; typedef NoPre Pre;
    __device__ __forceinline__ Pre prefetch(const Unit&, LAS unsigned char*, int, int, int) const { return Pre{}; }
    bf16_t* O; int ldc;
    __device__ __forceinline__ void operator()(const f32x4 (&acc)[2][2][4][2], const Unit& u, int wr, int wc, int fr, int fq, const Pre&, bool drain) const {
        const int row0 = u.orow0 + wr * 64 + fr, col0 = u.ocol0 + wc * 32 + 8 * fq;
        u32x4 w[2][4][2];
#pragma unroll
        for (int ai = 0; ai < 2; ++ai)
#pragma unroll
            for (int m = 0; m < 4; ++m)
#pragma unroll
                for (int bj = 0; bj < 2; ++bj) { const f32x4 v0 = acc[ai][bj][m][0], v1 = acc[ai][bj][m][1];
                    w[ai][m][bj].x = cvt_pk_bf16(v0[0], v0[1]); w[ai][m][bj].y = cvt_pk_bf16(v0[2], v0[3]); w[ai][m][bj].z = cvt_pk_bf16(v1[0], v1[1]); w[ai][m][bj].w = cvt_pk_bf16(v1[2], v1[3]); }
        if (drain) asm volatile("s_waitcnt vmcnt(0)" ::: "memory");
#pragma unroll
        for (int ai = 0; ai < 2; ++ai)
#pragma unroll
            for (int m = 0; m < 4; ++m) { bf16_t* rowp = O + (size_t)(row0 + ai * HALF + m * 16) * ldc + col0;
#pragma unroll
                for (int bj = 0; bj < 2; ++bj) *(GAS u32x4*)(rowp + bj * HALF) = w[ai][m][bj]; }
    }
};
struct EpiVT {
    static constexpr bool PERM = false; static constexpr int SCW = 0x7A7A7A7A; typedef NoPre Pre;
    __device__ __forceinline__ Pre prefetch(const Unit&, LAS unsigned char*, int, int, int) const { return Pre{}; }
    bf16_t* VT; int col_base;
    __device__ __forceinline__ void operator()(const f32x4 (&acc)[2][2][4][2], const Unit& u, int wr, int wc, int fr, int fq, const Pre&, bool drain) const {
        if (drain) asm volatile("s_waitcnt vmcnt(0)" ::: "memory");
        const int r0 = u.orow0; int b, pos0;
        if (r0 < NLAT) { b = r0 >> 12; pos0 = r0 & 4095; } else { b = (r0 - NLAT) >> 8; pos0 = SEQ + ((r0 - NLAT) & 255); }
        bf16_t* base = VT + ((size_t)b * 512 + (u.ocol0 - col_base) + wc * 32 + fr) * SPB + pos0 + wr * 64 + 4 * fq;
#pragma unroll
        for (int ai = 0; ai < 2; ++ai)
#pragma unroll
            for (int bj = 0; bj < 2; ++bj)
#pragma unroll
                for (int m = 0; m < 4; ++m)
#pragma unroll
                    for (int n = 0; n < 2; ++n) { const f32x4 v = acc[ai][bj][m][n];
                        *(GAS u32x2*)(base + (size_t)(bj * HALF + n * 16) * SPB + ai * HALF + m * 16) = (u32x2){cvt_pk_bf16(v[0], v[1]), cvt_pk_bf16(v[2], v[3])}; }
    }
};
struct EpiY8 {
    static constexpr bool PERM = true; static constexpr int SCW = 0x7A7A7A7A; typedef NoPre Pre;
    __device__ __forceinline__ Pre prefetch(const Unit&, LAS unsigned char*, int, int, int) const { return Pre{}; }
    unsigned char* O; int ldc;
    __device__ __forceinline__ void operator()(const f32x4 (&acc)[2][2][4][2], const Unit& u, int wr, int wc, int fr, int fq, const Pre&, bool drain) const {
        const int row0 = u.orow0 + wr * 64 + fr;
        u32x4 o[2][4];
#pragma unroll
        for (int ai = 0; ai < 2; ++ai)
#pragma unroll
            for (int m = 0; m < 4; ++m) { int w[4];
#pragma unroll
                for (int bj = 0; bj < 2; ++bj) { const f32x4 v0 = acc[ai][bj][m][0], v1 = acc[ai][bj][m][1];
                    int w0 = 0, w1 = 0;
                    w0 = __builtin_amdgcn_cvt_pk_fp8_f32(v0[0], v0[1], w0, false); w0 = __builtin_amdgcn_cvt_pk_fp8_f32(v0[2], v0[3], w0, true);
                    w1 = __builtin_amdgcn_cvt_pk_fp8_f32(v1[0], v1[1], w1, false); w1 = __builtin_amdgcn_cvt_pk_fp8_f32(v1[2], v1[3], w1, true);
                    w[2 * bj] = w0; w[2 * bj + 1] = w1; }
                o[ai][m] = (u32x4){(unsigned)w[0], (unsigned)w[1], (unsigned)w[2], (unsigned)w[3]}; }
        if (drain) asm volatile("s_waitcnt vmcnt(0)" ::: "memory");
#pragma unroll
        for (int ai = 0; ai < 2; ++ai)
#pragma unroll
            for (int m = 0; m < 4; ++m) *(GAS u32x4*)(O + (size_t)(row0 + ai * HALF + m * 16) * ldc + u.ocol0 + wc * 64 + fq * 16) = o[ai][m];
    }
};
struct EpiSwiglu {
    static constexpr bool PERM = true; static constexpr int SCW = 0x7A7A7A7A; typedef NoPre Pre;
    __device__ __forceinline__ Pre prefetch(const Unit&, LAS unsigned char*, int, int, int) const { return Pre{}; }
    unsigned char* ACT;
    __device__ __forceinline__ void operator()(const f32x4 (&acc)[2][2][4][2], const Unit& u, int wr, int wc, int fr, int fq, const Pre&, bool drain) const {
        const int row0 = u.orow0 + wr * 64 + fr, pn = u.ocol0 >> 8;
        u32x2 o[2][4];
#pragma unroll
        for (int ai = 0; ai < 2; ++ai)
#pragma unroll
            for (int m = 0; m < 4; ++m) {
                int w[2];
#pragma unroll
                for (int n = 0; n < 2; ++n) { const f32x4 g = acc[ai][0][m][n], up = acc[ai][1][m][n];
                    f32x4 e;
#pragma unroll
                    for (int i = 0; i < 4; ++i) e[i] = __builtin_amdgcn_exp2f(-g[i]);
                    const f32x4 d = e + 1.0f; f32x4 r;
#pragma unroll
                    for (int i = 0; i < 4; ++i) r[i] = __builtin_amdgcn_rcpf(d[i]);
                    const f32x4 h = (g * up) * r;
                    int v = 0; v = __builtin_amdgcn_cvt_pk_fp8_f32(h[0], h[1], v, false); v = __builtin_amdgcn_cvt_pk_fp8_f32(h[2], h[3], v, true); w[n] = v; }
                o[ai][m] = (u32x2){(unsigned)w[0], (unsigned)w[1]}; }
        if (drain) asm volatile("s_waitcnt vmcnt(0)" ::: "memory");
#pragma unroll
        for (int ai = 0; ai < 2; ++ai)
#pragma unroll
            for (int m = 0; m < 4; ++m) *(GAS u32x2*)(ACT + (size_t)(row0 + ai * HALF + m * 16) * EH + pn * 128 + wc * 32 + 8 * fq) = o[ai][m];
    }
};
constexpr float Y2_SCALE = 8.0f, Y2_INV = 1.0f / 8.0f;
struct EpiScatter {
    static constexpr bool PERM = true; static constexpr int SCW = 0x7D7D7D7D;
    struct Pre { const LAS int* tab; };
    unsigned char* Y2; const int* rowdst;
    __device__ __forceinline__ Pre prefetch(const Unit& u, LAS unsigned char* lds, int wid, int lane, int ui) const {
        LAS unsigned char* tab = lds + STAGE_BYTES + (ui & 1) * 1024;
        if (wid < 4) __builtin_amdgcn_global_load_lds((const unsigned*)(rowdst + u.orow0 + wid * 64 + lane), (LAS unsigned*)(tab + wid * 256), 4, 0, 0);
        Pre p; p.tab = (const LAS int*)tab; return p; }
    __device__ __forceinline__ void operator()(const f32x4 (&acc)[2][2][4][2], const Unit& u, int wr, int wc, int fr, int fq, const Pre& pre, bool drain) const {
        if (u.aux == 128) {
            u32x4 o[2][4];
#pragma unroll
            for (int ai = 0; ai < 2; ++ai)
#pragma unroll
                for (int m = 0; m < 4; ++m) { int w[4];
#pragma unroll
                    for (int bj = 0; bj < 2; ++bj) { const f32x4 v0 = acc[ai][bj][m][0], v1 = acc[ai][bj][m][1];
                        int w0 = 0, w1 = 0;
                        w0 = __builtin_amdgcn_cvt_pk_fp8_f32(v0[0], v0[1], w0, false); w0 = __builtin_amdgcn_cvt_pk_fp8_f32(v0[2], v0[3], w0, true);
                        w1 = __builtin_amdgcn_cvt_pk_fp8_f32(v1[0], v1[1], w1, false); w1 = __builtin_amdgcn_cvt_pk_fp8_f32(v1[2], v1[3], w1, true);
                        w[2 * bj] = w0; w[2 * bj + 1] = w1; }
                    o[ai][m] = (u32x4){(unsigned)w[0], (unsigned)w[1], (unsigned)w[2], (unsigned)w[3]}; }
            if (drain) asm volatile("s_waitcnt vmcnt(0)" ::: "memory");
#pragma unroll
            for (int ai = 0; ai < 2; ++ai)
#pragma unroll
                for (int m = 0; m < 4; ++m) { const int dst = pre.tab[wr * 64 + fr + ai * HALF + m * 16];
                    if (dst >= 0) *(GAS u32x4*)(Y2 + (size_t)dst * 512 + u.ocol0 + wc * 64 + fq * 16) = o[ai][m]; }
        } else {
            u32x2 o[2][4];
#pragma unroll
            for (int ai = 0; ai < 2; ++ai)
#pragma unroll
                for (int m = 0; m < 4; ++m) { unsigned w[2];
#pragma unroll
                    for (int bj = 0; bj < 2; ++bj) { const f32x4 v0 = acc[ai][bj][m][0], v1 = acc[ai][bj][m][1];
                        unsigned x = 0u;
                        x = __builtin_amdgcn_cvt_scalef32_pk_fp4_f32(x, v0[0], v0[1], 1.0f, 0); x = __builtin_amdgcn_cvt_scalef32_pk_fp4_f32(x, v0[2], v0[3], 1.0f, 1);
                        x = __builtin_amdgcn_cvt_scalef32_pk_fp4_f32(x, v1[0], v1[1], 1.0f, 2); x = __builtin_amdgcn_cvt_scalef32_pk_fp4_f32(x, v1[2], v1[3], 1.0f, 3);
                        w[bj] = x; }
                    o[ai][m] = (u32x2){w[0], w[1]}; }
            if (drain) asm volatile("s_waitcnt vmcnt(0)" ::: "memory");
#pragma unroll
            for (int ai = 0; ai < 2; ++ai)
#pragma unroll
                for (int m = 0; m < 4; ++m) { const int dst = pre.tab[wr * 64 + fr + ai * HALF + m * 16];
                    if (dst >= 0) *(GAS u32x2*)(Y2 + (size_t)dst * 512 + (u.ocol0 >> 1) + wc * 32 + fq * 8) = o[ai][m]; }
        }
    }
};

typedef int v8i __attribute__((ext_vector_type(8)));
typedef int v4i __attribute__((ext_vector_type(4)));
struct Frag { bf16x8 p[2]; __device__ __forceinline__ bf16x8& operator[](int k) { return p[k]; } __device__ __forceinline__ const bf16x8& operator[](int k) const { return p[k]; } };
template <class Epi, class Sched, bool GATHER, bool F8 = false, bool ALIGN_EPI = true, bool SP2 = true, bool NHALF = false, bool SWAP = false>
__device__ __forceinline__ void gemm_phase(const int tid_in, LAS unsigned char* lds, const void* Ag, const void* Bg, const int K, const int* rowidx, const Sched& S, const Epi& E) {
    int tid_ = tid_in; asm volatile("" : "+v"(tid_));
    const int tid = tid_, wid = __builtin_amdgcn_readfirstlane(tid >> 6), lane = tid & 63, wr = wid >> 2, wc = wid & 3, fr = lane & 15, fq = lane >> 4;
    const int KB = F8 ? K : 2 * K;
    const int nt = KB / 128;
    unsigned voffB[2];
#pragma unroll
    for (int i = 0; i < 2; ++i) { int R, C; stage_rc(tid * 16 + i * 8192, R, C); const int Rb = Epi::PERM ? ((R & ~31) + perm32(R & 31)) : R;
        voffB[i] = (unsigned)(Rb * KB + C * 2); }
    const size_t kstep = (size_t)128;
    const size_t hstep = (size_t)HALF * KB;
    const unsigned ldsw = (unsigned)wid * 1024u;
    const int aoff = F8 ? lds_byte(wr * 64 + fr, 16 * fq) : lds_byte(wr * 64 + fr, fq * 8), boff = F8 ? lds_byte(wc * 32 + fr, 16 * fq) : lds_byte(wc * 32 + fr, fq * 8);
    constexpr int PIECE1 = F8 ? 16 : 1024;
    const int sc_w = Epi::SCW, sc_a = 0x7F7F7F7F;
#define PG8_SA(b, h) (((b) * 2 + (h)) * HTB)
#define PG8_SB(b, h) ((4 + (b) * 2 + (h)) * HTB)
#define PG8_STAGE_B(bufoff, gbase) do { _Pragma("unroll") for (int _i = 0; _i < 2; ++_i) \
        __builtin_amdgcn_global_load_lds((const unsigned*)((const char*)(gbase) + voffB[_i]), (LAS unsigned*)(lds + (bufoff) + ldsw + _i * 8192), 16, 0, 0); } while (0)
#define PG8_STAGE_A(bufoff, gbase, h) do { const char* _gb = (const char*)(gbase) + (GATHER ? (size_t)0 : (size_t)(h) * hstep); \
        __builtin_amdgcn_global_load_lds((const unsigned*)(_gb + ac[GATHER ? (h) : 0][0]), (LAS unsigned*)(lds + (bufoff) + ldsw), 16, 0, 0); \
        __builtin_amdgcn_global_load_lds((const unsigned*)(_gb + ac[GATHER ? (h) : 0][1]), (LAS unsigned*)(lds + (bufoff) + ldsw + 8192), 16, 0, 0); } while (0)
#define PG8_LDA(dst, b, h) do { _Pragma("unroll") for (int m = 0; m < 4; ++m) { if constexpr (F8) { const v4i _l = *(const LAS v4i*)(lds + PG8_SA(b, h) + aoff + m * 2048), _h = *(const LAS v4i*)(lds + PG8_SA(b, h) + aoff + m * 2048 + PIECE1); dst##8[m] = __builtin_shufflevector(_l, _h, 0, 1, 2, 3, 4, 5, 6, 7); } \
        else { dst[m][0] = *(const LAS bf16x8*)(lds + PG8_SA(b, h) + aoff + m * 2048); dst[m][1] = *(const LAS bf16x8*)(lds + PG8_SA(b, h) + aoff + m * 2048 + PIECE1); } } } while (0)
#define PG8_LDB(dst, b, h) do { _Pragma("unroll") for (int n = 0; n < 2; ++n) { if constexpr (F8) { const v4i _l = *(const LAS v4i*)(lds + PG8_SB(b, h) + boff + n * 2048), _h = *(const LAS v4i*)(lds + PG8_SB(b, h) + boff + n * 2048 + PIECE1); dst##8[n] = __builtin_shufflevector(_l, _h, 0, 1, 2, 3, 4, 5, 6, 7); } \
        else { dst[n][0] = *(const LAS bf16x8*)(lds + PG8_SB(b, h) + boff + n * 2048); dst[n][1] = *(const LAS bf16x8*)(lds + PG8_SB(b, h) + boff + n * 2048 + PIECE1); } } } while (0)
#define PG8_MMA(ai, bj, At, Bt) do { __builtin_amdgcn_s_setprio(1); _Pragma("unroll") for (int m = 0; m < 4; ++m) _Pragma("unroll") for (int n = 0; n < 2; ++n) { \
        if constexpr (F8) asm volatile("v_mfma_scale_f32_16x16x128_f8f6f4 %0, %1, %2, %0, %3, %4 op_sel_hi:[0,0,0]" : "+v"(acc[ai][bj][m][n]) : "v"(Bt##8[n]), "v"(At##8[m]), "v"(sc_w), "v"(sc_a)); \
        else { _Pragma("unroll") for (int k = 0; k < 2; ++k) acc[ai][bj][m][n] = SWAP ? __builtin_amdgcn_mfma_f32_16x16x32_bf16(At[m][k], Bt[n][k], acc[ai][bj][m][n], 0, 0, 0) : __builtin_amdgcn_mfma_f32_16x16x32_bf16(Bt[n][k], At[m][k], acc[ai][bj][m][n], 0, 0, 0); } } \
        __builtin_amdgcn_s_setprio(0); } while (0)
#define PG8_WAIT_V(n) asm volatile("s_waitcnt vmcnt(" #n ")" ::: "memory")
#define PG8_WAIT_LOOP do { if constexpr (NHALF) PG8_WAIT_V(6); else PG8_WAIT_V(8); } while (0)
#define PG8_WAIT_L(n) asm volatile("s_waitcnt lgkmcnt(" #n ")" ::: "memory")
#define PG8_BAR __builtin_amdgcn_s_barrier()
#define PG8_SCHED __builtin_amdgcn_sched_barrier(0)
#define PG8_TAB(par) (lds + STAGE_BYTES + 2048 + (par) * 1024)
#define PG8_TABLOAD(par, row0) do { if (wid < 4) __builtin_amdgcn_global_load_lds((const unsigned*)(rowidx + (row0) + wid * 64 + lane), (LAS unsigned*)(PG8_TAB(par) + wid * 256), 4, 0, 0); } while (0)
#define PG8_AOFF_H(h, par) do { int _tz = tid; asm volatile("" : "+v"(_tz)); _Pragma("unroll") for (int _i = 0; _i < 2; ++_i) { int _R, _C; stage_rc(_tz * 16 + _i * 8192, _R, _C); \
        if (GATHER) ac[h][_i] = ((const LAS unsigned*)PG8_TAB(par))[(h) * HALF + _R] * (unsigned)KB + (unsigned)_C * 2u; \
        else ac[h][_i] = (unsigned)(((h) * HALF + _R) * KB) + (unsigned)_C * 2u; } } while (0)
    static_assert(SP2, "only the two-super-phase K-loop is kept");
    Unit cur, nxt; int ui = 0;
    if (!S.next(0, cur)) return;
    f32x4 acc[2][2][4][2];
#pragma unroll
    for (int a = 0; a < 2; ++a)
#pragma unroll
        for (int b = 0; b < 2; ++b)
#pragma unroll
            for (int m = 0; m < 4; ++m)
#pragma unroll
                for (int n = 0; n < 2; ++n) acc[a][b][m][n] = (f32x4){0.f, 0.f, 0.f, 0.f};
    bf16x8 At[F8 ? 1 : 4][2], B0[F8 ? 1 : 2][2], B1[F8 ? 1 : 2][2];
    v8i At8[F8 ? 4 : 1], B08[F8 ? 2 : 1], B18[F8 ? 2 : 1];
    unsigned ac[GATHER ? 2 : 1][2];
    if (GATHER) { PG8_TABLOAD(0, cur.arow0); PG8_WAIT_V(0); PG8_BAR; }
    PG8_AOFF_H(0, 0); if (GATHER) { PG8_AOFF_H((GATHER ? 1 : 0), 0); }
    const char* cA = (const char*)Ag + (GATHER ? (size_t)0 : (size_t)cur.arow0 * KB); const char* cB = (const char*)Bg + (size_t)cur.brow0 * KB;
    PG8_STAGE_B(PG8_SB(0, 0), cB); if constexpr (!NHALF) PG8_STAGE_B(PG8_SB(0, 1), cB + hstep); PG8_STAGE_A(PG8_SA(0, 0), cA, 0); PG8_STAGE_A(PG8_SA(0, 1), cA, 1);
    if (wr == 1) PG8_BAR;
    PG8_WAIT_V(2); PG8_BAR;
    PG8_STAGE_B(PG8_SB(1, 0), cB + kstep); PG8_STAGE_A(PG8_SA(1, 0), cA + kstep, 0); if constexpr (!NHALF) PG8_STAGE_B(PG8_SB(1, 1), cB + hstep + kstep);
    if constexpr (NHALF) PG8_WAIT_V(4); else PG8_WAIT_V(6);
    PG8_BAR;
    for (;;) {
        const typename Epi::Pre pre = E.prefetch(cur, lds, wid, lane, ui);
        const bool has_next = S.next(ui + 1, nxt);
        if (GATHER) { if (has_next) PG8_TABLOAD((ui + 1) & 1, nxt.arow0); }
        const char* nA = has_next ? ((const char*)Ag + (GATHER ? (size_t)0 : (size_t)nxt.arow0 * KB)) : cA; const char* nB = has_next ? (const char*)Bg + (size_t)nxt.brow0 * KB : cB;
_Pragma("nounroll")
        for (int t = 0; t < nt; t += 2) {
            const bool last = (t == nt - 2);
            const bool skipw = (t == 0) && (ui > 0);
            const char* a1 = cA + (size_t)(t + 1) * kstep;
            const char* a2 = last ? nA : cA + (size_t)(t + 2) * kstep; const char* b2 = last ? nB : cB + (size_t)(t + 2) * kstep;
            const char* a3 = a2 + kstep; const char* b3 = b2 + kstep;
            if (GATHER) { if (last && has_next) { PG8_AOFF_H(0, (ui + 1) & 1); } }
            PG8_LDB(B0, 0, 0); if constexpr (!NHALF) PG8_LDB(B1, 0, 1); PG8_SCHED; PG8_LDA(At, 0, 0); PG8_STAGE_A(PG8_SA(1, 1), a1, 1);
            if (!skipw) PG8_WAIT_LOOP; PG8_WAIT_L(0); PG8_BAR; PG8_MMA(0, 0, At, B0); if constexpr (!NHALF) PG8_MMA(0, 1, At, B1); PG8_BAR; PG8_SCHED;
            if (GATHER) { if (last && has_next) { PG8_AOFF_H(1, (ui + 1) & 1); } }
            PG8_LDA(At, 0, 1); PG8_STAGE_B(PG8_SB(0, 0), b2); if constexpr (!NHALF) PG8_STAGE_B(PG8_SB(0, 1), b2 + hstep); PG8_STAGE_A(PG8_SA(0, 0), a2, 0);
            if (!skipw) PG8_WAIT_LOOP; PG8_WAIT_L(0); PG8_BAR; PG8_MMA(1, 0, At, B0); if constexpr (!NHALF) PG8_MMA(1, 1, At, B1); PG8_BAR; PG8_SCHED;
            PG8_LDB(B0, 1, 0); if constexpr (!NHALF) PG8_LDB(B1, 1, 1); PG8_SCHED; PG8_LDA(At, 1, 0); PG8_STAGE_A(PG8_SA(0, 1), a2, 1);
            if (!skipw) PG8_WAIT_LOOP; PG8_WAIT_L(0); PG8_BAR; PG8_MMA(0, 0, At, B0); if constexpr (!NHALF) PG8_MMA(0, 1, At, B1); PG8_BAR; PG8_SCHED;
            PG8_LDA(At, 1, 1); PG8_STAGE_B(PG8_SB(1, 0), b3); if constexpr (!NHALF) PG8_STAGE_B(PG8_SB(1, 1), b3 + hstep); PG8_STAGE_A(PG8_SA(1, 0), a3, 0);
            PG8_WAIT_LOOP; PG8_WAIT_L(0); PG8_BAR; PG8_MMA(1, 0, At, B0); if constexpr (!NHALF) PG8_MMA(1, 1, At, B1); PG8_BAR; PG8_SCHED;
        }
        if constexpr (ALIGN_EPI) { if (wr == 0) PG8_BAR; }
        E(acc, cur, wr, wc, fr, fq, pre, has_next);
        if (!has_next) break;
#pragma unroll
        for (int a = 0; a < 2; ++a)
#pragma unroll
            for (int b = 0; b < 2; ++b)
#pragma unroll
                for (int m = 0; m < 4; ++m)
#pragma unroll
                    for (int n = 0; n < 2; ++n) acc[a][b][m][n] = (f32x4){0.f, 0.f, 0.f, 0.f};
        cur = nxt; cA = nA; cB = nB; ++ui;
        if constexpr (ALIGN_EPI) { if (wr == 1) PG8_BAR; }
    }
    PG8_WAIT_V(0);
    if constexpr (!ALIGN_EPI) { if (wr == 0) PG8_BAR; }
    PG8_BAR;
#undef PG8_SA
#undef PG8_SB
#undef PG8_STAGE_A
#undef PG8_STAGE_B
#undef PG8_LDA
#undef PG8_LDB
#undef PG8_MMA
#undef PG8_WAIT_V
#undef PG8_WAIT_L
#undef PG8_WAIT_LOOP
#undef PG8_BAR
#undef PG8_SCHED
#undef PG8_AOFF_H
#undef PG8_TAB
#undef PG8_TABLOAD
}
}

constexpr int NWAVES = 8, NTHR = 512;
constexpr size_t MiB = 1u << 20;
constexpr size_t WS_CTL = 0, CTL_BYTES = 1 * MiB;
constexpr size_t WS_MOD = 1 * MiB;
constexpr size_t WS_WIN = 3 * MiB;
constexpr size_t WS_WOUT = 29 * MiB;
constexpr size_t WS_WR = 37 * MiB;
constexpr size_t WS_HYF = 39 * MiB;
constexpr size_t WS_HYFC = 71 * MiB;
constexpr size_t WS_XC = 73 * MiB;
constexpr size_t WS_EXP1 = 89 * MiB;
constexpr size_t WS_EXP2 = 218 * MiB;
constexpr size_t WS_XM = 283 * MiB;
constexpr size_t WS_EIDX = 419 * MiB;
constexpr size_t WS_WGT = 422 * MiB;
constexpr size_t WS_RNK = 425 * MiB;
constexpr size_t WS_ROWTOK = 428 * MiB;
constexpr size_t WS_ROWDST = 431 * MiB;
constexpr size_t WS_TILEEXP = 434 * MiB;
constexpr size_t WS_BIG = 435 * MiB;
constexpr size_t WS_U = WS_BIG;
constexpr size_t WS_MIX = 877 * MiB;
constexpr size_t WS_VT = 1013 * MiB;
constexpr size_t WS_HV = 1081 * MiB;
constexpr size_t WS_Z2 = 1183 * MiB;
constexpr size_t WS_GDS = 1217 * MiB;
constexpr size_t WS_GSIN = 1285 * MiB;
constexpr size_t WS_GD = 1319 * MiB;
constexpr size_t WS_Y = 1321 * MiB;
constexpr size_t WS_LOGIT = WS_BIG;
constexpr size_t WS_ACT = WS_BIG;
constexpr size_t WS_Y2 = 758 * MiB;
constexpr size_t WS_XM8 = 1470 * MiB;
constexpr size_t WS_WRB = 1540 * MiB;
constexpr size_t WS_RBIAS = 1558 * MiB;
constexpr size_t WS_XR = 1600 * MiB;
constexpr size_t WS_END = 1736 * MiB;
constexpr int CW_BAR = 4096;
constexpr int CW_CNT = 16384;
constexpr int CW_NTL = 20480;

constexpr int LDS_BYTES = 163840;
constexpr int MISC_OFF = 163584;

struct Frame {
    LAS unsigned char* lds;
    int tid, lane, wave, G, wg;
    const float* const* in;
    float* out; unsigned char* ws; unsigned* ctl;
};
enum { I_X = 0, I_C, I_CTX, I_CCTX, I_WMOD, I_BMOD, I_WIN, I_RPB, I_WA2, I_BA2, I_GNORM, I_HSW, I_HSB, I_HW1, I_HB1, I_HF1, I_HW2, I_HB2, I_HF2, I_HW3, I_HB3, I_HDEC, I_HSKIP,
       I_WOUT, I_LN1G, I_LN1B, I_RW, I_RB, I_WEG, I_WEU, I_WED, I_WSG, I_WSU, I_WSD, I_LN2G, I_LN2B };

__device__ __forceinline__ int row_b(int row) { return row < NLAT ? (row >> 12) : 16; }
__device__ __forceinline__ const float* mod_ptr(const Frame& F, int l, int row) { return (const float*)(F.ws + WS_MOD) + ((size_t)l * 17 + row_b(row)) * 6144; }

constexpr float NA_QSCALE = 0.125f * 1.4426950408889634f, NA_CLAMP = 60.0f * 1.4426950408889634f;
template <class RowFn>
__device__ __forceinline__ void tr_item(const float* W, int ldw, int k0, int n0, bf16_t* dst, int ldd, RowFn rf, LAS float* scr, int lane, float scale = 1.0f) {
    float tv[32];
    const GAS float* wp = (const GAS float*)(W + (size_t)(k0 + (lane >> 5)) * ldw + n0 + (lane & 31));
#pragma unroll
    for (int i = 0; i < 32; ++i) tv[i] = __builtin_nontemporal_load(wp + (size_t)(2 * i) * ldw);
#pragma unroll
    for (int i = 0; i < 32; ++i) scr[(2 * i + (lane >> 5)) * 33 + (lane & 31)] = tv[i];
    LDS_WAIT(); asm volatile("" ::: "memory");
    const int c = lane & 7;
#pragma unroll
    for (int j = 0; j < 4; ++j) { const int n = (lane >> 3) + 8 * j; const LAS float* s = scr + (8 * c) * 33 + n;
        u32x4 o; o.x = pk2(s[0 * 33] * scale, s[1 * 33] * scale); o.y = pk2(s[2 * 33] * scale, s[3 * 33] * scale); o.z = pk2(s[4 * 33] * scale, s[5 * 33] * scale); o.w = pk2(s[6 * 33] * scale, s[7 * 33] * scale);
        *(GAS u32x4*)(dst + (size_t)rf(n0 + n) * ldd + k0 + 8 * c) = o; }
    LDS_WAIT(); asm volatile("" ::: "memory");
}
template <class RowFn>
__device__ __forceinline__ void tr_item_ks(const float* W, int ldw, int k0, int n0, bf16_t* dst, int ldd, RowFn rf, LAS float* scr, int lane, const float* ksc) {
    float tv[32];
    const GAS float* wp = (const GAS float*)(W + (size_t)(k0 + (lane >> 5)) * ldw + n0 + (lane & 31));
#pragma unroll
    for (int i = 0; i < 32; ++i) tv[i] = wp[(size_t)(2 * i) * ldw];
#pragma unroll
    for (int i = 0; i < 32; ++i) scr[(2 * i + (lane >> 5)) * 33 + (lane & 31)] = tv[i] * (1.0f + ksc[2 * i + (lane >> 5)]);
    LDS_WAIT(); asm volatile("" ::: "memory");
    const int c = lane & 7;
#pragma unroll
    for (int j = 0; j < 4; ++j) { const int n = (lane >> 3) + 8 * j; const LAS float* s = scr + (8 * c) * 33 + n;
        u32x4 o; o.x = pk2(s[0 * 33], s[1 * 33]); o.y = pk2(s[2 * 33], s[3 * 33]); o.z = pk2(s[4 * 33], s[5 * 33]); o.w = pk2(s[6 * 33], s[7 * 33]);
        *(GAS u32x4*)(dst + (size_t)rf(n0 + n) * ldd + k0 + 8 * c) = o; }
    LDS_WAIT(); asm volatile("" ::: "memory");
}
template <class RowFn>
__device__ __forceinline__ void tr_item8(const float* W, int ldw, int k0, int n0, unsigned char* dst, int ldd, RowFn rf, float scale, LAS float* scr, int lane) {
    float tv[32];
    const GAS float* wp = (const GAS float*)(W + (size_t)(k0 + (lane >> 5)) * ldw + n0 + (lane & 31));
#pragma unroll
    for (int i = 0; i < 32; ++i) tv[i] = __builtin_nontemporal_load(wp + (size_t)(2 * i) * ldw);
#pragma unroll
    for (int i = 0; i < 32; ++i) scr[(2 * i + (lane >> 5)) * 33 + (lane & 31)] = tv[i];
    LDS_WAIT(); asm volatile("" ::: "memory");
    const int n = lane >> 1, hf = lane & 1; const LAS float* s = scr + (32 * hf) * 33 + n;
    unsigned w[8];
#pragma unroll
    for (int j = 0; j < 8; ++j) { int v = 0; v = __builtin_amdgcn_cvt_pk_fp8_f32(s[(4 * j) * 33] * scale, s[(4 * j + 1) * 33] * scale, v, false); v = __builtin_amdgcn_cvt_pk_fp8_f32(s[(4 * j + 2) * 33] * scale, s[(4 * j + 3) * 33] * scale, v, true); w[j] = (unsigned)v; }
    unsigned char* d = dst + (size_t)rf(n0 + n) * ldd + k0 + 32 * hf;
    *(GAS u32x4*)d = (u32x4){w[0], w[1], w[2], w[3]}; *(GAS u32x4*)(d + 16) = (u32x4){w[4], w[5], w[6], w[7]};
    LDS_WAIT(); asm volatile("" ::: "memory");
}
struct RowId { __device__ __forceinline__ int operator()(int n) const { return n; } };
struct RowWin { __device__ __forceinline__ int operator()(int n) const { return n >= 2336 ? n - 32 : n; } };
struct RowGU { int up; __device__ __forceinline__ int operator()(int j) const { return (j >> 7) * 256 + up * 128 + (j & 127); } };

__device__ __forceinline__ void p0_static_weights(Frame& F) {
    LAS float* scr = (LAS float*)(F.lds + F.wave * 16384);
    const int gw = F.wg * NWAVES + F.wave, NGW = F.G * NWAVES;
    constexpr int I_IN = 16 * 97, I_OUT = 16 * 32, I_R = 16 * 4, PER_L = I_IN + I_OUT + I_R;
    for (int it = gw; it < DEPTH * PER_L; it += NGW) {
        const int l = it / PER_L; int r = it % PER_L;
        if (r < I_IN) { const int kb = r / 97, nb = r % 97; if (nb == 72) continue;
            tr_item(F.in[I_WIN] + (size_t)l * DM * DIN_REF, DIN_REF, kb * 64, nb * 32, (bf16_t*)(F.ws + WS_WIN) + (size_t)l * DIN * DM, DM, RowWin{}, scr, F.lane, nb < 16 ? NA_QSCALE : 1.0f); continue; }
        r -= I_IN;
        if (r < I_OUT) { const int kb = r / 32, nb = r % 32;
            tr_item(F.in[I_WOUT] + (size_t)l * DM * DM, DM, kb * 64, nb * 32, (bf16_t*)(F.ws + WS_WOUT) + (size_t)l * DM * DM, DM, RowId{}, scr, F.lane); continue; }
        r -= I_OUT;
        { const int kb = r / 4, nb = r % 4;
            tr_item(F.in[I_RW] + (size_t)l * DM * NEXP, NEXP, kb * 64, nb * 32, (bf16_t*)(F.ws + WS_WR) + (size_t)l * 256 * DM, DM, RowId{}, scr, F.lane); }
    }
    const int gt = F.wg * NTHR + F.tid, NGT = F.G * NTHR;
    for (int i = gt; i < DEPTH * 128 * DM / 8; i += NGT) { const int l = i / (128 * DM / 8), r = i % (128 * DM / 8);
        *(u32x4*)((bf16_t*)(F.ws + WS_WR) + ((size_t)l * 256 + 128) * DM + (size_t)r * 8) = (u32x4){0u, 0u, 0u, 0u}; }
    for (int i = gt; i < DEPTH * 256 * DM; i += NGT) {
        const int k = i % DM, n = (i / DM) % 256, l = i / (DM * 256), dir = n >> 7, j = n & 127;
        const float* wi = F.in[I_WIN] + ((size_t)l * DM + k) * DIN_REF + 2304 + dir * 16;
        const float* wa = F.in[I_WA2] + ((size_t)(l * 2 + dir) * 16) * 128 + j;
        float s = 0.f;
#pragma unroll
        for (int r = 0; r < 16; ++r) s += wi[r] * wa[r * 128];
        ((bf16_t*)(F.ws + WS_WIN))[((size_t)l * DIN + 3072 + n) * DM + k] = (bf16_t)f2bf(s);
    }
}
__device__ __forceinline__ void p0_mod(Frame& F) {
    LAS float* sc = (LAS float*)F.lds;
    LAS float* red = (LAS float*)(F.lds + 17 * 1024 * 4);
    for (int i = F.tid; i < 17 * 1024; i += NTHR) { const int r = i >> 10, k = i & 1023; const float v = r < 16 ? F.in[I_C][r * 1024 + k] : F.in[I_CCTX][k]; sc[i] = silu_f(v); }
    __syncthreads();
    const int kq = F.tid >> 7, cl = F.tid & 127;
    for (int u = F.wg; u < DEPTH * 48; u += F.G) {
        const int l = u / 48, col = (u % 48) * 128 + cl;
        const float* w = F.in[I_WMOD] + (size_t)l * DM * 6144 + col;
        float a[17];
#pragma unroll
        for (int r = 0; r < 17; ++r) a[r] = 0.f;
        for (int k0 = kq * 256; k0 < kq * 256 + 256; k0 += 16) {
            float wv[16];
#pragma unroll
            for (int q = 0; q < 16; ++q) wv[q] = *(const GAS float*)(w + (size_t)(k0 + q) * 6144);
#pragma unroll
            for (int q = 0; q < 16; ++q)
#pragma unroll
                for (int r = 0; r < 17; ++r) a[r] += sc[r * 1024 + k0 + q] * wv[q]; }
#pragma unroll
        for (int r = 0; r < 17; ++r) red[(kq * 17 + r) * 128 + cl] = a[r];
        __syncthreads();
        for (int i = F.tid; i < 17 * 128; i += NTHR) { const int r = i >> 7, c2 = i & 127, cc = (u % 48) * 128 + c2;
            const float s = red[(0 * 17 + r) * 128 + c2] + red[(1 * 17 + r) * 128 + c2] + red[(2 * 17 + r) * 128 + c2] + red[(3 * 17 + r) * 128 + c2] + F.in[I_BMOD][l * 6144 + cc];
            ((float*)(F.ws + WS_MOD))[((size_t)l * 17 + r) * 6144 + cc] = s; }
        __syncthreads();
    }
}
__device__ __forceinline__ void p0_hyena_filters(Frame& F) {
    LAS float* z = (LAS float*)F.lds;
    LAS float* h1 = z + 1092;
    LAS float* h2 = h1 + 33 * 64;
    LAS float* tt = h2 + 33 * 64;
    LAS float* W1 = tt + 64;
    LAS float* W2 = W1 + 33 * 64;
    constexpr int UL = 4096 / 32, UC = 256 / 32, UPL = UL + UC;
    for (int u = F.wg; u < DEPTH * UPL; u += F.G) {
        const int l = u / UPL, r = u % UPL; const bool lat = r < UL; const int L = lat ? 4096 : 256, n0 = (lat ? r : r - UL) * 32;
        __syncthreads();
        for (int i = F.tid; i < 33 * 64; i += NTHR) W1[i] = F.in[I_HW1][(size_t)l * 33 * 64 + i];
        for (int i = F.tid; i < 64 * 64; i += NTHR) W2[i] = F.in[I_HW2][(size_t)l * 64 * 64 + i];
        for (int i = F.tid; i < 33 * 33; i += NTHR) { const int p = i / 33, e = i % 33, n = n0 + p;
            const float t = (float)n / (float)(L - 1);
            float v;
            if (e == 0) v = t;
            else { const int kb = (e - 1) & 15; const float band = 1e-4f + (float)kb * ((15.0f - 1e-4f) / 15.0f);
                   const float w = 6.283185307179586f * (float)n / (float)L; const float ang = w * band;
                   v = e <= 16 ? __cosf(ang) : -__sinf(ang); }
            z[i] = v; if (e == 0) tt[p] = t; }
        __syncthreads();
        for (int i = F.tid; i < 33 * 64; i += NTHR) { const int p = i >> 6, j = i & 63; float s = F.in[I_HB1][l * 64 + j];
#pragma unroll 11
            for (int e = 0; e < 33; ++e) s += z[p * 33 + e] * W1[e * 64 + j];
            h1[i] = __sinf(F.in[I_HF1][l * 64 + j] * s); }
        __syncthreads();
        for (int i = F.tid; i < 33 * 64; i += NTHR) { const int p = i >> 6, j = i & 63; float s = F.in[I_HB2][l * 64 + j];
#pragma unroll 16
            for (int e = 0; e < 64; ++e) s += h1[p * 64 + e] * W2[e * 64 + j];
            h2[i] = __sinf(F.in[I_HF2][l * 64 + j] * s); }
        __syncthreads();
        {
            const int g = F.tid >> 8, col0 = 4 * (F.tid & 255), o = col0 >> 9, dir = (col0 >> 8) & 1, ch0 = col0 & 255;
            const int pb = (dir ? 0 : 1) + 16 * g;
            float a[4][16];
#pragma unroll
            for (int j = 0; j < 4; ++j)
#pragma unroll
                for (int q = 0; q < 16; ++q) a[j][q] = 0.f;
            const float* w3 = F.in[I_HW3] + (size_t)l * 64 * 1024 + col0;
            const LAS float* hp = h2 + pb * 64;
            f32x4 wa[4], wb[4];
#pragma unroll
            for (int q = 0; q < 4; ++q) wa[q] = *(const GAS f32x4*)(w3 + (size_t)q * 1024);
#define HF_BLOCK(wv_, k0_) do { _Pragma("unroll") for (int pi = 0; pi < 16; ++pi) { const f32x4 hv = *(const LAS f32x4*)(hp + pi * 64 + (k0_)); \
                _Pragma("unroll") for (int q = 0; q < 4; ++q) _Pragma("unroll") for (int j = 0; j < 4; ++j) a[j][pi] += hv[q] * wv_[q][j]; } } while (0)
#pragma unroll 1
            for (int k0 = 0; k0 < 64; k0 += 8) {
#pragma unroll
                for (int q = 0; q < 4; ++q) wb[q] = *(const GAS f32x4*)(w3 + (size_t)(k0 + 4 + q) * 1024);
                __builtin_amdgcn_sched_barrier(0);
                HF_BLOCK(wa, k0);
                __builtin_amdgcn_sched_barrier(0);
                { const int kn = k0 + 8 < 64 ? k0 + 8 : k0;
#pragma unroll
                  for (int q = 0; q < 4; ++q) wa[q] = *(const GAS f32x4*)(w3 + (size_t)(kn + q) * 1024); }
                __builtin_amdgcn_sched_barrier(0);
                HF_BLOCK(wb, k0 + 4);
                __builtin_amdgcn_sched_barrier(0);
            }
#undef HF_BLOCK
            const f32x4 b3 = *(const GAS f32x4*)(F.in[I_HB3] + l * 1024 + col0), dc = *(const GAS f32x4*)(F.in[I_HDEC] + ((size_t)(l * 2 + o) * 2 + dir) * 256 + ch0);
            float a0[4] = {0.f, 0.f, 0.f, 0.f};
            if (n0 == 0 && dir == 0 && g == 0) {
                for (int k = 0; k < 64; ++k) { const f32x4 wv = *(const GAS f32x4*)(w3 + (size_t)k * 1024); const float hv = h2[k];
#pragma unroll
                    for (int j = 0; j < 4; ++j) a0[j] += hv * wv[j]; } }
#pragma unroll
            for (int j = 0; j < 4; ++j) {
                const float dec = fabsf(dc[j]);
                bf16_t* R = lat ? (bf16_t*)(F.ws + WS_HYF) + ((size_t)(l * 2 + o) * 256 + ch0 + j) * 8192 : (bf16_t*)(F.ws + WS_HYFC) + ((size_t)(l * 2 + o) * 256 + ch0 + j) * 512;
                float v[16];
#pragma unroll
                for (int pi = 0; pi < 16; ++pi) v[pi] = (a[j][pi] + b3[j]) * __expf(-tt[pb + pi] * dec);
                unsigned w[8];
                if (dir == 0) {
                    if (n0 + 32 == L && g == 1) v[15] = 0.f;
#pragma unroll
                    for (int q = 0; q < 8; ++q) w[q] = pk2(v[15 - 2 * q], v[14 - 2 * q]);
                    GAS u32x4* dst = (GAS u32x4*)(R + (L - n0 - 32) + 16 * (1 - g));
                    dst[0] = (u32x4){w[0], w[1], w[2], w[3]}; dst[1] = (u32x4){w[4], w[5], w[6], w[7]};
                    if (n0 == 0 && g == 0) R[L] = (bf16_t)f2bf((a0[j] + b3[j]) * __expf(-tt[0] * dec) + F.in[I_HSKIP][(l * 2 + o) * 256 + ch0 + j]);
                } else if (n0 > 0 || g == 1) {
#pragma unroll
                    for (int q = 0; q < 8; ++q) w[q] = pk2(v[2 * q], v[2 * q + 1]);
                    GAS u32x4* dst = (GAS u32x4*)(R + (L + n0) + 16 * g);
                    dst[0] = (u32x4){w[0], w[1], w[2], w[3]}; dst[1] = (u32x4){w[4], w[5], w[6], w[7]};
                } else {
#pragma unroll
                    for (int pi = 1; pi < 16; ++pi) R[L + pi] = (bf16_t)f2bf(v[pi]);
                }
            }
        }
    }
    __syncthreads();
}
__device__ __forceinline__ void p0_init_rows(Frame& F) {
    const int gw = F.wg * NWAVES + F.wave, NGW = F.G * NWAVES;
    for (int row = gw; row < NROW; row += NGW) {
        const float* src = row < NLAT ? F.in[I_X] + (size_t)row * DM : F.in[I_CTX] + (size_t)(row - NLAT) * DM;
        const float* md = mod_ptr(F, 0, row);
        bf16_t* xr = (bf16_t*)(F.ws + WS_XR) + (size_t)row * DM; bf16_t* xm = (bf16_t*)(F.ws + WS_XM) + (size_t)row * DM;
#pragma unroll
        for (int j = 0; j < 4; ++j) { const int c = 4 * F.lane + 256 * j;
            const f32x4 v = __builtin_nontemporal_load((const GAS f32x4*)(src + c)), sh = *(const GAS f32x4*)(md + c), sc = *(const GAS f32x4*)(md + 1024 + c);
            *(GAS u32x2*)(xr + c) = (u32x2){pk2(v[0], v[1]), pk2(v[2], v[3])};
            u32x2 w; w.x = pk2(v[0] * (1.f + sc[0]) + sh[0], v[1] * (1.f + sc[1]) + sh[1]); w.y = pk2(v[2] * (1.f + sc[2]) + sh[2], v[3] * (1.f + sc[3]) + sh[3]);
            *(GAS u32x2*)(xm + c) = w; }
    }
}
__device__ __forceinline__ void p1_router_weights(Frame& F) {
    LAS float* scr = (LAS float*)(F.lds + F.wave * 16384);
    const int gw = F.wg * NWAVES + F.wave, NGW = F.G * NWAVES;
    const float* MOD = (const float*)(F.ws + WS_MOD);
    for (int it = gw; it < DEPTH * 17 * 64; it += NGW) {
        const int lb = it >> 6, l = lb / 17, kb = (it & 63) >> 2, nb = it & 3;
        tr_item_ks(F.in[I_RW] + (size_t)l * DM * NEXP, NEXP, kb * 64, nb * 32, (bf16_t*)(F.ws + WS_WRB) + (size_t)lb * 128 * DM, DM, RowId{}, scr, F.lane, MOD + (size_t)lb * 6144 + 4096 + kb * 64); }
    for (int it = gw; it < DEPTH * 17 * 8; it += NGW) {
        const int lb = it >> 3, l = lb / 17, n = (it & 7) * 16 + (F.lane & 15), kq = F.lane >> 4;
        const float* sh = MOD + (size_t)lb * 6144 + 3072 + kq * 256; const float* w = F.in[I_RW] + (size_t)l * DM * NEXP + (size_t)(kq * 256) * NEXP + n;
        float a = 0.f;
#pragma unroll 8
        for (int k = 0; k < 256; ++k) a += sh[k] * w[(size_t)k * NEXP];
        a += shx(a, 16, F.lane); a += shx(a, 32, F.lane);
        if (kq == 0) ((float*)(F.ws + WS_RBIAS))[(size_t)lb * 128 + n] = a; }
}
constexpr float WEXP_SCALE = 32.0f;
__device__ __forceinline__ void p_expert_weights(Frame& F, int l) {
    LAS float* scr = (LAS float*)(F.lds + F.wave * 16384);
    const int gw = F.wg * NWAVES + F.wave, NGW = F.G * NWAVES;
    constexpr int I1 = 16 * 8, I2 = 4 * 32, PER_E = 2 * I1 + I2;
    for (int it = gw; it < NE1 * PER_E; it += NGW) {
        const int e = it / PER_E; int r = it % PER_E;
        unsigned char* d1 = (unsigned char*)(F.ws + WS_EXP1) + (size_t)e * 512 * DM; unsigned char* d2 = (unsigned char*)(F.ws + WS_EXP2) + (size_t)e * DM * EH;
        if (r < 2 * I1) { const int up = r >= I1; if (up) r -= I1; const int kb = r / 8, nb = r % 8;
            const float* src = e < NEXP ? F.in[up ? I_WEU : I_WEG] + ((size_t)l * NEXP + e) * DM * EH : F.in[up ? I_WSU : I_WSG] + (size_t)l * DM * EH;
            tr_item8(src, EH, kb * 64, nb * 32, d1, DM, RowGU{up}, up ? WEXP_SCALE * 0.6931471805599453f : WEXP_SCALE * 1.4426950408889634f, scr, F.lane); }
        else { r -= 2 * I1; const int kb = r / 32, nb = r % 32;
            const float* src = e < NEXP ? F.in[I_WED] + ((size_t)l * NEXP + e) * EH * DM : F.in[I_WSD] + (size_t)l * EH * DM;
            tr_item8(src, DM, kb * 64, nb * 32, d2, EH, RowId{}, WEXP_SCALE, scr, F.lane); }
    }
}

__device__ __forceinline__ f32x4 mfma16(bf16x8 a, bf16x8 b, f32x4 c) { return __builtin_amdgcn_mfma_f32_16x16x32_bf16(a, b, c, 0, 0, 0); }

__device__ __forceinline__ void ph_transposes(Frame& F, int l) {
    LAS bf16_t* tile = (LAS bf16_t*)(F.lds + F.wave * 16384);
    const bf16_t* U = (const bf16_t*)(F.ws + WS_U);
    const int gw = F.wg * NWAVES + F.wave, NGW = F.G * NWAVES;
    const int rsub = F.lane >> 3, cseg = F.lane & 7;
    for (int u = gw; u < 1088 * 12; u += NGW) {
        const int tt = u / 12, blk = u % 12;
        int b, s0, Ls, rowbase, posbase;
        if (tt < 1024) { b = tt >> 6; s0 = (tt & 63) * 64; Ls = SEQ; rowbase = b * SEQ; posbase = 0; }
        else { const int t2 = tt - 1024; b = t2 >> 2; s0 = (t2 & 3) * 64; Ls = CTXL; rowbase = NLAT + b * CTXL; posbase = SEQ; }
        if (blk < 12) {
            constexpr int HT = 80;
            float w0[8], w1[8], w2[8], bb[8];
#pragma unroll
            for (int it = 0; it < 8; ++it) { const int col = blk * 64 + rsub + 8 * it; w0[it] = F.in[I_HSW][(l * 3 + 0) * 768 + col]; w1[it] = F.in[I_HSW][(l * 3 + 1) * 768 + col]; w2[it] = F.in[I_HSW][(l * 3 + 2) * 768 + col]; bb[it] = F.in[I_HSB][l * 768 + col]; }
            const bf16_t* p0 = U + (size_t)(rowbase + s0 + rsub) * DIN + UHY + blk * 64 + cseg * 8;
            u32x4 zc[8];
#pragma unroll
            for (int it = 0; it < 8; ++it) zc[it] = *(const GAS u32x4*)(p0 + (size_t)(8 * it) * DIN);
            u32x4 zh = (u32x4){0u, 0u, 0u, 0u};
            if (F.lane < 16) { const int hs = F.lane < 8 ? s0 - 1 : s0 + 64; if (hs >= 0 && hs < Ls) zh = *(const GAS u32x4*)(U + (size_t)(rowbase + hs) * DIN + UHY + blk * 64 + cseg * 8); }
#pragma unroll
            for (int it = 0; it < 8; ++it) { const unsigned a[4] = {zc[it].x, zc[it].y, zc[it].z, zc[it].w}; LAS bf16_t* d = tile + (cseg * 8) * HT + 8 + rsub + 8 * it;
#pragma unroll
                for (int i = 0; i < 4; ++i) { d[(2 * i) * HT] = (bf16_t)(a[i] & 0xffffu); d[(2 * i + 1) * HT] = (bf16_t)(a[i] >> 16); } }
            if (F.lane < 16) { const unsigned a[4] = {zh.x, zh.y, zh.z, zh.w}; LAS bf16_t* d = tile + (cseg * 8) * HT + (F.lane < 8 ? 7 : 72);
#pragma unroll
                for (int i = 0; i < 4; ++i) { d[(2 * i) * HT] = (bf16_t)(a[i] & 0xffffu); d[(2 * i + 1) * HT] = (bf16_t)(a[i] >> 16); } }
            LDS_WAIT(); asm volatile("" ::: "memory");
#pragma unroll
            for (int it = 0; it < 8; ++it) {
                const int ch = rsub + 8 * it; const LAS bf16_t* r = tile + ch * HT + 8 + cseg * 8;
                const u32x4 v = *(const LAS u32x4*)r; const unsigned hm = r[-1], hp = r[8];
                float x[10]; x[0] = __builtin_bit_cast(float, hm << 16); x[9] = __builtin_bit_cast(float, hp << 16);
                x[1] = bflo(v.x); x[2] = bfhi(v.x); x[3] = bflo(v.y); x[4] = bfhi(v.y); x[5] = bflo(v.z); x[6] = bfhi(v.z); x[7] = bflo(v.w); x[8] = bfhi(v.w);
                unsigned w[4];
#pragma unroll
                for (int i = 0; i < 4; ++i) w[i] = pk2(bb[it] + w0[it] * x[2 * i] + w1[it] * x[2 * i + 1] + w2[it] * x[2 * i + 2], bb[it] + w0[it] * x[2 * i + 1] + w1[it] * x[2 * i + 2] + w2[it] * x[2 * i + 3]);
                *(GAS u32x4*)((bf16_t*)(F.ws + WS_HV) + ((size_t)(blk * 64 + ch) * NB + b) * SPB + posbase + s0 + cseg * 8) = (u32x4){w[0], w[1], w[2], w[3]};
            }
            LDS_WAIT(); asm volatile("" ::: "memory");
            continue;
        } else {
            const int c0 = (blk - 12) * 64 + cseg * 8;
#pragma unroll
            for (int it = 0; it < 8; ++it) {
                const int sl = rsub + 8 * it, s = s0 + sl;
                const u32x4 zc = *(const GAS u32x4*)(U + (size_t)(rowbase + s) * DIN + UV + c0);
                const unsigned ac[4] = {zc.x, zc.y, zc.z, zc.w};
#pragma unroll
                for (int i = 0; i < 4; ++i) { tile[(cseg * 8 + 2 * i) * 72 + sl] = (bf16_t)(ac[i] & 0xffffu); tile[(cseg * 8 + 2 * i + 1) * 72 + sl] = (bf16_t)(ac[i] >> 16); }
            }
        }
        LDS_WAIT(); asm volatile("" ::: "memory");
#pragma unroll 2
        for (int it = 0; it < 8; ++it) {
            const int ch = rsub + 8 * it;
            const u32x4 v = *(const LAS u32x4*)(tile + ch * 72 + cseg * 8);
            bf16_t* dst;
            if (blk < 12) dst = (bf16_t*)(F.ws + WS_HV) + ((size_t)(blk * 64 + ch) * NB + b) * SPB + posbase + s0 + cseg * 8;
            else dst = (bf16_t*)(F.ws + WS_VT) + ((size_t)b * 512 + (blk - 12) * 64 + ch) * SPB + posbase + s0 + cseg * 8;
            *(GAS u32x4*)dst = v;
        }
        LDS_WAIT(); asm volatile("" ::: "memory");
    }
}

constexpr int NA_RPB = 0, NA_KC = 2048, NA_VC = NA_KC + 256 * 144, NA_KR = NA_VC + 64 * 528, NA_END = NA_KR + 9 * 64 * 144;
static_assert(NA_END <= MISC_OFF, "NA LDS map");
__device__ __forceinline__ bf16x8 gld16(const bf16_t* p) { return *(const GAS bf16x8*)p; }
__device__ __forceinline__ u32x2 gld8(const bf16_t* p) { return *(const GAS u32x2*)p; }
__device__ __forceinline__ const char* uni_ptr(const char* p) { const unsigned long long v = (unsigned long long)p; const unsigned lo = __builtin_amdgcn_readfirstlane((unsigned)v), hi = __builtin_amdgcn_readfirstlane((unsigned)(v >> 32)); return (const char*)(((unsigned long long)hi << 32) | lo); }
__device__ __forceinline__ bf16x8 gld16o(const char* ub, unsigned lo) { return *(const GAS bf16x8*)(ub + (size_t)lo); }
__device__ __forceinline__ u32x2 gld8o(const char* ub, unsigned lo) { return *(const GAS u32x2*)(ub + (size_t)lo); }
template <bool WIN>
__device__ __forceinline__ void na_unit(Frame& F, int b, int h, int r, int strip) {
    const bf16_t* U = (const bf16_t*)(F.ws + WS_U);
    const bf16_t* VT = (const bf16_t*)(F.ws + WS_VT) + ((size_t)b * 512 + h * 64) * SPB;
    const LAS float* rpb = (const LAS float*)(F.lds + NA_RPB);
    const LAS bf16_t* KC = (const LAS bf16_t*)(F.lds + NA_KC); const LAS bf16_t* VC = (const LAS bf16_t*)(F.lds + NA_VC);
    int ln_ = F.lane; asm volatile("" : "+v"(ln_));
    const int i = ln_ & 15, g = ln_ >> 4;
    const int qrow0 = WIN ? (b * SEQ + r * 64 + strip * 16) : (NLAT + b * CTXL + strip * 16);
    const int ki = 8 * (i >> 2) + (i & 3);
    const unsigned qlo = (unsigned)((i * DIN + 8 * g) * 2), klo = (unsigned)((ki * DIN + 8 * g) * 2), vlo = (unsigned)((i * SPB + 8 * g) * 2);
    const char* qb = uni_ptr((const char*)(U + (size_t)qrow0 * DIN + UQ + h * 64));
    const bf16x8 q0 = gld16o(qb, qlo), q1 = gld16o(qb + 64, qlo);
    int kr0 = 0, u0 = 0;
    if (WIN) { kr0 = r - 4; kr0 = kr0 < 0 ? 0 : (kr0 > 56 ? 56 : kr0); u0 = strip == 0 ? 0 : (strip == 1 ? 8 : (strip == 2 ? 24 : 32)); }
    const LAS bf16_t* KR = (const LAS bf16_t*)(F.lds + NA_KR);
    const char* vbase = uni_ptr((const char*)(VT + kr0 * 64 + u0));
    f32x4 o[4];
#pragma unroll
    for (int d = 0; d < 4; ++d) o[d] = (f32x4){0.f, 0.f, 0.f, 0.f};
    float lsum = 0.f;
#define NA_SB() __builtin_amdgcn_sched_barrier(0)
#define NA_WLOAD(vb_, cw) do { _Pragma("unroll") for (int d = 0; d < 4; ++d) vb_[d] = gld16o(vbase + ((size_t)(d * 16) * SPB + (cw) * 64) * 2, vlo); } while (0)
#define NA_KRING(kb_, cw) do { const LAS bf16_t* kp = KR + ((((kr0 + (cw)) % 9) * 64 + u0 + ki) * 72 + 8 * g); kb_[0][0] = *(const LAS bf16x8*)kp; kb_[0][1] = *(const LAS bf16x8*)(kp + 32); \
        kb_[1][0] = *(const LAS bf16x8*)(kp + 4 * 72); kb_[1][1] = *(const LAS bf16x8*)(kp + 4 * 72 + 32); } while (0)
#define NA_QK(kb_, s_) do { _Pragma("unroll") for (int t = 0; t < 2; ++t) { f32x4 a = (f32x4){0.f, 0.f, 0.f, 0.f}; a = mfma16(kb_[t][0], q0, a); a = mfma16(kb_[t][1], q1, a); s_[t] = a; } } while (0)
#define NA_PV(s_, vb_) do { u32x4 pw; pw.x = pk2(s_[0][0], s_[0][1]); pw.y = pk2(s_[0][2], s_[0][3]); pw.z = pk2(s_[1][0], s_[1][1]); pw.w = pk2(s_[1][2], s_[1][3]); const bf16x8 pf = __builtin_bit_cast(bf16x8, pw); \
        _Pragma("unroll") for (int d = 0; d < 4; ++d) o[d] = mfma16(vb_[d], pf, o[d]); } while (0)
    bf16x8 vA[4], vB[4], vC[4];
    if (WIN) { NA_WLOAD(vA, 0); NA_WLOAD(vB, 1); NA_WLOAD(vC, 2); NA_SB(); }
#pragma unroll
    for (int cc = 0; cc < 8; ++cc) {
        bf16x8 kc[2][2], vc[4]; f32x4 sc[2];
#pragma unroll
        for (int t = 0; t < 2; ++t) { const LAS bf16_t* kp = KC + (cc * 32 + ki + 4 * t) * 72 + 8 * g; kc[t][0] = *(const LAS bf16x8*)kp; kc[t][1] = *(const LAS bf16x8*)(kp + 32); }
#pragma unroll
        for (int d = 0; d < 4; ++d) vc[d] = *(const LAS bf16x8*)(VC + (d * 16 + i) * 264 + cc * 32 + 8 * g);
        NA_QK(kc, sc);
#pragma unroll
        for (int t = 0; t < 2; ++t)
#pragma unroll
            for (int e = 0; e < 4; ++e) { const float p = __builtin_amdgcn_exp2f(fminf(sc[t][e], NA_CLAMP)); sc[t][e] = p; lsum += p; }
        NA_PV(sc, vc);
    }
    if (WIN) {
        const int c = strip * 16 + i; int kc0 = c - 8; kc0 = kc0 < 0 ? 0 : (kc0 > 48 ? 48 : kc0);
        int dcl[2][4]; bool okm[2][4];
#pragma unroll
        for (int t = 0; t < 2; ++t)
#pragma unroll
            for (int e = 0; e < 4; ++e) { const int kc = u0 + 8 * g + 4 * t + e; okm[t][e] = (kc >= kc0) && (kc < kc0 + 16); int dc = kc - c + 15; dcl[t][e] = okm[t][e] ? (dc < 0 ? 0 : (dc > 30 ? 30 : dc)) : 31; }
#define NA_WCHUNK(vb_, cw) do { bf16x8 kw[2][2]; NA_KRING(kw, cw); f32x4 sw[2]; NA_QK(kw, sw); const LAS float* rp = rpb + (kr0 + (cw) - r + 7) * 32; \
        _Pragma("unroll") for (int t = 0; t < 2; ++t) _Pragma("unroll") for (int e = 0; e < 4; ++e) { const float x = sw[t][e] + rp[dcl[t][e]]; const float p = __builtin_amdgcn_exp2f(fminf(x, NA_CLAMP)); sw[t][e] = p; lsum += p; } \
        NA_PV(sw, vb_); } while (0)
        NA_WCHUNK(vA, 0); NA_SB(); NA_WLOAD(vA, 3); NA_SB();
        NA_WCHUNK(vB, 1); NA_SB(); NA_WLOAD(vB, 4); NA_SB();
        NA_WCHUNK(vC, 2); NA_SB(); NA_WLOAD(vC, 5); NA_SB();
        NA_WCHUNK(vA, 3); NA_SB(); NA_WLOAD(vA, 6); NA_SB();
        NA_WCHUNK(vB, 4); NA_SB(); NA_WLOAD(vB, 7); NA_SB();
        NA_WCHUNK(vC, 5); NA_SB();
        NA_WCHUNK(vA, 6); NA_SB();
        NA_WCHUNK(vB, 7); NA_SB();
#undef NA_WCHUNK
    }
    lsum += shx(lsum, 16, ln_); lsum += shx(lsum, 32, ln_);
    const float inv = 1.0f / lsum;
    char* op = (char*)uni_ptr((const char*)((bf16_t*)(F.ws + WS_MIX) + (size_t)qrow0 * DM + h * 64)); const unsigned olo = (unsigned)((i * DM + 4 * g) * 2);
#pragma unroll
    for (int d = 0; d < 4; ++d) { u32x2 w; w.x = pk2(o[d][0] * inv, o[d][1] * inv); w.y = pk2(o[d][2] * inv, o[d][3] * inv); *(GAS u32x2*)(op + d * 32 + (size_t)olo) = w; }
#undef NA_SB
#undef NA_WLOAD
#undef NA_KRING
#undef NA_QK
#undef NA_PV
}
__device__ __forceinline__ int na_kr0(int r) { const int k = r - 4; return k < 0 ? 0 : (k > 56 ? 56 : k); }
__device__ __forceinline__ void ph_na(Frame& F, int l, bool last) {
    const bf16_t* U = (const bf16_t*)(F.ws + WS_U);
    for (int job = F.wg; job < NB * 8 * 2; job += F.G) {
        const int half = job & 1, h = (job >> 1) & 7, b = job >> 4;
        int tz_; asm volatile("v_mbcnt_lo_u32_b32 %0, -1, 0\n\tv_mbcnt_hi_u32_b32 %0, -1, %0" : "=v"(tz_)); tz_ |= F.wave << 6;
        const bf16_t* krow = U + (size_t)(b * SEQ + (tz_ >> 3)) * DIN + UK + h * 64 + (tz_ & 7) * 8;
        LAS bf16_t* kdst = (LAS bf16_t*)(F.lds + NA_KR) + (tz_ >> 3) * 72 + (tz_ & 7) * 8;
        __syncthreads();
        { LAS float* rpb = (LAS float*)(F.lds + NA_RPB); const float* rsrc = F.in[I_RPB] + ((size_t)l * 8 + h) * 15 * 31;
          if (tz_ < 15 * 32) rpb[tz_] = (tz_ & 31) < 31 ? rsrc[(tz_ >> 5) * 31 + (tz_ & 31)] * 1.4426950408889634f : -1e30f;
          const int key = tz_ >> 1, hf = tz_ & 1; const bf16_t* src = U + (size_t)(NLAT + b * CTXL + key) * DIN + UK + h * 64 + hf * 32; LAS bf16_t* dst = (LAS bf16_t*)(F.lds + NA_KC) + key * 72 + hf * 32;
#pragma unroll
          for (int j = 0; j < 4; ++j) *(LAS bf16x8*)(dst + j * 8) = gld16(src + j * 8);
          const int dv = tz_ >> 3, seg = tz_ & 7; const bf16_t* vs = (const bf16_t*)(F.ws + WS_VT) + ((size_t)b * 512 + h * 64 + dv) * SPB + SEQ + seg * 32; LAS bf16_t* vd = (LAS bf16_t*)(F.lds + NA_VC) + dv * 264 + seg * 32;
#pragma unroll
          for (int j = 0; j < 4; ++j) *(LAS bf16x8*)(vd + j * 8) = gld16(vs + j * 8);
          const int lo = na_kr0(half * 32), hi0 = na_kr0(half * 32 + 1) + 7;
          for (int kr = lo; kr <= hi0; ++kr) *(LAS bf16x8*)(kdst + (kr % 9) * 64 * 72) = gld16(krow + (size_t)kr * 64 * DIN); }
        __syncthreads();
        int prev_hi = na_kr0(half * 32 + 1) + 7;
#pragma unroll 1
        for (int s = 0; s < 16; ++s) {
            const int r0 = half * 32 + 2 * s;
            const int nhi = s < 15 ? na_kr0(r0 + 3) + 7 : prev_hi;
            bf16x8 n0 = (bf16x8){0, 0, 0, 0, 0, 0, 0, 0}, n1 = n0;
            if (nhi > prev_hi) n0 = gld16(krow + (size_t)(prev_hi + 1) * 64 * DIN);
            if (nhi > prev_hi + 1) n1 = gld16(krow + (size_t)(prev_hi + 2) * 64 * DIN);
            na_unit<true>(F, b, h, r0 + (F.wave >> 2), F.wave & 3);
            __syncthreads();
            if (nhi > prev_hi) *(LAS bf16x8*)(kdst + ((prev_hi + 1) % 9) * 64 * 72) = n0;
            if (nhi > prev_hi + 1) *(LAS bf16x8*)(kdst + ((prev_hi + 2) % 9) * 64 * 72) = n1;
            __syncthreads();
            prev_hi = nhi;
        }
        if (!last) na_unit<false>(F, b, h, 0, half * 8 + F.wave);
    }
}

__device__ __forceinline__ void ph_hy_transpose(Frame& F, bool last) {
    LAS bf16_t* tile = (LAS bf16_t*)(F.lds + F.wave * 16384);
    const bf16_t* HYO = (const bf16_t*)(F.ws + WS_Y);
    const int gw = F.wg * NWAVES + F.wave, NGW = F.G * NWAVES;
    const int rsub = F.lane >> 3, cseg = F.lane & 7;
    const int ntt = last ? 1024 : 1088;
    for (int u = gw; u < ntt * 4; u += NGW) {
        const int tt = u >> 2, cb = u & 3;
        int b, s0, rowbase, posbase;
        if (tt < 1024) { b = tt >> 6; s0 = (tt & 63) * 64; rowbase = b * SEQ; posbase = 0; }
        else { const int t2 = tt - 1024; b = t2 >> 2; s0 = (t2 & 3) * 64; rowbase = NLAT + b * CTXL; posbase = SEQ; }
#pragma unroll 2
        for (int it = 0; it < 8; ++it) { const int c = rsub + 8 * it;
            const u32x4 v = *(const GAS u32x4*)(HYO + ((size_t)(cb * 64 + c) * NB + b) * SPB + posbase + s0 + cseg * 8); const unsigned a[4] = {v.x, v.y, v.z, v.w};
#pragma unroll
            for (int e = 0; e < 4; ++e) { tile[(cseg * 8 + 2 * e) * 72 + c] = (bf16_t)(a[e] & 0xffffu); tile[(cseg * 8 + 2 * e + 1) * 72 + c] = (bf16_t)(a[e] >> 16); } }
        LDS_WAIT(); asm volatile("" ::: "memory");
#pragma unroll 2
        for (int it = 0; it < 8; ++it) { const int p = rsub + 8 * it;
            const u32x4 v = *(const LAS u32x4*)(tile + p * 72 + cseg * 8);
            *(GAS u32x4*)((bf16_t*)(F.ws + WS_MIX) + (size_t)(rowbase + s0 + p) * DM + 768 + cb * 64 + cseg * 8) = v; }
        LDS_WAIT(); asm volatile("" ::: "memory");
    }
}

constexpr int G2_LAF = 0, G2_LAB = 8448;
constexpr int G2_QTF = 16896, G2_KTF = 22016, G2_QTB = 27136, G2_KTB = 32256;
constexpr int G2_VT = 37376, G2_ATT = 46592;
constexpr int G2_SF = 55808, G2_SB = 60928;
constexpr int G2_SEG = 66048, G2_HALF = 67328;
__device__ __forceinline__ float log_sigmoid_f(float x) { return fminf(x, 0.f) - __logf(1.0f + __expf(-fabsf(x))); }
__device__ __forceinline__ f32x4 mma_lds(const LAS bf16_t* A, int lda, const LAS bf16_t* B, int ldb, int ksteps, f32x4 acc, int lane) {
    const int r = lane & 15, g = lane >> 4;
    for (int ks = 0; ks < ksteps; ++ks) { const bf16x8 a = *(const LAS bf16x8*)(A + r * lda + ks * 32 + 8 * g), b = *(const LAS bf16x8*)(B + r * ldb + ks * 32 + 8 * g); acc = mfma16(a, b, acc); }
    return acc;
}
__device__ __forceinline__ int gla_row0(int b, int cn) { return cn >= 4 ? b * SEQ + (cn - 4) * 64 : NLAT + b * CTXL + cn * 64; }
struct GlaRaw { u32x4 q, k, f, b, v0, v1, g0, g1, s0, s1; };
template <bool FULL>
__device__ __forceinline__ GlaRaw gla_load(Frame& F, int u, int tl) {
    const int h = u & 3, cn = (u >> 2) % 68, b = (u >> 2) / 68, i = tl >> 2, part = tl & 3;
    const bf16_t* p = (const bf16_t*)(F.ws + WS_U) + (size_t)(gla_row0(b, cn) + i) * DIN;
    GlaRaw r;
    r.q = *(const GAS u32x4*)(p + UGQ + h * 32 + part * 8); r.k = *(const GAS u32x4*)(p + UGK + h * 32 + part * 8);
    r.f = *(const GAS u32x4*)(p + ULAF + h * 32 + part * 8); r.b = *(const GAS u32x4*)(p + ULAB + h * 32 + part * 8);
    r.v0 = *(const GAS u32x4*)(p + UGV + h * 64 + part * 16); r.v1 = *(const GAS u32x4*)(p + UGV + h * 64 + part * 16 + 8);
    if (FULL) { r.g0 = *(const GAS u32x4*)(p + UGR + h * 64 + part * 16); r.g1 = *(const GAS u32x4*)(p + UGR + h * 64 + part * 16 + 8);
        const bf16_t* sp = (const bf16_t*)(F.ws + WS_GSIN) + (size_t)u * 2 * 2048 + tl * 16; r.s0 = *(const GAS u32x4*)sp; r.s1 = *(const GAS u32x4*)(sp + 8); }
    else { r.g0 = (u32x4){0u, 0u, 0u, 0u}; r.g1 = r.g0; r.s0 = r.g0; r.s1 = r.g0; }
    return r;
}
template <bool FULL>
__device__ __forceinline__ void gla_prep(Frame& F, LAS unsigned char* L, int l, int u, int tl, const GlaRaw& raw) {
    const int h = u & 3, cn = (u >> 2) % 68, i = tl >> 2, part = tl & 3, d8 = part * 8;
    LAS float* LAF = (LAS float*)(L + G2_LAF); LAS float* LAB = (LAS float*)(L + G2_LAB); LAS bf16_t* VT = (LAS bf16_t*)(L + G2_VT); LAS float* SEG = (LAS float*)(L + G2_SEG);
    float q[8], k[8], tf[8], tb[8];
    unpack8(raw.q, q); unpack8(raw.k, k); unpack8(raw.f, tf); unpack8(raw.b, tb);
    const float* ba = F.in[I_BA2] + (size_t)l * 256 + h * 32 + d8;
#pragma unroll
    for (int e = 0; e < 8; ++e) { q[e] *= 0.17677669529663687f; LAF[i * 33 + d8 + e] = log_sigmoid_f(tf[e] + ba[e]) * 0.0625f; LAB[i * 33 + d8 + e] = log_sigmoid_f(tb[e] + ba[128 + e]) * 0.0625f; }
    if (cn >= 4) {
        const float pos = (part >> 1) ? (float)i : (float)(cn - 4);
#pragma unroll
        for (int e = 0; e < 8; ++e) { const float ang = pos * __expf(-(float)e * (9.210340371976184f / 8.0f)); const float sn = __sinf(ang), cs = __cosf(ang);
            const float qo = shx(q[e], 1, F.lane), ko = shx(k[e], 1, F.lane);
            if (part & 1) { q[e] = qo * sn + q[e] * cs; k[e] = ko * sn + k[e] * cs; } else { q[e] = q[e] * cs - qo * sn; k[e] = k[e] * cs - ko * sn; } }
    }
    { const unsigned a[8] = {raw.v0.x, raw.v0.y, raw.v0.z, raw.v0.w, raw.v1.x, raw.v1.y, raw.v1.z, raw.v1.w};
#pragma unroll
      for (int e = 0; e < 8; ++e) { VT[(part * 16 + 2 * e) * 72 + i] = (bf16_t)(a[e] & 0xffffu); VT[(part * 16 + 2 * e + 1) * 72 + i] = (bf16_t)(a[e] >> 16); } }
    __syncthreads();
    { const int x = tl & 63, d = x & 31, dir = x >> 5, seg = tl >> 6; LAS float* LA = (dir ? LAB : LAF) + d; float cv[16];
#pragma unroll
      for (int kk = 0; kk < 16; ++kk) { const int p = seg * 16 + kk, ti = dir ? 63 - p : p; cv[kk] = LA[ti * 33]; }
#pragma unroll
      for (int kk = 1; kk < 16; ++kk) cv[kk] += cv[kk - 1];
#pragma unroll
      for (int kk = 0; kk < 16; ++kk) { const int p = seg * 16 + kk, ti = dir ? 63 - p : p; LA[ti * 33] = cv[kk]; }
      SEG[x * 5 + seg] = cv[15]; }
    __syncthreads();
    { const int x = tl & 63, d = x & 31, dir = x >> 5, seg = tl >> 6; LAS float* LA = (dir ? LAB : LAF) + d; float cv[16];
      const float t0 = SEG[x * 5 + 0], t1 = SEG[x * 5 + 1], t2 = SEG[x * 5 + 2];
      const float pre = seg == 0 ? 0.f : (seg == 1 ? t0 : (seg == 2 ? t0 + t1 : t0 + t1 + t2));
#pragma unroll
      for (int kk = 0; kk < 16; ++kk) { const int p = seg * 16 + kk, ti = dir ? 63 - p : p; cv[kk] = LA[ti * 33]; }
#pragma unroll
      for (int kk = 0; kk < 16; ++kk) { const int p = seg * 16 + kk, ti = dir ? 63 - p : p; LA[ti * 33] = cv[kk] + pre; } }
    __syncthreads();
    if (FULL) {
        unsigned wqf[4], wkf[4], wqb[4], wkb[4];
#pragma unroll
        for (int e = 0; e < 4; ++e) { const int d = d8 + 2 * e; const float f0 = LAF[i * 33 + d], f1 = LAF[i * 33 + d + 1], b0 = LAB[i * 33 + d], b1 = LAB[i * 33 + d + 1];
            wqf[e] = pk2(q[2 * e] * __expf(f0), q[2 * e + 1] * __expf(f1)); wkf[e] = pk2(k[2 * e] * __expf(-f0), k[2 * e + 1] * __expf(-f1));
            wqb[e] = pk2(q[2 * e] * __expf(b0), q[2 * e + 1] * __expf(b1)); wkb[e] = pk2(k[2 * e] * __expf(-b0), k[2 * e + 1] * __expf(-b1)); }
        *(LAS u32x4*)((LAS bf16_t*)(L + G2_QTF) + i * 40 + d8) = (u32x4){wqf[0], wqf[1], wqf[2], wqf[3]}; *(LAS u32x4*)((LAS bf16_t*)(L + G2_KTF) + i * 40 + d8) = (u32x4){wkf[0], wkf[1], wkf[2], wkf[3]};
        *(LAS u32x4*)((LAS bf16_t*)(L + G2_QTB) + i * 40 + d8) = (u32x4){wqb[0], wqb[1], wqb[2], wqb[3]}; *(LAS u32x4*)((LAS bf16_t*)(L + G2_KTB) + i * 40 + d8) = (u32x4){wkb[0], wkb[1], wkb[2], wkb[3]};
    } else {
        LAS bf16_t* KDF = (LAS bf16_t*)(L + G2_QTF); LAS bf16_t* KDB = (LAS bf16_t*)(L + G2_KTF);
#pragma unroll
        for (int e = 0; e < 8; ++e) { const int d = d8 + e; const float bf = LAF[i * 33 + d], bb = LAB[i * 33 + d], bfl = LAF[63 * 33 + d], bbl = LAB[0 * 33 + d];
            KDF[d * 72 + i] = (bf16_t)f2bf(k[e] * __expf(bfl - bf)); KDB[d * 72 + i] = (bf16_t)f2bf(k[e] * __expf(bbl - bb)); }
    }
    __syncthreads();
}
__device__ __forceinline__ void ph_gla_local(Frame& F, int l) {
    const int hw = F.wave >> 2, wl = F.wave & 3, tl = F.tid & 255; LAS unsigned char* L = F.lds + hw * G2_HALF;
    constexpr int NU = NB * 68 * 4;
    int pp = F.wg;
    GlaRaw raw = gla_load<false>(F, (pp * 2 + hw) < NU ? pp * 2 + hw : 0, tl);
    for (; pp * 2 < NU; pp += F.G) {
        const int u = pp * 2 + hw, un = (pp + F.G) * 2 + hw;
        const GlaRaw nraw = gla_load<false>(F, un < NU ? un : u, tl);
        __syncthreads();
        gla_prep<false>(F, L, l, u, tl, raw);
        const int g = F.lane >> 4, c = F.lane & 15;
        float* DS = (float*)(F.ws + WS_GDS) + (size_t)u * 2 * 2048;
#pragma unroll
        for (int kk = 0; kk < 4; ++kk) { const int tix = wl * 4 + kk, dir = tix >> 3, mt = (tix >> 1) & 3, nt = tix & 1;
            f32x4 a = (f32x4){0.f, 0.f, 0.f, 0.f};
            a = mma_lds((const LAS bf16_t*)(L + G2_VT) + mt * 16 * 72, 72, (const LAS bf16_t*)(L + (dir ? G2_KTF : G2_QTF)) + nt * 16 * 72, 72, 2, a, F.lane);
#pragma unroll
            for (int e = 0; e < 4; ++e) DS[dir * 2048 + (mt * 16 + 4 * g + e) * 32 + nt * 16 + c] = a[e]; }
        if (tl < 64) { const int d = tl & 31, dir = tl >> 5; ((float*)(F.ws + WS_GD))[(size_t)u * 64 + tl] = __expf(dir ? ((LAS float*)(L + G2_LAB))[0 * 33 + d] : ((LAS float*)(L + G2_LAF))[63 * 33 + d]); }
        raw = nraw;
    }
}
__device__ __forceinline__ void ph_gla_scan(Frame& F) {
    const int gt = F.wg * NTHR + F.tid, NGT = F.G * NTHR;
    const float* DS = (const float*)(F.ws + WS_GDS); const float* GD = (const float*)(F.ws + WS_GD); bf16_t* SIN = (bf16_t*)(F.ws + WS_GSIN);
    for (int w = gt; w < 128 * 1024; w += NGT) {
        const int chain = w >> 10, el = (w & 1023) * 2, dir = chain & 1, h = (chain >> 1) & 3, b = chain >> 3, d = el & 31;
        float s0 = 0.f, s1 = 0.f;
        for (int step = 0; step < 68; step += 4) {
            f32x2 ds[4], dd[4]; size_t uu[4];
#pragma unroll
            for (int q = 0; q < 4; ++q) { const int st_ = step + q; const int cn = dir ? (st_ < 4 ? 3 - st_ : 71 - st_) : st_;
                uu[q] = (size_t)(b * 68 + cn) * 4 + h;
                ds[q] = *(const GAS f32x2*)(DS + (uu[q] * 2 + dir) * 2048 + el); dd[q] = *(const GAS f32x2*)(GD + uu[q] * 64 + dir * 32 + d); }
#pragma unroll
            for (int q = 0; q < 4; ++q) { *(GAS unsigned*)(SIN + (uu[q] * 2 + dir) * 2048 + el) = pk2(s0, s1); s0 = dd[q].x * s0 + ds[q].x; s1 = dd[q].y * s1 + ds[q].y; }
        }
    }
}
__device__ __forceinline__ void ph_gla_out(Frame& F, int l, bool last) {
    const int hw = F.wave >> 2, wl = F.wave & 3, tl = F.tid & 255; LAS unsigned char* L = F.lds + hw * G2_HALF;
    const int NV = last ? NB * 64 * 4 : NB * 68 * 4;
#define GLA_UNIT(v) (last ? ((((v) >> 8) * 68 + 4 + (((v) & 255) >> 2)) * 4 + ((v) & 3)) : (v))
    int pp = F.wg;
    GlaRaw raw = gla_load<true>(F, GLA_UNIT((pp * 2 + hw) < NV ? pp * 2 + hw : 0), tl);
    for (; pp * 2 < NV; pp += F.G) {
        const int u = GLA_UNIT(pp * 2 + hw), vn = (pp + F.G) * 2 + hw;
        const GlaRaw nraw = gla_load<true>(F, vn < NV ? GLA_UNIT(vn) : u, tl);
        const int h = u & 3, cn = (u >> 2) % 68, b = (u >> 2) / 68;
        __syncthreads();
        gla_prep<true>(F, L, l, u, tl, raw);
        { const int dir = tl >> 7, dv = (tl >> 1) & 63, d16 = (tl & 1) * 16; LAS bf16_t* S = (LAS bf16_t*)(L + (dir ? G2_SB : G2_SF)) + dv * 40 + d16; *(LAS u32x4*)S = raw.s0; *(LAS u32x4*)(S + 8) = raw.s1; }
        const int g = F.lane >> 4, c = F.lane & 15;
        LAS bf16_t* ATT = (LAS bf16_t*)(L + G2_ATT);
#pragma unroll
        for (int kk = 0; kk < 4; ++kk) { const int tile = wl * 4 + kk, mt = tile >> 2, nt = tile & 3;
            f32x4 af = (f32x4){0.f, 0.f, 0.f, 0.f}, ab = af;
            af = mma_lds((const LAS bf16_t*)(L + G2_QTF) + mt * 16 * 40, 40, (const LAS bf16_t*)(L + G2_KTF) + nt * 16 * 40, 40, 1, af, F.lane);
            ab = mma_lds((const LAS bf16_t*)(L + G2_QTB) + mt * 16 * 40, 40, (const LAS bf16_t*)(L + G2_KTB) + nt * 16 * 40, 40, 1, ab, F.lane);
#pragma unroll
            for (int e = 0; e < 4; ++e) { const int ii = mt * 16 + 4 * g + e, j = nt * 16 + c; const float vv = (j <= ii ? af[e] : 0.f) + (j >= ii ? ab[e] : 0.f); ATT[ii * 72 + j] = (bf16_t)f2bf(vv); } }
        __syncthreads();
        LAS float* O = (LAS float*)(L + G2_LAF);
#pragma unroll
        for (int kk = 0; kk < 4; ++kk) { const int tile = wl * 4 + kk, mt = tile >> 2, nt = tile & 3;
            f32x4 a = (f32x4){0.f, 0.f, 0.f, 0.f};
            a = mma_lds(ATT + mt * 16 * 72, 72, (const LAS bf16_t*)(L + G2_VT) + nt * 16 * 72, 72, 2, a, F.lane);
            a = mma_lds((const LAS bf16_t*)(L + G2_QTF) + mt * 16 * 40, 40, (const LAS bf16_t*)(L + G2_SF) + nt * 16 * 40, 40, 1, a, F.lane);
            a = mma_lds((const LAS bf16_t*)(L + G2_QTB) + mt * 16 * 40, 40, (const LAS bf16_t*)(L + G2_SB) + nt * 16 * 40, 40, 1, a, F.lane);
#pragma unroll
            for (int e = 0; e < 4; ++e) O[(mt * 16 + 4 * g + e) * 65 + nt * 16 + c] = a[e]; }
        __syncthreads();
        { const int i = tl >> 2, dv16 = (tl & 3) * 16; const int row = gla_row0(b, cn) + i;
          float v[16], gt[16]; float ss = 0.f;
#pragma unroll
          for (int e = 0; e < 16; ++e) { v[e] = O[i * 65 + dv16 + e]; ss += v[e] * v[e]; }
          ss += shx(ss, 1, F.lane); ss += shx(ss, 2, F.lane);
          const float rs = 1.0f / sqrtf(ss * (1.0f / 64.0f) + LN_EPS);
          unpack8(raw.g0, gt); unpack8(raw.g1, gt + 8);
          const float* gn = F.in[I_GNORM] + l * 64 + dv16;
          unsigned w[8];
#pragma unroll
          for (int e = 0; e < 8; ++e) w[e] = pk2(v[2 * e] * rs * gn[2 * e] * silu_f(gt[2 * e]), v[2 * e + 1] * rs * gn[2 * e + 1] * silu_f(gt[2 * e + 1]));
          bf16_t* mp = (bf16_t*)(F.ws + WS_MIX) + (size_t)row * DM + 512 + h * 64 + dv16;
          *(GAS u32x4*)mp = (u32x4){w[0], w[1], w[2], w[3]}; *(GAS u32x4*)(mp + 8) = (u32x4){w[4], w[5], w[6], w[7]}; }
        raw = nraw;
    }
#undef GLA_UNIT
}

template <int L>
__device__ __forceinline__ void hyena_conv(Frame& F, const bf16_t* Rg, const bf16_t* Uin, const bf16_t* Xmul, int pos0, bool final_out, int ch, bf16_t* Zout) {
    constexpr int CS = 2 * L + 16;
    constexpr int NTL = L / 16, J = (NTL >= 64) ? 16 : 2, NGRP = NTL / J, HJ = J / 2, NSTEP = L / 32;
    LAS bf16_t* Rl = (LAS bf16_t*)F.lds;
    __syncthreads();
    for (int c = F.tid; c < 2 * L / 8; c += NTHR) { const u32x4 v = *(const GAS u32x4*)(Rg + 8 * c); const unsigned a[4] = {v.x, v.y, v.z, v.w};
#pragma unroll
        for (int rho = 0; rho < 8; ++rho) { LAS bf16_t* d = Rl + rho * CS + 8 * c + rho;
#pragma unroll
            for (int k = 0; k < 4; ++k) { d[2 * k] = (bf16_t)(a[k] & 0xffffu); d[2 * k + 1] = (bf16_t)(a[k] >> 16); } } }
    __syncthreads();
    int ln_ = F.lane; asm volatile("" : "+v"(ln_));
    const int i = ln_ & 15, g = ln_ >> 4, rho = i & 7;
    const LAS bf16_t* Rc = Rl + rho * CS + rho;
    for (int grp = F.wave; grp < NGRP; grp += NWAVES) {
        f32x4 acc[J]; bf16x8 fr[J];
        const int tb = grp * J * 16;
        const LAS bf16_t* Rb = Rc + (L - tb - i + 8 * g);
#pragma unroll
        for (int j = 0; j < J; ++j) { acc[j] = (f32x4){0.f, 0.f, 0.f, 0.f}; fr[j] = *(const LAS bf16x8*)(Rb - 16 * j); }
        const char* ub = (const char*)(Uin + pos0); const unsigned ulo = (unsigned)((i * SPB + 8 * g) * 2);
        constexpr int PF = (HJ >= 4) ? 4 : 1;
        bf16x8 bq[PF];
#pragma unroll
        for (int p = 0; p < PF; ++p) bq[p] = *(const GAS bf16x8*)(ub + (size_t)(ulo + (unsigned)p * 64u));
#pragma unroll 1
        for (int q = 0; q < NSTEP / HJ; ++q) {
#pragma unroll
            for (int m = 0; m < HJ; ++m) {
                const int n = q * HJ + m;
                const int nn = (n + PF < NSTEP) ? n + PF : 0;
                if (n > 0) { fr[(J - 2 * m) % J] = *(const LAS bf16x8*)(Rb + 32 * n); fr[(J + 1 - 2 * m) % J] = *(const LAS bf16x8*)(Rb + 32 * n - 16); }
                const bf16x8 bcur = bq[m % PF];
#pragma unroll
                for (int jj = 0; jj < J; ++jj) { const int j = (jj + 2) % J; acc[j] = mfma16(fr[(j + J - 2 * m) % J], bcur, acc[j]); }
                bq[m % PF] = *(const GAS bf16x8*)(ub + (size_t)(ulo + (unsigned)nn * 64u));
            }
        }
#pragma unroll
        for (int j = 0; j < J; ++j) { const int t0 = tb + j * 16 + 4 * g;
            const u32x2 xw = *(const GAS u32x2*)(Xmul + (size_t)i * SPB + pos0 + t0);
            const float y0 = acc[j][0] * bflo(xw.x), y1 = acc[j][1] * bfhi(xw.x), y2 = acc[j][2] * bflo(xw.y), y3 = acc[j][3] * bfhi(xw.y);
            if (!final_out) { u32x2 w; w.x = pk2(y0, y1); w.y = pk2(y2, y3); *(GAS u32x2*)(Zout + (size_t)i * SPB + pos0 + t0) = w; }
            else { u32x2 w; w.x = pk2(y0, y1); w.y = pk2(y2, y3); *(GAS u32x2*)((bf16_t*)(F.ws + WS_Y) + ((size_t)ch * NB + i) * SPB + pos0 + t0) = w; } }
    }
}
__device__ __forceinline__ void ph_hyena(Frame& F, int l, bool last) {
    const bf16_t* HV = (const bf16_t*)(F.ws + WS_HV); bf16_t* Z2 = (bf16_t*)(F.ws + WS_Z2);
    for (int ch = F.wg; ch < 256; ch += F.G) {
        const bf16_t* v = HV + (size_t)(0 * 256 + ch) * NB * SPB; const bf16_t* x1 = HV + (size_t)(256 + ch) * NB * SPB; const bf16_t* x2 = HV + (size_t)(512 + ch) * NB * SPB;
        bf16_t* z = Z2 + (size_t)ch * NB * SPB;
        const bf16_t* R0 = (const bf16_t*)(F.ws + WS_HYF) + ((size_t)(l * 2 + 0) * 256 + ch) * 8192; const bf16_t* R1 = (const bf16_t*)(F.ws + WS_HYF) + ((size_t)(l * 2 + 1) * 256 + ch) * 8192;
        hyena_conv<4096>(F, R0, v, x1, 0, false, ch, z);
        VM_WAIT(); __syncthreads(); __builtin_amdgcn_fence(__ATOMIC_ACQUIRE, "agent"); VM_WAIT();
        hyena_conv<4096>(F, R1, z, x2, 0, true, ch, z);
        if (!last) {
            const bf16_t* C0 = (const bf16_t*)(F.ws + WS_HYFC) + ((size_t)(l * 2 + 0) * 256 + ch) * 512; const bf16_t* C1 = (const bf16_t*)(F.ws + WS_HYFC) + ((size_t)(l * 2 + 1) * 256 + ch) * 512;
            hyena_conv<256>(F, C0, v, x1, SEQ, false, ch, z);
            VM_WAIT(); __syncthreads(); __builtin_amdgcn_fence(__ATOMIC_ACQUIRE, "agent"); VM_WAIT();
            hyena_conv<256>(F, C1, z, x2, SEQ, true, ch, z);
        }
    }
}

__device__ __forceinline__ void ph_ln1(Frame& F, int l, int ntok) {
    const int gw = F.wg * NWAVES + F.wave, NGW = F.G * NWAVES;
    const int cA = 256 * (F.lane >> 4) + 32 * ((F.lane >> 2) & 3) + 8 * (F.lane & 3);
#define LN1_COL(j) (cA + ((j) < 2 ? 4 * (j) : 128 + 4 * ((j) - 2)))
    const float* lg = F.in[I_LN1G] + l * DM; const float* lb = F.in[I_LN1B] + l * DM;
    for (int row = gw; row < ntok; row += NGW) {
        bf16_t* xr = (bf16_t*)(F.ws + WS_XR) + (size_t)row * DM;
        const unsigned char* yr = (const unsigned char*)(F.ws + WS_Y) + (size_t)row * DM + 16 * F.lane;
        const float* md = mod_ptr(F, l, row);
        const u32x4 xa = __builtin_nontemporal_load((const GAS u32x4*)(xr + cA)), xb = __builtin_nontemporal_load((const GAS u32x4*)(xr + cA + 128)), ya = __builtin_nontemporal_load((const GAS u32x4*)yr);
        float x[16], y[16], v[16]; unpack8(xa, x); unpack8(xb, x + 8);
        { const unsigned a[4] = {ya.x, ya.y, ya.z, ya.w};
#pragma unroll
          for (int e = 0; e < 4; ++e) { const f32x2 lo = __builtin_amdgcn_cvt_pk_f32_fp8((int)a[e], false), hi = __builtin_amdgcn_cvt_pk_f32_fp8((int)a[e], true); y[4 * e] = lo.x; y[4 * e + 1] = lo.y; y[4 * e + 2] = hi.x; y[4 * e + 3] = hi.y; } }
        float s = 0.f;
#pragma unroll
        for (int j = 0; j < 4; ++j) { const f32x4 g1 = *(const GAS f32x4*)(md + 2048 + LN1_COL(j));
#pragma unroll
            for (int e = 0; e < 4; ++e) { v[4 * j + e] = x[4 * j + e] * DN_ALPHA + g1[e] * y[4 * j + e]; s += v[4 * j + e]; } }
        const float mean = wave_sum(s, F.lane) * (1.f / DM); float s2 = 0.f;
#pragma unroll
        for (int e = 0; e < 16; ++e) { v[e] -= mean; s2 += v[e] * v[e]; }
        const float rstd = 1.f / sqrtf(wave_sum(s2, F.lane) * (1.f / DM) + LN_EPS);
        unsigned wx[8]; int w8[4];
#pragma unroll
        for (int j = 0; j < 4; ++j) { const f32x4 g = *(const GAS f32x4*)(lg + LN1_COL(j)), bb = *(const GAS f32x4*)(lb + LN1_COL(j)), sh = *(const GAS f32x4*)(md + 3072 + LN1_COL(j)), sc = *(const GAS f32x4*)(md + 4096 + LN1_COL(j));
            float xn[4];
#pragma unroll
            for (int e = 0; e < 4; ++e) xn[e] = v[4 * j + e] * rstd * g[e] + bb[e];
            wx[2 * j] = pk2(xn[0], xn[1]); wx[2 * j + 1] = pk2(xn[2], xn[3]);
            const float h0 = xn[0] * (1.f + sc[0]) + sh[0], h1 = xn[1] * (1.f + sc[1]) + sh[1], h2 = xn[2] * (1.f + sc[2]) + sh[2], h3 = xn[3] * (1.f + sc[3]) + sh[3];
            int v = 0; v = __builtin_amdgcn_cvt_pk_fp8_f32(h0, h1, v, false); v = __builtin_amdgcn_cvt_pk_fp8_f32(h2, h3, v, true); w8[j] = v; }
        unsigned char* x8 = (unsigned char*)(F.ws + WS_XM8) + (size_t)row * DM;
        *(GAS u32x2*)(x8 + cA) = (u32x2){(unsigned)w8[0], (unsigned)w8[1]}; *(GAS u32x2*)(x8 + cA + 128) = (u32x2){(unsigned)w8[2], (unsigned)w8[3]};
        *(GAS u32x4*)(xr + cA) = (u32x4){wx[0], wx[1], wx[2], wx[3]}; *(GAS u32x4*)(xr + cA + 128) = (u32x4){wx[4], wx[5], wx[6], wx[7]};
    }
#undef LN1_COL
}
__device__ __forceinline__ void ph_ln2(Frame& F, int l, int ntok, bool last) {
    const int gw = F.wg * NWAVES + F.wave, NGW = F.G * NWAVES;
    const int cA = 256 * (F.lane >> 4) + 32 * ((F.lane >> 2) & 3) + 8 * (F.lane & 3);
#define LN2_COL(j) (cA + ((j) < 2 ? 4 * (j) : 128 + 4 * ((j) - 2)))
    const float* lg = F.in[I_LN2G] + l * DM; const float* lb = F.in[I_LN2B] + l * DM;
    for (int row = gw; row < ntok; row += NGW) {
        bf16_t* xr = (bf16_t*)(F.ws + WS_XR) + (size_t)row * DM;
        const unsigned char* y2 = (const unsigned char*)(F.ws + WS_Y2) + (size_t)row * 5120;
        const float* wg = (const float*)(F.ws + WS_WGT) + (size_t)row * 8;
        const float* md = mod_ptr(F, l, row);
        float ff[16];
#pragma unroll
        for (int e = 0; e < 16; ++e) ff[e] = 0.f;
        u32x2 q[8];
#pragma unroll
        for (int k = 0; k < 8; ++k) q[k] = __builtin_nontemporal_load((const GAS u32x2*)(y2 + k * 512 + 8 * F.lane));
        const u32x4 qs = __builtin_nontemporal_load((const GAS u32x4*)(y2 + 4096 + 16 * F.lane));
        { const unsigned a[4] = {qs.x, qs.y, qs.z, qs.w};
#pragma unroll
          for (int e = 0; e < 4; ++e) { const f32x2 lo = __builtin_amdgcn_cvt_pk_f32_fp8((int)a[e], false), hi = __builtin_amdgcn_cvt_pk_f32_fp8((int)a[e], true);
              ff[4 * e] += pg8::Y2_INV * lo.x; ff[4 * e + 1] += pg8::Y2_INV * lo.y; ff[4 * e + 2] += pg8::Y2_INV * hi.x; ff[4 * e + 3] += pg8::Y2_INV * hi.y; } }
#pragma unroll
        for (int k = 0; k < 8; ++k) { const float wk = wg[k] * pg8::Y2_INV; const unsigned a[2] = {q[k].x, q[k].y};
#pragma unroll
            for (int h = 0; h < 2; ++h) {
                const f32x2 p0 = __builtin_amdgcn_cvt_scalef32_pk_f32_fp4(a[h], 1.0f, 0), p1 = __builtin_amdgcn_cvt_scalef32_pk_f32_fp4(a[h], 1.0f, 1), p2 = __builtin_amdgcn_cvt_scalef32_pk_f32_fp4(a[h], 1.0f, 2), p3 = __builtin_amdgcn_cvt_scalef32_pk_f32_fp4(a[h], 1.0f, 3);
                ff[8 * h] += wk * p0.x; ff[8 * h + 1] += wk * p0.y; ff[8 * h + 2] += wk * p1.x; ff[8 * h + 3] += wk * p1.y; ff[8 * h + 4] += wk * p2.x; ff[8 * h + 5] += wk * p2.y; ff[8 * h + 6] += wk * p3.x; ff[8 * h + 7] += wk * p3.y; } }
        float v[16], xo[16]; float s = 0.f;
        { const u32x4 xa = __builtin_nontemporal_load((const GAS u32x4*)(xr + cA)), xb = __builtin_nontemporal_load((const GAS u32x4*)(xr + cA + 128)); unpack8(xa, xo); unpack8(xb, xo + 8); }
#pragma unroll
        for (int j = 0; j < 4; ++j) { const f32x4 g2 = *(const GAS f32x4*)(md + 5120 + LN2_COL(j));
#pragma unroll
            for (int e = 0; e < 4; ++e) { v[4 * j + e] = xo[4 * j + e] * DN_ALPHA + g2[e] * ff[4 * j + e]; s += v[4 * j + e]; } }
        const float mean = wave_sum(s, F.lane) * (1.f / DM); float s2 = 0.f;
#pragma unroll
        for (int e = 0; e < 16; ++e) { v[e] -= mean; s2 += v[e] * v[e]; }
        const float rstd = 1.f / sqrtf(wave_sum(s2, F.lane) * (1.f / DM) + LN_EPS);
        const float* mdn = last ? md : mod_ptr(F, l + 1, row);
        float xn[16];
#pragma unroll
        for (int j = 0; j < 4; ++j) { const f32x4 g = *(const GAS f32x4*)(lg + LN2_COL(j)), bb = *(const GAS f32x4*)(lb + LN2_COL(j));
#pragma unroll
            for (int e = 0; e < 4; ++e) xn[4 * j + e] = v[4 * j + e] * rstd * g[e] + bb[e]; }
        if (last) { float* op = F.out + (size_t)row * DM;
#pragma unroll
            for (int j = 0; j < 4; ++j) *(GAS f32x4*)(op + LN2_COL(j)) = (f32x4){xn[4 * j], xn[4 * j + 1], xn[4 * j + 2], xn[4 * j + 3]}; }
        else {
            *(GAS u32x4*)(xr + cA) = (u32x4){pk2(xn[0], xn[1]), pk2(xn[2], xn[3]), pk2(xn[4], xn[5]), pk2(xn[6], xn[7])}; *(GAS u32x4*)(xr + cA + 128) = (u32x4){pk2(xn[8], xn[9]), pk2(xn[10], xn[11]), pk2(xn[12], xn[13]), pk2(xn[14], xn[15])};
            bf16_t* xm = (bf16_t*)(F.ws + WS_XM) + (size_t)row * DM;
            unsigned w[8];
#pragma unroll
            for (int j = 0; j < 4; ++j) { const f32x4 sh = *(const GAS f32x4*)(mdn + LN2_COL(j)), sc = *(const GAS f32x4*)(mdn + 1024 + LN2_COL(j));
                w[2 * j] = pk2(xn[4 * j] * (1.f + sc[0]) + sh[0], xn[4 * j + 1] * (1.f + sc[1]) + sh[1]); w[2 * j + 1] = pk2(xn[4 * j + 2] * (1.f + sc[2]) + sh[2], xn[4 * j + 3] * (1.f + sc[3]) + sh[3]); }
            *(GAS u32x4*)(xm + cA) = (u32x4){w[0], w[1], w[2], w[3]}; *(GAS u32x4*)(xm + cA + 128) = (u32x4){w[4], w[5], w[6], w[7]};
        }
    }
#undef LN2_COL
}

__device__ __forceinline__ unsigned f_ord(float f) { const unsigned u = __builtin_bit_cast(unsigned, f); return (u & 0x80000000u) ? ~u : (u | 0x80000000u); }
__device__ __forceinline__ unsigned long long wave_max_u64(unsigned long long v, int lane) {
#pragma unroll
    for (int o = 1; o < 64; o <<= 1) { const unsigned lo = (unsigned)shxi((int)(unsigned)v, o, lane), hi = (unsigned)shxi((int)(unsigned)(v >> 32), o, lane); const unsigned long long w = ((unsigned long long)hi << 32) | lo; v = w > v ? w : v; }
    return v;
}
__device__ __forceinline__ float seg16_max(float v, int lane) { v = fmaxf(v, shx(v, 1, lane)); v = fmaxf(v, shx(v, 2, lane)); v = fmaxf(v, shx(v, 4, lane)); v = fmaxf(v, shx(v, 8, lane)); return v; }
__device__ __forceinline__ int seg16_min_i(int v, int lane) { int w; w = shxi(v, 1, lane); v = w < v ? w : v; w = shxi(v, 2, lane); v = w < v ? w : v; w = shxi(v, 4, lane); v = w < v ? w : v; w = shxi(v, 8, lane); v = w < v ? w : v; return v; }
template <int CTRL> __device__ __forceinline__ int dpp_i(int v) { return __builtin_amdgcn_update_dpp(0, v, CTRL, 0xf, 0xf, true); }
__device__ __forceinline__ unsigned row_max_u(unsigned v) { unsigned w; w = (unsigned)dpp_i<0xB1>((int)v); v = w > v ? w : v; w = (unsigned)dpp_i<0x4E>((int)v); v = w > v ? w : v; w = (unsigned)dpp_i<0x141>((int)v); v = w > v ? w : v; w = (unsigned)dpp_i<0x140>((int)v); v = w > v ? w : v; return v; }
__device__ __forceinline__ float row_max_f(float v) { v = fmaxf(v, __builtin_bit_cast(float, dpp_i<0xB1>(__builtin_bit_cast(int, v)))); v = fmaxf(v, __builtin_bit_cast(float, dpp_i<0x4E>(__builtin_bit_cast(int, v)))); v = fmaxf(v, __builtin_bit_cast(float, dpp_i<0x141>(__builtin_bit_cast(int, v)))); v = fmaxf(v, __builtin_bit_cast(float, dpp_i<0x140>(__builtin_bit_cast(int, v)))); return v; }
__device__ __forceinline__ int row_min_i(int v) { int w; w = dpp_i<0xB1>(v); v = w < v ? w : v; w = dpp_i<0x4E>(v); v = w < v ? w : v; w = dpp_i<0x141>(v); v = w < v ? w : v; w = dpp_i<0x140>(v); v = w < v ? w : v; return v; }
__device__ __forceinline__ float rdlane_f(float v, int l) { return __builtin_bit_cast(float, __builtin_amdgcn_readlane(__builtin_bit_cast(int, v), l)); }
__device__ __forceinline__ unsigned wave_max_u(unsigned v) {
    v = row_max_u(v);
    const unsigned a = (unsigned)__builtin_amdgcn_readlane((int)v, 0), b = (unsigned)__builtin_amdgcn_readlane((int)v, 16), c = (unsigned)__builtin_amdgcn_readlane((int)v, 32), d = (unsigned)__builtin_amdgcn_readlane((int)v, 48);
    const unsigned ab = a > b ? a : b, cd = c > d ? c : d; return ab > cd ? ab : cd;
}
__device__ __forceinline__ float row_top2(float v, int l16) {
    const float m1 = row_max_f(v);
    const int first = row_min_i(v == m1 ? l16 : 99);
    const float m2 = row_max_f(l16 == first ? -3.0e38f : v);
    return m1 + m2;
}
__device__ __forceinline__ float seg16_top2(float v, int lane) {
    const float m1 = seg16_max(v, lane);
    const int first = seg16_min_i(v == m1 ? (lane & 15) : 99, lane);
    const float m2 = seg16_max((lane & 15) == first ? -3.0e38f : v, lane);
    return m1 + m2;
}
__device__ __forceinline__ void ph_route(Frame& F, int l, int ntok) {
    LAS int* hist = (LAS int*)F.lds;
    LAS int* base = hist + 128;
    LAS unsigned* alist = (LAS unsigned*)(F.lds + 1024);
    const int tpw = (ntok + F.G - 1) / F.G, t0 = F.wg * tpw, t1 = (t0 + tpw) < ntok ? (t0 + tpw) : ntok;
    __syncthreads();
    if (F.tid < 128) hist[F.tid] = 0;
    __syncthreads();
    const float* LG = (const float*)(F.ws + WS_LOGIT); const float* rb = F.in[I_RB] + l * NEXP;
    const float b0 = rb[F.lane], b1 = rb[F.lane + 64];
    constexpr int RT = 4;
    for (int tb = t0 + F.wave * RT; tb < t1; tb += NWAVES * RT) {
        float s0[RT], s1[RT], e0[RT], e1[RT], gs0[RT], gs1[RT]; unsigned h0[RT], h1[RT]; int mye[RT]; float myw[RT], wsum[RT];
#pragma unroll
        for (int j = 0; j < RT; ++j) { const int tok = (tb + j) < t1 ? tb + j : t1 - 1;
            const float x0 = LG[(size_t)tok * 256 + F.lane], x1 = LG[(size_t)tok * 256 + 64 + F.lane];
            const float* rbs = (const float*)(F.ws + WS_RBIAS) + (size_t)(l * 17 + row_b(tok)) * 128; const float y0 = x0 + rbs[F.lane], y1 = x1 + rbs[64 + F.lane];
            s0[j] = __builtin_amdgcn_rcpf(1.0f + __expf(-y0)); s1[j] = __builtin_amdgcn_rcpf(1.0f + __expf(-y1)); e0[j] = s0[j] + b0; e1[j] = s1[j] + b1; }
#pragma unroll
        for (int j = 0; j < RT; ++j) { gs0[j] = row_top2(e0[j], F.lane & 15); gs1[j] = row_top2(e1[j], F.lane & 15); }
#pragma unroll
        for (int j = 0; j < RT; ++j) {
            float gsc[8];
#pragma unroll
            for (int g = 0; g < 4; ++g) { gsc[g] = rdlane_f(gs0[j], g * 16); gsc[4 + g] = rdlane_f(gs1[j], g * 16); }
            unsigned gmask = 0u;
#pragma unroll
            for (int g = 0; g < 8; ++g) { int cnt = 0;
#pragma unroll
                for (int g2 = 0; g2 < 8; ++g2) cnt += (gsc[g2] > gsc[g] || (gsc[g2] == gsc[g] && g2 < g)) ? 1 : 0;
                gmask |= (cnt < 4) ? (1u << g) : 0u; }
            const bool ok0 = (gmask >> (F.lane >> 4)) & 1u, ok1 = (gmask >> (4 + (F.lane >> 4))) & 1u;
            h0[j] = ok0 ? f_ord(e0[j]) : 0u; h1[j] = ok1 ? f_ord(e1[j]) : 0u;
            mye[j] = 0; myw[j] = 0.f; wsum[j] = 0.f; }
#pragma unroll
        for (int k = 0; k < 8; ++k) {
#pragma unroll
            for (int j = 0; j < RT; ++j) {
                const unsigned bh = h0[j] >= h1[j] ? h0[j] : h1[j];
                const unsigned H = wave_max_u(bh);
                const unsigned mylo = h0[j] == H ? (unsigned)(255 - F.lane) : (h1[j] == H ? (unsigned)(255 - 64 - F.lane) : 0u);
                const unsigned Lm = wave_max_u(mylo);
                const int e = 255 - (int)Lm;
                if (e < 64) { if (F.lane == e) h0[j] = 0u; } else { if (F.lane == e - 64) h1[j] = 0u; }
                const float sv = e < 64 ? rdlane_f(s0[j], e) : rdlane_f(s1[j], e - 64);
                wsum[j] += sv; if (F.lane == k) { mye[j] = e; myw[j] = sv; } }
        }
#pragma unroll
        for (int j = 0; j < RT; ++j) { const int tok = tb + j;
            if (tok < t1 && F.lane < 8) {
                const int lr = __hip_atomic_fetch_add(&hist[mye[j]], 1, __ATOMIC_RELAXED, __HIP_MEMORY_SCOPE_WORKGROUP);
                alist[(tok - t0) * 8 + F.lane] = (unsigned)mye[j] | ((unsigned)lr << 8);
                ((int*)(F.ws + WS_EIDX))[(size_t)tok * 8 + F.lane] = mye[j];
                ((float*)(F.ws + WS_WGT))[(size_t)tok * 8 + F.lane] = myw[j] / wsum[j] * 2.5f;
            } }
    }
    __syncthreads();
    if (F.tid < 128) { const int hcount = hist[F.tid]; base[F.tid] = hcount ? (int)atomicAdd(F.ctl + CW_CNT + l * 256 + F.tid, (unsigned)hcount) : 0; }
    __syncthreads();
    for (int a = F.tid; a < (t1 - t0) * 8; a += NTHR) { const unsigned v = alist[a]; ((int*)(F.ws + WS_RNK))[(size_t)t0 * 8 + a] = base[v & 0xffu] + (int)(v >> 8); }
}
__device__ __forceinline__ void ph_positions(Frame& F, int l, int ntok) {
    LAS int* cnt = (LAS int*)F.lds;
    LAS int* off = cnt + 132;
    __syncthreads();
    if (F.tid < NE1) cnt[F.tid] = F.tid < NEXP ? (int)__hip_atomic_load(F.ctl + CW_CNT + l * 256 + F.tid, __ATOMIC_RELAXED, __HIP_MEMORY_SCOPE_AGENT) : ntok;
    __syncthreads();
    if (F.tid == 0) { int o = 0; for (int e = 0; e < NE1; ++e) { off[e] = o; o += (cnt[e] + 255) & ~255; } off[NE1] = o; }
    __syncthreads();
    const int gt = F.wg * NTHR + F.tid, NGT = F.G * NTHR;
    int* rowtok = (int*)(F.ws + WS_ROWTOK); int* rowdst = (int*)(F.ws + WS_ROWDST); int* tile_exp = (int*)(F.ws + WS_TILEEXP);
    const int* eidx = (const int*)(F.ws + WS_EIDX); const int* rnk = (const int*)(F.ws + WS_RNK);
    for (int a = gt; a < ntok * 8; a += NGT) { const int tok = a >> 3, k = a & 7; const int pos = off[eidx[a]] + rnk[a]; rowtok[pos] = tok; rowdst[pos] = tok * 10 + k; }
    for (int tok = gt; tok < ntok; tok += NGT) { const int pos = off[NEXP] + tok; rowtok[pos] = tok; rowdst[pos] = tok * 10 + 8; }
    for (int i = gt; i < NE1 * 256; i += NGT) { const int e = i >> 8, p = i & 255; const int row = off[e] + cnt[e] + p; if (row < off[e + 1]) { rowtok[row] = 0; rowdst[row] = -1; } }
    for (int i = gt; i < NE1 * 320; i += NGT) { const int e = i / 320, p = i % 320; const int t = (off[e] >> 8) + p; if (t < (off[e + 1] >> 8)) tile_exp[t] = e; }
    if (gt == 0) F.ctl[CW_NTL + l] = (unsigned)(off[NE1] >> 8);
}

#ifndef MK_MULTI
#define MK_MULTI 0
#endif
constexpr int PH_PER_LAYER = 12, NPHASE = 2 + DEPTH * PH_PER_LAYER;
struct Args { const float* in[36]; float* out; unsigned char* ws; int ph_lo, ph_hi; };

__global__ void __launch_bounds__(NTHR, 2) mk_fwd(Args args) {
    extern __shared__ __attribute__((aligned(16))) unsigned char lds_raw[];
    Frame F;
    F.lds = (LAS unsigned char*)lds_raw;
    F.tid = threadIdx.x; F.lane = F.tid & 63; F.wave = __builtin_amdgcn_readfirstlane(F.tid >> 6);
    const int wave0 = F.wave;
    F.G = gridDim.x; F.wg = blockIdx.x;
    F.in = args.in;
    F.out = args.out; F.ws = args.ws; F.ctl = (unsigned*)(args.ws + WS_CTL);
    volatile LAS unsigned* MISC = (volatile LAS unsigned*)(F.lds + MISC_OFF);
    if (F.tid < 32) MISC[F.tid] = 0u;
    __syncthreads();
    const int lo = args.ph_lo, hi = args.ph_hi;
    const bool single = (hi - lo) > 1;
    XcdBarrier bar; bar.bar = F.ctl + CW_BAR; bar.x = 0; bar.st = nullptr;
    if (single) bar = xcd_barrier_post(F.ctl + CW_BAR, MISC + 8);
#define IN(k) (lo <= (k) && (k) < hi)
#ifndef PROBE_MASK
#define PROBE_MASK 0
#endif
#define REP(k) for (int _rep = 0; _rep < (((PROBE_MASK >> (k)) & 1) ? 2 : 1); ++_rep)
#define SEAM(k) do { if (IN(k) && IN((k) + 1)) { xcd_barrier(bar); if ((PROBE_MASK >> 15) & 1) xcd_barrier(bar); } } while (0)
#define FRESH() do { int _ln; asm volatile("v_mbcnt_lo_u32_b32 %0, -1, 0\n\tv_mbcnt_hi_u32_b32 %0, -1, %0" : "=v"(_ln)); int _wv = wave0; asm volatile("" : "+s"(_wv)); F.lane = _ln; F.wave = _wv; F.tid = (_wv << 6) | _ln; \
        unsigned char* _w = args.ws; asm volatile("" : "+s"(_w)); F.ws = _w; F.ctl = (unsigned*)(_w + WS_CTL); float* _o = args.out; asm volatile("" : "+s"(_o)); F.out = _o; } while (0)

    if (IN(0)) { FRESH(); REP(13) { p0_static_weights(F); __syncthreads(); } REP(14) { p0_mod(F); __syncthreads(); } FRESH(); REP(16) { p0_hyena_filters(F); __syncthreads(); } }
    SEAM(0);
    if (IN(1)) { FRESH(); p0_init_rows(F); __syncthreads(); FRESH(); p1_router_weights(F); }
    SEAM(1);
#pragma unroll 1
    for (int l = 0; l < DEPTH; ++l) {
        const int pb = 2 + l * PH_PER_LAYER; const bool last = (l == DEPTH - 1); const int ntok = last ? NLAT : NROW;
        if (IN(pb + 0)) { FRESH();
            REP(0) { p_expert_weights(F, l); __syncthreads(); }
            { pg8::ColMapOrder S; S.b.init(NROW, 11 * 256, F.G, F.wg); S.map = 0xCBA98763210ull; pg8::EpiBf16 E{(bf16_t*)(F.ws + WS_U), DIN};
              REP(1) pg8::gemm_phase<pg8::EpiBf16, pg8::ColMapOrder, false>(F.tid, F.lds, (const bf16_t*)(F.ws + WS_XM), (const bf16_t*)(F.ws + WS_WIN) + (size_t)l * DIN * DM, DM, nullptr, S, E); }
            __syncthreads(); FRESH();
            { pg8::ColMapOrder S; S.b.init(NROW, 2 * 256, F.G, (F.wg + 80) % F.G); S.map = 0x54ull; pg8::EpiVT E{(bf16_t*)(F.ws + WS_VT), UV};
              REP(1) pg8::gemm_phase<pg8::EpiVT, pg8::ColMapOrder, false, false, true, true, false, true>(F.tid, F.lds, (const bf16_t*)(F.ws + WS_XM), (const bf16_t*)(F.ws + WS_WIN) + (size_t)l * DIN * DM, DM, nullptr, S, E); }
        }
        SEAM(pb + 0);
        if (IN(pb + 1)) { FRESH(); REP(2) { ph_transposes(F, l); __syncthreads(); } FRESH(); REP(3) { ph_gla_local(F, l); __syncthreads(); } }
        SEAM(pb + 1);
        if (IN(pb + 2)) { FRESH(); REP(4) { ph_na(F, l, last); } FRESH(); REP(5) { ph_gla_scan(F); } __syncthreads(); FRESH(); REP(6) { ph_hyena(F, l, last); } }
        SEAM(pb + 2);
        if (IN(pb + 3)) { FRESH(); ph_hy_transpose(F, last); __syncthreads(); FRESH(); REP(7) { ph_gla_out(F, l, last); } }
        SEAM(pb + 3);
        if (IN(pb + 4)) { FRESH();
            pg8::DenseOrder S; S.init(ntok, DM, F.G, F.wg); pg8::EpiY8 E{(unsigned char*)(F.ws + WS_Y), DM};
            REP(8) pg8::gemm_phase<pg8::EpiY8, pg8::DenseOrder, false>(F.tid, F.lds, (const bf16_t*)(F.ws + WS_MIX), (const bf16_t*)(F.ws + WS_WOUT) + (size_t)l * DM * DM, DM, nullptr, S, E);
        }
        SEAM(pb + 4);
        if (IN(pb + 5)) { FRESH(); ph_ln1(F, l, ntok); }
        SEAM(pb + 5);
        if (IN(pb + 6)) { FRESH();
            pg8::RouterOrder S; S.b.init(ntok, 256, F.G, F.wg); pg8::EpiF32H E{(float*)(F.ws + WS_LOGIT), 256};
            REP(9) pg8::gemm_phase<pg8::EpiF32H, pg8::RouterOrder, false, false, true, true, true>(F.tid, F.lds, (const bf16_t*)(F.ws + WS_XR), (const bf16_t*)(F.ws + WS_WRB) + (size_t)l * 17 * 128 * DM, DM, nullptr, S, E);
        }
        SEAM(pb + 6);
        if (IN(pb + 7)) { FRESH(); ph_route(F, l, ntok); }
        SEAM(pb + 7);
        if (IN(pb + 8)) { FRESH(); REP(12) { ph_positions(F, l, ntok); __syncthreads(); } }
        SEAM(pb + 8);
        if (IN(pb + 9)) { FRESH();
            const int ntl = (int)__hip_atomic_load(F.ctl + CW_NTL + l, __ATOMIC_RELAXED, __HIP_MEMORY_SCOPE_AGENT);
            pg8::GroupedOrder S; S.init(ntl, 2, F.G, F.wg); S.preload((const int*)(F.ws + WS_TILEEXP), F.lds + pg8::STAGE_BYTES + 4096, F.tid, NTHR); pg8::EpiSwiglu E{(unsigned char*)(F.ws + WS_ACT)};
            REP(10) pg8::gemm_phase<pg8::EpiSwiglu, pg8::GroupedOrder, true, true>(F.tid, F.lds, (const void*)(F.ws + WS_XM8), (const void*)(F.ws + WS_EXP1), DM, (const int*)(F.ws + WS_ROWTOK), S, E);
        }
        SEAM(pb + 9);
        if (IN(pb + 10)) { FRESH();
            const int ntl = (int)__hip_atomic_load(F.ctl + CW_NTL + l, __ATOMIC_RELAXED, __HIP_MEMORY_SCOPE_AGENT);
            pg8::GroupedOrder S; S.init(ntl, 4, F.G, F.wg); S.preload((const int*)(F.ws + WS_TILEEXP), F.lds + pg8::STAGE_BYTES + 4096, F.tid, NTHR); pg8::EpiScatter E{(unsigned char*)(F.ws + WS_Y2), (const int*)(F.ws + WS_ROWDST)};
            REP(11) pg8::gemm_phase<pg8::EpiScatter, pg8::GroupedOrder, false, true>(F.tid, F.lds, (const void*)(F.ws + WS_ACT), (const void*)(F.ws + WS_EXP2), EH, nullptr, S, E);
        }
        SEAM(pb + 10);
        if (IN(pb + 11)) { FRESH(); ph_ln2(F, l, ntok, last); }
        SEAM(pb + 11);
    }
#undef IN
#undef SEAM
#undef FRESH
}

extern "C" void kernel_launch(void* const* d_in, const int* in_sizes, int n_in, void* d_out, int out_size, void* d_ws, size_t ws_size, hipStream_t stream) {
    static int grid = 0;
    if (grid == 0) {
        if (n_in != 36 || out_size != NLAT * DM || ws_size < WS_END) { fprintf(stderr, "kernel_launch: unexpected shapes (n_in %d out %d ws %zu need %zu)\n", n_in, out_size, ws_size, (size_t)WS_END); grid = -1; return; }
        int dev = 0, cus = 0, per_cu = 0;
        if (hipGetDevice(&dev) != hipSuccess || hipDeviceGetAttribute(&cus, hipDeviceAttributeMultiprocessorCount, dev) != hipSuccess) { grid = -1; return; }
        if (hipFuncSetAttribute((const void*)mk_fwd, hipFuncAttributeMaxDynamicSharedMemorySize, LDS_BYTES) != hipSuccess) { fprintf(stderr, "kernel_launch: hipFuncSetAttribute failed\n"); grid = -1; return; }
        if (hipOccupancyMaxActiveBlocksPerMultiprocessor(&per_cu, (const void*)mk_fwd, NTHR, LDS_BYTES) != hipSuccess || per_cu < 1) { fprintf(stderr, "kernel_launch: occupancy query says %d\n", per_cu); }
        (void)hipGetLastError();
        grid = cus;
    }
    if (grid < 0) return;
    (void)hipMemsetAsync((char*)d_ws + WS_CTL, 0, CTL_BYTES, stream);
    Args a{};
    for (int i = 0; i < 36; ++i) a.in[i] = (const float*)d_in[i];
    a.out = (float*)d_out; a.ws = (unsigned char*)d_ws;
#if MK_MULTI
    for (int p = 0; p < NPHASE; ++p) { a.ph_lo = p; a.ph_hi = p + 1; hipLaunchKernelGGL(mk_fwd, dim3(grid), dim3(NTHR), LDS_BYTES, stream, a); }
#else
    a.ph_lo = 0; a.ph_hi = NPHASE; hipLaunchKernelGGL(mk_fwd, dim3(grid), dim3(NTHR), LDS_BYTES, stream, a);
#endif
}
```

```cpp
#include <hip/hip_runtime.h>
#include <cstdio>
#include <cstdint>

#define LAS __attribute__((address_space(3)))
#define GAS __attribute__((address_space(1)))
typedef unsigned short bf16_t;
typedef short bf16x8 __attribute__((ext_vector_type(8)));
typedef float f32x4 __attribute__((ext_vector_type(4)));
typedef float f32x2 __attribute__((ext_vector_type(2)));
typedef unsigned u32x4 __attribute__((ext_vector_type(4)));
typedef unsigned u32x2 __attribute__((ext_vector_type(2)));

constexpr int NB = 16, SEQ = 4096, CTXL = 256, DM = 1024, DEPTH = 4;
constexpr int NLAT = NB * SEQ;
constexpr int NCTX = NB * CTXL;
constexpr int NROW = NLAT + NCTX;
constexpr int SPB = SEQ + CTXL;
constexpr int DIN_REF = 3104;
constexpr int DIN = 3328;
constexpr int UQ = 0, UK = 512, UV = 1024, UGQ = 1536, UGK = 1664, UGV = 1792, UGR = 2048, UHY = 2304, ULAF = 3072, ULAB = 3200;
constexpr int NEXP = 128, TOPK = 8, EH = 256;
constexpr int NE1 = NEXP + 1;
constexpr int RMAX = 659712;
constexpr int TMAX = RMAX / 256;
constexpr float LN_EPS = 1e-6f;
constexpr float DN_ALPHA = 1.6817928305074290f;

__device__ __forceinline__ unsigned f2bf(float f) { unsigned u = __builtin_bit_cast(unsigned, f); return (u + 0x7fffu + ((u >> 16) & 1u)) >> 16; }
typedef __bf16 bf16v2 __attribute__((ext_vector_type(2)));
__device__ __forceinline__ unsigned pk2(float lo, float hi) { const f32x2 v = {lo, hi}; const bf16v2 b = __builtin_convertvector(v, bf16v2); return __builtin_bit_cast(unsigned, b); }
__device__ __forceinline__ float bf2f(unsigned short b) { return __builtin_bit_cast(float, ((unsigned)b) << 16); }
__device__ __forceinline__ float bflo(unsigned w) { return __builtin_bit_cast(float, w << 16); }
__device__ __forceinline__ float bfhi(unsigned w) { return __builtin_bit_cast(float, w & 0xffff0000u); }
__device__ __forceinline__ float shx(float v, int o, int lane) { return __builtin_bit_cast(float, __builtin_amdgcn_ds_bpermute((lane ^ o) << 2, __builtin_bit_cast(int, v))); }
__device__ __forceinline__ int shxi(int v, int o, int lane) { return __builtin_amdgcn_ds_bpermute((lane ^ o) << 2, v); }
__device__ __forceinline__ float shf(float v, int src) { return __builtin_bit_cast(float, __builtin_amdgcn_ds_bpermute(src << 2, __builtin_bit_cast(int, v))); }
__device__ __forceinline__ float wave_sum(float v, int lane) {
#pragma unroll
    for (int o = 1; o < 64; o <<= 1) v += shx(v, o, lane);
    return v;
}
__device__ __forceinline__ void unpack8(const u32x4 q, float* o) { o[0] = bflo(q.x); o[1] = bfhi(q.x); o[2] = bflo(q.y); o[3] = bfhi(q.y); o[4] = bflo(q.z); o[5] = bfhi(q.z); o[6] = bflo(q.w); o[7] = bfhi(q.w); }
__device__ __forceinline__ float silu_f(float x) { return x * __builtin_amdgcn_rcpf(1.0f + __expf(-x)); }
#define LDS_WAIT() asm volatile("s_waitcnt lgkmcnt(0)" ::: "memory")
#define VM_WAIT() asm volatile("s_waitcnt vmcnt(0)" ::: "memory")

#define XB_TMO      128
#define XB_XCNT(j)  (256  + 64 * (j))
#define XB_XSUB(j)  (1280 + 64 * (j))
#define XB_XGEN(j)  (2304 + 64 * (j))
#define XB_TOP      3328
#define XB_TOPGEN   3392
#define XCD_BAR_WORDS 3456
#define XB_SPIN_CAP (1u << 18)

__device__ __forceinline__ unsigned xb_ld(unsigned* p)              { return __hip_atomic_load(p, __ATOMIC_RELAXED, __HIP_MEMORY_SCOPE_AGENT); }
__device__ __forceinline__ unsigned xb_add(unsigned* p, unsigned v) { return __hip_atomic_fetch_add(p, v, __ATOMIC_RELAXED, __HIP_MEMORY_SCOPE_AGENT); }
__device__ __forceinline__ unsigned xb_xcc_id() { return (unsigned)__builtin_amdgcn_s_getreg((3 << 11) | 20) & 0xFu; }
#define XB_SPIN(cond, bar) do { unsigned _sp = 0; while (cond) { __builtin_amdgcn_s_sleep(1); \
    if ((++_sp & 255u) == 0u) { if (xb_ld(&(bar)[XB_TMO])) break; if (_sp > XB_SPIN_CAP) { atomicAdd(&(bar)[XB_TMO], 1u); break; } } } } while (0)

struct XcdBarrier { unsigned* bar; unsigned x; volatile LAS unsigned* st; };

__device__ __forceinline__ XcdBarrier xcd_barrier_post(unsigned* bar, volatile LAS unsigned* st) {
    XcdBarrier b; b.bar = bar; b.x = xb_xcc_id(); b.st = st;
    if (threadIdx.x == 0) (void)xb_add(&bar[XB_XCNT(b.x)], 1u);
    return b;
}
__device__ __forceinline__ void xcd_barrier_complete(unsigned* bar, unsigned x, unsigned& nloc, unsigned& nx) {
    const unsigned G = gridDim.x * gridDim.y * gridDim.z;
    unsigned sum, cnt, mine, sp = 0u;
    for (;;) {
        sum = 0u; cnt = 0u; mine = 0u;
#pragma unroll
        for (unsigned j = 0; j < 16; ++j) { const unsigned c = xb_ld(&bar[XB_XCNT(j)]); sum += c; cnt += (c > 0u) ? 1u : 0u; mine = (j == x) ? c : mine; }
        if (sum == G) break;
        __builtin_amdgcn_s_sleep(1);
        if ((++sp & 255u) == 0u) { if (xb_ld(&bar[XB_TMO])) break; if (sp > XB_SPIN_CAP) { atomicAdd(&bar[XB_TMO], 1u); break; } }
    }
    nloc = mine > 0u ? mine : 1u; nx = cnt > 0u ? cnt : 1u;
}
__device__ __forceinline__ void xcd_barrier(const XcdBarrier& b) {
    asm volatile("s_waitcnt vmcnt(0)" ::: "memory");
    __syncthreads();
    if (threadIdx.x == 0) {
        unsigned* bar = b.bar;
        __builtin_amdgcn_s_waitcnt(0);
        unsigned nloc = b.st[0], nx = b.st[1];
        if (nloc == 0u) { xcd_barrier_complete(bar, b.x, nloc, nx); b.st[0] = nloc; b.st[1] = nx; }
        const unsigned old = xb_add(&bar[XB_XSUB(b.x)], 1u);
        const unsigned gen = old / nloc;
        if (old + 1u == (gen + 1u) * nloc) {
            __builtin_amdgcn_fence(__ATOMIC_RELEASE, "agent");
            asm volatile("s_waitcnt vmcnt(0)" ::: "memory");
            const unsigned og = xb_add(&bar[XB_TOP], 1u);
            const unsigned tg = og / nx;
            if (og + 1u == (tg + 1u) * nx) xb_add(&bar[XB_TOPGEN], 1u);
            else XB_SPIN(xb_ld(&bar[XB_TOPGEN]) == tg, bar);
            __builtin_amdgcn_fence(__ATOMIC_ACQUIRE, "agent");
            xb_add(&bar[XB_XGEN(b.x)], 1u);
            asm volatile("s_waitcnt vmcnt(0)" ::: "memory");
        } else {
            XB_SPIN(xb_ld(&bar[XB_XGEN(b.x)]) == gen, bar);
            __builtin_amdgcn_fence(__ATOMIC_ACQUIRE, "agent");
            asm volatile("s_waitcnt vmcnt(0)" ::: "memory");
        }
    }
    __syncthreads();
}

namespace pg8 {
constexpr int BM = 256, BK = 64, HALF = 128, HTB = HALF * BK * 2, STAGE_BYTES = 8 * HTB, NXCD = 8, WGM = 8;
__host__ __device__ __forceinline__ int lds_byte(int r, int c) { const int st = (r >> 4) * 2 + (c >> 5), rr = r & 15, cc = c & 31, ob = rr * 64 + cc * 2; return st * 1024 + (ob ^ (((ob >> 9) & 1) << 5)); }
__host__ __device__ __forceinline__ void stage_rc(int b, int& R, int& C) { const int st = b / 1024, sb = b % 1024, swz = sb ^ (((sb >> 9) & 1) << 5); R = (st >> 1) * 16 + swz / 64; C = (st & 1) * 32 + (swz % 64) / 2; }
__host__ __device__ __forceinline__ int perm32(int rho) { const int n = rho >> 4, i = rho & 15; return 8 * (i >> 2) + 4 * n + (i & 3); }

struct Unit { int arow0, brow0, orow0, ocol0, aux; };

struct DenseOrder {
    int nM, nN, nwg, G, c;
    __device__ void init(int M, int N, int G_, int c_) { nM = M / BM; nN = N / BM; nwg = nM * nN; G = G_; c = c_; }
    __device__ __forceinline__ bool next(int i, Unit& u) const {
        const long L = (long)i * G + c; if (L >= nwg) return false;
        int wgid = (int)L; { const int q = nwg / NXCD, r = nwg % NXCD, xcd = wgid % NXCD, off = wgid / NXCD; wgid = (xcd < r ? xcd * (q + 1) : r * (q + 1) + (xcd - r) * q) + off; }
        const int nig = WGM * nN, gid = wgid / nig, fm = gid * WGM, gsz = (nM - fm) < WGM ? (nM - fm) : WGM;
        const int pm = fm + ((wgid % nig) % gsz), pn = (wgid % nig) / gsz;
        u.arow0 = pm * BM; u.brow0 = pn * BM; u.orow0 = pm * BM; u.ocol0 = pn * BM; u.aux = 0; return true;
    }
};
struct GroupedOrder {
    const LAS unsigned char* tab; int nN, nslot, slot, t0, t1;
    __device__ __forceinline__ void init(int ntiles, int nN_, int G, int c) {
        nN = nN_;
        if ((G & 7) == 0) { const int per = (ntiles + 7) >> 3, x = c & 7; nslot = G >> 3; slot = c >> 3; t0 = x * per; t1 = (t0 + per) < ntiles ? (t0 + per) : ntiles; }
        else { nslot = G; slot = c; t0 = 0; t1 = ntiles; }
    }
    __device__ __forceinline__ void preload(const int* tile_exp, LAS unsigned char* lds_tab, int tid, int nthr) {
        __syncthreads();
        for (int i = tid; i < t1 - t0; i += nthr) lds_tab[i] = (unsigned char)tile_exp[t0 + i];
        __syncthreads();
        tab = lds_tab;
    }
    __device__ __forceinline__ bool next(int i, Unit& u) const {
        const int q = i * nslot + slot, t = t0 + q / nN, pn = q % nN;
        if (t >= t1) return false;
        const int e = (int)tab[t - t0];
        u.arow0 = t * BM; u.brow0 = (e * nN + pn) * BM; u.orow0 = t * BM; u.ocol0 = pn * BM; u.aux = e; return true;
    }
};

struct RouterOrder {
    DenseOrder b;
    __device__ __forceinline__ bool next(int i, Unit& u) const { if (!b.next(i, u)) return false; const int pm = u.arow0 >> 8; u.brow0 = (pm < 256 ? (pm >> 4) : 16) * 128; return true; }
};
struct ColMapOrder {
    DenseOrder b; unsigned long long map;
    __device__ __forceinline__ bool next(int i, Unit& u) const { if (!b.next(i, u)) return false; const int ph = (int)((map >> ((u.ocol0 >> 8) * 4)) & 15ull); u.brow0 = ph * BM; u.ocol0 = ph * BM; return true; }
};
template <class Base> struct RangeOrder {
    Base b; int i0, i1;
    __device__ __forceinline__ bool next(int i, Unit& u) const { const int j = i + i0; if (j >= i1) return false; return b.next(j, u); }
};

__device__ __forceinline__ unsigned cvt_pk_bf16(float lo, float hi) { return pk2(lo, hi); }

struct NoPre {};
struct EpiF32 {
    static constexpr bool PERM = false; static constexpr int SCW = 0x7A7A7A7A; typedef NoPre Pre;
    __device__ __forceinline__ Pre prefetch(const Unit&, LAS unsigned char*, int, int, int) const { return Pre{}; }
    float* C; int ldc;
    __device__ __forceinline__ void operator()(const f32x4 (&acc)[2][2][4][2], const Unit& u, int wr, int wc, int fr, int fq, const Pre&, bool drain) const {
        if (drain) asm volatile("s_waitcnt vmcnt(0)" ::: "memory");
        const int row0 = u.orow0 + wr * 64 + fr, col0 = u.ocol0 + wc * 32 + 4 * fq;
#pragma unroll
        for (int ai = 0; ai < 2; ++ai)
#pragma unroll
            for (int m = 0; m < 4; ++m) { float* rowp = C + (size_t)(row0 + ai * HALF + m * 16) * ldc + col0;
#pragma unroll
                for (int bj = 0; bj < 2; ++bj)
#pragma unroll
                    for (int n = 0; n < 2; ++n) *(GAS f32x4*)(rowp + bj * HALF + n * 16) = acc[ai][bj][m][n]; }
    }
};
struct EpiF32H {
    static constexpr bool PERM = false; static constexpr int SCW = 0x7A7A7A7A; typedef NoPre Pre;
    __device__ __forceinline__ Pre prefetch(const Unit&, LAS unsigned char*, int, int, int) const { return Pre{}; }
    float* C; int ldc;
    __device__ __forceinline__ void operator()(const f32x4 (&acc)[2][2][4][2], const Unit& u, int wr, int wc, int fr, int fq, const Pre&, bool drain) const {
        if (drain) asm volatile("s_waitcnt vmcnt(0)" ::: "memory");
        const int row0 = u.orow0 + wr * 64 + fr, col0 = wc * 32 + 4 * fq;
#pragma unroll
        for (int ai = 0; ai < 2; ++ai)
#pragma unroll
            for (int m = 0; m < 4; ++m) { float* rowp = C + (size_t)(row0 + ai * HALF + m * 16) * ldc + col0;
#pragma unroll
                for (int n = 0; n < 2; ++n) *(GAS f32x4*)(rowp + n * 16) = acc[ai][0][m][n]; }
    }
};
struct EpiBf16 {
    static constexpr bool PERM = true; static constexpr int SCW = 0x7A7A7A7A; typedef NoPre Pre;
    __device__ __forceinline__ Pre prefetch(const Unit&, LAS unsigned char*, int, int, int) const { return Pre{}; }
    bf16_t* O; int ldc;
    __device__ __forceinline__ void operator()(const f32x4 (&acc)[2][2][4][2], const Unit& u, int wr, int wc, int fr, int fq, const Pre&, bool drain) const {
        const int row0 = u.orow0 + wr * 64 + fr, col0 = u.ocol0 + wc * 32 + 8 * fq;
        u32x4 w[2][4][2];
#pragma unroll
        for (int ai = 0; ai < 2; ++ai)
#pragma unroll
            for (int m = 0; m < 4; ++m)
#pragma unroll
                for (int bj = 0; bj < 2; ++bj) { const f32x4 v0 = acc[ai][bj][m][0], v1 = acc[ai][bj][m][1];
                    w[ai][m][bj].x = cvt_pk_bf16(v0[0], v0[1]); w[ai][m][bj].y = cvt_pk_bf16(v0[2], v0[3]); w[ai][m][bj].z = cvt_pk_bf16(v1[0], v1[1]); w[ai][m][bj].w = cvt_pk_bf16(v1[2], v1[3]); }
        if (drain) asm volatile("s_waitcnt vmcnt(0)" ::: "memory");
#pragma unroll
        for (int ai = 0; ai < 2; ++ai)
#pragma unroll
            for (int m = 0; m < 4; ++m) { bf16_t* rowp = O + (size_t)(row0 + ai * HALF + m * 16) * ldc + col0;
#pragma unroll
                for (int bj = 0; bj < 2; ++bj) *(GAS u32x4*)(rowp + bj * HALF) = w[ai][m][bj]; }
    }
};
struct EpiVT {
    static constexpr bool PERM = false; static constexpr int SCW = 0x7A7A7A7A; typedef NoPre Pre;
    __device__ __forceinline__ Pre prefetch(const Unit&, LAS unsigned char*, int, int, int) const { return Pre{}; }
    bf16_t* VT; int col_base;
    __device__ __forceinline__ void operator()(const f32x4 (&acc)[2][2][4][2], const Unit& u, int wr, int wc, int fr, int fq, const Pre&, bool drain) const {
        if (drain) asm volatile("s_waitcnt vmcnt(0)" ::: "memory");
        const int r0 = u.orow0; int b, pos0;
        if (r0 < NLAT) { b = r0 >> 12; pos0 = r0 & 4095; } else { b = (r0 - NLAT) >> 8; pos0 = SEQ + ((r0 - NLAT) & 255); }
        bf16_t* base = VT + ((size_t)b * 512 + (u.ocol0 - col_base) + wc * 32 + fr) * SPB + pos0 + wr * 64 + 4 * fq;
#pragma unroll
        for (int ai = 0; ai < 2; ++ai)
#pragma unroll
            for (int bj = 0; bj < 2; ++bj)
#pragma unroll
                for (int m = 0; m < 4; ++m)
#pragma unroll
                    for (int n = 0; n < 2; ++n) { const f32x4 v = acc[ai][bj][m][n];
                        *(GAS u32x2*)(base + (size_t)(bj * HALF + n * 16) * SPB + ai * HALF + m * 16) = (u32x2){cvt_pk_bf16(v[0], v[1]), cvt_pk_bf16(v[2], v[3])}; }
    }
};
struct EpiY8 {
    static constexpr bool PERM = true; static constexpr int SCW = 0x7A7A7A7A; typedef NoPre Pre;
    __device__ __forceinline__ Pre prefetch(const Unit&, LAS unsigned char*, int, int, int) const { return Pre{}; }
    unsigned char* O; int ldc;
    __device__ __forceinline__ void operator()(const f32x4 (&acc)[2][2][4][2], const Unit& u, int wr, int wc, int fr, int fq, const Pre&, bool drain) const {
        const int row0 = u.orow0 + wr * 64 + fr;
        u32x4 o[2][4];
#pragma unroll
        for (int ai = 0; ai < 2; ++ai)
#pragma unroll
            for (int m = 0; m < 4; ++m) { int w[4];
#pragma unroll
                for (int bj = 0; bj < 2; ++bj) { const f32x4 v0 = acc[ai][bj][m][0], v1 = acc[ai][bj][m][1];
                    int w0 = 0, w1 = 0;
                    w0 = __builtin_amdgcn_cvt_pk_fp8_f32(v0[0], v0[1], w0, false); w0 = __builtin_amdgcn_cvt_pk_fp8_f32(v0[2], v0[3], w0, true);
                    w1 = __builtin_amdgcn_cvt_pk_fp8_f32(v1[0], v1[1], w1, false); w1 = __builtin_amdgcn_cvt_pk_fp8_f32(v1[2], v1[3], w1, true);
                    w[2 * bj] = w0; w[2 * bj + 1] = w1; }
                o[ai][m] = (u32x4){(unsigned)w[0], (unsigned)w[1], (unsigned)w[2], (unsigned)w[3]}; }
        if (drain) asm volatile("s_waitcnt vmcnt(0)" ::: "memory");
#pragma unroll
        for (int ai = 0; ai < 2; ++ai)
#pragma unroll
            for (int m = 0; m < 4; ++m) *(GAS u32x4*)(O + (size_t)(row0 + ai * HALF + m * 16) * ldc + u.ocol0 + wc * 64 + fq * 16) = o[ai][m];
    }
};
struct EpiSwiglu {
    static constexpr bool PERM = true; static constexpr int SCW = 0x7A7A7A7A; typedef NoPre Pre;
    __device__ __forceinline__ Pre prefetch(const Unit&, LAS unsigned char*, int, int, int) const { return Pre{}; }
    unsigned char* ACT;
    __device__ __forceinline__ void operator()(const f32x4 (&acc)[2][2][4][2], const Unit& u, int wr, int wc, int fr, int fq, const Pre&, bool drain) const {
        const int row0 = u.orow0 + wr * 64 + fr, pn = u.ocol0 >> 8;
        u32x2 o[2][4];
#pragma unroll
        for (int ai = 0; ai < 2; ++ai)
#pragma unroll
            for (int m = 0; m < 4; ++m) {
                int w[2];
#pragma unroll
                for (int n = 0; n < 2; ++n) { const f32x4 g = acc[ai][0][m][n], up = acc[ai][1][m][n];
                    f32x4 e;
#pragma unroll
                    for (int i = 0; i < 4; ++i) e[i] = __builtin_amdgcn_exp2f(-g[i]);
                    const f32x4 d = e + 1.0f; f32x4 r;
#pragma unroll
                    for (int i = 0; i < 4; ++i) r[i] = __builtin_amdgcn_rcpf(d[i]);
                    const f32x4 h = (g * up) * r;
                    int v = 0; v = __builtin_amdgcn_cvt_pk_fp8_f32(h[0], h[1], v, false); v = __builtin_amdgcn_cvt_pk_fp8_f32(h[2], h[3], v, true); w[n] = v; }
                o[ai][m] = (u32x2){(unsigned)w[0], (unsigned)w[1]}; }
        if (drain) asm volatile("s_waitcnt vmcnt(0)" ::: "memory");
#pragma unroll
        for (int ai = 0; ai < 2; ++ai)
#pragma unroll
            for (int m = 0; m < 4; ++m) *(GAS u32x2*)(ACT + (size_t)(row0 + ai * HALF + m * 16) * EH + pn * 128 + wc * 32 + 8 * fq) = o[ai][m];
    }
};
constexpr float Y2_SCALE = 8.0f, Y2_INV = 1.0f / 8.0f;
struct EpiScatter {
    static constexpr bool PERM = true; static constexpr int SCW = 0x7D7D7D7D;
    struct Pre { const LAS int* tab; };
    unsigned char* Y2; const int* rowdst;
    __device__ __forceinline__ Pre prefetch(const Unit& u, LAS unsigned char* lds, int wid, int lane, int ui) const {
        LAS unsigned char* tab = lds + STAGE_BYTES + (ui & 1) * 1024;
        if (wid < 4) __builtin_amdgcn_global_load_lds((const unsigned*)(rowdst + u.orow0 + wid * 64 + lane), (LAS unsigned*)(tab + wid * 256), 4, 0, 0);
        Pre p; p.tab = (const LAS int*)tab; return p; }
    __device__ __forceinline__ void operator()(const f32x4 (&acc)[2][2][4][2], const Unit& u, int wr, int wc, int fr, int fq, const Pre& pre, bool drain) const {
        if (u.aux == 128) {
            u32x4 o[2][4];
#pragma unroll
            for (int ai = 0; ai < 2; ++ai)
#pragma unroll
                for (int m = 0; m < 4; ++m) { int w[4];
#pragma unroll
                    for (int bj = 0; bj < 2; ++bj) { const f32x4 v0 = acc[ai][bj][m][0], v1 = acc[ai][bj][m][1];
                        int w0 = 0, w1 = 0;
                        w0 = __builtin_amdgcn_cvt_pk_fp8_f32(v0[0], v0[1], w0, false); w0 = __builtin_amdgcn_cvt_pk_fp8_f32(v0[2], v0[3], w0, true);
                        w1 = __builtin_amdgcn_cvt_pk_fp8_f32(v1[0], v1[1], w1, false); w1 = __builtin_amdgcn_cvt_pk_fp8_f32(v1[2], v1[3], w1, true);
                        w[2 * bj] = w0; w[2 * bj + 1] = w1; }
                    o[ai][m] = (u32x4){(unsigned)w[0], (unsigned)w[1], (unsigned)w[2], (unsigned)w[3]}; }
            if (drain) asm volatile("s_waitcnt vmcnt(0)" ::: "memory");
#pragma unroll
            for (int ai = 0; ai < 2; ++ai)
#pragma unroll
                for (int m = 0; m < 4; ++m) { const int dst = pre.tab[wr * 64 + fr + ai * HALF + m * 16];
                    if (dst >= 0) *(GAS u32x4*)(Y2 + (size_t)dst * 512 + u.ocol0 + wc * 64 + fq * 16) = o[ai][m]; }
        } else {
            u32x2 o[2][4];
#pragma unroll
            for (int ai = 0; ai < 2; ++ai)
#pragma unroll
                for (int m = 0; m < 4; ++m) { unsigned w[2];
#pragma unroll
                    for (int bj = 0; bj < 2; ++bj) { const f32x4 v0 = acc[ai][bj][m][0], v1 = acc[ai][bj][m][1];
                        unsigned x = 0u;
                        x = __builtin_amdgcn_cvt_scalef32_pk_fp4_f32(x, v0[0], v0[1], 1.0f, 0); x = __builtin_amdgcn_cvt_scalef32_pk_fp4_f32(x, v0[2], v0[3], 1.0f, 1);
                        x = __builtin_amdgcn_cvt_scalef32_pk_fp4_f32(x, v1[0], v1[1], 1.0f, 2); x = __builtin_amdgcn_cvt_scalef32_pk_fp4_f32(x, v1[2], v1[3], 1.0f, 3);
                        w[bj] = x; }
                    o[ai][m] = (u32x2){w[0], w[1]}; }
            if (drain) asm volatile("s_waitcnt vmcnt(0)" ::: "memory");
#pragma unroll
            for (int ai = 0; ai < 2; ++ai)
#pragma unroll
                for (int m = 0; m < 4; ++m) { const int dst = pre.tab[wr * 64 + fr + ai * HALF + m * 16];
                    if (dst >= 0) *(GAS u32x2*)(Y2 + (size_t)dst * 512 + (u.ocol0 >> 1) + wc * 32 + fq * 8) = o[ai][m]; }
        }
    }
};

typedef int v8i __attribute__((ext_vector_type(8)));
typedef int v4i __attribute__((ext_vector_type(4)));
struct Frag { bf16x8 p[2]; __device__ __forceinline__ bf16x8& operator[](int k) { return p[k]; } __device__ __forceinline__ const bf16x8& operator[](int k) const { return p[k]; } };
template <class Epi, class Sched, bool GATHER, bool F8 = false, bool ALIGN_EPI = true, bool SP2 = true, bool NHALF = false, bool SWAP = false>
__device__ __forceinline__ void gemm_phase(const int tid_in, LAS unsigned char* lds, const void* Ag, const void* Bg, const int K, const int* rowidx, const Sched& S, const Epi& E) {
    int tid_ = tid_in; asm volatile("" : "+v"(tid_));
    const int tid = tid_, wid = __builtin_amdgcn_readfirstlane(tid >> 6), lane = tid & 63, wr = wid >> 2, wc = wid & 3, fr = lane & 15, fq = lane >> 4;
    const int KB = F8 ? K : 2 * K;
    const int nt = KB / 128;
    unsigned voffB[2];
#pragma unroll
    for (int i = 0; i < 2; ++i) { int R, C; stage_rc(tid * 16 + i * 8192, R, C); const int Rb = Epi::PERM ? ((R & ~31) + perm32(R & 31)) : R;
        voffB[i] = (unsigned)(Rb * KB + C * 2); }
    const size_t kstep = (size_t)128;
    const size_t hstep = (size_t)HALF * KB;
    const unsigned ldsw = (unsigned)wid * 1024u;
    const int aoff = F8 ? lds_byte(wr * 64 + fr, 16 * fq) : lds_byte(wr * 64 + fr, fq * 8), boff = F8 ? lds_byte(wc * 32 + fr, 16 * fq) : lds_byte(wc * 32 + fr, fq * 8);
    constexpr int PIECE1 = F8 ? 16 : 1024;
    const int sc_w = Epi::SCW, sc_a = 0x7F7F7F7F;
#define PG8_SA(b, h) (((b) * 2 + (h)) * HTB)
#define PG8_SB(b, h) ((4 + (b) * 2 + (h)) * HTB)
#define PG8_STAGE_B(bufoff, gbase) do { _Pragma("unroll") for (int _i = 0; _i < 2; ++_i) \
        __builtin_amdgcn_global_load_lds((const unsigned*)((const char*)(gbase) + voffB[_i]), (LAS unsigned*)(lds + (bufoff) + ldsw + _i * 8192), 16, 0, 0); } while (0)
#define PG8_STAGE_A(bufoff, gbase, h) do { const char* _gb = (const char*)(gbase) + (GATHER ? (size_t)0 : (size_t)(h) * hstep); \
        __builtin_amdgcn_global_load_lds((const unsigned*)(_gb + ac[GATHER ? (h) : 0][0]), (LAS unsigned*)(lds + (bufoff) + ldsw), 16, 0, 0); \
        __builtin_amdgcn_global_load_lds((const unsigned*)(_gb + ac[GATHER ? (h) : 0][1]), (LAS unsigned*)(lds + (bufoff) + ldsw + 8192), 16, 0, 0); } while (0)
#define PG8_LDA(dst, b, h) do { _Pragma("unroll") for (int m = 0; m < 4; ++m) { if constexpr (F8) { const v4i _l = *(const LAS v4i*)(lds + PG8_SA(b, h) + aoff + m * 2048), _h = *(const LAS v4i*)(lds + PG8_SA(b, h) + aoff + m * 2048 + PIECE1); dst##8[m] = __builtin_shufflevector(_l, _h, 0, 1, 2, 3, 4, 5, 6, 7); } \
        else { dst[m][0] = *(const LAS bf16x8*)(lds + PG8_SA(b, h) + aoff + m * 2048); dst[m][1] = *(const LAS bf16x8*)(lds + PG8_SA(b, h) + aoff + m * 2048 + PIECE1); } } } while (0)
#define PG8_LDB(dst, b, h) do { _Pragma("unroll") for (int n = 0; n < 2; ++n) { if constexpr (F8) { const v4i _l = *(const LAS v4i*)(lds + PG8_SB(b, h) + boff + n * 2048), _h = *(const LAS v4i*)(lds + PG8_SB(b, h) + boff + n * 2048 + PIECE1); dst##8[n] = __builtin_shufflevector(_l, _h, 0, 1, 2, 3, 4, 5, 6, 7); } \
        else { dst[n][0] = *(const LAS bf16x8*)(lds + PG8_SB(b, h) + boff + n * 2048); dst[n][1] = *(const LAS bf16x8*)(lds + PG8_SB(b, h) + boff + n * 2048 + PIECE1); } } } while (0)
#define PG8_MMA(ai, bj, At, Bt) do { __builtin_amdgcn_s_setprio(1); _Pragma("unroll") for (int m = 0; m < 4; ++m) _Pragma("unroll") for (int n = 0; n < 2; ++n) { \
        if constexpr (F8) asm volatile("v_mfma_scale_f32_16x16x128_f8f6f4 %0, %1, %2, %0, %3, %4 op_sel_hi:[0,0,0]" : "+v"(acc[ai][bj][m][n]) : "v"(Bt##8[n]), "v"(At##8[m]), "v"(sc_w), "v"(sc_a)); \
        else { _Pragma("unroll") for (int k = 0; k < 2; ++k) acc[ai][bj][m][n] = SWAP ? __builtin_amdgcn_mfma_f32_16x16x32_bf16(At[m][k], Bt[n][k], acc[ai][bj][m][n], 0, 0, 0) : __builtin_amdgcn_mfma_f32_16x16x32_bf16(Bt[n][k], At[m][k], acc[ai][bj][m][n], 0, 0, 0); } } \
        __builtin_amdgcn_s_setprio(0); } while (0)
#define PG8_WAIT_V(n) asm volatile("s_waitcnt vmcnt(" #n ")" ::: "memory")
#define PG8_WAIT_LOOP do { if constexpr (NHALF) PG8_WAIT_V(6); else PG8_WAIT_V(8); } while (0)
#define PG8_WAIT_L(n) asm volatile("s_waitcnt lgkmcnt(" #n ")" ::: "memory")
#define PG8_BAR __builtin_amdgcn_s_barrier()
#define PG8_SCHED __builtin_amdgcn_sched_barrier(0)
#define PG8_TAB(par) (lds + STAGE_BYTES + 2048 + (par) * 1024)
#define PG8_TABLOAD(par, row0) do { if (wid < 4) __builtin_amdgcn_global_load_lds((const unsigned*)(rowidx + (row0) + wid * 64 + lane), (LAS unsigned*)(PG8_TAB(par) + wid * 256), 4, 0, 0); } while (0)
#define PG8_AOFF_H(h, par) do { int _tz = tid; asm volatile("" : "+v"(_tz)); _Pragma("unroll") for (int _i = 0; _i < 2; ++_i) { int _R, _C; stage_rc(_tz * 16 + _i * 8192, _R, _C); \
        if (GATHER) ac[h][_i] = ((const LAS unsigned*)PG8_TAB(par))[(h) * HALF + _R] * (unsigned)KB + (unsigned)_C * 2u; \
        else ac[h][_i] = (unsigned)(((h) * HALF + _R) * KB) + (unsigned)_C * 2u; } } while (0)
    static_assert(SP2, "only the two-super-phase K-loop is kept");
    Unit cur, nxt; int ui = 0;
    if (!S.next(0, cur)) return;
    f32x4 acc[2][2][4][2];
#pragma unroll
    for (int a = 0; a < 2; ++a)
#pragma unroll
        for (int b = 0; b < 2; ++b)
#pragma unroll
            for (int m = 0; m < 4; ++m)
#pragma unroll
                for (int n = 0; n < 2; ++n) acc[a][b][m][n] = (f32x4){0.f, 0.f, 0.f, 0.f};
    bf16x8 At[F8 ? 1 : 4][2], B0[F8 ? 1 : 2][2], B1[F8 ? 1 : 2][2];
    v8i At8[F8 ? 4 : 1], B08[F8 ? 2 : 1], B18[F8 ? 2 : 1];
    unsigned ac[GATHER ? 2 : 1][2];
    if (GATHER) { PG8_TABLOAD(0, cur.arow0); PG8_WAIT_V(0); PG8_BAR; }
    PG8_AOFF_H(0, 0); if (GATHER) { PG8_AOFF_H((GATHER ? 1 : 0), 0); }
    const char* cA = (const char*)Ag + (GATHER ? (size_t)0 : (size_t)cur.arow0 * KB); const char* cB = (const char*)Bg + (size_t)cur.brow0 * KB;
    PG8_STAGE_B(PG8_SB(0, 0), cB); if constexpr (!NHALF) PG8_STAGE_B(PG8_SB(0, 1), cB + hstep); PG8_STAGE_A(PG8_SA(0, 0), cA, 0); PG8_STAGE_A(PG8_SA(0, 1), cA, 1);
    if (wr == 1) PG8_BAR;
    PG8_WAIT_V(2); PG8_BAR;
    PG8_STAGE_B(PG8_SB(1, 0), cB + kstep); PG8_STAGE_A(PG8_SA(1, 0), cA + kstep, 0); if constexpr (!NHALF) PG8_STAGE_B(PG8_SB(1, 1), cB + hstep + kstep);
    if constexpr (NHALF) PG8_WAIT_V(4); else PG8_WAIT_V(6);
    PG8_BAR;
    for (;;) {
        const typename Epi::Pre pre = E.prefetch(cur, lds, wid, lane, ui);
        const bool has_next = S.next(ui + 1, nxt);
        if (GATHER) { if (has_next) PG8_TABLOAD((ui + 1) & 1, nxt.arow0); }
        const char* nA = has_next ? ((const char*)Ag + (GATHER ? (size_t)0 : (size_t)nxt.arow0 * KB)) : cA; const char* nB = has_next ? (const char*)Bg + (size_t)nxt.brow0 * KB : cB;
_Pragma("nounroll")
        for (int t = 0; t < nt; t += 2) {
            const bool last = (t == nt - 2);
            const bool skipw = (t == 0) && (ui > 0);
            const char* a1 = cA + (size_t)(t + 1) * kstep;
            const char* a2 = last ? nA : cA + (size_t)(t + 2) * kstep; const char* b2 = last ? nB : cB + (size_t)(t + 2) * kstep;
            const char* a3 = a2 + kstep; const char* b3 = b2 + kstep;
            if (GATHER) { if (last && has_next) { PG8_AOFF_H(0, (ui + 1) & 1); } }
            PG8_LDB(B0, 0, 0); if constexpr (!NHALF) PG8_LDB(B1, 0, 1); PG8_SCHED; PG8_LDA(At, 0, 0); PG8_STAGE_A(PG8_SA(1, 1), a1, 1);
            if (!skipw) PG8_WAIT_LOOP; PG8_WAIT_L(0); PG8_BAR; PG8_MMA(0, 0, At, B0); if constexpr (!NHALF) PG8_MMA(0, 1, At, B1); PG8_BAR; PG8_SCHED;
            if (GATHER) { if (last && has_next) { PG8_AOFF_H(1, (ui + 1) & 1); } }
            PG8_LDA(At, 0, 1); PG8_STAGE_B(PG8_SB(0, 0), b2); if constexpr (!NHALF) PG8_STAGE_B(PG8_SB(0, 1), b2 + hstep); PG8_STAGE_A(PG8_SA(0, 0), a2, 0);
            if (!skipw) PG8_WAIT_LOOP; PG8_WAIT_L(0); PG8_BAR; PG8_MMA(1, 0, At, B0); if constexpr (!NHALF) PG8_MMA(1, 1, At, B1); PG8_BAR; PG8_SCHED;
            PG8_LDB(B0, 1, 0); if constexpr (!NHALF) PG8_LDB(B1, 1, 1); PG8_SCHED; PG8_LDA(At, 1, 0); PG8_STAGE_A(PG8_SA(0, 1), a2, 1);
            if (!skipw) PG8_WAIT_LOOP; PG8_WAIT_L(0); PG8_BAR; PG8_MMA(0, 0, At, B0); if constexpr (!NHALF) PG8_MMA(0, 1, At, B1); PG8_BAR; PG8_SCHED;
            PG8_LDA(At, 1, 1); PG8_STAGE_B(PG8_SB(1, 0), b3); if constexpr (!NHALF) PG8_STAGE_B(PG8_SB(1, 1), b3 + hstep); PG8_STAGE_A(PG8_SA(1, 0), a3, 0);
            PG8_WAIT_LOOP; PG8_WAIT_L(0); PG8_BAR; PG8_MMA(1, 0, At, B0); if constexpr (!NHALF) PG8_MMA(1, 1, At, B1); PG8_BAR; PG8_SCHED;
        }
        if constexpr (ALIGN_EPI) { if (wr == 0) PG8_BAR; }
        E(acc, cur, wr, wc, fr, fq, pre, has_next);
        if (!has_next) break;
#pragma unroll
        for (int a = 0; a < 2; ++a)
#pragma unroll
            for (int b = 0; b < 2; ++b)
#pragma unroll
                for (int m = 0; m < 4; ++m)
#pragma unroll
                    for (int n = 0; n < 2; ++n) acc[a][b][m][n] = (f32x4){0.f, 0.f, 0.f, 0.f};
        cur = nxt; cA = nA; cB = nB; ++ui;
        if constexpr (ALIGN_EPI) { if (wr == 1) PG8_BAR; }
    }
    PG8_WAIT_V(0);
    if constexpr (!ALIGN_EPI) { if (wr == 0) PG8_BAR; }
    PG8_BAR;
#undef PG8_SA
#undef PG8_SB
#undef PG8_STAGE_A
#undef PG8_STAGE_B
#undef PG8_LDA
#undef PG8_LDB
#undef PG8_MMA
#undef PG8_WAIT_V
#undef PG8_WAIT_L
#undef PG8_WAIT_LOOP
#undef PG8_BAR
#undef PG8_SCHED
#undef PG8_AOFF_H
#undef PG8_TAB
#undef PG8_TABLOAD
}
}

constexpr int NWAVES = 8, NTHR = 512;
constexpr size_t MiB = 1u << 20;
constexpr size_t WS_CTL = 0, CTL_BYTES = 1 * MiB;
constexpr size_t WS_MOD = 1 * MiB;
constexpr size_t WS_WIN = 3 * MiB;
constexpr size_t WS_WOUT = 29 * MiB;
constexpr size_t WS_WR = 37 * MiB;
constexpr size_t WS_HYF = 39 * MiB;
constexpr size_t WS_HYFC = 71 * MiB;
constexpr size_t WS_XC = 73 * MiB;
constexpr size_t WS_EXP1 = 89 * MiB;
constexpr size_t WS_EXP2 = 218 * MiB;
constexpr size_t WS_XM = 283 * MiB;
constexpr size_t WS_EIDX = 419 * MiB;
constexpr size_t WS_WGT = 422 * MiB;
constexpr size_t WS_RNK = 425 * MiB;
constexpr size_t WS_ROWTOK = 428 * MiB;
constexpr size_t WS_ROWDST = 431 * MiB;
constexpr size_t WS_TILEEXP = 434 * MiB;
constexpr size_t WS_BIG = 435 * MiB;
constexpr size_t WS_U = WS_BIG;
constexpr size_t WS_MIX = 877 * MiB;
constexpr size_t WS_VT = 1013 * MiB;
constexpr size_t WS_HV = 1081 * MiB;
constexpr size_t WS_Z2 = 1183 * MiB;
constexpr size_t WS_GDS = 1217 * MiB;
constexpr size_t WS_GSIN = 1285 * MiB;
constexpr size_t WS_GD = 1319 * MiB;
constexpr size_t WS_Y = 1321 * MiB;
constexpr size_t WS_LOGIT = WS_BIG;
constexpr size_t WS_ACT = WS_BIG;
constexpr size_t WS_Y2 = 758 * MiB;
constexpr size_t WS_XM8 = 1470 * MiB;
constexpr size_t WS_WRB = 1540 * MiB;
constexpr size_t WS_RBIAS = 1558 * MiB;
constexpr size_t WS_XR = 1600 * MiB;
constexpr size_t WS_END = 1736 * MiB;
constexpr int CW_BAR = 4096;
constexpr int CW_CNT = 16384;
constexpr int CW_NTL = 20480;

constexpr int LDS_BYTES = 163840;
constexpr int MISC_OFF = 163584;

struct Frame {
    LAS unsigned char* lds;
    int tid, lane, wave, G, wg;
    const float* const* in;
    float* out; unsigned char* ws; unsigned* ctl;
};
enum { I_X = 0, I_C, I_CTX, I_CCTX, I_WMOD, I_BMOD, I_WIN, I_RPB, I_WA2, I_BA2, I_GNORM, I_HSW, I_HSB, I_HW1, I_HB1, I_HF1, I_HW2, I_HB2, I_HF2, I_HW3, I_HB3, I_HDEC, I_HSKIP,
       I_WOUT, I_LN1G, I_LN1B, I_RW, I_RB, I_WEG, I_WEU, I_WED, I_WSG, I_WSU, I_WSD, I_LN2G, I_LN2B };

__device__ __forceinline__ int row_b(int row) { return row < NLAT ? (row >> 12) : 16; }
__device__ __forceinline__ const float* mod_ptr(const Frame& F, int l, int row) { return (const float*)(F.ws + WS_MOD) + ((size_t)l * 17 + row_b(row)) * 6144; }

constexpr float NA_QSCALE = 0.125f * 1.4426950408889634f, NA_CLAMP = 60.0f * 1.4426950408889634f;
template <class RowFn>
__device__ __forceinline__ void tr_item(const float* W, int ldw, int k0, int n0, bf16_t* dst, int ldd, RowFn rf, LAS float* scr, int lane, float scale = 1.0f) {
    float tv[32];
    const GAS float* wp = (const GAS float*)(W + (size_t)(k0 + (lane >> 5)) * ldw + n0 + (lane & 31));
#pragma unroll
    for (int i = 0; i < 32; ++i) tv[i] = __builtin_nontemporal_load(wp + (size_t)(2 * i) * ldw);
#pragma unroll
    for (int i = 0; i < 32; ++i) scr[(2 * i + (lane >> 5)) * 33 + (lane & 31)] = tv[i];
    LDS_WAIT(); asm volatile("" ::: "memory");
    const int c = lane & 7;
#pragma unroll
    for (int j = 0; j < 4; ++j) { const int n = (lane >> 3) + 8 * j; const LAS float* s = scr + (8 * c) * 33 + n;
        u32x4 o; o.x = pk2(s[0 * 33] * scale, s[1 * 33] * scale); o.y = pk2(s[2 * 33] * scale, s[3 * 33] * scale); o.z = pk2(s[4 * 33] * scale, s[5 * 33] * scale); o.w = pk2(s[6 * 33] * scale, s[7 * 33] * scale);
        *(GAS u32x4*)(dst + (size_t)rf(n0 + n) * ldd + k0 + 8 * c) = o; }
    LDS_WAIT(); asm volatile("" ::: "memory");
}
template <class RowFn>
__device__ __forceinline__ void tr_item_ks(const float* W, int ldw, int k0, int n0, bf16_t* dst, int ldd, RowFn rf, LAS float* scr, int lane, const float* ksc) {
    float tv[32];
    const GAS float* wp = (const GAS float*)(W + (size_t)(k0 + (lane >> 5)) * ldw + n0 + (lane & 31));
#pragma unroll
    for (int i = 0; i < 32; ++i) tv[i] = wp[(size_t)(2 * i) * ldw];
#pragma unroll
    for (int i = 0; i < 32; ++i) scr[(2 * i + (lane >> 5)) * 33 + (lane & 31)] = tv[i] * (1.0f + ksc[2 * i + (lane >> 5)]);
    LDS_WAIT(); asm volatile("" ::: "memory");
    const int c = lane & 7;
#pragma unroll
    for (int j = 0; j < 4; ++j) { const int n = (lane >> 3) + 8 * j; const LAS float* s = scr + (8 * c) * 33 + n;
        u32x4 o; o.x = pk2(s[0 * 33], s[1 * 33]); o.y = pk2(s[2 * 33], s[3 * 33]); o.z = pk2(s[4 * 33], s[5 * 33]); o.w = pk2(s[6 * 33], s[7 * 33]);
        *(GAS u32x4*)(dst + (size_t)rf(n0 + n) * ldd + k0 + 8 * c) = o; }
    LDS_WAIT(); asm volatile("" ::: "memory");
}
template <class RowFn>
__device__ __forceinline__ void tr_item8(const float* W, int ldw, int k0, int n0, unsigned char* dst, int ldd, RowFn rf, float scale, LAS float* scr, int lane) {
    float tv[32];
    const GAS float* wp = (const GAS float*)(W + (size_t)(k0 + (lane >> 5)) * ldw + n0 + (lane & 31));
#pragma unroll
    for (int i = 0; i < 32; ++i) tv[i] = __builtin_nontemporal_load(wp + (size_t)(2 * i) * ldw);
#pragma unroll
    for (int i = 0; i < 32; ++i) scr[(2 * i + (lane >> 5)) * 33 + (lane & 31)] = tv[i];
    LDS_WAIT(); asm volatile("" ::: "memory");
    const int n = lane >> 1, hf = lane & 1; const LAS float* s = scr + (32 * hf) * 33 + n;
    unsigned w[8];
#pragma unroll
    for (int j = 0; j < 8; ++j) { int v = 0; v = __builtin_amdgcn_cvt_pk_fp8_f32(s[(4 * j) * 33] * scale, s[(4 * j + 1) * 33] * scale, v, false); v = __builtin_amdgcn_cvt_pk_fp8_f32(s[(4 * j + 2) * 33] * scale, s[(4 * j + 3) * 33] * scale, v, true); w[j] = (unsigned)v; }
    unsigned char* d = dst + (size_t)rf(n0 + n) * ldd + k0 + 32 * hf;
    *(GAS u32x4*)d = (u32x4){w[0], w[1], w[2], w[3]}; *(GAS u32x4*)(d + 16) = (u32x4){w[4], w[5], w[6], w[7]};
    LDS_WAIT(); asm volatile("" ::: "memory");
}
struct RowId { __device__ __forceinline__ int operator()(int n) const { return n; } };
struct RowWin { __device__ __forceinline__ int operator()(int n) const { return n >= 2336 ? n - 32 : n; } };
struct RowGU { int up; __device__ __forceinline__ int operator()(int j) const { return (j >> 7) * 256 + up * 128 + (j & 127); } };

__device__ __forceinline__ void p0_static_weights(Frame& F) {
    LAS float* scr = (LAS float*)(F.lds + F.wave * 16384);
    const int gw = F.wg * NWAVES + F.wave, NGW = F.G * NWAVES;
    constexpr int I_IN = 16 * 97, I_OUT = 16 * 32, I_R = 16 * 4, PER_L = I_IN + I_OUT + I_R;
    for (int it = gw; it < DEPTH * PER_L; it += NGW) {
        const int l = it / PER_L; int r = it % PER_L;
        if (r < I_IN) { const int kb = r / 97, nb = r % 97; if (nb == 72) continue;
            tr_item(F.in[I_WIN] + (size_t)l * DM * DIN_REF, DIN_REF, kb * 64, nb * 32, (bf16_t*)(F.ws + WS_WIN) + (size_t)l * DIN * DM, DM, RowWin{}, scr, F.lane, nb < 16 ? NA_QSCALE : 1.0f); continue; }
        r -= I_IN;
        if (r < I_OUT) { const int kb = r / 32, nb = r % 32;
            tr_item(F.in[I_WOUT] + (size_t)l * DM * DM, DM, kb * 64, nb * 32, (bf16_t*)(F.ws + WS_WOUT) + (size_t)l * DM * DM, DM, RowId{}, scr, F.lane); continue; }
        r -= I_OUT;
        { const int kb = r / 4, nb = r % 4;
            tr_item(F.in[I_RW] + (size_t)l * DM * NEXP, NEXP, kb * 64, nb * 32, (bf16_t*)(F.ws + WS_WR) + (size_t)l * 256 * DM, DM, RowId{}, scr, F.lane); }
    }
    const int gt = F.wg * NTHR + F.tid, NGT = F.G * NTHR;
    for (int i = gt; i < DEPTH * 128 * DM / 8; i += NGT) { const int l = i / (128 * DM / 8), r = i % (128 * DM / 8);
        *(u32x4*)((bf16_t*)(F.ws + WS_WR) + ((size_t)l * 256 + 128) * DM + (size_t)r * 8) = (u32x4){0u, 0u, 0u, 0u}; }
    for (int i = gt; i < DEPTH * 256 * DM; i += NGT) {
        const int k = i % DM, n = (i / DM) % 256, l = i / (DM * 256), dir = n >> 7, j = n & 127;
        const float* wi = F.in[I_WIN] + ((size_t)l * DM + k) * DIN_REF + 2304 + dir * 16;
        const float* wa = F.in[I_WA2] + ((size_t)(l * 2 + dir) * 16) * 128 + j;
        float s = 0.f;
#pragma unroll
        for (int r = 0; r < 16; ++r) s += wi[r] * wa[r * 128];
        ((bf16_t*)(F.ws + WS_WIN))[((size_t)l * DIN + 3072 + n) * DM + k] = (bf16_t)f2bf(s);
    }
}
__device__ __forceinline__ void p0_mod(Frame& F) {
    LAS float* sc = (LAS float*)F.lds;
    LAS float* red = (LAS float*)(F.lds + 17 * 1024 * 4);
    for (int i = F.tid; i < 17 * 1024; i += NTHR) { const int r = i >> 10, k = i & 1023; const float v = r < 16 ? F.in[I_C][r * 1024 + k] : F.in[I_CCTX][k]; sc[i] = silu_f(v); }
    __syncthreads();
    const int kq = F.tid >> 7, cl = F.tid & 127;
    for (int u = F.wg; u < DEPTH * 48; u += F.G) {
        const int l = u / 48, col = (u % 48) * 128 + cl;
        const float* w = F.in[I_WMOD] + (size_t)l * DM * 6144 + col;
        float a[17];
#pragma unroll
        for (int r = 0; r < 17; ++r) a[r] = 0.f;
        for (int k0 = kq * 256; k0 < kq * 256 + 256; k0 += 16) {
            float wv[16];
#pragma unroll
            for (int q = 0; q < 16; ++q) wv[q] = *(const GAS float*)(w + (size_t)(k0 + q) * 6144);
#pragma unroll
            for (int q = 0; q < 16; ++q)
#pragma unroll
                for (int r = 0; r < 17; ++r) a[r] += sc[r * 1024 + k0 + q] * wv[q]; }
#pragma unroll
        for (int r = 0; r < 17; ++r) red[(kq * 17 + r) * 128 + cl] = a[r];
        __syncthreads();
        for (int i = F.tid; i < 17 * 128; i += NTHR) { const int r = i >> 7, c2 = i & 127, cc = (u % 48) * 128 + c2;
            const float s = red[(0 * 17 + r) * 128 + c2] + red[(1 * 17 + r) * 128 + c2] + red[(2 * 17 + r) * 128 + c2] + red[(3 * 17 + r) * 128 + c2] + F.in[I_BMOD][l * 6144 + cc];
            ((float*)(F.ws + WS_MOD))[((size_t)l * 17 + r) * 6144 + cc] = s; }
        __syncthreads();
    }
}
__device__ __forceinline__ void p0_hyena_filters(Frame& F) {
    LAS float* z = (LAS float*)F.lds;
    LAS float* h1 = z + 1092;
    LAS float* h2 = h1 + 33 * 64;
    LAS float* tt = h2 + 33 * 64;
    LAS float* W1 = tt + 64;
    LAS float* W2 = W1 + 33 * 64;
    constexpr int UL = 4096 / 32, UC = 256 / 32, UPL = UL + UC;
    for (int u = F.wg; u < DEPTH * UPL; u += F.G) {
        const int l = u / UPL, r = u % UPL; const bool lat = r < UL; const int L = lat ? 4096 : 256, n0 = (lat ? r : r - UL) * 32;
        __syncthreads();
        for (int i = F.tid; i < 33 * 64; i += NTHR) W1[i] = F.in[I_HW1][(size_t)l * 33 * 64 + i];
        for (int i = F.tid; i < 64 * 64; i += NTHR) W2[i] = F.in[I_HW2][(size_t)l * 64 * 64 + i];
        for (int i = F.tid; i < 33 * 33; i += NTHR) { const int p = i / 33, e = i % 33, n = n0 + p;
            const float t = (float)n / (float)(L - 1);
            float v;
            if (e == 0) v = t;
            else { const int kb = (e - 1) & 15; const float band = 1e-4f + (float)kb * ((15.0f - 1e-4f) / 15.0f);
                   const float w = 6.283185307179586f * (float)n / (float)L; const float ang = w * band;
                   v = e <= 16 ? __cosf(ang) : -__sinf(ang); }
            z[i] = v; if (e == 0) tt[p] = t; }
        __syncthreads();
        for (int i = F.tid; i < 33 * 64; i += NTHR) { const int p = i >> 6, j = i & 63; float s = F.in[I_HB1][l * 64 + j];
#pragma unroll 11
            for (int e = 0; e < 33; ++e) s += z[p * 33 + e] * W1[e * 64 + j];
            h1[i] = __sinf(F.in[I_HF1][l * 64 + j] * s); }
        __syncthreads();
        for (int i = F.tid; i < 33 * 64; i += NTHR) { const int p = i >> 6, j = i & 63; float s = F.in[I_HB2][l * 64 + j];
#pragma unroll 16
            for (int e = 0; e < 64; ++e) s += h1[p * 64 + e] * W2[e * 64 + j];
            h2[i] = __sinf(F.in[I_HF2][l * 64 + j] * s); }
        __syncthreads();
        {
            const int g = F.tid >> 8, col0 = 4 * (F.tid & 255), o = col0 >> 9, dir = (col0 >> 8) & 1, ch0 = col0 & 255;
            const int pb = (dir ? 0 : 1) + 16 * g;
            float a[4][16];
#pragma unroll
            for (int j = 0; j < 4; ++j)
#pragma unroll
                for (int q = 0; q < 16; ++q) a[j][q] = 0.f;
            const float* w3 = F.in[I_HW3] + (size_t)l * 64 * 1024 + col0;
            const LAS float* hp = h2 + pb * 64;
            f32x4 wa[4], wb[4];
#pragma unroll
            for (int q = 0; q < 4; ++q) wa[q] = *(const GAS f32x4*)(w3 + (size_t)q * 1024);
#define HF_BLOCK(wv_, k0_) do { _Pragma("unroll") for (int pi = 0; pi < 16; ++pi) { const f32x4 hv = *(const LAS f32x4*)(hp + pi * 64 + (k0_)); \
                _Pragma("unroll") for (int q = 0; q < 4; ++q) _Pragma("unroll") for (int j = 0; j < 4; ++j) a[j][pi] += hv[q] * wv_[q][j]; } } while (0)
#pragma unroll 1
            for (int k0 = 0; k0 < 64; k0 += 8) {
#pragma unroll
                for (int q = 0; q < 4; ++q) wb[q] = *(const GAS f32x4*)(w3 + (size_t)(k0 + 4 + q) * 1024);
                __builtin_amdgcn_sched_barrier(0);
                HF_BLOCK(wa, k0);
                __builtin_amdgcn_sched_barrier(0);
                { const int kn = k0 + 8 < 64 ? k0 + 8 : k0;
#pragma unroll
                  for (int q = 0; q < 4; ++q) wa[q] = *(const GAS f32x4*)(w3 + (size_t)(kn + q) * 1024); }
                __builtin_amdgcn_sched_barrier(0);
                HF_BLOCK(wb, k0 + 4);
                __builtin_amdgcn_sched_barrier(0);
            }
#undef HF_BLOCK
            const f32x4 b3 = *(const GAS f32x4*)(F.in[I_HB3] + l * 1024 + col0), dc = *(const GAS f32x4*)(F.in[I_HDEC] + ((size_t)(l * 2 + o) * 2 + dir) * 256 + ch0);
            float a0[4] = {0.f, 0.f, 0.f, 0.f};
            if (n0 == 0 && dir == 0 && g == 0) {
                for (int k = 0; k < 64; ++k) { const f32x4 wv = *(const GAS f32x4*)(w3 + (size_t)k * 1024); const float hv = h2[k];
#pragma unroll
                    for (int j = 0; j < 4; ++j) a0[j] += hv * wv[j]; } }
#pragma unroll
            for (int j = 0; j < 4; ++j) {
                const float dec = fabsf(dc[j]);
                bf16_t* R = lat ? (bf16_t*)(F.ws + WS_HYF) + ((size_t)(l * 2 + o) * 256 + ch0 + j) * 8192 : (bf16_t*)(F.ws + WS_HYFC) + ((size_t)(l * 2 + o) * 256 + ch0 + j) * 512;
                float v[16];
#pragma unroll
                for (int pi = 0; pi < 16; ++pi) v[pi] = (a[j][pi] + b3[j]) * __expf(-tt[pb + pi] * dec);
                unsigned w[8];
                if (dir == 0) {
                    if (n0 + 32 == L && g == 1) v[15] = 0.f;
#pragma unroll
                    for (int q = 0; q < 8; ++q) w[q] = pk2(v[15 - 2 * q], v[14 - 2 * q]);
                    GAS u32x4* dst = (GAS u32x4*)(R + (L - n0 - 32) + 16 * (1 - g));
                    dst[0] = (u32x4){w[0], w[1], w[2], w[3]}; dst[1] = (u32x4){w[4], w[5], w[6], w[7]};
                    if (n0 == 0 && g == 0) R[L] = (bf16_t)f2bf((a0[j] + b3[j]) * __expf(-tt[0] * dec) + F.in[I_HSKIP][(l * 2 + o) * 256 + ch0 + j]);
                } else if (n0 > 0 || g == 1) {
#pragma unroll
                    for (int q = 0; q < 8; ++q) w[q] = pk2(v[2 * q], v[2 * q + 1]);
                    GAS u32x4* dst = (GAS u32x4*)(R + (L + n0) + 16 * g);
                    dst[0] = (u32x4){w[0], w[1], w[2], w[3]}; dst[1] = (u32x4){w[4], w[5], w[6], w[7]};
                } else {
#pragma unroll
                    for (int pi = 1; pi < 16; ++pi) R[L + pi] = (bf16_t)f2bf(v[pi]);
                }
            }
        }
    }
    __syncthreads();
}
__device__ __forceinline__ void p0_init_rows(Frame& F) {
    const int gw = F.wg * NWAVES + F.wave, NGW = F.G * NWAVES;
    for (int row = gw; row < NROW; row += NGW) {
        const float* src = row < NLAT ? F.in[I_X] + (size_t)row * DM : F.in[I_CTX] + (size_t)(row - NLAT) * DM;
        const float* md = mod_ptr(F, 0, row);
        bf16_t* xr = (bf16_t*)(F.ws + WS_XR) + (size_t)row * DM; bf16_t* xm = (bf16_t*)(F.ws + WS_XM) + (size_t)row * DM;
#pragma unroll
        for (int j = 0; j < 4; ++j) { const int c = 4 * F.lane + 256 * j;
            const f32x4 v = __builtin_nontemporal_load((const GAS f32x4*)(src + c)), sh = *(const GAS f32x4*)(md + c), sc = *(const GAS f32x4*)(md + 1024 + c);
            *(GAS u32x2*)(xr + c) = (u32x2){pk2(v[0], v[1]), pk2(v[2], v[3])};
            u32x2 w; w.x = pk2(v[0] * (1.f + sc[0]) + sh[0], v[1] * (1.f + sc[1]) + sh[1]); w.y = pk2(v[2] * (1.f + sc[2]) + sh[2], v[3] * (1.f + sc[3]) + sh[3]);
            *(GAS u32x2*)(xm + c) = w; }
    }
}
__device__ __forceinline__ void p1_router_weights(Frame& F) {
    LAS float* scr = (LAS float*)(F.lds + F.wave * 16384);
    const int gw = F.wg * NWAVES + F.wave, NGW = F.G * NWAVES;
    const float* MOD = (const float*)(F.ws + WS_MOD);
    for (int it = gw; it < DEPTH * 17 * 64; it += NGW) {
        const int lb = it >> 6, l = lb / 17, kb = (it & 63) >> 2, nb = it & 3;
        tr_item_ks(F.in[I_RW] + (size_t)l * DM * NEXP, NEXP, kb * 64, nb * 32, (bf16_t*)(F.ws + WS_WRB) + (size_t)lb * 128 * DM, DM, RowId{}, scr, F.lane, MOD + (size_t)lb * 6144 + 4096 + kb * 64); }
    for (int it = gw; it < DEPTH * 17 * 8; it += NGW) {
        const int lb = it >> 3, l = lb / 17, n = (it & 7) * 16 + (F.lane & 15), kq = F.lane >> 4;
        const float* sh = MOD + (size_t)lb * 6144 + 3072 + kq * 256; const float* w = F.in[I_RW] + (size_t)l * DM * NEXP + (size_t)(kq * 256) * NEXP + n;
        float a = 0.f;
#pragma unroll 8
        for (int k = 0; k < 256; ++k) a += sh[k] * w[(size_t)k * NEXP];
        a += shx(a, 16, F.lane); a += shx(a, 32, F.lane);
        if (kq == 0) ((float*)(F.ws + WS_RBIAS))[(size_t)lb * 128 + n] = a; }
}
constexpr float WEXP_SCALE = 32.0f;
constexpr int XW_ITEMS = NE1 * 384, XW_TAIL_E = 12288, XW_TAIL_G = 12288 + 7680;
__device__ __forceinline__ void p_expert_weights(Frame& F, int l, int it0, int it1, int nw, int w) {
    LAS float* scr = (LAS float*)(F.lds + F.wave * 16384);
    constexpr int I1 = 16 * 8, I2 = 4 * 32, PER_E = 2 * I1 + I2;
    for (int it = it0 + w; it < it1; it += nw) {
        const int e = it / PER_E; int r = it % PER_E;
        unsigned char* d1 = (unsigned char*)(F.ws + WS_EXP1) + (size_t)e * 512 * DM; unsigned char* d2 = (unsigned char*)(F.ws + WS_EXP2) + (size_t)e * DM * EH;
        if (r < 2 * I1) { const int up = r >= I1; if (up) r -= I1; const int kb = r / 8, nb = r % 8;
            const float* src = e < NEXP ? F.in[up ? I_WEU : I_WEG] + ((size_t)l * NEXP + e) * DM * EH : F.in[up ? I_WSU : I_WSG] + (size_t)l * DM * EH;
            tr_item8(src, EH, kb * 64, nb * 32, d1, DM, RowGU{up}, up ? WEXP_SCALE * 0.6931471805599453f : WEXP_SCALE * 1.4426950408889634f, scr, F.lane); }
        else { r -= 2 * I1; const int kb = r / 32, nb = r % 32;
            const float* src = e < NEXP ? F.in[I_WED] + ((size_t)l * NEXP + e) * EH * DM : F.in[I_WSD] + (size_t)l * EH * DM;
            tr_item8(src, DM, kb * 64, nb * 32, d2, EH, RowId{}, WEXP_SCALE, scr, F.lane); }
    }
}

__device__ __forceinline__ f32x4 mfma16(bf16x8 a, bf16x8 b, f32x4 c) { return __builtin_amdgcn_mfma_f32_16x16x32_bf16(a, b, c, 0, 0, 0); }

__device__ __forceinline__ void ph_transposes(Frame& F, int l) {
    LAS bf16_t* tile = (LAS bf16_t*)(F.lds + F.wave * 16384);
    const bf16_t* U = (const bf16_t*)(F.ws + WS_U);
    const int gw = F.wg * NWAVES + F.wave, NGW = F.G * NWAVES;
    const int rsub = F.lane >> 3, cseg = F.lane & 7;
    for (int u = gw; u < 1088 * 12; u += NGW) {
        const int tt = u / 12, blk = u % 12;
        int b, s0, Ls, rowbase, posbase;
        if (tt < 1024) { b = tt >> 6; s0 = (tt & 63) * 64; Ls = SEQ; rowbase = b * SEQ; posbase = 0; }
        else { const int t2 = tt - 1024; b = t2 >> 2; s0 = (t2 & 3) * 64; Ls = CTXL; rowbase = NLAT + b * CTXL; posbase = SEQ; }
        if (blk < 12) {
            constexpr int HT = 80;
            float w0[8], w1[8], w2[8], bb[8];
#pragma unroll
            for (int it = 0; it < 8; ++it) { const int col = blk * 64 + rsub + 8 * it; w0[it] = F.in[I_HSW][(l * 3 + 0) * 768 + col]; w1[it] = F.in[I_HSW][(l * 3 + 1) * 768 + col]; w2[it] = F.in[I_HSW][(l * 3 + 2) * 768 + col]; bb[it] = F.in[I_HSB][l * 768 + col]; }
            const bf16_t* p0 = U + (size_t)(rowbase + s0 + rsub) * DIN + UHY + blk * 64 + cseg * 8;
            u32x4 zc[8];
#pragma unroll
            for (int it = 0; it < 8; ++it) zc[it] = *(const GAS u32x4*)(p0 + (size_t)(8 * it) * DIN);
            u32x4 zh = (u32x4){0u, 0u, 0u, 0u};
            if (F.lane < 16) { const int hs = F.lane < 8 ? s0 - 1 : s0 + 64; if (hs >= 0 && hs < Ls) zh = *(const GAS u32x4*)(U + (size_t)(rowbase + hs) * DIN + UHY + blk * 64 + cseg * 8); }
#pragma unroll
            for (int it = 0; it < 8; ++it) { const unsigned a[4] = {zc[it].x, zc[it].y, zc[it].z, zc[it].w}; LAS bf16_t* d = tile + (cseg * 8) * HT + 8 + rsub + 8 * it;
#pragma unroll
                for (int i = 0; i < 4; ++i) { d[(2 * i) * HT] = (bf16_t)(a[i] & 0xffffu); d[(2 * i + 1) * HT] = (bf16_t)(a[i] >> 16); } }
            if (F.lane < 16) { const unsigned a[4] = {zh.x, zh.y, zh.z, zh.w}; LAS bf16_t* d = tile + (cseg * 8) * HT + (F.lane < 8 ? 7 : 72);
#pragma unroll
                for (int i = 0; i < 4; ++i) { d[(2 * i) * HT] = (bf16_t)(a[i] & 0xffffu); d[(2 * i + 1) * HT] = (bf16_t)(a[i] >> 16); } }
            LDS_WAIT(); asm volatile("" ::: "memory");
#pragma unroll
            for (int it = 0; it < 8; ++it) {
                const int ch = rsub + 8 * it; const LAS bf16_t* r = tile + ch * HT + 8 + cseg * 8;
                const u32x4 v = *(const LAS u32x4*)r; const unsigned hm = r[-1], hp = r[8];
                float x[10]; x[0] = __builtin_bit_cast(float, hm << 16); x[9] = __builtin_bit_cast(float, hp << 16);
                x[1] = bflo(v.x); x[2] = bfhi(v.x); x[3] = bflo(v.y); x[4] = bfhi(v.y); x[5] = bflo(v.z); x[6] = bfhi(v.z); x[7] = bflo(v.w); x[8] = bfhi(v.w);
                unsigned w[4];
#pragma unroll
                for (int i = 0; i < 4; ++i) w[i] = pk2(bb[it] + w0[it] * x[2 * i] + w1[it] * x[2 * i + 1] + w2[it] * x[2 * i + 2], bb[it] + w0[it] * x[2 * i + 1] + w1[it] * x[2 * i + 2] + w2[it] * x[2 * i + 3]);
                *(GAS u32x4*)((bf16_t*)(F.ws + WS_HV) + ((size_t)(blk * 64 + ch) * NB + b) * SPB + posbase + s0 + cseg * 8) = (u32x4){w[0], w[1], w[2], w[3]};
            }
            LDS_WAIT(); asm volatile("" ::: "memory");
            continue;
        } else {
            const int c0 = (blk - 12) * 64 + cseg * 8;
#pragma unroll
            for (int it = 0; it < 8; ++it) {
                const int sl = rsub + 8 * it, s = s0 + sl;
                const u32x4 zc = *(const GAS u32x4*)(U + (size_t)(rowbase + s) * DIN + UV + c0);
                const unsigned ac[4] = {zc.x, zc.y, zc.z, zc.w};
#pragma unroll
                for (int i = 0; i < 4; ++i) { tile[(cseg * 8 + 2 * i) * 72 + sl] = (bf16_t)(ac[i] & 0xffffu); tile[(cseg * 8 + 2 * i + 1) * 72 + sl] = (bf16_t)(ac[i] >> 16); }
            }
        }
        LDS_WAIT(); asm volatile("" ::: "memory");
#pragma unroll 2
        for (int it = 0; it < 8; ++it) {
            const int ch = rsub + 8 * it;
            const u32x4 v = *(const LAS u32x4*)(tile + ch * 72 + cseg * 8);
            bf16_t* dst;
            if (blk < 12) dst = (bf16_t*)(F.ws + WS_HV) + ((size_t)(blk * 64 + ch) * NB + b) * SPB + posbase + s0 + cseg * 8;
            else dst = (bf16_t*)(F.ws + WS_VT) + ((size_t)b * 512 + (blk - 12) * 64 + ch) * SPB + posbase + s0 + cseg * 8;
            *(GAS u32x4*)dst = v;
        }
        LDS_WAIT(); asm volatile("" ::: "memory");
    }
}

constexpr int NA_RPB = 0, NA_KC = 2048, NA_VC = NA_KC + 256 * 144, NA_KR = NA_VC + 64 * 528, NA_END = NA_KR + 9 * 64 * 144;
static_assert(NA_END <= MISC_OFF, "NA LDS map");
__device__ __forceinline__ bf16x8 gld16(const bf16_t* p) { return *(const GAS bf16x8*)p; }
__device__ __forceinline__ u32x2 gld8(const bf16_t* p) { return *(const GAS u32x2*)p; }
__device__ __forceinline__ const char* uni_ptr(const char* p) { const unsigned long long v = (unsigned long long)p; const unsigned lo = __builtin_amdgcn_readfirstlane((unsigned)v), hi = __builtin_amdgcn_readfirstlane((unsigned)(v >> 32)); return (const char*)(((unsigned long long)hi << 32) | lo); }
__device__ __forceinline__ bf16x8 gld16o(const char* ub, unsigned lo) { return *(const GAS bf16x8*)(ub + (size_t)lo); }
__device__ __forceinline__ u32x2 gld8o(const char* ub, unsigned lo) { return *(const GAS u32x2*)(ub + (size_t)lo); }
template <bool WIN>
__device__ __forceinline__ void na_unit(Frame& F, int b, int h, int r, int strip) {
    const bf16_t* U = (const bf16_t*)(F.ws + WS_U);
    const bf16_t* VT = (const bf16_t*)(F.ws + WS_VT) + ((size_t)b * 512 + h * 64) * SPB;
    const LAS float* rpb = (const LAS float*)(F.lds + NA_RPB);
    const LAS bf16_t* KC = (const LAS bf16_t*)(F.lds + NA_KC); const LAS bf16_t* VC = (const LAS bf16_t*)(F.lds + NA_VC);
    int ln_ = F.lane; asm volatile("" : "+v"(ln_));
    const int i = ln_ & 15, g = ln_ >> 4;
    const int qrow0 = WIN ? (b * SEQ + r * 64 + strip * 16) : (NLAT + b * CTXL + strip * 16);
    const int ki = 8 * (i >> 2) + (i & 3);
    const unsigned qlo = (unsigned)((i * DIN + 8 * g) * 2), klo = (unsigned)((ki * DIN + 8 * g) * 2), vlo = (unsigned)((i * SPB + 8 * g) * 2);
    const char* qb = uni_ptr((const char*)(U + (size_t)qrow0 * DIN + UQ + h * 64));
    const bf16x8 q0 = gld16o(qb, qlo), q1 = gld16o(qb + 64, qlo);
    int kr0 = 0, u0 = 0;
    if (WIN) { kr0 = r - 4; kr0 = kr0 < 0 ? 0 : (kr0 > 56 ? 56 : kr0); u0 = strip == 0 ? 0 : (strip == 1 ? 8 : (strip == 2 ? 24 : 32)); }
    const LAS bf16_t* KR = (const LAS bf16_t*)(F.lds + NA_KR);
    const char* vbase = uni_ptr((const char*)(VT + kr0 * 64 + u0));
    f32x4 o[4];
#pragma unroll
    for (int d = 0; d < 4; ++d) o[d] = (f32x4){0.f, 0.f, 0.f, 0.f};
    float lsum = 0.f;
#define NA_SB() __builtin_amdgcn_sched_barrier(0)
#define NA_WLOAD(vb_, cw) do { _Pragma("unroll") for (int d = 0; d < 4; ++d) vb_[d] = gld16o(vbase + ((size_t)(d * 16) * SPB + (cw) * 64) * 2, vlo); } while (0)
#define NA_KRING(kb_, cw) do { const LAS bf16_t* kp = KR + ((((kr0 + (cw)) % 9) * 64 + u0 + ki) * 72 + 8 * g); kb_[0][0] = *(const LAS bf16x8*)kp; kb_[0][1] = *(const LAS bf16x8*)(kp + 32); \
        kb_[1][0] = *(const LAS bf16x8*)(kp + 4 * 72); kb_[1][1] = *(const LAS bf16x8*)(kp + 4 * 72 + 32); } while (0)
#define NA_QK(kb_, s_) do { _Pragma("unroll") for (int t = 0; t < 2; ++t) { f32x4 a = (f32x4){0.f, 0.f, 0.f, 0.f}; a = mfma16(kb_[t][0], q0, a); a = mfma16(kb_[t][1], q1, a); s_[t] = a; } } while (0)
#define NA_PV(s_, vb_) do { u32x4 pw; pw.x = pk2(s_[0][0], s_[0][1]); pw.y = pk2(s_[0][2], s_[0][3]); pw.z = pk2(s_[1][0], s_[1][1]); pw.w = pk2(s_[1][2], s_[1][3]); const bf16x8 pf = __builtin_bit_cast(bf16x8, pw); \
        _Pragma("unroll") for (int d = 0; d < 4; ++d) o[d] = mfma16(vb_[d], pf, o[d]); } while (0)
    bf16x8 vA[4], vB[4], vC[4];
    if (WIN) { NA_WLOAD(vA, 0); NA_WLOAD(vB, 1); NA_WLOAD(vC, 2); NA_SB(); }
#pragma unroll
    for (int cc = 0; cc < 8; ++cc) {
        bf16x8 kc[2][2], vc[4]; f32x4 sc[2];
#pragma unroll
        for (int t = 0; t < 2; ++t) { const LAS bf16_t* kp = KC + (cc * 32 + ki + 4 * t) * 72 + 8 * g; kc[t][0] = *(const LAS bf16x8*)kp; kc[t][1] = *(const LAS bf16x8*)(kp + 32); }
#pragma unroll
        for (int d = 0; d < 4; ++d) vc[d] = *(const LAS bf16x8*)(VC + (d * 16 + i) * 264 + cc * 32 + 8 * g);
        NA_QK(kc, sc);
#pragma unroll
        for (int t = 0; t < 2; ++t)
#pragma unroll
            for (int e = 0; e < 4; ++e) { const float p = __builtin_amdgcn_exp2f(fminf(sc[t][e], NA_CLAMP)); sc[t][e] = p; lsum += p; }
        NA_PV(sc, vc);
    }
    if (WIN) {
        const int c = strip * 16 + i; int kc0 = c - 8; kc0 = kc0 < 0 ? 0 : (kc0 > 48 ? 48 : kc0);
        int dcl[2][4]; bool okm[2][4];
#pragma unroll
        for (int t = 0; t < 2; ++t)
#pragma unroll
            for (int e = 0; e < 4; ++e) { const int kc = u0 + 8 * g + 4 * t + e; okm[t][e] = (kc >= kc0) && (kc < kc0 + 16); int dc = kc - c + 15; dcl[t][e] = okm[t][e] ? (dc < 0 ? 0 : (dc > 30 ? 30 : dc)) : 31; }
#define NA_WCHUNK(vb_, cw) do { bf16x8 kw[2][2]; NA_KRING(kw, cw); f32x4 sw[2]; NA_QK(kw, sw); const LAS float* rp = rpb + (kr0 + (cw) - r + 7) * 32; \
        _Pragma("unroll") for (int t = 0; t < 2; ++t) _Pragma("unroll") for (int e = 0; e < 4; ++e) { const float x = sw[t][e] + rp[dcl[t][e]]; const float p = __builtin_amdgcn_exp2f(fminf(x, NA_CLAMP)); sw[t][e] = p; lsum += p; } \
        NA_PV(sw, vb_); } while (0)
        NA_WCHUNK(vA, 0); NA_SB(); NA_WLOAD(vA, 3); NA_SB();
        NA_WCHUNK(vB, 1); NA_SB(); NA_WLOAD(vB, 4); NA_SB();
        NA_WCHUNK(vC, 2); NA_SB(); NA_WLOAD(vC, 5); NA_SB();
        NA_WCHUNK(vA, 3); NA_SB(); NA_WLOAD(vA, 6); NA_SB();
        NA_WCHUNK(vB, 4); NA_SB(); NA_WLOAD(vB, 7); NA_SB();
        NA_WCHUNK(vC, 5); NA_SB();
        NA_WCHUNK(vA, 6); NA_SB();
        NA_WCHUNK(vB, 7); NA_SB();
#undef NA_WCHUNK
    }
    lsum += shx(lsum, 16, ln_); lsum += shx(lsum, 32, ln_);
    const float inv = 1.0f / lsum;
    char* op = (char*)uni_ptr((const char*)((bf16_t*)(F.ws + WS_MIX) + (size_t)qrow0 * DM + h * 64)); const unsigned olo = (unsigned)((i * DM + 4 * g) * 2);
#pragma unroll
    for (int d = 0; d < 4; ++d) { u32x2 w; w.x = pk2(o[d][0] * inv, o[d][1] * inv); w.y = pk2(o[d][2] * inv, o[d][3] * inv); *(GAS u32x2*)(op + d * 32 + (size_t)olo) = w; }
#undef NA_SB
#undef NA_WLOAD
#undef NA_KRING
#undef NA_QK
#undef NA_PV
}
__device__ __forceinline__ int na_kr0(int r) { const int k = r - 4; return k < 0 ? 0 : (k > 56 ? 56 : k); }
__device__ __forceinline__ void ph_na(Frame& F, int l, bool last) {
    const bf16_t* U = (const bf16_t*)(F.ws + WS_U);
    for (int job = F.wg; job < NB * 8 * 2; job += F.G) {
        const int half = job & 1, h = (job >> 1) & 7, b = job >> 4;
        int tz_; asm volatile("v_mbcnt_lo_u32_b32 %0, -1, 0\n\tv_mbcnt_hi_u32_b32 %0, -1, %0" : "=v"(tz_)); tz_ |= F.wave << 6;
        const bf16_t* krow = U + (size_t)(b * SEQ + (tz_ >> 3)) * DIN + UK + h * 64 + (tz_ & 7) * 8;
        LAS bf16_t* kdst = (LAS bf16_t*)(F.lds + NA_KR) + (tz_ >> 3) * 72 + (tz_ & 7) * 8;
        __syncthreads();
        { LAS float* rpb = (LAS float*)(F.lds + NA_RPB); const float* rsrc = F.in[I_RPB] + ((size_t)l * 8 + h) * 15 * 31;
          if (tz_ < 15 * 32) rpb[tz_] = (tz_ & 31) < 31 ? rsrc[(tz_ >> 5) * 31 + (tz_ & 31)] * 1.4426950408889634f : -1e30f;
          const int key = tz_ >> 1, hf = tz_ & 1; const bf16_t* src = U + (size_t)(NLAT + b * CTXL + key) * DIN + UK + h * 64 + hf * 32; LAS bf16_t* dst = (LAS bf16_t*)(F.lds + NA_KC) + key * 72 + hf * 32;
#pragma unroll
          for (int j = 0; j < 4; ++j) *(LAS bf16x8*)(dst + j * 8) = gld16(src + j * 8);
          const int dv = tz_ >> 3, seg = tz_ & 7; const bf16_t* vs = (const bf16_t*)(F.ws + WS_VT) + ((size_t)b * 512 + h * 64 + dv) * SPB + SEQ + seg * 32; LAS bf16_t* vd = (LAS bf16_t*)(F.lds + NA_VC) + dv * 264 + seg * 32;
#pragma unroll
          for (int j = 0; j < 4; ++j) *(LAS bf16x8*)(vd + j * 8) = gld16(vs + j * 8);
          const int lo = na_kr0(half * 32), hi0 = na_kr0(half * 32 + 1) + 7;
          for (int kr = lo; kr <= hi0; ++kr) *(LAS bf16x8*)(kdst + (kr % 9) * 64 * 72) = gld16(krow + (size_t)kr * 64 * DIN); }
        __syncthreads();
        int prev_hi = na_kr0(half * 32 + 1) + 7;
#pragma unroll 1
        for (int s = 0; s < 16; ++s) {
            const int r0 = half * 32 + 2 * s;
            const int nhi = s < 15 ? na_kr0(r0 + 3) + 7 : prev_hi;
            bf16x8 n0 = (bf16x8){0, 0, 0, 0, 0, 0, 0, 0}, n1 = n0;
            if (nhi > prev_hi) n0 = gld16(krow + (size_t)(prev_hi + 1) * 64 * DIN);
            if (nhi > prev_hi + 1) n1 = gld16(krow + (size_t)(prev_hi + 2) * 64 * DIN);
            na_unit<true>(F, b, h, r0 + (F.wave >> 2), F.wave & 3);
            __syncthreads();
            if (nhi > prev_hi) *(LAS bf16x8*)(kdst + ((prev_hi + 1) % 9) * 64 * 72) = n0;
            if (nhi > prev_hi + 1) *(LAS bf16x8*)(kdst + ((prev_hi + 2) % 9) * 64 * 72) = n1;
            __syncthreads();
            prev_hi = nhi;
        }
        if (!last) na_unit<false>(F, b, h, 0, half * 8 + F.wave);
    }
}

__device__ __forceinline__ void ph_hy_transpose(Frame& F, bool last) {
    LAS bf16_t* tile = (LAS bf16_t*)(F.lds + F.wave * 16384);
    const bf16_t* HYO = (const bf16_t*)(F.ws + WS_Y);
    const int gw = F.wg * NWAVES + F.wave, NGW = F.G * NWAVES;
    const int rsub = F.lane >> 3, cseg = F.lane & 7;
    const int ntt = last ? 1024 : 1088;
    for (int u = gw; u < ntt * 4; u += NGW) {
        const int tt = u >> 2, cb = u & 3;
        int b, s0, rowbase, posbase;
        if (tt < 1024) { b = tt >> 6; s0 = (tt & 63) * 64; rowbase = b * SEQ; posbase = 0; }
        else { const int t2 = tt - 1024; b = t2 >> 2; s0 = (t2 & 3) * 64; rowbase = NLAT + b * CTXL; posbase = SEQ; }
#pragma unroll 2
        for (int it = 0; it < 8; ++it) { const int c = rsub + 8 * it;
            const u32x4 v = *(const GAS u32x4*)(HYO + ((size_t)(cb * 64 + c) * NB + b) * SPB + posbase + s0 + cseg * 8); const unsigned a[4] = {v.x, v.y, v.z, v.w};
#pragma unroll
            for (int e = 0; e < 4; ++e) { tile[(cseg * 8 + 2 * e) * 72 + c] = (bf16_t)(a[e] & 0xffffu); tile[(cseg * 8 + 2 * e + 1) * 72 + c] = (bf16_t)(a[e] >> 16); } }
        LDS_WAIT(); asm volatile("" ::: "memory");
#pragma unroll 2
        for (int it = 0; it < 8; ++it) { const int p = rsub + 8 * it;
            const u32x4 v = *(const LAS u32x4*)(tile + p * 72 + cseg * 8);
            *(GAS u32x4*)((bf16_t*)(F.ws + WS_MIX) + (size_t)(rowbase + s0 + p) * DM + 768 + cb * 64 + cseg * 8) = v; }
        LDS_WAIT(); asm volatile("" ::: "memory");
    }
}

constexpr int G2_LAF = 0, G2_LAB = 8448;
constexpr int G2_QTF = 16896, G2_KTF = 22016, G2_QTB = 27136, G2_KTB = 32256;
constexpr int G2_VT = 37376, G2_ATT = 46592;
constexpr int G2_SF = 55808, G2_SB = 60928;
constexpr int G2_SEG = 66048, G2_HALF = 67328;
__device__ __forceinline__ float log_sigmoid_f(float x) { return fminf(x, 0.f) - __logf(1.0f + __expf(-fabsf(x))); }
__device__ __forceinline__ f32x4 mma_lds(const LAS bf16_t* A, int lda, const LAS bf16_t* B, int ldb, int ksteps, f32x4 acc, int lane) {
    const int r = lane & 15, g = lane >> 4;
    for (int ks = 0; ks < ksteps; ++ks) { const bf16x8 a = *(const LAS bf16x8*)(A + r * lda + ks * 32 + 8 * g), b = *(const LAS bf16x8*)(B + r * ldb + ks * 32 + 8 * g); acc = mfma16(a, b, acc); }
    return acc;
}
__device__ __forceinline__ int gla_row0(int b, int cn) { return cn >= 4 ? b * SEQ + (cn - 4) * 64 : NLAT + b * CTXL + cn * 64; }
struct GlaRaw { u32x4 q, k, f, b, v0, v1, g0, g1, s0, s1; };
template <bool FULL>
__device__ __forceinline__ GlaRaw gla_load(Frame& F, int u, int tl) {
    const int h = u & 3, cn = (u >> 2) % 68, b = (u >> 2) / 68, i = tl >> 2, part = tl & 3;
    const bf16_t* p = (const bf16_t*)(F.ws + WS_U) + (size_t)(gla_row0(b, cn) + i) * DIN;
    GlaRaw r;
    r.q = *(const GAS u32x4*)(p + UGQ + h * 32 + part * 8); r.k = *(const GAS u32x4*)(p + UGK + h * 32 + part * 8);
    r.f = *(const GAS u32x4*)(p + ULAF + h * 32 + part * 8); r.b = *(const GAS u32x4*)(p + ULAB + h * 32 + part * 8);
    r.v0 = *(const GAS u32x4*)(p + UGV + h * 64 + part * 16); r.v1 = *(const GAS u32x4*)(p + UGV + h * 64 + part * 16 + 8);
    if (FULL) { r.g0 = *(const GAS u32x4*)(p + UGR + h * 64 + part * 16); r.g1 = *(const GAS u32x4*)(p + UGR + h * 64 + part * 16 + 8);
        const bf16_t* sp = (const bf16_t*)(F.ws + WS_GSIN) + (size_t)u * 2 * 2048 + tl * 16; r.s0 = *(const GAS u32x4*)sp; r.s1 = *(const GAS u32x4*)(sp + 8); }
    else { r.g0 = (u32x4){0u, 0u, 0u, 0u}; r.g1 = r.g0; r.s0 = r.g0; r.s1 = r.g0; }
    return r;
}
template <bool FULL>
__device__ __forceinline__ void gla_prep(Frame& F, LAS unsigned char* L, int l, int u, int tl, const GlaRaw& raw) {
    const int h = u & 3, cn = (u >> 2) % 68, i = tl >> 2, part = tl & 3, d8 = part * 8;
    LAS float* LAF = (LAS float*)(L + G2_LAF); LAS float* LAB = (LAS float*)(L + G2_LAB); LAS bf16_t* VT = (LAS bf16_t*)(L + G2_VT); LAS float* SEG = (LAS float*)(L + G2_SEG);
    float q[8], k[8], tf[8], tb[8];
    unpack8(raw.q, q); unpack8(raw.k, k); unpack8(raw.f, tf); unpack8(raw.b, tb);
    const float* ba = F.in[I_BA2] + (size_t)l * 256 + h * 32 + d8;
#pragma unroll
    for (int e = 0; e < 8; ++e) { q[e] *= 0.17677669529663687f; LAF[i * 33 + d8 + e] = log_sigmoid_f(tf[e] + ba[e]) * 0.0625f; LAB[i * 33 + d8 + e] = log_sigmoid_f(tb[e] + ba[128 + e]) * 0.0625f; }
    if (cn >= 4) {
        const float pos = (part >> 1) ? (float)i : (float)(cn - 4);
#pragma unroll
        for (int e = 0; e < 8; ++e) { const float ang = pos * __expf(-(float)e * (9.210340371976184f / 8.0f)); const float sn = __sinf(ang), cs = __cosf(ang);
            const float qo = shx(q[e], 1, F.lane), ko = shx(k[e], 1, F.lane);
            if (part & 1) { q[e] = qo * sn + q[e] * cs; k[e] = ko * sn + k[e] * cs; } else { q[e] = q[e] * cs - qo * sn; k[e] = k[e] * cs - ko * sn; } }
    }
    { const unsigned a[8] = {raw.v0.x, raw.v0.y, raw.v0.z, raw.v0.w, raw.v1.x, raw.v1.y, raw.v1.z, raw.v1.w};
#pragma unroll
      for (int e = 0; e < 8; ++e) { VT[(part * 16 + 2 * e) * 72 + i] = (bf16_t)(a[e] & 0xffffu); VT[(part * 16 + 2 * e + 1) * 72 + i] = (bf16_t)(a[e] >> 16); } }
    __syncthreads();
    { const int x = tl & 63, d = x & 31, dir = x >> 5, seg = tl >> 6; LAS float* LA = (dir ? LAB : LAF) + d; float cv[16];
#pragma unroll
      for (int kk = 0; kk < 16; ++kk) { const int p = seg * 16 + kk, ti = dir ? 63 - p : p; cv[kk] = LA[ti * 33]; }
#pragma unroll
      for (int kk = 1; kk < 16; ++kk) cv[kk] += cv[kk - 1];
#pragma unroll
      for (int kk = 0; kk < 16; ++kk) { const int p = seg * 16 + kk, ti = dir ? 63 - p : p; LA[ti * 33] = cv[kk]; }
      SEG[x * 5 + seg] = cv[15]; }
    __syncthreads();
    { const int x = tl & 63, d = x & 31, dir = x >> 5, seg = tl >> 6; LAS float* LA = (dir ? LAB : LAF) + d; float cv[16];
      const float t0 = SEG[x * 5 + 0], t1 = SEG[x * 5 + 1], t2 = SEG[x * 5 + 2];
      const float pre = seg == 0 ? 0.f : (seg == 1 ? t0 : (seg == 2 ? t0 + t1 : t0 + t1 + t2));
#pragma unroll
      for (int kk = 0; kk < 16; ++kk) { const int p = seg * 16 + kk, ti = dir ? 63 - p : p; cv[kk] = LA[ti * 33]; }
#pragma unroll
      for (int kk = 0; kk < 16; ++kk) { const int p = seg * 16 + kk, ti = dir ? 63 - p : p; LA[ti * 33] = cv[kk] + pre; } }
    __syncthreads();
    if (FULL) {
        unsigned wqf[4], wkf[4], wqb[4], wkb[4];
#pragma unroll
        for (int e = 0; e < 4; ++e) { const int d = d8 + 2 * e; const float f0 = LAF[i * 33 + d], f1 = LAF[i * 33 + d + 1], b0 = LAB[i * 33 + d], b1 = LAB[i * 33 + d + 1];
            wqf[e] = pk2(q[2 * e] * __expf(f0), q[2 * e + 1] * __expf(f1)); wkf[e] = pk2(k[2 * e] * __expf(-f0), k[2 * e + 1] * __expf(-f1));
            wqb[e] = pk2(q[2 * e] * __expf(b0), q[2 * e + 1] * __expf(b1)); wkb[e] = pk2(k[2 * e] * __expf(-b0), k[2 * e + 1] * __expf(-b1)); }
        *(LAS u32x4*)((LAS bf16_t*)(L + G2_QTF) + i * 40 + d8) = (u32x4){wqf[0], wqf[1], wqf[2], wqf[3]}; *(LAS u32x4*)((LAS bf16_t*)(L + G2_KTF) + i * 40 + d8) = (u32x4){wkf[0], wkf[1], wkf[2], wkf[3]};
        *(LAS u32x4*)((LAS bf16_t*)(L + G2_QTB) + i * 40 + d8) = (u32x4){wqb[0], wqb[1], wqb[2], wqb[3]}; *(LAS u32x4*)((LAS bf16_t*)(L + G2_KTB) + i * 40 + d8) = (u32x4){wkb[0], wkb[1], wkb[2], wkb[3]};
    } else {
        LAS bf16_t* KDF = (LAS bf16_t*)(L + G2_QTF); LAS bf16_t* KDB = (LAS bf16_t*)(L + G2_KTF);
#pragma unroll
        for (int e = 0; e < 8; ++e) { const int d = d8 + e; const float bf = LAF[i * 33 + d], bb = LAB[i * 33 + d], bfl = LAF[63 * 33 + d], bbl = LAB[0 * 33 + d];
            KDF[d * 72 + i] = (bf16_t)f2bf(k[e] * __expf(bfl - bf)); KDB[d * 72 + i] = (bf16_t)f2bf(k[e] * __expf(bbl - bb)); }
    }
    __syncthreads();
}
__device__ __forceinline__ void ph_gla_local(Frame& F, int l) {
    const int hw = F.wave >> 2, wl = F.wave & 3, tl = F.tid & 255; LAS unsigned char* L = F.lds + hw * G2_HALF;
    constexpr int NU = NB * 68 * 4;
    int pp = F.wg;
    GlaRaw raw = gla_load<false>(F, (pp * 2 + hw) < NU ? pp * 2 + hw : 0, tl);
    for (; pp * 2 < NU; pp += F.G) {
        const int u = pp * 2 + hw, un = (pp + F.G) * 2 + hw;
        const GlaRaw nraw = gla_load<false>(F, un < NU ? un : u, tl);
        __syncthreads();
        gla_prep<false>(F, L, l, u, tl, raw);
        const int g = F.lane >> 4, c = F.lane & 15;
        float* DS = (float*)(F.ws + WS_GDS) + (size_t)u * 2 * 2048;
#pragma unroll
        for (int kk = 0; kk < 4; ++kk) { const int tix = wl * 4 + kk, dir = tix >> 3, mt = (tix >> 1) & 3, nt = tix & 1;
            f32x4 a = (f32x4){0.f, 0.f, 0.f, 0.f};
            a = mma_lds((const LAS bf16_t*)(L + G2_VT) + mt * 16 * 72, 72, (const LAS bf16_t*)(L + (dir ? G2_KTF : G2_QTF)) + nt * 16 * 72, 72, 2, a, F.lane);
#pragma unroll
            for (int e = 0; e < 4; ++e) DS[dir * 2048 + (mt * 16 + 4 * g + e) * 32 + nt * 16 + c] = a[e]; }
        if (tl < 64) { const int d = tl & 31, dir = tl >> 5; ((float*)(F.ws + WS_GD))[(size_t)u * 64 + tl] = __expf(dir ? ((LAS float*)(L + G2_LAB))[0 * 33 + d] : ((LAS float*)(L + G2_LAF))[63 * 33 + d]); }
        raw = nraw;
    }
}
__device__ __forceinline__ void ph_gla_scan(Frame& F) {
    const int gt = F.wg * NTHR + F.tid, NGT = F.G * NTHR;
    const float* DS = (const float*)(F.ws + WS_GDS); const float* GD = (const float*)(F.ws + WS_GD); bf16_t* SIN = (bf16_t*)(F.ws + WS_GSIN);
    for (int w = gt; w < 128 * 1024; w += NGT) {
        const int chain = w >> 10, el = (w & 1023) * 2, dir = chain & 1, h = (chain >> 1) & 3, b = chain >> 3, d = el & 31;
        float s0 = 0.f, s1 = 0.f;
        for (int step = 0; step < 68; step += 4) {
            f32x2 ds[4], dd[4]; size_t uu[4];
#pragma unroll
            for (int q = 0; q < 4; ++q) { const int st_ = step + q; const int cn = dir ? (st_ < 4 ? 3 - st_ : 71 - st_) : st_;
                uu[q] = (size_t)(b * 68 + cn) * 4 + h;
                ds[q] = *(const GAS f32x2*)(DS + (uu[q] * 2 + dir) * 2048 + el); dd[q] = *(const GAS f32x2*)(GD + uu[q] * 64 + dir * 32 + d); }
#pragma unroll
            for (int q = 0; q < 4; ++q) { *(GAS unsigned*)(SIN + (uu[q] * 2 + dir) * 2048 + el) = pk2(s0, s1); s0 = dd[q].x * s0 + ds[q].x; s1 = dd[q].y * s1 + ds[q].y; }
        }
    }
}
__device__ __forceinline__ void ph_gla_out(Frame& F, int l, bool last) {
    const int hw = F.wave >> 2, wl = F.wave & 3, tl = F.tid & 255; LAS unsigned char* L = F.lds + hw * G2_HALF;
    const int NV = last ? NB * 64 * 4 : NB * 68 * 4;
#define GLA_UNIT(v) (last ? ((((v) >> 8) * 68 + 4 + (((v) & 255) >> 2)) * 4 + ((v) & 3)) : (v))
    int pp = F.wg;
    GlaRaw raw = gla_load<true>(F, GLA_UNIT((pp * 2 + hw) < NV ? pp * 2 + hw : 0), tl);
    for (; pp * 2 < NV; pp += F.G) {
        const int u = GLA_UNIT(pp * 2 + hw), vn = (pp + F.G) * 2 + hw;
        const GlaRaw nraw = gla_load<true>(F, vn < NV ? GLA_UNIT(vn) : u, tl);
        const int h = u & 3, cn = (u >> 2) % 68, b = (u >> 2) / 68;
        __syncthreads();
        gla_prep<true>(F, L, l, u, tl, raw);
        { const int dir = tl >> 7, dv = (tl >> 1) & 63, d16 = (tl & 1) * 16; LAS bf16_t* S = (LAS bf16_t*)(L + (dir ? G2_SB : G2_SF)) + dv * 40 + d16; *(LAS u32x4*)S = raw.s0; *(LAS u32x4*)(S + 8) = raw.s1; }
        const int g = F.lane >> 4, c = F.lane & 15;
        LAS bf16_t* ATT = (LAS bf16_t*)(L + G2_ATT);
#pragma unroll
        for (int kk = 0; kk < 4; ++kk) { const int tile = wl * 4 + kk, mt = tile >> 2, nt = tile & 3;
            f32x4 af = (f32x4){0.f, 0.f, 0.f, 0.f}, ab = af;
            af = mma_lds((const LAS bf16_t*)(L + G2_QTF) + mt * 16 * 40, 40, (const LAS bf16_t*)(L + G2_KTF) + nt * 16 * 40, 40, 1, af, F.lane);
            ab = mma_lds((const LAS bf16_t*)(L + G2_QTB) + mt * 16 * 40, 40, (const LAS bf16_t*)(L + G2_KTB) + nt * 16 * 40, 40, 1, ab, F.lane);
#pragma unroll
            for (int e = 0; e < 4; ++e) { const int ii = mt * 16 + 4 * g + e, j = nt * 16 + c; const float vv = (j <= ii ? af[e] : 0.f) + (j >= ii ? ab[e] : 0.f); ATT[ii * 72 + j] = (bf16_t)f2bf(vv); } }
        __syncthreads();
        LAS float* O = (LAS float*)(L + G2_LAF);
#pragma unroll
        for (int kk = 0; kk < 4; ++kk) { const int tile = wl * 4 + kk, mt = tile >> 2, nt = tile & 3;
            f32x4 a = (f32x4){0.f, 0.f, 0.f, 0.f};
            a = mma_lds(ATT + mt * 16 * 72, 72, (const LAS bf16_t*)(L + G2_VT) + nt * 16 * 72, 72, 2, a, F.lane);
            a = mma_lds((const LAS bf16_t*)(L + G2_QTF) + mt * 16 * 40, 40, (const LAS bf16_t*)(L + G2_SF) + nt * 16 * 40, 40, 1, a, F.lane);
            a = mma_lds((const LAS bf16_t*)(L + G2_QTB) + mt * 16 * 40, 40, (const LAS bf16_t*)(L + G2_SB) + nt * 16 * 40, 40, 1, a, F.lane);
#pragma unroll
            for (int e = 0; e < 4; ++e) O[(mt * 16 + 4 * g + e) * 65 + nt * 16 + c] = a[e]; }
        __syncthreads();
        { const int i = tl >> 2, dv16 = (tl & 3) * 16; const int row = gla_row0(b, cn) + i;
          float v[16], gt[16]; float ss = 0.f;
#pragma unroll
          for (int e = 0; e < 16; ++e) { v[e] = O[i * 65 + dv16 + e]; ss += v[e] * v[e]; }
          ss += shx(ss, 1, F.lane); ss += shx(ss, 2, F.lane);
          const float rs = 1.0f / sqrtf(ss * (1.0f / 64.0f) + LN_EPS);
          unpack8(raw.g0, gt); unpack8(raw.g1, gt + 8);
          const float* gn = F.in[I_GNORM] + l * 64 + dv16;
          unsigned w[8];
#pragma unroll
          for (int e = 0; e < 8; ++e) w[e] = pk2(v[2 * e] * rs * gn[2 * e] * silu_f(gt[2 * e]), v[2 * e + 1] * rs * gn[2 * e + 1] * silu_f(gt[2 * e + 1]));
          bf16_t* mp = (bf16_t*)(F.ws + WS_MIX) + (size_t)row * DM + 512 + h * 64 + dv16;
          *(GAS u32x4*)mp = (u32x4){w[0], w[1], w[2], w[3]}; *(GAS u32x4*)(mp + 8) = (u32x4){w[4], w[5], w[6], w[7]}; }
        raw = nraw;
    }
#undef GLA_UNIT
}

template <int L>
__device__ __forceinline__ void hyena_conv(Frame& F, const bf16_t* Rg, const bf16_t* Uin, const bf16_t* Xmul, int pos0, bool final_out, int ch, bf16_t* Zout) {
    constexpr int CS = 2 * L + 16;
    constexpr int NTL = L / 16, J = (NTL >= 64) ? 16 : 2, NGRP = NTL / J, HJ = J / 2, NSTEP = L / 32;
    LAS bf16_t* Rl = (LAS bf16_t*)F.lds;
    __syncthreads();
    for (int c = F.tid; c < 2 * L / 8; c += NTHR) { const u32x4 v = *(const GAS u32x4*)(Rg + 8 * c); const unsigned a[4] = {v.x, v.y, v.z, v.w};
#pragma unroll
        for (int rho = 0; rho < 8; ++rho) { LAS bf16_t* d = Rl + rho * CS + 8 * c + rho;
#pragma unroll
            for (int k = 0; k < 4; ++k) { d[2 * k] = (bf16_t)(a[k] & 0xffffu); d[2 * k + 1] = (bf16_t)(a[k] >> 16); } } }
    __syncthreads();
    int ln_ = F.lane; asm volatile("" : "+v"(ln_));
    const int i = ln_ & 15, g = ln_ >> 4, rho = i & 7;
    const LAS bf16_t* Rc = Rl + rho * CS + rho;
    for (int grp = F.wave; grp < NGRP; grp += NWAVES) {
        f32x4 acc[J]; bf16x8 fr[J];
        const int tb = grp * J * 16;
        const LAS bf16_t* Rb = Rc + (L - tb - i + 8 * g);
#pragma unroll
        for (int j = 0; j < J; ++j) { acc[j] = (f32x4){0.f, 0.f, 0.f, 0.f}; fr[j] = *(const LAS bf16x8*)(Rb - 16 * j); }
        const char* ub = (const char*)(Uin + pos0); const unsigned ulo = (unsigned)((i * SPB + 8 * g) * 2);
        constexpr int PF = (HJ >= 4) ? 4 : 1;
        bf16x8 bq[PF];
#pragma unroll
        for (int p = 0; p < PF; ++p) bq[p] = *(const GAS bf16x8*)(ub + (size_t)(ulo + (unsigned)p * 64u));
#pragma unroll 1
        for (int q = 0; q < NSTEP / HJ; ++q) {
#pragma unroll
            for (int m = 0; m < HJ; ++m) {
                const int n = q * HJ + m;
                const int nn = (n + PF < NSTEP) ? n + PF : 0;
                if (n > 0) { fr[(J - 2 * m) % J] = *(const LAS bf16x8*)(Rb + 32 * n); fr[(J + 1 - 2 * m) % J] = *(const LAS bf16x8*)(Rb + 32 * n - 16); }
                const bf16x8 bcur = bq[m % PF];
#pragma unroll
                for (int jj = 0; jj < J; ++jj) { const int j = (jj + 2) % J; acc[j] = mfma16(fr[(j + J - 2 * m) % J], bcur, acc[j]); }
                bq[m % PF] = *(const GAS bf16x8*)(ub + (size_t)(ulo + (unsigned)nn * 64u));
            }
        }
#pragma unroll
        for (int j = 0; j < J; ++j) { const int t0 = tb + j * 16 + 4 * g;
            const u32x2 xw = *(const GAS u32x2*)(Xmul + (size_t)i * SPB + pos0 + t0);
            const float y0 = acc[j][0] * bflo(xw.x), y1 = acc[j][1] * bfhi(xw.x), y2 = acc[j][2] * bflo(xw.y), y3 = acc[j][3] * bfhi(xw.y);
            if (!final_out) { u32x2 w; w.x = pk2(y0, y1); w.y = pk2(y2, y3); *(GAS u32x2*)(Zout + (size_t)i * SPB + pos0 + t0) = w; }
            else { u32x2 w; w.x = pk2(y0, y1); w.y = pk2(y2, y3); *(GAS u32x2*)((bf16_t*)(F.ws + WS_Y) + ((size_t)ch * NB + i) * SPB + pos0 + t0) = w; } }
    }
}
__device__ __forceinline__ void ph_hyena(Frame& F, int l, bool last) {
    const bf16_t* HV = (const bf16_t*)(F.ws + WS_HV); bf16_t* Z2 = (bf16_t*)(F.ws + WS_Z2);
    for (int ch = F.wg; ch < 256; ch += F.G) {
        const bf16_t* v = HV + (size_t)(0 * 256 + ch) * NB * SPB; const bf16_t* x1 = HV + (size_t)(256 + ch) * NB * SPB; const bf16_t* x2 = HV + (size_t)(512 + ch) * NB * SPB;
        bf16_t* z = Z2 + (size_t)ch * NB * SPB;
        const bf16_t* R0 = (const bf16_t*)(F.ws + WS_HYF) + ((size_t)(l * 2 + 0) * 256 + ch) * 8192; const bf16_t* R1 = (const bf16_t*)(F.ws + WS_HYF) + ((size_t)(l * 2 + 1) * 256 + ch) * 8192;
        hyena_conv<4096>(F, R0, v, x1, 0, false, ch, z);
        VM_WAIT(); __syncthreads(); __builtin_amdgcn_fence(__ATOMIC_ACQUIRE, "agent"); VM_WAIT();
        hyena_conv<4096>(F, R1, z, x2, 0, true, ch, z);
        if (!last) {
            const bf16_t* C0 = (const bf16_t*)(F.ws + WS_HYFC) + ((size_t)(l * 2 + 0) * 256 + ch) * 512; const bf16_t* C1 = (const bf16_t*)(F.ws + WS_HYFC) + ((size_t)(l * 2 + 1) * 256 + ch) * 512;
            hyena_conv<256>(F, C0, v, x1, SEQ, false, ch, z);
            VM_WAIT(); __syncthreads(); __builtin_amdgcn_fence(__ATOMIC_ACQUIRE, "agent"); VM_WAIT();
            hyena_conv<256>(F, C1, z, x2, SEQ, true, ch, z);
        }
    }
}

__device__ __forceinline__ void ph_ln1(Frame& F, int l, int ntok) {
    const int gw = F.wg * NWAVES + F.wave, NGW = F.G * NWAVES;
    const int cA = 256 * (F.lane >> 4) + 32 * ((F.lane >> 2) & 3) + 8 * (F.lane & 3);
#define LN1_COL(j) (cA + ((j) < 2 ? 4 * (j) : 128 + 4 * ((j) - 2)))
    const float* lg = F.in[I_LN1G] + l * DM; const float* lb = F.in[I_LN1B] + l * DM;
    for (int row = gw; row < ntok; row += NGW) {
        bf16_t* xr = (bf16_t*)(F.ws + WS_XR) + (size_t)row * DM;
        const unsigned char* yr = (const unsigned char*)(F.ws + WS_Y) + (size_t)row * DM + 16 * F.lane;
        const float* md = mod_ptr(F, l, row);
        const u32x4 xa = __builtin_nontemporal_load((const GAS u32x4*)(xr + cA)), xb = __builtin_nontemporal_load((const GAS u32x4*)(xr + cA + 128)), ya = __builtin_nontemporal_load((const GAS u32x4*)yr);
        float x[16], y[16], v[16]; unpack8(xa, x); unpack8(xb, x + 8);
        { const unsigned a[4] = {ya.x, ya.y, ya.z, ya.w};
#pragma unroll
          for (int e = 0; e < 4; ++e) { const f32x2 lo = __builtin_amdgcn_cvt_pk_f32_fp8((int)a[e], false), hi = __builtin_amdgcn_cvt_pk_f32_fp8((int)a[e], true); y[4 * e] = lo.x; y[4 * e + 1] = lo.y; y[4 * e + 2] = hi.x; y[4 * e + 3] = hi.y; } }
        float s = 0.f;
#pragma unroll
        for (int j = 0; j < 4; ++j) { const f32x4 g1 = *(const GAS f32x4*)(md + 2048 + LN1_COL(j));
#pragma unroll
            for (int e = 0; e < 4; ++e) { v[4 * j + e] = x[4 * j + e] * DN_ALPHA + g1[e] * y[4 * j + e]; s += v[4 * j + e]; } }
        const float mean = wave_sum(s, F.lane) * (1.f / DM); float s2 = 0.f;
#pragma unroll
        for (int e = 0; e < 16; ++e) { v[e] -= mean; s2 += v[e] * v[e]; }
        const float rstd = 1.f / sqrtf(wave_sum(s2, F.lane) * (1.f / DM) + LN_EPS);
        unsigned wx[8]; int w8[4];
#pragma unroll
        for (int j = 0; j < 4; ++j) { const f32x4 g = *(const GAS f32x4*)(lg + LN1_COL(j)), bb = *(const GAS f32x4*)(lb + LN1_COL(j)), sh = *(const GAS f32x4*)(md + 3072 + LN1_COL(j)), sc = *(const GAS f32x4*)(md + 4096 + LN1_COL(j));
            float xn[4];
#pragma unroll
            for (int e = 0; e < 4; ++e) xn[e] = v[4 * j + e] * rstd * g[e] + bb[e];
            wx[2 * j] = pk2(xn[0], xn[1]); wx[2 * j + 1] = pk2(xn[2], xn[3]);
            const float h0 = xn[0] * (1.f + sc[0]) + sh[0], h1 = xn[1] * (1.f + sc[1]) + sh[1], h2 = xn[2] * (1.f + sc[2]) + sh[2], h3 = xn[3] * (1.f + sc[3]) + sh[3];
            int v = 0; v = __builtin_amdgcn_cvt_pk_fp8_f32(h0, h1, v, false); v = __builtin_amdgcn_cvt_pk_fp8_f32(h2, h3, v, true); w8[j] = v; }
        unsigned char* x8 = (unsigned char*)(F.ws + WS_XM8) + (size_t)row * DM;
        *(GAS u32x2*)(x8 + cA) = (u32x2){(unsigned)w8[0], (unsigned)w8[1]}; *(GAS u32x2*)(x8 + cA + 128) = (u32x2){(unsigned)w8[2], (unsigned)w8[3]};
        *(GAS u32x4*)(xr + cA) = (u32x4){wx[0], wx[1], wx[2], wx[3]}; *(GAS u32x4*)(xr + cA + 128) = (u32x4){wx[4], wx[5], wx[6], wx[7]};
    }
#undef LN1_COL
}
__device__ __forceinline__ void ph_ln2(Frame& F, int l, int ntok, bool last) {
    const int gw = F.wg * NWAVES + F.wave, NGW = F.G * NWAVES;
    const int cA = 256 * (F.lane >> 4) + 32 * ((F.lane >> 2) & 3) + 8 * (F.lane & 3);
#define LN2_COL(j) (cA + ((j) < 2 ? 4 * (j) : 128 + 4 * ((j) - 2)))
    const float* lg = F.in[I_LN2G] + l * DM; const float* lb = F.in[I_LN2B] + l * DM;
    for (int row = gw; row < ntok; row += NGW) {
        bf16_t* xr = (bf16_t*)(F.ws + WS_XR) + (size_t)row * DM;
        const unsigned char* y2 = (const unsigned char*)(F.ws + WS_Y2) + (size_t)row * 5120;
        const float* wg = (const float*)(F.ws + WS_WGT) + (size_t)row * 8;
        const float* md = mod_ptr(F, l, row);
        float ff[16];
#pragma unroll
        for (int e = 0; e < 16; ++e) ff[e] = 0.f;
        u32x2 q[8];
#pragma unroll
        for (int k = 0; k < 8; ++k) q[k] = __builtin_nontemporal_load((const GAS u32x2*)(y2 + k * 512 + 8 * F.lane));
        const u32x4 qs = __builtin_nontemporal_load((const GAS u32x4*)(y2 + 4096 + 16 * F.lane));
        { const unsigned a[4] = {qs.x, qs.y, qs.z, qs.w};
#pragma unroll
          for (int e = 0; e < 4; ++e) { const f32x2 lo = __builtin_amdgcn_cvt_pk_f32_fp8((int)a[e], false), hi = __builtin_amdgcn_cvt_pk_f32_fp8((int)a[e], true);
              ff[4 * e] += pg8::Y2_INV * lo.x; ff[4 * e + 1] += pg8::Y2_INV * lo.y; ff[4 * e + 2] += pg8::Y2_INV * hi.x; ff[4 * e + 3] += pg8::Y2_INV * hi.y; } }
#pragma unroll
        for (int k = 0; k < 8; ++k) { const float wk = wg[k] * pg8::Y2_INV; const unsigned a[2] = {q[k].x, q[k].y};
#pragma unroll
            for (int h = 0; h < 2; ++h) {
                const f32x2 p0 = __builtin_amdgcn_cvt_scalef32_pk_f32_fp4(a[h], 1.0f, 0), p1 = __builtin_amdgcn_cvt_scalef32_pk_f32_fp4(a[h], 1.0f, 1), p2 = __builtin_amdgcn_cvt_scalef32_pk_f32_fp4(a[h], 1.0f, 2), p3 = __builtin_amdgcn_cvt_scalef32_pk_f32_fp4(a[h], 1.0f, 3);
                ff[8 * h] += wk * p0.x; ff[8 * h + 1] += wk * p0.y; ff[8 * h + 2] += wk * p1.x; ff[8 * h + 3] += wk * p1.y; ff[8 * h + 4] += wk * p2.x; ff[8 * h + 5] += wk * p2.y; ff[8 * h + 6] += wk * p3.x; ff[8 * h + 7] += wk * p3.y; } }
        float v[16], xo[16]; float s = 0.f;
        { const u32x4 xa = __builtin_nontemporal_load((const GAS u32x4*)(xr + cA)), xb = __builtin_nontemporal_load((const GAS u32x4*)(xr + cA + 128)); unpack8(xa, xo); unpack8(xb, xo + 8); }
#pragma unroll
        for (int j = 0; j < 4; ++j) { const f32x4 g2 = *(const GAS f32x4*)(md + 5120 + LN2_COL(j));
#pragma unroll
            for (int e = 0; e < 4; ++e) { v[4 * j + e] = xo[4 * j + e] * DN_ALPHA + g2[e] * ff[4 * j + e]; s += v[4 * j + e]; } }
        const float mean = wave_sum(s, F.lane) * (1.f / DM); float s2 = 0.f;
#pragma unroll
        for (int e = 0; e < 16; ++e) { v[e] -= mean; s2 += v[e] * v[e]; }
        const float rstd = 1.f / sqrtf(wave_sum(s2, F.lane) * (1.f / DM) + LN_EPS);
        const float* mdn = last ? md : mod_ptr(F, l + 1, row);
        float xn[16];
#pragma unroll
        for (int j = 0; j < 4; ++j) { const f32x4 g = *(const GAS f32x4*)(lg + LN2_COL(j)), bb = *(const GAS f32x4*)(lb + LN2_COL(j));
#pragma unroll
            for (int e = 0; e < 4; ++e) xn[4 * j + e] = v[4 * j + e] * rstd * g[e] + bb[e]; }
        if (last) { float* op = F.out + (size_t)row * DM;
#pragma unroll
            for (int j = 0; j < 4; ++j) *(GAS f32x4*)(op + LN2_COL(j)) = (f32x4){xn[4 * j], xn[4 * j + 1], xn[4 * j + 2], xn[4 * j + 3]}; }
        else {
            *(GAS u32x4*)(xr + cA) = (u32x4){pk2(xn[0], xn[1]), pk2(xn[2], xn[3]), pk2(xn[4], xn[5]), pk2(xn[6], xn[7])}; *(GAS u32x4*)(xr + cA + 128) = (u32x4){pk2(xn[8], xn[9]), pk2(xn[10], xn[11]), pk2(xn[12], xn[13]), pk2(xn[14], xn[15])};
            bf16_t* xm = (bf16_t*)(F.ws + WS_XM) + (size_t)row * DM;
            unsigned w[8];
#pragma unroll
            for (int j = 0; j < 4; ++j) { const f32x4 sh = *(const GAS f32x4*)(mdn + LN2_COL(j)), sc = *(const GAS f32x4*)(mdn + 1024 + LN2_COL(j));
                w[2 * j] = pk2(xn[4 * j] * (1.f + sc[0]) + sh[0], xn[4 * j + 1] * (1.f + sc[1]) + sh[1]); w[2 * j + 1] = pk2(xn[4 * j + 2] * (1.f + sc[2]) + sh[2], xn[4 * j + 3] * (1.f + sc[3]) + sh[3]); }
            *(GAS u32x4*)(xm + cA) = (u32x4){w[0], w[1], w[2], w[3]}; *(GAS u32x4*)(xm + cA + 128) = (u32x4){w[4], w[5], w[6], w[7]};
        }
    }
#undef LN2_COL
}

__device__ __forceinline__ unsigned f_ord(float f) { const unsigned u = __builtin_bit_cast(unsigned, f); return (u & 0x80000000u) ? ~u : (u | 0x80000000u); }
__device__ __forceinline__ unsigned long long wave_max_u64(unsigned long long v, int lane) {
#pragma unroll
    for (int o = 1; o < 64; o <<= 1) { const unsigned lo = (unsigned)shxi((int)(unsigned)v, o, lane), hi = (unsigned)shxi((int)(unsigned)(v >> 32), o, lane); const unsigned long long w = ((unsigned long long)hi << 32) | lo; v = w > v ? w : v; }
    return v;
}
__device__ __forceinline__ float seg16_max(float v, int lane) { v = fmaxf(v, shx(v, 1, lane)); v = fmaxf(v, shx(v, 2, lane)); v = fmaxf(v, shx(v, 4, lane)); v = fmaxf(v, shx(v, 8, lane)); return v; }
__device__ __forceinline__ int seg16_min_i(int v, int lane) { int w; w = shxi(v, 1, lane); v = w < v ? w : v; w = shxi(v, 2, lane); v = w < v ? w : v; w = shxi(v, 4, lane); v = w < v ? w : v; w = shxi(v, 8, lane); v = w < v ? w : v; return v; }
template <int CTRL> __device__ __forceinline__ int dpp_i(int v) { return __builtin_amdgcn_update_dpp(0, v, CTRL, 0xf, 0xf, true); }
__device__ __forceinline__ unsigned row_max_u(unsigned v) { unsigned w; w = (unsigned)dpp_i<0xB1>((int)v); v = w > v ? w : v; w = (unsigned)dpp_i<0x4E>((int)v); v = w > v ? w : v; w = (unsigned)dpp_i<0x141>((int)v); v = w > v ? w : v; w = (unsigned)dpp_i<0x140>((int)v); v = w > v ? w : v; return v; }
__device__ __forceinline__ float row_max_f(float v) { v = fmaxf(v, __builtin_bit_cast(float, dpp_i<0xB1>(__builtin_bit_cast(int, v)))); v = fmaxf(v, __builtin_bit_cast(float, dpp_i<0x4E>(__builtin_bit_cast(int, v)))); v = fmaxf(v, __builtin_bit_cast(float, dpp_i<0x141>(__builtin_bit_cast(int, v)))); v = fmaxf(v, __builtin_bit_cast(float, dpp_i<0x140>(__builtin_bit_cast(int, v)))); return v; }
__device__ __forceinline__ int row_min_i(int v) { int w; w = dpp_i<0xB1>(v); v = w < v ? w : v; w = dpp_i<0x4E>(v); v = w < v ? w : v; w = dpp_i<0x141>(v); v = w < v ? w : v; w = dpp_i<0x140>(v); v = w < v ? w : v; return v; }
__device__ __forceinline__ float rdlane_f(float v, int l) { return __builtin_bit_cast(float, __builtin_amdgcn_readlane(__builtin_bit_cast(int, v), l)); }
__device__ __forceinline__ unsigned wave_max_u(unsigned v) {
    v = row_max_u(v);
    const unsigned a = (unsigned)__builtin_amdgcn_readlane((int)v, 0), b = (unsigned)__builtin_amdgcn_readlane((int)v, 16), c = (unsigned)__builtin_amdgcn_readlane((int)v, 32), d = (unsigned)__builtin_amdgcn_readlane((int)v, 48);
    const unsigned ab = a > b ? a : b, cd = c > d ? c : d; return ab > cd ? ab : cd;
}
__device__ __forceinline__ float row_top2(float v, int l16) {
    const float m1 = row_max_f(v);
    const int first = row_min_i(v == m1 ? l16 : 99);
    const float m2 = row_max_f(l16 == first ? -3.0e38f : v);
    return m1 + m2;
}
__device__ __forceinline__ float seg16_top2(float v, int lane) {
    const float m1 = seg16_max(v, lane);
    const int first = seg16_min_i(v == m1 ? (lane & 15) : 99, lane);
    const float m2 = seg16_max((lane & 15) == first ? -3.0e38f : v, lane);
    return m1 + m2;
}
__device__ __forceinline__ void ph_route(Frame& F, int l, int ntok) {
    LAS int* hist = (LAS int*)F.lds;
    LAS int* base = hist + 128;
    LAS unsigned* alist = (LAS unsigned*)(F.lds + 1024);
    const int tpw = (ntok + F.G - 1) / F.G, t0 = F.wg * tpw, t1 = (t0 + tpw) < ntok ? (t0 + tpw) : ntok;
    __syncthreads();
    if (F.tid < 128) hist[F.tid] = 0;
    __syncthreads();
    const float* LG = (const float*)(F.ws + WS_LOGIT); const float* rb = F.in[I_RB] + l * NEXP;
    const float b0 = rb[F.lane], b1 = rb[F.lane + 64];
    constexpr int RT = 4;
    for (int tb = t0 + F.wave * RT; tb < t1; tb += NWAVES * RT) {
        float s0[RT], s1[RT], e0[RT], e1[RT], gs0[RT], gs1[RT]; unsigned h0[RT], h1[RT]; int mye[RT]; float myw[RT], wsum[RT];
#pragma unroll
        for (int j = 0; j < RT; ++j) { const int tok = (tb + j) < t1 ? tb + j : t1 - 1;
            const float x0 = LG[(size_t)tok * 256 + F.lane], x1 = LG[(size_t)tok * 256 + 64 + F.lane];
            const float* rbs = (const float*)(F.ws + WS_RBIAS) + (size_t)(l * 17 + row_b(tok)) * 128; const float y0 = x0 + rbs[F.lane], y1 = x1 + rbs[64 + F.lane];
            s0[j] = __builtin_amdgcn_rcpf(1.0f + __expf(-y0)); s1[j] = __builtin_amdgcn_rcpf(1.0f + __expf(-y1)); e0[j] = s0[j] + b0; e1[j] = s1[j] + b1; }
#pragma unroll
        for (int j = 0; j < RT; ++j) { gs0[j] = row_top2(e0[j], F.lane & 15); gs1[j] = row_top2(e1[j], F.lane & 15); }
#pragma unroll
        for (int j = 0; j < RT; ++j) {
            float gsc[8];
#pragma unroll
            for (int g = 0; g < 4; ++g) { gsc[g] = rdlane_f(gs0[j], g * 16); gsc[4 + g] = rdlane_f(gs1[j], g * 16); }
            unsigned gmask = 0u;
#pragma unroll
            for (int g = 0; g < 8; ++g) { int cnt = 0;
#pragma unroll
                for (int g2 = 0; g2 < 8; ++g2) cnt += (gsc[g2] > gsc[g] || (gsc[g2] == gsc[g] && g2 < g)) ? 1 : 0;
                gmask |= (cnt < 4) ? (1u << g) : 0u; }
            const bool ok0 = (gmask >> (F.lane >> 4)) & 1u, ok1 = (gmask >> (4 + (F.lane >> 4))) & 1u;
            h0[j] = ok0 ? f_ord(e0[j]) : 0u; h1[j] = ok1 ? f_ord(e1[j]) : 0u;
            mye[j] = 0; myw[j] = 0.f; wsum[j] = 0.f; }
#pragma unroll
        for (int k = 0; k < 8; ++k) {
#pragma unroll
            for (int j = 0; j < RT; ++j) {
                const unsigned bh = h0[j] >= h1[j] ? h0[j] : h1[j];
                const unsigned H = wave_max_u(bh);
                const unsigned mylo = h0[j] == H ? (unsigned)(255 - F.lane) : (h1[j] == H ? (unsigned)(255 - 64 - F.lane) : 0u);
                const unsigned Lm = wave_max_u(mylo);
                const int e = 255 - (int)Lm;
                if (e < 64) { if (F.lane == e) h0[j] = 0u; } else { if (F.lane == e - 64) h1[j] = 0u; }
                const float sv = e < 64 ? rdlane_f(s0[j], e) : rdlane_f(s1[j], e - 64);
                wsum[j] += sv; if (F.lane == k) { mye[j] = e; myw[j] = sv; } }
        }
#pragma unroll
        for (int j = 0; j < RT; ++j) { const int tok = tb + j;
            if (tok < t1 && F.lane < 8) {
                const int lr = __hip_atomic_fetch_add(&hist[mye[j]], 1, __ATOMIC_RELAXED, __HIP_MEMORY_SCOPE_WORKGROUP);
                alist[(tok - t0) * 8 + F.lane] = (unsigned)mye[j] | ((unsigned)lr << 8);
                ((int*)(F.ws + WS_EIDX))[(size_t)tok * 8 + F.lane] = mye[j];
                ((float*)(F.ws + WS_WGT))[(size_t)tok * 8 + F.lane] = myw[j] / wsum[j] * 2.5f;
            } }
    }
    __syncthreads();
    if (F.tid < 128) { const int hcount = hist[F.tid]; base[F.tid] = hcount ? (int)atomicAdd(F.ctl + CW_CNT + l * 256 + F.tid, (unsigned)hcount) : 0; }
    __syncthreads();
    for (int a = F.tid; a < (t1 - t0) * 8; a += NTHR) { const unsigned v = alist[a]; ((int*)(F.ws + WS_RNK))[(size_t)t0 * 8 + a] = base[v & 0xffu] + (int)(v >> 8); }
}
__device__ __forceinline__ void ph_positions(Frame& F, int l, int ntok) {
    LAS int* cnt = (LAS int*)F.lds;
    LAS int* off = cnt + 132;
    __syncthreads();
    if (F.tid < NE1) cnt[F.tid] = F.tid < NEXP ? (int)__hip_atomic_load(F.ctl + CW_CNT + l * 256 + F.tid, __ATOMIC_RELAXED, __HIP_MEMORY_SCOPE_AGENT) : ntok;
    __syncthreads();
    if (F.tid == 0) { int o = 0; for (int e = 0; e < NE1; ++e) { off[e] = o; o += (cnt[e] + 255) & ~255; } off[NE1] = o; }
    __syncthreads();
    const int gt = F.wg * NTHR + F.tid, NGT = F.G * NTHR;
    int* rowtok = (int*)(F.ws + WS_ROWTOK); int* rowdst = (int*)(F.ws + WS_ROWDST); int* tile_exp = (int*)(F.ws + WS_TILEEXP);
    const int* eidx = (const int*)(F.ws + WS_EIDX); const int* rnk = (const int*)(F.ws + WS_RNK);
    for (int a = gt; a < ntok * 8; a += NGT) { const int tok = a >> 3, k = a & 7; const int pos = off[eidx[a]] + rnk[a]; rowtok[pos] = tok; rowdst[pos] = tok * 10 + k; }
    for (int tok = gt; tok < ntok; tok += NGT) { const int pos = off[NEXP] + tok; rowtok[pos] = tok; rowdst[pos] = tok * 10 + 8; }
    for (int i = gt; i < NE1 * 256; i += NGT) { const int e = i >> 8, p = i & 255; const int row = off[e] + cnt[e] + p; if (row < off[e + 1]) { rowtok[row] = 0; rowdst[row] = -1; } }
    for (int i = gt; i < NE1 * 320; i += NGT) { const int e = i / 320, p = i % 320; const int t = (off[e] >> 8) + p; if (t < (off[e + 1] >> 8)) tile_exp[t] = e; }
    if (gt == 0) F.ctl[CW_NTL + l] = (unsigned)(off[NE1] >> 8);
}

#ifndef MK_MULTI
#define MK_MULTI 0
#endif
constexpr int PH_PER_LAYER = 12, NPHASE = 2 + DEPTH * PH_PER_LAYER;
struct Args { const float* in[36]; float* out; unsigned char* ws; int ph_lo, ph_hi; };

__global__ void __launch_bounds__(NTHR, 2) mk_fwd(Args args) {
    extern __shared__ __attribute__((aligned(16))) unsigned char lds_raw[];
    Frame F;
    F.lds = (LAS unsigned char*)lds_raw;
    F.tid = threadIdx.x; F.lane = F.tid & 63; F.wave = __builtin_amdgcn_readfirstlane(F.tid >> 6);
    const int wave0 = F.wave;
    F.G = gridDim.x; F.wg = blockIdx.x;
    F.in = args.in;
    F.out = args.out; F.ws = args.ws; F.ctl = (unsigned*)(args.ws + WS_CTL);
    volatile LAS unsigned* MISC = (volatile LAS unsigned*)(F.lds + MISC_OFF);
    if (F.tid < 32) MISC[F.tid] = 0u;
    __syncthreads();
    const int lo = args.ph_lo, hi = args.ph_hi;
    const bool single = (hi - lo) > 1;
    XcdBarrier bar; bar.bar = F.ctl + CW_BAR; bar.x = 0; bar.st = nullptr;
    if (single) bar = xcd_barrier_post(F.ctl + CW_BAR, MISC + 8);
#define IN(k) (lo <= (k) && (k) < hi)
#ifndef PROBE_MASK
#define PROBE_MASK 0
#endif
#define REP(k) for (int _rep = 0; _rep < (((PROBE_MASK >> (k)) & 1) ? 2 : 1); ++_rep)
#define SEAM(k) do { if (IN(k) && IN((k) + 1)) { xcd_barrier(bar); if ((PROBE_MASK >> 15) & 1) xcd_barrier(bar); } } while (0)
#define FRESH() do { int _ln; asm volatile("v_mbcnt_lo_u32_b32 %0, -1, 0\n\tv_mbcnt_hi_u32_b32 %0, -1, %0" : "=v"(_ln)); int _wv = wave0; asm volatile("" : "+s"(_wv)); F.lane = _ln; F.wave = _wv; F.tid = (_wv << 6) | _ln; \
        unsigned char* _w = args.ws; asm volatile("" : "+s"(_w)); F.ws = _w; F.ctl = (unsigned*)(_w + WS_CTL); float* _o = args.out; asm volatile("" : "+s"(_o)); F.out = _o; } while (0)

    if (IN(0)) { FRESH(); REP(13) { p0_static_weights(F); __syncthreads(); } REP(14) { p0_mod(F); __syncthreads(); } FRESH(); REP(16) { p0_hyena_filters(F); __syncthreads(); } }
    SEAM(0);
    if (IN(1)) { FRESH(); p0_init_rows(F); __syncthreads(); FRESH(); p1_router_weights(F); }
    SEAM(1);
#pragma unroll 1
    for (int l = 0; l < DEPTH; ++l) {
        const int pb = 2 + l * PH_PER_LAYER; const bool last = (l == DEPTH - 1); const int ntok = last ? NLAT : NROW;
        if (IN(pb + 0)) { FRESH();
            REP(0) { p_expert_weights(F, l, (last || F.G != 256) ? 0 : XW_TAIL_G, XW_ITEMS, F.G * NWAVES, F.wg * NWAVES + F.wave); __syncthreads(); }
            { pg8::ColMapOrder S; S.b.init(NROW, 11 * 256, F.G, F.wg); S.map = 0xCBA98763210ull; pg8::EpiBf16 E{(bf16_t*)(F.ws + WS_U), DIN};
              REP(1) pg8::gemm_phase<pg8::EpiBf16, pg8::ColMapOrder, false>(F.tid, F.lds, (const bf16_t*)(F.ws + WS_XM), (const bf16_t*)(F.ws + WS_WIN) + (size_t)l * DIN * DM, DM, nullptr, S, E); }
            __syncthreads(); FRESH();
            { pg8::ColMapOrder S; S.b.init(NROW, 2 * 256, F.G, (F.wg + 80) % F.G); S.map = 0x54ull; pg8::EpiVT E{(bf16_t*)(F.ws + WS_VT), UV};
              REP(1) pg8::gemm_phase<pg8::EpiVT, pg8::ColMapOrder, false, false, true, true, false, true>(F.tid, F.lds, (const bf16_t*)(F.ws + WS_XM), (const bf16_t*)(F.ws + WS_WIN) + (size_t)l * DIN * DM, DM, nullptr, S, E); }
        }
        SEAM(pb + 0);
        if (IN(pb + 1)) { FRESH(); REP(2) { ph_transposes(F, l); __syncthreads(); } FRESH(); REP(3) { ph_gla_local(F, l); __syncthreads(); } }
        SEAM(pb + 1);
        if (IN(pb + 2)) { FRESH(); REP(4) { ph_na(F, l, last); } FRESH(); REP(5) { ph_gla_scan(F); } __syncthreads(); FRESH(); REP(6) { ph_hyena(F, l, last); } }
        SEAM(pb + 2);
        if (IN(pb + 3)) { FRESH(); ph_hy_transpose(F, last); __syncthreads(); FRESH(); REP(7) { ph_gla_out(F, l, last); } }
        SEAM(pb + 3);
        if (IN(pb + 4)) { FRESH();
            pg8::DenseOrder S; S.init(ntok, DM, F.G, F.wg); pg8::EpiY8 E{(unsigned char*)(F.ws + WS_Y), DM};
            REP(8) pg8::gemm_phase<pg8::EpiY8, pg8::DenseOrder, false>(F.tid, F.lds, (const bf16_t*)(F.ws + WS_MIX), (const bf16_t*)(F.ws + WS_WOUT) + (size_t)l * DM * DM, DM, nullptr, S, E);
            if (!last && F.G == 256 && F.wg >= 64) { __syncthreads(); FRESH(); p_expert_weights(F, l, 0, XW_TAIL_E, 192 * NWAVES, (F.wg - 64) * NWAVES + F.wave); }
        }
        SEAM(pb + 4);
        if (IN(pb + 5)) { FRESH(); ph_ln1(F, l, ntok); }
        SEAM(pb + 5);
        if (IN(pb + 6)) { FRESH();
            pg8::RouterOrder S; S.b.init(ntok, 256, F.G, F.wg); pg8::EpiF32H E{(float*)(F.ws + WS_LOGIT), 256};
            REP(9) pg8::gemm_phase<pg8::EpiF32H, pg8::RouterOrder, false, false, true, true, true>(F.tid, F.lds, (const bf16_t*)(F.ws + WS_XR), (const bf16_t*)(F.ws + WS_WRB) + (size_t)l * 17 * 128 * DM, DM, nullptr, S, E);
            if (!last && F.G == 256 && F.wg >= 16) { __syncthreads(); FRESH(); p_expert_weights(F, l, XW_TAIL_E, XW_TAIL_G, 240 * NWAVES, (F.wg - 16) * NWAVES + F.wave); }
        }
        SEAM(pb + 6);
        if (IN(pb + 7)) { FRESH(); ph_route(F, l, ntok); }
        SEAM(pb + 7);
        if (IN(pb + 8)) { FRESH(); REP(12) { ph_positions(F, l, ntok); __syncthreads(); } }
        SEAM(pb + 8);
        if (IN(pb + 9)) { FRESH();
            const int ntl = (int)__hip_atomic_load(F.ctl + CW_NTL + l, __ATOMIC_RELAXED, __HIP_MEMORY_SCOPE_AGENT);
            pg8::GroupedOrder S; S.init(ntl, 2, F.G, F.wg); S.preload((const int*)(F.ws + WS_TILEEXP), F.lds + pg8::STAGE_BYTES + 4096, F.tid, NTHR); pg8::EpiSwiglu E{(unsigned char*)(F.ws + WS_ACT)};
            REP(10) pg8::gemm_phase<pg8::EpiSwiglu, pg8::GroupedOrder, true, true>(F.tid, F.lds, (const void*)(F.ws + WS_XM8), (const void*)(F.ws + WS_EXP1), DM, (const int*)(F.ws + WS_ROWTOK), S, E);
        }
        SEAM(pb + 9);
        if (IN(pb + 10)) { FRESH();
            const int ntl = (int)__hip_atomic_load(F.ctl + CW_NTL + l, __ATOMIC_RELAXED, __HIP_MEMORY_SCOPE_AGENT);
            pg8::GroupedOrder S; S.init(ntl, 4, F.G, F.wg); S.preload((const int*)(F.ws + WS_TILEEXP), F.lds + pg8::STAGE_BYTES + 4096, F.tid, NTHR); pg8::EpiScatter E{(unsigned char*)(F.ws + WS_Y2), (const int*)(F.ws + WS_ROWDST)};
            REP(11) pg8::gemm_phase<pg8::EpiScatter, pg8::GroupedOrder, false, true>(F.tid, F.lds, (const void*)(F.ws + WS_ACT), (const void*)(F.ws + WS_EXP2), EH, nullptr, S, E);
        }
        SEAM(pb + 10);
        if (IN(pb + 11)) { FRESH(); ph_ln2(F, l, ntok, last); }
        SEAM(pb + 11);
    }
#undef IN
#undef SEAM
#undef FRESH
}

extern "C" void kernel_launch(void* const* d_in, const int* in_sizes, int n_in, void* d_out, int out_size, void* d_ws, size_t ws_size, hipStream_t stream) {
    static int grid = 0;
    if (grid == 0) {
        if (n_in != 36 || out_size != NLAT * DM || ws_size < WS_END) { fprintf(stderr, "kernel_launch: unexpected shapes (n_in %d out %d ws %zu need %zu)\n", n_in, out_size, ws_size, (size_t)WS_END); grid = -1; return; }
        int dev = 0, cus = 0, per_cu = 0;
        if (hipGetDevice(&dev) != hipSuccess || hipDeviceGetAttribute(&cus, hipDeviceAttributeMultiprocessorCount, dev) != hipSuccess) { grid = -1; return; }
        if (hipFuncSetAttribute((const void*)mk_fwd, hipFuncAttributeMaxDynamicSharedMemorySize, LDS_BYTES) != hipSuccess) { fprintf(stderr, "kernel_launch: hipFuncSetAttribute failed\n"); grid = -1; return; }
        if (hipOccupancyMaxActiveBlocksPerMultiprocessor(&per_cu, (const void*)mk_fwd, NTHR, LDS_BYTES) != hipSuccess || per_cu < 1) { fprintf(stderr, "kernel_launch: occupancy query says %d\n", per_cu); }
        (void)hipGetLastError();
        grid = cus;
    }
    if (grid < 0) return;
    (void)hipMemsetAsync((char*)d_ws + WS_CTL, 0, CTL_BYTES, stream);
    Args a{};
    for (int i = 0; i < 36; ++i) a.in[i] = (const float*)d_in[i];
    a.out = (float*)d_out; a.ws = (unsigned char*)d_ws;
#if MK_MULTI
    for (int p = 0; p < NPHASE; ++p) { a.ph_lo = p; a.ph_hi = p + 1; hipLaunchKernelGGL(mk_fwd, dim3(grid), dim3(NTHR), LDS_BYTES, stream, a); }
#else
    a.ph_lo = 0; a.ph_hi = NPHASE; hipLaunchKernelGGL(mk_fwd, dim3(grid), dim3(NTHR), LDS_BYTES, stream, a);
#endif
}
```

```cpp
#include <hip/hip_runtime.h>
#include <cstdio>
#include <cstdint>

#define LAS __attribute__((address_space(3)))
#define GAS __attribute__((address_space(1)))
typedef unsigned short bf16_t;
typedef short bf16x8 __attribute__((ext_vector_type(8)));
typedef float f32x4 __attribute__((ext_vector_type(4)));
typedef float f32x2 __attribute__((ext_vector_type(2)));
typedef unsigned u32x4 __attribute__((ext_vector_type(4)));
typedef unsigned u32x2 __attribute__((ext_vector_type(2)));

constexpr int NB = 16, SEQ = 4096, CTXL = 256, DM = 1024, DEPTH = 4;
constexpr int NLAT = NB * SEQ;
constexpr int NCTX = NB * CTXL;
constexpr int NROW = NLAT + NCTX;
constexpr int SPB = SEQ + CTXL;
constexpr int DIN_REF = 3104;
constexpr int DIN = 3328;
constexpr int UQ = 0, UK = 512, UV = 1024, UGQ = 1536, UGK = 1664, UGV = 1792, UGR = 2048, UHY = 2304, ULAF = 3072, ULAB = 3200;
constexpr int NEXP = 128, TOPK = 8, EH = 256;
constexpr int NE1 = NEXP + 1;
constexpr int RMAX = 659712;
constexpr int TMAX = RMAX / 256;
constexpr float LN_EPS = 1e-6f;
constexpr float DN_ALPHA = 1.6817928305074290f;

__device__ __forceinline__ unsigned f2bf(float f) { unsigned u = __builtin_bit_cast(unsigned, f); return (u + 0x7fffu + ((u >> 16) & 1u)) >> 16; }
typedef __bf16 bf16v2 __attribute__((ext_vector_type(2)));
__device__ __forceinline__ unsigned pk2(float lo, float hi) { const f32x2 v = {lo, hi}; const bf16v2 b = __builtin_convertvector(v, bf16v2); return __builtin_bit_cast(unsigned, b); }
__device__ __forceinline__ float bf2f(unsigned short b) { return __builtin_bit_cast(float, ((unsigned)b) << 16); }
__device__ __forceinline__ float bflo(unsigned w) { return __builtin_bit_cast(float, w << 16); }
__device__ __forceinline__ float bfhi(unsigned w) { return __builtin_bit_cast(float, w & 0xffff0000u); }
__device__ __forceinline__ float shx(float v, int o, int lane) { return __builtin_bit_cast(float, __builtin_amdgcn_ds_bpermute((lane ^ o) << 2, __builtin_bit_cast(int, v))); }
__device__ __forceinline__ int shxi(int v, int o, int lane) { return __builtin_amdgcn_ds_bpermute((lane ^ o) << 2, v); }
__device__ __forceinline__ float shf(float v, int src) { return __builtin_bit_cast(float, __builtin_amdgcn_ds_bpermute(src << 2, __builtin_bit_cast(int, v))); }
__device__ __forceinline__ float wave_sum(float v, int lane) {
#pragma unroll
    for (int o = 1; o < 64; o <<= 1) v += shx(v, o, lane);
    return v;
}
__device__ __forceinline__ void unpack8(const u32x4 q, float* o) { o[0] = bflo(q.x); o[1] = bfhi(q.x); o[2] = bflo(q.y); o[3] = bfhi(q.y); o[4] = bflo(q.z); o[5] = bfhi(q.z); o[6] = bflo(q.w); o[7] = bfhi(q.w); }
__device__ __forceinline__ float silu_f(float x) { return x * __builtin_amdgcn_rcpf(1.0f + __expf(-x)); }
#define LDS_WAIT() asm volatile("s_waitcnt lgkmcnt(0)" ::: "memory")
#define VM_WAIT() asm volatile("s_waitcnt vmcnt(0)" ::: "memory")

#define XB_TMO      128
#define XB_XCNT(j)  (256  + 64 * (j))
#define XB_XSUB(j)  (1280 + 64 * (j))
#define XB_XGEN(j)  (2304 + 64 * (j))
#define XB_TOP      3328
#define XB_TOPGEN   3392
#define XCD_BAR_WORDS 3456
#define XB_SPIN_CAP (1u << 18)

__device__ __forceinline__ unsigned xb_ld(unsigned* p)              { return __hip_atomic_load(p, __ATOMIC_RELAXED, __HIP_MEMORY_SCOPE_AGENT); }
__device__ __forceinline__ unsigned xb_add(unsigned* p, unsigned v) { return __hip_atomic_fetch_add(p, v, __ATOMIC_RELAXED, __HIP_MEMORY_SCOPE_AGENT); }
__device__ __forceinline__ unsigned xb_xcc_id() { return (unsigned)__builtin_amdgcn_s_getreg((3 << 11) | 20) & 0xFu; }
#define XB_SPIN(cond, bar) do { unsigned _sp = 0; while (cond) { __builtin_amdgcn_s_sleep(1); \
    if ((++_sp & 255u) == 0u) { if (xb_ld(&(bar)[XB_TMO])) break; if (_sp > XB_SPIN_CAP) { atomicAdd(&(bar)[XB_TMO], 1u); break; } } } } while (0)

struct XcdBarrier { unsigned* bar; unsigned x; volatile LAS unsigned* st; };

__device__ __forceinline__ XcdBarrier xcd_barrier_post(unsigned* bar, volatile LAS unsigned* st) {
    XcdBarrier b; b.bar = bar; b.x = xb_xcc_id(); b.st = st;
    if (threadIdx.x == 0) (void)xb_add(&bar[XB_XCNT(b.x)], 1u);
    return b;
}
__device__ __forceinline__ void xcd_barrier_complete(unsigned* bar, unsigned x, unsigned& nloc, unsigned& nx) {
    const unsigned G = gridDim.x * gridDim.y * gridDim.z;
    unsigned sum, cnt, mine, sp = 0u;
    for (;;) {
        sum = 0u; cnt = 0u; mine = 0u;
#pragma unroll
        for (unsigned j = 0; j < 16; ++j) { const unsigned c = xb_ld(&bar[XB_XCNT(j)]); sum += c; cnt += (c > 0u) ? 1u : 0u; mine = (j == x) ? c : mine; }
        if (sum == G) break;
        __builtin_amdgcn_s_sleep(1);
        if ((++sp & 255u) == 0u) { if (xb_ld(&bar[XB_TMO])) break; if (sp > XB_SPIN_CAP) { atomicAdd(&bar[XB_TMO], 1u); break; } }
    }
    nloc = mine > 0u ? mine : 1u; nx = cnt > 0u ? cnt : 1u;
}
__device__ __forceinline__ void xcd_barrier(const XcdBarrier& b) {
    asm volatile("s_waitcnt vmcnt(0)" ::: "memory");
    __syncthreads();
    if (threadIdx.x == 0) {
        unsigned* bar = b.bar;
        __builtin_amdgcn_s_waitcnt(0);
        unsigned nloc = b.st[0], nx = b.st[1];
        if (nloc == 0u) { xcd_barrier_complete(bar, b.x, nloc, nx); b.st[0] = nloc; b.st[1] = nx; }
        const unsigned old = xb_add(&bar[XB_XSUB(b.x)], 1u);
        const unsigned gen = old / nloc;
        if (old + 1u == (gen + 1u) * nloc) {
            __builtin_amdgcn_fence(__ATOMIC_RELEASE, "agent");
            asm volatile("s_waitcnt vmcnt(0)" ::: "memory");
            const unsigned og = xb_add(&bar[XB_TOP], 1u);
            const unsigned tg = og / nx;
            if (og + 1u == (tg + 1u) * nx) xb_add(&bar[XB_TOPGEN], 1u);
            else XB_SPIN(xb_ld(&bar[XB_TOPGEN]) == tg, bar);
            __builtin_amdgcn_fence(__ATOMIC_ACQUIRE, "agent");
            xb_add(&bar[XB_XGEN(b.x)], 1u);
            asm volatile("s_waitcnt vmcnt(0)" ::: "memory");
        } else {
            XB_SPIN(xb_ld(&bar[XB_XGEN(b.x)]) == gen, bar);
            __builtin_amdgcn_fence(__ATOMIC_ACQUIRE, "agent");
            asm volatile("s_waitcnt vmcnt(0)" ::: "memory");
        }
    }
    __syncthreads();
}

namespace pg8 {
constexpr int BM = 256, BK = 64, HALF = 128, HTB = HALF * BK * 2, STAGE_BYTES = 8 * HTB, NXCD = 8, WGM = 8;
__host__ __device__ __forceinline__ int lds_byte(int r, int c) { const int st = (r >> 4) * 2 + (c >> 5), rr = r & 15, cc = c & 31, ob = rr * 64 + cc * 2; return st * 1024 + (ob ^ (((ob >> 9) & 1) << 5)); }
__host__ __device__ __forceinline__ void stage_rc(int b, int& R, int& C) { const int st = b / 1024, sb = b % 1024, swz = sb ^ (((sb >> 9) & 1) << 5); R = (st >> 1) * 16 + swz / 64; C = (st & 1) * 32 + (swz % 64) / 2; }
__host__ __device__ __forceinline__ int perm32(int rho) { const int n = rho >> 4, i = rho & 15; return 8 * (i >> 2) + 4 * n + (i & 3); }

struct Unit { int arow0, brow0, orow0, ocol0, aux; };

struct DenseOrder {
    int nM, nN, nwg, G, c;
    __device__ void init(int M, int N, int G_, int c_) { nM = M / BM; nN = N / BM; nwg = nM * nN; G = G_; c = c_; }
    __device__ __forceinline__ bool next(int i, Unit& u) const {
        const long L = (long)i * G + c; if (L >= nwg) return false;
        int wgid = (int)L; { const int q = nwg / NXCD, r = nwg % NXCD, xcd = wgid % NXCD, off = wgid / NXCD; wgid = (xcd < r ? xcd * (q + 1) : r * (q + 1) + (xcd - r) * q) + off; }
        const int nig = WGM * nN, gid = wgid / nig, fm = gid * WGM, gsz = (nM - fm) < WGM ? (nM - fm) : WGM;
        const int pm = fm + ((wgid % nig) % gsz), pn = (wgid % nig) / gsz;
        u.arow0 = pm * BM; u.brow0 = pn * BM; u.orow0 = pm * BM; u.ocol0 = pn * BM; u.aux = 0; return true;
    }
};
struct GroupedOrder {
    const LAS unsigned char* tab; int nN, nslot, slot, t0, t1;
    __device__ __forceinline__ void init(int ntiles, int nN_, int G, int c) {
        nN = nN_;
        if ((G & 7) == 0) { const int per = (ntiles + 7) >> 3, x = c & 7; nslot = G >> 3; slot = c >> 3; t0 = x * per; t1 = (t0 + per) < ntiles ? (t0 + per) : ntiles; }
        else { nslot = G; slot = c; t0 = 0; t1 = ntiles; }
    }
    __device__ __forceinline__ void preload(const int* tile_exp, LAS unsigned char* lds_tab, int tid, int nthr) {
        __syncthreads();
        for (int i = tid; i < t1 - t0; i += nthr) lds_tab[i] = (unsigned char)tile_exp[t0 + i];
        __syncthreads();
        tab = lds_tab;
    }
    __device__ __forceinline__ bool next(int i, Unit& u) const {
        const int q = i * nslot + slot, t = t0 + q / nN, pn = q % nN;
        if (t >= t1) return false;
        const int e = (int)tab[t - t0];
        u.arow0 = t * BM; u.brow0 = (e * nN + pn) * BM; u.orow0 = t * BM; u.ocol0 = pn * BM; u.aux = e; return true;
    }
};

struct RouterOrder {
    DenseOrder b;
    __device__ __forceinline__ bool next(int i, Unit& u) const { if (!b.next(i, u)) return false; const int pm = u.arow0 >> 8; u.brow0 = (pm < 256 ? (pm >> 4) : 16) * 128; return true; }
};
struct ColMapOrder {
    DenseOrder b; unsigned long long map;
    __device__ __forceinline__ bool next(int i, Unit& u) const { if (!b.next(i, u)) return false; const int ph = (int)((map >> ((u.ocol0 >> 8) * 4)) & 15ull); u.brow0 = ph * BM; u.ocol0 = ph * BM; return true; }
};
template <class Base> struct RangeOrder {
    Base b; int i0, i1;
    __device__ __forceinline__ bool next(int i, Unit& u) const { const int j = i + i0; if (j >= i1) return false; return b.next(j, u); }
};

__device__ __forceinline__ unsigned cvt_pk_bf16(float lo, float hi) { return pk2(lo, hi); }

struct NoPre {};
struct EpiF32 {
    static constexpr bool PERM = false; static constexpr int SCW = 0x7A7A7A7A; typedef NoPre Pre;
    __device__ __forceinline__ Pre prefetch(const Unit&, LAS unsigned char*, int, int, int) const { return Pre{}; }
    float* C; int ldc;
    __device__ __forceinline__ void operator()(const f32x4 (&acc)[2][2][4][2], const Unit& u, int wr, int wc, int fr, int fq, const Pre&, bool drain) const {
        if (drain) asm volatile("s_waitcnt vmcnt(0)" ::: "memory");
        const int row0 = u.orow0 + wr * 64 + fr, col0 = u.ocol0 + wc * 32 + 4 * fq;
#pragma unroll
        for (int ai = 0; ai < 2; ++ai)
#pragma unroll
            for (int m = 0; m < 4; ++m) { float* rowp = C + (size_t)(row0 + ai * HALF + m * 16) * ldc + col0;
#pragma unroll
                for (int bj = 0; bj < 2; ++bj)
#pragma unroll
                    for (int n = 0; n < 2; ++n) *(GAS f32x4*)(rowp + bj * HALF + n * 16) = acc[ai][bj][m][n]; }
    }
};
struct EpiF32H {
    static constexpr bool PERM = false; static constexpr int SCW = 0x7A7A7A7A; typedef NoPre Pre;
    __device__ __forceinline__ Pre prefetch(const Unit&, LAS unsigned char*, int, int, int) const { return Pre{}; }
    float* C; int ldc;
    __device__ __forceinline__ void operator()(const f32x4 (&acc)[2][2][4][2], const Unit& u, int wr, int wc, int fr, int fq, const Pre&, bool drain) const {
        if (drain) asm volatile("s_waitcnt vmcnt(0)" ::: "memory");
        const int row0 = u.orow0 + wr * 64 + fr, col0 = wc * 32 + 4 * fq;
#pragma unroll
        for (int ai = 0; ai < 2; ++ai)
#pragma unroll
            for (int m = 0; m < 4; ++m) { float* rowp = C + (size_t)(row0 + ai * HALF + m * 16) * ldc + col0;
#pragma unroll
                for (int n = 0; n < 2; ++n) *(GAS f32x4*)(rowp + n * 16) = acc[ai][0][m][n]; }
    }
};
struct EpiBf16 {
    static constexpr bool PERM = true; static constexpr int SCW = 0x7A7A7A7A; typedef NoPre Pre;
    __device__ __forceinline__ Pre prefetch(const Unit&, LAS unsigned char*, int, int, int) const { return Pre{}; }
    bf16_t* O; int ldc;
    __device__ __forceinline__ void operator()(const f32x4 (&acc)[2][2][4][2], const Unit& u, int wr, int wc, int fr, int fq, const Pre&, bool drain) const {
        const int row0 = u.orow0 + wr * 64 + fr, col0 = u.ocol0 + wc * 32 + 8 * fq;
        u32x4 w[2][4][2];
#pragma unroll
        for (int ai = 0; ai < 2; ++ai)
#pragma unroll
            for (int m = 0; m < 4; ++m)
#pragma unroll
                for (int bj = 0; bj < 2; ++bj) { const f32x4 v0 = acc[ai][bj][m][0], v1 = acc[ai][bj][m][1];
                    w[ai][m][bj].x = cvt_pk_bf16(v0[0], v0[1]); w[ai][m][bj].y = cvt_pk_bf16(v0[2], v0[3]); w[ai][m][bj].z = cvt_pk_bf16(v1[0], v1[1]); w[ai][m][bj].w = cvt_pk_bf16(v1[2], v1[3]); }
        if (drain) asm volatile("s_waitcnt vmcnt(0)" ::: "memory");
#pragma unroll
        for (int ai = 0; ai < 2; ++ai)
#pragma unroll
            for (int m = 0; m < 4; ++m) { bf16_t* rowp = O + (size_t)(row0 + ai * HALF + m * 16) * ldc + col0;
#pragma unroll
                for (int bj = 0; bj < 2; ++bj) *(GAS u32x4*)(rowp + bj * HALF) = w[ai][m][bj]; }
    }
};
struct EpiVT {
    static constexpr bool PERM = false; static constexpr int SCW = 0x7A7A7A7A; typedef NoPre Pre;
    __device__ __forceinline__ Pre prefetch(const Unit&, LAS unsigned char*, int, int, int) const { return Pre{}; }
    bf16_t* VT; int col_base;
    __device__ __forceinline__ void operator()(const f32x4 (&acc)[2][2][4][2], const Unit& u, int wr, int wc, int fr, int fq, const Pre&, bool drain) const {
        if (drain) asm volatile("s_waitcnt vmcnt(0)" ::: "memory");
        const int r0 = u.orow0; int b, pos0;
        if (r0 < NLAT) { b = r0 >> 12; pos0 = r0 & 4095; } else { b = (r0 - NLAT) >> 8; pos0 = SEQ + ((r0 - NLAT) & 255); }
        bf16_t* base = VT + ((size_t)b * 512 + (u.ocol0 - col_base) + wc * 32 + fr) * SPB + pos0 + wr * 64 + 4 * fq;
#pragma unroll
        for (int ai = 0; ai < 2; ++ai)
#pragma unroll
            for (int bj = 0; bj < 2; ++bj)
#pragma unroll
                for (int m = 0; m < 4; ++m)
#pragma unroll
                    for (int n = 0; n < 2; ++n) { const f32x4 v = acc[ai][bj][m][n];
                        *(GAS u32x2*)(base + (size_t)(bj * HALF + n * 16) * SPB + ai * HALF + m * 16) = (u32x2){cvt_pk_bf16(v[0], v[1]), cvt_pk_bf16(v[2], v[3])}; }
    }
};
struct EpiY8 {
    static constexpr bool PERM = true; static constexpr int SCW = 0x7A7A7A7A; typedef NoPre Pre;
    __device__ __forceinline__ Pre prefetch(const Unit&, LAS unsigned char*, int, int, int) const { return Pre{}; }
    unsigned char* O; int ldc;
    __device__ __forceinline__ void operator()(const f32x4 (&acc)[2][2][4][2], const Unit& u, int wr, int wc, int fr, int fq, const Pre&, bool drain) const {
        const int row0 = u.orow0 + wr * 64 + fr;
        u32x4 o[2][4];
#pragma unroll
        for (int ai = 0; ai < 2; ++ai)
#pragma unroll
            for (int m = 0; m < 4; ++m) { int w[4];
#pragma unroll
                for (int bj = 0; bj < 2; ++bj) { const f32x4 v0 = acc[ai][bj][m][0], v1 = acc[ai][bj][m][1];
                    int w0 = 0, w1 = 0;
                    w0 = __builtin_amdgcn_cvt_pk_fp8_f32(v0[0], v0[1], w0, false); w0 = __builtin_amdgcn_cvt_pk_fp8_f32(v0[2], v0[3], w0, true);
                    w1 = __builtin_amdgcn_cvt_pk_fp8_f32(v1[0], v1[1], w1, false); w1 = __builtin_amdgcn_cvt_pk_fp8_f32(v1[2], v1[3], w1, true);
                    w[2 * bj] = w0; w[2 * bj + 1] = w1; }
                o[ai][m] = (u32x4){(unsigned)w[0], (unsigned)w[1], (unsigned)w[2], (unsigned)w[3]}; }
        if (drain) asm volatile("s_waitcnt vmcnt(0)" ::: "memory");
#pragma unroll
        for (int ai = 0; ai < 2; ++ai)
#pragma unroll
            for (int m = 0; m < 4; ++m) *(GAS u32x4*)(O + (size_t)(row0 + ai * HALF + m * 16) * ldc + u.ocol0 + wc * 64 + fq * 16) = o[ai][m];
    }
};
struct EpiSwiglu {
    static constexpr bool PERM = true; static constexpr int SCW = 0x7A7A7A7A; typedef NoPre Pre;
    __device__ __forceinline__ Pre prefetch(const Unit&, LAS unsigned char*, int, int, int) const { return Pre{}; }
    unsigned char* ACT;
    __device__ __forceinline__ void operator()(const f32x4 (&acc)[2][2][4][2], const Unit& u, int wr, int wc, int fr, int fq, const Pre&, bool drain) const {
        const int row0 = u.orow0 + wr * 64 + fr, pn = u.ocol0 >> 8;
        u32x2 o[2][4];
#pragma unroll
        for (int ai = 0; ai < 2; ++ai)
#pragma unroll
            for (int m = 0; m < 4; ++m) {
                int w[2];
#pragma unroll
                for (int n = 0; n < 2; ++n) { const f32x4 g = acc[ai][0][m][n], up = acc[ai][1][m][n];
                    f32x4 e;
#pragma unroll
                    for (int i = 0; i < 4; ++i) e[i] = __builtin_amdgcn_exp2f(-g[i]);
                    const f32x4 d = e + 1.0f; f32x4 r;
#pragma unroll
                    for (int i = 0; i < 4; ++i) r[i] = __builtin_amdgcn_rcpf(d[i]);
                    const f32x4 h = (g * up) * r;
                    int v = 0; v = __builtin_amdgcn_cvt_pk_fp8_f32(h[0], h[1], v, false); v = __builtin_amdgcn_cvt_pk_fp8_f32(h[2], h[3], v, true); w[n] = v; }
                o[ai][m] = (u32x2){(unsigned)w[0], (unsigned)w[1]}; }
        if (drain) asm volatile("s_waitcnt vmcnt(0)" ::: "memory");
#pragma unroll
        for (int ai = 0; ai < 2; ++ai)
#pragma unroll
            for (int m = 0; m < 4; ++m) *(GAS u32x2*)(ACT + (size_t)(row0 + ai * HALF + m * 16) * EH + pn * 128 + wc * 32 + 8 * fq) = o[ai][m];
    }
};
constexpr float Y2_SCALE = 8.0f, Y2_INV = 1.0f / 8.0f;
struct EpiScatter {
    static constexpr bool PERM = true; static constexpr int SCW = 0x7D7D7D7D;
    struct Pre { const LAS int* tab; };
    unsigned char* Y2; const int* rowdst;
    __device__ __forceinline__ Pre prefetch(const Unit& u, LAS unsigned char* lds, int wid, int lane, int ui) const {
        LAS unsigned char* tab = lds + STAGE_BYTES + (ui & 1) * 1024;
        if (wid < 4) __builtin_amdgcn_global_load_lds((const unsigned*)(rowdst + u.orow0 + wid * 64 + lane), (LAS unsigned*)(tab + wid * 256), 4, 0, 0);
        Pre p; p.tab = (const LAS int*)tab; return p; }
    __device__ __forceinline__ void operator()(const f32x4 (&acc)[2][2][4][2], const Unit& u, int wr, int wc, int fr, int fq, const Pre& pre, bool drain) const {
        if (u.aux == 128) {
            u32x4 o[2][4];
#pragma unroll
            for (int ai = 0; ai < 2; ++ai)
#pragma unroll
                for (int m = 0; m < 4; ++m) { int w[4];
#pragma unroll
                    for (int bj = 0; bj < 2; ++bj) { const f32x4 v0 = acc[ai][bj][m][0], v1 = acc[ai][bj][m][1];
                        int w0 = 0, w1 = 0;
                        w0 = __builtin_amdgcn_cvt_pk_fp8_f32(v0[0], v0[1], w0, false); w0 = __builtin_amdgcn_cvt_pk_fp8_f32(v0[2], v0[3], w0, true);
                        w1 = __builtin_amdgcn_cvt_pk_fp8_f32(v1[0], v1[1], w1, false); w1 = __builtin_amdgcn_cvt_pk_fp8_f32(v1[2], v1[3], w1, true);
                        w[2 * bj] = w0; w[2 * bj + 1] = w1; }
                    o[ai][m] = (u32x4){(unsigned)w[0], (unsigned)w[1], (unsigned)w[2], (unsigned)w[3]}; }
            if (drain) asm volatile("s_waitcnt vmcnt(0)" ::: "memory");
#pragma unroll
            for (int ai = 0; ai < 2; ++ai)
#pragma unroll
                for (int m = 0; m < 4; ++m) { const int dst = pre.tab[wr * 64 + fr + ai * HALF + m * 16];
                    if (dst >= 0) *(GAS u32x4*)(Y2 + (size_t)dst * 512 + u.ocol0 + wc * 64 + fq * 16) = o[ai][m]; }
        } else {
            u32x2 o[2][4];
#pragma unroll
            for (int ai = 0; ai < 2; ++ai)
#pragma unroll
                for (int m = 0; m < 4; ++m) { unsigned w[2];
#pragma unroll
                    for (int bj = 0; bj < 2; ++bj) { const f32x4 v0 = acc[ai][bj][m][0], v1 = acc[ai][bj][m][1];
                        unsigned x = 0u;
                        x = __builtin_amdgcn_cvt_scalef32_pk_fp4_f32(x, v0[0], v0[1], 1.0f, 0); x = __builtin_amdgcn_cvt_scalef32_pk_fp4_f32(x, v0[2], v0[3], 1.0f, 1);
                        x = __builtin_amdgcn_cvt_scalef32_pk_fp4_f32(x, v1[0], v1[1], 1.0f, 2); x = __builtin_amdgcn_cvt_scalef32_pk_fp4_f32(x, v1[2], v1[3], 1.0f, 3);
                        w[bj] = x; }
                    o[ai][m] = (u32x2){w[0], w[1]}; }
            if (drain) asm volatile("s_waitcnt vmcnt(0)" ::: "memory");
#pragma unroll
            for (int ai = 0; ai < 2; ++ai)
#pragma unroll
                for (int m = 0; m < 4; ++m) { const int dst = pre.tab[wr * 64 + fr + ai * HALF + m * 16];
                    if (dst >= 0) *(GAS u32x2*)(Y2 + (size_t)dst * 512 + (u.ocol0 >> 1) + wc * 32 + fq * 8) = o[ai][m]; }
        }
    }
};

typedef int v8i __attribute__((ext_vector_type(8)));
typedef int v4i __attribute__((ext_vector_type(4)));
struct Frag { bf16x8 p[2]; __device__ __forceinline__ bf16x8& operator[](int k) { return p[k]; } __device__ __forceinline__ const bf16x8& operator[](int k) const { return p[k]; } };
template <class Epi, class Sched, bool GATHER, bool F8 = false, bool ALIGN_EPI = true, bool SP2 = true, bool NHALF = false, bool SWAP = false>
__device__ __forceinline__ void gemm_phase(const int tid_in, LAS unsigned char* lds, const void* Ag, const void* Bg, const int K, const int* rowidx, const Sched& S, const Epi& E) {
    int tid_ = tid_in; asm volatile("" : "+v"(tid_));
    const int tid = tid_, wid = __builtin_amdgcn_readfirstlane(tid >> 6), lane = tid & 63, wr = wid >> 2, wc = wid & 3, fr = lane & 15, fq = lane >> 4;
    const int KB = F8 ? K : 2 * K;
    const int nt = KB / 128;
    unsigned voffB[2];
#pragma unroll
    for (int i = 0; i < 2; ++i) { int R, C; stage_rc(tid * 16 + i * 8192, R, C); const int Rb = Epi::PERM ? ((R & ~31) + perm32(R & 31)) : R;
        voffB[i] = (unsigned)(Rb * KB + C * 2); }
    const size_t kstep = (size_t)128;
    const size_t hstep = (size_t)HALF * KB;
    const unsigned ldsw = (unsigned)wid * 1024u;
    const int aoff = F8 ? lds_byte(wr * 64 + fr, 16 * fq) : lds_byte(wr * 64 + fr, fq * 8), boff = F8 ? lds_byte(wc * 32 + fr, 16 * fq) : lds_byte(wc * 32 + fr, fq * 8);
    constexpr int PIECE1 = F8 ? 16 : 1024;
    const int sc_w = Epi::SCW, sc_a = 0x7F7F7F7F;
#define PG8_SA(b, h) (((b) * 2 + (h)) * HTB)
#define PG8_SB(b, h) ((4 + (b) * 2 + (h)) * HTB)
#define PG8_STAGE_B(bufoff, gbase) do { _Pragma("unroll") for (int _i = 0; _i < 2; ++_i) \
        __builtin_amdgcn_global_load_lds((const unsigned*)((const char*)(gbase) + voffB[_i]), (LAS unsigned*)(lds + (bufoff) + ldsw + _i * 8192), 16, 0, 0); } while (0)
#define PG8_STAGE_A(bufoff, gbase, h) do { const char* _gb = (const char*)(gbase) + (GATHER ? (size_t)0 : (size_t)(h) * hstep); \
        __builtin_amdgcn_global_load_lds((const unsigned*)(_gb + ac[GATHER ? (h) : 0][0]), (LAS unsigned*)(lds + (bufoff) + ldsw), 16, 0, 0); \
        __builtin_amdgcn_global_load_lds((const unsigned*)(_gb + ac[GATHER ? (h) : 0][1]), (LAS unsigned*)(lds + (bufoff) + ldsw + 8192), 16, 0, 0); } while (0)
#define PG8_LDA(dst, b, h) do { _Pragma("unroll") for (int m = 0; m < 4; ++m) { if constexpr (F8) { const v4i _l = *(const LAS v4i*)(lds + PG8_SA(b, h) + aoff + m * 2048), _h = *(const LAS v4i*)(lds + PG8_SA(b, h) + aoff + m * 2048 + PIECE1); dst##8[m] = __builtin_shufflevector(_l, _h, 0, 1, 2, 3, 4, 5, 6, 7); } \
        else { dst[m][0] = *(const LAS bf16x8*)(lds + PG8_SA(b, h) + aoff + m * 2048); dst[m][1] = *(const LAS bf16x8*)(lds + PG8_SA(b, h) + aoff + m * 2048 + PIECE1); } } } while (0)
#define PG8_LDB(dst, b, h) do { _Pragma("unroll") for (int n = 0; n < 2; ++n) { if constexpr (F8) { const v4i _l = *(const LAS v4i*)(lds + PG8_SB(b, h) + boff + n * 2048), _h = *(const LAS v4i*)(lds + PG8_SB(b, h) + boff + n * 2048 + PIECE1); dst##8[n] = __builtin_shufflevector(_l, _h, 0, 1, 2, 3, 4, 5, 6, 7); } \
        else { dst[n][0] = *(const LAS bf16x8*)(lds + PG8_SB(b, h) + boff + n * 2048); dst[n][1] = *(const LAS bf16x8*)(lds + PG8_SB(b, h) + boff + n * 2048 + PIECE1); } } } while (0)
#define PG8_MMA(ai, bj, At, Bt) do { __builtin_amdgcn_s_setprio(1); _Pragma("unroll") for (int m = 0; m < 4; ++m) _Pragma("unroll") for (int n = 0; n < 2; ++n) { \
        if constexpr (F8) asm volatile("v_mfma_scale_f32_16x16x128_f8f6f4 %0, %1, %2, %0, %3, %4 op_sel_hi:[0,0,0]" : "+v"(acc[ai][bj][m][n]) : "v"(Bt##8[n]), "v"(At##8[m]), "v"(sc_w), "v"(sc_a)); \
        else { _Pragma("unroll") for (int k = 0; k < 2; ++k) acc[ai][bj][m][n] = SWAP ? __builtin_amdgcn_mfma_f32_16x16x32_bf16(At[m][k], Bt[n][k], acc[ai][bj][m][n], 0, 0, 0) : __builtin_amdgcn_mfma_f32_16x16x32_bf16(Bt[n][k], At[m][k], acc[ai][bj][m][n], 0, 0, 0); } } \
        __builtin_amdgcn_s_setprio(0); } while (0)
#define PG8_WAIT_V(n) asm volatile("s_waitcnt vmcnt(" #n ")" ::: "memory")
#define PG8_WAIT_LOOP do { if constexpr (NHALF) PG8_WAIT_V(6); else PG8_WAIT_V(8); } while (0)
#define PG8_WAIT_L(n) asm volatile("s_waitcnt lgkmcnt(" #n ")" ::: "memory")
#define PG8_BAR __builtin_amdgcn_s_barrier()
#define PG8_SCHED __builtin_amdgcn_sched_barrier(0)
#define PG8_TAB(par) (lds + STAGE_BYTES + 2048 + (par) * 1024)
#define PG8_TABLOAD(par, row0) do { if (wid < 4) __builtin_amdgcn_global_load_lds((const unsigned*)(rowidx + (row0) + wid * 64 + lane), (LAS unsigned*)(PG8_TAB(par) + wid * 256), 4, 0, 0); } while (0)
#define PG8_AOFF_H(h, par) do { int _tz = tid; asm volatile("" : "+v"(_tz)); _Pragma("unroll") for (int _i = 0; _i < 2; ++_i) { int _R, _C; stage_rc(_tz * 16 + _i * 8192, _R, _C); \
        if (GATHER) ac[h][_i] = ((const LAS unsigned*)PG8_TAB(par))[(h) * HALF + _R] * (unsigned)KB + (unsigned)_C * 2u; \
        else ac[h][_i] = (unsigned)(((h) * HALF + _R) * KB) + (unsigned)_C * 2u; } } while (0)
    static_assert(SP2, "only the two-super-phase K-loop is kept");
    Unit cur, nxt; int ui = 0;
    if (!S.next(0, cur)) return;
    f32x4 acc[2][2][4][2];
#pragma unroll
    for (int a = 0; a < 2; ++a)
#pragma unroll
        for (int b = 0; b < 2; ++b)
#pragma unroll
            for (int m = 0; m < 4; ++m)
#pragma unroll
                for (int n = 0; n < 2; ++n) acc[a][b][m][n] = (f32x4){0.f, 0.f, 0.f, 0.f};
    bf16x8 At[F8 ? 1 : 4][2], B0[F8 ? 1 : 2][2], B1[F8 ? 1 : 2][2];
    v8i At8[F8 ? 4 : 1], B08[F8 ? 2 : 1], B18[F8 ? 2 : 1];
    unsigned ac[GATHER ? 2 : 1][2];
    if (GATHER) { PG8_TABLOAD(0, cur.arow0); PG8_WAIT_V(0); PG8_BAR; }
    PG8_AOFF_H(0, 0); if (GATHER) { PG8_AOFF_H((GATHER ? 1 : 0), 0); }
    const char* cA = (const char*)Ag + (GATHER ? (size_t)0 : (size_t)cur.arow0 * KB); const char* cB = (const char*)Bg + (size_t)cur.brow0 * KB;
    PG8_STAGE_B(PG8_SB(0, 0), cB); if constexpr (!NHALF) PG8_STAGE_B(PG8_SB(0, 1), cB + hstep); PG8_STAGE_A(PG8_SA(0, 0), cA, 0); PG8_STAGE_A(PG8_SA(0, 1), cA, 1);
    if (wr == 1) PG8_BAR;
    PG8_WAIT_V(2); PG8_BAR;
    PG8_STAGE_B(PG8_SB(1, 0), cB + kstep); PG8_STAGE_A(PG8_SA(1, 0), cA + kstep, 0); if constexpr (!NHALF) PG8_STAGE_B(PG8_SB(1, 1), cB + hstep + kstep);
    if constexpr (NHALF) PG8_WAIT_V(4); else PG8_WAIT_V(6);
    PG8_BAR;
    for (;;) {
        const typename Epi::Pre pre = E.prefetch(cur, lds, wid, lane, ui);
        const bool has_next = S.next(ui + 1, nxt);
        if (GATHER) { if (has_next) PG8_TABLOAD((ui + 1) & 1, nxt.arow0); }
        const char* nA = has_next ? ((const char*)Ag + (GATHER ? (size_t)0 : (size_t)nxt.arow0 * KB)) : cA; const char* nB = has_next ? (const char*)Bg + (size_t)nxt.brow0 * KB : cB;
_Pragma("nounroll")
        for (int t = 0; t < nt; t += 2) {
            const bool last = (t == nt - 2);
            const bool skipw = (t == 0) && (ui > 0);
            const char* a1 = cA + (size_t)(t + 1) * kstep;
            const char* a2 = last ? nA : cA + (size_t)(t + 2) * kstep; const char* b2 = last ? nB : cB + (size_t)(t + 2) * kstep;
            const char* a3 = a2 + kstep; const char* b3 = b2 + kstep;
            if (GATHER) { if (last && has_next) { PG8_AOFF_H(0, (ui + 1) & 1); } }
            PG8_LDB(B0, 0, 0); if constexpr (!NHALF) PG8_LDB(B1, 0, 1); PG8_SCHED; PG8_LDA(At, 0, 0); PG8_STAGE_A(PG8_SA(1, 1), a1, 1);
            if (!skipw) PG8_WAIT_LOOP; PG8_WAIT_L(0); PG8_BAR; PG8_MMA(0, 0, At, B0); if constexpr (!NHALF) PG8_MMA(0, 1, At, B1); PG8_BAR; PG8_SCHED;
            if (GATHER) { if (last && has_next) { PG8_AOFF_H(1, (ui + 1) & 1); } }
            PG8_LDA(At, 0, 1); PG8_STAGE_B(PG8_SB(0, 0), b2); if constexpr (!NHALF) PG8_STAGE_B(PG8_SB(0, 1), b2 + hstep); PG8_STAGE_A(PG8_SA(0, 0), a2, 0);
            if (!skipw) PG8_WAIT_LOOP; PG8_WAIT_L(0); PG8_BAR; PG8_MMA(1, 0, At, B0); if constexpr (!NHALF) PG8_MMA(1, 1, At, B1); PG8_BAR; PG8_SCHED;
            PG8_LDB(B0, 1, 0); if constexpr (!NHALF) PG8_LDB(B1, 1, 1); PG8_SCHED; PG8_LDA(At, 1, 0); PG8_STAGE_A(PG8_SA(0, 1), a2, 1);
            if (!skipw) PG8_WAIT_LOOP; PG8_WAIT_L(0); PG8_BAR; PG8_MMA(0, 0, At, B0); if constexpr (!NHALF) PG8_MMA(0, 1, At, B1); PG8_BAR; PG8_SCHED;
            PG8_LDA(At, 1, 1); PG8_STAGE_B(PG8_SB(1, 0), b3); if constexpr (!NHALF) PG8_STAGE_B(PG8_SB(1, 1), b3 + hstep); PG8_STAGE_A(PG8_SA(1, 0), a3, 0);
            PG8_WAIT_LOOP; PG8_WAIT_L(0); PG8_BAR; PG8_MMA(1, 0, At, B0); if constexpr (!NHALF) PG8_MMA(1, 1, At, B1); PG8_BAR; PG8_SCHED;
        }
        if constexpr (ALIGN_EPI) { if (wr == 0) PG8_BAR; }
        E(acc, cur, wr, wc, fr, fq, pre, has_next);
        if (!has_next) break;
#pragma unroll
        for (int a = 0; a < 2; ++a)
#pragma unroll
            for (int b = 0; b < 2; ++b)
#pragma unroll
                for (int m = 0; m < 4; ++m)
#pragma unroll
                    for (int n = 0; n < 2; ++n) acc[a][b][m][n] = (f32x4){0.f, 0.f, 0.f, 0.f};
        cur = nxt; cA = nA; cB = nB; ++ui;
        if constexpr (ALIGN_EPI) { if (wr == 1) PG8_BAR; }
    }
    PG8_WAIT_V(0);
    if constexpr (!ALIGN_EPI) { if (wr == 0) PG8_BAR; }
    PG8_BAR;
#undef PG8_SA
#undef PG8_SB
#undef PG8_STAGE_A
#undef PG8_STAGE_B
#undef PG8_LDA
#undef PG8_LDB
#undef PG8_MMA
#undef PG8_WAIT_V
#undef PG8_WAIT_L
#undef PG8_WAIT_LOOP
#undef PG8_BAR
#undef PG8_SCHED
#undef PG8_AOFF_H
#undef PG8_TAB
#undef PG8_TABLOAD
}
}

constexpr int NWAVES = 8, NTHR = 512;
constexpr size_t MiB = 1u << 20;
constexpr size_t WS_CTL = 0, CTL_BYTES = 1 * MiB;
constexpr size_t WS_MOD = 1 * MiB;
constexpr size_t WS_WIN = 3 * MiB;
constexpr size_t WS_WOUT = 29 * MiB;
constexpr size_t WS_WR = 37 * MiB;
constexpr size_t WS_HYF = 39 * MiB;
constexpr size_t WS_HYFC = 71 * MiB;
constexpr size_t WS_XC = 73 * MiB;
constexpr size_t WS_EXP1 = 89 * MiB;
constexpr size_t WS_EXP2 = 218 * MiB;
constexpr size_t WS_XM = 283 * MiB;
constexpr size_t WS_EIDX = 419 * MiB;
constexpr size_t WS_WGT = 422 * MiB;
constexpr size_t WS_RNK = 425 * MiB;
constexpr size_t WS_ROWTOK = 428 * MiB;
constexpr size_t WS_ROWDST = 431 * MiB;
constexpr size_t WS_TILEEXP = 434 * MiB;
constexpr size_t WS_BIG = 435 * MiB;
constexpr size_t WS_U = WS_BIG;
constexpr size_t WS_MIX = 877 * MiB;
constexpr size_t WS_VT = 1013 * MiB;
constexpr size_t WS_HV = 1081 * MiB;
constexpr size_t WS_Z2 = 1183 * MiB;
constexpr size_t WS_GDS = 1217 * MiB;
constexpr size_t WS_GSIN = 1285 * MiB;
constexpr size_t WS_GD = 1319 * MiB;
constexpr size_t WS_Y = 1321 * MiB;
constexpr size_t WS_LOGIT = WS_BIG;
constexpr size_t WS_ACT = WS_BIG;
constexpr size_t WS_Y2 = 758 * MiB;
constexpr size_t WS_XM8 = 1470 * MiB;
constexpr size_t WS_WRB = 1540 * MiB;
constexpr size_t WS_RBIAS = 1558 * MiB;
constexpr size_t WS_XR = 1600 * MiB;
constexpr size_t WS_END = 1736 * MiB;
constexpr int CW_BAR = 4096;
constexpr int CW_CNT = 16384;
constexpr int CW_NTL = 20480;

constexpr int LDS_BYTES = 163840;
constexpr int MISC_OFF = 163584;

struct Frame {
    LAS unsigned char* lds;
    int tid, lane, wave, G, wg;
    const float* const* in;
    float* out; unsigned char* ws; unsigned* ctl;
};
enum { I_X = 0, I_C, I_CTX, I_CCTX, I_WMOD, I_BMOD, I_WIN, I_RPB, I_WA2, I_BA2, I_GNORM, I_HSW, I_HSB, I_HW1, I_HB1, I_HF1, I_HW2, I_HB2, I_HF2, I_HW3, I_HB3, I_HDEC, I_HSKIP,
       I_WOUT, I_LN1G, I_LN1B, I_RW, I_RB, I_WEG, I_WEU, I_WED, I_WSG, I_WSU, I_WSD, I_LN2G, I_LN2B };

__device__ __forceinline__ int row_b(int row) { return row < NLAT ? (row >> 12) : 16; }
__device__ __forceinline__ const float* mod_ptr(const Frame& F, int l, int row) { return (const float*)(F.ws + WS_MOD) + ((size_t)l * 17 + row_b(row)) * 6144; }

constexpr float NA_QSCALE = 0.125f * 1.4426950408889634f, NA_CLAMP = 60.0f * 1.4426950408889634f;
template <class RowFn>
__device__ __forceinline__ void tr_item(const float* W, int ldw, int k0, int n0, bf16_t* dst, int ldd, RowFn rf, LAS float* scr, int lane, float scale = 1.0f) {
    float tv[32];
    const GAS float* wp = (const GAS float*)(W + (size_t)(k0 + (lane >> 5)) * ldw + n0 + (lane & 31));
#pragma unroll
    for (int i = 0; i < 32; ++i) tv[i] = __builtin_nontemporal_load(wp + (size_t)(2 * i) * ldw);
#pragma unroll
    for (int i = 0; i < 32; ++i) scr[(2 * i + (lane >> 5)) * 33 + (lane & 31)] = tv[i];
    LDS_WAIT(); asm volatile("" ::: "memory");
    const int c = lane & 7;
#pragma unroll
    for (int j = 0; j < 4; ++j) { const int n = (lane >> 3) + 8 * j; const LAS float* s = scr + (8 * c) * 33 + n;
        u32x4 o; o.x = pk2(s[0 * 33] * scale, s[1 * 33] * scale); o.y = pk2(s[2 * 33] * scale, s[3 * 33] * scale); o.z = pk2(s[4 * 33] * scale, s[5 * 33] * scale); o.w = pk2(s[6 * 33] * scale, s[7 * 33] * scale);
        *(GAS u32x4*)(dst + (size_t)rf(n0 + n) * ldd + k0 + 8 * c) = o; }
    LDS_WAIT(); asm volatile("" ::: "memory");
}
template <class RowFn>
__device__ __forceinline__ void tr_item_ks(const float* W, int ldw, int k0, int n0, bf16_t* dst, int ldd, RowFn rf, LAS float* scr, int lane, const float* ksc) {
    float tv[32];
    const GAS float* wp = (const GAS float*)(W + (size_t)(k0 + (lane >> 5)) * ldw + n0 + (lane & 31));
#pragma unroll
    for (int i = 0; i < 32; ++i) tv[i] = wp[(size_t)(2 * i) * ldw];
#pragma unroll
    for (int i = 0; i < 32; ++i) scr[(2 * i + (lane >> 5)) * 33 + (lane & 31)] = tv[i] * (1.0f + ksc[2 * i + (lane >> 5)]);
    LDS_WAIT(); asm volatile("" ::: "memory");
    const int c = lane & 7;
#pragma unroll
    for (int j = 0; j < 4; ++j) { const int n = (lane >> 3) + 8 * j; const LAS float* s = scr + (8 * c) * 33 + n;
        u32x4 o; o.x = pk2(s[0 * 33], s[1 * 33]); o.y = pk2(s[2 * 33], s[3 * 33]); o.z = pk2(s[4 * 33], s[5 * 33]); o.w = pk2(s[6 * 33], s[7 * 33]);
        *(GAS u32x4*)(dst + (size_t)rf(n0 + n) * ldd + k0 + 8 * c) = o; }
    LDS_WAIT(); asm volatile("" ::: "memory");
}
template <class RowFn>
__device__ __forceinline__ void tr_item8(const float* W, int ldw, int k0, int n0, unsigned char* dst, int ldd, RowFn rf, float scale, LAS float* scr, int lane) {
    float tv[32];
    const GAS float* wp = (const GAS float*)(W + (size_t)(k0 + (lane >> 5)) * ldw + n0 + (lane & 31));
#pragma unroll
    for (int i = 0; i < 32; ++i) tv[i] = __builtin_nontemporal_load(wp + (size_t)(2 * i) * ldw);
#pragma unroll
    for (int i = 0; i < 32; ++i) scr[(2 * i + (lane >> 5)) * 33 + (lane & 31)] = tv[i];
    LDS_WAIT(); asm volatile("" ::: "memory");
    const int n = lane >> 1, hf = lane & 1; const LAS float* s = scr + (32 * hf) * 33 + n;
    unsigned w[8];
#pragma unroll
    for (int j = 0; j < 8; ++j) { int v = 0; v = __builtin_amdgcn_cvt_pk_fp8_f32(s[(4 * j) * 33] * scale, s[(4 * j + 1) * 33] * scale, v, false); v = __builtin_amdgcn_cvt_pk_fp8_f32(s[(4 * j + 2) * 33] * scale, s[(4 * j + 3) * 33] * scale, v, true); w[j] = (unsigned)v; }
    unsigned char* d = dst + (size_t)rf(n0 + n) * ldd + k0 + 32 * hf;
    *(GAS u32x4*)d = (u32x4){w[0], w[1], w[2], w[3]}; *(GAS u32x4*)(d + 16) = (u32x4){w[4], w[5], w[6], w[7]};
    LDS_WAIT(); asm volatile("" ::: "memory");
}
struct RowId { __device__ __forceinline__ int operator()(int n) const { return n; } };
struct RowWin { __device__ __forceinline__ int operator()(int n) const { return n >= 2336 ? n - 32 : n; } };
struct RowGU { int up; __device__ __forceinline__ int operator()(int j) const { return (j >> 7) * 256 + up * 128 + (j & 127); } };

__device__ __forceinline__ void p0_static_weights(Frame& F) {
    LAS float* scr = (LAS float*)(F.lds + F.wave * 16384);
    const int gw = F.wg * NWAVES + F.wave, NGW = F.G * NWAVES;
    constexpr int I_IN = 16 * 97, I_OUT = 16 * 32, I_R = 16 * 4, PER_L = I_IN + I_OUT + I_R;
    for (int it = gw; it < DEPTH * PER_L; it += NGW) {
        const int l = it / PER_L; int r = it % PER_L;
        if (r < I_IN) { const int kb = r / 97, nb = r % 97; if (nb == 72) continue;
            tr_item(F.in[I_WIN] + (size_t)l * DM * DIN_REF, DIN_REF, kb * 64, nb * 32, (bf16_t*)(F.ws + WS_WIN) + (size_t)l * DIN * DM, DM, RowWin{}, scr, F.lane, nb < 16 ? NA_QSCALE : 1.0f); continue; }
        r -= I_IN;
        if (r < I_OUT) { const int kb = r / 32, nb = r % 32;
            tr_item(F.in[I_WOUT] + (size_t)l * DM * DM, DM, kb * 64, nb * 32, (bf16_t*)(F.ws + WS_WOUT) + (size_t)l * DM * DM, DM, RowId{}, scr, F.lane); continue; }
        r -= I_OUT;
        { const int kb = r / 4, nb = r % 4;
            tr_item(F.in[I_RW] + (size_t)l * DM * NEXP, NEXP, kb * 64, nb * 32, (bf16_t*)(F.ws + WS_WR) + (size_t)l * 256 * DM, DM, RowId{}, scr, F.lane); }
    }
    const int gt = F.wg * NTHR + F.tid, NGT = F.G * NTHR;
    for (int i = gt; i < DEPTH * 128 * DM / 8; i += NGT) { const int l = i / (128 * DM / 8), r = i % (128 * DM / 8);
        *(u32x4*)((bf16_t*)(F.ws + WS_WR) + ((size_t)l * 256 + 128) * DM + (size_t)r * 8) = (u32x4){0u, 0u, 0u, 0u}; }
    for (int i = gt; i < DEPTH * 256 * DM; i += NGT) {
        const int k = i % DM, n = (i / DM) % 256, l = i / (DM * 256), dir = n >> 7, j = n & 127;
        const float* wi = F.in[I_WIN] + ((size_t)l * DM + k) * DIN_REF + 2304 + dir * 16;
        const float* wa = F.in[I_WA2] + ((size_t)(l * 2 + dir) * 16) * 128 + j;
        float s = 0.f;
#pragma unroll
        for (int r = 0; r < 16; ++r) s += wi[r] * wa[r * 128];
        ((bf16_t*)(F.ws + WS_WIN))[((size_t)l * DIN + 3072 + n) * DM + k] = (bf16_t)f2bf(s);
    }
}
__device__ __forceinline__ void p0_mod(Frame& F) {
    LAS float* sc = (LAS float*)F.lds;
    LAS float* red = (LAS float*)(F.lds + 17 * 1024 * 4);
    for (int i = F.tid; i < 17 * 1024; i += NTHR) { const int r = i >> 10, k = i & 1023; const float v = r < 16 ? F.in[I_C][r * 1024 + k] : F.in[I_CCTX][k]; sc[i] = silu_f(v); }
    __syncthreads();
    const int kq = F.tid >> 7, cl = F.tid & 127;
    for (int u = F.wg; u < DEPTH * 48; u += F.G) {
        const int l = u / 48, col = (u % 48) * 128 + cl;
        const float* w = F.in[I_WMOD] + (size_t)l * DM * 6144 + col;
        float a[17];
#pragma unroll
        for (int r = 0; r < 17; ++r) a[r] = 0.f;
        for (int k0 = kq * 256; k0 < kq * 256 + 256; k0 += 16) {
            float wv[16];
#pragma unroll
            for (int q = 0; q < 16; ++q) wv[q] = *(const GAS float*)(w + (size_t)(k0 + q) * 6144);
#pragma unroll
            for (int q = 0; q < 16; ++q)
#pragma unroll
                for (int r = 0; r < 17; ++r) a[r] += sc[r * 1024 + k0 + q] * wv[q]; }
#pragma unroll
        for (int r = 0; r < 17; ++r) red[(kq * 17 + r) * 128 + cl] = a[r];
        __syncthreads();
        for (int i = F.tid; i < 17 * 128; i += NTHR) { const int r = i >> 7, c2 = i & 127, cc = (u % 48) * 128 + c2;
            const float s = red[(0 * 17 + r) * 128 + c2] + red[(1 * 17 + r) * 128 + c2] + red[(2 * 17 + r) * 128 + c2] + red[(3 * 17 + r) * 128 + c2] + F.in[I_BMOD][l * 6144 + cc];
            ((float*)(F.ws + WS_MOD))[((size_t)l * 17 + r) * 6144 + cc] = s; }
        __syncthreads();
    }
}
__device__ __forceinline__ void p0_hyena_filters(Frame& F) {
    LAS float* z = (LAS float*)F.lds;
    LAS float* h1 = z + 1092;
    LAS float* h2 = h1 + 33 * 64;
    LAS float* tt = h2 + 33 * 64;
    LAS float* W1 = tt + 64;
    LAS float* W2 = W1 + 33 * 64;
    constexpr int UL = 4096 / 32, UC = 256 / 32, UPL = UL + UC;
    for (int u = F.wg; u < DEPTH * UPL; u += F.G) {
        const int l = u / UPL, r = u % UPL; const bool lat = r < UL; const int L = lat ? 4096 : 256, n0 = (lat ? r : r - UL) * 32;
        __syncthreads();
        for (int i = F.tid; i < 33 * 64; i += NTHR) W1[i] = F.in[I_HW1][(size_t)l * 33 * 64 + i];
        for (int i = F.tid; i < 64 * 64; i += NTHR) W2[i] = F.in[I_HW2][(size_t)l * 64 * 64 + i];
        for (int i = F.tid; i < 33 * 33; i += NTHR) { const int p = i / 33, e = i % 33, n = n0 + p;
            const float t = (float)n / (float)(L - 1);
            float v;
            if (e == 0) v = t;
            else { const int kb = (e - 1) & 15; const float band = 1e-4f + (float)kb * ((15.0f - 1e-4f) / 15.0f);
                   const float w = 6.283185307179586f * (float)n / (float)L; const float ang = w * band;
                   v = e <= 16 ? __cosf(ang) : -__sinf(ang); }
            z[i] = v; if (e == 0) tt[p] = t; }
        __syncthreads();
        for (int i = F.tid; i < 33 * 64; i += NTHR) { const int p = i >> 6, j = i & 63; float s = F.in[I_HB1][l * 64 + j];
#pragma unroll 11
            for (int e = 0; e < 33; ++e) s += z[p * 33 + e] * W1[e * 64 + j];
            h1[i] = __sinf(F.in[I_HF1][l * 64 + j] * s); }
        __syncthreads();
        for (int i = F.tid; i < 33 * 64; i += NTHR) { const int p = i >> 6, j = i & 63; float s = F.in[I_HB2][l * 64 + j];
#pragma unroll 16
            for (int e = 0; e < 64; ++e) s += h1[p * 64 + e] * W2[e * 64 + j];
            h2[i] = __sinf(F.in[I_HF2][l * 64 + j] * s); }
        __syncthreads();
        {
            const int g = F.tid >> 8, col0 = 4 * (F.tid & 255), o = col0 >> 9, dir = (col0 >> 8) & 1, ch0 = col0 & 255;
            const int pb = (dir ? 0 : 1) + 16 * g;
            float a[4][16];
#pragma unroll
            for (int j = 0; j < 4; ++j)
#pragma unroll
                for (int q = 0; q < 16; ++q) a[j][q] = 0.f;
            const float* w3 = F.in[I_HW3] + (size_t)l * 64 * 1024 + col0;
            const LAS float* hp = h2 + pb * 64;
            f32x4 wa[4], wb[4];
#pragma unroll
            for (int q = 0; q < 4; ++q) wa[q] = *(const GAS f32x4*)(w3 + (size_t)q * 1024);
#define HF_BLOCK(wv_, k0_) do { _Pragma("unroll") for (int pi = 0; pi < 16; ++pi) { const f32x4 hv = *(const LAS f32x4*)(hp + pi * 64 + (k0_)); \
                _Pragma("unroll") for (int q = 0; q < 4; ++q) _Pragma("unroll") for (int j = 0; j < 4; ++j) a[j][pi] += hv[q] * wv_[q][j]; } } while (0)
#pragma unroll 1
            for (int k0 = 0; k0 < 64; k0 += 8) {
#pragma unroll
                for (int q = 0; q < 4; ++q) wb[q] = *(const GAS f32x4*)(w3 + (size_t)(k0 + 4 + q) * 1024);
                __builtin_amdgcn_sched_barrier(0);
                HF_BLOCK(wa, k0);
                __builtin_amdgcn_sched_barrier(0);
                { const int kn = k0 + 8 < 64 ? k0 + 8 : k0;
#pragma unroll
                  for (int q = 0; q < 4; ++q) wa[q] = *(const GAS f32x4*)(w3 + (size_t)(kn + q) * 1024); }
                __builtin_amdgcn_sched_barrier(0);
                HF_BLOCK(wb, k0 + 4);
                __builtin_amdgcn_sched_barrier(0);
            }
#undef HF_BLOCK
            const f32x4 b3 = *(const GAS f32x4*)(F.in[I_HB3] + l * 1024 + col0), dc = *(const GAS f32x4*)(F.in[I_HDEC] + ((size_t)(l * 2 + o) * 2 + dir) * 256 + ch0);
            float a0[4] = {0.f, 0.f, 0.f, 0.f};
            if (n0 == 0 && dir == 0 && g == 0) {
                for (int k = 0; k < 64; ++k) { const f32x4 wv = *(const GAS f32x4*)(w3 + (size_t)k * 1024); const float hv = h2[k];
#pragma unroll
                    for (int j = 0; j < 4; ++j) a0[j] += hv * wv[j]; } }
#pragma unroll
            for (int j = 0; j < 4; ++j) {
                const float dec = fabsf(dc[j]);
                bf16_t* R = lat ? (bf16_t*)(F.ws + WS_HYF) + ((size_t)(l * 2 + o) * 256 + ch0 + j) * 8192 : (bf16_t*)(F.ws + WS_HYFC) + ((size_t)(l * 2 + o) * 256 + ch0 + j) * 512;
                float v[16];
#pragma unroll
                for (int pi = 0; pi < 16; ++pi) v[pi] = (a[j][pi] + b3[j]) * __expf(-tt[pb + pi] * dec);
                unsigned w[8];
                if (dir == 0) {
                    if (n0 + 32 == L && g == 1) v[15] = 0.f;
#pragma unroll
                    for (int q = 0; q < 8; ++q) w[q] = pk2(v[15 - 2 * q], v[14 - 2 * q]);
                    GAS u32x4* dst = (GAS u32x4*)(R + (L - n0 - 32) + 16 * (1 - g));
                    dst[0] = (u32x4){w[0], w[1], w[2], w[3]}; dst[1] = (u32x4){w[4], w[5], w[6], w[7]};
                    if (n0 == 0 && g == 0) R[L] = (bf16_t)f2bf((a0[j] + b3[j]) * __expf(-tt[0] * dec) + F.in[I_HSKIP][(l * 2 + o) * 256 + ch0 + j]);
                } else if (n0 > 0 || g == 1) {
#pragma unroll
                    for (int q = 0; q < 8; ++q) w[q] = pk2(v[2 * q], v[2 * q + 1]);
                    GAS u32x4* dst = (GAS u32x4*)(R + (L + n0) + 16 * g);
                    dst[0] = (u32x4){w[0], w[1], w[2], w[3]}; dst[1] = (u32x4){w[4], w[5], w[6], w[7]};
                } else {
#pragma unroll
                    for (int pi = 1; pi < 16; ++pi) R[L + pi] = (bf16_t)f2bf(v[pi]);
                }
            }
        }
    }
    __syncthreads();
}
__device__ __forceinline__ void p0_init_rows(Frame& F) {
    const int gw = F.wg * NWAVES + F.wave, NGW = F.G * NWAVES;
    for (int row = gw; row < NROW; row += NGW) {
        const float* src = row < NLAT ? F.in[I_X] + (size_t)row * DM : F.in[I_CTX] + (size_t)(row - NLAT) * DM;
        const float* md = mod_ptr(F, 0, row);
        bf16_t* xr = (bf16_t*)(F.ws + WS_XR) + (size_t)row * DM; bf16_t* xm = (bf16_t*)(F.ws + WS_XM) + (size_t)row * DM;
#pragma unroll
        for (int j = 0; j < 4; ++j) { const int c = 4 * F.lane + 256 * j;
            const f32x4 v = __builtin_nontemporal_load((const GAS f32x4*)(src + c)), sh = *(const GAS f32x4*)(md + c), sc = *(const GAS f32x4*)(md + 1024 + c);
            *(GAS u32x2*)(xr + c) = (u32x2){pk2(v[0], v[1]), pk2(v[2], v[3])};
            u32x2 w; w.x = pk2(v[0] * (1.f + sc[0]) + sh[0], v[1] * (1.f + sc[1]) + sh[1]); w.y = pk2(v[2] * (1.f + sc[2]) + sh[2], v[3] * (1.f + sc[3]) + sh[3]);
            *(GAS u32x2*)(xm + c) = w; }
    }
}
__device__ __forceinline__ void p1_router_weights(Frame& F) {
    LAS float* scr = (LAS float*)(F.lds + F.wave * 16384);
    const int gw = F.wg * NWAVES + F.wave, NGW = F.G * NWAVES;
    const float* MOD = (const float*)(F.ws + WS_MOD);
    for (int it = gw; it < DEPTH * 17 * 64; it += NGW) {
        const int lb = it >> 6, l = lb / 17, kb = (it & 63) >> 2, nb = it & 3;
        tr_item_ks(F.in[I_RW] + (size_t)l * DM * NEXP, NEXP, kb * 64, nb * 32, (bf16_t*)(F.ws + WS_WRB) + (size_t)lb * 128 * DM, DM, RowId{}, scr, F.lane, MOD + (size_t)lb * 6144 + 4096 + kb * 64); }
    for (int it = gw; it < DEPTH * 17 * 8; it += NGW) {
        const int lb = it >> 3, l = lb / 17, n = (it & 7) * 16 + (F.lane & 15), kq = F.lane >> 4;
        const float* sh = MOD + (size_t)lb * 6144 + 3072 + kq * 256; const float* w = F.in[I_RW] + (size_t)l * DM * NEXP + (size_t)(kq * 256) * NEXP + n;
        float a = 0.f;
#pragma unroll 8
        for (int k = 0; k < 256; ++k) a += sh[k] * w[(size_t)k * NEXP];
        a += shx(a, 16, F.lane); a += shx(a, 32, F.lane);
        if (kq == 0) ((float*)(F.ws + WS_RBIAS))[(size_t)lb * 128 + n] = a; }
}
constexpr float WEXP_SCALE = 32.0f;
constexpr int XW_ITEMS = NE1 * 384, XW_TAIL_E = 12288, XW_TAIL_G = 12288 + 7680;
__device__ __forceinline__ void p_expert_weights(Frame& F, int l, int it0, int it1, int nw, int w) {
    LAS float* scr = (LAS float*)(F.lds + F.wave * 16384);
    constexpr int I1 = 16 * 8, I2 = 4 * 32, PER_E = 2 * I1 + I2;
    for (int it = it0 + w; it < it1; it += nw) {
        const int e = it / PER_E; int r = it % PER_E;
        unsigned char* d1 = (unsigned char*)(F.ws + WS_EXP1) + (size_t)e * 512 * DM; unsigned char* d2 = (unsigned char*)(F.ws + WS_EXP2) + (size_t)e * DM * EH;
        if (r < 2 * I1) { const int up = r >= I1; if (up) r -= I1; const int kb = r / 8, nb = r % 8;
            const float* src = e < NEXP ? F.in[up ? I_WEU : I_WEG] + ((size_t)l * NEXP + e) * DM * EH : F.in[up ? I_WSU : I_WSG] + (size_t)l * DM * EH;
            tr_item8(src, EH, kb * 64, nb * 32, d1, DM, RowGU{up}, up ? WEXP_SCALE * 0.6931471805599453f : WEXP_SCALE * 1.4426950408889634f, scr, F.lane); }
        else { r -= 2 * I1; const int kb = r / 32, nb = r % 32;
            const float* src = e < NEXP ? F.in[I_WED] + ((size_t)l * NEXP + e) * EH * DM : F.in[I_WSD] + (size_t)l * EH * DM;
            tr_item8(src, DM, kb * 64, nb * 32, d2, EH, RowId{}, WEXP_SCALE, scr, F.lane); }
    }
}

__device__ __forceinline__ f32x4 mfma16(bf16x8 a, bf16x8 b, f32x4 c) { return __builtin_amdgcn_mfma_f32_16x16x32_bf16(a, b, c, 0, 0, 0); }

__device__ __forceinline__ void ph_transposes(Frame& F, int l) {
    LAS bf16_t* tile = (LAS bf16_t*)(F.lds + F.wave * 16384);
    const bf16_t* U = (const bf16_t*)(F.ws + WS_U);
    const int gw = F.wg * NWAVES + F.wave, NGW = F.G * NWAVES;
    const int rsub = F.lane >> 3, cseg = F.lane & 7;
    for (int u = gw; u < 1088 * 12; u += NGW) {
        const int tt = u / 12, blk = u % 12;
        int b, s0, Ls, rowbase, posbase;
        if (tt < 1024) { b = tt >> 6; s0 = (tt & 63) * 64; Ls = SEQ; rowbase = b * SEQ; posbase = 0; }
        else { const int t2 = tt - 1024; b = t2 >> 2; s0 = (t2 & 3) * 64; Ls = CTXL; rowbase = NLAT + b * CTXL; posbase = SEQ; }
        if (blk < 12) {
            constexpr int HT = 80;
            float w0[8], w1[8], w2[8], bb[8];
#pragma unroll
            for (int it = 0; it < 8; ++it) { const int col = blk * 64 + rsub + 8 * it; w0[it] = F.in[I_HSW][(l * 3 + 0) * 768 + col]; w1[it] = F.in[I_HSW][(l * 3 + 1) * 768 + col]; w2[it] = F.in[I_HSW][(l * 3 + 2) * 768 + col]; bb[it] = F.in[I_HSB][l * 768 + col]; }
            const bf16_t* p0 = U + (size_t)(rowbase + s0 + rsub) * DIN + UHY + blk * 64 + cseg * 8;
            u32x4 zc[8];
#pragma unroll
            for (int it = 0; it < 8; ++it) zc[it] = *(const GAS u32x4*)(p0 + (size_t)(8 * it) * DIN);
            u32x4 zh = (u32x4){0u, 0u, 0u, 0u};
            if (F.lane < 16) { const int hs = F.lane < 8 ? s0 - 1 : s0 + 64; if (hs >= 0 && hs < Ls) zh = *(const GAS u32x4*)(U + (size_t)(rowbase + hs) * DIN + UHY + blk * 64 + cseg * 8); }
#pragma unroll
            for (int it = 0; it < 8; ++it) { const unsigned a[4] = {zc[it].x, zc[it].y, zc[it].z, zc[it].w}; LAS bf16_t* d = tile + (cseg * 8) * HT + 8 + rsub + 8 * it;
#pragma unroll
                for (int i = 0; i < 4; ++i) { d[(2 * i) * HT] = (bf16_t)(a[i] & 0xffffu); d[(2 * i + 1) * HT] = (bf16_t)(a[i] >> 16); } }
            if (F.lane < 16) { const unsigned a[4] = {zh.x, zh.y, zh.z, zh.w}; LAS bf16_t* d = tile + (cseg * 8) * HT + (F.lane < 8 ? 7 : 72);
#pragma unroll
                for (int i = 0; i < 4; ++i) { d[(2 * i) * HT] = (bf16_t)(a[i] & 0xffffu); d[(2 * i + 1) * HT] = (bf16_t)(a[i] >> 16); } }
            LDS_WAIT(); asm volatile("" ::: "memory");
#pragma unroll
            for (int it = 0; it < 8; ++it) {
                const int ch = rsub + 8 * it; const LAS bf16_t* r = tile + ch * HT + 8 + cseg * 8;
                const u32x4 v = *(const LAS u32x4*)r; const unsigned hm = r[-1], hp = r[8];
                float x[10]; x[0] = __builtin_bit_cast(float, hm << 16); x[9] = __builtin_bit_cast(float, hp << 16);
                x[1] = bflo(v.x); x[2] = bfhi(v.x); x[3] = bflo(v.y); x[4] = bfhi(v.y); x[5] = bflo(v.z); x[6] = bfhi(v.z); x[7] = bflo(v.w); x[8] = bfhi(v.w);
                unsigned w[4];
#pragma unroll
                for (int i = 0; i < 4; ++i) w[i] = pk2(bb[it] + w0[it] * x[2 * i] + w1[it] * x[2 * i + 1] + w2[it] * x[2 * i + 2], bb[it] + w0[it] * x[2 * i + 1] + w1[it] * x[2 * i + 2] + w2[it] * x[2 * i + 3]);
                *(GAS u32x4*)((bf16_t*)(F.ws + WS_HV) + ((size_t)(blk * 64 + ch) * NB + b) * SPB + posbase + s0 + cseg * 8) = (u32x4){w[0], w[1], w[2], w[3]};
            }
            LDS_WAIT(); asm volatile("" ::: "memory");
            continue;
        } else {
            const int c0 = (blk - 12) * 64 + cseg * 8;
#pragma unroll
            for (int it = 0; it < 8; ++it) {
                const int sl = rsub + 8 * it, s = s0 + sl;
                const u32x4 zc = *(const GAS u32x4*)(U + (size_t)(rowbase + s) * DIN + UV + c0);
                const unsigned ac[4] = {zc.x, zc.y, zc.z, zc.w};
#pragma unroll
                for (int i = 0; i < 4; ++i) { tile[(cseg * 8 + 2 * i) * 72 + sl] = (bf16_t)(ac[i] & 0xffffu); tile[(cseg * 8 + 2 * i + 1) * 72 + sl] = (bf16_t)(ac[i] >> 16); }
            }
        }
        LDS_WAIT(); asm volatile("" ::: "memory");
#pragma unroll 2
        for (int it = 0; it < 8; ++it) {
            const int ch = rsub + 8 * it;
            const u32x4 v = *(const LAS u32x4*)(tile + ch * 72 + cseg * 8);
            bf16_t* dst;
            if (blk < 12) dst = (bf16_t*)(F.ws + WS_HV) + ((size_t)(blk * 64 + ch) * NB + b) * SPB + posbase + s0 + cseg * 8;
            else dst = (bf16_t*)(F.ws + WS_VT) + ((size_t)b * 512 + (blk - 12) * 64 + ch) * SPB + posbase + s0 + cseg * 8;
            *(GAS u32x4*)dst = v;
        }
        LDS_WAIT(); asm volatile("" ::: "memory");
    }
}

constexpr int NA_RPB = 0, NA_KC = 2048, NA_VC = NA_KC + 256 * 144, NA_KR = NA_VC + 64 * 528, NA_END = NA_KR + 9 * 64 * 144;
static_assert(NA_END <= MISC_OFF, "NA LDS map");
__device__ __forceinline__ bf16x8 gld16(const bf16_t* p) { return *(const GAS bf16x8*)p; }
__device__ __forceinline__ u32x2 gld8(const bf16_t* p) { return *(const GAS u32x2*)p; }
__device__ __forceinline__ const char* uni_ptr(const char* p) { const unsigned long long v = (unsigned long long)p; const unsigned lo = __builtin_amdgcn_readfirstlane((unsigned)v), hi = __builtin_amdgcn_readfirstlane((unsigned)(v >> 32)); return (const char*)(((unsigned long long)hi << 32) | lo); }
__device__ __forceinline__ bf16x8 gld16o(const char* ub, unsigned lo) { return *(const GAS bf16x8*)(ub + (size_t)lo); }
__device__ __forceinline__ u32x2 gld8o(const char* ub, unsigned lo) { return *(const GAS u32x2*)(ub + (size_t)lo); }
template <bool WIN>
__device__ __forceinline__ void na_unit(Frame& F, int b, int h, int r, int strip) {
    const bf16_t* U = (const bf16_t*)(F.ws + WS_U);
    const bf16_t* VT = (const bf16_t*)(F.ws + WS_VT) + ((size_t)b * 512 + h * 64) * SPB;
    const LAS float* rpb = (const LAS float*)(F.lds + NA_RPB);
    const LAS bf16_t* KC = (const LAS bf16_t*)(F.lds + NA_KC); const LAS bf16_t* VC = (const LAS bf16_t*)(F.lds + NA_VC);
    int ln_ = F.lane; asm volatile("" : "+v"(ln_));
    const int i = ln_ & 15, g = ln_ >> 4;
    const int qrow0 = WIN ? (b * SEQ + r * 64 + strip * 16) : (NLAT + b * CTXL + strip * 16);
    const int ki = 8 * (i >> 2) + (i & 3);
    const unsigned qlo = (unsigned)((i * DIN + 8 * g) * 2), klo = (unsigned)((ki * DIN + 8 * g) * 2), vlo = (unsigned)((i * SPB + 8 * g) * 2);
    const char* qb = uni_ptr((const char*)(U + (size_t)qrow0 * DIN + UQ + h * 64));
    const bf16x8 q0 = gld16o(qb, qlo), q1 = gld16o(qb + 64, qlo);
    int kr0 = 0, u0 = 0;
    if (WIN) { kr0 = r - 4; kr0 = kr0 < 0 ? 0 : (kr0 > 56 ? 56 : kr0); u0 = strip == 0 ? 0 : (strip == 1 ? 8 : (strip == 2 ? 24 : 32)); }
    const LAS bf16_t* KR = (const LAS bf16_t*)(F.lds + NA_KR);
    const char* vbase = uni_ptr((const char*)(VT + kr0 * 64 + u0));
    f32x4 o[4];
#pragma unroll
    for (int d = 0; d < 4; ++d) o[d] = (f32x4){0.f, 0.f, 0.f, 0.f};
    float lsum = 0.f;
#define NA_SB() __builtin_amdgcn_sched_barrier(0)
#define NA_WLOAD(vb_, cw) do { _Pragma("unroll") for (int d = 0; d < 4; ++d) vb_[d] = gld16o(vbase + ((size_t)(d * 16) * SPB + (cw) * 64) * 2, vlo); } while (0)
#define NA_KRING(kb_, cw) do { const LAS bf16_t* kp = KR + ((((kr0 + (cw)) % 9) * 64 + u0 + ki) * 72 + 8 * g); kb_[0][0] = *(const LAS bf16x8*)kp; kb_[0][1] = *(const LAS bf16x8*)(kp + 32); \
        kb_[1][0] = *(const LAS bf16x8*)(kp + 4 * 72); kb_[1][1] = *(const LAS bf16x8*)(kp + 4 * 72 + 32); } while (0)
#define NA_QK(kb_, s_) do { _Pragma("unroll") for (int t = 0; t < 2; ++t) { f32x4 a = (f32x4){0.f, 0.f, 0.f, 0.f}; a = mfma16(kb_[t][0], q0, a); a = mfma16(kb_[t][1], q1, a); s_[t] = a; } } while (0)
#define NA_PV(s_, vb_) do { u32x4 pw; pw.x = pk2(s_[0][0], s_[0][1]); pw.y = pk2(s_[0][2], s_[0][3]); pw.z = pk2(s_[1][0], s_[1][1]); pw.w = pk2(s_[1][2], s_[1][3]); const bf16x8 pf = __builtin_bit_cast(bf16x8, pw); \
        _Pragma("unroll") for (int d = 0; d < 4; ++d) o[d] = mfma16(vb_[d], pf, o[d]); } while (0)
    bf16x8 vA[4], vB[4], vC[4];
    if (WIN) { NA_WLOAD(vA, 0); NA_WLOAD(vB, 1); NA_WLOAD(vC, 2); NA_SB(); }
#pragma unroll
    for (int cc = 0; cc < 8; ++cc) {
        bf16x8 kc[2][2], vc[4]; f32x4 sc[2];
#pragma unroll
        for (int t = 0; t < 2; ++t) { const LAS bf16_t* kp = KC + (cc * 32 + ki + 4 * t) * 72 + 8 * g; kc[t][0] = *(const LAS bf16x8*)kp; kc[t][1] = *(const LAS bf16x8*)(kp + 32); }
#pragma unroll
        for (int d = 0; d < 4; ++d) vc[d] = *(const LAS bf16x8*)(VC + (d * 16 + i) * 264 + cc * 32 + 8 * g);
        NA_QK(kc, sc);
#pragma unroll
        for (int t = 0; t < 2; ++t)
#pragma unroll
            for (int e = 0; e < 4; ++e) { const float p = __builtin_amdgcn_exp2f(fminf(sc[t][e], NA_CLAMP)); sc[t][e] = p; lsum += p; }
        NA_PV(sc, vc);
    }
    if (WIN) {
        const int c = strip * 16 + i; int kc0 = c - 8; kc0 = kc0 < 0 ? 0 : (kc0 > 48 ? 48 : kc0);
        int dcl[2][4]; bool okm[2][4];
#pragma unroll
        for (int t = 0; t < 2; ++t)
#pragma unroll
            for (int e = 0; e < 4; ++e) { const int kc = u0 + 8 * g + 4 * t + e; okm[t][e] = (kc >= kc0) && (kc < kc0 + 16); int dc = kc - c + 15; dcl[t][e] = okm[t][e] ? (dc < 0 ? 0 : (dc > 30 ? 30 : dc)) : 31; }
#define NA_WCHUNK(vb_, cw) do { bf16x8 kw[2][2]; NA_KRING(kw, cw); f32x4 sw[2]; NA_QK(kw, sw); const LAS float* rp = rpb + (kr0 + (cw) - r + 7) * 32; \
        _Pragma("unroll") for (int t = 0; t < 2; ++t) _Pragma("unroll") for (int e = 0; e < 4; ++e) { const float x = sw[t][e] + rp[dcl[t][e]]; const float p = __builtin_amdgcn_exp2f(fminf(x, NA_CLAMP)); sw[t][e] = p; lsum += p; } \
        NA_PV(sw, vb_); } while (0)
        NA_WCHUNK(vA, 0); NA_SB(); NA_WLOAD(vA, 3); NA_SB();
        NA_WCHUNK(vB, 1); NA_SB(); NA_WLOAD(vB, 4); NA_SB();
        NA_WCHUNK(vC, 2); NA_SB(); NA_WLOAD(vC, 5); NA_SB();
        NA_WCHUNK(vA, 3); NA_SB(); NA_WLOAD(vA, 6); NA_SB();
        NA_WCHUNK(vB, 4); NA_SB(); NA_WLOAD(vB, 7); NA_SB();
        NA_WCHUNK(vC, 5); NA_SB();
        NA_WCHUNK(vA, 6); NA_SB();
        NA_WCHUNK(vB, 7); NA_SB();
#undef NA_WCHUNK
    }
    lsum += shx(lsum, 16, ln_); lsum += shx(lsum, 32, ln_);
    const float inv = 1.0f / lsum;
    char* op = (char*)uni_ptr((const char*)((bf16_t*)(F.ws + WS_MIX) + (size_t)qrow0 * DM + h * 64)); const unsigned olo = (unsigned)((i * DM + 4 * g) * 2);
#pragma unroll
    for (int d = 0; d < 4; ++d) { u32x2 w; w.x = pk2(o[d][0] * inv, o[d][1] * inv); w.y = pk2(o[d][2] * inv, o[d][3] * inv); *(GAS u32x2*)(op + d * 32 + (size_t)olo) = w; }
#undef NA_SB
#undef NA_WLOAD
#undef NA_KRING
#undef NA_QK
#undef NA_PV
}
__device__ __forceinline__ int na_kr0(int r) { const int k = r - 4; return k < 0 ? 0 : (k > 56 ? 56 : k); }
__device__ __forceinline__ void ph_na(Frame& F, int l, bool last) {
    const bf16_t* U = (const bf16_t*)(F.ws + WS_U);
    for (int job = F.wg; job < NB * 8 * 2; job += F.G) {
        const int half = job & 1, h = (job >> 1) & 7, b = job >> 4;
        int tz_; asm volatile("v_mbcnt_lo_u32_b32 %0, -1, 0\n\tv_mbcnt_hi_u32_b32 %0, -1, %0" : "=v"(tz_)); tz_ |= F.wave << 6;
        const bf16_t* krow = U + (size_t)(b * SEQ + (tz_ >> 3)) * DIN + UK + h * 64 + (tz_ & 7) * 8;
        LAS bf16_t* kdst = (LAS bf16_t*)(F.lds + NA_KR) + (tz_ >> 3) * 72 + (tz_ & 7) * 8;
        __syncthreads();
        { LAS float* rpb = (LAS float*)(F.lds + NA_RPB); const float* rsrc = F.in[I_RPB] + ((size_t)l * 8 + h) * 15 * 31;
          if (tz_ < 15 * 32) rpb[tz_] = (tz_ & 31) < 31 ? rsrc[(tz_ >> 5) * 31 + (tz_ & 31)] * 1.4426950408889634f : -1e30f;
          const int key = tz_ >> 1, hf = tz_ & 1; const bf16_t* src = U + (size_t)(NLAT + b * CTXL + key) * DIN + UK + h * 64 + hf * 32; LAS bf16_t* dst = (LAS bf16_t*)(F.lds + NA_KC) + key * 72 + hf * 32;
#pragma unroll
          for (int j = 0; j < 4; ++j) *(LAS bf16x8*)(dst + j * 8) = gld16(src + j * 8);
          const int dv = tz_ >> 3, seg = tz_ & 7; const bf16_t* vs = (const bf16_t*)(F.ws + WS_VT) + ((size_t)b * 512 + h * 64 + dv) * SPB + SEQ + seg * 32; LAS bf16_t* vd = (LAS bf16_t*)(F.lds + NA_VC) + dv * 264 + seg * 32;
#pragma unroll
          for (int j = 0; j < 4; ++j) *(LAS bf16x8*)(vd + j * 8) = gld16(vs + j * 8);
          const int lo = na_kr0(half * 32), hi0 = na_kr0(half * 32 + 1) + 7;
          for (int kr = lo; kr <= hi0; ++kr) *(LAS bf16x8*)(kdst + (kr % 9) * 64 * 72) = gld16(krow + (size_t)kr * 64 * DIN); }
        __syncthreads();
        int prev_hi = na_kr0(half * 32 + 1) + 7;
#pragma unroll 1
        for (int s = 0; s < 16; ++s) {
            const int r0 = half * 32 + 2 * s;
            const int nhi = s < 15 ? na_kr0(r0 + 3) + 7 : prev_hi;
            bf16x8 n0 = (bf16x8){0, 0, 0, 0, 0, 0, 0, 0}, n1 = n0;
            if (nhi > prev_hi) n0 = gld16(krow + (size_t)(prev_hi + 1) * 64 * DIN);
            if (nhi > prev_hi + 1) n1 = gld16(krow + (size_t)(prev_hi + 2) * 64 * DIN);
            na_unit<true>(F, b, h, r0 + (F.wave >> 2), F.wave & 3);
            __syncthreads();
            if (nhi > prev_hi) *(LAS bf16x8*)(kdst + ((prev_hi + 1) % 9) * 64 * 72) = n0;
            if (nhi > prev_hi + 1) *(LAS bf16x8*)(kdst + ((prev_hi + 2) % 9) * 64 * 72) = n1;
            __syncthreads();
            prev_hi = nhi;
        }
        if (!last) na_unit<false>(F, b, h, 0, half * 8 + F.wave);
    }
}

__device__ __forceinline__ void ph_hy_transpose(Frame& F, bool last) {
    LAS bf16_t* tile = (LAS bf16_t*)(F.lds + F.wave * 16384);
    const bf16_t* HYO = (const bf16_t*)(F.ws + WS_Y);
    const int gw = F.wg * NWAVES + F.wave, NGW = F.G * NWAVES;
    const int rsub = F.lane >> 3, cseg = F.lane & 7;
    const int ntt = last ? 1024 : 1088;
    for (int u = gw; u < ntt * 4; u += NGW) {
        const int tt = u >> 2, cb = u & 3;
        int b, s0, rowbase, posbase;
        if (tt < 1024) { b = tt >> 6; s0 = (tt & 63) * 64; rowbase = b * SEQ; posbase = 0; }
        else { const int t2 = tt - 1024; b = t2 >> 2; s0 = (t2 & 3) * 64; rowbase = NLAT + b * CTXL; posbase = SEQ; }
#pragma unroll 2
        for (int it = 0; it < 8; ++it) { const int c = rsub + 8 * it;
            const u32x4 v = *(const GAS u32x4*)(HYO + ((size_t)(cb * 64 + c) * NB + b) * SPB + posbase + s0 + cseg * 8); const unsigned a[4] = {v.x, v.y, v.z, v.w};
#pragma unroll
            for (int e = 0; e < 4; ++e) { tile[(cseg * 8 + 2 * e) * 72 + c] = (bf16_t)(a[e] & 0xffffu); tile[(cseg * 8 + 2 * e + 1) * 72 + c] = (bf16_t)(a[e] >> 16); } }
        LDS_WAIT(); asm volatile("" ::: "memory");
#pragma unroll 2
        for (int it = 0; it < 8; ++it) { const int p = rsub + 8 * it;
            const u32x4 v = *(const LAS u32x4*)(tile + p * 72 + cseg * 8);
            *(GAS u32x4*)((bf16_t*)(F.ws + WS_MIX) + (size_t)(rowbase + s0 + p) * DM + 768 + cb * 64 + cseg * 8) = v; }
        LDS_WAIT(); asm volatile("" ::: "memory");
    }
}

constexpr int G2_LAF = 0, G2_LAB = 8448;
constexpr int G2_QTF = 16896, G2_KTF = 22016, G2_QTB = 27136, G2_KTB = 32256;
constexpr int G2_VT = 37376, G2_ATT = 46592;
constexpr int G2_SF = 55808, G2_SB = 60928;
constexpr int G2_SEG = 66048, G2_HALF = 67328;
__device__ __forceinline__ float log_sigmoid_f(float x) { return fminf(x, 0.f) - __logf(1.0f + __expf(-fabsf(x))); }
__device__ __forceinline__ f32x4 mma_lds(const LAS bf16_t* A, int lda, const LAS bf16_t* B, int ldb, int ksteps, f32x4 acc, int lane) {
    const int r = lane & 15, g = lane >> 4;
    for (int ks = 0; ks < ksteps; ++ks) { const bf16x8 a = *(const LAS bf16x8*)(A + r * lda + ks * 32 + 8 * g), b = *(const LAS bf16x8*)(B + r * ldb + ks * 32 + 8 * g); acc = mfma16(a, b, acc); }
    return acc;
}
__device__ __forceinline__ int gla_row0(int b, int cn) { return cn >= 4 ? b * SEQ + (cn - 4) * 64 : NLAT + b * CTXL + cn * 64; }
struct GlaRaw { u32x4 q, k, f, b, v0, v1, g0, g1, s0, s1; };
template <bool FULL>
__device__ __forceinline__ GlaRaw gla_load(Frame& F, int u, int tl) {
    const int h = u & 3, cn = (u >> 2) % 68, b = (u >> 2) / 68, i = tl >> 2, part = tl & 3;
    const bf16_t* p = (const bf16_t*)(F.ws + WS_U) + (size_t)(gla_row0(b, cn) + i) * DIN;
    GlaRaw r;
    r.q = *(const GAS u32x4*)(p + UGQ + h * 32 + part * 8); r.k = *(const GAS u32x4*)(p + UGK + h * 32 + part * 8);
    r.f = *(const GAS u32x4*)(p + ULAF + h * 32 + part * 8); r.b = *(const GAS u32x4*)(p + ULAB + h * 32 + part * 8);
    r.v0 = *(const GAS u32x4*)(p + UGV + h * 64 + part * 16); r.v1 = *(const GAS u32x4*)(p + UGV + h * 64 + part * 16 + 8);
    if (FULL) { r.g0 = *(const GAS u32x4*)(p + UGR + h * 64 + part * 16); r.g1 = *(const GAS u32x4*)(p + UGR + h * 64 + part * 16 + 8);
        const bf16_t* sp = (const bf16_t*)(F.ws + WS_GSIN) + (size_t)u * 2 * 2048 + tl * 16; r.s0 = *(const GAS u32x4*)sp; r.s1 = *(const GAS u32x4*)(sp + 8); }
    else { r.g0 = (u32x4){0u, 0u, 0u, 0u}; r.g1 = r.g0; r.s0 = r.g0; r.s1 = r.g0; }
    return r;
}
template <bool FULL>
__device__ __forceinline__ void gla_prep(Frame& F, LAS unsigned char* L, int l, int u, int tl, const GlaRaw& raw) {
    const int h = u & 3, cn = (u >> 2) % 68, i = tl >> 2, part = tl & 3, d8 = part * 8;
    LAS float* LAF = (LAS float*)(L + G2_LAF); LAS float* LAB = (LAS float*)(L + G2_LAB); LAS bf16_t* VT = (LAS bf16_t*)(L + G2_VT); LAS float* SEG = (LAS float*)(L + G2_SEG);
    float q[8], k[8], tf[8], tb[8];
    unpack8(raw.q, q); unpack8(raw.k, k); unpack8(raw.f, tf); unpack8(raw.b, tb);
    const float* ba = F.in[I_BA2] + (size_t)l * 256 + h * 32 + d8;
#pragma unroll
    for (int e = 0; e < 8; ++e) { q[e] *= 0.17677669529663687f; LAF[i * 33 + d8 + e] = log_sigmoid_f(tf[e] + ba[e]) * 0.0625f; LAB[i * 33 + d8 + e] = log_sigmoid_f(tb[e] + ba[128 + e]) * 0.0625f; }
    if (cn >= 4) {
        const float pos = (part >> 1) ? (float)i : (float)(cn - 4);
#pragma unroll
        for (int e = 0; e < 8; ++e) { const float ang = pos * __expf(-(float)e * (9.210340371976184f / 8.0f)); const float sn = __sinf(ang), cs = __cosf(ang);
            const float qo = shx(q[e], 1, F.lane), ko = shx(k[e], 1, F.lane);
            if (part & 1) { q[e] = qo * sn + q[e] * cs; k[e] = ko * sn + k[e] * cs; } else { q[e] = q[e] * cs - qo * sn; k[e] = k[e] * cs - ko * sn; } }
    }
    { const unsigned a[8] = {raw.v0.x, raw.v0.y, raw.v0.z, raw.v0.w, raw.v1.x, raw.v1.y, raw.v1.z, raw.v1.w};
#pragma unroll
      for (int e = 0; e < 8; ++e) { VT[(part * 16 + 2 * e) * 72 + i] = (bf16_t)(a[e] & 0xffffu); VT[(part * 16 + 2 * e + 1) * 72 + i] = (bf16_t)(a[e] >> 16); } }
    __syncthreads();
    { const int x = tl & 63, d = x & 31, dir = x >> 5, seg = tl >> 6; LAS float* LA = (dir ? LAB : LAF) + d; float cv[16];
#pragma unroll
      for (int kk = 0; kk < 16; ++kk) { const int p = seg * 16 + kk, ti = dir ? 63 - p : p; cv[kk] = LA[ti * 33]; }
#pragma unroll
      for (int kk = 1; kk < 16; ++kk) cv[kk] += cv[kk - 1];
#pragma unroll
      for (int kk = 0; kk < 16; ++kk) { const int p = seg * 16 + kk, ti = dir ? 63 - p : p; LA[ti * 33] = cv[kk]; }
      SEG[x * 5 + seg] = cv[15]; }
    __syncthreads();
    { const int x = tl & 63, d = x & 31, dir = x >> 5, seg = tl >> 6; LAS float* LA = (dir ? LAB : LAF) + d; float cv[16];
      const float t0 = SEG[x * 5 + 0], t1 = SEG[x * 5 + 1], t2 = SEG[x * 5 + 2];
      const float pre = seg == 0 ? 0.f : (seg == 1 ? t0 : (seg == 2 ? t0 + t1 : t0 + t1 + t2));
#pragma unroll
      for (int kk = 0; kk < 16; ++kk) { const int p = seg * 16 + kk, ti = dir ? 63 - p : p; cv[kk] = LA[ti * 33]; }
#pragma unroll
      for (int kk = 0; kk < 16; ++kk) { const int p = seg * 16 + kk, ti = dir ? 63 - p : p; LA[ti * 33] = cv[kk] + pre; } }
    __syncthreads();
    if (FULL) {
        unsigned wqf[4], wkf[4], wqb[4], wkb[4];
#pragma unroll
        for (int e = 0; e < 4; ++e) { const int d = d8 + 2 * e; const float f0 = LAF[i * 33 + d], f1 = LAF[i * 33 + d + 1], b0 = LAB[i * 33 + d], b1 = LAB[i * 33 + d + 1];
            wqf[e] = pk2(q[2 * e] * __expf(f0), q[2 * e + 1] * __expf(f1)); wkf[e] = pk2(k[2 * e] * __expf(-f0), k[2 * e + 1] * __expf(-f1));
            wqb[e] = pk2(q[2 * e] * __expf(b0), q[2 * e + 1] * __expf(b1)); wkb[e] = pk2(k[2 * e] * __expf(-b0), k[2 * e + 1] * __expf(-b1)); }
        *(LAS u32x4*)((LAS bf16_t*)(L + G2_QTF) + i * 40 + d8) = (u32x4){wqf[0], wqf[1], wqf[2], wqf[3]}; *(LAS u32x4*)((LAS bf16_t*)(L + G2_KTF) + i * 40 + d8) = (u32x4){wkf[0], wkf[1], wkf[2], wkf[3]};
        *(LAS u32x4*)((LAS bf16_t*)(L + G2_QTB) + i * 40 + d8) = (u32x4){wqb[0], wqb[1], wqb[2], wqb[3]}; *(LAS u32x4*)((LAS bf16_t*)(L + G2_KTB) + i * 40 + d8) = (u32x4){wkb[0], wkb[1], wkb[2], wkb[3]};
    } else {
        LAS bf16_t* KDF = (LAS bf16_t*)(L + G2_QTF); LAS bf16_t* KDB = (LAS bf16_t*)(L + G2_KTF);
#pragma unroll
        for (int e = 0; e < 8; ++e) { const int d = d8 + e; const float bf = LAF[i * 33 + d], bb = LAB[i * 33 + d], bfl = LAF[63 * 33 + d], bbl = LAB[0 * 33 + d];
            KDF[d * 72 + i] = (bf16_t)f2bf(k[e] * __expf(bfl - bf)); KDB[d * 72 + i] = (bf16_t)f2bf(k[e] * __expf(bbl - bb)); }
    }
    __syncthreads();
}
__device__ __forceinline__ void ph_gla_local(Frame& F, int l) {
    const int hw = F.wave >> 2, wl = F.wave & 3, tl = F.tid & 255; LAS unsigned char* L = F.lds + hw * G2_HALF;
    constexpr int NU = NB * 68 * 4;
    int pp = F.wg;
    GlaRaw raw = gla_load<false>(F, (pp * 2 + hw) < NU ? pp * 2 + hw : 0, tl);
    for (; pp * 2 < NU; pp += F.G) {
        const int u = pp * 2 + hw, un = (pp + F.G) * 2 + hw;
        const GlaRaw nraw = gla_load<false>(F, un < NU ? un : u, tl);
        __syncthreads();
        gla_prep<false>(F, L, l, u, tl, raw);
        const int g = F.lane >> 4, c = F.lane & 15;
        float* DS = (float*)(F.ws + WS_GDS) + (size_t)u * 2 * 2048;
#pragma unroll
        for (int kk = 0; kk < 4; ++kk) { const int tix = wl * 4 + kk, dir = tix >> 3, mt = (tix >> 1) & 3, nt = tix & 1;
            f32x4 a = (f32x4){0.f, 0.f, 0.f, 0.f};
            a = mma_lds((const LAS bf16_t*)(L + G2_VT) + mt * 16 * 72, 72, (const LAS bf16_t*)(L + (dir ? G2_KTF : G2_QTF)) + nt * 16 * 72, 72, 2, a, F.lane);
#pragma unroll
            for (int e = 0; e < 4; ++e) DS[dir * 2048 + (mt * 16 + 4 * g + e) * 32 + nt * 16 + c] = a[e]; }
        if (tl < 64) { const int d = tl & 31, dir = tl >> 5; ((float*)(F.ws + WS_GD))[(size_t)u * 64 + tl] = __expf(dir ? ((LAS float*)(L + G2_LAB))[0 * 33 + d] : ((LAS float*)(L + G2_LAF))[63 * 33 + d]); }
        raw = nraw;
    }
}
__device__ __forceinline__ void ph_gla_scan(Frame& F) {
    const int gt = F.wg * NTHR + F.tid, NGT = F.G * NTHR;
    const float* DS = (const float*)(F.ws + WS_GDS); const float* GD = (const float*)(F.ws + WS_GD); bf16_t* SIN = (bf16_t*)(F.ws + WS_GSIN);
    for (int w = gt; w < 128 * 1024; w += NGT) {
        const int chain = w >> 10, el = (w & 1023) * 2, dir = chain & 1, h = (chain >> 1) & 3, b = chain >> 3, d = el & 31;
        float s0 = 0.f, s1 = 0.f;
        for (int step = 0; step < 68; step += 4) {
            f32x2 ds[4], dd[4]; size_t uu[4];
#pragma unroll
            for (int q = 0; q < 4; ++q) { const int st_ = step + q; const int cn = dir ? (st_ < 4 ? 3 - st_ : 71 - st_) : st_;
                uu[q] = (size_t)(b * 68 + cn) * 4 + h;
                ds[q] = *(const GAS f32x2*)(DS + (uu[q] * 2 + dir) * 2048 + el); dd[q] = *(const GAS f32x2*)(GD + uu[q] * 64 + dir * 32 + d); }
#pragma unroll
            for (int q = 0; q < 4; ++q) { *(GAS unsigned*)(SIN + (uu[q] * 2 + dir) * 2048 + el) = pk2(s0, s1); s0 = dd[q].x * s0 + ds[q].x; s1 = dd[q].y * s1 + ds[q].y; }
        }
    }
}
__device__ __forceinline__ void ph_gla_out(Frame& F, int l, bool last) {
    const int hw = F.wave >> 2, wl = F.wave & 3, tl = F.tid & 255; LAS unsigned char* L = F.lds + hw * G2_HALF;
    const int NV = last ? NB * 64 * 4 : NB * 68 * 4;
#define GLA_UNIT(v) (last ? ((((v) >> 8) * 68 + 4 + (((v) & 255) >> 2)) * 4 + ((v) & 3)) : (v))
    int pp = F.wg;
    GlaRaw raw = gla_load<true>(F, GLA_UNIT((pp * 2 + hw) < NV ? pp * 2 + hw : 0), tl);
    for (; pp * 2 < NV; pp += F.G) {
        const int u = GLA_UNIT(pp * 2 + hw), vn = (pp + F.G) * 2 + hw;
        const GlaRaw nraw = gla_load<true>(F, vn < NV ? GLA_UNIT(vn) : u, tl);
        const int h = u & 3, cn = (u >> 2) % 68, b = (u >> 2) / 68;
        __syncthreads();
        gla_prep<true>(F, L, l, u, tl, raw);
        { const int dir = tl >> 7, dv = (tl >> 1) & 63, d16 = (tl & 1) * 16; LAS bf16_t* S = (LAS bf16_t*)(L + (dir ? G2_SB : G2_SF)) + dv * 40 + d16; *(LAS u32x4*)S = raw.s0; *(LAS u32x4*)(S + 8) = raw.s1; }
        const int g = F.lane >> 4, c = F.lane & 15;
        LAS bf16_t* ATT = (LAS bf16_t*)(L + G2_ATT);
#pragma unroll
        for (int kk = 0; kk < 4; ++kk) { const int tile = wl * 4 + kk, mt = tile >> 2, nt = tile & 3;
            f32x4 af = (f32x4){0.f, 0.f, 0.f, 0.f}, ab = af;
            af = mma_lds((const LAS bf16_t*)(L + G2_QTF) + mt * 16 * 40, 40, (const LAS bf16_t*)(L + G2_KTF) + nt * 16 * 40, 40, 1, af, F.lane);
            ab = mma_lds((const LAS bf16_t*)(L + G2_QTB) + mt * 16 * 40, 40, (const LAS bf16_t*)(L + G2_KTB) + nt * 16 * 40, 40, 1, ab, F.lane);
#pragma unroll
            for (int e = 0; e < 4; ++e) { const int ii = mt * 16 + 4 * g + e, j = nt * 16 + c; const float vv = (j <= ii ? af[e] : 0.f) + (j >= ii ? ab[e] : 0.f); ATT[ii * 72 + j] = (bf16_t)f2bf(vv); } }
        __syncthreads();
        LAS float* O = (LAS float*)(L + G2_LAF);
#pragma unroll
        for (int kk = 0; kk < 4; ++kk) { const int tile = wl * 4 + kk, mt = tile >> 2, nt = tile & 3;
            f32x4 a = (f32x4){0.f, 0.f, 0.f, 0.f};
            a = mma_lds(ATT + mt * 16 * 72, 72, (const LAS bf16_t*)(L + G2_VT) + nt * 16 * 72, 72, 2, a, F.lane);
            a = mma_lds((const LAS bf16_t*)(L + G2_QTF) + mt * 16 * 40, 40, (const LAS bf16_t*)(L + G2_SF) + nt * 16 * 40, 40, 1, a, F.lane);
            a = mma_lds((const LAS bf16_t*)(L + G2_QTB) + mt * 16 * 40, 40, (const LAS bf16_t*)(L + G2_SB) + nt * 16 * 40, 40, 1, a, F.lane);
#pragma unroll
            for (int e = 0; e < 4; ++e) O[(mt * 16 + 4 * g + e) * 65 + nt * 16 + c] = a[e]; }
        __syncthreads();
        { const int i = tl >> 2, dv16 = (tl & 3) * 16; const int row = gla_row0(b, cn) + i;
          float v[16], gt[16]; float ss = 0.f;
#pragma unroll
          for (int e = 0; e < 16; ++e) { v[e] = O[i * 65 + dv16 + e]; ss += v[e] * v[e]; }
          ss += shx(ss, 1, F.lane); ss += shx(ss, 2, F.lane);
          const float rs = 1.0f / sqrtf(ss * (1.0f / 64.0f) + LN_EPS);
          unpack8(raw.g0, gt); unpack8(raw.g1, gt + 8);
          const float* gn = F.in[I_GNORM] + l * 64 + dv16;
          unsigned w[8];
#pragma unroll
          for (int e = 0; e < 8; ++e) w[e] = pk2(v[2 * e] * rs * gn[2 * e] * silu_f(gt[2 * e]), v[2 * e + 1] * rs * gn[2 * e + 1] * silu_f(gt[2 * e + 1]));
          bf16_t* mp = (bf16_t*)(F.ws + WS_MIX) + (size_t)row * DM + 512 + h * 64 + dv16;
          *(GAS u32x4*)mp = (u32x4){w[0], w[1], w[2], w[3]}; *(GAS u32x4*)(mp + 8) = (u32x4){w[4], w[5], w[6], w[7]}; }
        raw = nraw;
    }
#undef GLA_UNIT
}

template <int L>
__device__ __forceinline__ void hyena_conv(Frame& F, const bf16_t* Rg, const bf16_t* Uin, const bf16_t* Xmul, int pos0, bool final_out, int ch, bf16_t* Zout) {
    constexpr int CS = 2 * L + 16;
    constexpr int NTL = L / 16, J = (NTL >= 64) ? 16 : 2, NGRP = NTL / J, HJ = J / 2, NSTEP = L / 32;
    LAS bf16_t* Rl = (LAS bf16_t*)F.lds;
    __syncthreads();
    for (int c = F.tid; c < 2 * L / 8; c += NTHR) { const u32x4 v = *(const GAS u32x4*)(Rg + 8 * c); const unsigned a[4] = {v.x, v.y, v.z, v.w};
#pragma unroll
        for (int rho = 0; rho < 8; ++rho) { LAS bf16_t* d = Rl + rho * CS + 8 * c + rho;
#pragma unroll
            for (int k = 0; k < 4; ++k) { d[2 * k] = (bf16_t)(a[k] & 0xffffu); d[2 * k + 1] = (bf16_t)(a[k] >> 16); } } }
    __syncthreads();
    int ln_ = F.lane; asm volatile("" : "+v"(ln_));
    const int i = ln_ & 15, g = ln_ >> 4, rho = i & 7;
    const LAS bf16_t* Rc = Rl + rho * CS + rho;
    for (int grp = F.wave; grp < NGRP; grp += NWAVES) {
        f32x4 acc[J]; bf16x8 fr[J];
        const int tb = grp * J * 16;
        const LAS bf16_t* Rb = Rc + (L - tb - i + 8 * g);
#pragma unroll
        for (int j = 0; j < J; ++j) { acc[j] = (f32x4){0.f, 0.f, 0.f, 0.f}; fr[j] = *(const LAS bf16x8*)(Rb - 16 * j); }
        const char* ub = (const char*)(Uin + pos0); const unsigned ulo = (unsigned)((i * SPB + 8 * g) * 2);
        constexpr int PF = (HJ >= 4) ? 4 : 1;
        bf16x8 bq[PF];
#pragma unroll
        for (int p = 0; p < PF; ++p) bq[p] = *(const GAS bf16x8*)(ub + (size_t)(ulo + (unsigned)p * 64u));
        u32x2 xw[J];
#pragma unroll
        for (int j = 0; j < J; ++j) xw[j] = *(const GAS u32x2*)(Xmul + (size_t)i * SPB + pos0 + tb + j * 16 + 4 * g);
#pragma unroll 1
        for (int q = 0; q < NSTEP / HJ; ++q) {
#pragma unroll
            for (int m = 0; m < HJ; ++m) {
                const int n = q * HJ + m;
                const int nn = (n + PF < NSTEP) ? n + PF : 0;
                if (n > 0) { fr[(J - 2 * m) % J] = *(const LAS bf16x8*)(Rb + 32 * n); fr[(J + 1 - 2 * m) % J] = *(const LAS bf16x8*)(Rb + 32 * n - 16); }
                const bf16x8 bcur = bq[m % PF];
#pragma unroll
                for (int jj = 0; jj < J; ++jj) { const int j = (jj + 2) % J; acc[j] = mfma16(fr[(j + J - 2 * m) % J], bcur, acc[j]); }
                bq[m % PF] = *(const GAS bf16x8*)(ub + (size_t)(ulo + (unsigned)nn * 64u));
            }
        }
#pragma unroll
        for (int j = 0; j < J; ++j) { const int t0 = tb + j * 16 + 4 * g;
            const float y0 = acc[j][0] * bflo(xw[j].x), y1 = acc[j][1] * bfhi(xw[j].x), y2 = acc[j][2] * bflo(xw[j].y), y3 = acc[j][3] * bfhi(xw[j].y);
            if (!final_out) { u32x2 w; w.x = pk2(y0, y1); w.y = pk2(y2, y3); *(GAS u32x2*)(Zout + (size_t)i * SPB + pos0 + t0) = w; }
            else { u32x2 w; w.x = pk2(y0, y1); w.y = pk2(y2, y3); *(GAS u32x2*)((bf16_t*)(F.ws + WS_Y) + ((size_t)ch * NB + i) * SPB + pos0 + t0) = w; } }
    }
}
__device__ __forceinline__ void ph_hyena(Frame& F, int l, bool last) {
    const bf16_t* HV = (const bf16_t*)(F.ws + WS_HV); bf16_t* Z2 = (bf16_t*)(F.ws + WS_Z2);
    for (int ch = F.wg; ch < 256; ch += F.G) {
        const bf16_t* v = HV + (size_t)(0 * 256 + ch) * NB * SPB; const bf16_t* x1 = HV + (size_t)(256 + ch) * NB * SPB; const bf16_t* x2 = HV + (size_t)(512 + ch) * NB * SPB;
        bf16_t* z = Z2 + (size_t)ch * NB * SPB;
        const bf16_t* R0 = (const bf16_t*)(F.ws + WS_HYF) + ((size_t)(l * 2 + 0) * 256 + ch) * 8192; const bf16_t* R1 = (const bf16_t*)(F.ws + WS_HYF) + ((size_t)(l * 2 + 1) * 256 + ch) * 8192;
        hyena_conv<4096>(F, R0, v, x1, 0, false, ch, z);
        VM_WAIT(); __syncthreads(); __builtin_amdgcn_fence(__ATOMIC_ACQUIRE, "agent"); VM_WAIT();
        hyena_conv<4096>(F, R1, z, x2, 0, true, ch, z);
        if (!last) {
            const bf16_t* C0 = (const bf16_t*)(F.ws + WS_HYFC) + ((size_t)(l * 2 + 0) * 256 + ch) * 512; const bf16_t* C1 = (const bf16_t*)(F.ws + WS_HYFC) + ((size_t)(l * 2 + 1) * 256 + ch) * 512;
            hyena_conv<256>(F, C0, v, x1, SEQ, false, ch, z);
            VM_WAIT(); __syncthreads(); __builtin_amdgcn_fence(__ATOMIC_ACQUIRE, "agent"); VM_WAIT();
            hyena_conv<256>(F, C1, z, x2, SEQ, true, ch, z);
        }
    }
}

__device__ __forceinline__ void ph_ln1(Frame& F, int l, int ntok) {
    const int gw = F.wg * NWAVES + F.wave, NGW = F.G * NWAVES;
    const int cA = 256 * (F.lane >> 4) + 32 * ((F.lane >> 2) & 3) + 8 * (F.lane & 3);
#define LN1_COL(j) (cA + ((j) < 2 ? 4 * (j) : 128 + 4 * ((j) - 2)))
    const float* lg = F.in[I_LN1G] + l * DM; const float* lb = F.in[I_LN1B] + l * DM;
    for (int row = gw; row < ntok; row += NGW) {
        bf16_t* xr = (bf16_t*)(F.ws + WS_XR) + (size_t)row * DM;
        const unsigned char* yr = (const unsigned char*)(F.ws + WS_Y) + (size_t)row * DM + 16 * F.lane;
        const float* md = mod_ptr(F, l, row);
        const u32x4 xa = __builtin_nontemporal_load((const GAS u32x4*)(xr + cA)), xb = __builtin_nontemporal_load((const GAS u32x4*)(xr + cA + 128)), ya = __builtin_nontemporal_load((const GAS u32x4*)yr);
        float x[16], y[16], v[16]; unpack8(xa, x); unpack8(xb, x + 8);
        { const unsigned a[4] = {ya.x, ya.y, ya.z, ya.w};
#pragma unroll
          for (int e = 0; e < 4; ++e) { const f32x2 lo = __builtin_amdgcn_cvt_pk_f32_fp8((int)a[e], false), hi = __builtin_amdgcn_cvt_pk_f32_fp8((int)a[e], true); y[4 * e] = lo.x; y[4 * e + 1] = lo.y; y[4 * e + 2] = hi.x; y[4 * e + 3] = hi.y; } }
        float s = 0.f;
#pragma unroll
        for (int j = 0; j < 4; ++j) { const f32x4 g1 = *(const GAS f32x4*)(md + 2048 + LN1_COL(j));
#pragma unroll
            for (int e = 0; e < 4; ++e) { v[4 * j + e] = x[4 * j + e] * DN_ALPHA + g1[e] * y[4 * j + e]; s += v[4 * j + e]; } }
        const float mean = wave_sum(s, F.lane) * (1.f / DM); float s2 = 0.f;
#pragma unroll
        for (int e = 0; e < 16; ++e) { v[e] -= mean; s2 += v[e] * v[e]; }
        const float rstd = 1.f / sqrtf(wave_sum(s2, F.lane) * (1.f / DM) + LN_EPS);
        unsigned wx[8]; int w8[4];
#pragma unroll
        for (int j = 0; j < 4; ++j) { const f32x4 g = *(const GAS f32x4*)(lg + LN1_COL(j)), bb = *(const GAS f32x4*)(lb + LN1_COL(j)), sh = *(const GAS f32x4*)(md + 3072 + LN1_COL(j)), sc = *(const GAS f32x4*)(md + 4096 + LN1_COL(j));
            float xn[4];
#pragma unroll
            for (int e = 0; e < 4; ++e) xn[e] = v[4 * j + e] * rstd * g[e] + bb[e];
            wx[2 * j] = pk2(xn[0], xn[1]); wx[2 * j + 1] = pk2(xn[2], xn[3]);
            const float h0 = xn[0] * (1.f + sc[0]) + sh[0], h1 = xn[1] * (1.f + sc[1]) + sh[1], h2 = xn[2] * (1.f + sc[2]) + sh[2], h3 = xn[3] * (1.f + sc[3]) + sh[3];
            int v = 0; v = __builtin_amdgcn_cvt_pk_fp8_f32(h0, h1, v, false); v = __builtin_amdgcn_cvt_pk_fp8_f32(h2, h3, v, true); w8[j] = v; }
        unsigned char* x8 = (unsigned char*)(F.ws + WS_XM8) + (size_t)row * DM;
        *(GAS u32x2*)(x8 + cA) = (u32x2){(unsigned)w8[0], (unsigned)w8[1]}; *(GAS u32x2*)(x8 + cA + 128) = (u32x2){(unsigned)w8[2], (unsigned)w8[3]};
        *(GAS u32x4*)(xr + cA) = (u32x4){wx[0], wx[1], wx[2], wx[3]}; *(GAS u32x4*)(xr + cA + 128) = (u32x4){wx[4], wx[5], wx[6], wx[7]};
    }
#undef LN1_COL
}
__device__ __forceinline__ void ph_ln2(Frame& F, int l, int ntok, bool last) {
    const int gw = F.wg * NWAVES + F.wave, NGW = F.G * NWAVES;
    const int cA = 256 * (F.lane >> 4) + 32 * ((F.lane >> 2) & 3) + 8 * (F.lane & 3);
#define LN2_COL(j) (cA + ((j) < 2 ? 4 * (j) : 128 + 4 * ((j) - 2)))
    const float* lg = F.in[I_LN2G] + l * DM; const float* lb = F.in[I_LN2B] + l * DM;
    struct Ln2Raw { u32x2 q[8]; u32x4 qs, xa, xb; };
    auto ln2_load = [&](int row) { Ln2Raw r;
        const unsigned char* y2 = (const unsigned char*)(F.ws + WS_Y2) + (size_t)row * 5120;
        const bf16_t* xr = (const bf16_t*)(F.ws + WS_XR) + (size_t)row * DM;
#pragma unroll
        for (int k = 0; k < 8; ++k) r.q[k] = __builtin_nontemporal_load((const GAS u32x2*)(y2 + k * 512 + 8 * F.lane));
        r.qs = __builtin_nontemporal_load((const GAS u32x4*)(y2 + 4096 + 16 * F.lane));
        r.xa = __builtin_nontemporal_load((const GAS u32x4*)(xr + cA)); r.xb = __builtin_nontemporal_load((const GAS u32x4*)(xr + cA + 128));
        return r; };
    Ln2Raw cur = ln2_load(gw < ntok ? gw : 0);
    for (int row = gw; row < ntok; row += NGW) {
        const Ln2Raw nxt = ln2_load(row + NGW < ntok ? row + NGW : row);
        bf16_t* xr = (bf16_t*)(F.ws + WS_XR) + (size_t)row * DM;
        const float* wg = (const float*)(F.ws + WS_WGT) + (size_t)row * 8;
        const float* md = mod_ptr(F, l, row);
        float ff[16];
#pragma unroll
        for (int e = 0; e < 16; ++e) ff[e] = 0.f;
        { const unsigned a[4] = {cur.qs.x, cur.qs.y, cur.qs.z, cur.qs.w};
#pragma unroll
          for (int e = 0; e < 4; ++e) { const f32x2 lo = __builtin_amdgcn_cvt_pk_f32_fp8((int)a[e], false), hi = __builtin_amdgcn_cvt_pk_f32_fp8((int)a[e], true);
              ff[4 * e] += pg8::Y2_INV * lo.x; ff[4 * e + 1] += pg8::Y2_INV * lo.y; ff[4 * e + 2] += pg8::Y2_INV * hi.x; ff[4 * e + 3] += pg8::Y2_INV * hi.y; } }
#pragma unroll
        for (int k = 0; k < 8; ++k) { const float wk = wg[k] * pg8::Y2_INV; const unsigned a[2] = {cur.q[k].x, cur.q[k].y};
#pragma unroll
            for (int h = 0; h < 2; ++h) {
                const f32x2 p0 = __builtin_amdgcn_cvt_scalef32_pk_f32_fp4(a[h], 1.0f, 0), p1 = __builtin_amdgcn_cvt_scalef32_pk_f32_fp4(a[h], 1.0f, 1), p2 = __builtin_amdgcn_cvt_scalef32_pk_f32_fp4(a[h], 1.0f, 2), p3 = __builtin_amdgcn_cvt_scalef32_pk_f32_fp4(a[h], 1.0f, 3);
                ff[8 * h] += wk * p0.x; ff[8 * h + 1] += wk * p0.y; ff[8 * h + 2] += wk * p1.x; ff[8 * h + 3] += wk * p1.y; ff[8 * h + 4] += wk * p2.x; ff[8 * h + 5] += wk * p2.y; ff[8 * h + 6] += wk * p3.x; ff[8 * h + 7] += wk * p3.y; } }
        float v[16], xo[16]; float s = 0.f;
        unpack8(cur.xa, xo); unpack8(cur.xb, xo + 8);
#pragma unroll
        for (int j = 0; j < 4; ++j) { const f32x4 g2 = *(const GAS f32x4*)(md + 5120 + LN2_COL(j));
#pragma unroll
            for (int e = 0; e < 4; ++e) { v[4 * j + e] = xo[4 * j + e] * DN_ALPHA + g2[e] * ff[4 * j + e]; s += v[4 * j + e]; } }
        const float mean = wave_sum(s, F.lane) * (1.f / DM); float s2 = 0.f;
#pragma unroll
        for (int e = 0; e < 16; ++e) { v[e] -= mean; s2 += v[e] * v[e]; }
        const float rstd = 1.f / sqrtf(wave_sum(s2, F.lane) * (1.f / DM) + LN_EPS);
        const float* mdn = last ? md : mod_ptr(F, l + 1, row);
        float xn[16];
#pragma unroll
        for (int j = 0; j < 4; ++j) { const f32x4 g = *(const GAS f32x4*)(lg + LN2_COL(j)), bb = *(const GAS f32x4*)(lb + LN2_COL(j));
#pragma unroll
            for (int e = 0; e < 4; ++e) xn[4 * j + e] = v[4 * j + e] * rstd * g[e] + bb[e]; }
        if (last) { float* op = F.out + (size_t)row * DM;
#pragma unroll
            for (int j = 0; j < 4; ++j) *(GAS f32x4*)(op + LN2_COL(j)) = (f32x4){xn[4 * j], xn[4 * j + 1], xn[4 * j + 2], xn[4 * j + 3]}; }
        else {
            *(GAS u32x4*)(xr + cA) = (u32x4){pk2(xn[0], xn[1]), pk2(xn[2], xn[3]), pk2(xn[4], xn[5]), pk2(xn[6], xn[7])}; *(GAS u32x4*)(xr + cA + 128) = (u32x4){pk2(xn[8], xn[9]), pk2(xn[10], xn[11]), pk2(xn[12], xn[13]), pk2(xn[14], xn[15])};
            bf16_t* xm = (bf16_t*)(F.ws + WS_XM) + (size_t)row * DM;
            unsigned w[8];
#pragma unroll
            for (int j = 0; j < 4; ++j) { const f32x4 sh = *(const GAS f32x4*)(mdn + LN2_COL(j)), sc = *(const GAS f32x4*)(mdn + 1024 + LN2_COL(j));
                w[2 * j] = pk2(xn[4 * j] * (1.f + sc[0]) + sh[0], xn[4 * j + 1] * (1.f + sc[1]) + sh[1]); w[2 * j + 1] = pk2(xn[4 * j + 2] * (1.f + sc[2]) + sh[2], xn[4 * j + 3] * (1.f + sc[3]) + sh[3]); }
            *(GAS u32x4*)(xm + cA) = (u32x4){w[0], w[1], w[2], w[3]}; *(GAS u32x4*)(xm + cA + 128) = (u32x4){w[4], w[5], w[6], w[7]};
        }
        cur = nxt;
    }
#undef LN2_COL
}

__device__ __forceinline__ unsigned f_ord(float f) { const unsigned u = __builtin_bit_cast(unsigned, f); return (u & 0x80000000u) ? ~u : (u | 0x80000000u); }
__device__ __forceinline__ unsigned long long wave_max_u64(unsigned long long v, int lane) {
#pragma unroll
    for (int o = 1; o < 64; o <<= 1) { const unsigned lo = (unsigned)shxi((int)(unsigned)v, o, lane), hi = (unsigned)shxi((int)(unsigned)(v >> 32), o, lane); const unsigned long long w = ((unsigned long long)hi << 32) | lo; v = w > v ? w : v; }
    return v;
}
__device__ __forceinline__ float seg16_max(float v, int lane) { v = fmaxf(v, shx(v, 1, lane)); v = fmaxf(v, shx(v, 2, lane)); v = fmaxf(v, shx(v, 4, lane)); v = fmaxf(v, shx(v, 8, lane)); return v; }
__device__ __forceinline__ int seg16_min_i(int v, int lane) { int w; w = shxi(v, 1, lane); v = w < v ? w : v; w = shxi(v, 2, lane); v = w < v ? w : v; w = shxi(v, 4, lane); v = w < v ? w : v; w = shxi(v, 8, lane); v = w < v ? w : v; return v; }
template <int CTRL> __device__ __forceinline__ int dpp_i(int v) { return __builtin_amdgcn_update_dpp(0, v, CTRL, 0xf, 0xf, true); }
__device__ __forceinline__ unsigned row_max_u(unsigned v) { unsigned w; w = (unsigned)dpp_i<0xB1>((int)v); v = w > v ? w : v; w = (unsigned)dpp_i<0x4E>((int)v); v = w > v ? w : v; w = (unsigned)dpp_i<0x141>((int)v); v = w > v ? w : v; w = (unsigned)dpp_i<0x140>((int)v); v = w > v ? w : v; return v; }
__device__ __forceinline__ float row_max_f(float v) { v = fmaxf(v, __builtin_bit_cast(float, dpp_i<0xB1>(__builtin_bit_cast(int, v)))); v = fmaxf(v, __builtin_bit_cast(float, dpp_i<0x4E>(__builtin_bit_cast(int, v)))); v = fmaxf(v, __builtin_bit_cast(float, dpp_i<0x141>(__builtin_bit_cast(int, v)))); v = fmaxf(v, __builtin_bit_cast(float, dpp_i<0x140>(__builtin_bit_cast(int, v)))); return v; }
__device__ __forceinline__ int row_min_i(int v) { int w; w = dpp_i<0xB1>(v); v = w < v ? w : v; w = dpp_i<0x4E>(v); v = w < v ? w : v; w = dpp_i<0x141>(v); v = w < v ? w : v; w = dpp_i<0x140>(v); v = w < v ? w : v; return v; }
__device__ __forceinline__ float rdlane_f(float v, int l) { return __builtin_bit_cast(float, __builtin_amdgcn_readlane(__builtin_bit_cast(int, v), l)); }
__device__ __forceinline__ unsigned wave_max_u(unsigned v) {
    v = row_max_u(v);
    const unsigned a = (unsigned)__builtin_amdgcn_readlane((int)v, 0), b = (unsigned)__builtin_amdgcn_readlane((int)v, 16), c = (unsigned)__builtin_amdgcn_readlane((int)v, 32), d = (unsigned)__builtin_amdgcn_readlane((int)v, 48);
    const unsigned ab = a > b ? a : b, cd = c > d ? c : d; return ab > cd ? ab : cd;
}
__device__ __forceinline__ float row_top2(float v, int l16) {
    const float m1 = row_max_f(v);
    const int first = row_min_i(v == m1 ? l16 : 99);
    const float m2 = row_max_f(l16 == first ? -3.0e38f : v);
    return m1 + m2;
}
__device__ __forceinline__ float seg16_top2(float v, int lane) {
    const float m1 = seg16_max(v, lane);
    const int first = seg16_min_i(v == m1 ? (lane & 15) : 99, lane);
    const float m2 = seg16_max((lane & 15) == first ? -3.0e38f : v, lane);
    return m1 + m2;
}
__device__ __forceinline__ void ph_route(Frame& F, int l, int ntok) {
    LAS int* hist = (LAS int*)F.lds;
    LAS int* base = hist + 128;
    LAS unsigned* alist = (LAS unsigned*)(F.lds + 1024);
    const int tpw = (ntok + F.G - 1) / F.G, t0 = F.wg * tpw, t1 = (t0 + tpw) < ntok ? (t0 + tpw) : ntok;
    __syncthreads();
    if (F.tid < 128) hist[F.tid] = 0;
    __syncthreads();
    const float* LG = (const float*)(F.ws + WS_LOGIT); const float* rb = F.in[I_RB] + l * NEXP;
    const float b0 = rb[F.lane], b1 = rb[F.lane + 64];
    constexpr int RT = 4;
    for (int tb = t0 + F.wave * RT; tb < t1; tb += NWAVES * RT) {
        float s0[RT], s1[RT], e0[RT], e1[RT], gs0[RT], gs1[RT]; unsigned h0[RT], h1[RT]; int mye[RT]; float myw[RT], wsum[RT];
#pragma unroll
        for (int j = 0; j < RT; ++j) { const int tok = (tb + j) < t1 ? tb + j : t1 - 1;
            const float x0 = LG[(size_t)tok * 256 + F.lane], x1 = LG[(size_t)tok * 256 + 64 + F.lane];
            const float* rbs = (const float*)(F.ws + WS_RBIAS) + (size_t)(l * 17 + row_b(tok)) * 128; const float y0 = x0 + rbs[F.lane], y1 = x1 + rbs[64 + F.lane];
            s0[j] = __builtin_amdgcn_rcpf(1.0f + __expf(-y0)); s1[j] = __builtin_amdgcn_rcpf(1.0f + __expf(-y1)); e0[j] = s0[j] + b0; e1[j] = s1[j] + b1; }
#pragma unroll
        for (int j = 0; j < RT; ++j) { gs0[j] = row_top2(e0[j], F.lane & 15); gs1[j] = row_top2(e1[j], F.lane & 15); }
#pragma unroll
        for (int j = 0; j < RT; ++j) {
            float gsc[8];
#pragma unroll
            for (int g = 0; g < 4; ++g) { gsc[g] = rdlane_f(gs0[j], g * 16); gsc[4 + g] = rdlane_f(gs1[j], g * 16); }
            unsigned gmask = 0u;
#pragma unroll
            for (int g = 0; g < 8; ++g) { int cnt = 0;
#pragma unroll
                for (int g2 = 0; g2 < 8; ++g2) cnt += (gsc[g2] > gsc[g] || (gsc[g2] == gsc[g] && g2 < g)) ? 1 : 0;
                gmask |= (cnt < 4) ? (1u << g) : 0u; }
            const bool ok0 = (gmask >> (F.lane >> 4)) & 1u, ok1 = (gmask >> (4 + (F.lane >> 4))) & 1u;
            h0[j] = ok0 ? f_ord(e0[j]) : 0u; h1[j] = ok1 ? f_ord(e1[j]) : 0u;
            mye[j] = 0; myw[j] = 0.f; wsum[j] = 0.f; }
#pragma unroll
        for (int k = 0; k < 8; ++k) {
#pragma unroll
            for (int j = 0; j < RT; ++j) {
                const unsigned bh = h0[j] >= h1[j] ? h0[j] : h1[j];
                const unsigned H = wave_max_u(bh);
                const unsigned mylo = h0[j] == H ? (unsigned)(255 - F.lane) : (h1[j] == H ? (unsigned)(255 - 64 - F.lane) : 0u);
                const unsigned Lm = wave_max_u(mylo);
                const int e = 255 - (int)Lm;
                if (e < 64) { if (F.lane == e) h0[j] = 0u; } else { if (F.lane == e - 64) h1[j] = 0u; }
                const float sv = e < 64 ? rdlane_f(s0[j], e) : rdlane_f(s1[j], e - 64);
                wsum[j] += sv; if (F.lane == k) { mye[j] = e; myw[j] = sv; } }
        }
#pragma unroll
        for (int j = 0; j < RT; ++j) { const int tok = tb + j;
            if (tok < t1 && F.lane < 8) {
                const int lr = __hip_atomic_fetch_add(&hist[mye[j]], 1, __ATOMIC_RELAXED, __HIP_MEMORY_SCOPE_WORKGROUP);
                alist[(tok - t0) * 8 + F.lane] = (unsigned)mye[j] | ((unsigned)lr << 8);
                ((int*)(F.ws + WS_EIDX))[(size_t)tok * 8 + F.lane] = mye[j];
                ((float*)(F.ws + WS_WGT))[(size_t)tok * 8 + F.lane] = myw[j] / wsum[j] * 2.5f;
            } }
    }
    __syncthreads();
    if (F.tid < 128) { const int hcount = hist[F.tid]; base[F.tid] = hcount ? (int)atomicAdd(F.ctl + CW_CNT + l * 256 + F.tid, (unsigned)hcount) : 0; }
    __syncthreads();
    for (int a = F.tid; a < (t1 - t0) * 8; a += NTHR) { const unsigned v = alist[a]; ((int*)(F.ws + WS_RNK))[(size_t)t0 * 8 + a] = base[v & 0xffu] + (int)(v >> 8); }
}
__device__ __forceinline__ void ph_positions(Frame& F, int l, int ntok) {
    LAS int* cnt = (LAS int*)F.lds;
    LAS int* off = cnt + 132;
    __syncthreads();
    if (F.tid < NE1) cnt[F.tid] = F.tid < NEXP ? (int)__hip_atomic_load(F.ctl + CW_CNT + l * 256 + F.tid, __ATOMIC_RELAXED, __HIP_MEMORY_SCOPE_AGENT) : ntok;
    __syncthreads();
    if (F.tid == 0) { int o = 0; for (int e = 0; e < NE1; ++e) { off[e] = o; o += (cnt[e] + 255) & ~255; } off[NE1] = o; }
    __syncthreads();
    const int gt = F.wg * NTHR + F.tid, NGT = F.G * NTHR;
    int* rowtok = (int*)(F.ws + WS_ROWTOK); int* rowdst = (int*)(F.ws + WS_ROWDST); int* tile_exp = (int*)(F.ws + WS_TILEEXP);
    const int* eidx = (const int*)(F.ws + WS_EIDX); const int* rnk = (const int*)(F.ws + WS_RNK);
    for (int a = gt; a < ntok * 8; a += NGT) { const int tok = a >> 3, k = a & 7; const int pos = off[eidx[a]] + rnk[a]; rowtok[pos] = tok; rowdst[pos] = tok * 10 + k; }
    for (int tok = gt; tok < ntok; tok += NGT) { const int pos = off[NEXP] + tok; rowtok[pos] = tok; rowdst[pos] = tok * 10 + 8; }
    for (int i = gt; i < NE1 * 256; i += NGT) { const int e = i >> 8, p = i & 255; const int row = off[e] + cnt[e] + p; if (row < off[e + 1]) { rowtok[row] = 0; rowdst[row] = -1; } }
    for (int i = gt; i < NE1 * 320; i += NGT) { const int e = i / 320, p = i % 320; const int t = (off[e] >> 8) + p; if (t < (off[e + 1] >> 8)) tile_exp[t] = e; }
    if (gt == 0) F.ctl[CW_NTL + l] = (unsigned)(off[NE1] >> 8);
}

#ifndef MK_MULTI
#define MK_MULTI 0
#endif
constexpr int PH_PER_LAYER = 12, NPHASE = 2 + DEPTH * PH_PER_LAYER;
struct Args { const float* in[36]; float* out; unsigned char* ws; int ph_lo, ph_hi; };

__global__ void __launch_bounds__(NTHR, 2) mk_fwd(Args args) {
    extern __shared__ __attribute__((aligned(16))) unsigned char lds_raw[];
    Frame F;
    F.lds = (LAS unsigned char*)lds_raw;
    F.tid = threadIdx.x; F.lane = F.tid & 63; F.wave = __builtin_amdgcn_readfirstlane(F.tid >> 6);
    const int wave0 = F.wave;
    F.G = gridDim.x; F.wg = blockIdx.x;
    F.in = args.in;
    F.out = args.out; F.ws = args.ws; F.ctl = (unsigned*)(args.ws + WS_CTL);
    volatile LAS unsigned* MISC = (volatile LAS unsigned*)(F.lds + MISC_OFF);
    if (F.tid < 32) MISC[F.tid] = 0u;
    __syncthreads();
    const int lo = args.ph_lo, hi = args.ph_hi;
    const bool single = (hi - lo) > 1;
    XcdBarrier bar; bar.bar = F.ctl + CW_BAR; bar.x = 0; bar.st = nullptr;
    if (single) bar = xcd_barrier_post(F.ctl + CW_BAR, MISC + 8);
#define IN(k) (lo <= (k) && (k) < hi)
#ifndef PROBE_MASK
#define PROBE_MASK 0
#endif
#define REP(k) for (int _rep = 0; _rep < (((PROBE_MASK >> (k)) & 1) ? 2 : 1); ++_rep)
#define SEAM(k) do { if (IN(k) && IN((k) + 1)) { xcd_barrier(bar); if ((PROBE_MASK >> 15) & 1) xcd_barrier(bar); } } while (0)
#define FRESH() do { int _ln; asm volatile("v_mbcnt_lo_u32_b32 %0, -1, 0\n\tv_mbcnt_hi_u32_b32 %0, -1, %0" : "=v"(_ln)); int _wv = wave0; asm volatile("" : "+s"(_wv)); F.lane = _ln; F.wave = _wv; F.tid = (_wv << 6) | _ln; \
        unsigned char* _w = args.ws; asm volatile("" : "+s"(_w)); F.ws = _w; F.ctl = (unsigned*)(_w + WS_CTL); float* _o = args.out; asm volatile("" : "+s"(_o)); F.out = _o; } while (0)

    if (IN(0)) { FRESH(); REP(13) { p0_static_weights(F); __syncthreads(); } REP(14) { p0_mod(F); __syncthreads(); } FRESH(); REP(16) { p0_hyena_filters(F); __syncthreads(); } }
    SEAM(0);
    if (IN(1)) { FRESH(); p0_init_rows(F); __syncthreads(); FRESH(); p1_router_weights(F); }
    SEAM(1);
#pragma unroll 1
    for (int l = 0; l < DEPTH; ++l) {
        const int pb = 2 + l * PH_PER_LAYER; const bool last = (l == DEPTH - 1); const int ntok = last ? NLAT : NROW;
        if (IN(pb + 0)) { FRESH();
            REP(0) { p_expert_weights(F, l, (last || F.G != 256) ? 0 : XW_TAIL_G, XW_ITEMS, F.G * NWAVES, F.wg * NWAVES + F.wave); __syncthreads(); }
            { pg8::ColMapOrder S; S.b.init(NROW, 11 * 256, F.G, F.wg); S.map = 0xCBA98763210ull; pg8::EpiBf16 E{(bf16_t*)(F.ws + WS_U), DIN};
              REP(1) pg8::gemm_phase<pg8::EpiBf16, pg8::ColMapOrder, false>(F.tid, F.lds, (const bf16_t*)(F.ws + WS_XM), (const bf16_t*)(F.ws + WS_WIN) + (size_t)l * DIN * DM, DM, nullptr, S, E); }
            __syncthreads(); FRESH();
            { pg8::ColMapOrder S; S.b.init(NROW, 2 * 256, F.G, (F.wg + 80) % F.G); S.map = 0x54ull; pg8::EpiVT E{(bf16_t*)(F.ws + WS_VT), UV};
              REP(1) pg8::gemm_phase<pg8::EpiVT, pg8::ColMapOrder, false, false, true, true, false, true>(F.tid, F.lds, (const bf16_t*)(F.ws + WS_XM), (const bf16_t*)(F.ws + WS_WIN) + (size_t)l * DIN * DM, DM, nullptr, S, E); }
        }
        SEAM(pb + 0);
        if (IN(pb + 1)) { FRESH(); REP(2) { ph_transposes(F, l); __syncthreads(); } FRESH(); REP(3) { ph_gla_local(F, l); __syncthreads(); } }
        SEAM(pb + 1);
        if (IN(pb + 2)) { FRESH(); REP(4) { ph_na(F, l, last); } FRESH(); REP(5) { ph_gla_scan(F); } __syncthreads(); FRESH(); REP(6) { ph_hyena(F, l, last); } }
        SEAM(pb + 2);
        if (IN(pb + 3)) { FRESH(); ph_hy_transpose(F, last); __syncthreads(); FRESH(); REP(7) { ph_gla_out(F, l, last); } }
        SEAM(pb + 3);
        if (IN(pb + 4)) { FRESH();
            pg8::DenseOrder S; S.init(ntok, DM, F.G, F.wg); pg8::EpiY8 E{(unsigned char*)(F.ws + WS_Y), DM};
            REP(8) pg8::gemm_phase<pg8::EpiY8, pg8::DenseOrder, false>(F.tid, F.lds, (const bf16_t*)(F.ws + WS_MIX), (const bf16_t*)(F.ws + WS_WOUT) + (size_t)l * DM * DM, DM, nullptr, S, E);
            if (!last && F.G == 256 && F.wg >= 64) { __syncthreads(); FRESH(); p_expert_weights(F, l, 0, XW_TAIL_E, 192 * NWAVES, (F.wg - 64) * NWAVES + F.wave); }
        }
        SEAM(pb + 4);
        if (IN(pb + 5)) { FRESH(); ph_ln1(F, l, ntok); }
        SEAM(pb + 5);
        if (IN(pb + 6)) { FRESH();
            pg8::RouterOrder S; S.b.init(ntok, 256, F.G, F.wg); pg8::EpiF32H E{(float*)(F.ws + WS_LOGIT), 256};
            REP(9) pg8::gemm_phase<pg8::EpiF32H, pg8::RouterOrder, false, false, true, true, true>(F.tid, F.lds, (const bf16_t*)(F.ws + WS_XR), (const bf16_t*)(F.ws + WS_WRB) + (size_t)l * 17 * 128 * DM, DM, nullptr, S, E);
            if (!last && F.G == 256 && F.wg >= 16) { __syncthreads(); FRESH(); p_expert_weights(F, l, XW_TAIL_E, XW_TAIL_G, 240 * NWAVES, (F.wg - 16) * NWAVES + F.wave); }
        }
        SEAM(pb + 6);
        if (IN(pb + 7)) { FRESH(); ph_route(F, l, ntok); }
        SEAM(pb + 7);
        if (IN(pb + 8)) { FRESH(); REP(12) { ph_positions(F, l, ntok); __syncthreads(); } }
        SEAM(pb + 8);
        if (IN(pb + 9)) { FRESH();
            const int ntl = (int)__hip_atomic_load(F.ctl + CW_NTL + l, __ATOMIC_RELAXED, __HIP_MEMORY_SCOPE_AGENT);
            pg8::GroupedOrder S; S.init(ntl, 2, F.G, F.wg); S.preload((const int*)(F.ws + WS_TILEEXP), F.lds + pg8::STAGE_BYTES + 4096, F.tid, NTHR); pg8::EpiSwiglu E{(unsigned char*)(F.ws + WS_ACT)};
            REP(10) pg8::gemm_phase<pg8::EpiSwiglu, pg8::GroupedOrder, true, true>(F.tid, F.lds, (const void*)(F.ws + WS_XM8), (const void*)(F.ws + WS_EXP1), DM, (const int*)(F.ws + WS_ROWTOK), S, E);
        }
        SEAM(pb + 9);
        if (IN(pb + 10)) { FRESH();
            const int ntl = (int)__hip_atomic_load(F.ctl + CW_NTL + l, __ATOMIC_RELAXED, __HIP_MEMORY_SCOPE_AGENT);
            pg8::GroupedOrder S; S.init(ntl, 4, F.G, F.wg); S.preload((const int*)(F.ws + WS_TILEEXP), F.lds + pg8::STAGE_BYTES + 4096, F.tid, NTHR); pg8::EpiScatter E{(unsigned char*)(F.ws + WS_Y2), (const int*)(F.ws + WS_ROWDST)};
            REP(11) pg8::gemm_phase<pg8::EpiScatter, pg8::GroupedOrder, false, true>(F.tid, F.lds, (const void*)(F.ws + WS_ACT), (const void*)(F.ws + WS_EXP2), EH, nullptr, S, E);
        }
        SEAM(pb + 10);
        if (IN(pb + 11)) { FRESH(); ph_ln2(F, l, ntok, last); }
        SEAM(pb + 11);
    }
#undef IN
#undef SEAM
#undef FRESH
}

extern "C" void kernel_launch(void* const* d_in, const int* in_sizes, int n_in, void* d_out, int out_size, void* d_ws, size_t ws_size, hipStream_t stream) {
    static int grid = 0;
    if (grid == 0) {
        if (n_in != 36 || out_size != NLAT * DM || ws_size < WS_END) { fprintf(stderr, "kernel_launch: unexpected shapes (n_in %d out %d ws %zu need %zu)\n", n_in, out_size, ws_size, (size_t)WS_END); grid = -1; return; }
        int dev = 0, cus = 0, per_cu = 0;
        if (hipGetDevice(&dev) != hipSuccess || hipDeviceGetAttribute(&cus, hipDeviceAttributeMultiprocessorCount, dev) != hipSuccess) { grid = -1; return; }
        if (hipFuncSetAttribute((const void*)mk_fwd, hipFuncAttributeMaxDynamicSharedMemorySize, LDS_BYTES) != hipSuccess) { fprintf(stderr, "kernel_launch: hipFuncSetAttribute failed\n"); grid = -1; return; }
        if (hipOccupancyMaxActiveBlocksPerMultiprocessor(&per_cu, (const void*)mk_fwd, NTHR, LDS_BYTES) != hipSuccess || per_cu < 1) { fprintf(stderr, "kernel_launch: occupancy query says %d\n", per_cu); }
        (void)hipGetLastError();
        grid = cus;
    }
    if (grid < 0) return;
    (void)hipMemsetAsync((char*)d_ws + WS_CTL, 0, CTL_BYTES, stream);
    Args a{};
    for (int i = 0; i < 36; ++i) a.in[i] = (const float*)d_in[i];
    a.out = (float*)d_out; a.ws = (unsigned char*)d_ws;
#if MK_MULTI
    for (int p = 0; p < NPHASE; ++p) { a.ph_lo = p; a.ph_hi = p + 1; hipLaunchKernelGGL(mk_fwd, dim3(grid), dim3(NTHR), LDS_BYTES, stream, a); }
#else
    a.ph_lo = 0; a.ph_hi = NPHASE; hipLaunchKernelGGL(mk_fwd, dim3(grid), dim3(NTHR), LDS_BYTES, stream, a);
#endif
}
```

```cpp
#include <hip/hip_runtime.h>
#include <cstdio>
#include <cstdint>

#define LAS __attribute__((address_space(3)))
#define GAS __attribute__((address_space(1)))
typedef unsigned short bf16_t;
typedef short bf16x8 __attribute__((ext_vector_type(8)));
typedef float f32x4 __attribute__((ext_vector_type(4)));
typedef float f32x2 __attribute__((ext_vector_type(2)));
typedef unsigned u32x4 __attribute__((ext_vector_type(4)));
typedef unsigned u32x2 __attribute__((ext_vector_type(2)));

constexpr int NB = 16, SEQ = 4096, CTXL = 256, DM = 1024, DEPTH = 4;
constexpr int NLAT = NB * SEQ;
constexpr int NCTX = NB * CTXL;
constexpr int NROW = NLAT + NCTX;
constexpr int SPB = SEQ + CTXL;
constexpr int DIN_REF = 3104;
constexpr int DIN = 3328;
constexpr int UQ = 0, UK = 512, UV = 1024, UGQ = 1536, UGK = 1664, UGV = 1792, UGR = 2048, UHY = 2304, ULAF = 3072, ULAB = 3200;
constexpr int NEXP = 128, TOPK = 8, EH = 256;
constexpr int NE1 = NEXP + 1;
constexpr int RMAX = 659712;
constexpr int TMAX = RMAX / 256;
constexpr float LN_EPS = 1e-6f;
constexpr float DN_ALPHA = 1.6817928305074290f;

__device__ __forceinline__ unsigned f2bf(float f) { unsigned u = __builtin_bit_cast(unsigned, f); return (u + 0x7fffu + ((u >> 16) & 1u)) >> 16; }
typedef __bf16 bf16v2 __attribute__((ext_vector_type(2)));
__device__ __forceinline__ unsigned pk2(float lo, float hi) { const f32x2 v = {lo, hi}; const bf16v2 b = __builtin_convertvector(v, bf16v2); return __builtin_bit_cast(unsigned, b); }
__device__ __forceinline__ float bf2f(unsigned short b) { return __builtin_bit_cast(float, ((unsigned)b) << 16); }
__device__ __forceinline__ float bflo(unsigned w) { return __builtin_bit_cast(float, w << 16); }
__device__ __forceinline__ float bfhi(unsigned w) { return __builtin_bit_cast(float, w & 0xffff0000u); }
__device__ __forceinline__ float shx(float v, int o, int lane) { return __builtin_bit_cast(float, __builtin_amdgcn_ds_bpermute((lane ^ o) << 2, __builtin_bit_cast(int, v))); }
__device__ __forceinline__ int shxi(int v, int o, int lane) { return __builtin_amdgcn_ds_bpermute((lane ^ o) << 2, v); }
__device__ __forceinline__ float shf(float v, int src) { return __builtin_bit_cast(float, __builtin_amdgcn_ds_bpermute(src << 2, __builtin_bit_cast(int, v))); }
__device__ __forceinline__ float wave_sum(float v, int lane) {
#pragma unroll
    for (int o = 1; o < 64; o <<= 1) v += shx(v, o, lane);
    return v;
}
__device__ __forceinline__ void unpack8(const u32x4 q, float* o) { o[0] = bflo(q.x); o[1] = bfhi(q.x); o[2] = bflo(q.y); o[3] = bfhi(q.y); o[4] = bflo(q.z); o[5] = bfhi(q.z); o[6] = bflo(q.w); o[7] = bfhi(q.w); }
__device__ __forceinline__ float silu_f(float x) { return x * __builtin_amdgcn_rcpf(1.0f + __expf(-x)); }
#define LDS_WAIT() asm volatile("s_waitcnt lgkmcnt(0)" ::: "memory")
#define VM_WAIT() asm volatile("s_waitcnt vmcnt(0)" ::: "memory")

#define XB_TMO      128
#define XB_XCNT(j)  (256  + 64 * (j))
#define XB_XSUB(j)  (1280 + 64 * (j))
#define XB_XGEN(j)  (2304 + 64 * (j))
#define XB_TOP      3328
#define XB_TOPGEN   3392
#define XCD_BAR_WORDS 3456
#define XB_SPIN_CAP (1u << 18)

__device__ __forceinline__ unsigned xb_ld(unsigned* p)              { return __hip_atomic_load(p, __ATOMIC_RELAXED, __HIP_MEMORY_SCOPE_AGENT); }
__device__ __forceinline__ unsigned xb_add(unsigned* p, unsigned v) { return __hip_atomic_fetch_add(p, v, __ATOMIC_RELAXED, __HIP_MEMORY_SCOPE_AGENT); }
__device__ __forceinline__ unsigned xb_xcc_id() { return (unsigned)__builtin_amdgcn_s_getreg((3 << 11) | 20) & 0xFu; }
#define XB_SPIN(cond, bar) do { unsigned _sp = 0; while (cond) { __builtin_amdgcn_s_sleep(1); \
    if ((++_sp & 255u) == 0u) { if (xb_ld(&(bar)[XB_TMO])) break; if (_sp > XB_SPIN_CAP) { atomicAdd(&(bar)[XB_TMO], 1u); break; } } } } while (0)

struct XcdBarrier { unsigned* bar; unsigned x; volatile LAS unsigned* st; };

__device__ __forceinline__ XcdBarrier xcd_barrier_post(unsigned* bar, volatile LAS unsigned* st) {
    XcdBarrier b; b.bar = bar; b.x = xb_xcc_id(); b.st = st;
    if (threadIdx.x == 0) (void)xb_add(&bar[XB_XCNT(b.x)], 1u);
    return b;
}
__device__ __forceinline__ void xcd_barrier_complete(unsigned* bar, unsigned x, unsigned& nloc, unsigned& nx) {
    const unsigned G = gridDim.x * gridDim.y * gridDim.z;
    unsigned sum, cnt, mine, sp = 0u;
    for (;;) {
        sum = 0u; cnt = 0u; mine = 0u;
#pragma unroll
        for (unsigned j = 0; j < 16; ++j) { const unsigned c = xb_ld(&bar[XB_XCNT(j)]); sum += c; cnt += (c > 0u) ? 1u : 0u; mine = (j == x) ? c : mine; }
        if (sum == G) break;
        __builtin_amdgcn_s_sleep(1);
        if ((++sp & 255u) == 0u) { if (xb_ld(&bar[XB_TMO])) break; if (sp > XB_SPIN_CAP) { atomicAdd(&bar[XB_TMO], 1u); break; } }
    }
    nloc = mine > 0u ? mine : 1u; nx = cnt > 0u ? cnt : 1u;
}
__device__ __forceinline__ void xcd_barrier(const XcdBarrier& b) {
    asm volatile("s_waitcnt vmcnt(0)" ::: "memory");
    __syncthreads();
    if (threadIdx.x == 0) {
        unsigned* bar = b.bar;
        __builtin_amdgcn_s_waitcnt(0);
        unsigned nloc = b.st[0], nx = b.st[1];
        if (nloc == 0u) { xcd_barrier_complete(bar, b.x, nloc, nx); b.st[0] = nloc; b.st[1] = nx; }
        const unsigned old = xb_add(&bar[XB_XSUB(b.x)], 1u);
        const unsigned gen = old / nloc;
        if (old + 1u == (gen + 1u) * nloc) {
            __builtin_amdgcn_fence(__ATOMIC_RELEASE, "agent");
            asm volatile("s_waitcnt vmcnt(0)" ::: "memory");
            const unsigned og = xb_add(&bar[XB_TOP], 1u);
            const unsigned tg = og / nx;
            if (og + 1u == (tg + 1u) * nx) xb_add(&bar[XB_TOPGEN], 1u);
            else XB_SPIN(xb_ld(&bar[XB_TOPGEN]) == tg, bar);
            __builtin_amdgcn_fence(__ATOMIC_ACQUIRE, "agent");
            xb_add(&bar[XB_XGEN(b.x)], 1u);
            asm volatile("s_waitcnt vmcnt(0)" ::: "memory");
        } else {
            XB_SPIN(xb_ld(&bar[XB_XGEN(b.x)]) == gen, bar);
            __builtin_amdgcn_fence(__ATOMIC_ACQUIRE, "agent");
            asm volatile("s_waitcnt vmcnt(0)" ::: "memory");
        }
    }
    __syncthreads();
}

namespace pg8 {
constexpr int BM = 256, BK = 64, HALF = 128, HTB = HALF * BK * 2, STAGE_BYTES = 8 * HTB, NXCD = 8, WGM = 8;
__host__ __device__ __forceinline__ int lds_byte(int r, int c) { const int st = (r >> 4) * 2 + (c >> 5), rr = r & 15, cc = c & 31, ob = rr * 64 + cc * 2; return st * 1024 + (ob ^ (((ob >> 9) & 1) << 5)); }
__host__ __device__ __forceinline__ void stage_rc(int b, int& R, int& C) { const int st = b / 1024, sb = b % 1024, swz = sb ^ (((sb >> 9) & 1) << 5); R = (st >> 1) * 16 + swz / 64; C = (st & 1) * 32 + (swz % 64) / 2; }
__host__ __device__ __forceinline__ int perm32(int rho) { const int n = rho >> 4, i = rho & 15; return 8 * (i >> 2) + 4 * n + (i & 3); }

struct Unit { int arow0, brow0, orow0, ocol0, aux; };

struct DenseOrder {
    int nM, nN, nwg, G, c;
    __device__ void init(int M, int N, int G_, int c_) { nM = M / BM; nN = N / BM; nwg = nM * nN; G = G_; c = c_; }
    __device__ __forceinline__ bool next(int i, Unit& u) const {
        const long L = (long)i * G + c; if (L >= nwg) return false;
        int wgid = (int)L; { const int q = nwg / NXCD, r = nwg % NXCD, xcd = wgid % NXCD, off = wgid / NXCD; wgid = (xcd < r ? xcd * (q + 1) : r * (q + 1) + (xcd - r) * q) + off; }
        const int nig = WGM * nN, gid = wgid / nig, fm = gid * WGM, gsz = (nM - fm) < WGM ? (nM - fm) : WGM;
        const int pm = fm + ((wgid % nig) % gsz), pn = (wgid % nig) / gsz;
        u.arow0 = pm * BM; u.brow0 = pn * BM; u.orow0 = pm * BM; u.ocol0 = pn * BM; u.aux = 0; return true;
    }
};
struct GroupedOrder {
    const LAS unsigned char* tab; int nN, nslot, slot, t0, t1;
    __device__ __forceinline__ void init(int ntiles, int nN_, int G, int c) {
        nN = nN_;
        if ((G & 7) == 0) { const int per = (ntiles + 7) >> 3, x = c & 7; nslot = G >> 3; slot = c >> 3; t0 = x * per; t1 = (t0 + per) < ntiles ? (t0 + per) : ntiles; }
        else { nslot = G; slot = c; t0 = 0; t1 = ntiles; }
    }
    __device__ __forceinline__ void preload(const int* tile_exp, LAS unsigned char* lds_tab, int tid, int nthr) {
        __syncthreads();
        for (int i = tid; i < t1 - t0; i += nthr) lds_tab[i] = (unsigned char)tile_exp[t0 + i];
        __syncthreads();
        tab = lds_tab;
    }
    __device__ __forceinline__ bool next(int i, Unit& u) const {
        const int q = i * nslot + slot, t = t0 + q / nN, pn = q % nN;
        if (t >= t1) return false;
        const int e = (int)tab[t - t0];
        u.arow0 = t * BM; u.brow0 = (e * nN + pn) * BM; u.orow0 = t * BM; u.ocol0 = pn * BM; u.aux = e; return true;
    }
};

struct RouterOrder {
    DenseOrder b;
    __device__ __forceinline__ bool next(int i, Unit& u) const { if (!b.next(i, u)) return false; const int pm = u.arow0 >> 8; u.brow0 = (pm < 256 ? (pm >> 4) : 16) * 128; return true; }
};
struct ColMapOrder {
    DenseOrder b; unsigned long long map;
    __device__ __forceinline__ bool next(int i, Unit& u) const { if (!b.next(i, u)) return false; const int ph = (int)((map >> ((u.ocol0 >> 8) * 4)) & 15ull); u.brow0 = ph * BM; u.ocol0 = ph * BM; return true; }
};
template <class Base> struct RangeOrder {
    Base b; int i0, i1;
    __device__ __forceinline__ bool next(int i, Unit& u) const { const int j = i + i0; if (j >= i1) return false; return b.next(j, u); }
};

__device__ __forceinline__ unsigned cvt_pk_bf16(float lo, float hi) { return pk2(lo, hi); }

struct NoPre {};
struct EpiF32 {
    static constexpr bool PERM = false; static constexpr int SCW = 0x7A7A7A7A; typedef NoPre Pre;
    __device__ __forceinline__ Pre prefetch(const Unit&, LAS unsigned char*, int, int, int) const { return Pre{}; }
    float* C; int ldc;
    __device__ __forceinline__ void operator()(const f32x4 (&acc)[2][2][4][2], const Unit& u, int wr, int wc, int fr, int fq, const Pre&, bool drain) const {
        if (drain) asm volatile("s_waitcnt vmcnt(0)" ::: "memory");
        const int row0 = u.orow0 + wr * 64 + fr, col0 = u.ocol0 + wc * 32 + 4 * fq;
#pragma unroll
        for (int ai = 0; ai < 2; ++ai)
#pragma unroll
            for (int m = 0; m < 4; ++m) { float* rowp = C + (size_t)(row0 + ai * HALF + m * 16) * ldc + col0;
#pragma unroll
                for (int bj = 0; bj < 2; ++bj)
#pragma unroll
                    for (int n = 0; n < 2; ++n) *(GAS f32x4*)(rowp + bj * HALF + n * 16) = acc[ai][bj][m][n]; }
    }
};
struct EpiF32H {
    static constexpr bool PERM = false; static constexpr int SCW = 0x7A7A7A7A; typedef NoPre Pre;
    __device__ __forceinline__ Pre prefetch(const Unit&, LAS unsigned char*, int, int, int) const { return Pre{}; }
    float* C; int ldc;
    __device__ __forceinline__ void operator()(const f32x4 (&acc)[2][2][4][2], const Unit& u, int wr, int wc, int fr, int fq, const Pre&, bool drain) const {
        if (drain) asm volatile("s_waitcnt vmcnt(0)" ::: "memory");
        const int row0 = u.orow0 + wr * 64 + fr, col0 = wc * 32 + 4 * fq;
#pragma unroll
        for (int ai = 0; ai < 2; ++ai)
#pragma unroll
            for (int m = 0; m < 4; ++m) { float* rowp = C + (size_t)(row0 + ai * HALF + m * 16) * ldc + col0;
#pragma unroll
                for (int n = 0; n < 2; ++n) *(GAS f32x4*)(rowp + n * 16) = acc[ai][0][m][n]; }
    }
};
struct EpiBf16 {
    static constexpr bool PERM = true; static constexpr int SCW = 0x7A7A7A7A; typedef NoPre Pre;
    __device__ __forceinline__ Pre prefetch(const Unit&, LAS unsigned char*, int, int, int) const { return Pre{}; }
    bf16_t* O; int ldc;
    __device__ __forceinline__ void operator()(const f32x4 (&acc)[2][2][4][2], const Unit& u, int wr, int wc, int fr, int fq, const Pre&, bool drain) const {
        const int row0 = u.orow0 + wr * 64 + fr, col0 = u.ocol0 + wc * 32 + 8 * fq;
        u32x4 w[2][4][2];
#pragma unroll
        for (int ai = 0; ai < 2; ++ai)
#pragma unroll
            for (int m = 0; m < 4; ++m)
#pragma unroll
                for (int bj = 0; bj < 2; ++bj) { const f32x4 v0 = acc[ai][bj][m][0], v1 = acc[ai][bj][m][1];
                    w[ai][m][bj].x = cvt_pk_bf16(v0[0], v0[1]); w[ai][m][bj].y = cvt_pk_bf16(v0[2], v0[3]); w[ai][m][bj].z = cvt_pk_bf16(v1[0], v1[1]); w[ai][m][bj].w = cvt_pk_bf16(v1[2], v1[3]); }
        if (drain) asm volatile("s_waitcnt vmcnt(0)" ::: "memory");
#pragma unroll
        for (int ai = 0; ai < 2; ++ai)
#pragma unroll
            for (int m = 0; m < 4; ++m) { bf16_t* rowp = O + (size_t)(row0 + ai * HALF + m * 16) * ldc + col0;
#pragma unroll
                for (int bj = 0; bj < 2; ++bj) *(GAS u32x4*)(rowp + bj * HALF) = w[ai][m][bj]; }
    }
};
struct EpiVT {
    static constexpr bool PERM = false; static constexpr int SCW = 0x7A7A7A7A; typedef NoPre Pre;
    __device__ __forceinline__ Pre prefetch(const Unit&, LAS unsigned char*, int, int, int) const { return Pre{}; }
    bf16_t* VT; int col_base;
    __device__ __forceinline__ void operator()(const f32x4 (&acc)[2][2][4][2], const Unit& u, int wr, int wc, int fr, int fq, const Pre&, bool drain) const {
        if (drain) asm volatile("s_waitcnt vmcnt(0)" ::: "memory");
        const int r0 = u.orow0; int b, pos0;
        if (r0 < NLAT) { b = r0 >> 12; pos0 = r0 & 4095; } else { b = (r0 - NLAT) >> 8; pos0 = SEQ + ((r0 - NLAT) & 255); }
        bf16_t* base = VT + ((size_t)b * 512 + (u.ocol0 - col_base) + wc * 32 + fr) * SPB + pos0 + wr * 64 + 4 * fq;
#pragma unroll
        for (int ai = 0; ai < 2; ++ai)
#pragma unroll
            for (int bj = 0; bj < 2; ++bj)
#pragma unroll
                for (int m = 0; m < 4; ++m)
#pragma unroll
                    for (int n = 0; n < 2; ++n) { const f32x4 v = acc[ai][bj][m][n];
                        *(GAS u32x2*)(base + (size_t)(bj * HALF + n * 16) * SPB + ai * HALF + m * 16) = (u32x2){cvt_pk_bf16(v[0], v[1]), cvt_pk_bf16(v[2], v[3])}; }
    }
};
struct EpiY8 {
    static constexpr bool PERM = true; static constexpr int SCW = 0x7A7A7A7A; typedef NoPre Pre;
    __device__ __forceinline__ Pre prefetch(const Unit&, LAS unsigned char*, int, int, int) const { return Pre{}; }
    unsigned char* O; int ldc;
    __device__ __forceinline__ void operator()(const f32x4 (&acc)[2][2][4][2], const Unit& u, int wr, int wc, int fr, int fq, const Pre&, bool drain) const {
        const int row0 = u.orow0 + wr * 64 + fr;
        u32x4 o[2][4];
#pragma unroll
        for (int ai = 0; ai < 2; ++ai)
#pragma unroll
            for (int m = 0; m < 4; ++m) { int w[4];
#pragma unroll
                for (int bj = 0; bj < 2; ++bj) { const f32x4 v0 = acc[ai][bj][m][0], v1 = acc[ai][bj][m][1];
                    int w0 = 0, w1 = 0;
                    w0 = __builtin_amdgcn_cvt_pk_fp8_f32(v0[0], v0[1], w0, false); w0 = __builtin_amdgcn_cvt_pk_fp8_f32(v0[2], v0[3], w0, true);
                    w1 = __builtin_amdgcn_cvt_pk_fp8_f32(v1[0], v1[1], w1, false); w1 = __builtin_amdgcn_cvt_pk_fp8_f32(v1[2], v1[3], w1, true);
                    w[2 * bj] = w0; w[2 * bj + 1] = w1; }
                o[ai][m] = (u32x4){(unsigned)w[0], (unsigned)w[1], (unsigned)w[2], (unsigned)w[3]}; }
        if (drain) asm volatile("s_waitcnt vmcnt(0)" ::: "memory");
#pragma unroll
        for (int ai = 0; ai < 2; ++ai)
#pragma unroll
            for (int m = 0; m < 4; ++m) *(GAS u32x4*)(O + (size_t)(row0 + ai * HALF + m * 16) * ldc + u.ocol0 + wc * 64 + fq * 16) = o[ai][m];
    }
};
struct EpiSwiglu {
    static constexpr bool PERM = true; static constexpr int SCW = 0x7A7A7A7A; typedef NoPre Pre;
    __device__ __forceinline__ Pre prefetch(const Unit&, LAS unsigned char*, int, int, int) const { return Pre{}; }
    unsigned char* ACT;
    __device__ __forceinline__ void operator()(const f32x4 (&acc)[2][2][4][2], const Unit& u, int wr, int wc, int fr, int fq, const Pre&, bool drain) const {
        const int row0 = u.orow0 + wr * 64 + fr, pn = u.ocol0 >> 8;
        u32x2 o[2][4];
#pragma unroll
        for (int ai = 0; ai < 2; ++ai)
#pragma unroll
            for (int m = 0; m < 4; ++m) {
                int w[2];
#pragma unroll
                for (int n = 0; n < 2; ++n) { const f32x4 g = acc[ai][0][m][n], up = acc[ai][1][m][n];
                    f32x4 e;
#pragma unroll
                    for (int i = 0; i < 4; ++i) e[i] = __builtin_amdgcn_exp2f(-g[i]);
                    const f32x4 d = e + 1.0f; f32x4 r;
#pragma unroll
                    for (int i = 0; i < 4; ++i) r[i] = __builtin_amdgcn_rcpf(d[i]);
                    const f32x4 h = (g * up) * r;
                    int v = 0; v = __builtin_amdgcn_cvt_pk_fp8_f32(h[0], h[1], v, false); v = __builtin_amdgcn_cvt_pk_fp8_f32(h[2], h[3], v, true); w[n] = v; }
                o[ai][m] = (u32x2){(unsigned)w[0], (unsigned)w[1]}; }
        if (drain) asm volatile("s_waitcnt vmcnt(0)" ::: "memory");
#pragma unroll
        for (int ai = 0; ai < 2; ++ai)
#pragma unroll
            for (int m = 0; m < 4; ++m) *(GAS u32x2*)(ACT + (size_t)(row0 + ai * HALF + m * 16) * EH + pn * 128 + wc * 32 + 8 * fq) = o[ai][m];
    }
};
constexpr float Y2_SCALE = 8.0f, Y2_INV = 1.0f / 8.0f;
struct EpiScatter {
    static constexpr bool PERM = true; static constexpr int SCW = 0x7D7D7D7D;
    struct Pre { const LAS int* tab; };
    unsigned char* Y2; const int* rowdst;
    __device__ __forceinline__ Pre prefetch(const Unit& u, LAS unsigned char* lds, int wid, int lane, int ui) const {
        LAS unsigned char* tab = lds + STAGE_BYTES + (ui & 1) * 1024;
        if (wid < 4) __builtin_amdgcn_global_load_lds((const unsigned*)(rowdst + u.orow0 + wid * 64 + lane), (LAS unsigned*)(tab + wid * 256), 4, 0, 0);
        Pre p; p.tab = (const LAS int*)tab; return p; }
    __device__ __forceinline__ void operator()(const f32x4 (&acc)[2][2][4][2], const Unit& u, int wr, int wc, int fr, int fq, const Pre& pre, bool drain) const {
        if (u.aux == 128) {
            u32x4 o[2][4];
#pragma unroll
            for (int ai = 0; ai < 2; ++ai)
#pragma unroll
                for (int m = 0; m < 4; ++m) { int w[4];
#pragma unroll
                    for (int bj = 0; bj < 2; ++bj) { const f32x4 v0 = acc[ai][bj][m][0], v1 = acc[ai][bj][m][1];
                        int w0 = 0, w1 = 0;
                        w0 = __builtin_amdgcn_cvt_pk_fp8_f32(v0[0], v0[1], w0, false); w0 = __builtin_amdgcn_cvt_pk_fp8_f32(v0[2], v0[3], w0, true);
                        w1 = __builtin_amdgcn_cvt_pk_fp8_f32(v1[0], v1[1], w1, false); w1 = __builtin_amdgcn_cvt_pk_fp8_f32(v1[2], v1[3], w1, true);
                        w[2 * bj] = w0; w[2 * bj + 1] = w1; }
                    o[ai][m] = (u32x4){(unsigned)w[0], (unsigned)w[1], (unsigned)w[2], (unsigned)w[3]}; }
            if (drain) asm volatile("s_waitcnt vmcnt(0)" ::: "memory");
#pragma unroll
            for (int ai = 0; ai < 2; ++ai)
#pragma unroll
                for (int m = 0; m < 4; ++m) { const int dst = pre.tab[wr * 64 + fr + ai * HALF + m * 16];
                    if (dst >= 0) *(GAS u32x4*)(Y2 + (size_t)dst * 512 + u.ocol0 + wc * 64 + fq * 16) = o[ai][m]; }
        } else {
            u32x2 o[2][4];
#pragma unroll
            for (int ai = 0; ai < 2; ++ai)
#pragma unroll
                for (int m = 0; m < 4; ++m) { unsigned w[2];
#pragma unroll
                    for (int bj = 0; bj < 2; ++bj) { const f32x4 v0 = acc[ai][bj][m][0], v1 = acc[ai][bj][m][1];
                        unsigned x = 0u;
                        x = __builtin_amdgcn_cvt_scalef32_pk_fp4_f32(x, v0[0], v0[1], 1.0f, 0); x = __builtin_amdgcn_cvt_scalef32_pk_fp4_f32(x, v0[2], v0[3], 1.0f, 1);
                        x = __builtin_amdgcn_cvt_scalef32_pk_fp4_f32(x, v1[0], v1[1], 1.0f, 2); x = __builtin_amdgcn_cvt_scalef32_pk_fp4_f32(x, v1[2], v1[3], 1.0f, 3);
                        w[bj] = x; }
                    o[ai][m] = (u32x2){w[0], w[1]}; }
            if (drain) asm volatile("s_waitcnt vmcnt(0)" ::: "memory");
#pragma unroll
            for (int ai = 0; ai < 2; ++ai)
#pragma unroll
                for (int m = 0; m < 4; ++m) { const int dst = pre.tab[wr * 64 + fr + ai * HALF + m * 16];
                    if (dst >= 0) *(GAS u32x2*)(Y2 + (size_t)dst * 512 + (u.ocol0 >> 1) + wc * 32 + fq * 8) = o[ai][m]; }
        }
    }
};

typedef int v8i __attribute__((ext_vector_type(8)));
typedef int v4i __attribute__((ext_vector_type(4)));
struct Frag { bf16x8 p[2]; __device__ __forceinline__ bf16x8& operator[](int k) { return p[k]; } __device__ __forceinline__ const bf16x8& operator[](int k) const { return p[k]; } };
template <class Epi, class Sched, bool GATHER, bool F8 = false, bool ALIGN_EPI = true, bool SP2 = true, bool NHALF = false, bool SWAP = false>
__device__ __forceinline__ void gemm_phase(const int tid_in, LAS unsigned char* lds, const void* Ag, const void* Bg, const int K, const int* rowidx, const Sched& S, const Epi& E) {
    int tid_ = tid_in; asm volatile("" : "+v"(tid_));
    const int tid = tid_, wid = __builtin_amdgcn_readfirstlane(tid >> 6), lane = tid & 63, wr = wid >> 2, wc = wid & 3, fr = lane & 15, fq = lane >> 4;
    const int KB = F8 ? K : 2 * K;
    const int nt = KB / 128;
    unsigned voffB[2];
#pragma unroll
    for (int i = 0; i < 2; ++i) { int R, C; stage_rc(tid * 16 + i * 8192, R, C); const int Rb = Epi::PERM ? ((R & ~31) + perm32(R & 31)) : R;
        voffB[i] = (unsigned)(Rb * KB + C * 2); }
    const size_t kstep = (size_t)128;
    const size_t hstep = (size_t)HALF * KB;
    const unsigned ldsw = (unsigned)wid * 1024u;
    const int aoff = F8 ? lds_byte(wr * 64 + fr, 16 * fq) : lds_byte(wr * 64 + fr, fq * 8), boff = F8 ? lds_byte(wc * 32 + fr, 16 * fq) : lds_byte(wc * 32 + fr, fq * 8);
    constexpr int PIECE1 = F8 ? 16 : 1024;
    const int sc_w = Epi::SCW, sc_a = 0x7F7F7F7F;
#define PG8_SA(b, h) (((b) * 2 + (h)) * HTB)
#define PG8_SB(b, h) ((4 + (b) * 2 + (h)) * HTB)
#define PG8_STAGE_B(bufoff, gbase) do { _Pragma("unroll") for (int _i = 0; _i < 2; ++_i) \
        __builtin_amdgcn_global_load_lds((const unsigned*)((const char*)(gbase) + voffB[_i]), (LAS unsigned*)(lds + (bufoff) + ldsw + _i * 8192), 16, 0, 0); } while (0)
#define PG8_STAGE_A(bufoff, gbase, h) do { const char* _gb = (const char*)(gbase) + (GATHER ? (size_t)0 : (size_t)(h) * hstep); \
        __builtin_amdgcn_global_load_lds((const unsigned*)(_gb + ac[GATHER ? (h) : 0][0]), (LAS unsigned*)(lds + (bufoff) + ldsw), 16, 0, 0); \
        __builtin_amdgcn_global_load_lds((const unsigned*)(_gb + ac[GATHER ? (h) : 0][1]), (LAS unsigned*)(lds + (bufoff) + ldsw + 8192), 16, 0, 0); } while (0)
#define PG8_LDA(dst, b, h) do { _Pragma("unroll") for (int m = 0; m < 4; ++m) { if constexpr (F8) { const v4i _l = *(const LAS v4i*)(lds + PG8_SA(b, h) + aoff + m * 2048), _h = *(const LAS v4i*)(lds + PG8_SA(b, h) + aoff + m * 2048 + PIECE1); dst##8[m] = __builtin_shufflevector(_l, _h, 0, 1, 2, 3, 4, 5, 6, 7); } \
        else { dst[m][0] = *(const LAS bf16x8*)(lds + PG8_SA(b, h) + aoff + m * 2048); dst[m][1] = *(const LAS bf16x8*)(lds + PG8_SA(b, h) + aoff + m * 2048 + PIECE1); } } } while (0)
#define PG8_LDB(dst, b, h) do { _Pragma("unroll") for (int n = 0; n < 2; ++n) { if constexpr (F8) { const v4i _l = *(const LAS v4i*)(lds + PG8_SB(b, h) + boff + n * 2048), _h = *(const LAS v4i*)(lds + PG8_SB(b, h) + boff + n * 2048 + PIECE1); dst##8[n] = __builtin_shufflevector(_l, _h, 0, 1, 2, 3, 4, 5, 6, 7); } \
        else { dst[n][0] = *(const LAS bf16x8*)(lds + PG8_SB(b, h) + boff + n * 2048); dst[n][1] = *(const LAS bf16x8*)(lds + PG8_SB(b, h) + boff + n * 2048 + PIECE1); } } } while (0)
#define PG8_MMA(ai, bj, At, Bt) do { __builtin_amdgcn_s_setprio(1); _Pragma("unroll") for (int m = 0; m < 4; ++m) _Pragma("unroll") for (int n = 0; n < 2; ++n) { \
        if constexpr (F8) asm volatile("v_mfma_scale_f32_16x16x128_f8f6f4 %0, %1, %2, %0, %3, %4 op_sel_hi:[0,0,0]" : "+v"(acc[ai][bj][m][n]) : "v"(Bt##8[n]), "v"(At##8[m]), "v"(sc_w), "v"(sc_a)); \
        else { _Pragma("unroll") for (int k = 0; k < 2; ++k) acc[ai][bj][m][n] = SWAP ? __builtin_amdgcn_mfma_f32_16x16x32_bf16(At[m][k], Bt[n][k], acc[ai][bj][m][n], 0, 0, 0) : __builtin_amdgcn_mfma_f32_16x16x32_bf16(Bt[n][k], At[m][k], acc[ai][bj][m][n], 0, 0, 0); } } \
        __builtin_amdgcn_s_setprio(0); } while (0)
#define PG8_WAIT_V(n) asm volatile("s_waitcnt vmcnt(" #n ")" ::: "memory")
#define PG8_WAIT_LOOP do { if constexpr (NHALF) PG8_WAIT_V(6); else PG8_WAIT_V(8); } while (0)
#define PG8_WAIT_L(n) asm volatile("s_waitcnt lgkmcnt(" #n ")" ::: "memory")
#define PG8_BAR __builtin_amdgcn_s_barrier()
#define PG8_SCHED __builtin_amdgcn_sched_barrier(0)
#define PG8_TAB(par) (lds + STAGE_BYTES + 2048 + (par) * 1024)
#define PG8_TABLOAD(par, row0) do { if (wid < 4) __builtin_amdgcn_global_load_lds((const unsigned*)(rowidx + (row0) + wid * 64 + lane), (LAS unsigned*)(PG8_TAB(par) + wid * 256), 4, 0, 0); } while (0)
#define PG8_AOFF_H(h, par) do { int _tz = tid; asm volatile("" : "+v"(_tz)); _Pragma("unroll") for (int _i = 0; _i < 2; ++_i) { int _R, _C; stage_rc(_tz * 16 + _i * 8192, _R, _C); \
        if (GATHER) ac[h][_i] = ((const LAS unsigned*)PG8_TAB(par))[(h) * HALF + _R] * (unsigned)KB + (unsigned)_C * 2u; \
        else ac[h][_i] = (unsigned)(((h) * HALF + _R) * KB) + (unsigned)_C * 2u; } } while (0)
    static_assert(SP2, "only the two-super-phase K-loop is kept");
    Unit cur, nxt; int ui = 0;
    if (!S.next(0, cur)) return;
    f32x4 acc[2][2][4][2];
#pragma unroll
    for (int a = 0; a < 2; ++a)
#pragma unroll
        for (int b = 0; b < 2; ++b)
#pragma unroll
            for (int m = 0; m < 4; ++m)
#pragma unroll
                for (int n = 0; n < 2; ++n) acc[a][b][m][n] = (f32x4){0.f, 0.f, 0.f, 0.f};
    bf16x8 At[F8 ? 1 : 4][2], B0[F8 ? 1 : 2][2], B1[F8 ? 1 : 2][2];
    v8i At8[F8 ? 4 : 1], B08[F8 ? 2 : 1], B18[F8 ? 2 : 1];
    unsigned ac[GATHER ? 2 : 1][2];
    if (GATHER) { PG8_TABLOAD(0, cur.arow0); PG8_WAIT_V(0); PG8_BAR; }
    PG8_AOFF_H(0, 0); if (GATHER) { PG8_AOFF_H((GATHER ? 1 : 0), 0); }
    const char* cA = (const char*)Ag + (GATHER ? (size_t)0 : (size_t)cur.arow0 * KB); const char* cB = (const char*)Bg + (size_t)cur.brow0 * KB;
    PG8_STAGE_B(PG8_SB(0, 0), cB); if constexpr (!NHALF) PG8_STAGE_B(PG8_SB(0, 1), cB + hstep); PG8_STAGE_A(PG8_SA(0, 0), cA, 0); PG8_STAGE_A(PG8_SA(0, 1), cA, 1);
    if (wr == 1) PG8_BAR;
    PG8_WAIT_V(2); PG8_BAR;
    PG8_STAGE_B(PG8_SB(1, 0), cB + kstep); PG8_STAGE_A(PG8_SA(1, 0), cA + kstep, 0); if constexpr (!NHALF) PG8_STAGE_B(PG8_SB(1, 1), cB + hstep + kstep);
    if constexpr (NHALF) PG8_WAIT_V(4); else PG8_WAIT_V(6);
    PG8_BAR;
    for (;;) {
        const typename Epi::Pre pre = E.prefetch(cur, lds, wid, lane, ui);
        const bool has_next = S.next(ui + 1, nxt);
        if (GATHER) { if (has_next) PG8_TABLOAD((ui + 1) & 1, nxt.arow0); }
        const char* nA = has_next ? ((const char*)Ag + (GATHER ? (size_t)0 : (size_t)nxt.arow0 * KB)) : cA; const char* nB = has_next ? (const char*)Bg + (size_t)nxt.brow0 * KB : cB;
_Pragma("nounroll")
        for (int t = 0; t < nt; t += 2) {
            const bool last = (t == nt - 2);
            const bool skipw = (t == 0) && (ui > 0);
            const char* a1 = cA + (size_t)(t + 1) * kstep;
            const char* a2 = last ? nA : cA + (size_t)(t + 2) * kstep; const char* b2 = last ? nB : cB + (size_t)(t + 2) * kstep;
            const char* a3 = a2 + kstep; const char* b3 = b2 + kstep;
            if (GATHER) { if (last && has_next) { PG8_AOFF_H(0, (ui + 1) & 1); } }
            PG8_LDB(B0, 0, 0); if constexpr (!NHALF) PG8_LDB(B1, 0, 1); PG8_SCHED; PG8_LDA(At, 0, 0); PG8_STAGE_A(PG8_SA(1, 1), a1, 1);
            if (!skipw) PG8_WAIT_LOOP; PG8_WAIT_L(0); PG8_BAR; PG8_MMA(0, 0, At, B0); if constexpr (!NHALF) PG8_MMA(0, 1, At, B1); PG8_BAR; PG8_SCHED;
            if (GATHER) { if (last && has_next) { PG8_AOFF_H(1, (ui + 1) & 1); } }
            PG8_LDA(At, 0, 1); PG8_STAGE_B(PG8_SB(0, 0), b2); if constexpr (!NHALF) PG8_STAGE_B(PG8_SB(0, 1), b2 + hstep); PG8_STAGE_A(PG8_SA(0, 0), a2, 0);
            if (!skipw) PG8_WAIT_LOOP; PG8_WAIT_L(0); PG8_BAR; PG8_MMA(1, 0, At, B0); if constexpr (!NHALF) PG8_MMA(1, 1, At, B1); PG8_BAR; PG8_SCHED;
            PG8_LDB(B0, 1, 0); if constexpr (!NHALF) PG8_LDB(B1, 1, 1); PG8_SCHED; PG8_LDA(At, 1, 0); PG8_STAGE_A(PG8_SA(0, 1), a2, 1);
            if (!skipw) PG8_WAIT_LOOP; PG8_WAIT_L(0); PG8_BAR; PG8_MMA(0, 0, At, B0); if constexpr (!NHALF) PG8_MMA(0, 1, At, B1); PG8_BAR; PG8_SCHED;
            PG8_LDA(At, 1, 1); PG8_STAGE_B(PG8_SB(1, 0), b3); if constexpr (!NHALF) PG8_STAGE_B(PG8_SB(1, 1), b3 + hstep); PG8_STAGE_A(PG8_SA(1, 0), a3, 0);
            PG8_WAIT_LOOP; PG8_WAIT_L(0); PG8_BAR; PG8_MMA(1, 0, At, B0); if constexpr (!NHALF) PG8_MMA(1, 1, At, B1); PG8_BAR; PG8_SCHED;
        }
        if constexpr (ALIGN_EPI) { if (wr == 0) PG8_BAR; }
        E(acc, cur, wr, wc, fr, fq, pre, has_next);
        if (!has_next) break;
#pragma unroll
        for (int a = 0; a < 2; ++a)
#pragma unroll
            for (int b = 0; b < 2; ++b)
#pragma unroll
                for (int m = 0; m < 4; ++m)
#pragma unroll
                    for (int n = 0; n < 2; ++n) acc[a][b][m][n] = (f32x4){0.f, 0.f, 0.f, 0.f};
        cur = nxt; cA = nA; cB = nB; ++ui;
        if constexpr (ALIGN_EPI) { if (wr == 1) PG8_BAR; }
    }
    PG8_WAIT_V(0);
    if constexpr (!ALIGN_EPI) { if (wr == 0) PG8_BAR; }
    PG8_BAR;
#undef PG8_SA
#undef PG8_SB
#undef PG8_STAGE_A
#undef PG8_STAGE_B
#undef PG8_LDA
#undef PG8_LDB
#undef PG8_MMA
#undef PG8_WAIT_V
#undef PG8_WAIT_L
#undef PG8_WAIT_LOOP
#undef PG8_BAR
#undef PG8_SCHED
#undef PG8_AOFF_H
#undef PG8_TAB
#undef PG8_TABLOAD
}
}

constexpr int NWAVES = 8, NTHR = 512;
constexpr size_t MiB = 1u << 20;
constexpr size_t WS_CTL = 0, CTL_BYTES = 1 * MiB;
constexpr size_t WS_MOD = 1 * MiB;
constexpr size_t WS_WIN = 3 * MiB;
constexpr size_t WS_WOUT = 29 * MiB;
constexpr size_t WS_WR = 37 * MiB;
constexpr size_t WS_HYF = 39 * MiB;
constexpr size_t WS_HYFC = 71 * MiB;
constexpr size_t WS_XC = 73 * MiB;
constexpr size_t WS_EXP1 = 89 * MiB;
constexpr size_t WS_EXP2 = 218 * MiB;
constexpr size_t WS_XM = 283 * MiB;
constexpr size_t WS_EIDX = 419 * MiB;
constexpr size_t WS_WGT = 422 * MiB;
constexpr size_t WS_RNK = 425 * MiB;
constexpr size_t WS_ROWTOK = 428 * MiB;
constexpr size_t WS_ROWDST = 431 * MiB;
constexpr size_t WS_TILEEXP = 434 * MiB;
constexpr size_t WS_BIG = 435 * MiB;
constexpr size_t WS_U = WS_BIG;
constexpr size_t WS_MIX = 877 * MiB;
constexpr size_t WS_VT = 1013 * MiB;
constexpr size_t WS_HV = 1081 * MiB;
constexpr size_t WS_Z2 = 1183 * MiB;
constexpr size_t WS_GDS = 1217 * MiB;
constexpr size_t WS_GSIN = 1285 * MiB;
constexpr size_t WS_GD = 1319 * MiB;
constexpr size_t WS_Y = 1321 * MiB;
constexpr size_t WS_LOGIT = WS_BIG;
constexpr size_t WS_ACT = WS_BIG;
constexpr size_t WS_Y2 = 758 * MiB;
constexpr size_t WS_XM8 = 1470 * MiB;
constexpr size_t WS_WRB = 1540 * MiB;
constexpr size_t WS_RBIAS = 1558 * MiB;
constexpr size_t WS_XR = 1600 * MiB;
constexpr size_t WS_END = 1736 * MiB;
constexpr int CW_BAR = 4096;
constexpr int CW_CNT = 16384;
constexpr int CW_NTL = 20480;

constexpr int LDS_BYTES = 163840;
constexpr int MISC_OFF = 163584;

struct Frame {
    LAS unsigned char* lds;
    int tid, lane, wave, G, wg;
    const float* const* in;
    float* out; unsigned char* ws; unsigned* ctl;
};
enum { I_X = 0, I_C, I_CTX, I_CCTX, I_WMOD, I_BMOD, I_WIN, I_RPB, I_WA2, I_BA2, I_GNORM, I_HSW, I_HSB, I_HW1, I_HB1, I_HF1, I_HW2, I_HB2, I_HF2, I_HW3, I_HB3, I_HDEC, I_HSKIP,
       I_WOUT, I_LN1G, I_LN1B, I_RW, I_RB, I_WEG, I_WEU, I_WED, I_WSG, I_WSU, I_WSD, I_LN2G, I_LN2B };

__device__ __forceinline__ int row_b(int row) { return row < NLAT ? (row >> 12) : 16; }
__device__ __forceinline__ const float* mod_ptr(const Frame& F, int l, int row) { return (const float*)(F.ws + WS_MOD) + ((size_t)l * 17 + row_b(row)) * 6144; }

constexpr float NA_QSCALE = 0.125f * 1.4426950408889634f, NA_CLAMP = 60.0f * 1.4426950408889634f;
template <class RowFn>
__device__ __forceinline__ void tr_item(const float* W, int ldw, int k0, int n0, bf16_t* dst, int ldd, RowFn rf, LAS float* scr, int lane, float scale = 1.0f) {
    float tv[32];
    const GAS float* wp = (const GAS float*)(W + (size_t)(k0 + (lane >> 5)) * ldw + n0 + (lane & 31));
#pragma unroll
    for (int i = 0; i < 32; ++i) tv[i] = __builtin_nontemporal_load(wp + (size_t)(2 * i) * ldw);
#pragma unroll
    for (int i = 0; i < 32; ++i) scr[(2 * i + (lane >> 5)) * 33 + (lane & 31)] = tv[i];
    LDS_WAIT(); asm volatile("" ::: "memory");
    const int c = lane & 7;
#pragma unroll
    for (int j = 0; j < 4; ++j) { const int n = (lane >> 3) + 8 * j; const LAS float* s = scr + (8 * c) * 33 + n;
        u32x4 o; o.x = pk2(s[0 * 33] * scale, s[1 * 33] * scale); o.y = pk2(s[2 * 33] * scale, s[3 * 33] * scale); o.z = pk2(s[4 * 33] * scale, s[5 * 33] * scale); o.w = pk2(s[6 * 33] * scale, s[7 * 33] * scale);
        *(GAS u32x4*)(dst + (size_t)rf(n0 + n) * ldd + k0 + 8 * c) = o; }
    LDS_WAIT(); asm volatile("" ::: "memory");
}
template <class RowFn>
__device__ __forceinline__ void tr_item_ks(const float* W, int ldw, int k0, int n0, bf16_t* dst, int ldd, RowFn rf, LAS float* scr, int lane, const float* ksc) {
    float tv[32];
    const GAS float* wp = (const GAS float*)(W + (size_t)(k0 + (lane >> 5)) * ldw + n0 + (lane & 31));
#pragma unroll
    for (int i = 0; i < 32; ++i) tv[i] = wp[(size_t)(2 * i) * ldw];
#pragma unroll
    for (int i = 0; i < 32; ++i) scr[(2 * i + (lane >> 5)) * 33 + (lane & 31)] = tv[i] * (1.0f + ksc[2 * i + (lane >> 5)]);
    LDS_WAIT(); asm volatile("" ::: "memory");
    const int c = lane & 7;
#pragma unroll
    for (int j = 0; j < 4; ++j) { const int n = (lane >> 3) + 8 * j; const LAS float* s = scr + (8 * c) * 33 + n;
        u32x4 o; o.x = pk2(s[0 * 33], s[1 * 33]); o.y = pk2(s[2 * 33], s[3 * 33]); o.z = pk2(s[4 * 33], s[5 * 33]); o.w = pk2(s[6 * 33], s[7 * 33]);
        *(GAS u32x4*)(dst + (size_t)rf(n0 + n) * ldd + k0 + 8 * c) = o; }
    LDS_WAIT(); asm volatile("" ::: "memory");
}
template <class RowFn>
__device__ __forceinline__ void tr_item8(const float* W, int ldw, int k0, int n0, unsigned char* dst, int ldd, RowFn rf, float scale, LAS float* scr, int lane) {
    float tv[32];
    const GAS float* wp = (const GAS float*)(W + (size_t)(k0 + (lane >> 5)) * ldw + n0 + (lane & 31));
#pragma unroll
    for (int i = 0; i < 32; ++i) tv[i] = __builtin_nontemporal_load(wp + (size_t)(2 * i) * ldw);
#pragma unroll
    for (int i = 0; i < 32; ++i) scr[(2 * i + (lane >> 5)) * 33 + (lane & 31)] = tv[i];
    LDS_WAIT(); asm volatile("" ::: "memory");
    const int n = lane >> 1, hf = lane & 1; const LAS float* s = scr + (32 * hf) * 33 + n;
    unsigned w[8];
#pragma unroll
    for (int j = 0; j < 8; ++j) { int v = 0; v = __builtin_amdgcn_cvt_pk_fp8_f32(s[(4 * j) * 33] * scale, s[(4 * j + 1) * 33] * scale, v, false); v = __builtin_amdgcn_cvt_pk_fp8_f32(s[(4 * j + 2) * 33] * scale, s[(4 * j + 3) * 33] * scale, v, true); w[j] = (unsigned)v; }
    unsigned char* d = dst + (size_t)rf(n0 + n) * ldd + k0 + 32 * hf;
    *(GAS u32x4*)d = (u32x4){w[0], w[1], w[2], w[3]}; *(GAS u32x4*)(d + 16) = (u32x4){w[4], w[5], w[6], w[7]};
    LDS_WAIT(); asm volatile("" ::: "memory");
}
struct RowId { __device__ __forceinline__ int operator()(int n) const { return n; } };
struct RowWin { __device__ __forceinline__ int operator()(int n) const { return n >= 2336 ? n - 32 : n; } };
struct RowGU { int up; __device__ __forceinline__ int operator()(int j) const { return (j >> 7) * 256 + up * 128 + (j & 127); } };

__device__ __forceinline__ void p0_static_weights(Frame& F) {
    LAS float* scr = (LAS float*)(F.lds + F.wave * 16384);
    const int gw = F.wg * NWAVES + F.wave, NGW = F.G * NWAVES;
    constexpr int I_IN = 16 * 97, I_OUT = 16 * 32, I_R = 16 * 4, PER_L = I_IN + I_OUT + I_R;
    for (int it = gw; it < DEPTH * PER_L; it += NGW) {
        const int l = it / PER_L; int r = it % PER_L;
        if (r < I_IN) { const int kb = r / 97, nb = r % 97; if (nb == 72) continue;
            tr_item(F.in[I_WIN] + (size_t)l * DM * DIN_REF, DIN_REF, kb * 64, nb * 32, (bf16_t*)(F.ws + WS_WIN) + (size_t)l * DIN * DM, DM, RowWin{}, scr, F.lane, nb < 16 ? NA_QSCALE : 1.0f); continue; }
        r -= I_IN;
        if (r < I_OUT) { const int kb = r / 32, nb = r % 32;
            tr_item(F.in[I_WOUT] + (size_t)l * DM * DM, DM, kb * 64, nb * 32, (bf16_t*)(F.ws + WS_WOUT) + (size_t)l * DM * DM, DM, RowId{}, scr, F.lane); continue; }
        r -= I_OUT;
        { const int kb = r / 4, nb = r % 4;
            tr_item(F.in[I_RW] + (size_t)l * DM * NEXP, NEXP, kb * 64, nb * 32, (bf16_t*)(F.ws + WS_WR) + (size_t)l * 256 * DM, DM, RowId{}, scr, F.lane); }
    }
    const int gt = F.wg * NTHR + F.tid, NGT = F.G * NTHR;
    for (int i = gt; i < DEPTH * 128 * DM / 8; i += NGT) { const int l = i / (128 * DM / 8), r = i % (128 * DM / 8);
        *(u32x4*)((bf16_t*)(F.ws + WS_WR) + ((size_t)l * 256 + 128) * DM + (size_t)r * 8) = (u32x4){0u, 0u, 0u, 0u}; }
    for (int i = gt; i < DEPTH * 256 * DM; i += NGT) {
        const int k = i % DM, n = (i / DM) % 256, l = i / (DM * 256), dir = n >> 7, j = n & 127;
        const float* wi = F.in[I_WIN] + ((size_t)l * DM + k) * DIN_REF + 2304 + dir * 16;
        const float* wa = F.in[I_WA2] + ((size_t)(l * 2 + dir) * 16) * 128 + j;
        float s = 0.f;
#pragma unroll
        for (int r = 0; r < 16; ++r) s += wi[r] * wa[r * 128];
        ((bf16_t*)(F.ws + WS_WIN))[((size_t)l * DIN + 3072 + n) * DM + k] = (bf16_t)f2bf(s);
    }
}
__device__ __forceinline__ void p0_mod(Frame& F) {
    LAS float* sc = (LAS float*)F.lds;
    LAS float* red = (LAS float*)(F.lds + 17 * 1024 * 4);
    for (int i = F.tid; i < 17 * 1024; i += NTHR) { const int r = i >> 10, k = i & 1023; const float v = r < 16 ? F.in[I_C][r * 1024 + k] : F.in[I_CCTX][k]; sc[i] = silu_f(v); }
    __syncthreads();
    const int kq = F.tid >> 7, cl = F.tid & 127;
    for (int u = F.wg; u < DEPTH * 48; u += F.G) {
        const int l = u / 48, col = (u % 48) * 128 + cl;
        const float* w = F.in[I_WMOD] + (size_t)l * DM * 6144 + col;
        float a[17];
#pragma unroll
        for (int r = 0; r < 17; ++r) a[r] = 0.f;
        for (int k0 = kq * 256; k0 < kq * 256 + 256; k0 += 16) {
            float wv[16];
#pragma unroll
            for (int q = 0; q < 16; ++q) wv[q] = *(const GAS float*)(w + (size_t)(k0 + q) * 6144);
#pragma unroll
            for (int q = 0; q < 16; ++q)
#pragma unroll
                for (int r = 0; r < 17; ++r) a[r] += sc[r * 1024 + k0 + q] * wv[q]; }
#pragma unroll
        for (int r = 0; r < 17; ++r) red[(kq * 17 + r) * 128 + cl] = a[r];
        __syncthreads();
        for (int i = F.tid; i < 17 * 128; i += NTHR) { const int r = i >> 7, c2 = i & 127, cc = (u % 48) * 128 + c2;
            const float s = red[(0 * 17 + r) * 128 + c2] + red[(1 * 17 + r) * 128 + c2] + red[(2 * 17 + r) * 128 + c2] + red[(3 * 17 + r) * 128 + c2] + F.in[I_BMOD][l * 6144 + cc];
            ((float*)(F.ws + WS_MOD))[((size_t)l * 17 + r) * 6144 + cc] = s; }
        __syncthreads();
    }
}
__device__ __forceinline__ void p0_hyena_filters(Frame& F) {
    LAS float* z = (LAS float*)F.lds;
    LAS float* h1 = z + 1092;
    LAS float* h2 = h1 + 33 * 64;
    LAS float* tt = h2 + 33 * 64;
    LAS float* W1 = tt + 64;
    LAS float* W2 = W1 + 33 * 64;
    constexpr int UL = 4096 / 32, UC = 256 / 32, UPL = UL + UC;
    for (int u = F.wg; u < DEPTH * UPL; u += F.G) {
        const int l = u / UPL, r = u % UPL; const bool lat = r < UL; const int L = lat ? 4096 : 256, n0 = (lat ? r : r - UL) * 32;
        __syncthreads();
        for (int i = F.tid; i < 33 * 64; i += NTHR) W1[i] = F.in[I_HW1][(size_t)l * 33 * 64 + i];
        for (int i = F.tid; i < 64 * 64; i += NTHR) W2[i] = F.in[I_HW2][(size_t)l * 64 * 64 + i];
        for (int i = F.tid; i < 33 * 33; i += NTHR) { const int p = i / 33, e = i % 33, n = n0 + p;
            const float t = (float)n / (float)(L - 1);
            float v;
            if (e == 0) v = t;
            else { const int kb = (e - 1) & 15; const float band = 1e-4f + (float)kb * ((15.0f - 1e-4f) / 15.0f);
                   const float w = 6.283185307179586f * (float)n / (float)L; const float ang = w * band;
                   v = e <= 16 ? __cosf(ang) : -__sinf(ang); }
            z[i] = v; if (e == 0) tt[p] = t; }
        __syncthreads();
        for (int i = F.tid; i < 33 * 64; i += NTHR) { const int p = i >> 6, j = i & 63; float s = F.in[I_HB1][l * 64 + j];
#pragma unroll 11
            for (int e = 0; e < 33; ++e) s += z[p * 33 + e] * W1[e * 64 + j];
            h1[i] = __sinf(F.in[I_HF1][l * 64 + j] * s); }
        __syncthreads();
        for (int i = F.tid; i < 33 * 64; i += NTHR) { const int p = i >> 6, j = i & 63; float s = F.in[I_HB2][l * 64 + j];
#pragma unroll 16
            for (int e = 0; e < 64; ++e) s += h1[p * 64 + e] * W2[e * 64 + j];
            h2[i] = __sinf(F.in[I_HF2][l * 64 + j] * s); }
        __syncthreads();
        {
            const int g = F.tid >> 8, col0 = 4 * (F.tid & 255), o = col0 >> 9, dir = (col0 >> 8) & 1, ch0 = col0 & 255;
            const int pb = (dir ? 0 : 1) + 16 * g;
            float a[4][16];
#pragma unroll
            for (int j = 0; j < 4; ++j)
#pragma unroll
                for (int q = 0; q < 16; ++q) a[j][q] = 0.f;
            const float* w3 = F.in[I_HW3] + (size_t)l * 64 * 1024 + col0;
            const LAS float* hp = h2 + pb * 64;
            f32x4 wa[4], wb[4];
#pragma unroll
            for (int q = 0; q < 4; ++q) wa[q] = *(const GAS f32x4*)(w3 + (size_t)q * 1024);
#define HF_BLOCK(wv_, k0_) do { _Pragma("unroll") for (int pi = 0; pi < 16; ++pi) { const f32x4 hv = *(const LAS f32x4*)(hp + pi * 64 + (k0_)); \
                _Pragma("unroll") for (int q = 0; q < 4; ++q) _Pragma("unroll") for (int j = 0; j < 4; ++j) a[j][pi] += hv[q] * wv_[q][j]; } } while (0)
#pragma unroll 1
            for (int k0 = 0; k0 < 64; k0 += 8) {
#pragma unroll
                for (int q = 0; q < 4; ++q) wb[q] = *(const GAS f32x4*)(w3 + (size_t)(k0 + 4 + q) * 1024);
                __builtin_amdgcn_sched_barrier(0);
                HF_BLOCK(wa, k0);
                __builtin_amdgcn_sched_barrier(0);
                { const int kn = k0 + 8 < 64 ? k0 + 8 : k0;
#pragma unroll
                  for (int q = 0; q < 4; ++q) wa[q] = *(const GAS f32x4*)(w3 + (size_t)(kn + q) * 1024); }
                __builtin_amdgcn_sched_barrier(0);
                HF_BLOCK(wb, k0 + 4);
                __builtin_amdgcn_sched_barrier(0);
            }
#undef HF_BLOCK
            const f32x4 b3 = *(const GAS f32x4*)(F.in[I_HB3] + l * 1024 + col0), dc = *(const GAS f32x4*)(F.in[I_HDEC] + ((size_t)(l * 2 + o) * 2 + dir) * 256 + ch0);
            float a0[4] = {0.f, 0.f, 0.f, 0.f};
            if (n0 == 0 && dir == 0 && g == 0) {
                for (int k = 0; k < 64; ++k) { const f32x4 wv = *(const GAS f32x4*)(w3 + (size_t)k * 1024); const float hv = h2[k];
#pragma unroll
                    for (int j = 0; j < 4; ++j) a0[j] += hv * wv[j]; } }
#pragma unroll
            for (int j = 0; j < 4; ++j) {
                const float dec = fabsf(dc[j]);
                bf16_t* R = lat ? (bf16_t*)(F.ws + WS_HYF) + ((size_t)(l * 2 + o) * 256 + ch0 + j) * 8192 : (bf16_t*)(F.ws + WS_HYFC) + ((size_t)(l * 2 + o) * 256 + ch0 + j) * 512;
                float v[16];
#pragma unroll
                for (int pi = 0; pi < 16; ++pi) v[pi] = (a[j][pi] + b3[j]) * __expf(-tt[pb + pi] * dec);
                unsigned w[8];
                if (dir == 0) {
                    if (n0 + 32 == L && g == 1) v[15] = 0.f;
#pragma unroll
                    for (int q = 0; q < 8; ++q) w[q] = pk2(v[15 - 2 * q], v[14 - 2 * q]);
                    GAS u32x4* dst = (GAS u32x4*)(R + (L - n0 - 32) + 16 * (1 - g));
                    dst[0] = (u32x4){w[0], w[1], w[2], w[3]}; dst[1] = (u32x4){w[4], w[5], w[6], w[7]};
                    if (n0 == 0 && g == 0) R[L] = (bf16_t)f2bf((a0[j] + b3[j]) * __expf(-tt[0] * dec) + F.in[I_HSKIP][(l * 2 + o) * 256 + ch0 + j]);
                } else if (n0 > 0 || g == 1) {
#pragma unroll
                    for (int q = 0; q < 8; ++q) w[q] = pk2(v[2 * q], v[2 * q + 1]);
                    GAS u32x4* dst = (GAS u32x4*)(R + (L + n0) + 16 * g);
                    dst[0] = (u32x4){w[0], w[1], w[2], w[3]}; dst[1] = (u32x4){w[4], w[5], w[6], w[7]};
                } else {
#pragma unroll
                    for (int pi = 1; pi < 16; ++pi) R[L + pi] = (bf16_t)f2bf(v[pi]);
                }
            }
        }
    }
    __syncthreads();
}
__device__ __forceinline__ void p0_init_rows(Frame& F) {
    const int gw = F.wg * NWAVES + F.wave, NGW = F.G * NWAVES;
    for (int row = gw; row < NROW; row += NGW) {
        const float* src = row < NLAT ? F.in[I_X] + (size_t)row * DM : F.in[I_CTX] + (size_t)(row - NLAT) * DM;
        const float* md = mod_ptr(F, 0, row);
        bf16_t* xr = (bf16_t*)(F.ws + WS_XR) + (size_t)row * DM; bf16_t* xm = (bf16_t*)(F.ws + WS_XM) + (size_t)row * DM;
#pragma unroll
        for (int j = 0; j < 4; ++j) { const int c = 4 * F.lane + 256 * j;
            const f32x4 v = __builtin_nontemporal_load((const GAS f32x4*)(src + c)), sh = *(const GAS f32x4*)(md + c), sc = *(const GAS f32x4*)(md + 1024 + c);
            *(GAS u32x2*)(xr + c) = (u32x2){pk2(v[0], v[1]), pk2(v[2], v[3])};
            u32x2 w; w.x = pk2(v[0] * (1.f + sc[0]) + sh[0], v[1] * (1.f + sc[1]) + sh[1]); w.y = pk2(v[2] * (1.f + sc[2]) + sh[2], v[3] * (1.f + sc[3]) + sh[3]);
            *(GAS u32x2*)(xm + c) = w; }
    }
}
__device__ __forceinline__ void p1_router_weights(Frame& F) {
    LAS float* scr = (LAS float*)(F.lds + F.wave * 16384);
    const int gw = F.wg * NWAVES + F.wave, NGW = F.G * NWAVES;
    const float* MOD = (const float*)(F.ws + WS_MOD);
    for (int it = gw; it < DEPTH * 17 * 64; it += NGW) {
        const int lb = it >> 6, l = lb / 17, kb = (it & 63) >> 2, nb = it & 3;
        tr_item_ks(F.in[I_RW] + (size_t)l * DM * NEXP, NEXP, kb * 64, nb * 32, (bf16_t*)(F.ws + WS_WRB) + (size_t)lb * 128 * DM, DM, RowId{}, scr, F.lane, MOD + (size_t)lb * 6144 + 4096 + kb * 64); }
    for (int it = gw; it < DEPTH * 17 * 8; it += NGW) {
        const int lb = it >> 3, l = lb / 17, n = (it & 7) * 16 + (F.lane & 15), kq = F.lane >> 4;
        const float* sh = MOD + (size_t)lb * 6144 + 3072 + kq * 256; const float* w = F.in[I_RW] + (size_t)l * DM * NEXP + (size_t)(kq * 256) * NEXP + n;
        float a = 0.f;
#pragma unroll 8
        for (int k = 0; k < 256; ++k) a += sh[k] * w[(size_t)k * NEXP];
        a += shx(a, 16, F.lane); a += shx(a, 32, F.lane);
        if (kq == 0) ((float*)(F.ws + WS_RBIAS))[(size_t)lb * 128 + n] = a; }
}
constexpr float WEXP_SCALE = 32.0f;
constexpr int XW_ITEMS = NE1 * 384, XW_TAIL_E = 12288, XW_TAIL_G = 12288 + 7680;
__device__ __forceinline__ void p_expert_weights(Frame& F, int l, int it0, int it1, int nw, int w) {
    LAS float* scr = (LAS float*)(F.lds + F.wave * 16384);
    constexpr int I1 = 16 * 8, I2 = 4 * 32, PER_E = 2 * I1 + I2;
    for (int it = it0 + w; it < it1; it += nw) {
        const int e = it / PER_E; int r = it % PER_E;
        unsigned char* d1 = (unsigned char*)(F.ws + WS_EXP1) + (size_t)e * 512 * DM; unsigned char* d2 = (unsigned char*)(F.ws + WS_EXP2) + (size_t)e * DM * EH;
        if (r < 2 * I1) { const int up = r >= I1; if (up) r -= I1; const int kb = r / 8, nb = r % 8;
            const float* src = e < NEXP ? F.in[up ? I_WEU : I_WEG] + ((size_t)l * NEXP + e) * DM * EH : F.in[up ? I_WSU : I_WSG] + (size_t)l * DM * EH;
            tr_item8(src, EH, kb * 64, nb * 32, d1, DM, RowGU{up}, up ? WEXP_SCALE * 0.6931471805599453f : WEXP_SCALE * 1.4426950408889634f, scr, F.lane); }
        else { r -= 2 * I1; const int kb = r / 32, nb = r % 32;
            const float* src = e < NEXP ? F.in[I_WED] + ((size_t)l * NEXP + e) * EH * DM : F.in[I_WSD] + (size_t)l * EH * DM;
            tr_item8(src, DM, kb * 64, nb * 32, d2, EH, RowId{}, WEXP_SCALE, scr, F.lane); }
    }
}

__device__ __forceinline__ f32x4 mfma16(bf16x8 a, bf16x8 b, f32x4 c) { return __builtin_amdgcn_mfma_f32_16x16x32_bf16(a, b, c, 0, 0, 0); }

__device__ __forceinline__ void ph_transposes(Frame& F, int l) {
    LAS bf16_t* tile = (LAS bf16_t*)(F.lds + F.wave * 16384);
    const bf16_t* U = (const bf16_t*)(F.ws + WS_U);
    const int gw = F.wg * NWAVES + F.wave, NGW = F.G * NWAVES;
    const int rsub = F.lane >> 3, cseg = F.lane & 7;
    for (int u = gw; u < 1088 * 12; u += NGW) {
        const int tt = u / 12, blk = u % 12;
        int b, s0, Ls, rowbase, posbase;
        if (tt < 1024) { b = tt >> 6; s0 = (tt & 63) * 64; Ls = SEQ; rowbase = b * SEQ; posbase = 0; }
        else { const int t2 = tt - 1024; b = t2 >> 2; s0 = (t2 & 3) * 64; Ls = CTXL; rowbase = NLAT + b * CTXL; posbase = SEQ; }
        if (blk < 12) {
            constexpr int HT = 80;
            float w0[8], w1[8], w2[8], bb[8];
#pragma unroll
            for (int it = 0; it < 8; ++it) { const int col = blk * 64 + rsub + 8 * it; w0[it] = F.in[I_HSW][(l * 3 + 0) * 768 + col]; w1[it] = F.in[I_HSW][(l * 3 + 1) * 768 + col]; w2[it] = F.in[I_HSW][(l * 3 + 2) * 768 + col]; bb[it] = F.in[I_HSB][l * 768 + col]; }
            const bf16_t* p0 = U + (size_t)(rowbase + s0 + rsub) * DIN + UHY + blk * 64 + cseg * 8;
            u32x4 zc[8];
#pragma unroll
            for (int it = 0; it < 8; ++it) zc[it] = *(const GAS u32x4*)(p0 + (size_t)(8 * it) * DIN);
            u32x4 zh = (u32x4){0u, 0u, 0u, 0u};
            if (F.lane < 16) { const int hs = F.lane < 8 ? s0 - 1 : s0 + 64; if (hs >= 0 && hs < Ls) zh = *(const GAS u32x4*)(U + (size_t)(rowbase + hs) * DIN + UHY + blk * 64 + cseg * 8); }
#pragma unroll
            for (int it = 0; it < 8; ++it) { const unsigned a[4] = {zc[it].x, zc[it].y, zc[it].z, zc[it].w}; LAS bf16_t* d = tile + (cseg * 8) * HT + 8 + rsub + 8 * it;
#pragma unroll
                for (int i = 0; i < 4; ++i) { d[(2 * i) * HT] = (bf16_t)(a[i] & 0xffffu); d[(2 * i + 1) * HT] = (bf16_t)(a[i] >> 16); } }
            if (F.lane < 16) { const unsigned a[4] = {zh.x, zh.y, zh.z, zh.w}; LAS bf16_t* d = tile + (cseg * 8) * HT + (F.lane < 8 ? 7 : 72);
#pragma unroll
                for (int i = 0; i < 4; ++i) { d[(2 * i) * HT] = (bf16_t)(a[i] & 0xffffu); d[(2 * i + 1) * HT] = (bf16_t)(a[i] >> 16); } }
            LDS_WAIT(); asm volatile("" ::: "memory");
#pragma unroll
            for (int it = 0; it < 8; ++it) {
                const int ch = rsub + 8 * it; const LAS bf16_t* r = tile + ch * HT + 8 + cseg * 8;
                const u32x4 v = *(const LAS u32x4*)r; const unsigned hm = r[-1], hp = r[8];
                float x[10]; x[0] = __builtin_bit_cast(float, hm << 16); x[9] = __builtin_bit_cast(float, hp << 16);
                x[1] = bflo(v.x); x[2] = bfhi(v.x); x[3] = bflo(v.y); x[4] = bfhi(v.y); x[5] = bflo(v.z); x[6] = bfhi(v.z); x[7] = bflo(v.w); x[8] = bfhi(v.w);
                unsigned w[4];
#pragma unroll
                for (int i = 0; i < 4; ++i) w[i] = pk2(bb[it] + w0[it] * x[2 * i] + w1[it] * x[2 * i + 1] + w2[it] * x[2 * i + 2], bb[it] + w0[it] * x[2 * i + 1] + w1[it] * x[2 * i + 2] + w2[it] * x[2 * i + 3]);
                *(GAS u32x4*)((bf16_t*)(F.ws + WS_HV) + ((size_t)(blk * 64 + ch) * NB + b) * SPB + posbase + s0 + cseg * 8) = (u32x4){w[0], w[1], w[2], w[3]};
            }
            LDS_WAIT(); asm volatile("" ::: "memory");
            continue;
        } else {
            const int c0 = (blk - 12) * 64 + cseg * 8;
#pragma unroll
            for (int it = 0; it < 8; ++it) {
                const int sl = rsub + 8 * it, s = s0 + sl;
                const u32x4 zc = *(const GAS u32x4*)(U + (size_t)(rowbase + s) * DIN + UV + c0);
                const unsigned ac[4] = {zc.x, zc.y, zc.z, zc.w};
#pragma unroll
                for (int i = 0; i < 4; ++i) { tile[(cseg * 8 + 2 * i) * 72 + sl] = (bf16_t)(ac[i] & 0xffffu); tile[(cseg * 8 + 2 * i + 1) * 72 + sl] = (bf16_t)(ac[i] >> 16); }
            }
        }
        LDS_WAIT(); asm volatile("" ::: "memory");
#pragma unroll 2
        for (int it = 0; it < 8; ++it) {
            const int ch = rsub + 8 * it;
            const u32x4 v = *(const LAS u32x4*)(tile + ch * 72 + cseg * 8);
            bf16_t* dst;
            if (blk < 12) dst = (bf16_t*)(F.ws + WS_HV) + ((size_t)(blk * 64 + ch) * NB + b) * SPB + posbase + s0 + cseg * 8;
            else dst = (bf16_t*)(F.ws + WS_VT) + ((size_t)b * 512 + (blk - 12) * 64 + ch) * SPB + posbase + s0 + cseg * 8;
            *(GAS u32x4*)dst = v;
        }
        LDS_WAIT(); asm volatile("" ::: "memory");
    }
}

constexpr int NA_RPB = 0, NA_KC = 2048, NA_VC = NA_KC + 256 * 144, NA_KR = NA_VC + 64 * 528, NA_END = NA_KR + 9 * 64 * 144;
static_assert(NA_END <= MISC_OFF, "NA LDS map");
__device__ __forceinline__ bf16x8 gld16(const bf16_t* p) { return *(const GAS bf16x8*)p; }
__device__ __forceinline__ u32x2 gld8(const bf16_t* p) { return *(const GAS u32x2*)p; }
__device__ __forceinline__ const char* uni_ptr(const char* p) { const unsigned long long v = (unsigned long long)p; const unsigned lo = __builtin_amdgcn_readfirstlane((unsigned)v), hi = __builtin_amdgcn_readfirstlane((unsigned)(v >> 32)); return (const char*)(((unsigned long long)hi << 32) | lo); }
__device__ __forceinline__ bf16x8 gld16o(const char* ub, unsigned lo) { return *(const GAS bf16x8*)(ub + (size_t)lo); }
__device__ __forceinline__ u32x2 gld8o(const char* ub, unsigned lo) { return *(const GAS u32x2*)(ub + (size_t)lo); }
template <bool WIN>
__device__ __forceinline__ void na_unit(Frame& F, int b, int h, int r, int strip) {
    const bf16_t* U = (const bf16_t*)(F.ws + WS_U);
    const bf16_t* VT = (const bf16_t*)(F.ws + WS_VT) + ((size_t)b * 512 + h * 64) * SPB;
    const LAS float* rpb = (const LAS float*)(F.lds + NA_RPB);
    const LAS bf16_t* KC = (const LAS bf16_t*)(F.lds + NA_KC); const LAS bf16_t* VC = (const LAS bf16_t*)(F.lds + NA_VC);
    int ln_ = F.lane; asm volatile("" : "+v"(ln_));
    const int i = ln_ & 15, g = ln_ >> 4;
    const int qrow0 = WIN ? (b * SEQ + r * 64 + strip * 16) : (NLAT + b * CTXL + strip * 16);
    const int ki = 8 * (i >> 2) + (i & 3);
    const unsigned qlo = (unsigned)((i * DIN + 8 * g) * 2), klo = (unsigned)((ki * DIN + 8 * g) * 2), vlo = (unsigned)((i * SPB + 8 * g) * 2);
    const char* qb = uni_ptr((const char*)(U + (size_t)qrow0 * DIN + UQ + h * 64));
    const bf16x8 q0 = gld16o(qb, qlo), q1 = gld16o(qb + 64, qlo);
    int kr0 = 0, u0 = 0;
    if (WIN) { kr0 = r - 4; kr0 = kr0 < 0 ? 0 : (kr0 > 56 ? 56 : kr0); u0 = strip == 0 ? 0 : (strip == 1 ? 8 : (strip == 2 ? 24 : 32)); }
    const LAS bf16_t* KR = (const LAS bf16_t*)(F.lds + NA_KR);
    const char* vbase = uni_ptr((const char*)(VT + kr0 * 64 + u0));
    f32x4 o[4];
#pragma unroll
    for (int d = 0; d < 4; ++d) o[d] = (f32x4){0.f, 0.f, 0.f, 0.f};
    float lsum = 0.f;
#define NA_SB() __builtin_amdgcn_sched_barrier(0)
#define NA_WLOAD(vb_, cw) do { _Pragma("unroll") for (int d = 0; d < 4; ++d) vb_[d] = gld16o(vbase + ((size_t)(d * 16) * SPB + (cw) * 64) * 2, vlo); } while (0)
#define NA_KRING(kb_, cw) do { const LAS bf16_t* kp = KR + ((((kr0 + (cw)) % 9) * 64 + u0 + ki) * 72 + 8 * g); kb_[0][0] = *(const LAS bf16x8*)kp; kb_[0][1] = *(const LAS bf16x8*)(kp + 32); \
        kb_[1][0] = *(const LAS bf16x8*)(kp + 4 * 72); kb_[1][1] = *(const LAS bf16x8*)(kp + 4 * 72 + 32); } while (0)
#define NA_QK(kb_, s_) do { _Pragma("unroll") for (int t = 0; t < 2; ++t) { f32x4 a = (f32x4){0.f, 0.f, 0.f, 0.f}; a = mfma16(kb_[t][0], q0, a); a = mfma16(kb_[t][1], q1, a); s_[t] = a; } } while (0)
#define NA_PV(s_, vb_) do { u32x4 pw; pw.x = pk2(s_[0][0], s_[0][1]); pw.y = pk2(s_[0][2], s_[0][3]); pw.z = pk2(s_[1][0], s_[1][1]); pw.w = pk2(s_[1][2], s_[1][3]); const bf16x8 pf = __builtin_bit_cast(bf16x8, pw); \
        _Pragma("unroll") for (int d = 0; d < 4; ++d) o[d] = mfma16(vb_[d], pf, o[d]); } while (0)
    bf16x8 vA[4], vB[4], vC[4];
    if (WIN) { NA_WLOAD(vA, 0); NA_WLOAD(vB, 1); NA_WLOAD(vC, 2); NA_SB(); }
#pragma unroll
    for (int cc = 0; cc < 8; ++cc) {
        bf16x8 kc[2][2], vc[4]; f32x4 sc[2];
#pragma unroll
        for (int t = 0; t < 2; ++t) { const LAS bf16_t* kp = KC + (cc * 32 + ki + 4 * t) * 72 + 8 * g; kc[t][0] = *(const LAS bf16x8*)kp; kc[t][1] = *(const LAS bf16x8*)(kp + 32); }
#pragma unroll
        for (int d = 0; d < 4; ++d) vc[d] = *(const LAS bf16x8*)(VC + (d * 16 + i) * 264 + cc * 32 + 8 * g);
        NA_QK(kc, sc);
#pragma unroll
        for (int t = 0; t < 2; ++t)
#pragma unroll
            for (int e = 0; e < 4; ++e) { const float p = __builtin_amdgcn_exp2f(fminf(sc[t][e], NA_CLAMP)); sc[t][e] = p; lsum += p; }
        NA_PV(sc, vc);
    }
    if (WIN) {
        const int c = strip * 16 + i; int kc0 = c - 8; kc0 = kc0 < 0 ? 0 : (kc0 > 48 ? 48 : kc0);
        int dcl[2][4]; bool okm[2][4];
#pragma unroll
        for (int t = 0; t < 2; ++t)
#pragma unroll
            for (int e = 0; e < 4; ++e) { const int kc = u0 + 8 * g + 4 * t + e; okm[t][e] = (kc >= kc0) && (kc < kc0 + 16); int dc = kc - c + 15; dcl[t][e] = okm[t][e] ? (dc < 0 ? 0 : (dc > 30 ? 30 : dc)) : 31; }
#define NA_WCHUNK(vb_, cw) do { bf16x8 kw[2][2]; NA_KRING(kw, cw); f32x4 sw[2]; NA_QK(kw, sw); const LAS float* rp = rpb + (kr0 + (cw) - r + 7) * 32; \
        _Pragma("unroll") for (int t = 0; t < 2; ++t) _Pragma("unroll") for (int e = 0; e < 4; ++e) { const float x = sw[t][e] + rp[dcl[t][e]]; const float p = __builtin_amdgcn_exp2f(fminf(x, NA_CLAMP)); sw[t][e] = p; lsum += p; } \
        NA_PV(sw, vb_); } while (0)
        NA_WCHUNK(vA, 0); NA_SB(); NA_WLOAD(vA, 3); NA_SB();
        NA_WCHUNK(vB, 1); NA_SB(); NA_WLOAD(vB, 4); NA_SB();
        NA_WCHUNK(vC, 2); NA_SB(); NA_WLOAD(vC, 5); NA_SB();
        NA_WCHUNK(vA, 3); NA_SB(); NA_WLOAD(vA, 6); NA_SB();
        NA_WCHUNK(vB, 4); NA_SB(); NA_WLOAD(vB, 7); NA_SB();
        NA_WCHUNK(vC, 5); NA_SB();
        NA_WCHUNK(vA, 6); NA_SB();
        NA_WCHUNK(vB, 7); NA_SB();
#undef NA_WCHUNK
    }
    lsum += shx(lsum, 16, ln_); lsum += shx(lsum, 32, ln_);
    const float inv = 1.0f / lsum;
    char* op = (char*)uni_ptr((const char*)((bf16_t*)(F.ws + WS_MIX) + (size_t)qrow0 * DM + h * 64)); const unsigned olo = (unsigned)((i * DM + 4 * g) * 2);
#pragma unroll
    for (int d = 0; d < 4; ++d) { u32x2 w; w.x = pk2(o[d][0] * inv, o[d][1] * inv); w.y = pk2(o[d][2] * inv, o[d][3] * inv); *(GAS u32x2*)(op + d * 32 + (size_t)olo) = w; }
#undef NA_SB
#undef NA_WLOAD
#undef NA_KRING
#undef NA_QK
#undef NA_PV
}
__device__ __forceinline__ int na_kr0(int r) { const int k = r - 4; return k < 0 ? 0 : (k > 56 ? 56 : k); }
__device__ __forceinline__ void ph_na(Frame& F, int l, bool last) {
    const bf16_t* U = (const bf16_t*)(F.ws + WS_U);
    for (int job = F.wg; job < NB * 8 * 2; job += F.G) {
        const int half = job & 1, h = (job >> 1) & 7, b = job >> 4;
        int tz_; asm volatile("v_mbcnt_lo_u32_b32 %0, -1, 0\n\tv_mbcnt_hi_u32_b32 %0, -1, %0" : "=v"(tz_)); tz_ |= F.wave << 6;
        const bf16_t* krow = U + (size_t)(b * SEQ + (tz_ >> 3)) * DIN + UK + h * 64 + (tz_ & 7) * 8;
        LAS bf16_t* kdst = (LAS bf16_t*)(F.lds + NA_KR) + (tz_ >> 3) * 72 + (tz_ & 7) * 8;
        __syncthreads();
        { LAS float* rpb = (LAS float*)(F.lds + NA_RPB); const float* rsrc = F.in[I_RPB] + ((size_t)l * 8 + h) * 15 * 31;
          if (tz_ < 15 * 32) rpb[tz_] = (tz_ & 31) < 31 ? rsrc[(tz_ >> 5) * 31 + (tz_ & 31)] * 1.4426950408889634f : -1e30f;
          const int key = tz_ >> 1, hf = tz_ & 1; const bf16_t* src = U + (size_t)(NLAT + b * CTXL + key) * DIN + UK + h * 64 + hf * 32; LAS bf16_t* dst = (LAS bf16_t*)(F.lds + NA_KC) + key * 72 + hf * 32;
#pragma unroll
          for (int j = 0; j < 4; ++j) *(LAS bf16x8*)(dst + j * 8) = gld16(src + j * 8);
          const int dv = tz_ >> 3, seg = tz_ & 7; const bf16_t* vs = (const bf16_t*)(F.ws + WS_VT) + ((size_t)b * 512 + h * 64 + dv) * SPB + SEQ + seg * 32; LAS bf16_t* vd = (LAS bf16_t*)(F.lds + NA_VC) + dv * 264 + seg * 32;
#pragma unroll
          for (int j = 0; j < 4; ++j) *(LAS bf16x8*)(vd + j * 8) = gld16(vs + j * 8);
          const int lo = na_kr0(half * 32), hi0 = na_kr0(half * 32 + 1) + 7;
          for (int kr = lo; kr <= hi0; ++kr) *(LAS bf16x8*)(kdst + (kr % 9) * 64 * 72) = gld16(krow + (size_t)kr * 64 * DIN); }
        __syncthreads();
        int prev_hi = na_kr0(half * 32 + 1) + 7;
#pragma unroll 1
        for (int s = 0; s < 16; ++s) {
            const int r0 = half * 32 + 2 * s;
            const int nhi = s < 15 ? na_kr0(r0 + 3) + 7 : prev_hi;
            bf16x8 n0 = (bf16x8){0, 0, 0, 0, 0, 0, 0, 0}, n1 = n0;
            if (nhi > prev_hi) n0 = gld16(krow + (size_t)(prev_hi + 1) * 64 * DIN);
            if (nhi > prev_hi + 1) n1 = gld16(krow + (size_t)(prev_hi + 2) * 64 * DIN);
            na_unit<true>(F, b, h, r0 + (F.wave >> 2), F.wave & 3);
            __syncthreads();
            if (nhi > prev_hi) *(LAS bf16x8*)(kdst + ((prev_hi + 1) % 9) * 64 * 72) = n0;
            if (nhi > prev_hi + 1) *(LAS bf16x8*)(kdst + ((prev_hi + 2) % 9) * 64 * 72) = n1;
            __syncthreads();
            prev_hi = nhi;
        }
        if (!last) na_unit<false>(F, b, h, 0, half * 8 + F.wave);
    }
}

__device__ __forceinline__ void ph_hy_transpose(Frame& F, bool last) {
    LAS bf16_t* tile = (LAS bf16_t*)(F.lds + F.wave * 16384);
    const bf16_t* HYO = (const bf16_t*)(F.ws + WS_Y);
    const int gw = F.wg * NWAVES + F.wave, NGW = F.G * NWAVES;
    const int rsub = F.lane >> 3, cseg = F.lane & 7;
    const int ntt = last ? 1024 : 1088;
    for (int u = gw; u < ntt * 4; u += NGW) {
        const int tt = u >> 2, cb = u & 3;
        int b, s0, rowbase, posbase;
        if (tt < 1024) { b = tt >> 6; s0 = (tt & 63) * 64; rowbase = b * SEQ; posbase = 0; }
        else { const int t2 = tt - 1024; b = t2 >> 2; s0 = (t2 & 3) * 64; rowbase = NLAT + b * CTXL; posbase = SEQ; }
#pragma unroll 2
        for (int it = 0; it < 8; ++it) { const int c = rsub + 8 * it;
            const u32x4 v = *(const GAS u32x4*)(HYO + ((size_t)(cb * 64 + c) * NB + b) * SPB + posbase + s0 + cseg * 8); const unsigned a[4] = {v.x, v.y, v.z, v.w};
#pragma unroll
            for (int e = 0; e < 4; ++e) { tile[(cseg * 8 + 2 * e) * 72 + c] = (bf16_t)(a[e] & 0xffffu); tile[(cseg * 8 + 2 * e + 1) * 72 + c] = (bf16_t)(a[e] >> 16); } }
        LDS_WAIT(); asm volatile("" ::: "memory");
#pragma unroll 2
        for (int it = 0; it < 8; ++it) { const int p = rsub + 8 * it;
            const u32x4 v = *(const LAS u32x4*)(tile + p * 72 + cseg * 8);
            *(GAS u32x4*)((bf16_t*)(F.ws + WS_MIX) + (size_t)(rowbase + s0 + p) * DM + 768 + cb * 64 + cseg * 8) = v; }
        LDS_WAIT(); asm volatile("" ::: "memory");
    }
}

constexpr int G2_LAF = 0, G2_LAB = 8448;
constexpr int G2_QTF = 16896, G2_KTF = 22016, G2_QTB = 27136, G2_KTB = 32256;
constexpr int G2_VT = 37376, G2_ATT = 46592;
constexpr int G2_SF = 55808, G2_SB = 60928;
constexpr int G2_SEG = 66048, G2_HALF = 67328;
__device__ __forceinline__ float log_sigmoid_f(float x) { return fminf(x, 0.f) - __logf(1.0f + __expf(-fabsf(x))); }
__device__ __forceinline__ f32x4 mma_lds(const LAS bf16_t* A, int lda, const LAS bf16_t* B, int ldb, int ksteps, f32x4 acc, int lane) {
    const int r = lane & 15, g = lane >> 4;
    for (int ks = 0; ks < ksteps; ++ks) { const bf16x8 a = *(const LAS bf16x8*)(A + r * lda + ks * 32 + 8 * g), b = *(const LAS bf16x8*)(B + r * ldb + ks * 32 + 8 * g); acc = mfma16(a, b, acc); }
    return acc;
}
__device__ __forceinline__ int gla_row0(int b, int cn) { return cn >= 4 ? b * SEQ + (cn - 4) * 64 : NLAT + b * CTXL + cn * 64; }
struct GlaRaw { u32x4 q, k, f, b, v0, v1, g0, g1, s0, s1; };
template <bool FULL>
__device__ __forceinline__ GlaRaw gla_load(Frame& F, int u, int tl) {
    const int h = u & 3, cn = (u >> 2) % 68, b = (u >> 2) / 68, i = tl >> 2, part = tl & 3;
    const bf16_t* p = (const bf16_t*)(F.ws + WS_U) + (size_t)(gla_row0(b, cn) + i) * DIN;
    GlaRaw r;
    r.q = *(const GAS u32x4*)(p + UGQ + h * 32 + part * 8); r.k = *(const GAS u32x4*)(p + UGK + h * 32 + part * 8);
    r.f = *(const GAS u32x4*)(p + ULAF + h * 32 + part * 8); r.b = *(const GAS u32x4*)(p + ULAB + h * 32 + part * 8);
    r.v0 = *(const GAS u32x4*)(p + UGV + h * 64 + part * 16); r.v1 = *(const GAS u32x4*)(p + UGV + h * 64 + part * 16 + 8);
    if (FULL) { r.g0 = *(const GAS u32x4*)(p + UGR + h * 64 + part * 16); r.g1 = *(const GAS u32x4*)(p + UGR + h * 64 + part * 16 + 8);
        const bf16_t* sp = (const bf16_t*)(F.ws + WS_GSIN) + (size_t)u * 2 * 2048 + tl * 16; r.s0 = *(const GAS u32x4*)sp; r.s1 = *(const GAS u32x4*)(sp + 8); }
    else { r.g0 = (u32x4){0u, 0u, 0u, 0u}; r.g1 = r.g0; r.s0 = r.g0; r.s1 = r.g0; }
    return r;
}
template <bool FULL>
__device__ __forceinline__ void gla_prep(Frame& F, LAS unsigned char* L, int l, int u, int tl, const GlaRaw& raw) {
    const int h = u & 3, cn = (u >> 2) % 68, i = tl >> 2, part = tl & 3, d8 = part * 8;
    LAS float* LAF = (LAS float*)(L + G2_LAF); LAS float* LAB = (LAS float*)(L + G2_LAB); LAS bf16_t* VT = (LAS bf16_t*)(L + G2_VT); LAS float* SEG = (LAS float*)(L + G2_SEG);
    float q[8], k[8], tf[8], tb[8];
    unpack8(raw.q, q); unpack8(raw.k, k); unpack8(raw.f, tf); unpack8(raw.b, tb);
    const float* ba = F.in[I_BA2] + (size_t)l * 256 + h * 32 + d8;
#pragma unroll
    for (int e = 0; e < 8; ++e) { q[e] *= 0.17677669529663687f; LAF[i * 33 + d8 + e] = log_sigmoid_f(tf[e] + ba[e]) * 0.0625f; LAB[i * 33 + d8 + e] = log_sigmoid_f(tb[e] + ba[128 + e]) * 0.0625f; }
    if (cn >= 4) {
        const float pos = (part >> 1) ? (float)i : (float)(cn - 4);
#pragma unroll
        for (int e = 0; e < 8; ++e) { const float ang = pos * __expf(-(float)e * (9.210340371976184f / 8.0f)); const float sn = __sinf(ang), cs = __cosf(ang);
            const float qo = shx(q[e], 1, F.lane), ko = shx(k[e], 1, F.lane);
            if (part & 1) { q[e] = qo * sn + q[e] * cs; k[e] = ko * sn + k[e] * cs; } else { q[e] = q[e] * cs - qo * sn; k[e] = k[e] * cs - ko * sn; } }
    }
    { const unsigned a[8] = {raw.v0.x, raw.v0.y, raw.v0.z, raw.v0.w, raw.v1.x, raw.v1.y, raw.v1.z, raw.v1.w};
#pragma unroll
      for (int e = 0; e < 8; ++e) { VT[(part * 16 + 2 * e) * 72 + i] = (bf16_t)(a[e] & 0xffffu); VT[(part * 16 + 2 * e + 1) * 72 + i] = (bf16_t)(a[e] >> 16); } }
    __syncthreads();
    { const int x = tl & 63, d = x & 31, dir = x >> 5, seg = tl >> 6; LAS float* LA = (dir ? LAB : LAF) + d; float cv[16];
#pragma unroll
      for (int kk = 0; kk < 16; ++kk) { const int p = seg * 16 + kk, ti = dir ? 63 - p : p; cv[kk] = LA[ti * 33]; }
#pragma unroll
      for (int kk = 1; kk < 16; ++kk) cv[kk] += cv[kk - 1];
#pragma unroll
      for (int kk = 0; kk < 16; ++kk) { const int p = seg * 16 + kk, ti = dir ? 63 - p : p; LA[ti * 33] = cv[kk]; }
      SEG[x * 5 + seg] = cv[15]; }
    __syncthreads();
    { const int x = tl & 63, d = x & 31, dir = x >> 5, seg = tl >> 6; LAS float* LA = (dir ? LAB : LAF) + d; float cv[16];
      const float t0 = SEG[x * 5 + 0], t1 = SEG[x * 5 + 1], t2 = SEG[x * 5 + 2];
      const float pre = seg == 0 ? 0.f : (seg == 1 ? t0 : (seg == 2 ? t0 + t1 : t0 + t1 + t2));
#pragma unroll
      for (int kk = 0; kk < 16; ++kk) { const int p = seg * 16 + kk, ti = dir ? 63 - p : p; cv[kk] = LA[ti * 33]; }
#pragma unroll
      for (int kk = 0; kk < 16; ++kk) { const int p = seg * 16 + kk, ti = dir ? 63 - p : p; LA[ti * 33] = cv[kk] + pre; } }
    __syncthreads();
    if (FULL) {
        unsigned wqf[4], wkf[4], wqb[4], wkb[4];
#pragma unroll
        for (int e = 0; e < 4; ++e) { const int d = d8 + 2 * e; const float f0 = LAF[i * 33 + d], f1 = LAF[i * 33 + d + 1], b0 = LAB[i * 33 + d], b1 = LAB[i * 33 + d + 1];
            wqf[e] = pk2(q[2 * e] * __expf(f0), q[2 * e + 1] * __expf(f1)); wkf[e] = pk2(k[2 * e] * __expf(-f0), k[2 * e + 1] * __expf(-f1));
            wqb[e] = pk2(q[2 * e] * __expf(b0), q[2 * e + 1] * __expf(b1)); wkb[e] = pk2(k[2 * e] * __expf(-b0), k[2 * e + 1] * __expf(-b1)); }
        *(LAS u32x4*)((LAS bf16_t*)(L + G2_QTF) + i * 40 + d8) = (u32x4){wqf[0], wqf[1], wqf[2], wqf[3]}; *(LAS u32x4*)((LAS bf16_t*)(L + G2_KTF) + i * 40 + d8) = (u32x4){wkf[0], wkf[1], wkf[2], wkf[3]};
        *(LAS u32x4*)((LAS bf16_t*)(L + G2_QTB) + i * 40 + d8) = (u32x4){wqb[0], wqb[1], wqb[2], wqb[3]}; *(LAS u32x4*)((LAS bf16_t*)(L + G2_KTB) + i * 40 + d8) = (u32x4){wkb[0], wkb[1], wkb[2], wkb[3]};
    } else {
        LAS bf16_t* KDF = (LAS bf16_t*)(L + G2_QTF); LAS bf16_t* KDB = (LAS bf16_t*)(L + G2_KTF);
#pragma unroll
        for (int e = 0; e < 8; ++e) { const int d = d8 + e; const float bf = LAF[i * 33 + d], bb = LAB[i * 33 + d], bfl = LAF[63 * 33 + d], bbl = LAB[0 * 33 + d];
            KDF[d * 72 + i] = (bf16_t)f2bf(k[e] * __expf(bfl - bf)); KDB[d * 72 + i] = (bf16_t)f2bf(k[e] * __expf(bbl - bb)); }
    }
    __syncthreads();
}
__device__ __forceinline__ void ph_gla_local(Frame& F, int l) {
    const int hw = F.wave >> 2, wl = F.wave & 3, tl = F.tid & 255; LAS unsigned char* L = F.lds + hw * G2_HALF;
    constexpr int NU = NB * 68 * 4;
    int pp = F.wg;
    GlaRaw raw = gla_load<false>(F, (pp * 2 + hw) < NU ? pp * 2 + hw : 0, tl);
    for (; pp * 2 < NU; pp += F.G) {
        const int u = pp * 2 + hw, un = (pp + F.G) * 2 + hw;
        const GlaRaw nraw = gla_load<false>(F, un < NU ? un : u, tl);
        __syncthreads();
        gla_prep<false>(F, L, l, u, tl, raw);
        const int g = F.lane >> 4, c = F.lane & 15;
        float* DS = (float*)(F.ws + WS_GDS) + (size_t)u * 2 * 2048;
#pragma unroll
        for (int kk = 0; kk < 4; ++kk) { const int tix = wl * 4 + kk, dir = tix >> 3, mt = (tix >> 1) & 3, nt = tix & 1;
            f32x4 a = (f32x4){0.f, 0.f, 0.f, 0.f};
            a = mma_lds((const LAS bf16_t*)(L + G2_VT) + mt * 16 * 72, 72, (const LAS bf16_t*)(L + (dir ? G2_KTF : G2_QTF)) + nt * 16 * 72, 72, 2, a, F.lane);
#pragma unroll
            for (int e = 0; e < 4; ++e) DS[dir * 2048 + (mt * 16 + 4 * g + e) * 32 + nt * 16 + c] = a[e]; }
        if (tl < 64) { const int d = tl & 31, dir = tl >> 5; ((float*)(F.ws + WS_GD))[(size_t)u * 64 + tl] = __expf(dir ? ((LAS float*)(L + G2_LAB))[0 * 33 + d] : ((LAS float*)(L + G2_LAF))[63 * 33 + d]); }
        raw = nraw;
    }
}
__device__ __forceinline__ void ph_gla_scan(Frame& F) {
    const int gt = F.wg * NTHR + F.tid, NGT = F.G * NTHR;
    const float* DS = (const float*)(F.ws + WS_GDS); const float* GD = (const float*)(F.ws + WS_GD); bf16_t* SIN = (bf16_t*)(F.ws + WS_GSIN);
    for (int w = gt; w < 128 * 1024; w += NGT) {
        const int chain = w >> 10, el = (w & 1023) * 2, dir = chain & 1, h = (chain >> 1) & 3, b = chain >> 3, d = el & 31;
        float s0 = 0.f, s1 = 0.f;
        for (int step = 0; step < 68; step += 4) {
            f32x2 ds[4], dd[4]; size_t uu[4];
#pragma unroll
            for (int q = 0; q < 4; ++q) { const int st_ = step + q; const int cn = dir ? (st_ < 4 ? 3 - st_ : 71 - st_) : st_;
                uu[q] = (size_t)(b * 68 + cn) * 4 + h;
                ds[q] = *(const GAS f32x2*)(DS + (uu[q] * 2 + dir) * 2048 + el); dd[q] = *(const GAS f32x2*)(GD + uu[q] * 64 + dir * 32 + d); }
#pragma unroll
            for (int q = 0; q < 4; ++q) { *(GAS unsigned*)(SIN + (uu[q] * 2 + dir) * 2048 + el) = pk2(s0, s1); s0 = dd[q].x * s0 + ds[q].x; s1 = dd[q].y * s1 + ds[q].y; }
        }
    }
}
__device__ __forceinline__ void ph_gla_out(Frame& F, int l, bool last) {
    const int hw = F.wave >> 2, wl = F.wave & 3, tl = F.tid & 255; LAS unsigned char* L = F.lds + hw * G2_HALF;
    const int NV = last ? NB * 64 * 4 : NB * 68 * 4;
#define GLA_UNIT(v) (last ? ((((v) >> 8) * 68 + 4 + (((v) & 255) >> 2)) * 4 + ((v) & 3)) : (v))
    int pp = F.wg;
    GlaRaw raw = gla_load<true>(F, GLA_UNIT((pp * 2 + hw) < NV ? pp * 2 + hw : 0), tl);
    for (; pp * 2 < NV; pp += F.G) {
        const int u = GLA_UNIT(pp * 2 + hw), vn = (pp + F.G) * 2 + hw;
        const GlaRaw nraw = gla_load<true>(F, vn < NV ? GLA_UNIT(vn) : u, tl);
        const int h = u & 3, cn = (u >> 2) % 68, b = (u >> 2) / 68;
        __syncthreads();
        gla_prep<true>(F, L, l, u, tl, raw);
        { const int dir = tl >> 7, dv = (tl >> 1) & 63, d16 = (tl & 1) * 16; LAS bf16_t* S = (LAS bf16_t*)(L + (dir ? G2_SB : G2_SF)) + dv * 40 + d16; *(LAS u32x4*)S = raw.s0; *(LAS u32x4*)(S + 8) = raw.s1; }
        const int g = F.lane >> 4, c = F.lane & 15;
        LAS bf16_t* ATT = (LAS bf16_t*)(L + G2_ATT);
#pragma unroll
        for (int kk = 0; kk < 4; ++kk) { const int tile = wl * 4 + kk, mt = tile >> 2, nt = tile & 3;
            f32x4 af = (f32x4){0.f, 0.f, 0.f, 0.f}, ab = af;
            af = mma_lds((const LAS bf16_t*)(L + G2_QTF) + mt * 16 * 40, 40, (const LAS bf16_t*)(L + G2_KTF) + nt * 16 * 40, 40, 1, af, F.lane);
            ab = mma_lds((const LAS bf16_t*)(L + G2_QTB) + mt * 16 * 40, 40, (const LAS bf16_t*)(L + G2_KTB) + nt * 16 * 40, 40, 1, ab, F.lane);
#pragma unroll
            for (int e = 0; e < 4; ++e) { const int ii = mt * 16 + 4 * g + e, j = nt * 16 + c; const float vv = (j <= ii ? af[e] : 0.f) + (j >= ii ? ab[e] : 0.f); ATT[ii * 72 + j] = (bf16_t)f2bf(vv); } }
        __syncthreads();
        LAS float* O = (LAS float*)(L + G2_LAF);
#pragma unroll
        for (int kk = 0; kk < 4; ++kk) { const int tile = wl * 4 + kk, mt = tile >> 2, nt = tile & 3;
            f32x4 a = (f32x4){0.f, 0.f, 0.f, 0.f};
            a = mma_lds(ATT + mt * 16 * 72, 72, (const LAS bf16_t*)(L + G2_VT) + nt * 16 * 72, 72, 2, a, F.lane);
            a = mma_lds((const LAS bf16_t*)(L + G2_QTF) + mt * 16 * 40, 40, (const LAS bf16_t*)(L + G2_SF) + nt * 16 * 40, 40, 1, a, F.lane);
            a = mma_lds((const LAS bf16_t*)(L + G2_QTB) + mt * 16 * 40, 40, (const LAS bf16_t*)(L + G2_SB) + nt * 16 * 40, 40, 1, a, F.lane);
#pragma unroll
            for (int e = 0; e < 4; ++e) O[(mt * 16 + 4 * g + e) * 65 + nt * 16 + c] = a[e]; }
        __syncthreads();
        { const int i = tl >> 2, dv16 = (tl & 3) * 16; const int row = gla_row0(b, cn) + i;
          float v[16], gt[16]; float ss = 0.f;
#pragma unroll
          for (int e = 0; e < 16; ++e) { v[e] = O[i * 65 + dv16 + e]; ss += v[e] * v[e]; }
          ss += shx(ss, 1, F.lane); ss += shx(ss, 2, F.lane);
          const float rs = 1.0f / sqrtf(ss * (1.0f / 64.0f) + LN_EPS);
          unpack8(raw.g0, gt); unpack8(raw.g1, gt + 8);
          const float* gn = F.in[I_GNORM] + l * 64 + dv16;
          unsigned w[8];
#pragma unroll
          for (int e = 0; e < 8; ++e) w[e] = pk2(v[2 * e] * rs * gn[2 * e] * silu_f(gt[2 * e]), v[2 * e + 1] * rs * gn[2 * e + 1] * silu_f(gt[2 * e + 1]));
          bf16_t* mp = (bf16_t*)(F.ws + WS_MIX) + (size_t)row * DM + 512 + h * 64 + dv16;
          *(GAS u32x4*)mp = (u32x4){w[0], w[1], w[2], w[3]}; *(GAS u32x4*)(mp + 8) = (u32x4){w[4], w[5], w[6], w[7]}; }
        raw = nraw;
    }
#undef GLA_UNIT
}

template <int L>
__device__ __forceinline__ void hyena_conv(Frame& F, const bf16_t* Rg, const bf16_t* Uin, const bf16_t* Xmul, int pos0, bool final_out, int ch, bf16_t* Zout) {
    constexpr int CS = 2 * L + 16;
    constexpr int NTL = L / 16, J = (NTL >= 64) ? 16 : 2, NGRP = NTL / J, HJ = J / 2, NSTEP = L / 32;
    LAS bf16_t* Rl = (LAS bf16_t*)F.lds;
    __syncthreads();
    for (int c = F.tid; c < 2 * L / 8; c += NTHR) { const u32x4 v = *(const GAS u32x4*)(Rg + 8 * c); const unsigned a[4] = {v.x, v.y, v.z, v.w};
#pragma unroll
        for (int rho = 0; rho < 8; ++rho) { LAS bf16_t* d = Rl + rho * CS + 8 * c + rho;
#pragma unroll
            for (int k = 0; k < 4; ++k) { d[2 * k] = (bf16_t)(a[k] & 0xffffu); d[2 * k + 1] = (bf16_t)(a[k] >> 16); } } }
    __syncthreads();
    int ln_ = F.lane; asm volatile("" : "+v"(ln_));
    const int i = ln_ & 15, g = ln_ >> 4, rho = i & 7;
    const LAS bf16_t* Rc = Rl + rho * CS + rho;
    for (int grp = F.wave; grp < NGRP; grp += NWAVES) {
        f32x4 acc[J]; bf16x8 fr[J];
        const int tb = grp * J * 16;
        const LAS bf16_t* Rb = Rc + (L - tb - i + 8 * g);
#pragma unroll
        for (int j = 0; j < J; ++j) { acc[j] = (f32x4){0.f, 0.f, 0.f, 0.f}; fr[j] = *(const LAS bf16x8*)(Rb - 16 * j); }
        const char* ub = (const char*)(Uin + pos0); const unsigned ulo = (unsigned)((i * SPB + 8 * g) * 2);
        constexpr int PF = (HJ >= 4) ? 4 : 1;
        bf16x8 bq[PF];
#pragma unroll
        for (int p = 0; p < PF; ++p) bq[p] = *(const GAS bf16x8*)(ub + (size_t)(ulo + (unsigned)p * 64u));
        u32x2 xw[J];
#pragma unroll
        for (int j = 0; j < J; ++j) xw[j] = *(const GAS u32x2*)(Xmul + (size_t)i * SPB + pos0 + tb + j * 16 + 4 * g);
#pragma unroll 1
        for (int q = 0; q < NSTEP / HJ; ++q) {
#pragma unroll
            for (int m = 0; m < HJ; ++m) {
                const int n = q * HJ + m;
                const int nn = (n + PF < NSTEP) ? n + PF : 0;
                if (n > 0) { fr[(J - 2 * m) % J] = *(const LAS bf16x8*)(Rb + 32 * n); fr[(J + 1 - 2 * m) % J] = *(const LAS bf16x8*)(Rb + 32 * n - 16); }
                const bf16x8 bcur = bq[m % PF];
#pragma unroll
                for (int jj = 0; jj < J; ++jj) { const int j = (jj + 2) % J; acc[j] = mfma16(fr[(j + J - 2 * m) % J], bcur, acc[j]); }
                bq[m % PF] = *(const GAS bf16x8*)(ub + (size_t)(ulo + (unsigned)nn * 64u));
            }
        }
#pragma unroll
        for (int j = 0; j < J; ++j) { const int t0 = tb + j * 16 + 4 * g;
            const float y0 = acc[j][0] * bflo(xw[j].x), y1 = acc[j][1] * bfhi(xw[j].x), y2 = acc[j][2] * bflo(xw[j].y), y3 = acc[j][3] * bfhi(xw[j].y);
            if (!final_out) { u32x2 w; w.x = pk2(y0, y1); w.y = pk2(y2, y3); *(GAS u32x2*)(Zout + (size_t)i * SPB + pos0 + t0) = w; }
            else { u32x2 w; w.x = pk2(y0, y1); w.y = pk2(y2, y3); *(GAS u32x2*)((bf16_t*)(F.ws + WS_Y) + ((size_t)ch * NB + i) * SPB + pos0 + t0) = w; } }
    }
}
__device__ __forceinline__ void ph_hyena(Frame& F, int l, bool last) {
    const bf16_t* HV = (const bf16_t*)(F.ws + WS_HV); bf16_t* Z2 = (bf16_t*)(F.ws + WS_Z2);
    for (int ch = F.wg; ch < 256; ch += F.G) {
        const bf16_t* v = HV + (size_t)(0 * 256 + ch) * NB * SPB; const bf16_t* x1 = HV + (size_t)(256 + ch) * NB * SPB; const bf16_t* x2 = HV + (size_t)(512 + ch) * NB * SPB;
        bf16_t* z = Z2 + (size_t)ch * NB * SPB;
        const bf16_t* R0 = (const bf16_t*)(F.ws + WS_HYF) + ((size_t)(l * 2 + 0) * 256 + ch) * 8192; const bf16_t* R1 = (const bf16_t*)(F.ws + WS_HYF) + ((size_t)(l * 2 + 1) * 256 + ch) * 8192;
        hyena_conv<4096>(F, R0, v, x1, 0, false, ch, z);
        VM_WAIT(); __syncthreads(); __builtin_amdgcn_fence(__ATOMIC_ACQUIRE, "agent"); VM_WAIT();
        hyena_conv<4096>(F, R1, z, x2, 0, true, ch, z);
        if (!last) {
            const bf16_t* C0 = (const bf16_t*)(F.ws + WS_HYFC) + ((size_t)(l * 2 + 0) * 256 + ch) * 512; const bf16_t* C1 = (const bf16_t*)(F.ws + WS_HYFC) + ((size_t)(l * 2 + 1) * 256 + ch) * 512;
            hyena_conv<256>(F, C0, v, x1, SEQ, false, ch, z);
            VM_WAIT(); __syncthreads(); __builtin_amdgcn_fence(__ATOMIC_ACQUIRE, "agent"); VM_WAIT();
            hyena_conv<256>(F, C1, z, x2, SEQ, true, ch, z);
        }
    }
}

__device__ __forceinline__ void ph_ln1(Frame& F, int l, int ntok) {
    const int gw = F.wg * NWAVES + F.wave, NGW = F.G * NWAVES;
    const int cA = 256 * (F.lane >> 4) + 32 * ((F.lane >> 2) & 3) + 8 * (F.lane & 3);
#define LN1_COL(j) (cA + ((j) < 2 ? 4 * (j) : 128 + 4 * ((j) - 2)))
    const float* lg = F.in[I_LN1G] + l * DM; const float* lb = F.in[I_LN1B] + l * DM;
    for (int row = gw; row < ntok; row += NGW) {
        bf16_t* xr = (bf16_t*)(F.ws + WS_XR) + (size_t)row * DM;
        const unsigned char* yr = (const unsigned char*)(F.ws + WS_Y) + (size_t)row * DM + 16 * F.lane;
        const float* md = mod_ptr(F, l, row);
        const u32x4 xa = __builtin_nontemporal_load((const GAS u32x4*)(xr + cA)), xb = __builtin_nontemporal_load((const GAS u32x4*)(xr + cA + 128)), ya = __builtin_nontemporal_load((const GAS u32x4*)yr);
        float x[16], y[16], v[16]; unpack8(xa, x); unpack8(xb, x + 8);
        { const unsigned a[4] = {ya.x, ya.y, ya.z, ya.w};
#pragma unroll
          for (int e = 0; e < 4; ++e) { const f32x2 lo = __builtin_amdgcn_cvt_pk_f32_fp8((int)a[e], false), hi = __builtin_amdgcn_cvt_pk_f32_fp8((int)a[e], true); y[4 * e] = lo.x; y[4 * e + 1] = lo.y; y[4 * e + 2] = hi.x; y[4 * e + 3] = hi.y; } }
        float s = 0.f;
#pragma unroll
        for (int j = 0; j < 4; ++j) { const f32x4 g1 = *(const GAS f32x4*)(md + 2048 + LN1_COL(j));
#pragma unroll
            for (int e = 0; e < 4; ++e) { v[4 * j + e] = x[4 * j + e] * DN_ALPHA + g1[e] * y[4 * j + e]; s += v[4 * j + e]; } }
        const float mean = wave_sum(s, F.lane) * (1.f / DM); float s2 = 0.f;
#pragma unroll
        for (int e = 0; e < 16; ++e) { v[e] -= mean; s2 += v[e] * v[e]; }
        const float rstd = 1.f / sqrtf(wave_sum(s2, F.lane) * (1.f / DM) + LN_EPS);
        unsigned wx[8]; int w8[4];
#pragma unroll
        for (int j = 0; j < 4; ++j) { const f32x4 g = *(const GAS f32x4*)(lg + LN1_COL(j)), bb = *(const GAS f32x4*)(lb + LN1_COL(j)), sh = *(const GAS f32x4*)(md + 3072 + LN1_COL(j)), sc = *(const GAS f32x4*)(md + 4096 + LN1_COL(j));
            float xn[4];
#pragma unroll
            for (int e = 0; e < 4; ++e) xn[e] = v[4 * j + e] * rstd * g[e] + bb[e];
            wx[2 * j] = pk2(xn[0], xn[1]); wx[2 * j + 1] = pk2(xn[2], xn[3]);
            const float h0 = xn[0] * (1.f + sc[0]) + sh[0], h1 = xn[1] * (1.f + sc[1]) + sh[1], h2 = xn[2] * (1.f + sc[2]) + sh[2], h3 = xn[3] * (1.f + sc[3]) + sh[3];
            int v = 0; v = __builtin_amdgcn_cvt_pk_fp8_f32(h0, h1, v, false); v = __builtin_amdgcn_cvt_pk_fp8_f32(h2, h3, v, true); w8[j] = v; }
        unsigned char* x8 = (unsigned char*)(F.ws + WS_XM8) + (size_t)row * DM;
        *(GAS u32x2*)(x8 + cA) = (u32x2){(unsigned)w8[0], (unsigned)w8[1]}; *(GAS u32x2*)(x8 + cA + 128) = (u32x2){(unsigned)w8[2], (unsigned)w8[3]};
        *(GAS u32x4*)(xr + cA) = (u32x4){wx[0], wx[1], wx[2], wx[3]}; *(GAS u32x4*)(xr + cA + 128) = (u32x4){wx[4], wx[5], wx[6], wx[7]};
    }
#undef LN1_COL
}
__device__ __forceinline__ void ph_ln2(Frame& F, int l, int ntok, bool last) {
    const int gw = F.wg * NWAVES + F.wave, NGW = F.G * NWAVES;
    const int cA = 256 * (F.lane >> 4) + 32 * ((F.lane >> 2) & 3) + 8 * (F.lane & 3);
#define LN2_COL(j) (cA + ((j) < 2 ? 4 * (j) : 128 + 4 * ((j) - 2)))
    const float* lg = F.in[I_LN2G] + l * DM; const float* lb = F.in[I_LN2B] + l * DM;
    struct Ln2Raw { u32x2 q[8]; u32x4 qs, xa, xb; };
    auto ln2_load = [&](int row) { Ln2Raw r;
        const unsigned char* y2 = (const unsigned char*)(F.ws + WS_Y2) + (size_t)row * 5120;
        const bf16_t* xr = (const bf16_t*)(F.ws + WS_XR) + (size_t)row * DM;
#pragma unroll
        for (int k = 0; k < 8; ++k) r.q[k] = __builtin_nontemporal_load((const GAS u32x2*)(y2 + k * 512 + 8 * F.lane));
        r.qs = __builtin_nontemporal_load((const GAS u32x4*)(y2 + 4096 + 16 * F.lane));
        r.xa = __builtin_nontemporal_load((const GAS u32x4*)(xr + cA)); r.xb = __builtin_nontemporal_load((const GAS u32x4*)(xr + cA + 128));
        return r; };
    Ln2Raw cur = ln2_load(gw < ntok ? gw : 0);
    for (int row = gw; row < ntok; row += NGW) {
        const Ln2Raw nxt = ln2_load(row + NGW < ntok ? row + NGW : row);
        bf16_t* xr = (bf16_t*)(F.ws + WS_XR) + (size_t)row * DM;
        const float* wg = (const float*)(F.ws + WS_WGT) + (size_t)row * 8;
        const float* md = mod_ptr(F, l, row);
        float ff[16];
#pragma unroll
        for (int e = 0; e < 16; ++e) ff[e] = 0.f;
        { const unsigned a[4] = {cur.qs.x, cur.qs.y, cur.qs.z, cur.qs.w};
#pragma unroll
          for (int e = 0; e < 4; ++e) { const f32x2 lo = __builtin_amdgcn_cvt_pk_f32_fp8((int)a[e], false), hi = __builtin_amdgcn_cvt_pk_f32_fp8((int)a[e], true);
              ff[4 * e] += pg8::Y2_INV * lo.x; ff[4 * e + 1] += pg8::Y2_INV * lo.y; ff[4 * e + 2] += pg8::Y2_INV * hi.x; ff[4 * e + 3] += pg8::Y2_INV * hi.y; } }
#pragma unroll
        for (int k = 0; k < 8; ++k) { const float wk = wg[k] * pg8::Y2_INV; const unsigned a[2] = {cur.q[k].x, cur.q[k].y};
#pragma unroll
            for (int h = 0; h < 2; ++h) {
                const f32x2 p0 = __builtin_amdgcn_cvt_scalef32_pk_f32_fp4(a[h], 1.0f, 0), p1 = __builtin_amdgcn_cvt_scalef32_pk_f32_fp4(a[h], 1.0f, 1), p2 = __builtin_amdgcn_cvt_scalef32_pk_f32_fp4(a[h], 1.0f, 2), p3 = __builtin_amdgcn_cvt_scalef32_pk_f32_fp4(a[h], 1.0f, 3);
                ff[8 * h] += wk * p0.x; ff[8 * h + 1] += wk * p0.y; ff[8 * h + 2] += wk * p1.x; ff[8 * h + 3] += wk * p1.y; ff[8 * h + 4] += wk * p2.x; ff[8 * h + 5] += wk * p2.y; ff[8 * h + 6] += wk * p3.x; ff[8 * h + 7] += wk * p3.y; } }
        float v[16], xo[16]; float s = 0.f;
        unpack8(cur.xa, xo); unpack8(cur.xb, xo + 8);
#pragma unroll
        for (int j = 0; j < 4; ++j) { const f32x4 g2 = *(const GAS f32x4*)(md + 5120 + LN2_COL(j));
#pragma unroll
            for (int e = 0; e < 4; ++e) { v[4 * j + e] = xo[4 * j + e] * DN_ALPHA + g2[e] * ff[4 * j + e]; s += v[4 * j + e]; } }
        const float mean = wave_sum(s, F.lane) * (1.f / DM); float s2 = 0.f;
#pragma unroll
        for (int e = 0; e < 16; ++e) { v[e] -= mean; s2 += v[e] * v[e]; }
        const float rstd = 1.f / sqrtf(wave_sum(s2, F.lane) * (1.f / DM) + LN_EPS);
        const float* mdn = last ? md : mod_ptr(F, l + 1, row);
        float xn[16];
#pragma unroll
        for (int j = 0; j < 4; ++j) { const f32x4 g = *(const GAS f32x4*)(lg + LN2_COL(j)), bb = *(const GAS f32x4*)(lb + LN2_COL(j));
#pragma unroll
            for (int e = 0; e < 4; ++e) xn[4 * j + e] = v[4 * j + e] * rstd * g[e] + bb[e]; }
        if (last) { float* op = F.out + (size_t)row * DM;
#pragma unroll
            for (int j = 0; j < 4; ++j) *(GAS f32x4*)(op + LN2_COL(j)) = (f32x4){xn[4 * j], xn[4 * j + 1], xn[4 * j + 2], xn[4 * j + 3]}; }
        else {
            *(GAS u32x4*)(xr + cA) = (u32x4){pk2(xn[0], xn[1]), pk2(xn[2], xn[3]), pk2(xn[4], xn[5]), pk2(xn[6], xn[7])}; *(GAS u32x4*)(xr + cA + 128) = (u32x4){pk2(xn[8], xn[9]), pk2(xn[10], xn[11]), pk2(xn[12], xn[13]), pk2(xn[14], xn[15])};
            bf16_t* xm = (bf16_t*)(F.ws + WS_XM) + (size_t)row * DM;
            unsigned w[8];
#pragma unroll
            for (int j = 0; j < 4; ++j) { const f32x4 sh = *(const GAS f32x4*)(mdn + LN2_COL(j)), sc = *(const GAS f32x4*)(mdn + 1024 + LN2_COL(j));
                w[2 * j] = pk2(xn[4 * j] * (1.f + sc[0]) + sh[0], xn[4 * j + 1] * (1.f + sc[1]) + sh[1]); w[2 * j + 1] = pk2(xn[4 * j + 2] * (1.f + sc[2]) + sh[2], xn[4 * j + 3] * (1.f + sc[3]) + sh[3]); }
            *(GAS u32x4*)(xm + cA) = (u32x4){w[0], w[1], w[2], w[3]}; *(GAS u32x4*)(xm + cA + 128) = (u32x4){w[4], w[5], w[6], w[7]};
        }
        cur = nxt;
    }
#undef LN2_COL
}

__device__ __forceinline__ unsigned f_ord(float f) { const unsigned u = __builtin_bit_cast(unsigned, f); return (u & 0x80000000u) ? ~u : (u | 0x80000000u); }
__device__ __forceinline__ unsigned long long wave_max_u64(unsigned long long v, int lane) {
#pragma unroll
    for (int o = 1; o < 64; o <<= 1) { const unsigned lo = (unsigned)shxi((int)(unsigned)v, o, lane), hi = (unsigned)shxi((int)(unsigned)(v >> 32), o, lane); const unsigned long long w = ((unsigned long long)hi << 32) | lo; v = w > v ? w : v; }
    return v;
}
__device__ __forceinline__ float seg16_max(float v, int lane) { v = fmaxf(v, shx(v, 1, lane)); v = fmaxf(v, shx(v, 2, lane)); v = fmaxf(v, shx(v, 4, lane)); v = fmaxf(v, shx(v, 8, lane)); return v; }
__device__ __forceinline__ int seg16_min_i(int v, int lane) { int w; w = shxi(v, 1, lane); v = w < v ? w : v; w = shxi(v, 2, lane); v = w < v ? w : v; w = shxi(v, 4, lane); v = w < v ? w : v; w = shxi(v, 8, lane); v = w < v ? w : v; return v; }
template <int CTRL> __device__ __forceinline__ int dpp_i(int v) { return __builtin_amdgcn_update_dpp(0, v, CTRL, 0xf, 0xf, true); }
__device__ __forceinline__ unsigned row_max_u(unsigned v) { unsigned w; w = (unsigned)dpp_i<0xB1>((int)v); v = w > v ? w : v; w = (unsigned)dpp_i<0x4E>((int)v); v = w > v ? w : v; w = (unsigned)dpp_i<0x141>((int)v); v = w > v ? w : v; w = (unsigned)dpp_i<0x140>((int)v); v = w > v ? w : v; return v; }
__device__ __forceinline__ float row_max_f(float v) { v = fmaxf(v, __builtin_bit_cast(float, dpp_i<0xB1>(__builtin_bit_cast(int, v)))); v = fmaxf(v, __builtin_bit_cast(float, dpp_i<0x4E>(__builtin_bit_cast(int, v)))); v = fmaxf(v, __builtin_bit_cast(float, dpp_i<0x141>(__builtin_bit_cast(int, v)))); v = fmaxf(v, __builtin_bit_cast(float, dpp_i<0x140>(__builtin_bit_cast(int, v)))); return v; }
__device__ __forceinline__ int row_min_i(int v) { int w; w = dpp_i<0xB1>(v); v = w < v ? w : v; w = dpp_i<0x4E>(v); v = w < v ? w : v; w = dpp_i<0x141>(v); v = w < v ? w : v; w = dpp_i<0x140>(v); v = w < v ? w : v; return v; }
__device__ __forceinline__ float rdlane_f(float v, int l) { return __builtin_bit_cast(float, __builtin_amdgcn_readlane(__builtin_bit_cast(int, v), l)); }
__device__ __forceinline__ unsigned wave_max_u(unsigned v) {
    v = row_max_u(v);
    const unsigned a = (unsigned)__builtin_amdgcn_readlane((int)v, 0), b = (unsigned)__builtin_amdgcn_readlane((int)v, 16), c = (unsigned)__builtin_amdgcn_readlane((int)v, 32), d = (unsigned)__builtin_amdgcn_readlane((int)v, 48);
    const unsigned ab = a > b ? a : b, cd = c > d ? c : d; return ab > cd ? ab : cd;
}
__device__ __forceinline__ float row_top2(float v, int l16) {
    const float m1 = row_max_f(v);
    const int first = row_min_i(v == m1 ? l16 : 99);
    const float m2 = row_max_f(l16 == first ? -3.0e38f : v);
    return m1 + m2;
}
__device__ __forceinline__ float seg16_top2(float v, int lane) {
    const float m1 = seg16_max(v, lane);
    const int first = seg16_min_i(v == m1 ? (lane & 15) : 99, lane);
    const float m2 = seg16_max((lane & 15) == first ? -3.0e38f : v, lane);
    return m1 + m2;
}
__device__ __forceinline__ void ph_route(Frame& F, int l, int ntok) {
    LAS int* hist = (LAS int*)F.lds;
    LAS int* base = hist + 128;
    LAS unsigned* alist = (LAS unsigned*)(F.lds + 1024);
    const int tpw = (ntok + F.G - 1) / F.G, t0 = F.wg * tpw, t1 = (t0 + tpw) < ntok ? (t0 + tpw) : ntok;
    __syncthreads();
    if (F.tid < 128) hist[F.tid] = 0;
    __syncthreads();
    const float* LG = (const float*)(F.ws + WS_LOGIT); const float* rb = F.in[I_RB] + l * NEXP;
    const float b0 = rb[F.lane], b1 = rb[F.lane + 64];
    constexpr int RT = 4;
    float xq0[RT], xq1[RT];
#pragma unroll
    for (int j = 0; j < RT; ++j) { int tok = t0 + F.wave * RT + j; tok = tok < t1 ? tok : t1 - 1; tok = tok < 0 ? 0 : tok;
        xq0[j] = LG[(size_t)tok * 256 + F.lane]; xq1[j] = LG[(size_t)tok * 256 + 64 + F.lane]; }
    for (int tb = t0 + F.wave * RT; tb < t1; tb += NWAVES * RT) {
        float s0[RT], s1[RT], e0[RT], e1[RT], gs0[RT], gs1[RT]; unsigned h0[RT], h1[RT]; int mye[RT]; float myw[RT], wsum[RT];
        float xn0[RT], xn1[RT];
#pragma unroll
        for (int j = 0; j < RT; ++j) { int tok = tb + NWAVES * RT + j; tok = tok < t1 ? tok : t1 - 1;
            xn0[j] = LG[(size_t)tok * 256 + F.lane]; xn1[j] = LG[(size_t)tok * 256 + 64 + F.lane]; }
#pragma unroll
        for (int j = 0; j < RT; ++j) { const int tok = (tb + j) < t1 ? tb + j : t1 - 1;
            const float x0 = xq0[j], x1 = xq1[j];
            const float* rbs = (const float*)(F.ws + WS_RBIAS) + (size_t)(l * 17 + row_b(tok)) * 128; const float y0 = x0 + rbs[F.lane], y1 = x1 + rbs[64 + F.lane];
            s0[j] = __builtin_amdgcn_rcpf(1.0f + __expf(-y0)); s1[j] = __builtin_amdgcn_rcpf(1.0f + __expf(-y1)); e0[j] = s0[j] + b0; e1[j] = s1[j] + b1; }
#pragma unroll
        for (int j = 0; j < RT; ++j) { gs0[j] = row_top2(e0[j], F.lane & 15); gs1[j] = row_top2(e1[j], F.lane & 15); }
#pragma unroll
        for (int j = 0; j < RT; ++j) {
            float gsc[8];
#pragma unroll
            for (int g = 0; g < 4; ++g) { gsc[g] = rdlane_f(gs0[j], g * 16); gsc[4 + g] = rdlane_f(gs1[j], g * 16); }
            unsigned gmask = 0u;
#pragma unroll
            for (int g = 0; g < 8; ++g) { int cnt = 0;
#pragma unroll
                for (int g2 = 0; g2 < 8; ++g2) cnt += (gsc[g2] > gsc[g] || (gsc[g2] == gsc[g] && g2 < g)) ? 1 : 0;
                gmask |= (cnt < 4) ? (1u << g) : 0u; }
            const bool ok0 = (gmask >> (F.lane >> 4)) & 1u, ok1 = (gmask >> (4 + (F.lane >> 4))) & 1u;
            h0[j] = ok0 ? f_ord(e0[j]) : 0u; h1[j] = ok1 ? f_ord(e1[j]) : 0u;
            mye[j] = 0; myw[j] = 0.f; wsum[j] = 0.f; }
#pragma unroll
        for (int k = 0; k < 8; ++k) {
#pragma unroll
            for (int j = 0; j < RT; ++j) {
                const unsigned bh = h0[j] >= h1[j] ? h0[j] : h1[j];
                const unsigned H = wave_max_u(bh);
                const unsigned mylo = h0[j] == H ? (unsigned)(255 - F.lane) : (h1[j] == H ? (unsigned)(255 - 64 - F.lane) : 0u);
                const unsigned Lm = wave_max_u(mylo);
                const int e = 255 - (int)Lm;
                if (e < 64) { if (F.lane == e) h0[j] = 0u; } else { if (F.lane == e - 64) h1[j] = 0u; }
                const float sv = e < 64 ? rdlane_f(s0[j], e) : rdlane_f(s1[j], e - 64);
                wsum[j] += sv; if (F.lane == k) { mye[j] = e; myw[j] = sv; } }
        }
#pragma unroll
        for (int j = 0; j < RT; ++j) { const int tok = tb + j;
            if (tok < t1 && F.lane < 8) {
                const int lr = __hip_atomic_fetch_add(&hist[mye[j]], 1, __ATOMIC_RELAXED, __HIP_MEMORY_SCOPE_WORKGROUP);
                alist[(tok - t0) * 8 + F.lane] = (unsigned)mye[j] | ((unsigned)lr << 8);
                ((int*)(F.ws + WS_EIDX))[(size_t)tok * 8 + F.lane] = mye[j];
                ((float*)(F.ws + WS_WGT))[(size_t)tok * 8 + F.lane] = myw[j] / wsum[j] * 2.5f;
            } }
#pragma unroll
        for (int j = 0; j < RT; ++j) { xq0[j] = xn0[j]; xq1[j] = xn1[j]; }
    }
    __syncthreads();
    if (F.tid < 128) { const int hcount = hist[F.tid]; base[F.tid] = hcount ? (int)atomicAdd(F.ctl + CW_CNT + l * 256 + F.tid, (unsigned)hcount) : 0; }
    __syncthreads();
    for (int a = F.tid; a < (t1 - t0) * 8; a += NTHR) { const unsigned v = alist[a]; ((int*)(F.ws + WS_RNK))[(size_t)t0 * 8 + a] = base[v & 0xffu] + (int)(v >> 8); }
}
__device__ __forceinline__ void ph_positions(Frame& F, int l, int ntok) {
    LAS int* cnt = (LAS int*)F.lds;
    LAS int* off = cnt + 132;
    __syncthreads();
    if (F.tid < NE1) cnt[F.tid] = F.tid < NEXP ? (int)__hip_atomic_load(F.ctl + CW_CNT + l * 256 + F.tid, __ATOMIC_RELAXED, __HIP_MEMORY_SCOPE_AGENT) : ntok;
    __syncthreads();
    if (F.tid == 0) { int o = 0; for (int e = 0; e < NE1; ++e) { off[e] = o; o += (cnt[e] + 255) & ~255; } off[NE1] = o; }
    __syncthreads();
    const int gt = F.wg * NTHR + F.tid, NGT = F.G * NTHR;
    int* rowtok = (int*)(F.ws + WS_ROWTOK); int* rowdst = (int*)(F.ws + WS_ROWDST); int* tile_exp = (int*)(F.ws + WS_TILEEXP);
    const int* eidx = (const int*)(F.ws + WS_EIDX); const int* rnk = (const int*)(F.ws + WS_RNK);
    for (int a = gt; a < ntok * 8; a += NGT) { const int tok = a >> 3, k = a & 7; const int pos = off[eidx[a]] + rnk[a]; rowtok[pos] = tok; rowdst[pos] = tok * 10 + k; }
    for (int tok = gt; tok < ntok; tok += NGT) { const int pos = off[NEXP] + tok; rowtok[pos] = tok; rowdst[pos] = tok * 10 + 8; }
    for (int i = gt; i < NE1 * 256; i += NGT) { const int e = i >> 8, p = i & 255; const int row = off[e] + cnt[e] + p; if (row < off[e + 1]) { rowtok[row] = 0; rowdst[row] = -1; } }
    for (int i = gt; i < NE1 * 320; i += NGT) { const int e = i / 320, p = i % 320; const int t = (off[e] >> 8) + p; if (t < (off[e + 1] >> 8)) tile_exp[t] = e; }
    if (gt == 0) F.ctl[CW_NTL + l] = (unsigned)(off[NE1] >> 8);
}

#ifndef MK_MULTI
#define MK_MULTI 0
#endif
constexpr int PH_PER_LAYER = 12, NPHASE = 2 + DEPTH * PH_PER_LAYER;
struct Args { const float* in[36]; float* out; unsigned char* ws; int ph_lo, ph_hi; };

__global__ void __launch_bounds__(NTHR, 2) mk_fwd(Args args) {
    extern __shared__ __attribute__((aligned(16))) unsigned char lds_raw[];
    Frame F;
    F.lds = (LAS unsigned char*)lds_raw;
    F.tid = threadIdx.x; F.lane = F.tid & 63; F.wave = __builtin_amdgcn_readfirstlane(F.tid >> 6);
    const int wave0 = F.wave;
    F.G = gridDim.x; F.wg = blockIdx.x;
    F.in = args.in;
    F.out = args.out; F.ws = args.ws; F.ctl = (unsigned*)(args.ws + WS_CTL);
    volatile LAS unsigned* MISC = (volatile LAS unsigned*)(F.lds + MISC_OFF);
    if (F.tid < 32) MISC[F.tid] = 0u;
    __syncthreads();
    const int lo = args.ph_lo, hi = args.ph_hi;
    const bool single = (hi - lo) > 1;
    XcdBarrier bar; bar.bar = F.ctl + CW_BAR; bar.x = 0; bar.st = nullptr;
    if (single) bar = xcd_barrier_post(F.ctl + CW_BAR, MISC + 8);
#define IN(k) (lo <= (k) && (k) < hi)
#ifndef PROBE_MASK
#define PROBE_MASK 0
#endif
#define REP(k) for (int _rep = 0; _rep < (((PROBE_MASK >> (k)) & 1) ? 2 : 1); ++_rep)
#define SEAM(k) do { if (IN(k) && IN((k) + 1)) { xcd_barrier(bar); if ((PROBE_MASK >> 15) & 1) xcd_barrier(bar); } } while (0)
#define FRESH() do { int _ln; asm volatile("v_mbcnt_lo_u32_b32 %0, -1, 0\n\tv_mbcnt_hi_u32_b32 %0, -1, %0" : "=v"(_ln)); int _wv = wave0; asm volatile("" : "+s"(_wv)); F.lane = _ln; F.wave = _wv; F.tid = (_wv << 6) | _ln; \
        unsigned char* _w = args.ws; asm volatile("" : "+s"(_w)); F.ws = _w; F.ctl = (unsigned*)(_w + WS_CTL); float* _o = args.out; asm volatile("" : "+s"(_o)); F.out = _o; } while (0)

    if (IN(0)) { FRESH(); REP(13) { p0_static_weights(F); __syncthreads(); } REP(14) { p0_mod(F); __syncthreads(); } FRESH(); REP(16) { p0_hyena_filters(F); __syncthreads(); } }
    SEAM(0);
    if (IN(1)) { FRESH(); p0_init_rows(F); __syncthreads(); FRESH(); p1_router_weights(F); }
    SEAM(1);
#pragma unroll 1
    for (int l = 0; l < DEPTH; ++l) {
        const int pb = 2 + l * PH_PER_LAYER; const bool last = (l == DEPTH - 1); const int ntok = last ? NLAT : NROW;
        if (IN(pb + 0)) { FRESH();
            REP(0) { p_expert_weights(F, l, (last || F.G != 256) ? 0 : XW_TAIL_G, XW_ITEMS, F.G * NWAVES, F.wg * NWAVES + F.wave); __syncthreads(); }
            { pg8::ColMapOrder S; S.b.init(NROW, 11 * 256, F.G, F.wg); S.map = 0xCBA98763210ull; pg8::EpiBf16 E{(bf16_t*)(F.ws + WS_U), DIN};
              REP(1) pg8::gemm_phase<pg8::EpiBf16, pg8::ColMapOrder, false>(F.tid, F.lds, (const bf16_t*)(F.ws + WS_XM), (const bf16_t*)(F.ws + WS_WIN) + (size_t)l * DIN * DM, DM, nullptr, S, E); }
            __syncthreads(); FRESH();
            { pg8::ColMapOrder S; S.b.init(NROW, 2 * 256, F.G, (F.wg + 80) % F.G); S.map = 0x54ull; pg8::EpiVT E{(bf16_t*)(F.ws + WS_VT), UV};
              REP(1) pg8::gemm_phase<pg8::EpiVT, pg8::ColMapOrder, false, false, true, true, false, true>(F.tid, F.lds, (const bf16_t*)(F.ws + WS_XM), (const bf16_t*)(F.ws + WS_WIN) + (size_t)l * DIN * DM, DM, nullptr, S, E); }
        }
        SEAM(pb + 0);
        if (IN(pb + 1)) { FRESH(); REP(2) { ph_transposes(F, l); __syncthreads(); } FRESH(); REP(3) { ph_gla_local(F, l); __syncthreads(); } }
        SEAM(pb + 1);
        if (IN(pb + 2)) { FRESH(); REP(4) { ph_na(F, l, last); } FRESH(); REP(5) { ph_gla_scan(F); } __syncthreads(); FRESH(); REP(6) { ph_hyena(F, l, last); } }
        SEAM(pb + 2);
        if (IN(pb + 3)) { FRESH(); ph_hy_transpose(F, last); __syncthreads(); FRESH(); REP(7) { ph_gla_out(F, l, last); } }
        SEAM(pb + 3);
        if (IN(pb + 4)) { FRESH();
            pg8::DenseOrder S; S.init(ntok, DM, F.G, F.wg); pg8::EpiY8 E{(unsigned char*)(F.ws + WS_Y), DM};
            REP(8) pg8::gemm_phase<pg8::EpiY8, pg8::DenseOrder, false>(F.tid, F.lds, (const bf16_t*)(F.ws + WS_MIX), (const bf16_t*)(F.ws + WS_WOUT) + (size_t)l * DM * DM, DM, nullptr, S, E);
            if (!last && F.G == 256 && F.wg >= 64) { __syncthreads(); FRESH(); p_expert_weights(F, l, 0, XW_TAIL_E, 192 * NWAVES, (F.wg - 64) * NWAVES + F.wave); }
        }
        SEAM(pb + 4);
        if (IN(pb + 5)) { FRESH(); ph_ln1(F, l, ntok); }
        SEAM(pb + 5);
        if (IN(pb + 6)) { FRESH();
            pg8::RouterOrder S; S.b.init(ntok, 256, F.G, F.wg); pg8::EpiF32H E{(float*)(F.ws + WS_LOGIT), 256};
            REP(9) pg8::gemm_phase<pg8::EpiF32H, pg8::RouterOrder, false, false, true, true, true>(F.tid, F.lds, (const bf16_t*)(F.ws + WS_XR), (const bf16_t*)(F.ws + WS_WRB) + (size_t)l * 17 * 128 * DM, DM, nullptr, S, E);
            if (!last && F.G == 256 && F.wg >= 16) { __syncthreads(); FRESH(); p_expert_weights(F, l, XW_TAIL_E, XW_TAIL_G, 240 * NWAVES, (F.wg - 16) * NWAVES + F.wave); }
        }
        SEAM(pb + 6);
        if (IN(pb + 7)) { FRESH(); ph_route(F, l, ntok); }
        SEAM(pb + 7);
        if (IN(pb + 8)) { FRESH(); REP(12) { ph_positions(F, l, ntok); __syncthreads(); } }
        SEAM(pb + 8);
        if (IN(pb + 9)) { FRESH();
            const int ntl = (int)__hip_atomic_load(F.ctl + CW_NTL + l, __ATOMIC_RELAXED, __HIP_MEMORY_SCOPE_AGENT);
            pg8::GroupedOrder S; S.init(ntl, 2, F.G, F.wg); S.preload((const int*)(F.ws + WS_TILEEXP), F.lds + pg8::STAGE_BYTES + 4096, F.tid, NTHR); pg8::EpiSwiglu E{(unsigned char*)(F.ws + WS_ACT)};
            REP(10) pg8::gemm_phase<pg8::EpiSwiglu, pg8::GroupedOrder, true, true>(F.tid, F.lds, (const void*)(F.ws + WS_XM8), (const void*)(F.ws + WS_EXP1), DM, (const int*)(F.ws + WS_ROWTOK), S, E);
        }
        SEAM(pb + 9);
        if (IN(pb + 10)) { FRESH();
            const int ntl = (int)__hip_atomic_load(F.ctl + CW_NTL + l, __ATOMIC_RELAXED, __HIP_MEMORY_SCOPE_AGENT);
            pg8::GroupedOrder S; S.init(ntl, 4, F.G, F.wg); S.preload((const int*)(F.ws + WS_TILEEXP), F.lds + pg8::STAGE_BYTES + 4096, F.tid, NTHR); pg8::EpiScatter E{(unsigned char*)(F.ws + WS_Y2), (const int*)(F.ws + WS_ROWDST)};
            REP(11) pg8::gemm_phase<pg8::EpiScatter, pg8::GroupedOrder, false, true>(F.tid, F.lds, (const void*)(F.ws + WS_ACT), (const void*)(F.ws + WS_EXP2), EH, nullptr, S, E);
        }
        SEAM(pb + 10);
        if (IN(pb + 11)) { FRESH(); ph_ln2(F, l, ntok, last); }
        SEAM(pb + 11);
    }
#undef IN
#undef SEAM
#undef FRESH
}

extern "C" void kernel_launch(void* const* d_in, const int* in_sizes, int n_in, void* d_out, int out_size, void* d_ws, size_t ws_size, hipStream_t stream) {
    static int grid = 0;
    if (grid == 0) {
        if (n_in != 36 || out_size != NLAT * DM || ws_size < WS_END) { fprintf(stderr, "kernel_launch: unexpected shapes (n_in %d out %d ws %zu need %zu)\n", n_in, out_size, ws_size, (size_t)WS_END); grid = -1; return; }
        int dev = 0, cus = 0, per_cu = 0;
        if (hipGetDevice(&dev) != hipSuccess || hipDeviceGetAttribute(&cus, hipDeviceAttributeMultiprocessorCount, dev) != hipSuccess) { grid = -1; return; }
        if (hipFuncSetAttribute((const void*)mk_fwd, hipFuncAttributeMaxDynamicSharedMemorySize, LDS_BYTES) != hipSuccess) { fprintf(stderr, "kernel_launch: hipFuncSetAttribute failed\n"); grid = -1; return; }
        if (hipOccupancyMaxActiveBlocksPerMultiprocessor(&per_cu, (const void*)mk_fwd, NTHR, LDS_BYTES) != hipSuccess || per_cu < 1) { fprintf(stderr, "kernel_launch: occupancy query says %d\n", per_cu); }
        (void)hipGetLastError();
        grid = cus;
    }
    if (grid < 0) return;
    (void)hipMemsetAsync((char*)d_ws + WS_CTL, 0, CTL_BYTES, stream);
    Args a{};
    for (int i = 0; i < 36; ++i) a.in[i] = (const float*)d_in[i];
    a.out = (float*)d_out; a.ws = (unsigned char*)d_ws;
#if MK_MULTI
    for (int p = 0; p < NPHASE; ++p) { a.ph_lo = p; a.ph_hi = p + 1; hipLaunchKernelGGL(mk_fwd, dim3(grid), dim3(NTHR), LDS_BYTES, stream, a); }
#else
    a.ph_lo = 0; a.ph_hi = NPHASE; hipLaunchKernelGGL(mk_fwd, dim3(grid), dim3(NTHR), LDS_BYTES, stream, a);
#endif
}
```

```cpp
#include <hip/hip_runtime.h>
#include <cstdio>
#include <cstdint>

#define LAS __attribute__((address_space(3)))
#define GAS __attribute__((address_space(1)))
typedef unsigned short bf16_t;
typedef short bf16x8 __attribute__((ext_vector_type(8)));
typedef float f32x4 __attribute__((ext_vector_type(4)));
typedef float f32x2 __attribute__((ext_vector_type(2)));
typedef unsigned u32x4 __attribute__((ext_vector_type(4)));
typedef unsigned u32x2 __attribute__((ext_vector_type(2)));

constexpr int NB = 16, SEQ = 4096, CTXL = 256, DM = 1024, DEPTH = 4;
constexpr int NLAT = NB * SEQ;
constexpr int NCTX = NB * CTXL;
constexpr int NROW = NLAT + NCTX;
constexpr int SPB = SEQ + CTXL;
constexpr int DIN_REF = 3104;
constexpr int DIN = 3328;
constexpr int UQ = 0, UK = 512, UV = 1024, UGQ = 1536, UGK = 1664, UGV = 1792, UGR = 2048, UHY = 2304, ULAF = 3072, ULAB = 3200;
constexpr int NEXP = 128, TOPK = 8, EH = 256;
constexpr int NE1 = NEXP + 1;
constexpr int RMAX = 659712;
constexpr int TMAX = RMAX / 256;
constexpr float LN_EPS = 1e-6f;
constexpr float DN_ALPHA = 1.6817928305074290f;

__device__ __forceinline__ unsigned f2bf(float f) { unsigned u = __builtin_bit_cast(unsigned, f); return (u + 0x7fffu + ((u >> 16) & 1u)) >> 16; }
typedef __bf16 bf16v2 __attribute__((ext_vector_type(2)));
__device__ __forceinline__ unsigned pk2(float lo, float hi) { const f32x2 v = {lo, hi}; const bf16v2 b = __builtin_convertvector(v, bf16v2); return __builtin_bit_cast(unsigned, b); }
__device__ __forceinline__ float bf2f(unsigned short b) { return __builtin_bit_cast(float, ((unsigned)b) << 16); }
__device__ __forceinline__ float bflo(unsigned w) { return __builtin_bit_cast(float, w << 16); }
__device__ __forceinline__ float bfhi(unsigned w) { return __builtin_bit_cast(float, w & 0xffff0000u); }
__device__ __forceinline__ float shx(float v, int o, int lane) { return __builtin_bit_cast(float, __builtin_amdgcn_ds_bpermute((lane ^ o) << 2, __builtin_bit_cast(int, v))); }
__device__ __forceinline__ int shxi(int v, int o, int lane) { return __builtin_amdgcn_ds_bpermute((lane ^ o) << 2, v); }
__device__ __forceinline__ float shf(float v, int src) { return __builtin_bit_cast(float, __builtin_amdgcn_ds_bpermute(src << 2, __builtin_bit_cast(int, v))); }
__device__ __forceinline__ float wave_sum(float v, int lane) {
#pragma unroll
    for (int o = 1; o < 64; o <<= 1) v += shx(v, o, lane);
    return v;
}
__device__ __forceinline__ void unpack8(const u32x4 q, float* o) { o[0] = bflo(q.x); o[1] = bfhi(q.x); o[2] = bflo(q.y); o[3] = bfhi(q.y); o[4] = bflo(q.z); o[5] = bfhi(q.z); o[6] = bflo(q.w); o[7] = bfhi(q.w); }
__device__ __forceinline__ float silu_f(float x) { return x * __builtin_amdgcn_rcpf(1.0f + __expf(-x)); }
#define LDS_WAIT() asm volatile("s_waitcnt lgkmcnt(0)" ::: "memory")
#define VM_WAIT() asm volatile("s_waitcnt vmcnt(0)" ::: "memory")

#define XB_TMO      128
#define XB_XCNT(j)  (256  + 64 * (j))
#define XB_XSUB(j)  (1280 + 64 * (j))
#define XB_XGEN(j)  (2304 + 64 * (j))
#define XB_TOP      3328
#define XB_TOPGEN   3392
#define XCD_BAR_WORDS 3456
#define XB_SPIN_CAP (1u << 18)

__device__ __forceinline__ unsigned xb_ld(unsigned* p)              { return __hip_atomic_load(p, __ATOMIC_RELAXED, __HIP_MEMORY_SCOPE_AGENT); }
__device__ __forceinline__ unsigned xb_add(unsigned* p, unsigned v) { return __hip_atomic_fetch_add(p, v, __ATOMIC_RELAXED, __HIP_MEMORY_SCOPE_AGENT); }
__device__ __forceinline__ unsigned xb_xcc_id() { return (unsigned)__builtin_amdgcn_s_getreg((3 << 11) | 20) & 0xFu; }
#define XB_SPIN(cond, bar) do { unsigned _sp = 0; while (cond) { __builtin_amdgcn_s_sleep(1); \
    if ((++_sp & 255u) == 0u) { if (xb_ld(&(bar)[XB_TMO])) break; if (_sp > XB_SPIN_CAP) { atomicAdd(&(bar)[XB_TMO], 1u); break; } } } } while (0)

struct XcdBarrier { unsigned* bar; unsigned x; volatile LAS unsigned* st; };

__device__ __forceinline__ XcdBarrier xcd_barrier_post(unsigned* bar, volatile LAS unsigned* st) {
    XcdBarrier b; b.bar = bar; b.x = xb_xcc_id(); b.st = st;
    if (threadIdx.x == 0) (void)xb_add(&bar[XB_XCNT(b.x)], 1u);
    return b;
}
__device__ __forceinline__ void xcd_barrier_complete(unsigned* bar, unsigned x, unsigned& nloc, unsigned& nx) {
    const unsigned G = gridDim.x * gridDim.y * gridDim.z;
    unsigned sum, cnt, mine, sp = 0u;
    for (;;) {
        sum = 0u; cnt = 0u; mine = 0u;
#pragma unroll
        for (unsigned j = 0; j < 16; ++j) { const unsigned c = xb_ld(&bar[XB_XCNT(j)]); sum += c; cnt += (c > 0u) ? 1u : 0u; mine = (j == x) ? c : mine; }
        if (sum == G) break;
        __builtin_amdgcn_s_sleep(1);
        if ((++sp & 255u) == 0u) { if (xb_ld(&bar[XB_TMO])) break; if (sp > XB_SPIN_CAP) { atomicAdd(&bar[XB_TMO], 1u); break; } }
    }
    nloc = mine > 0u ? mine : 1u; nx = cnt > 0u ? cnt : 1u;
}
__device__ __forceinline__ void xcd_barrier(const XcdBarrier& b) {
    asm volatile("s_waitcnt vmcnt(0)" ::: "memory");
    __syncthreads();
    if (threadIdx.x == 0) {
        unsigned* bar = b.bar;
        __builtin_amdgcn_s_waitcnt(0);
        unsigned nloc = b.st[0], nx = b.st[1];
        if (nloc == 0u) { xcd_barrier_complete(bar, b.x, nloc, nx); b.st[0] = nloc; b.st[1] = nx; }
        const unsigned old = xb_add(&bar[XB_XSUB(b.x)], 1u);
        const unsigned gen = old / nloc;
        if (old + 1u == (gen + 1u) * nloc) {
            __builtin_amdgcn_fence(__ATOMIC_RELEASE, "agent");
            asm volatile("s_waitcnt vmcnt(0)" ::: "memory");
            const unsigned og = xb_add(&bar[XB_TOP], 1u);
            const unsigned tg = og / nx;
            if (og + 1u == (tg + 1u) * nx) xb_add(&bar[XB_TOPGEN], 1u);
            else XB_SPIN(xb_ld(&bar[XB_TOPGEN]) == tg, bar);
            __builtin_amdgcn_fence(__ATOMIC_ACQUIRE, "agent");
            xb_add(&bar[XB_XGEN(b.x)], 1u);
            asm volatile("s_waitcnt vmcnt(0)" ::: "memory");
        } else {
            XB_SPIN(xb_ld(&bar[XB_XGEN(b.x)]) == gen, bar);
            __builtin_amdgcn_fence(__ATOMIC_ACQUIRE, "agent");
            asm volatile("s_waitcnt vmcnt(0)" ::: "memory");
        }
    }
    __syncthreads();
}

namespace pg8 {
constexpr int BM = 256, BK = 64, HALF = 128, HTB = HALF * BK * 2, STAGE_BYTES = 8 * HTB, NXCD = 8, WGM = 8;
__host__ __device__ __forceinline__ int lds_byte(int r, int c) { const int st = (r >> 4) * 2 + (c >> 5), rr = r & 15, cc = c & 31, ob = rr * 64 + cc * 2; return st * 1024 + (ob ^ (((ob >> 9) & 1) << 5)); }
__host__ __device__ __forceinline__ void stage_rc(int b, int& R, int& C) { const int st = b / 1024, sb = b % 1024, swz = sb ^ (((sb >> 9) & 1) << 5); R = (st >> 1) * 16 + swz / 64; C = (st & 1) * 32 + (swz % 64) / 2; }
__host__ __device__ __forceinline__ int perm32(int rho) { const int n = rho >> 4, i = rho & 15; return 8 * (i >> 2) + 4 * n + (i & 3); }

struct Unit { int arow0, brow0, orow0, ocol0, aux; };

struct DenseOrder {
    int nM, nN, nwg, G, c;
    __device__ void init(int M, int N, int G_, int c_) { nM = M / BM; nN = N / BM; nwg = nM * nN; G = G_; c = c_; }
    __device__ __forceinline__ bool next(int i, Unit& u) const {
        const long L = (long)i * G + c; if (L >= nwg) return false;
        int wgid = (int)L; { const int q = nwg / NXCD, r = nwg % NXCD, xcd = wgid % NXCD, off = wgid / NXCD; wgid = (xcd < r ? xcd * (q + 1) : r * (q + 1) + (xcd - r) * q) + off; }
        const int nig = WGM * nN, gid = wgid / nig, fm = gid * WGM, gsz = (nM - fm) < WGM ? (nM - fm) : WGM;
        const int pm = fm + ((wgid % nig) % gsz), pn = (wgid % nig) / gsz;
        u.arow0 = pm * BM; u.brow0 = pn * BM; u.orow0 = pm * BM; u.ocol0 = pn * BM; u.aux = 0; return true;
    }
};
struct GroupedOrder {
    const LAS unsigned char* tab; int nN, nslot, slot, t0, t1;
    __device__ __forceinline__ void init(int ntiles, int nN_, int G, int c) {
        nN = nN_;
        if ((G & 7) == 0) { const int per = (ntiles + 7) >> 3, x = c & 7; nslot = G >> 3; slot = c >> 3; t0 = x * per; t1 = (t0 + per) < ntiles ? (t0 + per) : ntiles; }
        else { nslot = G; slot = c; t0 = 0; t1 = ntiles; }
    }
    __device__ __forceinline__ void preload(const int* tile_exp, LAS unsigned char* lds_tab, int tid, int nthr) {
        __syncthreads();
        for (int i = tid; i < t1 - t0; i += nthr) lds_tab[i] = (unsigned char)tile_exp[t0 + i];
        __syncthreads();
        tab = lds_tab;
    }
    __device__ __forceinline__ bool next(int i, Unit& u) const {
        const int q = i * nslot + slot, t = t0 + q / nN, pn = q % nN;
        if (t >= t1) return false;
        const int e = (int)tab[t - t0];
        u.arow0 = t * BM; u.brow0 = (e * nN + pn) * BM; u.orow0 = t * BM; u.ocol0 = pn * BM; u.aux = e; return true;
    }
};

struct RouterOrder {
    DenseOrder b;
    __device__ __forceinline__ bool next(int i, Unit& u) const { if (!b.next(i, u)) return false; const int pm = u.arow0 >> 8; u.brow0 = (pm < 256 ? (pm >> 4) : 16) * 128; return true; }
};
struct ColMapOrder {
    DenseOrder b; unsigned long long map;
    __device__ __forceinline__ bool next(int i, Unit& u) const { if (!b.next(i, u)) return false; const int ph = (int)((map >> ((u.ocol0 >> 8) * 4)) & 15ull); u.brow0 = ph * BM; u.ocol0 = ph * BM; return true; }
};
template <class Base> struct RangeOrder {
    Base b; int i0, i1;
    __device__ __forceinline__ bool next(int i, Unit& u) const { const int j = i + i0; if (j >= i1) return false; return b.next(j, u); }
};

__device__ __forceinline__ unsigned cvt_pk_bf16(float lo, float hi) { return pk2(lo, hi); }

struct NoPre {};
struct EpiF32 {
    static constexpr bool PERM = false; static constexpr int SCW = 0x7A7A7A7A; typedef NoPre Pre;
    __device__ __forceinline__ Pre prefetch(const Unit&, LAS unsigned char*, int, int, int) const { return Pre{}; }
    float* C; int ldc;
    __device__ __forceinline__ void operator()(const f32x4 (&acc)[2][2][4][2], const Unit& u, int wr, int wc, int fr, int fq, const Pre&, bool drain) const {
        if (drain) asm volatile("s_waitcnt vmcnt(0)" ::: "memory");
        const int row0 = u.orow0 + wr * 64 + fr, col0 = u.ocol0 + wc * 32 + 4 * fq;
#pragma unroll
        for (int ai = 0; ai < 2; ++ai)
#pragma unroll
            for (int m = 0; m < 4; ++m) { float* rowp = C + (size_t)(row0 + ai * HALF + m * 16) * ldc + col0;
#pragma unroll
                for (int bj = 0; bj < 2; ++bj)
#pragma unroll
                    for (int n = 0; n < 2; ++n) *(GAS f32x4*)(rowp + bj * HALF + n * 16) = acc[ai][bj][m][n]; }
    }
};
struct EpiF32H {
    static constexpr bool PERM = false; static constexpr int SCW = 0x7A7A7A7A; typedef NoPre Pre;
    __device__ __forceinline__ Pre prefetch(const Unit&, LAS unsigned char*, int, int, int) const { return Pre{}; }
    float* C; int ldc;
    __device__ __forceinline__ void operator()(const f32x4 (&acc)[2][2][4][2], const Unit& u, int wr, int wc, int fr, int fq, const Pre&, bool drain) const {
        if (drain) asm volatile("s_waitcnt vmcnt(0)" ::: "memory");
        const int row0 = u.orow0 + wr * 64 + fr, col0 = wc * 32 + 4 * fq;
#pragma unroll
        for (int ai = 0; ai < 2; ++ai)
#pragma unroll
            for (int m = 0; m < 4; ++m) { float* rowp = C + (size_t)(row0 + ai * HALF + m * 16) * ldc + col0;
#pragma unroll
                for (int n = 0; n < 2; ++n) *(GAS f32x4*)(rowp + n * 16) = acc[ai][0][m][n]; }
    }
};
struct EpiBf16 {
    static constexpr bool PERM = true; static constexpr int SCW = 0x7A7A7A7A; typedef NoPre Pre;
    __device__ __forceinline__ Pre prefetch(const Unit&, LAS unsigned char*, int, int, int) const { return Pre{}; }
    bf16_t* O; int ldc;
    __device__ __forceinline__ void operator()(const f32x4 (&acc)[2][2][4][2], const Unit& u, int wr, int wc, int fr, int fq, const Pre&, bool drain) const {
        const int row0 = u.orow0 + wr * 64 + fr, col0 = u.ocol0 + wc * 32 + 8 * fq;
        u32x4 w[2][4][2];
#pragma unroll
        for (int ai = 0; ai < 2; ++ai)
#pragma unroll
            for (int m = 0; m < 4; ++m)
#pragma unroll
                for (int bj = 0; bj < 2; ++bj) { const f32x4 v0 = acc[ai][bj][m][0], v1 = acc[ai][bj][m][1];
                    w[ai][m][bj].x = cvt_pk_bf16(v0[0], v0[1]); w[ai][m][bj].y = cvt_pk_bf16(v0[2], v0[3]); w[ai][m][bj].z = cvt_pk_bf16(v1[0], v1[1]); w[ai][m][bj].w = cvt_pk_bf16(v1[2], v1[3]); }
        if (drain) asm volatile("s_waitcnt vmcnt(0)" ::: "memory");
#pragma unroll
        for (int ai = 0; ai < 2; ++ai)
#pragma unroll
            for (int m = 0; m < 4; ++m) { bf16_t* rowp = O + (size_t)(row0 + ai * HALF + m * 16) * ldc + col0;
#pragma unroll
                for (int bj = 0; bj < 2; ++bj) *(GAS u32x4*)(rowp + bj * HALF) = w[ai][m][bj]; }
    }
};
struct EpiVT {
    static constexpr bool PERM = false; static constexpr int SCW = 0x7A7A7A7A; typedef NoPre Pre;
    __device__ __forceinline__ Pre prefetch(const Unit&, LAS unsigned char*, int, int, int) const { return Pre{}; }
    bf16_t* VT; int col_base;
    __device__ __forceinline__ void operator()(const f32x4 (&acc)[2][2][4][2], const Unit& u, int wr, int wc, int fr, int fq, const Pre&, bool drain) const {
        if (drain) asm volatile("s_waitcnt vmcnt(0)" ::: "memory");
        const int r0 = u.orow0; int b, pos0;
        if (r0 < NLAT) { b = r0 >> 12; pos0 = r0 & 4095; } else { b = (r0 - NLAT) >> 8; pos0 = SEQ + ((r0 - NLAT) & 255); }
        bf16_t* base = VT + ((size_t)b * 512 + (u.ocol0 - col_base) + wc * 32 + fr) * SPB + pos0 + wr * 64 + 4 * fq;
#pragma unroll
        for (int ai = 0; ai < 2; ++ai)
#pragma unroll
            for (int bj = 0; bj < 2; ++bj)
#pragma unroll
                for (int m = 0; m < 4; ++m)
#pragma unroll
                    for (int n = 0; n < 2; ++n) { const f32x4 v = acc[ai][bj][m][n];
                        *(GAS u32x2*)(base + (size_t)(bj * HALF + n * 16) * SPB + ai * HALF + m * 16) = (u32x2){cvt_pk_bf16(v[0], v[1]), cvt_pk_bf16(v[2], v[3])}; }
    }
};
struct EpiY8 {
    static constexpr bool PERM = true; static constexpr int SCW = 0x7A7A7A7A; typedef NoPre Pre;
    __device__ __forceinline__ Pre prefetch(const Unit&, LAS unsigned char*, int, int, int) const { return Pre{}; }
    unsigned char* O; int ldc;
    __device__ __forceinline__ void operator()(const f32x4 (&acc)[2][2][4][2], const Unit& u, int wr, int wc, int fr, int fq, const Pre&, bool drain) const {
        const int row0 = u.orow0 + wr * 64 + fr;
        u32x4 o[2][4];
#pragma unroll
        for (int ai = 0; ai < 2; ++ai)
#pragma unroll
            for (int m = 0; m < 4; ++m) { int w[4];
#pragma unroll
                for (int bj = 0; bj < 2; ++bj) { const f32x4 v0 = acc[ai][bj][m][0], v1 = acc[ai][bj][m][1];
                    int w0 = 0, w1 = 0;
                    w0 = __builtin_amdgcn_cvt_pk_fp8_f32(v0[0], v0[1], w0, false); w0 = __builtin_amdgcn_cvt_pk_fp8_f32(v0[2], v0[3], w0, true);
                    w1 = __builtin_amdgcn_cvt_pk_fp8_f32(v1[0], v1[1], w1, false); w1 = __builtin_amdgcn_cvt_pk_fp8_f32(v1[2], v1[3], w1, true);
                    w[2 * bj] = w0; w[2 * bj + 1] = w1; }
                o[ai][m] = (u32x4){(unsigned)w[0], (unsigned)w[1], (unsigned)w[2], (unsigned)w[3]}; }
        if (drain) asm volatile("s_waitcnt vmcnt(0)" ::: "memory");
#pragma unroll
        for (int ai = 0; ai < 2; ++ai)
#pragma unroll
            for (int m = 0; m < 4; ++m) *(GAS u32x4*)(O + (size_t)(row0 + ai * HALF + m * 16) * ldc + u.ocol0 + wc * 64 + fq * 16) = o[ai][m];
    }
};
struct EpiSwiglu {
    static constexpr bool PERM = true; static constexpr int SCW = 0x7A7A7A7A; typedef NoPre Pre;
    __device__ __forceinline__ Pre prefetch(const Unit&, LAS unsigned char*, int, int, int) const { return Pre{}; }
    unsigned char* ACT;
    __device__ __forceinline__ void operator()(const f32x4 (&acc)[2][2][4][2], const Unit& u, int wr, int wc, int fr, int fq, const Pre&, bool drain) const {
        const int row0 = u.orow0 + wr * 64 + fr, pn = u.ocol0 >> 8;
        u32x2 o[2][4];
#pragma unroll
        for (int ai = 0; ai < 2; ++ai)
#pragma unroll
            for (int m = 0; m < 4; ++m) {
                int w[2];
#pragma unroll
                for (int n = 0; n < 2; ++n) { const f32x4 g = acc[ai][0][m][n], up = acc[ai][1][m][n];
                    f32x4 e;
#pragma unroll
                    for (int i = 0; i < 4; ++i) e[i] = __builtin_amdgcn_exp2f(-g[i]);
                    const f32x4 d = e + 1.0f; f32x4 r;
#pragma unroll
                    for (int i = 0; i < 4; ++i) r[i] = __builtin_amdgcn_rcpf(d[i]);
                    const f32x4 h = (g * up) * r;
                    int v = 0; v = __builtin_amdgcn_cvt_pk_fp8_f32(h[0], h[1], v, false); v = __builtin_amdgcn_cvt_pk_fp8_f32(h[2], h[3], v, true); w[n] = v; }
                o[ai][m] = (u32x2){(unsigned)w[0], (unsigned)w[1]}; }
        if (drain) asm volatile("s_waitcnt vmcnt(0)" ::: "memory");
#pragma unroll
        for (int ai = 0; ai < 2; ++ai)
#pragma unroll
            for (int m = 0; m < 4; ++m) *(GAS u32x2*)(ACT + (size_t)(row0 + ai * HALF + m * 16) * EH + pn * 128 + wc * 32 + 8 * fq) = o[ai][m];
    }
};
constexpr float Y2_SCALE = 8.0f, Y2_INV = 1.0f / 8.0f;
struct EpiScatter {
    static constexpr bool PERM = true; static constexpr int SCW = 0x7D7D7D7D;
    struct Pre { const LAS int* tab; };
    unsigned char* Y2; const int* rowdst;
    __device__ __forceinline__ Pre prefetch(const Unit& u, LAS unsigned char* lds, int wid, int lane, int ui) const {
        LAS unsigned char* tab = lds + STAGE_BYTES + (ui & 1) * 1024;
        if (wid < 4) __builtin_amdgcn_global_load_lds((const unsigned*)(rowdst + u.orow0 + wid * 64 + lane), (LAS unsigned*)(tab + wid * 256), 4, 0, 0);
        Pre p; p.tab = (const LAS int*)tab; return p; }
    __device__ __forceinline__ void operator()(const f32x4 (&acc)[2][2][4][2], const Unit& u, int wr, int wc, int fr, int fq, const Pre& pre, bool drain) const {
        if (u.aux == 128) {
            u32x4 o[2][4];
#pragma unroll
            for (int ai = 0; ai < 2; ++ai)
#pragma unroll
                for (int m = 0; m < 4; ++m) { int w[4];
#pragma unroll
                    for (int bj = 0; bj < 2; ++bj) { const f32x4 v0 = acc[ai][bj][m][0], v1 = acc[ai][bj][m][1];
                        int w0 = 0, w1 = 0;
                        w0 = __builtin_amdgcn_cvt_pk_fp8_f32(v0[0], v0[1], w0, false); w0 = __builtin_amdgcn_cvt_pk_fp8_f32(v0[2], v0[3], w0, true);
                        w1 = __builtin_amdgcn_cvt_pk_fp8_f32(v1[0], v1[1], w1, false); w1 = __builtin_amdgcn_cvt_pk_fp8_f32(v1[2], v1[3], w1, true);
                        w[2 * bj] = w0; w[2 * bj + 1] = w1; }
                    o[ai][m] = (u32x4){(unsigned)w[0], (unsigned)w[1], (unsigned)w[2], (unsigned)w[3]}; }
            if (drain) asm volatile("s_waitcnt vmcnt(0)" ::: "memory");
#pragma unroll
            for (int ai = 0; ai < 2; ++ai)
#pragma unroll
                for (int m = 0; m < 4; ++m) { const int dst = pre.tab[wr * 64 + fr + ai * HALF + m * 16];
                    if (dst >= 0) *(GAS u32x4*)(Y2 + (size_t)dst * 512 + u.ocol0 + wc * 64 + fq * 16) = o[ai][m]; }
        } else {
            u32x2 o[2][4];
#pragma unroll
            for (int ai = 0; ai < 2; ++ai)
#pragma unroll
                for (int m = 0; m < 4; ++m) { unsigned w[2];
#pragma unroll
                    for (int bj = 0; bj < 2; ++bj) { const f32x4 v0 = acc[ai][bj][m][0], v1 = acc[ai][bj][m][1];
                        unsigned x = 0u;
                        x = __builtin_amdgcn_cvt_scalef32_pk_fp4_f32(x, v0[0], v0[1], 1.0f, 0); x = __builtin_amdgcn_cvt_scalef32_pk_fp4_f32(x, v0[2], v0[3], 1.0f, 1);
                        x = __builtin_amdgcn_cvt_scalef32_pk_fp4_f32(x, v1[0], v1[1], 1.0f, 2); x = __builtin_amdgcn_cvt_scalef32_pk_fp4_f32(x, v1[2], v1[3], 1.0f, 3);
                        w[bj] = x; }
                    o[ai][m] = (u32x2){w[0], w[1]}; }
            if (drain) asm volatile("s_waitcnt vmcnt(0)" ::: "memory");
#pragma unroll
            for (int ai = 0; ai < 2; ++ai)
#pragma unroll
                for (int m = 0; m < 4; ++m) { const int dst = pre.tab[wr * 64 + fr + ai * HALF + m * 16];
                    if (dst >= 0) *(GAS u32x2*)(Y2 + (size_t)dst * 512 + (u.ocol0 >> 1) + wc * 32 + fq * 8) = o[ai][m]; }
        }
    }
};

typedef int v8i __attribute__((ext_vector_type(8)));
typedef int v4i __attribute__((ext_vector_type(4)));
struct Frag { bf16x8 p[2]; __device__ __forceinline__ bf16x8& operator[](int k) { return p[k]; } __device__ __forceinline__ const bf16x8& operator[](int k) const { return p[k]; } };
template <class Epi, class Sched, bool GATHER, bool F8 = false, bool ALIGN_EPI = true, bool SP2 = true, bool NHALF = false, bool SWAP = false>
__device__ __forceinline__ void gemm_phase(const int tid_in, LAS unsigned char* lds, const void* Ag, const void* Bg, const int K, const int* rowidx, const Sched& S, const Epi& E) {
    int tid_ = tid_in; asm volatile("" : "+v"(tid_));
    const int tid = tid_, wid = __builtin_amdgcn_readfirstlane(tid >> 6), lane = tid & 63, wr = wid >> 2, wc = wid & 3, fr = lane & 15, fq = lane >> 4;
    const int KB = F8 ? K : 2 * K;
    const int nt = KB / 128;
    unsigned voffB[2];
#pragma unroll
    for (int i = 0; i < 2; ++i) { int R, C; stage_rc(tid * 16 + i * 8192, R, C); const int Rb = Epi::PERM ? ((R & ~31) + perm32(R & 31)) : R;
        voffB[i] = (unsigned)(Rb * KB + C * 2); }
    const size_t kstep = (size_t)128;
    const size_t hstep = (size_t)HALF * KB;
    const unsigned ldsw = (unsigned)wid * 1024u;
    const int aoff = F8 ? lds_byte(wr * 64 + fr, 16 * fq) : lds_byte(wr * 64 + fr, fq * 8), boff = F8 ? lds_byte(wc * 32 + fr, 16 * fq) : lds_byte(wc * 32 + fr, fq * 8);
    constexpr int PIECE1 = F8 ? 16 : 1024;
    const int sc_w = Epi::SCW, sc_a = 0x7F7F7F7F;
#define PG8_SA(b, h) (((b) * 2 + (h)) * HTB)
#define PG8_SB(b, h) ((4 + (b) * 2 + (h)) * HTB)
#define PG8_STAGE_B(bufoff, gbase) do { _Pragma("unroll") for (int _i = 0; _i < 2; ++_i) \
        __builtin_amdgcn_global_load_lds((const unsigned*)((const char*)(gbase) + voffB[_i]), (LAS unsigned*)(lds + (bufoff) + ldsw + _i * 8192), 16, 0, 0); } while (0)
#define PG8_STAGE_A(bufoff, gbase, h) do { const char* _gb = (const char*)(gbase) + (GATHER ? (size_t)0 : (size_t)(h) * hstep); \
        __builtin_amdgcn_global_load_lds((const unsigned*)(_gb + ac[GATHER ? (h) : 0][0]), (LAS unsigned*)(lds + (bufoff) + ldsw), 16, 0, 0); \
        __builtin_amdgcn_global_load_lds((const unsigned*)(_gb + ac[GATHER ? (h) : 0][1]), (LAS unsigned*)(lds + (bufoff) + ldsw + 8192), 16, 0, 0); } while (0)
#define PG8_LDA(dst, b, h) do { _Pragma("unroll") for (int m = 0; m < 4; ++m) { if constexpr (F8) { const v4i _l = *(const LAS v4i*)(lds + PG8_SA(b, h) + aoff + m * 2048), _h = *(const LAS v4i*)(lds + PG8_SA(b, h) + aoff + m * 2048 + PIECE1); dst##8[m] = __builtin_shufflevector(_l, _h, 0, 1, 2, 3, 4, 5, 6, 7); } \
        else { dst[m][0] = *(const LAS bf16x8*)(lds + PG8_SA(b, h) + aoff + m * 2048); dst[m][1] = *(const LAS bf16x8*)(lds + PG8_SA(b, h) + aoff + m * 2048 + PIECE1); } } } while (0)
#define PG8_LDB(dst, b, h) do { _Pragma("unroll") for (int n = 0; n < 2; ++n) { if constexpr (F8) { const v4i _l = *(const LAS v4i*)(lds + PG8_SB(b, h) + boff + n * 2048), _h = *(const LAS v4i*)(lds + PG8_SB(b, h) + boff + n * 2048 + PIECE1); dst##8[n] = __builtin_shufflevector(_l, _h, 0, 1, 2, 3, 4, 5, 6, 7); } \
        else { dst[n][0] = *(const LAS bf16x8*)(lds + PG8_SB(b, h) + boff + n * 2048); dst[n][1] = *(const LAS bf16x8*)(lds + PG8_SB(b, h) + boff + n * 2048 + PIECE1); } } } while (0)
#define PG8_MMA(ai, bj, At, Bt) do { __builtin_amdgcn_s_setprio(1); _Pragma("unroll") for (int m = 0; m < 4; ++m) _Pragma("unroll") for (int n = 0; n < 2; ++n) { \
        if constexpr (F8) asm volatile("v_mfma_scale_f32_16x16x128_f8f6f4 %0, %1, %2, %0, %3, %4 op_sel_hi:[0,0,0]" : "+v"(acc[ai][bj][m][n]) : "v"(Bt##8[n]), "v"(At##8[m]), "v"(sc_w), "v"(sc_a)); \
        else { _Pragma("unroll") for (int k = 0; k < 2; ++k) acc[ai][bj][m][n] = SWAP ? __builtin_amdgcn_mfma_f32_16x16x32_bf16(At[m][k], Bt[n][k], acc[ai][bj][m][n], 0, 0, 0) : __builtin_amdgcn_mfma_f32_16x16x32_bf16(Bt[n][k], At[m][k], acc[ai][bj][m][n], 0, 0, 0); } } \
        __builtin_amdgcn_s_setprio(0); } while (0)
#define PG8_WAIT_V(n) asm volatile("s_waitcnt vmcnt(" #n ")" ::: "memory")
#define PG8_WAIT_LOOP do { if constexpr (NHALF) PG8_WAIT_V(6); else PG8_WAIT_V(8); } while (0)
#define PG8_WAIT_L(n) asm volatile("s_waitcnt lgkmcnt(" #n ")" ::: "memory")
#define PG8_BAR __builtin_amdgcn_s_barrier()
#define PG8_SCHED __builtin_amdgcn_sched_barrier(0)
#define PG8_TAB(par) (lds + STAGE_BYTES + 2048 + (par) * 1024)
#define PG8_TABLOAD(par, row0) do { if (wid < 4) __builtin_amdgcn_global_load_lds((const unsigned*)(rowidx + (row0) + wid * 64 + lane), (LAS unsigned*)(PG8_TAB(par) + wid * 256), 4, 0, 0); } while (0)
#define PG8_AOFF_H(h, par) do { int _tz = tid; asm volatile("" : "+v"(_tz)); _Pragma("unroll") for (int _i = 0; _i < 2; ++_i) { int _R, _C; stage_rc(_tz * 16 + _i * 8192, _R, _C); \
        if (GATHER) ac[h][_i] = ((const LAS unsigned*)PG8_TAB(par))[(h) * HALF + _R] * (unsigned)KB + (unsigned)_C * 2u; \
        else ac[h][_i] = (unsigned)(((h) * HALF + _R) * KB) + (unsigned)_C * 2u; } } while (0)
    static_assert(SP2, "only the two-super-phase K-loop is kept");
    Unit cur, nxt; int ui = 0;
    if (!S.next(0, cur)) return;
    f32x4 acc[2][2][4][2];
#pragma unroll
    for (int a = 0; a < 2; ++a)
#pragma unroll
        for (int b = 0; b < 2; ++b)
#pragma unroll
            for (int m = 0; m < 4; ++m)
#pragma unroll
                for (int n = 0; n < 2; ++n) acc[a][b][m][n] = (f32x4){0.f, 0.f, 0.f, 0.f};
    bf16x8 At[F8 ? 1 : 4][2], B0[F8 ? 1 : 2][2], B1[F8 ? 1 : 2][2];
    v8i At8[F8 ? 4 : 1], B08[F8 ? 2 : 1], B18[F8 ? 2 : 1];
    unsigned ac[GATHER ? 2 : 1][2];
    if (GATHER) { PG8_TABLOAD(0, cur.arow0); PG8_WAIT_V(0); PG8_BAR; }
    PG8_AOFF_H(0, 0); if (GATHER) { PG8_AOFF_H((GATHER ? 1 : 0), 0); }
    const char* cA = (const char*)Ag + (GATHER ? (size_t)0 : (size_t)cur.arow0 * KB); const char* cB = (const char*)Bg + (size_t)cur.brow0 * KB;
    PG8_STAGE_B(PG8_SB(0, 0), cB); if constexpr (!NHALF) PG8_STAGE_B(PG8_SB(0, 1), cB + hstep); PG8_STAGE_A(PG8_SA(0, 0), cA, 0); PG8_STAGE_A(PG8_SA(0, 1), cA, 1);
    if (wr == 1) PG8_BAR;
    PG8_WAIT_V(2); PG8_BAR;
    PG8_STAGE_B(PG8_SB(1, 0), cB + kstep); PG8_STAGE_A(PG8_SA(1, 0), cA + kstep, 0); if constexpr (!NHALF) PG8_STAGE_B(PG8_SB(1, 1), cB + hstep + kstep);
    if constexpr (NHALF) PG8_WAIT_V(4); else PG8_WAIT_V(6);
    PG8_BAR;
    for (;;) {
        const typename Epi::Pre pre = E.prefetch(cur, lds, wid, lane, ui);
        const bool has_next = S.next(ui + 1, nxt);
        if (GATHER) { if (has_next) PG8_TABLOAD((ui + 1) & 1, nxt.arow0); }
        const char* nA = has_next ? ((const char*)Ag + (GATHER ? (size_t)0 : (size_t)nxt.arow0 * KB)) : cA; const char* nB = has_next ? (const char*)Bg + (size_t)nxt.brow0 * KB : cB;
_Pragma("nounroll")
        for (int t = 0; t < nt; t += 2) {
            const bool last = (t == nt - 2);
            const bool skipw = (t == 0) && (ui > 0);
            const char* a1 = cA + (size_t)(t + 1) * kstep;
            const char* a2 = last ? nA : cA + (size_t)(t + 2) * kstep; const char* b2 = last ? nB : cB + (size_t)(t + 2) * kstep;
            const char* a3 = a2 + kstep; const char* b3 = b2 + kstep;
            if (GATHER) { if (last && has_next) { PG8_AOFF_H(0, (ui + 1) & 1); } }
            PG8_LDB(B0, 0, 0); if constexpr (!NHALF) PG8_LDB(B1, 0, 1); PG8_SCHED; PG8_LDA(At, 0, 0); PG8_STAGE_A(PG8_SA(1, 1), a1, 1);
            if (!skipw) PG8_WAIT_LOOP; PG8_WAIT_L(0); PG8_BAR; PG8_MMA(0, 0, At, B0); if constexpr (!NHALF) PG8_MMA(0, 1, At, B1); PG8_BAR; PG8_SCHED;
            if (GATHER) { if (last && has_next) { PG8_AOFF_H(1, (ui + 1) & 1); } }
            PG8_LDA(At, 0, 1); PG8_STAGE_B(PG8_SB(0, 0), b2); if constexpr (!NHALF) PG8_STAGE_B(PG8_SB(0, 1), b2 + hstep); PG8_STAGE_A(PG8_SA(0, 0), a2, 0);
            if (!skipw) PG8_WAIT_LOOP; PG8_WAIT_L(0); PG8_BAR; PG8_MMA(1, 0, At, B0); if constexpr (!NHALF) PG8_MMA(1, 1, At, B1); PG8_BAR; PG8_SCHED;
            PG8_LDB(B0, 1, 0); if constexpr (!NHALF) PG8_LDB(B1, 1, 1); PG8_SCHED; PG8_LDA(At, 1, 0); PG8_STAGE_A(PG8_SA(0, 1), a2, 1);
            if (!skipw) PG8_WAIT_LOOP; PG8_WAIT_L(0); PG8_BAR; PG8_MMA(0, 0, At, B0); if constexpr (!NHALF) PG8_MMA(0, 1, At, B1); PG8_BAR; PG8_SCHED;
            PG8_LDA(At, 1, 1); PG8_STAGE_B(PG8_SB(1, 0), b3); if constexpr (!NHALF) PG8_STAGE_B(PG8_SB(1, 1), b3 + hstep); PG8_STAGE_A(PG8_SA(1, 0), a3, 0);
            PG8_WAIT_LOOP; PG8_WAIT_L(0); PG8_BAR; PG8_MMA(1, 0, At, B0); if constexpr (!NHALF) PG8_MMA(1, 1, At, B1); PG8_BAR; PG8_SCHED;
        }
        if constexpr (ALIGN_EPI) { if (wr == 0) PG8_BAR; }
        E(acc, cur, wr, wc, fr, fq, pre, has_next);
        if (!has_next) break;
#pragma unroll
        for (int a = 0; a < 2; ++a)
#pragma unroll
            for (int b = 0; b < 2; ++b)
#pragma unroll
                for (int m = 0; m < 4; ++m)
#pragma unroll
                    for (int n = 0; n < 2; ++n) acc[a][b][m][n] = (f32x4){0.f, 0.f, 0.f, 0.f};
        cur = nxt; cA = nA; cB = nB; ++ui;
        if constexpr (ALIGN_EPI) { if (wr == 1) PG8_BAR; }
    }
    PG8_WAIT_V(0);
    if constexpr (!ALIGN_EPI) { if (wr == 0) PG8_BAR; }
    PG8_BAR;
#undef PG8_SA
#undef PG8_SB
#undef PG8_STAGE_A
#undef PG8_STAGE_B
#undef PG8_LDA
#undef PG8_LDB
#undef PG8_MMA
#undef PG8_WAIT_V
#undef PG8_WAIT_L
#undef PG8_WAIT_LOOP
#undef PG8_BAR
#undef PG8_SCHED
#undef PG8_AOFF_H
#undef PG8_TAB
#undef PG8_TABLOAD
}
}

constexpr int NWAVES = 8, NTHR = 512;
constexpr size_t MiB = 1u << 20;
constexpr size_t WS_CTL = 0, CTL_BYTES = 1 * MiB;
constexpr size_t WS_MOD = 1 * MiB;
constexpr size_t WS_WIN = 3 * MiB;
constexpr size_t WS_WOUT = 29 * MiB;
constexpr size_t WS_WR = 37 * MiB;
constexpr size_t WS_HYF = 39 * MiB;
constexpr size_t WS_HYFC = 71 * MiB;
constexpr size_t WS_XC = 73 * MiB;
constexpr size_t WS_EXP1 = 89 * MiB;
constexpr size_t WS_EXP2 = 218 * MiB;
constexpr size_t WS_XM = 283 * MiB;
constexpr size_t WS_EIDX = 419 * MiB;
constexpr size_t WS_WGT = 422 * MiB;
constexpr size_t WS_RNK = 425 * MiB;
constexpr size_t WS_ROWTOK = 428 * MiB;
constexpr size_t WS_ROWDST = 431 * MiB;
constexpr size_t WS_TILEEXP = 434 * MiB;
constexpr size_t WS_BIG = 435 * MiB;
constexpr size_t WS_U = WS_BIG;
constexpr size_t WS_MIX = 877 * MiB;
constexpr size_t WS_VT = 1013 * MiB;
constexpr size_t WS_HV = 1081 * MiB;
constexpr size_t WS_Z2 = 1183 * MiB;
constexpr size_t WS_GDS = 1217 * MiB;
constexpr size_t WS_GSIN = 1285 * MiB;
constexpr size_t WS_GD = 1319 * MiB;
constexpr size_t WS_Y = 1321 * MiB;
constexpr size_t WS_LOGIT = WS_BIG;
constexpr size_t WS_ACT = WS_BIG;
constexpr size_t WS_Y2 = 758 * MiB;
constexpr size_t WS_XM8 = 1470 * MiB;
constexpr size_t WS_WRB = 1540 * MiB;
constexpr size_t WS_RBIAS = 1558 * MiB;
constexpr size_t WS_XR = 1600 * MiB;
constexpr size_t WS_END = 1736 * MiB;
constexpr int CW_BAR = 4096;
constexpr int CW_CNT = 16384;
constexpr int CW_NTL = 20480;

constexpr int LDS_BYTES = 163840;
constexpr int MISC_OFF = 163584;

struct Frame {
    LAS unsigned char* lds;
    int tid, lane, wave, G, wg;
    const float* const* in;
    float* out; unsigned char* ws; unsigned* ctl;
};
enum { I_X = 0, I_C, I_CTX, I_CCTX, I_WMOD, I_BMOD, I_WIN, I_RPB, I_WA2, I_BA2, I_GNORM, I_HSW, I_HSB, I_HW1, I_HB1, I_HF1, I_HW2, I_HB2, I_HF2, I_HW3, I_HB3, I_HDEC, I_HSKIP,
       I_WOUT, I_LN1G, I_LN1B, I_RW, I_RB, I_WEG, I_WEU, I_WED, I_WSG, I_WSU, I_WSD, I_LN2G, I_LN2B };

__device__ __forceinline__ int row_b(int row) { return row < NLAT ? (row >> 12) : 16; }
__device__ __forceinline__ const float* mod_ptr(const Frame& F, int l, int row) { return (const float*)(F.ws + WS_MOD) + ((size_t)l * 17 + row_b(row)) * 6144; }

constexpr float NA_QSCALE = 0.125f * 1.4426950408889634f, NA_CLAMP = 60.0f * 1.4426950408889634f;
template <class RowFn>
__device__ __forceinline__ void tr_item(const float* W, int ldw, int k0, int n0, bf16_t* dst, int ldd, RowFn rf, LAS float* scr, int lane, float scale = 1.0f) {
    float tv[32];
    const GAS float* wp = (const GAS float*)(W + (size_t)(k0 + (lane >> 5)) * ldw + n0 + (lane & 31));
#pragma unroll
    for (int i = 0; i < 32; ++i) tv[i] = __builtin_nontemporal_load(wp + (size_t)(2 * i) * ldw);
#pragma unroll
    for (int i = 0; i < 32; ++i) scr[(2 * i + (lane >> 5)) * 33 + (lane & 31)] = tv[i];
    LDS_WAIT(); asm volatile("" ::: "memory");
    const int c = lane & 7;
#pragma unroll
    for (int j = 0; j < 4; ++j) { const int n = (lane >> 3) + 8 * j; const LAS float* s = scr + (8 * c) * 33 + n;
        u32x4 o; o.x = pk2(s[0 * 33] * scale, s[1 * 33] * scale); o.y = pk2(s[2 * 33] * scale, s[3 * 33] * scale); o.z = pk2(s[4 * 33] * scale, s[5 * 33] * scale); o.w = pk2(s[6 * 33] * scale, s[7 * 33] * scale);
        *(GAS u32x4*)(dst + (size_t)rf(n0 + n) * ldd + k0 + 8 * c) = o; }
    LDS_WAIT(); asm volatile("" ::: "memory");
}
template <class RowFn>
__device__ __forceinline__ void tr_item_ks(const float* W, int ldw, int k0, int n0, bf16_t* dst, int ldd, RowFn rf, LAS float* scr, int lane, const float* ksc) {
    float tv[32];
    const GAS float* wp = (const GAS float*)(W + (size_t)(k0 + (lane >> 5)) * ldw + n0 + (lane & 31));
#pragma unroll
    for (int i = 0; i < 32; ++i) tv[i] = wp[(size_t)(2 * i) * ldw];
#pragma unroll
    for (int i = 0; i < 32; ++i) scr[(2 * i + (lane >> 5)) * 33 + (lane & 31)] = tv[i] * (1.0f + ksc[2 * i + (lane >> 5)]);
    LDS_WAIT(); asm volatile("" ::: "memory");
    const int c = lane & 7;
#pragma unroll
    for (int j = 0; j < 4; ++j) { const int n = (lane >> 3) + 8 * j; const LAS float* s = scr + (8 * c) * 33 + n;
        u32x4 o; o.x = pk2(s[0 * 33], s[1 * 33]); o.y = pk2(s[2 * 33], s[3 * 33]); o.z = pk2(s[4 * 33], s[5 * 33]); o.w = pk2(s[6 * 33], s[7 * 33]);
        *(GAS u32x4*)(dst + (size_t)rf(n0 + n) * ldd + k0 + 8 * c) = o; }
    LDS_WAIT(); asm volatile("" ::: "memory");
}
template <class RowFn>
__device__ __forceinline__ void tr_item8(const float* W, int ldw, int k0, int n0, unsigned char* dst, int ldd, RowFn rf, float scale, LAS float* scr, int lane) {
    float tv[32];
    const GAS float* wp = (const GAS float*)(W + (size_t)(k0 + (lane >> 5)) * ldw + n0 + (lane & 31));
#pragma unroll
    for (int i = 0; i < 32; ++i) tv[i] = __builtin_nontemporal_load(wp + (size_t)(2 * i) * ldw);
#pragma unroll
    for (int i = 0; i < 32; ++i) scr[(2 * i + (lane >> 5)) * 33 + (lane & 31)] = tv[i];
    LDS_WAIT(); asm volatile("" ::: "memory");
    const int n = lane >> 1, hf = lane & 1; const LAS float* s = scr + (32 * hf) * 33 + n;
    unsigned w[8];
#pragma unroll
    for (int j = 0; j < 8; ++j) { int v = 0; v = __builtin_amdgcn_cvt_pk_fp8_f32(s[(4 * j) * 33] * scale, s[(4 * j + 1) * 33] * scale, v, false); v = __builtin_amdgcn_cvt_pk_fp8_f32(s[(4 * j + 2) * 33] * scale, s[(4 * j + 3) * 33] * scale, v, true); w[j] = (unsigned)v; }
    unsigned char* d = dst + (size_t)rf(n0 + n) * ldd + k0 + 32 * hf;
    *(GAS u32x4*)d = (u32x4){w[0], w[1], w[2], w[3]}; *(GAS u32x4*)(d + 16) = (u32x4){w[4], w[5], w[6], w[7]};
    LDS_WAIT(); asm volatile("" ::: "memory");
}
struct RowId { __device__ __forceinline__ int operator()(int n) const { return n; } };
struct RowWin { __device__ __forceinline__ int operator()(int n) const { return n >= 2336 ? n - 32 : n; } };
struct RowGU { int up; __device__ __forceinline__ int operator()(int j) const { return (j >> 7) * 256 + up * 128 + (j & 127); } };

__device__ __forceinline__ void p0_static_weights(Frame& F) {
    LAS float* scr = (LAS float*)(F.lds + F.wave * 16384);
    const int gw = F.wg * NWAVES + F.wave, NGW = F.G * NWAVES;
    constexpr int I_IN = 16 * 97, I_OUT = 16 * 32, I_R = 16 * 4, PER_L = I_IN + I_OUT + I_R;
    for (int it = gw; it < DEPTH * PER_L; it += NGW) {
        const int l = it / PER_L; int r = it % PER_L;
        if (r < I_IN) { const int kb = r / 97, nb = r % 97; if (nb == 72) continue;
            tr_item(F.in[I_WIN] + (size_t)l * DM * DIN_REF, DIN_REF, kb * 64, nb * 32, (bf16_t*)(F.ws + WS_WIN) + (size_t)l * DIN * DM, DM, RowWin{}, scr, F.lane, nb < 16 ? NA_QSCALE : 1.0f); continue; }
        r -= I_IN;
        if (r < I_OUT) { const int kb = r / 32, nb = r % 32;
            tr_item(F.in[I_WOUT] + (size_t)l * DM * DM, DM, kb * 64, nb * 32, (bf16_t*)(F.ws + WS_WOUT) + (size_t)l * DM * DM, DM, RowId{}, scr, F.lane); continue; }
        r -= I_OUT;
        { const int kb = r / 4, nb = r % 4;
            tr_item(F.in[I_RW] + (size_t)l * DM * NEXP, NEXP, kb * 64, nb * 32, (bf16_t*)(F.ws + WS_WR) + (size_t)l * 256 * DM, DM, RowId{}, scr, F.lane); }
    }
    const int gt = F.wg * NTHR + F.tid, NGT = F.G * NTHR;
    for (int i = gt; i < DEPTH * 128 * DM / 8; i += NGT) { const int l = i / (128 * DM / 8), r = i % (128 * DM / 8);
        *(u32x4*)((bf16_t*)(F.ws + WS_WR) + ((size_t)l * 256 + 128) * DM + (size_t)r * 8) = (u32x4){0u, 0u, 0u, 0u}; }
    for (int i = gt; i < DEPTH * 256 * DM; i += NGT) {
        const int k = i % DM, n = (i / DM) % 256, l = i / (DM * 256), dir = n >> 7, j = n & 127;
        const float* wi = F.in[I_WIN] + ((size_t)l * DM + k) * DIN_REF + 2304 + dir * 16;
        const float* wa = F.in[I_WA2] + ((size_t)(l * 2 + dir) * 16) * 128 + j;
        float s = 0.f;
#pragma unroll
        for (int r = 0; r < 16; ++r) s += wi[r] * wa[r * 128];
        ((bf16_t*)(F.ws + WS_WIN))[((size_t)l * DIN + 3072 + n) * DM + k] = (bf16_t)f2bf(s);
    }
}
__device__ __forceinline__ void p0_mod(Frame& F) {
    LAS float* sc = (LAS float*)F.lds;
    LAS float* red = (LAS float*)(F.lds + 17 * 1024 * 4);
    for (int i = F.tid; i < 17 * 1024; i += NTHR) { const int r = i >> 10, k = i & 1023; const float v = r < 16 ? F.in[I_C][r * 1024 + k] : F.in[I_CCTX][k]; sc[i] = silu_f(v); }
    __syncthreads();
    const int kq = F.tid >> 7, cl = F.tid & 127;
    for (int u = F.wg; u < DEPTH * 48; u += F.G) {
        const int l = u / 48, col = (u % 48) * 128 + cl;
        const float* w = F.in[I_WMOD] + (size_t)l * DM * 6144 + col;
        float a[17];
#pragma unroll
        for (int r = 0; r < 17; ++r) a[r] = 0.f;
        for (int k0 = kq * 256; k0 < kq * 256 + 256; k0 += 16) {
            float wv[16];
#pragma unroll
            for (int q = 0; q < 16; ++q) wv[q] = *(const GAS float*)(w + (size_t)(k0 + q) * 6144);
#pragma unroll
            for (int q = 0; q < 16; ++q)
#pragma unroll
                for (int r = 0; r < 17; ++r) a[r] += sc[r * 1024 + k0 + q] * wv[q]; }
#pragma unroll
        for (int r = 0; r < 17; ++r) red[(kq * 17 + r) * 128 + cl] = a[r];
        __syncthreads();
        for (int i = F.tid; i < 17 * 128; i += NTHR) { const int r = i >> 7, c2 = i & 127, cc = (u % 48) * 128 + c2;
            const float s = red[(0 * 17 + r) * 128 + c2] + red[(1 * 17 + r) * 128 + c2] + red[(2 * 17 + r) * 128 + c2] + red[(3 * 17 + r) * 128 + c2] + F.in[I_BMOD][l * 6144 + cc];
            ((float*)(F.ws + WS_MOD))[((size_t)l * 17 + r) * 6144 + cc] = s; }
        __syncthreads();
    }
}
__device__ __forceinline__ void p0_hyena_filters(Frame& F) {
    LAS float* z = (LAS float*)F.lds;
    LAS float* h1 = z + 1092;
    LAS float* h2 = h1 + 33 * 64;
    LAS float* tt = h2 + 33 * 64;
    LAS float* W1 = tt + 64;
    LAS float* W2 = W1 + 33 * 64;
    constexpr int UL = 4096 / 32, UC = 256 / 32, UPL = UL + UC;
    for (int u = F.wg; u < DEPTH * UPL; u += F.G) {
        const int l = u / UPL, r = u % UPL; const bool lat = r < UL; const int L = lat ? 4096 : 256, n0 = (lat ? r : r - UL) * 32;
        __syncthreads();
        for (int i = F.tid; i < 33 * 64; i += NTHR) W1[i] = F.in[I_HW1][(size_t)l * 33 * 64 + i];
        for (int i = F.tid; i < 64 * 64; i += NTHR) W2[i] = F.in[I_HW2][(size_t)l * 64 * 64 + i];
        for (int i = F.tid; i < 33 * 33; i += NTHR) { const int p = i / 33, e = i % 33, n = n0 + p;
            const float t = (float)n / (float)(L - 1);
            float v;
            if (e == 0) v = t;
            else { const int kb = (e - 1) & 15; const float band = 1e-4f + (float)kb * ((15.0f - 1e-4f) / 15.0f);
                   const float w = 6.283185307179586f * (float)n / (float)L; const float ang = w * band;
                   v = e <= 16 ? __cosf(ang) : -__sinf(ang); }
            z[i] = v; if (e == 0) tt[p] = t; }
        __syncthreads();
        for (int i = F.tid; i < 33 * 64; i += NTHR) { const int p = i >> 6, j = i & 63; float s = F.in[I_HB1][l * 64 + j];
#pragma unroll 11
            for (int e = 0; e < 33; ++e) s += z[p * 33 + e] * W1[e * 64 + j];
            h1[i] = __sinf(F.in[I_HF1][l * 64 + j] * s); }
        __syncthreads();
        for (int i = F.tid; i < 33 * 64; i += NTHR) { const int p = i >> 6, j = i & 63; float s = F.in[I_HB2][l * 64 + j];
#pragma unroll 16
            for (int e = 0; e < 64; ++e) s += h1[p * 64 + e] * W2[e * 64 + j];
            h2[i] = __sinf(F.in[I_HF2][l * 64 + j] * s); }
        __syncthreads();
        {
            const int g = F.tid >> 8, col0 = 4 * (F.tid & 255), o = col0 >> 9, dir = (col0 >> 8) & 1, ch0 = col0 & 255;
            const int pb = (dir ? 0 : 1) + 16 * g;
            float a[4][16];
#pragma unroll
            for (int j = 0; j < 4; ++j)
#pragma unroll
                for (int q = 0; q < 16; ++q) a[j][q] = 0.f;
            const float* w3 = F.in[I_HW3] + (size_t)l * 64 * 1024 + col0;
            const LAS float* hp = h2 + pb * 64;
            f32x4 wa[4], wb[4];
#pragma unroll
            for (int q = 0; q < 4; ++q) wa[q] = *(const GAS f32x4*)(w3 + (size_t)q * 1024);
#define HF_BLOCK(wv_, k0_) do { _Pragma("unroll") for (int pi = 0; pi < 16; ++pi) { const f32x4 hv = *(const LAS f32x4*)(hp + pi * 64 + (k0_)); \
                _Pragma("unroll") for (int q = 0; q < 4; ++q) _Pragma("unroll") for (int j = 0; j < 4; ++j) a[j][pi] += hv[q] * wv_[q][j]; } } while (0)
#pragma unroll 1
            for (int k0 = 0; k0 < 64; k0 += 8) {
#pragma unroll
                for (int q = 0; q < 4; ++q) wb[q] = *(const GAS f32x4*)(w3 + (size_t)(k0 + 4 + q) * 1024);
                __builtin_amdgcn_sched_barrier(0);
                HF_BLOCK(wa, k0);
                __builtin_amdgcn_sched_barrier(0);
                { const int kn = k0 + 8 < 64 ? k0 + 8 : k0;
#pragma unroll
                  for (int q = 0; q < 4; ++q) wa[q] = *(const GAS f32x4*)(w3 + (size_t)(kn + q) * 1024); }
                __builtin_amdgcn_sched_barrier(0);
                HF_BLOCK(wb, k0 + 4);
                __builtin_amdgcn_sched_barrier(0);
            }
#undef HF_BLOCK
            const f32x4 b3 = *(const GAS f32x4*)(F.in[I_HB3] + l * 1024 + col0), dc = *(const GAS f32x4*)(F.in[I_HDEC] + ((size_t)(l * 2 + o) * 2 + dir) * 256 + ch0);
            float a0[4] = {0.f, 0.f, 0.f, 0.f};
            if (n0 == 0 && dir == 0 && g == 0) {
                for (int k = 0; k < 64; ++k) { const f32x4 wv = *(const GAS f32x4*)(w3 + (size_t)k * 1024); const float hv = h2[k];
#pragma unroll
                    for (int j = 0; j < 4; ++j) a0[j] += hv * wv[j]; } }
#pragma unroll
            for (int j = 0; j < 4; ++j) {
                const float dec = fabsf(dc[j]);
                bf16_t* R = lat ? (bf16_t*)(F.ws + WS_HYF) + ((size_t)(l * 2 + o) * 256 + ch0 + j) * 8192 : (bf16_t*)(F.ws + WS_HYFC) + ((size_t)(l * 2 + o) * 256 + ch0 + j) * 512;
                float v[16];
#pragma unroll
                for (int pi = 0; pi < 16; ++pi) v[pi] = (a[j][pi] + b3[j]) * __expf(-tt[pb + pi] * dec);
                unsigned w[8];
                if (dir == 0) {
                    if (n0 + 32 == L && g == 1) v[15] = 0.f;
#pragma unroll
                    for (int q = 0; q < 8; ++q) w[q] = pk2(v[15 - 2 * q], v[14 - 2 * q]);
                    GAS u32x4* dst = (GAS u32x4*)(R + (L - n0 - 32) + 16 * (1 - g));
                    dst[0] = (u32x4){w[0], w[1], w[2], w[3]}; dst[1] = (u32x4){w[4], w[5], w[6], w[7]};
                    if (n0 == 0 && g == 0) R[L] = (bf16_t)f2bf((a0[j] + b3[j]) * __expf(-tt[0] * dec) + F.in[I_HSKIP][(l * 2 + o) * 256 + ch0 + j]);
                } else if (n0 > 0 || g == 1) {
#pragma unroll
                    for (int q = 0; q < 8; ++q) w[q] = pk2(v[2 * q], v[2 * q + 1]);
                    GAS u32x4* dst = (GAS u32x4*)(R + (L + n0) + 16 * g);
                    dst[0] = (u32x4){w[0], w[1], w[2], w[3]}; dst[1] = (u32x4){w[4], w[5], w[6], w[7]};
                } else {
#pragma unroll
                    for (int pi = 1; pi < 16; ++pi) R[L + pi] = (bf16_t)f2bf(v[pi]);
                }
            }
        }
    }
    __syncthreads();
}
__device__ __forceinline__ void p0_init_rows(Frame& F) {
    const int gw = F.wg * NWAVES + F.wave, NGW = F.G * NWAVES;
    for (int row = gw; row < NROW; row += NGW) {
        const float* src = row < NLAT ? F.in[I_X] + (size_t)row * DM : F.in[I_CTX] + (size_t)(row - NLAT) * DM;
        const float* md = mod_ptr(F, 0, row);
        bf16_t* xr = (bf16_t*)(F.ws + WS_XR) + (size_t)row * DM; bf16_t* xm = (bf16_t*)(F.ws + WS_XM) + (size_t)row * DM;
#pragma unroll
        for (int j = 0; j < 4; ++j) { const int c = 4 * F.lane + 256 * j;
            const f32x4 v = __builtin_nontemporal_load((const GAS f32x4*)(src + c)), sh = *(const GAS f32x4*)(md + c), sc = *(const GAS f32x4*)(md + 1024 + c);
            *(GAS u32x2*)(xr + c) = (u32x2){pk2(v[0], v[1]), pk2(v[2], v[3])};
            u32x2 w; w.x = pk2(v[0] * (1.f + sc[0]) + sh[0], v[1] * (1.f + sc[1]) + sh[1]); w.y = pk2(v[2] * (1.f + sc[2]) + sh[2], v[3] * (1.f + sc[3]) + sh[3]);
            *(GAS u32x2*)(xm + c) = w; }
    }
}
__device__ __forceinline__ void p1_router_weights(Frame& F) {
    LAS float* scr = (LAS float*)(F.lds + F.wave * 16384);
    const int gw = F.wg * NWAVES + F.wave, NGW = F.G * NWAVES;
    const float* MOD = (const float*)(F.ws + WS_MOD);
    for (int it = gw; it < DEPTH * 17 * 64; it += NGW) {
        const int lb = it >> 6, l = lb / 17, kb = (it & 63) >> 2, nb = it & 3;
        tr_item_ks(F.in[I_RW] + (size_t)l * DM * NEXP, NEXP, kb * 64, nb * 32, (bf16_t*)(F.ws + WS_WRB) + (size_t)lb * 128 * DM, DM, RowId{}, scr, F.lane, MOD + (size_t)lb * 6144 + 4096 + kb * 64); }
    for (int it = gw; it < DEPTH * 17 * 8; it += NGW) {
        const int lb = it >> 3, l = lb / 17, n = (it & 7) * 16 + (F.lane & 15), kq = F.lane >> 4;
        const float* sh = MOD + (size_t)lb * 6144 + 3072 + kq * 256; const float* w = F.in[I_RW] + (size_t)l * DM * NEXP + (size_t)(kq * 256) * NEXP + n;
        float a = 0.f;
#pragma unroll 8
        for (int k = 0; k < 256; ++k) a += sh[k] * w[(size_t)k * NEXP];
        a += shx(a, 16, F.lane); a += shx(a, 32, F.lane);
        if (kq == 0) ((float*)(F.ws + WS_RBIAS))[(size_t)lb * 128 + n] = a; }
}
constexpr float WEXP_SCALE = 32.0f;
constexpr int XW_ITEMS = NE1 * 384, XW_TAIL_E = 12288, XW_TAIL_G = 12288 + 7680;
__device__ __forceinline__ void p_expert_weights(Frame& F, int l, int it0, int it1, int nw, int w) {
    LAS float* scr = (LAS float*)(F.lds + F.wave * 16384);
    constexpr int I1 = 16 * 8, I2 = 4 * 32, PER_E = 2 * I1 + I2;
    for (int it = it0 + w; it < it1; it += nw) {
        const int e = it / PER_E; int r = it % PER_E;
        unsigned char* d1 = (unsigned char*)(F.ws + WS_EXP1) + (size_t)e * 512 * DM; unsigned char* d2 = (unsigned char*)(F.ws + WS_EXP2) + (size_t)e * DM * EH;
        if (r < 2 * I1) { const int up = r >= I1; if (up) r -= I1; const int kb = r / 8, nb = r % 8;
            const float* src = e < NEXP ? F.in[up ? I_WEU : I_WEG] + ((size_t)l * NEXP + e) * DM * EH : F.in[up ? I_WSU : I_WSG] + (size_t)l * DM * EH;
            tr_item8(src, EH, kb * 64, nb * 32, d1, DM, RowGU{up}, up ? WEXP_SCALE * 0.6931471805599453f : WEXP_SCALE * 1.4426950408889634f, scr, F.lane); }
        else { r -= 2 * I1; const int kb = r / 32, nb = r % 32;
            const float* src = e < NEXP ? F.in[I_WED] + ((size_t)l * NEXP + e) * EH * DM : F.in[I_WSD] + (size_t)l * EH * DM;
            tr_item8(src, DM, kb * 64, nb * 32, d2, EH, RowId{}, WEXP_SCALE, scr, F.lane); }
    }
}

__device__ __forceinline__ f32x4 mfma16(bf16x8 a, bf16x8 b, f32x4 c) { return __builtin_amdgcn_mfma_f32_16x16x32_bf16(a, b, c, 0, 0, 0); }

__device__ __forceinline__ void ph_transposes(Frame& F, int l) {
    LAS bf16_t* tile = (LAS bf16_t*)(F.lds + F.wave * 16384);
    const bf16_t* U = (const bf16_t*)(F.ws + WS_U);
    const int gw = F.wg * NWAVES + F.wave, NGW = F.G * NWAVES;
    const int rsub = F.lane >> 3, cseg = F.lane & 7;
    for (int u = gw; u < 1088 * 12; u += NGW) {
        const int tt = u / 12, blk = u % 12;
        int b, s0, Ls, rowbase, posbase;
        if (tt < 1024) { b = tt >> 6; s0 = (tt & 63) * 64; Ls = SEQ; rowbase = b * SEQ; posbase = 0; }
        else { const int t2 = tt - 1024; b = t2 >> 2; s0 = (t2 & 3) * 64; Ls = CTXL; rowbase = NLAT + b * CTXL; posbase = SEQ; }
        if (blk < 12) {
            constexpr int HT = 80;
            float w0[8], w1[8], w2[8], bb[8];
#pragma unroll
            for (int it = 0; it < 8; ++it) { const int col = blk * 64 + rsub + 8 * it; w0[it] = F.in[I_HSW][(l * 3 + 0) * 768 + col]; w1[it] = F.in[I_HSW][(l * 3 + 1) * 768 + col]; w2[it] = F.in[I_HSW][(l * 3 + 2) * 768 + col]; bb[it] = F.in[I_HSB][l * 768 + col]; }
            const bf16_t* p0 = U + (size_t)(rowbase + s0 + rsub) * DIN + UHY + blk * 64 + cseg * 8;
            u32x4 zc[8];
#pragma unroll
            for (int it = 0; it < 8; ++it) zc[it] = *(const GAS u32x4*)(p0 + (size_t)(8 * it) * DIN);
            u32x4 zh = (u32x4){0u, 0u, 0u, 0u};
            if (F.lane < 16) { const int hs = F.lane < 8 ? s0 - 1 : s0 + 64; if (hs >= 0 && hs < Ls) zh = *(const GAS u32x4*)(U + (size_t)(rowbase + hs) * DIN + UHY + blk * 64 + cseg * 8); }
#pragma unroll
            for (int it = 0; it < 8; ++it) { const unsigned a[4] = {zc[it].x, zc[it].y, zc[it].z, zc[it].w}; LAS bf16_t* d = tile + (cseg * 8) * HT + 8 + rsub + 8 * it;
#pragma unroll
                for (int i = 0; i < 4; ++i) { d[(2 * i) * HT] = (bf16_t)(a[i] & 0xffffu); d[(2 * i + 1) * HT] = (bf16_t)(a[i] >> 16); } }
            if (F.lane < 16) { const unsigned a[4] = {zh.x, zh.y, zh.z, zh.w}; LAS bf16_t* d = tile + (cseg * 8) * HT + (F.lane < 8 ? 7 : 72);
#pragma unroll
                for (int i = 0; i < 4; ++i) { d[(2 * i) * HT] = (bf16_t)(a[i] & 0xffffu); d[(2 * i + 1) * HT] = (bf16_t)(a[i] >> 16); } }
            LDS_WAIT(); asm volatile("" ::: "memory");
#pragma unroll
            for (int it = 0; it < 8; ++it) {
                const int ch = rsub + 8 * it; const LAS bf16_t* r = tile + ch * HT + 8 + cseg * 8;
                const u32x4 v = *(const LAS u32x4*)r; const unsigned hm = r[-1], hp = r[8];
                float x[10]; x[0] = __builtin_bit_cast(float, hm << 16); x[9] = __builtin_bit_cast(float, hp << 16);
                x[1] = bflo(v.x); x[2] = bfhi(v.x); x[3] = bflo(v.y); x[4] = bfhi(v.y); x[5] = bflo(v.z); x[6] = bfhi(v.z); x[7] = bflo(v.w); x[8] = bfhi(v.w);
                unsigned w[4];
#pragma unroll
                for (int i = 0; i < 4; ++i) w[i] = pk2(bb[it] + w0[it] * x[2 * i] + w1[it] * x[2 * i + 1] + w2[it] * x[2 * i + 2], bb[it] + w0[it] * x[2 * i + 1] + w1[it] * x[2 * i + 2] + w2[it] * x[2 * i + 3]);
                *(GAS u32x4*)((bf16_t*)(F.ws + WS_HV) + ((size_t)(blk * 64 + ch) * NB + b) * SPB + posbase + s0 + cseg * 8) = (u32x4){w[0], w[1], w[2], w[3]};
            }
            LDS_WAIT(); asm volatile("" ::: "memory");
            continue;
        } else {
            const int c0 = (blk - 12) * 64 + cseg * 8;
#pragma unroll
            for (int it = 0; it < 8; ++it) {
                const int sl = rsub + 8 * it, s = s0 + sl;
                const u32x4 zc = *(const GAS u32x4*)(U + (size_t)(rowbase + s) * DIN + UV + c0);
                const unsigned ac[4] = {zc.x, zc.y, zc.z, zc.w};
#pragma unroll
                for (int i = 0; i < 4; ++i) { tile[(cseg * 8 + 2 * i) * 72 + sl] = (bf16_t)(ac[i] & 0xffffu); tile[(cseg * 8 + 2 * i + 1) * 72 + sl] = (bf16_t)(ac[i] >> 16); }
            }
        }
        LDS_WAIT(); asm volatile("" ::: "memory");
#pragma unroll 2
        for (int it = 0; it < 8; ++it) {
            const int ch = rsub + 8 * it;
            const u32x4 v = *(const LAS u32x4*)(tile + ch * 72 + cseg * 8);
            bf16_t* dst;
            if (blk < 12) dst = (bf16_t*)(F.ws + WS_HV) + ((size_t)(blk * 64 + ch) * NB + b) * SPB + posbase + s0 + cseg * 8;
            else dst = (bf16_t*)(F.ws + WS_VT) + ((size_t)b * 512 + (blk - 12) * 64 + ch) * SPB + posbase + s0 + cseg * 8;
            *(GAS u32x4*)dst = v;
        }
        LDS_WAIT(); asm volatile("" ::: "memory");
    }
}

constexpr int NA_RPB = 0, NA_KC = 2048, NA_VC = NA_KC + 256 * 144, NA_KR = NA_VC + 64 * 528, NA_END = NA_KR + 9 * 64 * 144;
static_assert(NA_END <= MISC_OFF, "NA LDS map");
__device__ __forceinline__ bf16x8 gld16(const bf16_t* p) { return *(const GAS bf16x8*)p; }
__device__ __forceinline__ u32x2 gld8(const bf16_t* p) { return *(const GAS u32x2*)p; }
__device__ __forceinline__ const char* uni_ptr(const char* p) { const unsigned long long v = (unsigned long long)p; const unsigned lo = __builtin_amdgcn_readfirstlane((unsigned)v), hi = __builtin_amdgcn_readfirstlane((unsigned)(v >> 32)); return (const char*)(((unsigned long long)hi << 32) | lo); }
__device__ __forceinline__ bf16x8 gld16o(const char* ub, unsigned lo) { return *(const GAS bf16x8*)(ub + (size_t)lo); }
__device__ __forceinline__ u32x2 gld8o(const char* ub, unsigned lo) { return *(const GAS u32x2*)(ub + (size_t)lo); }
template <bool WIN>
__device__ __forceinline__ void na_unit(Frame& F, int b, int h, int r, int strip) {
    const bf16_t* U = (const bf16_t*)(F.ws + WS_U);
    const bf16_t* VT = (const bf16_t*)(F.ws + WS_VT) + ((size_t)b * 512 + h * 64) * SPB;
    const LAS float* rpb = (const LAS float*)(F.lds + NA_RPB);
    const LAS bf16_t* KC = (const LAS bf16_t*)(F.lds + NA_KC); const LAS bf16_t* VC = (const LAS bf16_t*)(F.lds + NA_VC);
    int ln_ = F.lane; asm volatile("" : "+v"(ln_));
    const int i = ln_ & 15, g = ln_ >> 4;
    const int qrow0 = WIN ? (b * SEQ + r * 64 + strip * 16) : (NLAT + b * CTXL + strip * 16);
    const int ki = 8 * (i >> 2) + (i & 3);
    const unsigned qlo = (unsigned)((i * DIN + 8 * g) * 2), klo = (unsigned)((ki * DIN + 8 * g) * 2), vlo = (unsigned)((i * SPB + 8 * g) * 2);
    const char* qb = uni_ptr((const char*)(U + (size_t)qrow0 * DIN + UQ + h * 64));
    const bf16x8 q0 = gld16o(qb, qlo), q1 = gld16o(qb + 64, qlo);
    int kr0 = 0, u0 = 0;
    if (WIN) { kr0 = r - 4; kr0 = kr0 < 0 ? 0 : (kr0 > 56 ? 56 : kr0); u0 = strip == 0 ? 0 : (strip == 1 ? 8 : (strip == 2 ? 24 : 32)); }
    const LAS bf16_t* KR = (const LAS bf16_t*)(F.lds + NA_KR);
    const char* vbase = uni_ptr((const char*)(VT + kr0 * 64 + u0));
    f32x4 o[4];
#pragma unroll
    for (int d = 0; d < 4; ++d) o[d] = (f32x4){0.f, 0.f, 0.f, 0.f};
    float lsum = 0.f;
#define NA_SB() __builtin_amdgcn_sched_barrier(0)
#define NA_WLOAD(vb_, cw) do { _Pragma("unroll") for (int d = 0; d < 4; ++d) vb_[d] = gld16o(vbase + ((size_t)(d * 16) * SPB + (cw) * 64) * 2, vlo); } while (0)
#define NA_KRING(kb_, cw) do { const LAS bf16_t* kp = KR + ((((kr0 + (cw)) % 9) * 64 + u0 + ki) * 72 + 8 * g); kb_[0][0] = *(const LAS bf16x8*)kp; kb_[0][1] = *(const LAS bf16x8*)(kp + 32); \
        kb_[1][0] = *(const LAS bf16x8*)(kp + 4 * 72); kb_[1][1] = *(const LAS bf16x8*)(kp + 4 * 72 + 32); } while (0)
#define NA_QK(kb_, s_) do { _Pragma("unroll") for (int t = 0; t < 2; ++t) { f32x4 a = (f32x4){0.f, 0.f, 0.f, 0.f}; a = mfma16(kb_[t][0], q0, a); a = mfma16(kb_[t][1], q1, a); s_[t] = a; } } while (0)
#define NA_PV(s_, vb_) do { u32x4 pw; pw.x = pk2(s_[0][0], s_[0][1]); pw.y = pk2(s_[0][2], s_[0][3]); pw.z = pk2(s_[1][0], s_[1][1]); pw.w = pk2(s_[1][2], s_[1][3]); const bf16x8 pf = __builtin_bit_cast(bf16x8, pw); \
        _Pragma("unroll") for (int d = 0; d < 4; ++d) o[d] = mfma16(vb_[d], pf, o[d]); } while (0)
    bf16x8 vA[4], vB[4], vC[4];
    if (WIN) { NA_WLOAD(vA, 0); NA_WLOAD(vB, 1); NA_WLOAD(vC, 2); NA_SB(); }
#pragma unroll
    for (int cc = 0; cc < 8; ++cc) {
        bf16x8 kc[2][2], vc[4]; f32x4 sc[2];
#pragma unroll
        for (int t = 0; t < 2; ++t) { const LAS bf16_t* kp = KC + (cc * 32 + ki + 4 * t) * 72 + 8 * g; kc[t][0] = *(const LAS bf16x8*)kp; kc[t][1] = *(const LAS bf16x8*)(kp + 32); }
#pragma unroll
        for (int d = 0; d < 4; ++d) vc[d] = *(const LAS bf16x8*)(VC + (d * 16 + i) * 264 + cc * 32 + 8 * g);
        NA_QK(kc, sc);
#pragma unroll
        for (int t = 0; t < 2; ++t)
#pragma unroll
            for (int e = 0; e < 4; ++e) { const float p = __builtin_amdgcn_exp2f(fminf(sc[t][e], NA_CLAMP)); sc[t][e] = p; lsum += p; }
        NA_PV(sc, vc);
    }
    if (WIN) {
        const int c = strip * 16 + i; int kc0 = c - 8; kc0 = kc0 < 0 ? 0 : (kc0 > 48 ? 48 : kc0);
        int dcl[2][4]; bool okm[2][4];
#pragma unroll
        for (int t = 0; t < 2; ++t)
#pragma unroll
            for (int e = 0; e < 4; ++e) { const int kc = u0 + 8 * g + 4 * t + e; okm[t][e] = (kc >= kc0) && (kc < kc0 + 16); int dc = kc - c + 15; dcl[t][e] = okm[t][e] ? (dc < 0 ? 0 : (dc > 30 ? 30 : dc)) : 31; }
#define NA_WCHUNK(vb_, cw) do { bf16x8 kw[2][2]; NA_KRING(kw, cw); f32x4 sw[2]; NA_QK(kw, sw); const LAS float* rp = rpb + (kr0 + (cw) - r + 7) * 32; \
        _Pragma("unroll") for (int t = 0; t < 2; ++t) _Pragma("unroll") for (int e = 0; e < 4; ++e) { const float x = sw[t][e] + rp[dcl[t][e]]; const float p = __builtin_amdgcn_exp2f(fminf(x, NA_CLAMP)); sw[t][e] = p; lsum += p; } \
        NA_PV(sw, vb_); } while (0)
        NA_WCHUNK(vA, 0); NA_SB(); NA_WLOAD(vA, 3); NA_SB();
        NA_WCHUNK(vB, 1); NA_SB(); NA_WLOAD(vB, 4); NA_SB();
        NA_WCHUNK(vC, 2); NA_SB(); NA_WLOAD(vC, 5); NA_SB();
        NA_WCHUNK(vA, 3); NA_SB(); NA_WLOAD(vA, 6); NA_SB();
        NA_WCHUNK(vB, 4); NA_SB(); NA_WLOAD(vB, 7); NA_SB();
        NA_WCHUNK(vC, 5); NA_SB();
        NA_WCHUNK(vA, 6); NA_SB();
        NA_WCHUNK(vB, 7); NA_SB();
#undef NA_WCHUNK
    }
    lsum += shx(lsum, 16, ln_); lsum += shx(lsum, 32, ln_);
    const float inv = 1.0f / lsum;
    char* op = (char*)uni_ptr((const char*)((bf16_t*)(F.ws + WS_MIX) + (size_t)qrow0 * DM + h * 64)); const unsigned olo = (unsigned)((i * DM + 4 * g) * 2);
#pragma unroll
    for (int d = 0; d < 4; ++d) { u32x2 w; w.x = pk2(o[d][0] * inv, o[d][1] * inv); w.y = pk2(o[d][2] * inv, o[d][3] * inv); *(GAS u32x2*)(op + d * 32 + (size_t)olo) = w; }
#undef NA_SB
#undef NA_WLOAD
#undef NA_KRING
#undef NA_QK
#undef NA_PV
}
__device__ __forceinline__ int na_kr0(int r) { const int k = r - 4; return k < 0 ? 0 : (k > 56 ? 56 : k); }
__device__ __forceinline__ void ph_na(Frame& F, int l, bool last) {
    const bf16_t* U = (const bf16_t*)(F.ws + WS_U);
    for (int job = F.wg; job < NB * 8 * 2; job += F.G) {
        const int half = job & 1, h = (job >> 1) & 7, b = job >> 4;
        int tz_; asm volatile("v_mbcnt_lo_u32_b32 %0, -1, 0\n\tv_mbcnt_hi_u32_b32 %0, -1, %0" : "=v"(tz_)); tz_ |= F.wave << 6;
        const bf16_t* krow = U + (size_t)(b * SEQ + (tz_ >> 3)) * DIN + UK + h * 64 + (tz_ & 7) * 8;
        LAS bf16_t* kdst = (LAS bf16_t*)(F.lds + NA_KR) + (tz_ >> 3) * 72 + (tz_ & 7) * 8;
        __syncthreads();
        { LAS float* rpb = (LAS float*)(F.lds + NA_RPB); const float* rsrc = F.in[I_RPB] + ((size_t)l * 8 + h) * 15 * 31;
          if (tz_ < 15 * 32) rpb[tz_] = (tz_ & 31) < 31 ? rsrc[(tz_ >> 5) * 31 + (tz_ & 31)] * 1.4426950408889634f : -1e30f;
          const int key = tz_ >> 1, hf = tz_ & 1; const bf16_t* src = U + (size_t)(NLAT + b * CTXL + key) * DIN + UK + h * 64 + hf * 32; LAS bf16_t* dst = (LAS bf16_t*)(F.lds + NA_KC) + key * 72 + hf * 32;
#pragma unroll
          for (int j = 0; j < 4; ++j) *(LAS bf16x8*)(dst + j * 8) = gld16(src + j * 8);
          const int dv = tz_ >> 3, seg = tz_ & 7; const bf16_t* vs = (const bf16_t*)(F.ws + WS_VT) + ((size_t)b * 512 + h * 64 + dv) * SPB + SEQ + seg * 32; LAS bf16_t* vd = (LAS bf16_t*)(F.lds + NA_VC) + dv * 264 + seg * 32;
#pragma unroll
          for (int j = 0; j < 4; ++j) *(LAS bf16x8*)(vd + j * 8) = gld16(vs + j * 8);
          const int lo = na_kr0(half * 32), hi0 = na_kr0(half * 32 + 1) + 7;
          for (int kr = lo; kr <= hi0; ++kr) *(LAS bf16x8*)(kdst + (kr % 9) * 64 * 72) = gld16(krow + (size_t)kr * 64 * DIN); }
        __syncthreads();
        int prev_hi = na_kr0(half * 32 + 1) + 7;
#pragma unroll 1
        for (int s = 0; s < 16; ++s) {
            const int r0 = half * 32 + 2 * s;
            const int nhi = s < 15 ? na_kr0(r0 + 3) + 7 : prev_hi;
            bf16x8 n0 = (bf16x8){0, 0, 0, 0, 0, 0, 0, 0}, n1 = n0;
            if (nhi > prev_hi) n0 = gld16(krow + (size_t)(prev_hi + 1) * 64 * DIN);
            if (nhi > prev_hi + 1) n1 = gld16(krow + (size_t)(prev_hi + 2) * 64 * DIN);
            na_unit<true>(F, b, h, r0 + (F.wave >> 2), F.wave & 3);
            __syncthreads();
            if (nhi > prev_hi) *(LAS bf16x8*)(kdst + ((prev_hi + 1) % 9) * 64 * 72) = n0;
            if (nhi > prev_hi + 1) *(LAS bf16x8*)(kdst + ((prev_hi + 2) % 9) * 64 * 72) = n1;
            __syncthreads();
            prev_hi = nhi;
        }
        if (!last) na_unit<false>(F, b, h, 0, half * 8 + F.wave);
    }
}

__device__ __forceinline__ void ph_hy_transpose(Frame& F, bool last) {
    LAS bf16_t* tile = (LAS bf16_t*)(F.lds + F.wave * 16384);
    const bf16_t* HYO = (const bf16_t*)(F.ws + WS_Y);
    const int gw = F.wg * NWAVES + F.wave, NGW = F.G * NWAVES;
    const int rsub = F.lane >> 3, cseg = F.lane & 7;
    const int ntt = last ? 1024 : 1088;
    for (int u = gw; u < ntt * 4; u += NGW) {
        const int tt = u >> 2, cb = u & 3;
        int b, s0, rowbase, posbase;
        if (tt < 1024) { b = tt >> 6; s0 = (tt & 63) * 64; rowbase = b * SEQ; posbase = 0; }
        else { const int t2 = tt - 1024; b = t2 >> 2; s0 = (t2 & 3) * 64; rowbase = NLAT + b * CTXL; posbase = SEQ; }
#pragma unroll 2
        for (int it = 0; it < 8; ++it) { const int c = rsub + 8 * it;
            const u32x4 v = *(const GAS u32x4*)(HYO + ((size_t)(cb * 64 + c) * NB + b) * SPB + posbase + s0 + cseg * 8); const unsigned a[4] = {v.x, v.y, v.z, v.w};
#pragma unroll
            for (int e = 0; e < 4; ++e) { tile[(cseg * 8 + 2 * e) * 72 + c] = (bf16_t)(a[e] & 0xffffu); tile[(cseg * 8 + 2 * e + 1) * 72 + c] = (bf16_t)(a[e] >> 16); } }
        LDS_WAIT(); asm volatile("" ::: "memory");
#pragma unroll 2
        for (int it = 0; it < 8; ++it) { const int p = rsub + 8 * it;
            const u32x4 v = *(const LAS u32x4*)(tile + p * 72 + cseg * 8);
            *(GAS u32x4*)((bf16_t*)(F.ws + WS_MIX) + (size_t)(rowbase + s0 + p) * DM + 768 + cb * 64 + cseg * 8) = v; }
        LDS_WAIT(); asm volatile("" ::: "memory");
    }
}

constexpr int G2_LAF = 0, G2_LAB = 8448;
constexpr int G2_QTF = 16896, G2_KTF = 22016, G2_QTB = 27136, G2_KTB = 32256;
constexpr int G2_VT = 37376, G2_ATT = 46592;
constexpr int G2_SF = 55808, G2_SB = 60928;
constexpr int G2_SEG = 66048, G2_HALF = 67328;
__device__ __forceinline__ float log_sigmoid_f(float x) { return fminf(x, 0.f) - __logf(1.0f + __expf(-fabsf(x))); }
__device__ __forceinline__ f32x4 mma_lds(const LAS bf16_t* A, int lda, const LAS bf16_t* B, int ldb, int ksteps, f32x4 acc, int lane) {
    const int r = lane & 15, g = lane >> 4;
    for (int ks = 0; ks < ksteps; ++ks) { const bf16x8 a = *(const LAS bf16x8*)(A + r * lda + ks * 32 + 8 * g), b = *(const LAS bf16x8*)(B + r * ldb + ks * 32 + 8 * g); acc = mfma16(a, b, acc); }
    return acc;
}
__device__ __forceinline__ int gla_row0(int b, int cn) { return cn >= 4 ? b * SEQ + (cn - 4) * 64 : NLAT + b * CTXL + cn * 64; }
struct GlaRaw { u32x4 q, k, f, b, v0, v1, g0, g1, s0, s1; };
template <bool FULL>
__device__ __forceinline__ GlaRaw gla_load(Frame& F, int u, int tl) {
    const int h = u & 3, cn = (u >> 2) % 68, b = (u >> 2) / 68, i = tl >> 2, part = tl & 3;
    const bf16_t* p = (const bf16_t*)(F.ws + WS_U) + (size_t)(gla_row0(b, cn) + i) * DIN;
    GlaRaw r;
    r.q = *(const GAS u32x4*)(p + UGQ + h * 32 + part * 8); r.k = *(const GAS u32x4*)(p + UGK + h * 32 + part * 8);
    r.f = *(const GAS u32x4*)(p + ULAF + h * 32 + part * 8); r.b = *(const GAS u32x4*)(p + ULAB + h * 32 + part * 8);
    r.v0 = *(const GAS u32x4*)(p + UGV + h * 64 + part * 16); r.v1 = *(const GAS u32x4*)(p + UGV + h * 64 + part * 16 + 8);
    if (FULL) { r.g0 = *(const GAS u32x4*)(p + UGR + h * 64 + part * 16); r.g1 = *(const GAS u32x4*)(p + UGR + h * 64 + part * 16 + 8);
        const bf16_t* sp = (const bf16_t*)(F.ws + WS_GSIN) + (size_t)u * 2 * 2048 + tl * 16; r.s0 = *(const GAS u32x4*)sp; r.s1 = *(const GAS u32x4*)(sp + 8); }
    else { r.g0 = (u32x4){0u, 0u, 0u, 0u}; r.g1 = r.g0; r.s0 = r.g0; r.s1 = r.g0; }
    return r;
}
__device__ __forceinline__ GlaRaw gla_load_out(Frame& F, int u, int tl) {
    const int h = u & 3, cn = (u >> 2) % 68, b = (u >> 2) / 68, i = tl >> 2, part = tl & 3;
    const bf16_t* p = (const bf16_t*)(F.ws + WS_U) + (size_t)(gla_row0(b, cn) + i) * DIN;
    const bf16_t* gq = (const bf16_t*)(F.ws + WS_XM8) + (size_t)u * 8192 + i * 32 + part * 8;
    GlaRaw r;
    r.q = *(const GAS u32x4*)gq; r.k = *(const GAS u32x4*)(gq + 2048); r.f = *(const GAS u32x4*)(gq + 4096); r.b = *(const GAS u32x4*)(gq + 6144);
    r.v0 = *(const GAS u32x4*)(p + UGV + h * 64 + part * 16); r.v1 = *(const GAS u32x4*)(p + UGV + h * 64 + part * 16 + 8);
    r.g0 = *(const GAS u32x4*)(p + UGR + h * 64 + part * 16); r.g1 = *(const GAS u32x4*)(p + UGR + h * 64 + part * 16 + 8);
    const bf16_t* sp = (const bf16_t*)(F.ws + WS_GSIN) + (size_t)u * 2 * 2048 + tl * 16; r.s0 = *(const GAS u32x4*)sp; r.s1 = *(const GAS u32x4*)(sp + 8);
    return r;
}
template <bool FULL>
__device__ __forceinline__ void gla_prep(Frame& F, LAS unsigned char* L, int l, int u, int tl, const GlaRaw& raw) {
    const int h = u & 3, cn = (u >> 2) % 68, i = tl >> 2, part = tl & 3, d8 = part * 8;
    LAS float* LAF = (LAS float*)(L + G2_LAF); LAS float* LAB = (LAS float*)(L + G2_LAB); LAS bf16_t* VT = (LAS bf16_t*)(L + G2_VT); LAS float* SEG = (LAS float*)(L + G2_SEG);
    float q[8], k[8], tf[8], tb[8];
    unpack8(raw.q, q); unpack8(raw.k, k); unpack8(raw.f, tf); unpack8(raw.b, tb);
    const float* ba = F.in[I_BA2] + (size_t)l * 256 + h * 32 + d8;
#pragma unroll
    for (int e = 0; e < 8; ++e) { q[e] *= 0.17677669529663687f; LAF[i * 33 + d8 + e] = log_sigmoid_f(tf[e] + ba[e]) * 0.0625f; LAB[i * 33 + d8 + e] = log_sigmoid_f(tb[e] + ba[128 + e]) * 0.0625f; }
    if (cn >= 4) {
        const float pos = (part >> 1) ? (float)i : (float)(cn - 4);
#pragma unroll
        for (int e = 0; e < 8; ++e) { const float ang = pos * __expf(-(float)e * (9.210340371976184f / 8.0f)); const float sn = __sinf(ang), cs = __cosf(ang);
            const float qo = shx(q[e], 1, F.lane), ko = shx(k[e], 1, F.lane);
            if (part & 1) { q[e] = qo * sn + q[e] * cs; k[e] = ko * sn + k[e] * cs; } else { q[e] = q[e] * cs - qo * sn; k[e] = k[e] * cs - ko * sn; } }
    }
    { const unsigned a[8] = {raw.v0.x, raw.v0.y, raw.v0.z, raw.v0.w, raw.v1.x, raw.v1.y, raw.v1.z, raw.v1.w};
#pragma unroll
      for (int e = 0; e < 8; ++e) { VT[(part * 16 + 2 * e) * 72 + i] = (bf16_t)(a[e] & 0xffffu); VT[(part * 16 + 2 * e + 1) * 72 + i] = (bf16_t)(a[e] >> 16); } }
    __syncthreads();
    { const int x = tl & 63, d = x & 31, dir = x >> 5, seg = tl >> 6; LAS float* LA = (dir ? LAB : LAF) + d; float cv[16];
#pragma unroll
      for (int kk = 0; kk < 16; ++kk) { const int p = seg * 16 + kk, ti = dir ? 63 - p : p; cv[kk] = LA[ti * 33]; }
#pragma unroll
      for (int kk = 1; kk < 16; ++kk) cv[kk] += cv[kk - 1];
#pragma unroll
      for (int kk = 0; kk < 16; ++kk) { const int p = seg * 16 + kk, ti = dir ? 63 - p : p; LA[ti * 33] = cv[kk]; }
      SEG[x * 5 + seg] = cv[15]; }
    __syncthreads();
    { const int x = tl & 63, d = x & 31, dir = x >> 5, seg = tl >> 6; LAS float* LA = (dir ? LAB : LAF) + d; float cv[16];
      const float t0 = SEG[x * 5 + 0], t1 = SEG[x * 5 + 1], t2 = SEG[x * 5 + 2];
      const float pre = seg == 0 ? 0.f : (seg == 1 ? t0 : (seg == 2 ? t0 + t1 : t0 + t1 + t2));
#pragma unroll
      for (int kk = 0; kk < 16; ++kk) { const int p = seg * 16 + kk, ti = dir ? 63 - p : p; cv[kk] = LA[ti * 33]; }
#pragma unroll
      for (int kk = 0; kk < 16; ++kk) { const int p = seg * 16 + kk, ti = dir ? 63 - p : p; LA[ti * 33] = cv[kk] + pre; } }
    __syncthreads();
    if (FULL) {
        unsigned wqf[4], wkf[4], wqb[4], wkb[4];
#pragma unroll
        for (int e = 0; e < 4; ++e) { const int d = d8 + 2 * e; const float f0 = LAF[i * 33 + d], f1 = LAF[i * 33 + d + 1], b0 = LAB[i * 33 + d], b1 = LAB[i * 33 + d + 1];
            wqf[e] = pk2(q[2 * e] * __expf(f0), q[2 * e + 1] * __expf(f1)); wkf[e] = pk2(k[2 * e] * __expf(-f0), k[2 * e + 1] * __expf(-f1));
            wqb[e] = pk2(q[2 * e] * __expf(b0), q[2 * e + 1] * __expf(b1)); wkb[e] = pk2(k[2 * e] * __expf(-b0), k[2 * e + 1] * __expf(-b1)); }
        *(LAS u32x4*)((LAS bf16_t*)(L + G2_QTF) + i * 40 + d8) = (u32x4){wqf[0], wqf[1], wqf[2], wqf[3]}; *(LAS u32x4*)((LAS bf16_t*)(L + G2_KTF) + i * 40 + d8) = (u32x4){wkf[0], wkf[1], wkf[2], wkf[3]};
        *(LAS u32x4*)((LAS bf16_t*)(L + G2_QTB) + i * 40 + d8) = (u32x4){wqb[0], wqb[1], wqb[2], wqb[3]}; *(LAS u32x4*)((LAS bf16_t*)(L + G2_KTB) + i * 40 + d8) = (u32x4){wkb[0], wkb[1], wkb[2], wkb[3]};
    } else {
        LAS bf16_t* KDF = (LAS bf16_t*)(L + G2_QTF); LAS bf16_t* KDB = (LAS bf16_t*)(L + G2_KTF);
#pragma unroll
        for (int e = 0; e < 8; ++e) { const int d = d8 + e; const float bf = LAF[i * 33 + d], bb = LAB[i * 33 + d], bfl = LAF[63 * 33 + d], bbl = LAB[0 * 33 + d];
            KDF[d * 72 + i] = (bf16_t)f2bf(k[e] * __expf(bfl - bf)); KDB[d * 72 + i] = (bf16_t)f2bf(k[e] * __expf(bbl - bb)); }
        unsigned wqf[4], wkf[4], wqb[4], wkb[4];
#pragma unroll
        for (int e = 0; e < 4; ++e) { const int d = d8 + 2 * e; const float f0 = LAF[i * 33 + d], f1 = LAF[i * 33 + d + 1], b0 = LAB[i * 33 + d], b1 = LAB[i * 33 + d + 1];
            wqf[e] = pk2(q[2 * e] * __expf(f0), q[2 * e + 1] * __expf(f1)); wkf[e] = pk2(k[2 * e] * __expf(-f0), k[2 * e + 1] * __expf(-f1));
            wqb[e] = pk2(q[2 * e] * __expf(b0), q[2 * e + 1] * __expf(b1)); wkb[e] = pk2(k[2 * e] * __expf(-b0), k[2 * e + 1] * __expf(-b1)); }
        bf16_t* gq = (bf16_t*)(F.ws + WS_XM8) + (size_t)u * 8192 + i * 32 + d8;
        *(GAS u32x4*)gq = (u32x4){wqf[0], wqf[1], wqf[2], wqf[3]}; *(GAS u32x4*)(gq + 2048) = (u32x4){wkf[0], wkf[1], wkf[2], wkf[3]};
        *(GAS u32x4*)(gq + 4096) = (u32x4){wqb[0], wqb[1], wqb[2], wqb[3]}; *(GAS u32x4*)(gq + 6144) = (u32x4){wkb[0], wkb[1], wkb[2], wkb[3]};
    }
    __syncthreads();
}
__device__ __forceinline__ void ph_gla_local(Frame& F, int l) {
    const int hw = F.wave >> 2, wl = F.wave & 3, tl = F.tid & 255; LAS unsigned char* L = F.lds + hw * G2_HALF;
    constexpr int NU = NB * 68 * 4;
    int pp = F.wg;
    GlaRaw raw = gla_load<false>(F, (pp * 2 + hw) < NU ? pp * 2 + hw : 0, tl);
    for (; pp * 2 < NU; pp += F.G) {
        const int u = pp * 2 + hw, un = (pp + F.G) * 2 + hw;
        const GlaRaw nraw = gla_load<false>(F, un < NU ? un : u, tl);
        __syncthreads();
        gla_prep<false>(F, L, l, u, tl, raw);
        const int g = F.lane >> 4, c = F.lane & 15;
        float* DS = (float*)(F.ws + WS_GDS) + (size_t)u * 2 * 2048;
#pragma unroll
        for (int kk = 0; kk < 4; ++kk) { const int tix = wl * 4 + kk, dir = tix >> 3, mt = (tix >> 1) & 3, nt = tix & 1;
            f32x4 a = (f32x4){0.f, 0.f, 0.f, 0.f};
            a = mma_lds((const LAS bf16_t*)(L + G2_VT) + mt * 16 * 72, 72, (const LAS bf16_t*)(L + (dir ? G2_KTF : G2_QTF)) + nt * 16 * 72, 72, 2, a, F.lane);
#pragma unroll
            for (int e = 0; e < 4; ++e) DS[dir * 2048 + (mt * 16 + 4 * g + e) * 32 + nt * 16 + c] = a[e]; }
        if (tl < 64) { const int d = tl & 31, dir = tl >> 5; ((float*)(F.ws + WS_GD))[(size_t)u * 64 + tl] = __expf(dir ? ((LAS float*)(L + G2_LAB))[0 * 33 + d] : ((LAS float*)(L + G2_LAF))[63 * 33 + d]); }
        raw = nraw;
    }
}
__device__ __forceinline__ void ph_gla_scan(Frame& F) {
    const int gt = F.wg * NTHR + F.tid, NGT = F.G * NTHR;
    const float* DS = (const float*)(F.ws + WS_GDS); const float* GD = (const float*)(F.ws + WS_GD); bf16_t* SIN = (bf16_t*)(F.ws + WS_GSIN);
    for (int w = gt; w < 128 * 1024; w += NGT) {
        const int chain = w >> 10, el = (w & 1023) * 2, dir = chain & 1, h = (chain >> 1) & 3, b = chain >> 3, d = el & 31;
        float s0 = 0.f, s1 = 0.f;
        for (int step = 0; step < 68; step += 4) {
            f32x2 ds[4], dd[4]; size_t uu[4];
#pragma unroll
            for (int q = 0; q < 4; ++q) { const int st_ = step + q; const int cn = dir ? (st_ < 4 ? 3 - st_ : 71 - st_) : st_;
                uu[q] = (size_t)(b * 68 + cn) * 4 + h;
                ds[q] = *(const GAS f32x2*)(DS + (uu[q] * 2 + dir) * 2048 + el); dd[q] = *(const GAS f32x2*)(GD + uu[q] * 64 + dir * 32 + d); }
#pragma unroll
            for (int q = 0; q < 4; ++q) { *(GAS unsigned*)(SIN + (uu[q] * 2 + dir) * 2048 + el) = pk2(s0, s1); s0 = dd[q].x * s0 + ds[q].x; s1 = dd[q].y * s1 + ds[q].y; }
        }
    }
}
__device__ __forceinline__ void ph_gla_out(Frame& F, int l, bool last) {
    const int hw = F.wave >> 2, wl = F.wave & 3, tl = F.tid & 255; LAS unsigned char* L = F.lds + hw * G2_HALF;
    const int NV = last ? NB * 64 * 4 : NB * 68 * 4;
#define GLA_UNIT(v) (last ? ((((v) >> 8) * 68 + 4 + (((v) & 255) >> 2)) * 4 + ((v) & 3)) : (v))
    int pp = F.wg;
    GlaRaw raw = gla_load_out(F, GLA_UNIT((pp * 2 + hw) < NV ? pp * 2 + hw : 0), tl);
    __syncthreads();
    for (; pp * 2 < NV; pp += F.G) {
        const int u = GLA_UNIT(pp * 2 + hw), vn = (pp + F.G) * 2 + hw;
        const GlaRaw nraw = gla_load_out(F, vn < NV ? GLA_UNIT(vn) : u, tl);
        const int h = u & 3, cn = (u >> 2) % 68, b = (u >> 2) / 68;
        { const int i = tl >> 2, part = tl & 3, d8 = part * 8; LAS bf16_t* VT = (LAS bf16_t*)(L + G2_VT);
          *(LAS u32x4*)((LAS bf16_t*)(L + G2_QTF) + i * 40 + d8) = raw.q; *(LAS u32x4*)((LAS bf16_t*)(L + G2_KTF) + i * 40 + d8) = raw.k;
          *(LAS u32x4*)((LAS bf16_t*)(L + G2_QTB) + i * 40 + d8) = raw.f; *(LAS u32x4*)((LAS bf16_t*)(L + G2_KTB) + i * 40 + d8) = raw.b;
          const unsigned a[8] = {raw.v0.x, raw.v0.y, raw.v0.z, raw.v0.w, raw.v1.x, raw.v1.y, raw.v1.z, raw.v1.w};
#pragma unroll
          for (int e = 0; e < 8; ++e) { VT[(part * 16 + 2 * e) * 72 + i] = (bf16_t)(a[e] & 0xffffu); VT[(part * 16 + 2 * e + 1) * 72 + i] = (bf16_t)(a[e] >> 16); } }
        { const int dir = tl >> 7, dv = (tl >> 1) & 63, d16 = (tl & 1) * 16; LAS bf16_t* S = (LAS bf16_t*)(L + (dir ? G2_SB : G2_SF)) + dv * 40 + d16; *(LAS u32x4*)S = raw.s0; *(LAS u32x4*)(S + 8) = raw.s1; }
        __syncthreads();
        const int g = F.lane >> 4, c = F.lane & 15;
        LAS bf16_t* ATT = (LAS bf16_t*)(L + G2_ATT);
#pragma unroll
        for (int kk = 0; kk < 4; ++kk) { const int tile = wl * 4 + kk, mt = tile >> 2, nt = tile & 3;
            f32x4 af = (f32x4){0.f, 0.f, 0.f, 0.f}, ab = af;
            af = mma_lds((const LAS bf16_t*)(L + G2_QTF) + mt * 16 * 40, 40, (const LAS bf16_t*)(L + G2_KTF) + nt * 16 * 40, 40, 1, af, F.lane);
            ab = mma_lds((const LAS bf16_t*)(L + G2_QTB) + mt * 16 * 40, 40, (const LAS bf16_t*)(L + G2_KTB) + nt * 16 * 40, 40, 1, ab, F.lane);
#pragma unroll
            for (int e = 0; e < 4; ++e) { const int ii = mt * 16 + 4 * g + e, j = nt * 16 + c; const float vv = (j <= ii ? af[e] : 0.f) + (j >= ii ? ab[e] : 0.f); ATT[ii * 72 + j] = (bf16_t)f2bf(vv); } }
        __syncthreads();
        LAS float* O = (LAS float*)(L + G2_LAF);
#pragma unroll
        for (int kk = 0; kk < 4; ++kk) { const int tile = wl * 4 + kk, mt = tile >> 2, nt = tile & 3;
            f32x4 a = (f32x4){0.f, 0.f, 0.f, 0.f};
            a = mma_lds(ATT + mt * 16 * 72, 72, (const LAS bf16_t*)(L + G2_VT) + nt * 16 * 72, 72, 2, a, F.lane);
            a = mma_lds((const LAS bf16_t*)(L + G2_QTF) + mt * 16 * 40, 40, (const LAS bf16_t*)(L + G2_SF) + nt * 16 * 40, 40, 1, a, F.lane);
            a = mma_lds((const LAS bf16_t*)(L + G2_QTB) + mt * 16 * 40, 40, (const LAS bf16_t*)(L + G2_SB) + nt * 16 * 40, 40, 1, a, F.lane);
#pragma unroll
            for (int e = 0; e < 4; ++e) O[(mt * 16 + 4 * g + e) * 65 + nt * 16 + c] = a[e]; }
        __syncthreads();
        { const int i = tl >> 2, dv16 = (tl & 3) * 16; const int row = gla_row0(b, cn) + i;
          float v[16], gt[16]; float ss = 0.f;
#pragma unroll
          for (int e = 0; e < 16; ++e) { v[e] = O[i * 65 + dv16 + e]; ss += v[e] * v[e]; }
          ss += shx(ss, 1, F.lane); ss += shx(ss, 2, F.lane);
          const float rs = 1.0f / sqrtf(ss * (1.0f / 64.0f) + LN_EPS);
          unpack8(raw.g0, gt); unpack8(raw.g1, gt + 8);
          const float* gn = F.in[I_GNORM] + l * 64 + dv16;
          unsigned w[8];
#pragma unroll
          for (int e = 0; e < 8; ++e) w[e] = pk2(v[2 * e] * rs * gn[2 * e] * silu_f(gt[2 * e]), v[2 * e + 1] * rs * gn[2 * e + 1] * silu_f(gt[2 * e + 1]));
          bf16_t* mp = (bf16_t*)(F.ws + WS_MIX) + (size_t)row * DM + 512 + h * 64 + dv16;
          *(GAS u32x4*)mp = (u32x4){w[0], w[1], w[2], w[3]}; *(GAS u32x4*)(mp + 8) = (u32x4){w[4], w[5], w[6], w[7]}; }
        raw = nraw;
    }
#undef GLA_UNIT
}

template <int L>
__device__ __forceinline__ void hyena_conv(Frame& F, const bf16_t* Rg, const bf16_t* Uin, const bf16_t* Xmul, int pos0, bool final_out, int ch, bf16_t* Zout) {
    constexpr int CS = 2 * L + 16;
    constexpr int NTL = L / 16, J = (NTL >= 64) ? 16 : 2, NGRP = NTL / J, HJ = J / 2, NSTEP = L / 32;
    LAS bf16_t* Rl = (LAS bf16_t*)F.lds;
    __syncthreads();
    for (int c = F.tid; c < 2 * L / 8; c += NTHR) { const u32x4 v = *(const GAS u32x4*)(Rg + 8 * c); const unsigned a[4] = {v.x, v.y, v.z, v.w};
#pragma unroll
        for (int rho = 0; rho < 8; ++rho) { LAS bf16_t* d = Rl + rho * CS + 8 * c + rho;
#pragma unroll
            for (int k = 0; k < 4; ++k) { d[2 * k] = (bf16_t)(a[k] & 0xffffu); d[2 * k + 1] = (bf16_t)(a[k] >> 16); } } }
    __syncthreads();
    int ln_ = F.lane; asm volatile("" : "+v"(ln_));
    const int i = ln_ & 15, g = ln_ >> 4, rho = i & 7;
    const LAS bf16_t* Rc = Rl + rho * CS + rho;
    for (int grp = F.wave; grp < NGRP; grp += NWAVES) {
        f32x4 acc[J]; bf16x8 fr[J];
        const int tb = grp * J * 16;
        const LAS bf16_t* Rb = Rc + (L - tb - i + 8 * g);
#pragma unroll
        for (int j = 0; j < J; ++j) { acc[j] = (f32x4){0.f, 0.f, 0.f, 0.f}; fr[j] = *(const LAS bf16x8*)(Rb - 16 * j); }
        const char* ub = (const char*)(Uin + pos0); const unsigned ulo = (unsigned)((i * SPB + 8 * g) * 2);
        constexpr int PF = (HJ >= 4) ? 4 : 1;
        bf16x8 bq[PF];
#pragma unroll
        for (int p = 0; p < PF; ++p) bq[p] = *(const GAS bf16x8*)(ub + (size_t)(ulo + (unsigned)p * 64u));
        u32x2 xw[J];
#pragma unroll
        for (int j = 0; j < J; ++j) xw[j] = *(const GAS u32x2*)(Xmul + (size_t)i * SPB + pos0 + tb + j * 16 + 4 * g);
#pragma unroll 1
        for (int q = 0; q < NSTEP / HJ; ++q) {
#pragma unroll
            for (int m = 0; m < HJ; ++m) {
                const int n = q * HJ + m;
                const int nn = (n + PF < NSTEP) ? n + PF : 0;
                if (n > 0) { fr[(J - 2 * m) % J] = *(const LAS bf16x8*)(Rb + 32 * n); fr[(J + 1 - 2 * m) % J] = *(const LAS bf16x8*)(Rb + 32 * n - 16); }
                const bf16x8 bcur = bq[m % PF];
#pragma unroll
                for (int jj = 0; jj < J; ++jj) { const int j = (jj + 2) % J; acc[j] = mfma16(fr[(j + J - 2 * m) % J], bcur, acc[j]); }
                bq[m % PF] = *(const GAS bf16x8*)(ub + (size_t)(ulo + (unsigned)nn * 64u));
            }
        }
#pragma unroll
        for (int j = 0; j < J; ++j) { const int t0 = tb + j * 16 + 4 * g;
            const float y0 = acc[j][0] * bflo(xw[j].x), y1 = acc[j][1] * bfhi(xw[j].x), y2 = acc[j][2] * bflo(xw[j].y), y3 = acc[j][3] * bfhi(xw[j].y);
            if (!final_out) { u32x2 w; w.x = pk2(y0, y1); w.y = pk2(y2, y3); *(GAS u32x2*)(Zout + (size_t)i * SPB + pos0 + t0) = w; }
            else { u32x2 w; w.x = pk2(y0, y1); w.y = pk2(y2, y3); *(GAS u32x2*)((bf16_t*)(F.ws + WS_Y) + ((size_t)ch * NB + i) * SPB + pos0 + t0) = w; } }
    }
}
__device__ __forceinline__ void ph_hyena(Frame& F, int l, bool last) {
    const bf16_t* HV = (const bf16_t*)(F.ws + WS_HV); bf16_t* Z2 = (bf16_t*)(F.ws + WS_Z2);
    for (int ch = F.wg; ch < 256; ch += F.G) {
        const bf16_t* v = HV + (size_t)(0 * 256 + ch) * NB * SPB; const bf16_t* x1 = HV + (size_t)(256 + ch) * NB * SPB; const bf16_t* x2 = HV + (size_t)(512 + ch) * NB * SPB;
        bf16_t* z = Z2 + (size_t)ch * NB * SPB;
        const bf16_t* R0 = (const bf16_t*)(F.ws + WS_HYF) + ((size_t)(l * 2 + 0) * 256 + ch) * 8192; const bf16_t* R1 = (const bf16_t*)(F.ws + WS_HYF) + ((size_t)(l * 2 + 1) * 256 + ch) * 8192;
        hyena_conv<4096>(F, R0, v, x1, 0, false, ch, z);
        VM_WAIT(); __syncthreads(); __builtin_amdgcn_fence(__ATOMIC_ACQUIRE, "agent"); VM_WAIT();
        hyena_conv<4096>(F, R1, z, x2, 0, true, ch, z);
        if (!last) {
            const bf16_t* C0 = (const bf16_t*)(F.ws + WS_HYFC) + ((size_t)(l * 2 + 0) * 256 + ch) * 512; const bf16_t* C1 = (const bf16_t*)(F.ws + WS_HYFC) + ((size_t)(l * 2 + 1) * 256 + ch) * 512;
            hyena_conv<256>(F, C0, v, x1, SEQ, false, ch, z);
            VM_WAIT(); __syncthreads(); __builtin_amdgcn_fence(__ATOMIC_ACQUIRE, "agent"); VM_WAIT();
            hyena_conv<256>(F, C1, z, x2, SEQ, true, ch, z);
        }
    }
}

__device__ __forceinline__ void ph_ln1(Frame& F, int l, int ntok) {
    const int gw = F.wg * NWAVES + F.wave, NGW = F.G * NWAVES;
    const int cA = 256 * (F.lane >> 4) + 32 * ((F.lane >> 2) & 3) + 8 * (F.lane & 3);
#define LN1_COL(j) (cA + ((j) < 2 ? 4 * (j) : 128 + 4 * ((j) - 2)))
    const float* lg = F.in[I_LN1G] + l * DM; const float* lb = F.in[I_LN1B] + l * DM;
    for (int row = gw; row < ntok; row += NGW) {
        bf16_t* xr = (bf16_t*)(F.ws + WS_XR) + (size_t)row * DM;
        const unsigned char* yr = (const unsigned char*)(F.ws + WS_Y) + (size_t)row * DM + 16 * F.lane;
        const float* md = mod_ptr(F, l, row);
        const u32x4 xa = __builtin_nontemporal_load((const GAS u32x4*)(xr + cA)), xb = __builtin_nontemporal_load((const GAS u32x4*)(xr + cA + 128)), ya = __builtin_nontemporal_load((const GAS u32x4*)yr);
        float x[16], y[16], v[16]; unpack8(xa, x); unpack8(xb, x + 8);
        { const unsigned a[4] = {ya.x, ya.y, ya.z, ya.w};
#pragma unroll
          for (int e = 0; e < 4; ++e) { const f32x2 lo = __builtin_amdgcn_cvt_pk_f32_fp8((int)a[e], false), hi = __builtin_amdgcn_cvt_pk_f32_fp8((int)a[e], true); y[4 * e] = lo.x; y[4 * e + 1] = lo.y; y[4 * e + 2] = hi.x; y[4 * e + 3] = hi.y; } }
        float s = 0.f;
#pragma unroll
        for (int j = 0; j < 4; ++j) { const f32x4 g1 = *(const GAS f32x4*)(md + 2048 + LN1_COL(j));
#pragma unroll
            for (int e = 0; e < 4; ++e) { v[4 * j + e] = x[4 * j + e] * DN_ALPHA + g1[e] * y[4 * j + e]; s += v[4 * j + e]; } }
        const float mean = wave_sum(s, F.lane) * (1.f / DM); float s2 = 0.f;
#pragma unroll
        for (int e = 0; e < 16; ++e) { v[e] -= mean; s2 += v[e] * v[e]; }
        const float rstd = 1.f / sqrtf(wave_sum(s2, F.lane) * (1.f / DM) + LN_EPS);
        unsigned wx[8]; int w8[4];
#pragma unroll
        for (int j = 0; j < 4; ++j) { const f32x4 g = *(const GAS f32x4*)(lg + LN1_COL(j)), bb = *(const GAS f32x4*)(lb + LN1_COL(j)), sh = *(const GAS f32x4*)(md + 3072 + LN1_COL(j)), sc = *(const GAS f32x4*)(md + 4096 + LN1_COL(j));
            float xn[4];
#pragma unroll
            for (int e = 0; e < 4; ++e) xn[e] = v[4 * j + e] * rstd * g[e] + bb[e];
            wx[2 * j] = pk2(xn[0], xn[1]); wx[2 * j + 1] = pk2(xn[2], xn[3]);
            const float h0 = xn[0] * (1.f + sc[0]) + sh[0], h1 = xn[1] * (1.f + sc[1]) + sh[1], h2 = xn[2] * (1.f + sc[2]) + sh[2], h3 = xn[3] * (1.f + sc[3]) + sh[3];
            int v = 0; v = __builtin_amdgcn_cvt_pk_fp8_f32(h0, h1, v, false); v = __builtin_amdgcn_cvt_pk_fp8_f32(h2, h3, v, true); w8[j] = v; }
        unsigned char* x8 = (unsigned char*)(F.ws + WS_XM8) + (size_t)row * DM;
        *(GAS u32x2*)(x8 + cA) = (u32x2){(unsigned)w8[0], (unsigned)w8[1]}; *(GAS u32x2*)(x8 + cA + 128) = (u32x2){(unsigned)w8[2], (unsigned)w8[3]};
        *(GAS u32x4*)(xr + cA) = (u32x4){wx[0], wx[1], wx[2], wx[3]}; *(GAS u32x4*)(xr + cA + 128) = (u32x4){wx[4], wx[5], wx[6], wx[7]};
    }
#undef LN1_COL
}
__device__ __forceinline__ void ph_ln2(Frame& F, int l, int ntok, bool last) {
    const int gw = F.wg * NWAVES + F.wave, NGW = F.G * NWAVES;
    const int cA = 256 * (F.lane >> 4) + 32 * ((F.lane >> 2) & 3) + 8 * (F.lane & 3);
#define LN2_COL(j) (cA + ((j) < 2 ? 4 * (j) : 128 + 4 * ((j) - 2)))
    const float* lg = F.in[I_LN2G] + l * DM; const float* lb = F.in[I_LN2B] + l * DM;
    struct Ln2Raw { u32x2 q[8]; u32x4 qs, xa, xb; };
    auto ln2_load = [&](int row) { Ln2Raw r;
        const unsigned char* y2 = (const unsigned char*)(F.ws + WS_Y2) + (size_t)row * 5120;
        const bf16_t* xr = (const bf16_t*)(F.ws + WS_XR) + (size_t)row * DM;
#pragma unroll
        for (int k = 0; k < 8; ++k) r.q[k] = __builtin_nontemporal_load((const GAS u32x2*)(y2 + k * 512 + 8 * F.lane));
        r.qs = __builtin_nontemporal_load((const GAS u32x4*)(y2 + 4096 + 16 * F.lane));
        r.xa = __builtin_nontemporal_load((const GAS u32x4*)(xr + cA)); r.xb = __builtin_nontemporal_load((const GAS u32x4*)(xr + cA + 128));
        return r; };
    Ln2Raw cur = ln2_load(gw < ntok ? gw : 0);
    for (int row = gw; row < ntok; row += NGW) {
        const Ln2Raw nxt = ln2_load(row + NGW < ntok ? row + NGW : row);
        bf16_t* xr = (bf16_t*)(F.ws + WS_XR) + (size_t)row * DM;
        const float* wg = (const float*)(F.ws + WS_WGT) + (size_t)row * 8;
        const float* md = mod_ptr(F, l, row);
        float ff[16];
#pragma unroll
        for (int e = 0; e < 16; ++e) ff[e] = 0.f;
        { const unsigned a[4] = {cur.qs.x, cur.qs.y, cur.qs.z, cur.qs.w};
#pragma unroll
          for (int e = 0; e < 4; ++e) { const f32x2 lo = __builtin_amdgcn_cvt_pk_f32_fp8((int)a[e], false), hi = __builtin_amdgcn_cvt_pk_f32_fp8((int)a[e], true);
              ff[4 * e] += pg8::Y2_INV * lo.x; ff[4 * e + 1] += pg8::Y2_INV * lo.y; ff[4 * e + 2] += pg8::Y2_INV * hi.x; ff[4 * e + 3] += pg8::Y2_INV * hi.y; } }
#pragma unroll
        for (int k = 0; k < 8; ++k) { const float wk = wg[k] * pg8::Y2_INV; const unsigned a[2] = {cur.q[k].x, cur.q[k].y};
#pragma unroll
            for (int h = 0; h < 2; ++h) {
                const f32x2 p0 = __builtin_amdgcn_cvt_scalef32_pk_f32_fp4(a[h], 1.0f, 0), p1 = __builtin_amdgcn_cvt_scalef32_pk_f32_fp4(a[h], 1.0f, 1), p2 = __builtin_amdgcn_cvt_scalef32_pk_f32_fp4(a[h], 1.0f, 2), p3 = __builtin_amdgcn_cvt_scalef32_pk_f32_fp4(a[h], 1.0f, 3);
                ff[8 * h] += wk * p0.x; ff[8 * h + 1] += wk * p0.y; ff[8 * h + 2] += wk * p1.x; ff[8 * h + 3] += wk * p1.y; ff[8 * h + 4] += wk * p2.x; ff[8 * h + 5] += wk * p2.y; ff[8 * h + 6] += wk * p3.x; ff[8 * h + 7] += wk * p3.y; } }
        float v[16], xo[16]; float s = 0.f;
        unpack8(cur.xa, xo); unpack8(cur.xb, xo + 8);
#pragma unroll
        for (int j = 0; j < 4; ++j) { const f32x4 g2 = *(const GAS f32x4*)(md + 5120 + LN2_COL(j));
#pragma unroll
            for (int e = 0; e < 4; ++e) { v[4 * j + e] = xo[4 * j + e] * DN_ALPHA + g2[e] * ff[4 * j + e]; s += v[4 * j + e]; } }
        const float mean = wave_sum(s, F.lane) * (1.f / DM); float s2 = 0.f;
#pragma unroll
        for (int e = 0; e < 16; ++e) { v[e] -= mean; s2 += v[e] * v[e]; }
        const float rstd = 1.f / sqrtf(wave_sum(s2, F.lane) * (1.f / DM) + LN_EPS);
        const float* mdn = last ? md : mod_ptr(F, l + 1, row);
        float xn[16];
#pragma unroll
        for (int j = 0; j < 4; ++j) { const f32x4 g = *(const GAS f32x4*)(lg + LN2_COL(j)), bb = *(const GAS f32x4*)(lb + LN2_COL(j));
#pragma unroll
            for (int e = 0; e < 4; ++e) xn[4 * j + e] = v[4 * j + e] * rstd * g[e] + bb[e]; }
        if (last) { float* op = F.out + (size_t)row * DM;
#pragma unroll
            for (int j = 0; j < 4; ++j) *(GAS f32x4*)(op + LN2_COL(j)) = (f32x4){xn[4 * j], xn[4 * j + 1], xn[4 * j + 2], xn[4 * j + 3]}; }
        else {
            *(GAS u32x4*)(xr + cA) = (u32x4){pk2(xn[0], xn[1]), pk2(xn[2], xn[3]), pk2(xn[4], xn[5]), pk2(xn[6], xn[7])}; *(GAS u32x4*)(xr + cA + 128) = (u32x4){pk2(xn[8], xn[9]), pk2(xn[10], xn[11]), pk2(xn[12], xn[13]), pk2(xn[14], xn[15])};
            bf16_t* xm = (bf16_t*)(F.ws + WS_XM) + (size_t)row * DM;
            unsigned w[8];
#pragma unroll
            for (int j = 0; j < 4; ++j) { const f32x4 sh = *(const GAS f32x4*)(mdn + LN2_COL(j)), sc = *(const GAS f32x4*)(mdn + 1024 + LN2_COL(j));
                w[2 * j] = pk2(xn[4 * j] * (1.f + sc[0]) + sh[0], xn[4 * j + 1] * (1.f + sc[1]) + sh[1]); w[2 * j + 1] = pk2(xn[4 * j + 2] * (1.f + sc[2]) + sh[2], xn[4 * j + 3] * (1.f + sc[3]) + sh[3]); }
            *(GAS u32x4*)(xm + cA) = (u32x4){w[0], w[1], w[2], w[3]}; *(GAS u32x4*)(xm + cA + 128) = (u32x4){w[4], w[5], w[6], w[7]};
        }
        cur = nxt;
    }
#undef LN2_COL
}

__device__ __forceinline__ unsigned f_ord(float f) { const unsigned u = __builtin_bit_cast(unsigned, f); return (u & 0x80000000u) ? ~u : (u | 0x80000000u); }
__device__ __forceinline__ unsigned long long wave_max_u64(unsigned long long v, int lane) {
#pragma unroll
    for (int o = 1; o < 64; o <<= 1) { const unsigned lo = (unsigned)shxi((int)(unsigned)v, o, lane), hi = (unsigned)shxi((int)(unsigned)(v >> 32), o, lane); const unsigned long long w = ((unsigned long long)hi << 32) | lo; v = w > v ? w : v; }
    return v;
}
__device__ __forceinline__ float seg16_max(float v, int lane) { v = fmaxf(v, shx(v, 1, lane)); v = fmaxf(v, shx(v, 2, lane)); v = fmaxf(v, shx(v, 4, lane)); v = fmaxf(v, shx(v, 8, lane)); return v; }
__device__ __forceinline__ int seg16_min_i(int v, int lane) { int w; w = shxi(v, 1, lane); v = w < v ? w : v; w = shxi(v, 2, lane); v = w < v ? w : v; w = shxi(v, 4, lane); v = w < v ? w : v; w = shxi(v, 8, lane); v = w < v ? w : v; return v; }
template <int CTRL> __device__ __forceinline__ int dpp_i(int v) { return __builtin_amdgcn_update_dpp(0, v, CTRL, 0xf, 0xf, true); }
__device__ __forceinline__ unsigned row_max_u(unsigned v) { unsigned w; w = (unsigned)dpp_i<0xB1>((int)v); v = w > v ? w : v; w = (unsigned)dpp_i<0x4E>((int)v); v = w > v ? w : v; w = (unsigned)dpp_i<0x141>((int)v); v = w > v ? w : v; w = (unsigned)dpp_i<0x140>((int)v); v = w > v ? w : v; return v; }
__device__ __forceinline__ float row_max_f(float v) { v = fmaxf(v, __builtin_bit_cast(float, dpp_i<0xB1>(__builtin_bit_cast(int, v)))); v = fmaxf(v, __builtin_bit_cast(float, dpp_i<0x4E>(__builtin_bit_cast(int, v)))); v = fmaxf(v, __builtin_bit_cast(float, dpp_i<0x141>(__builtin_bit_cast(int, v)))); v = fmaxf(v, __builtin_bit_cast(float, dpp_i<0x140>(__builtin_bit_cast(int, v)))); return v; }
__device__ __forceinline__ int row_min_i(int v) { int w; w = dpp_i<0xB1>(v); v = w < v ? w : v; w = dpp_i<0x4E>(v); v = w < v ? w : v; w = dpp_i<0x141>(v); v = w < v ? w : v; w = dpp_i<0x140>(v); v = w < v ? w : v; return v; }
__device__ __forceinline__ float rdlane_f(float v, int l) { return __builtin_bit_cast(float, __builtin_amdgcn_readlane(__builtin_bit_cast(int, v), l)); }
__device__ __forceinline__ unsigned wave_max_u(unsigned v) {
    v = row_max_u(v);
    const unsigned a = (unsigned)__builtin_amdgcn_readlane((int)v, 0), b = (unsigned)__builtin_amdgcn_readlane((int)v, 16), c = (unsigned)__builtin_amdgcn_readlane((int)v, 32), d = (unsigned)__builtin_amdgcn_readlane((int)v, 48);
    const unsigned ab = a > b ? a : b, cd = c > d ? c : d; return ab > cd ? ab : cd;
}
__device__ __forceinline__ float row_top2(float v, int l16) {
    const float m1 = row_max_f(v);
    const int first = row_min_i(v == m1 ? l16 : 99);
    const float m2 = row_max_f(l16 == first ? -3.0e38f : v);
    return m1 + m2;
}
__device__ __forceinline__ float seg16_top2(float v, int lane) {
    const float m1 = seg16_max(v, lane);
    const int first = seg16_min_i(v == m1 ? (lane & 15) : 99, lane);
    const float m2 = seg16_max((lane & 15) == first ? -3.0e38f : v, lane);
    return m1 + m2;
}
__device__ __forceinline__ void ph_route(Frame& F, int l, int ntok) {
    LAS int* hist = (LAS int*)F.lds;
    LAS int* base = hist + 128;
    LAS unsigned* alist = (LAS unsigned*)(F.lds + 1024);
    const int tpw = (ntok + F.G - 1) / F.G, t0 = F.wg * tpw, t1 = (t0 + tpw) < ntok ? (t0 + tpw) : ntok;
    __syncthreads();
    if (F.tid < 128) hist[F.tid] = 0;
    __syncthreads();
    const float* LG = (const float*)(F.ws + WS_LOGIT); const float* rb = F.in[I_RB] + l * NEXP;
    const float b0 = rb[F.lane], b1 = rb[F.lane + 64];
    constexpr int RT = 4;
    float xq0[RT], xq1[RT];
#pragma unroll
    for (int j = 0; j < RT; ++j) { int tok = t0 + F.wave * RT + j; tok = tok < t1 ? tok : t1 - 1; tok = tok < 0 ? 0 : tok;
        xq0[j] = LG[(size_t)tok * 256 + F.lane]; xq1[j] = LG[(size_t)tok * 256 + 64 + F.lane]; }
    for (int tb = t0 + F.wave * RT; tb < t1; tb += NWAVES * RT) {
        float s0[RT], s1[RT], e0[RT], e1[RT], gs0[RT], gs1[RT]; unsigned h0[RT], h1[RT]; int mye[RT]; float myw[RT], wsum[RT];
        float xn0[RT], xn1[RT];
#pragma unroll
        for (int j = 0; j < RT; ++j) { int tok = tb + NWAVES * RT + j; tok = tok < t1 ? tok : t1 - 1;
            xn0[j] = LG[(size_t)tok * 256 + F.lane]; xn1[j] = LG[(size_t)tok * 256 + 64 + F.lane]; }
#pragma unroll
        for (int j = 0; j < RT; ++j) { const int tok = (tb + j) < t1 ? tb + j : t1 - 1;
            const float x0 = xq0[j], x1 = xq1[j];
            const float* rbs = (const float*)(F.ws + WS_RBIAS) + (size_t)(l * 17 + row_b(tok)) * 128; const float y0 = x0 + rbs[F.lane], y1 = x1 + rbs[64 + F.lane];
            s0[j] = __builtin_amdgcn_rcpf(1.0f + __expf(-y0)); s1[j] = __builtin_amdgcn_rcpf(1.0f + __expf(-y1)); e0[j] = s0[j] + b0; e1[j] = s1[j] + b1; }
#pragma unroll
        for (int j = 0; j < RT; ++j) { gs0[j] = row_top2(e0[j], F.lane & 15); gs1[j] = row_top2(e1[j], F.lane & 15); }
#pragma unroll
        for (int j = 0; j < RT; ++j) {
            float gsc[8];
#pragma unroll
            for (int g = 0; g < 4; ++g) { gsc[g] = rdlane_f(gs0[j], g * 16); gsc[4 + g] = rdlane_f(gs1[j], g * 16); }
            unsigned gmask = 0u;
#pragma unroll
            for (int g = 0; g < 8; ++g) { int cnt = 0;
#pragma unroll
                for (int g2 = 0; g2 < 8; ++g2) cnt += (gsc[g2] > gsc[g] || (gsc[g2] == gsc[g] && g2 < g)) ? 1 : 0;
                gmask |= (cnt < 4) ? (1u << g) : 0u; }
            const bool ok0 = (gmask >> (F.lane >> 4)) & 1u, ok1 = (gmask >> (4 + (F.lane >> 4))) & 1u;
            h0[j] = ok0 ? f_ord(e0[j]) : 0u; h1[j] = ok1 ? f_ord(e1[j]) : 0u;
            mye[j] = 0; myw[j] = 0.f; wsum[j] = 0.f; }
#pragma unroll
        for (int k = 0; k < 8; ++k) {
#pragma unroll
            for (int j = 0; j < RT; ++j) {
                const unsigned bh = h0[j] >= h1[j] ? h0[j] : h1[j];
                const unsigned H = wave_max_u(bh);
                const unsigned mylo = h0[j] == H ? (unsigned)(255 - F.lane) : (h1[j] == H ? (unsigned)(255 - 64 - F.lane) : 0u);
                const unsigned Lm = wave_max_u(mylo);
                const int e = 255 - (int)Lm;
                if (e < 64) { if (F.lane == e) h0[j] = 0u; } else { if (F.lane == e - 64) h1[j] = 0u; }
                const float sv = e < 64 ? rdlane_f(s0[j], e) : rdlane_f(s1[j], e - 64);
                wsum[j] += sv; if (F.lane == k) { mye[j] = e; myw[j] = sv; } }
        }
#pragma unroll
        for (int j = 0; j < RT; ++j) { const int tok = tb + j;
            if (tok < t1 && F.lane < 8) {
                const int lr = __hip_atomic_fetch_add(&hist[mye[j]], 1, __ATOMIC_RELAXED, __HIP_MEMORY_SCOPE_WORKGROUP);
                alist[(tok - t0) * 8 + F.lane] = (unsigned)mye[j] | ((unsigned)lr << 8);
                ((int*)(F.ws + WS_EIDX))[(size_t)tok * 8 + F.lane] = mye[j];
                ((float*)(F.ws + WS_WGT))[(size_t)tok * 8 + F.lane] = myw[j] / wsum[j] * 2.5f;
            } }
#pragma unroll
        for (int j = 0; j < RT; ++j) { xq0[j] = xn0[j]; xq1[j] = xn1[j]; }
    }
    __syncthreads();
    if (F.tid < 128) { const int hcount = hist[F.tid]; base[F.tid] = hcount ? (int)atomicAdd(F.ctl + CW_CNT + l * 256 + F.tid, (unsigned)hcount) : 0; }
    __syncthreads();
    for (int a = F.tid; a < (t1 - t0) * 8; a += NTHR) { const unsigned v = alist[a]; ((int*)(F.ws + WS_RNK))[(size_t)t0 * 8 + a] = base[v & 0xffu] + (int)(v >> 8); }
}
__device__ __forceinline__ void ph_positions(Frame& F, int l, int ntok) {
    LAS int* cnt = (LAS int*)F.lds;
    LAS int* off = cnt + 132;
    __syncthreads();
    if (F.tid < NE1) cnt[F.tid] = F.tid < NEXP ? (int)__hip_atomic_load(F.ctl + CW_CNT + l * 256 + F.tid, __ATOMIC_RELAXED, __HIP_MEMORY_SCOPE_AGENT) : ntok;
    __syncthreads();
    if (F.tid == 0) { int o = 0; for (int e = 0; e < NE1; ++e) { off[e] = o; o += (cnt[e] + 255) & ~255; } off[NE1] = o; }
    __syncthreads();
    const int gt = F.wg * NTHR + F.tid, NGT = F.G * NTHR;
    int* rowtok = (int*)(F.ws + WS_ROWTOK); int* rowdst = (int*)(F.ws + WS_ROWDST); int* tile_exp = (int*)(F.ws + WS_TILEEXP);
    const int* eidx = (const int*)(F.ws + WS_EIDX); const int* rnk = (const int*)(F.ws + WS_RNK);
    for (int a = gt; a < ntok * 8; a += NGT) { const int tok = a >> 3, k = a & 7; const int pos = off[eidx[a]] + rnk[a]; rowtok[pos] = tok; rowdst[pos] = tok * 10 + k; }
    for (int tok = gt; tok < ntok; tok += NGT) { const int pos = off[NEXP] + tok; rowtok[pos] = tok; rowdst[pos] = tok * 10 + 8; }
    for (int i = gt; i < NE1 * 256; i += NGT) { const int e = i >> 8, p = i & 255; const int row = off[e] + cnt[e] + p; if (row < off[e + 1]) { rowtok[row] = 0; rowdst[row] = -1; } }
    for (int i = gt; i < NE1 * 320; i += NGT) { const int e = i / 320, p = i % 320; const int t = (off[e] >> 8) + p; if (t < (off[e + 1] >> 8)) tile_exp[t] = e; }
    if (gt == 0) F.ctl[CW_NTL + l] = (unsigned)(off[NE1] >> 8);
}

#ifndef MK_MULTI
#define MK_MULTI 0
#endif
constexpr int PH_PER_LAYER = 12, NPHASE = 2 + DEPTH * PH_PER_LAYER;
struct Args { const float* in[36]; float* out; unsigned char* ws; int ph_lo, ph_hi; };

__global__ void __launch_bounds__(NTHR, 2) mk_fwd(Args args) {
    extern __shared__ __attribute__((aligned(16))) unsigned char lds_raw[];
    Frame F;
    F.lds = (LAS unsigned char*)lds_raw;
    F.tid = threadIdx.x; F.lane = F.tid & 63; F.wave = __builtin_amdgcn_readfirstlane(F.tid >> 6);
    const int wave0 = F.wave;
    F.G = gridDim.x; F.wg = blockIdx.x;
    F.in = args.in;
    F.out = args.out; F.ws = args.ws; F.ctl = (unsigned*)(args.ws + WS_CTL);
    volatile LAS unsigned* MISC = (volatile LAS unsigned*)(F.lds + MISC_OFF);
    if (F.tid < 32) MISC[F.tid] = 0u;
    __syncthreads();
    const int lo = args.ph_lo, hi = args.ph_hi;
    const bool single = (hi - lo) > 1;
    XcdBarrier bar; bar.bar = F.ctl + CW_BAR; bar.x = 0; bar.st = nullptr;
    if (single) bar = xcd_barrier_post(F.ctl + CW_BAR, MISC + 8);
#define IN(k) (lo <= (k) && (k) < hi)
#ifndef PROBE_MASK
#define PROBE_MASK 0
#endif
#define REP(k) for (int _rep = 0; _rep < (((PROBE_MASK >> (k)) & 1) ? 2 : 1); ++_rep)
#define SEAM(k) do { if (IN(k) && IN((k) + 1)) { xcd_barrier(bar); if ((PROBE_MASK >> 15) & 1) xcd_barrier(bar); } } while (0)
#define FRESH() do { int _ln; asm volatile("v_mbcnt_lo_u32_b32 %0, -1, 0\n\tv_mbcnt_hi_u32_b32 %0, -1, %0" : "=v"(_ln)); int _wv = wave0; asm volatile("" : "+s"(_wv)); F.lane = _ln; F.wave = _wv; F.tid = (_wv << 6) | _ln; \
        unsigned char* _w = args.ws; asm volatile("" : "+s"(_w)); F.ws = _w; F.ctl = (unsigned*)(_w + WS_CTL); float* _o = args.out; asm volatile("" : "+s"(_o)); F.out = _o; } while (0)

    if (IN(0)) { FRESH(); REP(13) { p0_static_weights(F); __syncthreads(); } REP(14) { p0_mod(F); __syncthreads(); } FRESH(); REP(16) { p0_hyena_filters(F); __syncthreads(); } }
    SEAM(0);
    if (IN(1)) { FRESH(); p0_init_rows(F); __syncthreads(); FRESH(); p1_router_weights(F); }
    SEAM(1);
#pragma unroll 1
    for (int l = 0; l < DEPTH; ++l) {
        const int pb = 2 + l * PH_PER_LAYER; const bool last = (l == DEPTH - 1); const int ntok = last ? NLAT : NROW;
        if (IN(pb + 0)) { FRESH();
            REP(0) { p_expert_weights(F, l, (last || F.G != 256) ? 0 : XW_TAIL_G, XW_ITEMS, F.G * NWAVES, F.wg * NWAVES + F.wave); __syncthreads(); }
            { pg8::ColMapOrder S; S.b.init(NROW, 11 * 256, F.G, F.wg); S.map = 0xCBA98763210ull; pg8::EpiBf16 E{(bf16_t*)(F.ws + WS_U), DIN};
              REP(1) pg8::gemm_phase<pg8::EpiBf16, pg8::ColMapOrder, false>(F.tid, F.lds, (const bf16_t*)(F.ws + WS_XM), (const bf16_t*)(F.ws + WS_WIN) + (size_t)l * DIN * DM, DM, nullptr, S, E); }
            __syncthreads(); FRESH();
            { pg8::ColMapOrder S; S.b.init(NROW, 2 * 256, F.G, (F.wg + 80) % F.G); S.map = 0x54ull; pg8::EpiVT E{(bf16_t*)(F.ws + WS_VT), UV};
              REP(1) pg8::gemm_phase<pg8::EpiVT, pg8::ColMapOrder, false, false, true, true, false, true>(F.tid, F.lds, (const bf16_t*)(F.ws + WS_XM), (const bf16_t*)(F.ws + WS_WIN) + (size_t)l * DIN * DM, DM, nullptr, S, E); }
        }
        SEAM(pb + 0);
        if (IN(pb + 1)) { FRESH(); REP(2) { ph_transposes(F, l); __syncthreads(); } FRESH(); REP(3) { ph_gla_local(F, l); __syncthreads(); } }
        SEAM(pb + 1);
        if (IN(pb + 2)) { FRESH(); REP(4) { ph_na(F, l, last); } FRESH(); REP(5) { ph_gla_scan(F); } __syncthreads(); FRESH(); REP(6) { ph_hyena(F, l, last); } }
        SEAM(pb + 2);
        if (IN(pb + 3)) { FRESH(); ph_hy_transpose(F, last); __syncthreads(); FRESH(); REP(7) { ph_gla_out(F, l, last); } }
        SEAM(pb + 3);
        if (IN(pb + 4)) { FRESH();
            pg8::DenseOrder S; S.init(ntok, DM, F.G, F.wg); pg8::EpiY8 E{(unsigned char*)(F.ws + WS_Y), DM};
            REP(8) pg8::gemm_phase<pg8::EpiY8, pg8::DenseOrder, false>(F.tid, F.lds, (const bf16_t*)(F.ws + WS_MIX), (const bf16_t*)(F.ws + WS_WOUT) + (size_t)l * DM * DM, DM, nullptr, S, E);
            if (!last && F.G == 256 && F.wg >= 64) { __syncthreads(); FRESH(); p_expert_weights(F, l, 0, XW_TAIL_E, 192 * NWAVES, (F.wg - 64) * NWAVES + F.wave); }
        }
        SEAM(pb + 4);
        if (IN(pb + 5)) { FRESH(); ph_ln1(F, l, ntok); }
        SEAM(pb + 5);
        if (IN(pb + 6)) { FRESH();
            pg8::RouterOrder S; S.b.init(ntok, 256, F.G, F.wg); pg8::EpiF32H E{(float*)(F.ws + WS_LOGIT), 256};
            REP(9) pg8::gemm_phase<pg8::EpiF32H, pg8::RouterOrder, false, false, true, true, true>(F.tid, F.lds, (const bf16_t*)(F.ws + WS_XR), (const bf16_t*)(F.ws + WS_WRB) + (size_t)l * 17 * 128 * DM, DM, nullptr, S, E);
            if (!last && F.G == 256 && F.wg >= 16) { __syncthreads(); FRESH(); p_expert_weights(F, l, XW_TAIL_E, XW_TAIL_G, 240 * NWAVES, (F.wg - 16) * NWAVES + F.wave); }
        }
        SEAM(pb + 6);
        if (IN(pb + 7)) { FRESH(); ph_route(F, l, ntok); }
        SEAM(pb + 7);
        if (IN(pb + 8)) { FRESH(); REP(12) { ph_positions(F, l, ntok); __syncthreads(); } }
        SEAM(pb + 8);
        if (IN(pb + 9)) { FRESH();
            const int ntl = (int)__hip_atomic_load(F.ctl + CW_NTL + l, __ATOMIC_RELAXED, __HIP_MEMORY_SCOPE_AGENT);
            pg8::GroupedOrder S; S.init(ntl, 2, F.G, F.wg); S.preload((const int*)(F.ws + WS_TILEEXP), F.lds + pg8::STAGE_BYTES + 4096, F.tid, NTHR); pg8::EpiSwiglu E{(unsigned char*)(F.ws + WS_ACT)};
            REP(10) pg8::gemm_phase<pg8::EpiSwiglu, pg8::GroupedOrder, true, true>(F.tid, F.lds, (const void*)(F.ws + WS_XM8), (const void*)(F.ws + WS_EXP1), DM, (const int*)(F.ws + WS_ROWTOK), S, E);
        }
        SEAM(pb + 9);
        if (IN(pb + 10)) { FRESH();
            const int ntl = (int)__hip_atomic_load(F.ctl + CW_NTL + l, __ATOMIC_RELAXED, __HIP_MEMORY_SCOPE_AGENT);
            pg8::GroupedOrder S; S.init(ntl, 4, F.G, F.wg); S.preload((const int*)(F.ws + WS_TILEEXP), F.lds + pg8::STAGE_BYTES + 4096, F.tid, NTHR); pg8::EpiScatter E{(unsigned char*)(F.ws + WS_Y2), (const int*)(F.ws + WS_ROWDST)};
            REP(11) pg8::gemm_phase<pg8::EpiScatter, pg8::GroupedOrder, false, true>(F.tid, F.lds, (const void*)(F.ws + WS_ACT), (const void*)(F.ws + WS_EXP2), EH, nullptr, S, E);
        }
        SEAM(pb + 10);
        if (IN(pb + 11)) { FRESH(); ph_ln2(F, l, ntok, last); }
        SEAM(pb + 11);
    }
#undef IN
#undef SEAM
#undef FRESH
}

extern "C" void kernel_launch(void* const* d_in, const int* in_sizes, int n_in, void* d_out, int out_size, void* d_ws, size_t ws_size, hipStream_t stream) {
    static int grid = 0;
    if (grid == 0) {
        if (n_in != 36 || out_size != NLAT * DM || ws_size < WS_END) { fprintf(stderr, "kernel_launch: unexpected shapes (n_in %d out %d ws %zu need %zu)\n", n_in, out_size, ws_size, (size_t)WS_END); grid = -1; return; }
        int dev = 0, cus = 0, per_cu = 0;
        if (hipGetDevice(&dev) != hipSuccess || hipDeviceGetAttribute(&cus, hipDeviceAttributeMultiprocessorCount, dev) != hipSuccess) { grid = -1; return; }
        if (hipFuncSetAttribute((const void*)mk_fwd, hipFuncAttributeMaxDynamicSharedMemorySize, LDS_BYTES) != hipSuccess) { fprintf(stderr, "kernel_launch: hipFuncSetAttribute failed\n"); grid = -1; return; }
        if (hipOccupancyMaxActiveBlocksPerMultiprocessor(&per_cu, (const void*)mk_fwd, NTHR, LDS_BYTES) != hipSuccess || per_cu < 1) { fprintf(stderr, "kernel_launch: occupancy query says %d\n", per_cu); }
        (void)hipGetLastError();
        grid = cus;
    }
    if (grid < 0) return;
    (void)hipMemsetAsync((char*)d_ws + WS_CTL, 0, CTL_BYTES, stream);
    Args a{};
    for (int i = 0; i < 36; ++i) a.in[i] = (const float*)d_in[i];
    a.out = (float*)d_out; a.ws = (unsigned char*)d_ws;
#if MK_MULTI
    for (int p = 0; p < NPHASE; ++p) { a.ph_lo = p; a.ph_hi = p + 1; hipLaunchKernelGGL(mk_fwd, dim3(grid), dim3(NTHR), LDS_BYTES, stream, a); }
#else
    a.ph_lo = 0; a.ph_hi = NPHASE; hipLaunchKernelGGL(mk_fwd, dim3(grid), dim3(NTHR), LDS_BYTES, stream, a);
#endif
}
```

```cpp
#include <hip/hip_runtime.h>
#include <cstdio>
#include <cstdint>

#define LAS __attribute__((address_space(3)))
#define GAS __attribute__((address_space(1)))
typedef unsigned short bf16_t;
typedef short bf16x8 __attribute__((ext_vector_type(8)));
typedef float f32x4 __attribute__((ext_vector_type(4)));
typedef float f32x2 __attribute__((ext_vector_type(2)));
typedef unsigned u32x4 __attribute__((ext_vector_type(4)));
typedef unsigned u32x2 __attribute__((ext_vector_type(2)));

constexpr int NB = 16, SEQ = 4096, CTXL = 256, DM = 1024, DEPTH = 4;
constexpr int NLAT = NB * SEQ;
constexpr int NCTX = NB * CTXL;
constexpr int NROW = NLAT + NCTX;
constexpr int SPB = SEQ + CTXL;
constexpr int DIN_REF = 3104;
constexpr int DIN = 3328;
constexpr int UQ = 0, UK = 512, UV = 1024, UGQ = 1536, UGK = 1664, UGV = 1792, UGR = 2048, UHY = 2304, ULAF = 3072, ULAB = 3200;
constexpr int NEXP = 128, TOPK = 8, EH = 256;
constexpr int NE1 = NEXP + 1;
constexpr int RMAX = 659712;
constexpr int TMAX = RMAX / 256;
constexpr float LN_EPS = 1e-6f;
constexpr float DN_ALPHA = 1.6817928305074290f;

__device__ __forceinline__ unsigned f2bf(float f) { unsigned u = __builtin_bit_cast(unsigned, f); return (u + 0x7fffu + ((u >> 16) & 1u)) >> 16; }
typedef __bf16 bf16v2 __attribute__((ext_vector_type(2)));
__device__ __forceinline__ unsigned pk2(float lo, float hi) { const f32x2 v = {lo, hi}; const bf16v2 b = __builtin_convertvector(v, bf16v2); return __builtin_bit_cast(unsigned, b); }
__device__ __forceinline__ float bf2f(unsigned short b) { return __builtin_bit_cast(float, ((unsigned)b) << 16); }
__device__ __forceinline__ float bflo(unsigned w) { return __builtin_bit_cast(float, w << 16); }
__device__ __forceinline__ float bfhi(unsigned w) { return __builtin_bit_cast(float, w & 0xffff0000u); }
__device__ __forceinline__ float shx(float v, int o, int lane) { return __builtin_bit_cast(float, __builtin_amdgcn_ds_bpermute((lane ^ o) << 2, __builtin_bit_cast(int, v))); }
__device__ __forceinline__ int shxi(int v, int o, int lane) { return __builtin_amdgcn_ds_bpermute((lane ^ o) << 2, v); }
__device__ __forceinline__ float shf(float v, int src) { return __builtin_bit_cast(float, __builtin_amdgcn_ds_bpermute(src << 2, __builtin_bit_cast(int, v))); }
__device__ __forceinline__ float wave_sum(float v, int lane) {
#pragma unroll
    for (int o = 1; o < 64; o <<= 1) v += shx(v, o, lane);
    return v;
}
__device__ __forceinline__ void unpack8(const u32x4 q, float* o) { o[0] = bflo(q.x); o[1] = bfhi(q.x); o[2] = bflo(q.y); o[3] = bfhi(q.y); o[4] = bflo(q.z); o[5] = bfhi(q.z); o[6] = bflo(q.w); o[7] = bfhi(q.w); }
__device__ __forceinline__ float silu_f(float x) { return x * __builtin_amdgcn_rcpf(1.0f + __expf(-x)); }
#define LDS_WAIT() asm volatile("s_waitcnt lgkmcnt(0)" ::: "memory")
#define VM_WAIT() asm volatile("s_waitcnt vmcnt(0)" ::: "memory")

#define XB_TMO      128
#define XB_XCNT(j)  (256  + 64 * (j))
#define XB_XSUB(j)  (1280 + 64 * (j))
#define XB_XGEN(j)  (2304 + 64 * (j))
#define XB_TOP      3328
#define XB_TOPGEN   3392
#define XCD_BAR_WORDS 3456
#define XB_SPIN_CAP (1u << 18)

__device__ __forceinline__ unsigned xb_ld(unsigned* p)              { return __hip_atomic_load(p, __ATOMIC_RELAXED, __HIP_MEMORY_SCOPE_AGENT); }
__device__ __forceinline__ unsigned xb_add(unsigned* p, unsigned v) { return __hip_atomic_fetch_add(p, v, __ATOMIC_RELAXED, __HIP_MEMORY_SCOPE_AGENT); }
__device__ __forceinline__ unsigned xb_xcc_id() { return (unsigned)__builtin_amdgcn_s_getreg((3 << 11) | 20) & 0xFu; }
#define XB_SPIN(cond, bar) do { unsigned _sp = 0; while (cond) { __builtin_amdgcn_s_sleep(1); \
    if ((++_sp & 255u) == 0u) { if (xb_ld(&(bar)[XB_TMO])) break; if (_sp > XB_SPIN_CAP) { atomicAdd(&(bar)[XB_TMO], 1u); break; } } } } while (0)

struct XcdBarrier { unsigned* bar; unsigned x; volatile LAS unsigned* st; };

__device__ __forceinline__ XcdBarrier xcd_barrier_post(unsigned* bar, volatile LAS unsigned* st) {
    XcdBarrier b; b.bar = bar; b.x = xb_xcc_id(); b.st = st;
    if (threadIdx.x == 0) (void)xb_add(&bar[XB_XCNT(b.x)], 1u);
    return b;
}
__device__ __forceinline__ void xcd_barrier_complete(unsigned* bar, unsigned x, unsigned& nloc, unsigned& nx) {
    const unsigned G = gridDim.x * gridDim.y * gridDim.z;
    unsigned sum, cnt, mine, sp = 0u;
    for (;;) {
        sum = 0u; cnt = 0u; mine = 0u;
#pragma unroll
        for (unsigned j = 0; j < 16; ++j) { const unsigned c = xb_ld(&bar[XB_XCNT(j)]); sum += c; cnt += (c > 0u) ? 1u : 0u; mine = (j == x) ? c : mine; }
        if (sum == G) break;
        __builtin_amdgcn_s_sleep(1);
        if ((++sp & 255u) == 0u) { if (xb_ld(&bar[XB_TMO])) break; if (sp > XB_SPIN_CAP) { atomicAdd(&bar[XB_TMO], 1u); break; } }
    }
    nloc = mine > 0u ? mine : 1u; nx = cnt > 0u ? cnt : 1u;
}
__device__ __forceinline__ void xcd_barrier(const XcdBarrier& b) {
    asm volatile("s_waitcnt vmcnt(0)" ::: "memory");
    __syncthreads();
    if (threadIdx.x == 0) {
        unsigned* bar = b.bar;
        __builtin_amdgcn_s_waitcnt(0);
        unsigned nloc = b.st[0], nx = b.st[1];
        if (nloc == 0u) { xcd_barrier_complete(bar, b.x, nloc, nx); b.st[0] = nloc; b.st[1] = nx; }
        const unsigned old = xb_add(&bar[XB_XSUB(b.x)], 1u);
        const unsigned gen = old / nloc;
        if (old + 1u == (gen + 1u) * nloc) {
            __builtin_amdgcn_fence(__ATOMIC_RELEASE, "agent");
            asm volatile("s_waitcnt vmcnt(0)" ::: "memory");
            const unsigned og = xb_add(&bar[XB_TOP], 1u);
            const unsigned tg = og / nx;
            if (og + 1u == (tg + 1u) * nx) xb_add(&bar[XB_TOPGEN], 1u);
            else XB_SPIN(xb_ld(&bar[XB_TOPGEN]) == tg, bar);
            __builtin_amdgcn_fence(__ATOMIC_ACQUIRE, "agent");
            xb_add(&bar[XB_XGEN(b.x)], 1u);
            asm volatile("s_waitcnt vmcnt(0)" ::: "memory");
        } else {
            XB_SPIN(xb_ld(&bar[XB_XGEN(b.x)]) == gen, bar);
            __builtin_amdgcn_fence(__ATOMIC_ACQUIRE, "agent");
            asm volatile("s_waitcnt vmcnt(0)" ::: "memory");
        }
    }
    __syncthreads();
}

namespace pg8 {
constexpr int BM = 256, BK = 64, HALF = 128, HTB = HALF * BK * 2, STAGE_BYTES = 8 * HTB, NXCD = 8, WGM = 8;
__host__ __device__ __forceinline__ int lds_byte(int r, int c) { const int st = (r >> 4) * 2 + (c >> 5), rr = r & 15, cc = c & 31, ob = rr * 64 + cc * 2; return st * 1024 + (ob ^ (((ob >> 9) & 1) << 5)); }
__host__ __device__ __forceinline__ void stage_rc(int b, int& R, int& C) { const int st = b / 1024, sb = b % 1024, swz = sb ^ (((sb >> 9) & 1) << 5); R = (st >> 1) * 16 + swz / 64; C = (st & 1) * 32 + (swz % 64) / 2; }
__host__ __device__ __forceinline__ int perm32(int rho) { const int n = rho >> 4, i = rho & 15; return 8 * (i >> 2) + 4 * n + (i & 3); }

struct Unit { int arow0, brow0, orow0, ocol0, aux; };

struct DenseOrder {
    int nM, nN, nwg, G, c;
    __device__ void init(int M, int N, int G_, int c_) { nM = M / BM; nN = N / BM; nwg = nM * nN; G = G_; c = c_; }
    __device__ __forceinline__ bool next(int i, Unit& u) const {
        const long L = (long)i * G + c; if (L >= nwg) return false;
        int wgid = (int)L; { const int q = nwg / NXCD, r = nwg % NXCD, xcd = wgid % NXCD, off = wgid / NXCD; wgid = (xcd < r ? xcd * (q + 1) : r * (q + 1) + (xcd - r) * q) + off; }
        const int nig = WGM * nN, gid = wgid / nig, fm = gid * WGM, gsz = (nM - fm) < WGM ? (nM - fm) : WGM;
        const int pm = fm + ((wgid % nig) % gsz), pn = (wgid % nig) / gsz;
        u.arow0 = pm * BM; u.brow0 = pn * BM; u.orow0 = pm * BM; u.ocol0 = pn * BM; u.aux = 0; return true;
    }
};
struct GroupedOrder {
    const LAS unsigned char* tab; int nN, nslot, slot, t0, t1;
    __device__ __forceinline__ void init(int ntiles, int nN_, int G, int c) {
        nN = nN_;
        if ((G & 7) == 0) { const int per = (ntiles + 7) >> 3, x = c & 7; nslot = G >> 3; slot = c >> 3; t0 = x * per; t1 = (t0 + per) < ntiles ? (t0 + per) : ntiles; }
        else { nslot = G; slot = c; t0 = 0; t1 = ntiles; }
    }
    __device__ __forceinline__ void preload(const int* tile_exp, LAS unsigned char* lds_tab, int tid, int nthr) {
        __syncthreads();
        for (int i = tid; i < t1 - t0; i += nthr) lds_tab[i] = (unsigned char)tile_exp[t0 + i];
        __syncthreads();
        tab = lds_tab;
    }
    __device__ __forceinline__ bool next(int i, Unit& u) const {
        const int q = i * nslot + slot, t = t0 + q / nN, pn = q % nN;
        if (t >= t1) return false;
        const int e = (int)tab[t - t0];
        u.arow0 = t * BM; u.brow0 = (e * nN + pn) * BM; u.orow0 = t * BM; u.ocol0 = pn * BM; u.aux = e; return true;
    }
};

struct RouterOrder {
    DenseOrder b;
    __device__ __forceinline__ bool next(int i, Unit& u) const { if (!b.next(i, u)) return false; const int pm = u.arow0 >> 8; u.brow0 = (pm < 256 ? (pm >> 4) : 16) * 128; return true; }
};
struct ColMapOrder {
    DenseOrder b; unsigned long long map;
    __device__ __forceinline__ bool next(int i, Unit& u) const { if (!b.next(i, u)) return false; const int ph = (int)((map >> ((u.ocol0 >> 8) * 4)) & 15ull); u.brow0 = ph * BM; u.ocol0 = ph * BM; return true; }
};
template <class Base> struct RangeOrder {
    Base b; int i0, i1;
    __device__ __forceinline__ bool next(int i, Unit& u) const { const int j = i + i0; if (j >= i1) return false; return b.next(j, u); }
};

__device__ __forceinline__ unsigned cvt_pk_bf16(float lo, float hi) { return pk2(lo, hi); }

struct NoPre {};
struct EpiF32 {
    static constexpr bool PERM = false; static constexpr int SCW = 0x7A7A7A7A; typedef NoPre Pre;
    __device__ __forceinline__ Pre prefetch(const Unit&, LAS unsigned char*, int, int, int) const { return Pre{}; }
    float* C; int ldc;
    __device__ __forceinline__ void operator()(const f32x4 (&acc)[2][2][4][2], const Unit& u, int wr, int wc, int fr, int fq, const Pre&, bool drain) const {
        if (drain) asm volatile("s_waitcnt vmcnt(0)" ::: "memory");
        const int row0 = u.orow0 + wr * 64 + fr, col0 = u.ocol0 + wc * 32 + 4 * fq;
#pragma unroll
        for (int ai = 0; ai < 2; ++ai)
#pragma unroll
            for (int m = 0; m < 4; ++m) { float* rowp = C + (size_t)(row0 + ai * HALF + m * 16) * ldc + col0;
#pragma unroll
                for (int bj = 0; bj < 2; ++bj)
#pragma unroll
                    for (int n = 0; n < 2; ++n) *(GAS f32x4*)(rowp + bj * HALF + n * 16) = acc[ai][bj][m][n]; }
    }
};
struct EpiF32H {
    static constexpr bool PERM = false; static constexpr int SCW = 0x7A7A7A7A; typedef NoPre Pre;
    __device__ __forceinline__ Pre prefetch(const Unit&, LAS unsigned char*, int, int, int) const { return Pre{}; }
    float* C; int ldc;
    __device__ __forceinline__ void operator()(const f32x4 (&acc)[2][2][4][2], const Unit& u, int wr, int wc, int fr, int fq, const Pre&, bool drain) const {
        if (drain) asm volatile("s_waitcnt vmcnt(0)" ::: "memory");
        const int row0 = u.orow0 + wr * 64 + fr, col0 = wc * 32 + 4 * fq;
#pragma unroll
        for (int ai = 0; ai < 2; ++ai)
#pragma unroll
            for (int m = 0; m < 4; ++m) { float* rowp = C + (size_t)(row0 + ai * HALF + m * 16) * ldc + col0;
#pragma unroll
                for (int n = 0; n < 2; ++n) *(GAS f32x4*)(rowp + n * 16) = acc[ai][0][m][n]; }
    }
};
struct EpiBf16 {
    static constexpr bool PERM = true; static constexpr int SCW = 0x7A7A7A7A; typedef NoPre Pre;
    __device__ __forceinline__ Pre prefetch(const Unit&, LAS unsigned char*, int, int, int) const { return Pre{}; }
    bf16_t* O; int ldc;
    __device__ __forceinline__ void operator()(const f32x4 (&acc)[2][2][4][2], const Unit& u, int wr, int wc, int fr, int fq, const Pre&, bool drain) const {
        const int row0 = u.orow0 + wr * 64 + fr, col0 = u.ocol0 + wc * 32 + 8 * fq;
        u32x4 w[2][4][2];
#pragma unroll
        for (int ai = 0; ai < 2; ++ai)
#pragma unroll
            for (int m = 0; m < 4; ++m)
#pragma unroll
                for (int bj = 0; bj < 2; ++bj) { const f32x4 v0 = acc[ai][bj][m][0], v1 = acc[ai][bj][m][1];
                    w[ai][m][bj].x = cvt_pk_bf16(v0[0], v0[1]); w[ai][m][bj].y = cvt_pk_bf16(v0[2], v0[3]); w[ai][m][bj].z = cvt_pk_bf16(v1[0], v1[1]); w[ai][m][bj].w = cvt_pk_bf16(v1[2], v1[3]); }
        if (drain) asm volatile("s_waitcnt vmcnt(0)" ::: "memory");
#pragma unroll
        for (int ai = 0; ai < 2; ++ai)
#pragma unroll
            for (int m = 0; m < 4; ++m) { bf16_t* rowp = O + (size_t)(row0 + ai * HALF + m * 16) * ldc + col0;
#pragma unroll
                for (int bj = 0; bj < 2; ++bj) *(GAS u32x4*)(rowp + bj * HALF) = w[ai][m][bj]; }
    }
};
struct EpiVT {
    static constexpr bool PERM = false; static constexpr int SCW = 0x7A7A7A7A; typedef NoPre Pre;
    __device__ __forceinline__ Pre prefetch(const Unit&, LAS unsigned char*, int, int, int) const { return Pre{}; }
    bf16_t* VT; int col_base;
    __device__ __forceinline__ void operator()(const f32x4 (&acc)[2][2][4][2], const Unit& u, int wr, int wc, int fr, int fq, const Pre&, bool drain) const {
        if (drain) asm volatile("s_waitcnt vmcnt(0)" ::: "memory");
        const int r0 = u.orow0; int b, pos0;
        if (r0 < NLAT) { b = r0 >> 12; pos0 = r0 & 4095; } else { b = (r0 - NLAT) >> 8; pos0 = SEQ + ((r0 - NLAT) & 255); }
        bf16_t* base = VT + ((size_t)b * 512 + (u.ocol0 - col_base) + wc * 32 + fr) * SPB + pos0 + wr * 64 + 4 * fq;
#pragma unroll
        for (int ai = 0; ai < 2; ++ai)
#pragma unroll
            for (int bj = 0; bj < 2; ++bj)
#pragma unroll
                for (int m = 0; m < 4; ++m)
#pragma unroll
                    for (int n = 0; n < 2; ++n) { const f32x4 v = acc[ai][bj][m][n];
                        *(GAS u32x2*)(base + (size_t)(bj * HALF + n * 16) * SPB + ai * HALF + m * 16) = (u32x2){cvt_pk_bf16(v[0], v[1]), cvt_pk_bf16(v[2], v[3])}; }
    }
};
struct EpiY8 {
    static constexpr bool PERM = true; static constexpr int SCW = 0x7A7A7A7A; typedef NoPre Pre;
    __device__ __forceinline__ Pre prefetch(const Unit&, LAS unsigned char*, int, int, int) const { return Pre{}; }
    unsigned char* O; int ldc;
    __device__ __forceinline__ void operator()(const f32x4 (&acc)[2][2][4][2], const Unit& u, int wr, int wc, int fr, int fq, const Pre&, bool drain) const {
        const int row0 = u.orow0 + wr * 64 + fr;
        u32x4 o[2][4];
#pragma unroll
        for (int ai = 0; ai < 2; ++ai)
#pragma unroll
            for (int m = 0; m < 4; ++m) { int w[4];
#pragma unroll
                for (int bj = 0; bj < 2; ++bj) { const f32x4 v0 = acc[ai][bj][m][0], v1 = acc[ai][bj][m][1];
                    int w0 = 0, w1 = 0;
                    w0 = __builtin_amdgcn_cvt_pk_fp8_f32(v0[0], v0[1], w0, false); w0 = __builtin_amdgcn_cvt_pk_fp8_f32(v0[2], v0[3], w0, true);
                    w1 = __builtin_amdgcn_cvt_pk_fp8_f32(v1[0], v1[1], w1, false); w1 = __builtin_amdgcn_cvt_pk_fp8_f32(v1[2], v1[3], w1, true);
                    w[2 * bj] = w0; w[2 * bj + 1] = w1; }
                o[ai][m] = (u32x4){(unsigned)w[0], (unsigned)w[1], (unsigned)w[2], (unsigned)w[3]}; }
        if (drain) asm volatile("s_waitcnt vmcnt(0)" ::: "memory");
#pragma unroll
        for (int ai = 0; ai < 2; ++ai)
#pragma unroll
            for (int m = 0; m < 4; ++m) *(GAS u32x4*)(O + (size_t)(row0 + ai * HALF + m * 16) * ldc + u.ocol0 + wc * 64 + fq * 16) = o[ai][m];
    }
};
struct EpiSwiglu {
    static constexpr bool PERM = true; static constexpr int SCW = 0x7A7A7A7A; typedef NoPre Pre;
    __device__ __forceinline__ Pre prefetch(const Unit&, LAS unsigned char*, int, int, int) const { return Pre{}; }
    unsigned char* ACT;
    __device__ __forceinline__ void operator()(const f32x4 (&acc)[2][2][4][2], const Unit& u, int wr, int wc, int fr, int fq, const Pre&, bool drain) const {
        const int row0 = u.orow0 + wr * 64 + fr, pn = u.ocol0 >> 8;
        u32x2 o[2][4];
#pragma unroll
        for (int ai = 0; ai < 2; ++ai)
#pragma unroll
            for (int m = 0; m < 4; ++m) {
                int w[2];
#pragma unroll
                for (int n = 0; n < 2; ++n) { const f32x4 g = acc[ai][0][m][n], up = acc[ai][1][m][n];
                    f32x4 e;
#pragma unroll
                    for (int i = 0; i < 4; ++i) e[i] = __builtin_amdgcn_exp2f(-g[i]);
                    const f32x4 d = e + 1.0f; f32x4 r;
#pragma unroll
                    for (int i = 0; i < 4; ++i) r[i] = __builtin_amdgcn_rcpf(d[i]);
                    const f32x4 h = (g * up) * r;
                    int v = 0; v = __builtin_amdgcn_cvt_pk_fp8_f32(h[0], h[1], v, false); v = __builtin_amdgcn_cvt_pk_fp8_f32(h[2], h[3], v, true); w[n] = v; }
                o[ai][m] = (u32x2){(unsigned)w[0], (unsigned)w[1]}; }
        if (drain) asm volatile("s_waitcnt vmcnt(0)" ::: "memory");
#pragma unroll
        for (int ai = 0; ai < 2; ++ai)
#pragma unroll
            for (int m = 0; m < 4; ++m) *(GAS u32x2*)(ACT + (size_t)(row0 + ai * HALF + m * 16) * EH + pn * 128 + wc * 32 + 8 * fq) = o[ai][m];
    }
};
constexpr float Y2_SCALE = 8.0f, Y2_INV = 1.0f / 8.0f;
struct EpiScatter {
    static constexpr bool PERM = true; static constexpr int SCW = 0x7D7D7D7D;
    struct Pre { const LAS int* tab; };
    unsigned char* Y2; const int* rowdst;
    __device__ __forceinline__ Pre prefetch(const Unit& u, LAS unsigned char* lds, int wid, int lane, int ui) const {
        LAS unsigned char* tab = lds + STAGE_BYTES + (ui & 1) * 1024;
        if (wid < 4) __builtin_amdgcn_global_load_lds((const unsigned*)(rowdst + u.orow0 + wid * 64 + lane), (LAS unsigned*)(tab + wid * 256), 4, 0, 0);
        Pre p; p.tab = (const LAS int*)tab; return p; }
    __device__ __forceinline__ void operator()(const f32x4 (&acc)[2][2][4][2], const Unit& u, int wr, int wc, int fr, int fq, const Pre& pre, bool drain) const {
        if (u.aux == 128) {
            u32x4 o[2][4];
#pragma unroll
            for (int ai = 0; ai < 2; ++ai)
#pragma unroll
                for (int m = 0; m < 4; ++m) { int w[4];
#pragma unroll
                    for (int bj = 0; bj < 2; ++bj) { const f32x4 v0 = acc[ai][bj][m][0], v1 = acc[ai][bj][m][1];
                        int w0 = 0, w1 = 0;
                        w0 = __builtin_amdgcn_cvt_pk_fp8_f32(v0[0], v0[1], w0, false); w0 = __builtin_amdgcn_cvt_pk_fp8_f32(v0[2], v0[3], w0, true);
                        w1 = __builtin_amdgcn_cvt_pk_fp8_f32(v1[0], v1[1], w1, false); w1 = __builtin_amdgcn_cvt_pk_fp8_f32(v1[2], v1[3], w1, true);
                        w[2 * bj] = w0; w[2 * bj + 1] = w1; }
                    o[ai][m] = (u32x4){(unsigned)w[0], (unsigned)w[1], (unsigned)w[2], (unsigned)w[3]}; }
            if (drain) asm volatile("s_waitcnt vmcnt(0)" ::: "memory");
#pragma unroll
            for (int ai = 0; ai < 2; ++ai)
#pragma unroll
                for (int m = 0; m < 4; ++m) { const int dst = pre.tab[wr * 64 + fr + ai * HALF + m * 16];
                    if (dst >= 0) *(GAS u32x4*)(Y2 + (size_t)dst * 512 + u.ocol0 + wc * 64 + fq * 16) = o[ai][m]; }
        } else {
            u32x2 o[2][4];
#pragma unroll
            for (int ai = 0; ai < 2; ++ai)
#pragma unroll
                for (int m = 0; m < 4; ++m) { unsigned w[2];
#pragma unroll
                    for (int bj = 0; bj < 2; ++bj) { const f32x4 v0 = acc[ai][bj][m][0], v1 = acc[ai][bj][m][1];
                        unsigned x = 0u;
                        x = __builtin_amdgcn_cvt_scalef32_pk_fp4_f32(x, v0[0], v0[1], 1.0f, 0); x = __builtin_amdgcn_cvt_scalef32_pk_fp4_f32(x, v0[2], v0[3], 1.0f, 1);
                        x = __builtin_amdgcn_cvt_scalef32_pk_fp4_f32(x, v1[0], v1[1], 1.0f, 2); x = __builtin_amdgcn_cvt_scalef32_pk_fp4_f32(x, v1[2], v1[3], 1.0f, 3);
                        w[bj] = x; }
                    o[ai][m] = (u32x2){w[0], w[1]}; }
            if (drain) asm volatile("s_waitcnt vmcnt(0)" ::: "memory");
#pragma unroll
            for (int ai = 0; ai < 2; ++ai)
#pragma unroll
                for (int m = 0; m < 4; ++m) { const int dst = pre.tab[wr * 64 + fr + ai * HALF + m * 16];
                    if (dst >= 0) *(GAS u32x2*)(Y2 + (size_t)dst * 512 + (u.ocol0 >> 1) + wc * 32 + fq * 8) = o[ai][m]; }
        }
    }
};

typedef int v8i __attribute__((ext_vector_type(8)));
typedef int v4i __attribute__((ext_vector_type(4)));
struct Frag { bf16x8 p[2]; __device__ __forceinline__ bf16x8& operator[](int k) { return p[k]; } __device__ __forceinline__ const bf16x8& operator[](int k) const { return p[k]; } };
template <class Epi, class Sched, bool GATHER, bool F8 = false, bool ALIGN_EPI = true, bool SP2 = true, bool NHALF = false, bool SWAP = false>
__device__ __forceinline__ void gemm_phase(const int tid_in, LAS unsigned char* lds, const void* Ag, const void* Bg, const int K, const int* rowidx, const Sched& S, const Epi& E) {
    int tid_ = tid_in; asm volatile("" : "+v"(tid_));
    const int tid = tid_, wid = __builtin_amdgcn_readfirstlane(tid >> 6), lane = tid & 63, wr = wid >> 2, wc = wid & 3, fr = lane & 15, fq = lane >> 4;
    const int KB = F8 ? K : 2 * K;
    const int nt = KB / 128;
    unsigned voffB[2];
#pragma unroll
    for (int i = 0; i < 2; ++i) { int R, C; stage_rc(tid * 16 + i * 8192, R, C); const int Rb = Epi::PERM ? ((R & ~31) + perm32(R & 31)) : R;
        voffB[i] = (unsigned)(Rb * KB + C * 2); }
    const size_t kstep = (size_t)128;
    const size_t hstep = (size_t)HALF * KB;
    const unsigned ldsw = (unsigned)wid * 1024u;
    const int aoff = F8 ? lds_byte(wr * 64 + fr, 16 * fq) : lds_byte(wr * 64 + fr, fq * 8), boff = F8 ? lds_byte(wc * 32 + fr, 16 * fq) : lds_byte(wc * 32 + fr, fq * 8);
    constexpr int PIECE1 = F8 ? 16 : 1024;
    const int sc_w = Epi::SCW, sc_a = 0x7F7F7F7F;
#define PG8_SA(b, h) (((b) * 2 + (h)) * HTB)
#define PG8_SB(b, h) ((4 + (b) * 2 + (h)) * HTB)
#define PG8_STAGE_B(bufoff, gbase) do { _Pragma("unroll") for (int _i = 0; _i < 2; ++_i) \
        __builtin_amdgcn_global_load_lds((const unsigned*)((const char*)(gbase) + voffB[_i]), (LAS unsigned*)(lds + (bufoff) + ldsw + _i * 8192), 16, 0, 0); } while (0)
#define PG8_STAGE_A(bufoff, gbase, h) do { const char* _gb = (const char*)(gbase) + (GATHER ? (size_t)0 : (size_t)(h) * hstep); \
        __builtin_amdgcn_global_load_lds((const unsigned*)(_gb + ac[GATHER ? (h) : 0][0]), (LAS unsigned*)(lds + (bufoff) + ldsw), 16, 0, 0); \
        __builtin_amdgcn_global_load_lds((const unsigned*)(_gb + ac[GATHER ? (h) : 0][1]), (LAS unsigned*)(lds + (bufoff) + ldsw + 8192), 16, 0, 0); } while (0)
#define PG8_LDA(dst, b, h) do { _Pragma("unroll") for (int m = 0; m < 4; ++m) { if constexpr (F8) { const v4i _l = *(const LAS v4i*)(lds + PG8_SA(b, h) + aoff + m * 2048), _h = *(const LAS v4i*)(lds + PG8_SA(b, h) + aoff + m * 2048 + PIECE1); dst##8[m] = __builtin_shufflevector(_l, _h, 0, 1, 2, 3, 4, 5, 6, 7); } \
        else { dst[m][0] = *(const LAS bf16x8*)(lds + PG8_SA(b, h) + aoff + m * 2048); dst[m][1] = *(const LAS bf16x8*)(lds + PG8_SA(b, h) + aoff + m * 2048 + PIECE1); } } } while (0)
#define PG8_LDB(dst, b, h) do { _Pragma("unroll") for (int n = 0; n < 2; ++n) { if constexpr (F8) { const v4i _l = *(const LAS v4i*)(lds + PG8_SB(b, h) + boff + n * 2048), _h = *(const LAS v4i*)(lds + PG8_SB(b, h) + boff + n * 2048 + PIECE1); dst##8[n] = __builtin_shufflevector(_l, _h, 0, 1, 2, 3, 4, 5, 6, 7); } \
        else { dst[n][0] = *(const LAS bf16x8*)(lds + PG8_SB(b, h) + boff + n * 2048); dst[n][1] = *(const LAS bf16x8*)(lds + PG8_SB(b, h) + boff + n * 2048 + PIECE1); } } } while (0)
#define PG8_MMA(ai, bj, At, Bt) do { __builtin_amdgcn_s_setprio(1); _Pragma("unroll") for (int m = 0; m < 4; ++m) _Pragma("unroll") for (int n = 0; n < 2; ++n) { \
        if constexpr (F8) asm volatile("v_mfma_scale_f32_16x16x128_f8f6f4 %0, %1, %2, %0, %3, %4 op_sel_hi:[0,0,0]" : "+v"(acc[ai][bj][m][n]) : "v"(Bt##8[n]), "v"(At##8[m]), "v"(sc_w), "v"(sc_a)); \
        else { _Pragma("unroll") for (int k = 0; k < 2; ++k) acc[ai][bj][m][n] = SWAP ? __builtin_amdgcn_mfma_f32_16x16x32_bf16(At[m][k], Bt[n][k], acc[ai][bj][m][n], 0, 0, 0) : __builtin_amdgcn_mfma_f32_16x16x32_bf16(Bt[n][k], At[m][k], acc[ai][bj][m][n], 0, 0, 0); } } \
        __builtin_amdgcn_s_setprio(0); } while (0)
#define PG8_WAIT_V(n) asm volatile("s_waitcnt vmcnt(" #n ")" ::: "memory")
#define PG8_WAIT_LOOP do { if constexpr (NHALF) PG8_WAIT_V(6); else PG8_WAIT_V(8); } while (0)
#define PG8_WAIT_L(n) asm volatile("s_waitcnt lgkmcnt(" #n ")" ::: "memory")
#define PG8_BAR __builtin_amdgcn_s_barrier()
#define PG8_SCHED __builtin_amdgcn_sched_barrier(0)
#define PG8_TAB(par) (lds + STAGE_BYTES + 2048 + (par) * 1024)
#define PG8_TABLOAD(par, row0) do { if (wid < 4) __builtin_amdgcn_global_load_lds((const unsigned*)(rowidx + (row0) + wid * 64 + lane), (LAS unsigned*)(PG8_TAB(par) + wid * 256), 4, 0, 0); } while (0)
#define PG8_AOFF_H(h, par) do { int _tz = tid; asm volatile("" : "+v"(_tz)); _Pragma("unroll") for (int _i = 0; _i < 2; ++_i) { int _R, _C; stage_rc(_tz * 16 + _i * 8192, _R, _C); \
        if (GATHER) ac[h][_i] = ((const LAS unsigned*)PG8_TAB(par))[(h) * HALF + _R] * (unsigned)KB + (unsigned)_C * 2u; \
        else ac[h][_i] = (unsigned)(((h) * HALF + _R) * KB) + (unsigned)_C * 2u; } } while (0)
    static_assert(SP2, "only the two-super-phase K-loop is kept");
    Unit cur, nxt; int ui = 0;
    if (!S.next(0, cur)) return;
    f32x4 acc[2][2][4][2];
#pragma unroll
    for (int a = 0; a < 2; ++a)
#pragma unroll
        for (int b = 0; b < 2; ++b)
#pragma unroll
            for (int m = 0; m < 4; ++m)
#pragma unroll
                for (int n = 0; n < 2; ++n) acc[a][b][m][n] = (f32x4){0.f, 0.f, 0.f, 0.f};
    bf16x8 At[F8 ? 1 : 4][2], B0[F8 ? 1 : 2][2], B1[F8 ? 1 : 2][2];
    v8i At8[F8 ? 4 : 1], B08[F8 ? 2 : 1], B18[F8 ? 2 : 1];
    unsigned ac[GATHER ? 2 : 1][2];
    if (GATHER) { PG8_TABLOAD(0, cur.arow0); PG8_WAIT_V(0); PG8_BAR; }
    PG8_AOFF_H(0, 0); if (GATHER) { PG8_AOFF_H((GATHER ? 1 : 0), 0); }
    const char* cA = (const char*)Ag + (GATHER ? (size_t)0 : (size_t)cur.arow0 * KB); const char* cB = (const char*)Bg + (size_t)cur.brow0 * KB;
    PG8_STAGE_B(PG8_SB(0, 0), cB); if constexpr (!NHALF) PG8_STAGE_B(PG8_SB(0, 1), cB + hstep); PG8_STAGE_A(PG8_SA(0, 0), cA, 0); PG8_STAGE_A(PG8_SA(0, 1), cA, 1);
    if (wr == 1) PG8_BAR;
    PG8_WAIT_V(2); PG8_BAR;
    PG8_STAGE_B(PG8_SB(1, 0), cB + kstep); PG8_STAGE_A(PG8_SA(1, 0), cA + kstep, 0); if constexpr (!NHALF) PG8_STAGE_B(PG8_SB(1, 1), cB + hstep + kstep);
    if constexpr (NHALF) PG8_WAIT_V(4); else PG8_WAIT_V(6);
    PG8_BAR;
    for (;;) {
        const typename Epi::Pre pre = E.prefetch(cur, lds, wid, lane, ui);
        const bool has_next = S.next(ui + 1, nxt);
        if (GATHER) { if (has_next) PG8_TABLOAD((ui + 1) & 1, nxt.arow0); }
        const char* nA = has_next ? ((const char*)Ag + (GATHER ? (size_t)0 : (size_t)nxt.arow0 * KB)) : cA; const char* nB = has_next ? (const char*)Bg + (size_t)nxt.brow0 * KB : cB;
_Pragma("nounroll")
        for (int t = 0; t < nt; t += 2) {
            const bool last = (t == nt - 2);
            const bool skipw = (t == 0) && (ui > 0);
            const char* a1 = cA + (size_t)(t + 1) * kstep;
            const char* a2 = last ? nA : cA + (size_t)(t + 2) * kstep; const char* b2 = last ? nB : cB + (size_t)(t + 2) * kstep;
            const char* a3 = a2 + kstep; const char* b3 = b2 + kstep;
            if (GATHER) { if (last && has_next) { PG8_AOFF_H(0, (ui + 1) & 1); } }
            PG8_LDB(B0, 0, 0); if constexpr (!NHALF) PG8_LDB(B1, 0, 1); PG8_SCHED; PG8_LDA(At, 0, 0); PG8_STAGE_A(PG8_SA(1, 1), a1, 1);
            if (!skipw) PG8_WAIT_LOOP; PG8_WAIT_L(0); PG8_BAR; PG8_MMA(0, 0, At, B0); if constexpr (!NHALF) PG8_MMA(0, 1, At, B1); PG8_BAR; PG8_SCHED;
            if (GATHER) { if (last && has_next) { PG8_AOFF_H(1, (ui + 1) & 1); } }
            PG8_LDA(At, 0, 1); PG8_STAGE_B(PG8_SB(0, 0), b2); if constexpr (!NHALF) PG8_STAGE_B(PG8_SB(0, 1), b2 + hstep); PG8_STAGE_A(PG8_SA(0, 0), a2, 0);
            if (!skipw) PG8_WAIT_LOOP; PG8_WAIT_L(0); PG8_BAR; PG8_MMA(1, 0, At, B0); if constexpr (!NHALF) PG8_MMA(1, 1, At, B1); PG8_BAR; PG8_SCHED;
            PG8_LDB(B0, 1, 0); if constexpr (!NHALF) PG8_LDB(B1, 1, 1); PG8_SCHED; PG8_LDA(At, 1, 0); PG8_STAGE_A(PG8_SA(0, 1), a2, 1);
            if (!skipw) PG8_WAIT_LOOP; PG8_WAIT_L(0); PG8_BAR; PG8_MMA(0, 0, At, B0); if constexpr (!NHALF) PG8_MMA(0, 1, At, B1); PG8_BAR; PG8_SCHED;
            PG8_LDA(At, 1, 1); PG8_STAGE_B(PG8_SB(1, 0), b3); if constexpr (!NHALF) PG8_STAGE_B(PG8_SB(1, 1), b3 + hstep); PG8_STAGE_A(PG8_SA(1, 0), a3, 0);
            PG8_WAIT_LOOP; PG8_WAIT_L(0); PG8_BAR; PG8_MMA(1, 0, At, B0); if constexpr (!NHALF) PG8_MMA(1, 1, At, B1); PG8_BAR; PG8_SCHED;
        }
        if constexpr (ALIGN_EPI) { if (wr == 0) PG8_BAR; }
        E(acc, cur, wr, wc, fr, fq, pre, has_next);
        if (!has_next) break;
#pragma unroll
        for (int a = 0; a < 2; ++a)
#pragma unroll
            for (int b = 0; b < 2; ++b)
#pragma unroll
                for (int m = 0; m < 4; ++m)
#pragma unroll
                    for (int n = 0; n < 2; ++n) acc[a][b][m][n] = (f32x4){0.f, 0.f, 0.f, 0.f};
        cur = nxt; cA = nA; cB = nB; ++ui;
        if constexpr (ALIGN_EPI) { if (wr == 1) PG8_BAR; }
    }
    PG8_WAIT_V(0);
    if constexpr (!ALIGN_EPI) { if (wr == 0) PG8_BAR; }
    PG8_BAR;
#undef PG8_SA
#undef PG8_SB
#undef PG8_STAGE_A
#undef PG8_STAGE_B
#undef PG8_LDA
#undef PG8_LDB
#undef PG8_MMA
#undef PG8_WAIT_V
#undef PG8_WAIT_L
#undef PG8_WAIT_LOOP
#undef PG8_BAR
#undef PG8_SCHED
#undef PG8_AOFF_H
#undef PG8_TAB
#undef PG8_TABLOAD
}
}

constexpr int NWAVES = 8, NTHR = 512;
constexpr size_t MiB = 1u << 20;
constexpr size_t WS_CTL = 0, CTL_BYTES = 1 * MiB;
constexpr size_t WS_MOD = 1 * MiB;
constexpr size_t WS_WIN = 3 * MiB;
constexpr size_t WS_WOUT = 29 * MiB;
constexpr size_t WS_WR = 37 * MiB;
constexpr size_t WS_HYF = 39 * MiB;
constexpr size_t WS_HYFC = 71 * MiB;
constexpr size_t WS_XC = 73 * MiB;
constexpr size_t WS_EXP1 = 89 * MiB;
constexpr size_t WS_EXP2 = 218 * MiB;
constexpr size_t WS_XM = 283 * MiB;
constexpr size_t WS_EIDX = 419 * MiB;
constexpr size_t WS_WGT = 422 * MiB;
constexpr size_t WS_RNK = 425 * MiB;
constexpr size_t WS_ROWTOK = 428 * MiB;
constexpr size_t WS_ROWDST = 431 * MiB;
constexpr size_t WS_TILEEXP = 434 * MiB;
constexpr size_t WS_BIG = 435 * MiB;
constexpr size_t WS_U = WS_BIG;
constexpr size_t WS_MIX = 877 * MiB;
constexpr size_t WS_VT = 1013 * MiB;
constexpr size_t WS_HV = 1081 * MiB;
constexpr size_t WS_Z2 = 1183 * MiB;
constexpr size_t WS_GDS = 1217 * MiB;
constexpr size_t WS_GSIN = 1285 * MiB;
constexpr size_t WS_GD = 1319 * MiB;
constexpr size_t WS_Y = 1321 * MiB;
constexpr size_t WS_LOGIT = WS_BIG;
constexpr size_t WS_ACT = WS_BIG;
constexpr size_t WS_Y2 = 758 * MiB;
constexpr size_t WS_XM8 = 1470 * MiB;
constexpr size_t WS_WRB = 1540 * MiB;
constexpr size_t WS_RBIAS = 1558 * MiB;
constexpr size_t WS_XR = 1600 * MiB;
constexpr size_t WS_END = 1736 * MiB;
constexpr int CW_BAR = 4096;
constexpr int CW_CNT = 16384;
constexpr int CW_NTL = 20480;

constexpr int LDS_BYTES = 163840;
constexpr int MISC_OFF = 163584;

struct Frame {
    LAS unsigned char* lds;
    int tid, lane, wave, G, wg;
    const float* const* in;
    float* out; unsigned char* ws; unsigned* ctl;
};
enum { I_X = 0, I_C, I_CTX, I_CCTX, I_WMOD, I_BMOD, I_WIN, I_RPB, I_WA2, I_BA2, I_GNORM, I_HSW, I_HSB, I_HW1, I_HB1, I_HF1, I_HW2, I_HB2, I_HF2, I_HW3, I_HB3, I_HDEC, I_HSKIP,
       I_WOUT, I_LN1G, I_LN1B, I_RW, I_RB, I_WEG, I_WEU, I_WED, I_WSG, I_WSU, I_WSD, I_LN2G, I_LN2B };

__device__ __forceinline__ int row_b(int row) { return row < NLAT ? (row >> 12) : 16; }
__device__ __forceinline__ const float* mod_ptr(const Frame& F, int l, int row) { return (const float*)(F.ws + WS_MOD) + ((size_t)l * 17 + row_b(row)) * 6144; }

constexpr float NA_QSCALE = 0.125f * 1.4426950408889634f, NA_CLAMP = 60.0f * 1.4426950408889634f;
template <class RowFn>
__device__ __forceinline__ void tr_item(const float* W, int ldw, int k0, int n0, bf16_t* dst, int ldd, RowFn rf, LAS float* scr, int lane, float scale = 1.0f) {
    float tv[32];
    const GAS float* wp = (const GAS float*)(W + (size_t)(k0 + (lane >> 5)) * ldw + n0 + (lane & 31));
#pragma unroll
    for (int i = 0; i < 32; ++i) tv[i] = __builtin_nontemporal_load(wp + (size_t)(2 * i) * ldw);
#pragma unroll
    for (int i = 0; i < 32; ++i) scr[(2 * i + (lane >> 5)) * 33 + (lane & 31)] = tv[i];
    LDS_WAIT(); asm volatile("" ::: "memory");
    const int c = lane & 7;
#pragma unroll
    for (int j = 0; j < 4; ++j) { const int n = (lane >> 3) + 8 * j; const LAS float* s = scr + (8 * c) * 33 + n;
        u32x4 o; o.x = pk2(s[0 * 33] * scale, s[1 * 33] * scale); o.y = pk2(s[2 * 33] * scale, s[3 * 33] * scale); o.z = pk2(s[4 * 33] * scale, s[5 * 33] * scale); o.w = pk2(s[6 * 33] * scale, s[7 * 33] * scale);
        *(GAS u32x4*)(dst + (size_t)rf(n0 + n) * ldd + k0 + 8 * c) = o; }
    LDS_WAIT(); asm volatile("" ::: "memory");
}
template <class RowFn>
__device__ __forceinline__ void tr_item_ks(const float* W, int ldw, int k0, int n0, bf16_t* dst, int ldd, RowFn rf, LAS float* scr, int lane, const float* ksc) {
    float tv[32];
    const GAS float* wp = (const GAS float*)(W + (size_t)(k0 + (lane >> 5)) * ldw + n0 + (lane & 31));
#pragma unroll
    for (int i = 0; i < 32; ++i) tv[i] = wp[(size_t)(2 * i) * ldw];
#pragma unroll
    for (int i = 0; i < 32; ++i) scr[(2 * i + (lane >> 5)) * 33 + (lane & 31)] = tv[i] * (1.0f + ksc[2 * i + (lane >> 5)]);
    LDS_WAIT(); asm volatile("" ::: "memory");
    const int c = lane & 7;
#pragma unroll
    for (int j = 0; j < 4; ++j) { const int n = (lane >> 3) + 8 * j; const LAS float* s = scr + (8 * c) * 33 + n;
        u32x4 o; o.x = pk2(s[0 * 33], s[1 * 33]); o.y = pk2(s[2 * 33], s[3 * 33]); o.z = pk2(s[4 * 33], s[5 * 33]); o.w = pk2(s[6 * 33], s[7 * 33]);
        *(GAS u32x4*)(dst + (size_t)rf(n0 + n) * ldd + k0 + 8 * c) = o; }
    LDS_WAIT(); asm volatile("" ::: "memory");
}
template <class RowFn>
__device__ __forceinline__ void tr_item8(const float* W, int ldw, int k0, int n0, unsigned char* dst, int ldd, RowFn rf, float scale, LAS float* scr, int lane) {
    float tv[32];
    const GAS float* wp = (const GAS float*)(W + (size_t)(k0 + (lane >> 5)) * ldw + n0 + (lane & 31));
#pragma unroll
    for (int i = 0; i < 32; ++i) tv[i] = __builtin_nontemporal_load(wp + (size_t)(2 * i) * ldw);
#pragma unroll
    for (int i = 0; i < 32; ++i) scr[(2 * i + (lane >> 5)) * 33 + (lane & 31)] = tv[i];
    LDS_WAIT(); asm volatile("" ::: "memory");
    const int n = lane >> 1, hf = lane & 1; const LAS float* s = scr + (32 * hf) * 33 + n;
    unsigned w[8];
#pragma unroll
    for (int j = 0; j < 8; ++j) { int v = 0; v = __builtin_amdgcn_cvt_pk_fp8_f32(s[(4 * j) * 33] * scale, s[(4 * j + 1) * 33] * scale, v, false); v = __builtin_amdgcn_cvt_pk_fp8_f32(s[(4 * j + 2) * 33] * scale, s[(4 * j + 3) * 33] * scale, v, true); w[j] = (unsigned)v; }
    unsigned char* d = dst + (size_t)rf(n0 + n) * ldd + k0 + 32 * hf;
    *(GAS u32x4*)d = (u32x4){w[0], w[1], w[2], w[3]}; *(GAS u32x4*)(d + 16) = (u32x4){w[4], w[5], w[6], w[7]};
    LDS_WAIT(); asm volatile("" ::: "memory");
}
struct RowId { __device__ __forceinline__ int operator()(int n) const { return n; } };
struct RowWin { __device__ __forceinline__ int operator()(int n) const { return n >= 2336 ? n - 32 : n; } };
struct RowGU { int up; __device__ __forceinline__ int operator()(int j) const { return (j >> 7) * 256 + up * 128 + (j & 127); } };

__device__ __forceinline__ void p0_static_weights(Frame& F) {
    LAS float* scr = (LAS float*)(F.lds + F.wave * 16384);
    const int gw = F.wg * NWAVES + F.wave, NGW = F.G * NWAVES;
    constexpr int I_IN = 16 * 97, I_OUT = 16 * 32, I_R = 16 * 4, PER_L = I_IN + I_OUT + I_R;
    for (int it = gw; it < DEPTH * PER_L; it += NGW) {
        const int l = it / PER_L; int r = it % PER_L;
        if (r < I_IN) { const int kb = r / 97, nb = r % 97; if (nb == 72) continue;
            tr_item(F.in[I_WIN] + (size_t)l * DM * DIN_REF, DIN_REF, kb * 64, nb * 32, (bf16_t*)(F.ws + WS_WIN) + (size_t)l * DIN * DM, DM, RowWin{}, scr, F.lane, nb < 16 ? NA_QSCALE : 1.0f); continue; }
        r -= I_IN;
        if (r < I_OUT) { const int kb = r / 32, nb = r % 32;
            tr_item(F.in[I_WOUT] + (size_t)l * DM * DM, DM, kb * 64, nb * 32, (bf16_t*)(F.ws + WS_WOUT) + (size_t)l * DM * DM, DM, RowId{}, scr, F.lane); continue; }
        r -= I_OUT;
        { const int kb = r / 4, nb = r % 4;
            tr_item(F.in[I_RW] + (size_t)l * DM * NEXP, NEXP, kb * 64, nb * 32, (bf16_t*)(F.ws + WS_WR) + (size_t)l * 256 * DM, DM, RowId{}, scr, F.lane); }
    }
    const int gt = F.wg * NTHR + F.tid, NGT = F.G * NTHR;
    for (int i = gt; i < DEPTH * 128 * DM / 8; i += NGT) { const int l = i / (128 * DM / 8), r = i % (128 * DM / 8);
        *(u32x4*)((bf16_t*)(F.ws + WS_WR) + ((size_t)l * 256 + 128) * DM + (size_t)r * 8) = (u32x4){0u, 0u, 0u, 0u}; }
    for (int i = gt; i < DEPTH * 256 * DM; i += NGT) {
        const int k = i % DM, n = (i / DM) % 256, l = i / (DM * 256), dir = n >> 7, j = n & 127;
        const float* wi = F.in[I_WIN] + ((size_t)l * DM + k) * DIN_REF + 2304 + dir * 16;
        const float* wa = F.in[I_WA2] + ((size_t)(l * 2 + dir) * 16) * 128 + j;
        float s = 0.f;
#pragma unroll
        for (int r = 0; r < 16; ++r) s += wi[r] * wa[r * 128];
        ((bf16_t*)(F.ws + WS_WIN))[((size_t)l * DIN + 3072 + n) * DM + k] = (bf16_t)f2bf(s);
    }
}
__device__ __forceinline__ void p0_mod(Frame& F) {
    LAS float* sc = (LAS float*)F.lds;
    LAS float* red = (LAS float*)(F.lds + 17 * 1024 * 4);
    for (int i = F.tid; i < 17 * 1024; i += NTHR) { const int r = i >> 10, k = i & 1023; const float v = r < 16 ? F.in[I_C][r * 1024 + k] : F.in[I_CCTX][k]; sc[i] = silu_f(v); }
    __syncthreads();
    const int kq = F.tid >> 7, cl = F.tid & 127;
    for (int u = F.wg; u < DEPTH * 48; u += F.G) {
        const int l = u / 48, col = (u % 48) * 128 + cl;
        const float* w = F.in[I_WMOD] + (size_t)l * DM * 6144 + col;
        float a[17];
#pragma unroll
        for (int r = 0; r < 17; ++r) a[r] = 0.f;
        for (int k0 = kq * 256; k0 < kq * 256 + 256; k0 += 16) {
            float wv[16];
#pragma unroll
            for (int q = 0; q < 16; ++q) wv[q] = *(const GAS float*)(w + (size_t)(k0 + q) * 6144);
#pragma unroll
            for (int q = 0; q < 16; ++q)
#pragma unroll
                for (int r = 0; r < 17; ++r) a[r] += sc[r * 1024 + k0 + q] * wv[q]; }
#pragma unroll
        for (int r = 0; r < 17; ++r) red[(kq * 17 + r) * 128 + cl] = a[r];
        __syncthreads();
        for (int i = F.tid; i < 17 * 128; i += NTHR) { const int r = i >> 7, c2 = i & 127, cc = (u % 48) * 128 + c2;
            const float s = red[(0 * 17 + r) * 128 + c2] + red[(1 * 17 + r) * 128 + c2] + red[(2 * 17 + r) * 128 + c2] + red[(3 * 17 + r) * 128 + c2] + F.in[I_BMOD][l * 6144 + cc];
            ((float*)(F.ws + WS_MOD))[((size_t)l * 17 + r) * 6144 + cc] = s; }
        __syncthreads();
    }
}
__device__ __forceinline__ void p0_hyena_filters(Frame& F) {
    LAS float* z = (LAS float*)F.lds;
    LAS float* h1 = z + 1092;
    LAS float* h2 = h1 + 33 * 64;
    LAS float* tt = h2 + 33 * 64;
    LAS float* W1 = tt + 64;
    LAS float* W2 = W1 + 33 * 64;
    constexpr int UL = 4096 / 32, UC = 256 / 32, UPL = UL + UC;
    for (int k = 0; ; ++k) {
        int u;
        if (F.G == 256) { if (k < 2) u = F.wg + k * 256; else if (k == 2 && F.wg >= 192 && F.wg < 192 + (DEPTH * UPL - 512)) u = 512 + (F.wg - 192); else break; }
        else { u = F.wg + k * F.G; if (u >= DEPTH * UPL) break; }
        const int l = u / UPL, r = u % UPL; const bool lat = r < UL; const int L = lat ? 4096 : 256, n0 = (lat ? r : r - UL) * 32;
        __syncthreads();
        for (int i = F.tid; i < 33 * 64; i += NTHR) W1[i] = F.in[I_HW1][(size_t)l * 33 * 64 + i];
        for (int i = F.tid; i < 64 * 64; i += NTHR) W2[i] = F.in[I_HW2][(size_t)l * 64 * 64 + i];
        for (int i = F.tid; i < 33 * 33; i += NTHR) { const int p = i / 33, e = i % 33, n = n0 + p;
            const float t = (float)n / (float)(L - 1);
            float v;
            if (e == 0) v = t;
            else { const int kb = (e - 1) & 15; const float band = 1e-4f + (float)kb * ((15.0f - 1e-4f) / 15.0f);
                   const float w = 6.283185307179586f * (float)n / (float)L; const float ang = w * band;
                   v = e <= 16 ? __cosf(ang) : -__sinf(ang); }
            z[i] = v; if (e == 0) tt[p] = t; }
        __syncthreads();
        for (int i = F.tid; i < 33 * 64; i += NTHR) { const int p = i >> 6, j = i & 63; float s = F.in[I_HB1][l * 64 + j];
#pragma unroll 11
            for (int e = 0; e < 33; ++e) s += z[p * 33 + e] * W1[e * 64 + j];
            h1[i] = __sinf(F.in[I_HF1][l * 64 + j] * s); }
        __syncthreads();
        for (int i = F.tid; i < 33 * 64; i += NTHR) { const int p = i >> 6, j = i & 63; float s = F.in[I_HB2][l * 64 + j];
#pragma unroll 16
            for (int e = 0; e < 64; ++e) s += h1[p * 64 + e] * W2[e * 64 + j];
            h2[i] = __sinf(F.in[I_HF2][l * 64 + j] * s); }
        __syncthreads();
        {
            const int g = F.tid >> 8, col0 = 4 * (F.tid & 255), o = col0 >> 9, dir = (col0 >> 8) & 1, ch0 = col0 & 255;
            const int pb = (dir ? 0 : 1) + 16 * g;
            float a[4][16];
#pragma unroll
            for (int j = 0; j < 4; ++j)
#pragma unroll
                for (int q = 0; q < 16; ++q) a[j][q] = 0.f;
            const float* w3 = F.in[I_HW3] + (size_t)l * 64 * 1024 + col0;
            const LAS float* hp = h2 + pb * 64;
            f32x4 wa[4], wb[4];
#pragma unroll
            for (int q = 0; q < 4; ++q) wa[q] = *(const GAS f32x4*)(w3 + (size_t)q * 1024);
#define HF_BLOCK(wv_, k0_) do { _Pragma("unroll") for (int pi = 0; pi < 16; ++pi) { const f32x4 hv = *(const LAS f32x4*)(hp + pi * 64 + (k0_)); \
                _Pragma("unroll") for (int q = 0; q < 4; ++q) _Pragma("unroll") for (int j = 0; j < 4; ++j) a[j][pi] += hv[q] * wv_[q][j]; } } while (0)
#pragma unroll 1
            for (int k0 = 0; k0 < 64; k0 += 8) {
#pragma unroll
                for (int q = 0; q < 4; ++q) wb[q] = *(const GAS f32x4*)(w3 + (size_t)(k0 + 4 + q) * 1024);
                __builtin_amdgcn_sched_barrier(0);
                HF_BLOCK(wa, k0);
                __builtin_amdgcn_sched_barrier(0);
                { const int kn = k0 + 8 < 64 ? k0 + 8 : k0;
#pragma unroll
                  for (int q = 0; q < 4; ++q) wa[q] = *(const GAS f32x4*)(w3 + (size_t)(kn + q) * 1024); }
                __builtin_amdgcn_sched_barrier(0);
                HF_BLOCK(wb, k0 + 4);
                __builtin_amdgcn_sched_barrier(0);
            }
#undef HF_BLOCK
            const f32x4 b3 = *(const GAS f32x4*)(F.in[I_HB3] + l * 1024 + col0), dc = *(const GAS f32x4*)(F.in[I_HDEC] + ((size_t)(l * 2 + o) * 2 + dir) * 256 + ch0);
            float a0[4] = {0.f, 0.f, 0.f, 0.f};
            if (n0 == 0 && dir == 0 && g == 0) {
                for (int k = 0; k < 64; ++k) { const f32x4 wv = *(const GAS f32x4*)(w3 + (size_t)k * 1024); const float hv = h2[k];
#pragma unroll
                    for (int j = 0; j < 4; ++j) a0[j] += hv * wv[j]; } }
#pragma unroll
            for (int j = 0; j < 4; ++j) {
                const float dec = fabsf(dc[j]);
                bf16_t* R = lat ? (bf16_t*)(F.ws + WS_HYF) + ((size_t)(l * 2 + o) * 256 + ch0 + j) * 8192 : (bf16_t*)(F.ws + WS_HYFC) + ((size_t)(l * 2 + o) * 256 + ch0 + j) * 512;
                float v[16];
#pragma unroll
                for (int pi = 0; pi < 16; ++pi) v[pi] = (a[j][pi] + b3[j]) * __expf(-tt[pb + pi] * dec);
                unsigned w[8];
                if (dir == 0) {
                    if (n0 + 32 == L && g == 1) v[15] = 0.f;
#pragma unroll
                    for (int q = 0; q < 8; ++q) w[q] = pk2(v[15 - 2 * q], v[14 - 2 * q]);
                    GAS u32x4* dst = (GAS u32x4*)(R + (L - n0 - 32) + 16 * (1 - g));
                    dst[0] = (u32x4){w[0], w[1], w[2], w[3]}; dst[1] = (u32x4){w[4], w[5], w[6], w[7]};
                    if (n0 == 0 && g == 0) R[L] = (bf16_t)f2bf((a0[j] + b3[j]) * __expf(-tt[0] * dec) + F.in[I_HSKIP][(l * 2 + o) * 256 + ch0 + j]);
                } else if (n0 > 0 || g == 1) {
#pragma unroll
                    for (int q = 0; q < 8; ++q) w[q] = pk2(v[2 * q], v[2 * q + 1]);
                    GAS u32x4* dst = (GAS u32x4*)(R + (L + n0) + 16 * g);
                    dst[0] = (u32x4){w[0], w[1], w[2], w[3]}; dst[1] = (u32x4){w[4], w[5], w[6], w[7]};
                } else {
#pragma unroll
                    for (int pi = 1; pi < 16; ++pi) R[L + pi] = (bf16_t)f2bf(v[pi]);
                }
            }
        }
    }
    __syncthreads();
}
__device__ __forceinline__ void p0_init_rows(Frame& F) {
    const int gw = F.wg * NWAVES + F.wave, NGW = F.G * NWAVES;
    for (int row = gw; row < NROW; row += NGW) {
        const float* src = row < NLAT ? F.in[I_X] + (size_t)row * DM : F.in[I_CTX] + (size_t)(row - NLAT) * DM;
        const float* md = mod_ptr(F, 0, row);
        bf16_t* xr = (bf16_t*)(F.ws + WS_XR) + (size_t)row * DM; bf16_t* xm = (bf16_t*)(F.ws + WS_XM) + (size_t)row * DM;
#pragma unroll
        for (int j = 0; j < 4; ++j) { const int c = 4 * F.lane + 256 * j;
            const f32x4 v = __builtin_nontemporal_load((const GAS f32x4*)(src + c)), sh = *(const GAS f32x4*)(md + c), sc = *(const GAS f32x4*)(md + 1024 + c);
            *(GAS u32x2*)(xr + c) = (u32x2){pk2(v[0], v[1]), pk2(v[2], v[3])};
            u32x2 w; w.x = pk2(v[0] * (1.f + sc[0]) + sh[0], v[1] * (1.f + sc[1]) + sh[1]); w.y = pk2(v[2] * (1.f + sc[2]) + sh[2], v[3] * (1.f + sc[3]) + sh[3]);
            *(GAS u32x2*)(xm + c) = w; }
    }
}
__device__ __forceinline__ void p1_router_weights(Frame& F) {
    LAS float* scr = (LAS float*)(F.lds + F.wave * 16384);
    const int gw = F.wg * NWAVES + F.wave, NGW = F.G * NWAVES;
    const float* MOD = (const float*)(F.ws + WS_MOD);
    for (int it = gw; it < DEPTH * 17 * 64; it += NGW) {
        const int lb = it >> 6, l = lb / 17, kb = (it & 63) >> 2, nb = it & 3;
        tr_item_ks(F.in[I_RW] + (size_t)l * DM * NEXP, NEXP, kb * 64, nb * 32, (bf16_t*)(F.ws + WS_WRB) + (size_t)lb * 128 * DM, DM, RowId{}, scr, F.lane, MOD + (size_t)lb * 6144 + 4096 + kb * 64); }
    for (int it = gw; it < DEPTH * 17 * 8; it += NGW) {
        const int lb = it >> 3, l = lb / 17, n = (it & 7) * 16 + (F.lane & 15), kq = F.lane >> 4;
        const float* sh = MOD + (size_t)lb * 6144 + 3072 + kq * 256; const float* w = F.in[I_RW] + (size_t)l * DM * NEXP + (size_t)(kq * 256) * NEXP + n;
        float a = 0.f;
#pragma unroll 8
        for (int k = 0; k < 256; ++k) a += sh[k] * w[(size_t)k * NEXP];
        a += shx(a, 16, F.lane); a += shx(a, 32, F.lane);
        if (kq == 0) ((float*)(F.ws + WS_RBIAS))[(size_t)lb * 128 + n] = a; }
}
constexpr float WEXP_SCALE = 32.0f;
constexpr int XW_ITEMS = NE1 * 384, XW_TAIL_E = 12288, XW_TAIL_G = 12288 + 7680;
__device__ __forceinline__ void p_expert_weights(Frame& F, int l, int it0, int it1, int nw, int w) {
    LAS float* scr = (LAS float*)(F.lds + F.wave * 16384);
    constexpr int I1 = 16 * 8, I2 = 4 * 32, PER_E = 2 * I1 + I2;
    for (int it = it0 + w; it < it1; it += nw) {
        const int e = it / PER_E; int r = it % PER_E;
        unsigned char* d1 = (unsigned char*)(F.ws + WS_EXP1) + (size_t)e * 512 * DM; unsigned char* d2 = (unsigned char*)(F.ws + WS_EXP2) + (size_t)e * DM * EH;
        if (r < 2 * I1) { const int up = r >= I1; if (up) r -= I1; const int kb = r / 8, nb = r % 8;
            const float* src = e < NEXP ? F.in[up ? I_WEU : I_WEG] + ((size_t)l * NEXP + e) * DM * EH : F.in[up ? I_WSU : I_WSG] + (size_t)l * DM * EH;
            tr_item8(src, EH, kb * 64, nb * 32, d1, DM, RowGU{up}, up ? WEXP_SCALE * 0.6931471805599453f : WEXP_SCALE * 1.4426950408889634f, scr, F.lane); }
        else { r -= 2 * I1; const int kb = r / 32, nb = r % 32;
            const float* src = e < NEXP ? F.in[I_WED] + ((size_t)l * NEXP + e) * EH * DM : F.in[I_WSD] + (size_t)l * EH * DM;
            tr_item8(src, DM, kb * 64, nb * 32, d2, EH, RowId{}, WEXP_SCALE, scr, F.lane); }
    }
}

__device__ __forceinline__ f32x4 mfma16(bf16x8 a, bf16x8 b, f32x4 c) { return __builtin_amdgcn_mfma_f32_16x16x32_bf16(a, b, c, 0, 0, 0); }

__device__ __forceinline__ void ph_transposes(Frame& F, int l) {
    LAS bf16_t* tile = (LAS bf16_t*)(F.lds + F.wave * 16384);
    const bf16_t* U = (const bf16_t*)(F.ws + WS_U);
    const int gw = F.wg * NWAVES + F.wave, NGW = F.G * NWAVES;
    const int rsub = F.lane >> 3, cseg = F.lane & 7;
    for (int u = gw; u < 1088 * 12; u += NGW) {
        const int tt = u / 12, blk = u % 12;
        int b, s0, Ls, rowbase, posbase;
        if (tt < 1024) { b = tt >> 6; s0 = (tt & 63) * 64; Ls = SEQ; rowbase = b * SEQ; posbase = 0; }
        else { const int t2 = tt - 1024; b = t2 >> 2; s0 = (t2 & 3) * 64; Ls = CTXL; rowbase = NLAT + b * CTXL; posbase = SEQ; }
        if (blk < 12) {
            constexpr int HT = 80;
            float w0[8], w1[8], w2[8], bb[8];
#pragma unroll
            for (int it = 0; it < 8; ++it) { const int col = blk * 64 + rsub + 8 * it; w0[it] = F.in[I_HSW][(l * 3 + 0) * 768 + col]; w1[it] = F.in[I_HSW][(l * 3 + 1) * 768 + col]; w2[it] = F.in[I_HSW][(l * 3 + 2) * 768 + col]; bb[it] = F.in[I_HSB][l * 768 + col]; }
            const bf16_t* p0 = U + (size_t)(rowbase + s0 + rsub) * DIN + UHY + blk * 64 + cseg * 8;
            u32x4 zc[8];
#pragma unroll
            for (int it = 0; it < 8; ++it) zc[it] = *(const GAS u32x4*)(p0 + (size_t)(8 * it) * DIN);
            u32x4 zh = (u32x4){0u, 0u, 0u, 0u};
            if (F.lane < 16) { const int hs = F.lane < 8 ? s0 - 1 : s0 + 64; if (hs >= 0 && hs < Ls) zh = *(const GAS u32x4*)(U + (size_t)(rowbase + hs) * DIN + UHY + blk * 64 + cseg * 8); }
#pragma unroll
            for (int it = 0; it < 8; ++it) { const unsigned a[4] = {zc[it].x, zc[it].y, zc[it].z, zc[it].w}; LAS bf16_t* d = tile + (cseg * 8) * HT + 8 + rsub + 8 * it;
#pragma unroll
                for (int i = 0; i < 4; ++i) { d[(2 * i) * HT] = (bf16_t)(a[i] & 0xffffu); d[(2 * i + 1) * HT] = (bf16_t)(a[i] >> 16); } }
            if (F.lane < 16) { const unsigned a[4] = {zh.x, zh.y, zh.z, zh.w}; LAS bf16_t* d = tile + (cseg * 8) * HT + (F.lane < 8 ? 7 : 72);
#pragma unroll
                for (int i = 0; i < 4; ++i) { d[(2 * i) * HT] = (bf16_t)(a[i] & 0xffffu); d[(2 * i + 1) * HT] = (bf16_t)(a[i] >> 16); } }
            LDS_WAIT(); asm volatile("" ::: "memory");
#pragma unroll
            for (int it = 0; it < 8; ++it) {
                const int ch = rsub + 8 * it; const LAS bf16_t* r = tile + ch * HT + 8 + cseg * 8;
                const u32x4 v = *(const LAS u32x4*)r; const unsigned hm = r[-1], hp = r[8];
                float x[10]; x[0] = __builtin_bit_cast(float, hm << 16); x[9] = __builtin_bit_cast(float, hp << 16);
                x[1] = bflo(v.x); x[2] = bfhi(v.x); x[3] = bflo(v.y); x[4] = bfhi(v.y); x[5] = bflo(v.z); x[6] = bfhi(v.z); x[7] = bflo(v.w); x[8] = bfhi(v.w);
                unsigned w[4];
#pragma unroll
                for (int i = 0; i < 4; ++i) w[i] = pk2(bb[it] + w0[it] * x[2 * i] + w1[it] * x[2 * i + 1] + w2[it] * x[2 * i + 2], bb[it] + w0[it] * x[2 * i + 1] + w1[it] * x[2 * i + 2] + w2[it] * x[2 * i + 3]);
                *(GAS u32x4*)((bf16_t*)(F.ws + WS_HV) + ((size_t)(blk * 64 + ch) * NB + b) * SPB + posbase + s0 + cseg * 8) = (u32x4){w[0], w[1], w[2], w[3]};
            }
            LDS_WAIT(); asm volatile("" ::: "memory");
            continue;
        } else {
            const int c0 = (blk - 12) * 64 + cseg * 8;
#pragma unroll
            for (int it = 0; it < 8; ++it) {
                const int sl = rsub + 8 * it, s = s0 + sl;
                const u32x4 zc = *(const GAS u32x4*)(U + (size_t)(rowbase + s) * DIN + UV + c0);
                const unsigned ac[4] = {zc.x, zc.y, zc.z, zc.w};
#pragma unroll
                for (int i = 0; i < 4; ++i) { tile[(cseg * 8 + 2 * i) * 72 + sl] = (bf16_t)(ac[i] & 0xffffu); tile[(cseg * 8 + 2 * i + 1) * 72 + sl] = (bf16_t)(ac[i] >> 16); }
            }
        }
        LDS_WAIT(); asm volatile("" ::: "memory");
#pragma unroll 2
        for (int it = 0; it < 8; ++it) {
            const int ch = rsub + 8 * it;
            const u32x4 v = *(const LAS u32x4*)(tile + ch * 72 + cseg * 8);
            bf16_t* dst;
            if (blk < 12) dst = (bf16_t*)(F.ws + WS_HV) + ((size_t)(blk * 64 + ch) * NB + b) * SPB + posbase + s0 + cseg * 8;
            else dst = (bf16_t*)(F.ws + WS_VT) + ((size_t)b * 512 + (blk - 12) * 64 + ch) * SPB + posbase + s0 + cseg * 8;
            *(GAS u32x4*)dst = v;
        }
        LDS_WAIT(); asm volatile("" ::: "memory");
    }
}

constexpr int NA_RPB = 0, NA_KC = 2048, NA_VC = NA_KC + 256 * 144, NA_KR = NA_VC + 64 * 528, NA_END = NA_KR + 9 * 64 * 144;
static_assert(NA_END <= MISC_OFF, "NA LDS map");
__device__ __forceinline__ bf16x8 gld16(const bf16_t* p) { return *(const GAS bf16x8*)p; }
__device__ __forceinline__ u32x2 gld8(const bf16_t* p) { return *(const GAS u32x2*)p; }
__device__ __forceinline__ const char* uni_ptr(const char* p) { const unsigned long long v = (unsigned long long)p; const unsigned lo = __builtin_amdgcn_readfirstlane((unsigned)v), hi = __builtin_amdgcn_readfirstlane((unsigned)(v >> 32)); return (const char*)(((unsigned long long)hi << 32) | lo); }
__device__ __forceinline__ bf16x8 gld16o(const char* ub, unsigned lo) { return *(const GAS bf16x8*)(ub + (size_t)lo); }
__device__ __forceinline__ u32x2 gld8o(const char* ub, unsigned lo) { return *(const GAS u32x2*)(ub + (size_t)lo); }
template <bool WIN>
__device__ __forceinline__ void na_unit(Frame& F, int b, int h, int r, int strip) {
    const bf16_t* U = (const bf16_t*)(F.ws + WS_U);
    const bf16_t* VT = (const bf16_t*)(F.ws + WS_VT) + ((size_t)b * 512 + h * 64) * SPB;
    const LAS float* rpb = (const LAS float*)(F.lds + NA_RPB);
    const LAS bf16_t* KC = (const LAS bf16_t*)(F.lds + NA_KC); const LAS bf16_t* VC = (const LAS bf16_t*)(F.lds + NA_VC);
    int ln_ = F.lane; asm volatile("" : "+v"(ln_));
    const int i = ln_ & 15, g = ln_ >> 4;
    const int qrow0 = WIN ? (b * SEQ + r * 64 + strip * 16) : (NLAT + b * CTXL + strip * 16);
    const int ki = 8 * (i >> 2) + (i & 3);
    const unsigned qlo = (unsigned)((i * DIN + 8 * g) * 2), klo = (unsigned)((ki * DIN + 8 * g) * 2), vlo = (unsigned)((i * SPB + 8 * g) * 2);
    const char* qb = uni_ptr((const char*)(U + (size_t)qrow0 * DIN + UQ + h * 64));
    const bf16x8 q0 = gld16o(qb, qlo), q1 = gld16o(qb + 64, qlo);
    int kr0 = 0, u0 = 0;
    if (WIN) { kr0 = r - 4; kr0 = kr0 < 0 ? 0 : (kr0 > 56 ? 56 : kr0); u0 = strip == 0 ? 0 : (strip == 1 ? 8 : (strip == 2 ? 24 : 32)); }
    const LAS bf16_t* KR = (const LAS bf16_t*)(F.lds + NA_KR);
    const char* vbase = uni_ptr((const char*)(VT + kr0 * 64 + u0));
    f32x4 o[4];
#pragma unroll
    for (int d = 0; d < 4; ++d) o[d] = (f32x4){0.f, 0.f, 0.f, 0.f};
    float lsum = 0.f;
#define NA_SB() __builtin_amdgcn_sched_barrier(0)
#define NA_WLOAD(vb_, cw) do { _Pragma("unroll") for (int d = 0; d < 4; ++d) vb_[d] = gld16o(vbase + ((size_t)(d * 16) * SPB + (cw) * 64) * 2, vlo); } while (0)
#define NA_KRING(kb_, cw) do { const LAS bf16_t* kp = KR + ((((kr0 + (cw)) % 9) * 64 + u0 + ki) * 72 + 8 * g); kb_[0][0] = *(const LAS bf16x8*)kp; kb_[0][1] = *(const LAS bf16x8*)(kp + 32); \
        kb_[1][0] = *(const LAS bf16x8*)(kp + 4 * 72); kb_[1][1] = *(const LAS bf16x8*)(kp + 4 * 72 + 32); } while (0)
#define NA_QK(kb_, s_) do { _Pragma("unroll") for (int t = 0; t < 2; ++t) { f32x4 a = (f32x4){0.f, 0.f, 0.f, 0.f}; a = mfma16(kb_[t][0], q0, a); a = mfma16(kb_[t][1], q1, a); s_[t] = a; } } while (0)
#define NA_PV(s_, vb_) do { u32x4 pw; pw.x = pk2(s_[0][0], s_[0][1]); pw.y = pk2(s_[0][2], s_[0][3]); pw.z = pk2(s_[1][0], s_[1][1]); pw.w = pk2(s_[1][2], s_[1][3]); const bf16x8 pf = __builtin_bit_cast(bf16x8, pw); \
        _Pragma("unroll") for (int d = 0; d < 4; ++d) o[d] = mfma16(vb_[d], pf, o[d]); } while (0)
    bf16x8 vA[4], vB[4], vC[4];
    if (WIN) { NA_WLOAD(vA, 0); NA_WLOAD(vB, 1); NA_WLOAD(vC, 2); NA_SB(); }
#pragma unroll
    for (int cc = 0; cc < 8; ++cc) {
        bf16x8 kc[2][2], vc[4]; f32x4 sc[2];
#pragma unroll
        for (int t = 0; t < 2; ++t) { const LAS bf16_t* kp = KC + (cc * 32 + ki + 4 * t) * 72 + 8 * g; kc[t][0] = *(const LAS bf16x8*)kp; kc[t][1] = *(const LAS bf16x8*)(kp + 32); }
#pragma unroll
        for (int d = 0; d < 4; ++d) vc[d] = *(const LAS bf16x8*)(VC + (d * 16 + i) * 264 + cc * 32 + 8 * g);
        NA_QK(kc, sc);
#pragma unroll
        for (int t = 0; t < 2; ++t)
#pragma unroll
            for (int e = 0; e < 4; ++e) { const float p = __builtin_amdgcn_exp2f(fminf(sc[t][e], NA_CLAMP)); sc[t][e] = p; lsum += p; }
        NA_PV(sc, vc);
    }
    if (WIN) {
        const int c = strip * 16 + i; int kc0 = c - 8; kc0 = kc0 < 0 ? 0 : (kc0 > 48 ? 48 : kc0);
        int dcl[2][4]; bool okm[2][4];
#pragma unroll
        for (int t = 0; t < 2; ++t)
#pragma unroll
            for (int e = 0; e < 4; ++e) { const int kc = u0 + 8 * g + 4 * t + e; okm[t][e] = (kc >= kc0) && (kc < kc0 + 16); int dc = kc - c + 15; dcl[t][e] = okm[t][e] ? (dc < 0 ? 0 : (dc > 30 ? 30 : dc)) : 31; }
#define NA_WCHUNK(vb_, cw) do { bf16x8 kw[2][2]; NA_KRING(kw, cw); f32x4 sw[2]; NA_QK(kw, sw); const LAS float* rp = rpb + (kr0 + (cw) - r + 7) * 32; \
        _Pragma("unroll") for (int t = 0; t < 2; ++t) _Pragma("unroll") for (int e = 0; e < 4; ++e) { const float x = sw[t][e] + rp[dcl[t][e]]; const float p = __builtin_amdgcn_exp2f(fminf(x, NA_CLAMP)); sw[t][e] = p; lsum += p; } \
        NA_PV(sw, vb_); } while (0)
        NA_WCHUNK(vA, 0); NA_SB(); NA_WLOAD(vA, 3); NA_SB();
        NA_WCHUNK(vB, 1); NA_SB(); NA_WLOAD(vB, 4); NA_SB();
        NA_WCHUNK(vC, 2); NA_SB(); NA_WLOAD(vC, 5); NA_SB();
        NA_WCHUNK(vA, 3); NA_SB(); NA_WLOAD(vA, 6); NA_SB();
        NA_WCHUNK(vB, 4); NA_SB(); NA_WLOAD(vB, 7); NA_SB();
        NA_WCHUNK(vC, 5); NA_SB();
        NA_WCHUNK(vA, 6); NA_SB();
        NA_WCHUNK(vB, 7); NA_SB();
#undef NA_WCHUNK
    }
    lsum += shx(lsum, 16, ln_); lsum += shx(lsum, 32, ln_);
    const float inv = 1.0f / lsum;
    char* op = (char*)uni_ptr((const char*)((bf16_t*)(F.ws + WS_MIX) + (size_t)qrow0 * DM + h * 64)); const unsigned olo = (unsigned)((i * DM + 4 * g) * 2);
#pragma unroll
    for (int d = 0; d < 4; ++d) { u32x2 w; w.x = pk2(o[d][0] * inv, o[d][1] * inv); w.y = pk2(o[d][2] * inv, o[d][3] * inv); *(GAS u32x2*)(op + d * 32 + (size_t)olo) = w; }
#undef NA_SB
#undef NA_WLOAD
#undef NA_KRING
#undef NA_QK
#undef NA_PV
}
__device__ __forceinline__ int na_kr0(int r) { const int k = r - 4; return k < 0 ? 0 : (k > 56 ? 56 : k); }
__device__ __forceinline__ void ph_na(Frame& F, int l, bool last) {
    const bf16_t* U = (const bf16_t*)(F.ws + WS_U);
    for (int job = F.wg; job < NB * 8 * 2; job += F.G) {
        const int half = job & 1, h = (job >> 1) & 7, b = job >> 4;
        int tz_; asm volatile("v_mbcnt_lo_u32_b32 %0, -1, 0\n\tv_mbcnt_hi_u32_b32 %0, -1, %0" : "=v"(tz_)); tz_ |= F.wave << 6;
        const bf16_t* krow = U + (size_t)(b * SEQ + (tz_ >> 3)) * DIN + UK + h * 64 + (tz_ & 7) * 8;
        LAS bf16_t* kdst = (LAS bf16_t*)(F.lds + NA_KR) + (tz_ >> 3) * 72 + (tz_ & 7) * 8;
        __syncthreads();
        { LAS float* rpb = (LAS float*)(F.lds + NA_RPB); const float* rsrc = F.in[I_RPB] + ((size_t)l * 8 + h) * 15 * 31;
          if (tz_ < 15 * 32) rpb[tz_] = (tz_ & 31) < 31 ? rsrc[(tz_ >> 5) * 31 + (tz_ & 31)] * 1.4426950408889634f : -1e30f;
          const int key = tz_ >> 1, hf = tz_ & 1; const bf16_t* src = U + (size_t)(NLAT + b * CTXL + key) * DIN + UK + h * 64 + hf * 32; LAS bf16_t* dst = (LAS bf16_t*)(F.lds + NA_KC) + key * 72 + hf * 32;
#pragma unroll
          for (int j = 0; j < 4; ++j) *(LAS bf16x8*)(dst + j * 8) = gld16(src + j * 8);
          const int dv = tz_ >> 3, seg = tz_ & 7; const bf16_t* vs = (const bf16_t*)(F.ws + WS_VT) + ((size_t)b * 512 + h * 64 + dv) * SPB + SEQ + seg * 32; LAS bf16_t* vd = (LAS bf16_t*)(F.lds + NA_VC) + dv * 264 + seg * 32;
#pragma unroll
          for (int j = 0; j < 4; ++j) *(LAS bf16x8*)(vd + j * 8) = gld16(vs + j * 8);
          const int lo = na_kr0(half * 32), hi0 = na_kr0(half * 32 + 1) + 7;
          for (int kr = lo; kr <= hi0; ++kr) *(LAS bf16x8*)(kdst + (kr % 9) * 64 * 72) = gld16(krow + (size_t)kr * 64 * DIN); }
        __syncthreads();
        int prev_hi = na_kr0(half * 32 + 1) + 7;
#pragma unroll 1
        for (int s = 0; s < 16; ++s) {
            const int r0 = half * 32 + 2 * s;
            const int nhi = s < 15 ? na_kr0(r0 + 3) + 7 : prev_hi;
            bf16x8 n0 = (bf16x8){0, 0, 0, 0, 0, 0, 0, 0}, n1 = n0;
            if (nhi > prev_hi) n0 = gld16(krow + (size_t)(prev_hi + 1) * 64 * DIN);
            if (nhi > prev_hi + 1) n1 = gld16(krow + (size_t)(prev_hi + 2) * 64 * DIN);
            na_unit<true>(F, b, h, r0 + (F.wave >> 2), F.wave & 3);
            __syncthreads();
            if (nhi > prev_hi) *(LAS bf16x8*)(kdst + ((prev_hi + 1) % 9) * 64 * 72) = n0;
            if (nhi > prev_hi + 1) *(LAS bf16x8*)(kdst + ((prev_hi + 2) % 9) * 64 * 72) = n1;
            __syncthreads();
            prev_hi = nhi;
        }
        if (!last) na_unit<false>(F, b, h, 0, half * 8 + F.wave);
    }
}

__device__ __forceinline__ void ph_hy_transpose(Frame& F, bool last) {
    LAS bf16_t* tile = (LAS bf16_t*)(F.lds + F.wave * 16384);
    const bf16_t* HYO = (const bf16_t*)(F.ws + WS_Y);
    const int gw = F.wg * NWAVES + F.wave, NGW = F.G * NWAVES;
    const int rsub = F.lane >> 3, cseg = F.lane & 7;
    const int ntt = last ? 1024 : 1088;
    for (int u = gw; u < ntt * 4; u += NGW) {
        const int tt = u >> 2, cb = u & 3;
        int b, s0, rowbase, posbase;
        if (tt < 1024) { b = tt >> 6; s0 = (tt & 63) * 64; rowbase = b * SEQ; posbase = 0; }
        else { const int t2 = tt - 1024; b = t2 >> 2; s0 = (t2 & 3) * 64; rowbase = NLAT + b * CTXL; posbase = SEQ; }
#pragma unroll 2
        for (int it = 0; it < 8; ++it) { const int c = rsub + 8 * it;
            const u32x4 v = *(const GAS u32x4*)(HYO + ((size_t)(cb * 64 + c) * NB + b) * SPB + posbase + s0 + cseg * 8); const unsigned a[4] = {v.x, v.y, v.z, v.w};
#pragma unroll
            for (int e = 0; e < 4; ++e) { tile[(cseg * 8 + 2 * e) * 72 + c] = (bf16_t)(a[e] & 0xffffu); tile[(cseg * 8 + 2 * e + 1) * 72 + c] = (bf16_t)(a[e] >> 16); } }
        LDS_WAIT(); asm volatile("" ::: "memory");
#pragma unroll 2
        for (int it = 0; it < 8; ++it) { const int p = rsub + 8 * it;
            const u32x4 v = *(const LAS u32x4*)(tile + p * 72 + cseg * 8);
            *(GAS u32x4*)((bf16_t*)(F.ws + WS_MIX) + (size_t)(rowbase + s0 + p) * DM + 768 + cb * 64 + cseg * 8) = v; }
        LDS_WAIT(); asm volatile("" ::: "memory");
    }
}

constexpr int G2_LAF = 0, G2_LAB = 8448;
constexpr int G2_QTF = 16896, G2_KTF = 22016, G2_QTB = 27136, G2_KTB = 32256;
constexpr int G2_VT = 37376, G2_ATT = 46592;
constexpr int G2_SF = 55808, G2_SB = 60928;
constexpr int G2_SEG = 66048, G2_HALF = 67328;
__device__ __forceinline__ float log_sigmoid_f(float x) { return fminf(x, 0.f) - __logf(1.0f + __expf(-fabsf(x))); }
__device__ __forceinline__ f32x4 mma_lds(const LAS bf16_t* A, int lda, const LAS bf16_t* B, int ldb, int ksteps, f32x4 acc, int lane) {
    const int r = lane & 15, g = lane >> 4;
    for (int ks = 0; ks < ksteps; ++ks) { const bf16x8 a = *(const LAS bf16x8*)(A + r * lda + ks * 32 + 8 * g), b = *(const LAS bf16x8*)(B + r * ldb + ks * 32 + 8 * g); acc = mfma16(a, b, acc); }
    return acc;
}
__device__ __forceinline__ int gla_row0(int b, int cn) { return cn >= 4 ? b * SEQ + (cn - 4) * 64 : NLAT + b * CTXL + cn * 64; }
struct GlaRaw { u32x4 q, k, f, b, v0, v1, g0, g1, s0, s1; };
template <bool FULL>
__device__ __forceinline__ GlaRaw gla_load(Frame& F, int u, int tl) {
    const int h = u & 3, cn = (u >> 2) % 68, b = (u >> 2) / 68, i = tl >> 2, part = tl & 3;
    const bf16_t* p = (const bf16_t*)(F.ws + WS_U) + (size_t)(gla_row0(b, cn) + i) * DIN;
    GlaRaw r;
    r.q = *(const GAS u32x4*)(p + UGQ + h * 32 + part * 8); r.k = *(const GAS u32x4*)(p + UGK + h * 32 + part * 8);
    r.f = *(const GAS u32x4*)(p + ULAF + h * 32 + part * 8); r.b = *(const GAS u32x4*)(p + ULAB + h * 32 + part * 8);
    r.v0 = *(const GAS u32x4*)(p + UGV + h * 64 + part * 16); r.v1 = *(const GAS u32x4*)(p + UGV + h * 64 + part * 16 + 8);
    if (FULL) { r.g0 = *(const GAS u32x4*)(p + UGR + h * 64 + part * 16); r.g1 = *(const GAS u32x4*)(p + UGR + h * 64 + part * 16 + 8);
        const bf16_t* sp = (const bf16_t*)(F.ws + WS_GSIN) + (size_t)u * 2 * 2048 + tl * 16; r.s0 = *(const GAS u32x4*)sp; r.s1 = *(const GAS u32x4*)(sp + 8); }
    else { r.g0 = (u32x4){0u, 0u, 0u, 0u}; r.g1 = r.g0; r.s0 = r.g0; r.s1 = r.g0; }
    return r;
}
__device__ __forceinline__ GlaRaw gla_load_out(Frame& F, int u, int tl) {
    const int h = u & 3, cn = (u >> 2) % 68, b = (u >> 2) / 68, i = tl >> 2, part = tl & 3;
    const bf16_t* p = (const bf16_t*)(F.ws + WS_U) + (size_t)(gla_row0(b, cn) + i) * DIN;
    const bf16_t* gq = (const bf16_t*)(F.ws + WS_XM8) + (size_t)u * 8192 + i * 32 + part * 8;
    GlaRaw r;
    r.q = *(const GAS u32x4*)gq; r.k = *(const GAS u32x4*)(gq + 2048); r.f = *(const GAS u32x4*)(gq + 4096); r.b = *(const GAS u32x4*)(gq + 6144);
    r.v0 = *(const GAS u32x4*)(p + UGV + h * 64 + part * 16); r.v1 = *(const GAS u32x4*)(p + UGV + h * 64 + part * 16 + 8);
    r.g0 = *(const GAS u32x4*)(p + UGR + h * 64 + part * 16); r.g1 = *(const GAS u32x4*)(p + UGR + h * 64 + part * 16 + 8);
    const bf16_t* sp = (const bf16_t*)(F.ws + WS_GSIN) + (size_t)u * 2 * 2048 + tl * 16; r.s0 = *(const GAS u32x4*)sp; r.s1 = *(const GAS u32x4*)(sp + 8);
    return r;
}
template <bool FULL>
__device__ __forceinline__ void gla_prep(Frame& F, LAS unsigned char* L, int l, int u, int tl, const GlaRaw& raw) {
    const int h = u & 3, cn = (u >> 2) % 68, i = tl >> 2, part = tl & 3, d8 = part * 8;
    LAS float* LAF = (LAS float*)(L + G2_LAF); LAS float* LAB = (LAS float*)(L + G2_LAB); LAS bf16_t* VT = (LAS bf16_t*)(L + G2_VT); LAS float* SEG = (LAS float*)(L + G2_SEG);
    float q[8], k[8], tf[8], tb[8];
    unpack8(raw.q, q); unpack8(raw.k, k); unpack8(raw.f, tf); unpack8(raw.b, tb);
    const float* ba = F.in[I_BA2] + (size_t)l * 256 + h * 32 + d8;
#pragma unroll
    for (int e = 0; e < 8; ++e) { q[e] *= 0.17677669529663687f; LAF[i * 33 + d8 + e] = log_sigmoid_f(tf[e] + ba[e]) * 0.0625f; LAB[i * 33 + d8 + e] = log_sigmoid_f(tb[e] + ba[128 + e]) * 0.0625f; }
    if (cn >= 4) {
        const float pos = (part >> 1) ? (float)i : (float)(cn - 4);
#pragma unroll
        for (int e = 0; e < 8; ++e) { const float ang = pos * __expf(-(float)e * (9.210340371976184f / 8.0f)); const float sn = __sinf(ang), cs = __cosf(ang);
            const float qo = shx(q[e], 1, F.lane), ko = shx(k[e], 1, F.lane);
            if (part & 1) { q[e] = qo * sn + q[e] * cs; k[e] = ko * sn + k[e] * cs; } else { q[e] = q[e] * cs - qo * sn; k[e] = k[e] * cs - ko * sn; } }
    }
    { const unsigned a[8] = {raw.v0.x, raw.v0.y, raw.v0.z, raw.v0.w, raw.v1.x, raw.v1.y, raw.v1.z, raw.v1.w};
#pragma unroll
      for (int e = 0; e < 8; ++e) { VT[(part * 16 + 2 * e) * 72 + i] = (bf16_t)(a[e] & 0xffffu); VT[(part * 16 + 2 * e + 1) * 72 + i] = (bf16_t)(a[e] >> 16); } }
    __syncthreads();
    { const int x = tl & 63, d = x & 31, dir = x >> 5, seg = tl >> 6; LAS float* LA = (dir ? LAB : LAF) + d; float cv[16];
#pragma unroll
      for (int kk = 0; kk < 16; ++kk) { const int p = seg * 16 + kk, ti = dir ? 63 - p : p; cv[kk] = LA[ti * 33]; }
#pragma unroll
      for (int kk = 1; kk < 16; ++kk) cv[kk] += cv[kk - 1];
#pragma unroll
      for (int kk = 0; kk < 16; ++kk) { const int p = seg * 16 + kk, ti = dir ? 63 - p : p; LA[ti * 33] = cv[kk]; }
      SEG[x * 5 + seg] = cv[15]; }
    __syncthreads();
    { const int x = tl & 63, d = x & 31, dir = x >> 5, seg = tl >> 6; LAS float* LA = (dir ? LAB : LAF) + d; float cv[16];
      const float t0 = SEG[x * 5 + 0], t1 = SEG[x * 5 + 1], t2 = SEG[x * 5 + 2];
      const float pre = seg == 0 ? 0.f : (seg == 1 ? t0 : (seg == 2 ? t0 + t1 : t0 + t1 + t2));
#pragma unroll
      for (int kk = 0; kk < 16; ++kk) { const int p = seg * 16 + kk, ti = dir ? 63 - p : p; cv[kk] = LA[ti * 33]; }
#pragma unroll
      for (int kk = 0; kk < 16; ++kk) { const int p = seg * 16 + kk, ti = dir ? 63 - p : p; LA[ti * 33] = cv[kk] + pre; } }
    __syncthreads();
    if (FULL) {
        unsigned wqf[4], wkf[4], wqb[4], wkb[4];
#pragma unroll
        for (int e = 0; e < 4; ++e) { const int d = d8 + 2 * e; const float f0 = LAF[i * 33 + d], f1 = LAF[i * 33 + d + 1], b0 = LAB[i * 33 + d], b1 = LAB[i * 33 + d + 1];
            wqf[e] = pk2(q[2 * e] * __expf(f0), q[2 * e + 1] * __expf(f1)); wkf[e] = pk2(k[2 * e] * __expf(-f0), k[2 * e + 1] * __expf(-f1));
            wqb[e] = pk2(q[2 * e] * __expf(b0), q[2 * e + 1] * __expf(b1)); wkb[e] = pk2(k[2 * e] * __expf(-b0), k[2 * e + 1] * __expf(-b1)); }
        *(LAS u32x4*)((LAS bf16_t*)(L + G2_QTF) + i * 40 + d8) = (u32x4){wqf[0], wqf[1], wqf[2], wqf[3]}; *(LAS u32x4*)((LAS bf16_t*)(L + G2_KTF) + i * 40 + d8) = (u32x4){wkf[0], wkf[1], wkf[2], wkf[3]};
        *(LAS u32x4*)((LAS bf16_t*)(L + G2_QTB) + i * 40 + d8) = (u32x4){wqb[0], wqb[1], wqb[2], wqb[3]}; *(LAS u32x4*)((LAS bf16_t*)(L + G2_KTB) + i * 40 + d8) = (u32x4){wkb[0], wkb[1], wkb[2], wkb[3]};
    } else {
        LAS bf16_t* KDF = (LAS bf16_t*)(L + G2_QTF); LAS bf16_t* KDB = (LAS bf16_t*)(L + G2_KTF);
#pragma unroll
        for (int e = 0; e < 8; ++e) { const int d = d8 + e; const float bf = LAF[i * 33 + d], bb = LAB[i * 33 + d], bfl = LAF[63 * 33 + d], bbl = LAB[0 * 33 + d];
            KDF[d * 72 + i] = (bf16_t)f2bf(k[e] * __expf(bfl - bf)); KDB[d * 72 + i] = (bf16_t)f2bf(k[e] * __expf(bbl - bb)); }
        unsigned wqf[4], wkf[4], wqb[4], wkb[4];
#pragma unroll
        for (int e = 0; e < 4; ++e) { const int d = d8 + 2 * e; const float f0 = LAF[i * 33 + d], f1 = LAF[i * 33 + d + 1], b0 = LAB[i * 33 + d], b1 = LAB[i * 33 + d + 1];
            wqf[e] = pk2(q[2 * e] * __expf(f0), q[2 * e + 1] * __expf(f1)); wkf[e] = pk2(k[2 * e] * __expf(-f0), k[2 * e + 1] * __expf(-f1));
            wqb[e] = pk2(q[2 * e] * __expf(b0), q[2 * e + 1] * __expf(b1)); wkb[e] = pk2(k[2 * e] * __expf(-b0), k[2 * e + 1] * __expf(-b1)); }
        bf16_t* gq = (bf16_t*)(F.ws + WS_XM8) + (size_t)u * 8192 + i * 32 + d8;
        *(GAS u32x4*)gq = (u32x4){wqf[0], wqf[1], wqf[2], wqf[3]}; *(GAS u32x4*)(gq + 2048) = (u32x4){wkf[0], wkf[1], wkf[2], wkf[3]};
        *(GAS u32x4*)(gq + 4096) = (u32x4){wqb[0], wqb[1], wqb[2], wqb[3]}; *(GAS u32x4*)(gq + 6144) = (u32x4){wkb[0], wkb[1], wkb[2], wkb[3]};
    }
    __syncthreads();
}
__device__ __forceinline__ void ph_gla_local(Frame& F, int l) {
    const int hw = F.wave >> 2, wl = F.wave & 3, tl = F.tid & 255; LAS unsigned char* L = F.lds + hw * G2_HALF;
    constexpr int NU = NB * 68 * 4;
    int pp = F.wg;
    GlaRaw raw = gla_load<false>(F, (pp * 2 + hw) < NU ? pp * 2 + hw : 0, tl);
    for (; pp * 2 < NU; pp += F.G) {
        const int u = pp * 2 + hw, un = (pp + F.G) * 2 + hw;
        const GlaRaw nraw = gla_load<false>(F, un < NU ? un : u, tl);
        __syncthreads();
        gla_prep<false>(F, L, l, u, tl, raw);
        const int g = F.lane >> 4, c = F.lane & 15;
        float* DS = (float*)(F.ws + WS_GDS) + (size_t)u * 2 * 2048;
#pragma unroll
        for (int kk = 0; kk < 4; ++kk) { const int tix = wl * 4 + kk, dir = tix >> 3, mt = (tix >> 1) & 3, nt = tix & 1;
            f32x4 a = (f32x4){0.f, 0.f, 0.f, 0.f};
            a = mma_lds((const LAS bf16_t*)(L + G2_VT) + mt * 16 * 72, 72, (const LAS bf16_t*)(L + (dir ? G2_KTF : G2_QTF)) + nt * 16 * 72, 72, 2, a, F.lane);
#pragma unroll
            for (int e = 0; e < 4; ++e) DS[dir * 2048 + (mt * 16 + 4 * g + e) * 32 + nt * 16 + c] = a[e]; }
        if (tl < 64) { const int d = tl & 31, dir = tl >> 5; ((float*)(F.ws + WS_GD))[(size_t)u * 64 + tl] = __expf(dir ? ((LAS float*)(L + G2_LAB))[0 * 33 + d] : ((LAS float*)(L + G2_LAF))[63 * 33 + d]); }
        raw = nraw;
    }
}
__device__ __forceinline__ void ph_gla_scan(Frame& F) {
    const int gt = F.wg * NTHR + F.tid, NGT = F.G * NTHR;
    const float* DS = (const float*)(F.ws + WS_GDS); const float* GD = (const float*)(F.ws + WS_GD); bf16_t* SIN = (bf16_t*)(F.ws + WS_GSIN);
    for (int w = gt; w < 128 * 1024; w += NGT) {
        const int chain = w >> 10, el = (w & 1023) * 2, dir = chain & 1, h = (chain >> 1) & 3, b = chain >> 3, d = el & 31;
        float s0 = 0.f, s1 = 0.f;
        for (int step = 0; step < 68; step += 4) {
            f32x2 ds[4], dd[4]; size_t uu[4];
#pragma unroll
            for (int q = 0; q < 4; ++q) { const int st_ = step + q; const int cn = dir ? (st_ < 4 ? 3 - st_ : 71 - st_) : st_;
                uu[q] = (size_t)(b * 68 + cn) * 4 + h;
                ds[q] = *(const GAS f32x2*)(DS + (uu[q] * 2 + dir) * 2048 + el); dd[q] = *(const GAS f32x2*)(GD + uu[q] * 64 + dir * 32 + d); }
#pragma unroll
            for (int q = 0; q < 4; ++q) { *(GAS unsigned*)(SIN + (uu[q] * 2 + dir) * 2048 + el) = pk2(s0, s1); s0 = dd[q].x * s0 + ds[q].x; s1 = dd[q].y * s1 + ds[q].y; }
        }
    }
}
__device__ __forceinline__ void ph_gla_out(Frame& F, int l, bool last) {
    const int hw = F.wave >> 2, wl = F.wave & 3, tl = F.tid & 255; LAS unsigned char* L = F.lds + hw * G2_HALF;
    const int NV = last ? NB * 64 * 4 : NB * 68 * 4;
#define GLA_UNIT(v) (last ? ((((v) >> 8) * 68 + 4 + (((v) & 255) >> 2)) * 4 + ((v) & 3)) : (v))
    int pp = F.wg;
    GlaRaw raw = gla_load_out(F, GLA_UNIT((pp * 2 + hw) < NV ? pp * 2 + hw : 0), tl);
    __syncthreads();
    for (; pp * 2 < NV; pp += F.G) {
        const int u = GLA_UNIT(pp * 2 + hw), vn = (pp + F.G) * 2 + hw;
        const GlaRaw nraw = gla_load_out(F, vn < NV ? GLA_UNIT(vn) : u, tl);
        const int h = u & 3, cn = (u >> 2) % 68, b = (u >> 2) / 68;
        { const int i = tl >> 2, part = tl & 3, d8 = part * 8; LAS bf16_t* VT = (LAS bf16_t*)(L + G2_VT);
          *(LAS u32x4*)((LAS bf16_t*)(L + G2_QTF) + i * 40 + d8) = raw.q; *(LAS u32x4*)((LAS bf16_t*)(L + G2_KTF) + i * 40 + d8) = raw.k;
          *(LAS u32x4*)((LAS bf16_t*)(L + G2_QTB) + i * 40 + d8) = raw.f; *(LAS u32x4*)((LAS bf16_t*)(L + G2_KTB) + i * 40 + d8) = raw.b;
          const unsigned a[8] = {raw.v0.x, raw.v0.y, raw.v0.z, raw.v0.w, raw.v1.x, raw.v1.y, raw.v1.z, raw.v1.w};
#pragma unroll
          for (int e = 0; e < 8; ++e) { VT[(part * 16 + 2 * e) * 72 + i] = (bf16_t)(a[e] & 0xffffu); VT[(part * 16 + 2 * e + 1) * 72 + i] = (bf16_t)(a[e] >> 16); } }
        { const int dir = tl >> 7, dv = (tl >> 1) & 63, d16 = (tl & 1) * 16; LAS bf16_t* S = (LAS bf16_t*)(L + (dir ? G2_SB : G2_SF)) + dv * 40 + d16; *(LAS u32x4*)S = raw.s0; *(LAS u32x4*)(S + 8) = raw.s1; }
        __syncthreads();
        const int g = F.lane >> 4, c = F.lane & 15;
        LAS bf16_t* ATT = (LAS bf16_t*)(L + G2_ATT);
#pragma unroll
        for (int kk = 0; kk < 4; ++kk) { const int tile = wl * 4 + kk, mt = tile >> 2, nt = tile & 3;
            f32x4 af = (f32x4){0.f, 0.f, 0.f, 0.f}, ab = af;
            af = mma_lds((const LAS bf16_t*)(L + G2_QTF) + mt * 16 * 40, 40, (const LAS bf16_t*)(L + G2_KTF) + nt * 16 * 40, 40, 1, af, F.lane);
            ab = mma_lds((const LAS bf16_t*)(L + G2_QTB) + mt * 16 * 40, 40, (const LAS bf16_t*)(L + G2_KTB) + nt * 16 * 40, 40, 1, ab, F.lane);
#pragma unroll
            for (int e = 0; e < 4; ++e) { const int ii = mt * 16 + 4 * g + e, j = nt * 16 + c; const float vv = (j <= ii ? af[e] : 0.f) + (j >= ii ? ab[e] : 0.f); ATT[ii * 72 + j] = (bf16_t)f2bf(vv); } }
        __syncthreads();
        LAS float* O = (LAS float*)(L + G2_LAF);
#pragma unroll
        for (int kk = 0; kk < 4; ++kk) { const int tile = wl * 4 + kk, mt = tile >> 2, nt = tile & 3;
            f32x4 a = (f32x4){0.f, 0.f, 0.f, 0.f};
            a = mma_lds(ATT + mt * 16 * 72, 72, (const LAS bf16_t*)(L + G2_VT) + nt * 16 * 72, 72, 2, a, F.lane);
            a = mma_lds((const LAS bf16_t*)(L + G2_QTF) + mt * 16 * 40, 40, (const LAS bf16_t*)(L + G2_SF) + nt * 16 * 40, 40, 1, a, F.lane);
            a = mma_lds((const LAS bf16_t*)(L + G2_QTB) + mt * 16 * 40, 40, (const LAS bf16_t*)(L + G2_SB) + nt * 16 * 40, 40, 1, a, F.lane);
#pragma unroll
            for (int e = 0; e < 4; ++e) O[(mt * 16 + 4 * g + e) * 65 + nt * 16 + c] = a[e]; }
        __syncthreads();
        { const int i = tl >> 2, dv16 = (tl & 3) * 16; const int row = gla_row0(b, cn) + i;
          float v[16], gt[16]; float ss = 0.f;
#pragma unroll
          for (int e = 0; e < 16; ++e) { v[e] = O[i * 65 + dv16 + e]; ss += v[e] * v[e]; }
          ss += shx(ss, 1, F.lane); ss += shx(ss, 2, F.lane);
          const float rs = 1.0f / sqrtf(ss * (1.0f / 64.0f) + LN_EPS);
          unpack8(raw.g0, gt); unpack8(raw.g1, gt + 8);
          const float* gn = F.in[I_GNORM] + l * 64 + dv16;
          unsigned w[8];
#pragma unroll
          for (int e = 0; e < 8; ++e) w[e] = pk2(v[2 * e] * rs * gn[2 * e] * silu_f(gt[2 * e]), v[2 * e + 1] * rs * gn[2 * e + 1] * silu_f(gt[2 * e + 1]));
          bf16_t* mp = (bf16_t*)(F.ws + WS_MIX) + (size_t)row * DM + 512 + h * 64 + dv16;
          *(GAS u32x4*)mp = (u32x4){w[0], w[1], w[2], w[3]}; *(GAS u32x4*)(mp + 8) = (u32x4){w[4], w[5], w[6], w[7]}; }
        raw = nraw;
    }
#undef GLA_UNIT
}

template <int L>
__device__ __forceinline__ void hyena_conv(Frame& F, const bf16_t* Rg, const bf16_t* Uin, const bf16_t* Xmul, int pos0, bool final_out, int ch, bf16_t* Zout) {
    constexpr int CS = 2 * L + 16;
    constexpr int NTL = L / 16, J = (NTL >= 64) ? 16 : 2, NGRP = NTL / J, HJ = J / 2, NSTEP = L / 32;
    LAS bf16_t* Rl = (LAS bf16_t*)F.lds;
    __syncthreads();
    for (int c = F.tid; c < 2 * L / 8; c += NTHR) { const u32x4 v = *(const GAS u32x4*)(Rg + 8 * c); const unsigned a[4] = {v.x, v.y, v.z, v.w};
#pragma unroll
        for (int rho = 0; rho < 8; ++rho) { LAS bf16_t* d = Rl + rho * CS + 8 * c + rho;
#pragma unroll
            for (int k = 0; k < 4; ++k) { d[2 * k] = (bf16_t)(a[k] & 0xffffu); d[2 * k + 1] = (bf16_t)(a[k] >> 16); } } }
    __syncthreads();
    int ln_ = F.lane; asm volatile("" : "+v"(ln_));
    const int i = ln_ & 15, g = ln_ >> 4, rho = i & 7;
    const LAS bf16_t* Rc = Rl + rho * CS + rho;
    for (int grp = F.wave; grp < NGRP; grp += NWAVES) {
        f32x4 acc[J]; bf16x8 fr[J];
        const int tb = grp * J * 16;
        const LAS bf16_t* Rb = Rc + (L - tb - i + 8 * g);
#pragma unroll
        for (int j = 0; j < J; ++j) { acc[j] = (f32x4){0.f, 0.f, 0.f, 0.f}; fr[j] = *(const LAS bf16x8*)(Rb - 16 * j); }
        const char* ub = (const char*)(Uin + pos0); const unsigned ulo = (unsigned)((i * SPB + 8 * g) * 2);
        constexpr int PF = (HJ >= 4) ? 4 : 1;
        bf16x8 bq[PF];
#pragma unroll
        for (int p = 0; p < PF; ++p) bq[p] = *(const GAS bf16x8*)(ub + (size_t)(ulo + (unsigned)p * 64u));
        u32x2 xw[J];
#pragma unroll
        for (int j = 0; j < J; ++j) xw[j] = *(const GAS u32x2*)(Xmul + (size_t)i * SPB + pos0 + tb + j * 16 + 4 * g);
#pragma unroll 1
        for (int q = 0; q < NSTEP / HJ; ++q) {
#pragma unroll
            for (int m = 0; m < HJ; ++m) {
                const int n = q * HJ + m;
                const int nn = (n + PF < NSTEP) ? n + PF : 0;
                if (n > 0) { fr[(J - 2 * m) % J] = *(const LAS bf16x8*)(Rb + 32 * n); fr[(J + 1 - 2 * m) % J] = *(const LAS bf16x8*)(Rb + 32 * n - 16); }
                const bf16x8 bcur = bq[m % PF];
#pragma unroll
                for (int jj = 0; jj < J; ++jj) { const int j = (jj + 2) % J; acc[j] = mfma16(fr[(j + J - 2 * m) % J], bcur, acc[j]); }
                bq[m % PF] = *(const GAS bf16x8*)(ub + (size_t)(ulo + (unsigned)nn * 64u));
            }
        }
#pragma unroll
        for (int j = 0; j < J; ++j) { const int t0 = tb + j * 16 + 4 * g;
            const float y0 = acc[j][0] * bflo(xw[j].x), y1 = acc[j][1] * bfhi(xw[j].x), y2 = acc[j][2] * bflo(xw[j].y), y3 = acc[j][3] * bfhi(xw[j].y);
            if (!final_out) { u32x2 w; w.x = pk2(y0, y1); w.y = pk2(y2, y3); *(GAS u32x2*)(Zout + (size_t)i * SPB + pos0 + t0) = w; }
            else { u32x2 w; w.x = pk2(y0, y1); w.y = pk2(y2, y3); *(GAS u32x2*)((bf16_t*)(F.ws + WS_Y) + ((size_t)ch * NB + i) * SPB + pos0 + t0) = w; } }
    }
}
__device__ __forceinline__ void ph_hyena(Frame& F, int l, bool last) {
    const bf16_t* HV = (const bf16_t*)(F.ws + WS_HV); bf16_t* Z2 = (bf16_t*)(F.ws + WS_Z2);
    for (int ch = F.wg; ch < 256; ch += F.G) {
        const bf16_t* v = HV + (size_t)(0 * 256 + ch) * NB * SPB; const bf16_t* x1 = HV + (size_t)(256 + ch) * NB * SPB; const bf16_t* x2 = HV + (size_t)(512 + ch) * NB * SPB;
        bf16_t* z = Z2 + (size_t)ch * NB * SPB;
        const bf16_t* R0 = (const bf16_t*)(F.ws + WS_HYF) + ((size_t)(l * 2 + 0) * 256 + ch) * 8192; const bf16_t* R1 = (const bf16_t*)(F.ws + WS_HYF) + ((size_t)(l * 2 + 1) * 256 + ch) * 8192;
        hyena_conv<4096>(F, R0, v, x1, 0, false, ch, z);
        VM_WAIT(); __syncthreads(); __builtin_amdgcn_fence(__ATOMIC_ACQUIRE, "agent"); VM_WAIT();
        hyena_conv<4096>(F, R1, z, x2, 0, true, ch, z);
        if (!last) {
            const bf16_t* C0 = (const bf16_t*)(F.ws + WS_HYFC) + ((size_t)(l * 2 + 0) * 256 + ch) * 512; const bf16_t* C1 = (const bf16_t*)(F.ws + WS_HYFC) + ((size_t)(l * 2 + 1) * 256 + ch) * 512;
            hyena_conv<256>(F, C0, v, x1, SEQ, false, ch, z);
            VM_WAIT(); __syncthreads(); __builtin_amdgcn_fence(__ATOMIC_ACQUIRE, "agent"); VM_WAIT();
            hyena_conv<256>(F, C1, z, x2, SEQ, true, ch, z);
        }
    }
}

__device__ __forceinline__ void ph_ln1(Frame& F, int l, int ntok) {
    const int gw = F.wg * NWAVES + F.wave, NGW = F.G * NWAVES;
    const int cA = 256 * (F.lane >> 4) + 32 * ((F.lane >> 2) & 3) + 8 * (F.lane & 3);
#define LN1_COL(j) (cA + ((j) < 2 ? 4 * (j) : 128 + 4 * ((j) - 2)))
    const float* lg = F.in[I_LN1G] + l * DM; const float* lb = F.in[I_LN1B] + l * DM;
    for (int row = gw; row < ntok; row += NGW) {
        bf16_t* xr = (bf16_t*)(F.ws + WS_XR) + (size_t)row * DM;
        const unsigned char* yr = (const unsigned char*)(F.ws + WS_Y) + (size_t)row * DM + 16 * F.lane;
        const float* md = mod_ptr(F, l, row);
        const u32x4 xa = __builtin_nontemporal_load((const GAS u32x4*)(xr + cA)), xb = __builtin_nontemporal_load((const GAS u32x4*)(xr + cA + 128)), ya = __builtin_nontemporal_load((const GAS u32x4*)yr);
        float x[16], y[16], v[16]; unpack8(xa, x); unpack8(xb, x + 8);
        { const unsigned a[4] = {ya.x, ya.y, ya.z, ya.w};
#pragma unroll
          for (int e = 0; e < 4; ++e) { const f32x2 lo = __builtin_amdgcn_cvt_pk_f32_fp8((int)a[e], false), hi = __builtin_amdgcn_cvt_pk_f32_fp8((int)a[e], true); y[4 * e] = lo.x; y[4 * e + 1] = lo.y; y[4 * e + 2] = hi.x; y[4 * e + 3] = hi.y; } }
        float s = 0.f;
#pragma unroll
        for (int j = 0; j < 4; ++j) { const f32x4 g1 = *(const GAS f32x4*)(md + 2048 + LN1_COL(j));
#pragma unroll
            for (int e = 0; e < 4; ++e) { v[4 * j + e] = x[4 * j + e] * DN_ALPHA + g1[e] * y[4 * j + e]; s += v[4 * j + e]; } }
        const float mean = wave_sum(s, F.lane) * (1.f / DM); float s2 = 0.f;
#pragma unroll
        for (int e = 0; e < 16; ++e) { v[e] -= mean; s2 += v[e] * v[e]; }
        const float rstd = 1.f / sqrtf(wave_sum(s2, F.lane) * (1.f / DM) + LN_EPS);
        unsigned wx[8]; int w8[4];
#pragma unroll
        for (int j = 0; j < 4; ++j) { const f32x4 g = *(const GAS f32x4*)(lg + LN1_COL(j)), bb = *(const GAS f32x4*)(lb + LN1_COL(j)), sh = *(const GAS f32x4*)(md + 3072 + LN1_COL(j)), sc = *(const GAS f32x4*)(md + 4096 + LN1_COL(j));
            float xn[4];
#pragma unroll
            for (int e = 0; e < 4; ++e) xn[e] = v[4 * j + e] * rstd * g[e] + bb[e];
            wx[2 * j] = pk2(xn[0], xn[1]); wx[2 * j + 1] = pk2(xn[2], xn[3]);
            const float h0 = xn[0] * (1.f + sc[0]) + sh[0], h1 = xn[1] * (1.f + sc[1]) + sh[1], h2 = xn[2] * (1.f + sc[2]) + sh[2], h3 = xn[3] * (1.f + sc[3]) + sh[3];
            int v = 0; v = __builtin_amdgcn_cvt_pk_fp8_f32(h0, h1, v, false); v = __builtin_amdgcn_cvt_pk_fp8_f32(h2, h3, v, true); w8[j] = v; }
        unsigned char* x8 = (unsigned char*)(F.ws + WS_XM8) + (size_t)row * DM;
        *(GAS u32x2*)(x8 + cA) = (u32x2){(unsigned)w8[0], (unsigned)w8[1]}; *(GAS u32x2*)(x8 + cA + 128) = (u32x2){(unsigned)w8[2], (unsigned)w8[3]};
        *(GAS u32x4*)(xr + cA) = (u32x4){wx[0], wx[1], wx[2], wx[3]}; *(GAS u32x4*)(xr + cA + 128) = (u32x4){wx[4], wx[5], wx[6], wx[7]};
    }
#undef LN1_COL
}
__device__ __forceinline__ void ph_ln2(Frame& F, int l, int ntok, bool last) {
    const int gw = F.wg * NWAVES + F.wave, NGW = F.G * NWAVES;
    const int cA = 256 * (F.lane >> 4) + 32 * ((F.lane >> 2) & 3) + 8 * (F.lane & 3);
#define LN2_COL(j) (cA + ((j) < 2 ? 4 * (j) : 128 + 4 * ((j) - 2)))
    const float* lg = F.in[I_LN2G] + l * DM; const float* lb = F.in[I_LN2B] + l * DM;
    struct Ln2Raw { u32x2 q[8]; u32x4 qs, xa, xb; };
    auto ln2_load = [&](int row) { Ln2Raw r;
        const unsigned char* y2 = (const unsigned char*)(F.ws + WS_Y2) + (size_t)row * 5120;
        const bf16_t* xr = (const bf16_t*)(F.ws + WS_XR) + (size_t)row * DM;
#pragma unroll
        for (int k = 0; k < 8; ++k) r.q[k] = __builtin_nontemporal_load((const GAS u32x2*)(y2 + k * 512 + 8 * F.lane));
        r.qs = __builtin_nontemporal_load((const GAS u32x4*)(y2 + 4096 + 16 * F.lane));
        r.xa = __builtin_nontemporal_load((const GAS u32x4*)(xr + cA)); r.xb = __builtin_nontemporal_load((const GAS u32x4*)(xr + cA + 128));
        return r; };
    Ln2Raw cur = ln2_load(gw < ntok ? gw : 0);
    for (int row = gw; row < ntok; row += NGW) {
        const Ln2Raw nxt = ln2_load(row + NGW < ntok ? row + NGW : row);
        bf16_t* xr = (bf16_t*)(F.ws + WS_XR) + (size_t)row * DM;
        const float* wg = (const float*)(F.ws + WS_WGT) + (size_t)row * 8;
        const float* md = mod_ptr(F, l, row);
        float ff[16];
#pragma unroll
        for (int e = 0; e < 16; ++e) ff[e] = 0.f;
        { const unsigned a[4] = {cur.qs.x, cur.qs.y, cur.qs.z, cur.qs.w};
#pragma unroll
          for (int e = 0; e < 4; ++e) { const f32x2 lo = __builtin_amdgcn_cvt_pk_f32_fp8((int)a[e], false), hi = __builtin_amdgcn_cvt_pk_f32_fp8((int)a[e], true);
              ff[4 * e] += pg8::Y2_INV * lo.x; ff[4 * e + 1] += pg8::Y2_INV * lo.y; ff[4 * e + 2] += pg8::Y2_INV * hi.x; ff[4 * e + 3] += pg8::Y2_INV * hi.y; } }
#pragma unroll
        for (int k = 0; k < 8; ++k) { const float wk = wg[k] * pg8::Y2_INV; const unsigned a[2] = {cur.q[k].x, cur.q[k].y};
#pragma unroll
            for (int h = 0; h < 2; ++h) {
                const f32x2 p0 = __builtin_amdgcn_cvt_scalef32_pk_f32_fp4(a[h], 1.0f, 0), p1 = __builtin_amdgcn_cvt_scalef32_pk_f32_fp4(a[h], 1.0f, 1), p2 = __builtin_amdgcn_cvt_scalef32_pk_f32_fp4(a[h], 1.0f, 2), p3 = __builtin_amdgcn_cvt_scalef32_pk_f32_fp4(a[h], 1.0f, 3);
                ff[8 * h] += wk * p0.x; ff[8 * h + 1] += wk * p0.y; ff[8 * h + 2] += wk * p1.x; ff[8 * h + 3] += wk * p1.y; ff[8 * h + 4] += wk * p2.x; ff[8 * h + 5] += wk * p2.y; ff[8 * h + 6] += wk * p3.x; ff[8 * h + 7] += wk * p3.y; } }
        float v[16], xo[16]; float s = 0.f;
        unpack8(cur.xa, xo); unpack8(cur.xb, xo + 8);
#pragma unroll
        for (int j = 0; j < 4; ++j) { const f32x4 g2 = *(const GAS f32x4*)(md + 5120 + LN2_COL(j));
#pragma unroll
            for (int e = 0; e < 4; ++e) { v[4 * j + e] = xo[4 * j + e] * DN_ALPHA + g2[e] * ff[4 * j + e]; s += v[4 * j + e]; } }
        const float mean = wave_sum(s, F.lane) * (1.f / DM); float s2 = 0.f;
#pragma unroll
        for (int e = 0; e < 16; ++e) { v[e] -= mean; s2 += v[e] * v[e]; }
        const float rstd = 1.f / sqrtf(wave_sum(s2, F.lane) * (1.f / DM) + LN_EPS);
        const float* mdn = last ? md : mod_ptr(F, l + 1, row);
        float xn[16];
#pragma unroll
        for (int j = 0; j < 4; ++j) { const f32x4 g = *(const GAS f32x4*)(lg + LN2_COL(j)), bb = *(const GAS f32x4*)(lb + LN2_COL(j));
#pragma unroll
            for (int e = 0; e < 4; ++e) xn[4 * j + e] = v[4 * j + e] * rstd * g[e] + bb[e]; }
        if (last) { float* op = F.out + (size_t)row * DM;
#pragma unroll
            for (int j = 0; j < 4; ++j) *(GAS f32x4*)(op + LN2_COL(j)) = (f32x4){xn[4 * j], xn[4 * j + 1], xn[4 * j + 2], xn[4 * j + 3]}; }
        else {
            *(GAS u32x4*)(xr + cA) = (u32x4){pk2(xn[0], xn[1]), pk2(xn[2], xn[3]), pk2(xn[4], xn[5]), pk2(xn[6], xn[7])}; *(GAS u32x4*)(xr + cA + 128) = (u32x4){pk2(xn[8], xn[9]), pk2(xn[10], xn[11]), pk2(xn[12], xn[13]), pk2(xn[14], xn[15])};
            bf16_t* xm = (bf16_t*)(F.ws + WS_XM) + (size_t)row * DM;
            unsigned w[8];
#pragma unroll
            for (int j = 0; j < 4; ++j) { const f32x4 sh = *(const GAS f32x4*)(mdn + LN2_COL(j)), sc = *(const GAS f32x4*)(mdn + 1024 + LN2_COL(j));
                w[2 * j] = pk2(xn[4 * j] * (1.f + sc[0]) + sh[0], xn[4 * j + 1] * (1.f + sc[1]) + sh[1]); w[2 * j + 1] = pk2(xn[4 * j + 2] * (1.f + sc[2]) + sh[2], xn[4 * j + 3] * (1.f + sc[3]) + sh[3]); }
            *(GAS u32x4*)(xm + cA) = (u32x4){w[0], w[1], w[2], w[3]}; *(GAS u32x4*)(xm + cA + 128) = (u32x4){w[4], w[5], w[6], w[7]};
        }
        cur = nxt;
    }
#undef LN2_COL
}

__device__ __forceinline__ unsigned f_ord(float f) { const unsigned u = __builtin_bit_cast(unsigned, f); return (u & 0x80000000u) ? ~u : (u | 0x80000000u); }
__device__ __forceinline__ unsigned long long wave_max_u64(unsigned long long v, int lane) {
#pragma unroll
    for (int o = 1; o < 64; o <<= 1) { const unsigned lo = (unsigned)shxi((int)(unsigned)v, o, lane), hi = (unsigned)shxi((int)(unsigned)(v >> 32), o, lane); const unsigned long long w = ((unsigned long long)hi << 32) | lo; v = w > v ? w : v; }
    return v;
}
__device__ __forceinline__ float seg16_max(float v, int lane) { v = fmaxf(v, shx(v, 1, lane)); v = fmaxf(v, shx(v, 2, lane)); v = fmaxf(v, shx(v, 4, lane)); v = fmaxf(v, shx(v, 8, lane)); return v; }
__device__ __forceinline__ int seg16_min_i(int v, int lane) { int w; w = shxi(v, 1, lane); v = w < v ? w : v; w = shxi(v, 2, lane); v = w < v ? w : v; w = shxi(v, 4, lane); v = w < v ? w : v; w = shxi(v, 8, lane); v = w < v ? w : v; return v; }
template <int CTRL> __device__ __forceinline__ int dpp_i(int v) { return __builtin_amdgcn_update_dpp(0, v, CTRL, 0xf, 0xf, true); }
__device__ __forceinline__ unsigned row_max_u(unsigned v) { unsigned w; w = (unsigned)dpp_i<0xB1>((int)v); v = w > v ? w : v; w = (unsigned)dpp_i<0x4E>((int)v); v = w > v ? w : v; w = (unsigned)dpp_i<0x141>((int)v); v = w > v ? w : v; w = (unsigned)dpp_i<0x140>((int)v); v = w > v ? w : v; return v; }
__device__ __forceinline__ float row_max_f(float v) { v = fmaxf(v, __builtin_bit_cast(float, dpp_i<0xB1>(__builtin_bit_cast(int, v)))); v = fmaxf(v, __builtin_bit_cast(float, dpp_i<0x4E>(__builtin_bit_cast(int, v)))); v = fmaxf(v, __builtin_bit_cast(float, dpp_i<0x141>(__builtin_bit_cast(int, v)))); v = fmaxf(v, __builtin_bit_cast(float, dpp_i<0x140>(__builtin_bit_cast(int, v)))); return v; }
__device__ __forceinline__ int row_min_i(int v) { int w; w = dpp_i<0xB1>(v); v = w < v ? w : v; w = dpp_i<0x4E>(v); v = w < v ? w : v; w = dpp_i<0x141>(v); v = w < v ? w : v; w = dpp_i<0x140>(v); v = w < v ? w : v; return v; }
__device__ __forceinline__ float rdlane_f(float v, int l) { return __builtin_bit_cast(float, __builtin_amdgcn_readlane(__builtin_bit_cast(int, v), l)); }
__device__ __forceinline__ unsigned wave_max_u(unsigned v) {
    v = row_max_u(v);
    const unsigned a = (unsigned)__builtin_amdgcn_readlane((int)v, 0), b = (unsigned)__builtin_amdgcn_readlane((int)v, 16), c = (unsigned)__builtin_amdgcn_readlane((int)v, 32), d = (unsigned)__builtin_amdgcn_readlane((int)v, 48);
    const unsigned ab = a > b ? a : b, cd = c > d ? c : d; return ab > cd ? ab : cd;
}
__device__ __forceinline__ float row_top2(float v, int l16) {
    const float m1 = row_max_f(v);
    const int first = row_min_i(v == m1 ? l16 : 99);
    const float m2 = row_max_f(l16 == first ? -3.0e38f : v);
    return m1 + m2;
}
__device__ __forceinline__ float seg16_top2(float v, int lane) {
    const float m1 = seg16_max(v, lane);
    const int first = seg16_min_i(v == m1 ? (lane & 15) : 99, lane);
    const float m2 = seg16_max((lane & 15) == first ? -3.0e38f : v, lane);
    return m1 + m2;
}
__device__ __forceinline__ void ph_route(Frame& F, int l, int ntok) {
    LAS int* hist = (LAS int*)F.lds;
    LAS int* base = hist + 128;
    LAS unsigned* alist = (LAS unsigned*)(F.lds + 1024);
    const int tpw = (ntok + F.G - 1) / F.G, t0 = F.wg * tpw, t1 = (t0 + tpw) < ntok ? (t0 + tpw) : ntok;
    __syncthreads();
    if (F.tid < 128) hist[F.tid] = 0;
    __syncthreads();
    const float* LG = (const float*)(F.ws + WS_LOGIT); const float* rb = F.in[I_RB] + l * NEXP;
    const float b0 = rb[F.lane], b1 = rb[F.lane + 64];
    constexpr int RT = 4;
    float xq0[RT], xq1[RT];
#pragma unroll
    for (int j = 0; j < RT; ++j) { int tok = t0 + F.wave * RT + j; tok = tok < t1 ? tok : t1 - 1; tok = tok < 0 ? 0 : tok;
        xq0[j] = LG[(size_t)tok * 256 + F.lane]; xq1[j] = LG[(size_t)tok * 256 + 64 + F.lane]; }
    for (int tb = t0 + F.wave * RT; tb < t1; tb += NWAVES * RT) {
        float s0[RT], s1[RT], e0[RT], e1[RT], gs0[RT], gs1[RT]; unsigned h0[RT], h1[RT]; int mye[RT]; float myw[RT], wsum[RT];
        float xn0[RT], xn1[RT];
#pragma unroll
        for (int j = 0; j < RT; ++j) { int tok = tb + NWAVES * RT + j; tok = tok < t1 ? tok : t1 - 1;
            xn0[j] = LG[(size_t)tok * 256 + F.lane]; xn1[j] = LG[(size_t)tok * 256 + 64 + F.lane]; }
#pragma unroll
        for (int j = 0; j < RT; ++j) { const int tok = (tb + j) < t1 ? tb + j : t1 - 1;
            const float x0 = xq0[j], x1 = xq1[j];
            const float* rbs = (const float*)(F.ws + WS_RBIAS) + (size_t)(l * 17 + row_b(tok)) * 128; const float y0 = x0 + rbs[F.lane], y1 = x1 + rbs[64 + F.lane];
            s0[j] = __builtin_amdgcn_rcpf(1.0f + __expf(-y0)); s1[j] = __builtin_amdgcn_rcpf(1.0f + __expf(-y1)); e0[j] = s0[j] + b0; e1[j] = s1[j] + b1; }
#pragma unroll
        for (int j = 0; j < RT; ++j) { gs0[j] = row_top2(e0[j], F.lane & 15); gs1[j] = row_top2(e1[j], F.lane & 15); }
#pragma unroll
        for (int j = 0; j < RT; ++j) {
            float gsc[8];
#pragma unroll
            for (int g = 0; g < 4; ++g) { gsc[g] = rdlane_f(gs0[j], g * 16); gsc[4 + g] = rdlane_f(gs1[j], g * 16); }
            unsigned gmask = 0u;
#pragma unroll
            for (int g = 0; g < 8; ++g) { int cnt = 0;
#pragma unroll
                for (int g2 = 0; g2 < 8; ++g2) cnt += (gsc[g2] > gsc[g] || (gsc[g2] == gsc[g] && g2 < g)) ? 1 : 0;
                gmask |= (cnt < 4) ? (1u << g) : 0u; }
            const bool ok0 = (gmask >> (F.lane >> 4)) & 1u, ok1 = (gmask >> (4 + (F.lane >> 4))) & 1u;
            h0[j] = ok0 ? f_ord(e0[j]) : 0u; h1[j] = ok1 ? f_ord(e1[j]) : 0u;
            mye[j] = 0; myw[j] = 0.f; wsum[j] = 0.f; }
#pragma unroll
        for (int k = 0; k < 8; ++k) {
#pragma unroll
            for (int j = 0; j < RT; ++j) {
                const unsigned bh = h0[j] >= h1[j] ? h0[j] : h1[j];
                const unsigned H = wave_max_u(bh);
                const unsigned mylo = h0[j] == H ? (unsigned)(255 - F.lane) : (h1[j] == H ? (unsigned)(255 - 64 - F.lane) : 0u);
                const unsigned Lm = wave_max_u(mylo);
                const int e = 255 - (int)Lm;
                if (e < 64) { if (F.lane == e) h0[j] = 0u; } else { if (F.lane == e - 64) h1[j] = 0u; }
                const float sv = e < 64 ? rdlane_f(s0[j], e) : rdlane_f(s1[j], e - 64);
                wsum[j] += sv; if (F.lane == k) { mye[j] = e; myw[j] = sv; } }
        }
#pragma unroll
        for (int j = 0; j < RT; ++j) { const int tok = tb + j;
            if (tok < t1 && F.lane < 8) {
                const int lr = __hip_atomic_fetch_add(&hist[mye[j]], 1, __ATOMIC_RELAXED, __HIP_MEMORY_SCOPE_WORKGROUP);
                alist[(tok - t0) * 8 + F.lane] = (unsigned)mye[j] | ((unsigned)lr << 8);
                ((int*)(F.ws + WS_EIDX))[(size_t)tok * 8 + F.lane] = mye[j];
                ((float*)(F.ws + WS_WGT))[(size_t)tok * 8 + F.lane] = myw[j] / wsum[j] * 2.5f;
            } }
#pragma unroll
        for (int j = 0; j < RT; ++j) { xq0[j] = xn0[j]; xq1[j] = xn1[j]; }
    }
    __syncthreads();
    if (F.tid < 128) { const int hcount = hist[F.tid]; base[F.tid] = hcount ? (int)atomicAdd(F.ctl + CW_CNT + l * 256 + F.tid, (unsigned)hcount) : 0; }
    __syncthreads();
    for (int a = F.tid; a < (t1 - t0) * 8; a += NTHR) { const unsigned v = alist[a]; ((int*)(F.ws + WS_RNK))[(size_t)t0 * 8 + a] = base[v & 0xffu] + (int)(v >> 8); }
}
__device__ __forceinline__ void ph_positions(Frame& F, int l, int ntok) {
    LAS int* cnt = (LAS int*)F.lds;
    LAS int* off = cnt + 132;
    __syncthreads();
    if (F.tid < NE1) cnt[F.tid] = F.tid < NEXP ? (int)__hip_atomic_load(F.ctl + CW_CNT + l * 256 + F.tid, __ATOMIC_RELAXED, __HIP_MEMORY_SCOPE_AGENT) : ntok;
    __syncthreads();
    if (F.tid == 0) { int o = 0; for (int e = 0; e < NE1; ++e) { off[e] = o; o += (cnt[e] + 255) & ~255; } off[NE1] = o; }
    __syncthreads();
    const int gt = F.wg * NTHR + F.tid, NGT = F.G * NTHR;
    int* rowtok = (int*)(F.ws + WS_ROWTOK); int* rowdst = (int*)(F.ws + WS_ROWDST); int* tile_exp = (int*)(F.ws + WS_TILEEXP);
    const int* eidx = (const int*)(F.ws + WS_EIDX); const int* rnk = (const int*)(F.ws + WS_RNK);
    for (int a = gt; a < ntok * 8; a += NGT) { const int tok = a >> 3, k = a & 7; const int pos = off[eidx[a]] + rnk[a]; rowtok[pos] = tok; rowdst[pos] = tok * 10 + k; }
    for (int tok = gt; tok < ntok; tok += NGT) { const int pos = off[NEXP] + tok; rowtok[pos] = tok; rowdst[pos] = tok * 10 + 8; }
    for (int i = gt; i < NE1 * 256; i += NGT) { const int e = i >> 8, p = i & 255; const int row = off[e] + cnt[e] + p; if (row < off[e + 1]) { rowtok[row] = 0; rowdst[row] = -1; } }
    for (int i = gt; i < NE1 * 320; i += NGT) { const int e = i / 320, p = i % 320; const int t = (off[e] >> 8) + p; if (t < (off[e + 1] >> 8)) tile_exp[t] = e; }
    if (gt == 0) F.ctl[CW_NTL + l] = (unsigned)(off[NE1] >> 8);
}

#ifndef MK_MULTI
#define MK_MULTI 0
#endif
constexpr int PH_PER_LAYER = 12, NPHASE = 2 + DEPTH * PH_PER_LAYER;
struct Args { const float* in[36]; float* out; unsigned char* ws; int ph_lo, ph_hi; };

__global__ void __launch_bounds__(NTHR, 2) mk_fwd(Args args) {
    extern __shared__ __attribute__((aligned(16))) unsigned char lds_raw[];
    Frame F;
    F.lds = (LAS unsigned char*)lds_raw;
    F.tid = threadIdx.x; F.lane = F.tid & 63; F.wave = __builtin_amdgcn_readfirstlane(F.tid >> 6);
    const int wave0 = F.wave;
    F.G = gridDim.x; F.wg = blockIdx.x;
    F.in = args.in;
    F.out = args.out; F.ws = args.ws; F.ctl = (unsigned*)(args.ws + WS_CTL);
    volatile LAS unsigned* MISC = (volatile LAS unsigned*)(F.lds + MISC_OFF);
    if (F.tid < 32) MISC[F.tid] = 0u;
    __syncthreads();
    const int lo = args.ph_lo, hi = args.ph_hi;
    const bool single = (hi - lo) > 1;
    XcdBarrier bar; bar.bar = F.ctl + CW_BAR; bar.x = 0; bar.st = nullptr;
    if (single) bar = xcd_barrier_post(F.ctl + CW_BAR, MISC + 8);
#define IN(k) (lo <= (k) && (k) < hi)
#ifndef PROBE_MASK
#define PROBE_MASK 0
#endif
#define REP(k) for (int _rep = 0; _rep < (((PROBE_MASK >> (k)) & 1) ? 2 : 1); ++_rep)
#define SEAM(k) do { if (IN(k) && IN((k) + 1)) { xcd_barrier(bar); if ((PROBE_MASK >> 15) & 1) xcd_barrier(bar); } } while (0)
#define FRESH() do { int _ln; asm volatile("v_mbcnt_lo_u32_b32 %0, -1, 0\n\tv_mbcnt_hi_u32_b32 %0, -1, %0" : "=v"(_ln)); int _wv = wave0; asm volatile("" : "+s"(_wv)); F.lane = _ln; F.wave = _wv; F.tid = (_wv << 6) | _ln; \
        unsigned char* _w = args.ws; asm volatile("" : "+s"(_w)); F.ws = _w; F.ctl = (unsigned*)(_w + WS_CTL); float* _o = args.out; asm volatile("" : "+s"(_o)); F.out = _o; } while (0)

    if (IN(0)) { FRESH(); REP(13) { p0_static_weights(F); __syncthreads(); } REP(14) { p0_mod(F); __syncthreads(); } FRESH(); REP(16) { p0_hyena_filters(F); __syncthreads(); } }
    SEAM(0);
    if (IN(1)) { FRESH(); p0_init_rows(F); __syncthreads(); FRESH(); p1_router_weights(F); }
    SEAM(1);
#pragma unroll 1
    for (int l = 0; l < DEPTH; ++l) {
        const int pb = 2 + l * PH_PER_LAYER; const bool last = (l == DEPTH - 1); const int ntok = last ? NLAT : NROW;
        if (IN(pb + 0)) { FRESH();
            REP(0) { p_expert_weights(F, l, (last || F.G != 256) ? 0 : XW_TAIL_G, XW_ITEMS, F.G * NWAVES, F.wg * NWAVES + F.wave); __syncthreads(); }
            { pg8::ColMapOrder S; S.b.init(NROW, 11 * 256, F.G, F.wg); S.map = 0xCBA98763210ull; pg8::EpiBf16 E{(bf16_t*)(F.ws + WS_U), DIN};
              REP(1) pg8::gemm_phase<pg8::EpiBf16, pg8::ColMapOrder, false>(F.tid, F.lds, (const bf16_t*)(F.ws + WS_XM), (const bf16_t*)(F.ws + WS_WIN) + (size_t)l * DIN * DM, DM, nullptr, S, E); }
            __syncthreads(); FRESH();
            { pg8::ColMapOrder S; S.b.init(NROW, 2 * 256, F.G, (F.wg + 80) % F.G); S.map = 0x54ull; pg8::EpiVT E{(bf16_t*)(F.ws + WS_VT), UV};
              REP(1) pg8::gemm_phase<pg8::EpiVT, pg8::ColMapOrder, false, false, true, true, false, true>(F.tid, F.lds, (const bf16_t*)(F.ws + WS_XM), (const bf16_t*)(F.ws + WS_WIN) + (size_t)l * DIN * DM, DM, nullptr, S, E); }
        }
        SEAM(pb + 0);
        if (IN(pb + 1)) { FRESH(); REP(2) { ph_transposes(F, l); __syncthreads(); } FRESH(); REP(3) { ph_gla_local(F, l); __syncthreads(); } }
        SEAM(pb + 1);
        if (IN(pb + 2)) { FRESH(); REP(4) { ph_na(F, l, last); } FRESH(); REP(5) { ph_gla_scan(F); } __syncthreads(); FRESH(); REP(6) { ph_hyena(F, l, last); } }
        SEAM(pb + 2);
        if (IN(pb + 3)) { FRESH(); ph_hy_transpose(F, last); __syncthreads(); FRESH(); REP(7) { ph_gla_out(F, l, last); } }
        SEAM(pb + 3);
        if (IN(pb + 4)) { FRESH();
            pg8::DenseOrder S; S.init(ntok, DM, F.G, F.wg); pg8::EpiY8 E{(unsigned char*)(F.ws + WS_Y), DM};
            REP(8) pg8::gemm_phase<pg8::EpiY8, pg8::DenseOrder, false>(F.tid, F.lds, (const bf16_t*)(F.ws + WS_MIX), (const bf16_t*)(F.ws + WS_WOUT) + (size_t)l * DM * DM, DM, nullptr, S, E);
            if (!last && F.G == 256 && F.wg >= 64) { __syncthreads(); FRESH(); p_expert_weights(F, l, 0, XW_TAIL_E, 192 * NWAVES, (F.wg - 64) * NWAVES + F.wave); }
        }
        SEAM(pb + 4);
        if (IN(pb + 5)) { FRESH(); ph_ln1(F, l, ntok); }
        SEAM(pb + 5);
        if (IN(pb + 6)) { FRESH();
            pg8::RouterOrder S; S.b.init(ntok, 256, F.G, F.wg); pg8::EpiF32H E{(float*)(F.ws + WS_LOGIT), 256};
            REP(9) pg8::gemm_phase<pg8::EpiF32H, pg8::RouterOrder, false, false, true, true, true>(F.tid, F.lds, (const bf16_t*)(F.ws + WS_XR), (const bf16_t*)(F.ws + WS_WRB) + (size_t)l * 17 * 128 * DM, DM, nullptr, S, E);
            if (!last && F.G == 256 && F.wg >= 16) { __syncthreads(); FRESH(); p_expert_weights(F, l, XW_TAIL_E, XW_TAIL_G, 240 * NWAVES, (F.wg - 16) * NWAVES + F.wave); }
        }
        SEAM(pb + 6);
        if (IN(pb + 7)) { FRESH(); ph_route(F, l, ntok); }
        SEAM(pb + 7);
        if (IN(pb + 8)) { FRESH(); REP(12) { ph_positions(F, l, ntok); __syncthreads(); } }
        SEAM(pb + 8);
        if (IN(pb + 9)) { FRESH();
            const int ntl = (int)__hip_atomic_load(F.ctl + CW_NTL + l, __ATOMIC_RELAXED, __HIP_MEMORY_SCOPE_AGENT);
            pg8::GroupedOrder S; S.init(ntl, 2, F.G, F.wg); S.preload((const int*)(F.ws + WS_TILEEXP), F.lds + pg8::STAGE_BYTES + 4096, F.tid, NTHR); pg8::EpiSwiglu E{(unsigned char*)(F.ws + WS_ACT)};
            REP(10) pg8::gemm_phase<pg8::EpiSwiglu, pg8::GroupedOrder, true, true>(F.tid, F.lds, (const void*)(F.ws + WS_XM8), (const void*)(F.ws + WS_EXP1), DM, (const int*)(F.ws + WS_ROWTOK), S, E);
        }
        SEAM(pb + 9);
        if (IN(pb + 10)) { FRESH();
            const int ntl = (int)__hip_atomic_load(F.ctl + CW_NTL + l, __ATOMIC_RELAXED, __HIP_MEMORY_SCOPE_AGENT);
            pg8::GroupedOrder S; S.init(ntl, 4, F.G, F.wg); S.preload((const int*)(F.ws + WS_TILEEXP), F.lds + pg8::STAGE_BYTES + 4096, F.tid, NTHR); pg8::EpiScatter E{(unsigned char*)(F.ws + WS_Y2), (const int*)(F.ws + WS_ROWDST)};
            REP(11) pg8::gemm_phase<pg8::EpiScatter, pg8::GroupedOrder, false, true>(F.tid, F.lds, (const void*)(F.ws + WS_ACT), (const void*)(F.ws + WS_EXP2), EH, nullptr, S, E);
        }
        SEAM(pb + 10);
        if (IN(pb + 11)) { FRESH(); ph_ln2(F, l, ntok, last); }
        SEAM(pb + 11);
    }
#undef IN
#undef SEAM
#undef FRESH
}

extern "C" void kernel_launch(void* const* d_in, const int* in_sizes, int n_in, void* d_out, int out_size, void* d_ws, size_t ws_size, hipStream_t stream) {
    static int grid = 0;
    if (grid == 0) {
        if (n_in != 36 || out_size != NLAT * DM || ws_size < WS_END) { fprintf(stderr, "kernel_launch: unexpected shapes (n_in %d out %d ws %zu need %zu)\n", n_in, out_size, ws_size, (size_t)WS_END); grid = -1; return; }
        int dev = 0, cus = 0, per_cu = 0;
        if (hipGetDevice(&dev) != hipSuccess || hipDeviceGetAttribute(&cus, hipDeviceAttributeMultiprocessorCount, dev) != hipSuccess) { grid = -1; return; }
        if (hipFuncSetAttribute((const void*)mk_fwd, hipFuncAttributeMaxDynamicSharedMemorySize, LDS_BYTES) != hipSuccess) { fprintf(stderr, "kernel_launch: hipFuncSetAttribute failed\n"); grid = -1; return; }
        if (hipOccupancyMaxActiveBlocksPerMultiprocessor(&per_cu, (const void*)mk_fwd, NTHR, LDS_BYTES) != hipSuccess || per_cu < 1) { fprintf(stderr, "kernel_launch: occupancy query says %d\n", per_cu); }
        (void)hipGetLastError();
        grid = cus;
    }
    if (grid < 0) return;
    (void)hipMemsetAsync((char*)d_ws + WS_CTL, 0, CTL_BYTES, stream);
    Args a{};
    for (int i = 0; i < 36; ++i) a.in[i] = (const float*)d_in[i];
    a.out = (float*)d_out; a.ws = (unsigned char*)d_ws;
#if MK_MULTI
    for (int p = 0; p < NPHASE; ++p) { a.ph_lo = p; a.ph_hi = p + 1; hipLaunchKernelGGL(mk_fwd, dim3(grid), dim3(NTHR), LDS_BYTES, stream, a); }
#else
    a.ph_lo = 0; a.ph_hi = NPHASE; hipLaunchKernelGGL(mk_fwd, dim3(grid), dim3(NTHR), LDS_BYTES, stream, a);
#endif
}
```

```cpp
#include <hip/hip_runtime.h>
#include <cstdio>
#include <cstdint>

#define LAS __attribute__((address_space(3)))
#define GAS __attribute__((address_space(1)))
typedef unsigned short bf16_t;
typedef short bf16x8 __attribute__((ext_vector_type(8)));
typedef float f32x4 __attribute__((ext_vector_type(4)));
typedef float f32x2 __attribute__((ext_vector_type(2)));
typedef unsigned u32x4 __attribute__((ext_vector_type(4)));
typedef unsigned u32x2 __attribute__((ext_vector_type(2)));

constexpr int NB = 16, SEQ = 4096, CTXL = 256, DM = 1024, DEPTH = 4;
constexpr int NLAT = NB * SEQ;
constexpr int NCTX = NB * CTXL;
constexpr int NROW = NLAT + NCTX;
constexpr int SPB = SEQ + CTXL;
constexpr int DIN_REF = 3104;
constexpr int DIN = 3328;
constexpr int UQ = 0, UK = 512, UV = 1024, UGQ = 1536, UGK = 1664, UGV = 1792, UGR = 2048, UHY = 2304, ULAF = 3072, ULAB = 3200;
constexpr int NEXP = 128, TOPK = 8, EH = 256;
constexpr int NE1 = NEXP + 1;
constexpr int RMAX = 659712;
constexpr int TMAX = RMAX / 256;
constexpr float LN_EPS = 1e-6f;
constexpr float DN_ALPHA = 1.6817928305074290f;

__device__ __forceinline__ unsigned f2bf(float f) { unsigned u = __builtin_bit_cast(unsigned, f); return (u + 0x7fffu + ((u >> 16) & 1u)) >> 16; }
typedef __bf16 bf16v2 __attribute__((ext_vector_type(2)));
__device__ __forceinline__ unsigned pk2(float lo, float hi) { const f32x2 v = {lo, hi}; const bf16v2 b = __builtin_convertvector(v, bf16v2); return __builtin_bit_cast(unsigned, b); }
__device__ __forceinline__ float bf2f(unsigned short b) { return __builtin_bit_cast(float, ((unsigned)b) << 16); }
__device__ __forceinline__ float bflo(unsigned w) { return __builtin_bit_cast(float, w << 16); }
__device__ __forceinline__ float bfhi(unsigned w) { return __builtin_bit_cast(float, w & 0xffff0000u); }
__device__ __forceinline__ float shx(float v, int o, int lane) { return __builtin_bit_cast(float, __builtin_amdgcn_ds_bpermute((lane ^ o) << 2, __builtin_bit_cast(int, v))); }
__device__ __forceinline__ int shxi(int v, int o, int lane) { return __builtin_amdgcn_ds_bpermute((lane ^ o) << 2, v); }
__device__ __forceinline__ float shf(float v, int src) { return __builtin_bit_cast(float, __builtin_amdgcn_ds_bpermute(src << 2, __builtin_bit_cast(int, v))); }
__device__ __forceinline__ float wave_sum(float v, int lane) {
#pragma unroll
    for (int o = 1; o < 64; o <<= 1) v += shx(v, o, lane);
    return v;
}
__device__ __forceinline__ void unpack8(const u32x4 q, float* o) { o[0] = bflo(q.x); o[1] = bfhi(q.x); o[2] = bflo(q.y); o[3] = bfhi(q.y); o[4] = bflo(q.z); o[5] = bfhi(q.z); o[6] = bflo(q.w); o[7] = bfhi(q.w); }
__device__ __forceinline__ float silu_f(float x) { return x * __builtin_amdgcn_rcpf(1.0f + __expf(-x)); }
#define LDS_WAIT() asm volatile("s_waitcnt lgkmcnt(0)" ::: "memory")
#define VM_WAIT() asm volatile("s_waitcnt vmcnt(0)" ::: "memory")

#define XB_TMO      128
#define XB_XCNT(j)  (256  + 64 * (j))
#define XB_XSUB(j)  (1280 + 64 * (j))
#define XB_XGEN(j)  (2304 + 64 * (j))
#define XB_TOP      3328
#define XB_TOPGEN   3392
#define XCD_BAR_WORDS 3456
#define XB_SPIN_CAP (1u << 18)

__device__ __forceinline__ unsigned xb_ld(unsigned* p)              { return __hip_atomic_load(p, __ATOMIC_RELAXED, __HIP_MEMORY_SCOPE_AGENT); }
__device__ __forceinline__ unsigned xb_add(unsigned* p, unsigned v) { return __hip_atomic_fetch_add(p, v, __ATOMIC_RELAXED, __HIP_MEMORY_SCOPE_AGENT); }
__device__ __forceinline__ unsigned xb_xcc_id() { return (unsigned)__builtin_amdgcn_s_getreg((3 << 11) | 20) & 0xFu; }
#define XB_SPIN(cond, bar) do { unsigned _sp = 0; while (cond) { __builtin_amdgcn_s_sleep(1); \
    if ((++_sp & 255u) == 0u) { if (xb_ld(&(bar)[XB_TMO])) break; if (_sp > XB_SPIN_CAP) { atomicAdd(&(bar)[XB_TMO], 1u); break; } } } } while (0)

struct XcdBarrier { unsigned* bar; unsigned x; volatile LAS unsigned* st; };

__device__ __forceinline__ XcdBarrier xcd_barrier_post(unsigned* bar, volatile LAS unsigned* st) {
    XcdBarrier b; b.bar = bar; b.x = xb_xcc_id(); b.st = st;
    if (threadIdx.x == 0) (void)xb_add(&bar[XB_XCNT(b.x)], 1u);
    return b;
}
__device__ __forceinline__ void xcd_barrier_complete(unsigned* bar, unsigned x, unsigned& nloc, unsigned& nx) {
    const unsigned G = gridDim.x * gridDim.y * gridDim.z;
    unsigned sum, cnt, mine, sp = 0u;
    for (;;) {
        sum = 0u; cnt = 0u; mine = 0u;
#pragma unroll
        for (unsigned j = 0; j < 16; ++j) { const unsigned c = xb_ld(&bar[XB_XCNT(j)]); sum += c; cnt += (c > 0u) ? 1u : 0u; mine = (j == x) ? c : mine; }
        if (sum == G) break;
        __builtin_amdgcn_s_sleep(1);
        if ((++sp & 255u) == 0u) { if (xb_ld(&bar[XB_TMO])) break; if (sp > XB_SPIN_CAP) { atomicAdd(&bar[XB_TMO], 1u); break; } }
    }
    nloc = mine > 0u ? mine : 1u; nx = cnt > 0u ? cnt : 1u;
}
__device__ __forceinline__ void xcd_barrier(const XcdBarrier& b) {
    asm volatile("s_waitcnt vmcnt(0)" ::: "memory");
    __syncthreads();
    if (threadIdx.x == 0) {
        unsigned* bar = b.bar;
        __builtin_amdgcn_s_waitcnt(0);
        unsigned nloc = b.st[0], nx = b.st[1];
        if (nloc == 0u) { xcd_barrier_complete(bar, b.x, nloc, nx); b.st[0] = nloc; b.st[1] = nx; }
        const unsigned old = xb_add(&bar[XB_XSUB(b.x)], 1u);
        const unsigned gen = old / nloc;
        if (old + 1u == (gen + 1u) * nloc) {
            __builtin_amdgcn_fence(__ATOMIC_RELEASE, "agent");
            asm volatile("s_waitcnt vmcnt(0)" ::: "memory");
            const unsigned og = xb_add(&bar[XB_TOP], 1u);
            const unsigned tg = og / nx;
            if (og + 1u == (tg + 1u) * nx) xb_add(&bar[XB_TOPGEN], 1u);
            else XB_SPIN(xb_ld(&bar[XB_TOPGEN]) == tg, bar);
            __builtin_amdgcn_fence(__ATOMIC_ACQUIRE, "agent");
            xb_add(&bar[XB_XGEN(b.x)], 1u);
            asm volatile("s_waitcnt vmcnt(0)" ::: "memory");
        } else {
            XB_SPIN(xb_ld(&bar[XB_XGEN(b.x)]) == gen, bar);
            __builtin_amdgcn_fence(__ATOMIC_ACQUIRE, "agent");
            asm volatile("s_waitcnt vmcnt(0)" ::: "memory");
        }
    }
    __syncthreads();
}

namespace pg8 {
constexpr int BM = 256, BK = 64, HALF = 128, HTB = HALF * BK * 2, STAGE_BYTES = 8 * HTB, NXCD = 8, WGM = 8;
__host__ __device__ __forceinline__ int lds_byte(int r, int c) { const int st = (r >> 4) * 2 + (c >> 5), rr = r & 15, cc = c & 31, ob = rr * 64 + cc * 2; return st * 1024 + (ob ^ (((ob >> 9) & 1) << 5)); }
__host__ __device__ __forceinline__ void stage_rc(int b, int& R, int& C) { const int st = b / 1024, sb = b % 1024, swz = sb ^ (((sb >> 9) & 1) << 5); R = (st >> 1) * 16 + swz / 64; C = (st & 1) * 32 + (swz % 64) / 2; }
__host__ __device__ __forceinline__ int perm32(int rho) { const int n = rho >> 4, i = rho & 15; return 8 * (i >> 2) + 4 * n + (i & 3); }

struct Unit { int arow0, brow0, orow0, ocol0, aux; };

struct DenseOrder {
    int nM, nN, nwg, G, c;
    __device__ void init(int M, int N, int G_, int c_) { nM = M / BM; nN = N / BM; nwg = nM * nN; G = G_; c = c_; }
    __device__ __forceinline__ bool next(int i, Unit& u) const {
        const long L = (long)i * G + c; if (L >= nwg) return false;
        int wgid = (int)L; { const int q = nwg / NXCD, r = nwg % NXCD, xcd = wgid % NXCD, off = wgid / NXCD; wgid = (xcd < r ? xcd * (q + 1) : r * (q + 1) + (xcd - r) * q) + off; }
        const int nig = WGM * nN, gid = wgid / nig, fm = gid * WGM, gsz = (nM - fm) < WGM ? (nM - fm) : WGM;
        const int pm = fm + ((wgid % nig) % gsz), pn = (wgid % nig) / gsz;
        u.arow0 = pm * BM; u.brow0 = pn * BM; u.orow0 = pm * BM; u.ocol0 = pn * BM; u.aux = 0; return true;
    }
};
struct GroupedOrder {
    const LAS unsigned char* tab; int nN, nslot, slot, t0, t1;
    __device__ __forceinline__ void init(int ntiles, int nN_, int G, int c) {
        nN = nN_;
        if ((G & 7) == 0) { const int per = (ntiles + 7) >> 3, x = c & 7; nslot = G >> 3; slot = c >> 3; t0 = x * per; t1 = (t0 + per) < ntiles ? (t0 + per) : ntiles; }
        else { nslot = G; slot = c; t0 = 0; t1 = ntiles; }
    }
    __device__ __forceinline__ void preload(const int* tile_exp, LAS unsigned char* lds_tab, int tid, int nthr) {
        __syncthreads();
        for (int i = tid; i < t1 - t0; i += nthr) lds_tab[i] = (unsigned char)tile_exp[t0 + i];
        __syncthreads();
        tab = lds_tab;
    }
    __device__ __forceinline__ bool next(int i, Unit& u) const {
        const int q = i * nslot + slot, t = t0 + q / nN, pn = q % nN;
        if (t >= t1) return false;
        const int e = (int)tab[t - t0];
        u.arow0 = t * BM; u.brow0 = (e * nN + pn) * BM; u.orow0 = t * BM; u.ocol0 = pn * BM; u.aux = e; return true;
    }
};

struct RouterOrder {
    DenseOrder b;
    __device__ __forceinline__ bool next(int i, Unit& u) const { if (!b.next(i, u)) return false; const int pm = u.arow0 >> 8; u.brow0 = (pm < 256 ? (pm >> 4) : 16) * 128; return true; }
};
struct ColMapOrder {
    DenseOrder b; unsigned long long map;
    __device__ __forceinline__ bool next(int i, Unit& u) const { if (!b.next(i, u)) return false; const int ph = (int)((map >> ((u.ocol0 >> 8) * 4)) & 15ull); u.brow0 = ph * BM; u.ocol0 = ph * BM; return true; }
};
template <class Base> struct RangeOrder {
    Base b; int i0, i1;
    __device__ __forceinline__ bool next(int i, Unit& u) const { const int j = i + i0; if (j >= i1) return false; return b.next(j, u); }
};

__device__ __forceinline__ unsigned cvt_pk_bf16(float lo, float hi) { return pk2(lo, hi); }

struct NoPre {};
struct EpiF32 {
    static constexpr bool PERM = false; static constexpr int SCW = 0x7A7A7A7A; typedef NoPre Pre;
    __device__ __forceinline__ Pre prefetch(const Unit&, LAS unsigned char*, int, int, int) const { return Pre{}; }
    float* C; int ldc;
    __device__ __forceinline__ void operator()(const f32x4 (&acc)[2][2][4][2], const Unit& u, int wr, int wc, int fr, int fq, const Pre&, bool drain) const {
        if (drain) asm volatile("s_waitcnt vmcnt(0)" ::: "memory");
        const int row0 = u.orow0 + wr * 64 + fr, col0 = u.ocol0 + wc * 32 + 4 * fq;
#pragma unroll
        for (int ai = 0; ai < 2; ++ai)
#pragma unroll
            for (int m = 0; m < 4; ++m) { float* rowp = C + (size_t)(row0 + ai * HALF + m * 16) * ldc + col0;
#pragma unroll
                for (int bj = 0; bj < 2; ++bj)
#pragma unroll
                    for (int n = 0; n < 2; ++n) *(GAS f32x4*)(rowp + bj * HALF + n * 16) = acc[ai][bj][m][n]; }
    }
};
struct EpiF32H {
    static constexpr bool PERM = false; static constexpr int SCW = 0x7A7A7A7A; typedef NoPre Pre;
    __device__ __forceinline__ Pre prefetch(const Unit&, LAS unsigned char*, int, int, int) const { return Pre{}; }
    float* C; int ldc;
    __device__ __forceinline__ void operator()(const f32x4 (&acc)[2][2][4][2], const Unit& u, int wr, int wc, int fr, int fq, const Pre&, bool drain) const {
        if (drain) asm volatile("s_waitcnt vmcnt(0)" ::: "memory");
        const int row0 = u.orow0 + wr * 64 + fr, col0 = wc * 32 + 4 * fq;
#pragma unroll
        for (int ai = 0; ai < 2; ++ai)
#pragma unroll
            for (int m = 0; m < 4; ++m) { float* rowp = C + (size_t)(row0 + ai * HALF + m * 16) * ldc + col0;
#pragma unroll
                for (int n = 0; n < 2; ++n) *(GAS f32x4*)(rowp + n * 16) = acc[ai][0][m][n]; }
    }
};
struct EpiBf16 {
    static constexpr bool PERM = true; static constexpr int SCW = 0x7A7A7A7A; typedef NoPre Pre;
    __device__ __forceinline__ Pre prefetch(const Unit&, LAS unsigned char*, int, int, int) const { return Pre{}; }
    bf16_t* O; int ldc;
    __device__ __forceinline__ void operator()(const f32x4 (&acc)[2][2][4][2], const Unit& u, int wr, int wc, int fr, int fq, const Pre&, bool drain) const {
        const int row0 = u.orow0 + wr * 64 + fr, col0 = u.ocol0 + wc * 32 + 8 * fq;
        u32x4 w[2][4][2];
#pragma unroll
        for (int ai = 0; ai < 2; ++ai)
#pragma unroll
            for (int m = 0; m < 4; ++m)
#pragma unroll
                for (int bj = 0; bj < 2; ++bj) { const f32x4 v0 = acc[ai][bj][m][0], v1 = acc[ai][bj][m][1];
                    w[ai][m][bj].x = cvt_pk_bf16(v0[0], v0[1]); w[ai][m][bj].y = cvt_pk_bf16(v0[2], v0[3]); w[ai][m][bj].z = cvt_pk_bf16(v1[0], v1[1]); w[ai][m][bj].w = cvt_pk_bf16(v1[2], v1[3]); }
        if (drain) asm volatile("s_waitcnt vmcnt(0)" ::: "memory");
#pragma unroll
        for (int ai = 0; ai < 2; ++ai)
#pragma unroll
            for (int m = 0; m < 4; ++m) { bf16_t* rowp = O + (size_t)(row0 + ai * HALF + m * 16) * ldc + col0;
#pragma unroll
                for (int bj = 0; bj < 2; ++bj) *(GAS u32x4*)(rowp + bj * HALF) = w[ai][m][bj]; }
    }
};
struct EpiVT {
    static constexpr bool PERM = false; static constexpr int SCW = 0x7A7A7A7A; typedef NoPre Pre;
    __device__ __forceinline__ Pre prefetch(const Unit&, LAS unsigned char*, int, int, int) const { return Pre{}; }
    bf16_t* VT; int col_base;
    __device__ __forceinline__ void operator()(const f32x4 (&acc)[2][2][4][2], const Unit& u, int wr, int wc, int fr, int fq, const Pre&, bool drain) const {
        if (drain) asm volatile("s_waitcnt vmcnt(0)" ::: "memory");
        const int r0 = u.orow0; int b, pos0;
        if (r0 < NLAT) { b = r0 >> 12; pos0 = r0 & 4095; } else { b = (r0 - NLAT) >> 8; pos0 = SEQ + ((r0 - NLAT) & 255); }
        bf16_t* base = VT + ((size_t)b * 512 + (u.ocol0 - col_base) + wc * 32 + fr) * SPB + pos0 + wr * 64 + 4 * fq;
#pragma unroll
        for (int ai = 0; ai < 2; ++ai)
#pragma unroll
            for (int bj = 0; bj < 2; ++bj)
#pragma unroll
                for (int m = 0; m < 4; ++m)
#pragma unroll
                    for (int n = 0; n < 2; ++n) { const f32x4 v = acc[ai][bj][m][n];
                        *(GAS u32x2*)(base + (size_t)(bj * HALF + n * 16) * SPB + ai * HALF + m * 16) = (u32x2){cvt_pk_bf16(v[0], v[1]), cvt_pk_bf16(v[2], v[3])}; }
    }
};
struct EpiY8 {
    static constexpr bool PERM = true; static constexpr int SCW = 0x7A7A7A7A; typedef NoPre Pre;
    __device__ __forceinline__ Pre prefetch(const Unit&, LAS unsigned char*, int, int, int) const { return Pre{}; }
    unsigned char* O; int ldc;
    __device__ __forceinline__ void operator()(const f32x4 (&acc)[2][2][4][2], const Unit& u, int wr, int wc, int fr, int fq, const Pre&, bool drain) const {
        const int row0 = u.orow0 + wr * 64 + fr;
        u32x4 o[2][4];
#pragma unroll
        for (int ai = 0; ai < 2; ++ai)
#pragma unroll
            for (int m = 0; m < 4; ++m) { int w[4];
#pragma unroll
                for (int bj = 0; bj < 2; ++bj) { const f32x4 v0 = acc[ai][bj][m][0], v1 = acc[ai][bj][m][1];
                    int w0 = 0, w1 = 0;
                    w0 = __builtin_amdgcn_cvt_pk_fp8_f32(v0[0], v0[1], w0, false); w0 = __builtin_amdgcn_cvt_pk_fp8_f32(v0[2], v0[3], w0, true);
                    w1 = __builtin_amdgcn_cvt_pk_fp8_f32(v1[0], v1[1], w1, false); w1 = __builtin_amdgcn_cvt_pk_fp8_f32(v1[2], v1[3], w1, true);
                    w[2 * bj] = w0; w[2 * bj + 1] = w1; }
                o[ai][m] = (u32x4){(unsigned)w[0], (unsigned)w[1], (unsigned)w[2], (unsigned)w[3]}; }
        if (drain) asm volatile("s_waitcnt vmcnt(0)" ::: "memory");
#pragma unroll
        for (int ai = 0; ai < 2; ++ai)
#pragma unroll
            for (int m = 0; m < 4; ++m) *(GAS u32x4*)(O + (size_t)(row0 + ai * HALF + m * 16) * ldc + u.ocol0 + wc * 64 + fq * 16) = o[ai][m];
    }
};
struct EpiSwiglu {
    static constexpr bool PERM = true; static constexpr int SCW = 0x7A7A7A7A; typedef NoPre Pre;
    __device__ __forceinline__ Pre prefetch(const Unit&, LAS unsigned char*, int, int, int) const { return Pre{}; }
    unsigned char* ACT;
    __device__ __forceinline__ void operator()(const f32x4 (&acc)[2][2][4][2], const Unit& u, int wr, int wc, int fr, int fq, const Pre&, bool drain) const {
        const int row0 = u.orow0 + wr * 64 + fr, pn = u.ocol0 >> 8;
        u32x2 o[2][4];
#pragma unroll
        for (int ai = 0; ai < 2; ++ai)
#pragma unroll
            for (int m = 0; m < 4; ++m) {
                int w[2];
#pragma unroll
                for (int n = 0; n < 2; ++n) { const f32x4 g = acc[ai][0][m][n], up = acc[ai][1][m][n];
                    f32x4 e;
#pragma unroll
                    for (int i = 0; i < 4; ++i) e[i] = __builtin_amdgcn_exp2f(-g[i]);
                    const f32x4 d = e + 1.0f; f32x4 r;
#pragma unroll
                    for (int i = 0; i < 4; ++i) r[i] = __builtin_amdgcn_rcpf(d[i]);
                    const f32x4 h = (g * up) * r;
                    int v = 0; v = __builtin_amdgcn_cvt_pk_fp8_f32(h[0], h[1], v, false); v = __builtin_amdgcn_cvt_pk_fp8_f32(h[2], h[3], v, true); w[n] = v; }
                o[ai][m] = (u32x2){(unsigned)w[0], (unsigned)w[1]}; }
        if (drain) asm volatile("s_waitcnt vmcnt(0)" ::: "memory");
#pragma unroll
        for (int ai = 0; ai < 2; ++ai)
#pragma unroll
            for (int m = 0; m < 4; ++m) *(GAS u32x2*)(ACT + (size_t)(row0 + ai * HALF + m * 16) * EH + pn * 128 + wc * 32 + 8 * fq) = o[ai][m];
    }
};
constexpr float Y2_SCALE = 8.0f, Y2_INV = 1.0f / 8.0f;
struct EpiScatter {
    static constexpr bool PERM = true; static constexpr int SCW = 0x7D7D7D7D;
    struct Pre { const LAS int* tab; };
    unsigned char* Y2; const int* rowdst;
    __device__ __forceinline__ Pre prefetch(const Unit& u, LAS unsigned char* lds, int wid, int lane, int ui) const {
        LAS unsigned char* tab = lds + STAGE_BYTES + (ui & 1) * 1024;
        if (wid < 4) __builtin_amdgcn_global_load_lds((const unsigned*)(rowdst + u.orow0 + wid * 64 + lane), (LAS unsigned*)(tab + wid * 256), 4, 0, 0);
        Pre p; p.tab = (const LAS int*)tab; return p; }
    __device__ __forceinline__ void operator()(const f32x4 (&acc)[2][2][4][2], const Unit& u, int wr, int wc, int fr, int fq, const Pre& pre, bool drain) const {
        if (u.aux == 128) {
            u32x4 o[2][4];
#pragma unroll
            for (int ai = 0; ai < 2; ++ai)
#pragma unroll
                for (int m = 0; m < 4; ++m) { int w[4];
#pragma unroll
                    for (int bj = 0; bj < 2; ++bj) { const f32x4 v0 = acc[ai][bj][m][0], v1 = acc[ai][bj][m][1];
                        int w0 = 0, w1 = 0;
                        w0 = __builtin_amdgcn_cvt_pk_fp8_f32(v0[0], v0[1], w0, false); w0 = __builtin_amdgcn_cvt_pk_fp8_f32(v0[2], v0[3], w0, true);
                        w1 = __builtin_amdgcn_cvt_pk_fp8_f32(v1[0], v1[1], w1, false); w1 = __builtin_amdgcn_cvt_pk_fp8_f32(v1[2], v1[3], w1, true);
                        w[2 * bj] = w0; w[2 * bj + 1] = w1; }
                    o[ai][m] = (u32x4){(unsigned)w[0], (unsigned)w[1], (unsigned)w[2], (unsigned)w[3]}; }
            if (drain) asm volatile("s_waitcnt vmcnt(0)" ::: "memory");
#pragma unroll
            for (int ai = 0; ai < 2; ++ai)
#pragma unroll
                for (int m = 0; m < 4; ++m) { const int dst = pre.tab[wr * 64 + fr + ai * HALF + m * 16];
                    if (dst >= 0) *(GAS u32x4*)(Y2 + (size_t)dst * 512 + u.ocol0 + wc * 64 + fq * 16) = o[ai][m]; }
        } else {
            u32x2 o[2][4];
#pragma unroll
            for (int ai = 0; ai < 2; ++ai)
#pragma unroll
                for (int m = 0; m < 4; ++m) { unsigned w[2];
#pragma unroll
                    for (int bj = 0; bj < 2; ++bj) { const f32x4 v0 = acc[ai][bj][m][0], v1 = acc[ai][bj][m][1];
                        unsigned x = 0u;
                        x = __builtin_amdgcn_cvt_scalef32_pk_fp4_f32(x, v0[0], v0[1], 1.0f, 0); x = __builtin_amdgcn_cvt_scalef32_pk_fp4_f32(x, v0[2], v0[3], 1.0f, 1);
                        x = __builtin_amdgcn_cvt_scalef32_pk_fp4_f32(x, v1[0], v1[1], 1.0f, 2); x = __builtin_amdgcn_cvt_scalef32_pk_fp4_f32(x, v1[2], v1[3], 1.0f, 3);
                        w[bj] = x; }
                    o[ai][m] = (u32x2){w[0], w[1]}; }
            if (drain) asm volatile("s_waitcnt vmcnt(0)" ::: "memory");
#pragma unroll
            for (int ai = 0; ai < 2; ++ai)
#pragma unroll
                for (int m = 0; m < 4; ++m) { const int dst = pre.tab[wr * 64 + fr + ai * HALF + m * 16];
                    if (dst >= 0) *(GAS u32x2*)(Y2 + (size_t)dst * 512 + (u.ocol0 >> 1) + wc * 32 + fq * 8) = o[ai][m]; }
        }
    }
};

typedef int v8i __attribute__((ext_vector_type(8)));
typedef int v4i __attribute__((ext_vector_type(4)));
struct Frag { bf16x8 p[2]; __device__ __forceinline__ bf16x8& operator[](int k) { return p[k]; } __device__ __forceinline__ const bf16x8& operator[](int k) const { return p[k]; } };
template <class Epi, class Sched, bool GATHER, bool F8 = false, bool ALIGN_EPI = true, bool SP2 = true, bool NHALF = false, bool SWAP = false>
__device__ __forceinline__ void gemm_phase(const int tid_in, LAS unsigned char* lds, const void* Ag, const void* Bg, const int K, const int* rowidx, const Sched& S, const Epi& E) {
    int tid_ = tid_in; asm volatile("" : "+v"(tid_));
    const int tid = tid_, wid = __builtin_amdgcn_readfirstlane(tid >> 6), lane = tid & 63, wr = wid >> 2, wc = wid & 3, fr = lane & 15, fq = lane >> 4;
    const int KB = F8 ? K : 2 * K;
    const int nt = KB / 128;
    unsigned voffB[2];
#pragma unroll
    for (int i = 0; i < 2; ++i) { int R, C; stage_rc(tid * 16 + i * 8192, R, C); const int Rb = Epi::PERM ? ((R & ~31) + perm32(R & 31)) : R;
        voffB[i] = (unsigned)(Rb * KB + C * 2); }
    const size_t kstep = (size_t)128;
    const size_t hstep = (size_t)HALF * KB;
    const unsigned ldsw = (unsigned)wid * 1024u;
    const int aoff = F8 ? lds_byte(wr * 64 + fr, 16 * fq) : lds_byte(wr * 64 + fr, fq * 8), boff = F8 ? lds_byte(wc * 32 + fr, 16 * fq) : lds_byte(wc * 32 + fr, fq * 8);
    constexpr int PIECE1 = F8 ? 16 : 1024;
    const int sc_w = Epi::SCW, sc_a = 0x7F7F7F7F;
#define PG8_SA(b, h) (((b) * 2 + (h)) * HTB)
#define PG8_SB(b, h) ((4 + (b) * 2 + (h)) * HTB)
#define PG8_STAGE_B(bufoff, gbase) do { _Pragma("unroll") for (int _i = 0; _i < 2; ++_i) \
        __builtin_amdgcn_global_load_lds((const unsigned*)((const char*)(gbase) + voffB[_i]), (LAS unsigned*)(lds + (bufoff) + ldsw + _i * 8192), 16, 0, 0); } while (0)
#define PG8_STAGE_A(bufoff, gbase, h) do { const char* _gb = (const char*)(gbase) + (GATHER ? (size_t)0 : (size_t)(h) * hstep); \
        __builtin_amdgcn_global_load_lds((const unsigned*)(_gb + ac[GATHER ? (h) : 0][0]), (LAS unsigned*)(lds + (bufoff) + ldsw), 16, 0, 0); \
        __builtin_amdgcn_global_load_lds((const unsigned*)(_gb + ac[GATHER ? (h) : 0][1]), (LAS unsigned*)(lds + (bufoff) + ldsw + 8192), 16, 0, 0); } while (0)
#define PG8_LDA(dst, b, h) do { _Pragma("unroll") for (int m = 0; m < 4; ++m) { if constexpr (F8) { const v4i _l = *(const LAS v4i*)(lds + PG8_SA(b, h) + aoff + m * 2048), _h = *(const LAS v4i*)(lds + PG8_SA(b, h) + aoff + m * 2048 + PIECE1); dst##8[m] = __builtin_shufflevector(_l, _h, 0, 1, 2, 3, 4, 5, 6, 7); } \
        else { dst[m][0] = *(const LAS bf16x8*)(lds + PG8_SA(b, h) + aoff + m * 2048); dst[m][1] = *(const LAS bf16x8*)(lds + PG8_SA(b, h) + aoff + m * 2048 + PIECE1); } } } while (0)
#define PG8_LDB(dst, b, h) do { _Pragma("unroll") for (int n = 0; n < 2; ++n) { if constexpr (F8) { const v4i _l = *(const LAS v4i*)(lds + PG8_SB(b, h) + boff + n * 2048), _h = *(const LAS v4i*)(lds + PG8_SB(b, h) + boff + n * 2048 + PIECE1); dst##8[n] = __builtin_shufflevector(_l, _h, 0, 1, 2, 3, 4, 5, 6, 7); } \
        else { dst[n][0] = *(const LAS bf16x8*)(lds + PG8_SB(b, h) + boff + n * 2048); dst[n][1] = *(const LAS bf16x8*)(lds + PG8_SB(b, h) + boff + n * 2048 + PIECE1); } } } while (0)
#define PG8_MMA(ai, bj, At, Bt) do { __builtin_amdgcn_s_setprio(1); _Pragma("unroll") for (int m = 0; m < 4; ++m) _Pragma("unroll") for (int n = 0; n < 2; ++n) { \
        if constexpr (F8) asm volatile("v_mfma_scale_f32_16x16x128_f8f6f4 %0, %1, %2, %0, %3, %4 op_sel_hi:[0,0,0]" : "+v"(acc[ai][bj][m][n]) : "v"(Bt##8[n]), "v"(At##8[m]), "v"(sc_w), "v"(sc_a)); \
        else { _Pragma("unroll") for (int k = 0; k < 2; ++k) acc[ai][bj][m][n] = SWAP ? __builtin_amdgcn_mfma_f32_16x16x32_bf16(At[m][k], Bt[n][k], acc[ai][bj][m][n], 0, 0, 0) : __builtin_amdgcn_mfma_f32_16x16x32_bf16(Bt[n][k], At[m][k], acc[ai][bj][m][n], 0, 0, 0); } } \
        __builtin_amdgcn_s_setprio(0); } while (0)
#define PG8_WAIT_V(n) asm volatile("s_waitcnt vmcnt(" #n ")" ::: "memory")
#define PG8_WAIT_LOOP do { if constexpr (NHALF) PG8_WAIT_V(6); else PG8_WAIT_V(8); } while (0)
#define PG8_WAIT_L(n) asm volatile("s_waitcnt lgkmcnt(" #n ")" ::: "memory")
#define PG8_BAR __builtin_amdgcn_s_barrier()
#define PG8_SCHED __builtin_amdgcn_sched_barrier(0)
#define PG8_TAB(par) (lds + STAGE_BYTES + 2048 + (par) * 1024)
#define PG8_TABLOAD(par, row0) do { if (wid < 4) __builtin_amdgcn_global_load_lds((const unsigned*)(rowidx + (row0) + wid * 64 + lane), (LAS unsigned*)(PG8_TAB(par) + wid * 256), 4, 0, 0); } while (0)
#define PG8_AOFF_H(h, par) do { int _tz = tid; asm volatile("" : "+v"(_tz)); _Pragma("unroll") for (int _i = 0; _i < 2; ++_i) { int _R, _C; stage_rc(_tz * 16 + _i * 8192, _R, _C); \
        if (GATHER) ac[h][_i] = ((const LAS unsigned*)PG8_TAB(par))[(h) * HALF + _R] * (unsigned)KB + (unsigned)_C * 2u; \
        else ac[h][_i] = (unsigned)(((h) * HALF + _R) * KB) + (unsigned)_C * 2u; } } while (0)
    static_assert(SP2, "only the two-super-phase K-loop is kept");
    Unit cur, nxt; int ui = 0;
    if (!S.next(0, cur)) return;
    f32x4 acc[2][2][4][2];
#pragma unroll
    for (int a = 0; a < 2; ++a)
#pragma unroll
        for (int b = 0; b < 2; ++b)
#pragma unroll
            for (int m = 0; m < 4; ++m)
#pragma unroll
                for (int n = 0; n < 2; ++n) acc[a][b][m][n] = (f32x4){0.f, 0.f, 0.f, 0.f};
    bf16x8 At[F8 ? 1 : 4][2], B0[F8 ? 1 : 2][2], B1[F8 ? 1 : 2][2];
    v8i At8[F8 ? 4 : 1], B08[F8 ? 2 : 1], B18[F8 ? 2 : 1];
    unsigned ac[GATHER ? 2 : 1][2];
    if (GATHER) { PG8_TABLOAD(0, cur.arow0); PG8_WAIT_V(0); PG8_BAR; }
    PG8_AOFF_H(0, 0); if (GATHER) { PG8_AOFF_H((GATHER ? 1 : 0), 0); }
    const char* cA = (const char*)Ag + (GATHER ? (size_t)0 : (size_t)cur.arow0 * KB); const char* cB = (const char*)Bg + (size_t)cur.brow0 * KB;
    PG8_STAGE_B(PG8_SB(0, 0), cB); if constexpr (!NHALF) PG8_STAGE_B(PG8_SB(0, 1), cB + hstep); PG8_STAGE_A(PG8_SA(0, 0), cA, 0); PG8_STAGE_A(PG8_SA(0, 1), cA, 1);
    if (wr == 1) PG8_BAR;
    PG8_WAIT_V(2); PG8_BAR;
    PG8_STAGE_B(PG8_SB(1, 0), cB + kstep); PG8_STAGE_A(PG8_SA(1, 0), cA + kstep, 0); if constexpr (!NHALF) PG8_STAGE_B(PG8_SB(1, 1), cB + hstep + kstep);
    if constexpr (NHALF) PG8_WAIT_V(4); else PG8_WAIT_V(6);
    PG8_BAR;
    for (;;) {
        const typename Epi::Pre pre = E.prefetch(cur, lds, wid, lane, ui);
        const bool has_next = S.next(ui + 1, nxt);
        if (GATHER) { if (has_next) PG8_TABLOAD((ui + 1) & 1, nxt.arow0); }
        const char* nA = has_next ? ((const char*)Ag + (GATHER ? (size_t)0 : (size_t)nxt.arow0 * KB)) : cA; const char* nB = has_next ? (const char*)Bg + (size_t)nxt.brow0 * KB : cB;
_Pragma("nounroll")
        for (int t = 0; t < nt; t += 2) {
            const bool last = (t == nt - 2);
            const bool skipw = (t == 0) && (ui > 0);
            const char* a1 = cA + (size_t)(t + 1) * kstep;
            const char* a2 = last ? nA : cA + (size_t)(t + 2) * kstep; const char* b2 = last ? nB : cB + (size_t)(t + 2) * kstep;
            const char* a3 = a2 + kstep; const char* b3 = b2 + kstep;
            if (GATHER) { if (last && has_next) { PG8_AOFF_H(0, (ui + 1) & 1); } }
            PG8_LDB(B0, 0, 0); if constexpr (!NHALF) PG8_LDB(B1, 0, 1); PG8_SCHED; PG8_LDA(At, 0, 0); PG8_STAGE_A(PG8_SA(1, 1), a1, 1);
            if (!skipw) PG8_WAIT_LOOP; PG8_WAIT_L(0); PG8_BAR; PG8_MMA(0, 0, At, B0); if constexpr (!NHALF) PG8_MMA(0, 1, At, B1); PG8_BAR; PG8_SCHED;
            if (GATHER) { if (last && has_next) { PG8_AOFF_H(1, (ui + 1) & 1); } }
            PG8_LDA(At, 0, 1); PG8_STAGE_B(PG8_SB(0, 0), b2); if constexpr (!NHALF) PG8_STAGE_B(PG8_SB(0, 1), b2 + hstep); PG8_STAGE_A(PG8_SA(0, 0), a2, 0);
            if (!skipw) PG8_WAIT_LOOP; PG8_WAIT_L(0); PG8_BAR; PG8_MMA(1, 0, At, B0); if constexpr (!NHALF) PG8_MMA(1, 1, At, B1); PG8_BAR; PG8_SCHED;
            PG8_LDB(B0, 1, 0); if constexpr (!NHALF) PG8_LDB(B1, 1, 1); PG8_SCHED; PG8_LDA(At, 1, 0); PG8_STAGE_A(PG8_SA(0, 1), a2, 1);
            if (!skipw) PG8_WAIT_LOOP; PG8_WAIT_L(0); PG8_BAR; PG8_MMA(0, 0, At, B0); if constexpr (!NHALF) PG8_MMA(0, 1, At, B1); PG8_BAR; PG8_SCHED;
            PG8_LDA(At, 1, 1); PG8_STAGE_B(PG8_SB(1, 0), b3); if constexpr (!NHALF) PG8_STAGE_B(PG8_SB(1, 1), b3 + hstep); PG8_STAGE_A(PG8_SA(1, 0), a3, 0);
            PG8_WAIT_LOOP; PG8_WAIT_L(0); PG8_BAR; PG8_MMA(1, 0, At, B0); if constexpr (!NHALF) PG8_MMA(1, 1, At, B1); PG8_BAR; PG8_SCHED;
        }
        if constexpr (ALIGN_EPI) { if (wr == 0) PG8_BAR; }
        E(acc, cur, wr, wc, fr, fq, pre, has_next);
        if (!has_next) break;
#pragma unroll
        for (int a = 0; a < 2; ++a)
#pragma unroll
            for (int b = 0; b < 2; ++b)
#pragma unroll
                for (int m = 0; m < 4; ++m)
#pragma unroll
                    for (int n = 0; n < 2; ++n) acc[a][b][m][n] = (f32x4){0.f, 0.f, 0.f, 0.f};
        cur = nxt; cA = nA; cB = nB; ++ui;
        if constexpr (ALIGN_EPI) { if (wr == 1) PG8_BAR; }
    }
    PG8_WAIT_V(0);
    if constexpr (!ALIGN_EPI) { if (wr == 0) PG8_BAR; }
    PG8_BAR;
#undef PG8_SA
#undef PG8_SB
#undef PG8_STAGE_A
#undef PG8_STAGE_B
#undef PG8_LDA
#undef PG8_LDB
#undef PG8_MMA
#undef PG8_WAIT_V
#undef PG8_WAIT_L
#undef PG8_WAIT_LOOP
#undef PG8_BAR
#undef PG8_SCHED
#undef PG8_AOFF_H
#undef PG8_TAB
#undef PG8_TABLOAD
}
}

constexpr int NWAVES = 8, NTHR = 512;
constexpr size_t MiB = 1u << 20;
constexpr size_t WS_CTL = 0, CTL_BYTES = 1 * MiB;
constexpr size_t WS_MOD = 1 * MiB;
constexpr size_t WS_WIN = 3 * MiB;
constexpr size_t WS_WOUT = 29 * MiB;
constexpr size_t WS_WR = 37 * MiB;
constexpr size_t WS_HYF = 39 * MiB;
constexpr size_t WS_HYFC = 71 * MiB;
constexpr size_t WS_XC = 73 * MiB;
constexpr size_t WS_EXP1 = 89 * MiB;
constexpr size_t WS_EXP2 = 218 * MiB;
constexpr size_t WS_XM = 283 * MiB;
constexpr size_t WS_EIDX = 419 * MiB;
constexpr size_t WS_WGT = 422 * MiB;
constexpr size_t WS_RNK = 425 * MiB;
constexpr size_t WS_ROWTOK = 428 * MiB;
constexpr size_t WS_ROWDST = 431 * MiB;
constexpr size_t WS_TILEEXP = 434 * MiB;
constexpr size_t WS_BIG = 435 * MiB;
constexpr size_t WS_U = WS_BIG;
constexpr size_t WS_MIX = 877 * MiB;
constexpr size_t WS_VT = 1013 * MiB;
constexpr size_t WS_HV = 1081 * MiB;
constexpr size_t WS_Z2 = 1183 * MiB;
constexpr size_t WS_GDS = 1217 * MiB;
constexpr size_t WS_GSIN = 1285 * MiB;
constexpr size_t WS_GD = 1319 * MiB;
constexpr size_t WS_Y = 1321 * MiB;
constexpr size_t WS_LOGIT = WS_BIG;
constexpr size_t WS_ACT = WS_BIG;
constexpr size_t WS_Y2 = 758 * MiB;
constexpr size_t WS_XM8 = 1470 * MiB;
constexpr size_t WS_WRB = 1540 * MiB;
constexpr size_t WS_RBIAS = 1558 * MiB;
constexpr size_t WS_XR = 1600 * MiB;
constexpr size_t WS_END = 1736 * MiB;
constexpr int CW_BAR = 4096;
constexpr int CW_CNT = 16384;
constexpr int CW_NTL = 20480;

constexpr int LDS_BYTES = 163840;
constexpr int MISC_OFF = 163584;

struct Frame {
    LAS unsigned char* lds;
    int tid, lane, wave, G, wg;
    const float* const* in;
    float* out; unsigned char* ws; unsigned* ctl;
};
enum { I_X = 0, I_C, I_CTX, I_CCTX, I_WMOD, I_BMOD, I_WIN, I_RPB, I_WA2, I_BA2, I_GNORM, I_HSW, I_HSB, I_HW1, I_HB1, I_HF1, I_HW2, I_HB2, I_HF2, I_HW3, I_HB3, I_HDEC, I_HSKIP,
       I_WOUT, I_LN1G, I_LN1B, I_RW, I_RB, I_WEG, I_WEU, I_WED, I_WSG, I_WSU, I_WSD, I_LN2G, I_LN2B };

__device__ __forceinline__ int row_b(int row) { return row < NLAT ? (row >> 12) : 16; }
__device__ __forceinline__ const float* mod_ptr(const Frame& F, int l, int row) { return (const float*)(F.ws + WS_MOD) + ((size_t)l * 17 + row_b(row)) * 6144; }

constexpr float NA_QSCALE = 0.125f * 1.4426950408889634f, NA_CLAMP = 60.0f * 1.4426950408889634f;
template <class RowFn>
__device__ __forceinline__ void tr_item(const float* W, int ldw, int k0, int n0, bf16_t* dst, int ldd, RowFn rf, LAS float* scr, int lane, float scale = 1.0f) {
    float tv[32];
    const GAS float* wp = (const GAS float*)(W + (size_t)(k0 + (lane >> 5)) * ldw + n0 + (lane & 31));
#pragma unroll
    for (int i = 0; i < 32; ++i) tv[i] = __builtin_nontemporal_load(wp + (size_t)(2 * i) * ldw);
#pragma unroll
    for (int i = 0; i < 32; ++i) scr[(2 * i + (lane >> 5)) * 33 + (lane & 31)] = tv[i];
    LDS_WAIT(); asm volatile("" ::: "memory");
    const int c = lane & 7;
#pragma unroll
    for (int j = 0; j < 4; ++j) { const int n = (lane >> 3) + 8 * j; const LAS float* s = scr + (8 * c) * 33 + n;
        u32x4 o; o.x = pk2(s[0 * 33] * scale, s[1 * 33] * scale); o.y = pk2(s[2 * 33] * scale, s[3 * 33] * scale); o.z = pk2(s[4 * 33] * scale, s[5 * 33] * scale); o.w = pk2(s[6 * 33] * scale, s[7 * 33] * scale);
        *(GAS u32x4*)(dst + (size_t)rf(n0 + n) * ldd + k0 + 8 * c) = o; }
    LDS_WAIT(); asm volatile("" ::: "memory");
}
template <class RowFn>
__device__ __forceinline__ void tr_item_ks(const float* W, int ldw, int k0, int n0, bf16_t* dst, int ldd, RowFn rf, LAS float* scr, int lane, const float* ksc) {
    float tv[32];
    const GAS float* wp = (const GAS float*)(W + (size_t)(k0 + (lane >> 5)) * ldw + n0 + (lane & 31));
#pragma unroll
    for (int i = 0; i < 32; ++i) tv[i] = wp[(size_t)(2 * i) * ldw];
#pragma unroll
    for (int i = 0; i < 32; ++i) scr[(2 * i + (lane >> 5)) * 33 + (lane & 31)] = tv[i] * (1.0f + ksc[2 * i + (lane >> 5)]);
    LDS_WAIT(); asm volatile("" ::: "memory");
    const int c = lane & 7;
#pragma unroll
    for (int j = 0; j < 4; ++j) { const int n = (lane >> 3) + 8 * j; const LAS float* s = scr + (8 * c) * 33 + n;
        u32x4 o; o.x = pk2(s[0 * 33], s[1 * 33]); o.y = pk2(s[2 * 33], s[3 * 33]); o.z = pk2(s[4 * 33], s[5 * 33]); o.w = pk2(s[6 * 33], s[7 * 33]);
        *(GAS u32x4*)(dst + (size_t)rf(n0 + n) * ldd + k0 + 8 * c) = o; }
    LDS_WAIT(); asm volatile("" ::: "memory");
}
template <class RowFn>
__device__ __forceinline__ void tr_item8(const float* W, int ldw, int k0, int n0, unsigned char* dst, int ldd, RowFn rf, float scale, LAS float* scr, int lane) {
    float tv[32];
    const GAS float* wp = (const GAS float*)(W + (size_t)(k0 + (lane >> 5)) * ldw + n0 + (lane & 31));
#pragma unroll
    for (int i = 0; i < 32; ++i) tv[i] = __builtin_nontemporal_load(wp + (size_t)(2 * i) * ldw);
#pragma unroll
    for (int i = 0; i < 32; ++i) scr[(2 * i + (lane >> 5)) * 33 + (lane & 31)] = tv[i];
    LDS_WAIT(); asm volatile("" ::: "memory");
    const int n = lane >> 1, hf = lane & 1; const LAS float* s = scr + (32 * hf) * 33 + n;
    unsigned w[8];
#pragma unroll
    for (int j = 0; j < 8; ++j) { int v = 0; v = __builtin_amdgcn_cvt_pk_fp8_f32(s[(4 * j) * 33] * scale, s[(4 * j + 1) * 33] * scale, v, false); v = __builtin_amdgcn_cvt_pk_fp8_f32(s[(4 * j + 2) * 33] * scale, s[(4 * j + 3) * 33] * scale, v, true); w[j] = (unsigned)v; }
    unsigned char* d = dst + (size_t)rf(n0 + n) * ldd + k0 + 32 * hf;
    *(GAS u32x4*)d = (u32x4){w[0], w[1], w[2], w[3]}; *(GAS u32x4*)(d + 16) = (u32x4){w[4], w[5], w[6], w[7]};
    LDS_WAIT(); asm volatile("" ::: "memory");
}
struct RowId { __device__ __forceinline__ int operator()(int n) const { return n; } };
struct RowWin { __device__ __forceinline__ int operator()(int n) const { return n >= 2336 ? n - 32 : n; } };
struct RowGU { int up; __device__ __forceinline__ int operator()(int j) const { return (j >> 7) * 256 + up * 128 + (j & 127); } };

__device__ __forceinline__ void p0_static_weights(Frame& F) {
    LAS float* scr = (LAS float*)(F.lds + F.wave * 16384);
    const int gw = F.wg * NWAVES + F.wave, NGW = F.G * NWAVES;
    constexpr int I_IN = 16 * 97, I_OUT = 16 * 32, I_R = 16 * 4, PER_L = I_IN + I_OUT + I_R;
    for (int it = gw; it < DEPTH * PER_L; it += NGW) {
        const int l = it / PER_L; int r = it % PER_L;
        if (r < I_IN) { const int kb = r / 97, nb = r % 97; if (nb == 72) continue;
            tr_item(F.in[I_WIN] + (size_t)l * DM * DIN_REF, DIN_REF, kb * 64, nb * 32, (bf16_t*)(F.ws + WS_WIN) + (size_t)l * DIN * DM, DM, RowWin{}, scr, F.lane, nb < 16 ? NA_QSCALE : 1.0f); continue; }
        r -= I_IN;
        if (r < I_OUT) { const int kb = r / 32, nb = r % 32;
            tr_item(F.in[I_WOUT] + (size_t)l * DM * DM, DM, kb * 64, nb * 32, (bf16_t*)(F.ws + WS_WOUT) + (size_t)l * DM * DM, DM, RowId{}, scr, F.lane); continue; }
        r -= I_OUT;
        { const int kb = r / 4, nb = r % 4;
            tr_item(F.in[I_RW] + (size_t)l * DM * NEXP, NEXP, kb * 64, nb * 32, (bf16_t*)(F.ws + WS_WR) + (size_t)l * 256 * DM, DM, RowId{}, scr, F.lane); }
    }
    const int gt = F.wg * NTHR + F.tid, NGT = F.G * NTHR;
    for (int i = gt; i < DEPTH * 128 * DM / 8; i += NGT) { const int l = i / (128 * DM / 8), r = i % (128 * DM / 8);
        *(u32x4*)((bf16_t*)(F.ws + WS_WR) + ((size_t)l * 256 + 128) * DM + (size_t)r * 8) = (u32x4){0u, 0u, 0u, 0u}; }
    for (int i = gt; i < DEPTH * 256 * DM; i += NGT) {
        const int k = i % DM, n = (i / DM) % 256, l = i / (DM * 256), dir = n >> 7, j = n & 127;
        const float* wi = F.in[I_WIN] + ((size_t)l * DM + k) * DIN_REF + 2304 + dir * 16;
        const float* wa = F.in[I_WA2] + ((size_t)(l * 2 + dir) * 16) * 128 + j;
        float s = 0.f;
#pragma unroll
        for (int r = 0; r < 16; ++r) s += wi[r] * wa[r * 128];
        ((bf16_t*)(F.ws + WS_WIN))[((size_t)l * DIN + 3072 + n) * DM + k] = (bf16_t)f2bf(s);
    }
}
__device__ __forceinline__ void p0_mod(Frame& F) {
    LAS float* sc = (LAS float*)F.lds;
    LAS float* red = (LAS float*)(F.lds + 17 * 1024 * 4);
    for (int i = F.tid; i < 17 * 1024; i += NTHR) { const int r = i >> 10, k = i & 1023; const float v = r < 16 ? F.in[I_C][r * 1024 + k] : F.in[I_CCTX][k]; sc[i] = silu_f(v); }
    __syncthreads();
    const int kq = F.tid >> 7, cl = F.tid & 127;
    for (int u = F.wg; u < DEPTH * 48; u += F.G) {
        const int l = u / 48, col = (u % 48) * 128 + cl;
        const float* w = F.in[I_WMOD] + (size_t)l * DM * 6144 + col;
        float a[17];
#pragma unroll
        for (int r = 0; r < 17; ++r) a[r] = 0.f;
        for (int k0 = kq * 256; k0 < kq * 256 + 256; k0 += 16) {
            float wv[16];
#pragma unroll
            for (int q = 0; q < 16; ++q) wv[q] = *(const GAS float*)(w + (size_t)(k0 + q) * 6144);
#pragma unroll
            for (int q = 0; q < 16; ++q)
#pragma unroll
                for (int r = 0; r < 17; ++r) a[r] += sc[r * 1024 + k0 + q] * wv[q]; }
#pragma unroll
        for (int r = 0; r < 17; ++r) red[(kq * 17 + r) * 128 + cl] = a[r];
        __syncthreads();
        for (int i = F.tid; i < 17 * 128; i += NTHR) { const int r = i >> 7, c2 = i & 127, cc = (u % 48) * 128 + c2;
            const float s = red[(0 * 17 + r) * 128 + c2] + red[(1 * 17 + r) * 128 + c2] + red[(2 * 17 + r) * 128 + c2] + red[(3 * 17 + r) * 128 + c2] + F.in[I_BMOD][l * 6144 + cc];
            ((float*)(F.ws + WS_MOD))[((size_t)l * 17 + r) * 6144 + cc] = s; }
        __syncthreads();
    }
}
__device__ __forceinline__ void p0_hyena_filters(Frame& F) {
    LAS float* z = (LAS float*)F.lds;
    LAS float* h1 = z + 1092;
    LAS float* h2 = h1 + 33 * 64;
    LAS float* tt = h2 + 33 * 64;
    LAS float* W1 = tt + 64;
    LAS float* W2 = W1 + 33 * 64;
    constexpr int UL = 4096 / 32, UC = 256 / 32, UPL = UL + UC;
    for (int k = 0; ; ++k) {
        int u;
        if (F.G == 256) { if (k < 2) u = F.wg + k * 256; else if (k == 2 && F.wg >= 192 && F.wg < 192 + (DEPTH * UPL - 512)) u = 512 + (F.wg - 192); else break; }
        else { u = F.wg + k * F.G; if (u >= DEPTH * UPL) break; }
        const int l = u / UPL, r = u % UPL; const bool lat = r < UL; const int L = lat ? 4096 : 256, n0 = (lat ? r : r - UL) * 32;
        __syncthreads();
        for (int i = F.tid; i < 33 * 64; i += NTHR) W1[i] = F.in[I_HW1][(size_t)l * 33 * 64 + i];
        for (int i = F.tid; i < 64 * 64; i += NTHR) W2[i] = F.in[I_HW2][(size_t)l * 64 * 64 + i];
        for (int i = F.tid; i < 33 * 33; i += NTHR) { const int p = i / 33, e = i % 33, n = n0 + p;
            const float t = (float)n / (float)(L - 1);
            float v;
            if (e == 0) v = t;
            else { const int kb = (e - 1) & 15; const float band = 1e-4f + (float)kb * ((15.0f - 1e-4f) / 15.0f);
                   const float w = 6.283185307179586f * (float)n / (float)L; const float ang = w * band;
                   v = e <= 16 ? __cosf(ang) : -__sinf(ang); }
            z[i] = v; if (e == 0) tt[p] = t; }
        __syncthreads();
        for (int i = F.tid; i < 33 * 64; i += NTHR) { const int p = i >> 6, j = i & 63; float s = F.in[I_HB1][l * 64 + j];
#pragma unroll 11
            for (int e = 0; e < 33; ++e) s += z[p * 33 + e] * W1[e * 64 + j];
            h1[i] = __sinf(F.in[I_HF1][l * 64 + j] * s); }
        __syncthreads();
        for (int i = F.tid; i < 33 * 64; i += NTHR) { const int p = i >> 6, j = i & 63; float s = F.in[I_HB2][l * 64 + j];
#pragma unroll 16
            for (int e = 0; e < 64; ++e) s += h1[p * 64 + e] * W2[e * 64 + j];
            h2[i] = __sinf(F.in[I_HF2][l * 64 + j] * s); }
        __syncthreads();
        {
            const int g = F.tid >> 8, col0 = 4 * (F.tid & 255), o = col0 >> 9, dir = (col0 >> 8) & 1, ch0 = col0 & 255;
            const int pb = (dir ? 0 : 1) + 16 * g;
            float a[4][16];
#pragma unroll
            for (int j = 0; j < 4; ++j)
#pragma unroll
                for (int q = 0; q < 16; ++q) a[j][q] = 0.f;
            const float* w3 = F.in[I_HW3] + (size_t)l * 64 * 1024 + col0;
            const LAS float* hp = h2 + pb * 64;
            f32x4 wa[4], wb[4];
#pragma unroll
            for (int q = 0; q < 4; ++q) wa[q] = *(const GAS f32x4*)(w3 + (size_t)q * 1024);
#define HF_BLOCK(wv_, k0_) do { _Pragma("unroll") for (int pi = 0; pi < 16; ++pi) { const f32x4 hv = *(const LAS f32x4*)(hp + pi * 64 + (k0_)); \
                _Pragma("unroll") for (int q = 0; q < 4; ++q) _Pragma("unroll") for (int j = 0; j < 4; ++j) a[j][pi] += hv[q] * wv_[q][j]; } } while (0)
#pragma unroll 1
            for (int k0 = 0; k0 < 64; k0 += 8) {
#pragma unroll
                for (int q = 0; q < 4; ++q) wb[q] = *(const GAS f32x4*)(w3 + (size_t)(k0 + 4 + q) * 1024);
                __builtin_amdgcn_sched_barrier(0);
                HF_BLOCK(wa, k0);
                __builtin_amdgcn_sched_barrier(0);
                { const int kn = k0 + 8 < 64 ? k0 + 8 : k0;
#pragma unroll
                  for (int q = 0; q < 4; ++q) wa[q] = *(const GAS f32x4*)(w3 + (size_t)(kn + q) * 1024); }
                __builtin_amdgcn_sched_barrier(0);
                HF_BLOCK(wb, k0 + 4);
                __builtin_amdgcn_sched_barrier(0);
            }
#undef HF_BLOCK
            const f32x4 b3 = *(const GAS f32x4*)(F.in[I_HB3] + l * 1024 + col0), dc = *(const GAS f32x4*)(F.in[I_HDEC] + ((size_t)(l * 2 + o) * 2 + dir) * 256 + ch0);
            float a0[4] = {0.f, 0.f, 0.f, 0.f};
            if (n0 == 0 && dir == 0 && g == 0) {
                for (int k = 0; k < 64; ++k) { const f32x4 wv = *(const GAS f32x4*)(w3 + (size_t)k * 1024); const float hv = h2[k];
#pragma unroll
                    for (int j = 0; j < 4; ++j) a0[j] += hv * wv[j]; } }
#pragma unroll
            for (int j = 0; j < 4; ++j) {
                const float dec = fabsf(dc[j]);
                bf16_t* R = lat ? (bf16_t*)(F.ws + WS_HYF) + ((size_t)(l * 2 + o) * 256 + ch0 + j) * 8192 : (bf16_t*)(F.ws + WS_HYFC) + ((size_t)(l * 2 + o) * 256 + ch0 + j) * 512;
                float v[16];
#pragma unroll
                for (int pi = 0; pi < 16; ++pi) v[pi] = (a[j][pi] + b3[j]) * __expf(-tt[pb + pi] * dec);
                unsigned w[8];
                if (dir == 0) {
                    if (n0 + 32 == L && g == 1) v[15] = 0.f;
#pragma unroll
                    for (int q = 0; q < 8; ++q) w[q] = pk2(v[15 - 2 * q], v[14 - 2 * q]);
                    GAS u32x4* dst = (GAS u32x4*)(R + (L - n0 - 32) + 16 * (1 - g));
                    dst[0] = (u32x4){w[0], w[1], w[2], w[3]}; dst[1] = (u32x4){w[4], w[5], w[6], w[7]};
                    if (n0 == 0 && g == 0) R[L] = (bf16_t)f2bf((a0[j] + b3[j]) * __expf(-tt[0] * dec) + F.in[I_HSKIP][(l * 2 + o) * 256 + ch0 + j]);
                } else if (n0 > 0 || g == 1) {
#pragma unroll
                    for (int q = 0; q < 8; ++q) w[q] = pk2(v[2 * q], v[2 * q + 1]);
                    GAS u32x4* dst = (GAS u32x4*)(R + (L + n0) + 16 * g);
                    dst[0] = (u32x4){w[0], w[1], w[2], w[3]}; dst[1] = (u32x4){w[4], w[5], w[6], w[7]};
                } else {
#pragma unroll
                    for (int pi = 1; pi < 16; ++pi) R[L + pi] = (bf16_t)f2bf(v[pi]);
                }
            }
        }
    }
    __syncthreads();
}
__device__ __forceinline__ void p0_init_rows(Frame& F) {
    const int gw = F.wg * NWAVES + F.wave, NGW = F.G * NWAVES;
    for (int row = gw; row < NROW; row += NGW) {
        const float* src = row < NLAT ? F.in[I_X] + (size_t)row * DM : F.in[I_CTX] + (size_t)(row - NLAT) * DM;
        const float* md = mod_ptr(F, 0, row);
        bf16_t* xr = (bf16_t*)(F.ws + WS_XR) + (size_t)row * DM; bf16_t* xm = (bf16_t*)(F.ws + WS_XM) + (size_t)row * DM;
#pragma unroll
        for (int j = 0; j < 4; ++j) { const int c = 4 * F.lane + 256 * j;
            const f32x4 v = __builtin_nontemporal_load((const GAS f32x4*)(src + c)), sh = *(const GAS f32x4*)(md + c), sc = *(const GAS f32x4*)(md + 1024 + c);
            *(GAS u32x2*)(xr + c) = (u32x2){pk2(v[0], v[1]), pk2(v[2], v[3])};
            u32x2 w; w.x = pk2(v[0] * (1.f + sc[0]) + sh[0], v[1] * (1.f + sc[1]) + sh[1]); w.y = pk2(v[2] * (1.f + sc[2]) + sh[2], v[3] * (1.f + sc[3]) + sh[3]);
            *(GAS u32x2*)(xm + c) = w; }
    }
}
__device__ __forceinline__ void p1_router_weights(Frame& F) {
    LAS float* scr = (LAS float*)(F.lds + F.wave * 16384);
    const int gw = F.wg * NWAVES + F.wave, NGW = F.G * NWAVES;
    const float* MOD = (const float*)(F.ws + WS_MOD);
    for (int it = gw; it < DEPTH * 17 * 64; it += NGW) {
        const int lb = it >> 6, l = lb / 17, kb = (it & 63) >> 2, nb = it & 3;
        tr_item_ks(F.in[I_RW] + (size_t)l * DM * NEXP, NEXP, kb * 64, nb * 32, (bf16_t*)(F.ws + WS_WRB) + (size_t)lb * 128 * DM, DM, RowId{}, scr, F.lane, MOD + (size_t)lb * 6144 + 4096 + kb * 64); }
    for (int it = gw; it < DEPTH * 17 * 8; it += NGW) {
        const int lb = it >> 3, l = lb / 17, n = (it & 7) * 16 + (F.lane & 15), kq = F.lane >> 4;
        const float* sh = MOD + (size_t)lb * 6144 + 3072 + kq * 256; const float* w = F.in[I_RW] + (size_t)l * DM * NEXP + (size_t)(kq * 256) * NEXP + n;
        float a = 0.f;
#pragma unroll 8
        for (int k = 0; k < 256; ++k) a += sh[k] * w[(size_t)k * NEXP];
        a += shx(a, 16, F.lane); a += shx(a, 32, F.lane);
        if (kq == 0) ((float*)(F.ws + WS_RBIAS))[(size_t)lb * 128 + n] = a; }
}
constexpr float WEXP_SCALE = 32.0f;
constexpr int XW_ITEMS = NE1 * 384, XW_TAIL_E = 12288, XW_TAIL_G = 12288 + 7680;
__device__ __forceinline__ void p_expert_weights(Frame& F, int l, int it0, int it1, int nw, int w) {
    LAS float* scr = (LAS float*)(F.lds + F.wave * 16384);
    constexpr int I1 = 16 * 8, I2 = 4 * 32, PER_E = 2 * I1 + I2;
    for (int it = it0 + w; it < it1; it += nw) {
        const int e = it / PER_E; int r = it % PER_E;
        unsigned char* d1 = (unsigned char*)(F.ws + WS_EXP1) + (size_t)e * 512 * DM; unsigned char* d2 = (unsigned char*)(F.ws + WS_EXP2) + (size_t)e * DM * EH;
        if (r < 2 * I1) { const int up = r >= I1; if (up) r -= I1; const int kb = r / 8, nb = r % 8;
            const float* src = e < NEXP ? F.in[up ? I_WEU : I_WEG] + ((size_t)l * NEXP + e) * DM * EH : F.in[up ? I_WSU : I_WSG] + (size_t)l * DM * EH;
            tr_item8(src, EH, kb * 64, nb * 32, d1, DM, RowGU{up}, up ? WEXP_SCALE * 0.6931471805599453f : WEXP_SCALE * 1.4426950408889634f, scr, F.lane); }
        else { r -= 2 * I1; const int kb = r / 32, nb = r % 32;
            const float* src = e < NEXP ? F.in[I_WED] + ((size_t)l * NEXP + e) * EH * DM : F.in[I_WSD] + (size_t)l * EH * DM;
            tr_item8(src, DM, kb * 64, nb * 32, d2, EH, RowId{}, WEXP_SCALE, scr, F.lane); }
    }
}

__device__ __forceinline__ f32x4 mfma16(bf16x8 a, bf16x8 b, f32x4 c) { return __builtin_amdgcn_mfma_f32_16x16x32_bf16(a, b, c, 0, 0, 0); }

__device__ __forceinline__ void ph_transposes(Frame& F, int l) {
    LAS bf16_t* tile = (LAS bf16_t*)(F.lds + F.wave * 16384);
    const bf16_t* U = (const bf16_t*)(F.ws + WS_U);
    const int gw = F.wg * NWAVES + F.wave, NGW = F.G * NWAVES;
    const int rsub = F.lane >> 3, cseg = F.lane & 7;
    for (int u = gw; u < 1088 * 12; u += NGW) {
        const int tt = u / 12, blk = u % 12;
        int b, s0, Ls, rowbase, posbase;
        if (tt < 1024) { b = tt >> 6; s0 = (tt & 63) * 64; Ls = SEQ; rowbase = b * SEQ; posbase = 0; }
        else { const int t2 = tt - 1024; b = t2 >> 2; s0 = (t2 & 3) * 64; Ls = CTXL; rowbase = NLAT + b * CTXL; posbase = SEQ; }
        if (blk < 12) {
            constexpr int HT = 80;
            float w0[8], w1[8], w2[8], bb[8];
#pragma unroll
            for (int it = 0; it < 8; ++it) { const int col = blk * 64 + rsub + 8 * it; w0[it] = F.in[I_HSW][(l * 3 + 0) * 768 + col]; w1[it] = F.in[I_HSW][(l * 3 + 1) * 768 + col]; w2[it] = F.in[I_HSW][(l * 3 + 2) * 768 + col]; bb[it] = F.in[I_HSB][l * 768 + col]; }
            const bf16_t* p0 = U + (size_t)(rowbase + s0 + rsub) * DIN + UHY + blk * 64 + cseg * 8;
            u32x4 zc[8];
#pragma unroll
            for (int it = 0; it < 8; ++it) zc[it] = *(const GAS u32x4*)(p0 + (size_t)(8 * it) * DIN);
            u32x4 zh = (u32x4){0u, 0u, 0u, 0u};
            if (F.lane < 16) { const int hs = F.lane < 8 ? s0 - 1 : s0 + 64; if (hs >= 0 && hs < Ls) zh = *(const GAS u32x4*)(U + (size_t)(rowbase + hs) * DIN + UHY + blk * 64 + cseg * 8); }
#pragma unroll
            for (int it = 0; it < 8; ++it) { const unsigned a[4] = {zc[it].x, zc[it].y, zc[it].z, zc[it].w}; LAS bf16_t* d = tile + (cseg * 8) * HT + 8 + rsub + 8 * it;
#pragma unroll
                for (int i = 0; i < 4; ++i) { d[(2 * i) * HT] = (bf16_t)(a[i] & 0xffffu); d[(2 * i + 1) * HT] = (bf16_t)(a[i] >> 16); } }
            if (F.lane < 16) { const unsigned a[4] = {zh.x, zh.y, zh.z, zh.w}; LAS bf16_t* d = tile + (cseg * 8) * HT + (F.lane < 8 ? 7 : 72);
#pragma unroll
                for (int i = 0; i < 4; ++i) { d[(2 * i) * HT] = (bf16_t)(a[i] & 0xffffu); d[(2 * i + 1) * HT] = (bf16_t)(a[i] >> 16); } }
            LDS_WAIT(); asm volatile("" ::: "memory");
#pragma unroll
            for (int it = 0; it < 8; ++it) {
                const int ch = rsub + 8 * it; const LAS bf16_t* r = tile + ch * HT + 8 + cseg * 8;
                const u32x4 v = *(const LAS u32x4*)r; const unsigned hm = r[-1], hp = r[8];
                float x[10]; x[0] = __builtin_bit_cast(float, hm << 16); x[9] = __builtin_bit_cast(float, hp << 16);
                x[1] = bflo(v.x); x[2] = bfhi(v.x); x[3] = bflo(v.y); x[4] = bfhi(v.y); x[5] = bflo(v.z); x[6] = bfhi(v.z); x[7] = bflo(v.w); x[8] = bfhi(v.w);
                unsigned w[4];
#pragma unroll
                for (int i = 0; i < 4; ++i) w[i] = pk2(bb[it] + w0[it] * x[2 * i] + w1[it] * x[2 * i + 1] + w2[it] * x[2 * i + 2], bb[it] + w0[it] * x[2 * i + 1] + w1[it] * x[2 * i + 2] + w2[it] * x[2 * i + 3]);
                *(GAS u32x4*)((bf16_t*)(F.ws + WS_HV) + ((size_t)(blk * 64 + ch) * NB + b) * SPB + posbase + s0 + cseg * 8) = (u32x4){w[0], w[1], w[2], w[3]};
            }
            LDS_WAIT(); asm volatile("" ::: "memory");
            continue;
        } else {
            const int c0 = (blk - 12) * 64 + cseg * 8;
#pragma unroll
            for (int it = 0; it < 8; ++it) {
                const int sl = rsub + 8 * it, s = s0 + sl;
                const u32x4 zc = *(const GAS u32x4*)(U + (size_t)(rowbase + s) * DIN + UV + c0);
                const unsigned ac[4] = {zc.x, zc.y, zc.z, zc.w};
#pragma unroll
                for (int i = 0; i < 4; ++i) { tile[(cseg * 8 + 2 * i) * 72 + sl] = (bf16_t)(ac[i] & 0xffffu); tile[(cseg * 8 + 2 * i + 1) * 72 + sl] = (bf16_t)(ac[i] >> 16); }
            }
        }
        LDS_WAIT(); asm volatile("" ::: "memory");
#pragma unroll 2
        for (int it = 0; it < 8; ++it) {
            const int ch = rsub + 8 * it;
            const u32x4 v = *(const LAS u32x4*)(tile + ch * 72 + cseg * 8);
            bf16_t* dst;
            if (blk < 12) dst = (bf16_t*)(F.ws + WS_HV) + ((size_t)(blk * 64 + ch) * NB + b) * SPB + posbase + s0 + cseg * 8;
            else dst = (bf16_t*)(F.ws + WS_VT) + ((size_t)b * 512 + (blk - 12) * 64 + ch) * SPB + posbase + s0 + cseg * 8;
            *(GAS u32x4*)dst = v;
        }
        LDS_WAIT(); asm volatile("" ::: "memory");
    }
}

constexpr int NA_RPB = 0, NA_KC = 2048, NA_VC = NA_KC + 256 * 144, NA_KR = NA_VC + 64 * 528, NA_END = NA_KR + 9 * 64 * 144;
static_assert(NA_END <= MISC_OFF, "NA LDS map");
__device__ __forceinline__ bf16x8 gld16(const bf16_t* p) { return *(const GAS bf16x8*)p; }
__device__ __forceinline__ u32x2 gld8(const bf16_t* p) { return *(const GAS u32x2*)p; }
__device__ __forceinline__ const char* uni_ptr(const char* p) { const unsigned long long v = (unsigned long long)p; const unsigned lo = __builtin_amdgcn_readfirstlane((unsigned)v), hi = __builtin_amdgcn_readfirstlane((unsigned)(v >> 32)); return (const char*)(((unsigned long long)hi << 32) | lo); }
__device__ __forceinline__ bf16x8 gld16o(const char* ub, unsigned lo) { return *(const GAS bf16x8*)(ub + (size_t)lo); }
__device__ __forceinline__ u32x2 gld8o(const char* ub, unsigned lo) { return *(const GAS u32x2*)(ub + (size_t)lo); }
template <bool WIN>
__device__ __forceinline__ void na_unit(Frame& F, int b, int h, int r, int strip) {
    const bf16_t* U = (const bf16_t*)(F.ws + WS_U);
    const bf16_t* VT = (const bf16_t*)(F.ws + WS_VT) + ((size_t)b * 512 + h * 64) * SPB;
    const LAS float* rpb = (const LAS float*)(F.lds + NA_RPB);
    const LAS bf16_t* KC = (const LAS bf16_t*)(F.lds + NA_KC); const LAS bf16_t* VC = (const LAS bf16_t*)(F.lds + NA_VC);
    int ln_ = F.lane; asm volatile("" : "+v"(ln_));
    const int i = ln_ & 15, g = ln_ >> 4;
    const int qrow0 = WIN ? (b * SEQ + r * 64 + strip * 16) : (NLAT + b * CTXL + strip * 16);
    const int ki = 8 * (i >> 2) + (i & 3);
    const unsigned qlo = (unsigned)((i * DIN + 8 * g) * 2), klo = (unsigned)((ki * DIN + 8 * g) * 2), vlo = (unsigned)((i * SPB + 8 * g) * 2);
    const char* qb = uni_ptr((const char*)(U + (size_t)qrow0 * DIN + UQ + h * 64));
    const bf16x8 q0 = gld16o(qb, qlo), q1 = gld16o(qb + 64, qlo);
    int kr0 = 0, u0 = 0;
    if (WIN) { kr0 = r - 4; kr0 = kr0 < 0 ? 0 : (kr0 > 56 ? 56 : kr0); u0 = strip == 0 ? 0 : (strip == 1 ? 8 : (strip == 2 ? 24 : 32)); }
    const LAS bf16_t* KR = (const LAS bf16_t*)(F.lds + NA_KR);
    const char* vbase = uni_ptr((const char*)(VT + kr0 * 64 + u0));
    f32x4 o[4];
#pragma unroll
    for (int d = 0; d < 4; ++d) o[d] = (f32x4){0.f, 0.f, 0.f, 0.f};
    float lsum = 0.f;
#define NA_SB() __builtin_amdgcn_sched_barrier(0)
#define NA_WLOAD(vb_, cw) do { _Pragma("unroll") for (int d = 0; d < 4; ++d) vb_[d] = gld16o(vbase + ((size_t)(d * 16) * SPB + (cw) * 64) * 2, vlo); } while (0)
#define NA_KRING(kb_, cw) do { const LAS bf16_t* kp = KR + ((((kr0 + (cw)) % 9) * 64 + u0 + ki) * 72 + 8 * g); kb_[0][0] = *(const LAS bf16x8*)kp; kb_[0][1] = *(const LAS bf16x8*)(kp + 32); \
        kb_[1][0] = *(const LAS bf16x8*)(kp + 4 * 72); kb_[1][1] = *(const LAS bf16x8*)(kp + 4 * 72 + 32); } while (0)
#define NA_QK(kb_, s_) do { _Pragma("unroll") for (int t = 0; t < 2; ++t) { f32x4 a = (f32x4){0.f, 0.f, 0.f, 0.f}; a = mfma16(kb_[t][0], q0, a); a = mfma16(kb_[t][1], q1, a); s_[t] = a; } } while (0)
#define NA_PV(s_, vb_) do { u32x4 pw; pw.x = pk2(s_[0][0], s_[0][1]); pw.y = pk2(s_[0][2], s_[0][3]); pw.z = pk2(s_[1][0], s_[1][1]); pw.w = pk2(s_[1][2], s_[1][3]); const bf16x8 pf = __builtin_bit_cast(bf16x8, pw); \
        _Pragma("unroll") for (int d = 0; d < 4; ++d) o[d] = mfma16(vb_[d], pf, o[d]); } while (0)
    bf16x8 vA[4], vB[4], vC[4];
    if (WIN) { NA_WLOAD(vA, 0); NA_WLOAD(vB, 1); NA_WLOAD(vC, 2); NA_SB(); }
#pragma unroll
    for (int cc = 0; cc < 8; ++cc) {
        bf16x8 kc[2][2], vc[4]; f32x4 sc[2];
#pragma unroll
        for (int t = 0; t < 2; ++t) { const LAS bf16_t* kp = KC + (cc * 32 + ki + 4 * t) * 72 + 8 * g; kc[t][0] = *(const LAS bf16x8*)kp; kc[t][1] = *(const LAS bf16x8*)(kp + 32); }
#pragma unroll
        for (int d = 0; d < 4; ++d) vc[d] = *(const LAS bf16x8*)(VC + (d * 16 + i) * 264 + cc * 32 + 8 * g);
        NA_QK(kc, sc);
#pragma unroll
        for (int t = 0; t < 2; ++t)
#pragma unroll
            for (int e = 0; e < 4; ++e) { const float p = __builtin_amdgcn_exp2f(fminf(sc[t][e], NA_CLAMP)); sc[t][e] = p; lsum += p; }
        NA_PV(sc, vc);
    }
    if (WIN) {
        const int c = strip * 16 + i; int kc0 = c - 8; kc0 = kc0 < 0 ? 0 : (kc0 > 48 ? 48 : kc0);
        int dcl[2][4]; bool okm[2][4];
#pragma unroll
        for (int t = 0; t < 2; ++t)
#pragma unroll
            for (int e = 0; e < 4; ++e) { const int kc = u0 + 8 * g + 4 * t + e; okm[t][e] = (kc >= kc0) && (kc < kc0 + 16); int dc = kc - c + 15; dcl[t][e] = okm[t][e] ? (dc < 0 ? 0 : (dc > 30 ? 30 : dc)) : 31; }
#define NA_WCHUNK(vb_, cw) do { bf16x8 kw[2][2]; NA_KRING(kw, cw); f32x4 sw[2]; NA_QK(kw, sw); const LAS float* rp = rpb + (kr0 + (cw) - r + 7) * 32; \
        _Pragma("unroll") for (int t = 0; t < 2; ++t) _Pragma("unroll") for (int e = 0; e < 4; ++e) { const float x = sw[t][e] + rp[dcl[t][e]]; const float p = __builtin_amdgcn_exp2f(fminf(x, NA_CLAMP)); sw[t][e] = p; lsum += p; } \
        NA_PV(sw, vb_); } while (0)
        NA_WCHUNK(vA, 0); NA_SB(); NA_WLOAD(vA, 3); NA_SB();
        NA_WCHUNK(vB, 1); NA_SB(); NA_WLOAD(vB, 4); NA_SB();
        NA_WCHUNK(vC, 2); NA_SB(); NA_WLOAD(vC, 5); NA_SB();
        NA_WCHUNK(vA, 3); NA_SB(); NA_WLOAD(vA, 6); NA_SB();
        NA_WCHUNK(vB, 4); NA_SB(); NA_WLOAD(vB, 7); NA_SB();
        NA_WCHUNK(vC, 5); NA_SB();
        NA_WCHUNK(vA, 6); NA_SB();
        NA_WCHUNK(vB, 7); NA_SB();
#undef NA_WCHUNK
    }
    lsum += shx(lsum, 16, ln_); lsum += shx(lsum, 32, ln_);
    const float inv = 1.0f / lsum;
    char* op = (char*)uni_ptr((const char*)((bf16_t*)(F.ws + WS_MIX) + (size_t)qrow0 * DM + h * 64)); const unsigned olo = (unsigned)((i * DM + 4 * g) * 2);
#pragma unroll
    for (int d = 0; d < 4; ++d) { u32x2 w; w.x = pk2(o[d][0] * inv, o[d][1] * inv); w.y = pk2(o[d][2] * inv, o[d][3] * inv); *(GAS u32x2*)(op + d * 32 + (size_t)olo) = w; }
#undef NA_SB
#undef NA_WLOAD
#undef NA_KRING
#undef NA_QK
#undef NA_PV
}
__device__ __forceinline__ int na_kr0(int r) { const int k = r - 4; return k < 0 ? 0 : (k > 56 ? 56 : k); }
__device__ __forceinline__ void ph_na(Frame& F, int l, bool last) {
    const bf16_t* U = (const bf16_t*)(F.ws + WS_U);
    for (int job = F.wg; job < NB * 8 * 2; job += F.G) {
        const int half = job & 1, h = (job >> 1) & 7, b = job >> 4;
        int tz_; asm volatile("v_mbcnt_lo_u32_b32 %0, -1, 0\n\tv_mbcnt_hi_u32_b32 %0, -1, %0" : "=v"(tz_)); tz_ |= F.wave << 6;
        const bf16_t* krow = U + (size_t)(b * SEQ + (tz_ >> 3)) * DIN + UK + h * 64 + (tz_ & 7) * 8;
        LAS bf16_t* kdst = (LAS bf16_t*)(F.lds + NA_KR) + (tz_ >> 3) * 72 + (tz_ & 7) * 8;
        __syncthreads();
        { LAS float* rpb = (LAS float*)(F.lds + NA_RPB); const float* rsrc = F.in[I_RPB] + ((size_t)l * 8 + h) * 15 * 31;
          if (tz_ < 15 * 32) rpb[tz_] = (tz_ & 31) < 31 ? rsrc[(tz_ >> 5) * 31 + (tz_ & 31)] * 1.4426950408889634f : -1e30f;
          const int key = tz_ >> 1, hf = tz_ & 1; const bf16_t* src = U + (size_t)(NLAT + b * CTXL + key) * DIN + UK + h * 64 + hf * 32; LAS bf16_t* dst = (LAS bf16_t*)(F.lds + NA_KC) + key * 72 + hf * 32;
#pragma unroll
          for (int j = 0; j < 4; ++j) *(LAS bf16x8*)(dst + j * 8) = gld16(src + j * 8);
          const int dv = tz_ >> 3, seg = tz_ & 7; const bf16_t* vs = (const bf16_t*)(F.ws + WS_VT) + ((size_t)b * 512 + h * 64 + dv) * SPB + SEQ + seg * 32; LAS bf16_t* vd = (LAS bf16_t*)(F.lds + NA_VC) + dv * 264 + seg * 32;
#pragma unroll
          for (int j = 0; j < 4; ++j) *(LAS bf16x8*)(vd + j * 8) = gld16(vs + j * 8);
          const int lo = na_kr0(half * 32), hi0 = na_kr0(half * 32 + 1) + 7;
          for (int kr = lo; kr <= hi0; ++kr) *(LAS bf16x8*)(kdst + (kr % 9) * 64 * 72) = gld16(krow + (size_t)kr * 64 * DIN); }
        __syncthreads();
        int prev_hi = na_kr0(half * 32 + 1) + 7;
#pragma unroll 1
        for (int s = 0; s < 16; ++s) {
            const int r0 = half * 32 + 2 * s;
            const int nhi = s < 15 ? na_kr0(r0 + 3) + 7 : prev_hi;
            bf16x8 n0 = (bf16x8){0, 0, 0, 0, 0, 0, 0, 0}, n1 = n0;
            if (nhi > prev_hi) n0 = gld16(krow + (size_t)(prev_hi + 1) * 64 * DIN);
            if (nhi > prev_hi + 1) n1 = gld16(krow + (size_t)(prev_hi + 2) * 64 * DIN);
            na_unit<true>(F, b, h, r0 + (F.wave >> 2), F.wave & 3);
            __syncthreads();
            if (nhi > prev_hi) *(LAS bf16x8*)(kdst + ((prev_hi + 1) % 9) * 64 * 72) = n0;
            if (nhi > prev_hi + 1) *(LAS bf16x8*)(kdst + ((prev_hi + 2) % 9) * 64 * 72) = n1;
            __syncthreads();
            prev_hi = nhi;
        }
        if (!last) na_unit<false>(F, b, h, 0, half * 8 + F.wave);
    }
}

__device__ __forceinline__ void ph_hy_transpose(Frame& F, bool last) {
    LAS bf16_t* tile = (LAS bf16_t*)(F.lds + F.wave * 16384);
    const bf16_t* HYO = (const bf16_t*)(F.ws + WS_Y);
    const int gw = F.wg * NWAVES + F.wave, NGW = F.G * NWAVES;
    const int rsub = F.lane >> 3, cseg = F.lane & 7;
    const int ntt = last ? 1024 : 1088;
    for (int u = gw; u < ntt * 4; u += NGW) {
        const int tt = u >> 2, cb = u & 3;
        int b, s0, rowbase, posbase;
        if (tt < 1024) { b = tt >> 6; s0 = (tt & 63) * 64; rowbase = b * SEQ; posbase = 0; }
        else { const int t2 = tt - 1024; b = t2 >> 2; s0 = (t2 & 3) * 64; rowbase = NLAT + b * CTXL; posbase = SEQ; }
#pragma unroll 2
        for (int it = 0; it < 8; ++it) { const int c = rsub + 8 * it;
            const u32x4 v = *(const GAS u32x4*)(HYO + ((size_t)(cb * 64 + c) * NB + b) * SPB + posbase + s0 + cseg * 8); const unsigned a[4] = {v.x, v.y, v.z, v.w};
#pragma unroll
            for (int e = 0; e < 4; ++e) { tile[(cseg * 8 + 2 * e) * 72 + c] = (bf16_t)(a[e] & 0xffffu); tile[(cseg * 8 + 2 * e + 1) * 72 + c] = (bf16_t)(a[e] >> 16); } }
        LDS_WAIT(); asm volatile("" ::: "memory");
#pragma unroll 2
        for (int it = 0; it < 8; ++it) { const int p = rsub + 8 * it;
            const u32x4 v = *(const LAS u32x4*)(tile + p * 72 + cseg * 8);
            *(GAS u32x4*)((bf16_t*)(F.ws + WS_MIX) + (size_t)(rowbase + s0 + p) * DM + 768 + cb * 64 + cseg * 8) = v; }
        LDS_WAIT(); asm volatile("" ::: "memory");
    }
}

constexpr int G2_LAF = 0, G2_LAB = 8448;
constexpr int G2_QTF = 16896, G2_KTF = 22016, G2_QTB = 27136, G2_KTB = 32256;
constexpr int G2_VT = 37376, G2_ATT = 46592;
constexpr int G2_SF = 55808, G2_SB = 60928;
constexpr int G2_SEG = 66048, G2_HALF = 67328;
__device__ __forceinline__ float log_sigmoid_f(float x) { return fminf(x, 0.f) - __logf(1.0f + __expf(-fabsf(x))); }
__device__ __forceinline__ f32x4 mma_lds(const LAS bf16_t* A, int lda, const LAS bf16_t* B, int ldb, int ksteps, f32x4 acc, int lane) {
    const int r = lane & 15, g = lane >> 4;
    for (int ks = 0; ks < ksteps; ++ks) { const bf16x8 a = *(const LAS bf16x8*)(A + r * lda + ks * 32 + 8 * g), b = *(const LAS bf16x8*)(B + r * ldb + ks * 32 + 8 * g); acc = mfma16(a, b, acc); }
    return acc;
}
__device__ __forceinline__ int gla_row0(int b, int cn) { return cn >= 4 ? b * SEQ + (cn - 4) * 64 : NLAT + b * CTXL + cn * 64; }
struct GlaRaw { u32x4 q, k, f, b, v0, v1, g0, g1, s0, s1; };
template <bool FULL>
__device__ __forceinline__ GlaRaw gla_load(Frame& F, int u, int tl) {
    const int h = u & 3, cn = (u >> 2) % 68, b = (u >> 2) / 68, i = tl >> 2, part = tl & 3;
    const bf16_t* p = (const bf16_t*)(F.ws + WS_U) + (size_t)(gla_row0(b, cn) + i) * DIN;
    GlaRaw r;
    r.q = *(const GAS u32x4*)(p + UGQ + h * 32 + part * 8); r.k = *(const GAS u32x4*)(p + UGK + h * 32 + part * 8);
    r.f = *(const GAS u32x4*)(p + ULAF + h * 32 + part * 8); r.b = *(const GAS u32x4*)(p + ULAB + h * 32 + part * 8);
    r.v0 = *(const GAS u32x4*)(p + UGV + h * 64 + part * 16); r.v1 = *(const GAS u32x4*)(p + UGV + h * 64 + part * 16 + 8);
    if (FULL) { r.g0 = *(const GAS u32x4*)(p + UGR + h * 64 + part * 16); r.g1 = *(const GAS u32x4*)(p + UGR + h * 64 + part * 16 + 8);
        const bf16_t* sp = (const bf16_t*)(F.ws + WS_GSIN) + (size_t)u * 2 * 2048 + tl * 16; r.s0 = *(const GAS u32x4*)sp; r.s1 = *(const GAS u32x4*)(sp + 8); }
    else { r.g0 = (u32x4){0u, 0u, 0u, 0u}; r.g1 = r.g0; r.s0 = r.g0; r.s1 = r.g0; }
    return r;
}
__device__ __forceinline__ GlaRaw gla_load_out(Frame& F, int u, int tl) {
    const int h = u & 3, cn = (u >> 2) % 68, b = (u >> 2) / 68, i = tl >> 2, part = tl & 3;
    const bf16_t* p = (const bf16_t*)(F.ws + WS_U) + (size_t)(gla_row0(b, cn) + i) * DIN;
    const bf16_t* gq = (const bf16_t*)(F.ws + WS_XM8) + (size_t)u * 8192 + i * 32 + part * 8;
    GlaRaw r;
    r.q = *(const GAS u32x4*)gq; r.k = *(const GAS u32x4*)(gq + 2048); r.f = *(const GAS u32x4*)(gq + 4096); r.b = *(const GAS u32x4*)(gq + 6144);
    r.v0 = *(const GAS u32x4*)(p + UGV + h * 64 + part * 16); r.v1 = *(const GAS u32x4*)(p + UGV + h * 64 + part * 16 + 8);
    r.g0 = *(const GAS u32x4*)(p + UGR + h * 64 + part * 16); r.g1 = *(const GAS u32x4*)(p + UGR + h * 64 + part * 16 + 8);
    const bf16_t* sp = (const bf16_t*)(F.ws + WS_GSIN) + (size_t)u * 2 * 2048 + tl * 16; r.s0 = *(const GAS u32x4*)sp; r.s1 = *(const GAS u32x4*)(sp + 8);
    return r;
}
template <bool FULL>
__device__ __forceinline__ void gla_prep(Frame& F, LAS unsigned char* L, int l, int u, int tl, const GlaRaw& raw) {
    const int h = u & 3, cn = (u >> 2) % 68, i = tl >> 2, part = tl & 3, d8 = part * 8;
    LAS float* LAF = (LAS float*)(L + G2_LAF); LAS float* LAB = (LAS float*)(L + G2_LAB); LAS bf16_t* VT = (LAS bf16_t*)(L + G2_VT); LAS float* SEG = (LAS float*)(L + G2_SEG);
    float q[8], k[8], tf[8], tb[8];
    unpack8(raw.q, q); unpack8(raw.k, k); unpack8(raw.f, tf); unpack8(raw.b, tb);
    const float* ba = F.in[I_BA2] + (size_t)l * 256 + h * 32 + d8;
#pragma unroll
    for (int e = 0; e < 8; ++e) { q[e] *= 0.17677669529663687f; LAF[i * 33 + d8 + e] = log_sigmoid_f(tf[e] + ba[e]) * 0.0625f; LAB[i * 33 + d8 + e] = log_sigmoid_f(tb[e] + ba[128 + e]) * 0.0625f; }
    if (cn >= 4) {
        const float pos = (part >> 1) ? (float)i : (float)(cn - 4);
#pragma unroll
        for (int e = 0; e < 8; ++e) { const float ang = pos * __expf(-(float)e * (9.210340371976184f / 8.0f)); const float sn = __sinf(ang), cs = __cosf(ang);
            const float qo = shx(q[e], 1, F.lane), ko = shx(k[e], 1, F.lane);
            if (part & 1) { q[e] = qo * sn + q[e] * cs; k[e] = ko * sn + k[e] * cs; } else { q[e] = q[e] * cs - qo * sn; k[e] = k[e] * cs - ko * sn; } }
    }
    { const unsigned a[8] = {raw.v0.x, raw.v0.y, raw.v0.z, raw.v0.w, raw.v1.x, raw.v1.y, raw.v1.z, raw.v1.w};
#pragma unroll
      for (int e = 0; e < 8; ++e) { VT[(part * 16 + 2 * e) * 72 + i] = (bf16_t)(a[e] & 0xffffu); VT[(part * 16 + 2 * e + 1) * 72 + i] = (bf16_t)(a[e] >> 16); } }
    __syncthreads();
    { const int x = tl & 63, d = x & 31, dir = x >> 5, seg = tl >> 6; LAS float* LA = (dir ? LAB : LAF) + d; float cv[16];
#pragma unroll
      for (int kk = 0; kk < 16; ++kk) { const int p = seg * 16 + kk, ti = dir ? 63 - p : p; cv[kk] = LA[ti * 33]; }
#pragma unroll
      for (int kk = 1; kk < 16; ++kk) cv[kk] += cv[kk - 1];
#pragma unroll
      for (int kk = 0; kk < 16; ++kk) { const int p = seg * 16 + kk, ti = dir ? 63 - p : p; LA[ti * 33] = cv[kk]; }
      SEG[x * 5 + seg] = cv[15]; }
    __syncthreads();
    { const int x = tl & 63, d = x & 31, dir = x >> 5, seg = tl >> 6; LAS float* LA = (dir ? LAB : LAF) + d; float cv[16];
      const float t0 = SEG[x * 5 + 0], t1 = SEG[x * 5 + 1], t2 = SEG[x * 5 + 2];
      const float pre = seg == 0 ? 0.f : (seg == 1 ? t0 : (seg == 2 ? t0 + t1 : t0 + t1 + t2));
#pragma unroll
      for (int kk = 0; kk < 16; ++kk) { const int p = seg * 16 + kk, ti = dir ? 63 - p : p; cv[kk] = LA[ti * 33]; }
#pragma unroll
      for (int kk = 0; kk < 16; ++kk) { const int p = seg * 16 + kk, ti = dir ? 63 - p : p; LA[ti * 33] = cv[kk] + pre; } }
    __syncthreads();
    if (FULL) {
        unsigned wqf[4], wkf[4], wqb[4], wkb[4];
#pragma unroll
        for (int e = 0; e < 4; ++e) { const int d = d8 + 2 * e; const float f0 = LAF[i * 33 + d], f1 = LAF[i * 33 + d + 1], b0 = LAB[i * 33 + d], b1 = LAB[i * 33 + d + 1];
            wqf[e] = pk2(q[2 * e] * __expf(f0), q[2 * e + 1] * __expf(f1)); wkf[e] = pk2(k[2 * e] * __expf(-f0), k[2 * e + 1] * __expf(-f1));
            wqb[e] = pk2(q[2 * e] * __expf(b0), q[2 * e + 1] * __expf(b1)); wkb[e] = pk2(k[2 * e] * __expf(-b0), k[2 * e + 1] * __expf(-b1)); }
        *(LAS u32x4*)((LAS bf16_t*)(L + G2_QTF) + i * 40 + d8) = (u32x4){wqf[0], wqf[1], wqf[2], wqf[3]}; *(LAS u32x4*)((LAS bf16_t*)(L + G2_KTF) + i * 40 + d8) = (u32x4){wkf[0], wkf[1], wkf[2], wkf[3]};
        *(LAS u32x4*)((LAS bf16_t*)(L + G2_QTB) + i * 40 + d8) = (u32x4){wqb[0], wqb[1], wqb[2], wqb[3]}; *(LAS u32x4*)((LAS bf16_t*)(L + G2_KTB) + i * 40 + d8) = (u32x4){wkb[0], wkb[1], wkb[2], wkb[3]};
    } else {
        LAS bf16_t* KDF = (LAS bf16_t*)(L + G2_QTF); LAS bf16_t* KDB = (LAS bf16_t*)(L + G2_KTF);
#pragma unroll
        for (int e = 0; e < 8; ++e) { const int d = d8 + e; const float bf = LAF[i * 33 + d], bb = LAB[i * 33 + d], bfl = LAF[63 * 33 + d], bbl = LAB[0 * 33 + d];
            KDF[d * 72 + i] = (bf16_t)f2bf(k[e] * __expf(bfl - bf)); KDB[d * 72 + i] = (bf16_t)f2bf(k[e] * __expf(bbl - bb)); }
        unsigned wqf[4], wkf[4], wqb[4], wkb[4];
#pragma unroll
        for (int e = 0; e < 4; ++e) { const int d = d8 + 2 * e; const float f0 = LAF[i * 33 + d], f1 = LAF[i * 33 + d + 1], b0 = LAB[i * 33 + d], b1 = LAB[i * 33 + d + 1];
            wqf[e] = pk2(q[2 * e] * __expf(f0), q[2 * e + 1] * __expf(f1)); wkf[e] = pk2(k[2 * e] * __expf(-f0), k[2 * e + 1] * __expf(-f1));
            wqb[e] = pk2(q[2 * e] * __expf(b0), q[2 * e + 1] * __expf(b1)); wkb[e] = pk2(k[2 * e] * __expf(-b0), k[2 * e + 1] * __expf(-b1)); }
        bf16_t* gq = (bf16_t*)(F.ws + WS_XM8) + (size_t)u * 8192 + i * 32 + d8;
        __builtin_nontemporal_store((u32x4){wqf[0], wqf[1], wqf[2], wqf[3]}, (GAS u32x4*)gq); __builtin_nontemporal_store((u32x4){wkf[0], wkf[1], wkf[2], wkf[3]}, (GAS u32x4*)(gq + 2048));
        __builtin_nontemporal_store((u32x4){wqb[0], wqb[1], wqb[2], wqb[3]}, (GAS u32x4*)(gq + 4096)); __builtin_nontemporal_store((u32x4){wkb[0], wkb[1], wkb[2], wkb[3]}, (GAS u32x4*)(gq + 6144));
    }
    __syncthreads();
}
__device__ __forceinline__ void ph_gla_local(Frame& F, int l) {
    const int hw = F.wave >> 2, wl = F.wave & 3, tl = F.tid & 255; LAS unsigned char* L = F.lds + hw * G2_HALF;
    constexpr int NU = NB * 68 * 4;
    int pp = F.wg;
    GlaRaw raw = gla_load<false>(F, (pp * 2 + hw) < NU ? pp * 2 + hw : 0, tl);
    for (; pp * 2 < NU; pp += F.G) {
        const int u = pp * 2 + hw, un = (pp + F.G) * 2 + hw;
        const GlaRaw nraw = gla_load<false>(F, un < NU ? un : u, tl);
        __syncthreads();
        gla_prep<false>(F, L, l, u, tl, raw);
        const int g = F.lane >> 4, c = F.lane & 15;
        float* DS = (float*)(F.ws + WS_GDS) + (size_t)u * 2 * 2048;
#pragma unroll
        for (int kk = 0; kk < 4; ++kk) { const int tix = wl * 4 + kk, dir = tix >> 3, mt = (tix >> 1) & 3, nt = tix & 1;
            f32x4 a = (f32x4){0.f, 0.f, 0.f, 0.f};
            a = mma_lds((const LAS bf16_t*)(L + G2_VT) + mt * 16 * 72, 72, (const LAS bf16_t*)(L + (dir ? G2_KTF : G2_QTF)) + nt * 16 * 72, 72, 2, a, F.lane);
#pragma unroll
            for (int e = 0; e < 4; ++e) DS[dir * 2048 + (mt * 16 + 4 * g + e) * 32 + nt * 16 + c] = a[e]; }
        if (tl < 64) { const int d = tl & 31, dir = tl >> 5; ((float*)(F.ws + WS_GD))[(size_t)u * 64 + tl] = __expf(dir ? ((LAS float*)(L + G2_LAB))[0 * 33 + d] : ((LAS float*)(L + G2_LAF))[63 * 33 + d]); }
        raw = nraw;
    }
}
__device__ __forceinline__ void ph_gla_scan(Frame& F) {
    const int gt = F.wg * NTHR + F.tid, NGT = F.G * NTHR;
    const float* DS = (const float*)(F.ws + WS_GDS); const float* GD = (const float*)(F.ws + WS_GD); bf16_t* SIN = (bf16_t*)(F.ws + WS_GSIN);
    for (int w = gt; w < 128 * 1024; w += NGT) {
        const int chain = w >> 10, el = (w & 1023) * 2, dir = chain & 1, h = (chain >> 1) & 3, b = chain >> 3, d = el & 31;
        float s0 = 0.f, s1 = 0.f;
        for (int step = 0; step < 68; step += 4) {
            f32x2 ds[4], dd[4]; size_t uu[4];
#pragma unroll
            for (int q = 0; q < 4; ++q) { const int st_ = step + q; const int cn = dir ? (st_ < 4 ? 3 - st_ : 71 - st_) : st_;
                uu[q] = (size_t)(b * 68 + cn) * 4 + h;
                ds[q] = *(const GAS f32x2*)(DS + (uu[q] * 2 + dir) * 2048 + el); dd[q] = *(const GAS f32x2*)(GD + uu[q] * 64 + dir * 32 + d); }
#pragma unroll
            for (int q = 0; q < 4; ++q) { *(GAS unsigned*)(SIN + (uu[q] * 2 + dir) * 2048 + el) = pk2(s0, s1); s0 = dd[q].x * s0 + ds[q].x; s1 = dd[q].y * s1 + ds[q].y; }
        }
    }
}
__device__ __forceinline__ void ph_gla_out(Frame& F, int l, bool last) {
    const int hw = F.wave >> 2, wl = F.wave & 3, tl = F.tid & 255; LAS unsigned char* L = F.lds + hw * G2_HALF;
    const int NV = last ? NB * 64 * 4 : NB * 68 * 4;
#define GLA_UNIT(v) (last ? ((((v) >> 8) * 68 + 4 + (((v) & 255) >> 2)) * 4 + ((v) & 3)) : (v))
    int pp = F.wg;
    GlaRaw raw = gla_load_out(F, GLA_UNIT((pp * 2 + hw) < NV ? pp * 2 + hw : 0), tl);
    __syncthreads();
    for (; pp * 2 < NV; pp += F.G) {
        const int u = GLA_UNIT(pp * 2 + hw), vn = (pp + F.G) * 2 + hw;
        const GlaRaw nraw = gla_load_out(F, vn < NV ? GLA_UNIT(vn) : u, tl);
        const int h = u & 3, cn = (u >> 2) % 68, b = (u >> 2) / 68;
        { const int i = tl >> 2, part = tl & 3, d8 = part * 8; LAS bf16_t* VT = (LAS bf16_t*)(L + G2_VT);
          *(LAS u32x4*)((LAS bf16_t*)(L + G2_QTF) + i * 40 + d8) = raw.q; *(LAS u32x4*)((LAS bf16_t*)(L + G2_KTF) + i * 40 + d8) = raw.k;
          *(LAS u32x4*)((LAS bf16_t*)(L + G2_QTB) + i * 40 + d8) = raw.f; *(LAS u32x4*)((LAS bf16_t*)(L + G2_KTB) + i * 40 + d8) = raw.b;
          const unsigned a[8] = {raw.v0.x, raw.v0.y, raw.v0.z, raw.v0.w, raw.v1.x, raw.v1.y, raw.v1.z, raw.v1.w};
#pragma unroll
          for (int e = 0; e < 8; ++e) { VT[(part * 16 + 2 * e) * 72 + i] = (bf16_t)(a[e] & 0xffffu); VT[(part * 16 + 2 * e + 1) * 72 + i] = (bf16_t)(a[e] >> 16); } }
        { const int dir = tl >> 7, dv = (tl >> 1) & 63, d16 = (tl & 1) * 16; LAS bf16_t* S = (LAS bf16_t*)(L + (dir ? G2_SB : G2_SF)) + dv * 40 + d16; *(LAS u32x4*)S = raw.s0; *(LAS u32x4*)(S + 8) = raw.s1; }
        __syncthreads();
        const int g = F.lane >> 4, c = F.lane & 15;
        LAS bf16_t* ATT = (LAS bf16_t*)(L + G2_ATT);
#pragma unroll
        for (int kk = 0; kk < 4; ++kk) { const int tile = wl * 4 + kk, mt = tile >> 2, nt = tile & 3;
            f32x4 af = (f32x4){0.f, 0.f, 0.f, 0.f}, ab = af;
            af = mma_lds((const LAS bf16_t*)(L + G2_QTF) + mt * 16 * 40, 40, (const LAS bf16_t*)(L + G2_KTF) + nt * 16 * 40, 40, 1, af, F.lane);
            ab = mma_lds((const LAS bf16_t*)(L + G2_QTB) + mt * 16 * 40, 40, (const LAS bf16_t*)(L + G2_KTB) + nt * 16 * 40, 40, 1, ab, F.lane);
#pragma unroll
            for (int e = 0; e < 4; ++e) { const int ii = mt * 16 + 4 * g + e, j = nt * 16 + c; const float vv = (j <= ii ? af[e] : 0.f) + (j >= ii ? ab[e] : 0.f); ATT[ii * 72 + j] = (bf16_t)f2bf(vv); } }
        __syncthreads();
        LAS float* O = (LAS float*)(L + G2_LAF);
#pragma unroll
        for (int kk = 0; kk < 4; ++kk) { const int tile = wl * 4 + kk, mt = tile >> 2, nt = tile & 3;
            f32x4 a = (f32x4){0.f, 0.f, 0.f, 0.f};
            a = mma_lds(ATT + mt * 16 * 72, 72, (const LAS bf16_t*)(L + G2_VT) + nt * 16 * 72, 72, 2, a, F.lane);
            a = mma_lds((const LAS bf16_t*)(L + G2_QTF) + mt * 16 * 40, 40, (const LAS bf16_t*)(L + G2_SF) + nt * 16 * 40, 40, 1, a, F.lane);
            a = mma_lds((const LAS bf16_t*)(L + G2_QTB) + mt * 16 * 40, 40, (const LAS bf16_t*)(L + G2_SB) + nt * 16 * 40, 40, 1, a, F.lane);
#pragma unroll
            for (int e = 0; e < 4; ++e) O[(mt * 16 + 4 * g + e) * 65 + nt * 16 + c] = a[e]; }
        __syncthreads();
        { const int i = tl >> 2, dv16 = (tl & 3) * 16; const int row = gla_row0(b, cn) + i;
          float v[16], gt[16]; float ss = 0.f;
#pragma unroll
          for (int e = 0; e < 16; ++e) { v[e] = O[i * 65 + dv16 + e]; ss += v[e] * v[e]; }
          ss += shx(ss, 1, F.lane); ss += shx(ss, 2, F.lane);
          const float rs = 1.0f / sqrtf(ss * (1.0f / 64.0f) + LN_EPS);
          unpack8(raw.g0, gt); unpack8(raw.g1, gt + 8);
          const float* gn = F.in[I_GNORM] + l * 64 + dv16;
          unsigned w[8];
#pragma unroll
          for (int e = 0; e < 8; ++e) w[e] = pk2(v[2 * e] * rs * gn[2 * e] * silu_f(gt[2 * e]), v[2 * e + 1] * rs * gn[2 * e + 1] * silu_f(gt[2 * e + 1]));
          bf16_t* mp = (bf16_t*)(F.ws + WS_MIX) + (size_t)row * DM + 512 + h * 64 + dv16;
          *(GAS u32x4*)mp = (u32x4){w[0], w[1], w[2], w[3]}; *(GAS u32x4*)(mp + 8) = (u32x4){w[4], w[5], w[6], w[7]}; }
        raw = nraw;
    }
#undef GLA_UNIT
}

template <int L>
__device__ __forceinline__ void hyena_conv(Frame& F, const bf16_t* Rg, const bf16_t* Uin, const bf16_t* Xmul, int pos0, bool final_out, int ch, bf16_t* Zout) {
    constexpr int CS = 2 * L + 16;
    constexpr int NTL = L / 16, J = (NTL >= 64) ? 16 : 2, NGRP = NTL / J, HJ = J / 2, NSTEP = L / 32;
    LAS bf16_t* Rl = (LAS bf16_t*)F.lds;
    __syncthreads();
    for (int c = F.tid; c < 2 * L / 8; c += NTHR) { const u32x4 v = *(const GAS u32x4*)(Rg + 8 * c); const unsigned a[4] = {v.x, v.y, v.z, v.w};
#pragma unroll
        for (int rho = 0; rho < 8; ++rho) { LAS bf16_t* d = Rl + rho * CS + 8 * c + rho;
#pragma unroll
            for (int k = 0; k < 4; ++k) { d[2 * k] = (bf16_t)(a[k] & 0xffffu); d[2 * k + 1] = (bf16_t)(a[k] >> 16); } } }
    __syncthreads();
    int ln_ = F.lane; asm volatile("" : "+v"(ln_));
    const int i = ln_ & 15, g = ln_ >> 4, rho = i & 7;
    const LAS bf16_t* Rc = Rl + rho * CS + rho;
    for (int grp = F.wave; grp < NGRP; grp += NWAVES) {
        f32x4 acc[J]; bf16x8 fr[J];
        const int tb = grp * J * 16;
        const LAS bf16_t* Rb = Rc + (L - tb - i + 8 * g);
#pragma unroll
        for (int j = 0; j < J; ++j) { acc[j] = (f32x4){0.f, 0.f, 0.f, 0.f}; fr[j] = *(const LAS bf16x8*)(Rb - 16 * j); }
        const char* ub = (const char*)(Uin + pos0); const unsigned ulo = (unsigned)((i * SPB + 8 * g) * 2);
        constexpr int PF = (HJ >= 4) ? 4 : 1;
        bf16x8 bq[PF];
#pragma unroll
        for (int p = 0; p < PF; ++p) bq[p] = *(const GAS bf16x8*)(ub + (size_t)(ulo + (unsigned)p * 64u));
        u32x2 xw[J];
#pragma unroll
        for (int j = 0; j < J; ++j) xw[j] = *(const GAS u32x2*)(Xmul + (size_t)i * SPB + pos0 + tb + j * 16 + 4 * g);
#pragma unroll 1
        for (int q = 0; q < NSTEP / HJ; ++q) {
#pragma unroll
            for (int m = 0; m < HJ; ++m) {
                const int n = q * HJ + m;
                const int nn = (n + PF < NSTEP) ? n + PF : 0;
                if (n > 0) { fr[(J - 2 * m) % J] = *(const LAS bf16x8*)(Rb + 32 * n); fr[(J + 1 - 2 * m) % J] = *(const LAS bf16x8*)(Rb + 32 * n - 16); }
                const bf16x8 bcur = bq[m % PF];
                __builtin_amdgcn_s_setprio(1);
#pragma unroll
                for (int jj = 0; jj < J; ++jj) { const int j = (jj + 2) % J; acc[j] = mfma16(fr[(j + J - 2 * m) % J], bcur, acc[j]); }
                __builtin_amdgcn_s_setprio(0);
                bq[m % PF] = *(const GAS bf16x8*)(ub + (size_t)(ulo + (unsigned)nn * 64u));
            }
        }
#pragma unroll
        for (int j = 0; j < J; ++j) { const int t0 = tb + j * 16 + 4 * g;
            const float y0 = acc[j][0] * bflo(xw[j].x), y1 = acc[j][1] * bfhi(xw[j].x), y2 = acc[j][2] * bflo(xw[j].y), y3 = acc[j][3] * bfhi(xw[j].y);
            if (!final_out) { u32x2 w; w.x = pk2(y0, y1); w.y = pk2(y2, y3); *(GAS u32x2*)(Zout + (size_t)i * SPB + pos0 + t0) = w; }
            else { u32x2 w; w.x = pk2(y0, y1); w.y = pk2(y2, y3); *(GAS u32x2*)((bf16_t*)(F.ws + WS_Y) + ((size_t)ch * NB + i) * SPB + pos0 + t0) = w; } }
    }
}
__device__ __forceinline__ void ph_hyena(Frame& F, int l, bool last) {
    const bf16_t* HV = (const bf16_t*)(F.ws + WS_HV); bf16_t* Z2 = (bf16_t*)(F.ws + WS_Z2);
    for (int ch = F.wg; ch < 256; ch += F.G) {
        const bf16_t* v = HV + (size_t)(0 * 256 + ch) * NB * SPB; const bf16_t* x1 = HV + (size_t)(256 + ch) * NB * SPB; const bf16_t* x2 = HV + (size_t)(512 + ch) * NB * SPB;
        bf16_t* z = Z2 + (size_t)ch * NB * SPB;
        const bf16_t* R0 = (const bf16_t*)(F.ws + WS_HYF) + ((size_t)(l * 2 + 0) * 256 + ch) * 8192; const bf16_t* R1 = (const bf16_t*)(F.ws + WS_HYF) + ((size_t)(l * 2 + 1) * 256 + ch) * 8192;
        hyena_conv<4096>(F, R0, v, x1, 0, false, ch, z);
        VM_WAIT(); __builtin_amdgcn_fence(__ATOMIC_RELEASE, "workgroup"); __syncthreads(); __builtin_amdgcn_fence(__ATOMIC_ACQUIRE, "workgroup");
        hyena_conv<4096>(F, R1, z, x2, 0, true, ch, z);
        if (!last) {
            const bf16_t* C0 = (const bf16_t*)(F.ws + WS_HYFC) + ((size_t)(l * 2 + 0) * 256 + ch) * 512; const bf16_t* C1 = (const bf16_t*)(F.ws + WS_HYFC) + ((size_t)(l * 2 + 1) * 256 + ch) * 512;
            hyena_conv<256>(F, C0, v, x1, SEQ, false, ch, z);
            VM_WAIT(); __builtin_amdgcn_fence(__ATOMIC_RELEASE, "workgroup"); __syncthreads(); __builtin_amdgcn_fence(__ATOMIC_ACQUIRE, "workgroup");
            hyena_conv<256>(F, C1, z, x2, SEQ, true, ch, z);
        }
    }
}

__device__ __forceinline__ void ph_ln1(Frame& F, int l, int ntok) {
    const int gw = F.wg * NWAVES + F.wave, NGW = F.G * NWAVES;
    const int cA = 256 * (F.lane >> 4) + 32 * ((F.lane >> 2) & 3) + 8 * (F.lane & 3);
#define LN1_COL(j) (cA + ((j) < 2 ? 4 * (j) : 128 + 4 * ((j) - 2)))
    const float* lg = F.in[I_LN1G] + l * DM; const float* lb = F.in[I_LN1B] + l * DM;
    for (int row = gw; row < ntok; row += NGW) {
        bf16_t* xr = (bf16_t*)(F.ws + WS_XR) + (size_t)row * DM;
        const unsigned char* yr = (const unsigned char*)(F.ws + WS_Y) + (size_t)row * DM + 16 * F.lane;
        const float* md = mod_ptr(F, l, row);
        const u32x4 xa = __builtin_nontemporal_load((const GAS u32x4*)(xr + cA)), xb = __builtin_nontemporal_load((const GAS u32x4*)(xr + cA + 128)), ya = __builtin_nontemporal_load((const GAS u32x4*)yr);
        float x[16], y[16], v[16]; unpack8(xa, x); unpack8(xb, x + 8);
        { const unsigned a[4] = {ya.x, ya.y, ya.z, ya.w};
#pragma unroll
          for (int e = 0; e < 4; ++e) { const f32x2 lo = __builtin_amdgcn_cvt_pk_f32_fp8((int)a[e], false), hi = __builtin_amdgcn_cvt_pk_f32_fp8((int)a[e], true); y[4 * e] = lo.x; y[4 * e + 1] = lo.y; y[4 * e + 2] = hi.x; y[4 * e + 3] = hi.y; } }
        float s = 0.f;
#pragma unroll
        for (int j = 0; j < 4; ++j) { const f32x4 g1 = *(const GAS f32x4*)(md + 2048 + LN1_COL(j));
#pragma unroll
            for (int e = 0; e < 4; ++e) { v[4 * j + e] = x[4 * j + e] * DN_ALPHA + g1[e] * y[4 * j + e]; s += v[4 * j + e]; } }
        const float mean = wave_sum(s, F.lane) * (1.f / DM); float s2 = 0.f;
#pragma unroll
        for (int e = 0; e < 16; ++e) { v[e] -= mean; s2 += v[e] * v[e]; }
        const float rstd = 1.f / sqrtf(wave_sum(s2, F.lane) * (1.f / DM) + LN_EPS);
        unsigned wx[8]; int w8[4];
#pragma unroll
        for (int j = 0; j < 4; ++j) { const f32x4 g = *(const GAS f32x4*)(lg + LN1_COL(j)), bb = *(const GAS f32x4*)(lb + LN1_COL(j)), sh = *(const GAS f32x4*)(md + 3072 + LN1_COL(j)), sc = *(const GAS f32x4*)(md + 4096 + LN1_COL(j));
            float xn[4];
#pragma unroll
            for (int e = 0; e < 4; ++e) xn[e] = v[4 * j + e] * rstd * g[e] + bb[e];
            wx[2 * j] = pk2(xn[0], xn[1]); wx[2 * j + 1] = pk2(xn[2], xn[3]);
            const float h0 = xn[0] * (1.f + sc[0]) + sh[0], h1 = xn[1] * (1.f + sc[1]) + sh[1], h2 = xn[2] * (1.f + sc[2]) + sh[2], h3 = xn[3] * (1.f + sc[3]) + sh[3];
            int v = 0; v = __builtin_amdgcn_cvt_pk_fp8_f32(h0, h1, v, false); v = __builtin_amdgcn_cvt_pk_fp8_f32(h2, h3, v, true); w8[j] = v; }
        unsigned char* x8 = (unsigned char*)(F.ws + WS_XM8) + (size_t)row * DM;
        __builtin_nontemporal_store((u32x2){(unsigned)w8[0], (unsigned)w8[1]}, (GAS u32x2*)(x8 + cA)); __builtin_nontemporal_store((u32x2){(unsigned)w8[2], (unsigned)w8[3]}, (GAS u32x2*)(x8 + cA + 128));
        __builtin_nontemporal_store((u32x4){wx[0], wx[1], wx[2], wx[3]}, (GAS u32x4*)(xr + cA)); __builtin_nontemporal_store((u32x4){wx[4], wx[5], wx[6], wx[7]}, (GAS u32x4*)(xr + cA + 128));
    }
#undef LN1_COL
}
__device__ __forceinline__ void ph_ln2(Frame& F, int l, int ntok, bool last) {
    const int gw = F.wg * NWAVES + F.wave, NGW = F.G * NWAVES;
    const int cA = 256 * (F.lane >> 4) + 32 * ((F.lane >> 2) & 3) + 8 * (F.lane & 3);
#define LN2_COL(j) (cA + ((j) < 2 ? 4 * (j) : 128 + 4 * ((j) - 2)))
    const float* lg = F.in[I_LN2G] + l * DM; const float* lb = F.in[I_LN2B] + l * DM;
    struct Ln2Raw { u32x2 q[8]; u32x4 qs, xa, xb; };
    auto ln2_load = [&](int row) { Ln2Raw r;
        const unsigned char* y2 = (const unsigned char*)(F.ws + WS_Y2) + (size_t)row * 5120;
        const bf16_t* xr = (const bf16_t*)(F.ws + WS_XR) + (size_t)row * DM;
#pragma unroll
        for (int k = 0; k < 8; ++k) r.q[k] = __builtin_nontemporal_load((const GAS u32x2*)(y2 + k * 512 + 8 * F.lane));
        r.qs = __builtin_nontemporal_load((const GAS u32x4*)(y2 + 4096 + 16 * F.lane));
        r.xa = __builtin_nontemporal_load((const GAS u32x4*)(xr + cA)); r.xb = __builtin_nontemporal_load((const GAS u32x4*)(xr + cA + 128));
        return r; };
    Ln2Raw cur = ln2_load(gw < ntok ? gw : 0);
    for (int row = gw; row < ntok; row += NGW) {
        const Ln2Raw nxt = ln2_load(row + NGW < ntok ? row + NGW : row);
        bf16_t* xr = (bf16_t*)(F.ws + WS_XR) + (size_t)row * DM;
        const float* wg = (const float*)(F.ws + WS_WGT) + (size_t)row * 8;
        const float* md = mod_ptr(F, l, row);
        float ff[16];
#pragma unroll
        for (int e = 0; e < 16; ++e) ff[e] = 0.f;
        { const unsigned a[4] = {cur.qs.x, cur.qs.y, cur.qs.z, cur.qs.w};
#pragma unroll
          for (int e = 0; e < 4; ++e) { const f32x2 lo = __builtin_amdgcn_cvt_pk_f32_fp8((int)a[e], false), hi = __builtin_amdgcn_cvt_pk_f32_fp8((int)a[e], true);
              ff[4 * e] += pg8::Y2_INV * lo.x; ff[4 * e + 1] += pg8::Y2_INV * lo.y; ff[4 * e + 2] += pg8::Y2_INV * hi.x; ff[4 * e + 3] += pg8::Y2_INV * hi.y; } }
#pragma unroll
        for (int k = 0; k < 8; ++k) { const float wk = wg[k] * pg8::Y2_INV; const unsigned a[2] = {cur.q[k].x, cur.q[k].y};
#pragma unroll
            for (int h = 0; h < 2; ++h) {
                const f32x2 p0 = __builtin_amdgcn_cvt_scalef32_pk_f32_fp4(a[h], 1.0f, 0), p1 = __builtin_amdgcn_cvt_scalef32_pk_f32_fp4(a[h], 1.0f, 1), p2 = __builtin_amdgcn_cvt_scalef32_pk_f32_fp4(a[h], 1.0f, 2), p3 = __builtin_amdgcn_cvt_scalef32_pk_f32_fp4(a[h], 1.0f, 3);
                ff[8 * h] += wk * p0.x; ff[8 * h + 1] += wk * p0.y; ff[8 * h + 2] += wk * p1.x; ff[8 * h + 3] += wk * p1.y; ff[8 * h + 4] += wk * p2.x; ff[8 * h + 5] += wk * p2.y; ff[8 * h + 6] += wk * p3.x; ff[8 * h + 7] += wk * p3.y; } }
        float v[16], xo[16]; float s = 0.f;
        unpack8(cur.xa, xo); unpack8(cur.xb, xo + 8);
#pragma unroll
        for (int j = 0; j < 4; ++j) { const f32x4 g2 = *(const GAS f32x4*)(md + 5120 + LN2_COL(j));
#pragma unroll
            for (int e = 0; e < 4; ++e) { v[4 * j + e] = xo[4 * j + e] * DN_ALPHA + g2[e] * ff[4 * j + e]; s += v[4 * j + e]; } }
        const float mean = wave_sum(s, F.lane) * (1.f / DM); float s2 = 0.f;
#pragma unroll
        for (int e = 0; e < 16; ++e) { v[e] -= mean; s2 += v[e] * v[e]; }
        const float rstd = 1.f / sqrtf(wave_sum(s2, F.lane) * (1.f / DM) + LN_EPS);
        const float* mdn = last ? md : mod_ptr(F, l + 1, row);
        float xn[16];
#pragma unroll
        for (int j = 0; j < 4; ++j) { const f32x4 g = *(const GAS f32x4*)(lg + LN2_COL(j)), bb = *(const GAS f32x4*)(lb + LN2_COL(j));
#pragma unroll
            for (int e = 0; e < 4; ++e) xn[4 * j + e] = v[4 * j + e] * rstd * g[e] + bb[e]; }
        if (last) { float* op = F.out + (size_t)row * DM;
#pragma unroll
            for (int j = 0; j < 4; ++j) *(GAS f32x4*)(op + LN2_COL(j)) = (f32x4){xn[4 * j], xn[4 * j + 1], xn[4 * j + 2], xn[4 * j + 3]}; }
        else {
            __builtin_nontemporal_store((u32x4){pk2(xn[0], xn[1]), pk2(xn[2], xn[3]), pk2(xn[4], xn[5]), pk2(xn[6], xn[7])}, (GAS u32x4*)(xr + cA)); __builtin_nontemporal_store((u32x4){pk2(xn[8], xn[9]), pk2(xn[10], xn[11]), pk2(xn[12], xn[13]), pk2(xn[14], xn[15])}, (GAS u32x4*)(xr + cA + 128));
            bf16_t* xm = (bf16_t*)(F.ws + WS_XM) + (size_t)row * DM;
            unsigned w[8];
#pragma unroll
            for (int j = 0; j < 4; ++j) { const f32x4 sh = *(const GAS f32x4*)(mdn + LN2_COL(j)), sc = *(const GAS f32x4*)(mdn + 1024 + LN2_COL(j));
                w[2 * j] = pk2(xn[4 * j] * (1.f + sc[0]) + sh[0], xn[4 * j + 1] * (1.f + sc[1]) + sh[1]); w[2 * j + 1] = pk2(xn[4 * j + 2] * (1.f + sc[2]) + sh[2], xn[4 * j + 3] * (1.f + sc[3]) + sh[3]); }
            *(GAS u32x4*)(xm + cA) = (u32x4){w[0], w[1], w[2], w[3]}; *(GAS u32x4*)(xm + cA + 128) = (u32x4){w[4], w[5], w[6], w[7]};
        }
        cur = nxt;
    }
#undef LN2_COL
}

__device__ __forceinline__ unsigned f_ord(float f) { const unsigned u = __builtin_bit_cast(unsigned, f); return (u & 0x80000000u) ? ~u : (u | 0x80000000u); }
__device__ __forceinline__ unsigned long long wave_max_u64(unsigned long long v, int lane) {
#pragma unroll
    for (int o = 1; o < 64; o <<= 1) { const unsigned lo = (unsigned)shxi((int)(unsigned)v, o, lane), hi = (unsigned)shxi((int)(unsigned)(v >> 32), o, lane); const unsigned long long w = ((unsigned long long)hi << 32) | lo; v = w > v ? w : v; }
    return v;
}
__device__ __forceinline__ float seg16_max(float v, int lane) { v = fmaxf(v, shx(v, 1, lane)); v = fmaxf(v, shx(v, 2, lane)); v = fmaxf(v, shx(v, 4, lane)); v = fmaxf(v, shx(v, 8, lane)); return v; }
__device__ __forceinline__ int seg16_min_i(int v, int lane) { int w; w = shxi(v, 1, lane); v = w < v ? w : v; w = shxi(v, 2, lane); v = w < v ? w : v; w = shxi(v, 4, lane); v = w < v ? w : v; w = shxi(v, 8, lane); v = w < v ? w : v; return v; }
template <int CTRL> __device__ __forceinline__ int dpp_i(int v) { return __builtin_amdgcn_update_dpp(0, v, CTRL, 0xf, 0xf, true); }
__device__ __forceinline__ unsigned row_max_u(unsigned v) { unsigned w; w = (unsigned)dpp_i<0xB1>((int)v); v = w > v ? w : v; w = (unsigned)dpp_i<0x4E>((int)v); v = w > v ? w : v; w = (unsigned)dpp_i<0x141>((int)v); v = w > v ? w : v; w = (unsigned)dpp_i<0x140>((int)v); v = w > v ? w : v; return v; }
__device__ __forceinline__ float row_max_f(float v) { v = fmaxf(v, __builtin_bit_cast(float, dpp_i<0xB1>(__builtin_bit_cast(int, v)))); v = fmaxf(v, __builtin_bit_cast(float, dpp_i<0x4E>(__builtin_bit_cast(int, v)))); v = fmaxf(v, __builtin_bit_cast(float, dpp_i<0x141>(__builtin_bit_cast(int, v)))); v = fmaxf(v, __builtin_bit_cast(float, dpp_i<0x140>(__builtin_bit_cast(int, v)))); return v; }
__device__ __forceinline__ int row_min_i(int v) { int w; w = dpp_i<0xB1>(v); v = w < v ? w : v; w = dpp_i<0x4E>(v); v = w < v ? w : v; w = dpp_i<0x141>(v); v = w < v ? w : v; w = dpp_i<0x140>(v); v = w < v ? w : v; return v; }
__device__ __forceinline__ float rdlane_f(float v, int l) { return __builtin_bit_cast(float, __builtin_amdgcn_readlane(__builtin_bit_cast(int, v), l)); }
__device__ __forceinline__ unsigned wave_max_u(unsigned v) {
    v = row_max_u(v);
    const unsigned a = (unsigned)__builtin_amdgcn_readlane((int)v, 0), b = (unsigned)__builtin_amdgcn_readlane((int)v, 16), c = (unsigned)__builtin_amdgcn_readlane((int)v, 32), d = (unsigned)__builtin_amdgcn_readlane((int)v, 48);
    const unsigned ab = a > b ? a : b, cd = c > d ? c : d; return ab > cd ? ab : cd;
}
__device__ __forceinline__ float row_top2(float v, int l16) {
    const float m1 = row_max_f(v);
    const int first = row_min_i(v == m1 ? l16 : 99);
    const float m2 = row_max_f(l16 == first ? -3.0e38f : v);
    return m1 + m2;
}
__device__ __forceinline__ float seg16_top2(float v, int lane) {
    const float m1 = seg16_max(v, lane);
    const int first = seg16_min_i(v == m1 ? (lane & 15) : 99, lane);
    const float m2 = seg16_max((lane & 15) == first ? -3.0e38f : v, lane);
    return m1 + m2;
}
__device__ __forceinline__ void ph_route(Frame& F, int l, int ntok) {
    LAS int* hist = (LAS int*)F.lds;
    LAS int* base = hist + 128;
    LAS unsigned* alist = (LAS unsigned*)(F.lds + 1024);
    const int tpw = (ntok + F.G - 1) / F.G, t0 = F.wg * tpw, t1 = (t0 + tpw) < ntok ? (t0 + tpw) : ntok;
    __syncthreads();
    if (F.tid < 128) hist[F.tid] = 0;
    __syncthreads();
    const float* LG = (const float*)(F.ws + WS_LOGIT); const float* rb = F.in[I_RB] + l * NEXP;
    const float b0 = rb[F.lane], b1 = rb[F.lane + 64];
    constexpr int RT = 4;
    float xq0[RT], xq1[RT];
#pragma unroll
    for (int j = 0; j < RT; ++j) { int tok = t0 + F.wave * RT + j; tok = tok < t1 ? tok : t1 - 1; tok = tok < 0 ? 0 : tok;
        xq0[j] = LG[(size_t)tok * 256 + F.lane]; xq1[j] = LG[(size_t)tok * 256 + 64 + F.lane]; }
    for (int tb = t0 + F.wave * RT; tb < t1; tb += NWAVES * RT) {
        float s0[RT], s1[RT], e0[RT], e1[RT], gs0[RT], gs1[RT]; unsigned h0[RT], h1[RT]; int mye[RT]; float myw[RT], wsum[RT];
        float xn0[RT], xn1[RT];
#pragma unroll
        for (int j = 0; j < RT; ++j) { int tok = tb + NWAVES * RT + j; tok = tok < t1 ? tok : t1 - 1;
            xn0[j] = LG[(size_t)tok * 256 + F.lane]; xn1[j] = LG[(size_t)tok * 256 + 64 + F.lane]; }
#pragma unroll
        for (int j = 0; j < RT; ++j) { const int tok = (tb + j) < t1 ? tb + j : t1 - 1;
            const float x0 = xq0[j], x1 = xq1[j];
            const float* rbs = (const float*)(F.ws + WS_RBIAS) + (size_t)(l * 17 + row_b(tok)) * 128; const float y0 = x0 + rbs[F.lane], y1 = x1 + rbs[64 + F.lane];
            s0[j] = __builtin_amdgcn_rcpf(1.0f + __expf(-y0)); s1[j] = __builtin_amdgcn_rcpf(1.0f + __expf(-y1)); e0[j] = s0[j] + b0; e1[j] = s1[j] + b1; }
#pragma unroll
        for (int j = 0; j < RT; ++j) { gs0[j] = row_top2(e0[j], F.lane & 15); gs1[j] = row_top2(e1[j], F.lane & 15); }
#pragma unroll
        for (int j = 0; j < RT; ++j) {
            float gsc[8];
#pragma unroll
            for (int g = 0; g < 4; ++g) { gsc[g] = rdlane_f(gs0[j], g * 16); gsc[4 + g] = rdlane_f(gs1[j], g * 16); }
            unsigned gmask = 0u;
#pragma unroll
            for (int g = 0; g < 8; ++g) { int cnt = 0;
#pragma unroll
                for (int g2 = 0; g2 < 8; ++g2) cnt += (gsc[g2] > gsc[g] || (gsc[g2] == gsc[g] && g2 < g)) ? 1 : 0;
                gmask |= (cnt < 4) ? (1u << g) : 0u; }
            const bool ok0 = (gmask >> (F.lane >> 4)) & 1u, ok1 = (gmask >> (4 + (F.lane >> 4))) & 1u;
            h0[j] = ok0 ? f_ord(e0[j]) : 0u; h1[j] = ok1 ? f_ord(e1[j]) : 0u;
            mye[j] = 0; myw[j] = 0.f; wsum[j] = 0.f; }
#pragma unroll
        for (int k = 0; k < 8; ++k) {
#pragma unroll
            for (int j = 0; j < RT; ++j) {
                const unsigned bh = h0[j] >= h1[j] ? h0[j] : h1[j];
                const unsigned H = wave_max_u(bh);
                const unsigned mylo = h0[j] == H ? (unsigned)(255 - F.lane) : (h1[j] == H ? (unsigned)(255 - 64 - F.lane) : 0u);
                const unsigned Lm = wave_max_u(mylo);
                const int e = 255 - (int)Lm;
                if (e < 64) { if (F.lane == e) h0[j] = 0u; } else { if (F.lane == e - 64) h1[j] = 0u; }
                const float sv = e < 64 ? rdlane_f(s0[j], e) : rdlane_f(s1[j], e - 64);
                wsum[j] += sv; if (F.lane == k) { mye[j] = e; myw[j] = sv; } }
        }
#pragma unroll
        for (int j = 0; j < RT; ++j) { const int tok = tb + j;
            if (tok < t1 && F.lane < 8) {
                const int lr = __hip_atomic_fetch_add(&hist[mye[j]], 1, __ATOMIC_RELAXED, __HIP_MEMORY_SCOPE_WORKGROUP);
                alist[(tok - t0) * 8 + F.lane] = (unsigned)mye[j] | ((unsigned)lr << 8);
                ((int*)(F.ws + WS_EIDX))[(size_t)tok * 8 + F.lane] = mye[j];
                ((float*)(F.ws + WS_WGT))[(size_t)tok * 8 + F.lane] = myw[j] / wsum[j] * 2.5f;
            } }
#pragma unroll
        for (int j = 0; j < RT; ++j) { xq0[j] = xn0[j]; xq1[j] = xn1[j]; }
    }
    __syncthreads();
    if (F.tid < 128) { const int hcount = hist[F.tid]; base[F.tid] = hcount ? (int)atomicAdd(F.ctl + CW_CNT + l * 256 + F.tid, (unsigned)hcount) : 0; }
    __syncthreads();
    for (int a = F.tid; a < (t1 - t0) * 8; a += NTHR) { const unsigned v = alist[a]; ((int*)(F.ws + WS_RNK))[(size_t)t0 * 8 + a] = base[v & 0xffu] + (int)(v >> 8); }
}
__device__ __forceinline__ void ph_positions(Frame& F, int l, int ntok) {
    LAS int* cnt = (LAS int*)F.lds;
    LAS int* off = cnt + 132;
    __syncthreads();
    if (F.tid < NE1) cnt[F.tid] = F.tid < NEXP ? (int)__hip_atomic_load(F.ctl + CW_CNT + l * 256 + F.tid, __ATOMIC_RELAXED, __HIP_MEMORY_SCOPE_AGENT) : ntok;
    __syncthreads();
    if (F.tid == 0) { int o = 0; for (int e = 0; e < NE1; ++e) { off[e] = o; o += (cnt[e] + 255) & ~255; } off[NE1] = o; }
    __syncthreads();
    const int gt = F.wg * NTHR + F.tid, NGT = F.G * NTHR;
    int* rowtok = (int*)(F.ws + WS_ROWTOK); int* rowdst = (int*)(F.ws + WS_ROWDST); int* tile_exp = (int*)(F.ws + WS_TILEEXP);
    const int* eidx = (const int*)(F.ws + WS_EIDX); const int* rnk = (const int*)(F.ws + WS_RNK);
    for (int a = gt; a < ntok * 8; a += NGT) { const int tok = a >> 3, k = a & 7; const int pos = off[eidx[a]] + rnk[a]; rowtok[pos] = tok; rowdst[pos] = tok * 10 + k; }
    for (int tok = gt; tok < ntok; tok += NGT) { const int pos = off[NEXP] + tok; rowtok[pos] = tok; rowdst[pos] = tok * 10 + 8; }
    for (int i = gt; i < NE1 * 256; i += NGT) { const int e = i >> 8, p = i & 255; const int row = off[e] + cnt[e] + p; if (row < off[e + 1]) { rowtok[row] = 0; rowdst[row] = -1; } }
    for (int i = gt; i < NE1 * 320; i += NGT) { const int e = i / 320, p = i % 320; const int t = (off[e] >> 8) + p; if (t < (off[e + 1] >> 8)) tile_exp[t] = e; }
    if (gt == 0) F.ctl[CW_NTL + l] = (unsigned)(off[NE1] >> 8);
}

#ifndef MK_MULTI
#define MK_MULTI 0
#endif
constexpr int PH_PER_LAYER = 12, NPHASE = 2 + DEPTH * PH_PER_LAYER;
struct Args { const float* in[36]; float* out; unsigned char* ws; int ph_lo, ph_hi; };

__global__ void __launch_bounds__(NTHR, 2) mk_fwd(Args args) {
    extern __shared__ __attribute__((aligned(16))) unsigned char lds_raw[];
    Frame F;
    F.lds = (LAS unsigned char*)lds_raw;
    F.tid = threadIdx.x; F.lane = F.tid & 63; F.wave = __builtin_amdgcn_readfirstlane(F.tid >> 6);
    const int wave0 = F.wave;
    F.G = gridDim.x; F.wg = blockIdx.x;
    F.in = args.in;
    F.out = args.out; F.ws = args.ws; F.ctl = (unsigned*)(args.ws + WS_CTL);
    volatile LAS unsigned* MISC = (volatile LAS unsigned*)(F.lds + MISC_OFF);
    if (F.tid < 32) MISC[F.tid] = 0u;
    __syncthreads();
    const int lo = args.ph_lo, hi = args.ph_hi;
    const bool single = (hi - lo) > 1;
    XcdBarrier bar; bar.bar = F.ctl + CW_BAR; bar.x = 0; bar.st = nullptr;
    if (single) bar = xcd_barrier_post(F.ctl + CW_BAR, MISC + 8);
#define IN(k) (lo <= (k) && (k) < hi)
#ifndef PROBE_MASK
#define PROBE_MASK 0
#endif
#define REP(k) for (int _rep = 0; _rep < (((PROBE_MASK >> (k)) & 1) ? 2 : 1); ++_rep)
#define SEAM(k) do { if (IN(k) && IN((k) + 1)) { xcd_barrier(bar); if ((PROBE_MASK >> 15) & 1) xcd_barrier(bar); } } while (0)
#define FRESH() do { int _ln; asm volatile("v_mbcnt_lo_u32_b32 %0, -1, 0\n\tv_mbcnt_hi_u32_b32 %0, -1, %0" : "=v"(_ln)); int _wv = wave0; asm volatile("" : "+s"(_wv)); F.lane = _ln; F.wave = _wv; F.tid = (_wv << 6) | _ln; \
        unsigned char* _w = args.ws; asm volatile("" : "+s"(_w)); F.ws = _w; F.ctl = (unsigned*)(_w + WS_CTL); float* _o = args.out; asm volatile("" : "+s"(_o)); F.out = _o; } while (0)

    if (IN(0)) { FRESH(); REP(13) { p0_static_weights(F); __syncthreads(); } REP(14) { p0_mod(F); __syncthreads(); } FRESH(); REP(16) { p0_hyena_filters(F); __syncthreads(); } }
    SEAM(0);
    if (IN(1)) { FRESH(); p0_init_rows(F); __syncthreads(); FRESH(); p1_router_weights(F); }
    SEAM(1);
#pragma unroll 1
    for (int l = 0; l < DEPTH; ++l) {
        const int pb = 2 + l * PH_PER_LAYER; const bool last = (l == DEPTH - 1); const int ntok = last ? NLAT : NROW;
        if (IN(pb + 0)) { FRESH();
            REP(0) { p_expert_weights(F, l, (last || F.G != 256) ? 0 : XW_TAIL_G, XW_ITEMS, F.G * NWAVES, F.wg * NWAVES + F.wave); __syncthreads(); }
            { pg8::ColMapOrder S; S.b.init(NROW, 11 * 256, F.G, F.wg); S.map = 0xCBA98763210ull; pg8::EpiBf16 E{(bf16_t*)(F.ws + WS_U), DIN};
              REP(1) pg8::gemm_phase<pg8::EpiBf16, pg8::ColMapOrder, false>(F.tid, F.lds, (const bf16_t*)(F.ws + WS_XM), (const bf16_t*)(F.ws + WS_WIN) + (size_t)l * DIN * DM, DM, nullptr, S, E); }
            __syncthreads(); FRESH();
            { pg8::ColMapOrder S; S.b.init(NROW, 2 * 256, F.G, (F.wg + 80) % F.G); S.map = 0x54ull; pg8::EpiVT E{(bf16_t*)(F.ws + WS_VT), UV};
              REP(1) pg8::gemm_phase<pg8::EpiVT, pg8::ColMapOrder, false, false, true, true, false, true>(F.tid, F.lds, (const bf16_t*)(F.ws + WS_XM), (const bf16_t*)(F.ws + WS_WIN) + (size_t)l * DIN * DM, DM, nullptr, S, E); }
        }
        SEAM(pb + 0);
        if (IN(pb + 1)) { FRESH(); REP(2) { ph_transposes(F, l); __syncthreads(); } FRESH(); REP(3) { ph_gla_local(F, l); __syncthreads(); } }
        SEAM(pb + 1);
        if (IN(pb + 2)) { FRESH(); REP(4) { ph_na(F, l, last); } FRESH(); REP(5) { ph_gla_scan(F); } __syncthreads(); FRESH(); REP(6) { ph_hyena(F, l, last); } }
        SEAM(pb + 2);
        if (IN(pb + 3)) { FRESH(); ph_hy_transpose(F, last); __syncthreads(); FRESH(); REP(7) { ph_gla_out(F, l, last); } }
        SEAM(pb + 3);
        if (IN(pb + 4)) { FRESH();
            pg8::DenseOrder S; S.init(ntok, DM, F.G, F.wg); pg8::EpiY8 E{(unsigned char*)(F.ws + WS_Y), DM};
            REP(8) pg8::gemm_phase<pg8::EpiY8, pg8::DenseOrder, false>(F.tid, F.lds, (const bf16_t*)(F.ws + WS_MIX), (const bf16_t*)(F.ws + WS_WOUT) + (size_t)l * DM * DM, DM, nullptr, S, E);
            if (!last && F.G == 256 && F.wg >= 64) { __syncthreads(); FRESH(); p_expert_weights(F, l, 0, XW_TAIL_E, 192 * NWAVES, (F.wg - 64) * NWAVES + F.wave); }
        }
        SEAM(pb + 4);
        if (IN(pb + 5)) { FRESH(); ph_ln1(F, l, ntok); }
        SEAM(pb + 5);
        if (IN(pb + 6)) { FRESH();
            pg8::RouterOrder S; S.b.init(ntok, 256, F.G, F.wg); pg8::EpiF32H E{(float*)(F.ws + WS_LOGIT), 256};
            REP(9) pg8::gemm_phase<pg8::EpiF32H, pg8::RouterOrder, false, false, true, true, true>(F.tid, F.lds, (const bf16_t*)(F.ws + WS_XR), (const bf16_t*)(F.ws + WS_WRB) + (size_t)l * 17 * 128 * DM, DM, nullptr, S, E);
            if (!last && F.G == 256 && F.wg >= 16) { __syncthreads(); FRESH(); p_expert_weights(F, l, XW_TAIL_E, XW_TAIL_G, 240 * NWAVES, (F.wg - 16) * NWAVES + F.wave); }
        }
        SEAM(pb + 6);
        if (IN(pb + 7)) { FRESH(); ph_route(F, l, ntok); }
        SEAM(pb + 7);
        if (IN(pb + 8)) { FRESH(); REP(12) { ph_positions(F, l, ntok); __syncthreads(); } }
        SEAM(pb + 8);
        if (IN(pb + 9)) { FRESH();
            const int ntl = (int)__hip_atomic_load(F.ctl + CW_NTL + l, __ATOMIC_RELAXED, __HIP_MEMORY_SCOPE_AGENT);
            pg8::GroupedOrder S; S.init(ntl, 2, F.G, F.wg); S.preload((const int*)(F.ws + WS_TILEEXP), F.lds + pg8::STAGE_BYTES + 4096, F.tid, NTHR); pg8::EpiSwiglu E{(unsigned char*)(F.ws + WS_ACT)};
            REP(10) pg8::gemm_phase<pg8::EpiSwiglu, pg8::GroupedOrder, true, true>(F.tid, F.lds, (const void*)(F.ws + WS_XM8), (const void*)(F.ws + WS_EXP1), DM, (const int*)(F.ws + WS_ROWTOK), S, E);
        }
        SEAM(pb + 9);
        if (IN(pb + 10)) { FRESH();
            const int ntl = (int)__hip_atomic_load(F.ctl + CW_NTL + l, __ATOMIC_RELAXED, __HIP_MEMORY_SCOPE_AGENT);
            pg8::GroupedOrder S; S.init(ntl, 4, F.G, F.wg); S.preload((const int*)(F.ws + WS_TILEEXP), F.lds + pg8::STAGE_BYTES + 4096, F.tid, NTHR); pg8::EpiScatter E{(unsigned char*)(F.ws + WS_Y2), (const int*)(F.ws + WS_ROWDST)};
            REP(11) pg8::gemm_phase<pg8::EpiScatter, pg8::GroupedOrder, false, true>(F.tid, F.lds, (const void*)(F.ws + WS_ACT), (const void*)(F.ws + WS_EXP2), EH, nullptr, S, E);
        }
        SEAM(pb + 10);
        if (IN(pb + 11)) { FRESH(); ph_ln2(F, l, ntok, last); }
        SEAM(pb + 11);
    }
#undef IN
#undef SEAM
#undef FRESH
}

extern "C" void kernel_launch(void* const* d_in, const int* in_sizes, int n_in, void* d_out, int out_size, void* d_ws, size_t ws_size, hipStream_t stream) {
    static int grid = 0;
    if (grid == 0) {
        if (n_in != 36 || out_size != NLAT * DM || ws_size < WS_END) { fprintf(stderr, "kernel_launch: unexpected shapes (n_in %d out %d ws %zu need %zu)\n", n_in, out_size, ws_size, (size_t)WS_END); grid = -1; return; }
        int dev = 0, cus = 0, per_cu = 0;
        if (hipGetDevice(&dev) != hipSuccess || hipDeviceGetAttribute(&cus, hipDeviceAttributeMultiprocessorCount, dev) != hipSuccess) { grid = -1; return; }
        if (hipFuncSetAttribute((const void*)mk_fwd, hipFuncAttributeMaxDynamicSharedMemorySize, LDS_BYTES) != hipSuccess) { fprintf(stderr, "kernel_launch: hipFuncSetAttribute failed\n"); grid = -1; return; }
        if (hipOccupancyMaxActiveBlocksPerMultiprocessor(&per_cu, (const void*)mk_fwd, NTHR, LDS_BYTES) != hipSuccess || per_cu < 1) { fprintf(stderr, "kernel_launch: occupancy query says %d\n", per_cu); }
        (void)hipGetLastError();
        grid = cus;
    }
    if (grid < 0) return;
    (void)hipMemsetAsync((char*)d_ws + WS_CTL, 0, CTL_BYTES, stream);
    Args a{};
    for (int i = 0; i < 36; ++i) a.in[i] = (const float*)d_in[i];
    a.out = (float*)d_out; a.ws = (unsigned char*)d_ws;
#if MK_MULTI
    for (int p = 0; p < NPHASE; ++p) { a.ph_lo = p; a.ph_hi = p + 1; hipLaunchKernelGGL(mk_fwd, dim3(grid), dim3(NTHR), LDS_BYTES, stream, a); }
#else
    a.ph_lo = 0; a.ph_hi = NPHASE; hipLaunchKernelGGL(mk_fwd, dim3(grid), dim3(NTHR), LDS_BYTES, stream, a);
#endif
}
```
